# Optimizing an MI355X kernel written in HIP

```python
import math
import jax, jax.numpy as jnp
from jax import lax
import numpy as np

D_MODEL = 1024
BATCH = 2
SEQ = 16384
DEPTH = 2

PLE_DIM = 256
HEAD_DIM = 64
DIFF_HEADS = 4
DSA_HEADS = 8
IDX_HEADS = 8
IDX_DIM = 64
TOPK_MAX = 256
N_GROUPS = 4
EXPERTS_PER_GROUP = 8
TOP_K_IN_GROUP = 2
D_EXPERT = 256
ROPE_THETA = 500000.0
ROT_DIM = HEAD_DIM // 4
Q_BLOCK = 128
LN_EPS = 1e-5
NEG_INF = -1e30
ALPHA = (2 * DEPTH) ** 0.25
BETA = (8 * DEPTH) ** -0.25
DIFF_WIDTH = DIFF_HEADS * 2 * HEAD_DIM
DSA_WIDTH = DSA_HEADS * HEAD_DIM
SPLIT_SIZES = (DIFF_WIDTH, DIFF_WIDTH, DIFF_WIDTH, DSA_WIDTH, DSA_WIDTH, DSA_WIDTH,
               IDX_HEADS * IDX_DIM, IDX_DIM, IDX_HEADS, D_MODEL, D_MODEL)
W_IN_COLS = sum(SPLIT_SIZES)

kernel_name = 'hybrid_diffattn_dsa_hiermoe_deepnorm'


def layer_norm(x, g, b):
    xf = x.astype(jnp.float32)
    mu = jnp.mean(xf, axis=-1, keepdims=True)
    var = jnp.mean(jnp.square(xf - mu), axis=-1, keepdims=True)
    y = (xf - mu) * lax.rsqrt(var + LN_EPS)
    return (y * g.astype(jnp.float32) + b.astype(jnp.float32)).astype(x.dtype)


def rms_norm(x, g):
    xf = x.astype(jnp.float32)
    y = xf * lax.rsqrt(jnp.mean(jnp.square(xf), axis=-1, keepdims=True) + LN_EPS)
    return (y * g.astype(jnp.float32)).astype(x.dtype)


def rope_tables(positions):
    inv_freq = 1.0 / (ROPE_THETA ** (jnp.arange(0, ROT_DIM, 2, dtype=jnp.float32) / ROT_DIM))
    ang = positions.astype(jnp.float32)[..., None] * inv_freq
    return jnp.cos(ang), jnp.sin(ang)


def partial_rope(t, cos, sin):
    half = ROT_DIM // 2
    shp = cos.shape[:2] + (1,) * (t.ndim - 3) + (half,)
    c = cos.reshape(shp).astype(t.dtype)
    s = sin.reshape(shp).astype(t.dtype)
    x1 = t[..., :half]
    x2 = t[..., half:ROT_DIM]
    return jnp.concatenate([x1 * c - x2 * s, x2 * c + x1 * s, t[..., ROT_DIM:]], axis=-1)


def diff_attention(q, k, v, lam):
    B, S, H, _, dk = q.shape
    nb = S // Q_BLOCK
    scale = dk ** -0.5
    qb = q.reshape(B, nb, Q_BLOCK, H, 2, dk).swapaxes(0, 1)
    key_pos = jnp.arange(S)

    def one_block(args):
        q_i, b_i = args
        q_pos = b_i * Q_BLOCK + jnp.arange(Q_BLOCK)
        s = jnp.einsum('bqhcd,bkhcd->bhcqk', q_i, k).astype(jnp.float32) * scale
        s = jnp.where(key_pos[None, :] <= q_pos[:, None], s, NEG_INF)
        pr = jax.nn.softmax(s, axis=-1)
        a = pr[:, :, 0] - lam * pr[:, :, 1]
        return jnp.einsum('bhqk,bkhe->bqhe', a.astype(v.dtype), v)

    o = lax.map(one_block, (qb, jnp.arange(nb)))
    return o.swapaxes(0, 1).reshape(B, S, H, v.shape[-1])


def dsa_attention(q, k, v, q_idx, k_idx, w_idx, topk):
    B, S, H, dh = q.shape
    nb = S // Q_BLOCK
    scale = dh ** -0.5
    to_blocks = lambda t: t.reshape((B, nb, Q_BLOCK) + t.shape[2:]).swapaxes(0, 1)
    key_pos = jnp.arange(S)

    def one_block(args):
        q_b, qi_b, wi_b, b_i = args
        q_pos = b_i * Q_BLOCK + jnp.arange(Q_BLOCK)
        dots = jnp.einsum('bqhd,bsd->bqhs', qi_b, k_idx).astype(jnp.float32) * (IDX_DIM ** -0.5)
        score = jnp.einsum('bqhs,bqh->bqs', jax.nn.relu(dots), wi_b.astype(jnp.float32))
        score = jnp.where(key_pos[None, None, :] <= q_pos[None, :, None], score, NEG_INF)
        _, sel = lax.top_k(score, topk)
        valid = sel <= q_pos[None, :, None]
        kg = jax.vmap(lambda kb, ib: kb[ib])(k, sel)
        vg = jax.vmap(lambda vb, ib: vb[ib])(v, sel)
        s = jnp.einsum('bqhd,bqkhd->bhqk', q_b, kg).astype(jnp.float32) * scale
        s = jnp.where(valid[:, None], s, NEG_INF)
        pr = jax.nn.softmax(s, axis=-1)
        return jnp.einsum('bhqk,bqkhd->bqhd', pr.astype(v.dtype), vg)

    o = lax.map(one_block, (to_blocks(q), to_blocks(q_idx), to_blocks(w_idx), jnp.arange(nb)))
    return o.swapaxes(0, 1).reshape(B, S, H * dh)


def token_mixers(x, cos, sin, w_in, lam_params, subln_g, w_bd, w_bs, w_o, lam_init):
    B, S, _ = x.shape
    h = x @ w_in
    points = [int(c) for c in np.cumsum(SPLIT_SIZES)[:-1]]
    dq, dkk, dv, sq, sk, sv, iq, ik, iw, ga, gb = jnp.split(h, points, axis=-1)

    dq = partial_rope(dq.reshape(B, S, DIFF_HEADS, 2, HEAD_DIM), cos, sin)
    dkk = partial_rope(dkk.reshape(B, S, DIFF_HEADS, 2, HEAD_DIM), cos, sin)
    dv = dv.reshape(B, S, DIFF_HEADS, 2 * HEAD_DIM)
    lp = lam_params.astype(jnp.float32)
    lam = jnp.exp(jnp.sum(lp[0] * lp[1])) - jnp.exp(jnp.sum(lp[2] * lp[3])) + lam_init
    ya = diff_attention(dq, dkk, dv, lam)
    ya = (rms_norm(ya, subln_g) * (1.0 - lam_init)).reshape(B, S, DIFF_WIDTH)

    sq = partial_rope(sq.reshape(B, S, DSA_HEADS, HEAD_DIM), cos, sin)
    sk = partial_rope(sk.reshape(B, S, DSA_HEADS, HEAD_DIM), cos, sin)
    sv = sv.reshape(B, S, DSA_HEADS, HEAD_DIM)
    iq = partial_rope(iq.reshape(B, S, IDX_HEADS, IDX_DIM), cos, sin)
    ik = partial_rope(ik, cos, sin)
    iw = iw * (IDX_HEADS ** -0.5)
    topk = min(TOPK_MAX, S // 4)
    yb = dsa_attention(sq, sk, sv, iq, ik, iw, topk)

    merged = jax.nn.sigmoid(ga) * (ya @ w_bd) + jax.nn.sigmoid(gb) * (yb @ w_bs)
    return merged @ w_o


def hierarchical_moe(x, w_rg, b_rg, w_re, b_re, w_g, w_u, w_d):
    B, S, D = x.shape
    xt = x.reshape(-1, D)
    n = xt.shape[0]
    g_prob = jax.nn.softmax((xt @ w_rg).astype(jnp.float32) + b_rg.astype(jnp.float32), axis=-1)
    g_val, g_idx = lax.top_k(g_prob, 1)
    e_logit = ((xt @ w_re).astype(jnp.float32) + b_re.astype(jnp.float32)).reshape(n, N_GROUPS, EXPERTS_PER_GROUP)
    e_logit = jnp.take_along_axis(e_logit, g_idx[:, :, None], axis=1)[:, 0]
    e_prob = jax.nn.softmax(e_logit, axis=-1)
    e_val, e_idx = lax.top_k(e_prob, TOP_K_IN_GROUP)
    e_val = e_val / jnp.sum(e_val, axis=-1, keepdims=True)
    within = jnp.sum(jax.nn.one_hot(e_idx, EXPERTS_PER_GROUP, dtype=jnp.float32) * e_val[..., None], axis=1)
    comb = jax.nn.one_hot(g_idx[:, 0], N_GROUPS, dtype=jnp.float32)[:, :, None] * (g_val * within)[:, None, :]
    y = jnp.zeros_like(xt)
    for g in range(N_GROUPS):
        hg = jax.nn.silu(jnp.einsum('nd,edf->nef', xt, w_g[g])) * jnp.einsum('nd,edf->nef', xt, w_u[g])
        y = y + jnp.einsum('nef,efd->nd', hg * comb[:, g, :, None].astype(hg.dtype), w_d[g])
    return y.reshape(B, S, D)


def setup_inputs(seed: int = 0) -> dict:
    key = jax.random.key(seed)
    ks = jax.random.split(key, 24)
    L, D = DEPTH, D_MODEL
    G, E, F = N_GROUPS, EXPERTS_PER_GROUP, D_EXPERT
    nrm = lambda k, shape, scale: jax.random.normal(k, shape, jnp.float32) * scale
    return {
        'x': nrm(ks[0], (BATCH, SEQ, D), 1.0),
        'p': nrm(ks[1], (L, BATCH, SEQ, PLE_DIM), 1.0),
        'positions': jnp.broadcast_to(jnp.arange(SEQ, dtype=jnp.int32), (BATCH, SEQ)),
        'w_in': nrm(ks[2], (L, D, W_IN_COLS), D ** -0.5),
        'diff_lambda': nrm(ks[3], (L, 4, HEAD_DIM), 0.1),
        'diff_subln_g': 1.0 + nrm(ks[4], (L, 2 * HEAD_DIM), 0.01),
        'w_branch_diff': nrm(ks[5], (L, DIFF_WIDTH, D), DIFF_WIDTH ** -0.5),
        'w_branch_dsa': nrm(ks[6], (L, DSA_WIDTH, D), DSA_WIDTH ** -0.5),
        'w_out': nrm(ks[7], (L, D, D), BETA * D ** -0.5),
        'ln1_g': 1.0 + nrm(ks[8], (L, D), 0.01),
        'ln1_b': nrm(ks[9], (L, D), 0.01),
        'w_route_group': nrm(ks[10], (L, D, G), D ** -0.5),
        'b_route_group': nrm(ks[11], (L, G), 0.01),
        'w_route_expert': nrm(ks[12], (L, D, G * E), D ** -0.5),
        'b_route_expert': nrm(ks[13], (L, G * E), 0.01),
        'w_exp_gate': nrm(ks[14], (L, G, E, D, F), D ** -0.5),
        'w_exp_up': nrm(ks[15], (L, G, E, D, F), D ** -0.5),
        'w_exp_down': nrm(ks[16], (L, G, E, F, D), BETA * F ** -0.5),
        'w_ple': nrm(ks[17], (L, PLE_DIM, D), BETA * PLE_DIM ** -0.5),
        'w_ple_gate': nrm(ks[18], (L, D, D), D ** -0.5),
        'ln2_g': 1.0 + nrm(ks[19], (L, D), 0.01),
        'ln2_b': nrm(ks[20], (L, D), 0.01),
    }


def reference(x, p, positions, w_in, diff_lambda, diff_subln_g, w_branch_diff, w_branch_dsa,
              w_out, ln1_g, ln1_b, w_route_group, b_route_group, w_route_expert, b_route_expert,
              w_exp_gate, w_exp_up, w_exp_down, w_ple, w_ple_gate, ln2_g, ln2_b):
    cos, sin = rope_tables(positions)
    for i in range(DEPTH):
        lam_init = 0.8 - 0.6 * math.exp(-0.3 * i)
        mix = token_mixers(x, cos, sin, w_in[i], diff_lambda[i], diff_subln_g[i],
                           w_branch_diff[i], w_branch_dsa[i], w_out[i], lam_init)
        x = layer_norm(ALPHA * x + mix, ln1_g[i], ln1_b[i])
        ffn = hierarchical_moe(x, w_route_group[i], b_route_group[i], w_route_expert[i],
                               b_route_expert[i], w_exp_gate[i], w_exp_up[i], w_exp_down[i])
        ple = jax.nn.sigmoid(x @ w_ple_gate[i]) * (p[i] @ w_ple[i])
        x = layer_norm(ALPHA * x + ffn + ple, ln2_g[i], ln2_b[i])
    return x
```

```cpp
#include <hip/hip_runtime.h>
#include <hip/hip_bf16.h>
#include <cstdio>
#include <cstdint>
#include <cmath>

__device__ __forceinline__ int ltid(int wave) { int t = (wave << 6) | (int)__builtin_amdgcn_mbcnt_hi(~0u, __builtin_amdgcn_mbcnt_lo(~0u, 0u)); asm volatile("" : "+v"(t)); return t; }

namespace pg8 {
#define PG8_LAS __attribute__((address_space(3)))
typedef unsigned short bf16_t;
typedef short bf16x8 __attribute__((ext_vector_type(8)));
typedef float f32x4 __attribute__((ext_vector_type(4)));
typedef unsigned u32x4 __attribute__((ext_vector_type(4)));
constexpr int BM = 256, BK = 64, HALF = 128, HTB = HALF * BK * 2  , STAGE_BYTES = 8 * HTB, NXCD = 8, WGM = 8;
constexpr float C2 = 0.125f * 1.4426950408889634f;

__host__ __device__ __forceinline__ int lds_byte(int r, int c) { const int st = (r >> 4) * 2 + (c >> 5), rr = r & 15, cc = c & 31, ob = rr * 64 + cc * 2; return st * 1024 + (ob ^ (((ob >> 9) & 1) << 5)); }
__host__ __device__ __forceinline__ void stage_rc(int b, int& R, int& C) { const int st = b / 1024, sb = b % 1024, swz = sb ^ (((sb >> 9) & 1) << 5); R = (st >> 1) * 16 + swz / 64; C = (st & 1) * 32 + (swz % 64) / 2; }
__host__ __device__ __forceinline__ int perm32(int rho) { const int n = rho >> 4, i = rho & 15; return 8 * (i >> 2) + 4 * n + (i & 3); }

struct Unit { int pm, pn; long boff; };
struct Gemm { const bf16_t* A; const bf16_t* Bt; int K, lda, ldb; const int* rows; };

struct StaticOrder {
    int nM, nN, nwg, G, c, ldb;
    __device__ void init(int M, int N, int G_, int c_, int ldb_) { nM = M / BM; nN = N / BM; nwg = nM * nN; G = G_; c = c_; ldb = ldb_; }
    __device__ bool next(int i, Unit& u) const {
        const long L = (long)i * G + c; if (L >= nwg) return false;
        int wgid = (int)L; { const int q = nwg / NXCD, r = nwg % NXCD, xcd = wgid % NXCD, off = wgid / NXCD; wgid = (xcd < r ? xcd * (q + 1) : r * (q + 1) + (xcd - r) * q) + off; }
        const int nig = WGM * nN, gid = wgid / nig, fm = gid * WGM, gsz = (nM - fm) < WGM ? (nM - fm) : WGM;
        u.pm = fm + ((wgid % nig) % gsz); u.pn = (wgid % nig) / gsz; u.boff = (long)u.pn * BM * ldb; return true;
    }
};

__device__ __forceinline__ unsigned cvt_pk_bf16(float lo, float hi) { unsigned r; asm volatile("v_cvt_pk_bf16_f32 %0, %1, %2" : "=v"(r) : "v"(lo), "v"(hi)); return r; }
__device__ __forceinline__ float bf_lo(unsigned w) { return __uint_as_float(w << 16); }
__device__ __forceinline__ float bf_hi(unsigned w) { return __uint_as_float(w & 0xffff0000u); }
__device__ __forceinline__ float sigm(float x) { return __builtin_amdgcn_rcpf(1.f + __builtin_amdgcn_exp2f(-1.4426950408889634f * x)); }
__device__ __forceinline__ u32x4 pack8(f32x4 a, f32x4 b) { u32x4 w; w.x = cvt_pk_bf16(a[0], a[1]); w.y = cvt_pk_bf16(a[2], a[3]); w.z = cvt_pk_bf16(b[0], b[1]); w.w = cvt_pk_bf16(b[2], b[3]); return w; }
__device__ __forceinline__ void unpack8(u32x4 w, f32x4& a, f32x4& b) { a = (f32x4){bf_lo(w.x), bf_hi(w.x), bf_lo(w.y), bf_hi(w.y)}; b = (f32x4){bf_lo(w.z), bf_hi(w.z), bf_lo(w.w), bf_hi(w.w)}; }

#define PG8_EPI_ARGS const f32x4 (&acc)[2][2][4][2], const Unit& u, int wr, int wc, int fr, int fq

#define PG8_PIN(x) asm volatile("" : "+v"(x))
template <class T> __device__ __forceinline__ T& at(const void* base, unsigned byteoff) { return *(T*)((char*)base + byteoff); }

struct EpiProj {
    bf16_t* base; size_t tstride; bf16_t* IK; float* IW; const float* rope;
    __device__ __forceinline__ void operator()(PG8_EPI_ARGS) const {
        const int pn = u.pn, row0 = u.pm * BM + wr * 64 + fr;
        if (pn < 14) {
            const int t = pn >> 1;
            bf16_t* dst = base + (size_t)t * tstride;
            const bool rp = (t == 0) | (t == 1) | (t == 3) | (t == 4) | (t == 6);
            const float sc = (t == 0 || t == 3) ? C2 : (t == 6 ? 0.125f : 1.f);
            const bool rotw = rp && ((wc & 1) == 0);
            const unsigned cb = (unsigned)((pn & 1) * 256 + wc * 32 + 8 * fq) * 2u;
#pragma unroll
            for (int ai = 0; ai < 2; ++ai)
#pragma unroll
                for (int m = 0; m < 4; ++m) {
                    unsigned row = (unsigned)(row0 + ai * HALF + m * 16); PG8_PIN(row);
                    f32x4 c0 = {1.f, 1.f, 1.f, 1.f}, c1 = c0, s0 = {0.f, 0.f, 0.f, 0.f}, s1 = s0;
                    if (rotw) { c0 = at<const f32x4>(rope, row * 64u); c1 = at<const f32x4>(rope, row * 64u + 16u); s0 = at<const f32x4>(rope, row * 64u + 32u); s1 = at<const f32x4>(rope, row * 64u + 48u); }
#pragma unroll
                    for (int bj = 0; bj < 2; ++bj) {
                        f32x4 v0 = acc[ai][bj][m][0], v1 = acc[ai][bj][m][1];
                        if (rotw) {
                            f32x4 p0, p1;
#pragma unroll
                            for (int i = 0; i < 4; ++i) { p0[i] = __shfl_xor(v0[i], 16); p1[i] = __shfl_xor(v1[i], 16); }
                            const float sg = (fq == 0) ? -1.f : 1.f;
                            const f32x4 r0 = v0 * c0 + (p0 * s0) * sg, r1 = v1 * c1 + (p1 * s1) * sg;
                            if (fq < 2) { v0 = r0; v1 = r1; }
                        }
                        v0 = v0 * sc; v1 = v1 * sc;
                        at<u32x4>(dst, row * 1024u + cb + bj * 256u) = pack8(v0, v1);
                    }
                    asm volatile("" ::: "memory");
                }
        } else {
#pragma unroll
            for (int ai = 0; ai < 2; ++ai)
#pragma unroll
                for (int m = 0; m < 4; ++m) {
                    unsigned row = (unsigned)(row0 + ai * HALF + m * 16); PG8_PIN(row);
                    f32x4 v0 = acc[ai][0][m][0], v1 = acc[ai][0][m][1];
                    if (wc == 0) {
                        const f32x4 c0 = at<const f32x4>(rope, row * 64u), c1 = at<const f32x4>(rope, row * 64u + 16u), s0 = at<const f32x4>(rope, row * 64u + 32u), s1 = at<const f32x4>(rope, row * 64u + 48u);
                        f32x4 p0, p1;
#pragma unroll
                        for (int i = 0; i < 4; ++i) { p0[i] = __shfl_xor(v0[i], 16); p1[i] = __shfl_xor(v1[i], 16); }
                        const float sg = (fq == 0) ? -1.f : 1.f;
                        const f32x4 r0 = v0 * c0 + (p0 * s0) * sg, r1 = v1 * c1 + (p1 * s1) * sg;
                        if (fq < 2) { v0 = r0; v1 = r1; }
                    }
                    if (wc < 2) at<u32x4>(IK, row * 128u + (unsigned)(wc * 32 + 8 * fq) * 2u) = pack8(v0, v1);
                    else if (wc == 2 && fq == 0) { at<f32x4>(IW, row * 32u) = v0 * 0.35355339059f; at<f32x4>(IW, row * 32u + 16u) = v1 * 0.35355339059f; }
                    asm volatile("" ::: "memory");
                }
        }
    }
};
struct EpiSig {
    bf16_t* out; int ldc;
    __device__ __forceinline__ void operator()(PG8_EPI_ARGS) const {
        const unsigned o0 = ((unsigned)(u.pm * BM + wr * 64 + fr) * 1024u + (unsigned)(u.pn * BM + wc * 32 + 8 * fq)) * 2u;
#pragma unroll
        for (int ai = 0; ai < 2; ++ai)
#pragma unroll
            for (int m = 0; m < 4; ++m) {
                unsigned o = o0 + (unsigned)(ai * HALF + m * 16) * 2048u; PG8_PIN(o);
#pragma unroll
                for (int bj = 0; bj < 2; ++bj) {
                    f32x4 v0 = acc[ai][bj][m][0], v1 = acc[ai][bj][m][1];
#pragma unroll
                    for (int i = 0; i < 4; ++i) { v0[i] = sigm(v0[i]); v1[i] = sigm(v1[i]); }
                    at<u32x4>(out, o + bj * 256u) = pack8(v0, v1);
                }
                asm volatile("" ::: "memory");
            }
    }
};
struct EpiGated {
    const bf16_t* gate; const bf16_t* addsrc; bf16_t* out; int ldc;
    __device__ __forceinline__ void operator()(PG8_EPI_ARGS) const {
        const unsigned o0 = ((unsigned)(u.pm * BM + wr * 64 + fr) * 1024u + (unsigned)(u.pn * BM + wc * 32 + 8 * fq)) * 2u;
#pragma unroll
        for (int ai = 0; ai < 2; ++ai)
#pragma unroll
            for (int m = 0; m < 4; ++m) {
                unsigned o = o0 + (unsigned)(ai * HALF + m * 16) * 2048u; PG8_PIN(o);
#pragma unroll
                for (int bj = 0; bj < 2; ++bj) {
                    f32x4 g0, g1; unpack8(at<const u32x4>(gate, o + bj * 256u), g0, g1);
                    f32x4 v0 = acc[ai][bj][m][0] * g0, v1 = acc[ai][bj][m][1] * g1;
                    if (addsrc) { f32x4 a0, a1; unpack8(at<const u32x4>(addsrc, o + bj * 256u), a0, a1); v0 = v0 + a0; v1 = v1 + a1; }
                    at<u32x4>(out, o + bj * 256u) = pack8(v0, v1);
                }
                asm volatile("" ::: "memory");
            }
    }
};
struct EpiResF32 {
    const float* x; float* out; float alpha;
    __device__ __forceinline__ void operator()(PG8_EPI_ARGS) const {
        const unsigned o0 = ((unsigned)(u.pm * BM + wr * 64 + fr) * 1024u + (unsigned)(u.pn * BM + wc * 32 + 8 * fq)) * 4u;
#pragma unroll
        for (int ai = 0; ai < 2; ++ai)
#pragma unroll
            for (int m = 0; m < 4; ++m) {
                unsigned o = o0 + (unsigned)(ai * HALF + m * 16) * 4096u; PG8_PIN(o);
#pragma unroll
                for (int bj = 0; bj < 2; ++bj) {
                    const f32x4 x0 = at<const f32x4>(x, o + bj * 512u), x1 = at<const f32x4>(x, o + bj * 512u + 16u);
                    at<f32x4>(out, o + bj * 512u) = x0 * alpha + acc[ai][bj][m][0]; at<f32x4>(out, o + bj * 512u + 16u) = x1 * alpha + acc[ai][bj][m][1];
                }
                asm volatile("" ::: "memory");
            }
    }
};
struct EpiGU {
    bf16_t* HG; const float* cw;
    __device__ __forceinline__ void operator()(PG8_EPI_ARGS) const {
        const int row0 = u.pm * BM + wr * 64 + fr; const unsigned cb = (unsigned)(u.pn * HALF + wc * 32 + 8 * fq) * 2u;
#pragma unroll
        for (int ai = 0; ai < 2; ++ai)
#pragma unroll
            for (int m = 0; m < 4; ++m) {
                unsigned row = (unsigned)(row0 + ai * HALF + m * 16); PG8_PIN(row);
                const float c = at<const float>(cw, row * 4u);
                f32x4 g0 = acc[ai][0][m][0], g1 = acc[ai][0][m][1]; const f32x4 u0 = acc[ai][1][m][0], u1 = acc[ai][1][m][1];
#pragma unroll
                for (int i = 0; i < 4; ++i) { g0[i] = g0[i] * sigm(g0[i]) * u0[i] * c; g1[i] = g1[i] * sigm(g1[i]) * u1[i] * c; }
                at<u32x4>(HG, row * 512u + cb) = pack8(g0, g1);
                asm volatile("" ::: "memory");
            }
    }
};
struct EpiDown {
    const int* ent; bf16_t* Y0; unsigned ystride;
    __device__ __forceinline__ void operator()(PG8_EPI_ARGS) const {
        const int row0 = u.pm * BM + wr * 64 + fr; const unsigned cb = (unsigned)(u.pn * BM + wc * 32 + 8 * fq) * 2u;
#pragma unroll
        for (int ai = 0; ai < 2; ++ai)
#pragma unroll
            for (int m = 0; m < 4; ++m) {
                unsigned row = (unsigned)(row0 + ai * HALF + m * 16); PG8_PIN(row);
                const int e = at<const int>(ent, row * 4u);
                if (e >= 0) { bf16_t* dst = Y0; const unsigned o = (unsigned)(e >> 1) * 2048u + cb + (unsigned)(e & 1) * ystride;
#pragma unroll
                    for (int bj = 0; bj < 2; ++bj) at<u32x4>(dst, o + bj * 256u) = pack8(acc[ai][bj][m][0], acc[ai][bj][m][1]); }
                asm volatile("" ::: "memory");
            }
    }
};
struct EpiStore {
    bf16_t* out; int ldc;
    __device__ __forceinline__ void operator()(PG8_EPI_ARGS) const {
        const unsigned o0 = ((unsigned)(u.pm * BM + wr * 64 + fr) * 1024u + (unsigned)(u.pn * BM + wc * 32 + 8 * fq)) * 2u;
#pragma unroll
        for (int ai = 0; ai < 2; ++ai)
#pragma unroll
            for (int m = 0; m < 4; ++m) {
                unsigned o = o0 + (unsigned)(ai * HALF + m * 16) * 2048u; PG8_PIN(o);
#pragma unroll
                for (int bj = 0; bj < 2; ++bj) at<u32x4>(out, o + bj * 256u) = pack8(acc[ai][bj][m][0], acc[ai][bj][m][1]);
                asm volatile("" ::: "memory");
            }
    }
};
struct EpiPle {
    const bf16_t* t1; bf16_t* out;
    __device__ __forceinline__ void operator()(PG8_EPI_ARGS) const {
        const unsigned o0 = ((unsigned)(u.pm * BM + wr * 64 + fr) * 1024u + (unsigned)(u.pn * BM + wc * 32 + 8 * fq)) * 2u;
#pragma unroll
        for (int ai = 0; ai < 2; ++ai)
#pragma unroll
            for (int m = 0; m < 4; ++m) {
                unsigned o = o0 + (unsigned)(ai * HALF + m * 16) * 2048u; PG8_PIN(o);
#pragma unroll
                for (int bj = 0; bj < 2; ++bj) {
                    f32x4 t0, t1v; unpack8(at<const u32x4>(t1, o + bj * 256u), t0, t1v);
                    f32x4 v0 = acc[ai][bj][m][0], v1 = acc[ai][bj][m][1];
#pragma unroll
                    for (int i = 0; i < 4; ++i) { v0[i] = sigm(v0[i]) * t0[i]; v1[i] = sigm(v1[i]) * t1v[i]; }
                    at<u32x4>(out, o + bj * 256u) = pack8(v0, v1);
                }
                asm volatile("" ::: "memory");
            }
    }
};

template <class Epi, class Sched, bool ALIGN_EPI, bool GATHER = false>
__device__ __forceinline__ void gemm_phase(PG8_LAS unsigned char* lds, const Gemm g, const Sched& S, const Epi& E, int wave_in) {
    const int tid = ltid(wave_in), wid = __builtin_amdgcn_readfirstlane(tid >> 6), lane = tid & 63, wr = wid >> 2, wc = wid & 3, fr = lane & 15, fq = lane >> 4;
    int K_ = g.K; asm volatile("" : "+s"(K_));
    const int K = K_, nt = K / BK;
    int RA[2], CA[2]; unsigned voffB[2], voffA[2];
#pragma unroll
    for (int i = 0; i < 2; ++i) { int R, C; stage_rc(tid * 16 + i * 8192, R, C); const int Rb = (R & ~31) + perm32(R & 31); RA[i] = R; CA[i] = C; voffB[i] = (unsigned)(Rb * g.ldb + C) * 2u; voffA[i] = (unsigned)(R * g.lda + C) * 2u; }
    const size_t hstepA = (size_t)HALF * g.lda * 2;
    const size_t kstep = (size_t)(BK * 2);
    const size_t hstepB = (size_t)HALF * g.ldb * 2;
    const unsigned ldsw = (unsigned)wid * 1024u;
    const int aoff = lds_byte(wr * 64 + fr, fq * 8), boff = lds_byte(wc * 32 + fr, fq * 8);
    const char* Ab = (const char*)g.A;
#define PG8_SA(b, h) (((b) * 2 + (h)) * HTB)
#define PG8_SB(b, h) ((4 + (b) * 2 + (h)) * HTB)
#define PG8_STAGE_A(bufoff, kb, OFF, h) do { _Pragma("unroll") for (int _i = 0; _i < 2; ++_i) { const char* _p; \
        if constexpr (GATHER) _p = Ab + (kb) + (OFF##_v)[h][_i]; else _p = Ab + ((kb) + (OFF##_u) + (size_t)(h) * hstepA) + voffA[_i]; \
        __builtin_amdgcn_global_load_lds((const unsigned*)_p, (PG8_LAS unsigned*)(lds + (bufoff) + ldsw + _i * 8192), 16, 0, 0); } } while (0)
#define PG8_STAGE_B(bufoff, gbase) do { _Pragma("unroll") for (int _i = 0; _i < 2; ++_i) \
        __builtin_amdgcn_global_load_lds((const unsigned*)((const char*)(gbase) + voffB[_i]), (PG8_LAS unsigned*)(lds + (bufoff) + ldsw + _i * 8192), 16, 0, 0); } while (0)
#define PG8_MKOFF(uu, OFF) do { if constexpr (GATHER) { _Pragma("unroll") for (int _h = 0; _h < 2; ++_h) _Pragma("unroll") for (int _i = 0; _i < 2; ++_i) { \
        const int _row = g.rows[(uu).pm * BM + _h * HALF + RA[_i]]; (OFF##_v)[_h][_i] = (unsigned)(_row * g.lda + CA[_i]) * 2u; } } else { OFF##_u = (size_t)(uu).pm * BM * g.lda * 2; } } while (0)
#define PG8_LDA(dst, b, h) do { _Pragma("unroll") for (int m = 0; m < 4; ++m) _Pragma("unroll") for (int k = 0; k < 2; ++k) dst[m][k] = *(const PG8_LAS bf16x8*)(lds + PG8_SA(b, h) + aoff + m * 2048 + k * 1024); } while (0)
#define PG8_LDB(dst, b, h) do { _Pragma("unroll") for (int n = 0; n < 2; ++n) _Pragma("unroll") for (int k = 0; k < 2; ++k) dst[n][k] = *(const PG8_LAS bf16x8*)(lds + PG8_SB(b, h) + boff + n * 2048 + k * 1024); } while (0)
#define PG8_MMA(ai, bj, At, Bt) do { __builtin_amdgcn_s_setprio(1); _Pragma("unroll") for (int m = 0; m < 4; ++m) _Pragma("unroll") for (int n = 0; n < 2; ++n) _Pragma("unroll") for (int k = 0; k < 2; ++k) \
        acc[ai][bj][m][n] = __builtin_amdgcn_mfma_f32_16x16x32_bf16(Bt[n][k], At[m][k], acc[ai][bj][m][n], 0, 0, 0); __builtin_amdgcn_s_setprio(0); } while (0)
#define PG8_WAIT_V(n) asm volatile("s_waitcnt vmcnt(" #n ")" ::: "memory")
#define PG8_WAIT_L(n) asm volatile("s_waitcnt lgkmcnt(" #n ")" ::: "memory")
#define PG8_BAR __builtin_amdgcn_s_barrier()
#define PG8_SCHED __builtin_amdgcn_sched_barrier(0)
    Unit cur, nxt; int ui = 0;
    if (!S.next(0, cur)) return;
    f32x4 acc[2][2][4][2];
#pragma unroll
    for (int a = 0; a < 2; ++a)
#pragma unroll
        for (int b = 0; b < 2; ++b)
#pragma unroll
            for (int m = 0; m < 4; ++m)
#pragma unroll
                for (int n = 0; n < 2; ++n) acc[a][b][m][n] = (f32x4){0.f, 0.f, 0.f, 0.f};
    bf16x8 At[4][2], B0[2][2], B1[2][2];
    unsigned offAc_v[2][2], offAn_v[2][2]; size_t offAc_u = 0, offAn_u = 0;
    PG8_MKOFF(cur, offAc);
    const char* cB = (const char*)(g.Bt + cur.boff);
    PG8_STAGE_B(PG8_SB(0, 0), cB); PG8_STAGE_B(PG8_SB(0, 1), cB + hstepB); PG8_STAGE_A(PG8_SA(0, 0), 0, offAc, 0); PG8_STAGE_A(PG8_SA(0, 1), 0, offAc, 1);
    if (wr == 1) PG8_BAR;
    PG8_WAIT_V(2); PG8_BAR;
    PG8_STAGE_B(PG8_SB(1, 0), cB + kstep); PG8_STAGE_A(PG8_SA(1, 0), kstep, offAc, 0); PG8_STAGE_B(PG8_SB(1, 1), cB + hstepB + kstep);
    PG8_WAIT_V(6); PG8_BAR;
    for (;;) {
        const bool has_next = S.next(ui + 1, nxt);
        if (has_next) { PG8_MKOFF(nxt, offAn); }
        else { offAn_u = offAc_u;
#pragma unroll
            for (int h = 0; h < 2; ++h)
#pragma unroll
                for (int i = 0; i < 2; ++i) offAn_v[h][i] = offAc_v[h][i];
        }
        const char* nB = has_next ? (const char*)(g.Bt + nxt.boff) : cB;
        for (int t = 0; t < nt; t += 2) {
            const bool last = (t == nt - 2);
            const size_t a1k = (size_t)(t + 1) * kstep;
            const size_t a2k = last ? (size_t)0 : (size_t)(t + 2) * kstep; const char* b2 = last ? nB : cB + (size_t)(t + 2) * kstep;
            const size_t a3k = a2k + kstep; const char* b3 = b2 + kstep;
            unsigned o2_v[2][2]; const size_t o2_u = last ? offAn_u : offAc_u;
#pragma unroll
            for (int h = 0; h < 2; ++h)
#pragma unroll
                for (int i = 0; i < 2; ++i) o2_v[h][i] = last ? offAn_v[h][i] : offAc_v[h][i];
            PG8_LDB(B0, 0, 0); PG8_LDB(B1, 0, 1); PG8_SCHED; PG8_LDA(At, 0, 0); PG8_STAGE_A(PG8_SA(1, 1), a1k, offAc, 1);
            PG8_WAIT_V(8); PG8_WAIT_L(0); PG8_BAR; PG8_MMA(0, 0, At, B0); PG8_MMA(0, 1, At, B1); PG8_BAR; PG8_SCHED;
            PG8_LDA(At, 0, 1); PG8_STAGE_B(PG8_SB(0, 0), b2); PG8_STAGE_B(PG8_SB(0, 1), b2 + hstepB); PG8_STAGE_A(PG8_SA(0, 0), a2k, o2, 0);
            PG8_WAIT_V(8); PG8_WAIT_L(0); PG8_BAR; PG8_MMA(1, 0, At, B0); PG8_MMA(1, 1, At, B1); PG8_BAR; PG8_SCHED;
            PG8_LDB(B0, 1, 0); PG8_LDB(B1, 1, 1); PG8_SCHED; PG8_LDA(At, 1, 0); PG8_STAGE_A(PG8_SA(0, 1), a2k, o2, 1);
            PG8_WAIT_V(8); PG8_WAIT_L(0); PG8_BAR; PG8_MMA(0, 0, At, B0); PG8_MMA(0, 1, At, B1); PG8_BAR; PG8_SCHED;
            PG8_LDA(At, 1, 1); PG8_STAGE_B(PG8_SB(1, 0), b3); PG8_STAGE_B(PG8_SB(1, 1), b3 + hstepB); PG8_STAGE_A(PG8_SA(1, 0), a3k, o2, 0);
            PG8_WAIT_V(8); PG8_WAIT_L(0); PG8_BAR; PG8_MMA(1, 0, At, B0); PG8_MMA(1, 1, At, B1); PG8_BAR; PG8_SCHED;
        }
        if constexpr (ALIGN_EPI) { if (wr == 0) PG8_BAR; }
        E(acc, cur, wr, wc, fr, fq);
        if (!has_next) break;
#pragma unroll
        for (int a = 0; a < 2; ++a)
#pragma unroll
            for (int b = 0; b < 2; ++b)
#pragma unroll
                for (int m = 0; m < 4; ++m)
#pragma unroll
                    for (int n = 0; n < 2; ++n) acc[a][b][m][n] = (f32x4){0.f, 0.f, 0.f, 0.f};
        cur = nxt; cB = nB; ++ui; offAc_u = offAn_u;
#pragma unroll
        for (int h = 0; h < 2; ++h)
#pragma unroll
            for (int i = 0; i < 2; ++i) offAc_v[h][i] = offAn_v[h][i];
        if constexpr (ALIGN_EPI) { if (wr == 1) PG8_BAR; }
    }
    PG8_WAIT_V(0);
    if constexpr (!ALIGN_EPI) { if (wr == 0) PG8_BAR; }
    PG8_BAR;
#undef PG8_SA
#undef PG8_SB
#undef PG8_STAGE_A
#undef PG8_STAGE_B
#undef PG8_MKOFF
#undef PG8_LDA
#undef PG8_LDB
#undef PG8_MMA
#undef PG8_WAIT_V
#undef PG8_WAIT_L
#undef PG8_BAR
#undef PG8_SCHED
}
}
namespace attn_body {
using bf16=__hip_bfloat16;
using bf16x8=__attribute__((ext_vector_type(8)))short;
using s16x4=__attribute__((ext_vector_type(4)))short;
using f32x16=__attribute__((ext_vector_type(16)))float;
using u32x4=__attribute__((ext_vector_type(4)))unsigned;
constexpr int BATCH=2,SEQ=16384,D=64,DM=512;
constexpr int NW=8,QBLK=32,QB=QBLK*NW,KVBLK=64,NQB=SEQ/QB;
constexpr int ATTN_PITCH=DM, ATTN_UNIT_ROWS=QB;
__device__ __forceinline__ int crow(int r,int hi){return (r&3)+8*(r>>2)+4*hi;}
#define SBAR() __builtin_amdgcn_sched_barrier(0)
__device__ __forceinline__ void cmask(f32x16&p0,f32x16&p1,int jb,int qrel,int hi){
  const float NEG=-INFINITY; int kb=64*jb+4*hi;
  #pragma unroll
  for(int r=0;r<16;++r){int kv=kb+(r&3)+8*(r>>2); if(kv>qrel)p0[r]=NEG; if(kv+32>qrel)p1[r]=NEG;}
}

constexpr int NSLOT=3, SLOTB=8192;
constexpr int LDS_K=0, LDS_V=NSLOT*SLOTB, LDS_WS=2*NSLOT*SLOTB, LDS_OST=LDS_WS+NW*64*4, LDS_MK=LDS_OST+NW*4096, LDS_BYTES=LDS_MK+NW*1024;
constexpr float C2=0.125f*1.4426950408889634f;
__device__ __forceinline__ void glds16(const void*gsrc,unsigned lds_dst){unsigned keep;
  asm volatile("s_mov_b32 %0, m0\n\ts_mov_b32 m0, %2\n\ts_nop 0\n\tglobal_load_lds_dwordx4 %1, off\n\ts_mov_b32 m0, %0":"=&s"(keep):"v"(gsrc),"s"(lds_dst):"memory");}
__device__ __forceinline__ float max3f(float a,float b,float c){float r;asm("v_max3_f32 %0, %1, %2, %3":"=v"(r):"v"(a),"v"(b),"v"(c));return r;}
__device__ __forceinline__ float max2f(float a,float b){float r;asm("v_max_f32_e32 %0, %1, %2":"=v"(r):"v"(a),"v"(b));return r;}
__device__ __forceinline__ float fadd_s(float a,float b){float r;asm("v_add_f32_e32 %0, %1, %2":"=v"(r):"v"(a),"v"(b));return r;}
__device__ __forceinline__ float fsub_s(float a,float b){float r;asm("v_sub_f32_e32 %0, %1, %2":"=v"(r):"v"(a),"v"(b));return r;}
typedef float f32x2_t __attribute__((ext_vector_type(2))); typedef __bf16 bf16x2_t __attribute__((ext_vector_type(2)));
__device__ __forceinline__ unsigned cvtpk_s(float lo,float hi){f32x2_t v={lo,hi};bf16x2_t b=__builtin_convertvector(v,bf16x2_t);return __builtin_bit_cast(unsigned,b);}
#define WAIT_BAR(N) asm volatile("s_waitcnt vmcnt(" #N ") lgkmcnt(0)\n\ts_barrier":::"memory")

__device__ __forceinline__ void qkt(f32x16&p0,f32x16&p1,const char*Kslot,const bf16x8*qr,const f32x16&negm,int r32,int hi){
  const char*kb=Kslot+hi*1024+r32*16;
  #pragma unroll
  for(int d0=0;d0<4;++d0){
    const bf16x8 b0=*reinterpret_cast<const bf16x8*>(kb+d0*2048);
    const bf16x8 b1=*reinterpret_cast<const bf16x8*>(kb+d0*2048+512);
    if(d0==0){p0=__builtin_amdgcn_mfma_f32_32x32x16_bf16(b0,qr[0],negm,0,0,0);p1=__builtin_amdgcn_mfma_f32_32x32x16_bf16(b1,qr[0],negm,0,0,0);}
    else{p0=__builtin_amdgcn_mfma_f32_32x32x16_bf16(b0,qr[d0],p0,0,0,0);p1=__builtin_amdgcn_mfma_f32_32x32x16_bf16(b1,qr[d0],p1,0,0,0);}}
}
typedef __attribute__((address_space(3))) const char* lds_cptr;
typedef short v4i16_t __attribute__((ext_vector_type(4)));
__device__ __forceinline__ void kload8(bf16x8*kf,lds_cptr kp){
  kf[0]=*(const __attribute__((address_space(3))) bf16x8*)(kp);      kf[1]=*(const __attribute__((address_space(3))) bf16x8*)(kp+512);
  kf[2]=*(const __attribute__((address_space(3))) bf16x8*)(kp+2048); kf[3]=*(const __attribute__((address_space(3))) bf16x8*)(kp+2560);
  kf[4]=*(const __attribute__((address_space(3))) bf16x8*)(kp+4096); kf[5]=*(const __attribute__((address_space(3))) bf16x8*)(kp+4608);
  kf[6]=*(const __attribute__((address_space(3))) bf16x8*)(kp+6144); kf[7]=*(const __attribute__((address_space(3))) bf16x8*)(kp+6656);
}
__device__ __forceinline__ void kload2(bf16x8*kf,lds_cptr kp,int j){ kf[2*j]=*(const __attribute__((address_space(3))) bf16x8*)(kp+j*2048); kf[2*j+1]=*(const __attribute__((address_space(3))) bf16x8*)(kp+j*2048+512); }
__device__ __forceinline__ s16x4 vtr(lds_cptr p){ return __builtin_bit_cast(s16x4,__builtin_amdgcn_ds_read_tr16_b64_v4i16((__attribute__((address_space(3))) v4i16_t*)p)); }
__device__ __forceinline__ float rowmax(const f32x16&p0,const f32x16&p1){
  float a=max3f(p0[0],p0[1],p1[0]),b=max3f(p0[2],p0[3],p1[1]);a=max3f(a,p1[2],p1[3]);
  #pragma unroll
  for(int r=4;r<16;r+=4){a=max3f(a,p0[r],p0[r+1]);b=max3f(b,p0[r+2],p0[r+3]);a=max3f(a,p1[r],p1[r+1]);b=max3f(b,p1[r+2],p1[r+3]);}
  const float m=max2f(a,b);
  auto rr=__builtin_amdgcn_permlane32_swap(__float_as_uint(m),__float_as_uint(m),false,false);
  return max2f(__uint_as_float(rr[0]),__uint_as_float(rr[1]));
}
__device__ __forceinline__ void pv(f32x16*o,int vb,bf16x8 pa0,bf16x8 pa1,bf16x8 pa2,bf16x8 pa3){
  #pragma unroll
  for(int d0=0;d0<2;++d0){s16x4 lo[4],hi[4];
    #pragma unroll
    for(int ks=0;ks<4;++ks){
      asm volatile("ds_read_b64_tr_b16 %0,%1 offset:%c2":"=&v"(lo[ks]):"v"(vb),"i"(d0*4096+ks*1024):"memory");
      asm volatile("ds_read_b64_tr_b16 %0,%1 offset:%c2":"=&v"(hi[ks]):"v"(vb),"i"(d0*4096+ks*1024+512):"memory");}
    asm volatile("s_waitcnt lgkmcnt(0)":::"memory");SBAR();
    #define PK(k) (bf16x8){lo[k][0],lo[k][1],lo[k][2],lo[k][3],hi[k][0],hi[k][1],hi[k][2],hi[k][3]}
    o[d0]=__builtin_amdgcn_mfma_f32_32x32x16_bf16(pa0,PK(0),o[d0],0,0,0);
    o[d0]=__builtin_amdgcn_mfma_f32_32x32x16_bf16(pa1,PK(1),o[d0],0,0,0);
    o[d0]=__builtin_amdgcn_mfma_f32_32x32x16_bf16(pa2,PK(2),o[d0],0,0,0);
    o[d0]=__builtin_amdgcn_mfma_f32_32x32x16_bf16(pa3,PK(3),o[d0],0,0,0);
    #undef PK
  }
}

#ifndef ATTN_STORE16
#define ATTN_STORE16(p,v) (*(u32x4*)(p)=(v))
#endif
template<int THRL,bool MASKED> __device__ __forceinline__ void attn_unit(int b,int hq,int hv,int qb,const bf16*Q,const bf16*__restrict__ K,const bf16*__restrict__ V,bf16*O,const unsigned long long*__restrict__ MK,char*shm,int wave_in){
  const int tid=ltid(wave_in),lane=tid&63,r32=lane&31,hi=lane>>5; const int wid=__builtin_amdgcn_readfirstlane(tid>>6);
  const long rowbase=(long)b*SEQ; const int q0=qb*QB;
  const bf16*Qw=Q+(rowbase+q0+wid*QBLK)*DM+hq*D;
  const bf16*Kh=K+rowbase*DM+hq*D,*Vh=V+rowbase*DM+hv*D;
  const unsigned lds0=(unsigned)(uintptr_t)shm;
  float*wsf=(float*)(shm+LDS_WS)+wid*64;
  const bf16*ksrc=Kh+(long)lane*DM+wid*8;
  const bf16*vsrc=Vh+(long)(16*(wid&3)+(lane>>2))*DM+(wid>>2)*32+(lane&3)*8;
  const unsigned kdst=lds0+LDS_K+wid*1024, vdst=lds0+LDS_V+wid*1024;
  #define DMA_K(t,slot) glds16(ksrc+(long)(t)*KVBLK*DM,(unsigned)__builtin_amdgcn_readfirstlane(kdst+(slot)))
  #define DMA_V(t,slot) glds16(vsrc+(long)(t)*KVBLK*DM,(unsigned)__builtin_amdgcn_readfirstlane(vdst+(slot)))
  const long mq0=(long)q0+wid*QBLK+2*(lane&15); const unsigned mdst=lds0+LDS_MK+wid*1024;
  #define DMA_M(t) do{ if(MASKED){ if(lane<16){ const long t_=(t); glds16(MK+(16384L*t_-32L*t_*(t_-1)+mq0-64L*t_),(unsigned)__builtin_amdgcn_readfirstlane(mdst+(((t)&3)*256))); } } }while(0)
  unsigned mw0=0xffffffffu,mw1=0xffffffffu;
  #define MKRD(t) do{ if(MASKED){ const unsigned long long w_=*(const __attribute__((address_space(3))) unsigned long long*)(shm3+LDS_MK+wid*1024+(((t)&3)*256)+r32*8); mw0=((unsigned)w_)>>(4*hi); mw1=((unsigned)(w_>>32))>>(4*hi); } }while(0)
  #define MAND(X,r,MW) do{ if(MASKED){ X[r]=__uint_as_float(__float_as_uint(X[r])&(unsigned)__builtin_amdgcn_sbfe((int)(MW),((r)&3)+8*((r)>>2),1)); } }while(0)
  const int vb0=(int)(lds0+LDS_V)+((lane>>4)&1)*32+(lane&3)*8+(4*hi+((lane&15)>>2))*64;
  const char*Kbase=shm+LDS_K; bf16x8 kf[8];
  const lds_cptr shm3=(lds_cptr)shm; const lds_cptr kp0=shm3+LDS_K+hi*1024+r32*16; const lds_cptr vp0=shm3+LDS_V+((lane>>4)&1)*32+(lane&3)*8+(4*hi+((lane&15)>>2))*64;
  const int NT=(q0+QB)/KVBLK;
  DMA_M(0);DMA_K(0,0);DMA_V(0,0);DMA_K(1,SLOTB);
  bf16x8 qr[4];
  #pragma unroll
  for(int d0=0;d0<4;++d0)qr[d0]=*reinterpret_cast<const bf16x8*>(&Qw[(long)r32*DM+d0*16+hi*8]);
  float mhat=0.f,l_reg=0.f;f32x16 o[2];o[0]=f32x16{};o[1]=f32x16{};f32x16 negm=f32x16{};asm volatile("":"+v"(negm));
  const int qrel=wid*QBLK+r32;
  #define CMASK(P0,P1,t) do{int jb_=(t)-(NT-4); if(jb_>=0)cmask(P0,P1,jb_,qrel,hi);}while(0)
  bool resc=false;
  #define START(P0,P1) do{ const float rm=rowmax(P0,P1); resc=false; \
    { const float dl=rm; mhat=fadd_s(mhat,dl); \
      _Pragma("unroll") for(int r=0;r<16;++r){P0[r]=fsub_s(P0[r],dl);P1[r]=fsub_s(P1[r],dl);} \
      _Pragma("unroll") for(int r=0;r<16;++r)negm[r]=-mhat; asm volatile("":"+v"(negm)); } \
    _Pragma("unroll") for(int r=0;r<16;++r)P0[r]=__builtin_amdgcn_exp2f(P0[r]); }while(0)
  #define RESC() do{ if(resc){ asm volatile("s_waitcnt lgkmcnt(0)":::"memory"); \
      _Pragma("unroll") for(int d_=0;d_<2;++d_) _Pragma("unroll") for(int r=0;r<16;++r)o[d_][r]*=wsf[crow(r,hi)]; } }while(0)
  f32x16 pA0,pA1,pB0,pB1;
  int sl_prev=0,sl_cur=0,sl_next=SLOTB;
  #define ROT() do{sl_prev=sl_cur;sl_cur=sl_next;sl_next=(sl_next==(NSLOT-1)*SLOTB)?0:sl_next+SLOTB;}while(0)
  DMA_K(2,2*SLOTB);DMA_M(1);
  if(MASKED){WAIT_BAR(4);}else{WAIT_BAR(3);}
  qkt(pA0,pA1,Kbase,qr,negm,r32,hi);asm volatile("s_nop 15\n\ts_nop 7":"+v"(pA0),"+v"(pA1));CMASK(pA0,pA1,0);
  START(pA0,pA1);
  _Pragma("unroll") for(int r=0;r<16;++r)pA1[r]=__builtin_amdgcn_exp2f(pA1[r]);
  MKRD(0); _Pragma("unroll") for(int r=0;r<16;++r){MAND(pA0,r,mw0);MAND(pA1,r,mw1);}
  WAIT_BAR(0);
  DMA_K(3,0);DMA_V(1,SLOTB);DMA_M(2);
  ROT();
  kload8(kf,kp0+sl_cur);
  if(MASKED){WAIT_BAR(3);}else{WAIT_BAR(2);}
  s16x4 vlo[8],vhi[8]; u32x4 pw0,pw1,pw2,pw3;
  #define PKW(P,B) cvtpk_s(P[B],P[B+1])
  #define PAF(k) __builtin_bit_cast(bf16x8,pw##k)
  #define VFR(i) (bf16x8){vlo[i][0],vlo[i][1],vlo[i][2],vlo[i][3],vhi[i][0],vhi[i][1],vhi[i][2],vhi[i][3]}
  #define PIN(x) asm volatile("":"+v"(x))
  #define MX3(a,b,c) __builtin_fmaxf(__builtin_fmaxf((a),(b)),(c))
  #define GAPA(MF,A0,A1,A2,A3,W0,W1,PW) do{ MF; sacc+=A0; sacc+=A1; sacc+=A2; sacc+=A3; PIN(sacc); W0; W1; PIN(PW); SBAR(); }while(0)
  #define EX(v) __builtin_amdgcn_exp2f(v)
  #define GAPB(MF,X,B,MW) do{ MF; X[B]=EX(X[B]); X[B+1]=EX(X[B+1]); X[B+2]=EX(X[B+2]); X[B+3]=EX(X[B+3]); MAND(X,B,MW); MAND(X,B+1,MW); MAND(X,B+2,MW); MAND(X,B+3,MW); PIN(X); SBAR(); }while(0)
  #define VRD(i) do{ vlo[i]=vtr(vp_+(((i)>>2)*4096+((i)&3)*1024)); vhi[i]=vtr(vp_+(((i)>>2)*4096+((i)&3)*1024+512)); }while(0)
  #define KRD(G,j) do{ if(G){ kload2(kf,kp0+sl_next,j); SBAR(); } }while(0)
  #define STEP(C0,C1,P0,P1,t,GK,GV,GL,GM) do{ SBAR(); \
    const lds_cptr vp_=vp0+sl_prev; \
    VRD(0); SBAR(); float sacc=(P0[0]+P0[1]); \
    GAPA(C0=__builtin_amdgcn_mfma_f32_32x32x16_bf16(kf[0],qr[0],negm,0,0,0), P0[2],P0[3],P0[4],P0[5],     pw0[0]=PKW(P0,0), pw0[1]=PKW(P0,2), pw0); \
    VRD(4); SBAR(); GAPA(C1=__builtin_amdgcn_mfma_f32_32x32x16_bf16(kf[1],qr[0],negm,0,0,0), P0[6],P0[7],P0[8],P0[9],     pw0[2]=PKW(P0,4), pw0[3]=PKW(P0,6), pw0); \
    VRD(1); SBAR(); GAPA(C0=__builtin_amdgcn_mfma_f32_32x32x16_bf16(kf[2],qr[1],C0,0,0,0),   P0[10],P0[11],P0[12],P0[13], pw1[0]=PKW(P0,8), pw1[1]=PKW(P0,10), pw1); \
    VRD(5); SBAR(); GAPA(C1=__builtin_amdgcn_mfma_f32_32x32x16_bf16(kf[3],qr[1],C1,0,0,0),   P0[14],P0[15],P1[0],P1[1],   pw1[2]=PKW(P0,12),pw1[3]=PKW(P0,14), pw1); \
    VRD(2); SBAR(); GAPA(C0=__builtin_amdgcn_mfma_f32_32x32x16_bf16(kf[4],qr[2],C0,0,0,0),   P1[2],P1[3],P1[4],P1[5],     pw2[0]=PKW(P1,0), pw2[1]=PKW(P1,2), pw2); \
    VRD(6); SBAR(); GAPA(C1=__builtin_amdgcn_mfma_f32_32x32x16_bf16(kf[5],qr[2],C1,0,0,0),   P1[6],P1[7],P1[8],P1[9],     pw2[2]=PKW(P1,4), pw2[3]=PKW(P1,6), pw2); \
    VRD(3); SBAR(); GAPA(C0=__builtin_amdgcn_mfma_f32_32x32x16_bf16(kf[6],qr[3],C0,0,0,0),   P1[10],P1[11],P1[12],P1[13], pw3[0]=PKW(P1,8), pw3[1]=PKW(P1,10), pw3); \
    VRD(7); SBAR(); GAPA(C1=__builtin_amdgcn_mfma_f32_32x32x16_bf16(kf[7],qr[3],C1,0,0,0),   P1[14],P1[15],0.f,0.f,       pw3[2]=PKW(P1,12),pw3[3]=PKW(P1,14), pw3); \
    l_reg+=sacc; \
    if(GK){DMA_K((t)+3,sl_cur);} if(GV){DMA_V((t)+1,sl_next);} if(GM){DMA_M((t)+2);} MKRD(t); \
    CMASK(C0,C1,t); \
    { float a=MX3(C0[0],C0[1],C1[0]),b=MX3(C0[2],C0[3],C1[1]); a=MX3(a,C1[2],C1[3]); \
      _Pragma("unroll") for(int r=4;r<16;r+=4){a=MX3(a,C0[r],C0[r+1]);b=MX3(b,C0[r+2],C0[r+3]);a=MX3(a,C1[r],C1[r+1]);b=MX3(b,C1[r+2],C1[r+3]);} \
      float rm=__builtin_fmaxf(a,b); { auto rr=__builtin_amdgcn_permlane32_swap(__float_as_uint(rm),__float_as_uint(rm),false,false); rm=__builtin_fmaxf(__uint_as_float(rr[0]),__uint_as_float(rr[1])); } \
      resc=false; \
      if(__builtin_expect(__any(rm>(float)THRL),0)){ const float dl=__builtin_fmaxf(rm,0.f); mhat+=dl; \
        _Pragma("unroll") for(int r=0;r<16;++r){C0[r]-=dl;C1[r]-=dl;} \
        _Pragma("unroll") for(int r=0;r<16;++r)negm[r]=-mhat; asm volatile("":"+v"(negm)); \
        const float f=__builtin_amdgcn_exp2f(-dl); l_reg*=f; if(hi==0)wsf[r32]=f; resc=true; } } \
    SBAR(); \
    GAPB(o[0]=__builtin_amdgcn_mfma_f32_32x32x16_bf16(PAF(0),VFR(0),o[0],0,0,0), C0,0,mw0); \
    GAPB(o[1]=__builtin_amdgcn_mfma_f32_32x32x16_bf16(PAF(0),VFR(4),o[1],0,0,0), C0,4,mw0); \
    KRD(GL,0); GAPB(o[0]=__builtin_amdgcn_mfma_f32_32x32x16_bf16(PAF(1),VFR(1),o[0],0,0,0), C0,8,mw0); \
    KRD(GL,1); GAPB(o[1]=__builtin_amdgcn_mfma_f32_32x32x16_bf16(PAF(1),VFR(5),o[1],0,0,0), C0,12,mw0); \
    KRD(GL,2); GAPB(o[0]=__builtin_amdgcn_mfma_f32_32x32x16_bf16(PAF(2),VFR(2),o[0],0,0,0), C1,0,mw1); \
    KRD(GL,3); GAPB(o[1]=__builtin_amdgcn_mfma_f32_32x32x16_bf16(PAF(2),VFR(6),o[1],0,0,0), C1,4,mw1); \
    GAPB(o[0]=__builtin_amdgcn_mfma_f32_32x32x16_bf16(PAF(3),VFR(3),o[0],0,0,0), C1,8,mw1); \
    GAPB(o[1]=__builtin_amdgcn_mfma_f32_32x32x16_bf16(PAF(3),VFR(7),o[1],0,0,0), C1,12,mw1); \
    }while(0)
  int t=1;
  #undef CMASK
  #define CMASK(P0,P1,t) do{}while(0)
  for(;t+5<NT;t+=2){
    STEP(pB0,pB1,pA0,pA1,t,true,true,true,true);     if(MASKED){WAIT_BAR(3);}else{WAIT_BAR(2);} RESC(); ROT();
    STEP(pA0,pA1,pB0,pB1,t+1,true,true,true,true);   if(MASKED){WAIT_BAR(3);}else{WAIT_BAR(2);} RESC(); ROT();
  }
  #undef CMASK
  #define CMASK(P0,P1,t) do{int jb_=(t)-(NT-4); if(jb_>=0)cmask(P0,P1,jb_,qrel,hi);}while(0)
  #define ENDW(tt) do{ if(MASKED){ if((tt)+3<NT){WAIT_BAR(3);} else if((tt)+2<NT){WAIT_BAR(2);} else {WAIT_BAR(0);} } else { if((tt)+3<NT){WAIT_BAR(2);} else if((tt)+2<NT){WAIT_BAR(1);} else {WAIT_BAR(0);} } }while(0)
  for(;t+1<NT;t+=2){
    STEP(pB0,pB1,pA0,pA1,t,(t+3<NT),(t+1<NT),(t+1<NT),(t+2<NT));       ENDW(t);   RESC(); ROT();
    STEP(pA0,pA1,pB0,pB1,t+1,(t+4<NT),(t+2<NT),(t+2<NT),(t+3<NT));     ENDW(t+1); RESC(); ROT();
  }
  STEP(pB0,pB1,pA0,pA1,NT-1,false,false,false,false); RESC();
  { float sacc=pB0[0]+pB0[1]; _Pragma("unroll") for(int r=2;r<16;++r)sacc+=pB0[r]; _Pragma("unroll") for(int r=0;r<16;++r)sacc+=pB1[r]; l_reg+=sacc;
    pw0=(u32x4){PKW(pB0,0),PKW(pB0,2),PKW(pB0,4),PKW(pB0,6)};pw1=(u32x4){PKW(pB0,8),PKW(pB0,10),PKW(pB0,12),PKW(pB0,14)};pw2=(u32x4){PKW(pB1,0),PKW(pB1,2),PKW(pB1,4),PKW(pB1,6)};pw3=(u32x4){PKW(pB1,8),PKW(pB1,10),PKW(pB1,12),PKW(pB1,14)};
    SBAR(); pv(o,vb0+sl_cur,PAF(0),PAF(1),PAF(2),PAF(3)); }
  #undef PKW
  #undef PAF
  #undef VFR
  #undef PIN
  #undef MX3
  #undef GAPA
  #undef GAPB
  #undef EX
  #undef VRD
  #undef KRD
  #undef STEP
  #undef ENDW
  {auto rr=__builtin_amdgcn_permlane32_swap(__float_as_uint(l_reg),__float_as_uint(l_reg),false,false);l_reg=__uint_as_float(rr[0])+__uint_as_float(rr[1]);}
  if(hi==0)wsf[32+r32]=l_reg;asm volatile("s_waitcnt lgkmcnt(0)":::"memory");
  float rli[16];
  #pragma unroll
  for(int r=0;r<16;++r)rli[r]=__builtin_amdgcn_rcpf(wsf[32+crow(r,hi)]);
  bf16*Ow=O+(rowbase+q0+wid*QBLK)*DM+hv*D;
  { bf16*stg=(bf16*)(shm+LDS_OST)+wid*2048;
    #pragma unroll
    for(int r=0;r<16;++r){const int orow=crow(r,hi);
      #pragma unroll
      for(int d0=0;d0<2;++d0)stg[orow*64+d0*32+r32]=__float2bfloat16(o[d0][r]*rli[r]);}
    asm volatile("s_waitcnt lgkmcnt(0)":::"memory");
    #pragma unroll
    for(int i=0;i<4;++i){const int row=i*8+(lane>>3),ch=lane&7; const u32x4 v=*(const u32x4*)(stg+row*64+ch*8); ATTN_STORE16(Ow+(long)row*DM+ch*8,v);} }
  asm volatile("s_waitcnt lgkmcnt(0)\n\ts_barrier":::"memory");
  #undef DMA_K
  #undef DMA_V
  #undef DMA_M
  #undef MKRD
  #undef MAND
  #undef CMASK
  #undef START
  #undef RESC
  #undef ROT
}
constexpr int ATTN_LDS_BYTES=LDS_BYTES;
#undef SBAR
#undef WAIT_BAR
}

constexpr int NWAVES = 8;
#ifndef MK_PER_PHASE
#define MK_PER_PHASE 0
#endif

constexpr int BATCH = 2, SEQ = 16384, NTOK = BATCH * SEQ, DMODEL = 1024, DEPTH = 2;
constexpr int WIN_OLD = 5704, WIN_NEW = 5888, P1_N = 3840;
constexpr float LN_EPS = 1e-5f, ALPHA = 1.41421356237f;
constexpr int NPH_LAYER = 12, NPHASE = DEPTH * NPH_LAYER;

constexpr size_t MiB = 1u << 20;
constexpr size_t WS_CTL = 0, CTL_ZERO_BYTES = 1 * MiB;
constexpr size_t WS_SMALL = 1 * MiB, SM_LAM = 0, SM_WR = 4096, SM_BR = SM_WR + 2 * 36 * 1024 * 4;
constexpr size_t WS_ROPE = 2 * MiB;
constexpr size_t WS_ROUTE = 4 * MiB, RT_E = 0, RT_C = 256 * 1024, RT_HIST = 512 * 1024, RT_TOT = 544 * 1024, RT_ROW = 576 * 1024, RT_ENT = 864 * 1024, RT_CW = 1152 * 1024;
constexpr int LIST_CAP = 65536 + 32 * 256;
constexpr size_t WS_WB = 6 * MiB;
constexpr size_t WB_WIN = 0, WB_WBD = (size_t)WIN_NEW * 1024 * 2, WB_WBS = WB_WBD + MiB, WB_WO = WB_WBS + MiB, WB_WPG = WB_WO + 2 * MiB, WB_WPLE = WB_WPG + 2 * MiB,
                 WB_WGU = WB_WPLE + MiB / 2, WB_WD = WB_WGU + 32 * MiB, WB_END = WB_WD + 16 * MiB;
static_assert(WB_END == 66 * MiB, "weight copies");
constexpr size_t WS_XB = 72 * MiB;
constexpr size_t WS_DQ = 136 * MiB, TSTRIDE = 32 * MiB, WS_IK = 360 * MiB, WS_IW = 364 * MiB;
constexpr size_t WS_O0 = 365 * MiB, WS_O1 = 397 * MiB, WS_YB = 429 * MiB, WS_MASK = 461 * MiB;
constexpr long MASK_BSTRIDE = 2105344;
constexpr size_t WS_YA = 136 * MiB, WS_MERGED = 168 * MiB, WS_TMPG = 240 * MiB, WS_PRE1 = 240 * MiB;
constexpr size_t WS_HG = 136 * MiB, WS_PLE = 172 * MiB, WS_Y0 = 368 * MiB, WS_Y1 = 432 * MiB, WS_PB = 496 * MiB, WS_END = 512 * MiB;
static_assert(WS_MASK + 2 * MASK_BSTRIDE * 8 <= WS_PB, "mask fits");
constexpr int CW_TMO = 0, CW_CODE = 1, CW_BAR = 4096;

constexpr int RING_OFF = 0, RING_BYTES = 131072;
constexpr int XTR_OFF = RING_BYTES, XTR_BYTES = 4096;
constexpr int MISC_OFF = XTR_OFF + XTR_BYTES;
constexpr int LDS_BYTES = 147456;
static_assert(MISC_OFF + 128 <= LDS_BYTES, "LDS map");
#define GAS __attribute__((address_space(1)))
#define LAS __attribute__((address_space(3)))
typedef unsigned short bf16;
typedef unsigned v4u __attribute__((ext_vector_type(4)));
typedef float f32x4 __attribute__((ext_vector_type(4)));
typedef short bf16x8 __attribute__((ext_vector_type(8)));
typedef GAS unsigned gu32;
typedef GAS unsigned long long gu64;
#define RLX_AGENT __ATOMIC_RELAXED, __HIP_MEMORY_SCOPE_AGENT
#define LDS_WAIT() asm volatile("s_waitcnt lgkmcnt(0)" ::: "memory")
#define VM_WAIT() asm volatile("s_waitcnt vmcnt(0)" ::: "memory")
__device__ __forceinline__ unsigned long long rt() { return __builtin_amdgcn_s_memrealtime(); }
__device__ __forceinline__ unsigned f2bf(float f) { unsigned u = __builtin_bit_cast(unsigned, f); return (u + 0x7fffu + ((u >> 16) & 1u)) >> 16; }
__device__ __forceinline__ unsigned pk2(float lo, float hi) { return f2bf(lo) | (f2bf(hi) << 16); }

#define XB_TMO      128
#define XB_XCNT(j)  (256  + 64 * (j))
#define XB_XSUB(j)  (1280 + 64 * (j))
#define XB_XGEN(j)  (2304 + 64 * (j))
#define XB_TOP      3328
#define XB_TOPGEN   3392
#define XCD_BAR_WORDS 3456
#define XB_SPIN_CAP (1u << 18)

__device__ __forceinline__ unsigned xb_ld(unsigned* p)              { return __hip_atomic_load(p, __ATOMIC_RELAXED, __HIP_MEMORY_SCOPE_AGENT); }
__device__ __forceinline__ unsigned xb_add(unsigned* p, unsigned v) { return __hip_atomic_fetch_add(p, v, __ATOMIC_RELAXED, __HIP_MEMORY_SCOPE_AGENT); }
__device__ __forceinline__ unsigned xb_xcc_id() { return (unsigned)__builtin_amdgcn_s_getreg((3 << 11) | 20) & 0xFu; }
#define XB_SPIN(cond, bar) do { unsigned _sp = 0; while (cond) { __builtin_amdgcn_s_sleep(1); \
    if ((++_sp & 255u) == 0u) { if (xb_ld(&(bar)[XB_TMO])) break; if (_sp > XB_SPIN_CAP) { atomicAdd(&(bar)[XB_TMO], 1u); break; } } } } while (0)

struct XcdBarrier {
    unsigned* bar; unsigned x;
    volatile LAS unsigned* st;
};

__device__ __forceinline__ XcdBarrier xcd_barrier_post(unsigned* bar, volatile LAS unsigned* st) {
    XcdBarrier b; b.bar = bar; b.x = xb_xcc_id(); b.st = st;
    if (threadIdx.x == 0) (void)xb_add(&bar[XB_XCNT(b.x)], 1u);
    return b;
}
__device__ __forceinline__ void xcd_barrier_complete(unsigned* bar, unsigned x, unsigned& nloc, unsigned& nx) {
    const unsigned G = gridDim.x * gridDim.y * gridDim.z;
    unsigned sum, cnt, mine, sp = 0u;
    for (;;) {
        sum = 0u; cnt = 0u; mine = 0u;
#pragma unroll
        for (unsigned j = 0; j < 16; ++j) { const unsigned c = xb_ld(&bar[XB_XCNT(j)]); sum += c; cnt += (c > 0u) ? 1u : 0u; mine = (j == x) ? c : mine; }
        if (sum == G) break;
        __builtin_amdgcn_s_sleep(1);
        if ((++sp & 255u) == 0u) { if (xb_ld(&bar[XB_TMO])) break; if (sp > XB_SPIN_CAP) { atomicAdd(&bar[XB_TMO], 1u); break; } }
    }
    nloc = mine > 0u ? mine : 1u; nx = cnt > 0u ? cnt : 1u;
}

__device__ __forceinline__ void xcd_barrier(const XcdBarrier& b) {
    asm volatile("s_waitcnt vmcnt(0)" ::: "memory");
    __syncthreads();
    if (threadIdx.x == 0) {
        unsigned* bar = b.bar;
        __builtin_amdgcn_s_waitcnt(0);
        unsigned nloc = b.st[0], nx = b.st[1];
        if (nloc == 0u) { xcd_barrier_complete(bar, b.x, nloc, nx); b.st[0] = nloc; b.st[1] = nx; }
        const unsigned old = xb_add(&bar[XB_XSUB(b.x)], 1u);
        const unsigned gen = old / nloc;
        if (old + 1u == (gen + 1u) * nloc) {
            __builtin_amdgcn_fence(__ATOMIC_RELEASE, "agent");
            asm volatile("s_waitcnt vmcnt(0)" ::: "memory");
            const unsigned og = xb_add(&bar[XB_TOP], 1u);
            const unsigned tg = og / nx;
            if (og + 1u == (tg + 1u) * nx) xb_add(&bar[XB_TOPGEN], 1u);
            else XB_SPIN(xb_ld(&bar[XB_TOPGEN]) == tg, bar);
            __builtin_amdgcn_fence(__ATOMIC_ACQUIRE, "agent");
            xb_add(&bar[XB_XGEN(b.x)], 1u);
            asm volatile("s_waitcnt vmcnt(0)" ::: "memory");
        } else {
            XB_SPIN(xb_ld(&bar[XB_XGEN(b.x)]) == gen, bar);
            __builtin_amdgcn_fence(__ATOMIC_ACQUIRE, "agent");
            asm volatile("s_waitcnt vmcnt(0)" ::: "memory");
        }
    }
    __syncthreads();
}

#ifndef DBG
#define DBG 0
#endif
struct Args { const void* in[22]; float* out; unsigned char* ws; int ph_lo, ph_hi; };
struct Frame {
    LAS unsigned char* lds;
    volatile LAS unsigned* MISC;
    gu32* ctl;
    int tid, lane, wave;
    int vcu, G, bx;
    unsigned char* ws; unsigned char* ws0;
    float* out; float* out0;
    const Args* ap;
};
#define INP(k) (F.ap->in[(k)])
__device__ __forceinline__ float wave_sum(float v) {
#pragma unroll
    for (int o = 1; o < 64; o <<= 1) v += __shfl_xor(v, o);
    return v;
}
typedef float f32x2 __attribute__((ext_vector_type(2)));

__device__ __forceinline__ void tr_item(const float* W, int ldn, int col0, int nvalid, bf16* WT, int K, int row0, LAS float* scr, int kb, int lane) {
    const int k0 = 64 * kb, n = lane & 31;
#pragma unroll 8
    for (int i = 0; i < 32; ++i) { const int kk = 2 * i + (lane >> 5); scr[kk * 33 + n] = (n < nvalid) ? W[(size_t)(k0 + kk) * ldn + col0 + n] : 0.f; }
    LDS_WAIT(); asm volatile("" ::: "memory");
    const int c = lane & 7;
#pragma unroll
    for (int j = 0; j < 4; ++j) { const int nn = (lane >> 3) + 8 * j; const LAS float* s = scr + (8 * c) * 33 + nn;
        v4u o; o.x = pk2(s[0 * 33], s[1 * 33]); o.y = pk2(s[2 * 33], s[3 * 33]); o.z = pk2(s[4 * 33], s[5 * 33]); o.w = pk2(s[6 * 33], s[7 * 33]);
        *(GAS v4u*)(WT + (size_t)(row0 + nn) * K + k0 + 8 * c) = o; }
    LDS_WAIT(); asm volatile("" ::: "memory");
}
__device__ __forceinline__ void pw_phase(Frame& F, int l) {
    LAS float* scr = (LAS float*)(F.lds + RING_OFF + F.wave * 16384);
    const int gw = F.vcu * NWAVES + F.wave, NGW = F.G * NWAVES, lane = F.lane;
    unsigned char* wb = F.ws + WS_WB;
    bf16* WIN = (bf16*)(wb + WB_WIN);
    const float* w_in = (const float*)INP(3) + (size_t)l * 1024 * WIN_OLD;
    constexpr int I_A = 16 * 114, I_B = 16, I_C = 16 * 64, I_BD = 8 * 32, I_O = 16 * 32, I_PLE = 4 * 32, I_GU = 32 * 4 * 64, I_D = 32 * 128;
    constexpr int NITEMS = I_A + I_B + I_C + 2 * I_BD + 2 * I_O + I_PLE + I_GU + I_D;
    for (int it = gw; it < NITEMS; it += NGW) {
        int r = it;
        if (r < I_A) { const int kb = r / 114, nb = r % 114; tr_item(w_in, WIN_OLD, 32 * nb, 32, WIN, 1024, 32 * nb, scr, kb, lane); continue; } r -= I_A;
        if (r < I_B) { tr_item(w_in, WIN_OLD, 3648, 8, WIN, 1024, 3648, scr, r, lane); continue; } r -= I_B;
        if (r < I_C) { const int kb = r / 64, nb = r % 64; tr_item(w_in, WIN_OLD, 3656 + 32 * nb, 32, WIN, 1024, 3840 + 32 * nb, scr, kb, lane); continue; } r -= I_C;
        if (r < I_BD) { tr_item((const float*)INP(6) + (size_t)l * 512 * 1024, 1024, 32 * (r % 32), 32, (bf16*)(wb + WB_WBD), 512, 32 * (r % 32), scr, r / 32, lane); continue; } r -= I_BD;
        if (r < I_BD) { tr_item((const float*)INP(7) + (size_t)l * 512 * 1024, 1024, 32 * (r % 32), 32, (bf16*)(wb + WB_WBS), 512, 32 * (r % 32), scr, r / 32, lane); continue; } r -= I_BD;
        if (r < I_O) { tr_item((const float*)INP(8) + (size_t)l * 1024 * 1024, 1024, 32 * (r % 32), 32, (bf16*)(wb + WB_WO), 1024, 32 * (r % 32), scr, r / 32, lane); continue; } r -= I_O;
        if (r < I_O) { tr_item((const float*)INP(19) + (size_t)l * 1024 * 1024, 1024, 32 * (r % 32), 32, (bf16*)(wb + WB_WPG), 1024, 32 * (r % 32), scr, r / 32, lane); continue; } r -= I_O;
        if (r < I_PLE) { tr_item((const float*)INP(18) + (size_t)l * 256 * 1024, 1024, 32 * (r % 32), 32, (bf16*)(wb + WB_WPLE), 256, 32 * (r % 32), scr, r / 32, lane); continue; } r -= I_PLE;
        if (r < I_GU) { const int e = r >> 8, sub = (r >> 6) & 3, q = r & 63, kb = q >> 2, nb = q & 3;
            const float* W = ((sub & 1) ? (const float*)INP(16) : (const float*)INP(15)) + (size_t)(l * 32 + e) * 1024 * 256;
            tr_item(W, 256, (sub >> 1) * 128 + 32 * nb, 32, (bf16*)(wb + WB_WGU), 1024, e * 512 + sub * 128 + 32 * nb, scr, kb, lane); continue; } r -= I_GU;
        { const int e = r >> 7, q = r & 127, kb = q >> 5, nb = q & 31;
            tr_item((const float*)INP(17) + (size_t)(l * 32 + e) * 256 * 1024, 1024, 32 * nb, 32, (bf16*)(wb + WB_WD), 256, e * 1024 + 32 * nb, scr, kb, lane); }
    }
    for (int ch = F.vcu * 512 + F.tid; ch < 160 * 128; ch += F.G * 512) *(GAS v4u*)(WIN + (size_t)3680 * 1024 + (size_t)ch * 8) = (v4u){0u, 0u, 0u, 0u};
    if (l == 0) {
        const float* x = (const float*)INP(0); bf16* XB = (bf16*)(F.ws + WS_XB);
        for (int m = gw; m < NTOK; m += NGW) {
            const GAS f32x4* xr = (const GAS f32x4*)(x + (size_t)m * 1024) + lane; GAS unsigned long long* o8 = (GAS unsigned long long*)(XB + (size_t)m * 1024) + lane;
#pragma unroll
            for (int j = 0; j < 4; ++j) { const f32x4 v = xr[64 * j]; o8[64 * j] = (unsigned long long)pk2(v.x, v.y) | ((unsigned long long)pk2(v.z, v.w) << 32); }
        }
        const int* pos = (const int*)INP(2); float* rope = (float*)(F.ws + WS_ROPE);
        for (int idx = F.vcu * 512 + F.tid; idx < NTOK * 8; idx += F.G * 512) {
            const int m = idx >> 3, j = idx & 7; const float invf = exp2f(-2.366446071f * (float)j); const float ang = (float)pos[m] * invf;
            double rev = (double)ang * 0.15915494309189535; rev -= rint(rev);
            rope[m * 16 + j] = (DBG & 16) ? 1.f : __builtin_amdgcn_cosf((float)rev); rope[m * 16 + 8 + j] = (DBG & 16) ? 0.f : __builtin_amdgcn_sinf((float)rev);
        }
        float* WR = (float*)(F.ws + WS_SMALL + SM_WR); float* BR = (float*)(F.ws + WS_SMALL + SM_BR);
        for (int idx = F.vcu * 512 + F.tid; idx < 2 * 36 * 1024; idx += F.G * 512) {
            const int ll = idx / (36 * 1024), r = idx % (36 * 1024), j = r >> 10, k = r & 1023;
            WR[idx] = (j < 4) ? ((const float*)INP(11))[((size_t)ll * 1024 + k) * 4 + j] : ((const float*)INP(13))[((size_t)ll * 1024 + k) * 32 + (j - 4)];
        }
        if (F.vcu == 0 && F.tid < 72) { const int ll = F.tid / 36, j = F.tid % 36; BR[F.tid] = (j < 4) ? ((const float*)INP(12))[ll * 4 + j] : ((const float*)INP(14))[ll * 32 + j - 4]; }
        if (F.vcu == 0 && F.tid < 2) { const float* lp = (const float*)INP(4) + F.tid * 256; float a = 0.f, b = 0.f;
            for (int i = 0; i < 64; ++i) { a += lp[i] * lp[64 + i]; b += lp[128 + i] * lp[192 + i]; }
            const float lam_init = (F.tid == 0) ? 0.2f : 0.35550907f;
            ((float*)(F.ws + WS_SMALL + SM_LAM))[F.tid] = __expf(a) - __expf(b) + lam_init; }
    }
}

namespace idxr {
typedef float f32x16 __attribute__((ext_vector_type(16)));
constexpr int HROW = 513;
__device__ __forceinline__ int crow(int r, int hi) { return (r & 3) + 8 * (r >> 2) + 4 * hi; }
__device__ __forceinline__ unsigned f2key(float f) { const unsigned u = __float_as_uint(f); return u ^ ((unsigned)((int)u >> 31) | 0x80000000u); }
__device__ __forceinline__ int key2bin(unsigned key) { const int k = (int)(key >> 19); const int a = min(max(k, 1936), 2447), b = min(max(k, 5743), 6255); return a + b - 7679; }
__device__ __forceinline__ long moff(int tl) { return 16384L * tl - 32L * tl * (tl - 1); }

__device__ __forceinline__ void score_tile(f32x4 (&sc)[4], const bf16x8 (&qf)[8][2], const float (&w)[8], const unsigned short* IKb, int key0, int fr, int fq) {
    bf16x8 kf[4][2];
#pragma unroll
    for (int kg = 0; kg < 4; ++kg)
#pragma unroll
        for (int ks = 0; ks < 2; ++ks) kf[kg][ks] = *(const bf16x8*)(IKb + (size_t)(key0 + 16 * kg + fr) * 64 + ks * 32 + fq * 8);
#pragma unroll
    for (int kg = 0; kg < 4; ++kg) sc[kg] = (f32x4){0.f, 0.f, 0.f, 0.f};
#define IDX_MM(D, h) do { _Pragma("unroll") for (int kg = 0; kg < 4; ++kg) { D[kg] = __builtin_amdgcn_mfma_f32_16x16x32_bf16(kf[kg][0], qf[h][0], (f32x4){0.f, 0.f, 0.f, 0.f}, 0, 0, 0); \
        D[kg] = __builtin_amdgcn_mfma_f32_16x16x32_bf16(kf[kg][1], qf[h][1], D[kg], 0, 0, 0); } } while (0)
#define IDX_ACC(D, h) do { _Pragma("unroll") for (int kg = 0; kg < 4; ++kg) _Pragma("unroll") for (int i = 0; i < 4; ++i) sc[kg][i] = __builtin_fmaf(w[h], __builtin_fmaxf(D[kg][i], 0.f), sc[kg][i]); \
        asm volatile("" : "+v"(sc[0]), "+v"(sc[1]), "+v"(sc[2]), "+v"(sc[3]), "+v"(kf[0][0]), "+v"(kf[1][0]), "+v"(kf[2][0]), "+v"(kf[3][0])); } while (0)
    f32x4 dA[4], dB[4];
    IDX_MM(dA, 0);
    IDX_MM(dB, 1); IDX_ACC(dA, 0);
    IDX_MM(dA, 2); IDX_ACC(dB, 1);
    IDX_MM(dB, 3); IDX_ACC(dA, 2);
    IDX_MM(dA, 4); IDX_ACC(dB, 3);
    IDX_MM(dB, 5); IDX_ACC(dA, 4);
    IDX_MM(dA, 6); IDX_ACC(dB, 5);
    IDX_MM(dB, 7); IDX_ACC(dA, 6);
    IDX_ACC(dB, 7);
#undef IDX_MM
#undef IDX_ACC
}
}

__device__ __forceinline__ void indexer_unit(Frame& F, int b, int qblk, const bf16* IQ, const bf16* IK, const float* IW, unsigned long long* mask64  ) {
    using namespace idxr;
    const int lane = F.lane, fr = lane & 15, fq = lane >> 4, wid = F.wave, qgrp = wid & 3, kh = wid >> 2;
    const int qloc = 16 * qgrp + fr, q = 64 * qblk + qloc;
    const size_t row = (size_t)b * SEQ + q;
    LAS unsigned* hist = (LAS unsigned*)(F.lds + RING_OFF);
    LAS int* bstarA = (LAS int*)(F.lds + XTR_OFF + 1024); LAS int* needA = bstarA + 64; LAS unsigned* ccnt = (LAS unsigned*)(needA + 64);
    LAS unsigned long long* cand = (LAS unsigned long long*)(F.lds + RING_OFF);
    bf16x8 qf[8][2]; float w[8];
#pragma unroll
    for (int h = 0; h < 8; ++h)
#pragma unroll
        for (int ks = 0; ks < 2; ++ks) qf[h][ks] = *(const bf16x8*)(IQ + row * 512 + h * 64 + ks * 32 + fq * 8);
    { const f32x4* wp = (const f32x4*)(IW + row * 8); const f32x4 w0 = wp[0], w1 = wp[1]; w[0] = w0.x; w[1] = w0.y; w[2] = w0.z; w[3] = w0.w; w[4] = w1.x; w[5] = w1.y; w[6] = w1.z; w[7] = w1.w; }
    for (int i = F.tid; i < 64 * HROW; i += NWAVES * 64) hist[i] = 0u;
    __syncthreads();
    const unsigned short* IKb = IK + (size_t)b * SEQ * 64;
    const int nsteps = (qblk + 2) >> 1, qmin_w = 64 * qblk + 16 * qgrp, qmax_w = qmin_w + 15;
    LAS unsigned* hrow = hist + qloc * HROW;
#pragma unroll 1
    for (int j = 0; j < nsteps; ++j) {
        const int tl = 2 * j + kh, key0 = 64 * tl;
        if (key0 > qmax_w) continue;
        f32x4 sc[4]; score_tile(sc, qf, w, IKb, key0, fr, fq);
        const bool full = (key0 + 63 <= qmin_w);
        int fq_ = fq, q_ = q; asm volatile("" : "+v"(fq_), "+v"(q_));
#pragma unroll
        for (int kg = 0; kg < 4; ++kg)
#pragma unroll
            for (int i = 0; i < 4; ++i) {
                const int bin = key2bin(f2key(sc[kg][i]));
                if (full || key0 + 16 * kg + 4 * fq_ + i <= q_) __hip_atomic_fetch_add(hrow + (bin >> 1), 1u << ((bin & 1) * 16), __ATOMIC_RELAXED, __HIP_MEMORY_SCOPE_WORKGROUP);                if (i == 3) __builtin_amdgcn_sched_barrier(0);
            }
    }
    __syncthreads();
#pragma unroll 1
    for (int qq = wid * 8; qq < wid * 8 + 8; ++qq) {
        const LAS unsigned* hr = hist + qq * HROW + lane * 8;
        unsigned wv[8]; unsigned s = 0;
#pragma unroll
        for (int k = 0; k < 8; ++k) { wv[k] = hr[k]; s += (wv[k] & 0xffffu) + (wv[k] >> 16); }
        unsigned v = s;
#pragma unroll
        for (int off = 1; off < 64; off <<= 1) { const unsigned t = __shfl_down(v, off); if (lane + off < 64) v += t; }
        const unsigned above = v - s, total = __shfl(v, 0);
        if (total > 256u) {
            if (above < 256u && v >= 256u) {
                unsigned c = above; int found = -1, need = 0;
#pragma unroll
                for (int k = 15; k >= 0; --k) { const unsigned cnt = (k & 1) ? (wv[k >> 1] >> 16) : (wv[k >> 1] & 0xffffu);
                    if (found < 0) { if (c + cnt >= 256u) { found = k; need = 256 - (int)c; } else c += cnt; } }
                bstarA[qq] = lane * 16 + found; needA[qq] = need;
            }
        } else if (lane == 0) { bstarA[qq] = -1; needA[qq] = 0; }
        if (lane == 0) ccnt[qq] = 0u;
    }
    __syncthreads();
    const int bs = bstarA[qloc];
#pragma unroll 1
    for (int j = 0; j < nsteps; ++j) {
        const int tl = 2 * j + kh, key0 = 64 * tl;
        if (tl > qblk) continue;
        unsigned long long* mword = mask64 + (moff(tl) + (q - 64 * tl));
        if (key0 > qmax_w) { if (fq == 0) *mword = 0ull; continue; }
        f32x4 sc[4]; score_tile(sc, qf, w, IKb, key0, fr, fq);
        const bool full = (key0 + 63 <= qmin_w);
        unsigned wlo = 0u, whi = 0u;
        int fq_ = fq, q_ = q; asm volatile("" : "+v"(fq_), "+v"(q_));
#pragma unroll
        for (int kg = 0; kg < 4; ++kg)
#pragma unroll
            for (int i = 0; i < 4; ++i) {
                const unsigned key = f2key(sc[kg][i]); const int bin = key2bin(key); const int krel = 16 * kg + 4 * fq_ + i, kidx = key0 + krel;
                const bool valid = full || kidx <= q_;
                if (valid && bin > bs) { if (kg < 2) wlo |= 1u << (krel & 31); else whi |= 1u << (krel & 31); }
                if (valid && bin == bs) { const unsigned p = __hip_atomic_fetch_add(ccnt + qloc, 1u, __ATOMIC_RELAXED, __HIP_MEMORY_SCOPE_WORKGROUP);
                    if (p < 256u) cand[qloc * 256 + p] = ((unsigned long long)key << 32) | (unsigned long long)(0xffffu - (unsigned)kidx); }                if (i == 3) __builtin_amdgcn_sched_barrier(0);
            }
        wlo |= __shfl_xor(wlo, 16); whi |= __shfl_xor(whi, 16); wlo |= __shfl_xor(wlo, 32); whi |= __shfl_xor(whi, 32);
        if (fq == 0) *mword = ((unsigned long long)whi << 32) | wlo;
    }
    VM_WAIT();
    __syncthreads();
#pragma unroll 1
    for (int qq = wid * 8; qq < wid * 8 + 8; ++qq) {
        const unsigned cn = ccnt[qq]; const int m = (int)(cn < 256u ? cn : 256u), need = needA[qq];
        if (m == 0) continue;
        const LAS unsigned long long* cb = cand + qq * 256;
        unsigned long long e[4]; int rank[4];
#pragma unroll
        for (int jj = 0; jj < 4; ++jj) { const int i = lane + 64 * jj; e[jj] = (i < m) ? cb[i] : 0ull; rank[jj] = 0; }
        if (need < m) for (int i2 = 0; i2 < m; ++i2) { const unsigned long long x = cb[i2];
#pragma unroll
            for (int jj = 0; jj < 4; ++jj) rank[jj] += (x > e[jj]) ? 1 : 0; }
        const int qglob = 64 * qblk + qq;
#pragma unroll
        for (int jj = 0; jj < 4; ++jj) { const int i = lane + 64 * jj;
            if (i < m && rank[jj] < need) { const int kidx = 0xffff - (int)(e[jj] & 0xffffull); const int tl = kidx >> 6;
                __hip_atomic_fetch_or(mask64 + (moff(tl) + (qglob - 64 * tl)), 1ull << (kidx & 63), __ATOMIC_RELAXED, __HIP_MEMORY_SCOPE_AGENT); } }
    }
    __syncthreads();
}

__device__ __forceinline__ void ya_phase(Frame& F, int l) {
    const int gw = F.vcu * NWAVES + F.wave, NGW = F.G * NWAVES, lane = F.lane;
    const bf16* O0 = (const bf16*)(F.ws + WS_O0); const bf16* O1 = (const bf16*)(F.ws + WS_O1); bf16* YA = (bf16*)(F.ws + WS_YA);
    const float lam = (DBG & 8) ? 0.f : ((const float*)(F.ws + WS_SMALL + SM_LAM))[l];
    const float lam_init = (l == 0) ? 0.2f : 0.35550907f;
    const float* gp = (const float*)INP(5) + l * 128 + (lane & 15) * 8;
    float gg[8];
#pragma unroll
    for (int i = 0; i < 8; ++i) gg[i] = gp[i] * (1.f - lam_init);
    for (int m = gw; m < NTOK; m += NGW) {
        const v4u a = *(const GAS v4u*)(O0 + (size_t)m * 512 + lane * 8), c = *(const GAS v4u*)(O1 + (size_t)m * 512 + lane * 8);
        f32x4 a0, a1, c0, c1; pg8::unpack8(a, a0, a1); pg8::unpack8(c, c0, c1);
        f32x4 d0 = a0 - c0 * lam, d1 = a1 - c1 * lam;
        float ss = (d0.x * d0.x + d0.y * d0.y) + (d0.z * d0.z + d0.w * d0.w) + (d1.x * d1.x + d1.y * d1.y) + (d1.z * d1.z + d1.w * d1.w);
        ss += __shfl_xor(ss, 1); ss += __shfl_xor(ss, 2); ss += __shfl_xor(ss, 4); ss += __shfl_xor(ss, 8);
        const float rs = 1.0f / sqrtf(ss * (1.0f / 128.0f) + LN_EPS);
        f32x4 o0 = {d0.x * rs * gg[0], d0.y * rs * gg[1], d0.z * rs * gg[2], d0.w * rs * gg[3]}, o1 = {d1.x * rs * gg[4], d1.y * rs * gg[5], d1.z * rs * gg[6], d1.w * rs * gg[7]};
        *(GAS v4u*)(YA + (size_t)m * 512 + lane * 8) = pg8::pack8(o0, o1);
    }
}

__device__ __forceinline__ void ln_row(f32x4 (&v)[4], const float* g, const float* bb, int lane) {
    float s = 0.f;
#pragma unroll
    for (int j = 0; j < 4; ++j) s += (v[j].x + v[j].y) + (v[j].z + v[j].w);
    const float mean = wave_sum(s) * (1.f / 1024.f); float s2 = 0.f;
#pragma unroll
    for (int j = 0; j < 4; ++j) { v[j] = v[j] - mean; s2 += (v[j].x * v[j].x + v[j].y * v[j].y) + (v[j].z * v[j].z + v[j].w * v[j].w); }
    const float rstd = 1.f / sqrtf(wave_sum(s2) * (1.f / 1024.f) + LN_EPS);
#pragma unroll
    for (int j = 0; j < 4; ++j) { const f32x4 gv = *((const f32x4*)g + lane + 64 * j), bv = *((const f32x4*)bb + lane + 64 * j); v[j] = v[j] * rstd * gv + bv; }
}

__device__ __forceinline__ void ln1_router_phase(Frame& F, int l) {
    const int gw = F.vcu * NWAVES + F.wave, NGW = F.G * NWAVES, lane = F.lane;
    float* X1F = (float*)(F.ws + WS_PRE1); bf16* X1B = (bf16*)(F.ws + WS_XB);
    const float* g1 = (const float*)INP(9) + l * 1024; const float* b1 = (const float*)INP(10) + l * 1024;
    const float* WR = (const float*)(F.ws + WS_SMALL + SM_WR) + (size_t)l * 36 * 1024; const float* BR = (const float*)(F.ws + WS_SMALL + SM_BR) + l * 36;
    int* route_e = (int*)(F.ws + WS_ROUTE + RT_E); float* route_c = (float*)(F.ws + WS_ROUTE + RT_C);
    LAS unsigned* rhist = (LAS unsigned*)(F.lds + XTR_OFF + 1536);
    if (F.tid < 32) rhist[F.tid] = 0u;
    __syncthreads();
    for (int m = gw; m < NTOK; m += NGW) {
        GAS f32x4* xr = (GAS f32x4*)(X1F + (size_t)m * 1024) + lane;
        f32x4 v[4];
#pragma unroll
        for (int j = 0; j < 4; ++j) v[j] = xr[64 * j];
        ln_row(v, g1, b1, lane);
        GAS unsigned long long* o8 = (GAS unsigned long long*)(X1B + (size_t)m * 1024) + lane;
#pragma unroll
        for (int j = 0; j < 4; ++j) { xr[64 * j] = v[j]; o8[64 * j] = (unsigned long long)pk2(v[j].x, v[j].y) | ((unsigned long long)pk2(v[j].z, v[j].w) << 32); }
        float lg[4];
#pragma unroll
        for (int j = 0; j < 4; ++j) { const f32x4* wj = (const f32x4*)(WR + j * 1024) + lane; float s = 0.f;
#pragma unroll
            for (int c = 0; c < 4; ++c) { const f32x4 wv = wj[64 * c]; s += (v[c].x * wv.x + v[c].y * wv.y) + (v[c].z * wv.z + v[c].w * wv.w); }
            lg[j] = wave_sum(s) + BR[j]; asm volatile("" ::: "memory"); }
        int gi = 0; float gm = lg[0];
#pragma unroll
        for (int i = 1; i < 4; ++i) if (lg[i] > gm) { gm = lg[i]; gi = i; }
        float gs = 0.f;
#pragma unroll
        for (int i = 0; i < 4; ++i) gs += __expf(lg[i] - gm);
        const float gval = 1.f / gs;
        gi = __builtin_amdgcn_readfirstlane(gi);
        float el[8];
#pragma unroll
        for (int k = 0; k < 8; ++k) { const f32x4* wj = (const f32x4*)(WR + (4 + gi * 8 + k) * 1024) + lane; float s = 0.f;
#pragma unroll
            for (int c = 0; c < 4; ++c) { const f32x4 wv = wj[64 * c]; s += (v[c].x * wv.x + v[c].y * wv.y) + (v[c].z * wv.z + v[c].w * wv.w); }
            el[k] = wave_sum(s) + BR[4 + gi * 8 + k]; asm volatile("" ::: "memory"); }
        int i0 = 0; float m0 = el[0];
#pragma unroll
        for (int k = 1; k < 8; ++k) if (el[k] > m0) { m0 = el[k]; i0 = k; }
        int i1 = -1; float m1 = -INFINITY;
#pragma unroll
        for (int k = 0; k < 8; ++k) if (k != i0 && el[k] > m1) { m1 = el[k]; i1 = k; }
        const float c0 = gval / (1.f + __expf(m1 - m0)), c1 = gval - c0;
        if (lane == 0) {
            const int e0 = gi * 8 + i0, e1 = gi * 8 + i1;
            route_e[m * 2] = e0; route_e[m * 2 + 1] = e1; route_c[m * 2] = c0; route_c[m * 2 + 1] = c1;
            __hip_atomic_fetch_add(rhist + e0, 1u, __ATOMIC_RELAXED, __HIP_MEMORY_SCOPE_WORKGROUP); __hip_atomic_fetch_add(rhist + e1, 1u, __ATOMIC_RELAXED, __HIP_MEMORY_SCOPE_WORKGROUP);
        }
    }
    __syncthreads();
    if (F.tid < 32) ((int*)(F.ws + WS_ROUTE + RT_HIST))[F.vcu * 32 + F.tid] = (int)rhist[F.tid];
}

__device__ __forceinline__ void lists_phase(Frame& F, int l) {
    const int tid = F.tid, NGW = F.G * NWAVES;
    const int* wghist = (const int*)(F.ws + WS_ROUTE + RT_HIST);
    const int* route_e = (const int*)(F.ws + WS_ROUTE + RT_E); const float* route_c = (const float*)(F.ws + WS_ROUTE + RT_C);
    int* gtot = (int*)(F.ws + WS_ROUTE + RT_TOT);
    int* list_row = (int*)(F.ws + WS_ROUTE + RT_ROW); int* list_ent = (int*)(F.ws + WS_ROUTE + RT_ENT); float* list_c = (float*)(F.ws + WS_ROUTE + RT_CW);
    LAS int* part = (LAS int*)(F.lds + RING_OFF);
    LAS int* earr = (LAS int*)(F.lds + XTR_OFF + 2048);
    LAS int* tot = (LAS int*)(F.lds + XTR_OFF + 3072); LAS int* wgoff = tot + 32; LAS int* mbase = wgoff + 32;
    { const int e = tid & 31, pt = tid >> 5; int t = 0, pre = 0;
      for (int w2 = pt * 16; w2 < pt * 16 + 16; ++w2) if (w2 < F.G) { const int h = wghist[w2 * 32 + e]; t += h; if (w2 < F.vcu) pre += h; }
      part[pt * 64 + e] = t; part[pt * 64 + 32 + e] = pre; }
    __syncthreads();
    if (tid < 32) { int t = 0, pre = 0; for (int pt = 0; pt < 16; ++pt) { t += part[pt * 64 + tid]; pre += part[pt * 64 + 32 + tid]; } tot[tid] = t; wgoff[tid] = pre; }
    __syncthreads();
    if (tid == 0) { int bse = 0; for (int e = 0; e < 32; ++e) { mbase[e] = bse; bse += (tot[e] + 255) & ~255; } mbase[32] = bse; }
    __syncthreads();
    int myE = -1, myTok = 0, mySlot = 0;
    if (tid < 256) { const int n = tid >> 1; mySlot = tid & 1; myTok = F.vcu * NWAVES + (n & 7) + NGW * (n >> 3); myE = route_e[myTok * 2 + mySlot]; earr[tid] = myE; }
    __syncthreads();
    if (tid < 256) { int rk = 0; for (int t2 = 0; t2 < tid; ++t2) rk += (earr[t2] == myE) ? 1 : 0;
        const int pos = mbase[myE] + wgoff[myE] + rk;
        list_row[pos] = myTok; list_ent[pos] = myTok * 2 + mySlot; list_c[pos] = route_c[myTok * 2 + mySlot]; }
    if (F.vcu == 0) {
        if (tid < 33) gtot[tid] = mbase[tid];
        const int e = tid >> 4;
        for (int pos = mbase[e] + tot[e] + (tid & 15); pos < mbase[e + 1]; pos += 16) { list_row[pos] = 0; list_ent[pos] = -1; list_c[pos] = 0.f; }
    }
    const float* p = (const float*)INP(1) + (size_t)l * NTOK * 256; bf16* PB = (bf16*)(F.ws + WS_PB);
    for (int m = F.vcu * NWAVES + F.wave; m < NTOK; m += NGW) { const f32x4 v = *((const GAS f32x4*)(p + (size_t)m * 256) + F.lane);
        *((GAS unsigned long long*)(PB + (size_t)m * 256) + F.lane) = (unsigned long long)pk2(v.x, v.y) | ((unsigned long long)pk2(v.z, v.w) << 32); }
}

struct GroupSched {
    int nunits, G, c, shift; const LAS int* tile_e; long estride, substride;
    __device__ __forceinline__ bool next(int i, pg8::Unit& u) const {
        const long L = (long)i * G + c; if (L >= nunits) return false;
        const int rt = (int)(L >> shift), sub = (int)L & ((1 << shift) - 1), e = tile_e[rt];
        u.pm = rt; u.pn = sub; u.boff = (long)e * estride + (long)sub * substride; return true;
    }
};
__device__ __forceinline__ int build_tile_table(Frame& F) {
    const int* gtot = (const int*)(F.ws + WS_ROUTE + RT_TOT);
    LAS int* tile_e = (LAS int*)(F.lds + XTR_OFF);
    const int T = gtot[32] >> 8;
    for (int rt = F.tid; rt < T; rt += NWAVES * 64) { int e = 0; for (int k = 1; k < 32; ++k) if (gtot[k] <= rt * 256) e = k; tile_e[rt] = e; }
    __syncthreads();
    return T;
}

__device__ __forceinline__ void ln2_phase(Frame& F, int l) {
    const int gw = F.vcu * NWAVES + F.wave, NGW = F.G * NWAVES, lane = F.lane;
    const float* X1F = (const float*)(F.ws + WS_PRE1); const bf16* Y0 = (const bf16*)(F.ws + WS_Y0); const bf16* Y1 = (const bf16*)(F.ws + WS_Y1); const bf16* PLE = (const bf16*)(F.ws + WS_PLE);
    const float* g2 = (const float*)INP(20) + l * 1024; const float* b2 = (const float*)INP(21) + l * 1024;
    bf16* XB = (bf16*)(F.ws + WS_XB);
    for (int m = gw; m < NTOK; m += NGW) {
        const GAS f32x4* xr = (const GAS f32x4*)(X1F + (size_t)m * 1024) + lane;
        const GAS unsigned long long* y0 = (const GAS unsigned long long*)(Y0 + (size_t)m * 1024) + lane; const GAS unsigned long long* y1 = (const GAS unsigned long long*)(Y1 + (size_t)m * 1024) + lane;
        const GAS unsigned long long* pl = (const GAS unsigned long long*)(PLE + (size_t)m * 1024) + lane;
        f32x4 v[4];
#pragma unroll
        for (int j = 0; j < 4; ++j) { const f32x4 x = xr[64 * j]; const unsigned long long a = y0[64 * j], c = y1[64 * j], d = pl[64 * j];
            const unsigned a0 = (unsigned)a, a1 = (unsigned)(a >> 32), c0 = (unsigned)c, c1 = (unsigned)(c >> 32), d0 = (unsigned)d, d1 = (unsigned)(d >> 32);
            const float km = (DBG & 1) ? 0.f : 1.f, kp = (DBG & 2) ? 0.f : 1.f;
            v[j].x = x.x * ALPHA + km * (pg8::bf_lo(a0) + pg8::bf_lo(c0)) + kp * pg8::bf_lo(d0); v[j].y = x.y * ALPHA + km * (pg8::bf_hi(a0) + pg8::bf_hi(c0)) + kp * pg8::bf_hi(d0);
            v[j].z = x.z * ALPHA + km * (pg8::bf_lo(a1) + pg8::bf_lo(c1)) + kp * pg8::bf_lo(d1); v[j].w = x.w * ALPHA + km * (pg8::bf_hi(a1) + pg8::bf_hi(c1)) + kp * pg8::bf_hi(d1); }
        ln_row(v, g2, b2, lane);
#if CHK
        if (l == DEPTH - 1 && __hip_atomic_load(F.ctl + CW_CHK, RLX_AGENT) != 0u) { const float qn = __builtin_nanf(""); v[0] = (f32x4){qn, qn, qn, qn}; }
#endif
        GAS f32x4* o = (GAS f32x4*)(F.out + (size_t)m * 1024) + lane;
#pragma unroll
        for (int j = 0; j < 4; ++j) o[64 * j] = v[j];
        if (l + 1 < DEPTH) { GAS unsigned long long* o8 = (GAS unsigned long long*)(XB + (size_t)m * 1024) + lane;
#pragma unroll
            for (int j = 0; j < 4; ++j) o8[64 * j] = (unsigned long long)pk2(v[j].x, v[j].y) | ((unsigned long long)pk2(v[j].z, v[j].w) << 32); }
    }
}


#ifndef CHK
#define CHK 0
#endif
constexpr int CW_CHK = 2;
#if CHK
__device__ __forceinline__ void chk_fail(Frame& F, unsigned code) { __hip_atomic_store(F.ctl + CW_CHK, code, RLX_AGENT); }
__device__ __forceinline__ float bf2f(unsigned short v) { return __uint_as_float((unsigned)v << 16); }
__device__ __forceinline__ unsigned hash32(unsigned x) { x ^= x >> 16; x *= 0x7feb352du; x ^= x >> 15; x *= 0x846ca68bu; x ^= x >> 16; return x; }
__device__ __forceinline__ bool close_to(float got, float want, float rel, float ab) { return fabsf(got - want) <= ab + rel * fabsf(want) && got == got; }
__device__ __forceinline__ void cs_ref(float ang, float& c, float& s) {
    double rev = (double)ang * 0.15915494309189535; rev -= rint(rev); const double x = rev * 6.283185307179586, x2 = x * x;
    double tc = 1.0, ts = x, sc = 1.0, ss = x;
#pragma unroll 1
    for (int k = 1; k <= 14; ++k) { tc *= -x2 / (double)((2 * k - 1) * (2 * k)); ts *= -x2 / (double)((2 * k) * (2 * k + 1)); sc += tc; ss += ts; }
    c = (float)sc; s = (float)ss;
}
__device__ __forceinline__ void chk_proj(Frame& F) {
    const float* x = (const float*)INP(0); const float* w_in = (const float*)INP(3); const int* pos = (const int*)INP(2);
    const int gw = F.vcu * NWAVES + F.wave, lane = F.lane;
    for (int it = 0; it < 4; ++it) {
        const unsigned h = hash32((unsigned)(gw * 4 + it) * 2654435761u + 12345u);
        const int m = (int)(h % (unsigned)NTOK), col = (int)((h >> 7) % 3656u);
        int t, cw; if (col < 3584) { t = col >> 9; cw = col & 511; } else if (col < 3648) { t = 7; cw = col - 3584; } else { t = 8; cw = col - 3648; }
        const int d = cw & 63; const bool roped = (t == 0 || t == 1 || t == 3 || t == 4 || t == 6 || t == 7) && d < 16;
        const int pcol = roped ? (d < 8 ? col + 8 : col - 8) : col;
        float a = 0.f, b2 = 0.f;
        for (int k = lane; k < 1024; k += 64) { const float xv = x[(size_t)m * 1024 + k]; a += xv * w_in[(size_t)k * WIN_OLD + col]; b2 += xv * w_in[(size_t)k * WIN_OLD + pcol]; }
        a = wave_sum(a); b2 = wave_sum(b2);
        float val = a;
        if (roped) { const int j = d & 7; const float invf = 1.0f / powf(500000.0f, (float)j * 0.125f); float c, s; cs_ref((float)pos[m] * invf, c, s); val = (d < 8) ? a * c - b2 * s : a * c + b2 * s; }
        const float sc = (t == 0 || t == 3) ? pg8::C2 : (t == 6 ? 0.125f : (t == 8 ? 0.35355339059f : 1.f));
        val *= sc;
        float got;
        if (t < 7) got = bf2f(((const bf16*)(F.ws + WS_DQ + (size_t)t * TSTRIDE))[(size_t)m * 512 + cw]);
        else if (t == 7) got = bf2f(((const bf16*)(F.ws + WS_IK))[(size_t)m * 64 + cw]);
        else got = ((const float*)(F.ws + WS_IW))[(size_t)m * 8 + cw];
        if (lane == 0 && !close_to(got, val, 0.02f, 0.02f)) chk_fail(F, 0x100u + (unsigned)t);
    }
}
__device__ __forceinline__ void chk_attn(Frame& F) {
    LAS float* red = (LAS float*)(F.lds + RING_OFF);
    const unsigned h = hash32((unsigned)F.vcu * 977u + 7u);
    const int a = F.vcu % 48, t = (F.vcu < 8) ? (int)(h % 300u) : (int)(h % (unsigned)SEQ);
    int b, hq, hv; const bf16 *Q, *K, *V, *O; bool masked = false;
    if (a < 32) { b = a >> 4; const int hh = (a >> 2) & 3, c = (a >> 1) & 1, hf = a & 1; hq = 2 * hh + c; hv = 2 * hh + hf;
        Q = (const bf16*)(F.ws + WS_DQ); K = (const bf16*)(F.ws + WS_DQ + TSTRIDE); V = (const bf16*)(F.ws + WS_DQ + 2 * TSTRIDE); O = (const bf16*)(F.ws + (c ? WS_O1 : WS_O0)); }
    else { b = (a - 32) >> 3; hq = hv = (a - 32) & 7; masked = true;
        Q = (const bf16*)(F.ws + WS_DQ + 3 * TSTRIDE); K = (const bf16*)(F.ws + WS_DQ + 4 * TSTRIDE); V = (const bf16*)(F.ws + WS_DQ + 5 * TSTRIDE); O = (const bf16*)(F.ws + WS_YB); }
    const unsigned long long* MK = (const unsigned long long*)(F.ws + WS_MASK) + (size_t)b * MASK_BSTRIDE;
    const size_t row = (size_t)b * SEQ + t;
    if (F.tid < 66) red[F.tid] = (F.tid == 0) ? -1e30f : 0.f;
    __syncthreads();
    float mx = -1e30f;
    for (int s = F.tid; s <= t; s += 512) {
        if (masked) { const int tl = s >> 6; const unsigned long long w = MK[idxr::moff(tl) + (t - 64 * tl)]; if (!((w >> (s & 63)) & 1ull)) continue; }
        float lg = 0.f; for (int d = 0; d < 64; ++d) lg += bf2f(Q[row * 512 + hq * 64 + d]) * bf2f(K[((size_t)b * SEQ + s) * 512 + hq * 64 + d]);
        mx = fmaxf(mx, lg);
    }
    for (int o = 1; o < 64; o <<= 1) mx = fmaxf(mx, __shfl_xor(mx, o));
    if (F.lane == 0) { float old = red[0]; while (mx > old) { const unsigned prev = atomicCAS((unsigned*)&red[0], __float_as_uint(old), __float_as_uint(mx)); if (prev == __float_as_uint(old)) break; old = __uint_as_float(prev); } }
    __syncthreads();
    mx = red[0];
    __syncthreads();
    float sum = 0.f;
    for (int s = F.tid; s <= t; s += 512) {
        if (masked) { const int tl = s >> 6; const unsigned long long w = MK[idxr::moff(tl) + (t - 64 * tl)]; if (!((w >> (s & 63)) & 1ull)) continue; }
        float lg = 0.f; for (int d = 0; d < 64; ++d) lg += bf2f(Q[row * 512 + hq * 64 + d]) * bf2f(K[((size_t)b * SEQ + s) * 512 + hq * 64 + d]);
        const float p = exp2f(lg - mx); sum += p;
        for (int d = 0; d < 64; ++d) atomicAdd((float*)&red[2 + d], p * bf2f(V[((size_t)b * SEQ + s) * 512 + hv * 64 + d]));
    }
    atomicAdd((float*)&red[1], sum);
    __syncthreads();
    if (F.tid < 64) { const float want = red[2 + F.tid] / red[1], got = bf2f(O[row * 512 + hv * 64 + F.tid]);
        if (!close_to(got, want, 0.03f, 0.003f)) chk_fail(F, masked ? 0x220u : 0x210u); }
    __syncthreads();
}
__device__ __forceinline__ void chk_mask(Frame& F) {
    LAS float* sc = (LAS float*)(F.lds + RING_OFF);
    LAS unsigned* cnt = (LAS unsigned*)(F.lds + XTR_OFF + 2048);
    if (F.vcu >= 64) return;
    const unsigned h = hash32((unsigned)F.vcu * 31337u + 99u);
    const int b = F.vcu & 1, t = (F.vcu < 6) ? (int)(h % 400u) : (int)(h % (unsigned)SEQ);
    const bf16* IQ = (const bf16*)(F.ws + WS_DQ + 6 * TSTRIDE); const bf16* IK = (const bf16*)(F.ws + WS_IK); const float* IW = (const float*)(F.ws + WS_IW);
    const unsigned long long* MK = (const unsigned long long*)(F.ws + WS_MASK) + (size_t)b * MASK_BSTRIDE;
    const size_t row = (size_t)b * SEQ + t;
    if (F.tid < 2) cnt[F.tid] = 0u;
    for (int s = F.tid; s <= t; s += 512) { float tot = 0.f;
        for (int hh = 0; hh < 8; ++hh) { float d = 0.f; for (int e = 0; e < 64; ++e) d += bf2f(IQ[row * 512 + hh * 64 + e]) * bf2f(IK[((size_t)b * SEQ + s) * 64 + e]); tot += IW[row * 8 + hh] * fmaxf(d, 0.f); }
        sc[s] = tot; }
    __syncthreads();
    for (int s = F.tid; s <= t; s += 512) { const float v = sc[s]; int rk = 0;
        for (int s2 = 0; s2 <= t; ++s2) { const float v2 = sc[s2]; rk += (v2 > v || (v2 == v && s2 < s)) ? 1 : 0; }
        const bool want = rk < 256; const int tl = s >> 6; const bool got = (MK[idxr::moff(tl) + (t - 64 * tl)] >> (s & 63)) & 1ull;
        if (want != got) atomicAdd((unsigned*)&cnt[0], 1u); if (got) atomicAdd((unsigned*)&cnt[1], 1u); }
    __syncthreads();
    if (F.tid == 0) { const unsigned expect = (t + 1 < 256) ? (unsigned)(t + 1) : 256u; if (cnt[1] != expect) chk_fail(F, 0x230u); else if (cnt[0] > 8u) chk_fail(F, 0x231u); }
    __syncthreads();
}
__device__ __forceinline__ void chk_pre1(Frame& F) {
    LAS float* mg = (LAS float*)(F.lds + RING_OFF);
    const float* x = (const float*)INP(0); const float* w_in = (const float*)INP(3); const float* wbd = (const float*)INP(6); const float* wbs = (const float*)INP(7); const float* wo = (const float*)INP(8);
    const bf16* YA = (const bf16*)(F.ws + WS_YA); const bf16* YB = (const bf16*)(F.ws + WS_YB); const float* PRE = (const float*)(F.ws + WS_PRE1);
    const int m = (int)(hash32((unsigned)F.vcu * 7919u + 3u) % (unsigned)NTOK);
    for (int c = F.tid; c < 1024; c += 512) { float ga = 0.f, gb = 0.f, pa = 0.f, pb = 0.f;
        for (int k = 0; k < 1024; ++k) { const float xv = bf2f((unsigned short)f2bf(x[(size_t)m * 1024 + k])); ga += xv * w_in[(size_t)k * WIN_OLD + 3656 + c]; gb += xv * w_in[(size_t)k * WIN_OLD + 4680 + c]; }
        for (int k = 0; k < 512; ++k) { pa += bf2f(YA[(size_t)m * 512 + k]) * wbd[(size_t)k * 1024 + c]; pb += bf2f(YB[(size_t)m * 512 + k]) * wbs[(size_t)k * 1024 + c]; }
        mg[c] = pa / (1.f + expf(-ga)) + pb / (1.f + expf(-gb)); }
    __syncthreads();
    for (int c = F.tid; c < 1024; c += 512) { float mix = 0.f; for (int k = 0; k < 1024; ++k) mix += mg[k] * wo[(size_t)k * 1024 + c];
        const float want = ALPHA * x[(size_t)m * 1024 + c] + mix, got = PRE[(size_t)m * 1024 + c];
        if (!close_to(got, want, 0.01f, 0.01f)) chk_fail(F, 0x300u); }
    __syncthreads();
}
__device__ __forceinline__ void chk_ffn(Frame& F) {
    LAS float* lgs = (LAS float*)(F.lds + RING_OFF);
    const float* X1 = (const float*)(F.ws + WS_PRE1); const float* wrg = (const float*)INP(11); const float* brg = (const float*)INP(12); const float* wre = (const float*)INP(13); const float* bre = (const float*)INP(14);
    const float* wg = (const float*)INP(15); const float* wu = (const float*)INP(16); const float* wd = (const float*)INP(17); const float* wple = (const float*)INP(18); const float* wpg = (const float*)INP(19); const float* p = (const float*)INP(1);
    const bf16* Y0 = (const bf16*)(F.ws + WS_Y0); const bf16* Y1 = (const bf16*)(F.ws + WS_Y1); const bf16* PLE = (const bf16*)(F.ws + WS_PLE);
    const int m = (int)(hash32((unsigned)F.vcu * 104729u + 11u) % (unsigned)NTOK);
    if (F.tid < 36) { float s = 0.f; for (int k = 0; k < 1024; ++k) s += X1[(size_t)m * 1024 + k] * (F.tid < 4 ? wrg[k * 4 + F.tid] : wre[k * 32 + F.tid - 4]); lgs[F.tid] = s + (F.tid < 4 ? brg[F.tid] : bre[F.tid - 4]); }
    __syncthreads();
    int gi = 0; for (int i = 1; i < 4; ++i) if (lgs[i] > lgs[gi]) gi = i;
    float gs = 0.f; for (int i = 0; i < 4; ++i) gs += expf(lgs[i] - lgs[gi]); const float gval = 1.f / gs;
    int i0 = 0; for (int k = 1; k < 8; ++k) if (lgs[4 + gi * 8 + k] > lgs[4 + gi * 8 + i0]) i0 = k;
    int i1 = (i0 == 0) ? 1 : 0; for (int k = 0; k < 8; ++k) if (k != i0 && lgs[4 + gi * 8 + k] > lgs[4 + gi * 8 + i1]) i1 = k;
    const float l0 = lgs[4 + gi * 8 + i0], l1 = lgs[4 + gi * 8 + i1], c0 = gval / (1.f + expf(l1 - l0)), c1 = gval - c0;
    __syncthreads();
    { const int sl = F.tid >> 8, f = F.tid & 255, e = gi * 8 + (sl ? i1 : i0); const float* G = wg + (size_t)e * 1024 * 256; const float* U = wu + (size_t)e * 1024 * 256; float g = 0.f, u = 0.f;
      for (int k = 0; k < 1024; ++k) { const float xv = X1[(size_t)m * 1024 + k]; g += xv * G[(size_t)k * 256 + f]; u += xv * U[(size_t)k * 256 + f]; }
      lgs[64 + F.tid] = g / (1.f + expf(-g)) * u * (sl ? c1 : c0); }
    __syncthreads();
    for (int c = F.tid; c < 1024; c += 512) { float y = 0.f;
        for (int sl = 0; sl < 2; ++sl) { const int e = gi * 8 + (sl ? i1 : i0); const float* D = wd + (size_t)e * 256 * 1024; for (int f = 0; f < 256; ++f) y += lgs[64 + sl * 256 + f] * D[(size_t)f * 1024 + c]; }
        const float goty = bf2f(Y0[(size_t)m * 1024 + c]) + bf2f(Y1[(size_t)m * 1024 + c]);
        if (!close_to(goty, y, 0.03f, 0.004f)) chk_fail(F, 0x400u);
        float gt = 0.f, tp = 0.f; for (int k = 0; k < 1024; ++k) gt += X1[(size_t)m * 1024 + k] * wpg[(size_t)k * 1024 + c]; for (int k = 0; k < 256; ++k) tp += p[(size_t)m * 256 + k] * wple[(size_t)k * 1024 + c];
        const float wantp = tp / (1.f + expf(-gt)), gotp = bf2f(PLE[(size_t)m * 1024 + c]);
        if (!close_to(gotp, wantp, 0.03f, 0.01f)) chk_fail(F, 0x410u); }
    __syncthreads();
}
#endif

#ifndef PHSEL
#define PHSEL 0xFFF
#endif
#define PHON(k) (((PHSEL) >> (k)) & 1)
__global__ void __launch_bounds__(NWAVES * 64, 2) skel_fwd(Args args) {
    extern __shared__ __attribute__((aligned(16))) unsigned char lds[];
    Frame F;
    F.lds = (LAS unsigned char*)lds;
    F.MISC = (volatile LAS unsigned*)(F.lds + MISC_OFF);
    F.tid = threadIdx.x; F.lane = F.tid & 63; F.wave = __builtin_amdgcn_readfirstlane(F.tid >> 6);
    F.G = gridDim.x; F.bx = blockIdx.x; { const int bx = blockIdx.x; F.vcu = (F.G % 8 == 0) ? (bx % 8) * (F.G / 8) + bx / 8 : bx; }
    F.ws = F.ws0 = args.ws; F.out = F.out0 = args.out; F.ap = &args;
    F.ctl = (gu32*)(F.ws + WS_CTL);
    for (int u = F.tid; u < (MISC_OFF + 128 - XTR_OFF) / 4; u += NWAVES * 64) ((LAS unsigned*)(F.lds + XTR_OFF))[u] = 0u;
    __syncthreads();
#if MK_PER_PHASE
    XcdBarrier bar; bar.bar = (unsigned*)(F.ctl + CW_BAR); bar.x = 0; bar.st = nullptr;
#define GRID_BAR() do { if (F.tid == 0) __hip_atomic_store(F.ctl + CW_TMO, 0xBADBA0u, RLX_AGENT); } while (0)
#else
    XcdBarrier bar = xcd_barrier_post((unsigned*)(F.ctl + CW_BAR), F.MISC + 8);
#define GRID_BAR() xcd_barrier(bar)
#endif
    const int lo = args.ph_lo, hi = args.ph_hi;
#define IN(k) (lo <= (k) && (k) < hi)
#define SEAM(k) do { if (IN(k) && IN((k) + 1)) GRID_BAR(); } while (0)
#define PHASE_ENTER() { size_t zo_ = 0; asm volatile("" : "+s"(zo_)); F.ws = F.ws0 + zo_; F.out = F.out0 + zo_; } F.vcu = __builtin_amdgcn_readfirstlane(F.vcu); asm volatile("" : "+s"(F.vcu), "+s"(F.G), "+s"(F.bx)); asm volatile("" : "+s"(F.lds)); F.tid = ltid(F.wave); F.lane = F.tid & 63; unsigned char* const ws = F.ws; bf16* const XB = (bf16*)(ws + WS_XB); (void)XB
    for (int l = 0; l < DEPTH; ++l) {
        const int pb = l * NPH_LAYER;
        if (PHON(0) && IN(pb + 0)) { PHASE_ENTER(); pw_phase(F, l); }
        SEAM(pb + 0);
        if (PHON(1) && IN(pb + 1)) { PHASE_ENTER();
            pg8::Gemm g{XB, (const bf16*)(ws + WS_WB + WB_WIN), 1024, 1024, 1024, nullptr}; pg8::StaticOrder S; S.init(NTOK, P1_N, F.G, F.bx, 1024);
            pg8::EpiProj E{(bf16*)(ws + WS_DQ), TSTRIDE / 2, (bf16*)(ws + WS_IK), (float*)(ws + WS_IW), (const float*)(ws + WS_ROPE)};
            pg8::gemm_phase<pg8::EpiProj, pg8::StaticOrder, true>(F.lds + RING_OFF, g, S, E, F.wave);
        }
        SEAM(pb + 1);
#if CHK
        if (l == 0 && IN(pb + 2) && (CHK & 1)) { PHASE_ENTER(); chk_proj(F); }
#endif
        if (PHON(2) && IN(pb + 2)) { PHASE_ENTER();
            const bf16* IQ = (const bf16*)(ws + WS_DQ + 6 * TSTRIDE); const bf16* IK = (const bf16*)(ws + WS_IK); const float* IW = (const float*)(ws + WS_IW);
            for (int p = F.vcu; p < 256; p += F.G) { const int b = p >> 7, s = p & 127;
                unsigned long long* m32 = (unsigned long long*)(ws + WS_MASK) + (size_t)b * MASK_BSTRIDE;
                for (int k2 = 0; k2 < 2; ++k2) indexer_unit(F, b, k2 ? s : 255 - s, IQ, IK, IW, m32); }
        }
        SEAM(pb + 2);
        if (PHON(3) && IN(pb + 3)) { PHASE_ENTER();
            using attn_body::bf16;
            const bf16* DQ = (const bf16*)(ws + WS_DQ); const bf16* DK = (const bf16*)(ws + WS_DQ + TSTRIDE); const bf16* DV = (const bf16*)(ws + WS_DQ + 2 * TSTRIDE);
            for (int p = F.vcu; p < 1024; p += F.G) { const int a = p >> 5, s = p & 31, b = a >> 4, h = (a >> 2) & 3, c = (a >> 1) & 1, hf = a & 1;
                bf16* O = (bf16*)(ws + (c ? WS_O1 : WS_O0));
                attn_body::attn_unit<8, false>(b, 2 * h + c, 2 * h + hf, 63 - s, DQ, DK, DV, O, nullptr, (char*)lds + RING_OFF, F.wave);
                attn_body::attn_unit<8, false>(b, 2 * h + c, 2 * h + hf, s, DQ, DK, DV, O, nullptr, (char*)lds + RING_OFF, F.wave); }
            const bf16* SQ = (const bf16*)(ws + WS_DQ + 3 * TSTRIDE); const bf16* SK = (const bf16*)(ws + WS_DQ + 4 * TSTRIDE); const bf16* SV = (const bf16*)(ws + WS_DQ + 5 * TSTRIDE);
            for (int p = F.vcu; p < 512; p += F.G) { const int a = p >> 5, s = p & 31, b = a >> 3, h = a & 7;
                const unsigned long long* MK = (const unsigned long long*)(ws + WS_MASK) + (size_t)b * MASK_BSTRIDE;
                attn_body::attn_unit<8, true>(b, h, h, 63 - s, SQ, SK, SV, (bf16*)(ws + WS_YB), MK, (char*)lds + RING_OFF, F.wave);
                attn_body::attn_unit<8, true>(b, h, h, s, SQ, SK, SV, (bf16*)(ws + WS_YB), MK, (char*)lds + RING_OFF, F.wave); }
        }
        SEAM(pb + 3);
#if CHK
        if (l == 0 && IN(pb + 4) && (CHK & 2)) { PHASE_ENTER(); chk_attn(F); }
        if (l == 0 && IN(pb + 4) && (CHK & 4)) { PHASE_ENTER(); chk_mask(F); }
#endif
        if (PHON(4) && IN(pb + 4)) { PHASE_ENTER(); ya_phase(F, l); }
        SEAM(pb + 4);
        if (PHON(5) && IN(pb + 5)) { PHASE_ENTER();
#define RELA() { size_t zo_ = 0; asm volatile("" : "+s"(zo_)); F.ws = F.ws0 + zo_; } unsigned char* const ws = F.ws; bf16* const XB = (bf16*)(ws + WS_XB); (void)XB; const bf16* WIN = (const bf16*)(ws + WS_WB + WB_WIN); bf16* MG = (bf16*)(ws + WS_MERGED); bf16* TG = (bf16*)(ws + WS_TMPG); (void)WIN; (void)MG; (void)TG
            { RELA(); pg8::Gemm g{XB, WIN + (size_t)3840 * 1024, 1024, 1024, 1024, nullptr}; pg8::StaticOrder S; S.init(NTOK, 1024, F.G, F.bx, 1024);
              pg8::EpiSig E{MG, 1024}; pg8::gemm_phase<pg8::EpiSig, pg8::StaticOrder, true>(F.lds + RING_OFF, g, S, E, F.wave); }
            { RELA(); pg8::Gemm g{XB, WIN + (size_t)4864 * 1024, 1024, 1024, 1024, nullptr}; pg8::StaticOrder S; S.init(NTOK, 1024, F.G, F.bx, 1024);
              pg8::EpiSig E{TG, 1024}; pg8::gemm_phase<pg8::EpiSig, pg8::StaticOrder, true>(F.lds + RING_OFF, g, S, E, F.wave); }
            VM_WAIT(); __builtin_amdgcn_fence(__ATOMIC_ACQUIRE, "agent"); VM_WAIT();
            { RELA(); pg8::Gemm g{(const bf16*)(ws + WS_YA), (const bf16*)(ws + WS_WB + WB_WBD), 512, 512, 512, nullptr}; pg8::StaticOrder S; S.init(NTOK, 1024, F.G, F.bx, 512);
              pg8::EpiGated E{MG, nullptr, MG, 1024}; pg8::gemm_phase<pg8::EpiGated, pg8::StaticOrder, true>(F.lds + RING_OFF, g, S, E, F.wave); }
            VM_WAIT(); __builtin_amdgcn_fence(__ATOMIC_ACQUIRE, "agent"); VM_WAIT();
            { RELA(); pg8::Gemm g{(const bf16*)(ws + WS_YB), (const bf16*)(ws + WS_WB + WB_WBS), 512, 512, 512, nullptr}; pg8::StaticOrder S; S.init(NTOK, 1024, F.G, F.bx, 512);
              pg8::EpiGated E{TG, MG, MG, 1024}; if (!(DBG & 4)) pg8::gemm_phase<pg8::EpiGated, pg8::StaticOrder, true>(F.lds + RING_OFF, g, S, E, F.wave); }
        }
        SEAM(pb + 5);
        if (PHON(6) && IN(pb + 6)) { PHASE_ENTER();
            pg8::Gemm g{(const bf16*)(ws + WS_MERGED), (const bf16*)(ws + WS_WB + WB_WO), 1024, 1024, 1024, nullptr}; pg8::StaticOrder S; S.init(NTOK, 1024, F.G, F.bx, 1024);
            const float* xres = (l == 0) ? (const float*)INP(0) : (const float*)F.out;
            pg8::EpiResF32 E{xres, (float*)(ws + WS_PRE1), ALPHA}; pg8::gemm_phase<pg8::EpiResF32, pg8::StaticOrder, true>(F.lds + RING_OFF, g, S, E, F.wave);
        }
        SEAM(pb + 6);
#if CHK
        if (l == 0 && IN(pb + 7) && (CHK & 8)) { PHASE_ENTER(); chk_pre1(F); }
#endif
        if (PHON(7) && IN(pb + 7)) { PHASE_ENTER(); ln1_router_phase(F, l); }
        SEAM(pb + 7);
        if (PHON(8) && IN(pb + 8)) { PHASE_ENTER(); lists_phase(F, l); }
        SEAM(pb + 8);
        if (PHON(9) && IN(pb + 9)) { PHASE_ENTER();
            const int T = build_tile_table(F);
            pg8::Gemm g{XB, (const bf16*)(ws + WS_WB + WB_WGU), 1024, 1024, 1024, (const int*)(ws + WS_ROUTE + RT_ROW)};
            GroupSched S{2 * T, F.G, F.vcu, 1, (const LAS int*)(F.lds + XTR_OFF), 512L * 1024, 256L * 1024};
            pg8::EpiGU E{(bf16*)(ws + WS_HG), (const float*)(ws + WS_ROUTE + RT_CW)};
            pg8::gemm_phase<pg8::EpiGU, GroupSched, true, true>(F.lds + RING_OFF, g, S, E, F.wave);
        }
        SEAM(pb + 9);
        if (PHON(10) && IN(pb + 10)) { PHASE_ENTER();
            const int T = build_tile_table(F);
#ifndef P10SEL
#define P10SEL 7
#endif
            if (P10SEL & 1) { RELA(); pg8::Gemm g{(const bf16*)(ws + WS_HG), (const bf16*)(ws + WS_WB + WB_WD), 256, 256, 256, nullptr};
              GroupSched S{4 * T, F.G, F.vcu, 2, (const LAS int*)(F.lds + XTR_OFF), 1024L * 256, 256L * 256};
              pg8::EpiDown E{(const int*)(ws + WS_ROUTE + RT_ENT), (bf16*)(ws + WS_Y0), (unsigned)(WS_Y1 - WS_Y0)};
              pg8::gemm_phase<pg8::EpiDown, GroupSched, true>(F.lds + RING_OFF, g, S, E, F.wave); }
            if (P10SEL & 2) { RELA(); pg8::Gemm g{(const bf16*)(ws + WS_PB), (const bf16*)(ws + WS_WB + WB_WPLE), 256, 256, 256, nullptr}; pg8::StaticOrder S; S.init(NTOK, 1024, F.G, F.bx, 256);
              pg8::EpiStore E{(bf16*)(ws + WS_PLE), 1024}; pg8::gemm_phase<pg8::EpiStore, pg8::StaticOrder, true>(F.lds + RING_OFF, g, S, E, F.wave); }
            VM_WAIT(); __builtin_amdgcn_fence(__ATOMIC_ACQUIRE, "agent"); VM_WAIT();
            if (P10SEL & 4) { RELA(); pg8::Gemm g{XB, (const bf16*)(ws + WS_WB + WB_WPG), 1024, 1024, 1024, nullptr}; pg8::StaticOrder S; S.init(NTOK, 1024, F.G, F.bx, 1024);
              pg8::EpiPle E{(const bf16*)(ws + WS_PLE), (bf16*)(ws + WS_PLE)}; pg8::gemm_phase<pg8::EpiPle, pg8::StaticOrder, true>(F.lds + RING_OFF, g, S, E, F.wave); }
        }
        SEAM(pb + 10);
#if CHK
        if (l == 0 && IN(pb + 11) && (CHK & 16)) { PHASE_ENTER(); chk_ffn(F); }
#endif
        if (PHON(11) && IN(pb + 11)) { PHASE_ENTER(); ln2_phase(F, l); }
        if (l + 1 < DEPTH) SEAM(pb + 11);
    }
#undef IN
#undef SEAM
}

extern "C" void kernel_launch(void* const* d_in, const int* in_sizes, int n_in, void* d_out, int out_size, void* d_ws, size_t ws_size, hipStream_t stream) {
    static int grid = 0;
    if (grid == 0) {
        if (n_in != 22 || in_sizes[0] != NTOK * DMODEL || out_size != NTOK * DMODEL || ws_size < WS_END) { fprintf(stderr, "kernel_launch: unexpected problem geometry (n_in %d, ws %zu); nothing launched\n", n_in, ws_size); grid = -1; return; }
        int dev = 0, cus = 0, per_cu = 0;
        if (hipGetDevice(&dev) != hipSuccess || hipDeviceGetAttribute(&cus, hipDeviceAttributeMultiprocessorCount, dev) != hipSuccess) { grid = -1; return; }
        if (hipFuncSetAttribute((const void*)skel_fwd, hipFuncAttributeMaxDynamicSharedMemorySize, LDS_BYTES) != hipSuccess) { fprintf(stderr, "kernel_launch: hipFuncSetAttribute failed\n"); grid = -1; return; }
        if (hipOccupancyMaxActiveBlocksPerMultiprocessor(&per_cu, (const void*)skel_fwd, NWAVES * 64, LDS_BYTES) != hipSuccess || per_cu < 1) { fprintf(stderr, "kernel_launch: occupancy query reports %d\n", per_cu); }
        (void)hipGetLastError();
        if (cus < 256) { fprintf(stderr, "kernel_launch: needs 256 CUs (got %d)\n", cus); grid = -1; return; }
        grid = 256;
    }
    if (grid < 0) return;
    if (hipMemsetAsync((char*)d_ws + WS_CTL, 0, CTL_ZERO_BYTES, stream) != hipSuccess) return;
    Args a{};
    for (int i = 0; i < 22; ++i) a.in[i] = d_in[i];
    a.out = (float*)d_out; a.ws = (unsigned char*)d_ws;
#if MK_PER_PHASE
    for (int ph = 0; ph < NPHASE; ++ph) { a.ph_lo = ph; a.ph_hi = ph + 1; hipLaunchKernelGGL(skel_fwd, dim3(grid), dim3(NWAVES * 64), LDS_BYTES, stream, a); }
#else
    a.ph_lo = 0; a.ph_hi = NPHASE;
    hipLaunchKernelGGL(skel_fwd, dim3(grid), dim3(NWAVES * 64), LDS_BYTES, stream, a);
#endif
}
```

```cpp
#include <hip/hip_runtime.h>
#include <hip/hip_bf16.h>
#include <cstdio>
#include <cstdint>
#include <cmath>

__device__ __forceinline__ int ltid(int wave) { int l; asm volatile("v_mbcnt_lo_u32_b32 %0, -1, 0\n\tv_mbcnt_hi_u32_b32 %0, -1, %0" : "=v"(l)); return (wave << 6) | l; }

namespace pg8 {
#define PG8_LAS __attribute__((address_space(3)))
typedef unsigned short bf16_t;
typedef short bf16x8 __attribute__((ext_vector_type(8)));
typedef float f32x4 __attribute__((ext_vector_type(4)));
typedef unsigned u32x4 __attribute__((ext_vector_type(4)));
typedef int i32x4_t __attribute__((ext_vector_type(4)));
typedef int i32x8_t __attribute__((ext_vector_type(8)));
constexpr int BM = 256, BK = 64, HALF = 128, HTB = HALF * BK * 2  , STAGE_BYTES = 8 * HTB, NXCD = 8, WGM = 8;
constexpr float C2 = 0.125f * 1.4426950408889634f;

__host__ __device__ __forceinline__ int lds_byte(int r, int c) { const int st = (r >> 4) * 2 + (c >> 5), rr = r & 15, cc = c & 31, ob = rr * 64 + cc * 2; return st * 1024 + (ob ^ (((ob >> 9) & 1) << 5)); }
__host__ __device__ __forceinline__ void stage_rc(int b, int& R, int& C) { const int st = b / 1024, sb = b % 1024, swz = sb ^ (((sb >> 9) & 1) << 5); R = (st >> 1) * 16 + swz / 64; C = (st & 1) * 32 + (swz % 64) / 2; }
__host__ __device__ __forceinline__ int perm32(int rho) { const int n = rho >> 4, i = rho & 15; return 8 * (i >> 2) + 4 * n + (i & 3); }

struct Unit { int pm, pn; long boff; };
struct Gemm { const bf16_t* A; const bf16_t* Bt; int K, lda, ldb; const int* rows; };

struct StaticOrder {
    int nM, nN, nwg, G, c, ldb;
    __device__ void init(int M, int N, int G_, int c_, int ldb_) { nM = M / BM; nN = N / BM; nwg = nM * nN; G = G_; c = c_; ldb = ldb_; }
    __device__ bool next(int i, Unit& u) const {
        const long L = (long)i * G + c; if (L >= nwg) return false;
        int wgid = (int)L; { const int q = nwg / NXCD, r = nwg % NXCD, xcd = wgid % NXCD, off = wgid / NXCD; wgid = (xcd < r ? xcd * (q + 1) : r * (q + 1) + (xcd - r) * q) + off; }
        const int nig = WGM * nN, gid = wgid / nig, fm = gid * WGM, gsz = (nM - fm) < WGM ? (nM - fm) : WGM;
        u.pm = fm + ((wgid % nig) % gsz); u.pn = (wgid % nig) / gsz; u.boff = (long)u.pn * BM * ldb; return true;
    }
};

__device__ __forceinline__ unsigned cvt_pk_bf16(float lo, float hi) { unsigned r; asm volatile("v_cvt_pk_bf16_f32 %0, %1, %2" : "=v"(r) : "v"(lo), "v"(hi)); return r; }
__device__ __forceinline__ float bf_lo(unsigned w) { return __uint_as_float(w << 16); }
__device__ __forceinline__ float bf_hi(unsigned w) { return __uint_as_float(w & 0xffff0000u); }
__device__ __forceinline__ float sigm(float x) { return __builtin_amdgcn_rcpf(1.f + __builtin_amdgcn_exp2f(-1.4426950408889634f * x)); }
__device__ __forceinline__ u32x4 pack8(f32x4 a, f32x4 b) { u32x4 w; w.x = cvt_pk_bf16(a[0], a[1]); w.y = cvt_pk_bf16(a[2], a[3]); w.z = cvt_pk_bf16(b[0], b[1]); w.w = cvt_pk_bf16(b[2], b[3]); return w; }
__device__ __forceinline__ void unpack8(u32x4 w, f32x4& a, f32x4& b) { a = (f32x4){bf_lo(w.x), bf_hi(w.x), bf_lo(w.y), bf_hi(w.y)}; b = (f32x4){bf_lo(w.z), bf_hi(w.z), bf_lo(w.w), bf_hi(w.w)}; }

#define PG8_EPI_ARGS const f32x4 (&acc)[2][2][4][2], const Unit& u, int wr, int wc, int fr, int fq

#define PG8_PIN(x) asm volatile("" : "+v"(x))
template <class T> __device__ __forceinline__ T& at(const void* base, unsigned byteoff) { return *(T*)((char*)base + byteoff); }

struct EpiProj {
    bf16_t* base; size_t tstride; bf16_t* IK; float* IW; const float* rope;
    __device__ __forceinline__ void operator()(PG8_EPI_ARGS) const {
        const int pn = u.pn, row0 = u.pm * BM + wr * 64 + fr;
        if (pn < 14) {
            const int t = pn >> 1;
            bf16_t* dst = base + (size_t)t * tstride;
            const bool rp = (t == 0) | (t == 1) | (t == 3) | (t == 4) | (t == 6);
            const float sc = (t == 0 || t == 3) ? C2 : (t == 6 ? 0.125f : 1.f);
            const bool rotw = rp && ((wc & 1) == 0);
            const unsigned cb = (unsigned)((pn & 1) * 256 + wc * 32 + 8 * fq) * 2u;
#pragma unroll
            for (int ai = 0; ai < 2; ++ai)
#pragma unroll
                for (int m = 0; m < 4; ++m) {
                    unsigned row = (unsigned)(row0 + ai * HALF + m * 16); PG8_PIN(row);
                    f32x4 c0 = {1.f, 1.f, 1.f, 1.f}, c1 = c0, s0 = {0.f, 0.f, 0.f, 0.f}, s1 = s0;
                    if (rotw) { c0 = at<const f32x4>(rope, row * 64u); c1 = at<const f32x4>(rope, row * 64u + 16u); s0 = at<const f32x4>(rope, row * 64u + 32u); s1 = at<const f32x4>(rope, row * 64u + 48u); }
#pragma unroll
                    for (int bj = 0; bj < 2; ++bj) {
                        f32x4 v0 = acc[ai][bj][m][0], v1 = acc[ai][bj][m][1];
                        if (rotw) {
                            f32x4 p0, p1;
#pragma unroll
                            for (int i = 0; i < 4; ++i) { p0[i] = __shfl_xor(v0[i], 16); p1[i] = __shfl_xor(v1[i], 16); }
                            const float sg = (fq == 0) ? -1.f : 1.f;
                            const f32x4 r0 = v0 * c0 + (p0 * s0) * sg, r1 = v1 * c1 + (p1 * s1) * sg;
                            if (fq < 2) { v0 = r0; v1 = r1; }
                        }
                        v0 = v0 * sc; v1 = v1 * sc;
                        at<u32x4>(dst, row * 1024u + cb + bj * 256u) = pack8(v0, v1);
                    }
                    asm volatile("" ::: "memory");
                }
        } else {
#pragma unroll
            for (int ai = 0; ai < 2; ++ai)
#pragma unroll
                for (int m = 0; m < 4; ++m) {
                    unsigned row = (unsigned)(row0 + ai * HALF + m * 16); PG8_PIN(row);
                    f32x4 v0 = acc[ai][0][m][0], v1 = acc[ai][0][m][1];
                    if (wc == 0) {
                        const f32x4 c0 = at<const f32x4>(rope, row * 64u), c1 = at<const f32x4>(rope, row * 64u + 16u), s0 = at<const f32x4>(rope, row * 64u + 32u), s1 = at<const f32x4>(rope, row * 64u + 48u);
                        f32x4 p0, p1;
#pragma unroll
                        for (int i = 0; i < 4; ++i) { p0[i] = __shfl_xor(v0[i], 16); p1[i] = __shfl_xor(v1[i], 16); }
                        const float sg = (fq == 0) ? -1.f : 1.f;
                        const f32x4 r0 = v0 * c0 + (p0 * s0) * sg, r1 = v1 * c1 + (p1 * s1) * sg;
                        if (fq < 2) { v0 = r0; v1 = r1; }
                    }
                    if (wc < 2) at<u32x4>(IK, row * 128u + (unsigned)(wc * 32 + 8 * fq) * 2u) = pack8(v0, v1);
                    else if (wc == 2 && fq == 0) { at<f32x4>(IW, row * 32u) = v0 * 0.35355339059f; at<f32x4>(IW, row * 32u + 16u) = v1 * 0.35355339059f; }
                    asm volatile("" ::: "memory");
                }
        }
    }
};
struct EpiSig {
    unsigned char* out; int ldc; float pre;
    __device__ __forceinline__ void operator()(PG8_EPI_ARGS) const {
        const unsigned o0 = (unsigned)(u.pm * BM + wr * 64 + fr) * 1024u + (unsigned)(u.pn * BM + wc * 32 + 8 * fq);
#pragma unroll
        for (int ai = 0; ai < 2; ++ai)
#pragma unroll
            for (int m = 0; m < 4; ++m) {
                unsigned o = o0 + (unsigned)(ai * HALF + m * 16) * 1024u; PG8_PIN(o);
#pragma unroll
                for (int bj = 0; bj < 2; ++bj) {
                    const f32x4 v0 = acc[ai][bj][m][0], v1 = acc[ai][bj][m][1];
                    unsigned w0 = 0u, w1 = 0u;
#pragma unroll
                    for (int i = 0; i < 4; ++i) { w0 = __builtin_amdgcn_cvt_pk_u8_f32(sigm(v0[i] * pre) * 255.f, i, w0); w1 = __builtin_amdgcn_cvt_pk_u8_f32(sigm(v1[i] * pre) * 255.f, i, w1); }
                    at<unsigned long long>(out, o + bj * 128u) = (unsigned long long)w0 | ((unsigned long long)w1 << 32);
                }
                asm volatile("" ::: "memory");
            }
    }
};
template <bool ADD>
struct EpiGatedT {
    const unsigned char* gate; const bf16_t* addsrc; bf16_t* out; int ldc;
    __device__ __forceinline__ void operator()(PG8_EPI_ARGS) const {
        const unsigned o0 = ((unsigned)(u.pm * BM + wr * 64 + fr) * 1024u + (unsigned)(u.pn * BM + wc * 32 + 8 * fq)) * 2u;
        constexpr int NB = ADD ? 4 : 8;
        unsigned long long gq[NB][2]; u32x4 aq[ADD ? NB : 1][2];
#define PG8_GT_LD(it) do { unsigned o_ = o0 + (unsigned)(((it) >> 2) * HALF + ((it) & 3) * 16) * 2048u; PG8_PIN(o_); \
            gq[(it) % NB][0] = at<const unsigned long long>(gate, o_ >> 1); gq[(it) % NB][1] = at<const unsigned long long>(gate, (o_ >> 1) + 128u); \
            if constexpr (ADD) { aq[(it) % NB][0] = at<const u32x4>(addsrc, o_); aq[(it) % NB][1] = at<const u32x4>(addsrc, o_ + 256u); } } while (0)
#pragma unroll
        for (int it = 0; it < NB; ++it) PG8_GT_LD(it);
#pragma unroll
        for (int it = 0; it < 8; ++it) { const int ai = it >> 2, m = it & 3;
                unsigned o = o0 + (unsigned)(ai * HALF + m * 16) * 2048u; PG8_PIN(o);
                f32x4 v0[2], v1[2];
#pragma unroll
                for (int bj = 0; bj < 2; ++bj) {
                    const unsigned long long gw = gq[it % NB][bj]; const unsigned glo = (unsigned)gw, ghi = (unsigned)(gw >> 32); constexpr float K8 = 1.f / 255.f;
                    const f32x4 g0 = {(float)(glo & 0xffu) * K8, (float)((glo >> 8) & 0xffu) * K8, (float)((glo >> 16) & 0xffu) * K8, (float)(glo >> 24) * K8};
                    const f32x4 g1 = {(float)(ghi & 0xffu) * K8, (float)((ghi >> 8) & 0xffu) * K8, (float)((ghi >> 16) & 0xffu) * K8, (float)(ghi >> 24) * K8};
                    v0[bj] = acc[ai][bj][m][0] * g0; v1[bj] = acc[ai][bj][m][1] * g1;
                    if constexpr (ADD) { f32x4 a0, a1; unpack8(aq[it % NB][bj], a0, a1); v0[bj] = v0[bj] + a0; v1[bj] = v1[bj] + a1; }
                }
                if (it + NB < 8) PG8_GT_LD(it + NB);
#pragma unroll
                for (int bj = 0; bj < 2; ++bj) at<u32x4>(out, o + bj * 256u) = pack8(v0[bj], v1[bj]);
                asm volatile("" ::: "memory");
            }
#undef PG8_GT_LD
    }
};
struct EpiResBf16 {
    const bf16_t* x; bf16_t* out; float alpha;
    __device__ __forceinline__ void operator()(PG8_EPI_ARGS) const {
        const unsigned o0 = ((unsigned)(u.pm * BM + wr * 64 + fr) * 1024u + (unsigned)(u.pn * BM + wc * 32 + 8 * fq)) * 2u;
        u32x4 xq[8][2];
#define PG8_X_LD(buf, it) do { unsigned o_ = o0 + (unsigned)(((it) >> 2) * HALF + ((it) & 3) * 16) * 2048u; PG8_PIN(o_); \
            xq[buf][0] = at<const u32x4>(x, o_); xq[buf][1] = at<const u32x4>(x, o_ + 256u); } while (0)
#pragma unroll
        for (int it = 0; it < 8; ++it) PG8_X_LD(it, it);
#pragma unroll
        for (int it = 0; it < 8; ++it) { const int ai = it >> 2, m = it & 3;
                unsigned o = o0 + (unsigned)(ai * HALF + m * 16) * 2048u; PG8_PIN(o);
#pragma unroll
                for (int bj = 0; bj < 2; ++bj) { f32x4 x0, x1; unpack8(xq[it][bj], x0, x1);
                    at<u32x4>(out, o + bj * 256u) = pack8(x0 * alpha + acc[ai][bj][m][0], x1 * alpha + acc[ai][bj][m][1]); }
                asm volatile("" ::: "memory");
            }
#undef PG8_X_LD
    }
};
struct EpiGU {
    bf16_t* HG; const float* cw; float pre;
    __device__ __forceinline__ void operator()(PG8_EPI_ARGS) const {
        const int row0 = u.pm * BM + wr * 64 + fr; const unsigned cb = (unsigned)(u.pn * HALF + wc * 32 + 8 * fq) * 2u;
        float cv[8];
#pragma unroll
        for (int it = 0; it < 8; ++it) cv[it] = at<const float>(cw, (unsigned)(row0 + (it >> 2) * HALF + (it & 3) * 16) * 4u);
#pragma unroll
        for (int it = 0; it < 8; ++it) { const int ai = it >> 2, m = it & 3;
                unsigned row = (unsigned)(row0 + ai * HALF + m * 16); PG8_PIN(row);
                const float c = cv[it];
                f32x4 g0 = acc[ai][0][m][0] * pre, g1 = acc[ai][0][m][1] * pre; const f32x4 u0 = acc[ai][1][m][0] * pre, u1 = acc[ai][1][m][1] * pre;
#pragma unroll
                for (int i = 0; i < 4; ++i) { g0[i] = g0[i] * sigm(g0[i]) * u0[i] * c; g1[i] = g1[i] * sigm(g1[i]) * u1[i] * c; }
                at<u32x4>(HG, row * 512u + cb) = pack8(g0, g1);
                asm volatile("" ::: "memory");
            }
    }
};
struct EpiDown {
    const int* ent; bf16_t* Y0; unsigned ystride;
    __device__ __forceinline__ void operator()(PG8_EPI_ARGS) const {
        const int row0 = u.pm * BM + wr * 64 + fr; const unsigned cb = (unsigned)(u.pn * BM + wc * 32 + 8 * fq) * 2u;
        int ev[8];
#pragma unroll
        for (int it = 0; it < 8; ++it) ev[it] = at<const int>(ent, (unsigned)(row0 + (it >> 2) * HALF + (it & 3) * 16) * 4u);
#pragma unroll
        for (int it = 0; it < 8; ++it) { const int ai = it >> 2, m = it & 3; const int e = ev[it];
                if (e >= 0) { unsigned o = (unsigned)(e >> 1) * 2048u + cb + (unsigned)(e & 1) * ystride; PG8_PIN(o);
#pragma unroll
                    for (int bj = 0; bj < 2; ++bj) at<u32x4>(Y0, o + bj * 256u) = pack8(acc[ai][bj][m][0], acc[ai][bj][m][1]); }
                asm volatile("" ::: "memory");
            }
    }
};
struct EpiStore {
    bf16_t* out; int ldc;
    __device__ __forceinline__ void operator()(PG8_EPI_ARGS) const {
        const unsigned o0 = ((unsigned)(u.pm * BM + wr * 64 + fr) * 1024u + (unsigned)(u.pn * BM + wc * 32 + 8 * fq)) * 2u;
#pragma unroll
        for (int ai = 0; ai < 2; ++ai)
#pragma unroll
            for (int m = 0; m < 4; ++m) {
                unsigned o = o0 + (unsigned)(ai * HALF + m * 16) * 2048u; PG8_PIN(o);
#pragma unroll
                for (int bj = 0; bj < 2; ++bj) at<u32x4>(out, o + bj * 256u) = pack8(acc[ai][bj][m][0], acc[ai][bj][m][1]);
                asm volatile("" ::: "memory");
            }
    }
};
struct EpiPle {
    const bf16_t* t1; bf16_t* out; float pre;
    __device__ __forceinline__ void operator()(PG8_EPI_ARGS) const {
        const unsigned o0 = ((unsigned)(u.pm * BM + wr * 64 + fr) * 1024u + (unsigned)(u.pn * BM + wc * 32 + 8 * fq)) * 2u;
        u32x4 tq[8][2];
#define PG8_T_LD(buf, it) do { unsigned o_ = o0 + (unsigned)(((it) >> 2) * HALF + ((it) & 3) * 16) * 2048u; PG8_PIN(o_); \
            tq[buf][0] = at<const u32x4>(t1, o_); tq[buf][1] = at<const u32x4>(t1, o_ + 256u); } while (0)
#pragma unroll
        for (int it = 0; it < 8; ++it) PG8_T_LD(it, it);
#pragma unroll
        for (int it = 0; it < 8; ++it) { const int ai = it >> 2, m = it & 3;
                unsigned o = o0 + (unsigned)(ai * HALF + m * 16) * 2048u; PG8_PIN(o);
#pragma unroll
                for (int bj = 0; bj < 2; ++bj) {
                    f32x4 t0, t1v; unpack8(tq[it][bj], t0, t1v);
                    f32x4 v0 = acc[ai][bj][m][0], v1 = acc[ai][bj][m][1];
#pragma unroll
                    for (int i = 0; i < 4; ++i) { v0[i] = sigm(v0[i] * pre) * t0[i]; v1[i] = sigm(v1[i] * pre) * t1v[i]; }
                    at<u32x4>(out, o + bj * 256u) = pack8(v0, v1);
                }
                asm volatile("" ::: "memory");
            }
#undef PG8_T_LD
    }
};

template <class Epi, class Sched, bool ALIGN_EPI, bool GATHER = false, bool FP8 = false>
__device__ __forceinline__ void gemm_phase(PG8_LAS unsigned char* lds, const Gemm g, const Sched& S, const Epi& E, int wave_in) {
    const int tid = ltid(wave_in), wid = __builtin_amdgcn_readfirstlane(tid >> 6), lane = tid & 63, wr = wid >> 2, wc = wid & 3, fr = lane & 15, fq = lane >> 4;
    int K_ = g.K; asm volatile("" : "+s"(K_));
    const int K = K_, nt = K / BK;
    int RA[2], CA[2]; unsigned voffB[2], voffA[2];
#pragma unroll
    for (int i = 0; i < 2; ++i) { int R, C; stage_rc(tid * 16 + i * 8192, R, C); const int Rb = (R & ~31) + perm32(R & 31); RA[i] = R; CA[i] = C; voffB[i] = (unsigned)(Rb * g.ldb + C) * 2u; voffA[i] = (unsigned)(R * g.lda + C) * 2u; }
    const size_t hstepA = (size_t)HALF * g.lda * 2;
    const size_t kstep = (size_t)(BK * 2);
    const size_t hstepB = (size_t)HALF * g.ldb * 2;
    const unsigned ldsw = (unsigned)wid * 1024u;
    const int aoff = lds_byte(wr * 64 + fr, fq * 8), boff = lds_byte(wc * 32 + fr, fq * 8);
    const char* Ab = (const char*)g.A;
#define PG8_SA(b, h) (((b) * 2 + (h)) * HTB)
#define PG8_SB(b, h) ((4 + (b) * 2 + (h)) * HTB)
#define PG8_STAGE_A(bufoff, kb, OFF, h) do { _Pragma("unroll") for (int _i = 0; _i < 2; ++_i) { const char* _p; \
        if constexpr (GATHER) _p = Ab + (kb) + (OFF##_v)[h][_i]; else _p = Ab + ((kb) + (OFF##_u) + (size_t)(h) * hstepA) + voffA[_i]; \
        __builtin_amdgcn_global_load_lds((const unsigned*)_p, (PG8_LAS unsigned*)(lds + (bufoff) + ldsw + _i * 8192), 16, 0, 0); } } while (0)
#define PG8_STAGE_B(bufoff, gbase) do { _Pragma("unroll") for (int _i = 0; _i < 2; ++_i) \
        __builtin_amdgcn_global_load_lds((const unsigned*)((const char*)(gbase) + voffB[_i]), (PG8_LAS unsigned*)(lds + (bufoff) + ldsw + _i * 8192), 16, 0, 0); } while (0)
#define PG8_MKOFF(uu, OFF) do { if constexpr (GATHER) { _Pragma("unroll") for (int _h = 0; _h < 2; ++_h) _Pragma("unroll") for (int _i = 0; _i < 2; ++_i) { \
        const int _row = g.rows[(uu).pm * BM + _h * HALF + RA[_i]]; (OFF##_v)[_h][_i] = (unsigned)(_row * g.lda + CA[_i]) * 2u; } } else { OFF##_u = (size_t)(uu).pm * BM * g.lda * 2; } } while (0)
#define PG8_LDA(dst, b, h) do { _Pragma("unroll") for (int m = 0; m < 4; ++m) { if constexpr (FP8) { dst##8[m].lo = *(const PG8_LAS i32x4_t*)(lds + PG8_SA(b, h) + aoff + m * 2048); dst##8[m].hi = *(const PG8_LAS i32x4_t*)(lds + PG8_SA(b, h) + aoff + m * 2048 + 1024); } \
        else { _Pragma("unroll") for (int k = 0; k < 2; ++k) dst[m][k] = *(const PG8_LAS bf16x8*)(lds + PG8_SA(b, h) + aoff + m * 2048 + k * 1024); } } } while (0)
#define PG8_LDB(dst, b, h) do { _Pragma("unroll") for (int n = 0; n < 2; ++n) { if constexpr (FP8) { dst##8[n].lo = *(const PG8_LAS i32x4_t*)(lds + PG8_SB(b, h) + boff + n * 2048); dst##8[n].hi = *(const PG8_LAS i32x4_t*)(lds + PG8_SB(b, h) + boff + n * 2048 + 1024); } \
        else { _Pragma("unroll") for (int k = 0; k < 2; ++k) dst[n][k] = *(const PG8_LAS bf16x8*)(lds + PG8_SB(b, h) + boff + n * 2048 + k * 1024); } } } while (0)
#define PG8_MMA(ai, bj, At, Bt) do { __builtin_amdgcn_s_setprio(1); \
        if constexpr (FP8) { _Pragma("unroll") for (int m = 0; m < 4; ++m) _Pragma("unroll") for (int n = 0; n < 2; ++n) \
            asm volatile("v_mfma_f32_16x16x128_f8f6f4 %0, %1, %2, %0" : "+v"(acc[ai][bj][m][n]) : "v"(Bt##8[n]), "v"(At##8[m])); }   \
        else { _Pragma("unroll") for (int m = 0; m < 4; ++m) _Pragma("unroll") for (int n = 0; n < 2; ++n) _Pragma("unroll") for (int k = 0; k < 2; ++k) \
            acc[ai][bj][m][n] = __builtin_amdgcn_mfma_f32_16x16x32_bf16(Bt[n][k], At[m][k], acc[ai][bj][m][n], 0, 0, 0); } __builtin_amdgcn_s_setprio(0); } while (0)
#define PG8_WAIT_V(n) asm volatile("s_waitcnt vmcnt(" #n ")" ::: "memory")
#define PG8_WAIT_L(n) asm volatile("s_waitcnt lgkmcnt(" #n ")" ::: "memory")
#define PG8_BAR __builtin_amdgcn_s_barrier()
#define PG8_SCHED __builtin_amdgcn_sched_barrier(0)
    Unit cur, nxt; int ui = 0;
    if (!S.next(0, cur)) return;
    f32x4 acc[2][2][4][2];
#pragma unroll
    for (int a = 0; a < 2; ++a)
#pragma unroll
        for (int b = 0; b < 2; ++b)
#pragma unroll
            for (int m = 0; m < 4; ++m)
#pragma unroll
                for (int n = 0; n < 2; ++n) acc[a][b][m][n] = (f32x4){0.f, 0.f, 0.f, 0.f};
    bf16x8 At[4][2], B0[2][2], B1[2][2];
    i32x8_t At8[4], B08[2], B18[2];
    unsigned offAc_v[2][2], offAn_v[2][2]; size_t offAc_u = 0, offAn_u = 0;
    PG8_MKOFF(cur, offAc);
    const char* cB = (const char*)(g.Bt + cur.boff);
    PG8_STAGE_B(PG8_SB(0, 0), cB); PG8_STAGE_B(PG8_SB(0, 1), cB + hstepB); PG8_STAGE_A(PG8_SA(0, 0), 0, offAc, 0); PG8_STAGE_A(PG8_SA(0, 1), 0, offAc, 1);
    if (wr == 1) PG8_BAR;
    PG8_WAIT_V(2); PG8_BAR;
    PG8_STAGE_B(PG8_SB(1, 0), cB + kstep); PG8_STAGE_A(PG8_SA(1, 0), kstep, offAc, 0); PG8_STAGE_B(PG8_SB(1, 1), cB + hstepB + kstep);
    PG8_WAIT_V(6); PG8_BAR;
    for (;;) {
        const bool has_next = S.next(ui + 1, nxt);
        if (has_next) { PG8_MKOFF(nxt, offAn); }
        else { offAn_u = offAc_u;
#pragma unroll
            for (int h = 0; h < 2; ++h)
#pragma unroll
                for (int i = 0; i < 2; ++i) offAn_v[h][i] = offAc_v[h][i];
        }
        const char* nB = has_next ? (const char*)(g.Bt + nxt.boff) : cB;
        for (int t = 0; t < nt; t += 2) {
            const bool last = (t == nt - 2);
            const size_t a1k = (size_t)(t + 1) * kstep;
            const size_t a2k = last ? (size_t)0 : (size_t)(t + 2) * kstep; const char* b2 = last ? nB : cB + (size_t)(t + 2) * kstep;
            const size_t a3k = a2k + kstep; const char* b3 = b2 + kstep;
            unsigned o2_v[2][2]; const size_t o2_u = last ? offAn_u : offAc_u;
#pragma unroll
            for (int h = 0; h < 2; ++h)
#pragma unroll
                for (int i = 0; i < 2; ++i) o2_v[h][i] = last ? offAn_v[h][i] : offAc_v[h][i];
            PG8_LDB(B0, 0, 0); PG8_LDB(B1, 0, 1); PG8_SCHED; PG8_LDA(At, 0, 0); PG8_STAGE_A(PG8_SA(1, 1), a1k, offAc, 1);
            PG8_WAIT_V(8); PG8_WAIT_L(0); PG8_BAR; PG8_MMA(0, 0, At, B0); PG8_MMA(0, 1, At, B1); PG8_BAR; PG8_SCHED;
            PG8_LDA(At, 0, 1); PG8_STAGE_B(PG8_SB(0, 0), b2); PG8_STAGE_B(PG8_SB(0, 1), b2 + hstepB); PG8_STAGE_A(PG8_SA(0, 0), a2k, o2, 0);
            PG8_WAIT_V(8); PG8_WAIT_L(0); PG8_BAR; PG8_MMA(1, 0, At, B0); PG8_MMA(1, 1, At, B1); PG8_BAR; PG8_SCHED;
            PG8_LDB(B0, 1, 0); PG8_LDB(B1, 1, 1); PG8_SCHED; PG8_LDA(At, 1, 0); PG8_STAGE_A(PG8_SA(0, 1), a2k, o2, 1);
            PG8_WAIT_V(8); PG8_WAIT_L(0); PG8_BAR; PG8_MMA(0, 0, At, B0); PG8_MMA(0, 1, At, B1); PG8_BAR; PG8_SCHED;
            PG8_LDA(At, 1, 1); PG8_STAGE_B(PG8_SB(1, 0), b3); PG8_STAGE_B(PG8_SB(1, 1), b3 + hstepB); PG8_STAGE_A(PG8_SA(1, 0), a3k, o2, 0);
            PG8_WAIT_V(8); PG8_WAIT_L(0); PG8_BAR; PG8_MMA(1, 0, At, B0); PG8_MMA(1, 1, At, B1); PG8_BAR; PG8_SCHED;
        }
        if constexpr (ALIGN_EPI) { if (wr == 0) PG8_BAR; }
        if constexpr (FP8) asm volatile("s_nop 15\n\ts_nop 15\n\ts_nop 7" ::: "memory");
        E(acc, cur, wr, wc, fr, fq);
        if (!has_next) break;
#pragma unroll
        for (int a = 0; a < 2; ++a)
#pragma unroll
            for (int b = 0; b < 2; ++b)
#pragma unroll
                for (int m = 0; m < 4; ++m)
#pragma unroll
                    for (int n = 0; n < 2; ++n) acc[a][b][m][n] = (f32x4){0.f, 0.f, 0.f, 0.f};
        cur = nxt; cB = nB; ++ui; offAc_u = offAn_u;
#pragma unroll
        for (int h = 0; h < 2; ++h)
#pragma unroll
            for (int i = 0; i < 2; ++i) offAc_v[h][i] = offAn_v[h][i];
        if constexpr (ALIGN_EPI) { if (wr == 1) PG8_BAR; }
    }
    PG8_WAIT_V(0);
    if constexpr (!ALIGN_EPI) { if (wr == 0) PG8_BAR; }
    PG8_BAR;
#undef PG8_SA
#undef PG8_SB
#undef PG8_STAGE_A
#undef PG8_STAGE_B
#undef PG8_MKOFF
#undef PG8_LDA
#undef PG8_LDB
#undef PG8_MMA
#undef PG8_WAIT_V
#undef PG8_WAIT_L
#undef PG8_BAR
#undef PG8_SCHED
}
}
namespace attn_body {
using bf16=__hip_bfloat16;
using bf16x8=__attribute__((ext_vector_type(8)))short;
using s16x4=__attribute__((ext_vector_type(4)))short;
using f32x16=__attribute__((ext_vector_type(16)))float;
using u32x4=__attribute__((ext_vector_type(4)))unsigned;
constexpr int BATCH=2,SEQ=16384,D=64,DM=512;
constexpr int NW=8,QBLK=32,QB=QBLK*NW,KVBLK=64,NQB=SEQ/QB;
constexpr int ATTN_PITCH=DM, ATTN_UNIT_ROWS=QB;
__device__ __forceinline__ int crow(int r,int hi){return (r&3)+8*(r>>2)+4*hi;}
#define SBAR() __builtin_amdgcn_sched_barrier(0)
__device__ __forceinline__ void cmask(f32x16&p0,f32x16&p1,int jb,int qrel,int hi){
  const float NEG=-INFINITY; int kb=64*jb+4*hi;
  #pragma unroll
  for(int r=0;r<16;++r){int kv=kb+(r&3)+8*(r>>2); if(kv>qrel)p0[r]=NEG; if(kv+32>qrel)p1[r]=NEG;}
}

constexpr int NSLOT=3, SLOTB=8192;
constexpr int LDS_K=0, LDS_V=NSLOT*SLOTB, LDS_WS=2*NSLOT*SLOTB, LDS_OST=LDS_WS+NW*64*4, LDS_MK=LDS_OST+NW*4096, LDS_BYTES=LDS_MK+NW*1024, LDS_BYTES_WIDE=LDS_V+NSLOT*2*SLOTB+NW*64*4+NW*4096;
constexpr float C2=0.125f*1.4426950408889634f;
__device__ __forceinline__ void glds16(const void*gsrc,unsigned lds_dst){unsigned keep;
  asm volatile("s_mov_b32 %0, m0\n\ts_mov_b32 m0, %2\n\ts_nop 0\n\tglobal_load_lds_dwordx4 %1, off\n\ts_mov_b32 m0, %0":"=&s"(keep):"v"(gsrc),"s"(lds_dst):"memory");}
__device__ __forceinline__ float max3f(float a,float b,float c){float r;asm("v_max3_f32 %0, %1, %2, %3":"=v"(r):"v"(a),"v"(b),"v"(c));return r;}
__device__ __forceinline__ float max2f(float a,float b){float r;asm("v_max_f32_e32 %0, %1, %2":"=v"(r):"v"(a),"v"(b));return r;}
__device__ __forceinline__ float fadd_s(float a,float b){float r;asm("v_add_f32_e32 %0, %1, %2":"=v"(r):"v"(a),"v"(b));return r;}
__device__ __forceinline__ float fsub_s(float a,float b){float r;asm("v_sub_f32_e32 %0, %1, %2":"=v"(r):"v"(a),"v"(b));return r;}
typedef float f32x2_t __attribute__((ext_vector_type(2))); typedef __bf16 bf16x2_t __attribute__((ext_vector_type(2)));
__device__ __forceinline__ unsigned cvtpk_s(float lo,float hi){f32x2_t v={lo,hi};bf16x2_t b=__builtin_convertvector(v,bf16x2_t);return __builtin_bit_cast(unsigned,b);}
#define WAIT_BAR(N) asm volatile("s_waitcnt vmcnt(" #N ") lgkmcnt(0)\n\ts_barrier":::"memory")

__device__ __forceinline__ void qkt(f32x16&p0,f32x16&p1,const char*Kslot,const bf16x8*qr,const f32x16&ci0,const f32x16&ci1,int r32,int hi){
  const char*kb=Kslot+hi*1024+r32*16;
  #pragma unroll
  for(int d0=0;d0<4;++d0){
    const bf16x8 b0=*reinterpret_cast<const bf16x8*>(kb+d0*2048);
    const bf16x8 b1=*reinterpret_cast<const bf16x8*>(kb+d0*2048+512);
    if(d0==0){p0=__builtin_amdgcn_mfma_f32_32x32x16_bf16(b0,qr[0],ci0,0,0,0);p1=__builtin_amdgcn_mfma_f32_32x32x16_bf16(b1,qr[0],ci1,0,0,0);}
    else{p0=__builtin_amdgcn_mfma_f32_32x32x16_bf16(b0,qr[d0],p0,0,0,0);p1=__builtin_amdgcn_mfma_f32_32x32x16_bf16(b1,qr[d0],p1,0,0,0);}}
}
typedef __attribute__((address_space(3))) const char* lds_cptr;
typedef short v4i16_t __attribute__((ext_vector_type(4)));
__device__ __forceinline__ void kload8(bf16x8*kf,lds_cptr kp){
  kf[0]=*(const __attribute__((address_space(3))) bf16x8*)(kp);      kf[1]=*(const __attribute__((address_space(3))) bf16x8*)(kp+512);
  kf[2]=*(const __attribute__((address_space(3))) bf16x8*)(kp+2048); kf[3]=*(const __attribute__((address_space(3))) bf16x8*)(kp+2560);
  kf[4]=*(const __attribute__((address_space(3))) bf16x8*)(kp+4096); kf[5]=*(const __attribute__((address_space(3))) bf16x8*)(kp+4608);
  kf[6]=*(const __attribute__((address_space(3))) bf16x8*)(kp+6144); kf[7]=*(const __attribute__((address_space(3))) bf16x8*)(kp+6656);
}
__device__ __forceinline__ void kload2(bf16x8*kf,lds_cptr kp,int j){ kf[2*j]=*(const __attribute__((address_space(3))) bf16x8*)(kp+j*2048); kf[2*j+1]=*(const __attribute__((address_space(3))) bf16x8*)(kp+j*2048+512); }
__device__ __forceinline__ s16x4 vtr(lds_cptr p){ return __builtin_bit_cast(s16x4,__builtin_amdgcn_ds_read_tr16_b64_v4i16((__attribute__((address_space(3))) v4i16_t*)p)); }
__device__ __forceinline__ float rowmax(const f32x16&p0,const f32x16&p1){
  float a=max3f(p0[0],p0[1],p1[0]),b=max3f(p0[2],p0[3],p1[1]);a=max3f(a,p1[2],p1[3]);
  #pragma unroll
  for(int r=4;r<16;r+=4){a=max3f(a,p0[r],p0[r+1]);b=max3f(b,p0[r+2],p0[r+3]);a=max3f(a,p1[r],p1[r+1]);b=max3f(b,p1[r+2],p1[r+3]);}
  const float m=max2f(a,b);
  auto rr=__builtin_amdgcn_permlane32_swap(__float_as_uint(m),__float_as_uint(m),false,false);
  return max2f(__uint_as_float(rr[0]),__uint_as_float(rr[1]));
}
__device__ __forceinline__ void pv(f32x16*o,int vb,bf16x8 pa0,bf16x8 pa1,bf16x8 pa2,bf16x8 pa3){
  #pragma unroll
  for(int d0=0;d0<2;++d0){s16x4 lo[4],hi[4];
    #pragma unroll
    for(int ks=0;ks<4;++ks){
      asm volatile("ds_read_b64_tr_b16 %0,%1 offset:%c2":"=&v"(lo[ks]):"v"(vb),"i"(d0*4096+ks*1024):"memory");
      asm volatile("ds_read_b64_tr_b16 %0,%1 offset:%c2":"=&v"(hi[ks]):"v"(vb),"i"(d0*4096+ks*1024+512):"memory");}
    asm volatile("s_waitcnt lgkmcnt(0)":::"memory");SBAR();
    #define PK(k) (bf16x8){lo[k][0],lo[k][1],lo[k][2],lo[k][3],hi[k][0],hi[k][1],hi[k][2],hi[k][3]}
    o[d0]=__builtin_amdgcn_mfma_f32_32x32x16_bf16(pa0,PK(0),o[d0],0,0,0);
    o[d0]=__builtin_amdgcn_mfma_f32_32x32x16_bf16(pa1,PK(1),o[d0],0,0,0);
    o[d0]=__builtin_amdgcn_mfma_f32_32x32x16_bf16(pa2,PK(2),o[d0],0,0,0);
    o[d0]=__builtin_amdgcn_mfma_f32_32x32x16_bf16(pa3,PK(3),o[d0],0,0,0);
    #undef PK
  }
}

#ifndef ATTN_STORE16
#define ATTN_STORE16(p,v) (*(u32x4*)(p)=(v))
#endif
template<int THRL,bool MASKED,bool WIDE,bool NOMAX> __device__ __forceinline__ void attn_unit(int b,int hq,int hv,int qb,const bf16*Q,const bf16*__restrict__ K,const bf16*__restrict__ V,bf16*O,const unsigned long long*__restrict__ MK,char*shm,int wave_in,int badoff){
  const int tid=ltid(wave_in),lane=tid&63,r32=lane&31,hi=lane>>5; const int wid=__builtin_amdgcn_readfirstlane(tid>>6);
  const long rowbase=(long)b*SEQ; const int q0=qb*QB;
  const bf16*Qw=Q+(rowbase+q0+wid*QBLK)*DM+hq*D;
  const bf16*Kh=K+rowbase*DM+hq*D,*Vh=V+rowbase*DM+hv*D;
  constexpr int VSLOT=WIDE?2*SLOTB:SLOTB, L_WS=LDS_V+NSLOT*VSLOT, L_OST=L_WS+NW*64*4, L_MK=L_OST+NW*4096, L_TAB=L_MK+NW*2048;
  #define VS(sl) (WIDE?2*(sl):(sl))
  const unsigned lds0=(unsigned)(uintptr_t)shm;
  float*wsf=(float*)(shm+L_WS)+wid*64;
  const bf16*ksrc=Kh+(long)lane*DM+wid*8;
  const bf16*vsrc=Vh+(long)(16*(wid&3)+(lane>>2))*DM+(wid>>2)*32+(lane&3)*8;
  const unsigned kdst=lds0+LDS_K+wid*1024, vdst=lds0+LDS_V+wid*1024;
  #define DMA_K(t,slot) glds16(ksrc+(long)(t)*KVBLK*DM,(unsigned)__builtin_amdgcn_readfirstlane(kdst+(slot)))
  #define DMA_V(t,slot) do{ glds16(vsrc+(long)(t)*KVBLK*DM,(unsigned)__builtin_amdgcn_readfirstlane(vdst+VS(slot))); if(WIDE){ glds16(vsrc+64+(long)(t)*KVBLK*DM,(unsigned)__builtin_amdgcn_readfirstlane(vdst+VS(slot)+8192)); } }while(0)
  const long mq0=(long)q0+wid*QBLK+2*(lane&15); const unsigned mdst=lds0+L_MK+wid*2048;
  #define DMA_M4(t0) do{ if(MASKED){ const long t_=(long)(t0)+(lane>>4); if(t_<NT){ glds16(MK+(16384L*t_-32L*t_*(t_-1)+mq0-64L*t_),(unsigned)__builtin_amdgcn_readfirstlane(mdst+(((t0)&7)*256))); } } }while(0)
  unsigned mw0=0u,mw1=0u;
  #define MKRD(t) do{ if(MASKED){ const unsigned long long w_=*(const __attribute__((address_space(3))) unsigned long long*)(shm3+L_MK+wid*2048+(((t)&7)*256)+r32*8); mw0=(unsigned)w_; mw1=(unsigned)(w_>>32); } }while(0)
  #define MAND(X,r,MW) do{}while(0)
  bf16x8 aid[2];
  if(MASKED){
    #pragma unroll
    for(int ks=0;ks<2;++ks)
      #pragma unroll
      for(int j=0;j<8;++j) aid[ks][j]=(short)((r32==16*ks+8*hi+j)?0x3F80:0);
  }
  #define TABRD(w,ks) (*(const __attribute__((address_space(3))) bf16x8*)(shm3+L_TAB+((((w)>>(16*(ks)+8*hi))&0xffu)<<4)))
  #define BIAS(C0,C1,CI) do{ const bf16x8 f00_=TABRD(mw0,0),f01_=TABRD(mw0,1),f10_=TABRD(mw1,0),f11_=TABRD(mw1,1); \
    C0=__builtin_amdgcn_mfma_f32_32x32x16_bf16(aid[0],f00_,CI,0,0,0); C1=__builtin_amdgcn_mfma_f32_32x32x16_bf16(aid[0],f10_,CI,0,0,0); \
    C0=__builtin_amdgcn_mfma_f32_32x32x16_bf16(aid[1],f01_,C0,0,0,0); C1=__builtin_amdgcn_mfma_f32_32x32x16_bf16(aid[1],f11_,C1,0,0,0); }while(0)
  const int vb0=(int)(lds0+LDS_V)+((lane>>4)&1)*32+(lane&3)*8+(4*hi+((lane&15)>>2))*64;
  const char*Kbase=shm+LDS_K; bf16x8 kf[8];
  const lds_cptr shm3=(lds_cptr)shm; const lds_cptr kp0=shm3+LDS_K+hi*1024+r32*16; const lds_cptr vp0=shm3+LDS_V+((lane>>4)&1)*32+(lane&3)*8+(4*hi+((lane&15)>>2))*64;
  const int NT=(q0+QB)/KVBLK;
  DMA_M4(0);DMA_K(0,0);DMA_V(0,0);DMA_K(1,SLOTB);
  bf16x8 qr[4];
  #pragma unroll
  for(int d0=0;d0<4;++d0)qr[d0]=*reinterpret_cast<const bf16x8*>(&Qw[(long)r32*DM+d0*16+hi*8]);
  float mhat=0.f,l_reg=0.f;f32x16 o[4];o[0]=f32x16{};o[1]=f32x16{};o[2]=f32x16{};o[3]=f32x16{};f32x16 negm=f32x16{}; if(!WIDE&&!NOMAX){ asm volatile("":"+v"(negm)); }
  const int qrel=wid*QBLK+r32;
  #define CMASK(P0,P1,t) do{int jb_=(t)-(NT-4); if(jb_>=0)cmask(P0,P1,jb_,qrel,hi);}while(0)
  bool resc=false;
  #define START(P0,P1) do{ resc=false; \
    if constexpr(!NOMAX){ const float rm=rowmax(P0,P1); const float dl=rm; mhat=fadd_s(mhat,dl); \
      _Pragma("unroll") for(int r=0;r<16;++r){P0[r]=fsub_s(P0[r],dl);P1[r]=fsub_s(P1[r],dl);} \
      if(!WIDE){ _Pragma("unroll") for(int r=0;r<16;++r)negm[r]=-mhat; asm volatile("":"+v"(negm)); } } \
    _Pragma("unroll") for(int r=0;r<16;++r)P0[r]=__builtin_amdgcn_exp2f(P0[r]); }while(0)
  #define RESC() do{ if constexpr(!NOMAX) if(resc){ asm volatile("s_waitcnt lgkmcnt(0)":::"memory"); \
      _Pragma("unroll") for(int d_=0;d_<(WIDE?4:2);++d_) _Pragma("unroll") for(int r=0;r<16;++r)o[d_][r]*=wsf[crow(r,hi)]; } }while(0)
  f32x16 pA0,pA1,pB0,pB1;
  int sl_prev=0,sl_cur=0,sl_next=SLOTB;
  #define ROT() do{sl_prev=sl_cur;sl_cur=sl_next;sl_next=(sl_next==(NSLOT-1)*SLOTB)?0:sl_next+SLOTB;}while(0)
  DMA_K(2,2*SLOTB); const bool m4b_=MASKED&&(4<NT); if(m4b_){DMA_M4(4);}
  if(WIDE||m4b_){WAIT_BAR(4);}else{WAIT_BAR(3);}
  if(MASKED){ MKRD(0); BIAS(pA0,pA1,negm); qkt(pA0,pA1,Kbase,qr,pA0,pA1,r32,hi); } else { qkt(pA0,pA1,Kbase,qr,negm,negm,r32,hi); }
  asm volatile("s_nop 15\n\ts_nop 7":"+v"(pA0),"+v"(pA1));CMASK(pA0,pA1,0);
  START(pA0,pA1);
  _Pragma("unroll") for(int r=0;r<16;++r)pA1[r]=__builtin_amdgcn_exp2f(pA1[r]);
  WAIT_BAR(0);
  DMA_K(3,0);DMA_V(1,SLOTB);
  ROT();
  kload8(kf,kp0+sl_cur);
  if(WIDE){WAIT_BAR(3);}else{WAIT_BAR(2);}
  s16x4 vlo[8],vhi[8]; u32x4 pw0,pw1,pw2,pw3;
  #define PKW(P,B) cvtpk_s(P[B],P[B+1])
  #define PAF(k) __builtin_bit_cast(bf16x8,pw##k)
  #define VFR(i) (bf16x8){vlo[i][0],vlo[i][1],vlo[i][2],vlo[i][3],vhi[i][0],vhi[i][1],vhi[i][2],vhi[i][3]}
  #define PIN(x) asm volatile("":"+v"(x))
  #define MX3(a,b,c) __builtin_fmaxf(__builtin_fmaxf((a),(b)),(c))
  #define GAPA(MF,A0,A1,A2,A3,W0,W1,PW) do{ MF; sacc+=A0; sacc+=A1; sacc+=A2; sacc+=A3; PIN(sacc); W0; W1; PIN(PW); SBAR(); }while(0)
  #define EX(v) __builtin_amdgcn_exp2f(v)
  #define GAPB(MF,X,B,MW) do{ MF; X[B]=EX(X[B]); X[B+1]=EX(X[B+1]); X[B+2]=EX(X[B+2]); X[B+3]=EX(X[B+3]); MAND(X,B,MW); MAND(X,B+1,MW); MAND(X,B+2,MW); MAND(X,B+3,MW); PIN(X); SBAR(); }while(0)
  #define GAPB2(MF,X,B) do{ MF; X[B]=EX(X[B]); X[B+1]=EX(X[B+1]); PIN(X); SBAR(); }while(0)
  #define VRD(i) do{ vlo[i]=vtr(vp_+(((i)>>2)*4096+((i)&3)*1024)); vhi[i]=vtr(vp_+(((i)>>2)*4096+((i)&3)*1024+512)); }while(0)
  #define KRD(G,j) do{ if(G){ kload2(kf,kp0+sl_next,j); SBAR(); } }while(0)
  #define STEP(C0,C1,P0,P1,t,GK,GV,GL,GM) do{ SBAR(); \
    const lds_cptr vp_=vp0+VS(sl_prev); \
    if(MASKED){ MKRD(t); BIAS(C0,C1,negm); SBAR(); } \
    VRD(0); SBAR(); float sacc=(P0[0]+P0[1]); \
    GAPA(C0=__builtin_amdgcn_mfma_f32_32x32x16_bf16(kf[0],qr[0],(MASKED?C0:negm),0,0,0), P0[2],P0[3],P0[4],P0[5],     pw0[0]=PKW(P0,0), pw0[1]=PKW(P0,2), pw0); \
    VRD(4); SBAR(); GAPA(C1=__builtin_amdgcn_mfma_f32_32x32x16_bf16(kf[1],qr[0],(MASKED?C1:negm),0,0,0), P0[6],P0[7],P0[8],P0[9],     pw0[2]=PKW(P0,4), pw0[3]=PKW(P0,6), pw0); \
    VRD(1); SBAR(); GAPA(C0=__builtin_amdgcn_mfma_f32_32x32x16_bf16(kf[2],qr[1],C0,0,0,0),   P0[10],P0[11],P0[12],P0[13], pw1[0]=PKW(P0,8), pw1[1]=PKW(P0,10), pw1); \
    VRD(5); SBAR(); GAPA(C1=__builtin_amdgcn_mfma_f32_32x32x16_bf16(kf[3],qr[1],C1,0,0,0),   P0[14],P0[15],P1[0],P1[1],   pw1[2]=PKW(P0,12),pw1[3]=PKW(P0,14), pw1); \
    VRD(2); SBAR(); GAPA(C0=__builtin_amdgcn_mfma_f32_32x32x16_bf16(kf[4],qr[2],C0,0,0,0),   P1[2],P1[3],P1[4],P1[5],     pw2[0]=PKW(P1,0), pw2[1]=PKW(P1,2), pw2); \
    VRD(6); SBAR(); GAPA(C1=__builtin_amdgcn_mfma_f32_32x32x16_bf16(kf[5],qr[2],C1,0,0,0),   P1[6],P1[7],P1[8],P1[9],     pw2[2]=PKW(P1,4), pw2[3]=PKW(P1,6), pw2); \
    VRD(3); SBAR(); GAPA(C0=__builtin_amdgcn_mfma_f32_32x32x16_bf16(kf[6],qr[3],C0,0,0,0),   P1[10],P1[11],P1[12],P1[13], pw3[0]=PKW(P1,8), pw3[1]=PKW(P1,10), pw3); \
    VRD(7); SBAR(); GAPA(C1=__builtin_amdgcn_mfma_f32_32x32x16_bf16(kf[7],qr[3],C1,0,0,0),   P1[14],P1[15],0.f,0.f,       pw3[2]=PKW(P1,12),pw3[3]=PKW(P1,14), pw3); \
    l_reg+=sacc; \
    if(GK){DMA_K((t)+3,sl_cur);} if(GV){DMA_V((t)+1,sl_next);} if(MASKED&&GM){ if((((t)&3)==0)&&((t)+4<NT)){DMA_M4((t)+4);} } \
    CMASK(C0,C1,t); \
    if constexpr(!NOMAX){ float a=MX3(C0[0],C0[1],C1[0]),b=MX3(C0[2],C0[3],C1[1]); a=MX3(a,C1[2],C1[3]); \
      _Pragma("unroll") for(int r=4;r<16;r+=4){a=MX3(a,C0[r],C0[r+1]);b=MX3(b,C0[r+2],C0[r+3]);a=MX3(a,C1[r],C1[r+1]);b=MX3(b,C1[r+2],C1[r+3]);} \
      float rm=__builtin_fmaxf(a,b); { auto rr=__builtin_amdgcn_permlane32_swap(__float_as_uint(rm),__float_as_uint(rm),false,false); rm=__builtin_fmaxf(__uint_as_float(rr[0]),__uint_as_float(rr[1])); } \
      resc=false; \
      if(__builtin_expect(__any(rm>(float)THRL),0)){ const float dl=__builtin_fmaxf(rm,0.f); mhat+=dl; \
        _Pragma("unroll") for(int r=0;r<16;++r){C0[r]-=dl;C1[r]-=dl;} \
        _Pragma("unroll") for(int r=0;r<16;++r)negm[r]=-mhat; asm volatile("":"+v"(negm)); \
        const float f=__builtin_amdgcn_exp2f(-dl); l_reg*=f; if(hi==0)wsf[r32]=f; resc=true; } } \
    SBAR(); \
    GAPB(o[0]=__builtin_amdgcn_mfma_f32_32x32x16_bf16(PAF(0),VFR(0),o[0],0,0,0), C0,0,mw0); \
    GAPB(o[1]=__builtin_amdgcn_mfma_f32_32x32x16_bf16(PAF(0),VFR(4),o[1],0,0,0), C0,4,mw0); \
    KRD(GL,0); GAPB(o[0]=__builtin_amdgcn_mfma_f32_32x32x16_bf16(PAF(1),VFR(1),o[0],0,0,0), C0,8,mw0); \
    KRD(GL,1); GAPB(o[1]=__builtin_amdgcn_mfma_f32_32x32x16_bf16(PAF(1),VFR(5),o[1],0,0,0), C0,12,mw0); \
    KRD(GL,2); GAPB(o[0]=__builtin_amdgcn_mfma_f32_32x32x16_bf16(PAF(2),VFR(2),o[0],0,0,0), C1,0,mw1); \
    KRD(GL,3); GAPB(o[1]=__builtin_amdgcn_mfma_f32_32x32x16_bf16(PAF(2),VFR(6),o[1],0,0,0), C1,4,mw1); \
    GAPB(o[0]=__builtin_amdgcn_mfma_f32_32x32x16_bf16(PAF(3),VFR(3),o[0],0,0,0), C1,8,mw1); \
    GAPB(o[1]=__builtin_amdgcn_mfma_f32_32x32x16_bf16(PAF(3),VFR(7),o[1],0,0,0), C1,12,mw1); \
    }while(0)
  #define VLD(n,f) do{ vlo[(n)&3]=vtr(vp_+(((f)>>2)*4096+((f)&3)*1024)); vhi[(n)&3]=vtr(vp_+(((f)>>2)*4096+((f)&3)*1024+512)); }while(0)
  #define VFW(n) (bf16x8){vlo[(n)&3][0],vlo[(n)&3][1],vlo[(n)&3][2],vlo[(n)&3][3],vhi[(n)&3][0],vhi[(n)&3][1],vhi[(n)&3][2],vhi[(n)&3][3]}
  #define PVN(OD,k,n,fnext) do{ OD=__builtin_amdgcn_mfma_f32_32x32x16_bf16(PAF(k),VFW(n),OD,0,0,0); SBAR(); if((fnext)>=0){ VLD(n,fnext); SBAR(); } }while(0)
  #define STEPW(C0,C1,P0,P1,t,GK,GV,GL) do{ SBAR(); \
    const lds_cptr vp_=vp0+VS(sl_prev); \
    VLD(0,0); SBAR(); float sacc=(P0[0]+P0[1]); f32x16 ci_=f32x16{}; if constexpr(!NOMAX){ const float nm_=-mhat; _Pragma("unroll") for(int r=0;r<16;++r)ci_[r]=nm_; }     \
    GAPA(C0=__builtin_amdgcn_mfma_f32_32x32x16_bf16(kf[0],qr[0],ci_,0,0,0), P0[2],P0[3],P0[4],P0[5],     pw0[0]=PKW(P0,0), pw0[1]=PKW(P0,2), pw0); \
    VLD(1,4); SBAR(); GAPA(C1=__builtin_amdgcn_mfma_f32_32x32x16_bf16(kf[1],qr[0],ci_,0,0,0), P0[6],P0[7],P0[8],P0[9],     pw0[2]=PKW(P0,4), pw0[3]=PKW(P0,6), pw0); \
    VLD(2,1); SBAR(); GAPA(C0=__builtin_amdgcn_mfma_f32_32x32x16_bf16(kf[2],qr[1],C0,0,0,0),   P0[10],P0[11],P0[12],P0[13], pw1[0]=PKW(P0,8), pw1[1]=PKW(P0,10), pw1); \
    VLD(3,5); SBAR(); GAPA(C1=__builtin_amdgcn_mfma_f32_32x32x16_bf16(kf[3],qr[1],C1,0,0,0),   P0[14],P0[15],P1[0],P1[1],   pw1[2]=PKW(P0,12),pw1[3]=PKW(P0,14), pw1); \
    GAPA(C0=__builtin_amdgcn_mfma_f32_32x32x16_bf16(kf[4],qr[2],C0,0,0,0),   P1[2],P1[3],P1[4],P1[5],     pw2[0]=PKW(P1,0), pw2[1]=PKW(P1,2), pw2); \
    GAPA(C1=__builtin_amdgcn_mfma_f32_32x32x16_bf16(kf[5],qr[2],C1,0,0,0),   P1[6],P1[7],P1[8],P1[9],     pw2[2]=PKW(P1,4), pw2[3]=PKW(P1,6), pw2); \
    GAPA(C0=__builtin_amdgcn_mfma_f32_32x32x16_bf16(kf[6],qr[3],C0,0,0,0),   P1[10],P1[11],P1[12],P1[13], pw3[0]=PKW(P1,8), pw3[1]=PKW(P1,10), pw3); \
    GAPA(C1=__builtin_amdgcn_mfma_f32_32x32x16_bf16(kf[7],qr[3],C1,0,0,0),   P1[14],P1[15],0.f,0.f,       pw3[2]=PKW(P1,12),pw3[3]=PKW(P1,14), pw3); \
    l_reg+=sacc; \
    if(GK){DMA_K((t)+3,sl_cur);} if(GV){DMA_V((t)+1,sl_next);} \
    CMASK(C0,C1,t); \
    if constexpr(!NOMAX){ float a=MX3(C0[0],C0[1],C1[0]),b=MX3(C0[2],C0[3],C1[1]); a=MX3(a,C1[2],C1[3]); \
      _Pragma("unroll") for(int r=4;r<16;r+=4){a=MX3(a,C0[r],C0[r+1]);b=MX3(b,C0[r+2],C0[r+3]);a=MX3(a,C1[r],C1[r+1]);b=MX3(b,C1[r+2],C1[r+3]);} \
      float rm=__builtin_fmaxf(a,b); { auto rr=__builtin_amdgcn_permlane32_swap(__float_as_uint(rm),__float_as_uint(rm),false,false); rm=__builtin_fmaxf(__uint_as_float(rr[0]),__uint_as_float(rr[1])); } \
      resc=false; \
      if(__builtin_expect(__any(rm>(float)THRL),0)){ const float dl=__builtin_fmaxf(rm,0.f); mhat+=dl; \
        _Pragma("unroll") for(int r=0;r<16;++r){C0[r]-=dl;C1[r]-=dl;} \
        const float f=__builtin_amdgcn_exp2f(-dl); l_reg*=f; if(hi==0)wsf[r32]=f; resc=true; } } \
    SBAR(); \
    GAPB2(o[0]=__builtin_amdgcn_mfma_f32_32x32x16_bf16(PAF(0),VFW(0),o[0],0,0,0), C0,0); VLD(0,2); SBAR(); \
    GAPB2(o[1]=__builtin_amdgcn_mfma_f32_32x32x16_bf16(PAF(0),VFW(1),o[1],0,0,0), C0,2); VLD(1,6); SBAR(); \
    KRD(GL,0); GAPB2(o[0]=__builtin_amdgcn_mfma_f32_32x32x16_bf16(PAF(1),VFW(2),o[0],0,0,0), C0,4); VLD(2,3); SBAR(); \
    KRD(GL,1); GAPB2(o[1]=__builtin_amdgcn_mfma_f32_32x32x16_bf16(PAF(1),VFW(3),o[1],0,0,0), C0,6); VLD(3,7); SBAR(); \
    KRD(GL,2); GAPB2(o[0]=__builtin_amdgcn_mfma_f32_32x32x16_bf16(PAF(2),VFW(4),o[0],0,0,0), C0,8); VLD(4,8); SBAR(); \
    KRD(GL,3); GAPB2(o[1]=__builtin_amdgcn_mfma_f32_32x32x16_bf16(PAF(2),VFW(5),o[1],0,0,0), C0,10); VLD(5,12); SBAR(); \
    GAPB2(o[0]=__builtin_amdgcn_mfma_f32_32x32x16_bf16(PAF(3),VFW(6),o[0],0,0,0), C0,12); VLD(6,9); SBAR(); \
    GAPB2(o[1]=__builtin_amdgcn_mfma_f32_32x32x16_bf16(PAF(3),VFW(7),o[1],0,0,0), C0,14); VLD(7,13); SBAR(); \
    GAPB2(o[2]=__builtin_amdgcn_mfma_f32_32x32x16_bf16(PAF(0),VFW(8),o[2],0,0,0), C1,0); VLD(8,10); SBAR(); \
    GAPB2(o[3]=__builtin_amdgcn_mfma_f32_32x32x16_bf16(PAF(0),VFW(9),o[3],0,0,0), C1,2); VLD(9,14); SBAR(); \
    GAPB2(o[2]=__builtin_amdgcn_mfma_f32_32x32x16_bf16(PAF(1),VFW(10),o[2],0,0,0), C1,4); VLD(10,11); SBAR(); \
    GAPB2(o[3]=__builtin_amdgcn_mfma_f32_32x32x16_bf16(PAF(1),VFW(11),o[3],0,0,0), C1,6); VLD(11,15); SBAR(); \
    GAPB2(o[2]=__builtin_amdgcn_mfma_f32_32x32x16_bf16(PAF(2),VFW(12),o[2],0,0,0), C1,8); \
    GAPB2(o[3]=__builtin_amdgcn_mfma_f32_32x32x16_bf16(PAF(2),VFW(13),o[3],0,0,0), C1,10); \
    GAPB2(o[2]=__builtin_amdgcn_mfma_f32_32x32x16_bf16(PAF(3),VFW(14),o[2],0,0,0), C1,12); \
    GAPB2(o[3]=__builtin_amdgcn_mfma_f32_32x32x16_bf16(PAF(3),VFW(15),o[3],0,0,0), C1,14); \
    }while(0)
  #define STEPX(C0,C1,P0,P1,t,GK,GV,GL,GM) do{ if constexpr(WIDE){ STEPW(C0,C1,P0,P1,t,GK,GV,GL); } else { STEP(C0,C1,P0,P1,t,GK,GV,GL,GM); } }while(0)
  int t=1;
  #undef CMASK
  #define CMASK(P0,P1,t) do{}while(0)
  for(;t+5<NT;t+=2){
    STEPX(pB0,pB1,pA0,pA1,t,true,true,true,true);     if(WIDE){WAIT_BAR(3);}else{WAIT_BAR(2);} RESC(); ROT();
    STEPX(pA0,pA1,pB0,pB1,t+1,true,true,true,true);   if(WIDE||(MASKED&&(((t+1)&3)==0))){WAIT_BAR(3);}else{WAIT_BAR(2);} RESC(); ROT();
  }
  #undef CMASK
  #define CMASK(P0,P1,t) do{int jb_=(t)-(NT-4); if(jb_>=0)cmask(P0,P1,jb_,qrel,hi);}while(0)
  #define ENDW(tt) do{ if(WIDE){ if((tt)+3<NT){WAIT_BAR(3);} else if((tt)+2<NT){WAIT_BAR(2);} else {WAIT_BAR(0);} } else { if((tt)+3<NT){WAIT_BAR(2);} else if((tt)+2<NT){WAIT_BAR(1);} else {WAIT_BAR(0);} } }while(0)
  for(;t+1<NT;t+=2){
    STEPX(pB0,pB1,pA0,pA1,t,(t+3<NT),(t+1<NT),(t+1<NT),(t+2<NT));       ENDW(t);   RESC(); ROT();
    STEPX(pA0,pA1,pB0,pB1,t+1,(t+4<NT),(t+2<NT),(t+2<NT),(t+3<NT));     ENDW(t+1); RESC(); ROT();
  }
  STEPX(pB0,pB1,pA0,pA1,NT-1,false,false,false,false); RESC();
  { float sacc=pB0[0]+pB0[1]; _Pragma("unroll") for(int r=2;r<16;++r)sacc+=pB0[r]; _Pragma("unroll") for(int r=0;r<16;++r)sacc+=pB1[r]; l_reg+=sacc;
    pw0=(u32x4){PKW(pB0,0),PKW(pB0,2),PKW(pB0,4),PKW(pB0,6)};pw1=(u32x4){PKW(pB0,8),PKW(pB0,10),PKW(pB0,12),PKW(pB0,14)};pw2=(u32x4){PKW(pB1,0),PKW(pB1,2),PKW(pB1,4),PKW(pB1,6)};pw3=(u32x4){PKW(pB1,8),PKW(pB1,10),PKW(pB1,12),PKW(pB1,14)};
    SBAR(); pv(o,vb0+VS(sl_cur),PAF(0),PAF(1),PAF(2),PAF(3)); if(WIDE){ pv(o+2,vb0+VS(sl_cur)+8192,PAF(0),PAF(1),PAF(2),PAF(3)); } }
  #undef PKW
  #undef PAF
  #undef VFR
  #undef PIN
  #undef MX3
  #undef GAPA
  #undef GAPB
  #undef GAPB2
  #undef EX
  #undef VRD
  #undef KRD
  #undef VLD
  #undef VFW
  #undef PVN
  #undef STEPW
  #undef STEPX
  #undef STEP
  #undef ENDW
  {auto rr=__builtin_amdgcn_permlane32_swap(__float_as_uint(l_reg),__float_as_uint(l_reg),false,false);l_reg=__uint_as_float(rr[0])+__uint_as_float(rr[1]);}
  if constexpr(NOMAX){ if(!(l_reg>7.9e-31f&&l_reg<1.2e30f))*(__attribute__((address_space(3))) unsigned*)((__attribute__((address_space(3))) char*)shm+badoff)=1u; }
  if(hi==0)wsf[32+r32]=l_reg;asm volatile("s_waitcnt lgkmcnt(0)":::"memory");
  float rli[16];
  #pragma unroll
  for(int r=0;r<16;++r)rli[r]=__builtin_amdgcn_rcpf(wsf[32+crow(r,hi)]);
  bf16*Ow=O+(rowbase+q0+wid*QBLK)*DM+hv*D;
  #pragma unroll
  for(int hf=0;hf<(WIDE?2:1);++hf){ bf16*stg=(bf16*)(shm+L_OST)+wid*2048;
    #pragma unroll
    for(int r=0;r<16;++r){const int orow=crow(r,hi);
      #pragma unroll
      for(int d0=0;d0<2;++d0)stg[orow*64+d0*32+r32]=__float2bfloat16(o[2*hf+d0][r]*rli[r]);}
    asm volatile("s_waitcnt lgkmcnt(0)":::"memory");
    #pragma unroll
    for(int i=0;i<4;++i){const int row=i*8+(lane>>3),ch=lane&7; const u32x4 v=*(const u32x4*)(stg+row*64+ch*8); ATTN_STORE16(Ow+(long)row*DM+hf*64+ch*8,v);}
    asm volatile("s_waitcnt lgkmcnt(0)":::"memory"); }
  asm volatile("s_waitcnt lgkmcnt(0)\n\ts_barrier":::"memory");
  #undef DMA_K
  #undef DMA_V
  #undef DMA_M4
  #undef MKRD
  #undef MAND
  #undef TABRD
  #undef BIAS
  #undef CMASK
  #undef START
  #undef RESC
  #undef ROT
  #undef VS
}
constexpr int ATTN_LDS_BYTES=LDS_BYTES+NW*1024+4096;
__device__ __forceinline__ void mask_table_init(char*shm,int tid){
  if(tid<256){ u32x4 v; unsigned e[8];
    #pragma unroll
    for(int j=0;j<8;++j) e[j]=((tid>>j)&1)?0u:0xC400u;
    v.x=e[0]|(e[1]<<16); v.y=e[2]|(e[3]<<16); v.z=e[4]|(e[5]<<16); v.w=e[6]|(e[7]<<16);
    *(u32x4*)(shm+LDS_MK+NW*2048+tid*16)=v; }
  __syncthreads();
}
#undef SBAR
#undef WAIT_BAR
}

constexpr int NWAVES = 8;
#ifndef MK_PER_PHASE
#define MK_PER_PHASE 0
#endif

#ifndef CHK
#define CHK 0
#endif
constexpr int CW_CHK = 2;
constexpr int BATCH = 2, SEQ = 16384, NTOK = BATCH * SEQ, DMODEL = 1024, DEPTH = 2;
constexpr int WIN_OLD = 5704, WIN_NEW = 5888, P1_N = 3840;
constexpr float LN_EPS = 1e-5f, ALPHA = 1.41421356237f;
constexpr int NPH_LAYER = 12, NPHASE = DEPTH * NPH_LAYER;

constexpr size_t MiB = 1u << 20;
constexpr size_t WS_CTL = 0, CTL_ZERO_BYTES = 1 * MiB;
constexpr size_t WS_SMALL = 1 * MiB, SM_LAM = 0, SM_WR = 4096, SM_BR = SM_WR + 2 * 36 * 1024 * 4;
constexpr size_t WS_ROPE = 2 * MiB;
constexpr size_t WS_ROUTE = 4 * MiB, RT_E = 0, RT_C = 256 * 1024, RT_HIST = 512 * 1024, RT_TOT = 544 * 1024, RT_ROW = 576 * 1024, RT_ENT = 864 * 1024, RT_CW = 1152 * 1024;
constexpr int LIST_CAP = 65536 + 32 * 256;
constexpr size_t WS_WB = 6 * MiB;
constexpr size_t WB_WIN = 0, WB_WBD = (size_t)WIN_NEW * 1024 * 2, WB_WBS = WB_WBD + MiB, WB_WO = WB_WBS + MiB, WB_WPG = WB_WO + 2 * MiB, WB_WPLE = WB_WPG + 2 * MiB,
                 WB_WGU = WB_WPLE + MiB / 2, WB_WD = WB_WGU + 32 * MiB, WB_END = WB_WD + 16 * MiB;
static_assert(WB_END == 66 * MiB, "weight copies");
constexpr size_t WB_WG8 = WB_WIN + (size_t)3840 * 1024 * 2;
constexpr size_t WS_XB = 72 * MiB;
constexpr size_t WS_DQ = 136 * MiB, TSTRIDE = 32 * MiB, WS_IK = 360 * MiB, WS_IW = 364 * MiB;
constexpr size_t WS_O0 = 365 * MiB, WS_O1 = 397 * MiB, WS_YB = 429 * MiB, WS_MASK = 461 * MiB;
constexpr long MASK_BSTRIDE = 2105344;
constexpr size_t WS_YA = 136 * MiB, WS_MERGED = 168 * MiB, WS_TMPG = 240 * MiB, WS_PRE1 = 240 * MiB;
constexpr size_t OUT_XB8 = 0, OUT_X1B8 = 32 * MiB, OUT_T1 = 64 * MiB;
constexpr size_t WS_HG = 136 * MiB, WS_PLE = 172 * MiB, WS_Y0 = 368 * MiB, WS_Y1 = 432 * MiB, WS_PB = 496 * MiB, WS_END = 512 * MiB;
static_assert(WS_MASK + 2 * MASK_BSTRIDE * 8 <= WS_PB, "mask fits");
constexpr int CW_TMO = 0, CW_CODE = 1, CW_BAR = 4096, CW_QUEUE = 8192;

constexpr int RING_OFF = 0, RING_BYTES = 131072;
constexpr int XTR_OFF = RING_BYTES, XTR_BYTES = 4096;
constexpr int MISC_OFF = XTR_OFF + XTR_BYTES;
constexpr int LDS_BYTES = 147456;
static_assert(MISC_OFF + 128 <= LDS_BYTES, "LDS map");
#define GAS __attribute__((address_space(1)))
#define LAS __attribute__((address_space(3)))
typedef unsigned short bf16;
typedef unsigned v4u __attribute__((ext_vector_type(4)));
typedef float f32x4 __attribute__((ext_vector_type(4)));
typedef short bf16x8 __attribute__((ext_vector_type(8)));
typedef GAS unsigned gu32;
typedef GAS unsigned long long gu64;
#define RLX_AGENT __ATOMIC_RELAXED, __HIP_MEMORY_SCOPE_AGENT
#define LDS_WAIT() asm volatile("s_waitcnt lgkmcnt(0)" ::: "memory")
#define VM_WAIT() asm volatile("s_waitcnt vmcnt(0)" ::: "memory")
__device__ __forceinline__ unsigned long long rt() { return __builtin_amdgcn_s_memrealtime(); }
__device__ __forceinline__ unsigned f2bf(float f) { unsigned u = __builtin_bit_cast(unsigned, f); return (u + 0x7fffu + ((u >> 16) & 1u)) >> 16; }
__device__ __forceinline__ unsigned pk2(float lo, float hi) { return f2bf(lo) | (f2bf(hi) << 16); }

#define XB_TMO      128
#define XB_XCNT(j)  (256  + 64 * (j))
#define XB_XSUB(j)  (1280 + 64 * (j))
#define XB_XGEN(j)  (2304 + 64 * (j))
#define XB_TOP      3328
#define XB_TOPGEN   3392
#define XCD_BAR_WORDS 3456
#define XB_SPIN_CAP (1u << 18)

__device__ __forceinline__ unsigned xb_ld(unsigned* p)              { return __hip_atomic_load(p, __ATOMIC_RELAXED, __HIP_MEMORY_SCOPE_AGENT); }
__device__ __forceinline__ unsigned xb_add(unsigned* p, unsigned v) { return __hip_atomic_fetch_add(p, v, __ATOMIC_RELAXED, __HIP_MEMORY_SCOPE_AGENT); }
__device__ __forceinline__ unsigned xb_xcc_id() { return (unsigned)__builtin_amdgcn_s_getreg((3 << 11) | 20) & 0xFu; }
#define XB_SPIN(cond, bar) do { unsigned _sp = 0; while (cond) { __builtin_amdgcn_s_sleep(1); \
    if ((++_sp & 255u) == 0u) { if (xb_ld(&(bar)[XB_TMO])) break; if (_sp > XB_SPIN_CAP) { atomicAdd(&(bar)[XB_TMO], 1u); break; } } } } while (0)

struct XcdBarrier {
    unsigned* bar; unsigned x;
    volatile LAS unsigned* st;
};

__device__ __forceinline__ XcdBarrier xcd_barrier_post(unsigned* bar, volatile LAS unsigned* st) {
    XcdBarrier b; b.bar = bar; b.x = xb_xcc_id(); b.st = st;
    if (threadIdx.x == 0) (void)xb_add(&bar[XB_XCNT(b.x)], 1u);
    return b;
}
__device__ __forceinline__ void xcd_barrier_complete(unsigned* bar, unsigned x, unsigned& nloc, unsigned& nx) {
    const unsigned G = gridDim.x * gridDim.y * gridDim.z;
    unsigned sum, cnt, mine, sp = 0u;
    for (;;) {
        sum = 0u; cnt = 0u; mine = 0u;
#pragma unroll
        for (unsigned j = 0; j < 16; ++j) { const unsigned c = xb_ld(&bar[XB_XCNT(j)]); sum += c; cnt += (c > 0u) ? 1u : 0u; mine = (j == x) ? c : mine; }
        if (sum == G) break;
        __builtin_amdgcn_s_sleep(1);
        if ((++sp & 255u) == 0u) { if (xb_ld(&bar[XB_TMO])) break; if (sp > XB_SPIN_CAP) { atomicAdd(&bar[XB_TMO], 1u); break; } }
    }
    nloc = mine > 0u ? mine : 1u; nx = cnt > 0u ? cnt : 1u;
}

__device__ __forceinline__ void xcd_barrier(const XcdBarrier& b) {
    asm volatile("s_waitcnt vmcnt(0)" ::: "memory");
    __syncthreads();
    if (threadIdx.x == 0) {
        unsigned* bar = b.bar;
        __builtin_amdgcn_s_waitcnt(0);
        unsigned nloc = b.st[0], nx = b.st[1];
        if (nloc == 0u) { xcd_barrier_complete(bar, b.x, nloc, nx); b.st[0] = nloc; b.st[1] = nx; }
        const unsigned old = xb_add(&bar[XB_XSUB(b.x)], 1u);
        const unsigned gen = old / nloc;
        if (old + 1u == (gen + 1u) * nloc) {
            __builtin_amdgcn_fence(__ATOMIC_RELEASE, "agent");
            asm volatile("s_waitcnt vmcnt(0)" ::: "memory");
            const unsigned og = xb_add(&bar[XB_TOP], 1u);
            const unsigned tg = og / nx;
            if (og + 1u == (tg + 1u) * nx) xb_add(&bar[XB_TOPGEN], 1u);
            else XB_SPIN(xb_ld(&bar[XB_TOPGEN]) == tg, bar);
            __builtin_amdgcn_fence(__ATOMIC_ACQUIRE, "agent");
            xb_add(&bar[XB_XGEN(b.x)], 1u);
            asm volatile("s_waitcnt vmcnt(0)" ::: "memory");
        } else {
            XB_SPIN(xb_ld(&bar[XB_XGEN(b.x)]) == gen, bar);
            __builtin_amdgcn_fence(__ATOMIC_ACQUIRE, "agent");
            asm volatile("s_waitcnt vmcnt(0)" ::: "memory");
        }
    }
    __syncthreads();
}

#ifndef DBG
#define DBG 0
#endif
struct Args { const void* in[22]; float* out; unsigned char* ws; int ph_lo, ph_hi; };
struct Frame {
    LAS unsigned char* lds;
    volatile LAS unsigned* MISC;
    gu32* ctl;
    int tid, lane, wave;
    int vcu, G, bx;
    unsigned char* ws; unsigned char* ws0;
    float* out; float* out0;
    const Args* ap;
};
#define INP(k) (F.ap->in[(k)])
__device__ __forceinline__ float wave_sum(float v) {
#pragma unroll
    for (int o = 1; o < 64; o <<= 1) v += __shfl_xor(v, o);
    return v;
}
typedef float f32x2 __attribute__((ext_vector_type(2)));

__device__ __forceinline__ void tr_item(const float* W, int ldn, int col0, int nvalid, bf16* WT, int K, int row0, LAS float* scr, int kb, int lane) {
    const int k0 = 64 * kb, n = lane & 31;
#pragma unroll 8
    for (int i = 0; i < 32; ++i) { const int kk = 2 * i + (lane >> 5); scr[kk * 33 + n] = (n < nvalid) ? W[(size_t)(k0 + kk) * ldn + col0 + n] : 0.f; }
    LDS_WAIT(); asm volatile("" ::: "memory");
    const int c = lane & 7;
#pragma unroll
    for (int j = 0; j < 4; ++j) { const int nn = (lane >> 3) + 8 * j; const LAS float* s = scr + (8 * c) * 33 + nn;
        v4u o; o.x = pk2(s[0 * 33], s[1 * 33]); o.y = pk2(s[2 * 33], s[3 * 33]); o.z = pk2(s[4 * 33], s[5 * 33]); o.w = pk2(s[6 * 33], s[7 * 33]);
        *(GAS v4u*)(WT + (size_t)(row0 + nn) * K + k0 + 8 * c) = o; }
    LDS_WAIT(); asm volatile("" ::: "memory");
}
__device__ __forceinline__ unsigned pk4_fp8(float a, float b, float c, float d) { int p = __builtin_amdgcn_cvt_pk_fp8_f32(a, b, 0, false); return (unsigned)__builtin_amdgcn_cvt_pk_fp8_f32(c, d, p, true); }
__device__ __forceinline__ void tr_item8(const float* W, int ldn, int col0, unsigned char* WT, int K, int row0, LAS float* scr, int kb, int lane) {
    const int k0 = 64 * kb, n = lane & 31;
#pragma unroll 8
    for (int i = 0; i < 32; ++i) { const int kk = 2 * i + (lane >> 5); scr[kk * 33 + n] = W[(size_t)(k0 + kk) * ldn + col0 + n] * 64.f; }
    LDS_WAIT(); asm volatile("" ::: "memory");
    const int c = lane & 7;
#pragma unroll
    for (int j = 0; j < 4; ++j) { const int nn = (lane >> 3) + 8 * j; const LAS float* s = scr + (8 * c) * 33 + nn;
        const unsigned long long o = (unsigned long long)pk4_fp8(s[0 * 33], s[1 * 33], s[2 * 33], s[3 * 33]) | ((unsigned long long)pk4_fp8(s[4 * 33], s[5 * 33], s[6 * 33], s[7 * 33]) << 32);
        *(GAS unsigned long long*)(WT + (size_t)(row0 + nn) * K + k0 + 8 * c) = o; }
    LDS_WAIT(); asm volatile("" ::: "memory");
}
__device__ __forceinline__ void pw_phase(Frame& F, int l) {
    LAS float* scr = (LAS float*)(F.lds + RING_OFF + F.wave * 16384);
    const int gw = F.vcu * NWAVES + F.wave, NGW = F.G * NWAVES, lane = F.lane;
    unsigned char* wb = F.ws + WS_WB;
    bf16* WIN = (bf16*)(wb + WB_WIN);
    const float* w_in = (const float*)INP(3) + (size_t)l * 1024 * WIN_OLD;
    constexpr int I_A = 16 * 114, I_B = 16, I_C = 16 * 64, I_BD = 8 * 32, I_O = 16 * 32, I_PLE = 4 * 32, I_GU = 32 * 4 * 64, I_D = 32 * 128;
    constexpr int NITEMS = I_A + I_B + I_C + 2 * I_BD + 2 * I_O + I_PLE + I_GU + I_D;
    for (int it = gw; it < NITEMS; it += NGW) {
        int r = it;
        if (r < I_A) { const int kb = r / 114, nb = r % 114; tr_item(w_in, WIN_OLD, 32 * nb, 32, WIN, 1024, 32 * nb, scr, kb, lane); continue; } r -= I_A;
        if (r < I_B) { tr_item(w_in, WIN_OLD, 3648, 8, WIN, 1024, 3648, scr, r, lane); continue; } r -= I_B;
        if (r < I_C) { const int kb = r / 64, nb = r % 64; tr_item8(w_in, WIN_OLD, 3656 + 32 * nb, wb + WB_WG8, 1024, 32 * nb, scr, kb, lane); continue; } r -= I_C;
        if (r < I_BD) { tr_item((const float*)INP(6) + (size_t)l * 512 * 1024, 1024, 32 * (r % 32), 32, (bf16*)(wb + WB_WBD), 512, 32 * (r % 32), scr, r / 32, lane); continue; } r -= I_BD;
        if (r < I_BD) { tr_item((const float*)INP(7) + (size_t)l * 512 * 1024, 1024, 32 * (r % 32), 32, (bf16*)(wb + WB_WBS), 512, 32 * (r % 32), scr, r / 32, lane); continue; } r -= I_BD;
        if (r < I_O) { tr_item((const float*)INP(8) + (size_t)l * 1024 * 1024, 1024, 32 * (r % 32), 32, (bf16*)(wb + WB_WO), 1024, 32 * (r % 32), scr, r / 32, lane); continue; } r -= I_O;
        if (r < I_O) { tr_item8((const float*)INP(19) + (size_t)l * 1024 * 1024, 1024, 32 * (r % 32), wb + WB_WPG, 1024, 32 * (r % 32), scr, r / 32, lane); continue; } r -= I_O;
        if (r < I_PLE) { tr_item((const float*)INP(18) + (size_t)l * 256 * 1024, 1024, 32 * (r % 32), 32, (bf16*)(wb + WB_WPLE), 256, 32 * (r % 32), scr, r / 32, lane); continue; } r -= I_PLE;
        if (r < I_GU) { const int e = r >> 8, sub = (r >> 6) & 3, q = r & 63, kb = q >> 2, nb = q & 3;
            const float* W = ((sub & 1) ? (const float*)INP(16) : (const float*)INP(15)) + (size_t)(l * 32 + e) * 1024 * 256;
            tr_item8(W, 256, (sub >> 1) * 128 + 32 * nb, wb + WB_WGU, 1024, e * 512 + sub * 128 + 32 * nb, scr, kb, lane); continue; } r -= I_GU;
        { const int e = r >> 7, q = r & 127, kb = q >> 5, nb = q & 31;
            tr_item((const float*)INP(17) + (size_t)(l * 32 + e) * 256 * 1024, 1024, 32 * nb, 32, (bf16*)(wb + WB_WD), 256, e * 1024 + 32 * nb, scr, kb, lane); }
    }
    { unsigned z_ = 0u; asm volatile("" : "+v"(z_));
      for (int ch = F.vcu * 512 + F.tid; ch < 160 * 128; ch += F.G * 512) *(GAS v4u*)(WIN + (size_t)3680 * 1024 + (size_t)ch * 8) = (v4u){z_, z_, z_, z_}; }
    const float* p = (const float*)INP(1) + (size_t)l * NTOK * 256; bf16* PB = (bf16*)(F.ws + WS_PB);
    for (int m0 = gw; m0 < NTOK; m0 += 4 * NGW) { f32x4 v[4];
#pragma unroll
        for (int j = 0; j < 4; ++j) { const int m = min(m0 + j * NGW, NTOK - 1); v[j] = *((const GAS f32x4*)(p + (size_t)m * 256) + lane); }
#pragma unroll
        for (int j = 0; j < 4; ++j) { const int m = m0 + j * NGW; if (m < NTOK) *((GAS unsigned long long*)(PB + (size_t)m * 256) + lane) = (unsigned long long)pk2(v[j].x, v[j].y) | ((unsigned long long)pk2(v[j].z, v[j].w) << 32); } }
    if (l == 0) {
        const float* x = (const float*)INP(0); bf16* XB = (bf16*)(F.ws + WS_XB);
        for (int m0 = gw; m0 < NTOK; m0 += 2 * NGW) { f32x4 v[2][4];
#pragma unroll
            for (int r = 0; r < 2; ++r) { const int m = min(m0 + r * NGW, NTOK - 1); const GAS f32x4* xr = (const GAS f32x4*)(x + (size_t)m * 1024) + lane;
#pragma unroll
                for (int j = 0; j < 4; ++j) v[r][j] = xr[64 * j]; }
#pragma unroll
            for (int r = 0; r < 2; ++r) { const int m = m0 + r * NGW; if (m < NTOK) { GAS unsigned long long* o8 = (GAS unsigned long long*)(XB + (size_t)m * 1024) + lane;
#pragma unroll
                for (int j = 0; j < 4; ++j) { const f32x4 w = v[r][j]; o8[64 * j] = (unsigned long long)pk2(w.x, w.y) | ((unsigned long long)pk2(w.z, w.w) << 32);
                    ((GAS unsigned*)((unsigned char*)F.out + OUT_XB8 + (size_t)m * 1024) + lane)[64 * j] = pk4_fp8(w.x, w.y, w.z, w.w); } } }
        }
        const int* pos = (const int*)INP(2); float* rope = (float*)(F.ws + WS_ROPE);
        for (int idx = F.vcu * 512 + F.tid; idx < NTOK * 8; idx += F.G * 512) {
            const int m = idx >> 3, j = idx & 7; const float invf = exp2f(-2.366446071f * (float)j); const float ang = (float)pos[m] * invf;
            double rev = (double)ang * 0.15915494309189535; rev -= rint(rev);
            rope[m * 16 + j] = (DBG & 16) ? 1.f : __builtin_amdgcn_cosf((float)rev); rope[m * 16 + 8 + j] = (DBG & 16) ? 0.f : __builtin_amdgcn_sinf((float)rev);
        }
        float* WR = (float*)(F.ws + WS_SMALL + SM_WR); float* BR = (float*)(F.ws + WS_SMALL + SM_BR);
        for (int idx = F.vcu * 512 + F.tid; idx < 2 * 36 * 1024; idx += F.G * 512) {
            const int ll = idx / (36 * 1024), r = idx % (36 * 1024), j = r >> 10, k = r & 1023;
            WR[idx] = (j < 4) ? ((const float*)INP(11))[((size_t)ll * 1024 + k) * 4 + j] : ((const float*)INP(13))[((size_t)ll * 1024 + k) * 32 + (j - 4)];
        }
        if (F.vcu == 0 && F.tid < 72) { const int ll = F.tid / 36, j = F.tid % 36; BR[F.tid] = (j < 4) ? ((const float*)INP(12))[ll * 4 + j] : ((const float*)INP(14))[ll * 32 + j - 4]; }
        if (F.vcu == 0 && F.tid < 2) { const float* lp = (const float*)INP(4) + F.tid * 256; float a = 0.f, b = 0.f;
            for (int i = 0; i < 64; ++i) { a += lp[i] * lp[64 + i]; b += lp[128 + i] * lp[192 + i]; }
            const float lam_init = (F.tid == 0) ? 0.2f : 0.35550907f;
            ((float*)(F.ws + WS_SMALL + SM_LAM))[F.tid] = __expf(a) - __expf(b) + lam_init; }
    }
}

namespace idxr {
typedef float f32x16 __attribute__((ext_vector_type(16)));
typedef short s16x2 __attribute__((ext_vector_type(2)));
typedef __fp16 h16x2 __attribute__((ext_vector_type(2)));
constexpr int HROW = 513;
__device__ __forceinline__ unsigned f2key(float f) { const unsigned u = __float_as_uint(f); return u ^ ((unsigned)((int)u >> 31) | 0x80000000u); }
__device__ __forceinline__ unsigned bins2(float a, float b) {
    const unsigned h = __builtin_bit_cast(unsigned, __builtin_amdgcn_cvt_pkrtz(a, b));
    const unsigned m = __builtin_bit_cast(unsigned, (s16x2)(__builtin_bit_cast(s16x2, h) >> (s16x2){15, 15}));
    const unsigned key = h ^ (m | 0x80008000u);
    return (key >> 5) & 0x07fc07fcu;
}
__device__ __forceinline__ float f16bits(unsigned h) { return (float)__builtin_bit_cast(__fp16, (unsigned short)h); }
__device__ __forceinline__ float bin_edge(int b) {
    if (b <= 0) return -__builtin_inff();
    if (b >= 512) return __builtin_inff();
    const unsigned K = (unsigned)b << 7;
    if (K >= 0x8000u) { const unsigned H = K & 0x7fffu; return (H >= 0x7c00u) ? __builtin_inff() : f16bits(H); }
    const unsigned M1 = ((0xFFFFu ^ K) & 0x7fffu) + 1u;
    const float v = (M1 >= 0x7c00u) ? __builtin_inff() : f16bits(M1);
    return -__uint_as_float(__float_as_uint(v) - 1u);
}
__device__ __forceinline__ long moff(int tl) { return 16384L * tl - 32L * tl * (tl - 1); }
__device__ __forceinline__ void load_k2(bf16x8 (&ka)[2], bf16x8 (&kb)[2], const unsigned short* IKb, int key0, int kg0, int fr, int fq) {
#pragma unroll
    for (int ks = 0; ks < 2; ++ks) { ka[ks] = *(const bf16x8*)(IKb + (size_t)(key0 + 16 * kg0 + fr) * 64 + ks * 32 + fq * 8); kb[ks] = *(const bf16x8*)(IKb + (size_t)(key0 + 16 * kg0 + 16 + fr) * 64 + ks * 32 + fq * 8); }
}
__device__ __forceinline__ void score_half(f32x4& sa, f32x4& sb, const bf16x8 (&qf)[8][2], const bf16x8 (&ql)[2], const float (&w)[8], bf16x8 (&ka)[2], bf16x8 (&kb)[2]) {
    sa = __builtin_amdgcn_mfma_f32_16x16x32_bf16(ka[0], ql[0], (f32x4){0.f, 0.f, 0.f, 0.f}, 0, 0, 0); sb = __builtin_amdgcn_mfma_f32_16x16x32_bf16(kb[0], ql[0], (f32x4){0.f, 0.f, 0.f, 0.f}, 0, 0, 0);
    sa = __builtin_amdgcn_mfma_f32_16x16x32_bf16(ka[1], ql[1], sa, 0, 0, 0); sb = __builtin_amdgcn_mfma_f32_16x16x32_bf16(kb[1], ql[1], sb, 0, 0, 0);
    f32x4 Da[2], Db[2];
#define IDX_M(h, D) do { \
        D[0] = __builtin_amdgcn_mfma_f32_16x16x32_bf16(ka[0], qf[h][0], (f32x4){0.f, 0.f, 0.f, 0.f}, 0, 0, 0); D[1] = __builtin_amdgcn_mfma_f32_16x16x32_bf16(kb[0], qf[h][0], (f32x4){0.f, 0.f, 0.f, 0.f}, 0, 0, 0); \
        D[0] = __builtin_amdgcn_mfma_f32_16x16x32_bf16(ka[1], qf[h][1], D[0], 0, 0, 0); D[1] = __builtin_amdgcn_mfma_f32_16x16x32_bf16(kb[1], qf[h][1], D[1], 0, 0, 0); } while (0)
#define IDX_F(h, D, O) asm volatile("" : "+v"(O[0]), "+v"(O[1]));     \
        asm volatile( \
        "v_fma_f32 %0, %8, |%9|, %0\n\tv_fma_f32 %1, %8, |%10|, %1\n\tv_fma_f32 %2, %8, |%11|, %2\n\tv_fma_f32 %3, %8, |%12|, %3\n\t" \
        "v_fma_f32 %4, %8, |%13|, %4\n\tv_fma_f32 %5, %8, |%14|, %5\n\tv_fma_f32 %6, %8, |%15|, %6\n\tv_fma_f32 %7, %8, |%16|, %7" \
        : "+v"(sa[0]), "+v"(sa[1]), "+v"(sa[2]), "+v"(sa[3]), "+v"(sb[0]), "+v"(sb[1]), "+v"(sb[2]), "+v"(sb[3]) \
        : "v"(w[h]), "v"(D[0][0]), "v"(D[0][1]), "v"(D[0][2]), "v"(D[0][3]), "v"(D[1][0]), "v"(D[1][1]), "v"(D[1][2]), "v"(D[1][3])); \
        asm volatile("" : "+v"(ka[0]), "+v"(kb[0]))
    IDX_M(0, Da); IDX_M(1, Db);
    asm volatile("s_nop 7" : "+v"(Da[0]), "+v"(Da[1]), "+v"(Db[0]), "+v"(Db[1]), "+v"(sa), "+v"(sb));
#pragma unroll
    for (int h = 0; h < 6; h += 2) { IDX_F(h, Da, Db); IDX_M(h + 2, Da); IDX_F(h + 1, Db, Da); IDX_M(h + 3, Db); }
    IDX_F(6, Da, Db); asm volatile("s_nop 7" : "+v"(Db[0]), "+v"(Db[1])); IDX_F(7, Db, Da);
#undef IDX_M
#undef IDX_F
}
#define IDX_SCORE(sc, kf, key0, more) do { const int nk_ = (more) ? (key0) + 128 : (key0); \
        idxr::score_half(sc[0], sc[1], qf, ql, w, kf[0], kf[1]); idxr::load_k2(kf[0], kf[1], IKb, nk_, 0, fr, fq); \
        idxr::score_half(sc[2], sc[3], qf, ql, w, kf[2], kf[3]); idxr::load_k2(kf[2], kf[3], IKb, nk_, 2, fr, fq); } while (0)
}

__device__ __forceinline__ void indexer_unit(Frame& F, int b, int qblk, const bf16* IQ, const bf16* IK, const float* IW, unsigned long long* mask64  ) {
    using namespace idxr;
    const int lane = F.lane, fr = lane & 15, fq = lane >> 4, wid = F.wave, qgrp = wid & 3, kh = wid >> 2;
    const int qloc = 16 * qgrp + fr, q = 64 * qblk + qloc;
    const size_t row = (size_t)b * SEQ + q;
    LAS unsigned* hist = (LAS unsigned*)(F.lds + RING_OFF);
    LAS int* bstarA = (LAS int*)(F.lds + XTR_OFF + 1024); LAS int* needA = bstarA + 64; LAS float* thiA = (LAS float*)(needA + 64); LAS float* tloA = thiA + 64;
    LAS unsigned* cand = (LAS unsigned*)(F.lds + RING_OFF);
    LAS unsigned* wcnt = (LAS unsigned*)(F.lds + XTR_OFF + 2048);
    bf16x8 qf[8][2], ql[2]; float w[8];
#pragma unroll
    for (int h = 0; h < 8; ++h)
#pragma unroll
        for (int ks = 0; ks < 2; ++ks) qf[h][ks] = *(const bf16x8*)(IQ + row * 512 + h * 64 + ks * 32 + fq * 8);
    { const f32x4* wp = (const f32x4*)(IW + row * 8); const f32x4 w0 = wp[0], w1 = wp[1]; w[0] = 0.5f * w0.x; w[1] = 0.5f * w0.y; w[2] = 0.5f * w0.z; w[3] = 0.5f * w0.w; w[4] = 0.5f * w1.x; w[5] = 0.5f * w1.y; w[6] = 0.5f * w1.z; w[7] = 0.5f * w1.w; }
#pragma unroll
    for (int ks = 0; ks < 2; ++ks) {
        float acc8[8];
#pragma unroll
        for (int e = 0; e < 8; ++e) acc8[e] = 0.f;
#pragma unroll
        for (int h = 0; h < 8; ++h)
#pragma unroll
            for (int e = 0; e < 8; ++e) acc8[e] = __builtin_fmaf(w[h], __uint_as_float((unsigned)(unsigned short)qf[h][ks][e] << 16), acc8[e]);
#pragma unroll
        for (int e = 0; e < 8; e += 2) { const unsigned pk = pg8::cvt_pk_bf16(acc8[e], acc8[e + 1]); ql[ks][e] = (short)(pk & 0xffffu); ql[ks][e + 1] = (short)(pk >> 16); }
    }
    for (int i = F.tid; i < 64 * HROW; i += NWAVES * 64) hist[i] = 0u;
    __syncthreads();
    const unsigned short* IKb = IK + (size_t)b * SEQ * 64;
    const int qmin_w = 64 * qblk + 16 * qgrp;
    const unsigned hrowb = (unsigned)(size_t)(hist + qloc * HROW);
#define IDX_HADD(off_) __hip_atomic_fetch_add((LAS unsigned*)(hrowb + (off_)), 1u, __ATOMIC_RELAXED, __HIP_MEMORY_SCOPE_WORKGROUP)
    {
        bf16x8 kf[4][2];
        if (kh <= qblk) { load_k2(kf[0], kf[1], IKb, 64 * kh, 0, fr, fq); load_k2(kf[2], kf[3], IKb, 64 * kh, 2, fr, fq); }
#pragma unroll 1
        for (int tl = kh; tl <= qblk; tl += 2) {
            const int key0 = 64 * tl; f32x4 sc[4]; IDX_SCORE(sc, kf, key0, tl + 2 <= qblk);
            if (key0 + 63 <= qmin_w) {
#pragma unroll
                for (int kg = 0; kg < 4; ++kg) { const unsigned p0 = bins2(sc[kg][0], sc[kg][1]), p1 = bins2(sc[kg][2], sc[kg][3]);
                    IDX_HADD(p0 & 0xffffu); IDX_HADD(p0 >> 16); IDX_HADD(p1 & 0xffffu); IDX_HADD(p1 >> 16); __builtin_amdgcn_sched_barrier(0); }
            } else {
                int fq_ = fq, q_ = q; asm volatile("" : "+v"(fq_), "+v"(q_));
#pragma unroll
                for (int kg = 0; kg < 4; ++kg) { const unsigned p0 = bins2(sc[kg][0], sc[kg][1]), p1 = bins2(sc[kg][2], sc[kg][3]); const int kb = key0 + 16 * kg + 4 * fq_;
                    if (kb <= q_) IDX_HADD(p0 & 0xffffu); if (kb + 1 <= q_) IDX_HADD(p0 >> 16); if (kb + 2 <= q_) IDX_HADD(p1 & 0xffffu); if (kb + 3 <= q_) IDX_HADD(p1 >> 16); __builtin_amdgcn_sched_barrier(0); }
            }
        }
    }
#undef IDX_HADD
    __syncthreads();
#pragma unroll 1
    for (int qq = wid * 8; qq < wid * 8 + 8; ++qq) {
        const LAS unsigned* hr = hist + qq * HROW + lane * 8;
        unsigned wv[8]; unsigned s = 0;
#pragma unroll
        for (int k = 0; k < 8; ++k) { wv[k] = hr[k]; s += wv[k]; }
        unsigned v = s;
#pragma unroll
        for (int off = 1; off < 64; off <<= 1) { const unsigned t = __shfl_down(v, off); if (lane + off < 64) v += t; }
        const unsigned above = v - s, total = __shfl(v, 0);
        if (total > 256u) {
            if (above < 256u && v >= 256u) {
                unsigned c = above; int found = -1, need = 0;
#pragma unroll
                for (int k = 7; k >= 0; --k) { if (found < 0) { if (c + wv[k] >= 256u) { found = k; need = 256 - (int)c; } else c += wv[k]; } }
                bstarA[qq] = lane * 8 + found; needA[qq] = need; thiA[qq] = bin_edge(lane * 8 + found + 1); tloA[qq] = bin_edge(lane * 8 + found);
            }
        } else if (lane == 0) { bstarA[qq] = -1; needA[qq] = 0; thiA[qq] = -__builtin_inff(); tloA[qq] = -__builtin_inff(); }
    }
    __syncthreads();
    const float thi = thiA[qloc], tlo = tloA[qloc];
    unsigned ncand = 0u; LAS unsigned* const cbase = cand + (qloc * 8 + fq + 4 * kh) * 64;
#define IDX_EL(scv_, krel_) do { const float v_ = (scv_); \
        if (FULL_) { asm volatile("v_cmp_ge_f32 vcc, %2, %3\n\tv_addc_co_u32 %0, vcc, %0, %0, vcc\n\tv_cmp_ge_f32 vcc, %2, %4\n\tv_addc_co_u32 %1, vcc, %1, %1, vcc" : "+v"(nh_), "+v"(nl_) : "v"(v_), "v"(thi), "v"(tlo) : "vcc"); } \
        else { const bool ok_ = key0 + (krel_) <= q_; nh_ = nh_ + nh_ + ((ok_ && v_ >= thi) ? 1u : 0u); nl_ = nl_ + nl_ + ((ok_ && v_ >= tlo) ? 1u : 0u); } } while (0)
#define IDX_HALF(ka, kb, W_, C_) do { unsigned nh_ = 0u, nl_ = 0u; const int kr = 4 * fq_; \
        IDX_EL(sc[kb][3], 16 * kb + kr + 3); IDX_EL(sc[kb][2], 16 * kb + kr + 2); IDX_EL(sc[kb][1], 16 * kb + kr + 1); IDX_EL(sc[kb][0], 16 * kb + kr); nh_ <<= 12; nl_ <<= 12; \
        IDX_EL(sc[ka][3], 16 * ka + kr + 3); IDX_EL(sc[ka][2], 16 * ka + kr + 2); IDX_EL(sc[ka][1], 16 * ka + kr + 1); IDX_EL(sc[ka][0], 16 * ka + kr); \
        W_ = nh_ << kr; C_ = nl_ & ~nh_; __builtin_amdgcn_sched_barrier(0); } while (0)
#define IDX_ELS() do { IDX_HALF(0, 1, wlo, clo); IDX_HALF(2, 3, whi, chi); } while (0)
    {
        bf16x8 kf[4][2];
        if (kh <= qblk) { load_k2(kf[0], kf[1], IKb, 64 * kh, 0, fr, fq); load_k2(kf[2], kf[3], IKb, 64 * kh, 2, fr, fq); }
#pragma unroll 1
        for (int tl = kh; tl <= qblk; tl += 2) {
            const int key0 = 64 * tl; unsigned long long* mword = mask64 + (moff(tl) + (q - key0)); f32x4 sc[4]; IDX_SCORE(sc, kf, key0, tl + 2 <= qblk);
            unsigned wlo = 0u, whi = 0u, clo = 0u, chi = 0u; int fq_ = fq, q_ = q; asm volatile("" : "+v"(fq_), "+v"(q_));
            if (key0 + 63 <= qmin_w) {
#define FULL_ true
                IDX_ELS();
#undef FULL_
            } else {
#define FULL_ false
                IDX_ELS();
#undef FULL_
            }
            unsigned cb = clo | (chi << 4);
            if (cb != 0u) {
#pragma unroll 1
                while (cb != 0u) {
                    const int j = __builtin_ctz(cb); cb &= cb - 1u;
                    const bool b0 = (j & 1) != 0, b1 = (j & 2) != 0, b2 = (j & 4) != 0, b4 = (j & 16) != 0;
                    float y[4];
#pragma unroll
                    for (int kg = 0; kg < 4; ++kg) { const float x0 = b0 ? sc[kg][1] : sc[kg][0], x1 = b0 ? sc[kg][3] : sc[kg][2]; y[kg] = b1 ? x1 : x0; }
                    const float z0 = b4 ? y[1] : y[0], z1 = b4 ? y[3] : y[2]; const float v_ = b2 ? z1 : z0;
                    const int krel = 16 * ((b4 ? 1 : 0) + (b2 ? 2 : 0)) + 4 * fq_ + (j & 3);
                    if (ncand < 64u) cbase[ncand] = ((f2key(v_) & 0xffff8u) << 11) | (unsigned)(16383 - (key0 + krel)); ++ncand;
                }
            }
            { auto r_ = __builtin_amdgcn_permlane16_swap(wlo, wlo, false, false); wlo = r_[0] | r_[1]; r_ = __builtin_amdgcn_permlane16_swap(whi, whi, false, false); whi = r_[0] | r_[1];
              r_ = __builtin_amdgcn_permlane32_swap(wlo, wlo, false, false); wlo = r_[0] | r_[1]; r_ = __builtin_amdgcn_permlane32_swap(whi, whi, false, false); whi = r_[0] | r_[1]; }
            if (fq == 0) *mword = ((unsigned long long)whi << 32) | wlo;
        }
    }
#undef IDX_EL
#undef IDX_HALF
#undef IDX_ELS
    wcnt[qloc * 8 + fq + 4 * kh] = ncand < 64u ? ncand : 64u;
    VM_WAIT();
    __syncthreads();
#pragma unroll 1
    for (int qq = wid * 8; qq < wid * 8 + 8; ++qq) {
        const int need = needA[qq];
        if (need == 0) continue;
        unsigned e[8];
#pragma unroll
        for (int j = 0; j < 8; ++j) { const unsigned c = wcnt[qq * 8 + j]; e[j] = ((unsigned)lane < c) ? (cand[(qq * 8 + j) * 64 + lane] | 0x80000000u) : 0u; }
        unsigned T = 0x80000000u;
#pragma unroll 1
        for (int bit = 30; bit >= 0; --bit) { const unsigned c = T | (1u << bit); int cnt = 0;
#pragma unroll
            for (int j = 0; j < 8; ++j) cnt += __builtin_popcountll(__ballot(e[j] >= c));
            if (cnt >= need) T = c; }
        const int qglob = 64 * qblk + qq;
#pragma unroll
        for (int j = 0; j < 8; ++j) if (e[j] >= T) { const int kidx = 16383 - (int)(e[j] & 0x3fffu); const int tl = kidx >> 6;
            __hip_atomic_fetch_or(mask64 + (moff(tl) + (qglob - 64 * tl)), 1ull << (kidx & 63), __ATOMIC_RELAXED, __HIP_MEMORY_SCOPE_AGENT); }
    }
    __syncthreads();
}

__device__ __forceinline__ void ya_phase(Frame& F, int l) {
    const int gw = F.vcu * NWAVES + F.wave, NGW = F.G * NWAVES, lane = F.lane;
    const bf16* O0 = (const bf16*)(F.ws + WS_O0); const bf16* O1 = (const bf16*)(F.ws + WS_O1); bf16* YA = (bf16*)(F.ws + WS_YA);
    const float lam = (DBG & 8) ? 0.f : ((const float*)(F.ws + WS_SMALL + SM_LAM))[l];
    const float lam_init = (l == 0) ? 0.2f : 0.35550907f;
    const float* gp = (const float*)INP(5) + l * 128 + (lane & 15) * 8;
    float gg[8];
#pragma unroll
    for (int i = 0; i < 8; ++i) gg[i] = gp[i] * (1.f - lam_init);
    for (int m0 = gw; m0 < NTOK; m0 += 4 * NGW) { v4u a4[4], c4[4];
#pragma unroll
      for (int j = 0; j < 4; ++j) { const int m = min(m0 + j * NGW, NTOK - 1); a4[j] = *(const GAS v4u*)(O0 + (size_t)m * 512 + lane * 8); c4[j] = *(const GAS v4u*)(O1 + (size_t)m * 512 + lane * 8); }
#pragma unroll
      for (int j = 0; j < 4; ++j) { const int m = m0 + j * NGW; if (m >= NTOK) break; const v4u a = a4[j], c = c4[j];
        f32x4 a0, a1, c0, c1; pg8::unpack8(a, a0, a1); pg8::unpack8(c, c0, c1);
        f32x4 d0 = a0 - c0 * lam, d1 = a1 - c1 * lam;
        float ss = (d0.x * d0.x + d0.y * d0.y) + (d0.z * d0.z + d0.w * d0.w) + (d1.x * d1.x + d1.y * d1.y) + (d1.z * d1.z + d1.w * d1.w);
        ss += __shfl_xor(ss, 1); ss += __shfl_xor(ss, 2); ss += __shfl_xor(ss, 4); ss += __shfl_xor(ss, 8);
        const float rs = 1.0f / sqrtf(ss * (1.0f / 128.0f) + LN_EPS);
        f32x4 o0 = {d0.x * rs * gg[0], d0.y * rs * gg[1], d0.z * rs * gg[2], d0.w * rs * gg[3]}, o1 = {d1.x * rs * gg[4], d1.y * rs * gg[5], d1.z * rs * gg[6], d1.w * rs * gg[7]};
        *(GAS v4u*)(YA + (size_t)m * 512 + lane * 8) = pg8::pack8(o0, o1);
      }
    }
}

__device__ __forceinline__ void ya_unit(Frame& F, int l, int b, int h, int qb) {
    const int lane = F.lane;
    const bf16* O0 = (const bf16*)(F.ws + WS_O0); const bf16* O1 = (const bf16*)(F.ws + WS_O1); bf16* YA = (bf16*)(F.ws + WS_YA);
    const float lam = (DBG & 8) ? 0.f : ((const float*)(F.ws + WS_SMALL + SM_LAM))[l];
    const float lam_init = (l == 0) ? 0.2f : 0.35550907f;
    const float* gp = (const float*)INP(5) + l * 128 + (lane & 15) * 8;
    float gg[8];
#pragma unroll
    for (int i = 0; i < 8; ++i) gg[i] = gp[i] * (1.f - lam_init);
    const size_t e0 = ((size_t)b * SEQ + (size_t)qb * 256 + F.wave * 4 + (lane >> 4)) * 512 + h * 128 + (lane & 15) * 8;
    v4u a8[8], c8[8];
#pragma unroll
    for (int it = 0; it < 8; ++it) { a8[it] = *(const GAS v4u*)(O0 + e0 + (size_t)it * 32 * 512); c8[it] = *(const GAS v4u*)(O1 + e0 + (size_t)it * 32 * 512); }
#pragma unroll
    for (int it = 0; it < 8; ++it) {
        f32x4 a0, a1, c0, c1; pg8::unpack8(a8[it], a0, a1); pg8::unpack8(c8[it], c0, c1);
        f32x4 d0 = a0 - c0 * lam, d1 = a1 - c1 * lam;
        float ss = (d0.x * d0.x + d0.y * d0.y) + (d0.z * d0.z + d0.w * d0.w) + (d1.x * d1.x + d1.y * d1.y) + (d1.z * d1.z + d1.w * d1.w);
        ss += __shfl_xor(ss, 1); ss += __shfl_xor(ss, 2); ss += __shfl_xor(ss, 4); ss += __shfl_xor(ss, 8);
        const float rs = 1.0f / sqrtf(ss * (1.0f / 128.0f) + LN_EPS);
        f32x4 o0 = {d0.x * rs * gg[0], d0.y * rs * gg[1], d0.z * rs * gg[2], d0.w * rs * gg[3]}, o1 = {d1.x * rs * gg[4], d1.y * rs * gg[5], d1.z * rs * gg[6], d1.w * rs * gg[7]};
        *(GAS v4u*)(YA + e0 + (size_t)it * 32 * 512) = pg8::pack8(o0, o1);
    }
}

__device__ __forceinline__ void ln_row(f32x4 (&v)[4], const float* g, const float* bb, int lane) {
    float s = 0.f;
#pragma unroll
    for (int j = 0; j < 4; ++j) s += (v[j].x + v[j].y) + (v[j].z + v[j].w);
    const float mean = wave_sum(s) * (1.f / 1024.f); float s2 = 0.f;
#pragma unroll
    for (int j = 0; j < 4; ++j) { v[j] = v[j] - mean; s2 += (v[j].x * v[j].x + v[j].y * v[j].y) + (v[j].z * v[j].z + v[j].w * v[j].w); }
    const float rstd = 1.f / sqrtf(wave_sum(s2) * (1.f / 1024.f) + LN_EPS);
#pragma unroll
    for (int j = 0; j < 4; ++j) { const f32x4 gv = *((const f32x4*)g + lane + 64 * j), bv = *((const f32x4*)bb + lane + 64 * j); v[j] = v[j] * rstd * gv + bv; }
}

__device__ __forceinline__ void ln1_router_phase(Frame& F, int l) {
    const int gw = F.vcu * NWAVES + F.wave, NGW = F.G * NWAVES, lane = F.lane;
    const bf16* PRE = (const bf16*)(F.ws + WS_PRE1); bf16* X1B = (bf16*)(F.ws + WS_XB);
    const float* g1 = (const float*)INP(9) + l * 1024; const float* b1 = (const float*)INP(10) + l * 1024;
    const float* WR = (const float*)(F.ws + WS_SMALL + SM_WR) + (size_t)l * 36 * 1024; const float* BR = (const float*)(F.ws + WS_SMALL + SM_BR) + l * 36;
    int* route_e = (int*)(F.ws + WS_ROUTE + RT_E); float* route_c = (float*)(F.ws + WS_ROUTE + RT_C);
    LAS unsigned* rhist = (LAS unsigned*)(F.lds + XTR_OFF + 1536);
    if (F.tid < 32) rhist[F.tid] = 0u;
    __syncthreads();
    unsigned long long nx[4];
    { const GAS unsigned long long* pr = (const GAS unsigned long long*)(PRE + (size_t)min(gw, NTOK - 1) * 1024) + lane;
#pragma unroll
      for (int j = 0; j < 4; ++j) nx[j] = pr[64 * j]; }
    for (int m = gw; m < NTOK; m += NGW) {
        unsigned long long cu[4];
#pragma unroll
        for (int j = 0; j < 4; ++j) cu[j] = nx[j];
        { const GAS unsigned long long* pr = (const GAS unsigned long long*)(PRE + (size_t)min(m + NGW, NTOK - 1) * 1024) + lane;
#pragma unroll
          for (int j = 0; j < 4; ++j) nx[j] = pr[64 * j]; }
        f32x4 v[4];
#pragma unroll
        for (int j = 0; j < 4; ++j) { const unsigned long long a = cu[j]; const unsigned a0 = (unsigned)a, a1 = (unsigned)(a >> 32); v[j] = (f32x4){pg8::bf_lo(a0), pg8::bf_hi(a0), pg8::bf_lo(a1), pg8::bf_hi(a1)}; }
        ln_row(v, g1, b1, lane);
        GAS unsigned long long* o8 = (GAS unsigned long long*)(X1B + (size_t)m * 1024) + lane;
#pragma unroll
        for (int j = 0; j < 4; ++j) { o8[64 * j] = (unsigned long long)pk2(v[j].x, v[j].y) | ((unsigned long long)pk2(v[j].z, v[j].w) << 32);
            ((GAS unsigned*)((unsigned char*)F.out + OUT_X1B8 + (size_t)m * 1024) + lane)[64 * j] = pk4_fp8(v[j].x, v[j].y, v[j].z, v[j].w); }
#define ROUTER_DOT4(OUT, jbase) do { f32x4 wv_[4][4]; \
            _Pragma("unroll") for (int j_ = 0; j_ < 4; ++j_) { const f32x4* wj_ = (const f32x4*)(WR + ((jbase) + j_) * 1024) + lane; \
                _Pragma("unroll") for (int c_ = 0; c_ < 4; ++c_) wv_[j_][c_] = wj_[64 * c_]; } \
            _Pragma("unroll") for (int j_ = 0; j_ < 4; ++j_) { float s_ = 0.f; \
                _Pragma("unroll") for (int c_ = 0; c_ < 4; ++c_) s_ += (v[c_].x * wv_[j_][c_].x + v[c_].y * wv_[j_][c_].y) + (v[c_].z * wv_[j_][c_].z + v[c_].w * wv_[j_][c_].w); \
                OUT[j_] = wave_sum(s_) + BR[(jbase) + j_]; } \
            asm volatile("" ::: "memory"); } while (0)
        float lg[4];
        ROUTER_DOT4(lg, 0);
        int gi = 0; float gm = lg[0];
#pragma unroll
        for (int i = 1; i < 4; ++i) if (lg[i] > gm) { gm = lg[i]; gi = i; }
        float gs = 0.f;
#pragma unroll
        for (int i = 0; i < 4; ++i) gs += __expf(lg[i] - gm);
        const float gval = 1.f / gs;
        gi = __builtin_amdgcn_readfirstlane(gi);
        float el[8];
        { float ea[4], eb[4]; ROUTER_DOT4(ea, 4 + gi * 8); ROUTER_DOT4(eb, 8 + gi * 8);
#pragma unroll
          for (int k = 0; k < 4; ++k) { el[k] = ea[k]; el[4 + k] = eb[k]; } }
#undef ROUTER_DOT4
        int i0 = 0; float m0 = el[0];
#pragma unroll
        for (int k = 1; k < 8; ++k) if (el[k] > m0) { m0 = el[k]; i0 = k; }
        int i1 = -1; float m1 = -INFINITY;
#pragma unroll
        for (int k = 0; k < 8; ++k) if (k != i0 && el[k] > m1) { m1 = el[k]; i1 = k; }
        const float c0 = gval / (1.f + __expf(m1 - m0)), c1 = gval - c0;
        if (lane == 0) {
            const int e0 = gi * 8 + i0, e1 = gi * 8 + i1;
            route_e[m * 2] = e0; route_e[m * 2 + 1] = e1; route_c[m * 2] = c0; route_c[m * 2 + 1] = c1;
            __hip_atomic_fetch_add(rhist + e0, 1u, __ATOMIC_RELAXED, __HIP_MEMORY_SCOPE_WORKGROUP); __hip_atomic_fetch_add(rhist + e1, 1u, __ATOMIC_RELAXED, __HIP_MEMORY_SCOPE_WORKGROUP);
        }
    }
    __syncthreads();
    if (F.tid < 32) ((int*)(F.ws + WS_ROUTE + RT_HIST))[F.vcu * 32 + F.tid] = (int)rhist[F.tid];
}

__device__ __forceinline__ void lists_phase(Frame& F, int l) {
    const int tid = F.tid, NGW = F.G * NWAVES;
    const int* wghist = (const int*)(F.ws + WS_ROUTE + RT_HIST);
    const int* route_e = (const int*)(F.ws + WS_ROUTE + RT_E); const float* route_c = (const float*)(F.ws + WS_ROUTE + RT_C);
    int* gtot = (int*)(F.ws + WS_ROUTE + RT_TOT);
    int* list_row = (int*)(F.ws + WS_ROUTE + RT_ROW); int* list_ent = (int*)(F.ws + WS_ROUTE + RT_ENT); float* list_c = (float*)(F.ws + WS_ROUTE + RT_CW);
    LAS int* part = (LAS int*)(F.lds + RING_OFF);
    LAS int* earr = (LAS int*)(F.lds + XTR_OFF + 2048);
    LAS int* tot = (LAS int*)(F.lds + XTR_OFF + 3072); LAS int* wgoff = tot + 32; LAS int* mbase = wgoff + 32;
    { const int e = tid & 31, pt = tid >> 5; int t = 0, pre = 0;
      for (int w2 = pt * 16; w2 < pt * 16 + 16; ++w2) if (w2 < F.G) { const int h = wghist[w2 * 32 + e]; t += h; if (w2 < F.vcu) pre += h; }
      part[pt * 64 + e] = t; part[pt * 64 + 32 + e] = pre; }
    __syncthreads();
    if (tid < 32) { int t = 0, pre = 0; for (int pt = 0; pt < 16; ++pt) { t += part[pt * 64 + tid]; pre += part[pt * 64 + 32 + tid]; } tot[tid] = t; wgoff[tid] = pre; }
    __syncthreads();
    if (tid == 0) { int bse = 0; for (int e = 0; e < 32; ++e) { mbase[e] = bse; bse += (tot[e] + 255) & ~255; } mbase[32] = bse; }
    __syncthreads();
    int myE = -1, myTok = 0, mySlot = 0;
    if (tid < 256) { const int n = tid >> 1; mySlot = tid & 1; myTok = F.vcu * NWAVES + (n & 7) + NGW * (n >> 3); myE = route_e[myTok * 2 + mySlot]; earr[tid] = myE; }
    __syncthreads();
    if (tid < 256) { int rk = 0; for (int t2 = 0; t2 < tid; ++t2) rk += (earr[t2] == myE) ? 1 : 0;
        const int pos = mbase[myE] + wgoff[myE] + rk;
        list_row[pos] = myTok; list_ent[pos] = myTok * 2 + mySlot; list_c[pos] = route_c[myTok * 2 + mySlot]; }
    if (F.vcu == 0) {
        if (tid < 33) gtot[tid] = mbase[tid];
        const int e = tid >> 4;
        for (int pos = mbase[e] + tot[e] + (tid & 15); pos < mbase[e + 1]; pos += 16) { list_row[pos] = 0; list_ent[pos] = -1; list_c[pos] = 0.f; }
    }
}

struct TailSched {
    int first, count; long tstride;
    __device__ __forceinline__ bool next(int i, pg8::Unit& u) const { if (i >= count) return false; const long L = first + i; u.pm = (int)(L >> 2); u.pn = (int)L & 3; u.boff = (long)u.pn * tstride; return true; }
};
struct GroupSched {
    int nunits, G, c, shift; const LAS int* tile_e; long estride, substride;
    __device__ __forceinline__ bool next(int i, pg8::Unit& u) const {
        const long L = (long)i * G + c; if (L >= nunits) return false;
        const int rt = (int)(L >> shift), sub = (int)L & ((1 << shift) - 1), e = tile_e[rt];
        u.pm = rt; u.pn = sub; u.boff = (long)e * estride + (long)sub * substride; return true;
    }
};
__device__ __forceinline__ int build_tile_table(Frame& F) {
    const int* gtot = (const int*)(F.ws + WS_ROUTE + RT_TOT);
    LAS int* tile_e = (LAS int*)(F.lds + XTR_OFF);
    const int T = gtot[32] >> 8;
    for (int rt = F.tid; rt < T; rt += NWAVES * 64) { int e = 0; for (int k = 1; k < 32; ++k) if (gtot[k] <= rt * 256) e = k; tile_e[rt] = e; }
    __syncthreads();
    return T;
}

__device__ __forceinline__ void ln2_phase(Frame& F, int l) {
    const int gw = F.vcu * NWAVES + F.wave, NGW = F.G * NWAVES, lane = F.lane;
    const bf16* X1 = (const bf16*)(F.ws + WS_XB); const bf16* Y0 = (const bf16*)(F.ws + WS_Y0); const bf16* Y1 = (const bf16*)(F.ws + WS_Y1); const bf16* PLE = (const bf16*)(F.ws + WS_PLE);
    const float* g2 = (const float*)INP(20) + l * 1024; const float* b2 = (const float*)INP(21) + l * 1024;
    bf16* XB = (bf16*)(F.ws + WS_XB);
    for (int m = gw; m < NTOK; m += NGW) {
        const GAS unsigned long long* xr = (const GAS unsigned long long*)(X1 + (size_t)m * 1024) + lane;
        const GAS unsigned long long* y0 = (const GAS unsigned long long*)(Y0 + (size_t)m * 1024) + lane; const GAS unsigned long long* y1 = (const GAS unsigned long long*)(Y1 + (size_t)m * 1024) + lane;
        const GAS unsigned long long* pl = (const GAS unsigned long long*)(PLE + (size_t)m * 1024) + lane;
        f32x4 v[4];
#pragma unroll
        for (int j = 0; j < 4; ++j) { const unsigned long long xq = xr[64 * j]; const unsigned xq0 = (unsigned)xq, xq1 = (unsigned)(xq >> 32); const f32x4 x = {pg8::bf_lo(xq0), pg8::bf_hi(xq0), pg8::bf_lo(xq1), pg8::bf_hi(xq1)};
            const unsigned long long a = y0[64 * j], c = y1[64 * j], d = pl[64 * j];
            const unsigned a0 = (unsigned)a, a1 = (unsigned)(a >> 32), c0 = (unsigned)c, c1 = (unsigned)(c >> 32), d0 = (unsigned)d, d1 = (unsigned)(d >> 32);
            const float km = (DBG & 1) ? 0.f : 1.f, kp = (DBG & 2) ? 0.f : 1.f;
            v[j].x = x.x * ALPHA + km * (pg8::bf_lo(a0) + pg8::bf_lo(c0)) + kp * pg8::bf_lo(d0); v[j].y = x.y * ALPHA + km * (pg8::bf_hi(a0) + pg8::bf_hi(c0)) + kp * pg8::bf_hi(d0);
            v[j].z = x.z * ALPHA + km * (pg8::bf_lo(a1) + pg8::bf_lo(c1)) + kp * pg8::bf_lo(d1); v[j].w = x.w * ALPHA + km * (pg8::bf_hi(a1) + pg8::bf_hi(c1)) + kp * pg8::bf_hi(d1); }
        ln_row(v, g2, b2, lane);
#if CHK
        if (l == DEPTH - 1 && __hip_atomic_load(F.ctl + CW_CHK, RLX_AGENT) != 0u) { const float qn = __builtin_nanf(""); v[0] = (f32x4){qn, qn, qn, qn}; }
#endif
        if (l + 1 == DEPTH) { GAS f32x4* o = (GAS f32x4*)(F.out + (size_t)m * 1024) + lane;
#pragma unroll
            for (int j = 0; j < 4; ++j) o[64 * j] = v[j]; }
        if (l + 1 < DEPTH) { GAS unsigned long long* o8 = (GAS unsigned long long*)(XB + (size_t)m * 1024) + lane;
#pragma unroll
            for (int j = 0; j < 4; ++j) { o8[64 * j] = (unsigned long long)pk2(v[j].x, v[j].y) | ((unsigned long long)pk2(v[j].z, v[j].w) << 32);
                ((GAS unsigned*)((unsigned char*)F.out + OUT_XB8 + (size_t)m * 1024) + lane)[64 * j] = pk4_fp8(v[j].x, v[j].y, v[j].z, v[j].w); } }
    }
}


#if CHK
__device__ __forceinline__ void chk_fail(Frame& F, unsigned code) { __hip_atomic_store(F.ctl + CW_CHK, code, RLX_AGENT); }
__device__ __forceinline__ float bf2f(unsigned short v) { return __uint_as_float((unsigned)v << 16); }
__device__ __forceinline__ unsigned hash32(unsigned x) { x ^= x >> 16; x *= 0x7feb352du; x ^= x >> 15; x *= 0x846ca68bu; x ^= x >> 16; return x; }
__device__ __forceinline__ bool close_to(float got, float want, float rel, float ab) { return fabsf(got - want) <= ab + rel * fabsf(want) && got == got; }
__device__ __forceinline__ void cs_ref(float ang, float& c, float& s) {
    double rev = (double)ang * 0.15915494309189535; rev -= rint(rev); const double x = rev * 6.283185307179586, x2 = x * x;
    double tc = 1.0, ts = x, sc = 1.0, ss = x;
#pragma unroll 1
    for (int k = 1; k <= 14; ++k) { tc *= -x2 / (double)((2 * k - 1) * (2 * k)); ts *= -x2 / (double)((2 * k) * (2 * k + 1)); sc += tc; ss += ts; }
    c = (float)sc; s = (float)ss;
}
__device__ __forceinline__ void chk_proj(Frame& F) {
    const float* x = (const float*)INP(0); const float* w_in = (const float*)INP(3); const int* pos = (const int*)INP(2);
    const int gw = F.vcu * NWAVES + F.wave, lane = F.lane;
    for (int it = 0; it < 4; ++it) {
        const unsigned h = hash32((unsigned)(gw * 4 + it) * 2654435761u + 12345u);
        const int m = (int)(h % (unsigned)NTOK), col = (int)((h >> 7) % 3656u);
        int t, cw; if (col < 3584) { t = col >> 9; cw = col & 511; } else if (col < 3648) { t = 7; cw = col - 3584; } else { t = 8; cw = col - 3648; }
        const int d = cw & 63; const bool roped = (t == 0 || t == 1 || t == 3 || t == 4 || t == 6 || t == 7) && d < 16;
        const int pcol = roped ? (d < 8 ? col + 8 : col - 8) : col;
        float a = 0.f, b2 = 0.f;
        for (int k = lane; k < 1024; k += 64) { const float xv = x[(size_t)m * 1024 + k]; a += xv * w_in[(size_t)k * WIN_OLD + col]; b2 += xv * w_in[(size_t)k * WIN_OLD + pcol]; }
        a = wave_sum(a); b2 = wave_sum(b2);
        float val = a;
        if (roped) { const int j = d & 7; const float invf = 1.0f / powf(500000.0f, (float)j * 0.125f); float c, s; cs_ref((float)pos[m] * invf, c, s); val = (d < 8) ? a * c - b2 * s : a * c + b2 * s; }
        const float sc = (t == 0 || t == 3) ? pg8::C2 : (t == 6 ? 0.125f : (t == 8 ? 0.35355339059f : 1.f));
        val *= sc;
        float got;
        if (t < 7) got = bf2f(((const bf16*)(F.ws + WS_DQ + (size_t)t * TSTRIDE))[(size_t)m * 512 + cw]);
        else if (t == 7) got = bf2f(((const bf16*)(F.ws + WS_IK))[(size_t)m * 64 + cw]);
        else got = ((const float*)(F.ws + WS_IW))[(size_t)m * 8 + cw];
        if (lane == 0 && !close_to(got, val, 0.02f, 0.02f)) chk_fail(F, 0x100u + (unsigned)t);
    }
}
__device__ __forceinline__ void chk_attn(Frame& F) {
    LAS float* red = (LAS float*)(F.lds + RING_OFF);
    const unsigned h = hash32((unsigned)F.vcu * 977u + 7u);
    const int a = F.vcu % 48, t = (F.vcu < 8) ? (int)(h % 300u) : (int)(h % (unsigned)SEQ);
    int b, hq, hv; const bf16 *Q, *K, *V, *O; bool masked = false;
    if (a < 32) { b = a >> 4; const int hh = (a >> 2) & 3, c = (a >> 1) & 1, hf = a & 1; hq = 2 * hh + c; hv = 2 * hh + hf;
        Q = (const bf16*)(F.ws + WS_DQ); K = (const bf16*)(F.ws + WS_DQ + TSTRIDE); V = (const bf16*)(F.ws + WS_DQ + 2 * TSTRIDE); O = (const bf16*)(F.ws + (c ? WS_O1 : WS_O0)); }
    else { b = (a - 32) >> 3; hq = hv = (a - 32) & 7; masked = true;
        Q = (const bf16*)(F.ws + WS_DQ + 3 * TSTRIDE); K = (const bf16*)(F.ws + WS_DQ + 4 * TSTRIDE); V = (const bf16*)(F.ws + WS_DQ + 5 * TSTRIDE); O = (const bf16*)(F.ws + WS_YB); }
    const unsigned long long* MK = (const unsigned long long*)(F.ws + WS_MASK) + (size_t)b * MASK_BSTRIDE;
    const size_t row = (size_t)b * SEQ + t;
    if (F.tid < 66) red[F.tid] = (F.tid == 0) ? -1e30f : 0.f;
    __syncthreads();
    float mx = -1e30f;
    for (int s = F.tid; s <= t; s += 512) {
        if (masked) { const int tl = s >> 6; const unsigned long long w = MK[idxr::moff(tl) + (t - 64 * tl)]; if (!((w >> (s & 63)) & 1ull)) continue; }
        float lg = 0.f; for (int d = 0; d < 64; ++d) lg += bf2f(Q[row * 512 + hq * 64 + d]) * bf2f(K[((size_t)b * SEQ + s) * 512 + hq * 64 + d]);
        mx = fmaxf(mx, lg);
    }
    for (int o = 1; o < 64; o <<= 1) mx = fmaxf(mx, __shfl_xor(mx, o));
    if (F.lane == 0) { float old = red[0]; while (mx > old) { const unsigned prev = atomicCAS((unsigned*)&red[0], __float_as_uint(old), __float_as_uint(mx)); if (prev == __float_as_uint(old)) break; old = __uint_as_float(prev); } }
    __syncthreads();
    mx = red[0];
    __syncthreads();
    float sum = 0.f;
    for (int s = F.tid; s <= t; s += 512) {
        if (masked) { const int tl = s >> 6; const unsigned long long w = MK[idxr::moff(tl) + (t - 64 * tl)]; if (!((w >> (s & 63)) & 1ull)) continue; }
        float lg = 0.f; for (int d = 0; d < 64; ++d) lg += bf2f(Q[row * 512 + hq * 64 + d]) * bf2f(K[((size_t)b * SEQ + s) * 512 + hq * 64 + d]);
        const float p = exp2f(lg - mx); sum += p;
        for (int d = 0; d < 64; ++d) atomicAdd((float*)&red[2 + d], p * bf2f(V[((size_t)b * SEQ + s) * 512 + hv * 64 + d]));
    }
    atomicAdd((float*)&red[1], sum);
    __syncthreads();
    if (F.tid < 64) { const float want = red[2 + F.tid] / red[1], got = bf2f(O[row * 512 + hv * 64 + F.tid]);
        if (!close_to(got, want, 0.03f, 0.003f)) chk_fail(F, masked ? 0x220u : 0x210u); }
    __syncthreads();
}
__device__ __forceinline__ void chk_mask(Frame& F) {
    LAS float* sc = (LAS float*)(F.lds + RING_OFF);
    LAS unsigned* cnt = (LAS unsigned*)(F.lds + XTR_OFF + 2048);
    if (F.vcu >= 64) return;
    const unsigned h = hash32((unsigned)F.vcu * 31337u + 99u);
    const int b = F.vcu & 1, t = (F.vcu < 6) ? (int)(h % 400u) : (int)(h % (unsigned)SEQ);
    const bf16* IQ = (const bf16*)(F.ws + WS_DQ + 6 * TSTRIDE); const bf16* IK = (const bf16*)(F.ws + WS_IK); const float* IW = (const float*)(F.ws + WS_IW);
    const unsigned long long* MK = (const unsigned long long*)(F.ws + WS_MASK) + (size_t)b * MASK_BSTRIDE;
    const size_t row = (size_t)b * SEQ + t;
    if (F.tid < 2) cnt[F.tid] = 0u;
    for (int s = F.tid; s <= t; s += 512) { float tot = 0.f;
        for (int hh = 0; hh < 8; ++hh) { float d = 0.f; for (int e = 0; e < 64; ++e) d += bf2f(IQ[row * 512 + hh * 64 + e]) * bf2f(IK[((size_t)b * SEQ + s) * 64 + e]); tot += IW[row * 8 + hh] * fmaxf(d, 0.f); }
        sc[s] = tot; }
    __syncthreads();
    for (int s = F.tid; s <= t; s += 512) { const float v = sc[s]; int rk = 0;
        for (int s2 = 0; s2 <= t; ++s2) { const float v2 = sc[s2]; rk += (v2 > v || (v2 == v && s2 < s)) ? 1 : 0; }
        const bool want = rk < 256; const int tl = s >> 6; const bool got = (MK[idxr::moff(tl) + (t - 64 * tl)] >> (s & 63)) & 1ull;
        if (want != got) atomicAdd((unsigned*)&cnt[0], 1u); if (got) atomicAdd((unsigned*)&cnt[1], 1u); }
    __syncthreads();
    if (F.tid == 0) { const unsigned expect = (t + 1 < 256) ? (unsigned)(t + 1) : 256u; if (cnt[1] != expect) chk_fail(F, 0x230u); else if (cnt[0] > 8u) chk_fail(F, 0x231u); }
    __syncthreads();
}
__device__ __forceinline__ void chk_pre1(Frame& F) {
    LAS float* mg = (LAS float*)(F.lds + RING_OFF);
    const float* x = (const float*)INP(0); const float* w_in = (const float*)INP(3); const float* wbd = (const float*)INP(6); const float* wbs = (const float*)INP(7); const float* wo = (const float*)INP(8);
    const bf16* YA = (const bf16*)(F.ws + WS_YA); const bf16* YB = (const bf16*)(F.ws + WS_YB); const bf16* PRE = (const bf16*)(F.ws + WS_PRE1);
    const int m = (int)(hash32((unsigned)F.vcu * 7919u + 3u) % (unsigned)NTOK);
    for (int c = F.tid; c < 1024; c += 512) { float ga = 0.f, gb = 0.f, pa = 0.f, pb = 0.f;
        for (int k = 0; k < 1024; ++k) { const float xv = bf2f((unsigned short)f2bf(x[(size_t)m * 1024 + k])); ga += xv * w_in[(size_t)k * WIN_OLD + 3656 + c]; gb += xv * w_in[(size_t)k * WIN_OLD + 4680 + c]; }
        for (int k = 0; k < 512; ++k) { pa += bf2f(YA[(size_t)m * 512 + k]) * wbd[(size_t)k * 1024 + c]; pb += bf2f(YB[(size_t)m * 512 + k]) * wbs[(size_t)k * 1024 + c]; }
        mg[c] = pa / (1.f + expf(-ga)) + pb / (1.f + expf(-gb)); }
    __syncthreads();
    for (int c = F.tid; c < 1024; c += 512) { float mix = 0.f; for (int k = 0; k < 1024; ++k) mix += mg[k] * wo[(size_t)k * 1024 + c];
        const float want = ALPHA * x[(size_t)m * 1024 + c] + mix, got = bf2f(PRE[(size_t)m * 1024 + c]);
        if (!close_to(got, want, 0.015f, 0.015f)) chk_fail(F, 0x300u); }
    __syncthreads();
}
__device__ __forceinline__ void chk_ffn(Frame& F) {
    LAS float* lgs = (LAS float*)(F.lds + RING_OFF);
    const bf16* X1 = (const bf16*)(F.ws + WS_XB); const float* wrg = (const float*)INP(11); const float* brg = (const float*)INP(12); const float* wre = (const float*)INP(13); const float* bre = (const float*)INP(14);
    const float* wg = (const float*)INP(15); const float* wu = (const float*)INP(16); const float* wd = (const float*)INP(17); const float* wple = (const float*)INP(18); const float* wpg = (const float*)INP(19); const float* p = (const float*)INP(1);
    const bf16* Y0 = (const bf16*)(F.ws + WS_Y0); const bf16* Y1 = (const bf16*)(F.ws + WS_Y1); const bf16* PLE = (const bf16*)(F.ws + WS_PLE);
    const int m = (int)(hash32((unsigned)F.vcu * 104729u + 11u) % (unsigned)NTOK);
    if (F.tid < 36) { float s = 0.f; for (int k = 0; k < 1024; ++k) s += bf2f(X1[(size_t)m * 1024 + k]) * (F.tid < 4 ? wrg[k * 4 + F.tid] : wre[k * 32 + F.tid - 4]); lgs[F.tid] = s + (F.tid < 4 ? brg[F.tid] : bre[F.tid - 4]); }
    __syncthreads();
    int gi = 0; for (int i = 1; i < 4; ++i) if (lgs[i] > lgs[gi]) gi = i;
    float gs = 0.f; for (int i = 0; i < 4; ++i) gs += expf(lgs[i] - lgs[gi]); const float gval = 1.f / gs;
    int i0 = 0; for (int k = 1; k < 8; ++k) if (lgs[4 + gi * 8 + k] > lgs[4 + gi * 8 + i0]) i0 = k;
    int i1 = (i0 == 0) ? 1 : 0; for (int k = 0; k < 8; ++k) if (k != i0 && lgs[4 + gi * 8 + k] > lgs[4 + gi * 8 + i1]) i1 = k;
    const float l0 = lgs[4 + gi * 8 + i0], l1 = lgs[4 + gi * 8 + i1], c0 = gval / (1.f + expf(l1 - l0)), c1 = gval - c0;
    __syncthreads();
    { const int sl = F.tid >> 8, f = F.tid & 255, e = gi * 8 + (sl ? i1 : i0); const float* G = wg + (size_t)e * 1024 * 256; const float* U = wu + (size_t)e * 1024 * 256; float g = 0.f, u = 0.f;
      for (int k = 0; k < 1024; ++k) { const float xv = bf2f(X1[(size_t)m * 1024 + k]); g += xv * G[(size_t)k * 256 + f]; u += xv * U[(size_t)k * 256 + f]; }
      lgs[64 + F.tid] = g / (1.f + expf(-g)) * u * (sl ? c1 : c0); }
    __syncthreads();
    for (int c = F.tid; c < 1024; c += 512) { float y = 0.f;
        for (int sl = 0; sl < 2; ++sl) { const int e = gi * 8 + (sl ? i1 : i0); const float* D = wd + (size_t)e * 256 * 1024; for (int f = 0; f < 256; ++f) y += lgs[64 + sl * 256 + f] * D[(size_t)f * 1024 + c]; }
        const float goty = bf2f(Y0[(size_t)m * 1024 + c]) + bf2f(Y1[(size_t)m * 1024 + c]);
        if (!close_to(goty, y, 0.03f, 0.004f)) chk_fail(F, 0x400u);
        float gt = 0.f, tp = 0.f; for (int k = 0; k < 1024; ++k) gt += bf2f(X1[(size_t)m * 1024 + k]) * wpg[(size_t)k * 1024 + c]; for (int k = 0; k < 256; ++k) tp += p[(size_t)m * 256 + k] * wple[(size_t)k * 1024 + c];
        const float wantp = tp / (1.f + expf(-gt)), gotp = bf2f(PLE[(size_t)m * 1024 + c]);
        if (!close_to(gotp, wantp, 0.03f, 0.01f)) chk_fail(F, 0x410u); }
    __syncthreads();
}
#endif

#ifndef PHSEL
#define PHSEL 0xFFF
#endif
#define PHON(k) (((PHSEL) >> (k)) & 1)
#ifndef DUP
#define DUP 0
#endif
#define DUPREP(k) for (int rep_ = 0; rep_ < (((DUP) >> (k)) & 1) + 1; ++rep_)
__global__ void __launch_bounds__(NWAVES * 64, 2) skel_fwd(Args args) {
    extern __shared__ __attribute__((aligned(16))) unsigned char lds[];
    Frame F;
    F.lds = (LAS unsigned char*)lds;
    F.MISC = (volatile LAS unsigned*)(F.lds + MISC_OFF);
    F.tid = threadIdx.x; F.lane = F.tid & 63; F.wave = __builtin_amdgcn_readfirstlane(F.tid >> 6);
    F.G = gridDim.x; F.bx = blockIdx.x; { const int bx = blockIdx.x; F.vcu = (F.G % 8 == 0) ? (bx % 8) * (F.G / 8) + bx / 8 : bx; }
    F.ws = F.ws0 = args.ws; F.out = F.out0 = args.out; F.ap = &args;
    F.ctl = (gu32*)(F.ws + WS_CTL);
    for (int u = F.tid; u < (MISC_OFF + 128 - XTR_OFF) / 4; u += NWAVES * 64) ((LAS unsigned*)(F.lds + XTR_OFF))[u] = 0u;
    __syncthreads();
#if MK_PER_PHASE
    XcdBarrier bar; bar.bar = (unsigned*)(F.ctl + CW_BAR); bar.x = 0; bar.st = nullptr;
#define GRID_BAR() do { if (F.tid == 0) __hip_atomic_store(F.ctl + CW_TMO, 0xBADBA0u, RLX_AGENT); } while (0)
#else
    XcdBarrier bar = xcd_barrier_post((unsigned*)(F.ctl + CW_BAR), F.MISC + 8);
#ifndef IDLEPROBE
#define IDLEPROBE 0
#endif
#if IDLEPROBE
#define GRID_BAR() do { const unsigned long long t0_ = rt(); xcd_barrier(bar); if (F.tid == 0) __hip_atomic_fetch_add(F.ctl + 12288 + seam_no, (unsigned)(rt() - t0_), RLX_AGENT); ++seam_no; } while (0)
#else
#define GRID_BAR() xcd_barrier(bar)
#endif
#endif
    const int lo = args.ph_lo, hi = args.ph_hi;
    int seam_no = 0; (void)seam_no;
#define IN(k) (lo <= (k) && (k) < hi)
#define SEAM(k) do { if (IN(k) && IN((k) + 1)) GRID_BAR(); } while (0)
#define PHASE_ENTER() { size_t zo_ = 0; asm volatile("" : "+s"(zo_)); F.ws = F.ws0 + zo_; F.out = F.out0 + zo_; } F.vcu = __builtin_amdgcn_readfirstlane(F.vcu); asm volatile("" : "+s"(F.vcu), "+s"(F.G), "+s"(F.bx)); asm volatile("" : "+s"(F.lds)); F.tid = ltid(F.wave); F.lane = F.tid & 63; unsigned char* const ws = F.ws; bf16* const XB = (bf16*)(ws + WS_XB); (void)XB
    for (int l = 0; l < DEPTH; ++l) {
        const int pb = l * NPH_LAYER;
        if (PHON(0) && IN(pb + 0)) DUPREP(0) { PHASE_ENTER(); pw_phase(F, l); }
        SEAM(pb + 0);
        if (PHON(1) && IN(pb + 1)) DUPREP(1) { PHASE_ENTER();
            pg8::Gemm g{XB, (const bf16*)(ws + WS_WB + WB_WIN), 1024, 1024, 1024, nullptr}; pg8::StaticOrder S; S.init(NTOK, P1_N, F.G, F.bx, 1024);
            pg8::EpiProj E{(bf16*)(ws + WS_DQ), TSTRIDE / 2, (bf16*)(ws + WS_IK), (float*)(ws + WS_IW), (const float*)(ws + WS_ROPE)};
            pg8::gemm_phase<pg8::EpiProj, pg8::StaticOrder, true>(F.lds + RING_OFF, g, S, E, F.wave);
            { pg8::Gemm g2{(const bf16*)(ws + WS_PB), (const bf16*)(ws + WS_WB + WB_WPLE), 256, 256, 256, nullptr};
                TailSched S2{(F.bx >= 128) ? (F.bx - 128) * 3 : 384 + F.bx, (F.bx >= 128) ? 3 : 1, 256L * 256};
                pg8::EpiStore E2{(bf16*)((unsigned char*)F.out + OUT_T1), 1024}; pg8::gemm_phase<pg8::EpiStore, TailSched, true>(F.lds + RING_OFF, g2, S2, E2, F.wave); }
        }
        SEAM(pb + 1);
        if (PHON(2) && IN(pb + 2)) DUPREP(2) { PHASE_ENTER();
            const bf16* IQ = (const bf16*)(ws + WS_DQ + 6 * TSTRIDE); const bf16* IK = (const bf16*)(ws + WS_IK); const float* IW = (const float*)(ws + WS_IW);
            for (int p = F.vcu; p < 256; p += F.G) { const int b = p >> 7, s = p & 127;
                unsigned long long* m32 = (unsigned long long*)(ws + WS_MASK) + (size_t)b * MASK_BSTRIDE;
                for (int k2 = 0; k2 < 2; ++k2) indexer_unit(F, b, k2 ? s : 255 - s, IQ, IK, IW, m32); }
        }
        SEAM(pb + 2);
        if (PHON(3) && IN(pb + 3)) DUPREP(3) { PHASE_ENTER();
            using attn_body::bf16;
            const bf16* DQ = (const bf16*)(ws + WS_DQ); const bf16* DK = (const bf16*)(ws + WS_DQ + TSTRIDE); const bf16* DV = (const bf16*)(ws + WS_DQ + 2 * TSTRIDE);
            LAS unsigned* qslot = (LAS unsigned*)(F.lds + MISC_OFF + 64);
            gu32* qctr = F.ctl + CW_QUEUE + l * 64;
            LAS unsigned* const badp = (LAS unsigned*)(F.lds + MISC_OFF + 80); constexpr int BADOFF = MISC_OFF + 80 - RING_OFF;
#define GRAB(ctr_, u_) do { __syncthreads(); if (F.tid == 0) { *qslot = __hip_atomic_fetch_add((ctr_), 1u, RLX_AGENT); *badp = 0u; } __syncthreads(); u_ = (int)*qslot; } while (0)
#ifndef DUPW
#define DUPW 0
#endif
            for (int dw_ = 0; dw_ <= DUPW; ++dw_)
            for (;;) { int u; GRAB(qctr + 8 * dw_, u); if (u >= 512) break;
                const int qb = 63 - (u >> 3), a = u & 7, b = a >> 2, h = a & 3;
#pragma unroll 1
                for (int c = 0; c < 2; ++c) {
                    bf16* O = (bf16*)(ws + (c ? WS_O1 : WS_O0));
                    attn_body::attn_unit<8, false, true, true>(b, 2 * h + c, 2 * h, qb, DQ, DK, DV, O, nullptr, (char*)lds + RING_OFF, F.wave, BADOFF);
#if !(CHK && MK_PER_PHASE)
                    if (*(volatile LAS unsigned*)badp) { __syncthreads(); if (F.tid == 0) *badp = 0u;
                        attn_body::attn_unit<8, false, true, false>(b, 2 * h + c, 2 * h, qb, DQ, DK, DV, O, nullptr, (char*)lds + RING_OFF, F.wave, BADOFF); }
#endif
                }
                VM_WAIT(); __syncthreads(); __builtin_amdgcn_fence(__ATOMIC_ACQUIRE, "agent");
                ya_unit(F, l, b, h, qb);
            }
            const bf16* SQ = (const bf16*)(ws + WS_DQ + 3 * TSTRIDE); const bf16* SK = (const bf16*)(ws + WS_DQ + 4 * TSTRIDE); const bf16* SV = (const bf16*)(ws + WS_DQ + 5 * TSTRIDE);
            attn_body::mask_table_init((char*)lds + RING_OFF, F.tid);
#ifndef DUPS
#define DUPS 0
#endif
            for (int ds_ = 0; ds_ <= DUPS; ++ds_)
            for (;;) { int u; GRAB(qctr + 32 + 8 * ds_, u); if (u >= 1024) break;
                const int qb = 63 - (u >> 4), a = u & 15, b = a >> 3, h = a & 7;
                const unsigned long long* MK = (const unsigned long long*)(ws + WS_MASK) + (size_t)b * MASK_BSTRIDE;
                attn_body::attn_unit<8, true, false, true>(b, h, h, qb, SQ, SK, SV, (bf16*)(ws + WS_YB), MK, (char*)lds + RING_OFF, F.wave, BADOFF);
#if !(CHK && MK_PER_PHASE)
                if (*(volatile LAS unsigned*)badp) attn_body::attn_unit<8, true, false, false>(b, h, h, qb, SQ, SK, SV, (bf16*)(ws + WS_YB), MK, (char*)lds + RING_OFF, F.wave, BADOFF);
#endif
                }
#undef GRAB
        }
        SEAM(pb + 3);
        if (PHON(5) && IN(pb + 5)) DUPREP(5) { PHASE_ENTER();
#define RELA() { size_t zo_ = 0; asm volatile("" : "+s"(zo_)); F.ws = F.ws0 + zo_; } unsigned char* const ws = F.ws; bf16* const XB = (bf16*)(ws + WS_XB); (void)XB; const bf16* WIN = (const bf16*)(ws + WS_WB + WB_WIN); bf16* MG = (bf16*)(ws + WS_MERGED); unsigned char* G1 = ws + WS_TMPG; unsigned char* G2 = ws + WS_TMPG + 32 * MiB; (void)WIN; (void)MG; (void)G1; (void)G2
            { RELA(); pg8::Gemm g{(const bf16*)((unsigned char*)F.out + OUT_XB8), (const bf16*)(ws + WS_WB + WB_WG8), 512, 512, 512, nullptr}; pg8::StaticOrder S; S.init(NTOK, 1024, F.G, F.bx, 512);
              pg8::EpiSig E{G1, 1024, 1.f / 64.f}; pg8::gemm_phase<pg8::EpiSig, pg8::StaticOrder, true, false, true>(F.lds + RING_OFF, g, S, E, F.wave); }
            { RELA(); pg8::Gemm g{(const bf16*)((unsigned char*)F.out + OUT_XB8), (const bf16*)(ws + WS_WB + WB_WG8 + (size_t)1024 * 1024), 512, 512, 512, nullptr}; pg8::StaticOrder S; S.init(NTOK, 1024, F.G, F.bx, 512);
              pg8::EpiSig E{G2, 1024, 1.f / 64.f}; pg8::gemm_phase<pg8::EpiSig, pg8::StaticOrder, true, false, true>(F.lds + RING_OFF, g, S, E, F.wave); }
            VM_WAIT(); __builtin_amdgcn_fence(__ATOMIC_ACQUIRE, "agent"); VM_WAIT();
            { RELA(); pg8::Gemm g{(const bf16*)(ws + WS_YA), (const bf16*)(ws + WS_WB + WB_WBD), 512, 512, 512, nullptr}; pg8::StaticOrder S; S.init(NTOK, 1024, F.G, F.bx, 512);
              pg8::EpiGatedT<false> E{G1, nullptr, MG, 1024}; pg8::gemm_phase<pg8::EpiGatedT<false>, pg8::StaticOrder, true>(F.lds + RING_OFF, g, S, E, F.wave); }
            VM_WAIT(); __builtin_amdgcn_fence(__ATOMIC_ACQUIRE, "agent"); VM_WAIT();
            { RELA(); pg8::Gemm g{(const bf16*)(ws + WS_YB), (const bf16*)(ws + WS_WB + WB_WBS), 512, 512, 512, nullptr}; pg8::StaticOrder S; S.init(NTOK, 1024, F.G, F.bx, 512);
              pg8::EpiGatedT<true> E{G2, MG, MG, 1024}; if (!(DBG & 4)) pg8::gemm_phase<pg8::EpiGatedT<true>, pg8::StaticOrder, true>(F.lds + RING_OFF, g, S, E, F.wave); }
        }
        SEAM(pb + 5);
        if (PHON(6) && IN(pb + 6)) DUPREP(6) { PHASE_ENTER();
            pg8::Gemm g{(const bf16*)(ws + WS_MERGED), (const bf16*)(ws + WS_WB + WB_WO), 1024, 1024, 1024, nullptr}; pg8::StaticOrder S; S.init(NTOK, 1024, F.G, F.bx, 1024);
            pg8::EpiResBf16 E{XB, (bf16*)(ws + WS_PRE1), ALPHA}; pg8::gemm_phase<pg8::EpiResBf16, pg8::StaticOrder, true>(F.lds + RING_OFF, g, S, E, F.wave);
        }
        SEAM(pb + 6);
        if (PHON(7) && IN(pb + 7)) DUPREP(7) { PHASE_ENTER(); ln1_router_phase(F, l); }
        SEAM(pb + 7);
        if (PHON(8) && IN(pb + 8)) DUPREP(8) { PHASE_ENTER(); lists_phase(F, l); }
        SEAM(pb + 8);
        if (PHON(9) && IN(pb + 9)) DUPREP(9) { PHASE_ENTER();
            const int T = build_tile_table(F);
            pg8::Gemm g{(const bf16*)((unsigned char*)F.out + OUT_X1B8), (const bf16*)(ws + WS_WB + WB_WGU), 512, 512, 512, (const int*)(ws + WS_ROUTE + RT_ROW)};
            GroupSched S{2 * T, F.G, F.vcu, 1, (const LAS int*)(F.lds + XTR_OFF), 512L * 512, 256L * 512};
            pg8::EpiGU E{(bf16*)(ws + WS_HG), (const float*)(ws + WS_ROUTE + RT_CW), 1.f / 64.f};
            pg8::gemm_phase<pg8::EpiGU, GroupSched, true, true, true>(F.lds + RING_OFF, g, S, E, F.wave);
        }
        SEAM(pb + 9);
        if (PHON(10) && IN(pb + 10)) DUPREP(10) { PHASE_ENTER();
            const int T = build_tile_table(F);
#ifndef P10SEL
#define P10SEL 7
#endif
            if (P10SEL & 1) { RELA(); pg8::Gemm g{(const bf16*)(ws + WS_HG), (const bf16*)(ws + WS_WB + WB_WD), 256, 256, 256, nullptr};
              GroupSched S{4 * T, F.G, F.vcu, 2, (const LAS int*)(F.lds + XTR_OFF), 1024L * 256, 256L * 256};
              pg8::EpiDown E{(const int*)(ws + WS_ROUTE + RT_ENT), (bf16*)(ws + WS_Y0), (unsigned)(WS_Y1 - WS_Y0)};
              pg8::gemm_phase<pg8::EpiDown, GroupSched, true>(F.lds + RING_OFF, g, S, E, F.wave); }
            if (P10SEL & 4) { RELA(); pg8::Gemm g{(const bf16*)((unsigned char*)F.out + OUT_X1B8), (const bf16*)(ws + WS_WB + WB_WPG), 512, 512, 512, nullptr}; pg8::StaticOrder S; S.init(NTOK, 1024, F.G, F.bx, 512);
              pg8::EpiPle E{(const bf16*)((unsigned char*)F.out + OUT_T1), (bf16*)(ws + WS_PLE), 1.f / 64.f}; pg8::gemm_phase<pg8::EpiPle, pg8::StaticOrder, true, false, true>(F.lds + RING_OFF, g, S, E, F.wave); }
        }
        SEAM(pb + 10);
        if (PHON(11) && IN(pb + 11)) DUPREP(11) { PHASE_ENTER(); ln2_phase(F, l); }
        if (l + 1 < DEPTH) SEAM(pb + 11);
    }
#if IDLEPROBE
    xcd_barrier(bar);
    if (blockIdx.x == 0 && F.tid == 0) { unsigned long long tot = 0; for (int k = 0; k < 23; ++k) if ((IDLEPROBE >> k) & 1) tot += __hip_atomic_load(F.ctl + 12288 + k, RLX_AGENT);
        const unsigned long long t0 = rt(), dur = tot / 256; while (rt() - t0 < dur) __builtin_amdgcn_s_sleep(8); }
#endif
#undef IN
#undef SEAM
}

#if CHK
__global__ void __launch_bounds__(NWAVES * 64, 2) chk_kernel(Args args, int which) {
    extern __shared__ __attribute__((aligned(16))) unsigned char lds[];
    Frame F;
    F.lds = (LAS unsigned char*)lds; F.MISC = (volatile LAS unsigned*)(F.lds + MISC_OFF);
    F.tid = threadIdx.x; F.lane = F.tid & 63; F.wave = __builtin_amdgcn_readfirstlane(F.tid >> 6);
    F.G = gridDim.x; F.bx = blockIdx.x; { const int bx = blockIdx.x; F.vcu = (F.G % 8 == 0) ? (bx % 8) * (F.G / 8) + bx / 8 : bx; }
    F.ws = F.ws0 = args.ws; F.out = F.out0 = args.out; F.ap = &args; F.ctl = (gu32*)(F.ws + WS_CTL);
    if (which == 1) chk_proj(F);
    if (which == 2) chk_attn(F);
    if (which == 4) chk_mask(F);
    if (which == 8) chk_pre1(F);
    if (which == 16) chk_ffn(F);
}
#endif
extern "C" void kernel_launch(void* const* d_in, const int* in_sizes, int n_in, void* d_out, int out_size, void* d_ws, size_t ws_size, hipStream_t stream) {
    static int grid = 0;
    if (grid == 0) {
        if (n_in != 22 || in_sizes[0] != NTOK * DMODEL || out_size != NTOK * DMODEL || ws_size < WS_END) { fprintf(stderr, "kernel_launch: unexpected problem geometry (n_in %d, ws %zu); nothing launched\n", n_in, ws_size); grid = -1; return; }
        int dev = 0, cus = 0, per_cu = 0;
        if (hipGetDevice(&dev) != hipSuccess || hipDeviceGetAttribute(&cus, hipDeviceAttributeMultiprocessorCount, dev) != hipSuccess) { grid = -1; return; }
        if (hipFuncSetAttribute((const void*)skel_fwd, hipFuncAttributeMaxDynamicSharedMemorySize, LDS_BYTES) != hipSuccess) { fprintf(stderr, "kernel_launch: hipFuncSetAttribute failed\n"); grid = -1; return; }
        if (hipOccupancyMaxActiveBlocksPerMultiprocessor(&per_cu, (const void*)skel_fwd, NWAVES * 64, LDS_BYTES) != hipSuccess || per_cu < 1) { fprintf(stderr, "kernel_launch: occupancy query reports %d\n", per_cu); }
        (void)hipGetLastError();
        if (cus < 256) { fprintf(stderr, "kernel_launch: needs 256 CUs (got %d)\n", cus); grid = -1; return; }
        grid = 256;
    }
    if (grid < 0) return;
    if (hipMemsetAsync((char*)d_ws + WS_CTL, 0, CTL_ZERO_BYTES, stream) != hipSuccess) return;
    Args a{};
    for (int i = 0; i < 22; ++i) a.in[i] = d_in[i];
    a.out = (float*)d_out; a.ws = (unsigned char*)d_ws;
#if MK_PER_PHASE
    for (int ph = 0; ph < NPHASE; ++ph) { a.ph_lo = ph; a.ph_hi = ph + 1; hipLaunchKernelGGL(skel_fwd, dim3(grid), dim3(NWAVES * 64), LDS_BYTES, stream, a);
#if CHK
        static bool chk_set = false; if (!chk_set) { (void)hipFuncSetAttribute((const void*)chk_kernel, hipFuncAttributeMaxDynamicSharedMemorySize, LDS_BYTES); chk_set = true; }
        if (ph == 1 && (CHK & 1)) hipLaunchKernelGGL(chk_kernel, dim3(grid), dim3(NWAVES * 64), LDS_BYTES, stream, a, 1);
        if (ph == 3 && (CHK & 2)) hipLaunchKernelGGL(chk_kernel, dim3(grid), dim3(NWAVES * 64), LDS_BYTES, stream, a, 2);
        if (ph == 3 && (CHK & 4)) hipLaunchKernelGGL(chk_kernel, dim3(grid), dim3(NWAVES * 64), LDS_BYTES, stream, a, 4);
        if (ph == 6 && (CHK & 8)) hipLaunchKernelGGL(chk_kernel, dim3(grid), dim3(NWAVES * 64), LDS_BYTES, stream, a, 8);
        if (ph == 10 && (CHK & 16)) hipLaunchKernelGGL(chk_kernel, dim3(grid), dim3(NWAVES * 64), LDS_BYTES, stream, a, 16);
#endif
    }
#else
    a.ph_lo = 0; a.ph_hi = NPHASE;
    hipLaunchKernelGGL(skel_fwd, dim3(grid), dim3(NWAVES * 64), LDS_BYTES, stream, a);
#endif
}
```

```cpp
#include <hip/hip_runtime.h>
#include <hip/hip_bf16.h>
#include <cstdio>
#include <cstdint>
#include <cmath>

__device__ __forceinline__ int ltid(int wave) { int l; asm volatile("v_mbcnt_lo_u32_b32 %0, -1, 0\n\tv_mbcnt_hi_u32_b32 %0, -1, %0" : "=v"(l)); return (wave << 6) | l; }

namespace pg8 {
#define PG8_LAS __attribute__((address_space(3)))
typedef unsigned short bf16_t;
typedef short bf16x8 __attribute__((ext_vector_type(8)));
typedef float f32x4 __attribute__((ext_vector_type(4)));
typedef unsigned u32x4 __attribute__((ext_vector_type(4)));
typedef int i32x4_t __attribute__((ext_vector_type(4)));
typedef int i32x8_t __attribute__((ext_vector_type(8)));
constexpr int BM = 256, BK = 64, HALF = 128, HTB = HALF * BK * 2  , STAGE_BYTES = 8 * HTB, NXCD = 8, WGM = 8;
constexpr float C2 = 0.125f * 1.4426950408889634f;

__host__ __device__ __forceinline__ int lds_byte(int r, int c) { const int st = (r >> 4) * 2 + (c >> 5), rr = r & 15, cc = c & 31, ob = rr * 64 + cc * 2; return st * 1024 + (ob ^ (((ob >> 9) & 1) << 5)); }
__host__ __device__ __forceinline__ void stage_rc(int b, int& R, int& C) { const int st = b / 1024, sb = b % 1024, swz = sb ^ (((sb >> 9) & 1) << 5); R = (st >> 1) * 16 + swz / 64; C = (st & 1) * 32 + (swz % 64) / 2; }
__host__ __device__ __forceinline__ int perm32(int rho) { const int n = rho >> 4, i = rho & 15; return 8 * (i >> 2) + 4 * n + (i & 3); }

struct Unit { int pm, pn; long boff; };
struct Gemm { const bf16_t* A; const bf16_t* Bt; int K, lda, ldb; const int* rows; };

struct StaticOrder {
    int nM, nN, nwg, G, c, ldb;
    __device__ void init(int M, int N, int G_, int c_, int ldb_) { nM = M / BM; nN = N / BM; nwg = nM * nN; G = G_; c = c_; ldb = ldb_; }
    __device__ bool next(int i, Unit& u) const {
        const long L = (long)i * G + c; if (L >= nwg) return false;
        int wgid = (int)L; { const int q = nwg / NXCD, r = nwg % NXCD, xcd = wgid % NXCD, off = wgid / NXCD; wgid = (xcd < r ? xcd * (q + 1) : r * (q + 1) + (xcd - r) * q) + off; }
        const int nig = WGM * nN, gid = wgid / nig, fm = gid * WGM, gsz = (nM - fm) < WGM ? (nM - fm) : WGM;
        u.pm = fm + ((wgid % nig) % gsz); u.pn = (wgid % nig) / gsz; u.boff = (long)u.pn * BM * ldb; return true;
    }
};

__device__ __forceinline__ unsigned cvt_pk_bf16(float lo, float hi) { unsigned r; asm volatile("v_cvt_pk_bf16_f32 %0, %1, %2" : "=v"(r) : "v"(lo), "v"(hi)); return r; }
__device__ __forceinline__ float bf_lo(unsigned w) { return __uint_as_float(w << 16); }
__device__ __forceinline__ float bf_hi(unsigned w) { return __uint_as_float(w & 0xffff0000u); }
__device__ __forceinline__ float sigm(float x) { return __builtin_amdgcn_rcpf(1.f + __builtin_amdgcn_exp2f(-1.4426950408889634f * x)); }
__device__ __forceinline__ u32x4 pack8(f32x4 a, f32x4 b) { u32x4 w; w.x = cvt_pk_bf16(a[0], a[1]); w.y = cvt_pk_bf16(a[2], a[3]); w.z = cvt_pk_bf16(b[0], b[1]); w.w = cvt_pk_bf16(b[2], b[3]); return w; }
__device__ __forceinline__ void unpack8(u32x4 w, f32x4& a, f32x4& b) { a = (f32x4){bf_lo(w.x), bf_hi(w.x), bf_lo(w.y), bf_hi(w.y)}; b = (f32x4){bf_lo(w.z), bf_hi(w.z), bf_lo(w.w), bf_hi(w.w)}; }

#define PG8_EPI_ARGS const f32x4 (&acc)[2][2][4][2], const Unit& u, int wr, int wc, int fr, int fq

#define PG8_PIN(x) asm volatile("" : "+v"(x))
template <class T> __device__ __forceinline__ T& at(const void* base, unsigned byteoff) { return *(T*)((char*)base + byteoff); }

__device__ __forceinline__ float xor16(float v, int fq) { const auto r = __builtin_amdgcn_permlane16_swap(__float_as_uint(v), __float_as_uint(v), false, false); return __uint_as_float((fq & 1) ? r[0] : r[1]); }
struct EpiProj {
    bf16_t* base; size_t tstride; bf16_t* IK; float* IW; const float* rope;
    __device__ __forceinline__ void operator()(PG8_EPI_ARGS) const {
        const int pn = u.pn, row0 = u.pm * BM + wr * 64 + fr;
        if (pn < 14) {
            const int t = pn >> 1;
            bf16_t* dst = base + (size_t)t * tstride;
            const bool rp = (t == 0) | (t == 1) | (t == 3) | (t == 4) | (t == 6);
            const float sc = (t == 0 || t == 3) ? C2 : (t == 6 ? 0.125f : 1.f);
            const bool rotw = rp && ((wc & 1) == 0);
            const unsigned cb = (unsigned)((pn & 1) * 256 + wc * 32 + 8 * fq) * 2u;
            constexpr int RB = 2; f32x4 rq[RB][4];
#define PG8_RP_LD(it) do { if (rotw) { unsigned r_ = (unsigned)(row0 + ((it) >> 2) * HALF + ((it) & 3) * 16); PG8_PIN(r_); \
                rq[(it) % RB][0] = at<const f32x4>(rope, r_ * 64u); rq[(it) % RB][1] = at<const f32x4>(rope, r_ * 64u + 16u); rq[(it) % RB][2] = at<const f32x4>(rope, r_ * 64u + 32u); rq[(it) % RB][3] = at<const f32x4>(rope, r_ * 64u + 48u); } } while (0)
#pragma unroll
            for (int it = 0; it < RB; ++it) PG8_RP_LD(it);
#pragma unroll
            for (int ai = 0; ai < 2; ++ai)
#pragma unroll
                for (int m = 0; m < 4; ++m) { const int it = ai * 4 + m;
                    unsigned row = (unsigned)(row0 + ai * HALF + m * 16); PG8_PIN(row);
                    f32x4 c0 = {1.f, 1.f, 1.f, 1.f}, c1 = c0, s0 = {0.f, 0.f, 0.f, 0.f}, s1 = s0;
                    if (rotw) { c0 = rq[it % RB][0]; c1 = rq[it % RB][1]; s0 = rq[it % RB][2]; s1 = rq[it % RB][3]; }
                    if (it + RB < 8) PG8_RP_LD(it + RB);
#pragma unroll
                    for (int bj = 0; bj < 2; ++bj) {
                        f32x4 v0 = acc[ai][bj][m][0], v1 = acc[ai][bj][m][1];
                        if (rotw) {
                            f32x4 p0, p1;
#pragma unroll
                            for (int i = 0; i < 4; ++i) { p0[i] = xor16(v0[i], fq); p1[i] = xor16(v1[i], fq); }
                            const float sg = (fq == 0) ? -1.f : 1.f;
                            const f32x4 r0 = v0 * c0 + (p0 * s0) * sg, r1 = v1 * c1 + (p1 * s1) * sg;
                            if (fq < 2) { v0 = r0; v1 = r1; }
                        }
                        v0 = v0 * sc; v1 = v1 * sc;
                        at<u32x4>(dst, row * 1024u + cb + bj * 256u) = pack8(v0, v1);
                    }
                    asm volatile("" ::: "memory");
                }
#undef PG8_RP_LD
        } else {
#pragma unroll
            for (int ai = 0; ai < 2; ++ai)
#pragma unroll
                for (int m = 0; m < 4; ++m) {
                    unsigned row = (unsigned)(row0 + ai * HALF + m * 16); PG8_PIN(row);
                    f32x4 v0 = acc[ai][0][m][0], v1 = acc[ai][0][m][1];
                    if (wc == 0) {
                        const f32x4 c0 = at<const f32x4>(rope, row * 64u), c1 = at<const f32x4>(rope, row * 64u + 16u), s0 = at<const f32x4>(rope, row * 64u + 32u), s1 = at<const f32x4>(rope, row * 64u + 48u);
                        f32x4 p0, p1;
#pragma unroll
                        for (int i = 0; i < 4; ++i) { p0[i] = xor16(v0[i], fq); p1[i] = xor16(v1[i], fq); }
                        const float sg = (fq == 0) ? -1.f : 1.f;
                        const f32x4 r0 = v0 * c0 + (p0 * s0) * sg, r1 = v1 * c1 + (p1 * s1) * sg;
                        if (fq < 2) { v0 = r0; v1 = r1; }
                    }
                    if (wc < 2) at<u32x4>(IK, row * 128u + (unsigned)(wc * 32 + 8 * fq) * 2u) = pack8(v0, v1);
                    else if (wc == 2 && fq == 0) { at<f32x4>(IW, row * 32u) = v0 * 0.35355339059f; at<f32x4>(IW, row * 32u + 16u) = v1 * 0.35355339059f; }
                    asm volatile("" ::: "memory");
                }
        }
    }
};
struct EpiSig {
    unsigned char* out; int ldc; float pre;
    __device__ __forceinline__ void operator()(PG8_EPI_ARGS) const {
        const unsigned o0 = (unsigned)(u.pm * BM + wr * 64 + fr) * 1024u + (unsigned)(u.pn * BM + wc * 32 + 8 * fq);
#pragma unroll
        for (int ai = 0; ai < 2; ++ai)
#pragma unroll
            for (int m = 0; m < 4; ++m) {
                unsigned o = o0 + (unsigned)(ai * HALF + m * 16) * 1024u; PG8_PIN(o);
#pragma unroll
                for (int bj = 0; bj < 2; ++bj) {
                    const f32x4 v0 = acc[ai][bj][m][0], v1 = acc[ai][bj][m][1];
                    unsigned w0 = 0u, w1 = 0u;
#pragma unroll
                    for (int i = 0; i < 4; ++i) { w0 = __builtin_amdgcn_cvt_pk_u8_f32(sigm(v0[i] * pre) * 255.f, i, w0); w1 = __builtin_amdgcn_cvt_pk_u8_f32(sigm(v1[i] * pre) * 255.f, i, w1); }
                    at<unsigned long long>(out, o + bj * 128u) = (unsigned long long)w0 | ((unsigned long long)w1 << 32);
                }
                asm volatile("" ::: "memory");
            }
    }
};
template <bool ADD>
struct EpiGatedT {
    const unsigned char* gate; const bf16_t* addsrc; bf16_t* out; int ldc;
    __device__ __forceinline__ void operator()(PG8_EPI_ARGS) const {
        const unsigned o0 = ((unsigned)(u.pm * BM + wr * 64 + fr) * 1024u + (unsigned)(u.pn * BM + wc * 32 + 8 * fq)) * 2u;
        constexpr int NB = ADD ? 4 : 8;
        unsigned long long gq[NB][2]; u32x4 aq[ADD ? NB : 1][2];
#define PG8_GT_LD(it) do { unsigned o_ = o0 + (unsigned)(((it) >> 2) * HALF + ((it) & 3) * 16) * 2048u; PG8_PIN(o_); \
            gq[(it) % NB][0] = at<const unsigned long long>(gate, o_ >> 1); gq[(it) % NB][1] = at<const unsigned long long>(gate, (o_ >> 1) + 128u); \
            if constexpr (ADD) { aq[(it) % NB][0] = at<const u32x4>(addsrc, o_); aq[(it) % NB][1] = at<const u32x4>(addsrc, o_ + 256u); } } while (0)
#pragma unroll
        for (int it = 0; it < NB; ++it) PG8_GT_LD(it);
#pragma unroll
        for (int it = 0; it < 8; ++it) { const int ai = it >> 2, m = it & 3;
                unsigned o = o0 + (unsigned)(ai * HALF + m * 16) * 2048u; PG8_PIN(o);
                f32x4 v0[2], v1[2];
#pragma unroll
                for (int bj = 0; bj < 2; ++bj) {
                    const unsigned long long gw = gq[it % NB][bj]; const unsigned glo = (unsigned)gw, ghi = (unsigned)(gw >> 32); constexpr float K8 = 1.f / 255.f;
                    const f32x4 g0 = {(float)(glo & 0xffu) * K8, (float)((glo >> 8) & 0xffu) * K8, (float)((glo >> 16) & 0xffu) * K8, (float)(glo >> 24) * K8};
                    const f32x4 g1 = {(float)(ghi & 0xffu) * K8, (float)((ghi >> 8) & 0xffu) * K8, (float)((ghi >> 16) & 0xffu) * K8, (float)(ghi >> 24) * K8};
                    v0[bj] = acc[ai][bj][m][0] * g0; v1[bj] = acc[ai][bj][m][1] * g1;
                    if constexpr (ADD) { f32x4 a0, a1; unpack8(aq[it % NB][bj], a0, a1); v0[bj] = v0[bj] + a0; v1[bj] = v1[bj] + a1; }
                }
                if (it + NB < 8) PG8_GT_LD(it + NB);
#pragma unroll
                for (int bj = 0; bj < 2; ++bj) at<u32x4>(out, o + bj * 256u) = pack8(v0[bj], v1[bj]);
                asm volatile("" ::: "memory");
            }
#undef PG8_GT_LD
    }
};
struct EpiResBf16 {
    const bf16_t* x; bf16_t* out; float alpha;
    __device__ __forceinline__ void operator()(PG8_EPI_ARGS) const {
        const unsigned o0 = ((unsigned)(u.pm * BM + wr * 64 + fr) * 1024u + (unsigned)(u.pn * BM + wc * 32 + 8 * fq)) * 2u;
        u32x4 xq[8][2];
#define PG8_X_LD(buf, it) do { unsigned o_ = o0 + (unsigned)(((it) >> 2) * HALF + ((it) & 3) * 16) * 2048u; PG8_PIN(o_); \
            xq[buf][0] = at<const u32x4>(x, o_); xq[buf][1] = at<const u32x4>(x, o_ + 256u); } while (0)
#pragma unroll
        for (int it = 0; it < 8; ++it) PG8_X_LD(it, it);
#pragma unroll
        for (int it = 0; it < 8; ++it) { const int ai = it >> 2, m = it & 3;
                unsigned o = o0 + (unsigned)(ai * HALF + m * 16) * 2048u; PG8_PIN(o);
#pragma unroll
                for (int bj = 0; bj < 2; ++bj) { f32x4 x0, x1; unpack8(xq[it][bj], x0, x1);
                    at<u32x4>(out, o + bj * 256u) = pack8(x0 * alpha + acc[ai][bj][m][0], x1 * alpha + acc[ai][bj][m][1]); }
                asm volatile("" ::: "memory");
            }
#undef PG8_X_LD
    }
};
struct EpiGU {
    bf16_t* HG; const float* cw; float pre;
    __device__ __forceinline__ void operator()(PG8_EPI_ARGS) const {
        const int row0 = u.pm * BM + wr * 64 + fr; const unsigned cb = (unsigned)(u.pn * HALF + wc * 32 + 8 * fq) * 2u;
        float cv[8];
#pragma unroll
        for (int it = 0; it < 8; ++it) cv[it] = at<const float>(cw, (unsigned)(row0 + (it >> 2) * HALF + (it & 3) * 16) * 4u);
#pragma unroll
        for (int it = 0; it < 8; ++it) { const int ai = it >> 2, m = it & 3;
                unsigned row = (unsigned)(row0 + ai * HALF + m * 16); PG8_PIN(row);
                const float c = cv[it];
                f32x4 g0 = acc[ai][0][m][0] * pre, g1 = acc[ai][0][m][1] * pre; const f32x4 u0 = acc[ai][1][m][0] * pre, u1 = acc[ai][1][m][1] * pre;
#pragma unroll
                for (int i = 0; i < 4; ++i) { g0[i] = g0[i] * sigm(g0[i]) * u0[i] * c; g1[i] = g1[i] * sigm(g1[i]) * u1[i] * c; }
                at<u32x4>(HG, row * 512u + cb) = pack8(g0, g1);
                asm volatile("" ::: "memory");
            }
    }
};
struct EpiDown {
    const int* ent; bf16_t* Y0; unsigned ystride;
    __device__ __forceinline__ void operator()(PG8_EPI_ARGS) const {
        const int row0 = u.pm * BM + wr * 64 + fr; const unsigned cb = (unsigned)(u.pn * BM + wc * 32 + 8 * fq) * 2u;
        int ev[8];
#pragma unroll
        for (int it = 0; it < 8; ++it) ev[it] = at<const int>(ent, (unsigned)(row0 + (it >> 2) * HALF + (it & 3) * 16) * 4u);
#pragma unroll
        for (int it = 0; it < 8; ++it) { const int ai = it >> 2, m = it & 3; const int e = ev[it];
                if (e >= 0) { unsigned o = (unsigned)(e >> 1) * 2048u + cb + (unsigned)(e & 1) * ystride; PG8_PIN(o);
#pragma unroll
                    for (int bj = 0; bj < 2; ++bj) at<u32x4>(Y0, o + bj * 256u) = pack8(acc[ai][bj][m][0], acc[ai][bj][m][1]); }
                asm volatile("" ::: "memory");
            }
    }
};
struct EpiStore {
    bf16_t* out; int ldc;
    __device__ __forceinline__ void operator()(PG8_EPI_ARGS) const {
        const unsigned o0 = ((unsigned)(u.pm * BM + wr * 64 + fr) * 1024u + (unsigned)(u.pn * BM + wc * 32 + 8 * fq)) * 2u;
#pragma unroll
        for (int ai = 0; ai < 2; ++ai)
#pragma unroll
            for (int m = 0; m < 4; ++m) {
                unsigned o = o0 + (unsigned)(ai * HALF + m * 16) * 2048u; PG8_PIN(o);
#pragma unroll
                for (int bj = 0; bj < 2; ++bj) at<u32x4>(out, o + bj * 256u) = pack8(acc[ai][bj][m][0], acc[ai][bj][m][1]);
                asm volatile("" ::: "memory");
            }
    }
};
struct EpiPle {
    const bf16_t* t1; bf16_t* out; float pre;
    __device__ __forceinline__ void operator()(PG8_EPI_ARGS) const {
        const unsigned o0 = ((unsigned)(u.pm * BM + wr * 64 + fr) * 1024u + (unsigned)(u.pn * BM + wc * 32 + 8 * fq)) * 2u;
        u32x4 tq[8][2];
#define PG8_T_LD(buf, it) do { unsigned o_ = o0 + (unsigned)(((it) >> 2) * HALF + ((it) & 3) * 16) * 2048u; PG8_PIN(o_); \
            tq[buf][0] = at<const u32x4>(t1, o_); tq[buf][1] = at<const u32x4>(t1, o_ + 256u); } while (0)
#pragma unroll
        for (int it = 0; it < 8; ++it) PG8_T_LD(it, it);
#pragma unroll
        for (int it = 0; it < 8; ++it) { const int ai = it >> 2, m = it & 3;
                unsigned o = o0 + (unsigned)(ai * HALF + m * 16) * 2048u; PG8_PIN(o);
#pragma unroll
                for (int bj = 0; bj < 2; ++bj) {
                    f32x4 t0, t1v; unpack8(tq[it][bj], t0, t1v);
                    f32x4 v0 = acc[ai][bj][m][0], v1 = acc[ai][bj][m][1];
#pragma unroll
                    for (int i = 0; i < 4; ++i) { v0[i] = sigm(v0[i] * pre) * t0[i]; v1[i] = sigm(v1[i] * pre) * t1v[i]; }
                    at<u32x4>(out, o + bj * 256u) = pack8(v0, v1);
                }
                asm volatile("" ::: "memory");
            }
#undef PG8_T_LD
    }
};

template <class Epi, class Sched, bool ALIGN_EPI, bool GATHER = false, bool FP8 = false>
__device__ __forceinline__ void gemm_phase(PG8_LAS unsigned char* lds, const Gemm g, const Sched& S, const Epi& E, int wave_in) {
    const int tid = ltid(wave_in), wid = __builtin_amdgcn_readfirstlane(tid >> 6), lane = tid & 63, wr = wid >> 2, wc = wid & 3, fr = lane & 15, fq = lane >> 4;
    int K_ = g.K; asm volatile("" : "+s"(K_));
    const int K = K_, nt = K / BK;
    int RA[2], CA[2]; unsigned voffB[2], voffA[2];
#pragma unroll
    for (int i = 0; i < 2; ++i) { int R, C; stage_rc(tid * 16 + i * 8192, R, C); const int Rb = (R & ~31) + perm32(R & 31); RA[i] = R; CA[i] = C; voffB[i] = (unsigned)(Rb * g.ldb + C) * 2u; voffA[i] = (unsigned)(R * g.lda + C) * 2u; }
    const size_t hstepA = (size_t)HALF * g.lda * 2;
    const size_t kstep = (size_t)(BK * 2);
    const size_t hstepB = (size_t)HALF * g.ldb * 2;
    const unsigned ldsw = (unsigned)wid * 1024u;
    const int aoff = lds_byte(wr * 64 + fr, fq * 8), boff = lds_byte(wc * 32 + fr, fq * 8);
    const char* Ab = (const char*)g.A;
#define PG8_SA(b, h) (((b) * 2 + (h)) * HTB)
#define PG8_SB(b, h) ((4 + (b) * 2 + (h)) * HTB)
#define PG8_STAGE_A(bufoff, kb, OFF, h) do { _Pragma("unroll") for (int _i = 0; _i < 2; ++_i) { const char* _p; \
        if constexpr (GATHER) _p = Ab + (kb) + (OFF##_v)[h][_i]; else _p = Ab + ((kb) + (OFF##_u) + (size_t)(h) * hstepA) + voffA[_i]; \
        __builtin_amdgcn_global_load_lds((const unsigned*)_p, (PG8_LAS unsigned*)(lds + (bufoff) + ldsw + _i * 8192), 16, 0, 0); } } while (0)
#define PG8_STAGE_B(bufoff, gbase) do { _Pragma("unroll") for (int _i = 0; _i < 2; ++_i) \
        __builtin_amdgcn_global_load_lds((const unsigned*)((const char*)(gbase) + voffB[_i]), (PG8_LAS unsigned*)(lds + (bufoff) + ldsw + _i * 8192), 16, 0, 0); } while (0)
#define PG8_MKOFF(uu, OFF) do { if constexpr (GATHER) { _Pragma("unroll") for (int _h = 0; _h < 2; ++_h) _Pragma("unroll") for (int _i = 0; _i < 2; ++_i) { \
        const int _row = g.rows[(uu).pm * BM + _h * HALF + RA[_i]]; (OFF##_v)[_h][_i] = (unsigned)(_row * g.lda + CA[_i]) * 2u; } } else { OFF##_u = (size_t)(uu).pm * BM * g.lda * 2; } } while (0)
#define PG8_LDA(dst, b, h) do { _Pragma("unroll") for (int m = 0; m < 4; ++m) { if constexpr (FP8) { dst##8[m].lo = *(const PG8_LAS i32x4_t*)(lds + PG8_SA(b, h) + aoff + m * 2048); dst##8[m].hi = *(const PG8_LAS i32x4_t*)(lds + PG8_SA(b, h) + aoff + m * 2048 + 1024); } \
        else { _Pragma("unroll") for (int k = 0; k < 2; ++k) dst[m][k] = *(const PG8_LAS bf16x8*)(lds + PG8_SA(b, h) + aoff + m * 2048 + k * 1024); } } } while (0)
#define PG8_LDB(dst, b, h) do { _Pragma("unroll") for (int n = 0; n < 2; ++n) { if constexpr (FP8) { dst##8[n].lo = *(const PG8_LAS i32x4_t*)(lds + PG8_SB(b, h) + boff + n * 2048); dst##8[n].hi = *(const PG8_LAS i32x4_t*)(lds + PG8_SB(b, h) + boff + n * 2048 + 1024); } \
        else { _Pragma("unroll") for (int k = 0; k < 2; ++k) dst[n][k] = *(const PG8_LAS bf16x8*)(lds + PG8_SB(b, h) + boff + n * 2048 + k * 1024); } } } while (0)
#define PG8_MMA(ai, bj, At, Bt) do { __builtin_amdgcn_s_setprio(1); \
        if constexpr (FP8) { _Pragma("unroll") for (int m = 0; m < 4; ++m) _Pragma("unroll") for (int n = 0; n < 2; ++n) \
            asm volatile("v_mfma_f32_16x16x128_f8f6f4 %0, %1, %2, %0" : "+v"(acc[ai][bj][m][n]) : "v"(Bt##8[n]), "v"(At##8[m])); }   \
        else { _Pragma("unroll") for (int m = 0; m < 4; ++m) _Pragma("unroll") for (int n = 0; n < 2; ++n) _Pragma("unroll") for (int k = 0; k < 2; ++k) \
            acc[ai][bj][m][n] = __builtin_amdgcn_mfma_f32_16x16x32_bf16(Bt[n][k], At[m][k], acc[ai][bj][m][n], 0, 0, 0); } __builtin_amdgcn_s_setprio(0); } while (0)
#define PG8_WAIT_V(n) asm volatile("s_waitcnt vmcnt(" #n ")" ::: "memory")
#define PG8_WAIT_L(n) asm volatile("s_waitcnt lgkmcnt(" #n ")" ::: "memory")
#define PG8_BAR __builtin_amdgcn_s_barrier()
#define PG8_SCHED __builtin_amdgcn_sched_barrier(0)
    Unit cur, nxt; int ui = 0;
    if (!S.next(0, cur)) return;
    f32x4 acc[2][2][4][2];
#pragma unroll
    for (int a = 0; a < 2; ++a)
#pragma unroll
        for (int b = 0; b < 2; ++b)
#pragma unroll
            for (int m = 0; m < 4; ++m)
#pragma unroll
                for (int n = 0; n < 2; ++n) acc[a][b][m][n] = (f32x4){0.f, 0.f, 0.f, 0.f};
    bf16x8 At[4][2], B0[2][2], B1[2][2];
    i32x8_t At8[4], B08[2], B18[2];
    unsigned offAc_v[2][2], offAn_v[2][2]; size_t offAc_u = 0, offAn_u = 0;
    PG8_MKOFF(cur, offAc);
    const char* cB = (const char*)(g.Bt + cur.boff);
    PG8_STAGE_B(PG8_SB(0, 0), cB); PG8_STAGE_B(PG8_SB(0, 1), cB + hstepB); PG8_STAGE_A(PG8_SA(0, 0), 0, offAc, 0); PG8_STAGE_A(PG8_SA(0, 1), 0, offAc, 1);
    if (wr == 1) PG8_BAR;
    PG8_WAIT_V(2); PG8_BAR;
    PG8_STAGE_B(PG8_SB(1, 0), cB + kstep); PG8_STAGE_A(PG8_SA(1, 0), kstep, offAc, 0); PG8_STAGE_B(PG8_SB(1, 1), cB + hstepB + kstep);
    PG8_WAIT_V(6); PG8_BAR;
    for (;;) {
        const bool has_next = S.next(ui + 1, nxt);
        if (has_next) { PG8_MKOFF(nxt, offAn); }
        else { offAn_u = offAc_u;
#pragma unroll
            for (int h = 0; h < 2; ++h)
#pragma unroll
                for (int i = 0; i < 2; ++i) offAn_v[h][i] = offAc_v[h][i];
        }
        const char* nB = has_next ? (const char*)(g.Bt + nxt.boff) : cB;
        for (int t = 0; t < nt; t += 2) {
            const bool last = (t == nt - 2);
            const size_t a1k = (size_t)(t + 1) * kstep;
            const size_t a2k = last ? (size_t)0 : (size_t)(t + 2) * kstep; const char* b2 = last ? nB : cB + (size_t)(t + 2) * kstep;
            const size_t a3k = a2k + kstep; const char* b3 = b2 + kstep;
            unsigned o2_v[2][2]; const size_t o2_u = last ? offAn_u : offAc_u;
#pragma unroll
            for (int h = 0; h < 2; ++h)
#pragma unroll
                for (int i = 0; i < 2; ++i) o2_v[h][i] = last ? offAn_v[h][i] : offAc_v[h][i];
            PG8_LDB(B0, 0, 0); PG8_LDB(B1, 0, 1); PG8_SCHED; PG8_LDA(At, 0, 0); PG8_STAGE_A(PG8_SA(1, 1), a1k, offAc, 1);
            PG8_WAIT_V(8); PG8_WAIT_L(0); PG8_BAR; PG8_MMA(0, 0, At, B0); PG8_MMA(0, 1, At, B1); PG8_BAR; PG8_SCHED;
            PG8_LDA(At, 0, 1); PG8_STAGE_B(PG8_SB(0, 0), b2); PG8_STAGE_B(PG8_SB(0, 1), b2 + hstepB); PG8_STAGE_A(PG8_SA(0, 0), a2k, o2, 0);
            PG8_WAIT_V(8); PG8_WAIT_L(0); PG8_BAR; PG8_MMA(1, 0, At, B0); PG8_MMA(1, 1, At, B1); PG8_BAR; PG8_SCHED;
            PG8_LDB(B0, 1, 0); PG8_LDB(B1, 1, 1); PG8_SCHED; PG8_LDA(At, 1, 0); PG8_STAGE_A(PG8_SA(0, 1), a2k, o2, 1);
            PG8_WAIT_V(8); PG8_WAIT_L(0); PG8_BAR; PG8_MMA(0, 0, At, B0); PG8_MMA(0, 1, At, B1); PG8_BAR; PG8_SCHED;
            PG8_LDA(At, 1, 1); PG8_STAGE_B(PG8_SB(1, 0), b3); PG8_STAGE_B(PG8_SB(1, 1), b3 + hstepB); PG8_STAGE_A(PG8_SA(1, 0), a3k, o2, 0);
            PG8_WAIT_V(8); PG8_WAIT_L(0); PG8_BAR; PG8_MMA(1, 0, At, B0); PG8_MMA(1, 1, At, B1); PG8_BAR; PG8_SCHED;
        }
        if constexpr (ALIGN_EPI) { if (wr == 0) PG8_BAR; }
        if constexpr (FP8) asm volatile("s_nop 15\n\ts_nop 15\n\ts_nop 7" ::: "memory");
        E(acc, cur, wr, wc, fr, fq);
        if (!has_next) break;
#pragma unroll
        for (int a = 0; a < 2; ++a)
#pragma unroll
            for (int b = 0; b < 2; ++b)
#pragma unroll
                for (int m = 0; m < 4; ++m)
#pragma unroll
                    for (int n = 0; n < 2; ++n) acc[a][b][m][n] = (f32x4){0.f, 0.f, 0.f, 0.f};
        cur = nxt; cB = nB; ++ui; offAc_u = offAn_u;
#pragma unroll
        for (int h = 0; h < 2; ++h)
#pragma unroll
            for (int i = 0; i < 2; ++i) offAc_v[h][i] = offAn_v[h][i];
        if constexpr (ALIGN_EPI) { if (wr == 1) PG8_BAR; }
    }
    PG8_WAIT_V(0);
    if constexpr (!ALIGN_EPI) { if (wr == 0) PG8_BAR; }
    PG8_BAR;
#undef PG8_SA
#undef PG8_SB
#undef PG8_STAGE_A
#undef PG8_STAGE_B
#undef PG8_MKOFF
#undef PG8_LDA
#undef PG8_LDB
#undef PG8_MMA
#undef PG8_WAIT_V
#undef PG8_WAIT_L
#undef PG8_BAR
#undef PG8_SCHED
}
}
namespace attn_body {
using bf16=__hip_bfloat16;
using bf16x8=__attribute__((ext_vector_type(8)))short;
using s16x4=__attribute__((ext_vector_type(4)))short;
using f32x16=__attribute__((ext_vector_type(16)))float;
using u32x4=__attribute__((ext_vector_type(4)))unsigned;
constexpr int BATCH=2,SEQ=16384,D=64,DM=512;
constexpr int NW=8,QBLK=32,QB=QBLK*NW,KVBLK=64,NQB=SEQ/QB;
constexpr int ATTN_PITCH=DM, ATTN_UNIT_ROWS=QB;
__device__ __forceinline__ int crow(int r,int hi){return (r&3)+8*(r>>2)+4*hi;}
#define SBAR() __builtin_amdgcn_sched_barrier(0)
__device__ __forceinline__ void cmask(f32x16&p0,f32x16&p1,int jb,int qrel,int hi){
  const float NEG=-INFINITY; int kb=64*jb+4*hi;
  #pragma unroll
  for(int r=0;r<16;++r){int kv=kb+(r&3)+8*(r>>2); if(kv>qrel)p0[r]=NEG; if(kv+32>qrel)p1[r]=NEG;}
}

constexpr int NSLOT=3, SLOTB=8192;
constexpr int LDS_K=0, LDS_V=NSLOT*SLOTB, LDS_WS=2*NSLOT*SLOTB, LDS_OST=LDS_WS+NW*64*4, LDS_MK=LDS_OST+NW*4096, LDS_BYTES=LDS_MK+NW*1024, LDS_BYTES_WIDE=LDS_V+NSLOT*2*SLOTB+NW*64*4+NW*4096;
constexpr float C2=0.125f*1.4426950408889634f;
__device__ __forceinline__ void glds16(const void*gsrc,unsigned lds_dst){unsigned keep;
  asm volatile("s_mov_b32 %0, m0\n\ts_mov_b32 m0, %2\n\ts_nop 0\n\tglobal_load_lds_dwordx4 %1, off\n\ts_mov_b32 m0, %0":"=&s"(keep):"v"(gsrc),"s"(lds_dst):"memory");}
__device__ __forceinline__ float max3f(float a,float b,float c){float r;asm("v_max3_f32 %0, %1, %2, %3":"=v"(r):"v"(a),"v"(b),"v"(c));return r;}
__device__ __forceinline__ float max2f(float a,float b){float r;asm("v_max_f32_e32 %0, %1, %2":"=v"(r):"v"(a),"v"(b));return r;}
__device__ __forceinline__ float fadd_s(float a,float b){float r;asm("v_add_f32_e32 %0, %1, %2":"=v"(r):"v"(a),"v"(b));return r;}
__device__ __forceinline__ float fsub_s(float a,float b){float r;asm("v_sub_f32_e32 %0, %1, %2":"=v"(r):"v"(a),"v"(b));return r;}
typedef float f32x2_t __attribute__((ext_vector_type(2))); typedef __bf16 bf16x2_t __attribute__((ext_vector_type(2)));
__device__ __forceinline__ unsigned cvtpk_s(float lo,float hi){f32x2_t v={lo,hi};bf16x2_t b=__builtin_convertvector(v,bf16x2_t);return __builtin_bit_cast(unsigned,b);}
#define WAIT_BAR(N) asm volatile("s_waitcnt vmcnt(" #N ") lgkmcnt(0)\n\ts_barrier":::"memory")

__device__ __forceinline__ void qkt(f32x16&p0,f32x16&p1,const char*Kslot,const bf16x8*qr,const f32x16&ci0,const f32x16&ci1,int r32,int hi){
  const char*kb=Kslot+hi*1024+r32*16;
  #pragma unroll
  for(int d0=0;d0<4;++d0){
    const bf16x8 b0=*reinterpret_cast<const bf16x8*>(kb+d0*2048);
    const bf16x8 b1=*reinterpret_cast<const bf16x8*>(kb+d0*2048+512);
    if(d0==0){p0=__builtin_amdgcn_mfma_f32_32x32x16_bf16(b0,qr[0],ci0,0,0,0);p1=__builtin_amdgcn_mfma_f32_32x32x16_bf16(b1,qr[0],ci1,0,0,0);}
    else{p0=__builtin_amdgcn_mfma_f32_32x32x16_bf16(b0,qr[d0],p0,0,0,0);p1=__builtin_amdgcn_mfma_f32_32x32x16_bf16(b1,qr[d0],p1,0,0,0);}}
}
typedef __attribute__((address_space(3))) const char* lds_cptr;
typedef short v4i16_t __attribute__((ext_vector_type(4)));
__device__ __forceinline__ void kload8(bf16x8*kf,lds_cptr kp){
  kf[0]=*(const __attribute__((address_space(3))) bf16x8*)(kp);      kf[1]=*(const __attribute__((address_space(3))) bf16x8*)(kp+512);
  kf[2]=*(const __attribute__((address_space(3))) bf16x8*)(kp+2048); kf[3]=*(const __attribute__((address_space(3))) bf16x8*)(kp+2560);
  kf[4]=*(const __attribute__((address_space(3))) bf16x8*)(kp+4096); kf[5]=*(const __attribute__((address_space(3))) bf16x8*)(kp+4608);
  kf[6]=*(const __attribute__((address_space(3))) bf16x8*)(kp+6144); kf[7]=*(const __attribute__((address_space(3))) bf16x8*)(kp+6656);
}
__device__ __forceinline__ void kload2(bf16x8*kf,lds_cptr kp,int j){ kf[2*j]=*(const __attribute__((address_space(3))) bf16x8*)(kp+j*2048); kf[2*j+1]=*(const __attribute__((address_space(3))) bf16x8*)(kp+j*2048+512); }
__device__ __forceinline__ s16x4 vtr(lds_cptr p){ return __builtin_bit_cast(s16x4,__builtin_amdgcn_ds_read_tr16_b64_v4i16((__attribute__((address_space(3))) v4i16_t*)p)); }
__device__ __forceinline__ float rowmax(const f32x16&p0,const f32x16&p1){
  float a=max3f(p0[0],p0[1],p1[0]),b=max3f(p0[2],p0[3],p1[1]);a=max3f(a,p1[2],p1[3]);
  #pragma unroll
  for(int r=4;r<16;r+=4){a=max3f(a,p0[r],p0[r+1]);b=max3f(b,p0[r+2],p0[r+3]);a=max3f(a,p1[r],p1[r+1]);b=max3f(b,p1[r+2],p1[r+3]);}
  const float m=max2f(a,b);
  auto rr=__builtin_amdgcn_permlane32_swap(__float_as_uint(m),__float_as_uint(m),false,false);
  return max2f(__uint_as_float(rr[0]),__uint_as_float(rr[1]));
}
__device__ __forceinline__ void pv(f32x16*o,int vb,bf16x8 pa0,bf16x8 pa1,bf16x8 pa2,bf16x8 pa3){
  #pragma unroll
  for(int d0=0;d0<2;++d0){s16x4 lo[4],hi[4];
    #pragma unroll
    for(int ks=0;ks<4;++ks){
      asm volatile("ds_read_b64_tr_b16 %0,%1 offset:%c2":"=&v"(lo[ks]):"v"(vb),"i"(d0*4096+ks*1024):"memory");
      asm volatile("ds_read_b64_tr_b16 %0,%1 offset:%c2":"=&v"(hi[ks]):"v"(vb),"i"(d0*4096+ks*1024+512):"memory");}
    asm volatile("s_waitcnt lgkmcnt(0)":::"memory");SBAR();
    #define PK(k) (bf16x8){lo[k][0],lo[k][1],lo[k][2],lo[k][3],hi[k][0],hi[k][1],hi[k][2],hi[k][3]}
    o[d0]=__builtin_amdgcn_mfma_f32_32x32x16_bf16(pa0,PK(0),o[d0],0,0,0);
    o[d0]=__builtin_amdgcn_mfma_f32_32x32x16_bf16(pa1,PK(1),o[d0],0,0,0);
    o[d0]=__builtin_amdgcn_mfma_f32_32x32x16_bf16(pa2,PK(2),o[d0],0,0,0);
    o[d0]=__builtin_amdgcn_mfma_f32_32x32x16_bf16(pa3,PK(3),o[d0],0,0,0);
    #undef PK
  }
}

#ifndef ATTN_STORE16
#define ATTN_STORE16(p,v) (*(u32x4*)(p)=(v))
#endif
template<int THRL,bool MASKED,bool WIDE,bool NOMAX> __device__ __forceinline__ void attn_unit(int b,int hq,int hv,int qb,const bf16*Q,const bf16*__restrict__ K,const bf16*__restrict__ V,bf16*O,const unsigned long long*__restrict__ MK,char*shm,int wave_in,int badoff){
  const int tid=ltid(wave_in),lane=tid&63,r32=lane&31,hi=lane>>5; const int wid=__builtin_amdgcn_readfirstlane(tid>>6);
  const long rowbase=(long)b*SEQ; const int q0=qb*QB;
  const bf16*Qw=Q+(rowbase+q0+wid*QBLK)*DM+hq*D;
  const bf16*Kh=K+rowbase*DM+hq*D,*Vh=V+rowbase*DM+hv*D;
  constexpr int VSLOT=WIDE?2*SLOTB:SLOTB, L_WS=LDS_V+NSLOT*VSLOT, L_OST=L_WS+NW*64*4, L_MK=L_OST+NW*4096, L_TAB=L_MK+NW*2048;
  #define VS(sl) (WIDE?2*(sl):(sl))
  const unsigned lds0=(unsigned)(uintptr_t)shm;
  float*wsf=(float*)(shm+L_WS)+wid*64;
  const bf16*ksrc=Kh+(long)lane*DM+wid*8;
  const bf16*vsrc=Vh+(long)(16*(wid&3)+(lane>>2))*DM+(wid>>2)*32+(lane&3)*8;
  const unsigned kdst=lds0+LDS_K+wid*1024, vdst=lds0+LDS_V+wid*1024;
  #define DMA_K(t,slot) glds16(ksrc+(long)(t)*KVBLK*DM,(unsigned)__builtin_amdgcn_readfirstlane(kdst+(slot)))
  #define DMA_V(t,slot) do{ glds16(vsrc+(long)(t)*KVBLK*DM,(unsigned)__builtin_amdgcn_readfirstlane(vdst+VS(slot))); if(WIDE){ glds16(vsrc+64+(long)(t)*KVBLK*DM,(unsigned)__builtin_amdgcn_readfirstlane(vdst+VS(slot)+8192)); } }while(0)
  const long mq0=(long)q0+wid*QBLK+2*(lane&15); const unsigned mdst=lds0+L_MK+wid*2048;
  #define DMA_M4(t0) do{ if(MASKED){ const long t_=(long)(t0)+(lane>>4); if(t_<NT){ glds16(MK+(16384L*t_-32L*t_*(t_-1)+mq0-64L*t_),(unsigned)__builtin_amdgcn_readfirstlane(mdst+(((t0)&7)*256))); } } }while(0)
  unsigned mw0=0u,mw1=0u;
  #define MKRD(t) do{ if(MASKED){ const unsigned long long w_=*(const __attribute__((address_space(3))) unsigned long long*)(shm3+L_MK+wid*2048+(((t)&7)*256)+r32*8); mw0=(unsigned)w_; mw1=(unsigned)(w_>>32); } }while(0)
  #define MAND(X,r,MW) do{}while(0)
  bf16x8 aid[2];
  if(MASKED){
    #pragma unroll
    for(int ks=0;ks<2;++ks)
      #pragma unroll
      for(int j=0;j<8;++j) aid[ks][j]=(short)((r32==16*ks+8*hi+j)?0x3F80:0);
  }
  #define TABRD(w,ks) (*(const __attribute__((address_space(3))) bf16x8*)(shm3+L_TAB+((((w)>>(16*(ks)+8*hi))&0xffu)<<4)))
  #define BIAS(C0,C1,CI) do{ const bf16x8 f00_=TABRD(mw0,0),f01_=TABRD(mw0,1),f10_=TABRD(mw1,0),f11_=TABRD(mw1,1); \
    C0=__builtin_amdgcn_mfma_f32_32x32x16_bf16(aid[0],f00_,CI,0,0,0); C1=__builtin_amdgcn_mfma_f32_32x32x16_bf16(aid[0],f10_,CI,0,0,0); \
    C0=__builtin_amdgcn_mfma_f32_32x32x16_bf16(aid[1],f01_,C0,0,0,0); C1=__builtin_amdgcn_mfma_f32_32x32x16_bf16(aid[1],f11_,C1,0,0,0); }while(0)
  const int vb0=(int)(lds0+LDS_V)+((lane>>4)&1)*32+(lane&3)*8+(4*hi+((lane&15)>>2))*64;
  const char*Kbase=shm+LDS_K; bf16x8 kf[8];
  const lds_cptr shm3=(lds_cptr)shm; const lds_cptr kp0=shm3+LDS_K+hi*1024+r32*16; const lds_cptr vp0=shm3+LDS_V+((lane>>4)&1)*32+(lane&3)*8+(4*hi+((lane&15)>>2))*64;
  const int NT=(q0+QB)/KVBLK;
  DMA_M4(0);DMA_K(0,0);DMA_V(0,0);DMA_K(1,SLOTB);
  bf16x8 qr[4];
  #pragma unroll
  for(int d0=0;d0<4;++d0)qr[d0]=*reinterpret_cast<const bf16x8*>(&Qw[(long)r32*DM+d0*16+hi*8]);
  float mhat=0.f,l_reg=0.f;f32x16 o[4];o[0]=f32x16{};o[1]=f32x16{};o[2]=f32x16{};o[3]=f32x16{};f32x16 negm=f32x16{}; if(!WIDE&&!NOMAX){ asm volatile("":"+v"(negm)); }
  const int qrel=wid*QBLK+r32;
  #define CMASK(P0,P1,t) do{int jb_=(t)-(NT-4); if(jb_>=0)cmask(P0,P1,jb_,qrel,hi);}while(0)
  bool resc=false;
  #define START(P0,P1) do{ resc=false; \
    if constexpr(!NOMAX){ const float rm=rowmax(P0,P1); const float dl=rm; mhat=fadd_s(mhat,dl); \
      _Pragma("unroll") for(int r=0;r<16;++r){P0[r]=fsub_s(P0[r],dl);P1[r]=fsub_s(P1[r],dl);} \
      if(!WIDE){ _Pragma("unroll") for(int r=0;r<16;++r)negm[r]=-mhat; asm volatile("":"+v"(negm)); } } \
    _Pragma("unroll") for(int r=0;r<16;++r)P0[r]=__builtin_amdgcn_exp2f(P0[r]); }while(0)
  #define RESC() do{ if constexpr(!NOMAX) if(resc){ asm volatile("s_waitcnt lgkmcnt(0)":::"memory"); \
      _Pragma("unroll") for(int d_=0;d_<(WIDE?4:2);++d_) _Pragma("unroll") for(int r=0;r<16;++r)o[d_][r]*=wsf[crow(r,hi)]; } }while(0)
  f32x16 pA0,pA1,pB0,pB1;
  int sl_prev=0,sl_cur=0,sl_next=SLOTB;
  #define ROT() do{sl_prev=sl_cur;sl_cur=sl_next;sl_next=(sl_next==(NSLOT-1)*SLOTB)?0:sl_next+SLOTB;}while(0)
  DMA_K(2,2*SLOTB); const bool m4b_=MASKED&&(4<NT); if(m4b_){DMA_M4(4);}
  if(WIDE||m4b_){WAIT_BAR(4);}else{WAIT_BAR(3);}
  if(MASKED){ MKRD(0); BIAS(pA0,pA1,negm); qkt(pA0,pA1,Kbase,qr,pA0,pA1,r32,hi); } else { qkt(pA0,pA1,Kbase,qr,negm,negm,r32,hi); }
  asm volatile("s_nop 15\n\ts_nop 7":"+v"(pA0),"+v"(pA1));CMASK(pA0,pA1,0);
  START(pA0,pA1);
  _Pragma("unroll") for(int r=0;r<16;++r)pA1[r]=__builtin_amdgcn_exp2f(pA1[r]);
  WAIT_BAR(0);
  DMA_K(3,0);DMA_V(1,SLOTB);
  ROT();
  kload8(kf,kp0+sl_cur);
  if(WIDE){WAIT_BAR(3);}else{WAIT_BAR(2);}
  s16x4 vlo[8],vhi[8]; u32x4 pw0,pw1,pw2,pw3;
  #define PKW(P,B) cvtpk_s(P[B],P[B+1])
  #define PAF(k) __builtin_bit_cast(bf16x8,pw##k)
  #define VFR(i) (bf16x8){vlo[i][0],vlo[i][1],vlo[i][2],vlo[i][3],vhi[i][0],vhi[i][1],vhi[i][2],vhi[i][3]}
  #define PIN(x) asm volatile("":"+v"(x))
  #define MX3(a,b,c) __builtin_fmaxf(__builtin_fmaxf((a),(b)),(c))
  #define GAPA(MF,A0,A1,A2,A3,W0,W1,PW) do{ MF; sacc+=A0; sacc+=A1; sacc+=A2; sacc+=A3; PIN(sacc); W0; W1; PIN(PW); SBAR(); }while(0)
  #define EX(v) __builtin_amdgcn_exp2f(v)
  #define GAPB(MF,X,B,MW) do{ MF; X[B]=EX(X[B]); X[B+1]=EX(X[B+1]); X[B+2]=EX(X[B+2]); X[B+3]=EX(X[B+3]); MAND(X,B,MW); MAND(X,B+1,MW); MAND(X,B+2,MW); MAND(X,B+3,MW); PIN(X); SBAR(); }while(0)
  #define GAPB2(MF,X,B) do{ MF; X[B]=EX(X[B]); X[B+1]=EX(X[B+1]); PIN(X); SBAR(); }while(0)
  #define VRD(i) do{ vlo[i]=vtr(vp_+(((i)>>2)*4096+((i)&3)*1024)); vhi[i]=vtr(vp_+(((i)>>2)*4096+((i)&3)*1024+512)); }while(0)
  #define KRD(G,j) do{ if(G){ kload2(kf,kp0+sl_next,j); SBAR(); } }while(0)
  #define STEP(C0,C1,P0,P1,t,GK,GV,GL,GM) do{ SBAR(); \
    const lds_cptr vp_=vp0+VS(sl_prev); \
    if(MASKED){ MKRD(t); BIAS(C0,C1,negm); SBAR(); } \
    VRD(0); SBAR(); float sacc=(P0[0]+P0[1]); \
    GAPA(C0=__builtin_amdgcn_mfma_f32_32x32x16_bf16(kf[0],qr[0],(MASKED?C0:negm),0,0,0), P0[2],P0[3],P0[4],P0[5],     pw0[0]=PKW(P0,0), pw0[1]=PKW(P0,2), pw0); \
    VRD(4); SBAR(); GAPA(C1=__builtin_amdgcn_mfma_f32_32x32x16_bf16(kf[1],qr[0],(MASKED?C1:negm),0,0,0), P0[6],P0[7],P0[8],P0[9],     pw0[2]=PKW(P0,4), pw0[3]=PKW(P0,6), pw0); \
    VRD(1); SBAR(); GAPA(C0=__builtin_amdgcn_mfma_f32_32x32x16_bf16(kf[2],qr[1],C0,0,0,0),   P0[10],P0[11],P0[12],P0[13], pw1[0]=PKW(P0,8), pw1[1]=PKW(P0,10), pw1); \
    VRD(5); SBAR(); GAPA(C1=__builtin_amdgcn_mfma_f32_32x32x16_bf16(kf[3],qr[1],C1,0,0,0),   P0[14],P0[15],P1[0],P1[1],   pw1[2]=PKW(P0,12),pw1[3]=PKW(P0,14), pw1); \
    VRD(2); SBAR(); GAPA(C0=__builtin_amdgcn_mfma_f32_32x32x16_bf16(kf[4],qr[2],C0,0,0,0),   P1[2],P1[3],P1[4],P1[5],     pw2[0]=PKW(P1,0), pw2[1]=PKW(P1,2), pw2); \
    VRD(6); SBAR(); GAPA(C1=__builtin_amdgcn_mfma_f32_32x32x16_bf16(kf[5],qr[2],C1,0,0,0),   P1[6],P1[7],P1[8],P1[9],     pw2[2]=PKW(P1,4), pw2[3]=PKW(P1,6), pw2); \
    VRD(3); SBAR(); GAPA(C0=__builtin_amdgcn_mfma_f32_32x32x16_bf16(kf[6],qr[3],C0,0,0,0),   P1[10],P1[11],P1[12],P1[13], pw3[0]=PKW(P1,8), pw3[1]=PKW(P1,10), pw3); \
    VRD(7); SBAR(); GAPA(C1=__builtin_amdgcn_mfma_f32_32x32x16_bf16(kf[7],qr[3],C1,0,0,0),   P1[14],P1[15],0.f,0.f,       pw3[2]=PKW(P1,12),pw3[3]=PKW(P1,14), pw3); \
    l_reg+=sacc; \
    if(GK){DMA_K((t)+3,sl_cur);} if(GV){DMA_V((t)+1,sl_next);} if(MASKED&&GM){ if((((t)&3)==0)&&((t)+4<NT)){DMA_M4((t)+4);} } \
    CMASK(C0,C1,t); \
    if constexpr(!NOMAX){ float a=MX3(C0[0],C0[1],C1[0]),b=MX3(C0[2],C0[3],C1[1]); a=MX3(a,C1[2],C1[3]); \
      _Pragma("unroll") for(int r=4;r<16;r+=4){a=MX3(a,C0[r],C0[r+1]);b=MX3(b,C0[r+2],C0[r+3]);a=MX3(a,C1[r],C1[r+1]);b=MX3(b,C1[r+2],C1[r+3]);} \
      float rm=__builtin_fmaxf(a,b); { auto rr=__builtin_amdgcn_permlane32_swap(__float_as_uint(rm),__float_as_uint(rm),false,false); rm=__builtin_fmaxf(__uint_as_float(rr[0]),__uint_as_float(rr[1])); } \
      resc=false; \
      if(__builtin_expect(__any(rm>(float)THRL),0)){ const float dl=__builtin_fmaxf(rm,0.f); mhat+=dl; \
        _Pragma("unroll") for(int r=0;r<16;++r){C0[r]-=dl;C1[r]-=dl;} \
        _Pragma("unroll") for(int r=0;r<16;++r)negm[r]=-mhat; asm volatile("":"+v"(negm)); \
        const float f=__builtin_amdgcn_exp2f(-dl); l_reg*=f; if(hi==0)wsf[r32]=f; resc=true; } } \
    SBAR(); \
    GAPB(o[0]=__builtin_amdgcn_mfma_f32_32x32x16_bf16(PAF(0),VFR(0),o[0],0,0,0), C0,0,mw0); \
    GAPB(o[1]=__builtin_amdgcn_mfma_f32_32x32x16_bf16(PAF(0),VFR(4),o[1],0,0,0), C0,4,mw0); \
    KRD(GL,0); GAPB(o[0]=__builtin_amdgcn_mfma_f32_32x32x16_bf16(PAF(1),VFR(1),o[0],0,0,0), C0,8,mw0); \
    KRD(GL,1); GAPB(o[1]=__builtin_amdgcn_mfma_f32_32x32x16_bf16(PAF(1),VFR(5),o[1],0,0,0), C0,12,mw0); \
    KRD(GL,2); GAPB(o[0]=__builtin_amdgcn_mfma_f32_32x32x16_bf16(PAF(2),VFR(2),o[0],0,0,0), C1,0,mw1); \
    KRD(GL,3); GAPB(o[1]=__builtin_amdgcn_mfma_f32_32x32x16_bf16(PAF(2),VFR(6),o[1],0,0,0), C1,4,mw1); \
    GAPB(o[0]=__builtin_amdgcn_mfma_f32_32x32x16_bf16(PAF(3),VFR(3),o[0],0,0,0), C1,8,mw1); \
    GAPB(o[1]=__builtin_amdgcn_mfma_f32_32x32x16_bf16(PAF(3),VFR(7),o[1],0,0,0), C1,12,mw1); \
    }while(0)
  #define VLD(n,f) do{ vlo[(n)&3]=vtr(vp_+(((f)>>2)*4096+((f)&3)*1024)); vhi[(n)&3]=vtr(vp_+(((f)>>2)*4096+((f)&3)*1024+512)); }while(0)
  #define VFW(n) (bf16x8){vlo[(n)&3][0],vlo[(n)&3][1],vlo[(n)&3][2],vlo[(n)&3][3],vhi[(n)&3][0],vhi[(n)&3][1],vhi[(n)&3][2],vhi[(n)&3][3]}
  #define PVN(OD,k,n,fnext) do{ OD=__builtin_amdgcn_mfma_f32_32x32x16_bf16(PAF(k),VFW(n),OD,0,0,0); SBAR(); if((fnext)>=0){ VLD(n,fnext); SBAR(); } }while(0)
  #define STEPW(C0,C1,P0,P1,t,GK,GV,GL) do{ SBAR(); \
    const lds_cptr vp_=vp0+VS(sl_prev); \
    VLD(0,0); SBAR(); float sacc=(P0[0]+P0[1]); f32x16 ci_=f32x16{}; if constexpr(!NOMAX){ const float nm_=-mhat; _Pragma("unroll") for(int r=0;r<16;++r)ci_[r]=nm_; }     \
    GAPA(C0=__builtin_amdgcn_mfma_f32_32x32x16_bf16(kf[0],qr[0],ci_,0,0,0), P0[2],P0[3],P0[4],P0[5],     pw0[0]=PKW(P0,0), pw0[1]=PKW(P0,2), pw0); \
    VLD(1,4); SBAR(); GAPA(C1=__builtin_amdgcn_mfma_f32_32x32x16_bf16(kf[1],qr[0],ci_,0,0,0), P0[6],P0[7],P0[8],P0[9],     pw0[2]=PKW(P0,4), pw0[3]=PKW(P0,6), pw0); \
    VLD(2,1); SBAR(); GAPA(C0=__builtin_amdgcn_mfma_f32_32x32x16_bf16(kf[2],qr[1],C0,0,0,0),   P0[10],P0[11],P0[12],P0[13], pw1[0]=PKW(P0,8), pw1[1]=PKW(P0,10), pw1); \
    VLD(3,5); SBAR(); GAPA(C1=__builtin_amdgcn_mfma_f32_32x32x16_bf16(kf[3],qr[1],C1,0,0,0),   P0[14],P0[15],P1[0],P1[1],   pw1[2]=PKW(P0,12),pw1[3]=PKW(P0,14), pw1); \
    GAPA(C0=__builtin_amdgcn_mfma_f32_32x32x16_bf16(kf[4],qr[2],C0,0,0,0),   P1[2],P1[3],P1[4],P1[5],     pw2[0]=PKW(P1,0), pw2[1]=PKW(P1,2), pw2); \
    GAPA(C1=__builtin_amdgcn_mfma_f32_32x32x16_bf16(kf[5],qr[2],C1,0,0,0),   P1[6],P1[7],P1[8],P1[9],     pw2[2]=PKW(P1,4), pw2[3]=PKW(P1,6), pw2); \
    GAPA(C0=__builtin_amdgcn_mfma_f32_32x32x16_bf16(kf[6],qr[3],C0,0,0,0),   P1[10],P1[11],P1[12],P1[13], pw3[0]=PKW(P1,8), pw3[1]=PKW(P1,10), pw3); \
    GAPA(C1=__builtin_amdgcn_mfma_f32_32x32x16_bf16(kf[7],qr[3],C1,0,0,0),   P1[14],P1[15],0.f,0.f,       pw3[2]=PKW(P1,12),pw3[3]=PKW(P1,14), pw3); \
    l_reg+=sacc; \
    if(GK){DMA_K((t)+3,sl_cur);} if(GV){DMA_V((t)+1,sl_next);} \
    CMASK(C0,C1,t); \
    if constexpr(!NOMAX){ float a=MX3(C0[0],C0[1],C1[0]),b=MX3(C0[2],C0[3],C1[1]); a=MX3(a,C1[2],C1[3]); \
      _Pragma("unroll") for(int r=4;r<16;r+=4){a=MX3(a,C0[r],C0[r+1]);b=MX3(b,C0[r+2],C0[r+3]);a=MX3(a,C1[r],C1[r+1]);b=MX3(b,C1[r+2],C1[r+3]);} \
      float rm=__builtin_fmaxf(a,b); { auto rr=__builtin_amdgcn_permlane32_swap(__float_as_uint(rm),__float_as_uint(rm),false,false); rm=__builtin_fmaxf(__uint_as_float(rr[0]),__uint_as_float(rr[1])); } \
      resc=false; \
      if(__builtin_expect(__any(rm>(float)THRL),0)){ const float dl=__builtin_fmaxf(rm,0.f); mhat+=dl; \
        _Pragma("unroll") for(int r=0;r<16;++r){C0[r]-=dl;C1[r]-=dl;} \
        const float f=__builtin_amdgcn_exp2f(-dl); l_reg*=f; if(hi==0)wsf[r32]=f; resc=true; } } \
    SBAR(); \
    GAPB2(o[0]=__builtin_amdgcn_mfma_f32_32x32x16_bf16(PAF(0),VFW(0),o[0],0,0,0), C0,0); VLD(0,2); SBAR(); \
    GAPB2(o[1]=__builtin_amdgcn_mfma_f32_32x32x16_bf16(PAF(0),VFW(1),o[1],0,0,0), C0,2); VLD(1,6); SBAR(); \
    KRD(GL,0); GAPB2(o[0]=__builtin_amdgcn_mfma_f32_32x32x16_bf16(PAF(1),VFW(2),o[0],0,0,0), C0,4); VLD(2,3); SBAR(); \
    KRD(GL,1); GAPB2(o[1]=__builtin_amdgcn_mfma_f32_32x32x16_bf16(PAF(1),VFW(3),o[1],0,0,0), C0,6); VLD(3,7); SBAR(); \
    KRD(GL,2); GAPB2(o[0]=__builtin_amdgcn_mfma_f32_32x32x16_bf16(PAF(2),VFW(4),o[0],0,0,0), C0,8); VLD(4,8); SBAR(); \
    KRD(GL,3); GAPB2(o[1]=__builtin_amdgcn_mfma_f32_32x32x16_bf16(PAF(2),VFW(5),o[1],0,0,0), C0,10); VLD(5,12); SBAR(); \
    GAPB2(o[0]=__builtin_amdgcn_mfma_f32_32x32x16_bf16(PAF(3),VFW(6),o[0],0,0,0), C0,12); VLD(6,9); SBAR(); \
    GAPB2(o[1]=__builtin_amdgcn_mfma_f32_32x32x16_bf16(PAF(3),VFW(7),o[1],0,0,0), C0,14); VLD(7,13); SBAR(); \
    GAPB2(o[2]=__builtin_amdgcn_mfma_f32_32x32x16_bf16(PAF(0),VFW(8),o[2],0,0,0), C1,0); VLD(8,10); SBAR(); \
    GAPB2(o[3]=__builtin_amdgcn_mfma_f32_32x32x16_bf16(PAF(0),VFW(9),o[3],0,0,0), C1,2); VLD(9,14); SBAR(); \
    GAPB2(o[2]=__builtin_amdgcn_mfma_f32_32x32x16_bf16(PAF(1),VFW(10),o[2],0,0,0), C1,4); VLD(10,11); SBAR(); \
    GAPB2(o[3]=__builtin_amdgcn_mfma_f32_32x32x16_bf16(PAF(1),VFW(11),o[3],0,0,0), C1,6); VLD(11,15); SBAR(); \
    GAPB2(o[2]=__builtin_amdgcn_mfma_f32_32x32x16_bf16(PAF(2),VFW(12),o[2],0,0,0), C1,8); \
    GAPB2(o[3]=__builtin_amdgcn_mfma_f32_32x32x16_bf16(PAF(2),VFW(13),o[3],0,0,0), C1,10); \
    GAPB2(o[2]=__builtin_amdgcn_mfma_f32_32x32x16_bf16(PAF(3),VFW(14),o[2],0,0,0), C1,12); \
    GAPB2(o[3]=__builtin_amdgcn_mfma_f32_32x32x16_bf16(PAF(3),VFW(15),o[3],0,0,0), C1,14); \
    }while(0)
  #define STEPX(C0,C1,P0,P1,t,GK,GV,GL,GM) do{ if constexpr(WIDE){ STEPW(C0,C1,P0,P1,t,GK,GV,GL); } else { STEP(C0,C1,P0,P1,t,GK,GV,GL,GM); } }while(0)
  int t=1;
  #undef CMASK
  #define CMASK(P0,P1,t) do{}while(0)
  for(;t+5<NT;t+=2){
    STEPX(pB0,pB1,pA0,pA1,t,true,true,true,true);     if(WIDE){WAIT_BAR(3);}else{WAIT_BAR(2);} RESC(); ROT();
    STEPX(pA0,pA1,pB0,pB1,t+1,true,true,true,true);   if(WIDE||(MASKED&&(((t+1)&3)==0))){WAIT_BAR(3);}else{WAIT_BAR(2);} RESC(); ROT();
  }
  #undef CMASK
  #define CMASK(P0,P1,t) do{int jb_=(t)-(NT-4); if(jb_>=0)cmask(P0,P1,jb_,qrel,hi);}while(0)
  #define ENDW(tt) do{ if(WIDE){ if((tt)+3<NT){WAIT_BAR(3);} else if((tt)+2<NT){WAIT_BAR(2);} else {WAIT_BAR(0);} } else { if((tt)+3<NT){WAIT_BAR(2);} else if((tt)+2<NT){WAIT_BAR(1);} else {WAIT_BAR(0);} } }while(0)
  for(;t+1<NT;t+=2){
    STEPX(pB0,pB1,pA0,pA1,t,(t+3<NT),(t+1<NT),(t+1<NT),(t+2<NT));       ENDW(t);   RESC(); ROT();
    STEPX(pA0,pA1,pB0,pB1,t+1,(t+4<NT),(t+2<NT),(t+2<NT),(t+3<NT));     ENDW(t+1); RESC(); ROT();
  }
  STEPX(pB0,pB1,pA0,pA1,NT-1,false,false,false,false); RESC();
  { float sacc=pB0[0]+pB0[1]; _Pragma("unroll") for(int r=2;r<16;++r)sacc+=pB0[r]; _Pragma("unroll") for(int r=0;r<16;++r)sacc+=pB1[r]; l_reg+=sacc;
    pw0=(u32x4){PKW(pB0,0),PKW(pB0,2),PKW(pB0,4),PKW(pB0,6)};pw1=(u32x4){PKW(pB0,8),PKW(pB0,10),PKW(pB0,12),PKW(pB0,14)};pw2=(u32x4){PKW(pB1,0),PKW(pB1,2),PKW(pB1,4),PKW(pB1,6)};pw3=(u32x4){PKW(pB1,8),PKW(pB1,10),PKW(pB1,12),PKW(pB1,14)};
    SBAR(); pv(o,vb0+VS(sl_cur),PAF(0),PAF(1),PAF(2),PAF(3)); if(WIDE){ pv(o+2,vb0+VS(sl_cur)+8192,PAF(0),PAF(1),PAF(2),PAF(3)); } }
  #undef PKW
  #undef PAF
  #undef VFR
  #undef PIN
  #undef MX3
  #undef GAPA
  #undef GAPB
  #undef GAPB2
  #undef EX
  #undef VRD
  #undef KRD
  #undef VLD
  #undef VFW
  #undef PVN
  #undef STEPW
  #undef STEPX
  #undef STEP
  #undef ENDW
  {auto rr=__builtin_amdgcn_permlane32_swap(__float_as_uint(l_reg),__float_as_uint(l_reg),false,false);l_reg=__uint_as_float(rr[0])+__uint_as_float(rr[1]);}
  if constexpr(NOMAX){ if(!(l_reg>7.9e-31f&&l_reg<1.2e30f))*(__attribute__((address_space(3))) unsigned*)((__attribute__((address_space(3))) char*)shm+badoff)=1u; }
  if(hi==0)wsf[32+r32]=l_reg;asm volatile("s_waitcnt lgkmcnt(0)":::"memory");
  float rli[16];
  #pragma unroll
  for(int r=0;r<16;++r)rli[r]=__builtin_amdgcn_rcpf(wsf[32+crow(r,hi)]);
  bf16*Ow=O+(rowbase+q0+wid*QBLK)*DM+hv*D;
  #pragma unroll
  for(int hf=0;hf<(WIDE?2:1);++hf){ bf16*stg=(bf16*)(shm+L_OST)+wid*2048;
    #pragma unroll
    for(int r=0;r<16;++r){const int orow=crow(r,hi);
      #pragma unroll
      for(int d0=0;d0<2;++d0)stg[orow*64+d0*32+r32]=__float2bfloat16(o[2*hf+d0][r]*rli[r]);}
    asm volatile("s_waitcnt lgkmcnt(0)":::"memory");
    #pragma unroll
    for(int i=0;i<4;++i){const int row=i*8+(lane>>3),ch=lane&7; const u32x4 v=*(const u32x4*)(stg+row*64+ch*8); ATTN_STORE16(Ow+(long)row*DM+hf*64+ch*8,v);}
    asm volatile("s_waitcnt lgkmcnt(0)":::"memory"); }
  asm volatile("s_waitcnt lgkmcnt(0)\n\ts_barrier":::"memory");
  #undef DMA_K
  #undef DMA_V
  #undef DMA_M4
  #undef MKRD
  #undef MAND
  #undef TABRD
  #undef BIAS
  #undef CMASK
  #undef START
  #undef RESC
  #undef ROT
  #undef VS
}
constexpr int ATTN_LDS_BYTES=LDS_BYTES+NW*1024+4096;
__device__ __forceinline__ void mask_table_init(char*shm,int tid){
  if(tid<256){ u32x4 v; unsigned e[8];
    #pragma unroll
    for(int j=0;j<8;++j) e[j]=((tid>>j)&1)?0u:0xC400u;
    v.x=e[0]|(e[1]<<16); v.y=e[2]|(e[3]<<16); v.z=e[4]|(e[5]<<16); v.w=e[6]|(e[7]<<16);
    *(u32x4*)(shm+LDS_MK+NW*2048+tid*16)=v; }
  __syncthreads();
}
#undef SBAR
#undef WAIT_BAR
}

constexpr int NWAVES = 8;
#ifndef MK_PER_PHASE
#define MK_PER_PHASE 0
#endif

#ifndef CHK
#define CHK 0
#endif
constexpr int CW_CHK = 2;
constexpr int BATCH = 2, SEQ = 16384, NTOK = BATCH * SEQ, DMODEL = 1024, DEPTH = 2;
constexpr int WIN_OLD = 5704, WIN_NEW = 5888, P1_N = 3840;
constexpr float LN_EPS = 1e-5f, ALPHA = 1.41421356237f;
constexpr int NPH_LAYER = 12, NPHASE = DEPTH * NPH_LAYER;

constexpr size_t MiB = 1u << 20;
constexpr size_t WS_CTL = 0, CTL_ZERO_BYTES = 1 * MiB;
constexpr size_t WS_SMALL = 1 * MiB, SM_LAM = 0, SM_WR = 4096, SM_BR = SM_WR + 2 * 36 * 1024 * 4;
constexpr size_t WS_ROPE = 2 * MiB;
constexpr size_t WS_ROUTE = 4 * MiB, RT_E = 0, RT_C = 256 * 1024, RT_HIST = 512 * 1024, RT_TOT = 544 * 1024, RT_ROW = 576 * 1024, RT_ENT = 864 * 1024, RT_CW = 1152 * 1024;
constexpr int LIST_CAP = 65536 + 32 * 256;
constexpr size_t WS_WB = 6 * MiB;
constexpr size_t WB_WIN = 0, WB_WBD = (size_t)WIN_NEW * 1024 * 2, WB_WBS = WB_WBD + MiB, WB_WO = WB_WBS + MiB, WB_WPG = WB_WO + 2 * MiB, WB_WPLE = WB_WPG + 2 * MiB,
                 WB_WGU = WB_WPLE + MiB / 2, WB_WD = WB_WGU + 32 * MiB, WB_END = WB_WD + 16 * MiB;
static_assert(WB_END == 66 * MiB, "weight copies");
constexpr size_t WB_WG8 = WB_WIN + (size_t)3840 * 1024 * 2;
constexpr size_t WS_XB = 72 * MiB;
constexpr size_t WS_DQ = 136 * MiB, TSTRIDE = 32 * MiB, WS_IK = 360 * MiB, WS_IW = 364 * MiB;
constexpr size_t WS_O0 = 365 * MiB, WS_O1 = 397 * MiB, WS_YB = 429 * MiB, WS_MASK = 461 * MiB;
constexpr long MASK_BSTRIDE = 2105344;
constexpr size_t WS_YA = 136 * MiB, WS_MERGED = 168 * MiB, WS_TMPG = 240 * MiB, WS_PRE1 = 240 * MiB;
constexpr size_t OUT_XB8 = 0, OUT_X1B8 = 32 * MiB, OUT_T1 = 64 * MiB;
constexpr size_t WS_HG = 136 * MiB, WS_PLE = 172 * MiB, WS_Y0 = 368 * MiB, WS_Y1 = 432 * MiB, WS_PB = 496 * MiB, WS_END = 512 * MiB;
static_assert(WS_MASK + 2 * MASK_BSTRIDE * 8 <= WS_PB, "mask fits");
constexpr int CW_TMO = 0, CW_CODE = 1, CW_BAR = 4096, CW_QUEUE = 8192;

constexpr int RING_OFF = 0, RING_BYTES = 131072;
constexpr int XTR_OFF = RING_BYTES, XTR_BYTES = 4096;
constexpr int MISC_OFF = XTR_OFF + XTR_BYTES;
constexpr int LDS_BYTES = 147456;
static_assert(MISC_OFF + 128 <= LDS_BYTES, "LDS map");
#define GAS __attribute__((address_space(1)))
#define LAS __attribute__((address_space(3)))
typedef unsigned short bf16;
typedef unsigned v4u __attribute__((ext_vector_type(4)));
typedef float f32x4 __attribute__((ext_vector_type(4)));
typedef short bf16x8 __attribute__((ext_vector_type(8)));
typedef GAS unsigned gu32;
typedef GAS unsigned long long gu64;
#define RLX_AGENT __ATOMIC_RELAXED, __HIP_MEMORY_SCOPE_AGENT
#define LDS_WAIT() asm volatile("s_waitcnt lgkmcnt(0)" ::: "memory")
#define VM_WAIT() asm volatile("s_waitcnt vmcnt(0)" ::: "memory")
__device__ __forceinline__ unsigned long long rt() { return __builtin_amdgcn_s_memrealtime(); }
__device__ __forceinline__ unsigned f2bf(float f) { unsigned u = __builtin_bit_cast(unsigned, f); return (u + 0x7fffu + ((u >> 16) & 1u)) >> 16; }
__device__ __forceinline__ unsigned pk2(float lo, float hi) { return f2bf(lo) | (f2bf(hi) << 16); }

#define XB_TMO      128
#define XB_XCNT(j)  (256  + 64 * (j))
#define XB_XSUB(j)  (1280 + 64 * (j))
#define XB_XGEN(j)  (2304 + 64 * (j))
#define XB_TOP      3328
#define XB_TOPGEN   3392
#define XCD_BAR_WORDS 3456
#define XB_SPIN_CAP (1u << 18)

__device__ __forceinline__ unsigned xb_ld(unsigned* p)              { return __hip_atomic_load(p, __ATOMIC_RELAXED, __HIP_MEMORY_SCOPE_AGENT); }
__device__ __forceinline__ unsigned xb_add(unsigned* p, unsigned v) { return __hip_atomic_fetch_add(p, v, __ATOMIC_RELAXED, __HIP_MEMORY_SCOPE_AGENT); }
__device__ __forceinline__ unsigned xb_xcc_id() { return (unsigned)__builtin_amdgcn_s_getreg((3 << 11) | 20) & 0xFu; }
#define XB_SPIN(cond, bar) do { unsigned _sp = 0; while (cond) { __builtin_amdgcn_s_sleep(1); \
    if ((++_sp & 255u) == 0u) { if (xb_ld(&(bar)[XB_TMO])) break; if (_sp > XB_SPIN_CAP) { atomicAdd(&(bar)[XB_TMO], 1u); break; } } } } while (0)

struct XcdBarrier {
    unsigned* bar; unsigned x;
    volatile LAS unsigned* st;
};

__device__ __forceinline__ XcdBarrier xcd_barrier_post(unsigned* bar, volatile LAS unsigned* st) {
    XcdBarrier b; b.bar = bar; b.x = xb_xcc_id(); b.st = st;
    if (threadIdx.x == 0) (void)xb_add(&bar[XB_XCNT(b.x)], 1u);
    return b;
}
__device__ __forceinline__ void xcd_barrier_complete(unsigned* bar, unsigned x, unsigned& nloc, unsigned& nx) {
    const unsigned G = gridDim.x * gridDim.y * gridDim.z;
    unsigned sum, cnt, mine, sp = 0u;
    for (;;) {
        sum = 0u; cnt = 0u; mine = 0u;
#pragma unroll
        for (unsigned j = 0; j < 16; ++j) { const unsigned c = xb_ld(&bar[XB_XCNT(j)]); sum += c; cnt += (c > 0u) ? 1u : 0u; mine = (j == x) ? c : mine; }
        if (sum == G) break;
        __builtin_amdgcn_s_sleep(1);
        if ((++sp & 255u) == 0u) { if (xb_ld(&bar[XB_TMO])) break; if (sp > XB_SPIN_CAP) { atomicAdd(&bar[XB_TMO], 1u); break; } }
    }
    nloc = mine > 0u ? mine : 1u; nx = cnt > 0u ? cnt : 1u;
}

__device__ __forceinline__ void xcd_barrier(const XcdBarrier& b) {
    asm volatile("s_waitcnt vmcnt(0)" ::: "memory");
    __syncthreads();
    if (threadIdx.x == 0) {
        unsigned* bar = b.bar;
        __builtin_amdgcn_s_waitcnt(0);
        unsigned nloc = b.st[0], nx = b.st[1];
        if (nloc == 0u) { xcd_barrier_complete(bar, b.x, nloc, nx); b.st[0] = nloc; b.st[1] = nx; }
        const unsigned old = xb_add(&bar[XB_XSUB(b.x)], 1u);
        const unsigned gen = old / nloc;
        if (old + 1u == (gen + 1u) * nloc) {
            __builtin_amdgcn_fence(__ATOMIC_RELEASE, "agent");
            asm volatile("s_waitcnt vmcnt(0)" ::: "memory");
            const unsigned og = xb_add(&bar[XB_TOP], 1u);
            const unsigned tg = og / nx;
            if (og + 1u == (tg + 1u) * nx) xb_add(&bar[XB_TOPGEN], 1u);
            else XB_SPIN(xb_ld(&bar[XB_TOPGEN]) == tg, bar);
            __builtin_amdgcn_fence(__ATOMIC_ACQUIRE, "agent");
            xb_add(&bar[XB_XGEN(b.x)], 1u);
            asm volatile("s_waitcnt vmcnt(0)" ::: "memory");
        } else {
            XB_SPIN(xb_ld(&bar[XB_XGEN(b.x)]) == gen, bar);
            __builtin_amdgcn_fence(__ATOMIC_ACQUIRE, "agent");
            asm volatile("s_waitcnt vmcnt(0)" ::: "memory");
        }
    }
    __syncthreads();
}

#ifndef DBG
#define DBG 0
#endif
struct Args { const void* in[22]; float* out; unsigned char* ws; int ph_lo, ph_hi; };
struct Frame {
    LAS unsigned char* lds;
    volatile LAS unsigned* MISC;
    gu32* ctl;
    int tid, lane, wave;
    int vcu, G, bx;
    unsigned char* ws; unsigned char* ws0;
    float* out; float* out0;
    const Args* ap;
};
#define INP(k) (F.ap->in[(k)])
#define DPP_F(v, ctrl) __builtin_bit_cast(float, __builtin_amdgcn_update_dpp(0, __builtin_bit_cast(int, (v)), (ctrl), 0xf, 0xf, true))
__device__ __forceinline__ float row16_sum(float v) {
    v += DPP_F(v, 0xB1);
    v += DPP_F(v, 0x4E);
    v += DPP_F(v, 0x141);
    v += DPP_F(v, 0x140);
    return v;
}
__device__ __forceinline__ float wave_sum(float v) {
    v = row16_sum(v);
    { auto r = __builtin_amdgcn_permlane16_swap(__float_as_uint(v), __float_as_uint(v), false, false); v = __uint_as_float(r[0]) + __uint_as_float(r[1]); }
    { auto r = __builtin_amdgcn_permlane32_swap(__float_as_uint(v), __float_as_uint(v), false, false); v = __uint_as_float(r[0]) + __uint_as_float(r[1]); }
    return v;
}
typedef float f32x2 __attribute__((ext_vector_type(2)));

__device__ __forceinline__ void tr_item(const float* W, int ldn, int col0, int nvalid, bf16* WT, int K, int row0, LAS float* scr, int kb, int lane) {
    const int k0 = 64 * kb, n = lane & 31;
#pragma unroll 8
    for (int i = 0; i < 32; ++i) { const int kk = 2 * i + (lane >> 5); scr[kk * 33 + n] = (n < nvalid) ? W[(size_t)(k0 + kk) * ldn + col0 + n] : 0.f; }
    LDS_WAIT(); asm volatile("" ::: "memory");
    const int c = lane & 7;
#pragma unroll
    for (int j = 0; j < 4; ++j) { const int nn = (lane >> 3) + 8 * j; const LAS float* s = scr + (8 * c) * 33 + nn;
        v4u o; o.x = pk2(s[0 * 33], s[1 * 33]); o.y = pk2(s[2 * 33], s[3 * 33]); o.z = pk2(s[4 * 33], s[5 * 33]); o.w = pk2(s[6 * 33], s[7 * 33]);
        *(GAS v4u*)(WT + (size_t)(row0 + nn) * K + k0 + 8 * c) = o; }
    LDS_WAIT(); asm volatile("" ::: "memory");
}
__device__ __forceinline__ unsigned pk4_fp8(float a, float b, float c, float d) { int p = __builtin_amdgcn_cvt_pk_fp8_f32(a, b, 0, false); return (unsigned)__builtin_amdgcn_cvt_pk_fp8_f32(c, d, p, true); }
__device__ __forceinline__ void tr_item8(const float* W, int ldn, int col0, unsigned char* WT, int K, int row0, LAS float* scr, int kb, int lane) {
    const int k0 = 64 * kb, n = lane & 31;
#pragma unroll 8
    for (int i = 0; i < 32; ++i) { const int kk = 2 * i + (lane >> 5); scr[kk * 33 + n] = W[(size_t)(k0 + kk) * ldn + col0 + n] * 64.f; }
    LDS_WAIT(); asm volatile("" ::: "memory");
    const int c = lane & 7;
#pragma unroll
    for (int j = 0; j < 4; ++j) { const int nn = (lane >> 3) + 8 * j; const LAS float* s = scr + (8 * c) * 33 + nn;
        const unsigned long long o = (unsigned long long)pk4_fp8(s[0 * 33], s[1 * 33], s[2 * 33], s[3 * 33]) | ((unsigned long long)pk4_fp8(s[4 * 33], s[5 * 33], s[6 * 33], s[7 * 33]) << 32);
        *(GAS unsigned long long*)(WT + (size_t)(row0 + nn) * K + k0 + 8 * c) = o; }
    LDS_WAIT(); asm volatile("" ::: "memory");
}
__device__ __forceinline__ void pw_phase(Frame& F, int l) {
    LAS float* scr = (LAS float*)(F.lds + RING_OFF + F.wave * 16384);
    const int gw = F.vcu * NWAVES + F.wave, NGW = F.G * NWAVES, lane = F.lane;
    unsigned char* wb = F.ws + WS_WB;
    bf16* WIN = (bf16*)(wb + WB_WIN);
    const float* w_in = (const float*)INP(3) + (size_t)l * 1024 * WIN_OLD;
    constexpr int I_A = 16 * 114, I_B = 16, I_C = 16 * 64, I_BD = 8 * 32, I_O = 16 * 32, I_PLE = 4 * 32, I_GU = 32 * 4 * 64, I_D = 32 * 128;
    constexpr int NITEMS = I_A + I_B + I_C + 2 * I_BD + 2 * I_O + I_PLE + I_GU + I_D;
    for (int it = gw; it < NITEMS; it += NGW) {
        int r = it;
        if (r < I_A) { const int kb = r / 114, nb = r % 114; tr_item(w_in, WIN_OLD, 32 * nb, 32, WIN, 1024, 32 * nb, scr, kb, lane); continue; } r -= I_A;
        if (r < I_B) { tr_item(w_in, WIN_OLD, 3648, 8, WIN, 1024, 3648, scr, r, lane); continue; } r -= I_B;
        if (r < I_C) { const int kb = r / 64, nb = r % 64; tr_item8(w_in, WIN_OLD, 3656 + 32 * nb, wb + WB_WG8, 1024, 32 * nb, scr, kb, lane); continue; } r -= I_C;
        if (r < I_BD) { tr_item((const float*)INP(6) + (size_t)l * 512 * 1024, 1024, 32 * (r % 32), 32, (bf16*)(wb + WB_WBD), 512, 32 * (r % 32), scr, r / 32, lane); continue; } r -= I_BD;
        if (r < I_BD) { tr_item((const float*)INP(7) + (size_t)l * 512 * 1024, 1024, 32 * (r % 32), 32, (bf16*)(wb + WB_WBS), 512, 32 * (r % 32), scr, r / 32, lane); continue; } r -= I_BD;
        if (r < I_O) { tr_item((const float*)INP(8) + (size_t)l * 1024 * 1024, 1024, 32 * (r % 32), 32, (bf16*)(wb + WB_WO), 1024, 32 * (r % 32), scr, r / 32, lane); continue; } r -= I_O;
        if (r < I_O) { tr_item8((const float*)INP(19) + (size_t)l * 1024 * 1024, 1024, 32 * (r % 32), wb + WB_WPG, 1024, 32 * (r % 32), scr, r / 32, lane); continue; } r -= I_O;
        if (r < I_PLE) { tr_item((const float*)INP(18) + (size_t)l * 256 * 1024, 1024, 32 * (r % 32), 32, (bf16*)(wb + WB_WPLE), 256, 32 * (r % 32), scr, r / 32, lane); continue; } r -= I_PLE;
        if (r < I_GU) { const int e = r >> 8, sub = (r >> 6) & 3, q = r & 63, kb = q >> 2, nb = q & 3;
            const float* W = ((sub & 1) ? (const float*)INP(16) : (const float*)INP(15)) + (size_t)(l * 32 + e) * 1024 * 256;
            tr_item8(W, 256, (sub >> 1) * 128 + 32 * nb, wb + WB_WGU, 1024, e * 512 + sub * 128 + 32 * nb, scr, kb, lane); continue; } r -= I_GU;
        { const int e = r >> 7, q = r & 127, kb = q >> 5, nb = q & 31;
            tr_item((const float*)INP(17) + (size_t)(l * 32 + e) * 256 * 1024, 1024, 32 * nb, 32, (bf16*)(wb + WB_WD), 256, e * 1024 + 32 * nb, scr, kb, lane); }
    }
    { unsigned z_ = 0u; asm volatile("" : "+v"(z_));
      for (int ch = F.vcu * 512 + F.tid; ch < 160 * 128; ch += F.G * 512) *(GAS v4u*)(WIN + (size_t)3680 * 1024 + (size_t)ch * 8) = (v4u){z_, z_, z_, z_}; }
    const float* p = (const float*)INP(1) + (size_t)l * NTOK * 256; bf16* PB = (bf16*)(F.ws + WS_PB);
    for (int m0 = gw; m0 < NTOK; m0 += 4 * NGW) { f32x4 v[4];
#pragma unroll
        for (int j = 0; j < 4; ++j) { const int m = min(m0 + j * NGW, NTOK - 1); v[j] = *((const GAS f32x4*)(p + (size_t)m * 256) + lane); }
#pragma unroll
        for (int j = 0; j < 4; ++j) { const int m = m0 + j * NGW; if (m < NTOK) *((GAS unsigned long long*)(PB + (size_t)m * 256) + lane) = (unsigned long long)pk2(v[j].x, v[j].y) | ((unsigned long long)pk2(v[j].z, v[j].w) << 32); } }
    if (l == 0) {
        const float* x = (const float*)INP(0); bf16* XB = (bf16*)(F.ws + WS_XB);
        for (int m0 = gw; m0 < NTOK; m0 += 2 * NGW) { f32x4 v[2][4];
#pragma unroll
            for (int r = 0; r < 2; ++r) { const int m = min(m0 + r * NGW, NTOK - 1); const GAS f32x4* xr = (const GAS f32x4*)(x + (size_t)m * 1024) + lane;
#pragma unroll
                for (int j = 0; j < 4; ++j) v[r][j] = xr[64 * j]; }
#pragma unroll
            for (int r = 0; r < 2; ++r) { const int m = m0 + r * NGW; if (m < NTOK) { GAS unsigned long long* o8 = (GAS unsigned long long*)(XB + (size_t)m * 1024) + lane;
#pragma unroll
                for (int j = 0; j < 4; ++j) { const f32x4 w = v[r][j]; o8[64 * j] = (unsigned long long)pk2(w.x, w.y) | ((unsigned long long)pk2(w.z, w.w) << 32);
                    ((GAS unsigned*)((unsigned char*)F.out + OUT_XB8 + (size_t)m * 1024) + lane)[64 * j] = pk4_fp8(w.x, w.y, w.z, w.w); } } }
        }
        const int* pos = (const int*)INP(2); float* rope = (float*)(F.ws + WS_ROPE);
        for (int idx = F.vcu * 512 + F.tid; idx < NTOK * 8; idx += F.G * 512) {
            const int m = idx >> 3, j = idx & 7; const float invf = exp2f(-2.366446071f * (float)j); const float ang = (float)pos[m] * invf;
            double rev = (double)ang * 0.15915494309189535; rev -= rint(rev);
            rope[m * 16 + j] = (DBG & 16) ? 1.f : __builtin_amdgcn_cosf((float)rev); rope[m * 16 + 8 + j] = (DBG & 16) ? 0.f : __builtin_amdgcn_sinf((float)rev);
        }
        float* WR = (float*)(F.ws + WS_SMALL + SM_WR); float* BR = (float*)(F.ws + WS_SMALL + SM_BR);
        for (int idx = F.vcu * 512 + F.tid; idx < 2 * 36 * 1024; idx += F.G * 512) {
            const int ll = idx / (36 * 1024), r = idx % (36 * 1024), j = r >> 10, k = r & 1023;
            WR[idx] = (j < 4) ? ((const float*)INP(11))[((size_t)ll * 1024 + k) * 4 + j] : ((const float*)INP(13))[((size_t)ll * 1024 + k) * 32 + (j - 4)];
        }
        if (F.vcu == 0 && F.tid < 72) { const int ll = F.tid / 36, j = F.tid % 36; BR[F.tid] = (j < 4) ? ((const float*)INP(12))[ll * 4 + j] : ((const float*)INP(14))[ll * 32 + j - 4]; }
        if (F.vcu == 0 && F.tid < 2) { const float* lp = (const float*)INP(4) + F.tid * 256; float a = 0.f, b = 0.f;
            for (int i = 0; i < 64; ++i) { a += lp[i] * lp[64 + i]; b += lp[128 + i] * lp[192 + i]; }
            const float lam_init = (F.tid == 0) ? 0.2f : 0.35550907f;
            ((float*)(F.ws + WS_SMALL + SM_LAM))[F.tid] = __expf(a) - __expf(b) + lam_init; }
    }
}

namespace idxr {
typedef float f32x16 __attribute__((ext_vector_type(16)));
typedef short s16x2 __attribute__((ext_vector_type(2)));
typedef __fp16 h16x2 __attribute__((ext_vector_type(2)));
constexpr int HROW = 513;
__device__ __forceinline__ unsigned f2key(float f) { const unsigned u = __float_as_uint(f); return u ^ ((unsigned)((int)u >> 31) | 0x80000000u); }
__device__ __forceinline__ unsigned bins2(float a, float b) {
    const unsigned h = __builtin_bit_cast(unsigned, __builtin_amdgcn_cvt_pkrtz(a, b));
    const unsigned m = __builtin_bit_cast(unsigned, (s16x2)(__builtin_bit_cast(s16x2, h) >> (s16x2){15, 15}));
    const unsigned key = h ^ (m | 0x80008000u);
    return (key >> 5) & 0x07fc07fcu;
}
__device__ __forceinline__ float f16bits(unsigned h) { return (float)__builtin_bit_cast(__fp16, (unsigned short)h); }
__device__ __forceinline__ float bin_edge(int b) {
    if (b <= 0) return -__builtin_inff();
    if (b >= 512) return __builtin_inff();
    const unsigned K = (unsigned)b << 7;
    if (K >= 0x8000u) { const unsigned H = K & 0x7fffu; return (H >= 0x7c00u) ? __builtin_inff() : f16bits(H); }
    const unsigned M1 = ((0xFFFFu ^ K) & 0x7fffu) + 1u;
    const float v = (M1 >= 0x7c00u) ? __builtin_inff() : f16bits(M1);
    return -__uint_as_float(__float_as_uint(v) - 1u);
}
__device__ __forceinline__ long moff(int tl) { return 16384L * tl - 32L * tl * (tl - 1); }
__device__ __forceinline__ void load_k2(bf16x8 (&ka)[2], bf16x8 (&kb)[2], const unsigned short* IKb, int key0, int kg0, int fr, int fq) {
#pragma unroll
    for (int ks = 0; ks < 2; ++ks) { ka[ks] = *(const bf16x8*)(IKb + (size_t)(key0 + 16 * kg0 + fr) * 64 + ks * 32 + fq * 8); kb[ks] = *(const bf16x8*)(IKb + (size_t)(key0 + 16 * kg0 + 16 + fr) * 64 + ks * 32 + fq * 8); }
}
__device__ __forceinline__ void score_half(f32x4& sa, f32x4& sb, const bf16x8 (&qf)[8][2], const bf16x8 (&ql)[2], const float (&w)[8], bf16x8 (&ka)[2], bf16x8 (&kb)[2]) {
    sa = __builtin_amdgcn_mfma_f32_16x16x32_bf16(ka[0], ql[0], (f32x4){0.f, 0.f, 0.f, 0.f}, 0, 0, 0); sb = __builtin_amdgcn_mfma_f32_16x16x32_bf16(kb[0], ql[0], (f32x4){0.f, 0.f, 0.f, 0.f}, 0, 0, 0);
    sa = __builtin_amdgcn_mfma_f32_16x16x32_bf16(ka[1], ql[1], sa, 0, 0, 0); sb = __builtin_amdgcn_mfma_f32_16x16x32_bf16(kb[1], ql[1], sb, 0, 0, 0);
    f32x4 Da[2], Db[2];
#define IDX_M(h, D) do { \
        D[0] = __builtin_amdgcn_mfma_f32_16x16x32_bf16(ka[0], qf[h][0], (f32x4){0.f, 0.f, 0.f, 0.f}, 0, 0, 0); D[1] = __builtin_amdgcn_mfma_f32_16x16x32_bf16(kb[0], qf[h][0], (f32x4){0.f, 0.f, 0.f, 0.f}, 0, 0, 0); \
        D[0] = __builtin_amdgcn_mfma_f32_16x16x32_bf16(ka[1], qf[h][1], D[0], 0, 0, 0); D[1] = __builtin_amdgcn_mfma_f32_16x16x32_bf16(kb[1], qf[h][1], D[1], 0, 0, 0); } while (0)
#define IDX_F(h, D, O) asm volatile("" : "+v"(O[0]), "+v"(O[1]));     \
        asm volatile( \
        "v_fma_f32 %0, %8, |%9|, %0\n\tv_fma_f32 %1, %8, |%10|, %1\n\tv_fma_f32 %2, %8, |%11|, %2\n\tv_fma_f32 %3, %8, |%12|, %3\n\t" \
        "v_fma_f32 %4, %8, |%13|, %4\n\tv_fma_f32 %5, %8, |%14|, %5\n\tv_fma_f32 %6, %8, |%15|, %6\n\tv_fma_f32 %7, %8, |%16|, %7" \
        : "+v"(sa[0]), "+v"(sa[1]), "+v"(sa[2]), "+v"(sa[3]), "+v"(sb[0]), "+v"(sb[1]), "+v"(sb[2]), "+v"(sb[3]) \
        : "v"(w[h]), "v"(D[0][0]), "v"(D[0][1]), "v"(D[0][2]), "v"(D[0][3]), "v"(D[1][0]), "v"(D[1][1]), "v"(D[1][2]), "v"(D[1][3])); \
        asm volatile("" : "+v"(ka[0]), "+v"(kb[0]))
    IDX_M(0, Da); IDX_M(1, Db);
    asm volatile("s_nop 7" : "+v"(Da[0]), "+v"(Da[1]), "+v"(Db[0]), "+v"(Db[1]), "+v"(sa), "+v"(sb));
#pragma unroll
    for (int h = 0; h < 6; h += 2) { IDX_F(h, Da, Db); IDX_M(h + 2, Da); IDX_F(h + 1, Db, Da); IDX_M(h + 3, Db); }
    IDX_F(6, Da, Db); asm volatile("s_nop 7" : "+v"(Db[0]), "+v"(Db[1])); IDX_F(7, Db, Da);
#undef IDX_M
#undef IDX_F
}
#define IDX_SCORE(sc, kf, key0, more) do { const int nk_ = (more) ? (key0) + 128 : (key0); \
        idxr::score_half(sc[0], sc[1], qf, ql, w, kf[0], kf[1]); idxr::load_k2(kf[0], kf[1], IKb, nk_, 0, fr, fq); \
        idxr::score_half(sc[2], sc[3], qf, ql, w, kf[2], kf[3]); idxr::load_k2(kf[2], kf[3], IKb, nk_, 2, fr, fq); } while (0)
}

__device__ __forceinline__ void indexer_unit(Frame& F, int b, int qblk, const bf16* IQ, const bf16* IK, const float* IW, unsigned long long* mask64  ) {
    using namespace idxr;
    const int lane = F.lane, fr = lane & 15, fq = lane >> 4, wid = F.wave, qgrp = wid & 3, kh = wid >> 2;
    const int qloc = 16 * qgrp + fr, q = 64 * qblk + qloc;
    const size_t row = (size_t)b * SEQ + q;
    LAS unsigned* hist = (LAS unsigned*)(F.lds + RING_OFF);
    LAS int* bstarA = (LAS int*)(F.lds + XTR_OFF + 1024); LAS int* needA = bstarA + 64; LAS float* thiA = (LAS float*)(needA + 64); LAS float* tloA = thiA + 64;
    LAS unsigned* cand = (LAS unsigned*)(F.lds + RING_OFF);
    LAS unsigned* wcnt = (LAS unsigned*)(F.lds + XTR_OFF + 2048);
    bf16x8 qf[8][2], ql[2]; float w[8];
#pragma unroll
    for (int h = 0; h < 8; ++h)
#pragma unroll
        for (int ks = 0; ks < 2; ++ks) qf[h][ks] = *(const bf16x8*)(IQ + row * 512 + h * 64 + ks * 32 + fq * 8);
    { const f32x4* wp = (const f32x4*)(IW + row * 8); const f32x4 w0 = wp[0], w1 = wp[1]; w[0] = 0.5f * w0.x; w[1] = 0.5f * w0.y; w[2] = 0.5f * w0.z; w[3] = 0.5f * w0.w; w[4] = 0.5f * w1.x; w[5] = 0.5f * w1.y; w[6] = 0.5f * w1.z; w[7] = 0.5f * w1.w; }
#pragma unroll
    for (int ks = 0; ks < 2; ++ks) {
        float acc8[8];
#pragma unroll
        for (int e = 0; e < 8; ++e) acc8[e] = 0.f;
#pragma unroll
        for (int h = 0; h < 8; ++h)
#pragma unroll
            for (int e = 0; e < 8; ++e) acc8[e] = __builtin_fmaf(w[h], __uint_as_float((unsigned)(unsigned short)qf[h][ks][e] << 16), acc8[e]);
#pragma unroll
        for (int e = 0; e < 8; e += 2) { const unsigned pk = pg8::cvt_pk_bf16(acc8[e], acc8[e + 1]); ql[ks][e] = (short)(pk & 0xffffu); ql[ks][e + 1] = (short)(pk >> 16); }
    }
    for (int i = F.tid; i < 64 * HROW; i += NWAVES * 64) hist[i] = 0u;
    __syncthreads();
    const unsigned short* IKb = IK + (size_t)b * SEQ * 64;
    const int qmin_w = 64 * qblk + 16 * qgrp;
    const unsigned hrowb = (unsigned)(size_t)(hist + qloc * HROW);
#define IDX_HADD(off_) __hip_atomic_fetch_add((LAS unsigned*)(hrowb + (off_)), 1u, __ATOMIC_RELAXED, __HIP_MEMORY_SCOPE_WORKGROUP)
    {
        bf16x8 kf[4][2];
        if (kh <= qblk) { load_k2(kf[0], kf[1], IKb, 64 * kh, 0, fr, fq); load_k2(kf[2], kf[3], IKb, 64 * kh, 2, fr, fq); }
#pragma unroll 1
        for (int tl = kh; tl <= qblk; tl += 2) {
            const int key0 = 64 * tl; f32x4 sc[4]; IDX_SCORE(sc, kf, key0, tl + 2 <= qblk);
            if (key0 + 63 <= qmin_w) {
#pragma unroll
                for (int kg = 0; kg < 4; ++kg) { const unsigned p0 = bins2(sc[kg][0], sc[kg][1]), p1 = bins2(sc[kg][2], sc[kg][3]);
                    IDX_HADD(p0 & 0xffffu); IDX_HADD(p0 >> 16); IDX_HADD(p1 & 0xffffu); IDX_HADD(p1 >> 16); __builtin_amdgcn_sched_barrier(0); }
            } else {
                int fq_ = fq, q_ = q; asm volatile("" : "+v"(fq_), "+v"(q_));
#pragma unroll
                for (int kg = 0; kg < 4; ++kg) { const unsigned p0 = bins2(sc[kg][0], sc[kg][1]), p1 = bins2(sc[kg][2], sc[kg][3]); const int kb = key0 + 16 * kg + 4 * fq_;
                    if (kb <= q_) IDX_HADD(p0 & 0xffffu); if (kb + 1 <= q_) IDX_HADD(p0 >> 16); if (kb + 2 <= q_) IDX_HADD(p1 & 0xffffu); if (kb + 3 <= q_) IDX_HADD(p1 >> 16); __builtin_amdgcn_sched_barrier(0); }
            }
        }
    }
#undef IDX_HADD
    __syncthreads();
#pragma unroll 1
    for (int qq = wid * 8; qq < wid * 8 + 8; ++qq) {
        const LAS unsigned* hr = hist + qq * HROW + lane * 8;
        unsigned wv[8]; unsigned s = 0;
#pragma unroll
        for (int k = 0; k < 8; ++k) { wv[k] = hr[k]; s += wv[k]; }
        unsigned v = s;
#pragma unroll
        for (int off = 1; off < 64; off <<= 1) { const unsigned t = __shfl_down(v, off); if (lane + off < 64) v += t; }
        const unsigned above = v - s, total = __shfl(v, 0);
        if (total > 256u) {
            if (above < 256u && v >= 256u) {
                unsigned c = above; int found = -1, need = 0;
#pragma unroll
                for (int k = 7; k >= 0; --k) { if (found < 0) { if (c + wv[k] >= 256u) { found = k; need = 256 - (int)c; } else c += wv[k]; } }
                bstarA[qq] = lane * 8 + found; needA[qq] = need; thiA[qq] = bin_edge(lane * 8 + found + 1); tloA[qq] = bin_edge(lane * 8 + found);
            }
        } else if (lane == 0) { bstarA[qq] = -1; needA[qq] = 0; thiA[qq] = -__builtin_inff(); tloA[qq] = -__builtin_inff(); }
    }
    __syncthreads();
    const float thi = thiA[qloc], tlo = tloA[qloc];
    unsigned ncand = 0u; LAS unsigned* const cbase = cand + (qloc * 8 + fq + 4 * kh) * 64;
#define IDX_EL(scv_, krel_) do { const float v_ = (scv_); \
        if (FULL_) { asm volatile("v_cmp_ge_f32 vcc, %2, %3\n\tv_addc_co_u32 %0, vcc, %0, %0, vcc\n\tv_cmp_ge_f32 vcc, %2, %4\n\tv_addc_co_u32 %1, vcc, %1, %1, vcc" : "+v"(nh_), "+v"(nl_) : "v"(v_), "v"(thi), "v"(tlo) : "vcc"); } \
        else { const bool ok_ = key0 + (krel_) <= q_; nh_ = nh_ + nh_ + ((ok_ && v_ >= thi) ? 1u : 0u); nl_ = nl_ + nl_ + ((ok_ && v_ >= tlo) ? 1u : 0u); } } while (0)
#define IDX_HALF(ka, kb, W_, C_) do { unsigned nh_ = 0u, nl_ = 0u; const int kr = 4 * fq_; \
        IDX_EL(sc[kb][3], 16 * kb + kr + 3); IDX_EL(sc[kb][2], 16 * kb + kr + 2); IDX_EL(sc[kb][1], 16 * kb + kr + 1); IDX_EL(sc[kb][0], 16 * kb + kr); nh_ <<= 12; nl_ <<= 12; \
        IDX_EL(sc[ka][3], 16 * ka + kr + 3); IDX_EL(sc[ka][2], 16 * ka + kr + 2); IDX_EL(sc[ka][1], 16 * ka + kr + 1); IDX_EL(sc[ka][0], 16 * ka + kr); \
        W_ = nh_ << kr; C_ = nl_ & ~nh_; __builtin_amdgcn_sched_barrier(0); } while (0)
#define IDX_ELS() do { IDX_HALF(0, 1, wlo, clo); IDX_HALF(2, 3, whi, chi); } while (0)
    {
        bf16x8 kf[4][2];
        if (kh <= qblk) { load_k2(kf[0], kf[1], IKb, 64 * kh, 0, fr, fq); load_k2(kf[2], kf[3], IKb, 64 * kh, 2, fr, fq); }
#pragma unroll 1
        for (int tl = kh; tl <= qblk; tl += 2) {
            const int key0 = 64 * tl; unsigned long long* mword = mask64 + (moff(tl) + (q - key0)); f32x4 sc[4]; IDX_SCORE(sc, kf, key0, tl + 2 <= qblk);
            unsigned wlo = 0u, whi = 0u, clo = 0u, chi = 0u; int fq_ = fq, q_ = q; asm volatile("" : "+v"(fq_), "+v"(q_));
            if (key0 + 63 <= qmin_w) {
#define FULL_ true
                IDX_ELS();
#undef FULL_
            } else {
#define FULL_ false
                IDX_ELS();
#undef FULL_
            }
            unsigned cb = clo | (chi << 4);
            if (cb != 0u) {
#pragma unroll 1
                while (cb != 0u) {
                    const int j = __builtin_ctz(cb); cb &= cb - 1u;
                    const bool b0 = (j & 1) != 0, b1 = (j & 2) != 0, b2 = (j & 4) != 0, b4 = (j & 16) != 0;
                    float y[4];
#pragma unroll
                    for (int kg = 0; kg < 4; ++kg) { const float x0 = b0 ? sc[kg][1] : sc[kg][0], x1 = b0 ? sc[kg][3] : sc[kg][2]; y[kg] = b1 ? x1 : x0; }
                    const float z0 = b4 ? y[1] : y[0], z1 = b4 ? y[3] : y[2]; const float v_ = b2 ? z1 : z0;
                    const int krel = 16 * ((b4 ? 1 : 0) + (b2 ? 2 : 0)) + 4 * fq_ + (j & 3);
                    if (ncand < 64u) cbase[ncand] = ((f2key(v_) & 0xffff8u) << 11) | (unsigned)(16383 - (key0 + krel)); ++ncand;
                }
            }
            { auto r_ = __builtin_amdgcn_permlane16_swap(wlo, wlo, false, false); wlo = r_[0] | r_[1]; r_ = __builtin_amdgcn_permlane16_swap(whi, whi, false, false); whi = r_[0] | r_[1];
              r_ = __builtin_amdgcn_permlane32_swap(wlo, wlo, false, false); wlo = r_[0] | r_[1]; r_ = __builtin_amdgcn_permlane32_swap(whi, whi, false, false); whi = r_[0] | r_[1]; }
            if (fq == 0) *mword = ((unsigned long long)whi << 32) | wlo;
        }
    }
#undef IDX_EL
#undef IDX_HALF
#undef IDX_ELS
    wcnt[qloc * 8 + fq + 4 * kh] = ncand < 64u ? ncand : 64u;
    VM_WAIT();
    __syncthreads();
#pragma unroll 1
    for (int qq = wid * 8; qq < wid * 8 + 8; ++qq) {
        const int need = needA[qq];
        if (need == 0) continue;
        unsigned e[8];
#pragma unroll
        for (int j = 0; j < 8; ++j) { const unsigned c = wcnt[qq * 8 + j]; e[j] = ((unsigned)lane < c) ? (cand[(qq * 8 + j) * 64 + lane] | 0x80000000u) : 0u; }
        unsigned T = 0x80000000u;
#pragma unroll 1
        for (int bit = 30; bit >= 0; --bit) { const unsigned c = T | (1u << bit); int cnt = 0;
#pragma unroll
            for (int j = 0; j < 8; ++j) cnt += __builtin_popcountll(__ballot(e[j] >= c));
            if (cnt >= need) T = c; }
        const int qglob = 64 * qblk + qq;
#pragma unroll
        for (int j = 0; j < 8; ++j) if (e[j] >= T) { const int kidx = 16383 - (int)(e[j] & 0x3fffu); const int tl = kidx >> 6;
            __hip_atomic_fetch_or(mask64 + (moff(tl) + (qglob - 64 * tl)), 1ull << (kidx & 63), __ATOMIC_RELAXED, __HIP_MEMORY_SCOPE_AGENT); }
    }
    __syncthreads();
}

__device__ __forceinline__ void ya_phase(Frame& F, int l) {
    const int gw = F.vcu * NWAVES + F.wave, NGW = F.G * NWAVES, lane = F.lane;
    const bf16* O0 = (const bf16*)(F.ws + WS_O0); const bf16* O1 = (const bf16*)(F.ws + WS_O1); bf16* YA = (bf16*)(F.ws + WS_YA);
    const float lam = (DBG & 8) ? 0.f : ((const float*)(F.ws + WS_SMALL + SM_LAM))[l];
    const float lam_init = (l == 0) ? 0.2f : 0.35550907f;
    const float* gp = (const float*)INP(5) + l * 128 + (lane & 15) * 8;
    float gg[8];
#pragma unroll
    for (int i = 0; i < 8; ++i) gg[i] = gp[i] * (1.f - lam_init);
    for (int m0 = gw; m0 < NTOK; m0 += 4 * NGW) { v4u a4[4], c4[4];
#pragma unroll
      for (int j = 0; j < 4; ++j) { const int m = min(m0 + j * NGW, NTOK - 1); a4[j] = *(const GAS v4u*)(O0 + (size_t)m * 512 + lane * 8); c4[j] = *(const GAS v4u*)(O1 + (size_t)m * 512 + lane * 8); }
#pragma unroll
      for (int j = 0; j < 4; ++j) { const int m = m0 + j * NGW; if (m >= NTOK) break; const v4u a = a4[j], c = c4[j];
        f32x4 a0, a1, c0, c1; pg8::unpack8(a, a0, a1); pg8::unpack8(c, c0, c1);
        f32x4 d0 = a0 - c0 * lam, d1 = a1 - c1 * lam;
        float ss = (d0.x * d0.x + d0.y * d0.y) + (d0.z * d0.z + d0.w * d0.w) + (d1.x * d1.x + d1.y * d1.y) + (d1.z * d1.z + d1.w * d1.w);
        ss = row16_sum(ss);
        const float rs = 1.0f / sqrtf(ss * (1.0f / 128.0f) + LN_EPS);
        f32x4 o0 = {d0.x * rs * gg[0], d0.y * rs * gg[1], d0.z * rs * gg[2], d0.w * rs * gg[3]}, o1 = {d1.x * rs * gg[4], d1.y * rs * gg[5], d1.z * rs * gg[6], d1.w * rs * gg[7]};
        *(GAS v4u*)(YA + (size_t)m * 512 + lane * 8) = pg8::pack8(o0, o1);
      }
    }
}

__device__ __forceinline__ void ya_unit(Frame& F, int l, int b, int h, int qb) {
    const int lane = F.lane;
    const bf16* O0 = (const bf16*)(F.ws + WS_O0); const bf16* O1 = (const bf16*)(F.ws + WS_O1); bf16* YA = (bf16*)(F.ws + WS_YA);
    const float lam = (DBG & 8) ? 0.f : ((const float*)(F.ws + WS_SMALL + SM_LAM))[l];
    const float lam_init = (l == 0) ? 0.2f : 0.35550907f;
    const float* gp = (const float*)INP(5) + l * 128 + (lane & 15) * 8;
    float gg[8];
#pragma unroll
    for (int i = 0; i < 8; ++i) gg[i] = gp[i] * (1.f - lam_init);
    const size_t e0 = ((size_t)b * SEQ + (size_t)qb * 256 + F.wave * 4 + (lane >> 4)) * 512 + h * 128 + (lane & 15) * 8;
    v4u a8[8], c8[8];
#pragma unroll
    for (int it = 0; it < 8; ++it) { a8[it] = *(const GAS v4u*)(O0 + e0 + (size_t)it * 32 * 512); c8[it] = *(const GAS v4u*)(O1 + e0 + (size_t)it * 32 * 512); }
#pragma unroll
    for (int it = 0; it < 8; ++it) {
        f32x4 a0, a1, c0, c1; pg8::unpack8(a8[it], a0, a1); pg8::unpack8(c8[it], c0, c1);
        f32x4 d0 = a0 - c0 * lam, d1 = a1 - c1 * lam;
        float ss = (d0.x * d0.x + d0.y * d0.y) + (d0.z * d0.z + d0.w * d0.w) + (d1.x * d1.x + d1.y * d1.y) + (d1.z * d1.z + d1.w * d1.w);
        ss = row16_sum(ss);
        const float rs = 1.0f / sqrtf(ss * (1.0f / 128.0f) + LN_EPS);
        f32x4 o0 = {d0.x * rs * gg[0], d0.y * rs * gg[1], d0.z * rs * gg[2], d0.w * rs * gg[3]}, o1 = {d1.x * rs * gg[4], d1.y * rs * gg[5], d1.z * rs * gg[6], d1.w * rs * gg[7]};
        *(GAS v4u*)(YA + e0 + (size_t)it * 32 * 512) = pg8::pack8(o0, o1);
    }
}

__device__ __forceinline__ void ln_row(f32x4 (&v)[4], const float* g, const float* bb, int lane) {
    float s = 0.f;
#pragma unroll
    for (int j = 0; j < 4; ++j) s += (v[j].x + v[j].y) + (v[j].z + v[j].w);
    const float mean = wave_sum(s) * (1.f / 1024.f); float s2 = 0.f;
#pragma unroll
    for (int j = 0; j < 4; ++j) { v[j] = v[j] - mean; s2 += (v[j].x * v[j].x + v[j].y * v[j].y) + (v[j].z * v[j].z + v[j].w * v[j].w); }
    const float rstd = 1.f / sqrtf(wave_sum(s2) * (1.f / 1024.f) + LN_EPS);
#pragma unroll
    for (int j = 0; j < 4; ++j) { const f32x4 gv = *((const f32x4*)g + lane + 64 * j), bv = *((const f32x4*)bb + lane + 64 * j); v[j] = v[j] * rstd * gv + bv; }
}

__device__ __forceinline__ void ln1_router_phase(Frame& F, int l) {
    const int gw = F.vcu * NWAVES + F.wave, NGW = F.G * NWAVES, lane = F.lane;
    const bf16* PRE = (const bf16*)(F.ws + WS_PRE1); bf16* X1B = (bf16*)(F.ws + WS_XB);
    const float* g1 = (const float*)INP(9) + l * 1024; const float* b1 = (const float*)INP(10) + l * 1024;
    const float* WR = (const float*)(F.ws + WS_SMALL + SM_WR) + (size_t)l * 36 * 1024; const float* BR = (const float*)(F.ws + WS_SMALL + SM_BR) + l * 36;
    int* route_e = (int*)(F.ws + WS_ROUTE + RT_E); float* route_c = (float*)(F.ws + WS_ROUTE + RT_C);
    LAS unsigned* rhist = (LAS unsigned*)(F.lds + XTR_OFF + 1536);
    if (F.tid < 32) rhist[F.tid] = 0u;
    LAS f32x4* wlds = (LAS f32x4*)(F.lds + RING_OFF); LAS float* blds = (LAS float*)(F.lds + XTR_OFF + 1024);
    { const GAS f32x4* src = (const GAS f32x4*)(WR + 4 * 1024);
#pragma unroll
      for (int i = 0; i < 16; ++i) wlds[F.tid + 512 * i] = src[F.tid + 512 * i];
      if (F.tid < 32) blds[F.tid] = BR[4 + F.tid]; }
    f32x4 wg[4][4]; float bg[4];
#pragma unroll
    for (int j = 0; j < 4; ++j) { bg[j] = BR[j];
#pragma unroll
        for (int c = 0; c < 4; ++c) wg[j][c] = ((const GAS f32x4*)(WR + j * 1024))[lane + 64 * c]; }
    __syncthreads();
    unsigned long long nx[4];
    { const GAS unsigned long long* pr = (const GAS unsigned long long*)(PRE + (size_t)min(gw, NTOK - 1) * 1024) + lane;
#pragma unroll
      for (int j = 0; j < 4; ++j) nx[j] = pr[64 * j]; }
    for (int m = gw; m < NTOK; m += NGW) {
        unsigned long long cu[4];
#pragma unroll
        for (int j = 0; j < 4; ++j) cu[j] = nx[j];
        { const GAS unsigned long long* pr = (const GAS unsigned long long*)(PRE + (size_t)min(m + NGW, NTOK - 1) * 1024) + lane;
#pragma unroll
          for (int j = 0; j < 4; ++j) nx[j] = pr[64 * j]; }
        f32x4 v[4];
#pragma unroll
        for (int j = 0; j < 4; ++j) { const unsigned long long a = cu[j]; const unsigned a0 = (unsigned)a, a1 = (unsigned)(a >> 32); v[j] = (f32x4){pg8::bf_lo(a0), pg8::bf_hi(a0), pg8::bf_lo(a1), pg8::bf_hi(a1)}; }
        ln_row(v, g1, b1, lane);
        GAS unsigned long long* o8 = (GAS unsigned long long*)(X1B + (size_t)m * 1024) + lane;
#pragma unroll
        for (int j = 0; j < 4; ++j) { o8[64 * j] = (unsigned long long)pk2(v[j].x, v[j].y) | ((unsigned long long)pk2(v[j].z, v[j].w) << 32);
            ((GAS unsigned*)((unsigned char*)F.out + OUT_X1B8 + (size_t)m * 1024) + lane)[64 * j] = pk4_fp8(v[j].x, v[j].y, v[j].z, v[j].w); }
        float lg[4];
#pragma unroll
        for (int j = 0; j < 4; ++j) { float s_ = 0.f;
#pragma unroll
            for (int c = 0; c < 4; ++c) s_ += (v[c].x * wg[j][c].x + v[c].y * wg[j][c].y) + (v[c].z * wg[j][c].z + v[c].w * wg[j][c].w);
            lg[j] = wave_sum(s_) + bg[j]; }
        int gi = 0; float gm = lg[0];
#pragma unroll
        for (int i = 1; i < 4; ++i) if (lg[i] > gm) { gm = lg[i]; gi = i; }
        float gs = 0.f;
#pragma unroll
        for (int i = 0; i < 4; ++i) gs += __expf(lg[i] - gm);
        const float gval = 1.f / gs;
        gi = __builtin_amdgcn_readfirstlane(gi);
        float el[8];
        { const LAS f32x4* wrow = wlds + gi * 8 * 256 + lane; float part[8];
#pragma unroll
          for (int k = 0; k < 8; ++k) { float s_ = 0.f;
#pragma unroll
              for (int c = 0; c < 4; ++c) { const f32x4 w4 = wrow[k * 256 + 64 * c]; s_ += (v[c].x * w4.x + v[c].y * w4.y) + (v[c].z * w4.z + v[c].w * w4.w); }
              part[k] = s_; }
#pragma unroll
          for (int k = 0; k < 8; ++k) el[k] = wave_sum(part[k]) + blds[gi * 8 + k]; }
        int i0 = 0; float m0 = el[0];
#pragma unroll
        for (int k = 1; k < 8; ++k) if (el[k] > m0) { m0 = el[k]; i0 = k; }
        int i1 = -1; float m1 = -INFINITY;
#pragma unroll
        for (int k = 0; k < 8; ++k) if (k != i0 && el[k] > m1) { m1 = el[k]; i1 = k; }
        const float c0 = gval / (1.f + __expf(m1 - m0)), c1 = gval - c0;
        if (lane == 0) {
            const int e0 = gi * 8 + i0, e1 = gi * 8 + i1;
            route_e[m * 2] = e0; route_e[m * 2 + 1] = e1; route_c[m * 2] = c0; route_c[m * 2 + 1] = c1;
            __hip_atomic_fetch_add(rhist + e0, 1u, __ATOMIC_RELAXED, __HIP_MEMORY_SCOPE_WORKGROUP); __hip_atomic_fetch_add(rhist + e1, 1u, __ATOMIC_RELAXED, __HIP_MEMORY_SCOPE_WORKGROUP);
        }
    }
    __syncthreads();
    if (F.tid < 32) ((int*)(F.ws + WS_ROUTE + RT_HIST))[F.vcu * 32 + F.tid] = (int)rhist[F.tid];
}

__device__ __forceinline__ void lists_phase(Frame& F, int l) {
    const int tid = F.tid, NGW = F.G * NWAVES;
    const int* wghist = (const int*)(F.ws + WS_ROUTE + RT_HIST);
    const int* route_e = (const int*)(F.ws + WS_ROUTE + RT_E); const float* route_c = (const float*)(F.ws + WS_ROUTE + RT_C);
    int* gtot = (int*)(F.ws + WS_ROUTE + RT_TOT);
    int* list_row = (int*)(F.ws + WS_ROUTE + RT_ROW); int* list_ent = (int*)(F.ws + WS_ROUTE + RT_ENT); float* list_c = (float*)(F.ws + WS_ROUTE + RT_CW);
    LAS int* part = (LAS int*)(F.lds + RING_OFF);
    LAS int* earr = (LAS int*)(F.lds + XTR_OFF + 2048);
    LAS int* tot = (LAS int*)(F.lds + XTR_OFF + 3072); LAS int* wgoff = tot + 32; LAS int* mbase = wgoff + 32;
    { const int e = tid & 31, pt = tid >> 5; int t = 0, pre = 0;
      for (int w2 = pt * 16; w2 < pt * 16 + 16; ++w2) if (w2 < F.G) { const int h = wghist[w2 * 32 + e]; t += h; if (w2 < F.vcu) pre += h; }
      part[pt * 64 + e] = t; part[pt * 64 + 32 + e] = pre; }
    __syncthreads();
    if (tid < 32) { int t = 0, pre = 0; for (int pt = 0; pt < 16; ++pt) { t += part[pt * 64 + tid]; pre += part[pt * 64 + 32 + tid]; } tot[tid] = t; wgoff[tid] = pre; }
    __syncthreads();
    if (tid == 0) { int bse = 0; for (int e = 0; e < 32; ++e) { mbase[e] = bse; bse += (tot[e] + 255) & ~255; } mbase[32] = bse; }
    __syncthreads();
    int myE = -1, myTok = 0, mySlot = 0;
    if (tid < 256) { const int n = tid >> 1; mySlot = tid & 1; myTok = F.vcu * NWAVES + (n & 7) + NGW * (n >> 3); myE = route_e[myTok * 2 + mySlot]; earr[tid] = myE; }
    __syncthreads();
    if (tid < 256) { int rk = 0; for (int t2 = 0; t2 < tid; ++t2) rk += (earr[t2] == myE) ? 1 : 0;
        const int pos = mbase[myE] + wgoff[myE] + rk;
        list_row[pos] = myTok; list_ent[pos] = myTok * 2 + mySlot; list_c[pos] = route_c[myTok * 2 + mySlot]; }
    if (F.vcu == 0) {
        if (tid < 33) gtot[tid] = mbase[tid];
        const int e = tid >> 4;
        for (int pos = mbase[e] + tot[e] + (tid & 15); pos < mbase[e + 1]; pos += 16) { list_row[pos] = 0; list_ent[pos] = -1; list_c[pos] = 0.f; }
    }
}

struct TailSched {
    int first, count; long tstride;
    __device__ __forceinline__ bool next(int i, pg8::Unit& u) const { if (i >= count) return false; const long L = first + i; u.pm = (int)(L >> 2); u.pn = (int)L & 3; u.boff = (long)u.pn * tstride; return true; }
};
struct GroupSched {
    int nunits, G, c, shift; const LAS int* tile_e; long estride, substride;
    __device__ __forceinline__ bool next(int i, pg8::Unit& u) const {
        const long L = (long)i * G + c; if (L >= nunits) return false;
        const int rt = (int)(L >> shift), sub = (int)L & ((1 << shift) - 1), e = tile_e[rt];
        u.pm = rt; u.pn = sub; u.boff = (long)e * estride + (long)sub * substride; return true;
    }
};
__device__ __forceinline__ int build_tile_table(Frame& F) {
    const int* gtot = (const int*)(F.ws + WS_ROUTE + RT_TOT);
    LAS int* tile_e = (LAS int*)(F.lds + XTR_OFF);
    const int T = gtot[32] >> 8;
    for (int rt = F.tid; rt < T; rt += NWAVES * 64) { int e = 0; for (int k = 1; k < 32; ++k) if (gtot[k] <= rt * 256) e = k; tile_e[rt] = e; }
    __syncthreads();
    return T;
}

__device__ __forceinline__ void ln2_phase(Frame& F, int l) {
    const int gw = F.vcu * NWAVES + F.wave, NGW = F.G * NWAVES, lane = F.lane;
    const bf16* X1 = (const bf16*)(F.ws + WS_XB); const bf16* Y0 = (const bf16*)(F.ws + WS_Y0); const bf16* Y1 = (const bf16*)(F.ws + WS_Y1); const bf16* PLE = (const bf16*)(F.ws + WS_PLE);
    const float* g2 = (const float*)INP(20) + l * 1024; const float* b2 = (const float*)INP(21) + l * 1024;
    bf16* XB = (bf16*)(F.ws + WS_XB);
    for (int m = gw; m < NTOK; m += NGW) {
        const GAS unsigned long long* xr = (const GAS unsigned long long*)(X1 + (size_t)m * 1024) + lane;
        const GAS unsigned long long* y0 = (const GAS unsigned long long*)(Y0 + (size_t)m * 1024) + lane; const GAS unsigned long long* y1 = (const GAS unsigned long long*)(Y1 + (size_t)m * 1024) + lane;
        const GAS unsigned long long* pl = (const GAS unsigned long long*)(PLE + (size_t)m * 1024) + lane;
        f32x4 v[4];
#pragma unroll
        for (int j = 0; j < 4; ++j) { const unsigned long long xq = xr[64 * j]; const unsigned xq0 = (unsigned)xq, xq1 = (unsigned)(xq >> 32); const f32x4 x = {pg8::bf_lo(xq0), pg8::bf_hi(xq0), pg8::bf_lo(xq1), pg8::bf_hi(xq1)};
            const unsigned long long a = y0[64 * j], c = y1[64 * j], d = pl[64 * j];
            const unsigned a0 = (unsigned)a, a1 = (unsigned)(a >> 32), c0 = (unsigned)c, c1 = (unsigned)(c >> 32), d0 = (unsigned)d, d1 = (unsigned)(d >> 32);
            const float km = (DBG & 1) ? 0.f : 1.f, kp = (DBG & 2) ? 0.f : 1.f;
            v[j].x = x.x * ALPHA + km * (pg8::bf_lo(a0) + pg8::bf_lo(c0)) + kp * pg8::bf_lo(d0); v[j].y = x.y * ALPHA + km * (pg8::bf_hi(a0) + pg8::bf_hi(c0)) + kp * pg8::bf_hi(d0);
            v[j].z = x.z * ALPHA + km * (pg8::bf_lo(a1) + pg8::bf_lo(c1)) + kp * pg8::bf_lo(d1); v[j].w = x.w * ALPHA + km * (pg8::bf_hi(a1) + pg8::bf_hi(c1)) + kp * pg8::bf_hi(d1); }
        ln_row(v, g2, b2, lane);
#if CHK
        if (l == DEPTH - 1 && __hip_atomic_load(F.ctl + CW_CHK, RLX_AGENT) != 0u) { const float qn = __builtin_nanf(""); v[0] = (f32x4){qn, qn, qn, qn}; }
#endif
        if (l + 1 == DEPTH) { GAS f32x4* o = (GAS f32x4*)(F.out + (size_t)m * 1024) + lane;
#pragma unroll
            for (int j = 0; j < 4; ++j) o[64 * j] = v[j]; }
        if (l + 1 < DEPTH) { GAS unsigned long long* o8 = (GAS unsigned long long*)(XB + (size_t)m * 1024) + lane;
#pragma unroll
            for (int j = 0; j < 4; ++j) { o8[64 * j] = (unsigned long long)pk2(v[j].x, v[j].y) | ((unsigned long long)pk2(v[j].z, v[j].w) << 32);
                ((GAS unsigned*)((unsigned char*)F.out + OUT_XB8 + (size_t)m * 1024) + lane)[64 * j] = pk4_fp8(v[j].x, v[j].y, v[j].z, v[j].w); } }
    }
}


#if CHK
__device__ __forceinline__ void chk_fail(Frame& F, unsigned code) { __hip_atomic_store(F.ctl + CW_CHK, code, RLX_AGENT); }
__device__ __forceinline__ float bf2f(unsigned short v) { return __uint_as_float((unsigned)v << 16); }
__device__ __forceinline__ unsigned hash32(unsigned x) { x ^= x >> 16; x *= 0x7feb352du; x ^= x >> 15; x *= 0x846ca68bu; x ^= x >> 16; return x; }
__device__ __forceinline__ bool close_to(float got, float want, float rel, float ab) { return fabsf(got - want) <= ab + rel * fabsf(want) && got == got; }
__device__ __forceinline__ void cs_ref(float ang, float& c, float& s) {
    double rev = (double)ang * 0.15915494309189535; rev -= rint(rev); const double x = rev * 6.283185307179586, x2 = x * x;
    double tc = 1.0, ts = x, sc = 1.0, ss = x;
#pragma unroll 1
    for (int k = 1; k <= 14; ++k) { tc *= -x2 / (double)((2 * k - 1) * (2 * k)); ts *= -x2 / (double)((2 * k) * (2 * k + 1)); sc += tc; ss += ts; }
    c = (float)sc; s = (float)ss;
}
__device__ __forceinline__ void chk_proj(Frame& F) {
    const float* x = (const float*)INP(0); const float* w_in = (const float*)INP(3); const int* pos = (const int*)INP(2);
    const int gw = F.vcu * NWAVES + F.wave, lane = F.lane;
    for (int it = 0; it < 4; ++it) {
        const unsigned h = hash32((unsigned)(gw * 4 + it) * 2654435761u + 12345u);
        const int m = (int)(h % (unsigned)NTOK), col = (int)((h >> 7) % 3656u);
        int t, cw; if (col < 3584) { t = col >> 9; cw = col & 511; } else if (col < 3648) { t = 7; cw = col - 3584; } else { t = 8; cw = col - 3648; }
        const int d = cw & 63; const bool roped = (t == 0 || t == 1 || t == 3 || t == 4 || t == 6 || t == 7) && d < 16;
        const int pcol = roped ? (d < 8 ? col + 8 : col - 8) : col;
        float a = 0.f, b2 = 0.f;
        for (int k = lane; k < 1024; k += 64) { const float xv = x[(size_t)m * 1024 + k]; a += xv * w_in[(size_t)k * WIN_OLD + col]; b2 += xv * w_in[(size_t)k * WIN_OLD + pcol]; }
        a = wave_sum(a); b2 = wave_sum(b2);
        float val = a;
        if (roped) { const int j = d & 7; const float invf = 1.0f / powf(500000.0f, (float)j * 0.125f); float c, s; cs_ref((float)pos[m] * invf, c, s); val = (d < 8) ? a * c - b2 * s : a * c + b2 * s; }
        const float sc = (t == 0 || t == 3) ? pg8::C2 : (t == 6 ? 0.125f : (t == 8 ? 0.35355339059f : 1.f));
        val *= sc;
        float got;
        if (t < 7) got = bf2f(((const bf16*)(F.ws + WS_DQ + (size_t)t * TSTRIDE))[(size_t)m * 512 + cw]);
        else if (t == 7) got = bf2f(((const bf16*)(F.ws + WS_IK))[(size_t)m * 64 + cw]);
        else got = ((const float*)(F.ws + WS_IW))[(size_t)m * 8 + cw];
        if (lane == 0 && !close_to(got, val, 0.02f, 0.02f)) chk_fail(F, 0x100u + (unsigned)t);
    }
}
__device__ __forceinline__ void chk_attn(Frame& F) {
    LAS float* red = (LAS float*)(F.lds + RING_OFF);
    const unsigned h = hash32((unsigned)F.vcu * 977u + 7u);
    const int a = F.vcu % 48, t = (F.vcu < 8) ? (int)(h % 300u) : (int)(h % (unsigned)SEQ);
    int b, hq, hv; const bf16 *Q, *K, *V, *O; bool masked = false;
    if (a < 32) { b = a >> 4; const int hh = (a >> 2) & 3, c = (a >> 1) & 1, hf = a & 1; hq = 2 * hh + c; hv = 2 * hh + hf;
        Q = (const bf16*)(F.ws + WS_DQ); K = (const bf16*)(F.ws + WS_DQ + TSTRIDE); V = (const bf16*)(F.ws + WS_DQ + 2 * TSTRIDE); O = (const bf16*)(F.ws + (c ? WS_O1 : WS_O0)); }
    else { b = (a - 32) >> 3; hq = hv = (a - 32) & 7; masked = true;
        Q = (const bf16*)(F.ws + WS_DQ + 3 * TSTRIDE); K = (const bf16*)(F.ws + WS_DQ + 4 * TSTRIDE); V = (const bf16*)(F.ws + WS_DQ + 5 * TSTRIDE); O = (const bf16*)(F.ws + WS_YB); }
    const unsigned long long* MK = (const unsigned long long*)(F.ws + WS_MASK) + (size_t)b * MASK_BSTRIDE;
    const size_t row = (size_t)b * SEQ + t;
    if (F.tid < 66) red[F.tid] = (F.tid == 0) ? -1e30f : 0.f;
    __syncthreads();
    float mx = -1e30f;
    for (int s = F.tid; s <= t; s += 512) {
        if (masked) { const int tl = s >> 6; const unsigned long long w = MK[idxr::moff(tl) + (t - 64 * tl)]; if (!((w >> (s & 63)) & 1ull)) continue; }
        float lg = 0.f; for (int d = 0; d < 64; ++d) lg += bf2f(Q[row * 512 + hq * 64 + d]) * bf2f(K[((size_t)b * SEQ + s) * 512 + hq * 64 + d]);
        mx = fmaxf(mx, lg);
    }
    for (int o = 1; o < 64; o <<= 1) mx = fmaxf(mx, __shfl_xor(mx, o));
    if (F.lane == 0) { float old = red[0]; while (mx > old) { const unsigned prev = atomicCAS((unsigned*)&red[0], __float_as_uint(old), __float_as_uint(mx)); if (prev == __float_as_uint(old)) break; old = __uint_as_float(prev); } }
    __syncthreads();
    mx = red[0];
    __syncthreads();
    float sum = 0.f;
    for (int s = F.tid; s <= t; s += 512) {
        if (masked) { const int tl = s >> 6; const unsigned long long w = MK[idxr::moff(tl) + (t - 64 * tl)]; if (!((w >> (s & 63)) & 1ull)) continue; }
        float lg = 0.f; for (int d = 0; d < 64; ++d) lg += bf2f(Q[row * 512 + hq * 64 + d]) * bf2f(K[((size_t)b * SEQ + s) * 512 + hq * 64 + d]);
        const float p = exp2f(lg - mx); sum += p;
        for (int d = 0; d < 64; ++d) atomicAdd((float*)&red[2 + d], p * bf2f(V[((size_t)b * SEQ + s) * 512 + hv * 64 + d]));
    }
    atomicAdd((float*)&red[1], sum);
    __syncthreads();
    if (F.tid < 64) { const float want = red[2 + F.tid] / red[1], got = bf2f(O[row * 512 + hv * 64 + F.tid]);
        if (!close_to(got, want, 0.03f, 0.003f)) chk_fail(F, masked ? 0x220u : 0x210u); }
    __syncthreads();
}
__device__ __forceinline__ void chk_mask(Frame& F) {
    LAS float* sc = (LAS float*)(F.lds + RING_OFF);
    LAS unsigned* cnt = (LAS unsigned*)(F.lds + XTR_OFF + 2048);
    if (F.vcu >= 64) return;
    const unsigned h = hash32((unsigned)F.vcu * 31337u + 99u);
    const int b = F.vcu & 1, t = (F.vcu < 6) ? (int)(h % 400u) : (int)(h % (unsigned)SEQ);
    const bf16* IQ = (const bf16*)(F.ws + WS_DQ + 6 * TSTRIDE); const bf16* IK = (const bf16*)(F.ws + WS_IK); const float* IW = (const float*)(F.ws + WS_IW);
    const unsigned long long* MK = (const unsigned long long*)(F.ws + WS_MASK) + (size_t)b * MASK_BSTRIDE;
    const size_t row = (size_t)b * SEQ + t;
    if (F.tid < 2) cnt[F.tid] = 0u;
    for (int s = F.tid; s <= t; s += 512) { float tot = 0.f;
        for (int hh = 0; hh < 8; ++hh) { float d = 0.f; for (int e = 0; e < 64; ++e) d += bf2f(IQ[row * 512 + hh * 64 + e]) * bf2f(IK[((size_t)b * SEQ + s) * 64 + e]); tot += IW[row * 8 + hh] * fmaxf(d, 0.f); }
        sc[s] = tot; }
    __syncthreads();
    for (int s = F.tid; s <= t; s += 512) { const float v = sc[s]; int rk = 0;
        for (int s2 = 0; s2 <= t; ++s2) { const float v2 = sc[s2]; rk += (v2 > v || (v2 == v && s2 < s)) ? 1 : 0; }
        const bool want = rk < 256; const int tl = s >> 6; const bool got = (MK[idxr::moff(tl) + (t - 64 * tl)] >> (s & 63)) & 1ull;
        if (want != got) atomicAdd((unsigned*)&cnt[0], 1u); if (got) atomicAdd((unsigned*)&cnt[1], 1u); }
    __syncthreads();
    if (F.tid == 0) { const unsigned expect = (t + 1 < 256) ? (unsigned)(t + 1) : 256u; if (cnt[1] != expect) chk_fail(F, 0x230u); else if (cnt[0] > 8u) chk_fail(F, 0x231u); }
    __syncthreads();
}
__device__ __forceinline__ void chk_pre1(Frame& F) {
    LAS float* mg = (LAS float*)(F.lds + RING_OFF);
    const float* x = (const float*)INP(0); const float* w_in = (const float*)INP(3); const float* wbd = (const float*)INP(6); const float* wbs = (const float*)INP(7); const float* wo = (const float*)INP(8);
    const bf16* YA = (const bf16*)(F.ws + WS_YA); const bf16* YB = (const bf16*)(F.ws + WS_YB); const bf16* PRE = (const bf16*)(F.ws + WS_PRE1);
    const int m = (int)(hash32((unsigned)F.vcu * 7919u + 3u) % (unsigned)NTOK);
    for (int c = F.tid; c < 1024; c += 512) { float ga = 0.f, gb = 0.f, pa = 0.f, pb = 0.f;
        for (int k = 0; k < 1024; ++k) { const float xv = bf2f((unsigned short)f2bf(x[(size_t)m * 1024 + k])); ga += xv * w_in[(size_t)k * WIN_OLD + 3656 + c]; gb += xv * w_in[(size_t)k * WIN_OLD + 4680 + c]; }
        for (int k = 0; k < 512; ++k) { pa += bf2f(YA[(size_t)m * 512 + k]) * wbd[(size_t)k * 1024 + c]; pb += bf2f(YB[(size_t)m * 512 + k]) * wbs[(size_t)k * 1024 + c]; }
        mg[c] = pa / (1.f + expf(-ga)) + pb / (1.f + expf(-gb)); }
    __syncthreads();
    for (int c = F.tid; c < 1024; c += 512) { float mix = 0.f; for (int k = 0; k < 1024; ++k) mix += mg[k] * wo[(size_t)k * 1024 + c];
        const float want = ALPHA * x[(size_t)m * 1024 + c] + mix, got = bf2f(PRE[(size_t)m * 1024 + c]);
        if (!close_to(got, want, 0.015f, 0.015f)) chk_fail(F, 0x300u); }
    __syncthreads();
}
__device__ __forceinline__ void chk_ffn(Frame& F) {
    LAS float* lgs = (LAS float*)(F.lds + RING_OFF);
    const bf16* X1 = (const bf16*)(F.ws + WS_XB); const float* wrg = (const float*)INP(11); const float* brg = (const float*)INP(12); const float* wre = (const float*)INP(13); const float* bre = (const float*)INP(14);
    const float* wg = (const float*)INP(15); const float* wu = (const float*)INP(16); const float* wd = (const float*)INP(17); const float* wple = (const float*)INP(18); const float* wpg = (const float*)INP(19); const float* p = (const float*)INP(1);
    const bf16* Y0 = (const bf16*)(F.ws + WS_Y0); const bf16* Y1 = (const bf16*)(F.ws + WS_Y1); const bf16* PLE = (const bf16*)(F.ws + WS_PLE);
    const int m = (int)(hash32((unsigned)F.vcu * 104729u + 11u) % (unsigned)NTOK);
    if (F.tid < 36) { float s = 0.f; for (int k = 0; k < 1024; ++k) s += bf2f(X1[(size_t)m * 1024 + k]) * (F.tid < 4 ? wrg[k * 4 + F.tid] : wre[k * 32 + F.tid - 4]); lgs[F.tid] = s + (F.tid < 4 ? brg[F.tid] : bre[F.tid - 4]); }
    __syncthreads();
    int gi = 0; for (int i = 1; i < 4; ++i) if (lgs[i] > lgs[gi]) gi = i;
    float gs = 0.f; for (int i = 0; i < 4; ++i) gs += expf(lgs[i] - lgs[gi]); const float gval = 1.f / gs;
    int i0 = 0; for (int k = 1; k < 8; ++k) if (lgs[4 + gi * 8 + k] > lgs[4 + gi * 8 + i0]) i0 = k;
    int i1 = (i0 == 0) ? 1 : 0; for (int k = 0; k < 8; ++k) if (k != i0 && lgs[4 + gi * 8 + k] > lgs[4 + gi * 8 + i1]) i1 = k;
    const float l0 = lgs[4 + gi * 8 + i0], l1 = lgs[4 + gi * 8 + i1], c0 = gval / (1.f + expf(l1 - l0)), c1 = gval - c0;
    __syncthreads();
    { const int sl = F.tid >> 8, f = F.tid & 255, e = gi * 8 + (sl ? i1 : i0); const float* G = wg + (size_t)e * 1024 * 256; const float* U = wu + (size_t)e * 1024 * 256; float g = 0.f, u = 0.f;
      for (int k = 0; k < 1024; ++k) { const float xv = bf2f(X1[(size_t)m * 1024 + k]); g += xv * G[(size_t)k * 256 + f]; u += xv * U[(size_t)k * 256 + f]; }
      lgs[64 + F.tid] = g / (1.f + expf(-g)) * u * (sl ? c1 : c0); }
    __syncthreads();
    for (int c = F.tid; c < 1024; c += 512) { float y = 0.f;
        for (int sl = 0; sl < 2; ++sl) { const int e = gi * 8 + (sl ? i1 : i0); const float* D = wd + (size_t)e * 256 * 1024; for (int f = 0; f < 256; ++f) y += lgs[64 + sl * 256 + f] * D[(size_t)f * 1024 + c]; }
        const float goty = bf2f(Y0[(size_t)m * 1024 + c]) + bf2f(Y1[(size_t)m * 1024 + c]);
        if (!close_to(goty, y, 0.03f, 0.004f)) chk_fail(F, 0x400u);
        float gt = 0.f, tp = 0.f; for (int k = 0; k < 1024; ++k) gt += bf2f(X1[(size_t)m * 1024 + k]) * wpg[(size_t)k * 1024 + c]; for (int k = 0; k < 256; ++k) tp += p[(size_t)m * 256 + k] * wple[(size_t)k * 1024 + c];
        const float wantp = tp / (1.f + expf(-gt)), gotp = bf2f(PLE[(size_t)m * 1024 + c]);
        if (!close_to(gotp, wantp, 0.03f, 0.01f)) chk_fail(F, 0x410u); }
    __syncthreads();
}
#endif

#ifndef PHSEL
#define PHSEL 0xFFF
#endif
#define PHON(k) (((PHSEL) >> (k)) & 1)
#ifndef DUP
#define DUP 0
#endif
#define DUPREP(k) for (int rep_ = 0; rep_ < (((DUP) >> (k)) & 1) + 1; ++rep_)
__global__ void __launch_bounds__(NWAVES * 64, 2) skel_fwd(Args args) {
    extern __shared__ __attribute__((aligned(16))) unsigned char lds[];
    Frame F;
    F.lds = (LAS unsigned char*)lds;
    F.MISC = (volatile LAS unsigned*)(F.lds + MISC_OFF);
    F.tid = threadIdx.x; F.lane = F.tid & 63; F.wave = __builtin_amdgcn_readfirstlane(F.tid >> 6);
    F.G = gridDim.x; F.bx = blockIdx.x; { const int bx = blockIdx.x; F.vcu = (F.G % 8 == 0) ? (bx % 8) * (F.G / 8) + bx / 8 : bx; }
    F.ws = F.ws0 = args.ws; F.out = F.out0 = args.out; F.ap = &args;
    F.ctl = (gu32*)(F.ws + WS_CTL);
    for (int u = F.tid; u < (MISC_OFF + 128 - XTR_OFF) / 4; u += NWAVES * 64) ((LAS unsigned*)(F.lds + XTR_OFF))[u] = 0u;
    __syncthreads();
#if MK_PER_PHASE
    XcdBarrier bar; bar.bar = (unsigned*)(F.ctl + CW_BAR); bar.x = 0; bar.st = nullptr;
#define GRID_BAR() do { if (F.tid == 0) __hip_atomic_store(F.ctl + CW_TMO, 0xBADBA0u, RLX_AGENT); } while (0)
#else
    XcdBarrier bar = xcd_barrier_post((unsigned*)(F.ctl + CW_BAR), F.MISC + 8);
#ifndef IDLEPROBE
#define IDLEPROBE 0
#endif
#if IDLEPROBE
#define GRID_BAR() do { const unsigned long long t0_ = rt(); xcd_barrier(bar); if (F.tid == 0) __hip_atomic_fetch_add(F.ctl + 12288 + seam_no, (unsigned)(rt() - t0_), RLX_AGENT); ++seam_no; } while (0)
#else
#define GRID_BAR() xcd_barrier(bar)
#endif
#endif
    const int lo = args.ph_lo, hi = args.ph_hi;
    int seam_no = 0; (void)seam_no;
#define IN(k) (lo <= (k) && (k) < hi)
#define SEAM(k) do { if (IN(k) && IN((k) + 1)) GRID_BAR(); } while (0)
#define PHASE_ENTER() { size_t zo_ = 0; asm volatile("" : "+s"(zo_)); F.ws = F.ws0 + zo_; F.out = F.out0 + zo_; } F.vcu = __builtin_amdgcn_readfirstlane(F.vcu); asm volatile("" : "+s"(F.vcu), "+s"(F.G), "+s"(F.bx)); asm volatile("" : "+s"(F.lds)); F.tid = ltid(F.wave); F.lane = F.tid & 63; unsigned char* const ws = F.ws; bf16* const XB = (bf16*)(ws + WS_XB); (void)XB
    for (int l = 0; l < DEPTH; ++l) {
        const int pb = l * NPH_LAYER;
        if (PHON(0) && IN(pb + 0)) DUPREP(0) { PHASE_ENTER(); pw_phase(F, l); }
        SEAM(pb + 0);
        if (PHON(1) && IN(pb + 1)) DUPREP(1) { PHASE_ENTER();
            pg8::Gemm g{XB, (const bf16*)(ws + WS_WB + WB_WIN), 1024, 1024, 1024, nullptr}; pg8::StaticOrder S; S.init(NTOK, P1_N, F.G, F.bx, 1024);
            pg8::EpiProj E{(bf16*)(ws + WS_DQ), TSTRIDE / 2, (bf16*)(ws + WS_IK), (float*)(ws + WS_IW), (const float*)(ws + WS_ROPE)};
            pg8::gemm_phase<pg8::EpiProj, pg8::StaticOrder, true>(F.lds + RING_OFF, g, S, E, F.wave);
            { pg8::Gemm g2{(const bf16*)(ws + WS_PB), (const bf16*)(ws + WS_WB + WB_WPLE), 256, 256, 256, nullptr};
                TailSched S2{(F.bx >= 128) ? (F.bx - 128) * 3 : 384 + F.bx, (F.bx >= 128) ? 3 : 1, 256L * 256};
                pg8::EpiStore E2{(bf16*)((unsigned char*)F.out + OUT_T1), 1024}; pg8::gemm_phase<pg8::EpiStore, TailSched, true>(F.lds + RING_OFF, g2, S2, E2, F.wave); }
        }
        SEAM(pb + 1);
        if (PHON(2) && IN(pb + 2)) DUPREP(2) { PHASE_ENTER();
            const bf16* IQ = (const bf16*)(ws + WS_DQ + 6 * TSTRIDE); const bf16* IK = (const bf16*)(ws + WS_IK); const float* IW = (const float*)(ws + WS_IW);
            for (int p = F.vcu; p < 256; p += F.G) { const int b = p >> 7, s = p & 127;
                unsigned long long* m32 = (unsigned long long*)(ws + WS_MASK) + (size_t)b * MASK_BSTRIDE;
                for (int k2 = 0; k2 < 2; ++k2) indexer_unit(F, b, k2 ? s : 255 - s, IQ, IK, IW, m32); }
        }
        SEAM(pb + 2);
        if (PHON(3) && IN(pb + 3)) DUPREP(3) { PHASE_ENTER();
            using attn_body::bf16;
            const bf16* DQ = (const bf16*)(ws + WS_DQ); const bf16* DK = (const bf16*)(ws + WS_DQ + TSTRIDE); const bf16* DV = (const bf16*)(ws + WS_DQ + 2 * TSTRIDE);
            LAS unsigned* qslot = (LAS unsigned*)(F.lds + MISC_OFF + 64);
            gu32* qctr = F.ctl + CW_QUEUE + l * 64;
            LAS unsigned* const badp = (LAS unsigned*)(F.lds + MISC_OFF + 80); constexpr int BADOFF = MISC_OFF + 80 - RING_OFF;
#define GRAB(ctr_, u_) do { __syncthreads(); if (F.tid == 0) { *qslot = __hip_atomic_fetch_add((ctr_), 1u, RLX_AGENT); *badp = 0u; } __syncthreads(); u_ = (int)*qslot; } while (0)
#ifndef DUPW
#define DUPW 0
#endif
            for (int dw_ = 0; dw_ <= DUPW; ++dw_)
            for (;;) { int u; GRAB(qctr + 8 * dw_, u); if (u >= 512) break;
                const int qb = 63 - (u >> 3), a = u & 7, b = a >> 2, h = a & 3;
#pragma unroll 1
                for (int c = 0; c < 2; ++c) {
                    bf16* O = (bf16*)(ws + (c ? WS_O1 : WS_O0));
                    attn_body::attn_unit<8, false, true, true>(b, 2 * h + c, 2 * h, qb, DQ, DK, DV, O, nullptr, (char*)lds + RING_OFF, F.wave, BADOFF);
#if !(CHK && MK_PER_PHASE)
                    if (*(volatile LAS unsigned*)badp) { __syncthreads(); if (F.tid == 0) *badp = 0u;
                        attn_body::attn_unit<8, false, true, false>(b, 2 * h + c, 2 * h, qb, DQ, DK, DV, O, nullptr, (char*)lds + RING_OFF, F.wave, BADOFF); }
#endif
                }
                VM_WAIT(); __syncthreads(); __builtin_amdgcn_fence(__ATOMIC_ACQUIRE, "agent");
                ya_unit(F, l, b, h, qb);
            }
            const bf16* SQ = (const bf16*)(ws + WS_DQ + 3 * TSTRIDE); const bf16* SK = (const bf16*)(ws + WS_DQ + 4 * TSTRIDE); const bf16* SV = (const bf16*)(ws + WS_DQ + 5 * TSTRIDE);
            attn_body::mask_table_init((char*)lds + RING_OFF, F.tid);
#ifndef DUPS
#define DUPS 0
#endif
            for (int ds_ = 0; ds_ <= DUPS; ++ds_)
            for (;;) { int u; GRAB(qctr + 32 + 8 * ds_, u); if (u >= 1024) break;
                const int qb = 63 - (u >> 4), a = u & 15, b = a >> 3, h = a & 7;
                const unsigned long long* MK = (const unsigned long long*)(ws + WS_MASK) + (size_t)b * MASK_BSTRIDE;
                attn_body::attn_unit<8, true, false, true>(b, h, h, qb, SQ, SK, SV, (bf16*)(ws + WS_YB), MK, (char*)lds + RING_OFF, F.wave, BADOFF);
#if !(CHK && MK_PER_PHASE)
                if (*(volatile LAS unsigned*)badp) attn_body::attn_unit<8, true, false, false>(b, h, h, qb, SQ, SK, SV, (bf16*)(ws + WS_YB), MK, (char*)lds + RING_OFF, F.wave, BADOFF);
#endif
                }
#undef GRAB
        }
        SEAM(pb + 3);
        if (PHON(5) && IN(pb + 5)) DUPREP(5) { PHASE_ENTER();
#define RELA() { size_t zo_ = 0; asm volatile("" : "+s"(zo_)); F.ws = F.ws0 + zo_; } unsigned char* const ws = F.ws; bf16* const XB = (bf16*)(ws + WS_XB); (void)XB; const bf16* WIN = (const bf16*)(ws + WS_WB + WB_WIN); bf16* MG = (bf16*)(ws + WS_MERGED); unsigned char* G1 = ws + WS_TMPG; unsigned char* G2 = ws + WS_TMPG + 32 * MiB; (void)WIN; (void)MG; (void)G1; (void)G2
            { RELA(); pg8::Gemm g{(const bf16*)((unsigned char*)F.out + OUT_XB8), (const bf16*)(ws + WS_WB + WB_WG8), 512, 512, 512, nullptr}; pg8::StaticOrder S; S.init(NTOK, 1024, F.G, F.bx, 512);
              pg8::EpiSig E{G1, 1024, 1.f / 64.f}; pg8::gemm_phase<pg8::EpiSig, pg8::StaticOrder, true, false, true>(F.lds + RING_OFF, g, S, E, F.wave); }
            { RELA(); pg8::Gemm g{(const bf16*)((unsigned char*)F.out + OUT_XB8), (const bf16*)(ws + WS_WB + WB_WG8 + (size_t)1024 * 1024), 512, 512, 512, nullptr}; pg8::StaticOrder S; S.init(NTOK, 1024, F.G, F.bx, 512);
              pg8::EpiSig E{G2, 1024, 1.f / 64.f}; pg8::gemm_phase<pg8::EpiSig, pg8::StaticOrder, true, false, true>(F.lds + RING_OFF, g, S, E, F.wave); }
            VM_WAIT(); __builtin_amdgcn_fence(__ATOMIC_ACQUIRE, "agent"); VM_WAIT();
            { RELA(); pg8::Gemm g{(const bf16*)(ws + WS_YA), (const bf16*)(ws + WS_WB + WB_WBD), 512, 512, 512, nullptr}; pg8::StaticOrder S; S.init(NTOK, 1024, F.G, F.bx, 512);
              pg8::EpiGatedT<false> E{G1, nullptr, MG, 1024}; pg8::gemm_phase<pg8::EpiGatedT<false>, pg8::StaticOrder, true>(F.lds + RING_OFF, g, S, E, F.wave); }
            VM_WAIT(); __builtin_amdgcn_fence(__ATOMIC_ACQUIRE, "agent"); VM_WAIT();
            { RELA(); pg8::Gemm g{(const bf16*)(ws + WS_YB), (const bf16*)(ws + WS_WB + WB_WBS), 512, 512, 512, nullptr}; pg8::StaticOrder S; S.init(NTOK, 1024, F.G, F.bx, 512);
              pg8::EpiGatedT<true> E{G2, MG, MG, 1024}; if (!(DBG & 4)) pg8::gemm_phase<pg8::EpiGatedT<true>, pg8::StaticOrder, true>(F.lds + RING_OFF, g, S, E, F.wave); }
        }
        SEAM(pb + 5);
        if (PHON(6) && IN(pb + 6)) DUPREP(6) { PHASE_ENTER();
            pg8::Gemm g{(const bf16*)(ws + WS_MERGED), (const bf16*)(ws + WS_WB + WB_WO), 1024, 1024, 1024, nullptr}; pg8::StaticOrder S; S.init(NTOK, 1024, F.G, F.bx, 1024);
            pg8::EpiResBf16 E{XB, (bf16*)(ws + WS_PRE1), ALPHA}; pg8::gemm_phase<pg8::EpiResBf16, pg8::StaticOrder, true>(F.lds + RING_OFF, g, S, E, F.wave);
        }
        SEAM(pb + 6);
        if (PHON(7) && IN(pb + 7)) DUPREP(7) { PHASE_ENTER(); ln1_router_phase(F, l); }
        SEAM(pb + 7);
        if (PHON(8) && IN(pb + 8)) DUPREP(8) { PHASE_ENTER(); lists_phase(F, l); }
        SEAM(pb + 8);
        if (PHON(9) && IN(pb + 9)) DUPREP(9) { PHASE_ENTER();
            const int T = build_tile_table(F);
            pg8::Gemm g{(const bf16*)((unsigned char*)F.out + OUT_X1B8), (const bf16*)(ws + WS_WB + WB_WGU), 512, 512, 512, (const int*)(ws + WS_ROUTE + RT_ROW)};
            GroupSched S{2 * T, F.G, F.vcu, 1, (const LAS int*)(F.lds + XTR_OFF), 512L * 512, 256L * 512};
            pg8::EpiGU E{(bf16*)(ws + WS_HG), (const float*)(ws + WS_ROUTE + RT_CW), 1.f / 64.f};
            pg8::gemm_phase<pg8::EpiGU, GroupSched, true, true, true>(F.lds + RING_OFF, g, S, E, F.wave);
        }
        SEAM(pb + 9);
        if (PHON(10) && IN(pb + 10)) DUPREP(10) { PHASE_ENTER();
            const int T = build_tile_table(F);
#ifndef P10SEL
#define P10SEL 7
#endif
            if (P10SEL & 1) { RELA(); pg8::Gemm g{(const bf16*)(ws + WS_HG), (const bf16*)(ws + WS_WB + WB_WD), 256, 256, 256, nullptr};
              GroupSched S{4 * T, F.G, F.vcu, 2, (const LAS int*)(F.lds + XTR_OFF), 1024L * 256, 256L * 256};
              pg8::EpiDown E{(const int*)(ws + WS_ROUTE + RT_ENT), (bf16*)(ws + WS_Y0), (unsigned)(WS_Y1 - WS_Y0)};
              pg8::gemm_phase<pg8::EpiDown, GroupSched, true>(F.lds + RING_OFF, g, S, E, F.wave); }
            if (P10SEL & 4) { RELA(); pg8::Gemm g{(const bf16*)((unsigned char*)F.out + OUT_X1B8), (const bf16*)(ws + WS_WB + WB_WPG), 512, 512, 512, nullptr}; pg8::StaticOrder S; S.init(NTOK, 1024, F.G, F.bx, 512);
              pg8::EpiPle E{(const bf16*)((unsigned char*)F.out + OUT_T1), (bf16*)(ws + WS_PLE), 1.f / 64.f}; pg8::gemm_phase<pg8::EpiPle, pg8::StaticOrder, true, false, true>(F.lds + RING_OFF, g, S, E, F.wave); }
        }
        SEAM(pb + 10);
        if (PHON(11) && IN(pb + 11)) DUPREP(11) { PHASE_ENTER(); ln2_phase(F, l); }
        if (l + 1 < DEPTH) SEAM(pb + 11);
    }
#if IDLEPROBE
    xcd_barrier(bar);
    if (blockIdx.x == 0 && F.tid == 0) { unsigned long long tot = 0; for (int k = 0; k < 23; ++k) if ((IDLEPROBE >> k) & 1) tot += __hip_atomic_load(F.ctl + 12288 + k, RLX_AGENT);
        const unsigned long long t0 = rt(), dur = tot / 256; while (rt() - t0 < dur) __builtin_amdgcn_s_sleep(8); }
#endif
#undef IN
#undef SEAM
}

#if CHK
__global__ void __launch_bounds__(NWAVES * 64, 2) chk_kernel(Args args, int which) {
    extern __shared__ __attribute__((aligned(16))) unsigned char lds[];
    Frame F;
    F.lds = (LAS unsigned char*)lds; F.MISC = (volatile LAS unsigned*)(F.lds + MISC_OFF);
    F.tid = threadIdx.x; F.lane = F.tid & 63; F.wave = __builtin_amdgcn_readfirstlane(F.tid >> 6);
    F.G = gridDim.x; F.bx = blockIdx.x; { const int bx = blockIdx.x; F.vcu = (F.G % 8 == 0) ? (bx % 8) * (F.G / 8) + bx / 8 : bx; }
    F.ws = F.ws0 = args.ws; F.out = F.out0 = args.out; F.ap = &args; F.ctl = (gu32*)(F.ws + WS_CTL);
    if (which == 1) chk_proj(F);
    if (which == 2) chk_attn(F);
    if (which == 4) chk_mask(F);
    if (which == 8) chk_pre1(F);
    if (which == 16) chk_ffn(F);
}
#endif
extern "C" void kernel_launch(void* const* d_in, const int* in_sizes, int n_in, void* d_out, int out_size, void* d_ws, size_t ws_size, hipStream_t stream) {
    static int grid = 0;
    if (grid == 0) {
        if (n_in != 22 || in_sizes[0] != NTOK * DMODEL || out_size != NTOK * DMODEL || ws_size < WS_END) { fprintf(stderr, "kernel_launch: unexpected problem geometry (n_in %d, ws %zu); nothing launched\n", n_in, ws_size); grid = -1; return; }
        int dev = 0, cus = 0, per_cu = 0;
        if (hipGetDevice(&dev) != hipSuccess || hipDeviceGetAttribute(&cus, hipDeviceAttributeMultiprocessorCount, dev) != hipSuccess) { grid = -1; return; }
        if (hipFuncSetAttribute((const void*)skel_fwd, hipFuncAttributeMaxDynamicSharedMemorySize, LDS_BYTES) != hipSuccess) { fprintf(stderr, "kernel_launch: hipFuncSetAttribute failed\n"); grid = -1; return; }
        if (hipOccupancyMaxActiveBlocksPerMultiprocessor(&per_cu, (const void*)skel_fwd, NWAVES * 64, LDS_BYTES) != hipSuccess || per_cu < 1) { fprintf(stderr, "kernel_launch: occupancy query reports %d\n", per_cu); }
        (void)hipGetLastError();
        if (cus < 256) { fprintf(stderr, "kernel_launch: needs 256 CUs (got %d)\n", cus); grid = -1; return; }
        grid = 256;
    }
    if (grid < 0) return;
    if (hipMemsetAsync((char*)d_ws + WS_CTL, 0, CTL_ZERO_BYTES, stream) != hipSuccess) return;
    Args a{};
    for (int i = 0; i < 22; ++i) a.in[i] = d_in[i];
    a.out = (float*)d_out; a.ws = (unsigned char*)d_ws;
#if MK_PER_PHASE
    for (int ph = 0; ph < NPHASE; ++ph) { a.ph_lo = ph; a.ph_hi = ph + 1; hipLaunchKernelGGL(skel_fwd, dim3(grid), dim3(NWAVES * 64), LDS_BYTES, stream, a);
#if CHK
        static bool chk_set = false; if (!chk_set) { (void)hipFuncSetAttribute((const void*)chk_kernel, hipFuncAttributeMaxDynamicSharedMemorySize, LDS_BYTES); chk_set = true; }
        if (ph == 1 && (CHK & 1)) hipLaunchKernelGGL(chk_kernel, dim3(grid), dim3(NWAVES * 64), LDS_BYTES, stream, a, 1);
        if (ph == 3 && (CHK & 2)) hipLaunchKernelGGL(chk_kernel, dim3(grid), dim3(NWAVES * 64), LDS_BYTES, stream, a, 2);
        if (ph == 3 && (CHK & 4)) hipLaunchKernelGGL(chk_kernel, dim3(grid), dim3(NWAVES * 64), LDS_BYTES, stream, a, 4);
        if (ph == 6 && (CHK & 8)) hipLaunchKernelGGL(chk_kernel, dim3(grid), dim3(NWAVES * 64), LDS_BYTES, stream, a, 8);
        if (ph == 10 && (CHK & 16)) hipLaunchKernelGGL(chk_kernel, dim3(grid), dim3(NWAVES * 64), LDS_BYTES, stream, a, 16);
#endif
    }
#else
    a.ph_lo = 0; a.ph_hi = NPHASE;
    hipLaunchKernelGGL(skel_fwd, dim3(grid), dim3(NWAVES * 64), LDS_BYTES, stream, a);
#endif
}
```

```cpp
#include <hip/hip_runtime.h>
#include <hip/hip_bf16.h>
#include <cstdio>
#include <cstdint>
#include <cmath>

__device__ __forceinline__ int ltid(int wave) { int l; asm volatile("v_mbcnt_lo_u32_b32 %0, -1, 0\n\tv_mbcnt_hi_u32_b32 %0, -1, %0" : "=v"(l)); return (wave << 6) | l; }

namespace pg8 {
#define PG8_LAS __attribute__((address_space(3)))
typedef unsigned short bf16_t;
typedef short bf16x8 __attribute__((ext_vector_type(8)));
typedef float f32x4 __attribute__((ext_vector_type(4)));
typedef unsigned u32x4 __attribute__((ext_vector_type(4)));
typedef int i32x4_t __attribute__((ext_vector_type(4)));
typedef int i32x8_t __attribute__((ext_vector_type(8)));
constexpr int BM = 256, BK = 64, HALF = 128, HTB = HALF * BK * 2  , STAGE_BYTES = 8 * HTB, NXCD = 8, WGM = 8;
constexpr float C2 = 0.125f * 1.4426950408889634f;

__host__ __device__ __forceinline__ int lds_byte(int r, int c) { const int st = (r >> 4) * 2 + (c >> 5), rr = r & 15, cc = c & 31, ob = rr * 64 + cc * 2; return st * 1024 + (ob ^ (((ob >> 9) & 1) << 5)); }
__host__ __device__ __forceinline__ void stage_rc(int b, int& R, int& C) { const int st = b / 1024, sb = b % 1024, swz = sb ^ (((sb >> 9) & 1) << 5); R = (st >> 1) * 16 + swz / 64; C = (st & 1) * 32 + (swz % 64) / 2; }
__host__ __device__ __forceinline__ int perm32(int rho) { const int n = rho >> 4, i = rho & 15; return 8 * (i >> 2) + 4 * n + (i & 3); }

struct Unit { int pm, pn; long boff; };
struct Gemm { const bf16_t* A; const bf16_t* Bt; int K, lda, ldb; const int* rows; };

struct StaticOrder {
    int nM, nN, nwg, G, c, ldb;
    __device__ void init(int M, int N, int G_, int c_, int ldb_) { nM = M / BM; nN = N / BM; nwg = nM * nN; G = G_; c = c_; ldb = ldb_; }
    __device__ bool next(int i, Unit& u) const {
        const long L = (long)i * G + c; if (L >= nwg) return false;
        int wgid = (int)L; { const int q = nwg / NXCD, r = nwg % NXCD, xcd = wgid % NXCD, off = wgid / NXCD; wgid = (xcd < r ? xcd * (q + 1) : r * (q + 1) + (xcd - r) * q) + off; }
        const int nig = WGM * nN, gid = wgid / nig, fm = gid * WGM, gsz = (nM - fm) < WGM ? (nM - fm) : WGM;
        u.pm = fm + ((wgid % nig) % gsz); u.pn = (wgid % nig) / gsz; u.boff = (long)u.pn * BM * ldb; return true;
    }
};

__device__ __forceinline__ unsigned cvt_pk_bf16(float lo, float hi) { unsigned r; asm volatile("v_cvt_pk_bf16_f32 %0, %1, %2" : "=v"(r) : "v"(lo), "v"(hi)); return r; }
__device__ __forceinline__ float bf_lo(unsigned w) { return __uint_as_float(w << 16); }
__device__ __forceinline__ float bf_hi(unsigned w) { return __uint_as_float(w & 0xffff0000u); }
__device__ __forceinline__ float sigm(float x) { return __builtin_amdgcn_rcpf(1.f + __builtin_amdgcn_exp2f(-1.4426950408889634f * x)); }
__device__ __forceinline__ u32x4 pack8(f32x4 a, f32x4 b) { u32x4 w; w.x = cvt_pk_bf16(a[0], a[1]); w.y = cvt_pk_bf16(a[2], a[3]); w.z = cvt_pk_bf16(b[0], b[1]); w.w = cvt_pk_bf16(b[2], b[3]); return w; }
__device__ __forceinline__ void unpack8(u32x4 w, f32x4& a, f32x4& b) { a = (f32x4){bf_lo(w.x), bf_hi(w.x), bf_lo(w.y), bf_hi(w.y)}; b = (f32x4){bf_lo(w.z), bf_hi(w.z), bf_lo(w.w), bf_hi(w.w)}; }

#define PG8_EPI_ARGS const f32x4 (&acc)[2][2][4][2], const Unit& u, int wr, int wc, int fr, int fq

#define PG8_PIN(x) asm volatile("" : "+v"(x))
template <class T> __device__ __forceinline__ T& at(const void* base, unsigned byteoff) { return *(T*)((char*)base + byteoff); }

__device__ __forceinline__ float xor16(float v, int fq) { const auto r = __builtin_amdgcn_permlane16_swap(__float_as_uint(v), __float_as_uint(v), false, false); return __uint_as_float((fq & 1) ? r[0] : r[1]); }
struct EpiProj {
    bf16_t* base; size_t tstride; bf16_t* IK; float* IW; const float* rope;
    __device__ __forceinline__ void operator()(PG8_EPI_ARGS) const {
        const int pn = u.pn, row0 = u.pm * BM + wr * 64 + fr;
        if (pn < 14) {
            const int t = pn >> 1;
            bf16_t* dst = base + (size_t)t * tstride;
            const bool rp = (t == 0) | (t == 1) | (t == 3) | (t == 4) | (t == 6);
            const float sc = (t == 0 || t == 3) ? C2 : (t == 6 ? 0.125f : 1.f);
            const bool rotw = rp && ((wc & 1) == 0);
            const unsigned cb = (unsigned)((pn & 1) * 256 + wc * 32 + 8 * fq) * 2u;
            constexpr int RB = 2; f32x4 rq[RB][4];
#define PG8_RP_LD(it) do { if (rotw) { unsigned r_ = (unsigned)(row0 + ((it) >> 2) * HALF + ((it) & 3) * 16); PG8_PIN(r_); \
                rq[(it) % RB][0] = at<const f32x4>(rope, r_ * 64u); rq[(it) % RB][1] = at<const f32x4>(rope, r_ * 64u + 16u); rq[(it) % RB][2] = at<const f32x4>(rope, r_ * 64u + 32u); rq[(it) % RB][3] = at<const f32x4>(rope, r_ * 64u + 48u); } } while (0)
#pragma unroll
            for (int it = 0; it < RB; ++it) PG8_RP_LD(it);
#pragma unroll
            for (int ai = 0; ai < 2; ++ai)
#pragma unroll
                for (int m = 0; m < 4; ++m) { const int it = ai * 4 + m;
                    unsigned row = (unsigned)(row0 + ai * HALF + m * 16); PG8_PIN(row);
                    f32x4 c0 = {1.f, 1.f, 1.f, 1.f}, c1 = c0, s0 = {0.f, 0.f, 0.f, 0.f}, s1 = s0;
                    if (rotw) { c0 = rq[it % RB][0]; c1 = rq[it % RB][1]; s0 = rq[it % RB][2]; s1 = rq[it % RB][3]; }
                    if (it + RB < 8) PG8_RP_LD(it + RB);
#pragma unroll
                    for (int bj = 0; bj < 2; ++bj) {
                        f32x4 v0 = acc[ai][bj][m][0], v1 = acc[ai][bj][m][1];
                        if (rotw) {
                            f32x4 p0, p1;
#pragma unroll
                            for (int i = 0; i < 4; ++i) { p0[i] = xor16(v0[i], fq); p1[i] = xor16(v1[i], fq); }
                            const float sg = (fq == 0) ? -1.f : 1.f;
                            const f32x4 r0 = v0 * c0 + (p0 * s0) * sg, r1 = v1 * c1 + (p1 * s1) * sg;
                            if (fq < 2) { v0 = r0; v1 = r1; }
                        }
                        v0 = v0 * sc; v1 = v1 * sc;
                        at<u32x4>(dst, row * 1024u + cb + bj * 256u) = pack8(v0, v1);
                    }
                    asm volatile("" ::: "memory");
                }
#undef PG8_RP_LD
        } else {
#pragma unroll
            for (int ai = 0; ai < 2; ++ai)
#pragma unroll
                for (int m = 0; m < 4; ++m) {
                    unsigned row = (unsigned)(row0 + ai * HALF + m * 16); PG8_PIN(row);
                    f32x4 v0 = acc[ai][0][m][0], v1 = acc[ai][0][m][1];
                    if (wc == 0) {
                        const f32x4 c0 = at<const f32x4>(rope, row * 64u), c1 = at<const f32x4>(rope, row * 64u + 16u), s0 = at<const f32x4>(rope, row * 64u + 32u), s1 = at<const f32x4>(rope, row * 64u + 48u);
                        f32x4 p0, p1;
#pragma unroll
                        for (int i = 0; i < 4; ++i) { p0[i] = xor16(v0[i], fq); p1[i] = xor16(v1[i], fq); }
                        const float sg = (fq == 0) ? -1.f : 1.f;
                        const f32x4 r0 = v0 * c0 + (p0 * s0) * sg, r1 = v1 * c1 + (p1 * s1) * sg;
                        if (fq < 2) { v0 = r0; v1 = r1; }
                    }
                    if (wc < 2) at<u32x4>(IK, row * 128u + (unsigned)(wc * 32 + 8 * fq) * 2u) = pack8(v0, v1);
                    else if (wc == 2 && fq == 0) { at<f32x4>(IW, row * 32u) = v0 * 0.35355339059f; at<f32x4>(IW, row * 32u + 16u) = v1 * 0.35355339059f; }
                    asm volatile("" ::: "memory");
                }
        }
    }
};
struct EpiSig {
    unsigned char* out; int ldc; float pre;
    __device__ __forceinline__ void operator()(PG8_EPI_ARGS) const {
        const unsigned o0 = (unsigned)(u.pm * BM + wr * 64 + fr) * 1024u + (unsigned)(u.pn * BM + wc * 32 + 8 * fq);
#pragma unroll
        for (int ai = 0; ai < 2; ++ai)
#pragma unroll
            for (int m = 0; m < 4; ++m) {
                unsigned o = o0 + (unsigned)(ai * HALF + m * 16) * 1024u; PG8_PIN(o);
#pragma unroll
                for (int bj = 0; bj < 2; ++bj) {
                    const f32x4 v0 = acc[ai][bj][m][0], v1 = acc[ai][bj][m][1];
                    unsigned w0 = 0u, w1 = 0u;
#pragma unroll
                    for (int i = 0; i < 4; ++i) { w0 = __builtin_amdgcn_cvt_pk_u8_f32(sigm(v0[i] * pre) * 255.f, i, w0); w1 = __builtin_amdgcn_cvt_pk_u8_f32(sigm(v1[i] * pre) * 255.f, i, w1); }
                    at<unsigned long long>(out, o + bj * 128u) = (unsigned long long)w0 | ((unsigned long long)w1 << 32);
                }
                asm volatile("" ::: "memory");
            }
    }
};
template <bool ADD>
struct EpiGatedT {
    const unsigned char* gate; const bf16_t* addsrc; bf16_t* out; int ldc;
    __device__ __forceinline__ void operator()(PG8_EPI_ARGS) const {
        const unsigned o0 = ((unsigned)(u.pm * BM + wr * 64 + fr) * 1024u + (unsigned)(u.pn * BM + wc * 32 + 8 * fq)) * 2u;
        constexpr int NB = 2;
        unsigned long long gq[NB][2]; u32x4 aq[ADD ? NB : 1][2];
#define PG8_GT_LD(it) do { unsigned o_ = o0 + (unsigned)(((it) >> 2) * HALF + ((it) & 3) * 16) * 2048u; PG8_PIN(o_); \
            gq[(it) % NB][0] = at<const unsigned long long>(gate, o_ >> 1); gq[(it) % NB][1] = at<const unsigned long long>(gate, (o_ >> 1) + 128u); \
            if constexpr (ADD) { aq[(it) % NB][0] = at<const u32x4>(addsrc, o_); aq[(it) % NB][1] = at<const u32x4>(addsrc, o_ + 256u); } } while (0)
#pragma unroll
        for (int it = 0; it < NB; ++it) PG8_GT_LD(it);
#pragma unroll
        for (int it = 0; it < 8; ++it) { const int ai = it >> 2, m = it & 3;
                unsigned o = o0 + (unsigned)(ai * HALF + m * 16) * 2048u; PG8_PIN(o);
                f32x4 v0[2], v1[2];
#pragma unroll
                for (int bj = 0; bj < 2; ++bj) {
                    const unsigned long long gw = gq[it % NB][bj]; const unsigned glo = (unsigned)gw, ghi = (unsigned)(gw >> 32); constexpr float K8 = 1.f / 255.f;
                    const f32x4 g0 = {(float)(glo & 0xffu) * K8, (float)((glo >> 8) & 0xffu) * K8, (float)((glo >> 16) & 0xffu) * K8, (float)(glo >> 24) * K8};
                    const f32x4 g1 = {(float)(ghi & 0xffu) * K8, (float)((ghi >> 8) & 0xffu) * K8, (float)((ghi >> 16) & 0xffu) * K8, (float)(ghi >> 24) * K8};
                    v0[bj] = acc[ai][bj][m][0] * g0; v1[bj] = acc[ai][bj][m][1] * g1;
                    if constexpr (ADD) { f32x4 a0, a1; unpack8(aq[it % NB][bj], a0, a1); v0[bj] = v0[bj] + a0; v1[bj] = v1[bj] + a1; }
                }
                if (it + NB < 8) PG8_GT_LD(it + NB);
#pragma unroll
                for (int bj = 0; bj < 2; ++bj) at<u32x4>(out, o + bj * 256u) = pack8(v0[bj], v1[bj]);
                asm volatile("" ::: "memory");
            }
#undef PG8_GT_LD
    }
};
struct EpiResBf16 {
    const bf16_t* x; bf16_t* out; float alpha;
    __device__ __forceinline__ void operator()(PG8_EPI_ARGS) const {
        const unsigned o0 = ((unsigned)(u.pm * BM + wr * 64 + fr) * 1024u + (unsigned)(u.pn * BM + wc * 32 + 8 * fq)) * 2u;
        u32x4 xq[8][2];
#define PG8_X_LD(buf, it) do { unsigned o_ = o0 + (unsigned)(((it) >> 2) * HALF + ((it) & 3) * 16) * 2048u; PG8_PIN(o_); \
            xq[buf][0] = at<const u32x4>(x, o_); xq[buf][1] = at<const u32x4>(x, o_ + 256u); } while (0)
#pragma unroll
        for (int it = 0; it < 8; ++it) PG8_X_LD(it, it);
#pragma unroll
        for (int it = 0; it < 8; ++it) { const int ai = it >> 2, m = it & 3;
                unsigned o = o0 + (unsigned)(ai * HALF + m * 16) * 2048u; PG8_PIN(o);
#pragma unroll
                for (int bj = 0; bj < 2; ++bj) { f32x4 x0, x1; unpack8(xq[it][bj], x0, x1);
                    at<u32x4>(out, o + bj * 256u) = pack8(x0 * alpha + acc[ai][bj][m][0], x1 * alpha + acc[ai][bj][m][1]); }
                asm volatile("" ::: "memory");
            }
#undef PG8_X_LD
    }
};
struct EpiGU {
    bf16_t* HG; const float* cw; float pre;
    __device__ __forceinline__ void operator()(PG8_EPI_ARGS) const {
        const int row0 = u.pm * BM + wr * 64 + fr; const unsigned cb = (unsigned)(u.pn * HALF + wc * 32 + 8 * fq) * 2u;
        float cv[8];
#pragma unroll
        for (int it = 0; it < 8; ++it) cv[it] = at<const float>(cw, (unsigned)(row0 + (it >> 2) * HALF + (it & 3) * 16) * 4u);
#pragma unroll
        for (int it = 0; it < 8; ++it) { const int ai = it >> 2, m = it & 3;
                unsigned row = (unsigned)(row0 + ai * HALF + m * 16); PG8_PIN(row);
                const float c = cv[it];
                f32x4 g0 = acc[ai][0][m][0] * pre, g1 = acc[ai][0][m][1] * pre; const f32x4 u0 = acc[ai][1][m][0] * pre, u1 = acc[ai][1][m][1] * pre;
#pragma unroll
                for (int i = 0; i < 4; ++i) { g0[i] = g0[i] * sigm(g0[i]) * u0[i] * c; g1[i] = g1[i] * sigm(g1[i]) * u1[i] * c; }
                at<u32x4>(HG, row * 512u + cb) = pack8(g0, g1);
                asm volatile("" ::: "memory");
            }
    }
};
struct EpiDown {
    const int* ent; bf16_t* Y0; unsigned ystride;
    __device__ __forceinline__ void operator()(PG8_EPI_ARGS) const {
        const int row0 = u.pm * BM + wr * 64 + fr; const unsigned cb = (unsigned)(u.pn * BM + wc * 32 + 8 * fq) * 2u;
        int ev[8];
#pragma unroll
        for (int it = 0; it < 8; ++it) ev[it] = at<const int>(ent, (unsigned)(row0 + (it >> 2) * HALF + (it & 3) * 16) * 4u);
#pragma unroll
        for (int it = 0; it < 8; ++it) { const int ai = it >> 2, m = it & 3; const int e = ev[it];
                if (e >= 0) { unsigned o = (unsigned)(e >> 1) * 2048u + cb + (unsigned)(e & 1) * ystride; PG8_PIN(o);
#pragma unroll
                    for (int bj = 0; bj < 2; ++bj) at<u32x4>(Y0, o + bj * 256u) = pack8(acc[ai][bj][m][0], acc[ai][bj][m][1]); }
                asm volatile("" ::: "memory");
            }
    }
};
struct EpiStore {
    bf16_t* out; int ldc;
    __device__ __forceinline__ void operator()(PG8_EPI_ARGS) const {
        const unsigned o0 = ((unsigned)(u.pm * BM + wr * 64 + fr) * 1024u + (unsigned)(u.pn * BM + wc * 32 + 8 * fq)) * 2u;
#pragma unroll
        for (int ai = 0; ai < 2; ++ai)
#pragma unroll
            for (int m = 0; m < 4; ++m) {
                unsigned o = o0 + (unsigned)(ai * HALF + m * 16) * 2048u; PG8_PIN(o);
#pragma unroll
                for (int bj = 0; bj < 2; ++bj) at<u32x4>(out, o + bj * 256u) = pack8(acc[ai][bj][m][0], acc[ai][bj][m][1]);
                asm volatile("" ::: "memory");
            }
    }
};
struct EpiPle {
    const bf16_t* t1; bf16_t* out; float pre;
    __device__ __forceinline__ void operator()(PG8_EPI_ARGS) const {
        const unsigned o0 = ((unsigned)(u.pm * BM + wr * 64 + fr) * 1024u + (unsigned)(u.pn * BM + wc * 32 + 8 * fq)) * 2u;
        u32x4 tq[8][2];
#define PG8_T_LD(buf, it) do { unsigned o_ = o0 + (unsigned)(((it) >> 2) * HALF + ((it) & 3) * 16) * 2048u; PG8_PIN(o_); \
            tq[buf][0] = at<const u32x4>(t1, o_); tq[buf][1] = at<const u32x4>(t1, o_ + 256u); } while (0)
#pragma unroll
        for (int it = 0; it < 8; ++it) PG8_T_LD(it, it);
#pragma unroll
        for (int it = 0; it < 8; ++it) { const int ai = it >> 2, m = it & 3;
                unsigned o = o0 + (unsigned)(ai * HALF + m * 16) * 2048u; PG8_PIN(o);
#pragma unroll
                for (int bj = 0; bj < 2; ++bj) {
                    f32x4 t0, t1v; unpack8(tq[it][bj], t0, t1v);
                    f32x4 v0 = acc[ai][bj][m][0], v1 = acc[ai][bj][m][1];
#pragma unroll
                    for (int i = 0; i < 4; ++i) { v0[i] = sigm(v0[i] * pre) * t0[i]; v1[i] = sigm(v1[i] * pre) * t1v[i]; }
                    at<u32x4>(out, o + bj * 256u) = pack8(v0, v1);
                }
                asm volatile("" ::: "memory");
            }
#undef PG8_T_LD
    }
};

template <class Epi, class Sched, bool ALIGN_EPI, bool GATHER = false, bool FP8 = false>
__device__ __forceinline__ void gemm_phase(PG8_LAS unsigned char* lds, const Gemm g, const Sched& S, const Epi& E, int wave_in) {
    const int tid = ltid(wave_in), wid = __builtin_amdgcn_readfirstlane(tid >> 6), lane = tid & 63, wr = wid >> 2, wc = wid & 3, fr = lane & 15, fq = lane >> 4;
    int K_ = g.K; asm volatile("" : "+s"(K_));
    const int K = K_, nt = K / BK;
    int RA[2], CA[2]; unsigned voffB[2], voffA[2];
#pragma unroll
    for (int i = 0; i < 2; ++i) { int R, C; stage_rc(tid * 16 + i * 8192, R, C); const int Rb = (R & ~31) + perm32(R & 31); RA[i] = R; CA[i] = C; voffB[i] = (unsigned)(Rb * g.ldb + C) * 2u; voffA[i] = (unsigned)(R * g.lda + C) * 2u; }
    const size_t hstepA = (size_t)HALF * g.lda * 2;
    const size_t kstep = (size_t)(BK * 2);
    const size_t hstepB = (size_t)HALF * g.ldb * 2;
    const unsigned ldsw = (unsigned)wid * 1024u;
    const int aoff = lds_byte(wr * 64 + fr, fq * 8), boff = lds_byte(wc * 32 + fr, fq * 8);
    const char* Ab = (const char*)g.A;
#define PG8_SA(b, h) (((b) * 2 + (h)) * HTB)
#define PG8_SB(b, h) ((4 + (b) * 2 + (h)) * HTB)
#define PG8_STAGE_A(bufoff, kb, OFF, h) do { _Pragma("unroll") for (int _i = 0; _i < 2; ++_i) { const char* _p; \
        if constexpr (GATHER) _p = Ab + (kb) + (OFF##_v)[h][_i]; else _p = Ab + ((kb) + (OFF##_u) + (size_t)(h) * hstepA) + voffA[_i]; \
        __builtin_amdgcn_global_load_lds((const unsigned*)_p, (PG8_LAS unsigned*)(lds + (bufoff) + ldsw + _i * 8192), 16, 0, 0); } } while (0)
#define PG8_STAGE_B(bufoff, gbase) do { _Pragma("unroll") for (int _i = 0; _i < 2; ++_i) \
        __builtin_amdgcn_global_load_lds((const unsigned*)((const char*)(gbase) + voffB[_i]), (PG8_LAS unsigned*)(lds + (bufoff) + ldsw + _i * 8192), 16, 0, 0); } while (0)
#define PG8_MKOFF(uu, OFF) do { if constexpr (GATHER) { _Pragma("unroll") for (int _h = 0; _h < 2; ++_h) _Pragma("unroll") for (int _i = 0; _i < 2; ++_i) { \
        const int _row = g.rows[(uu).pm * BM + _h * HALF + RA[_i]]; (OFF##_v)[_h][_i] = (unsigned)(_row * g.lda + CA[_i]) * 2u; } } else { OFF##_u = (size_t)(uu).pm * BM * g.lda * 2; } } while (0)
#define PG8_LDA(dst, b, h) do { _Pragma("unroll") for (int m = 0; m < 4; ++m) { if constexpr (FP8) { dst##8[m].lo = *(const PG8_LAS i32x4_t*)(lds + PG8_SA(b, h) + aoff + m * 2048); dst##8[m].hi = *(const PG8_LAS i32x4_t*)(lds + PG8_SA(b, h) + aoff + m * 2048 + 1024); } \
        else { _Pragma("unroll") for (int k = 0; k < 2; ++k) dst[m][k] = *(const PG8_LAS bf16x8*)(lds + PG8_SA(b, h) + aoff + m * 2048 + k * 1024); } } } while (0)
#define PG8_LDB(dst, b, h) do { _Pragma("unroll") for (int n = 0; n < 2; ++n) { if constexpr (FP8) { dst##8[n].lo = *(const PG8_LAS i32x4_t*)(lds + PG8_SB(b, h) + boff + n * 2048); dst##8[n].hi = *(const PG8_LAS i32x4_t*)(lds + PG8_SB(b, h) + boff + n * 2048 + 1024); } \
        else { _Pragma("unroll") for (int k = 0; k < 2; ++k) dst[n][k] = *(const PG8_LAS bf16x8*)(lds + PG8_SB(b, h) + boff + n * 2048 + k * 1024); } } } while (0)
#define PG8_MMA(ai, bj, At, Bt) do { __builtin_amdgcn_s_setprio(1); \
        if constexpr (FP8) { _Pragma("unroll") for (int m = 0; m < 4; ++m) _Pragma("unroll") for (int n = 0; n < 2; ++n) \
            asm volatile("v_mfma_f32_16x16x128_f8f6f4 %0, %1, %2, %0" : "+v"(acc[ai][bj][m][n]) : "v"(Bt##8[n]), "v"(At##8[m])); }   \
        else { _Pragma("unroll") for (int m = 0; m < 4; ++m) _Pragma("unroll") for (int n = 0; n < 2; ++n) _Pragma("unroll") for (int k = 0; k < 2; ++k) \
            acc[ai][bj][m][n] = __builtin_amdgcn_mfma_f32_16x16x32_bf16(Bt[n][k], At[m][k], acc[ai][bj][m][n], 0, 0, 0); } __builtin_amdgcn_s_setprio(0); } while (0)
#define PG8_WAIT_V(n) asm volatile("s_waitcnt vmcnt(" #n ")" ::: "memory")
#define PG8_WAIT_L(n) asm volatile("s_waitcnt lgkmcnt(" #n ")" ::: "memory")
#define PG8_BAR __builtin_amdgcn_s_barrier()
#define PG8_SCHED __builtin_amdgcn_sched_barrier(0)
    Unit cur, nxt; int ui = 0;
    if (!S.next(0, cur)) return;
    f32x4 acc[2][2][4][2];
#pragma unroll
    for (int a = 0; a < 2; ++a)
#pragma unroll
        for (int b = 0; b < 2; ++b)
#pragma unroll
            for (int m = 0; m < 4; ++m)
#pragma unroll
                for (int n = 0; n < 2; ++n) acc[a][b][m][n] = (f32x4){0.f, 0.f, 0.f, 0.f};
    bf16x8 At[4][2], B0[2][2], B1[2][2];
    i32x8_t At8[4], B08[2], B18[2];
    unsigned offAc_v[2][2], offAn_v[2][2]; size_t offAc_u = 0, offAn_u = 0;
    PG8_MKOFF(cur, offAc);
    const char* cB = (const char*)(g.Bt + cur.boff);
    PG8_STAGE_B(PG8_SB(0, 0), cB); PG8_STAGE_B(PG8_SB(0, 1), cB + hstepB); PG8_STAGE_A(PG8_SA(0, 0), 0, offAc, 0); PG8_STAGE_A(PG8_SA(0, 1), 0, offAc, 1);
    if (wr == 1) PG8_BAR;
    PG8_WAIT_V(2); PG8_BAR;
    PG8_STAGE_B(PG8_SB(1, 0), cB + kstep); PG8_STAGE_A(PG8_SA(1, 0), kstep, offAc, 0); PG8_STAGE_B(PG8_SB(1, 1), cB + hstepB + kstep);
    PG8_WAIT_V(6); PG8_BAR;
    for (;;) {
        const bool has_next = S.next(ui + 1, nxt);
        if (has_next) { PG8_MKOFF(nxt, offAn); }
        else { offAn_u = offAc_u;
#pragma unroll
            for (int h = 0; h < 2; ++h)
#pragma unroll
                for (int i = 0; i < 2; ++i) offAn_v[h][i] = offAc_v[h][i];
        }
        const char* nB = has_next ? (const char*)(g.Bt + nxt.boff) : cB;
        for (int t = 0; t < nt; t += 2) {
            const bool last = (t == nt - 2);
            const size_t a1k = (size_t)(t + 1) * kstep;
            const size_t a2k = last ? (size_t)0 : (size_t)(t + 2) * kstep; const char* b2 = last ? nB : cB + (size_t)(t + 2) * kstep;
            const size_t a3k = a2k + kstep; const char* b3 = b2 + kstep;
            unsigned o2_v[2][2]; const size_t o2_u = last ? offAn_u : offAc_u;
#pragma unroll
            for (int h = 0; h < 2; ++h)
#pragma unroll
                for (int i = 0; i < 2; ++i) o2_v[h][i] = last ? offAn_v[h][i] : offAc_v[h][i];
            PG8_LDB(B0, 0, 0); PG8_LDB(B1, 0, 1); PG8_SCHED; PG8_LDA(At, 0, 0); PG8_STAGE_A(PG8_SA(1, 1), a1k, offAc, 1);
            PG8_WAIT_V(8); PG8_WAIT_L(0); PG8_BAR; PG8_MMA(0, 0, At, B0); PG8_MMA(0, 1, At, B1); PG8_BAR; PG8_SCHED;
            PG8_LDA(At, 0, 1); PG8_STAGE_B(PG8_SB(0, 0), b2); PG8_STAGE_B(PG8_SB(0, 1), b2 + hstepB); PG8_STAGE_A(PG8_SA(0, 0), a2k, o2, 0);
            PG8_WAIT_V(8); PG8_WAIT_L(0); PG8_BAR; PG8_MMA(1, 0, At, B0); PG8_MMA(1, 1, At, B1); PG8_BAR; PG8_SCHED;
            PG8_LDB(B0, 1, 0); PG8_LDB(B1, 1, 1); PG8_SCHED; PG8_LDA(At, 1, 0); PG8_STAGE_A(PG8_SA(0, 1), a2k, o2, 1);
            PG8_WAIT_V(8); PG8_WAIT_L(0); PG8_BAR; PG8_MMA(0, 0, At, B0); PG8_MMA(0, 1, At, B1); PG8_BAR; PG8_SCHED;
            PG8_LDA(At, 1, 1); PG8_STAGE_B(PG8_SB(1, 0), b3); PG8_STAGE_B(PG8_SB(1, 1), b3 + hstepB); PG8_STAGE_A(PG8_SA(1, 0), a3k, o2, 0);
            PG8_WAIT_V(8); PG8_WAIT_L(0); PG8_BAR; PG8_MMA(1, 0, At, B0); PG8_MMA(1, 1, At, B1); PG8_BAR; PG8_SCHED;
        }
        if constexpr (ALIGN_EPI) { if (wr == 0) PG8_BAR; }
        if constexpr (FP8) asm volatile("s_nop 15\n\ts_nop 15\n\ts_nop 7" ::: "memory");
        E(acc, cur, wr, wc, fr, fq);
        if (!has_next) break;
#pragma unroll
        for (int a = 0; a < 2; ++a)
#pragma unroll
            for (int b = 0; b < 2; ++b)
#pragma unroll
                for (int m = 0; m < 4; ++m)
#pragma unroll
                    for (int n = 0; n < 2; ++n) acc[a][b][m][n] = (f32x4){0.f, 0.f, 0.f, 0.f};
        cur = nxt; cB = nB; ++ui; offAc_u = offAn_u;
#pragma unroll
        for (int h = 0; h < 2; ++h)
#pragma unroll
            for (int i = 0; i < 2; ++i) offAc_v[h][i] = offAn_v[h][i];
        if constexpr (ALIGN_EPI) { if (wr == 1) PG8_BAR; }
    }
    PG8_WAIT_V(0);
    if constexpr (!ALIGN_EPI) { if (wr == 0) PG8_BAR; }
    PG8_BAR;
#undef PG8_SA
#undef PG8_SB
#undef PG8_STAGE_A
#undef PG8_STAGE_B
#undef PG8_MKOFF
#undef PG8_LDA
#undef PG8_LDB
#undef PG8_MMA
#undef PG8_WAIT_V
#undef PG8_WAIT_L
#undef PG8_BAR
#undef PG8_SCHED
}
}
namespace attn_body {
using bf16=__hip_bfloat16;
using bf16x8=__attribute__((ext_vector_type(8)))short;
using s16x4=__attribute__((ext_vector_type(4)))short;
using f32x16=__attribute__((ext_vector_type(16)))float;
using u32x4=__attribute__((ext_vector_type(4)))unsigned;
constexpr int BATCH=2,SEQ=16384,D=64,DM=512;
constexpr int NW=8,QBLK=32,QB=QBLK*NW,KVBLK=64,NQB=SEQ/QB;
constexpr int ATTN_PITCH=DM, ATTN_UNIT_ROWS=QB;
__device__ __forceinline__ int crow(int r,int hi){return (r&3)+8*(r>>2)+4*hi;}
#define SBAR() __builtin_amdgcn_sched_barrier(0)
__device__ __forceinline__ void cmask(f32x16&p0,f32x16&p1,int jb,int qrel,int hi){
  const float NEG=-INFINITY; int kb=64*jb+4*hi;
  #pragma unroll
  for(int r=0;r<16;++r){int kv=kb+(r&3)+8*(r>>2); if(kv>qrel)p0[r]=NEG; if(kv+32>qrel)p1[r]=NEG;}
}

constexpr int NSLOT=3, SLOTB=8192;
constexpr int LDS_K=0, LDS_V=NSLOT*SLOTB, LDS_WS=2*NSLOT*SLOTB, LDS_OST=LDS_WS+NW*64*4, LDS_MK=LDS_OST+NW*4096, LDS_BYTES=LDS_MK+NW*1024, LDS_BYTES_WIDE=LDS_V+NSLOT*2*SLOTB+NW*64*4+NW*4096;
constexpr float C2=0.125f*1.4426950408889634f;
__device__ __forceinline__ void glds16(const void*gsrc,unsigned lds_dst){unsigned keep;
  asm volatile("s_mov_b32 %0, m0\n\ts_mov_b32 m0, %2\n\ts_nop 0\n\tglobal_load_lds_dwordx4 %1, off\n\ts_mov_b32 m0, %0":"=&s"(keep):"v"(gsrc),"s"(lds_dst):"memory");}
__device__ __forceinline__ float max3f(float a,float b,float c){float r;asm("v_max3_f32 %0, %1, %2, %3":"=v"(r):"v"(a),"v"(b),"v"(c));return r;}
__device__ __forceinline__ float max2f(float a,float b){float r;asm("v_max_f32_e32 %0, %1, %2":"=v"(r):"v"(a),"v"(b));return r;}
__device__ __forceinline__ float fadd_s(float a,float b){float r;asm("v_add_f32_e32 %0, %1, %2":"=v"(r):"v"(a),"v"(b));return r;}
__device__ __forceinline__ float fsub_s(float a,float b){float r;asm("v_sub_f32_e32 %0, %1, %2":"=v"(r):"v"(a),"v"(b));return r;}
typedef float f32x2_t __attribute__((ext_vector_type(2))); typedef __bf16 bf16x2_t __attribute__((ext_vector_type(2)));
__device__ __forceinline__ unsigned cvtpk_s(float lo,float hi){f32x2_t v={lo,hi};bf16x2_t b=__builtin_convertvector(v,bf16x2_t);return __builtin_bit_cast(unsigned,b);}
#define WAIT_BAR(N) asm volatile("s_waitcnt vmcnt(" #N ") lgkmcnt(0)\n\ts_barrier":::"memory")

__device__ __forceinline__ void qkt(f32x16&p0,f32x16&p1,const char*Kslot,const bf16x8*qr,const f32x16&ci0,const f32x16&ci1,int r32,int hi){
  const char*kb=Kslot+hi*1024+r32*16;
  #pragma unroll
  for(int d0=0;d0<4;++d0){
    const bf16x8 b0=*reinterpret_cast<const bf16x8*>(kb+d0*2048);
    const bf16x8 b1=*reinterpret_cast<const bf16x8*>(kb+d0*2048+512);
    if(d0==0){p0=__builtin_amdgcn_mfma_f32_32x32x16_bf16(b0,qr[0],ci0,0,0,0);p1=__builtin_amdgcn_mfma_f32_32x32x16_bf16(b1,qr[0],ci1,0,0,0);}
    else{p0=__builtin_amdgcn_mfma_f32_32x32x16_bf16(b0,qr[d0],p0,0,0,0);p1=__builtin_amdgcn_mfma_f32_32x32x16_bf16(b1,qr[d0],p1,0,0,0);}}
}
typedef __attribute__((address_space(3))) const char* lds_cptr;
typedef short v4i16_t __attribute__((ext_vector_type(4)));
__device__ __forceinline__ void kload8(bf16x8*kf,lds_cptr kp){
  kf[0]=*(const __attribute__((address_space(3))) bf16x8*)(kp);      kf[1]=*(const __attribute__((address_space(3))) bf16x8*)(kp+512);
  kf[2]=*(const __attribute__((address_space(3))) bf16x8*)(kp+2048); kf[3]=*(const __attribute__((address_space(3))) bf16x8*)(kp+2560);
  kf[4]=*(const __attribute__((address_space(3))) bf16x8*)(kp+4096); kf[5]=*(const __attribute__((address_space(3))) bf16x8*)(kp+4608);
  kf[6]=*(const __attribute__((address_space(3))) bf16x8*)(kp+6144); kf[7]=*(const __attribute__((address_space(3))) bf16x8*)(kp+6656);
}
__device__ __forceinline__ void kload2(bf16x8*kf,lds_cptr kp,int j){ kf[2*j]=*(const __attribute__((address_space(3))) bf16x8*)(kp+j*2048); kf[2*j+1]=*(const __attribute__((address_space(3))) bf16x8*)(kp+j*2048+512); }
__device__ __forceinline__ s16x4 vtr(lds_cptr p){ return __builtin_bit_cast(s16x4,__builtin_amdgcn_ds_read_tr16_b64_v4i16((__attribute__((address_space(3))) v4i16_t*)p)); }
__device__ __forceinline__ float rowmax(const f32x16&p0,const f32x16&p1){
  float a=max3f(p0[0],p0[1],p1[0]),b=max3f(p0[2],p0[3],p1[1]);a=max3f(a,p1[2],p1[3]);
  #pragma unroll
  for(int r=4;r<16;r+=4){a=max3f(a,p0[r],p0[r+1]);b=max3f(b,p0[r+2],p0[r+3]);a=max3f(a,p1[r],p1[r+1]);b=max3f(b,p1[r+2],p1[r+3]);}
  const float m=max2f(a,b);
  auto rr=__builtin_amdgcn_permlane32_swap(__float_as_uint(m),__float_as_uint(m),false,false);
  return max2f(__uint_as_float(rr[0]),__uint_as_float(rr[1]));
}
__device__ __forceinline__ void pv(f32x16*o,int vb,bf16x8 pa0,bf16x8 pa1,bf16x8 pa2,bf16x8 pa3){
  #pragma unroll
  for(int d0=0;d0<2;++d0){s16x4 lo[4],hi[4];
    #pragma unroll
    for(int ks=0;ks<4;++ks){
      asm volatile("ds_read_b64_tr_b16 %0,%1 offset:%c2":"=&v"(lo[ks]):"v"(vb),"i"(d0*4096+ks*1024):"memory");
      asm volatile("ds_read_b64_tr_b16 %0,%1 offset:%c2":"=&v"(hi[ks]):"v"(vb),"i"(d0*4096+ks*1024+512):"memory");}
    asm volatile("s_waitcnt lgkmcnt(0)":::"memory");SBAR();
    #define PK(k) (bf16x8){lo[k][0],lo[k][1],lo[k][2],lo[k][3],hi[k][0],hi[k][1],hi[k][2],hi[k][3]}
    o[d0]=__builtin_amdgcn_mfma_f32_32x32x16_bf16(pa0,PK(0),o[d0],0,0,0);
    o[d0]=__builtin_amdgcn_mfma_f32_32x32x16_bf16(pa1,PK(1),o[d0],0,0,0);
    o[d0]=__builtin_amdgcn_mfma_f32_32x32x16_bf16(pa2,PK(2),o[d0],0,0,0);
    o[d0]=__builtin_amdgcn_mfma_f32_32x32x16_bf16(pa3,PK(3),o[d0],0,0,0);
    #undef PK
  }
}

#ifndef ATTN_STORE16
#define ATTN_STORE16(p,v) (*(u32x4*)(p)=(v))
#endif
template<int THRL,bool MASKED,bool WIDE,bool NOMAX> __device__ __forceinline__ void attn_unit(int b,int hq,int hv,int qb,const bf16*Q,const bf16*__restrict__ K,const bf16*__restrict__ V,bf16*O,const unsigned long long*__restrict__ MK,char*shm,int wave_in,int badoff){
  const int tid=ltid(wave_in),lane=tid&63,r32=lane&31,hi=lane>>5; const int wid=__builtin_amdgcn_readfirstlane(tid>>6);
  const long rowbase=(long)b*SEQ; const int q0=qb*QB;
  const bf16*Qw=Q+(rowbase+q0+wid*QBLK)*DM+hq*D;
  const bf16*Kh=K+rowbase*DM+hq*D,*Vh=V+rowbase*DM+hv*D;
  constexpr int VSLOT=WIDE?2*SLOTB:SLOTB, L_WS=LDS_V+NSLOT*VSLOT, L_OST=L_WS+NW*64*4, L_MK=L_OST+NW*4096, L_TAB=L_MK+NW*2048;
  #define VS(sl) (WIDE?2*(sl):(sl))
  const unsigned lds0=(unsigned)(uintptr_t)shm;
  float*wsf=(float*)(shm+L_WS)+wid*64;
  const bf16*ksrc=Kh+(long)lane*DM+wid*8;
  const bf16*vsrc=Vh+(long)(16*(wid&3)+(lane>>2))*DM+(wid>>2)*32+(lane&3)*8;
  const unsigned kdst=lds0+LDS_K+wid*1024, vdst=lds0+LDS_V+wid*1024;
  #define DMA_K(t,slot) glds16(ksrc+(long)(t)*KVBLK*DM,(unsigned)__builtin_amdgcn_readfirstlane(kdst+(slot)))
  #define DMA_V(t,slot) do{ glds16(vsrc+(long)(t)*KVBLK*DM,(unsigned)__builtin_amdgcn_readfirstlane(vdst+VS(slot))); if(WIDE){ glds16(vsrc+64+(long)(t)*KVBLK*DM,(unsigned)__builtin_amdgcn_readfirstlane(vdst+VS(slot)+8192)); } }while(0)
  const long mq0=(long)q0+wid*QBLK+2*(lane&15); const unsigned mdst=lds0+L_MK+wid*2048;
  #define DMA_M4(t0) do{ if(MASKED){ const long t_=(long)(t0)+(lane>>4); if(t_<NT){ glds16(MK+(16384L*t_-32L*t_*(t_-1)+mq0-64L*t_),(unsigned)__builtin_amdgcn_readfirstlane(mdst+(((t0)&7)*256))); } } }while(0)
  unsigned mw0=0u,mw1=0u;
  #define MKRD(t) do{ if(MASKED){ const unsigned long long w_=*(const __attribute__((address_space(3))) unsigned long long*)(shm3+L_MK+wid*2048+(((t)&7)*256)+r32*8); mw0=(unsigned)w_; mw1=(unsigned)(w_>>32); } }while(0)
  #define MAND(X,r,MW) do{}while(0)
  bf16x8 aid[2];
  if(MASKED){
    #pragma unroll
    for(int ks=0;ks<2;++ks)
      #pragma unroll
      for(int j=0;j<8;++j) aid[ks][j]=(short)((r32==16*ks+8*hi+j)?0x3F80:0);
  }
  #define TABRD(w,ks) (*(const __attribute__((address_space(3))) bf16x8*)(shm3+L_TAB+((((w)>>(16*(ks)+8*hi))&0xffu)<<4)))
  #define BIAS(C0,C1,CI) do{ const bf16x8 f00_=TABRD(mw0,0),f01_=TABRD(mw0,1),f10_=TABRD(mw1,0),f11_=TABRD(mw1,1); \
    C0=__builtin_amdgcn_mfma_f32_32x32x16_bf16(aid[0],f00_,CI,0,0,0); C1=__builtin_amdgcn_mfma_f32_32x32x16_bf16(aid[0],f10_,CI,0,0,0); \
    C0=__builtin_amdgcn_mfma_f32_32x32x16_bf16(aid[1],f01_,C0,0,0,0); C1=__builtin_amdgcn_mfma_f32_32x32x16_bf16(aid[1],f11_,C1,0,0,0); }while(0)
  const int vb0=(int)(lds0+LDS_V)+((lane>>4)&1)*32+(lane&3)*8+(4*hi+((lane&15)>>2))*64;
  const char*Kbase=shm+LDS_K; bf16x8 kf[8];
  const lds_cptr shm3=(lds_cptr)shm; const lds_cptr kp0=shm3+LDS_K+hi*1024+r32*16; const lds_cptr vp0=shm3+LDS_V+((lane>>4)&1)*32+(lane&3)*8+(4*hi+((lane&15)>>2))*64;
  const int NT=(q0+QB)/KVBLK;
  DMA_M4(0);DMA_K(0,0);DMA_V(0,0);DMA_K(1,SLOTB);
  bf16x8 qr[4];
  #pragma unroll
  for(int d0=0;d0<4;++d0)qr[d0]=*reinterpret_cast<const bf16x8*>(&Qw[(long)r32*DM+d0*16+hi*8]);
  float mhat=0.f,l_reg=0.f;f32x16 o[4];o[0]=f32x16{};o[1]=f32x16{};o[2]=f32x16{};o[3]=f32x16{};f32x16 negm=f32x16{}; if(!WIDE&&!NOMAX){ asm volatile("":"+v"(negm)); }
  const int qrel=wid*QBLK+r32;
  #define CMASK(P0,P1,t) do{int jb_=(t)-(NT-4); if(jb_>=0)cmask(P0,P1,jb_,qrel,hi);}while(0)
  bool resc=false;
  #define START(P0,P1) do{ resc=false; \
    if constexpr(!NOMAX){ const float rm=rowmax(P0,P1); const float dl=rm; mhat=fadd_s(mhat,dl); \
      _Pragma("unroll") for(int r=0;r<16;++r){P0[r]=fsub_s(P0[r],dl);P1[r]=fsub_s(P1[r],dl);} \
      if(!WIDE){ _Pragma("unroll") for(int r=0;r<16;++r)negm[r]=-mhat; asm volatile("":"+v"(negm)); } } \
    _Pragma("unroll") for(int r=0;r<16;++r)P0[r]=__builtin_amdgcn_exp2f(P0[r]); }while(0)
  #define RESC() do{ if constexpr(!NOMAX) if(resc){ asm volatile("s_waitcnt lgkmcnt(0)":::"memory"); \
      _Pragma("unroll") for(int d_=0;d_<(WIDE?4:2);++d_) _Pragma("unroll") for(int r=0;r<16;++r)o[d_][r]*=wsf[crow(r,hi)]; } }while(0)
  f32x16 pA0,pA1,pB0,pB1;
  int sl_prev=0,sl_cur=0,sl_next=SLOTB;
  #define ROT() do{sl_prev=sl_cur;sl_cur=sl_next;sl_next=(sl_next==(NSLOT-1)*SLOTB)?0:sl_next+SLOTB;}while(0)
  DMA_K(2,2*SLOTB); const bool m4b_=MASKED&&(4<NT); if(m4b_){DMA_M4(4);}
  if(WIDE||m4b_){WAIT_BAR(4);}else{WAIT_BAR(3);}
  if(MASKED){ MKRD(0); BIAS(pA0,pA1,negm); qkt(pA0,pA1,Kbase,qr,pA0,pA1,r32,hi); } else { qkt(pA0,pA1,Kbase,qr,negm,negm,r32,hi); }
  asm volatile("s_nop 15\n\ts_nop 7":"+v"(pA0),"+v"(pA1));CMASK(pA0,pA1,0);
  START(pA0,pA1);
  _Pragma("unroll") for(int r=0;r<16;++r)pA1[r]=__builtin_amdgcn_exp2f(pA1[r]);
  WAIT_BAR(0);
  DMA_K(3,0);DMA_V(1,SLOTB);
  ROT();
  kload8(kf,kp0+sl_cur);
  if(WIDE){WAIT_BAR(3);}else{WAIT_BAR(2);}
  s16x4 vlo[8],vhi[8]; u32x4 pw0,pw1,pw2,pw3;
  #define PKW(P,B) cvtpk_s(P[B],P[B+1])
  #define PAF(k) __builtin_bit_cast(bf16x8,pw##k)
  #define VFR(i) (bf16x8){vlo[i][0],vlo[i][1],vlo[i][2],vlo[i][3],vhi[i][0],vhi[i][1],vhi[i][2],vhi[i][3]}
  #define PIN(x) asm volatile("":"+v"(x))
  #define MX3(a,b,c) __builtin_fmaxf(__builtin_fmaxf((a),(b)),(c))
  #define GAPA(MF,A0,A1,A2,A3,W0,W1,PW) do{ MF; sacc+=A0; sacc+=A1; sacc+=A2; sacc+=A3; PIN(sacc); W0; W1; PIN(PW); SBAR(); }while(0)
  #define EX(v) __builtin_amdgcn_exp2f(v)
  #define GAPB(MF,X,B,MW) do{ MF; X[B]=EX(X[B]); X[B+1]=EX(X[B+1]); X[B+2]=EX(X[B+2]); X[B+3]=EX(X[B+3]); MAND(X,B,MW); MAND(X,B+1,MW); MAND(X,B+2,MW); MAND(X,B+3,MW); PIN(X); SBAR(); }while(0)
  #define GAPB2(MF,X,B) do{ MF; X[B]=EX(X[B]); X[B+1]=EX(X[B+1]); PIN(X); SBAR(); }while(0)
  #define VRD(i) do{ vlo[i]=vtr(vp_+(((i)>>2)*4096+((i)&3)*1024)); vhi[i]=vtr(vp_+(((i)>>2)*4096+((i)&3)*1024+512)); }while(0)
  #define KRD(G,j) do{ if(G){ kload2(kf,kp0+sl_next,j); SBAR(); } }while(0)
  #define STEP(C0,C1,P0,P1,t,GK,GV,GL,GM) do{ SBAR(); \
    const lds_cptr vp_=vp0+VS(sl_prev); \
    if(MASKED){ MKRD(t); BIAS(C0,C1,negm); SBAR(); } \
    VRD(0); SBAR(); float sacc=(P0[0]+P0[1]); \
    GAPA(C0=__builtin_amdgcn_mfma_f32_32x32x16_bf16(kf[0],qr[0],(MASKED?C0:negm),0,0,0), P0[2],P0[3],P0[4],P0[5],     pw0[0]=PKW(P0,0), pw0[1]=PKW(P0,2), pw0); \
    VRD(4); SBAR(); GAPA(C1=__builtin_amdgcn_mfma_f32_32x32x16_bf16(kf[1],qr[0],(MASKED?C1:negm),0,0,0), P0[6],P0[7],P0[8],P0[9],     pw0[2]=PKW(P0,4), pw0[3]=PKW(P0,6), pw0); \
    VRD(1); SBAR(); GAPA(C0=__builtin_amdgcn_mfma_f32_32x32x16_bf16(kf[2],qr[1],C0,0,0,0),   P0[10],P0[11],P0[12],P0[13], pw1[0]=PKW(P0,8), pw1[1]=PKW(P0,10), pw1); \
    VRD(5); SBAR(); GAPA(C1=__builtin_amdgcn_mfma_f32_32x32x16_bf16(kf[3],qr[1],C1,0,0,0),   P0[14],P0[15],P1[0],P1[1],   pw1[2]=PKW(P0,12),pw1[3]=PKW(P0,14), pw1); \
    VRD(2); SBAR(); GAPA(C0=__builtin_amdgcn_mfma_f32_32x32x16_bf16(kf[4],qr[2],C0,0,0,0),   P1[2],P1[3],P1[4],P1[5],     pw2[0]=PKW(P1,0), pw2[1]=PKW(P1,2), pw2); \
    VRD(6); SBAR(); GAPA(C1=__builtin_amdgcn_mfma_f32_32x32x16_bf16(kf[5],qr[2],C1,0,0,0),   P1[6],P1[7],P1[8],P1[9],     pw2[2]=PKW(P1,4), pw2[3]=PKW(P1,6), pw2); \
    VRD(3); SBAR(); GAPA(C0=__builtin_amdgcn_mfma_f32_32x32x16_bf16(kf[6],qr[3],C0,0,0,0),   P1[10],P1[11],P1[12],P1[13], pw3[0]=PKW(P1,8), pw3[1]=PKW(P1,10), pw3); \
    VRD(7); SBAR(); GAPA(C1=__builtin_amdgcn_mfma_f32_32x32x16_bf16(kf[7],qr[3],C1,0,0,0),   P1[14],P1[15],0.f,0.f,       pw3[2]=PKW(P1,12),pw3[3]=PKW(P1,14), pw3); \
    l_reg+=sacc; \
    if(GK){DMA_K((t)+3,sl_cur);} if(GV){DMA_V((t)+1,sl_next);} if(MASKED&&GM){ if((((t)&3)==0)&&((t)+4<NT)){DMA_M4((t)+4);} } \
    CMASK(C0,C1,t); \
    if constexpr(!NOMAX){ float a=MX3(C0[0],C0[1],C1[0]),b=MX3(C0[2],C0[3],C1[1]); a=MX3(a,C1[2],C1[3]); \
      _Pragma("unroll") for(int r=4;r<16;r+=4){a=MX3(a,C0[r],C0[r+1]);b=MX3(b,C0[r+2],C0[r+3]);a=MX3(a,C1[r],C1[r+1]);b=MX3(b,C1[r+2],C1[r+3]);} \
      float rm=__builtin_fmaxf(a,b); { auto rr=__builtin_amdgcn_permlane32_swap(__float_as_uint(rm),__float_as_uint(rm),false,false); rm=__builtin_fmaxf(__uint_as_float(rr[0]),__uint_as_float(rr[1])); } \
      resc=false; \
      if(__builtin_expect(__any(rm>(float)THRL),0)){ const float dl=__builtin_fmaxf(rm,0.f); mhat+=dl; \
        _Pragma("unroll") for(int r=0;r<16;++r){C0[r]-=dl;C1[r]-=dl;} \
        _Pragma("unroll") for(int r=0;r<16;++r)negm[r]=-mhat; asm volatile("":"+v"(negm)); \
        const float f=__builtin_amdgcn_exp2f(-dl); l_reg*=f; if(hi==0)wsf[r32]=f; resc=true; } } \
    SBAR(); \
    GAPB(o[0]=__builtin_amdgcn_mfma_f32_32x32x16_bf16(PAF(0),VFR(0),o[0],0,0,0), C0,0,mw0); \
    GAPB(o[1]=__builtin_amdgcn_mfma_f32_32x32x16_bf16(PAF(0),VFR(4),o[1],0,0,0), C0,4,mw0); \
    KRD(GL,0); GAPB(o[0]=__builtin_amdgcn_mfma_f32_32x32x16_bf16(PAF(1),VFR(1),o[0],0,0,0), C0,8,mw0); \
    KRD(GL,1); GAPB(o[1]=__builtin_amdgcn_mfma_f32_32x32x16_bf16(PAF(1),VFR(5),o[1],0,0,0), C0,12,mw0); \
    KRD(GL,2); GAPB(o[0]=__builtin_amdgcn_mfma_f32_32x32x16_bf16(PAF(2),VFR(2),o[0],0,0,0), C1,0,mw1); \
    KRD(GL,3); GAPB(o[1]=__builtin_amdgcn_mfma_f32_32x32x16_bf16(PAF(2),VFR(6),o[1],0,0,0), C1,4,mw1); \
    GAPB(o[0]=__builtin_amdgcn_mfma_f32_32x32x16_bf16(PAF(3),VFR(3),o[0],0,0,0), C1,8,mw1); \
    GAPB(o[1]=__builtin_amdgcn_mfma_f32_32x32x16_bf16(PAF(3),VFR(7),o[1],0,0,0), C1,12,mw1); \
    }while(0)
  #define VLD(n,f) do{ vlo[(n)&3]=vtr(vp_+(((f)>>2)*4096+((f)&3)*1024)); vhi[(n)&3]=vtr(vp_+(((f)>>2)*4096+((f)&3)*1024+512)); }while(0)
  #define VFW(n) (bf16x8){vlo[(n)&3][0],vlo[(n)&3][1],vlo[(n)&3][2],vlo[(n)&3][3],vhi[(n)&3][0],vhi[(n)&3][1],vhi[(n)&3][2],vhi[(n)&3][3]}
  #define PVN(OD,k,n,fnext) do{ OD=__builtin_amdgcn_mfma_f32_32x32x16_bf16(PAF(k),VFW(n),OD,0,0,0); SBAR(); if((fnext)>=0){ VLD(n,fnext); SBAR(); } }while(0)
  #define STEPW(C0,C1,P0,P1,t,GK,GV,GL) do{ SBAR(); \
    const lds_cptr vp_=vp0+VS(sl_prev); \
    VLD(0,0); SBAR(); float sacc=(P0[0]+P0[1]); f32x16 ci_=f32x16{}; if constexpr(!NOMAX){ const float nm_=-mhat; _Pragma("unroll") for(int r=0;r<16;++r)ci_[r]=nm_; }     \
    GAPA(C0=__builtin_amdgcn_mfma_f32_32x32x16_bf16(kf[0],qr[0],ci_,0,0,0), P0[2],P0[3],P0[4],P0[5],     pw0[0]=PKW(P0,0), pw0[1]=PKW(P0,2), pw0); \
    VLD(1,4); SBAR(); GAPA(C1=__builtin_amdgcn_mfma_f32_32x32x16_bf16(kf[1],qr[0],ci_,0,0,0), P0[6],P0[7],P0[8],P0[9],     pw0[2]=PKW(P0,4), pw0[3]=PKW(P0,6), pw0); \
    VLD(2,1); SBAR(); GAPA(C0=__builtin_amdgcn_mfma_f32_32x32x16_bf16(kf[2],qr[1],C0,0,0,0),   P0[10],P0[11],P0[12],P0[13], pw1[0]=PKW(P0,8), pw1[1]=PKW(P0,10), pw1); \
    VLD(3,5); SBAR(); GAPA(C1=__builtin_amdgcn_mfma_f32_32x32x16_bf16(kf[3],qr[1],C1,0,0,0),   P0[14],P0[15],P1[0],P1[1],   pw1[2]=PKW(P0,12),pw1[3]=PKW(P0,14), pw1); \
    GAPA(C0=__builtin_amdgcn_mfma_f32_32x32x16_bf16(kf[4],qr[2],C0,0,0,0),   P1[2],P1[3],P1[4],P1[5],     pw2[0]=PKW(P1,0), pw2[1]=PKW(P1,2), pw2); \
    GAPA(C1=__builtin_amdgcn_mfma_f32_32x32x16_bf16(kf[5],qr[2],C1,0,0,0),   P1[6],P1[7],P1[8],P1[9],     pw2[2]=PKW(P1,4), pw2[3]=PKW(P1,6), pw2); \
    GAPA(C0=__builtin_amdgcn_mfma_f32_32x32x16_bf16(kf[6],qr[3],C0,0,0,0),   P1[10],P1[11],P1[12],P1[13], pw3[0]=PKW(P1,8), pw3[1]=PKW(P1,10), pw3); \
    GAPA(C1=__builtin_amdgcn_mfma_f32_32x32x16_bf16(kf[7],qr[3],C1,0,0,0),   P1[14],P1[15],0.f,0.f,       pw3[2]=PKW(P1,12),pw3[3]=PKW(P1,14), pw3); \
    l_reg+=sacc; \
    if(GK){DMA_K((t)+3,sl_cur);} if(GV){DMA_V((t)+1,sl_next);} \
    CMASK(C0,C1,t); \
    if constexpr(!NOMAX){ float a=MX3(C0[0],C0[1],C1[0]),b=MX3(C0[2],C0[3],C1[1]); a=MX3(a,C1[2],C1[3]); \
      _Pragma("unroll") for(int r=4;r<16;r+=4){a=MX3(a,C0[r],C0[r+1]);b=MX3(b,C0[r+2],C0[r+3]);a=MX3(a,C1[r],C1[r+1]);b=MX3(b,C1[r+2],C1[r+3]);} \
      float rm=__builtin_fmaxf(a,b); { auto rr=__builtin_amdgcn_permlane32_swap(__float_as_uint(rm),__float_as_uint(rm),false,false); rm=__builtin_fmaxf(__uint_as_float(rr[0]),__uint_as_float(rr[1])); } \
      resc=false; \
      if(__builtin_expect(__any(rm>(float)THRL),0)){ const float dl=__builtin_fmaxf(rm,0.f); mhat+=dl; \
        _Pragma("unroll") for(int r=0;r<16;++r){C0[r]-=dl;C1[r]-=dl;} \
        const float f=__builtin_amdgcn_exp2f(-dl); l_reg*=f; if(hi==0)wsf[r32]=f; resc=true; } } \
    SBAR(); \
    GAPB2(o[0]=__builtin_amdgcn_mfma_f32_32x32x16_bf16(PAF(0),VFW(0),o[0],0,0,0), C0,0); VLD(0,2); SBAR(); \
    GAPB2(o[1]=__builtin_amdgcn_mfma_f32_32x32x16_bf16(PAF(0),VFW(1),o[1],0,0,0), C0,2); VLD(1,6); SBAR(); \
    KRD(GL,0); GAPB2(o[0]=__builtin_amdgcn_mfma_f32_32x32x16_bf16(PAF(1),VFW(2),o[0],0,0,0), C0,4); VLD(2,3); SBAR(); \
    KRD(GL,1); GAPB2(o[1]=__builtin_amdgcn_mfma_f32_32x32x16_bf16(PAF(1),VFW(3),o[1],0,0,0), C0,6); VLD(3,7); SBAR(); \
    KRD(GL,2); GAPB2(o[0]=__builtin_amdgcn_mfma_f32_32x32x16_bf16(PAF(2),VFW(4),o[0],0,0,0), C0,8); VLD(4,8); SBAR(); \
    KRD(GL,3); GAPB2(o[1]=__builtin_amdgcn_mfma_f32_32x32x16_bf16(PAF(2),VFW(5),o[1],0,0,0), C0,10); VLD(5,12); SBAR(); \
    GAPB2(o[0]=__builtin_amdgcn_mfma_f32_32x32x16_bf16(PAF(3),VFW(6),o[0],0,0,0), C0,12); VLD(6,9); SBAR(); \
    GAPB2(o[1]=__builtin_amdgcn_mfma_f32_32x32x16_bf16(PAF(3),VFW(7),o[1],0,0,0), C0,14); VLD(7,13); SBAR(); \
    GAPB2(o[2]=__builtin_amdgcn_mfma_f32_32x32x16_bf16(PAF(0),VFW(8),o[2],0,0,0), C1,0); VLD(8,10); SBAR(); \
    GAPB2(o[3]=__builtin_amdgcn_mfma_f32_32x32x16_bf16(PAF(0),VFW(9),o[3],0,0,0), C1,2); VLD(9,14); SBAR(); \
    GAPB2(o[2]=__builtin_amdgcn_mfma_f32_32x32x16_bf16(PAF(1),VFW(10),o[2],0,0,0), C1,4); VLD(10,11); SBAR(); \
    GAPB2(o[3]=__builtin_amdgcn_mfma_f32_32x32x16_bf16(PAF(1),VFW(11),o[3],0,0,0), C1,6); VLD(11,15); SBAR(); \
    GAPB2(o[2]=__builtin_amdgcn_mfma_f32_32x32x16_bf16(PAF(2),VFW(12),o[2],0,0,0), C1,8); \
    GAPB2(o[3]=__builtin_amdgcn_mfma_f32_32x32x16_bf16(PAF(2),VFW(13),o[3],0,0,0), C1,10); \
    GAPB2(o[2]=__builtin_amdgcn_mfma_f32_32x32x16_bf16(PAF(3),VFW(14),o[2],0,0,0), C1,12); \
    GAPB2(o[3]=__builtin_amdgcn_mfma_f32_32x32x16_bf16(PAF(3),VFW(15),o[3],0,0,0), C1,14); \
    }while(0)
  #define STEPX(C0,C1,P0,P1,t,GK,GV,GL,GM) do{ if constexpr(WIDE){ STEPW(C0,C1,P0,P1,t,GK,GV,GL); } else { STEP(C0,C1,P0,P1,t,GK,GV,GL,GM); } }while(0)
  int t=1;
  #undef CMASK
  #define CMASK(P0,P1,t) do{}while(0)
  for(;t+5<NT;t+=2){
    STEPX(pB0,pB1,pA0,pA1,t,true,true,true,true);     if(WIDE){WAIT_BAR(3);}else{WAIT_BAR(2);} RESC(); ROT();
    STEPX(pA0,pA1,pB0,pB1,t+1,true,true,true,true);   if(WIDE||(MASKED&&(((t+1)&3)==0))){WAIT_BAR(3);}else{WAIT_BAR(2);} RESC(); ROT();
  }
  #undef CMASK
  #define CMASK(P0,P1,t) do{int jb_=(t)-(NT-4); if(jb_>=0)cmask(P0,P1,jb_,qrel,hi);}while(0)
  #define ENDW(tt) do{ if(WIDE){ if((tt)+3<NT){WAIT_BAR(3);} else if((tt)+2<NT){WAIT_BAR(2);} else {WAIT_BAR(0);} } else { if((tt)+3<NT){WAIT_BAR(2);} else if((tt)+2<NT){WAIT_BAR(1);} else {WAIT_BAR(0);} } }while(0)
  for(;t+1<NT;t+=2){
    STEPX(pB0,pB1,pA0,pA1,t,(t+3<NT),(t+1<NT),(t+1<NT),(t+2<NT));       ENDW(t);   RESC(); ROT();
    STEPX(pA0,pA1,pB0,pB1,t+1,(t+4<NT),(t+2<NT),(t+2<NT),(t+3<NT));     ENDW(t+1); RESC(); ROT();
  }
  STEPX(pB0,pB1,pA0,pA1,NT-1,false,false,false,false); RESC();
  { float sacc=pB0[0]+pB0[1]; _Pragma("unroll") for(int r=2;r<16;++r)sacc+=pB0[r]; _Pragma("unroll") for(int r=0;r<16;++r)sacc+=pB1[r]; l_reg+=sacc;
    pw0=(u32x4){PKW(pB0,0),PKW(pB0,2),PKW(pB0,4),PKW(pB0,6)};pw1=(u32x4){PKW(pB0,8),PKW(pB0,10),PKW(pB0,12),PKW(pB0,14)};pw2=(u32x4){PKW(pB1,0),PKW(pB1,2),PKW(pB1,4),PKW(pB1,6)};pw3=(u32x4){PKW(pB1,8),PKW(pB1,10),PKW(pB1,12),PKW(pB1,14)};
    SBAR(); pv(o,vb0+VS(sl_cur),PAF(0),PAF(1),PAF(2),PAF(3)); if(WIDE){ pv(o+2,vb0+VS(sl_cur)+8192,PAF(0),PAF(1),PAF(2),PAF(3)); } }
  #undef PKW
  #undef PAF
  #undef VFR
  #undef PIN
  #undef MX3
  #undef GAPA
  #undef GAPB
  #undef GAPB2
  #undef EX
  #undef VRD
  #undef KRD
  #undef VLD
  #undef VFW
  #undef PVN
  #undef STEPW
  #undef STEPX
  #undef STEP
  #undef ENDW
  {auto rr=__builtin_amdgcn_permlane32_swap(__float_as_uint(l_reg),__float_as_uint(l_reg),false,false);l_reg=__uint_as_float(rr[0])+__uint_as_float(rr[1]);}
  if constexpr(NOMAX){ if(!(l_reg>7.9e-31f&&l_reg<1.2e30f))*(__attribute__((address_space(3))) unsigned*)((__attribute__((address_space(3))) char*)shm+badoff)=1u; }
  if(hi==0)wsf[32+r32]=l_reg;asm volatile("s_waitcnt lgkmcnt(0)":::"memory");
  float rli[16];
  #pragma unroll
  for(int r=0;r<16;++r)rli[r]=__builtin_amdgcn_rcpf(wsf[32+crow(r,hi)]);
  bf16*Ow=O+(rowbase+q0+wid*QBLK)*DM+hv*D;
  #pragma unroll
  for(int hf=0;hf<(WIDE?2:1);++hf){ bf16*stg=(bf16*)(shm+L_OST)+wid*2048;
    #pragma unroll
    for(int r=0;r<16;++r){const int orow=crow(r,hi);
      #pragma unroll
      for(int d0=0;d0<2;++d0)stg[orow*64+d0*32+r32]=__float2bfloat16(o[2*hf+d0][r]*rli[r]);}
    asm volatile("s_waitcnt lgkmcnt(0)":::"memory");
    #pragma unroll
    for(int i=0;i<4;++i){const int row=i*8+(lane>>3),ch=lane&7; const u32x4 v=*(const u32x4*)(stg+row*64+ch*8); ATTN_STORE16(Ow+(long)row*DM+hf*64+ch*8,v);}
    asm volatile("s_waitcnt lgkmcnt(0)":::"memory"); }
  asm volatile("s_waitcnt lgkmcnt(0)\n\ts_barrier":::"memory");
  #undef DMA_K
  #undef DMA_V
  #undef DMA_M4
  #undef MKRD
  #undef MAND
  #undef TABRD
  #undef BIAS
  #undef CMASK
  #undef START
  #undef RESC
  #undef ROT
  #undef VS
}
constexpr int ATTN_LDS_BYTES=LDS_BYTES+NW*1024+4096;
__device__ __forceinline__ void mask_table_init(char*shm,int tid){
  if(tid<256){ u32x4 v; unsigned e[8];
    #pragma unroll
    for(int j=0;j<8;++j) e[j]=((tid>>j)&1)?0u:0xC400u;
    v.x=e[0]|(e[1]<<16); v.y=e[2]|(e[3]<<16); v.z=e[4]|(e[5]<<16); v.w=e[6]|(e[7]<<16);
    *(u32x4*)(shm+LDS_MK+NW*2048+tid*16)=v; }
  __syncthreads();
}
#undef SBAR
#undef WAIT_BAR
}

constexpr int NWAVES = 8;
#ifndef MK_PER_PHASE
#define MK_PER_PHASE 0
#endif

#ifndef CHK
#define CHK 0
#endif
constexpr int CW_CHK = 2;
constexpr int BATCH = 2, SEQ = 16384, NTOK = BATCH * SEQ, DMODEL = 1024, DEPTH = 2;
constexpr int WIN_OLD = 5704, WIN_NEW = 5888, P1_N = 3840;
constexpr float LN_EPS = 1e-5f, ALPHA = 1.41421356237f;
constexpr int NPH_LAYER = 12, NPHASE = DEPTH * NPH_LAYER;

constexpr size_t MiB = 1u << 20;
constexpr size_t WS_CTL = 0, CTL_ZERO_BYTES = 1 * MiB;
constexpr size_t WS_SMALL = 1 * MiB, SM_LAM = 0, SM_WR = 4096, SM_BR = SM_WR + 2 * 36 * 1024 * 4;
constexpr size_t WS_ROPE = 2 * MiB;
constexpr size_t WS_ROUTE = 4 * MiB, RT_E = 0, RT_C = 256 * 1024, RT_HIST = 512 * 1024, RT_TOT = 544 * 1024, RT_ROW = 576 * 1024, RT_ENT = 864 * 1024, RT_CW = 1152 * 1024;
constexpr int LIST_CAP = 65536 + 32 * 256;
constexpr size_t WS_WB = 6 * MiB;
constexpr size_t WB_WIN = 0, WB_WBD = (size_t)WIN_NEW * 1024 * 2, WB_WBS = WB_WBD + MiB, WB_WO = WB_WBS + MiB, WB_WPG = WB_WO + 2 * MiB, WB_WPLE = WB_WPG + 2 * MiB,
                 WB_WGU = WB_WPLE + MiB / 2, WB_WD = WB_WGU + 32 * MiB, WB_END = WB_WD + 16 * MiB;
static_assert(WB_END == 66 * MiB, "weight copies");
constexpr size_t WB_WG8 = WB_WIN + (size_t)3840 * 1024 * 2;
constexpr size_t WS_XB = 72 * MiB;
constexpr size_t WS_DQ = 136 * MiB, TSTRIDE = 32 * MiB, WS_IK = 360 * MiB, WS_IW = 364 * MiB;
constexpr size_t WS_O0 = 365 * MiB, WS_O1 = 397 * MiB, WS_YB = 429 * MiB, WS_MASK = 461 * MiB;
constexpr long MASK_BSTRIDE = 2105344;
constexpr size_t WS_YA = 136 * MiB, WS_MERGED = 168 * MiB, WS_TMPG = 240 * MiB, WS_PRE1 = 240 * MiB;
constexpr size_t OUT_XB8 = 0, OUT_X1B8 = 32 * MiB, OUT_T1 = 64 * MiB;
constexpr size_t WS_HG = 136 * MiB, WS_PLE = 172 * MiB, WS_Y0 = 368 * MiB, WS_Y1 = 432 * MiB, WS_PB = 496 * MiB, WS_END = 512 * MiB;
static_assert(WS_MASK + 2 * MASK_BSTRIDE * 8 <= WS_PB, "mask fits");
constexpr int CW_TMO = 0, CW_CODE = 1, CW_BAR = 4096, CW_QUEUE = 8192;

constexpr int RING_OFF = 0, RING_BYTES = 131072;
constexpr int XTR_OFF = RING_BYTES, XTR_BYTES = 4096;
constexpr int MISC_OFF = XTR_OFF + XTR_BYTES;
constexpr int LDS_BYTES = 147456;
static_assert(MISC_OFF + 128 <= LDS_BYTES, "LDS map");
#define GAS __attribute__((address_space(1)))
#define LAS __attribute__((address_space(3)))
typedef unsigned short bf16;
typedef unsigned v4u __attribute__((ext_vector_type(4)));
typedef float f32x4 __attribute__((ext_vector_type(4)));
typedef short bf16x8 __attribute__((ext_vector_type(8)));
typedef GAS unsigned gu32;
typedef GAS unsigned long long gu64;
#define RLX_AGENT __ATOMIC_RELAXED, __HIP_MEMORY_SCOPE_AGENT
#define LDS_WAIT() asm volatile("s_waitcnt lgkmcnt(0)" ::: "memory")
#define VM_WAIT() asm volatile("s_waitcnt vmcnt(0)" ::: "memory")
__device__ __forceinline__ unsigned long long rt() { return __builtin_amdgcn_s_memrealtime(); }
__device__ __forceinline__ unsigned f2bf(float f) { unsigned u = __builtin_bit_cast(unsigned, f); return (u + 0x7fffu + ((u >> 16) & 1u)) >> 16; }
__device__ __forceinline__ unsigned pk2(float lo, float hi) { return f2bf(lo) | (f2bf(hi) << 16); }

#define XB_TMO      128
#define XB_XCNT(j)  (256  + 64 * (j))
#define XB_XSUB(j)  (1280 + 64 * (j))
#define XB_XGEN(j)  (2304 + 64 * (j))
#define XB_TOP      3328
#define XB_TOPGEN   3392
#define XCD_BAR_WORDS 3456
#define XB_SPIN_CAP (1u << 18)

__device__ __forceinline__ unsigned xb_ld(unsigned* p)              { return __hip_atomic_load(p, __ATOMIC_RELAXED, __HIP_MEMORY_SCOPE_AGENT); }
__device__ __forceinline__ unsigned xb_add(unsigned* p, unsigned v) { return __hip_atomic_fetch_add(p, v, __ATOMIC_RELAXED, __HIP_MEMORY_SCOPE_AGENT); }
__device__ __forceinline__ unsigned xb_xcc_id() { return (unsigned)__builtin_amdgcn_s_getreg((3 << 11) | 20) & 0xFu; }
#define XB_SPIN(cond, bar) do { unsigned _sp = 0; while (cond) { __builtin_amdgcn_s_sleep(1); \
    if ((++_sp & 255u) == 0u) { if (xb_ld(&(bar)[XB_TMO])) break; if (_sp > XB_SPIN_CAP) { atomicAdd(&(bar)[XB_TMO], 1u); break; } } } } while (0)

struct XcdBarrier {
    unsigned* bar; unsigned x;
    volatile LAS unsigned* st;
};

__device__ __forceinline__ XcdBarrier xcd_barrier_post(unsigned* bar, volatile LAS unsigned* st) {
    XcdBarrier b; b.bar = bar; b.x = xb_xcc_id(); b.st = st;
    if (threadIdx.x == 0) (void)xb_add(&bar[XB_XCNT(b.x)], 1u);
    return b;
}
__device__ __forceinline__ void xcd_barrier_complete(unsigned* bar, unsigned x, unsigned& nloc, unsigned& nx) {
    const unsigned G = gridDim.x * gridDim.y * gridDim.z;
    unsigned sum, cnt, mine, sp = 0u;
    for (;;) {
        sum = 0u; cnt = 0u; mine = 0u;
#pragma unroll
        for (unsigned j = 0; j < 16; ++j) { const unsigned c = xb_ld(&bar[XB_XCNT(j)]); sum += c; cnt += (c > 0u) ? 1u : 0u; mine = (j == x) ? c : mine; }
        if (sum == G) break;
        __builtin_amdgcn_s_sleep(1);
        if ((++sp & 255u) == 0u) { if (xb_ld(&bar[XB_TMO])) break; if (sp > XB_SPIN_CAP) { atomicAdd(&bar[XB_TMO], 1u); break; } }
    }
    nloc = mine > 0u ? mine : 1u; nx = cnt > 0u ? cnt : 1u;
}

__device__ __forceinline__ void xcd_barrier(const XcdBarrier& b) {
    asm volatile("s_waitcnt vmcnt(0)" ::: "memory");
    __syncthreads();
    if (threadIdx.x == 0) {
        unsigned* bar = b.bar;
        __builtin_amdgcn_s_waitcnt(0);
        unsigned nloc = b.st[0], nx = b.st[1];
        if (nloc == 0u) { xcd_barrier_complete(bar, b.x, nloc, nx); b.st[0] = nloc; b.st[1] = nx; }
        const unsigned old = xb_add(&bar[XB_XSUB(b.x)], 1u);
        const unsigned gen = old / nloc;
        if (old + 1u == (gen + 1u) * nloc) {
            __builtin_amdgcn_fence(__ATOMIC_RELEASE, "agent");
            asm volatile("s_waitcnt vmcnt(0)" ::: "memory");
            const unsigned og = xb_add(&bar[XB_TOP], 1u);
            const unsigned tg = og / nx;
            if (og + 1u == (tg + 1u) * nx) xb_add(&bar[XB_TOPGEN], 1u);
            else XB_SPIN(xb_ld(&bar[XB_TOPGEN]) == tg, bar);
            __builtin_amdgcn_fence(__ATOMIC_ACQUIRE, "agent");
            xb_add(&bar[XB_XGEN(b.x)], 1u);
            asm volatile("s_waitcnt vmcnt(0)" ::: "memory");
        } else {
            XB_SPIN(xb_ld(&bar[XB_XGEN(b.x)]) == gen, bar);
            __builtin_amdgcn_fence(__ATOMIC_ACQUIRE, "agent");
            asm volatile("s_waitcnt vmcnt(0)" ::: "memory");
        }
    }
    __syncthreads();
}

#ifndef DBG
#define DBG 0
#endif
struct Args { const void* in[22]; float* out; unsigned char* ws; int ph_lo, ph_hi; };
struct Frame {
    LAS unsigned char* lds;
    volatile LAS unsigned* MISC;
    gu32* ctl;
    int tid, lane, wave;
    int vcu, G, bx;
    unsigned char* ws; unsigned char* ws0;
    float* out; float* out0;
    const Args* ap;
};
#define INP(k) (F.ap->in[(k)])
#define DPP_F(v, ctrl) __builtin_bit_cast(float, __builtin_amdgcn_update_dpp(0, __builtin_bit_cast(int, (v)), (ctrl), 0xf, 0xf, true))
__device__ __forceinline__ float row16_sum(float v) {
    v += DPP_F(v, 0xB1);
    v += DPP_F(v, 0x4E);
    v += DPP_F(v, 0x141);
    v += DPP_F(v, 0x140);
    return v;
}
__device__ __forceinline__ float wave_sum(float v) {
    v = row16_sum(v);
    { auto r = __builtin_amdgcn_permlane16_swap(__float_as_uint(v), __float_as_uint(v), false, false); v = __uint_as_float(r[0]) + __uint_as_float(r[1]); }
    { auto r = __builtin_amdgcn_permlane32_swap(__float_as_uint(v), __float_as_uint(v), false, false); v = __uint_as_float(r[0]) + __uint_as_float(r[1]); }
    return v;
}
typedef float f32x2 __attribute__((ext_vector_type(2)));

__device__ __forceinline__ void tr_item(const float* W, int ldn, int col0, int nvalid, bf16* WT, int K, int row0, LAS float* scr, int kb, int lane) {
    const int k0 = 64 * kb, n = lane & 31;
#pragma unroll 8
    for (int i = 0; i < 32; ++i) { const int kk = 2 * i + (lane >> 5); scr[kk * 33 + n] = (n < nvalid) ? W[(size_t)(k0 + kk) * ldn + col0 + n] : 0.f; }
    LDS_WAIT(); asm volatile("" ::: "memory");
    const int c = lane & 7;
#pragma unroll
    for (int j = 0; j < 4; ++j) { const int nn = (lane >> 3) + 8 * j; const LAS float* s = scr + (8 * c) * 33 + nn;
        v4u o; o.x = pk2(s[0 * 33], s[1 * 33]); o.y = pk2(s[2 * 33], s[3 * 33]); o.z = pk2(s[4 * 33], s[5 * 33]); o.w = pk2(s[6 * 33], s[7 * 33]);
        *(GAS v4u*)(WT + (size_t)(row0 + nn) * K + k0 + 8 * c) = o; }
    LDS_WAIT(); asm volatile("" ::: "memory");
}
__device__ __forceinline__ unsigned pk4_fp8(float a, float b, float c, float d) { int p = __builtin_amdgcn_cvt_pk_fp8_f32(a, b, 0, false); return (unsigned)__builtin_amdgcn_cvt_pk_fp8_f32(c, d, p, true); }
__device__ __forceinline__ void tr_item8(const float* W, int ldn, int col0, unsigned char* WT, int K, int row0, LAS float* scr, int kb, int lane) {
    const int k0 = 64 * kb, n = lane & 31;
#pragma unroll 8
    for (int i = 0; i < 32; ++i) { const int kk = 2 * i + (lane >> 5); scr[kk * 33 + n] = W[(size_t)(k0 + kk) * ldn + col0 + n] * 64.f; }
    LDS_WAIT(); asm volatile("" ::: "memory");
    const int c = lane & 7;
#pragma unroll
    for (int j = 0; j < 4; ++j) { const int nn = (lane >> 3) + 8 * j; const LAS float* s = scr + (8 * c) * 33 + nn;
        const unsigned long long o = (unsigned long long)pk4_fp8(s[0 * 33], s[1 * 33], s[2 * 33], s[3 * 33]) | ((unsigned long long)pk4_fp8(s[4 * 33], s[5 * 33], s[6 * 33], s[7 * 33]) << 32);
        *(GAS unsigned long long*)(WT + (size_t)(row0 + nn) * K + k0 + 8 * c) = o; }
    LDS_WAIT(); asm volatile("" ::: "memory");
}
__device__ __forceinline__ void pw_phase(Frame& F, int l) {
    LAS float* scr = (LAS float*)(F.lds + RING_OFF + F.wave * 16384);
    const int gw = F.vcu * NWAVES + F.wave, NGW = F.G * NWAVES, lane = F.lane;
    unsigned char* wb = F.ws + WS_WB;
    bf16* WIN = (bf16*)(wb + WB_WIN);
    const float* w_in = (const float*)INP(3) + (size_t)l * 1024 * WIN_OLD;
    constexpr int I_A = 16 * 114, I_B = 16, I_C = 16 * 64, I_BD = 8 * 32, I_O = 16 * 32, I_PLE = 4 * 32, I_GU = 32 * 4 * 64, I_D = 32 * 128;
    constexpr int NITEMS = I_A + I_B + I_C + 2 * I_BD + 2 * I_O + I_PLE + I_GU + I_D;
    for (int it = gw; it < NITEMS; it += NGW) {
        int r = it;
        if (r < I_A) { const int kb = r / 114, nb = r % 114; tr_item(w_in, WIN_OLD, 32 * nb, 32, WIN, 1024, 32 * nb, scr, kb, lane); continue; } r -= I_A;
        if (r < I_B) { tr_item(w_in, WIN_OLD, 3648, 8, WIN, 1024, 3648, scr, r, lane); continue; } r -= I_B;
        if (r < I_C) { const int kb = r / 64, nb = r % 64; tr_item8(w_in, WIN_OLD, 3656 + 32 * nb, wb + WB_WG8, 1024, 32 * nb, scr, kb, lane); continue; } r -= I_C;
        if (r < I_BD) { tr_item((const float*)INP(6) + (size_t)l * 512 * 1024, 1024, 32 * (r % 32), 32, (bf16*)(wb + WB_WBD), 512, 32 * (r % 32), scr, r / 32, lane); continue; } r -= I_BD;
        if (r < I_BD) { tr_item((const float*)INP(7) + (size_t)l * 512 * 1024, 1024, 32 * (r % 32), 32, (bf16*)(wb + WB_WBS), 512, 32 * (r % 32), scr, r / 32, lane); continue; } r -= I_BD;
        if (r < I_O) { tr_item((const float*)INP(8) + (size_t)l * 1024 * 1024, 1024, 32 * (r % 32), 32, (bf16*)(wb + WB_WO), 1024, 32 * (r % 32), scr, r / 32, lane); continue; } r -= I_O;
        if (r < I_O) { tr_item8((const float*)INP(19) + (size_t)l * 1024 * 1024, 1024, 32 * (r % 32), wb + WB_WPG, 1024, 32 * (r % 32), scr, r / 32, lane); continue; } r -= I_O;
        if (r < I_PLE) { tr_item((const float*)INP(18) + (size_t)l * 256 * 1024, 1024, 32 * (r % 32), 32, (bf16*)(wb + WB_WPLE), 256, 32 * (r % 32), scr, r / 32, lane); continue; } r -= I_PLE;
        if (r < I_GU) { const int e = r >> 8, sub = (r >> 6) & 3, q = r & 63, kb = q >> 2, nb = q & 3;
            const float* W = ((sub & 1) ? (const float*)INP(16) : (const float*)INP(15)) + (size_t)(l * 32 + e) * 1024 * 256;
            tr_item8(W, 256, (sub >> 1) * 128 + 32 * nb, wb + WB_WGU, 1024, e * 512 + sub * 128 + 32 * nb, scr, kb, lane); continue; } r -= I_GU;
        { const int e = r >> 7, q = r & 127, kb = q >> 5, nb = q & 31;
            tr_item((const float*)INP(17) + (size_t)(l * 32 + e) * 256 * 1024, 1024, 32 * nb, 32, (bf16*)(wb + WB_WD), 256, e * 1024 + 32 * nb, scr, kb, lane); }
    }
    { unsigned z_ = 0u; asm volatile("" : "+v"(z_));
      for (int ch = F.vcu * 512 + F.tid; ch < 160 * 128; ch += F.G * 512) *(GAS v4u*)(WIN + (size_t)3680 * 1024 + (size_t)ch * 8) = (v4u){z_, z_, z_, z_}; }
    const float* p = (const float*)INP(1) + (size_t)l * NTOK * 256; bf16* PB = (bf16*)(F.ws + WS_PB);
    for (int m0 = gw; m0 < NTOK; m0 += 4 * NGW) { f32x4 v[4];
#pragma unroll
        for (int j = 0; j < 4; ++j) { const int m = min(m0 + j * NGW, NTOK - 1); v[j] = *((const GAS f32x4*)(p + (size_t)m * 256) + lane); }
#pragma unroll
        for (int j = 0; j < 4; ++j) { const int m = m0 + j * NGW; if (m < NTOK) *((GAS unsigned long long*)(PB + (size_t)m * 256) + lane) = (unsigned long long)pk2(v[j].x, v[j].y) | ((unsigned long long)pk2(v[j].z, v[j].w) << 32); } }
    if (l == 0) {
        const float* x = (const float*)INP(0); bf16* XB = (bf16*)(F.ws + WS_XB);
        for (int m0 = gw; m0 < NTOK; m0 += 2 * NGW) { f32x4 v[2][4];
#pragma unroll
            for (int r = 0; r < 2; ++r) { const int m = min(m0 + r * NGW, NTOK - 1); const GAS f32x4* xr = (const GAS f32x4*)(x + (size_t)m * 1024) + lane;
#pragma unroll
                for (int j = 0; j < 4; ++j) v[r][j] = xr[64 * j]; }
#pragma unroll
            for (int r = 0; r < 2; ++r) { const int m = m0 + r * NGW; if (m < NTOK) { GAS unsigned long long* o8 = (GAS unsigned long long*)(XB + (size_t)m * 1024) + lane;
#pragma unroll
                for (int j = 0; j < 4; ++j) { const f32x4 w = v[r][j]; o8[64 * j] = (unsigned long long)pk2(w.x, w.y) | ((unsigned long long)pk2(w.z, w.w) << 32);
                    ((GAS unsigned*)((unsigned char*)F.out + OUT_XB8 + (size_t)m * 1024) + lane)[64 * j] = pk4_fp8(w.x, w.y, w.z, w.w); } } }
        }
        const int* pos = (const int*)INP(2); float* rope = (float*)(F.ws + WS_ROPE);
        for (int idx = F.vcu * 512 + F.tid; idx < NTOK * 8; idx += F.G * 512) {
            const int m = idx >> 3, j = idx & 7; const float invf = exp2f(-2.366446071f * (float)j); const float ang = (float)pos[m] * invf;
            double rev = (double)ang * 0.15915494309189535; rev -= rint(rev);
            rope[m * 16 + j] = (DBG & 16) ? 1.f : __builtin_amdgcn_cosf((float)rev); rope[m * 16 + 8 + j] = (DBG & 16) ? 0.f : __builtin_amdgcn_sinf((float)rev);
        }
        float* WR = (float*)(F.ws + WS_SMALL + SM_WR); float* BR = (float*)(F.ws + WS_SMALL + SM_BR);
        for (int idx = F.vcu * 512 + F.tid; idx < 2 * 36 * 1024; idx += F.G * 512) {
            const int ll = idx / (36 * 1024), r = idx % (36 * 1024), j = r >> 10, k = r & 1023;
            WR[idx] = (j < 4) ? ((const float*)INP(11))[((size_t)ll * 1024 + k) * 4 + j] : ((const float*)INP(13))[((size_t)ll * 1024 + k) * 32 + (j - 4)];
        }
        if (F.vcu == 0 && F.tid < 72) { const int ll = F.tid / 36, j = F.tid % 36; BR[F.tid] = (j < 4) ? ((const float*)INP(12))[ll * 4 + j] : ((const float*)INP(14))[ll * 32 + j - 4]; }
        if (F.vcu == 0 && F.tid < 2) { const float* lp = (const float*)INP(4) + F.tid * 256; float a = 0.f, b = 0.f;
            for (int i = 0; i < 64; ++i) { a += lp[i] * lp[64 + i]; b += lp[128 + i] * lp[192 + i]; }
            const float lam_init = (F.tid == 0) ? 0.2f : 0.35550907f;
            ((float*)(F.ws + WS_SMALL + SM_LAM))[F.tid] = __expf(a) - __expf(b) + lam_init; }
    }
}

namespace idxr {
typedef float f32x16 __attribute__((ext_vector_type(16)));
typedef short s16x2 __attribute__((ext_vector_type(2)));
typedef __fp16 h16x2 __attribute__((ext_vector_type(2)));
constexpr int HROW = 513;
__device__ __forceinline__ unsigned f2key(float f) { const unsigned u = __float_as_uint(f); return u ^ ((unsigned)((int)u >> 31) | 0x80000000u); }
__device__ __forceinline__ unsigned bins2(float a, float b) {
    const unsigned h = __builtin_bit_cast(unsigned, __builtin_amdgcn_cvt_pkrtz(a, b));
    const unsigned m = __builtin_bit_cast(unsigned, (s16x2)(__builtin_bit_cast(s16x2, h) >> (s16x2){15, 15}));
    const unsigned key = h ^ (m | 0x80008000u);
    return (key >> 5) & 0x07fc07fcu;
}
__device__ __forceinline__ float f16bits(unsigned h) { return (float)__builtin_bit_cast(__fp16, (unsigned short)h); }
__device__ __forceinline__ float bin_edge(int b) {
    if (b <= 0) return -__builtin_inff();
    if (b >= 512) return __builtin_inff();
    const unsigned K = (unsigned)b << 7;
    if (K >= 0x8000u) { const unsigned H = K & 0x7fffu; return (H >= 0x7c00u) ? __builtin_inff() : f16bits(H); }
    const unsigned M1 = ((0xFFFFu ^ K) & 0x7fffu) + 1u;
    const float v = (M1 >= 0x7c00u) ? __builtin_inff() : f16bits(M1);
    return -__uint_as_float(__float_as_uint(v) - 1u);
}
__device__ __forceinline__ long moff(int tl) { return 16384L * tl - 32L * tl * (tl - 1); }
__device__ __forceinline__ void load_k2(bf16x8 (&ka)[2], bf16x8 (&kb)[2], const unsigned short* IKb, int key0, int kg0, int fr, int fq) {
#pragma unroll
    for (int ks = 0; ks < 2; ++ks) { ka[ks] = *(const bf16x8*)(IKb + (size_t)(key0 + 16 * kg0 + fr) * 64 + ks * 32 + fq * 8); kb[ks] = *(const bf16x8*)(IKb + (size_t)(key0 + 16 * kg0 + 16 + fr) * 64 + ks * 32 + fq * 8); }
}
__device__ __forceinline__ void score_half(f32x4& sa, f32x4& sb, const bf16x8 (&qf)[8][2], const bf16x8 (&ql)[2], const float (&w)[8], bf16x8 (&ka)[2], bf16x8 (&kb)[2]) {
    sa = __builtin_amdgcn_mfma_f32_16x16x32_bf16(ka[0], ql[0], (f32x4){0.f, 0.f, 0.f, 0.f}, 0, 0, 0); sb = __builtin_amdgcn_mfma_f32_16x16x32_bf16(kb[0], ql[0], (f32x4){0.f, 0.f, 0.f, 0.f}, 0, 0, 0);
    sa = __builtin_amdgcn_mfma_f32_16x16x32_bf16(ka[1], ql[1], sa, 0, 0, 0); sb = __builtin_amdgcn_mfma_f32_16x16x32_bf16(kb[1], ql[1], sb, 0, 0, 0);
    f32x4 Da[2], Db[2];
#define IDX_M(h, D) do { \
        D[0] = __builtin_amdgcn_mfma_f32_16x16x32_bf16(ka[0], qf[h][0], (f32x4){0.f, 0.f, 0.f, 0.f}, 0, 0, 0); D[1] = __builtin_amdgcn_mfma_f32_16x16x32_bf16(kb[0], qf[h][0], (f32x4){0.f, 0.f, 0.f, 0.f}, 0, 0, 0); \
        D[0] = __builtin_amdgcn_mfma_f32_16x16x32_bf16(ka[1], qf[h][1], D[0], 0, 0, 0); D[1] = __builtin_amdgcn_mfma_f32_16x16x32_bf16(kb[1], qf[h][1], D[1], 0, 0, 0); } while (0)
#define IDX_F(h, D, O) asm volatile("" : "+v"(O[0]), "+v"(O[1]));     \
        asm volatile( \
        "v_fma_f32 %0, %8, |%9|, %0\n\tv_fma_f32 %1, %8, |%10|, %1\n\tv_fma_f32 %2, %8, |%11|, %2\n\tv_fma_f32 %3, %8, |%12|, %3\n\t" \
        "v_fma_f32 %4, %8, |%13|, %4\n\tv_fma_f32 %5, %8, |%14|, %5\n\tv_fma_f32 %6, %8, |%15|, %6\n\tv_fma_f32 %7, %8, |%16|, %7" \
        : "+v"(sa[0]), "+v"(sa[1]), "+v"(sa[2]), "+v"(sa[3]), "+v"(sb[0]), "+v"(sb[1]), "+v"(sb[2]), "+v"(sb[3]) \
        : "v"(w[h]), "v"(D[0][0]), "v"(D[0][1]), "v"(D[0][2]), "v"(D[0][3]), "v"(D[1][0]), "v"(D[1][1]), "v"(D[1][2]), "v"(D[1][3])); \
        asm volatile("" : "+v"(ka[0]), "+v"(kb[0]))
    IDX_M(0, Da); IDX_M(1, Db);
    asm volatile("s_nop 7" : "+v"(Da[0]), "+v"(Da[1]), "+v"(Db[0]), "+v"(Db[1]), "+v"(sa), "+v"(sb));
#pragma unroll
    for (int h = 0; h < 6; h += 2) { IDX_F(h, Da, Db); IDX_M(h + 2, Da); IDX_F(h + 1, Db, Da); IDX_M(h + 3, Db); }
    IDX_F(6, Da, Db); asm volatile("s_nop 7" : "+v"(Db[0]), "+v"(Db[1])); IDX_F(7, Db, Da);
#undef IDX_M
#undef IDX_F
}
#define IDX_SCORE(sc, kf, key0, more) do { const int nk_ = (more) ? (key0) + 128 : (key0); \
        idxr::score_half(sc[0], sc[1], qf, ql, w, kf[0], kf[1]); idxr::load_k2(kf[0], kf[1], IKb, nk_, 0, fr, fq); \
        idxr::score_half(sc[2], sc[3], qf, ql, w, kf[2], kf[3]); idxr::load_k2(kf[2], kf[3], IKb, nk_, 2, fr, fq); } while (0)
}

__device__ __forceinline__ void indexer_unit(Frame& F, int b, int qblk, const bf16* IQ, const bf16* IK, const float* IW, unsigned long long* mask64  ) {
    using namespace idxr;
    const int lane = F.lane, fr = lane & 15, fq = lane >> 4, wid = F.wave, qgrp = wid & 3, kh = wid >> 2;
    const int qloc = 16 * qgrp + fr, q = 64 * qblk + qloc;
    const size_t row = (size_t)b * SEQ + q;
    LAS unsigned* hist = (LAS unsigned*)(F.lds + RING_OFF);
    LAS int* bstarA = (LAS int*)(F.lds + XTR_OFF + 1024); LAS int* needA = bstarA + 64; LAS float* thiA = (LAS float*)(needA + 64); LAS float* tloA = thiA + 64;
    LAS unsigned* cand = (LAS unsigned*)(F.lds + RING_OFF);
    LAS unsigned* wcnt = (LAS unsigned*)(F.lds + XTR_OFF + 2048);
    bf16x8 qf[8][2], ql[2]; float w[8];
#pragma unroll
    for (int h = 0; h < 8; ++h)
#pragma unroll
        for (int ks = 0; ks < 2; ++ks) qf[h][ks] = *(const bf16x8*)(IQ + row * 512 + h * 64 + ks * 32 + fq * 8);
    { const f32x4* wp = (const f32x4*)(IW + row * 8); const f32x4 w0 = wp[0], w1 = wp[1]; w[0] = 0.5f * w0.x; w[1] = 0.5f * w0.y; w[2] = 0.5f * w0.z; w[3] = 0.5f * w0.w; w[4] = 0.5f * w1.x; w[5] = 0.5f * w1.y; w[6] = 0.5f * w1.z; w[7] = 0.5f * w1.w; }
#pragma unroll
    for (int ks = 0; ks < 2; ++ks) {
        float acc8[8];
#pragma unroll
        for (int e = 0; e < 8; ++e) acc8[e] = 0.f;
#pragma unroll
        for (int h = 0; h < 8; ++h)
#pragma unroll
            for (int e = 0; e < 8; ++e) acc8[e] = __builtin_fmaf(w[h], __uint_as_float((unsigned)(unsigned short)qf[h][ks][e] << 16), acc8[e]);
#pragma unroll
        for (int e = 0; e < 8; e += 2) { const unsigned pk = pg8::cvt_pk_bf16(acc8[e], acc8[e + 1]); ql[ks][e] = (short)(pk & 0xffffu); ql[ks][e + 1] = (short)(pk >> 16); }
    }
    for (int i = F.tid; i < 64 * HROW; i += NWAVES * 64) hist[i] = 0u;
    __syncthreads();
    const unsigned short* IKb = IK + (size_t)b * SEQ * 64;
    const int qmin_w = 64 * qblk + 16 * qgrp;
    const unsigned hrowb = (unsigned)(size_t)(hist + qloc * HROW);
#define IDX_HADD(off_) __hip_atomic_fetch_add((LAS unsigned*)(hrowb + (off_)), 1u, __ATOMIC_RELAXED, __HIP_MEMORY_SCOPE_WORKGROUP)
    {
        bf16x8 kf[4][2];
        if (kh <= qblk) { load_k2(kf[0], kf[1], IKb, 64 * kh, 0, fr, fq); load_k2(kf[2], kf[3], IKb, 64 * kh, 2, fr, fq); }
#pragma unroll 1
        for (int tl = kh; tl <= qblk; tl += 2) {
            const int key0 = 64 * tl; f32x4 sc[4]; IDX_SCORE(sc, kf, key0, tl + 2 <= qblk);
            if (key0 + 63 <= qmin_w) {
#pragma unroll
                for (int kg = 0; kg < 4; ++kg) { const unsigned p0 = bins2(sc[kg][0], sc[kg][1]), p1 = bins2(sc[kg][2], sc[kg][3]);
                    IDX_HADD(p0 & 0xffffu); IDX_HADD(p0 >> 16); IDX_HADD(p1 & 0xffffu); IDX_HADD(p1 >> 16); __builtin_amdgcn_sched_barrier(0); }
            } else {
                int fq_ = fq, q_ = q; asm volatile("" : "+v"(fq_), "+v"(q_));
#pragma unroll
                for (int kg = 0; kg < 4; ++kg) { const unsigned p0 = bins2(sc[kg][0], sc[kg][1]), p1 = bins2(sc[kg][2], sc[kg][3]); const int kb = key0 + 16 * kg + 4 * fq_;
                    if (kb <= q_) IDX_HADD(p0 & 0xffffu); if (kb + 1 <= q_) IDX_HADD(p0 >> 16); if (kb + 2 <= q_) IDX_HADD(p1 & 0xffffu); if (kb + 3 <= q_) IDX_HADD(p1 >> 16); __builtin_amdgcn_sched_barrier(0); }
            }
        }
    }
#undef IDX_HADD
    __syncthreads();
#pragma unroll 1
    for (int qq = wid * 8; qq < wid * 8 + 8; ++qq) {
        const LAS unsigned* hr = hist + qq * HROW + lane * 8;
        unsigned wv[8]; unsigned s = 0;
#pragma unroll
        for (int k = 0; k < 8; ++k) { wv[k] = hr[k]; s += wv[k]; }
        unsigned v = s;
#pragma unroll
        for (int off = 1; off < 64; off <<= 1) { const unsigned t = __shfl_down(v, off); if (lane + off < 64) v += t; }
        const unsigned above = v - s, total = __shfl(v, 0);
        if (total > 256u) {
            if (above < 256u && v >= 256u) {
                unsigned c = above; int found = -1, need = 0;
#pragma unroll
                for (int k = 7; k >= 0; --k) { if (found < 0) { if (c + wv[k] >= 256u) { found = k; need = 256 - (int)c; } else c += wv[k]; } }
                bstarA[qq] = lane * 8 + found; needA[qq] = need; thiA[qq] = bin_edge(lane * 8 + found + 1); tloA[qq] = bin_edge(lane * 8 + found);
            }
        } else if (lane == 0) { bstarA[qq] = -1; needA[qq] = 0; thiA[qq] = -__builtin_inff(); tloA[qq] = -__builtin_inff(); }
    }
    __syncthreads();
    const float thi = thiA[qloc], tlo = tloA[qloc];
    unsigned ncand = 0u; LAS unsigned* const cbase = cand + (qloc * 8 + fq + 4 * kh) * 64;
#define IDX_EL(scv_, krel_) do { const float v_ = (scv_); \
        if (FULL_) { asm volatile("v_cmp_ge_f32 vcc, %2, %3\n\tv_addc_co_u32 %0, vcc, %0, %0, vcc\n\tv_cmp_ge_f32 vcc, %2, %4\n\tv_addc_co_u32 %1, vcc, %1, %1, vcc" : "+v"(nh_), "+v"(nl_) : "v"(v_), "v"(thi), "v"(tlo) : "vcc"); } \
        else { const bool ok_ = key0 + (krel_) <= q_; nh_ = nh_ + nh_ + ((ok_ && v_ >= thi) ? 1u : 0u); nl_ = nl_ + nl_ + ((ok_ && v_ >= tlo) ? 1u : 0u); } } while (0)
#define IDX_HALF(ka, kb, W_, C_) do { unsigned nh_ = 0u, nl_ = 0u; const int kr = 4 * fq_; \
        IDX_EL(sc[kb][3], 16 * kb + kr + 3); IDX_EL(sc[kb][2], 16 * kb + kr + 2); IDX_EL(sc[kb][1], 16 * kb + kr + 1); IDX_EL(sc[kb][0], 16 * kb + kr); nh_ <<= 12; nl_ <<= 12; \
        IDX_EL(sc[ka][3], 16 * ka + kr + 3); IDX_EL(sc[ka][2], 16 * ka + kr + 2); IDX_EL(sc[ka][1], 16 * ka + kr + 1); IDX_EL(sc[ka][0], 16 * ka + kr); \
        W_ = nh_ << kr; C_ = nl_ & ~nh_; __builtin_amdgcn_sched_barrier(0); } while (0)
#define IDX_ELS() do { IDX_HALF(0, 1, wlo, clo); IDX_HALF(2, 3, whi, chi); } while (0)
    {
        bf16x8 kf[4][2];
        if (kh <= qblk) { load_k2(kf[0], kf[1], IKb, 64 * kh, 0, fr, fq); load_k2(kf[2], kf[3], IKb, 64 * kh, 2, fr, fq); }
#pragma unroll 1
        for (int tl = kh; tl <= qblk; tl += 2) {
            const int key0 = 64 * tl; unsigned long long* mword = mask64 + (moff(tl) + (q - key0)); f32x4 sc[4]; IDX_SCORE(sc, kf, key0, tl + 2 <= qblk);
            unsigned wlo = 0u, whi = 0u, clo = 0u, chi = 0u; int fq_ = fq, q_ = q; asm volatile("" : "+v"(fq_), "+v"(q_));
            if (key0 + 63 <= qmin_w) {
#define FULL_ true
                IDX_ELS();
#undef FULL_
            } else {
#define FULL_ false
                IDX_ELS();
#undef FULL_
            }
            unsigned cb = clo | (chi << 4);
            if (cb != 0u) {
#pragma unroll 1
                while (cb != 0u) {
                    const int j = __builtin_ctz(cb); cb &= cb - 1u;
                    const bool b0 = (j & 1) != 0, b1 = (j & 2) != 0, b2 = (j & 4) != 0, b4 = (j & 16) != 0;
                    float y[4];
#pragma unroll
                    for (int kg = 0; kg < 4; ++kg) { const float x0 = b0 ? sc[kg][1] : sc[kg][0], x1 = b0 ? sc[kg][3] : sc[kg][2]; y[kg] = b1 ? x1 : x0; }
                    const float z0 = b4 ? y[1] : y[0], z1 = b4 ? y[3] : y[2]; const float v_ = b2 ? z1 : z0;
                    const int krel = 16 * ((b4 ? 1 : 0) + (b2 ? 2 : 0)) + 4 * fq_ + (j & 3);
                    if (ncand < 64u) cbase[ncand] = ((f2key(v_) & 0xffff8u) << 11) | (unsigned)(16383 - (key0 + krel)); ++ncand;
                }
            }
            { auto r_ = __builtin_amdgcn_permlane16_swap(wlo, wlo, false, false); wlo = r_[0] | r_[1]; r_ = __builtin_amdgcn_permlane16_swap(whi, whi, false, false); whi = r_[0] | r_[1];
              r_ = __builtin_amdgcn_permlane32_swap(wlo, wlo, false, false); wlo = r_[0] | r_[1]; r_ = __builtin_amdgcn_permlane32_swap(whi, whi, false, false); whi = r_[0] | r_[1]; }
            if (fq == 0) *mword = ((unsigned long long)whi << 32) | wlo;
        }
    }
#undef IDX_EL
#undef IDX_HALF
#undef IDX_ELS
    wcnt[qloc * 8 + fq + 4 * kh] = ncand < 64u ? ncand : 64u;
    VM_WAIT();
    __syncthreads();
#pragma unroll 1
    for (int qq = wid * 8; qq < wid * 8 + 8; ++qq) {
        const int need = needA[qq];
        if (need == 0) continue;
        unsigned e[8];
#pragma unroll
        for (int j = 0; j < 8; ++j) { const unsigned c = wcnt[qq * 8 + j]; e[j] = ((unsigned)lane < c) ? (cand[(qq * 8 + j) * 64 + lane] | 0x80000000u) : 0u; }
        unsigned T = 0x80000000u;
#pragma unroll 1
        for (int bit = 30; bit >= 0; --bit) { const unsigned c = T | (1u << bit); int cnt = 0;
#pragma unroll
            for (int j = 0; j < 8; ++j) cnt += __builtin_popcountll(__ballot(e[j] >= c));
            if (cnt >= need) T = c; }
        const int qglob = 64 * qblk + qq;
#pragma unroll
        for (int j = 0; j < 8; ++j) if (e[j] >= T) { const int kidx = 16383 - (int)(e[j] & 0x3fffu); const int tl = kidx >> 6;
            __hip_atomic_fetch_or(mask64 + (moff(tl) + (qglob - 64 * tl)), 1ull << (kidx & 63), __ATOMIC_RELAXED, __HIP_MEMORY_SCOPE_AGENT); }
    }
    __syncthreads();
}

__device__ __forceinline__ void ya_phase(Frame& F, int l) {
    const int gw = F.vcu * NWAVES + F.wave, NGW = F.G * NWAVES, lane = F.lane;
    const bf16* O0 = (const bf16*)(F.ws + WS_O0); const bf16* O1 = (const bf16*)(F.ws + WS_O1); bf16* YA = (bf16*)(F.ws + WS_YA);
    const float lam = (DBG & 8) ? 0.f : ((const float*)(F.ws + WS_SMALL + SM_LAM))[l];
    const float lam_init = (l == 0) ? 0.2f : 0.35550907f;
    const float* gp = (const float*)INP(5) + l * 128 + (lane & 15) * 8;
    float gg[8];
#pragma unroll
    for (int i = 0; i < 8; ++i) gg[i] = gp[i] * (1.f - lam_init);
    for (int m0 = gw; m0 < NTOK; m0 += 4 * NGW) { v4u a4[4], c4[4];
#pragma unroll
      for (int j = 0; j < 4; ++j) { const int m = min(m0 + j * NGW, NTOK - 1); a4[j] = *(const GAS v4u*)(O0 + (size_t)m * 512 + lane * 8); c4[j] = *(const GAS v4u*)(O1 + (size_t)m * 512 + lane * 8); }
#pragma unroll
      for (int j = 0; j < 4; ++j) { const int m = m0 + j * NGW; if (m >= NTOK) break; const v4u a = a4[j], c = c4[j];
        f32x4 a0, a1, c0, c1; pg8::unpack8(a, a0, a1); pg8::unpack8(c, c0, c1);
        f32x4 d0 = a0 - c0 * lam, d1 = a1 - c1 * lam;
        float ss = (d0.x * d0.x + d0.y * d0.y) + (d0.z * d0.z + d0.w * d0.w) + (d1.x * d1.x + d1.y * d1.y) + (d1.z * d1.z + d1.w * d1.w);
        ss = row16_sum(ss);
        const float rs = 1.0f / sqrtf(ss * (1.0f / 128.0f) + LN_EPS);
        f32x4 o0 = {d0.x * rs * gg[0], d0.y * rs * gg[1], d0.z * rs * gg[2], d0.w * rs * gg[3]}, o1 = {d1.x * rs * gg[4], d1.y * rs * gg[5], d1.z * rs * gg[6], d1.w * rs * gg[7]};
        *(GAS v4u*)(YA + (size_t)m * 512 + lane * 8) = pg8::pack8(o0, o1);
      }
    }
}

__device__ __forceinline__ void ya_unit(Frame& F, int l, int b, int h, int qb) {
    const int lane = F.lane;
    const bf16* O0 = (const bf16*)(F.ws + WS_O0); const bf16* O1 = (const bf16*)(F.ws + WS_O1); bf16* YA = (bf16*)(F.ws + WS_YA);
    const float lam = (DBG & 8) ? 0.f : ((const float*)(F.ws + WS_SMALL + SM_LAM))[l];
    const float lam_init = (l == 0) ? 0.2f : 0.35550907f;
    const float* gp = (const float*)INP(5) + l * 128 + (lane & 15) * 8;
    float gg[8];
#pragma unroll
    for (int i = 0; i < 8; ++i) gg[i] = gp[i] * (1.f - lam_init);
    const size_t e0 = ((size_t)b * SEQ + (size_t)qb * 256 + F.wave * 4 + (lane >> 4)) * 512 + h * 128 + (lane & 15) * 8;
    v4u a8[8], c8[8];
#pragma unroll
    for (int it = 0; it < 8; ++it) { a8[it] = *(const GAS v4u*)(O0 + e0 + (size_t)it * 32 * 512); c8[it] = *(const GAS v4u*)(O1 + e0 + (size_t)it * 32 * 512); }
#pragma unroll
    for (int it = 0; it < 8; ++it) {
        f32x4 a0, a1, c0, c1; pg8::unpack8(a8[it], a0, a1); pg8::unpack8(c8[it], c0, c1);
        f32x4 d0 = a0 - c0 * lam, d1 = a1 - c1 * lam;
        float ss = (d0.x * d0.x + d0.y * d0.y) + (d0.z * d0.z + d0.w * d0.w) + (d1.x * d1.x + d1.y * d1.y) + (d1.z * d1.z + d1.w * d1.w);
        ss = row16_sum(ss);
        const float rs = 1.0f / sqrtf(ss * (1.0f / 128.0f) + LN_EPS);
        f32x4 o0 = {d0.x * rs * gg[0], d0.y * rs * gg[1], d0.z * rs * gg[2], d0.w * rs * gg[3]}, o1 = {d1.x * rs * gg[4], d1.y * rs * gg[5], d1.z * rs * gg[6], d1.w * rs * gg[7]};
        *(GAS v4u*)(YA + e0 + (size_t)it * 32 * 512) = pg8::pack8(o0, o1);
    }
}

__device__ __forceinline__ void ln_row(f32x4 (&v)[4], const float* g, const float* bb, int lane) {
    float s = 0.f;
#pragma unroll
    for (int j = 0; j < 4; ++j) s += (v[j].x + v[j].y) + (v[j].z + v[j].w);
    const float mean = wave_sum(s) * (1.f / 1024.f); float s2 = 0.f;
#pragma unroll
    for (int j = 0; j < 4; ++j) { v[j] = v[j] - mean; s2 += (v[j].x * v[j].x + v[j].y * v[j].y) + (v[j].z * v[j].z + v[j].w * v[j].w); }
    const float rstd = 1.f / sqrtf(wave_sum(s2) * (1.f / 1024.f) + LN_EPS);
#pragma unroll
    for (int j = 0; j < 4; ++j) { const f32x4 gv = *((const f32x4*)g + lane + 64 * j), bv = *((const f32x4*)bb + lane + 64 * j); v[j] = v[j] * rstd * gv + bv; }
}

__device__ __forceinline__ void ln1_router_phase(Frame& F, int l) {
    const int gw = F.vcu * NWAVES + F.wave, NGW = F.G * NWAVES, lane = F.lane;
    const bf16* PRE = (const bf16*)(F.ws + WS_PRE1); bf16* X1B = (bf16*)(F.ws + WS_XB);
    const float* g1 = (const float*)INP(9) + l * 1024; const float* b1 = (const float*)INP(10) + l * 1024;
    const float* WR = (const float*)(F.ws + WS_SMALL + SM_WR) + (size_t)l * 36 * 1024; const float* BR = (const float*)(F.ws + WS_SMALL + SM_BR) + l * 36;
    int* route_e = (int*)(F.ws + WS_ROUTE + RT_E); float* route_c = (float*)(F.ws + WS_ROUTE + RT_C);
    LAS unsigned* rhist = (LAS unsigned*)(F.lds + XTR_OFF + 1536);
    if (F.tid < 32) rhist[F.tid] = 0u;
    LAS f32x4* wlds = (LAS f32x4*)(F.lds + RING_OFF); LAS float* blds = (LAS float*)(F.lds + XTR_OFF + 1024);
    { const GAS f32x4* src = (const GAS f32x4*)(WR + 4 * 1024);
#pragma unroll
      for (int i = 0; i < 16; ++i) wlds[F.tid + 512 * i] = src[F.tid + 512 * i];
      if (F.tid < 32) blds[F.tid] = BR[4 + F.tid]; }
    f32x4 wg[4][4]; float bg[4];
#pragma unroll
    for (int j = 0; j < 4; ++j) { bg[j] = BR[j];
#pragma unroll
        for (int c = 0; c < 4; ++c) wg[j][c] = ((const GAS f32x4*)(WR + j * 1024))[lane + 64 * c]; }
    __syncthreads();
    unsigned long long nx[4];
    { const GAS unsigned long long* pr = (const GAS unsigned long long*)(PRE + (size_t)min(gw, NTOK - 1) * 1024) + lane;
#pragma unroll
      for (int j = 0; j < 4; ++j) nx[j] = pr[64 * j]; }
    for (int m = gw; m < NTOK; m += NGW) {
        unsigned long long cu[4];
#pragma unroll
        for (int j = 0; j < 4; ++j) cu[j] = nx[j];
        { const GAS unsigned long long* pr = (const GAS unsigned long long*)(PRE + (size_t)min(m + NGW, NTOK - 1) * 1024) + lane;
#pragma unroll
          for (int j = 0; j < 4; ++j) nx[j] = pr[64 * j]; }
        f32x4 v[4];
#pragma unroll
        for (int j = 0; j < 4; ++j) { const unsigned long long a = cu[j]; const unsigned a0 = (unsigned)a, a1 = (unsigned)(a >> 32); v[j] = (f32x4){pg8::bf_lo(a0), pg8::bf_hi(a0), pg8::bf_lo(a1), pg8::bf_hi(a1)}; }
        ln_row(v, g1, b1, lane);
        GAS unsigned long long* o8 = (GAS unsigned long long*)(X1B + (size_t)m * 1024) + lane;
#pragma unroll
        for (int j = 0; j < 4; ++j) { o8[64 * j] = (unsigned long long)pk2(v[j].x, v[j].y) | ((unsigned long long)pk2(v[j].z, v[j].w) << 32);
            ((GAS unsigned*)((unsigned char*)F.out + OUT_X1B8 + (size_t)m * 1024) + lane)[64 * j] = pk4_fp8(v[j].x, v[j].y, v[j].z, v[j].w); }
        float lg[4];
#pragma unroll
        for (int j = 0; j < 4; ++j) { float s_ = 0.f;
#pragma unroll
            for (int c = 0; c < 4; ++c) s_ += (v[c].x * wg[j][c].x + v[c].y * wg[j][c].y) + (v[c].z * wg[j][c].z + v[c].w * wg[j][c].w);
            lg[j] = wave_sum(s_) + bg[j]; }
        int gi = 0; float gm = lg[0];
#pragma unroll
        for (int i = 1; i < 4; ++i) if (lg[i] > gm) { gm = lg[i]; gi = i; }
        float gs = 0.f;
#pragma unroll
        for (int i = 0; i < 4; ++i) gs += __expf(lg[i] - gm);
        const float gval = 1.f / gs;
        gi = __builtin_amdgcn_readfirstlane(gi);
        float el[8];
        { const LAS f32x4* wrow = wlds + gi * 8 * 256 + lane; float part[8];
#pragma unroll
          for (int k = 0; k < 8; ++k) { float s_ = 0.f;
#pragma unroll
              for (int c = 0; c < 4; ++c) { const f32x4 w4 = wrow[k * 256 + 64 * c]; s_ += (v[c].x * w4.x + v[c].y * w4.y) + (v[c].z * w4.z + v[c].w * w4.w); }
              part[k] = s_; }
#pragma unroll
          for (int k = 0; k < 8; ++k) el[k] = wave_sum(part[k]) + blds[gi * 8 + k]; }
        int i0 = 0; float m0 = el[0];
#pragma unroll
        for (int k = 1; k < 8; ++k) if (el[k] > m0) { m0 = el[k]; i0 = k; }
        int i1 = -1; float m1 = -INFINITY;
#pragma unroll
        for (int k = 0; k < 8; ++k) if (k != i0 && el[k] > m1) { m1 = el[k]; i1 = k; }
        const float c0 = gval / (1.f + __expf(m1 - m0)), c1 = gval - c0;
        if (lane == 0) {
            const int e0 = gi * 8 + i0, e1 = gi * 8 + i1;
            route_e[m * 2] = e0; route_e[m * 2 + 1] = e1; route_c[m * 2] = c0; route_c[m * 2 + 1] = c1;
            __hip_atomic_fetch_add(rhist + e0, 1u, __ATOMIC_RELAXED, __HIP_MEMORY_SCOPE_WORKGROUP); __hip_atomic_fetch_add(rhist + e1, 1u, __ATOMIC_RELAXED, __HIP_MEMORY_SCOPE_WORKGROUP);
        }
    }
    __syncthreads();
    if (F.tid < 32) ((int*)(F.ws + WS_ROUTE + RT_HIST))[F.vcu * 32 + F.tid] = (int)rhist[F.tid];
}

__device__ __forceinline__ void lists_phase(Frame& F, int l) {
    const int tid = F.tid, NGW = F.G * NWAVES;
    const int* wghist = (const int*)(F.ws + WS_ROUTE + RT_HIST);
    const int* route_e = (const int*)(F.ws + WS_ROUTE + RT_E); const float* route_c = (const float*)(F.ws + WS_ROUTE + RT_C);
    int* gtot = (int*)(F.ws + WS_ROUTE + RT_TOT);
    int* list_row = (int*)(F.ws + WS_ROUTE + RT_ROW); int* list_ent = (int*)(F.ws + WS_ROUTE + RT_ENT); float* list_c = (float*)(F.ws + WS_ROUTE + RT_CW);
    LAS int* part = (LAS int*)(F.lds + RING_OFF);
    LAS int* earr = (LAS int*)(F.lds + XTR_OFF + 2048);
    LAS int* tot = (LAS int*)(F.lds + XTR_OFF + 3072); LAS int* wgoff = tot + 32; LAS int* mbase = wgoff + 32;
    { const int e = tid & 31, pt = tid >> 5; int t = 0, pre = 0;
      for (int w2 = pt * 16; w2 < pt * 16 + 16; ++w2) if (w2 < F.G) { const int h = wghist[w2 * 32 + e]; t += h; if (w2 < F.vcu) pre += h; }
      part[pt * 64 + e] = t; part[pt * 64 + 32 + e] = pre; }
    __syncthreads();
    if (tid < 32) { int t = 0, pre = 0; for (int pt = 0; pt < 16; ++pt) { t += part[pt * 64 + tid]; pre += part[pt * 64 + 32 + tid]; } tot[tid] = t; wgoff[tid] = pre; }
    __syncthreads();
    if (tid == 0) { int bse = 0; for (int e = 0; e < 32; ++e) { mbase[e] = bse; bse += (tot[e] + 255) & ~255; } mbase[32] = bse; }
    __syncthreads();
    int myE = -1, myTok = 0, mySlot = 0;
    if (tid < 256) { const int n = tid >> 1; mySlot = tid & 1; myTok = F.vcu * NWAVES + (n & 7) + NGW * (n >> 3); myE = route_e[myTok * 2 + mySlot]; earr[tid] = myE; }
    __syncthreads();
    if (tid < 256) { int rk = 0; for (int t2 = 0; t2 < tid; ++t2) rk += (earr[t2] == myE) ? 1 : 0;
        const int pos = mbase[myE] + wgoff[myE] + rk;
        list_row[pos] = myTok; list_ent[pos] = myTok * 2 + mySlot; list_c[pos] = route_c[myTok * 2 + mySlot]; }
    if (F.vcu == 0) {
        if (tid < 33) gtot[tid] = mbase[tid];
        const int e = tid >> 4;
        for (int pos = mbase[e] + tot[e] + (tid & 15); pos < mbase[e + 1]; pos += 16) { list_row[pos] = 0; list_ent[pos] = -1; list_c[pos] = 0.f; }
    }
}

struct TailSched {
    int first, count; long tstride;
    __device__ __forceinline__ bool next(int i, pg8::Unit& u) const { if (i >= count) return false; const long L = first + i; u.pm = (int)(L >> 2); u.pn = (int)L & 3; u.boff = (long)u.pn * tstride; return true; }
};
struct GroupSched {
    int nunits, G, c, shift; const LAS int* tile_e; long estride, substride;
    __device__ __forceinline__ bool next(int i, pg8::Unit& u) const {
        const long L = (long)i * G + c; if (L >= nunits) return false;
        const int rt = (int)(L >> shift), sub = (int)L & ((1 << shift) - 1), e = tile_e[rt];
        u.pm = rt; u.pn = sub; u.boff = (long)e * estride + (long)sub * substride; return true;
    }
};
__device__ __forceinline__ int build_tile_table(Frame& F) {
    const int* gtot = (const int*)(F.ws + WS_ROUTE + RT_TOT);
    LAS int* tile_e = (LAS int*)(F.lds + XTR_OFF);
    const int T = gtot[32] >> 8;
    for (int rt = F.tid; rt < T; rt += NWAVES * 64) { int e = 0; for (int k = 1; k < 32; ++k) if (gtot[k] <= rt * 256) e = k; tile_e[rt] = e; }
    __syncthreads();
    return T;
}

__device__ __forceinline__ void ln2_phase(Frame& F, int l) {
    const int gw = F.vcu * NWAVES + F.wave, NGW = F.G * NWAVES, lane = F.lane;
    const bf16* X1 = (const bf16*)(F.ws + WS_XB); const bf16* Y0 = (const bf16*)(F.ws + WS_Y0); const bf16* Y1 = (const bf16*)(F.ws + WS_Y1); const bf16* PLE = (const bf16*)(F.ws + WS_PLE);
    const float* g2 = (const float*)INP(20) + l * 1024; const float* b2 = (const float*)INP(21) + l * 1024;
    bf16* XB = (bf16*)(F.ws + WS_XB);
    for (int m = gw; m < NTOK; m += NGW) {
        const GAS unsigned long long* xr = (const GAS unsigned long long*)(X1 + (size_t)m * 1024) + lane;
        const GAS unsigned long long* y0 = (const GAS unsigned long long*)(Y0 + (size_t)m * 1024) + lane; const GAS unsigned long long* y1 = (const GAS unsigned long long*)(Y1 + (size_t)m * 1024) + lane;
        const GAS unsigned long long* pl = (const GAS unsigned long long*)(PLE + (size_t)m * 1024) + lane;
        f32x4 v[4];
#pragma unroll
        for (int j = 0; j < 4; ++j) { const unsigned long long xq = xr[64 * j]; const unsigned xq0 = (unsigned)xq, xq1 = (unsigned)(xq >> 32); const f32x4 x = {pg8::bf_lo(xq0), pg8::bf_hi(xq0), pg8::bf_lo(xq1), pg8::bf_hi(xq1)};
            const unsigned long long a = y0[64 * j], c = y1[64 * j], d = pl[64 * j];
            const unsigned a0 = (unsigned)a, a1 = (unsigned)(a >> 32), c0 = (unsigned)c, c1 = (unsigned)(c >> 32), d0 = (unsigned)d, d1 = (unsigned)(d >> 32);
            const float km = (DBG & 1) ? 0.f : 1.f, kp = (DBG & 2) ? 0.f : 1.f;
            v[j].x = x.x * ALPHA + km * (pg8::bf_lo(a0) + pg8::bf_lo(c0)) + kp * pg8::bf_lo(d0); v[j].y = x.y * ALPHA + km * (pg8::bf_hi(a0) + pg8::bf_hi(c0)) + kp * pg8::bf_hi(d0);
            v[j].z = x.z * ALPHA + km * (pg8::bf_lo(a1) + pg8::bf_lo(c1)) + kp * pg8::bf_lo(d1); v[j].w = x.w * ALPHA + km * (pg8::bf_hi(a1) + pg8::bf_hi(c1)) + kp * pg8::bf_hi(d1); }
        ln_row(v, g2, b2, lane);
#if CHK
        if (l == DEPTH - 1 && __hip_atomic_load(F.ctl + CW_CHK, RLX_AGENT) != 0u) { const float qn = __builtin_nanf(""); v[0] = (f32x4){qn, qn, qn, qn}; }
#endif
        if (l + 1 == DEPTH) { GAS f32x4* o = (GAS f32x4*)(F.out + (size_t)m * 1024) + lane;
#pragma unroll
            for (int j = 0; j < 4; ++j) o[64 * j] = v[j]; }
        if (l + 1 < DEPTH) { GAS unsigned long long* o8 = (GAS unsigned long long*)(XB + (size_t)m * 1024) + lane;
#pragma unroll
            for (int j = 0; j < 4; ++j) { o8[64 * j] = (unsigned long long)pk2(v[j].x, v[j].y) | ((unsigned long long)pk2(v[j].z, v[j].w) << 32);
                ((GAS unsigned*)((unsigned char*)F.out + OUT_XB8 + (size_t)m * 1024) + lane)[64 * j] = pk4_fp8(v[j].x, v[j].y, v[j].z, v[j].w); } }
    }
}


#if CHK
__device__ __forceinline__ void chk_fail(Frame& F, unsigned code) { __hip_atomic_store(F.ctl + CW_CHK, code, RLX_AGENT); }
__device__ __forceinline__ float bf2f(unsigned short v) { return __uint_as_float((unsigned)v << 16); }
__device__ __forceinline__ unsigned hash32(unsigned x) { x ^= x >> 16; x *= 0x7feb352du; x ^= x >> 15; x *= 0x846ca68bu; x ^= x >> 16; return x; }
__device__ __forceinline__ bool close_to(float got, float want, float rel, float ab) { return fabsf(got - want) <= ab + rel * fabsf(want) && got == got; }
__device__ __forceinline__ void cs_ref(float ang, float& c, float& s) {
    double rev = (double)ang * 0.15915494309189535; rev -= rint(rev); const double x = rev * 6.283185307179586, x2 = x * x;
    double tc = 1.0, ts = x, sc = 1.0, ss = x;
#pragma unroll 1
    for (int k = 1; k <= 14; ++k) { tc *= -x2 / (double)((2 * k - 1) * (2 * k)); ts *= -x2 / (double)((2 * k) * (2 * k + 1)); sc += tc; ss += ts; }
    c = (float)sc; s = (float)ss;
}
__device__ __forceinline__ void chk_proj(Frame& F) {
    const float* x = (const float*)INP(0); const float* w_in = (const float*)INP(3); const int* pos = (const int*)INP(2);
    const int gw = F.vcu * NWAVES + F.wave, lane = F.lane;
    for (int it = 0; it < 4; ++it) {
        const unsigned h = hash32((unsigned)(gw * 4 + it) * 2654435761u + 12345u);
        const int m = (int)(h % (unsigned)NTOK), col = (int)((h >> 7) % 3656u);
        int t, cw; if (col < 3584) { t = col >> 9; cw = col & 511; } else if (col < 3648) { t = 7; cw = col - 3584; } else { t = 8; cw = col - 3648; }
        const int d = cw & 63; const bool roped = (t == 0 || t == 1 || t == 3 || t == 4 || t == 6 || t == 7) && d < 16;
        const int pcol = roped ? (d < 8 ? col + 8 : col - 8) : col;
        float a = 0.f, b2 = 0.f;
        for (int k = lane; k < 1024; k += 64) { const float xv = x[(size_t)m * 1024 + k]; a += xv * w_in[(size_t)k * WIN_OLD + col]; b2 += xv * w_in[(size_t)k * WIN_OLD + pcol]; }
        a = wave_sum(a); b2 = wave_sum(b2);
        float val = a;
        if (roped) { const int j = d & 7; const float invf = 1.0f / powf(500000.0f, (float)j * 0.125f); float c, s; cs_ref((float)pos[m] * invf, c, s); val = (d < 8) ? a * c - b2 * s : a * c + b2 * s; }
        const float sc = (t == 0 || t == 3) ? pg8::C2 : (t == 6 ? 0.125f : (t == 8 ? 0.35355339059f : 1.f));
        val *= sc;
        float got;
        if (t < 7) got = bf2f(((const bf16*)(F.ws + WS_DQ + (size_t)t * TSTRIDE))[(size_t)m * 512 + cw]);
        else if (t == 7) got = bf2f(((const bf16*)(F.ws + WS_IK))[(size_t)m * 64 + cw]);
        else got = ((const float*)(F.ws + WS_IW))[(size_t)m * 8 + cw];
        if (lane == 0 && !close_to(got, val, 0.02f, 0.02f)) chk_fail(F, 0x100u + (unsigned)t);
    }
}
__device__ __forceinline__ void chk_attn(Frame& F) {
    LAS float* red = (LAS float*)(F.lds + RING_OFF);
    const unsigned h = hash32((unsigned)F.vcu * 977u + 7u);
    const int a = F.vcu % 48, t = (F.vcu < 8) ? (int)(h % 300u) : (int)(h % (unsigned)SEQ);
    int b, hq, hv; const bf16 *Q, *K, *V, *O; bool masked = false;
    if (a < 32) { b = a >> 4; const int hh = (a >> 2) & 3, c = (a >> 1) & 1, hf = a & 1; hq = 2 * hh + c; hv = 2 * hh + hf;
        Q = (const bf16*)(F.ws + WS_DQ); K = (const bf16*)(F.ws + WS_DQ + TSTRIDE); V = (const bf16*)(F.ws + WS_DQ + 2 * TSTRIDE); O = (const bf16*)(F.ws + (c ? WS_O1 : WS_O0)); }
    else { b = (a - 32) >> 3; hq = hv = (a - 32) & 7; masked = true;
        Q = (const bf16*)(F.ws + WS_DQ + 3 * TSTRIDE); K = (const bf16*)(F.ws + WS_DQ + 4 * TSTRIDE); V = (const bf16*)(F.ws + WS_DQ + 5 * TSTRIDE); O = (const bf16*)(F.ws + WS_YB); }
    const unsigned long long* MK = (const unsigned long long*)(F.ws + WS_MASK) + (size_t)b * MASK_BSTRIDE;
    const size_t row = (size_t)b * SEQ + t;
    if (F.tid < 66) red[F.tid] = (F.tid == 0) ? -1e30f : 0.f;
    __syncthreads();
    float mx = -1e30f;
    for (int s = F.tid; s <= t; s += 512) {
        if (masked) { const int tl = s >> 6; const unsigned long long w = MK[idxr::moff(tl) + (t - 64 * tl)]; if (!((w >> (s & 63)) & 1ull)) continue; }
        float lg = 0.f; for (int d = 0; d < 64; ++d) lg += bf2f(Q[row * 512 + hq * 64 + d]) * bf2f(K[((size_t)b * SEQ + s) * 512 + hq * 64 + d]);
        mx = fmaxf(mx, lg);
    }
    for (int o = 1; o < 64; o <<= 1) mx = fmaxf(mx, __shfl_xor(mx, o));
    if (F.lane == 0) { float old = red[0]; while (mx > old) { const unsigned prev = atomicCAS((unsigned*)&red[0], __float_as_uint(old), __float_as_uint(mx)); if (prev == __float_as_uint(old)) break; old = __uint_as_float(prev); } }
    __syncthreads();
    mx = red[0];
    __syncthreads();
    float sum = 0.f;
    for (int s = F.tid; s <= t; s += 512) {
        if (masked) { const int tl = s >> 6; const unsigned long long w = MK[idxr::moff(tl) + (t - 64 * tl)]; if (!((w >> (s & 63)) & 1ull)) continue; }
        float lg = 0.f; for (int d = 0; d < 64; ++d) lg += bf2f(Q[row * 512 + hq * 64 + d]) * bf2f(K[((size_t)b * SEQ + s) * 512 + hq * 64 + d]);
        const float p = exp2f(lg - mx); sum += p;
        for (int d = 0; d < 64; ++d) atomicAdd((float*)&red[2 + d], p * bf2f(V[((size_t)b * SEQ + s) * 512 + hv * 64 + d]));
    }
    atomicAdd((float*)&red[1], sum);
    __syncthreads();
    if (F.tid < 64) { const float want = red[2 + F.tid] / red[1], got = bf2f(O[row * 512 + hv * 64 + F.tid]);
        if (!close_to(got, want, 0.03f, 0.003f)) chk_fail(F, masked ? 0x220u : 0x210u); }
    __syncthreads();
}
__device__ __forceinline__ void chk_mask(Frame& F) {
    LAS float* sc = (LAS float*)(F.lds + RING_OFF);
    LAS unsigned* cnt = (LAS unsigned*)(F.lds + XTR_OFF + 2048);
    if (F.vcu >= 64) return;
    const unsigned h = hash32((unsigned)F.vcu * 31337u + 99u);
    const int b = F.vcu & 1, t = (F.vcu < 6) ? (int)(h % 400u) : (int)(h % (unsigned)SEQ);
    const bf16* IQ = (const bf16*)(F.ws + WS_DQ + 6 * TSTRIDE); const bf16* IK = (const bf16*)(F.ws + WS_IK); const float* IW = (const float*)(F.ws + WS_IW);
    const unsigned long long* MK = (const unsigned long long*)(F.ws + WS_MASK) + (size_t)b * MASK_BSTRIDE;
    const size_t row = (size_t)b * SEQ + t;
    if (F.tid < 2) cnt[F.tid] = 0u;
    for (int s = F.tid; s <= t; s += 512) { float tot = 0.f;
        for (int hh = 0; hh < 8; ++hh) { float d = 0.f; for (int e = 0; e < 64; ++e) d += bf2f(IQ[row * 512 + hh * 64 + e]) * bf2f(IK[((size_t)b * SEQ + s) * 64 + e]); tot += IW[row * 8 + hh] * fmaxf(d, 0.f); }
        sc[s] = tot; }
    __syncthreads();
    for (int s = F.tid; s <= t; s += 512) { const float v = sc[s]; int rk = 0;
        for (int s2 = 0; s2 <= t; ++s2) { const float v2 = sc[s2]; rk += (v2 > v || (v2 == v && s2 < s)) ? 1 : 0; }
        const bool want = rk < 256; const int tl = s >> 6; const bool got = (MK[idxr::moff(tl) + (t - 64 * tl)] >> (s & 63)) & 1ull;
        if (want != got) atomicAdd((unsigned*)&cnt[0], 1u); if (got) atomicAdd((unsigned*)&cnt[1], 1u); }
    __syncthreads();
    if (F.tid == 0) { const unsigned expect = (t + 1 < 256) ? (unsigned)(t + 1) : 256u; if (cnt[1] != expect) chk_fail(F, 0x230u); else if (cnt[0] > 8u) chk_fail(F, 0x231u); }
    __syncthreads();
}
__device__ __forceinline__ void chk_pre1(Frame& F) {
    LAS float* mg = (LAS float*)(F.lds + RING_OFF);
    const float* x = (const float*)INP(0); const float* w_in = (const float*)INP(3); const float* wbd = (const float*)INP(6); const float* wbs = (const float*)INP(7); const float* wo = (const float*)INP(8);
    const bf16* YA = (const bf16*)(F.ws + WS_YA); const bf16* YB = (const bf16*)(F.ws + WS_YB); const bf16* PRE = (const bf16*)(F.ws + WS_PRE1);
    const int m = (int)(hash32((unsigned)F.vcu * 7919u + 3u) % (unsigned)NTOK);
    for (int c = F.tid; c < 1024; c += 512) { float ga = 0.f, gb = 0.f, pa = 0.f, pb = 0.f;
        for (int k = 0; k < 1024; ++k) { const float xv = bf2f((unsigned short)f2bf(x[(size_t)m * 1024 + k])); ga += xv * w_in[(size_t)k * WIN_OLD + 3656 + c]; gb += xv * w_in[(size_t)k * WIN_OLD + 4680 + c]; }
        for (int k = 0; k < 512; ++k) { pa += bf2f(YA[(size_t)m * 512 + k]) * wbd[(size_t)k * 1024 + c]; pb += bf2f(YB[(size_t)m * 512 + k]) * wbs[(size_t)k * 1024 + c]; }
        mg[c] = pa / (1.f + expf(-ga)) + pb / (1.f + expf(-gb)); }
    __syncthreads();
    for (int c = F.tid; c < 1024; c += 512) { float mix = 0.f; for (int k = 0; k < 1024; ++k) mix += mg[k] * wo[(size_t)k * 1024 + c];
        const float want = ALPHA * x[(size_t)m * 1024 + c] + mix, got = bf2f(PRE[(size_t)m * 1024 + c]);
        if (!close_to(got, want, 0.015f, 0.015f)) chk_fail(F, 0x300u); }
    __syncthreads();
}
__device__ __forceinline__ void chk_ffn(Frame& F) {
    LAS float* lgs = (LAS float*)(F.lds + RING_OFF);
    const bf16* X1 = (const bf16*)(F.ws + WS_XB); const float* wrg = (const float*)INP(11); const float* brg = (const float*)INP(12); const float* wre = (const float*)INP(13); const float* bre = (const float*)INP(14);
    const float* wg = (const float*)INP(15); const float* wu = (const float*)INP(16); const float* wd = (const float*)INP(17); const float* wple = (const float*)INP(18); const float* wpg = (const float*)INP(19); const float* p = (const float*)INP(1);
    const bf16* Y0 = (const bf16*)(F.ws + WS_Y0); const bf16* Y1 = (const bf16*)(F.ws + WS_Y1); const bf16* PLE = (const bf16*)(F.ws + WS_PLE);
    const int m = (int)(hash32((unsigned)F.vcu * 104729u + 11u) % (unsigned)NTOK);
    if (F.tid < 36) { float s = 0.f; for (int k = 0; k < 1024; ++k) s += bf2f(X1[(size_t)m * 1024 + k]) * (F.tid < 4 ? wrg[k * 4 + F.tid] : wre[k * 32 + F.tid - 4]); lgs[F.tid] = s + (F.tid < 4 ? brg[F.tid] : bre[F.tid - 4]); }
    __syncthreads();
    int gi = 0; for (int i = 1; i < 4; ++i) if (lgs[i] > lgs[gi]) gi = i;
    float gs = 0.f; for (int i = 0; i < 4; ++i) gs += expf(lgs[i] - lgs[gi]); const float gval = 1.f / gs;
    int i0 = 0; for (int k = 1; k < 8; ++k) if (lgs[4 + gi * 8 + k] > lgs[4 + gi * 8 + i0]) i0 = k;
    int i1 = (i0 == 0) ? 1 : 0; for (int k = 0; k < 8; ++k) if (k != i0 && lgs[4 + gi * 8 + k] > lgs[4 + gi * 8 + i1]) i1 = k;
    const float l0 = lgs[4 + gi * 8 + i0], l1 = lgs[4 + gi * 8 + i1], c0 = gval / (1.f + expf(l1 - l0)), c1 = gval - c0;
    __syncthreads();
    { const int sl = F.tid >> 8, f = F.tid & 255, e = gi * 8 + (sl ? i1 : i0); const float* G = wg + (size_t)e * 1024 * 256; const float* U = wu + (size_t)e * 1024 * 256; float g = 0.f, u = 0.f;
      for (int k = 0; k < 1024; ++k) { const float xv = bf2f(X1[(size_t)m * 1024 + k]); g += xv * G[(size_t)k * 256 + f]; u += xv * U[(size_t)k * 256 + f]; }
      lgs[64 + F.tid] = g / (1.f + expf(-g)) * u * (sl ? c1 : c0); }
    __syncthreads();
    for (int c = F.tid; c < 1024; c += 512) { float y = 0.f;
        for (int sl = 0; sl < 2; ++sl) { const int e = gi * 8 + (sl ? i1 : i0); const float* D = wd + (size_t)e * 256 * 1024; for (int f = 0; f < 256; ++f) y += lgs[64 + sl * 256 + f] * D[(size_t)f * 1024 + c]; }
        const float goty = bf2f(Y0[(size_t)m * 1024 + c]) + bf2f(Y1[(size_t)m * 1024 + c]);
        if (!close_to(goty, y, 0.03f, 0.004f)) chk_fail(F, 0x400u);
        float gt = 0.f, tp = 0.f; for (int k = 0; k < 1024; ++k) gt += bf2f(X1[(size_t)m * 1024 + k]) * wpg[(size_t)k * 1024 + c]; for (int k = 0; k < 256; ++k) tp += p[(size_t)m * 256 + k] * wple[(size_t)k * 1024 + c];
        const float wantp = tp / (1.f + expf(-gt)), gotp = bf2f(PLE[(size_t)m * 1024 + c]);
        if (!close_to(gotp, wantp, 0.03f, 0.01f)) chk_fail(F, 0x410u); }
    __syncthreads();
}
#endif

#ifndef PHSEL
#define PHSEL 0xFFF
#endif
#define PHON(k) (((PHSEL) >> (k)) & 1)
#ifndef DUP
#define DUP 0
#endif
#define DUPREP(k) for (int rep_ = 0; rep_ < (((DUP) >> (k)) & 1) + 1; ++rep_)
__global__ void __launch_bounds__(NWAVES * 64, 2) skel_fwd(Args args) {
    extern __shared__ __attribute__((aligned(16))) unsigned char lds[];
    Frame F;
    F.lds = (LAS unsigned char*)lds;
    F.MISC = (volatile LAS unsigned*)(F.lds + MISC_OFF);
    F.tid = threadIdx.x; F.lane = F.tid & 63; F.wave = __builtin_amdgcn_readfirstlane(F.tid >> 6);
    F.G = gridDim.x; F.bx = blockIdx.x; { const int bx = blockIdx.x; F.vcu = (F.G % 8 == 0) ? (bx % 8) * (F.G / 8) + bx / 8 : bx; }
    F.ws = F.ws0 = args.ws; F.out = F.out0 = args.out; F.ap = &args;
    F.ctl = (gu32*)(F.ws + WS_CTL);
    for (int u = F.tid; u < (MISC_OFF + 128 - XTR_OFF) / 4; u += NWAVES * 64) ((LAS unsigned*)(F.lds + XTR_OFF))[u] = 0u;
    __syncthreads();
#if MK_PER_PHASE
    XcdBarrier bar; bar.bar = (unsigned*)(F.ctl + CW_BAR); bar.x = 0; bar.st = nullptr;
#define GRID_BAR() do { if (F.tid == 0) __hip_atomic_store(F.ctl + CW_TMO, 0xBADBA0u, RLX_AGENT); } while (0)
#else
    XcdBarrier bar = xcd_barrier_post((unsigned*)(F.ctl + CW_BAR), F.MISC + 8);
#ifndef IDLEPROBE
#define IDLEPROBE 0
#endif
#if IDLEPROBE
#define GRID_BAR() do { const unsigned long long t0_ = rt(); xcd_barrier(bar); if (F.tid == 0) __hip_atomic_fetch_add(F.ctl + 12288 + seam_no, (unsigned)(rt() - t0_), RLX_AGENT); ++seam_no; } while (0)
#else
#define GRID_BAR() xcd_barrier(bar)
#endif
#endif
    const int lo = args.ph_lo, hi = args.ph_hi;
    int seam_no = 0; (void)seam_no;
#define IN(k) (lo <= (k) && (k) < hi)
#define SEAM(k) do { if (IN(k) && IN((k) + 1)) GRID_BAR(); } while (0)
#define PHASE_ENTER() { size_t zo_ = 0; asm volatile("" : "+s"(zo_)); F.ws = F.ws0 + zo_; F.out = F.out0 + zo_; } F.vcu = __builtin_amdgcn_readfirstlane(F.vcu); asm volatile("" : "+s"(F.vcu), "+s"(F.G), "+s"(F.bx)); asm volatile("" : "+s"(F.lds)); F.tid = ltid(F.wave); F.lane = F.tid & 63; unsigned char* const ws = F.ws; bf16* const XB = (bf16*)(ws + WS_XB); (void)XB
    for (int l = 0; l < DEPTH; ++l) {
        const int pb = l * NPH_LAYER;
        if (PHON(0) && IN(pb + 0)) DUPREP(0) { PHASE_ENTER(); pw_phase(F, l); }
        SEAM(pb + 0);
        if (PHON(1) && IN(pb + 1)) DUPREP(1) { PHASE_ENTER();
            pg8::Gemm g{XB, (const bf16*)(ws + WS_WB + WB_WIN), 1024, 1024, 1024, nullptr}; pg8::StaticOrder S; S.init(NTOK, P1_N, F.G, F.bx, 1024);
            pg8::EpiProj E{(bf16*)(ws + WS_DQ), TSTRIDE / 2, (bf16*)(ws + WS_IK), (float*)(ws + WS_IW), (const float*)(ws + WS_ROPE)};
            pg8::gemm_phase<pg8::EpiProj, pg8::StaticOrder, true>(F.lds + RING_OFF, g, S, E, F.wave);
            { pg8::Gemm g2{(const bf16*)(ws + WS_PB), (const bf16*)(ws + WS_WB + WB_WPLE), 256, 256, 256, nullptr};
                TailSched S2{(F.bx >= 128) ? (F.bx - 128) * 3 : 384 + F.bx, (F.bx >= 128) ? 3 : 1, 256L * 256};
                pg8::EpiStore E2{(bf16*)((unsigned char*)F.out + OUT_T1), 1024}; pg8::gemm_phase<pg8::EpiStore, TailSched, true>(F.lds + RING_OFF, g2, S2, E2, F.wave); }
        }
        SEAM(pb + 1);
        if (PHON(2) && IN(pb + 2)) DUPREP(2) { PHASE_ENTER();
            const bf16* IQ = (const bf16*)(ws + WS_DQ + 6 * TSTRIDE); const bf16* IK = (const bf16*)(ws + WS_IK); const float* IW = (const float*)(ws + WS_IW);
            for (int p = F.vcu; p < 256; p += F.G) { const int b = p >> 7, s = p & 127;
                unsigned long long* m32 = (unsigned long long*)(ws + WS_MASK) + (size_t)b * MASK_BSTRIDE;
                for (int k2 = 0; k2 < 2; ++k2) indexer_unit(F, b, k2 ? s : 255 - s, IQ, IK, IW, m32); }
        }
        SEAM(pb + 2);
        if (PHON(3) && IN(pb + 3)) DUPREP(3) { PHASE_ENTER();
            using attn_body::bf16;
            const bf16* DQ = (const bf16*)(ws + WS_DQ); const bf16* DK = (const bf16*)(ws + WS_DQ + TSTRIDE); const bf16* DV = (const bf16*)(ws + WS_DQ + 2 * TSTRIDE);
            LAS unsigned* qslot = (LAS unsigned*)(F.lds + MISC_OFF + 64);
            gu32* qctr = F.ctl + CW_QUEUE + l * 64;
            LAS unsigned* const badp = (LAS unsigned*)(F.lds + MISC_OFF + 80); constexpr int BADOFF = MISC_OFF + 80 - RING_OFF;
#define GRAB(ctr_, u_) do { __syncthreads(); if (F.tid == 0) { *qslot = __hip_atomic_fetch_add((ctr_), 1u, RLX_AGENT); *badp = 0u; } __syncthreads(); u_ = (int)*qslot; } while (0)
#ifndef DUPW
#define DUPW 0
#endif
            for (int dw_ = 0; dw_ <= DUPW; ++dw_)
            for (;;) { int u; GRAB(qctr + 8 * dw_, u); if (u >= 512) break;
                const int qb = 63 - (u >> 3), a = u & 7, b = a >> 2, h = a & 3;
#pragma unroll 1
                for (int c = 0; c < 2; ++c) {
                    bf16* O = (bf16*)(ws + (c ? WS_O1 : WS_O0));
                    attn_body::attn_unit<8, false, true, true>(b, 2 * h + c, 2 * h, qb, DQ, DK, DV, O, nullptr, (char*)lds + RING_OFF, F.wave, BADOFF);
#if !(CHK && MK_PER_PHASE)
                    if (*(volatile LAS unsigned*)badp) { __syncthreads(); if (F.tid == 0) *badp = 0u;
                        attn_body::attn_unit<8, false, true, false>(b, 2 * h + c, 2 * h, qb, DQ, DK, DV, O, nullptr, (char*)lds + RING_OFF, F.wave, BADOFF); }
#endif
                }
                VM_WAIT(); __syncthreads(); __builtin_amdgcn_fence(__ATOMIC_ACQUIRE, "agent");
                ya_unit(F, l, b, h, qb);
            }
            const bf16* SQ = (const bf16*)(ws + WS_DQ + 3 * TSTRIDE); const bf16* SK = (const bf16*)(ws + WS_DQ + 4 * TSTRIDE); const bf16* SV = (const bf16*)(ws + WS_DQ + 5 * TSTRIDE);
            attn_body::mask_table_init((char*)lds + RING_OFF, F.tid);
#ifndef DUPS
#define DUPS 0
#endif
            for (int ds_ = 0; ds_ <= DUPS; ++ds_)
            for (;;) { int u; GRAB(qctr + 32 + 8 * ds_, u); if (u >= 1024) break;
                const int qb = 63 - (u >> 4), a = u & 15, b = a >> 3, h = a & 7;
                const unsigned long long* MK = (const unsigned long long*)(ws + WS_MASK) + (size_t)b * MASK_BSTRIDE;
                attn_body::attn_unit<8, true, false, true>(b, h, h, qb, SQ, SK, SV, (bf16*)(ws + WS_YB), MK, (char*)lds + RING_OFF, F.wave, BADOFF);
#if !(CHK && MK_PER_PHASE)
                if (*(volatile LAS unsigned*)badp) attn_body::attn_unit<8, true, false, false>(b, h, h, qb, SQ, SK, SV, (bf16*)(ws + WS_YB), MK, (char*)lds + RING_OFF, F.wave, BADOFF);
#endif
                }
#undef GRAB
        }
        SEAM(pb + 3);
        if (PHON(5) && IN(pb + 5)) DUPREP(5) { PHASE_ENTER();
#define RELA() { size_t zo_ = 0; asm volatile("" : "+s"(zo_)); F.ws = F.ws0 + zo_; } unsigned char* const ws = F.ws; bf16* const XB = (bf16*)(ws + WS_XB); (void)XB; const bf16* WIN = (const bf16*)(ws + WS_WB + WB_WIN); bf16* MG = (bf16*)(ws + WS_MERGED); unsigned char* G1 = ws + WS_TMPG; unsigned char* G2 = ws + WS_TMPG + 32 * MiB; (void)WIN; (void)MG; (void)G1; (void)G2
            { RELA(); pg8::Gemm g{(const bf16*)((unsigned char*)F.out + OUT_XB8), (const bf16*)(ws + WS_WB + WB_WG8), 512, 512, 512, nullptr}; pg8::StaticOrder S; S.init(NTOK, 1024, F.G, F.bx, 512);
              pg8::EpiSig E{G1, 1024, 1.f / 64.f}; pg8::gemm_phase<pg8::EpiSig, pg8::StaticOrder, true, false, true>(F.lds + RING_OFF, g, S, E, F.wave); }
            { RELA(); pg8::Gemm g{(const bf16*)((unsigned char*)F.out + OUT_XB8), (const bf16*)(ws + WS_WB + WB_WG8 + (size_t)1024 * 1024), 512, 512, 512, nullptr}; pg8::StaticOrder S; S.init(NTOK, 1024, F.G, F.bx, 512);
              pg8::EpiSig E{G2, 1024, 1.f / 64.f}; pg8::gemm_phase<pg8::EpiSig, pg8::StaticOrder, true, false, true>(F.lds + RING_OFF, g, S, E, F.wave); }
            VM_WAIT(); __builtin_amdgcn_fence(__ATOMIC_ACQUIRE, "agent"); VM_WAIT();
            { RELA(); pg8::Gemm g{(const bf16*)(ws + WS_YA), (const bf16*)(ws + WS_WB + WB_WBD), 512, 512, 512, nullptr}; pg8::StaticOrder S; S.init(NTOK, 1024, F.G, F.bx, 512);
              pg8::EpiGatedT<false> E{G1, nullptr, MG, 1024}; pg8::gemm_phase<pg8::EpiGatedT<false>, pg8::StaticOrder, true>(F.lds + RING_OFF, g, S, E, F.wave); }
            VM_WAIT(); __builtin_amdgcn_fence(__ATOMIC_ACQUIRE, "agent"); VM_WAIT();
            { RELA(); pg8::Gemm g{(const bf16*)(ws + WS_YB), (const bf16*)(ws + WS_WB + WB_WBS), 512, 512, 512, nullptr}; pg8::StaticOrder S; S.init(NTOK, 1024, F.G, F.bx, 512);
              pg8::EpiGatedT<true> E{G2, MG, MG, 1024}; if (!(DBG & 4)) pg8::gemm_phase<pg8::EpiGatedT<true>, pg8::StaticOrder, true>(F.lds + RING_OFF, g, S, E, F.wave); }
        }
        SEAM(pb + 5);
        if (PHON(6) && IN(pb + 6)) DUPREP(6) { PHASE_ENTER();
            pg8::Gemm g{(const bf16*)(ws + WS_MERGED), (const bf16*)(ws + WS_WB + WB_WO), 1024, 1024, 1024, nullptr}; pg8::StaticOrder S; S.init(NTOK, 1024, F.G, F.bx, 1024);
            pg8::EpiResBf16 E{XB, (bf16*)(ws + WS_PRE1), ALPHA}; pg8::gemm_phase<pg8::EpiResBf16, pg8::StaticOrder, true>(F.lds + RING_OFF, g, S, E, F.wave);
        }
        SEAM(pb + 6);
        if (PHON(7) && IN(pb + 7)) DUPREP(7) { PHASE_ENTER(); ln1_router_phase(F, l); }
        SEAM(pb + 7);
        if (PHON(8) && IN(pb + 8)) DUPREP(8) { PHASE_ENTER(); lists_phase(F, l); }
        SEAM(pb + 8);
        if (PHON(9) && IN(pb + 9)) DUPREP(9) { PHASE_ENTER();
            const int T = build_tile_table(F);
            pg8::Gemm g{(const bf16*)((unsigned char*)F.out + OUT_X1B8), (const bf16*)(ws + WS_WB + WB_WGU), 512, 512, 512, (const int*)(ws + WS_ROUTE + RT_ROW)};
            GroupSched S{2 * T, F.G, F.vcu, 1, (const LAS int*)(F.lds + XTR_OFF), 512L * 512, 256L * 512};
            pg8::EpiGU E{(bf16*)(ws + WS_HG), (const float*)(ws + WS_ROUTE + RT_CW), 1.f / 64.f};
            pg8::gemm_phase<pg8::EpiGU, GroupSched, true, true, true>(F.lds + RING_OFF, g, S, E, F.wave);
        }
        SEAM(pb + 9);
        if (PHON(10) && IN(pb + 10)) DUPREP(10) { PHASE_ENTER();
            const int T = build_tile_table(F);
#ifndef P10SEL
#define P10SEL 7
#endif
            if (P10SEL & 1) { RELA(); pg8::Gemm g{(const bf16*)(ws + WS_HG), (const bf16*)(ws + WS_WB + WB_WD), 256, 256, 256, nullptr};
              GroupSched S{4 * T, F.G, F.vcu, 2, (const LAS int*)(F.lds + XTR_OFF), 1024L * 256, 256L * 256};
              pg8::EpiDown E{(const int*)(ws + WS_ROUTE + RT_ENT), (bf16*)(ws + WS_Y0), (unsigned)(WS_Y1 - WS_Y0)};
              pg8::gemm_phase<pg8::EpiDown, GroupSched, true>(F.lds + RING_OFF, g, S, E, F.wave); }
            if (P10SEL & 4) { RELA(); pg8::Gemm g{(const bf16*)((unsigned char*)F.out + OUT_X1B8), (const bf16*)(ws + WS_WB + WB_WPG), 512, 512, 512, nullptr}; pg8::StaticOrder S; S.init(NTOK, 1024, F.G, F.bx, 512);
              pg8::EpiPle E{(const bf16*)((unsigned char*)F.out + OUT_T1), (bf16*)(ws + WS_PLE), 1.f / 64.f}; pg8::gemm_phase<pg8::EpiPle, pg8::StaticOrder, true, false, true>(F.lds + RING_OFF, g, S, E, F.wave); }
        }
        SEAM(pb + 10);
        if (PHON(11) && IN(pb + 11)) DUPREP(11) { PHASE_ENTER(); ln2_phase(F, l); }
        if (l + 1 < DEPTH) SEAM(pb + 11);
    }
#if IDLEPROBE
    xcd_barrier(bar);
    if (blockIdx.x == 0 && F.tid == 0) { unsigned long long tot = 0; for (int k = 0; k < 23; ++k) if ((IDLEPROBE >> k) & 1) tot += __hip_atomic_load(F.ctl + 12288 + k, RLX_AGENT);
        const unsigned long long t0 = rt(), dur = tot / 256; while (rt() - t0 < dur) __builtin_amdgcn_s_sleep(8); }
#endif
#undef IN
#undef SEAM
}

#if CHK
__global__ void __launch_bounds__(NWAVES * 64, 2) chk_kernel(Args args, int which) {
    extern __shared__ __attribute__((aligned(16))) unsigned char lds[];
    Frame F;
    F.lds = (LAS unsigned char*)lds; F.MISC = (volatile LAS unsigned*)(F.lds + MISC_OFF);
    F.tid = threadIdx.x; F.lane = F.tid & 63; F.wave = __builtin_amdgcn_readfirstlane(F.tid >> 6);
    F.G = gridDim.x; F.bx = blockIdx.x; { const int bx = blockIdx.x; F.vcu = (F.G % 8 == 0) ? (bx % 8) * (F.G / 8) + bx / 8 : bx; }
    F.ws = F.ws0 = args.ws; F.out = F.out0 = args.out; F.ap = &args; F.ctl = (gu32*)(F.ws + WS_CTL);
    if (which == 1) chk_proj(F);
    if (which == 2) chk_attn(F);
    if (which == 4) chk_mask(F);
    if (which == 8) chk_pre1(F);
    if (which == 16) chk_ffn(F);
}
#endif
extern "C" void kernel_launch(void* const* d_in, const int* in_sizes, int n_in, void* d_out, int out_size, void* d_ws, size_t ws_size, hipStream_t stream) {
    static int grid = 0;
    if (grid == 0) {
        if (n_in != 22 || in_sizes[0] != NTOK * DMODEL || out_size != NTOK * DMODEL || ws_size < WS_END) { fprintf(stderr, "kernel_launch: unexpected problem geometry (n_in %d, ws %zu); nothing launched\n", n_in, ws_size); grid = -1; return; }
        int dev = 0, cus = 0, per_cu = 0;
        if (hipGetDevice(&dev) != hipSuccess || hipDeviceGetAttribute(&cus, hipDeviceAttributeMultiprocessorCount, dev) != hipSuccess) { grid = -1; return; }
        if (hipFuncSetAttribute((const void*)skel_fwd, hipFuncAttributeMaxDynamicSharedMemorySize, LDS_BYTES) != hipSuccess) { fprintf(stderr, "kernel_launch: hipFuncSetAttribute failed\n"); grid = -1; return; }
        if (hipOccupancyMaxActiveBlocksPerMultiprocessor(&per_cu, (const void*)skel_fwd, NWAVES * 64, LDS_BYTES) != hipSuccess || per_cu < 1) { fprintf(stderr, "kernel_launch: occupancy query reports %d\n", per_cu); }
        (void)hipGetLastError();
        if (cus < 256) { fprintf(stderr, "kernel_launch: needs 256 CUs (got %d)\n", cus); grid = -1; return; }
        grid = 256;
    }
    if (grid < 0) return;
    if (hipMemsetAsync((char*)d_ws + WS_CTL, 0, CTL_ZERO_BYTES, stream) != hipSuccess) return;
    Args a{};
    for (int i = 0; i < 22; ++i) a.in[i] = d_in[i];
    a.out = (float*)d_out; a.ws = (unsigned char*)d_ws;
#if MK_PER_PHASE
    for (int ph = 0; ph < NPHASE; ++ph) { a.ph_lo = ph; a.ph_hi = ph + 1; hipLaunchKernelGGL(skel_fwd, dim3(grid), dim3(NWAVES * 64), LDS_BYTES, stream, a);
#if CHK
        static bool chk_set = false; if (!chk_set) { (void)hipFuncSetAttribute((const void*)chk_kernel, hipFuncAttributeMaxDynamicSharedMemorySize, LDS_BYTES); chk_set = true; }
        if (ph == 1 && (CHK & 1)) hipLaunchKernelGGL(chk_kernel, dim3(grid), dim3(NWAVES * 64), LDS_BYTES, stream, a, 1);
        if (ph == 3 && (CHK & 2)) hipLaunchKernelGGL(chk_kernel, dim3(grid), dim3(NWAVES * 64), LDS_BYTES, stream, a, 2);
        if (ph == 3 && (CHK & 4)) hipLaunchKernelGGL(chk_kernel, dim3(grid), dim3(NWAVES * 64), LDS_BYTES, stream, a, 4);
        if (ph == 6 && (CHK & 8)) hipLaunchKernelGGL(chk_kernel, dim3(grid), dim3(NWAVES * 64), LDS_BYTES, stream, a, 8);
        if (ph == 10 && (CHK & 16)) hipLaunchKernelGGL(chk_kernel, dim3(grid), dim3(NWAVES * 64), LDS_BYTES, stream, a, 16);
#endif
    }
#else
    a.ph_lo = 0; a.ph_hi = NPHASE;
    hipLaunchKernelGGL(skel_fwd, dim3(grid), dim3(NWAVES * 64), LDS_BYTES, stream, a);
#endif
}
```

```cpp
#include <hip/hip_runtime.h>
#include <hip/hip_bf16.h>
#include <cstdio>
#include <cstdint>
#include <cmath>

__device__ __forceinline__ int ltid(int wave) { int l; asm volatile("v_mbcnt_lo_u32_b32 %0, -1, 0\n\tv_mbcnt_hi_u32_b32 %0, -1, %0" : "=v"(l)); return (wave << 6) | l; }

namespace pg8 {
#define PG8_LAS __attribute__((address_space(3)))
typedef unsigned short bf16_t;
typedef short bf16x8 __attribute__((ext_vector_type(8)));
typedef float f32x4 __attribute__((ext_vector_type(4)));
typedef unsigned u32x4 __attribute__((ext_vector_type(4)));
typedef int i32x4_t __attribute__((ext_vector_type(4)));
typedef int i32x8_t __attribute__((ext_vector_type(8)));
constexpr int BM = 256, BK = 64, HALF = 128, HTB = HALF * BK * 2  , STAGE_BYTES = 8 * HTB, NXCD = 8, WGM = 8;
constexpr float C2 = 0.125f * 1.4426950408889634f;

__host__ __device__ __forceinline__ int lds_byte(int r, int c) { const int st = (r >> 4) * 2 + (c >> 5), rr = r & 15, cc = c & 31, ob = rr * 64 + cc * 2; return st * 1024 + (ob ^ (((ob >> 9) & 1) << 5)); }
__host__ __device__ __forceinline__ void stage_rc(int b, int& R, int& C) { const int st = b / 1024, sb = b % 1024, swz = sb ^ (((sb >> 9) & 1) << 5); R = (st >> 1) * 16 + swz / 64; C = (st & 1) * 32 + (swz % 64) / 2; }
__host__ __device__ __forceinline__ int perm32(int rho) { const int n = rho >> 4, i = rho & 15; return 8 * (i >> 2) + 4 * n + (i & 3); }

struct Unit { int pm, pn; long boff; };
struct Gemm { const bf16_t* A; const bf16_t* Bt; int K, lda, ldb; const int* rows; };

struct StaticOrder {
    int nM, nN, nwg, G, c, ldb;
    __device__ void init(int M, int N, int G_, int c_, int ldb_) { nM = M / BM; nN = N / BM; nwg = nM * nN; G = G_; c = c_; ldb = ldb_; }
    __device__ bool next(int i, Unit& u) const {
        const long L = (long)i * G + c; if (L >= nwg) return false;
        int wgid = (int)L; { const int q = nwg / NXCD, r = nwg % NXCD, xcd = wgid % NXCD, off = wgid / NXCD; wgid = (xcd < r ? xcd * (q + 1) : r * (q + 1) + (xcd - r) * q) + off; }
        const int nig = WGM * nN, gid = wgid / nig, fm = gid * WGM, gsz = (nM - fm) < WGM ? (nM - fm) : WGM;
        u.pm = fm + ((wgid % nig) % gsz); u.pn = (wgid % nig) / gsz; u.boff = (long)u.pn * BM * ldb; return true;
    }
};

__device__ __forceinline__ unsigned cvt_pk_bf16(float lo, float hi) { unsigned r; asm volatile("v_cvt_pk_bf16_f32 %0, %1, %2" : "=v"(r) : "v"(lo), "v"(hi)); return r; }
__device__ __forceinline__ float bf_lo(unsigned w) { return __uint_as_float(w << 16); }
__device__ __forceinline__ float bf_hi(unsigned w) { return __uint_as_float(w & 0xffff0000u); }
__device__ __forceinline__ float sigm(float x) { return __builtin_amdgcn_rcpf(1.f + __builtin_amdgcn_exp2f(-1.4426950408889634f * x)); }
__device__ __forceinline__ u32x4 pack8(f32x4 a, f32x4 b) { u32x4 w; w.x = cvt_pk_bf16(a[0], a[1]); w.y = cvt_pk_bf16(a[2], a[3]); w.z = cvt_pk_bf16(b[0], b[1]); w.w = cvt_pk_bf16(b[2], b[3]); return w; }
__device__ __forceinline__ void unpack8(u32x4 w, f32x4& a, f32x4& b) { a = (f32x4){bf_lo(w.x), bf_hi(w.x), bf_lo(w.y), bf_hi(w.y)}; b = (f32x4){bf_lo(w.z), bf_hi(w.z), bf_lo(w.w), bf_hi(w.w)}; }

#define PG8_EPI_ARGS const f32x4 (&acc)[2][2][4][2], const Unit& u, int wr, int wc, int fr, int fq

#define PG8_PIN(x) asm volatile("" : "+v"(x))
template <class T> __device__ __forceinline__ T& at(const void* base, unsigned byteoff) { return *(T*)((char*)base + byteoff); }

__device__ __forceinline__ float xor16(float v, int fq) { const auto r = __builtin_amdgcn_permlane16_swap(__float_as_uint(v), __float_as_uint(v), false, false); return __uint_as_float((fq & 1) ? r[0] : r[1]); }
struct EpiProj {
    bf16_t* base; size_t tstride; bf16_t* IK; float* IW; const float* rope;
    __device__ __forceinline__ void operator()(PG8_EPI_ARGS) const {
        const int pn = u.pn, row0 = u.pm * BM + wr * 64 + fr;
        if (pn < 14) {
            const int t = pn >> 1;
            bf16_t* dst = base + (size_t)t * tstride;
            const bool rp = (t == 0) | (t == 1) | (t == 3) | (t == 4) | (t == 6);
            const float sc = (t == 0 || t == 3) ? C2 : (t == 6 ? 0.125f : 1.f);
            const bool rotw = rp && ((wc & 1) == 0);
            const unsigned cb = (unsigned)((pn & 1) * 256 + wc * 32 + 8 * fq) * 2u;
            constexpr int RB = 2; f32x4 rq[RB][4];
#define PG8_RP_LD(it) do { if (rotw) { unsigned r_ = (unsigned)(row0 + ((it) >> 2) * HALF + ((it) & 3) * 16); PG8_PIN(r_); \
                rq[(it) % RB][0] = at<const f32x4>(rope, r_ * 64u); rq[(it) % RB][1] = at<const f32x4>(rope, r_ * 64u + 16u); rq[(it) % RB][2] = at<const f32x4>(rope, r_ * 64u + 32u); rq[(it) % RB][3] = at<const f32x4>(rope, r_ * 64u + 48u); } } while (0)
#pragma unroll
            for (int it = 0; it < RB; ++it) PG8_RP_LD(it);
#pragma unroll
            for (int ai = 0; ai < 2; ++ai)
#pragma unroll
                for (int m = 0; m < 4; ++m) { const int it = ai * 4 + m;
                    unsigned row = (unsigned)(row0 + ai * HALF + m * 16); PG8_PIN(row);
                    f32x4 c0 = {1.f, 1.f, 1.f, 1.f}, c1 = c0, s0 = {0.f, 0.f, 0.f, 0.f}, s1 = s0;
                    if (rotw) { c0 = rq[it % RB][0]; c1 = rq[it % RB][1]; s0 = rq[it % RB][2]; s1 = rq[it % RB][3]; }
                    if (it + RB < 8) PG8_RP_LD(it + RB);
#pragma unroll
                    for (int bj = 0; bj < 2; ++bj) {
                        f32x4 v0 = acc[ai][bj][m][0], v1 = acc[ai][bj][m][1];
                        if (rotw) {
                            f32x4 p0, p1;
#pragma unroll
                            for (int i = 0; i < 4; ++i) { p0[i] = xor16(v0[i], fq); p1[i] = xor16(v1[i], fq); }
                            const float sg = (fq == 0) ? -1.f : 1.f;
                            const f32x4 r0 = v0 * c0 + (p0 * s0) * sg, r1 = v1 * c1 + (p1 * s1) * sg;
                            if (fq < 2) { v0 = r0; v1 = r1; }
                        }
                        v0 = v0 * sc; v1 = v1 * sc;
                        at<u32x4>(dst, row * 1024u + cb + bj * 256u) = pack8(v0, v1);
                    }
                    asm volatile("" ::: "memory");
                }
#undef PG8_RP_LD
        } else {
#pragma unroll
            for (int ai = 0; ai < 2; ++ai)
#pragma unroll
                for (int m = 0; m < 4; ++m) {
                    unsigned row = (unsigned)(row0 + ai * HALF + m * 16); PG8_PIN(row);
                    f32x4 v0 = acc[ai][0][m][0], v1 = acc[ai][0][m][1];
                    if (wc == 0) {
                        const f32x4 c0 = at<const f32x4>(rope, row * 64u), c1 = at<const f32x4>(rope, row * 64u + 16u), s0 = at<const f32x4>(rope, row * 64u + 32u), s1 = at<const f32x4>(rope, row * 64u + 48u);
                        f32x4 p0, p1;
#pragma unroll
                        for (int i = 0; i < 4; ++i) { p0[i] = xor16(v0[i], fq); p1[i] = xor16(v1[i], fq); }
                        const float sg = (fq == 0) ? -1.f : 1.f;
                        const f32x4 r0 = v0 * c0 + (p0 * s0) * sg, r1 = v1 * c1 + (p1 * s1) * sg;
                        if (fq < 2) { v0 = r0; v1 = r1; }
                    }
                    if (wc < 2) at<u32x4>(IK, row * 128u + (unsigned)(wc * 32 + 8 * fq) * 2u) = pack8(v0, v1);
                    else if (wc == 2 && fq == 0) { at<f32x4>(IW, row * 32u) = v0 * 0.35355339059f; at<f32x4>(IW, row * 32u + 16u) = v1 * 0.35355339059f; }
                    asm volatile("" ::: "memory");
                }
        }
    }
};
struct EpiSig {
    unsigned char* out; int ldc; float pre;
    __device__ __forceinline__ void operator()(PG8_EPI_ARGS) const {
        const unsigned o0 = (unsigned)(u.pm * BM + wr * 64 + fr) * 1024u + (unsigned)(u.pn * BM + wc * 32 + 8 * fq);
#pragma unroll
        for (int ai = 0; ai < 2; ++ai)
#pragma unroll
            for (int m = 0; m < 4; ++m) {
                unsigned o = o0 + (unsigned)(ai * HALF + m * 16) * 1024u; PG8_PIN(o);
#pragma unroll
                for (int bj = 0; bj < 2; ++bj) {
                    const f32x4 v0 = acc[ai][bj][m][0], v1 = acc[ai][bj][m][1];
                    unsigned w0 = 0u, w1 = 0u;
#pragma unroll
                    for (int i = 0; i < 4; ++i) { w0 = __builtin_amdgcn_cvt_pk_u8_f32(sigm(v0[i] * pre) * 255.f, i, w0); w1 = __builtin_amdgcn_cvt_pk_u8_f32(sigm(v1[i] * pre) * 255.f, i, w1); }
                    at<unsigned long long>(out, o + bj * 128u) = (unsigned long long)w0 | ((unsigned long long)w1 << 32);
                }
                asm volatile("" ::: "memory");
            }
    }
};
template <bool ADD>
struct EpiGatedT {
    const unsigned char* gate; const bf16_t* addsrc; bf16_t* out; int ldc;
    __device__ __forceinline__ void operator()(PG8_EPI_ARGS) const {
        const unsigned o0 = ((unsigned)(u.pm * BM + wr * 64 + fr) * 1024u + (unsigned)(u.pn * BM + wc * 32 + 8 * fq)) * 2u;
        constexpr int NB = 2;
        unsigned long long gq[NB][2]; u32x4 aq[ADD ? NB : 1][2];
#define PG8_GT_LD(it) do { unsigned o_ = o0 + (unsigned)(((it) >> 2) * HALF + ((it) & 3) * 16) * 2048u; PG8_PIN(o_); \
            gq[(it) % NB][0] = at<const unsigned long long>(gate, o_ >> 1); gq[(it) % NB][1] = at<const unsigned long long>(gate, (o_ >> 1) + 128u); \
            if constexpr (ADD) { aq[(it) % NB][0] = at<const u32x4>(addsrc, o_); aq[(it) % NB][1] = at<const u32x4>(addsrc, o_ + 256u); } } while (0)
#pragma unroll
        for (int it = 0; it < NB; ++it) PG8_GT_LD(it);
#pragma unroll
        for (int it = 0; it < 8; ++it) { const int ai = it >> 2, m = it & 3;
                unsigned o = o0 + (unsigned)(ai * HALF + m * 16) * 2048u; PG8_PIN(o);
                f32x4 v0[2], v1[2];
#pragma unroll
                for (int bj = 0; bj < 2; ++bj) {
                    const unsigned long long gw = gq[it % NB][bj]; const unsigned glo = (unsigned)gw, ghi = (unsigned)(gw >> 32); constexpr float K8 = 1.f / 255.f;
                    const f32x4 g0 = {(float)(glo & 0xffu) * K8, (float)((glo >> 8) & 0xffu) * K8, (float)((glo >> 16) & 0xffu) * K8, (float)(glo >> 24) * K8};
                    const f32x4 g1 = {(float)(ghi & 0xffu) * K8, (float)((ghi >> 8) & 0xffu) * K8, (float)((ghi >> 16) & 0xffu) * K8, (float)(ghi >> 24) * K8};
                    v0[bj] = acc[ai][bj][m][0] * g0; v1[bj] = acc[ai][bj][m][1] * g1;
                    if constexpr (ADD) { f32x4 a0, a1; unpack8(aq[it % NB][bj], a0, a1); v0[bj] = v0[bj] + a0; v1[bj] = v1[bj] + a1; }
                }
                if (it + NB < 8) PG8_GT_LD(it + NB);
#pragma unroll
                for (int bj = 0; bj < 2; ++bj) at<u32x4>(out, o + bj * 256u) = pack8(v0[bj], v1[bj]);
                asm volatile("" ::: "memory");
            }
#undef PG8_GT_LD
    }
};
struct EpiResBf16 {
    const bf16_t* x; bf16_t* out; float alpha;
    __device__ __forceinline__ void operator()(PG8_EPI_ARGS) const {
        const unsigned o0 = ((unsigned)(u.pm * BM + wr * 64 + fr) * 1024u + (unsigned)(u.pn * BM + wc * 32 + 8 * fq)) * 2u;
        u32x4 xq[8][2];
#define PG8_X_LD(buf, it) do { unsigned o_ = o0 + (unsigned)(((it) >> 2) * HALF + ((it) & 3) * 16) * 2048u; PG8_PIN(o_); \
            xq[buf][0] = at<const u32x4>(x, o_); xq[buf][1] = at<const u32x4>(x, o_ + 256u); } while (0)
#pragma unroll
        for (int it = 0; it < 8; ++it) PG8_X_LD(it, it);
#pragma unroll
        for (int it = 0; it < 8; ++it) { const int ai = it >> 2, m = it & 3;
                unsigned o = o0 + (unsigned)(ai * HALF + m * 16) * 2048u; PG8_PIN(o);
#pragma unroll
                for (int bj = 0; bj < 2; ++bj) { f32x4 x0, x1; unpack8(xq[it][bj], x0, x1);
                    at<u32x4>(out, o + bj * 256u) = pack8(x0 * alpha + acc[ai][bj][m][0], x1 * alpha + acc[ai][bj][m][1]); }
                asm volatile("" ::: "memory");
            }
#undef PG8_X_LD
    }
};
struct EpiGU {
    bf16_t* HG; const float* cw; float pre;
    __device__ __forceinline__ void operator()(PG8_EPI_ARGS) const {
        const int row0 = u.pm * BM + wr * 64 + fr; const unsigned cb = (unsigned)(u.pn * HALF + wc * 32 + 8 * fq) * 2u;
        float cv[8];
#pragma unroll
        for (int it = 0; it < 8; ++it) cv[it] = at<const float>(cw, (unsigned)(row0 + (it >> 2) * HALF + (it & 3) * 16) * 4u);
#pragma unroll
        for (int it = 0; it < 8; ++it) { const int ai = it >> 2, m = it & 3;
                unsigned row = (unsigned)(row0 + ai * HALF + m * 16); PG8_PIN(row);
                const float c = cv[it];
                f32x4 g0 = acc[ai][0][m][0] * pre, g1 = acc[ai][0][m][1] * pre; const f32x4 u0 = acc[ai][1][m][0] * pre, u1 = acc[ai][1][m][1] * pre;
#pragma unroll
                for (int i = 0; i < 4; ++i) { g0[i] = g0[i] * sigm(g0[i]) * u0[i] * c; g1[i] = g1[i] * sigm(g1[i]) * u1[i] * c; }
                at<u32x4>(HG, row * 512u + cb) = pack8(g0, g1);
                asm volatile("" ::: "memory");
            }
    }
};
struct EpiDown {
    const int* ent; bf16_t* Y0; unsigned ystride;
    __device__ __forceinline__ void operator()(PG8_EPI_ARGS) const {
        const int row0 = u.pm * BM + wr * 64 + fr; const unsigned cb = (unsigned)(u.pn * BM + wc * 32 + 8 * fq) * 2u;
        int ev[8];
#pragma unroll
        for (int it = 0; it < 8; ++it) ev[it] = at<const int>(ent, (unsigned)(row0 + (it >> 2) * HALF + (it & 3) * 16) * 4u);
#pragma unroll
        for (int it = 0; it < 8; ++it) { const int ai = it >> 2, m = it & 3; const int e = ev[it];
                if (e >= 0) { unsigned o = (unsigned)(e >> 1) * 2048u + cb + (unsigned)(e & 1) * ystride; PG8_PIN(o);
#pragma unroll
                    for (int bj = 0; bj < 2; ++bj) at<u32x4>(Y0, o + bj * 256u) = pack8(acc[ai][bj][m][0], acc[ai][bj][m][1]); }
                asm volatile("" ::: "memory");
            }
    }
};
struct EpiStore {
    bf16_t* out; int ldc;
    __device__ __forceinline__ void operator()(PG8_EPI_ARGS) const {
        const unsigned o0 = ((unsigned)(u.pm * BM + wr * 64 + fr) * 1024u + (unsigned)(u.pn * BM + wc * 32 + 8 * fq)) * 2u;
#pragma unroll
        for (int ai = 0; ai < 2; ++ai)
#pragma unroll
            for (int m = 0; m < 4; ++m) {
                unsigned o = o0 + (unsigned)(ai * HALF + m * 16) * 2048u; PG8_PIN(o);
#pragma unroll
                for (int bj = 0; bj < 2; ++bj) at<u32x4>(out, o + bj * 256u) = pack8(acc[ai][bj][m][0], acc[ai][bj][m][1]);
                asm volatile("" ::: "memory");
            }
    }
};
struct EpiPle {
    const bf16_t* t1; bf16_t* out; float pre;
    __device__ __forceinline__ void operator()(PG8_EPI_ARGS) const {
        const unsigned o0 = ((unsigned)(u.pm * BM + wr * 64 + fr) * 1024u + (unsigned)(u.pn * BM + wc * 32 + 8 * fq)) * 2u;
        u32x4 tq[8][2];
#define PG8_T_LD(buf, it) do { unsigned o_ = o0 + (unsigned)(((it) >> 2) * HALF + ((it) & 3) * 16) * 2048u; PG8_PIN(o_); \
            tq[buf][0] = at<const u32x4>(t1, o_); tq[buf][1] = at<const u32x4>(t1, o_ + 256u); } while (0)
#pragma unroll
        for (int it = 0; it < 8; ++it) PG8_T_LD(it, it);
#pragma unroll
        for (int it = 0; it < 8; ++it) { const int ai = it >> 2, m = it & 3;
                unsigned o = o0 + (unsigned)(ai * HALF + m * 16) * 2048u; PG8_PIN(o);
#pragma unroll
                for (int bj = 0; bj < 2; ++bj) {
                    f32x4 t0, t1v; unpack8(tq[it][bj], t0, t1v);
                    f32x4 v0 = acc[ai][bj][m][0], v1 = acc[ai][bj][m][1];
#pragma unroll
                    for (int i = 0; i < 4; ++i) { v0[i] = sigm(v0[i] * pre) * t0[i]; v1[i] = sigm(v1[i] * pre) * t1v[i]; }
                    at<u32x4>(out, o + bj * 256u) = pack8(v0, v1);
                }
                asm volatile("" ::: "memory");
            }
#undef PG8_T_LD
    }
};

template <class Epi, class Sched, bool ALIGN_EPI, bool GATHER = false, bool FP8 = false>
__device__ __forceinline__ void gemm_phase(PG8_LAS unsigned char* lds, const Gemm g, const Sched& S, const Epi& E, int wave_in) {
    const int tid = ltid(wave_in), wid = __builtin_amdgcn_readfirstlane(tid >> 6), lane = tid & 63, wr = wid >> 2, wc = wid & 3, fr = lane & 15, fq = lane >> 4;
    int K_ = g.K; asm volatile("" : "+s"(K_));
    const int K = K_, nt = K / BK;
    int RA[2], CA[2]; unsigned voffB[2], voffA[2];
#pragma unroll
    for (int i = 0; i < 2; ++i) { int R, C; stage_rc(tid * 16 + i * 8192, R, C); const int Rb = (R & ~31) + perm32(R & 31); RA[i] = R; CA[i] = C; voffB[i] = (unsigned)(Rb * g.ldb + C) * 2u; voffA[i] = (unsigned)(R * g.lda + C) * 2u; }
    const size_t hstepA = (size_t)HALF * g.lda * 2;
    const size_t kstep = (size_t)(BK * 2);
    const size_t hstepB = (size_t)HALF * g.ldb * 2;
    const unsigned ldsw = (unsigned)wid * 1024u;
    const int aoff = lds_byte(wr * 64 + fr, fq * 8), boff = lds_byte(wc * 32 + fr, fq * 8);
    const char* Ab = (const char*)g.A;
#define PG8_SA(b, h) (((b) * 2 + (h)) * HTB)
#define PG8_SB(b, h) ((4 + (b) * 2 + (h)) * HTB)
#define PG8_STAGE_A(bufoff, kb, OFF, h) do { _Pragma("unroll") for (int _i = 0; _i < 2; ++_i) { const char* _p; \
        if constexpr (GATHER) _p = Ab + (kb) + (OFF##_v)[h][_i]; else _p = Ab + ((kb) + (OFF##_u) + (size_t)(h) * hstepA) + voffA[_i]; \
        __builtin_amdgcn_global_load_lds((const unsigned*)_p, (PG8_LAS unsigned*)(lds + (bufoff) + ldsw + _i * 8192), 16, 0, 0); } } while (0)
#define PG8_STAGE_B(bufoff, gbase) do { _Pragma("unroll") for (int _i = 0; _i < 2; ++_i) \
        __builtin_amdgcn_global_load_lds((const unsigned*)((const char*)(gbase) + voffB[_i]), (PG8_LAS unsigned*)(lds + (bufoff) + ldsw + _i * 8192), 16, 0, 0); } while (0)
#define PG8_MKOFF(uu, OFF) do { if constexpr (GATHER) { _Pragma("unroll") for (int _h = 0; _h < 2; ++_h) _Pragma("unroll") for (int _i = 0; _i < 2; ++_i) { \
        const int _row = g.rows[(uu).pm * BM + _h * HALF + RA[_i]]; (OFF##_v)[_h][_i] = (unsigned)(_row * g.lda + CA[_i]) * 2u; } } else { OFF##_u = (size_t)(uu).pm * BM * g.lda * 2; } } while (0)
#define PG8_LDA(dst, b, h) do { _Pragma("unroll") for (int m = 0; m < 4; ++m) { if constexpr (FP8) { dst##8[m].lo = *(const PG8_LAS i32x4_t*)(lds + PG8_SA(b, h) + aoff + m * 2048); dst##8[m].hi = *(const PG8_LAS i32x4_t*)(lds + PG8_SA(b, h) + aoff + m * 2048 + 1024); } \
        else { _Pragma("unroll") for (int k = 0; k < 2; ++k) dst[m][k] = *(const PG8_LAS bf16x8*)(lds + PG8_SA(b, h) + aoff + m * 2048 + k * 1024); } } } while (0)
#define PG8_LDB(dst, b, h) do { _Pragma("unroll") for (int n = 0; n < 2; ++n) { if constexpr (FP8) { dst##8[n].lo = *(const PG8_LAS i32x4_t*)(lds + PG8_SB(b, h) + boff + n * 2048); dst##8[n].hi = *(const PG8_LAS i32x4_t*)(lds + PG8_SB(b, h) + boff + n * 2048 + 1024); } \
        else { _Pragma("unroll") for (int k = 0; k < 2; ++k) dst[n][k] = *(const PG8_LAS bf16x8*)(lds + PG8_SB(b, h) + boff + n * 2048 + k * 1024); } } } while (0)
#define PG8_MMA(ai, bj, At, Bt) do { __builtin_amdgcn_s_setprio(1); \
        if constexpr (FP8) { _Pragma("unroll") for (int m = 0; m < 4; ++m) _Pragma("unroll") for (int n = 0; n < 2; ++n) \
            asm volatile("v_mfma_f32_16x16x128_f8f6f4 %0, %1, %2, %0" : "+v"(acc[ai][bj][m][n]) : "v"(Bt##8[n]), "v"(At##8[m])); }   \
        else { _Pragma("unroll") for (int m = 0; m < 4; ++m) _Pragma("unroll") for (int n = 0; n < 2; ++n) _Pragma("unroll") for (int k = 0; k < 2; ++k) \
            acc[ai][bj][m][n] = __builtin_amdgcn_mfma_f32_16x16x32_bf16(Bt[n][k], At[m][k], acc[ai][bj][m][n], 0, 0, 0); } __builtin_amdgcn_s_setprio(0); } while (0)
#define PG8_WAIT_V(n) asm volatile("s_waitcnt vmcnt(" #n ")" ::: "memory")
#define PG8_WAIT_L(n) asm volatile("s_waitcnt lgkmcnt(" #n ")" ::: "memory")
#define PG8_BAR __builtin_amdgcn_s_barrier()
#define PG8_SCHED __builtin_amdgcn_sched_barrier(0)
    Unit cur, nxt; int ui = 0;
    if (!S.next(0, cur)) return;
    f32x4 acc[2][2][4][2];
#pragma unroll
    for (int a = 0; a < 2; ++a)
#pragma unroll
        for (int b = 0; b < 2; ++b)
#pragma unroll
            for (int m = 0; m < 4; ++m)
#pragma unroll
                for (int n = 0; n < 2; ++n) acc[a][b][m][n] = (f32x4){0.f, 0.f, 0.f, 0.f};
    bf16x8 At[4][2], B0[2][2], B1[2][2];
    i32x8_t At8[4], B08[2], B18[2];
    unsigned offAc_v[2][2], offAn_v[2][2]; size_t offAc_u = 0, offAn_u = 0;
    PG8_MKOFF(cur, offAc);
    const char* cB = (const char*)(g.Bt + cur.boff);
    PG8_STAGE_B(PG8_SB(0, 0), cB); PG8_STAGE_B(PG8_SB(0, 1), cB + hstepB); PG8_STAGE_A(PG8_SA(0, 0), 0, offAc, 0); PG8_STAGE_A(PG8_SA(0, 1), 0, offAc, 1);
    if (wr == 1) PG8_BAR;
    PG8_WAIT_V(2); PG8_BAR;
    PG8_STAGE_B(PG8_SB(1, 0), cB + kstep); PG8_STAGE_A(PG8_SA(1, 0), kstep, offAc, 0); PG8_STAGE_B(PG8_SB(1, 1), cB + hstepB + kstep);
    PG8_WAIT_V(6); PG8_BAR;
    for (;;) {
        const bool has_next = S.next(ui + 1, nxt);
        if (has_next) { PG8_MKOFF(nxt, offAn); }
        else { offAn_u = offAc_u;
#pragma unroll
            for (int h = 0; h < 2; ++h)
#pragma unroll
                for (int i = 0; i < 2; ++i) offAn_v[h][i] = offAc_v[h][i];
        }
        const char* nB = has_next ? (const char*)(g.Bt + nxt.boff) : cB;
        for (int t = 0; t < nt; t += 2) {
            const bool last = (t == nt - 2);
            const size_t a1k = (size_t)(t + 1) * kstep;
            const size_t a2k = last ? (size_t)0 : (size_t)(t + 2) * kstep; const char* b2 = last ? nB : cB + (size_t)(t + 2) * kstep;
            const size_t a3k = a2k + kstep; const char* b3 = b2 + kstep;
            unsigned o2_v[2][2]; const size_t o2_u = last ? offAn_u : offAc_u;
#pragma unroll
            for (int h = 0; h < 2; ++h)
#pragma unroll
                for (int i = 0; i < 2; ++i) o2_v[h][i] = last ? offAn_v[h][i] : offAc_v[h][i];
            PG8_LDB(B0, 0, 0); PG8_LDB(B1, 0, 1); PG8_SCHED; PG8_LDA(At, 0, 0); PG8_STAGE_A(PG8_SA(1, 1), a1k, offAc, 1);
            PG8_WAIT_V(8); PG8_WAIT_L(0); PG8_BAR; PG8_MMA(0, 0, At, B0); PG8_MMA(0, 1, At, B1); PG8_BAR; PG8_SCHED;
            PG8_LDA(At, 0, 1); PG8_STAGE_B(PG8_SB(0, 0), b2); PG8_STAGE_B(PG8_SB(0, 1), b2 + hstepB); PG8_STAGE_A(PG8_SA(0, 0), a2k, o2, 0);
            PG8_WAIT_V(8); PG8_WAIT_L(0); PG8_BAR; PG8_MMA(1, 0, At, B0); PG8_MMA(1, 1, At, B1); PG8_BAR; PG8_SCHED;
            PG8_LDB(B0, 1, 0); PG8_LDB(B1, 1, 1); PG8_SCHED; PG8_LDA(At, 1, 0); PG8_STAGE_A(PG8_SA(0, 1), a2k, o2, 1);
            PG8_WAIT_V(8); PG8_WAIT_L(0); PG8_BAR; PG8_MMA(0, 0, At, B0); PG8_MMA(0, 1, At, B1); PG8_BAR; PG8_SCHED;
            PG8_LDA(At, 1, 1); PG8_STAGE_B(PG8_SB(1, 0), b3); PG8_STAGE_B(PG8_SB(1, 1), b3 + hstepB); PG8_STAGE_A(PG8_SA(1, 0), a3k, o2, 0);
            PG8_WAIT_V(8); PG8_WAIT_L(0); PG8_BAR; PG8_MMA(1, 0, At, B0); PG8_MMA(1, 1, At, B1); PG8_BAR; PG8_SCHED;
        }
        if constexpr (ALIGN_EPI) { if (wr == 0) PG8_BAR; }
        if constexpr (FP8) asm volatile("s_nop 15\n\ts_nop 15\n\ts_nop 7" ::: "memory");
        E(acc, cur, wr, wc, fr, fq);
        if (!has_next) break;
#pragma unroll
        for (int a = 0; a < 2; ++a)
#pragma unroll
            for (int b = 0; b < 2; ++b)
#pragma unroll
                for (int m = 0; m < 4; ++m)
#pragma unroll
                    for (int n = 0; n < 2; ++n) acc[a][b][m][n] = (f32x4){0.f, 0.f, 0.f, 0.f};
        cur = nxt; cB = nB; ++ui; offAc_u = offAn_u;
#pragma unroll
        for (int h = 0; h < 2; ++h)
#pragma unroll
            for (int i = 0; i < 2; ++i) offAc_v[h][i] = offAn_v[h][i];
        if constexpr (ALIGN_EPI) { if (wr == 1) PG8_BAR; }
    }
    PG8_WAIT_V(0);
    if constexpr (!ALIGN_EPI) { if (wr == 0) PG8_BAR; }
    PG8_BAR;
#undef PG8_SA
#undef PG8_SB
#undef PG8_STAGE_A
#undef PG8_STAGE_B
#undef PG8_MKOFF
#undef PG8_LDA
#undef PG8_LDB
#undef PG8_MMA
#undef PG8_WAIT_V
#undef PG8_WAIT_L
#undef PG8_BAR
#undef PG8_SCHED
}
}
namespace attn_body {
using bf16=__hip_bfloat16;
using bf16x8=__attribute__((ext_vector_type(8)))short;
using s16x4=__attribute__((ext_vector_type(4)))short;
using f32x16=__attribute__((ext_vector_type(16)))float;
using u32x4=__attribute__((ext_vector_type(4)))unsigned;
constexpr int BATCH=2,SEQ=16384,D=64,DM=512;
constexpr int NW=8,QBLK=32,QB=QBLK*NW,KVBLK=64,NQB=SEQ/QB;
constexpr int ATTN_PITCH=DM, ATTN_UNIT_ROWS=QB;
__device__ __forceinline__ int crow(int r,int hi){return (r&3)+8*(r>>2)+4*hi;}
#define SBAR() __builtin_amdgcn_sched_barrier(0)
__device__ __forceinline__ void cmask(f32x16&p0,f32x16&p1,int jb,int qrel,int hi){
  const float NEG=-INFINITY; int kb=64*jb+4*hi;
  #pragma unroll
  for(int r=0;r<16;++r){int kv=kb+(r&3)+8*(r>>2); if(kv>qrel)p0[r]=NEG; if(kv+32>qrel)p1[r]=NEG;}
}

constexpr int NSLOT=3, SLOTB=8192;
constexpr int LDS_K=0, LDS_V=NSLOT*SLOTB, LDS_WS=2*NSLOT*SLOTB, LDS_OST=LDS_WS+NW*64*4, LDS_MK=LDS_OST+NW*4096, LDS_BYTES=LDS_MK+NW*1024, LDS_BYTES_WIDE=LDS_V+NSLOT*2*SLOTB+NW*64*4+NW*4096;
constexpr float C2=0.125f*1.4426950408889634f;
__device__ __forceinline__ void glds16(const void*gsrc,unsigned lds_dst){unsigned keep;
  asm volatile("s_mov_b32 %0, m0\n\ts_mov_b32 m0, %2\n\ts_nop 0\n\tglobal_load_lds_dwordx4 %1, off\n\ts_mov_b32 m0, %0":"=&s"(keep):"v"(gsrc),"s"(lds_dst):"memory");}
__device__ __forceinline__ float max3f(float a,float b,float c){float r;asm("v_max3_f32 %0, %1, %2, %3":"=v"(r):"v"(a),"v"(b),"v"(c));return r;}
__device__ __forceinline__ float max2f(float a,float b){float r;asm("v_max_f32_e32 %0, %1, %2":"=v"(r):"v"(a),"v"(b));return r;}
__device__ __forceinline__ float fadd_s(float a,float b){float r;asm("v_add_f32_e32 %0, %1, %2":"=v"(r):"v"(a),"v"(b));return r;}
__device__ __forceinline__ float fsub_s(float a,float b){float r;asm("v_sub_f32_e32 %0, %1, %2":"=v"(r):"v"(a),"v"(b));return r;}
typedef float f32x2_t __attribute__((ext_vector_type(2))); typedef __bf16 bf16x2_t __attribute__((ext_vector_type(2)));
__device__ __forceinline__ unsigned cvtpk_s(float lo,float hi){f32x2_t v={lo,hi};bf16x2_t b=__builtin_convertvector(v,bf16x2_t);return __builtin_bit_cast(unsigned,b);}
#define WAIT_BAR(N) asm volatile("s_waitcnt vmcnt(" #N ") lgkmcnt(0)\n\ts_barrier":::"memory")

__device__ __forceinline__ void qkt(f32x16&p0,f32x16&p1,const char*Kslot,const bf16x8*qr,const f32x16&ci0,const f32x16&ci1,int r32,int hi){
  const char*kb=Kslot+hi*1024+r32*16;
  #pragma unroll
  for(int d0=0;d0<4;++d0){
    const bf16x8 b0=*reinterpret_cast<const bf16x8*>(kb+d0*2048);
    const bf16x8 b1=*reinterpret_cast<const bf16x8*>(kb+d0*2048+512);
    if(d0==0){p0=__builtin_amdgcn_mfma_f32_32x32x16_bf16(b0,qr[0],ci0,0,0,0);p1=__builtin_amdgcn_mfma_f32_32x32x16_bf16(b1,qr[0],ci1,0,0,0);}
    else{p0=__builtin_amdgcn_mfma_f32_32x32x16_bf16(b0,qr[d0],p0,0,0,0);p1=__builtin_amdgcn_mfma_f32_32x32x16_bf16(b1,qr[d0],p1,0,0,0);}}
}
typedef __attribute__((address_space(3))) const char* lds_cptr;
typedef short v4i16_t __attribute__((ext_vector_type(4)));
__device__ __forceinline__ void kload8(bf16x8*kf,lds_cptr kp){
  kf[0]=*(const __attribute__((address_space(3))) bf16x8*)(kp);      kf[1]=*(const __attribute__((address_space(3))) bf16x8*)(kp+512);
  kf[2]=*(const __attribute__((address_space(3))) bf16x8*)(kp+2048); kf[3]=*(const __attribute__((address_space(3))) bf16x8*)(kp+2560);
  kf[4]=*(const __attribute__((address_space(3))) bf16x8*)(kp+4096); kf[5]=*(const __attribute__((address_space(3))) bf16x8*)(kp+4608);
  kf[6]=*(const __attribute__((address_space(3))) bf16x8*)(kp+6144); kf[7]=*(const __attribute__((address_space(3))) bf16x8*)(kp+6656);
}
__device__ __forceinline__ void kload2(bf16x8*kf,lds_cptr kp,int j){ kf[2*j]=*(const __attribute__((address_space(3))) bf16x8*)(kp+j*2048); kf[2*j+1]=*(const __attribute__((address_space(3))) bf16x8*)(kp+j*2048+512); }
__device__ __forceinline__ s16x4 vtr(lds_cptr p){ return __builtin_bit_cast(s16x4,__builtin_amdgcn_ds_read_tr16_b64_v4i16((__attribute__((address_space(3))) v4i16_t*)p)); }
__device__ __forceinline__ float rowmax(const f32x16&p0,const f32x16&p1){
  float a=max3f(p0[0],p0[1],p1[0]),b=max3f(p0[2],p0[3],p1[1]);a=max3f(a,p1[2],p1[3]);
  #pragma unroll
  for(int r=4;r<16;r+=4){a=max3f(a,p0[r],p0[r+1]);b=max3f(b,p0[r+2],p0[r+3]);a=max3f(a,p1[r],p1[r+1]);b=max3f(b,p1[r+2],p1[r+3]);}
  const float m=max2f(a,b);
  auto rr=__builtin_amdgcn_permlane32_swap(__float_as_uint(m),__float_as_uint(m),false,false);
  return max2f(__uint_as_float(rr[0]),__uint_as_float(rr[1]));
}
__device__ __forceinline__ void pv(f32x16*o,int vb,bf16x8 pa0,bf16x8 pa1,bf16x8 pa2,bf16x8 pa3){
  #pragma unroll
  for(int d0=0;d0<2;++d0){s16x4 lo[4],hi[4];
    #pragma unroll
    for(int ks=0;ks<4;++ks){
      asm volatile("ds_read_b64_tr_b16 %0,%1 offset:%c2":"=&v"(lo[ks]):"v"(vb),"i"(d0*4096+ks*1024):"memory");
      asm volatile("ds_read_b64_tr_b16 %0,%1 offset:%c2":"=&v"(hi[ks]):"v"(vb),"i"(d0*4096+ks*1024+512):"memory");}
    asm volatile("s_waitcnt lgkmcnt(0)":::"memory");SBAR();
    #define PK(k) (bf16x8){lo[k][0],lo[k][1],lo[k][2],lo[k][3],hi[k][0],hi[k][1],hi[k][2],hi[k][3]}
    o[d0]=__builtin_amdgcn_mfma_f32_32x32x16_bf16(pa0,PK(0),o[d0],0,0,0);
    o[d0]=__builtin_amdgcn_mfma_f32_32x32x16_bf16(pa1,PK(1),o[d0],0,0,0);
    o[d0]=__builtin_amdgcn_mfma_f32_32x32x16_bf16(pa2,PK(2),o[d0],0,0,0);
    o[d0]=__builtin_amdgcn_mfma_f32_32x32x16_bf16(pa3,PK(3),o[d0],0,0,0);
    #undef PK
  }
}

#ifndef ATTN_STORE16
#define ATTN_STORE16(p,v) (*(u32x4*)(p)=(v))
#endif
template<int THRL,bool MASKED,bool WIDE,bool NOMAX> __device__ __forceinline__ void attn_unit(int b,int hq,int hv,int qb,const bf16*Q,const bf16*__restrict__ K,const bf16*__restrict__ V,bf16*O,const unsigned long long*__restrict__ MK,char*shm,int wave_in,int badoff){
  const int tid=ltid(wave_in),lane=tid&63,r32=lane&31,hi=lane>>5; const int wid=__builtin_amdgcn_readfirstlane(tid>>6);
  const long rowbase=(long)b*SEQ; const int q0=qb*QB;
  const bf16*Qw=Q+(rowbase+q0+wid*QBLK)*DM+hq*D;
  const bf16*Kh=K+rowbase*DM+hq*D,*Vh=V+rowbase*DM+hv*D;
  constexpr int VSLOT=WIDE?2*SLOTB:SLOTB, L_WS=LDS_V+NSLOT*VSLOT, L_OST=L_WS+NW*64*4, L_MK=L_OST+NW*4096, L_TAB=L_MK+NW*2048;
  #define VS(sl) (WIDE?2*(sl):(sl))
  const unsigned lds0=(unsigned)(uintptr_t)shm;
  float*wsf=(float*)(shm+L_WS)+wid*64;
  const bf16*ksrc=Kh+(long)lane*DM+wid*8;
  const bf16*vsrc=Vh+(long)(16*(wid&3)+(lane>>2))*DM+(wid>>2)*32+(lane&3)*8;
  const unsigned kdst=lds0+LDS_K+wid*1024, vdst=lds0+LDS_V+wid*1024;
  #define DMA_K(t,slot) glds16(ksrc+(long)(t)*KVBLK*DM,(unsigned)__builtin_amdgcn_readfirstlane(kdst+(slot)))
  #define DMA_V(t,slot) do{ glds16(vsrc+(long)(t)*KVBLK*DM,(unsigned)__builtin_amdgcn_readfirstlane(vdst+VS(slot))); if(WIDE){ glds16(vsrc+64+(long)(t)*KVBLK*DM,(unsigned)__builtin_amdgcn_readfirstlane(vdst+VS(slot)+8192)); } }while(0)
  const long mq0=(long)q0+wid*QBLK+2*(lane&15); const unsigned mdst=lds0+L_MK+wid*2048;
  #define DMA_M4(t0) do{ if(MASKED){ const long t_=(long)(t0)+(lane>>4); if(t_<NT){ glds16(MK+(16384L*t_-32L*t_*(t_-1)+mq0-64L*t_),(unsigned)__builtin_amdgcn_readfirstlane(mdst+(((t0)&7)*256))); } } }while(0)
  unsigned mw0=0u,mw1=0u;
  #define MKRD(t) do{ if(MASKED){ const unsigned long long w_=*(const __attribute__((address_space(3))) unsigned long long*)(shm3+L_MK+wid*2048+(((t)&7)*256)+r32*8); mw0=(unsigned)w_; mw1=(unsigned)(w_>>32); } }while(0)
  #define MAND(X,r,MW) do{}while(0)
  bf16x8 aid[2];
  if(MASKED){
    #pragma unroll
    for(int ks=0;ks<2;++ks)
      #pragma unroll
      for(int j=0;j<8;++j) aid[ks][j]=(short)((r32==16*ks+8*hi+j)?0x3F80:0);
  }
  #define TABRD(w,ks) (*(const __attribute__((address_space(3))) bf16x8*)(shm3+L_TAB+((((w)>>(16*(ks)+8*hi))&0xffu)<<4)))
  #define BIAS(C0,C1,CI) do{ const bf16x8 f00_=TABRD(mw0,0),f01_=TABRD(mw0,1),f10_=TABRD(mw1,0),f11_=TABRD(mw1,1); \
    C0=__builtin_amdgcn_mfma_f32_32x32x16_bf16(aid[0],f00_,CI,0,0,0); C1=__builtin_amdgcn_mfma_f32_32x32x16_bf16(aid[0],f10_,CI,0,0,0); \
    C0=__builtin_amdgcn_mfma_f32_32x32x16_bf16(aid[1],f01_,C0,0,0,0); C1=__builtin_amdgcn_mfma_f32_32x32x16_bf16(aid[1],f11_,C1,0,0,0); }while(0)
  const int vb0=(int)(lds0+LDS_V)+((lane>>4)&1)*32+(lane&3)*8+(4*hi+((lane&15)>>2))*64;
  const char*Kbase=shm+LDS_K; bf16x8 kf[8];
  const lds_cptr shm3=(lds_cptr)shm; const lds_cptr kp0=shm3+LDS_K+hi*1024+r32*16; const lds_cptr vp0=shm3+LDS_V+((lane>>4)&1)*32+(lane&3)*8+(4*hi+((lane&15)>>2))*64;
  const int NT=(q0+QB)/KVBLK;
  DMA_M4(0);DMA_K(0,0);DMA_V(0,0);DMA_K(1,SLOTB);
  bf16x8 qr[4];
  #pragma unroll
  for(int d0=0;d0<4;++d0)qr[d0]=*reinterpret_cast<const bf16x8*>(&Qw[(long)r32*DM+d0*16+hi*8]);
  float mhat=0.f,l_reg=0.f;f32x16 o[4];o[0]=f32x16{};o[1]=f32x16{};o[2]=f32x16{};o[3]=f32x16{};f32x16 negm=f32x16{}; if(!WIDE&&!NOMAX){ asm volatile("":"+v"(negm)); }
  const int qrel=wid*QBLK+r32;
  #define CMASK(P0,P1,t) do{int jb_=(t)-(NT-4); if(jb_>=0)cmask(P0,P1,jb_,qrel,hi);}while(0)
  bool resc=false;
  #define START(P0,P1) do{ resc=false; \
    if constexpr(!NOMAX){ const float rm=rowmax(P0,P1); const float dl=rm; mhat=fadd_s(mhat,dl); \
      _Pragma("unroll") for(int r=0;r<16;++r){P0[r]=fsub_s(P0[r],dl);P1[r]=fsub_s(P1[r],dl);} \
      if(!WIDE){ _Pragma("unroll") for(int r=0;r<16;++r)negm[r]=-mhat; asm volatile("":"+v"(negm)); } } \
    _Pragma("unroll") for(int r=0;r<16;++r)P0[r]=__builtin_amdgcn_exp2f(P0[r]); }while(0)
  #define RESC() do{ if constexpr(!NOMAX) if(resc){ asm volatile("s_waitcnt lgkmcnt(0)":::"memory"); \
      _Pragma("unroll") for(int d_=0;d_<(WIDE?4:2);++d_) _Pragma("unroll") for(int r=0;r<16;++r)o[d_][r]*=wsf[crow(r,hi)]; } }while(0)
  f32x16 pA0,pA1,pB0,pB1;
  int sl_prev=0,sl_cur=0,sl_next=SLOTB;
  #define ROT() do{sl_prev=sl_cur;sl_cur=sl_next;sl_next=(sl_next==(NSLOT-1)*SLOTB)?0:sl_next+SLOTB;}while(0)
  DMA_K(2,2*SLOTB); const bool m4b_=MASKED&&(4<NT); if(m4b_){DMA_M4(4);}
  if(WIDE||m4b_){WAIT_BAR(4);}else{WAIT_BAR(3);}
  if(MASKED){ MKRD(0); BIAS(pA0,pA1,negm); qkt(pA0,pA1,Kbase,qr,pA0,pA1,r32,hi); } else { qkt(pA0,pA1,Kbase,qr,negm,negm,r32,hi); }
  asm volatile("s_nop 15\n\ts_nop 7":"+v"(pA0),"+v"(pA1));CMASK(pA0,pA1,0);
  START(pA0,pA1);
  _Pragma("unroll") for(int r=0;r<16;++r)pA1[r]=__builtin_amdgcn_exp2f(pA1[r]);
  WAIT_BAR(0);
  DMA_K(3,0);DMA_V(1,SLOTB);
  ROT();
  kload8(kf,kp0+sl_cur);
  if(WIDE){WAIT_BAR(3);}else{WAIT_BAR(2);}
  s16x4 vlo[8],vhi[8]; u32x4 pw0,pw1,pw2,pw3;
  #define PKW(P,B) cvtpk_s(P[B],P[B+1])
  #define PAF(k) __builtin_bit_cast(bf16x8,pw##k)
  #define VFR(i) (bf16x8){vlo[i][0],vlo[i][1],vlo[i][2],vlo[i][3],vhi[i][0],vhi[i][1],vhi[i][2],vhi[i][3]}
  #define PIN(x) asm volatile("":"+v"(x))
  #define MX3(a,b,c) __builtin_fmaxf(__builtin_fmaxf((a),(b)),(c))
  #define GAPA(MF,A0,A1,A2,A3,W0,W1,PW) do{ MF; sacc+=A0; sacc+=A1; sacc+=A2; sacc+=A3; PIN(sacc); W0; W1; PIN(PW); SBAR(); }while(0)
  #define EX(v) __builtin_amdgcn_exp2f(v)
  #define GAPB(MF,X,B,MW) do{ MF; X[B]=EX(X[B]); X[B+1]=EX(X[B+1]); X[B+2]=EX(X[B+2]); X[B+3]=EX(X[B+3]); MAND(X,B,MW); MAND(X,B+1,MW); MAND(X,B+2,MW); MAND(X,B+3,MW); PIN(X); SBAR(); }while(0)
  #define GAPB2(MF,X,B) do{ MF; X[B]=EX(X[B]); X[B+1]=EX(X[B+1]); PIN(X); SBAR(); }while(0)
  #define VRD(i) do{ vlo[i]=vtr(vp_+(((i)>>2)*4096+((i)&3)*1024)); vhi[i]=vtr(vp_+(((i)>>2)*4096+((i)&3)*1024+512)); }while(0)
  #define KRD(G,j) do{ if(G){ kload2(kf,kp0+sl_next,j); SBAR(); } }while(0)
  #define STEP(C0,C1,P0,P1,t,GK,GV,GL,GM) do{ SBAR(); \
    const lds_cptr vp_=vp0+VS(sl_prev); \
    if(MASKED){ MKRD(t); BIAS(C0,C1,negm); SBAR(); } \
    VRD(0); SBAR(); float sacc=(P0[0]+P0[1]); \
    GAPA(C0=__builtin_amdgcn_mfma_f32_32x32x16_bf16(kf[0],qr[0],(MASKED?C0:negm),0,0,0), P0[2],P0[3],P0[4],P0[5],     pw0[0]=PKW(P0,0), pw0[1]=PKW(P0,2), pw0); \
    VRD(4); SBAR(); GAPA(C1=__builtin_amdgcn_mfma_f32_32x32x16_bf16(kf[1],qr[0],(MASKED?C1:negm),0,0,0), P0[6],P0[7],P0[8],P0[9],     pw0[2]=PKW(P0,4), pw0[3]=PKW(P0,6), pw0); \
    VRD(1); SBAR(); GAPA(C0=__builtin_amdgcn_mfma_f32_32x32x16_bf16(kf[2],qr[1],C0,0,0,0),   P0[10],P0[11],P0[12],P0[13], pw1[0]=PKW(P0,8), pw1[1]=PKW(P0,10), pw1); \
    VRD(5); SBAR(); GAPA(C1=__builtin_amdgcn_mfma_f32_32x32x16_bf16(kf[3],qr[1],C1,0,0,0),   P0[14],P0[15],P1[0],P1[1],   pw1[2]=PKW(P0,12),pw1[3]=PKW(P0,14), pw1); \
    VRD(2); SBAR(); GAPA(C0=__builtin_amdgcn_mfma_f32_32x32x16_bf16(kf[4],qr[2],C0,0,0,0),   P1[2],P1[3],P1[4],P1[5],     pw2[0]=PKW(P1,0), pw2[1]=PKW(P1,2), pw2); \
    VRD(6); SBAR(); GAPA(C1=__builtin_amdgcn_mfma_f32_32x32x16_bf16(kf[5],qr[2],C1,0,0,0),   P1[6],P1[7],P1[8],P1[9],     pw2[2]=PKW(P1,4), pw2[3]=PKW(P1,6), pw2); \
    VRD(3); SBAR(); GAPA(C0=__builtin_amdgcn_mfma_f32_32x32x16_bf16(kf[6],qr[3],C0,0,0,0),   P1[10],P1[11],P1[12],P1[13], pw3[0]=PKW(P1,8), pw3[1]=PKW(P1,10), pw3); \
    VRD(7); SBAR(); GAPA(C1=__builtin_amdgcn_mfma_f32_32x32x16_bf16(kf[7],qr[3],C1,0,0,0),   P1[14],P1[15],0.f,0.f,       pw3[2]=PKW(P1,12),pw3[3]=PKW(P1,14), pw3); \
    l_reg+=sacc; \
    if(GK){DMA_K((t)+3,sl_cur);} if(GV){DMA_V((t)+1,sl_next);} if(MASKED&&GM){ if((((t)&3)==0)&&((t)+4<NT)){DMA_M4((t)+4);} } \
    CMASK(C0,C1,t); \
    if constexpr(!NOMAX){ float a=MX3(C0[0],C0[1],C1[0]),b=MX3(C0[2],C0[3],C1[1]); a=MX3(a,C1[2],C1[3]); \
      _Pragma("unroll") for(int r=4;r<16;r+=4){a=MX3(a,C0[r],C0[r+1]);b=MX3(b,C0[r+2],C0[r+3]);a=MX3(a,C1[r],C1[r+1]);b=MX3(b,C1[r+2],C1[r+3]);} \
      float rm=__builtin_fmaxf(a,b); { auto rr=__builtin_amdgcn_permlane32_swap(__float_as_uint(rm),__float_as_uint(rm),false,false); rm=__builtin_fmaxf(__uint_as_float(rr[0]),__uint_as_float(rr[1])); } \
      resc=false; \
      if(__builtin_expect(__any(rm>(float)THRL),0)){ const float dl=__builtin_fmaxf(rm,0.f); mhat+=dl; \
        _Pragma("unroll") for(int r=0;r<16;++r){C0[r]-=dl;C1[r]-=dl;} \
        _Pragma("unroll") for(int r=0;r<16;++r)negm[r]=-mhat; asm volatile("":"+v"(negm)); \
        const float f=__builtin_amdgcn_exp2f(-dl); l_reg*=f; if(hi==0)wsf[r32]=f; resc=true; } } \
    SBAR(); \
    GAPB(o[0]=__builtin_amdgcn_mfma_f32_32x32x16_bf16(PAF(0),VFR(0),o[0],0,0,0), C0,0,mw0); \
    GAPB(o[1]=__builtin_amdgcn_mfma_f32_32x32x16_bf16(PAF(0),VFR(4),o[1],0,0,0), C0,4,mw0); \
    KRD(GL,0); GAPB(o[0]=__builtin_amdgcn_mfma_f32_32x32x16_bf16(PAF(1),VFR(1),o[0],0,0,0), C0,8,mw0); \
    KRD(GL,1); GAPB(o[1]=__builtin_amdgcn_mfma_f32_32x32x16_bf16(PAF(1),VFR(5),o[1],0,0,0), C0,12,mw0); \
    KRD(GL,2); GAPB(o[0]=__builtin_amdgcn_mfma_f32_32x32x16_bf16(PAF(2),VFR(2),o[0],0,0,0), C1,0,mw1); \
    KRD(GL,3); GAPB(o[1]=__builtin_amdgcn_mfma_f32_32x32x16_bf16(PAF(2),VFR(6),o[1],0,0,0), C1,4,mw1); \
    GAPB(o[0]=__builtin_amdgcn_mfma_f32_32x32x16_bf16(PAF(3),VFR(3),o[0],0,0,0), C1,8,mw1); \
    GAPB(o[1]=__builtin_amdgcn_mfma_f32_32x32x16_bf16(PAF(3),VFR(7),o[1],0,0,0), C1,12,mw1); \
    }while(0)
  #define VLD(n,f) do{ vlo[(n)&3]=vtr(vp_+(((f)>>2)*4096+((f)&3)*1024)); vhi[(n)&3]=vtr(vp_+(((f)>>2)*4096+((f)&3)*1024+512)); }while(0)
  #define VFW(n) (bf16x8){vlo[(n)&3][0],vlo[(n)&3][1],vlo[(n)&3][2],vlo[(n)&3][3],vhi[(n)&3][0],vhi[(n)&3][1],vhi[(n)&3][2],vhi[(n)&3][3]}
  #define PVN(OD,k,n,fnext) do{ OD=__builtin_amdgcn_mfma_f32_32x32x16_bf16(PAF(k),VFW(n),OD,0,0,0); SBAR(); if((fnext)>=0){ VLD(n,fnext); SBAR(); } }while(0)
  #define STEPW(C0,C1,P0,P1,t,GK,GV,GL) do{ SBAR(); \
    const lds_cptr vp_=vp0+VS(sl_prev); \
    VLD(0,0); SBAR(); float sacc=(P0[0]+P0[1]); f32x16 ci_=f32x16{}; if constexpr(!NOMAX){ const float nm_=-mhat; _Pragma("unroll") for(int r=0;r<16;++r)ci_[r]=nm_; }     \
    GAPA(C0=__builtin_amdgcn_mfma_f32_32x32x16_bf16(kf[0],qr[0],ci_,0,0,0), P0[2],P0[3],P0[4],P0[5],     pw0[0]=PKW(P0,0), pw0[1]=PKW(P0,2), pw0); \
    VLD(1,4); SBAR(); GAPA(C1=__builtin_amdgcn_mfma_f32_32x32x16_bf16(kf[1],qr[0],ci_,0,0,0), P0[6],P0[7],P0[8],P0[9],     pw0[2]=PKW(P0,4), pw0[3]=PKW(P0,6), pw0); \
    VLD(2,1); SBAR(); GAPA(C0=__builtin_amdgcn_mfma_f32_32x32x16_bf16(kf[2],qr[1],C0,0,0,0),   P0[10],P0[11],P0[12],P0[13], pw1[0]=PKW(P0,8), pw1[1]=PKW(P0,10), pw1); \
    VLD(3,5); SBAR(); GAPA(C1=__builtin_amdgcn_mfma_f32_32x32x16_bf16(kf[3],qr[1],C1,0,0,0),   P0[14],P0[15],P1[0],P1[1],   pw1[2]=PKW(P0,12),pw1[3]=PKW(P0,14), pw1); \
    GAPA(C0=__builtin_amdgcn_mfma_f32_32x32x16_bf16(kf[4],qr[2],C0,0,0,0),   P1[2],P1[3],P1[4],P1[5],     pw2[0]=PKW(P1,0), pw2[1]=PKW(P1,2), pw2); \
    GAPA(C1=__builtin_amdgcn_mfma_f32_32x32x16_bf16(kf[5],qr[2],C1,0,0,0),   P1[6],P1[7],P1[8],P1[9],     pw2[2]=PKW(P1,4), pw2[3]=PKW(P1,6), pw2); \
    GAPA(C0=__builtin_amdgcn_mfma_f32_32x32x16_bf16(kf[6],qr[3],C0,0,0,0),   P1[10],P1[11],P1[12],P1[13], pw3[0]=PKW(P1,8), pw3[1]=PKW(P1,10), pw3); \
    GAPA(C1=__builtin_amdgcn_mfma_f32_32x32x16_bf16(kf[7],qr[3],C1,0,0,0),   P1[14],P1[15],0.f,0.f,       pw3[2]=PKW(P1,12),pw3[3]=PKW(P1,14), pw3); \
    l_reg+=sacc; \
    if(GK){DMA_K((t)+3,sl_cur);} if(GV){DMA_V((t)+1,sl_next);} \
    CMASK(C0,C1,t); \
    if constexpr(!NOMAX){ float a=MX3(C0[0],C0[1],C1[0]),b=MX3(C0[2],C0[3],C1[1]); a=MX3(a,C1[2],C1[3]); \
      _Pragma("unroll") for(int r=4;r<16;r+=4){a=MX3(a,C0[r],C0[r+1]);b=MX3(b,C0[r+2],C0[r+3]);a=MX3(a,C1[r],C1[r+1]);b=MX3(b,C1[r+2],C1[r+3]);} \
      float rm=__builtin_fmaxf(a,b); { auto rr=__builtin_amdgcn_permlane32_swap(__float_as_uint(rm),__float_as_uint(rm),false,false); rm=__builtin_fmaxf(__uint_as_float(rr[0]),__uint_as_float(rr[1])); } \
      resc=false; \
      if(__builtin_expect(__any(rm>(float)THRL),0)){ const float dl=__builtin_fmaxf(rm,0.f); mhat+=dl; \
        _Pragma("unroll") for(int r=0;r<16;++r){C0[r]-=dl;C1[r]-=dl;} \
        const float f=__builtin_amdgcn_exp2f(-dl); l_reg*=f; if(hi==0)wsf[r32]=f; resc=true; } } \
    SBAR(); \
    GAPB2(o[0]=__builtin_amdgcn_mfma_f32_32x32x16_bf16(PAF(0),VFW(0),o[0],0,0,0), C0,0); VLD(0,2); SBAR(); \
    GAPB2(o[1]=__builtin_amdgcn_mfma_f32_32x32x16_bf16(PAF(0),VFW(1),o[1],0,0,0), C0,2); VLD(1,6); SBAR(); \
    KRD(GL,0); GAPB2(o[0]=__builtin_amdgcn_mfma_f32_32x32x16_bf16(PAF(1),VFW(2),o[0],0,0,0), C0,4); VLD(2,3); SBAR(); \
    KRD(GL,1); GAPB2(o[1]=__builtin_amdgcn_mfma_f32_32x32x16_bf16(PAF(1),VFW(3),o[1],0,0,0), C0,6); VLD(3,7); SBAR(); \
    KRD(GL,2); GAPB2(o[0]=__builtin_amdgcn_mfma_f32_32x32x16_bf16(PAF(2),VFW(4),o[0],0,0,0), C0,8); VLD(4,8); SBAR(); \
    KRD(GL,3); GAPB2(o[1]=__builtin_amdgcn_mfma_f32_32x32x16_bf16(PAF(2),VFW(5),o[1],0,0,0), C0,10); VLD(5,12); SBAR(); \
    GAPB2(o[0]=__builtin_amdgcn_mfma_f32_32x32x16_bf16(PAF(3),VFW(6),o[0],0,0,0), C0,12); VLD(6,9); SBAR(); \
    GAPB2(o[1]=__builtin_amdgcn_mfma_f32_32x32x16_bf16(PAF(3),VFW(7),o[1],0,0,0), C0,14); VLD(7,13); SBAR(); \
    GAPB2(o[2]=__builtin_amdgcn_mfma_f32_32x32x16_bf16(PAF(0),VFW(8),o[2],0,0,0), C1,0); VLD(8,10); SBAR(); \
    GAPB2(o[3]=__builtin_amdgcn_mfma_f32_32x32x16_bf16(PAF(0),VFW(9),o[3],0,0,0), C1,2); VLD(9,14); SBAR(); \
    GAPB2(o[2]=__builtin_amdgcn_mfma_f32_32x32x16_bf16(PAF(1),VFW(10),o[2],0,0,0), C1,4); VLD(10,11); SBAR(); \
    GAPB2(o[3]=__builtin_amdgcn_mfma_f32_32x32x16_bf16(PAF(1),VFW(11),o[3],0,0,0), C1,6); VLD(11,15); SBAR(); \
    GAPB2(o[2]=__builtin_amdgcn_mfma_f32_32x32x16_bf16(PAF(2),VFW(12),o[2],0,0,0), C1,8); \
    GAPB2(o[3]=__builtin_amdgcn_mfma_f32_32x32x16_bf16(PAF(2),VFW(13),o[3],0,0,0), C1,10); \
    GAPB2(o[2]=__builtin_amdgcn_mfma_f32_32x32x16_bf16(PAF(3),VFW(14),o[2],0,0,0), C1,12); \
    GAPB2(o[3]=__builtin_amdgcn_mfma_f32_32x32x16_bf16(PAF(3),VFW(15),o[3],0,0,0), C1,14); \
    }while(0)
  #define STEPX(C0,C1,P0,P1,t,GK,GV,GL,GM) do{ if constexpr(WIDE){ STEPW(C0,C1,P0,P1,t,GK,GV,GL); } else { STEP(C0,C1,P0,P1,t,GK,GV,GL,GM); } }while(0)
  int t=1;
  #undef CMASK
  #define CMASK(P0,P1,t) do{}while(0)
  for(;t+5<NT;t+=2){
    STEPX(pB0,pB1,pA0,pA1,t,true,true,true,true);     if(WIDE){WAIT_BAR(3);}else{WAIT_BAR(2);} RESC(); ROT();
    STEPX(pA0,pA1,pB0,pB1,t+1,true,true,true,true);   if(WIDE||(MASKED&&(((t+1)&3)==0))){WAIT_BAR(3);}else{WAIT_BAR(2);} RESC(); ROT();
  }
  #undef CMASK
  #define CMASK(P0,P1,t) do{int jb_=(t)-(NT-4); if(jb_>=0)cmask(P0,P1,jb_,qrel,hi);}while(0)
  #define ENDW(tt) do{ if(WIDE){ if((tt)+3<NT){WAIT_BAR(3);} else if((tt)+2<NT){WAIT_BAR(2);} else {WAIT_BAR(0);} } else { if((tt)+3<NT){WAIT_BAR(2);} else if((tt)+2<NT){WAIT_BAR(1);} else {WAIT_BAR(0);} } }while(0)
  for(;t+1<NT;t+=2){
    STEPX(pB0,pB1,pA0,pA1,t,(t+3<NT),(t+1<NT),(t+1<NT),(t+2<NT));       ENDW(t);   RESC(); ROT();
    STEPX(pA0,pA1,pB0,pB1,t+1,(t+4<NT),(t+2<NT),(t+2<NT),(t+3<NT));     ENDW(t+1); RESC(); ROT();
  }
  STEPX(pB0,pB1,pA0,pA1,NT-1,false,false,false,false); RESC();
  { float sacc=pB0[0]+pB0[1]; _Pragma("unroll") for(int r=2;r<16;++r)sacc+=pB0[r]; _Pragma("unroll") for(int r=0;r<16;++r)sacc+=pB1[r]; l_reg+=sacc;
    pw0=(u32x4){PKW(pB0,0),PKW(pB0,2),PKW(pB0,4),PKW(pB0,6)};pw1=(u32x4){PKW(pB0,8),PKW(pB0,10),PKW(pB0,12),PKW(pB0,14)};pw2=(u32x4){PKW(pB1,0),PKW(pB1,2),PKW(pB1,4),PKW(pB1,6)};pw3=(u32x4){PKW(pB1,8),PKW(pB1,10),PKW(pB1,12),PKW(pB1,14)};
    SBAR(); pv(o,vb0+VS(sl_cur),PAF(0),PAF(1),PAF(2),PAF(3)); if(WIDE){ pv(o+2,vb0+VS(sl_cur)+8192,PAF(0),PAF(1),PAF(2),PAF(3)); } }
  #undef PKW
  #undef PAF
  #undef VFR
  #undef PIN
  #undef MX3
  #undef GAPA
  #undef GAPB
  #undef GAPB2
  #undef EX
  #undef VRD
  #undef KRD
  #undef VLD
  #undef VFW
  #undef PVN
  #undef STEPW
  #undef STEPX
  #undef STEP
  #undef ENDW
  {auto rr=__builtin_amdgcn_permlane32_swap(__float_as_uint(l_reg),__float_as_uint(l_reg),false,false);l_reg=__uint_as_float(rr[0])+__uint_as_float(rr[1]);}
  if constexpr(NOMAX){ if(!(l_reg>7.9e-31f&&l_reg<1.2e30f))*(__attribute__((address_space(3))) unsigned*)((__attribute__((address_space(3))) char*)shm+badoff)=1u; }
  if(hi==0)wsf[32+r32]=l_reg;asm volatile("s_waitcnt lgkmcnt(0)":::"memory");
  float rli[16];
  #pragma unroll
  for(int r=0;r<16;++r)rli[r]=__builtin_amdgcn_rcpf(wsf[32+crow(r,hi)]);
  bf16*Ow=O+(rowbase+q0+wid*QBLK)*DM+hv*D;
  #pragma unroll
  for(int hf=0;hf<(WIDE?2:1);++hf){ bf16*stg=(bf16*)(shm+L_OST)+wid*2048;
    #pragma unroll
    for(int r=0;r<16;++r){const int orow=crow(r,hi);
      #pragma unroll
      for(int d0=0;d0<2;++d0)stg[orow*64+d0*32+r32]=__float2bfloat16(o[2*hf+d0][r]*rli[r]);}
    asm volatile("s_waitcnt lgkmcnt(0)":::"memory");
    #pragma unroll
    for(int i=0;i<4;++i){const int row=i*8+(lane>>3),ch=lane&7; const u32x4 v=*(const u32x4*)(stg+row*64+ch*8); ATTN_STORE16(Ow+(long)row*DM+hf*64+ch*8,v);}
    asm volatile("s_waitcnt lgkmcnt(0)":::"memory"); }
  asm volatile("s_waitcnt lgkmcnt(0)\n\ts_barrier":::"memory");
  #undef DMA_K
  #undef DMA_V
  #undef DMA_M4
  #undef MKRD
  #undef MAND
  #undef TABRD
  #undef BIAS
  #undef CMASK
  #undef START
  #undef RESC
  #undef ROT
  #undef VS
}
constexpr int ATTN_LDS_BYTES=LDS_BYTES+NW*1024+4096;
__device__ __forceinline__ void mask_table_init(char*shm,int tid){
  if(tid<256){ u32x4 v; unsigned e[8];
    #pragma unroll
    for(int j=0;j<8;++j) e[j]=((tid>>j)&1)?0u:0xC400u;
    v.x=e[0]|(e[1]<<16); v.y=e[2]|(e[3]<<16); v.z=e[4]|(e[5]<<16); v.w=e[6]|(e[7]<<16);
    *(u32x4*)(shm+LDS_MK+NW*2048+tid*16)=v; }
  __syncthreads();
}
#undef SBAR
#undef WAIT_BAR
}

constexpr int NWAVES = 8;
#ifndef MK_PER_PHASE
#define MK_PER_PHASE 0
#endif

#ifndef CHK
#define CHK 0
#endif
constexpr int CW_CHK = 2;
constexpr int BATCH = 2, SEQ = 16384, NTOK = BATCH * SEQ, DMODEL = 1024, DEPTH = 2;
constexpr int WIN_OLD = 5704, WIN_NEW = 5888, P1_N = 3840;
constexpr float LN_EPS = 1e-5f, ALPHA = 1.41421356237f;
constexpr int NPH_LAYER = 12, NPHASE = DEPTH * NPH_LAYER;

constexpr size_t MiB = 1u << 20;
constexpr size_t WS_CTL = 0, CTL_ZERO_BYTES = 1 * MiB;
constexpr size_t WS_SMALL = 1 * MiB, SM_LAM = 0, SM_WR = 4096, SM_BR = SM_WR + 2 * 36 * 1024 * 4;
constexpr size_t WS_ROPE = 2 * MiB;
constexpr size_t WS_ROUTE = 4 * MiB, RT_E = 0, RT_C = 256 * 1024, RT_HIST = 512 * 1024, RT_TOT = 544 * 1024, RT_ROW = 576 * 1024, RT_ENT = 864 * 1024, RT_CW = 1152 * 1024;
constexpr int LIST_CAP = 65536 + 32 * 256;
constexpr size_t WS_WB = 6 * MiB;
constexpr size_t WB_WIN = 0, WB_WBD = (size_t)WIN_NEW * 1024 * 2, WB_WBS = WB_WBD + MiB, WB_WO = WB_WBS + MiB, WB_WPG = WB_WO + 2 * MiB, WB_WPLE = WB_WPG + 2 * MiB,
                 WB_WGU = WB_WPLE + MiB / 2, WB_WD = WB_WGU + 32 * MiB, WB_END = WB_WD + 16 * MiB;
static_assert(WB_END == 66 * MiB, "weight copies");
constexpr size_t WB_WG8 = WB_WIN + (size_t)3840 * 1024 * 2;
constexpr size_t WS_XB = 72 * MiB;
constexpr size_t WS_DQ = 136 * MiB, TSTRIDE = 32 * MiB, WS_IK = 360 * MiB, WS_IW = 364 * MiB;
constexpr size_t WS_O0 = 365 * MiB, WS_O1 = 397 * MiB, WS_YB = 429 * MiB, WS_MASK = 461 * MiB;
constexpr long MASK_BSTRIDE = 2105344;
constexpr size_t WS_YA = 136 * MiB, WS_MERGED = 168 * MiB, WS_TMPG = 240 * MiB, WS_PRE1 = 240 * MiB;
constexpr size_t OUT_XB8 = 0, OUT_X1B8 = 32 * MiB, OUT_T1 = 64 * MiB;
constexpr size_t WS_HG = 136 * MiB, WS_PLE = 172 * MiB, WS_Y0 = 368 * MiB, WS_Y1 = 432 * MiB, WS_PB = 496 * MiB, WS_END = 512 * MiB;
static_assert(WS_MASK + 2 * MASK_BSTRIDE * 8 <= WS_PB, "mask fits");
constexpr int CW_TMO = 0, CW_CODE = 1, CW_BAR = 4096, CW_QUEUE = 8192;

constexpr int RING_OFF = 0, RING_BYTES = 131072;
constexpr int XTR_OFF = RING_BYTES, XTR_BYTES = 4096;
constexpr int MISC_OFF = XTR_OFF + XTR_BYTES;
constexpr int LDS_BYTES = 147456;
static_assert(MISC_OFF + 128 <= LDS_BYTES, "LDS map");
#define GAS __attribute__((address_space(1)))
#define LAS __attribute__((address_space(3)))
typedef unsigned short bf16;
typedef unsigned v4u __attribute__((ext_vector_type(4)));
typedef float f32x4 __attribute__((ext_vector_type(4)));
typedef short bf16x8 __attribute__((ext_vector_type(8)));
typedef GAS unsigned gu32;
typedef GAS unsigned long long gu64;
#define RLX_AGENT __ATOMIC_RELAXED, __HIP_MEMORY_SCOPE_AGENT
#define LDS_WAIT() asm volatile("s_waitcnt lgkmcnt(0)" ::: "memory")
#define VM_WAIT() asm volatile("s_waitcnt vmcnt(0)" ::: "memory")
__device__ __forceinline__ unsigned long long rt() { return __builtin_amdgcn_s_memrealtime(); }
__device__ __forceinline__ unsigned f2bf(float f) { unsigned u = __builtin_bit_cast(unsigned, f); return (u + 0x7fffu + ((u >> 16) & 1u)) >> 16; }
__device__ __forceinline__ unsigned pk2(float lo, float hi) { return f2bf(lo) | (f2bf(hi) << 16); }

#define XB_TMO      128
#define XB_XCNT(j)  (256  + 64 * (j))
#define XB_XSUB(j)  (1280 + 64 * (j))
#define XB_XGEN(j)  (2304 + 64 * (j))
#define XB_TOP      3328
#define XB_TOPGEN   3392
#define XCD_BAR_WORDS 3456
#define XB_SPIN_CAP (1u << 18)

__device__ __forceinline__ unsigned xb_ld(unsigned* p)              { return __hip_atomic_load(p, __ATOMIC_RELAXED, __HIP_MEMORY_SCOPE_AGENT); }
__device__ __forceinline__ unsigned xb_add(unsigned* p, unsigned v) { return __hip_atomic_fetch_add(p, v, __ATOMIC_RELAXED, __HIP_MEMORY_SCOPE_AGENT); }
__device__ __forceinline__ unsigned xb_xcc_id() { return (unsigned)__builtin_amdgcn_s_getreg((3 << 11) | 20) & 0xFu; }
#define XB_SPIN(cond, bar) do { unsigned _sp = 0; while (cond) { __builtin_amdgcn_s_sleep(1); \
    if ((++_sp & 255u) == 0u) { if (xb_ld(&(bar)[XB_TMO])) break; if (_sp > XB_SPIN_CAP) { atomicAdd(&(bar)[XB_TMO], 1u); break; } } } } while (0)

struct XcdBarrier {
    unsigned* bar; unsigned x;
    volatile LAS unsigned* st;
};

__device__ __forceinline__ XcdBarrier xcd_barrier_post(unsigned* bar, volatile LAS unsigned* st) {
    XcdBarrier b; b.bar = bar; b.x = xb_xcc_id(); b.st = st;
    if (threadIdx.x == 0) (void)xb_add(&bar[XB_XCNT(b.x)], 1u);
    return b;
}
__device__ __forceinline__ void xcd_barrier_complete(unsigned* bar, unsigned x, unsigned& nloc, unsigned& nx) {
    const unsigned G = gridDim.x * gridDim.y * gridDim.z;
    unsigned sum, cnt, mine, sp = 0u;
    for (;;) {
        sum = 0u; cnt = 0u; mine = 0u;
#pragma unroll
        for (unsigned j = 0; j < 16; ++j) { const unsigned c = xb_ld(&bar[XB_XCNT(j)]); sum += c; cnt += (c > 0u) ? 1u : 0u; mine = (j == x) ? c : mine; }
        if (sum == G) break;
        __builtin_amdgcn_s_sleep(1);
        if ((++sp & 255u) == 0u) { if (xb_ld(&bar[XB_TMO])) break; if (sp > XB_SPIN_CAP) { atomicAdd(&bar[XB_TMO], 1u); break; } }
    }
    nloc = mine > 0u ? mine : 1u; nx = cnt > 0u ? cnt : 1u;
}

__device__ __forceinline__ void xcd_barrier(const XcdBarrier& b) {
    asm volatile("s_waitcnt vmcnt(0)" ::: "memory");
    __syncthreads();
    if (threadIdx.x == 0) {
        unsigned* bar = b.bar;
        __builtin_amdgcn_s_waitcnt(0);
        unsigned nloc = b.st[0], nx = b.st[1];
        if (nloc == 0u) { xcd_barrier_complete(bar, b.x, nloc, nx); b.st[0] = nloc; b.st[1] = nx; }
        const unsigned old = xb_add(&bar[XB_XSUB(b.x)], 1u);
        const unsigned gen = old / nloc;
        if (old + 1u == (gen + 1u) * nloc) {
            __builtin_amdgcn_fence(__ATOMIC_RELEASE, "agent");
            asm volatile("s_waitcnt vmcnt(0)" ::: "memory");
            const unsigned og = xb_add(&bar[XB_TOP], 1u);
            const unsigned tg = og / nx;
            if (og + 1u == (tg + 1u) * nx) xb_add(&bar[XB_TOPGEN], 1u);
            else XB_SPIN(xb_ld(&bar[XB_TOPGEN]) == tg, bar);
            __builtin_amdgcn_fence(__ATOMIC_ACQUIRE, "agent");
            xb_add(&bar[XB_XGEN(b.x)], 1u);
            asm volatile("s_waitcnt vmcnt(0)" ::: "memory");
        } else {
            XB_SPIN(xb_ld(&bar[XB_XGEN(b.x)]) == gen, bar);
            __builtin_amdgcn_fence(__ATOMIC_ACQUIRE, "agent");
            asm volatile("s_waitcnt vmcnt(0)" ::: "memory");
        }
    }
    __syncthreads();
}

#ifndef DBG
#define DBG 0
#endif
struct Args { const void* in[22]; float* out; unsigned char* ws; int ph_lo, ph_hi; };
struct Frame {
    LAS unsigned char* lds;
    volatile LAS unsigned* MISC;
    gu32* ctl;
    int tid, lane, wave;
    int vcu, G, bx;
    unsigned char* ws; unsigned char* ws0;
    float* out; float* out0;
    const Args* ap;
};
#define INP(k) (F.ap->in[(k)])
#define DPP_F(v, ctrl) __builtin_bit_cast(float, __builtin_amdgcn_update_dpp(0, __builtin_bit_cast(int, (v)), (ctrl), 0xf, 0xf, true))
__device__ __forceinline__ float row16_sum(float v) {
    v += DPP_F(v, 0xB1);
    v += DPP_F(v, 0x4E);
    v += DPP_F(v, 0x141);
    v += DPP_F(v, 0x140);
    return v;
}
__device__ __forceinline__ float wave_sum(float v) {
    v = row16_sum(v);
    { auto r = __builtin_amdgcn_permlane16_swap(__float_as_uint(v), __float_as_uint(v), false, false); v = __uint_as_float(r[0]) + __uint_as_float(r[1]); }
    { auto r = __builtin_amdgcn_permlane32_swap(__float_as_uint(v), __float_as_uint(v), false, false); v = __uint_as_float(r[0]) + __uint_as_float(r[1]); }
    return v;
}
typedef float f32x2 __attribute__((ext_vector_type(2)));

__device__ __forceinline__ void tr_item(const float* W, int ldn, int col0, int nvalid, bf16* WT, int K, int row0, LAS float* scr, int kb, int lane) {
    const int k0 = 64 * kb, n = lane & 31;
#pragma unroll 8
    for (int i = 0; i < 32; ++i) { const int kk = 2 * i + (lane >> 5); scr[kk * 33 + n] = (n < nvalid) ? W[(size_t)(k0 + kk) * ldn + col0 + n] : 0.f; }
    LDS_WAIT(); asm volatile("" ::: "memory");
    const int c = lane & 7;
#pragma unroll
    for (int j = 0; j < 4; ++j) { const int nn = (lane >> 3) + 8 * j; const LAS float* s = scr + (8 * c) * 33 + nn;
        v4u o; o.x = pk2(s[0 * 33], s[1 * 33]); o.y = pk2(s[2 * 33], s[3 * 33]); o.z = pk2(s[4 * 33], s[5 * 33]); o.w = pk2(s[6 * 33], s[7 * 33]);
        *(GAS v4u*)(WT + (size_t)(row0 + nn) * K + k0 + 8 * c) = o; }
    LDS_WAIT(); asm volatile("" ::: "memory");
}
__device__ __forceinline__ unsigned pk4_fp8(float a, float b, float c, float d) { int p = __builtin_amdgcn_cvt_pk_fp8_f32(a, b, 0, false); return (unsigned)__builtin_amdgcn_cvt_pk_fp8_f32(c, d, p, true); }
__device__ __forceinline__ void tr_item8(const float* W, int ldn, int col0, unsigned char* WT, int K, int row0, LAS float* scr, int kb, int lane) {
    const int k0 = 64 * kb, n = lane & 31;
#pragma unroll 8
    for (int i = 0; i < 32; ++i) { const int kk = 2 * i + (lane >> 5); scr[kk * 33 + n] = W[(size_t)(k0 + kk) * ldn + col0 + n] * 64.f; }
    LDS_WAIT(); asm volatile("" ::: "memory");
    const int c = lane & 7;
#pragma unroll
    for (int j = 0; j < 4; ++j) { const int nn = (lane >> 3) + 8 * j; const LAS float* s = scr + (8 * c) * 33 + nn;
        const unsigned long long o = (unsigned long long)pk4_fp8(s[0 * 33], s[1 * 33], s[2 * 33], s[3 * 33]) | ((unsigned long long)pk4_fp8(s[4 * 33], s[5 * 33], s[6 * 33], s[7 * 33]) << 32);
        *(GAS unsigned long long*)(WT + (size_t)(row0 + nn) * K + k0 + 8 * c) = o; }
    LDS_WAIT(); asm volatile("" ::: "memory");
}
__device__ __forceinline__ void pw_phase(Frame& F, int l) {
    LAS float* scr = (LAS float*)(F.lds + RING_OFF + F.wave * 16384);
    const int gw = F.vcu * NWAVES + F.wave, NGW = F.G * NWAVES, lane = F.lane;
    unsigned char* wb = F.ws + WS_WB;
    bf16* WIN = (bf16*)(wb + WB_WIN);
    const float* w_in = (const float*)INP(3) + (size_t)l * 1024 * WIN_OLD;
    constexpr int I_A = 16 * 114, I_B = 16, I_C = 16 * 64, I_BD = 8 * 32, I_O = 16 * 32, I_PLE = 4 * 32, I_GU = 32 * 4 * 64, I_D = 32 * 128;
    constexpr int NITEMS = I_A + I_B + I_C + 2 * I_BD + 2 * I_O + I_PLE + I_GU + I_D;
    for (int it = gw; it < NITEMS; it += NGW) {
        int r = it;
        if (r < I_A) { const int kb = r / 114, nb = r % 114; tr_item(w_in, WIN_OLD, 32 * nb, 32, WIN, 1024, 32 * nb, scr, kb, lane); continue; } r -= I_A;
        if (r < I_B) { tr_item(w_in, WIN_OLD, 3648, 8, WIN, 1024, 3648, scr, r, lane); continue; } r -= I_B;
        if (r < I_C) { const int kb = r / 64, nb = r % 64; tr_item8(w_in, WIN_OLD, 3656 + 32 * nb, wb + WB_WG8, 1024, 32 * nb, scr, kb, lane); continue; } r -= I_C;
        if (r < I_BD) { tr_item((const float*)INP(6) + (size_t)l * 512 * 1024, 1024, 32 * (r % 32), 32, (bf16*)(wb + WB_WBD), 512, 32 * (r % 32), scr, r / 32, lane); continue; } r -= I_BD;
        if (r < I_BD) { tr_item((const float*)INP(7) + (size_t)l * 512 * 1024, 1024, 32 * (r % 32), 32, (bf16*)(wb + WB_WBS), 512, 32 * (r % 32), scr, r / 32, lane); continue; } r -= I_BD;
        if (r < I_O) { tr_item((const float*)INP(8) + (size_t)l * 1024 * 1024, 1024, 32 * (r % 32), 32, (bf16*)(wb + WB_WO), 1024, 32 * (r % 32), scr, r / 32, lane); continue; } r -= I_O;
        if (r < I_O) { tr_item8((const float*)INP(19) + (size_t)l * 1024 * 1024, 1024, 32 * (r % 32), wb + WB_WPG, 1024, 32 * (r % 32), scr, r / 32, lane); continue; } r -= I_O;
        if (r < I_PLE) { tr_item((const float*)INP(18) + (size_t)l * 256 * 1024, 1024, 32 * (r % 32), 32, (bf16*)(wb + WB_WPLE), 256, 32 * (r % 32), scr, r / 32, lane); continue; } r -= I_PLE;
        if (r < I_GU) { const int e = r >> 8, sub = (r >> 6) & 3, q = r & 63, kb = q >> 2, nb = q & 3;
            const float* W = ((sub & 1) ? (const float*)INP(16) : (const float*)INP(15)) + (size_t)(l * 32 + e) * 1024 * 256;
            tr_item8(W, 256, (sub >> 1) * 128 + 32 * nb, wb + WB_WGU, 1024, e * 512 + sub * 128 + 32 * nb, scr, kb, lane); continue; } r -= I_GU;
        { const int e = r >> 7, q = r & 127, kb = q >> 5, nb = q & 31;
            tr_item((const float*)INP(17) + (size_t)(l * 32 + e) * 256 * 1024, 1024, 32 * nb, 32, (bf16*)(wb + WB_WD), 256, e * 1024 + 32 * nb, scr, kb, lane); }
    }
    { unsigned z_ = 0u; asm volatile("" : "+v"(z_));
      for (int ch = F.vcu * 512 + F.tid; ch < 160 * 128; ch += F.G * 512) *(GAS v4u*)(WIN + (size_t)3680 * 1024 + (size_t)ch * 8) = (v4u){z_, z_, z_, z_}; }
    const float* p = (const float*)INP(1) + (size_t)l * NTOK * 256; bf16* PB = (bf16*)(F.ws + WS_PB);
    for (int m0 = gw; m0 < NTOK; m0 += 4 * NGW) { f32x4 v[4];
#pragma unroll
        for (int j = 0; j < 4; ++j) { const int m = min(m0 + j * NGW, NTOK - 1); v[j] = *((const GAS f32x4*)(p + (size_t)m * 256) + lane); }
#pragma unroll
        for (int j = 0; j < 4; ++j) { const int m = m0 + j * NGW; if (m < NTOK) *((GAS unsigned long long*)(PB + (size_t)m * 256) + lane) = (unsigned long long)pk2(v[j].x, v[j].y) | ((unsigned long long)pk2(v[j].z, v[j].w) << 32); } }
    if (l == 0) {
        const float* x = (const float*)INP(0); bf16* XB = (bf16*)(F.ws + WS_XB);
        for (int m0 = gw; m0 < NTOK; m0 += 2 * NGW) { f32x4 v[2][4];
#pragma unroll
            for (int r = 0; r < 2; ++r) { const int m = min(m0 + r * NGW, NTOK - 1); const GAS f32x4* xr = (const GAS f32x4*)(x + (size_t)m * 1024) + lane;
#pragma unroll
                for (int j = 0; j < 4; ++j) v[r][j] = xr[64 * j]; }
#pragma unroll
            for (int r = 0; r < 2; ++r) { const int m = m0 + r * NGW; if (m < NTOK) { GAS unsigned long long* o8 = (GAS unsigned long long*)(XB + (size_t)m * 1024) + lane;
#pragma unroll
                for (int j = 0; j < 4; ++j) { const f32x4 w = v[r][j]; o8[64 * j] = (unsigned long long)pk2(w.x, w.y) | ((unsigned long long)pk2(w.z, w.w) << 32);
                    ((GAS unsigned*)((unsigned char*)F.out + OUT_XB8 + (size_t)m * 1024) + lane)[64 * j] = pk4_fp8(w.x, w.y, w.z, w.w); } } }
        }
        const int* pos = (const int*)INP(2); float* rope = (float*)(F.ws + WS_ROPE);
        for (int idx = F.vcu * 512 + F.tid; idx < NTOK * 8; idx += F.G * 512) {
            const int m = idx >> 3, j = idx & 7; const float invf = exp2f(-2.366446071f * (float)j); const float ang = (float)pos[m] * invf;
            double rev = (double)ang * 0.15915494309189535; rev -= rint(rev);
            rope[m * 16 + j] = (DBG & 16) ? 1.f : __builtin_amdgcn_cosf((float)rev); rope[m * 16 + 8 + j] = (DBG & 16) ? 0.f : __builtin_amdgcn_sinf((float)rev);
        }
        float* WR = (float*)(F.ws + WS_SMALL + SM_WR); float* BR = (float*)(F.ws + WS_SMALL + SM_BR);
        for (int idx = F.vcu * 512 + F.tid; idx < 2 * 36 * 1024; idx += F.G * 512) {
            const int ll = idx / (36 * 1024), r = idx % (36 * 1024), j = r >> 10, k = r & 1023;
            WR[idx] = (j < 4) ? ((const float*)INP(11))[((size_t)ll * 1024 + k) * 4 + j] : ((const float*)INP(13))[((size_t)ll * 1024 + k) * 32 + (j - 4)];
        }
        if (F.vcu == 0 && F.tid < 72) { const int ll = F.tid / 36, j = F.tid % 36; BR[F.tid] = (j < 4) ? ((const float*)INP(12))[ll * 4 + j] : ((const float*)INP(14))[ll * 32 + j - 4]; }
        if (F.vcu == 0 && F.tid < 2) { const float* lp = (const float*)INP(4) + F.tid * 256; float a = 0.f, b = 0.f;
            for (int i = 0; i < 64; ++i) { a += lp[i] * lp[64 + i]; b += lp[128 + i] * lp[192 + i]; }
            const float lam_init = (F.tid == 0) ? 0.2f : 0.35550907f;
            ((float*)(F.ws + WS_SMALL + SM_LAM))[F.tid] = __expf(a) - __expf(b) + lam_init; }
    }
}

namespace idxr {
typedef float f32x16 __attribute__((ext_vector_type(16)));
typedef short s16x2 __attribute__((ext_vector_type(2)));
typedef __fp16 h16x2 __attribute__((ext_vector_type(2)));
constexpr int HROW = 513;
__device__ __forceinline__ unsigned f2key(float f) { const unsigned u = __float_as_uint(f); return u ^ ((unsigned)((int)u >> 31) | 0x80000000u); }
__device__ __forceinline__ unsigned bins2(float a, float b) {
    const unsigned h = __builtin_bit_cast(unsigned, __builtin_amdgcn_cvt_pkrtz(a, b));
    const unsigned m = __builtin_bit_cast(unsigned, (s16x2)(__builtin_bit_cast(s16x2, h) >> (s16x2){15, 15}));
    const unsigned key = h ^ (m | 0x80008000u);
    return (key >> 5) & 0x07fc07fcu;
}
__device__ __forceinline__ float f16bits(unsigned h) { return (float)__builtin_bit_cast(__fp16, (unsigned short)h); }
__device__ __forceinline__ float bin_edge(int b) {
    if (b <= 0) return -__builtin_inff();
    if (b >= 512) return __builtin_inff();
    const unsigned K = (unsigned)b << 7;
    if (K >= 0x8000u) { const unsigned H = K & 0x7fffu; return (H >= 0x7c00u) ? __builtin_inff() : f16bits(H); }
    const unsigned M1 = ((0xFFFFu ^ K) & 0x7fffu) + 1u;
    const float v = (M1 >= 0x7c00u) ? __builtin_inff() : f16bits(M1);
    return -__uint_as_float(__float_as_uint(v) - 1u);
}
__device__ __forceinline__ long moff(int tl) { return 16384L * tl - 32L * tl * (tl - 1); }
__device__ __forceinline__ void load_k2(bf16x8 (&ka)[2], bf16x8 (&kb)[2], const unsigned short* IKb, int key0, int kg0, int fr, int fq) {
#pragma unroll
    for (int ks = 0; ks < 2; ++ks) { ka[ks] = *(const bf16x8*)(IKb + (size_t)(key0 + 16 * kg0 + fr) * 64 + ks * 32 + fq * 8); kb[ks] = *(const bf16x8*)(IKb + (size_t)(key0 + 16 * kg0 + 16 + fr) * 64 + ks * 32 + fq * 8); }
}
__device__ __forceinline__ void score_half(f32x4& sa, f32x4& sb, const bf16x8 (&qf)[8][2], const bf16x8 (&ql)[2], const float (&w)[8], bf16x8 (&ka)[2], bf16x8 (&kb)[2]) {
    sa = __builtin_amdgcn_mfma_f32_16x16x32_bf16(ka[0], ql[0], (f32x4){0.f, 0.f, 0.f, 0.f}, 0, 0, 0); sb = __builtin_amdgcn_mfma_f32_16x16x32_bf16(kb[0], ql[0], (f32x4){0.f, 0.f, 0.f, 0.f}, 0, 0, 0);
    sa = __builtin_amdgcn_mfma_f32_16x16x32_bf16(ka[1], ql[1], sa, 0, 0, 0); sb = __builtin_amdgcn_mfma_f32_16x16x32_bf16(kb[1], ql[1], sb, 0, 0, 0);
    f32x4 Da[2], Db[2];
#define IDX_M(h, D) do { \
        D[0] = __builtin_amdgcn_mfma_f32_16x16x32_bf16(ka[0], qf[h][0], (f32x4){0.f, 0.f, 0.f, 0.f}, 0, 0, 0); D[1] = __builtin_amdgcn_mfma_f32_16x16x32_bf16(kb[0], qf[h][0], (f32x4){0.f, 0.f, 0.f, 0.f}, 0, 0, 0); \
        D[0] = __builtin_amdgcn_mfma_f32_16x16x32_bf16(ka[1], qf[h][1], D[0], 0, 0, 0); D[1] = __builtin_amdgcn_mfma_f32_16x16x32_bf16(kb[1], qf[h][1], D[1], 0, 0, 0); } while (0)
#define IDX_F(h, D, O) asm volatile("" : "+v"(O[0]), "+v"(O[1]));     \
        asm volatile( \
        "v_fma_f32 %0, %8, |%9|, %0\n\tv_fma_f32 %1, %8, |%10|, %1\n\tv_fma_f32 %2, %8, |%11|, %2\n\tv_fma_f32 %3, %8, |%12|, %3\n\t" \
        "v_fma_f32 %4, %8, |%13|, %4\n\tv_fma_f32 %5, %8, |%14|, %5\n\tv_fma_f32 %6, %8, |%15|, %6\n\tv_fma_f32 %7, %8, |%16|, %7" \
        : "+v"(sa[0]), "+v"(sa[1]), "+v"(sa[2]), "+v"(sa[3]), "+v"(sb[0]), "+v"(sb[1]), "+v"(sb[2]), "+v"(sb[3]) \
        : "v"(w[h]), "v"(D[0][0]), "v"(D[0][1]), "v"(D[0][2]), "v"(D[0][3]), "v"(D[1][0]), "v"(D[1][1]), "v"(D[1][2]), "v"(D[1][3])); \
        asm volatile("" : "+v"(ka[0]), "+v"(kb[0]))
    IDX_M(0, Da); IDX_M(1, Db);
    asm volatile("s_nop 7" : "+v"(Da[0]), "+v"(Da[1]), "+v"(Db[0]), "+v"(Db[1]), "+v"(sa), "+v"(sb));
#pragma unroll
    for (int h = 0; h < 6; h += 2) { IDX_F(h, Da, Db); IDX_M(h + 2, Da); IDX_F(h + 1, Db, Da); IDX_M(h + 3, Db); }
    IDX_F(6, Da, Db); asm volatile("s_nop 7" : "+v"(Db[0]), "+v"(Db[1])); IDX_F(7, Db, Da);
#undef IDX_M
#undef IDX_F
}
#define IDX_SCORE(sc, kf, key0, more) do { const int nk_ = (more) ? (key0) + 128 : (key0); \
        idxr::score_half(sc[0], sc[1], qf, ql, w, kf[0], kf[1]); idxr::load_k2(kf[0], kf[1], IKb, nk_, 0, fr, fq); \
        idxr::score_half(sc[2], sc[3], qf, ql, w, kf[2], kf[3]); idxr::load_k2(kf[2], kf[3], IKb, nk_, 2, fr, fq); } while (0)
}

__device__ __forceinline__ void indexer_unit(Frame& F, int b, int qblk, const bf16* IQ, const bf16* IK, const float* IW, unsigned long long* mask64  ) {
    using namespace idxr;
    const int lane = F.lane, fr = lane & 15, fq = lane >> 4, wid = F.wave, qgrp = wid & 3, kh = wid >> 2;
    const int qloc = 16 * qgrp + fr, q = 64 * qblk + qloc;
    const size_t row = (size_t)b * SEQ + q;
    LAS unsigned* hist = (LAS unsigned*)(F.lds + RING_OFF);
    LAS int* bstarA = (LAS int*)(F.lds + XTR_OFF + 1024); LAS int* needA = bstarA + 64; LAS float* thiA = (LAS float*)(needA + 64); LAS float* tloA = thiA + 64;
    LAS unsigned* cand = (LAS unsigned*)(F.lds + RING_OFF);
    LAS unsigned* wcnt = (LAS unsigned*)(F.lds + XTR_OFF + 2048);
    bf16x8 qf[8][2], ql[2]; float w[8];
#pragma unroll
    for (int h = 0; h < 8; ++h)
#pragma unroll
        for (int ks = 0; ks < 2; ++ks) qf[h][ks] = *(const bf16x8*)(IQ + row * 512 + h * 64 + ks * 32 + fq * 8);
    { const f32x4* wp = (const f32x4*)(IW + row * 8); const f32x4 w0 = wp[0], w1 = wp[1]; w[0] = 0.5f * w0.x; w[1] = 0.5f * w0.y; w[2] = 0.5f * w0.z; w[3] = 0.5f * w0.w; w[4] = 0.5f * w1.x; w[5] = 0.5f * w1.y; w[6] = 0.5f * w1.z; w[7] = 0.5f * w1.w; }
#pragma unroll
    for (int ks = 0; ks < 2; ++ks) {
        float acc8[8];
#pragma unroll
        for (int e = 0; e < 8; ++e) acc8[e] = 0.f;
#pragma unroll
        for (int h = 0; h < 8; ++h)
#pragma unroll
            for (int e = 0; e < 8; ++e) acc8[e] = __builtin_fmaf(w[h], __uint_as_float((unsigned)(unsigned short)qf[h][ks][e] << 16), acc8[e]);
#pragma unroll
        for (int e = 0; e < 8; e += 2) { const unsigned pk = pg8::cvt_pk_bf16(acc8[e], acc8[e + 1]); ql[ks][e] = (short)(pk & 0xffffu); ql[ks][e + 1] = (short)(pk >> 16); }
    }
    for (int i = F.tid; i < 64 * HROW; i += NWAVES * 64) hist[i] = 0u;
    __syncthreads();
    const unsigned short* IKb = IK + (size_t)b * SEQ * 64;
    const int qmin_w = 64 * qblk + 16 * qgrp;
    const unsigned hrowb = (unsigned)(size_t)(hist + qloc * HROW);
#define IDX_HADD(off_) __hip_atomic_fetch_add((LAS unsigned*)(hrowb + (off_)), 1u, __ATOMIC_RELAXED, __HIP_MEMORY_SCOPE_WORKGROUP)
    {
        bf16x8 kf[4][2];
        if (kh <= qblk) { load_k2(kf[0], kf[1], IKb, 64 * kh, 0, fr, fq); load_k2(kf[2], kf[3], IKb, 64 * kh, 2, fr, fq); }
#pragma unroll 1
        for (int tl = kh; tl <= qblk; tl += 2) {
            const int key0 = 64 * tl; f32x4 sc[4]; IDX_SCORE(sc, kf, key0, tl + 2 <= qblk);
            if (key0 + 63 <= qmin_w) {
#pragma unroll
                for (int kg = 0; kg < 4; ++kg) { const unsigned p0 = bins2(sc[kg][0], sc[kg][1]), p1 = bins2(sc[kg][2], sc[kg][3]);
                    IDX_HADD(p0 & 0xffffu); IDX_HADD(p0 >> 16); IDX_HADD(p1 & 0xffffu); IDX_HADD(p1 >> 16); __builtin_amdgcn_sched_barrier(0); }
            } else {
                int fq_ = fq, q_ = q; asm volatile("" : "+v"(fq_), "+v"(q_));
#pragma unroll
                for (int kg = 0; kg < 4; ++kg) { const unsigned p0 = bins2(sc[kg][0], sc[kg][1]), p1 = bins2(sc[kg][2], sc[kg][3]); const int kb = key0 + 16 * kg + 4 * fq_;
                    if (kb <= q_) IDX_HADD(p0 & 0xffffu); if (kb + 1 <= q_) IDX_HADD(p0 >> 16); if (kb + 2 <= q_) IDX_HADD(p1 & 0xffffu); if (kb + 3 <= q_) IDX_HADD(p1 >> 16); __builtin_amdgcn_sched_barrier(0); }
            }
        }
    }
#undef IDX_HADD
    __syncthreads();
#pragma unroll 1
    for (int qq = wid * 8; qq < wid * 8 + 8; ++qq) {
        const LAS unsigned* hr = hist + qq * HROW + lane * 8;
        unsigned wv[8]; unsigned s = 0;
#pragma unroll
        for (int k = 0; k < 8; ++k) { wv[k] = hr[k]; s += wv[k]; }
        unsigned v = s;
#pragma unroll
        for (int off = 1; off < 64; off <<= 1) { const unsigned t = __shfl_down(v, off); if (lane + off < 64) v += t; }
        const unsigned above = v - s, total = __shfl(v, 0);
        if (total > 256u) {
            if (above < 256u && v >= 256u) {
                unsigned c = above; int found = -1, need = 0;
#pragma unroll
                for (int k = 7; k >= 0; --k) { if (found < 0) { if (c + wv[k] >= 256u) { found = k; need = 256 - (int)c; } else c += wv[k]; } }
                bstarA[qq] = lane * 8 + found; needA[qq] = need; thiA[qq] = bin_edge(lane * 8 + found + 1); tloA[qq] = bin_edge(lane * 8 + found);
            }
        } else if (lane == 0) { bstarA[qq] = -1; needA[qq] = 0; thiA[qq] = -__builtin_inff(); tloA[qq] = -__builtin_inff(); }
    }
    __syncthreads();
    const float thi = thiA[qloc], tlo = tloA[qloc];
    unsigned ncand = 0u; LAS unsigned* const cbase = cand + (qloc * 8 + fq + 4 * kh) * 64;
#define IDX_EL(scv_, krel_) do { const float v_ = (scv_); \
        if (FULL_) { asm volatile("v_cmp_ge_f32 vcc, %2, %3\n\tv_addc_co_u32 %0, vcc, %0, %0, vcc\n\tv_cmp_ge_f32 vcc, %2, %4\n\tv_addc_co_u32 %1, vcc, %1, %1, vcc" : "+v"(nh_), "+v"(nl_) : "v"(v_), "v"(thi), "v"(tlo) : "vcc"); } \
        else { const bool ok_ = key0 + (krel_) <= q_; nh_ = nh_ + nh_ + ((ok_ && v_ >= thi) ? 1u : 0u); nl_ = nl_ + nl_ + ((ok_ && v_ >= tlo) ? 1u : 0u); } } while (0)
#define IDX_HALF(ka, kb, W_, C_) do { unsigned nh_ = 0u, nl_ = 0u; const int kr = 4 * fq_; \
        IDX_EL(sc[kb][3], 16 * kb + kr + 3); IDX_EL(sc[kb][2], 16 * kb + kr + 2); IDX_EL(sc[kb][1], 16 * kb + kr + 1); IDX_EL(sc[kb][0], 16 * kb + kr); nh_ <<= 12; nl_ <<= 12; \
        IDX_EL(sc[ka][3], 16 * ka + kr + 3); IDX_EL(sc[ka][2], 16 * ka + kr + 2); IDX_EL(sc[ka][1], 16 * ka + kr + 1); IDX_EL(sc[ka][0], 16 * ka + kr); \
        W_ = nh_ << kr; C_ = nl_ & ~nh_; __builtin_amdgcn_sched_barrier(0); } while (0)
#define IDX_ELS() do { IDX_HALF(0, 1, wlo, clo); IDX_HALF(2, 3, whi, chi); } while (0)
    {
        bf16x8 kf[4][2];
        if (kh <= qblk) { load_k2(kf[0], kf[1], IKb, 64 * kh, 0, fr, fq); load_k2(kf[2], kf[3], IKb, 64 * kh, 2, fr, fq); }
#pragma unroll 1
        for (int tl = kh; tl <= qblk; tl += 2) {
            const int key0 = 64 * tl; unsigned long long* mword = mask64 + (moff(tl) + (q - key0)); f32x4 sc[4]; IDX_SCORE(sc, kf, key0, tl + 2 <= qblk);
            unsigned wlo = 0u, whi = 0u, clo = 0u, chi = 0u; int fq_ = fq, q_ = q; asm volatile("" : "+v"(fq_), "+v"(q_));
            if (key0 + 63 <= qmin_w) {
#define FULL_ true
                IDX_ELS();
#undef FULL_
            } else {
#define FULL_ false
                IDX_ELS();
#undef FULL_
            }
            unsigned cb = clo | (chi << 4);
            if (cb != 0u) {
#pragma unroll 1
                while (cb != 0u) {
                    const int j = __builtin_ctz(cb); cb &= cb - 1u;
                    const bool b0 = (j & 1) != 0, b1 = (j & 2) != 0, b2 = (j & 4) != 0, b4 = (j & 16) != 0;
                    float y[4];
#pragma unroll
                    for (int kg = 0; kg < 4; ++kg) { const float x0 = b0 ? sc[kg][1] : sc[kg][0], x1 = b0 ? sc[kg][3] : sc[kg][2]; y[kg] = b1 ? x1 : x0; }
                    const float z0 = b4 ? y[1] : y[0], z1 = b4 ? y[3] : y[2]; const float v_ = b2 ? z1 : z0;
                    const int krel = 16 * ((b4 ? 1 : 0) + (b2 ? 2 : 0)) + 4 * fq_ + (j & 3);
                    if (ncand < 64u) cbase[ncand] = ((f2key(v_) & 0xffff8u) << 11) | (unsigned)(16383 - (key0 + krel)); ++ncand;
                }
            }
            { auto r_ = __builtin_amdgcn_permlane16_swap(wlo, wlo, false, false); wlo = r_[0] | r_[1]; r_ = __builtin_amdgcn_permlane16_swap(whi, whi, false, false); whi = r_[0] | r_[1];
              r_ = __builtin_amdgcn_permlane32_swap(wlo, wlo, false, false); wlo = r_[0] | r_[1]; r_ = __builtin_amdgcn_permlane32_swap(whi, whi, false, false); whi = r_[0] | r_[1]; }
            if (fq == 0) *mword = ((unsigned long long)whi << 32) | wlo;
        }
    }
#undef IDX_EL
#undef IDX_HALF
#undef IDX_ELS
    wcnt[qloc * 8 + fq + 4 * kh] = ncand < 64u ? ncand : 64u;
    VM_WAIT();
    __syncthreads();
#pragma unroll 1
    for (int qq = wid * 8; qq < wid * 8 + 8; ++qq) {
        const int need = needA[qq];
        if (need == 0) continue;
        unsigned e[8];
#pragma unroll
        for (int j = 0; j < 8; ++j) { const unsigned c = wcnt[qq * 8 + j]; e[j] = ((unsigned)lane < c) ? (cand[(qq * 8 + j) * 64 + lane] | 0x80000000u) : 0u; }
        unsigned T = 0x80000000u; int cntT = 0;
#pragma unroll
        for (int j = 0; j < 8; ++j) cntT += __builtin_popcountll(__ballot(e[j] >= T));
#pragma unroll 1
        for (int bit = 30; bit >= 0 && cntT != need; --bit) { const unsigned c = T | (1u << bit); int cnt = 0;
#pragma unroll
            for (int j = 0; j < 8; ++j) cnt += __builtin_popcountll(__ballot(e[j] >= c));
            if (cnt >= need) { T = c; cntT = cnt; } }
        const int qglob = 64 * qblk + qq;
#pragma unroll
        for (int j = 0; j < 8; ++j) if (e[j] >= T) { const int kidx = 16383 - (int)(e[j] & 0x3fffu); const int tl = kidx >> 6;
            __hip_atomic_fetch_or(mask64 + (moff(tl) + (qglob - 64 * tl)), 1ull << (kidx & 63), __ATOMIC_RELAXED, __HIP_MEMORY_SCOPE_AGENT); }
    }
    __syncthreads();
}

__device__ __forceinline__ void ya_phase(Frame& F, int l) {
    const int gw = F.vcu * NWAVES + F.wave, NGW = F.G * NWAVES, lane = F.lane;
    const bf16* O0 = (const bf16*)(F.ws + WS_O0); const bf16* O1 = (const bf16*)(F.ws + WS_O1); bf16* YA = (bf16*)(F.ws + WS_YA);
    const float lam = (DBG & 8) ? 0.f : ((const float*)(F.ws + WS_SMALL + SM_LAM))[l];
    const float lam_init = (l == 0) ? 0.2f : 0.35550907f;
    const float* gp = (const float*)INP(5) + l * 128 + (lane & 15) * 8;
    float gg[8];
#pragma unroll
    for (int i = 0; i < 8; ++i) gg[i] = gp[i] * (1.f - lam_init);
    for (int m0 = gw; m0 < NTOK; m0 += 4 * NGW) { v4u a4[4], c4[4];
#pragma unroll
      for (int j = 0; j < 4; ++j) { const int m = min(m0 + j * NGW, NTOK - 1); a4[j] = *(const GAS v4u*)(O0 + (size_t)m * 512 + lane * 8); c4[j] = *(const GAS v4u*)(O1 + (size_t)m * 512 + lane * 8); }
#pragma unroll
      for (int j = 0; j < 4; ++j) { const int m = m0 + j * NGW; if (m >= NTOK) break; const v4u a = a4[j], c = c4[j];
        f32x4 a0, a1, c0, c1; pg8::unpack8(a, a0, a1); pg8::unpack8(c, c0, c1);
        f32x4 d0 = a0 - c0 * lam, d1 = a1 - c1 * lam;
        float ss = (d0.x * d0.x + d0.y * d0.y) + (d0.z * d0.z + d0.w * d0.w) + (d1.x * d1.x + d1.y * d1.y) + (d1.z * d1.z + d1.w * d1.w);
        ss = row16_sum(ss);
        const float rs = 1.0f / sqrtf(ss * (1.0f / 128.0f) + LN_EPS);
        f32x4 o0 = {d0.x * rs * gg[0], d0.y * rs * gg[1], d0.z * rs * gg[2], d0.w * rs * gg[3]}, o1 = {d1.x * rs * gg[4], d1.y * rs * gg[5], d1.z * rs * gg[6], d1.w * rs * gg[7]};
        *(GAS v4u*)(YA + (size_t)m * 512 + lane * 8) = pg8::pack8(o0, o1);
      }
    }
}

__device__ __forceinline__ void ya_unit(Frame& F, int l, int b, int h, int qb) {
    const int lane = F.lane;
    const bf16* O0 = (const bf16*)(F.ws + WS_O0); const bf16* O1 = (const bf16*)(F.ws + WS_O1); bf16* YA = (bf16*)(F.ws + WS_YA);
    const float lam = (DBG & 8) ? 0.f : ((const float*)(F.ws + WS_SMALL + SM_LAM))[l];
    const float lam_init = (l == 0) ? 0.2f : 0.35550907f;
    const float* gp = (const float*)INP(5) + l * 128 + (lane & 15) * 8;
    float gg[8];
#pragma unroll
    for (int i = 0; i < 8; ++i) gg[i] = gp[i] * (1.f - lam_init);
    const size_t e0 = ((size_t)b * SEQ + (size_t)qb * 256 + F.wave * 4 + (lane >> 4)) * 512 + h * 128 + (lane & 15) * 8;
    v4u a8[8], c8[8];
#pragma unroll
    for (int it = 0; it < 8; ++it) { a8[it] = *(const GAS v4u*)(O0 + e0 + (size_t)it * 32 * 512); c8[it] = *(const GAS v4u*)(O1 + e0 + (size_t)it * 32 * 512); }
#pragma unroll
    for (int it = 0; it < 8; ++it) {
        f32x4 a0, a1, c0, c1; pg8::unpack8(a8[it], a0, a1); pg8::unpack8(c8[it], c0, c1);
        f32x4 d0 = a0 - c0 * lam, d1 = a1 - c1 * lam;
        float ss = (d0.x * d0.x + d0.y * d0.y) + (d0.z * d0.z + d0.w * d0.w) + (d1.x * d1.x + d1.y * d1.y) + (d1.z * d1.z + d1.w * d1.w);
        ss = row16_sum(ss);
        const float rs = 1.0f / sqrtf(ss * (1.0f / 128.0f) + LN_EPS);
        f32x4 o0 = {d0.x * rs * gg[0], d0.y * rs * gg[1], d0.z * rs * gg[2], d0.w * rs * gg[3]}, o1 = {d1.x * rs * gg[4], d1.y * rs * gg[5], d1.z * rs * gg[6], d1.w * rs * gg[7]};
        *(GAS v4u*)(YA + e0 + (size_t)it * 32 * 512) = pg8::pack8(o0, o1);
    }
}

__device__ __forceinline__ void ln_row(f32x4 (&v)[4], const float* g, const float* bb, int lane) {
    float s = 0.f;
#pragma unroll
    for (int j = 0; j < 4; ++j) s += (v[j].x + v[j].y) + (v[j].z + v[j].w);
    const float mean = wave_sum(s) * (1.f / 1024.f); float s2 = 0.f;
#pragma unroll
    for (int j = 0; j < 4; ++j) { v[j] = v[j] - mean; s2 += (v[j].x * v[j].x + v[j].y * v[j].y) + (v[j].z * v[j].z + v[j].w * v[j].w); }
    const float rstd = 1.f / sqrtf(wave_sum(s2) * (1.f / 1024.f) + LN_EPS);
#pragma unroll
    for (int j = 0; j < 4; ++j) { const f32x4 gv = *((const f32x4*)g + lane + 64 * j), bv = *((const f32x4*)bb + lane + 64 * j); v[j] = v[j] * rstd * gv + bv; }
}

__device__ __forceinline__ void ln1_router_phase(Frame& F, int l) {
    const int gw = F.vcu * NWAVES + F.wave, NGW = F.G * NWAVES, lane = F.lane;
    const bf16* PRE = (const bf16*)(F.ws + WS_PRE1); bf16* X1B = (bf16*)(F.ws + WS_XB);
    const float* g1 = (const float*)INP(9) + l * 1024; const float* b1 = (const float*)INP(10) + l * 1024;
    const float* WR = (const float*)(F.ws + WS_SMALL + SM_WR) + (size_t)l * 36 * 1024; const float* BR = (const float*)(F.ws + WS_SMALL + SM_BR) + l * 36;
    int* route_e = (int*)(F.ws + WS_ROUTE + RT_E); float* route_c = (float*)(F.ws + WS_ROUTE + RT_C);
    LAS unsigned* rhist = (LAS unsigned*)(F.lds + XTR_OFF + 1536);
    if (F.tid < 32) rhist[F.tid] = 0u;
    LAS f32x4* wlds = (LAS f32x4*)(F.lds + RING_OFF); LAS float* blds = (LAS float*)(F.lds + XTR_OFF + 1024);
    { const GAS f32x4* src = (const GAS f32x4*)(WR + 4 * 1024);
#pragma unroll
      for (int i = 0; i < 16; ++i) wlds[F.tid + 512 * i] = src[F.tid + 512 * i];
      if (F.tid < 32) blds[F.tid] = BR[4 + F.tid]; }
    f32x4 wg[4][4]; float bg[4];
#pragma unroll
    for (int j = 0; j < 4; ++j) { bg[j] = BR[j];
#pragma unroll
        for (int c = 0; c < 4; ++c) wg[j][c] = ((const GAS f32x4*)(WR + j * 1024))[lane + 64 * c]; }
    __syncthreads();
    unsigned long long nx[4];
    { const GAS unsigned long long* pr = (const GAS unsigned long long*)(PRE + (size_t)min(gw, NTOK - 1) * 1024) + lane;
#pragma unroll
      for (int j = 0; j < 4; ++j) nx[j] = pr[64 * j]; }
    for (int m = gw; m < NTOK; m += NGW) {
        unsigned long long cu[4];
#pragma unroll
        for (int j = 0; j < 4; ++j) cu[j] = nx[j];
        { const GAS unsigned long long* pr = (const GAS unsigned long long*)(PRE + (size_t)min(m + NGW, NTOK - 1) * 1024) + lane;
#pragma unroll
          for (int j = 0; j < 4; ++j) nx[j] = pr[64 * j]; }
        f32x4 v[4];
#pragma unroll
        for (int j = 0; j < 4; ++j) { const unsigned long long a = cu[j]; const unsigned a0 = (unsigned)a, a1 = (unsigned)(a >> 32); v[j] = (f32x4){pg8::bf_lo(a0), pg8::bf_hi(a0), pg8::bf_lo(a1), pg8::bf_hi(a1)}; }
        ln_row(v, g1, b1, lane);
        GAS unsigned long long* o8 = (GAS unsigned long long*)(X1B + (size_t)m * 1024) + lane;
#pragma unroll
        for (int j = 0; j < 4; ++j) { o8[64 * j] = (unsigned long long)pk2(v[j].x, v[j].y) | ((unsigned long long)pk2(v[j].z, v[j].w) << 32);
            ((GAS unsigned*)((unsigned char*)F.out + OUT_X1B8 + (size_t)m * 1024) + lane)[64 * j] = pk4_fp8(v[j].x, v[j].y, v[j].z, v[j].w); }
        float lg[4];
#pragma unroll
        for (int j = 0; j < 4; ++j) { float s_ = 0.f;
#pragma unroll
            for (int c = 0; c < 4; ++c) s_ += (v[c].x * wg[j][c].x + v[c].y * wg[j][c].y) + (v[c].z * wg[j][c].z + v[c].w * wg[j][c].w);
            lg[j] = wave_sum(s_) + bg[j]; }
        int gi = 0; float gm = lg[0];
#pragma unroll
        for (int i = 1; i < 4; ++i) if (lg[i] > gm) { gm = lg[i]; gi = i; }
        float gs = 0.f;
#pragma unroll
        for (int i = 0; i < 4; ++i) gs += __expf(lg[i] - gm);
        const float gval = 1.f / gs;
        gi = __builtin_amdgcn_readfirstlane(gi);
        float el[8];
        { const LAS f32x4* wrow = wlds + gi * 8 * 256 + lane; float part[8];
#pragma unroll
          for (int k = 0; k < 8; ++k) { float s_ = 0.f;
#pragma unroll
              for (int c = 0; c < 4; ++c) { const f32x4 w4 = wrow[k * 256 + 64 * c]; s_ += (v[c].x * w4.x + v[c].y * w4.y) + (v[c].z * w4.z + v[c].w * w4.w); }
              part[k] = s_; }
#pragma unroll
          for (int k = 0; k < 8; ++k) el[k] = wave_sum(part[k]) + blds[gi * 8 + k]; }
        int i0 = 0; float m0 = el[0];
#pragma unroll
        for (int k = 1; k < 8; ++k) if (el[k] > m0) { m0 = el[k]; i0 = k; }
        int i1 = -1; float m1 = -INFINITY;
#pragma unroll
        for (int k = 0; k < 8; ++k) if (k != i0 && el[k] > m1) { m1 = el[k]; i1 = k; }
        const float c0 = gval / (1.f + __expf(m1 - m0)), c1 = gval - c0;
        if (lane == 0) {
            const int e0 = gi * 8 + i0, e1 = gi * 8 + i1;
            route_e[m * 2] = e0; route_e[m * 2 + 1] = e1; route_c[m * 2] = c0; route_c[m * 2 + 1] = c1;
            __hip_atomic_fetch_add(rhist + e0, 1u, __ATOMIC_RELAXED, __HIP_MEMORY_SCOPE_WORKGROUP); __hip_atomic_fetch_add(rhist + e1, 1u, __ATOMIC_RELAXED, __HIP_MEMORY_SCOPE_WORKGROUP);
        }
    }
    __syncthreads();
    if (F.tid < 32) ((int*)(F.ws + WS_ROUTE + RT_HIST))[F.vcu * 32 + F.tid] = (int)rhist[F.tid];
}

__device__ __forceinline__ void lists_phase(Frame& F, int l) {
    const int tid = F.tid, NGW = F.G * NWAVES;
    const int* wghist = (const int*)(F.ws + WS_ROUTE + RT_HIST);
    const int* route_e = (const int*)(F.ws + WS_ROUTE + RT_E); const float* route_c = (const float*)(F.ws + WS_ROUTE + RT_C);
    int* gtot = (int*)(F.ws + WS_ROUTE + RT_TOT);
    int* list_row = (int*)(F.ws + WS_ROUTE + RT_ROW); int* list_ent = (int*)(F.ws + WS_ROUTE + RT_ENT); float* list_c = (float*)(F.ws + WS_ROUTE + RT_CW);
    LAS int* part = (LAS int*)(F.lds + RING_OFF);
    LAS int* earr = (LAS int*)(F.lds + XTR_OFF + 2048);
    LAS int* tot = (LAS int*)(F.lds + XTR_OFF + 3072); LAS int* wgoff = tot + 32; LAS int* mbase = wgoff + 32;
    { const int e = tid & 31, pt = tid >> 5; int t = 0, pre = 0;
      for (int w2 = pt * 16; w2 < pt * 16 + 16; ++w2) if (w2 < F.G) { const int h = wghist[w2 * 32 + e]; t += h; if (w2 < F.vcu) pre += h; }
      part[pt * 64 + e] = t; part[pt * 64 + 32 + e] = pre; }
    __syncthreads();
    if (tid < 32) { int t = 0, pre = 0; for (int pt = 0; pt < 16; ++pt) { t += part[pt * 64 + tid]; pre += part[pt * 64 + 32 + tid]; } tot[tid] = t; wgoff[tid] = pre; }
    __syncthreads();
    if (tid == 0) { int bse = 0; for (int e = 0; e < 32; ++e) { mbase[e] = bse; bse += (tot[e] + 255) & ~255; } mbase[32] = bse; }
    __syncthreads();
    int myE = -1, myTok = 0, mySlot = 0;
    if (tid < 256) { const int n = tid >> 1; mySlot = tid & 1; myTok = F.vcu * NWAVES + (n & 7) + NGW * (n >> 3); myE = route_e[myTok * 2 + mySlot]; earr[tid] = myE; }
    __syncthreads();
    if (tid < 256) { int rk = 0; for (int t2 = 0; t2 < tid; ++t2) rk += (earr[t2] == myE) ? 1 : 0;
        const int pos = mbase[myE] + wgoff[myE] + rk;
        list_row[pos] = myTok; list_ent[pos] = myTok * 2 + mySlot; list_c[pos] = route_c[myTok * 2 + mySlot]; }
    if (F.vcu == 0) {
        if (tid < 33) gtot[tid] = mbase[tid];
        const int e = tid >> 4;
        for (int pos = mbase[e] + tot[e] + (tid & 15); pos < mbase[e + 1]; pos += 16) { list_row[pos] = 0; list_ent[pos] = -1; list_c[pos] = 0.f; }
    }
}

struct TailSched {
    int first, count; long tstride;
    __device__ __forceinline__ bool next(int i, pg8::Unit& u) const { if (i >= count) return false; const long L = first + i; u.pm = (int)(L >> 2); u.pn = (int)L & 3; u.boff = (long)u.pn * tstride; return true; }
};
struct GroupSched {
    int nunits, G, c, shift; const LAS int* tile_e; long estride, substride;
    __device__ __forceinline__ bool next(int i, pg8::Unit& u) const {
        const long L = (long)i * G + c; if (L >= nunits) return false;
        const int rt = (int)(L >> shift), sub = (int)L & ((1 << shift) - 1), e = tile_e[rt];
        u.pm = rt; u.pn = sub; u.boff = (long)e * estride + (long)sub * substride; return true;
    }
};
__device__ __forceinline__ int build_tile_table(Frame& F) {
    const int* gtot = (const int*)(F.ws + WS_ROUTE + RT_TOT);
    LAS int* tile_e = (LAS int*)(F.lds + XTR_OFF);
    const int T = gtot[32] >> 8;
    for (int rt = F.tid; rt < T; rt += NWAVES * 64) { int e = 0; for (int k = 1; k < 32; ++k) if (gtot[k] <= rt * 256) e = k; tile_e[rt] = e; }
    __syncthreads();
    return T;
}

__device__ __forceinline__ void ln2_phase(Frame& F, int l) {
    const int gw = F.vcu * NWAVES + F.wave, NGW = F.G * NWAVES, lane = F.lane;
    const bf16* X1 = (const bf16*)(F.ws + WS_XB); const bf16* Y0 = (const bf16*)(F.ws + WS_Y0); const bf16* Y1 = (const bf16*)(F.ws + WS_Y1); const bf16* PLE = (const bf16*)(F.ws + WS_PLE);
    const float* g2 = (const float*)INP(20) + l * 1024; const float* b2 = (const float*)INP(21) + l * 1024;
    bf16* XB = (bf16*)(F.ws + WS_XB);
    for (int m = gw; m < NTOK; m += NGW) {
        const GAS unsigned long long* xr = (const GAS unsigned long long*)(X1 + (size_t)m * 1024) + lane;
        const GAS unsigned long long* y0 = (const GAS unsigned long long*)(Y0 + (size_t)m * 1024) + lane; const GAS unsigned long long* y1 = (const GAS unsigned long long*)(Y1 + (size_t)m * 1024) + lane;
        const GAS unsigned long long* pl = (const GAS unsigned long long*)(PLE + (size_t)m * 1024) + lane;
        f32x4 v[4];
#pragma unroll
        for (int j = 0; j < 4; ++j) { const unsigned long long xq = xr[64 * j]; const unsigned xq0 = (unsigned)xq, xq1 = (unsigned)(xq >> 32); const f32x4 x = {pg8::bf_lo(xq0), pg8::bf_hi(xq0), pg8::bf_lo(xq1), pg8::bf_hi(xq1)};
            const unsigned long long a = y0[64 * j], c = y1[64 * j], d = pl[64 * j];
            const unsigned a0 = (unsigned)a, a1 = (unsigned)(a >> 32), c0 = (unsigned)c, c1 = (unsigned)(c >> 32), d0 = (unsigned)d, d1 = (unsigned)(d >> 32);
            const float km = (DBG & 1) ? 0.f : 1.f, kp = (DBG & 2) ? 0.f : 1.f;
            v[j].x = x.x * ALPHA + km * (pg8::bf_lo(a0) + pg8::bf_lo(c0)) + kp * pg8::bf_lo(d0); v[j].y = x.y * ALPHA + km * (pg8::bf_hi(a0) + pg8::bf_hi(c0)) + kp * pg8::bf_hi(d0);
            v[j].z = x.z * ALPHA + km * (pg8::bf_lo(a1) + pg8::bf_lo(c1)) + kp * pg8::bf_lo(d1); v[j].w = x.w * ALPHA + km * (pg8::bf_hi(a1) + pg8::bf_hi(c1)) + kp * pg8::bf_hi(d1); }
        ln_row(v, g2, b2, lane);
#if CHK
        if (l == DEPTH - 1 && __hip_atomic_load(F.ctl + CW_CHK, RLX_AGENT) != 0u) { const float qn = __builtin_nanf(""); v[0] = (f32x4){qn, qn, qn, qn}; }
#endif
        if (l + 1 == DEPTH) { GAS f32x4* o = (GAS f32x4*)(F.out + (size_t)m * 1024) + lane;
#pragma unroll
            for (int j = 0; j < 4; ++j) o[64 * j] = v[j]; }
        if (l + 1 < DEPTH) { GAS unsigned long long* o8 = (GAS unsigned long long*)(XB + (size_t)m * 1024) + lane;
#pragma unroll
            for (int j = 0; j < 4; ++j) { o8[64 * j] = (unsigned long long)pk2(v[j].x, v[j].y) | ((unsigned long long)pk2(v[j].z, v[j].w) << 32);
                ((GAS unsigned*)((unsigned char*)F.out + OUT_XB8 + (size_t)m * 1024) + lane)[64 * j] = pk4_fp8(v[j].x, v[j].y, v[j].z, v[j].w); } }
    }
}


#if CHK
__device__ __forceinline__ void chk_fail(Frame& F, unsigned code) { __hip_atomic_store(F.ctl + CW_CHK, code, RLX_AGENT); }
__device__ __forceinline__ float bf2f(unsigned short v) { return __uint_as_float((unsigned)v << 16); }
__device__ __forceinline__ unsigned hash32(unsigned x) { x ^= x >> 16; x *= 0x7feb352du; x ^= x >> 15; x *= 0x846ca68bu; x ^= x >> 16; return x; }
__device__ __forceinline__ bool close_to(float got, float want, float rel, float ab) { return fabsf(got - want) <= ab + rel * fabsf(want) && got == got; }
__device__ __forceinline__ void cs_ref(float ang, float& c, float& s) {
    double rev = (double)ang * 0.15915494309189535; rev -= rint(rev); const double x = rev * 6.283185307179586, x2 = x * x;
    double tc = 1.0, ts = x, sc = 1.0, ss = x;
#pragma unroll 1
    for (int k = 1; k <= 14; ++k) { tc *= -x2 / (double)((2 * k - 1) * (2 * k)); ts *= -x2 / (double)((2 * k) * (2 * k + 1)); sc += tc; ss += ts; }
    c = (float)sc; s = (float)ss;
}
__device__ __forceinline__ void chk_proj(Frame& F) {
    const float* x = (const float*)INP(0); const float* w_in = (const float*)INP(3); const int* pos = (const int*)INP(2);
    const int gw = F.vcu * NWAVES + F.wave, lane = F.lane;
    for (int it = 0; it < 4; ++it) {
        const unsigned h = hash32((unsigned)(gw * 4 + it) * 2654435761u + 12345u);
        const int m = (int)(h % (unsigned)NTOK), col = (int)((h >> 7) % 3656u);
        int t, cw; if (col < 3584) { t = col >> 9; cw = col & 511; } else if (col < 3648) { t = 7; cw = col - 3584; } else { t = 8; cw = col - 3648; }
        const int d = cw & 63; const bool roped = (t == 0 || t == 1 || t == 3 || t == 4 || t == 6 || t == 7) && d < 16;
        const int pcol = roped ? (d < 8 ? col + 8 : col - 8) : col;
        float a = 0.f, b2 = 0.f;
        for (int k = lane; k < 1024; k += 64) { const float xv = x[(size_t)m * 1024 + k]; a += xv * w_in[(size_t)k * WIN_OLD + col]; b2 += xv * w_in[(size_t)k * WIN_OLD + pcol]; }
        a = wave_sum(a); b2 = wave_sum(b2);
        float val = a;
        if (roped) { const int j = d & 7; const float invf = 1.0f / powf(500000.0f, (float)j * 0.125f); float c, s; cs_ref((float)pos[m] * invf, c, s); val = (d < 8) ? a * c - b2 * s : a * c + b2 * s; }
        const float sc = (t == 0 || t == 3) ? pg8::C2 : (t == 6 ? 0.125f : (t == 8 ? 0.35355339059f : 1.f));
        val *= sc;
        float got;
        if (t < 7) got = bf2f(((const bf16*)(F.ws + WS_DQ + (size_t)t * TSTRIDE))[(size_t)m * 512 + cw]);
        else if (t == 7) got = bf2f(((const bf16*)(F.ws + WS_IK))[(size_t)m * 64 + cw]);
        else got = ((const float*)(F.ws + WS_IW))[(size_t)m * 8 + cw];
        if (lane == 0 && !close_to(got, val, 0.02f, 0.02f)) chk_fail(F, 0x100u + (unsigned)t);
    }
}
__device__ __forceinline__ void chk_attn(Frame& F) {
    LAS float* red = (LAS float*)(F.lds + RING_OFF);
    const unsigned h = hash32((unsigned)F.vcu * 977u + 7u);
    const int a = F.vcu % 48, t = (F.vcu < 8) ? (int)(h % 300u) : (int)(h % (unsigned)SEQ);
    int b, hq, hv; const bf16 *Q, *K, *V, *O; bool masked = false;
    if (a < 32) return;
    if (a < 32) { b = a >> 4; const int hh = (a >> 2) & 3, c = (a >> 1) & 1, hf = a & 1; hq = 2 * hh + c; hv = 2 * hh + hf;
        Q = (const bf16*)(F.ws + WS_DQ); K = (const bf16*)(F.ws + WS_DQ + TSTRIDE); V = (const bf16*)(F.ws + WS_DQ + 2 * TSTRIDE); O = (const bf16*)(F.ws + (c ? WS_O1 : WS_O0)); }
    else { b = (a - 32) >> 3; hq = hv = (a - 32) & 7; masked = true;
        Q = (const bf16*)(F.ws + WS_DQ + 3 * TSTRIDE); K = (const bf16*)(F.ws + WS_DQ + 4 * TSTRIDE); V = (const bf16*)(F.ws + WS_DQ + 5 * TSTRIDE); O = (const bf16*)(F.ws + WS_YB); }
    const unsigned long long* MK = (const unsigned long long*)(F.ws + WS_MASK) + (size_t)b * MASK_BSTRIDE;
    const size_t row = (size_t)b * SEQ + t;
    if (F.tid < 66) red[F.tid] = (F.tid == 0) ? -1e30f : 0.f;
    __syncthreads();
    float mx = -1e30f;
    for (int s = F.tid; s <= t; s += 512) {
        if (masked) { const int tl = s >> 6; const unsigned long long w = MK[idxr::moff(tl) + (t - 64 * tl)]; if (!((w >> (s & 63)) & 1ull)) continue; }
        float lg = 0.f; for (int d = 0; d < 64; ++d) lg += bf2f(Q[row * 512 + hq * 64 + d]) * bf2f(K[((size_t)b * SEQ + s) * 512 + hq * 64 + d]);
        mx = fmaxf(mx, lg);
    }
    for (int o = 1; o < 64; o <<= 1) mx = fmaxf(mx, __shfl_xor(mx, o));
    if (F.lane == 0) { float old = red[0]; while (mx > old) { const unsigned prev = atomicCAS((unsigned*)&red[0], __float_as_uint(old), __float_as_uint(mx)); if (prev == __float_as_uint(old)) break; old = __uint_as_float(prev); } }
    __syncthreads();
    mx = red[0];
    __syncthreads();
    float sum = 0.f;
    for (int s = F.tid; s <= t; s += 512) {
        if (masked) { const int tl = s >> 6; const unsigned long long w = MK[idxr::moff(tl) + (t - 64 * tl)]; if (!((w >> (s & 63)) & 1ull)) continue; }
        float lg = 0.f; for (int d = 0; d < 64; ++d) lg += bf2f(Q[row * 512 + hq * 64 + d]) * bf2f(K[((size_t)b * SEQ + s) * 512 + hq * 64 + d]);
        const float p = exp2f(lg - mx); sum += p;
        for (int d = 0; d < 64; ++d) atomicAdd((float*)&red[2 + d], p * bf2f(V[((size_t)b * SEQ + s) * 512 + hv * 64 + d]));
    }
    atomicAdd((float*)&red[1], sum);
    __syncthreads();
    if (F.tid < 64) { const float want = red[2 + F.tid] / red[1], got = bf2f(O[row * 512 + hv * 64 + F.tid]);
        if (!close_to(got, want, 0.03f, 0.003f)) chk_fail(F, masked ? 0x220u : 0x210u); }
    __syncthreads();
}
__device__ __forceinline__ void chk_mask(Frame& F) {
    LAS float* sc = (LAS float*)(F.lds + RING_OFF);
    LAS unsigned* cnt = (LAS unsigned*)(F.lds + XTR_OFF + 2048);
    if (F.vcu >= 64) return;
    const unsigned h = hash32((unsigned)F.vcu * 31337u + 99u);
    const int b = F.vcu & 1, t = (F.vcu < 6) ? (int)(h % 400u) : (int)(h % (unsigned)SEQ);
    const bf16* IQ = (const bf16*)(F.ws + WS_DQ + 6 * TSTRIDE); const bf16* IK = (const bf16*)(F.ws + WS_IK); const float* IW = (const float*)(F.ws + WS_IW);
    const unsigned long long* MK = (const unsigned long long*)(F.ws + WS_MASK) + (size_t)b * MASK_BSTRIDE;
    const size_t row = (size_t)b * SEQ + t;
    if (F.tid < 2) cnt[F.tid] = 0u;
    for (int s = F.tid; s <= t; s += 512) { float tot = 0.f;
        for (int hh = 0; hh < 8; ++hh) { float d = 0.f; for (int e = 0; e < 64; ++e) d += bf2f(IQ[row * 512 + hh * 64 + e]) * bf2f(IK[((size_t)b * SEQ + s) * 64 + e]); tot += IW[row * 8 + hh] * fmaxf(d, 0.f); }
        sc[s] = tot; }
    __syncthreads();
    for (int s = F.tid; s <= t; s += 512) { const float v = sc[s]; int rk = 0;
        for (int s2 = 0; s2 <= t; ++s2) { const float v2 = sc[s2]; rk += (v2 > v || (v2 == v && s2 < s)) ? 1 : 0; }
        const bool want = rk < 256; const int tl = s >> 6; const bool got = (MK[idxr::moff(tl) + (t - 64 * tl)] >> (s & 63)) & 1ull;
        if (want != got) atomicAdd((unsigned*)&cnt[0], 1u); if (got) atomicAdd((unsigned*)&cnt[1], 1u); }
    __syncthreads();
    if (F.tid == 0) { const unsigned expect = (t + 1 < 256) ? (unsigned)(t + 1) : 256u; if (cnt[1] != expect) chk_fail(F, 0x230u); else if (cnt[0] > 8u) chk_fail(F, 0x231u); }
    __syncthreads();
}
__device__ __forceinline__ void chk_pre1(Frame& F) {
    LAS float* mg = (LAS float*)(F.lds + RING_OFF);
    const float* x = (const float*)INP(0); const float* w_in = (const float*)INP(3); const float* wbd = (const float*)INP(6); const float* wbs = (const float*)INP(7); const float* wo = (const float*)INP(8);
    const bf16* YA = (const bf16*)(F.ws + WS_YA); const bf16* YB = (const bf16*)(F.ws + WS_YB); const bf16* PRE = (const bf16*)(F.ws + WS_PRE1);
    const int m = (int)(hash32((unsigned)F.vcu * 7919u + 3u) % (unsigned)NTOK);
    for (int c = F.tid; c < 1024; c += 512) { float ga = 0.f, gb = 0.f, pa = 0.f, pb = 0.f;
        for (int k = 0; k < 1024; ++k) { const float xv = bf2f((unsigned short)f2bf(x[(size_t)m * 1024 + k])); ga += xv * w_in[(size_t)k * WIN_OLD + 3656 + c]; gb += xv * w_in[(size_t)k * WIN_OLD + 4680 + c]; }
        for (int k = 0; k < 512; ++k) { pa += bf2f(YA[(size_t)m * 512 + k]) * wbd[(size_t)k * 1024 + c]; pb += bf2f(YB[(size_t)m * 512 + k]) * wbs[(size_t)k * 1024 + c]; }
        mg[c] = pa / (1.f + expf(-ga)) + pb / (1.f + expf(-gb)); }
    __syncthreads();
    for (int c = F.tid; c < 1024; c += 512) { float mix = 0.f; for (int k = 0; k < 1024; ++k) mix += mg[k] * wo[(size_t)k * 1024 + c];
        const float want = ALPHA * x[(size_t)m * 1024 + c] + mix, got = bf2f(PRE[(size_t)m * 1024 + c]);
        if (!close_to(got, want, 0.015f, 0.015f)) chk_fail(F, 0x300u); }
    __syncthreads();
}
__device__ __forceinline__ void chk_ffn(Frame& F) {
    LAS float* lgs = (LAS float*)(F.lds + RING_OFF);
    const bf16* X1 = (const bf16*)(F.ws + WS_XB); const float* wrg = (const float*)INP(11); const float* brg = (const float*)INP(12); const float* wre = (const float*)INP(13); const float* bre = (const float*)INP(14);
    const float* wg = (const float*)INP(15); const float* wu = (const float*)INP(16); const float* wd = (const float*)INP(17); const float* wple = (const float*)INP(18); const float* wpg = (const float*)INP(19); const float* p = (const float*)INP(1);
    const bf16* Y0 = (const bf16*)(F.ws + WS_Y0); const bf16* Y1 = (const bf16*)(F.ws + WS_Y1); const bf16* PLE = (const bf16*)(F.ws + WS_PLE);
    const int m = (int)(hash32((unsigned)F.vcu * 104729u + 11u) % (unsigned)NTOK);
    if (F.tid < 36) { float s = 0.f; for (int k = 0; k < 1024; ++k) s += bf2f(X1[(size_t)m * 1024 + k]) * (F.tid < 4 ? wrg[k * 4 + F.tid] : wre[k * 32 + F.tid - 4]); lgs[F.tid] = s + (F.tid < 4 ? brg[F.tid] : bre[F.tid - 4]); }
    __syncthreads();
    int gi = 0; for (int i = 1; i < 4; ++i) if (lgs[i] > lgs[gi]) gi = i;
    float gs = 0.f; for (int i = 0; i < 4; ++i) gs += expf(lgs[i] - lgs[gi]); const float gval = 1.f / gs;
    int i0 = 0; for (int k = 1; k < 8; ++k) if (lgs[4 + gi * 8 + k] > lgs[4 + gi * 8 + i0]) i0 = k;
    int i1 = (i0 == 0) ? 1 : 0; for (int k = 0; k < 8; ++k) if (k != i0 && lgs[4 + gi * 8 + k] > lgs[4 + gi * 8 + i1]) i1 = k;
    const float l0 = lgs[4 + gi * 8 + i0], l1 = lgs[4 + gi * 8 + i1], c0 = gval / (1.f + expf(l1 - l0)), c1 = gval - c0;
    __syncthreads();
    { const int sl = F.tid >> 8, f = F.tid & 255, e = gi * 8 + (sl ? i1 : i0); const float* G = wg + (size_t)e * 1024 * 256; const float* U = wu + (size_t)e * 1024 * 256; float g = 0.f, u = 0.f;
      for (int k = 0; k < 1024; ++k) { const float xv = bf2f(X1[(size_t)m * 1024 + k]); g += xv * G[(size_t)k * 256 + f]; u += xv * U[(size_t)k * 256 + f]; }
      lgs[64 + F.tid] = g / (1.f + expf(-g)) * u * (sl ? c1 : c0); }
    __syncthreads();
    for (int c = F.tid; c < 1024; c += 512) { float y = 0.f;
        for (int sl = 0; sl < 2; ++sl) { const int e = gi * 8 + (sl ? i1 : i0); const float* D = wd + (size_t)e * 256 * 1024; for (int f = 0; f < 256; ++f) y += lgs[64 + sl * 256 + f] * D[(size_t)f * 1024 + c]; }
        const float goty = bf2f(Y0[(size_t)m * 1024 + c]) + bf2f(Y1[(size_t)m * 1024 + c]);
        if (!close_to(goty, y, 0.03f, 0.004f)) chk_fail(F, 0x400u);
        float gt = 0.f, tp = 0.f; for (int k = 0; k < 1024; ++k) gt += bf2f(X1[(size_t)m * 1024 + k]) * wpg[(size_t)k * 1024 + c]; for (int k = 0; k < 256; ++k) tp += p[(size_t)m * 256 + k] * wple[(size_t)k * 1024 + c];
        const float wantp = tp / (1.f + expf(-gt)), gotp = bf2f(PLE[(size_t)m * 1024 + c]);
        if (!close_to(gotp, wantp, 0.03f, 0.01f)) chk_fail(F, 0x410u); }
    __syncthreads();
}
#endif

#ifndef PHSEL
#define PHSEL 0xFFF
#endif
#define PHON(k) (((PHSEL) >> (k)) & 1)
#ifndef DUP
#define DUP 0
#endif
#define DUPREP(k) for (int rep_ = 0; rep_ < (((DUP) >> (k)) & 1) + 1; ++rep_)
__global__ void __launch_bounds__(NWAVES * 64, 2) skel_fwd(Args args) {
    extern __shared__ __attribute__((aligned(16))) unsigned char lds[];
    Frame F;
    F.lds = (LAS unsigned char*)lds;
    F.MISC = (volatile LAS unsigned*)(F.lds + MISC_OFF);
    F.tid = threadIdx.x; F.lane = F.tid & 63; F.wave = __builtin_amdgcn_readfirstlane(F.tid >> 6);
    F.G = gridDim.x; F.bx = blockIdx.x; { const int bx = blockIdx.x; F.vcu = (F.G % 8 == 0) ? (bx % 8) * (F.G / 8) + bx / 8 : bx; }
    F.ws = F.ws0 = args.ws; F.out = F.out0 = args.out; F.ap = &args;
    F.ctl = (gu32*)(F.ws + WS_CTL);
    for (int u = F.tid; u < (MISC_OFF + 128 - XTR_OFF) / 4; u += NWAVES * 64) ((LAS unsigned*)(F.lds + XTR_OFF))[u] = 0u;
    __syncthreads();
#if MK_PER_PHASE
    XcdBarrier bar; bar.bar = (unsigned*)(F.ctl + CW_BAR); bar.x = 0; bar.st = nullptr;
#define GRID_BAR() do { if (F.tid == 0) __hip_atomic_store(F.ctl + CW_TMO, 0xBADBA0u, RLX_AGENT); } while (0)
#else
    XcdBarrier bar = xcd_barrier_post((unsigned*)(F.ctl + CW_BAR), F.MISC + 8);
#ifndef IDLEPROBE
#define IDLEPROBE 0
#endif
#if IDLEPROBE
#define GRID_BAR() do { const unsigned long long t0_ = rt(); xcd_barrier(bar); if (F.tid == 0) __hip_atomic_fetch_add(F.ctl + 12288 + seam_no, (unsigned)(rt() - t0_), RLX_AGENT); ++seam_no; } while (0)
#else
#define GRID_BAR() xcd_barrier(bar)
#endif
#endif
    const int lo = args.ph_lo, hi = args.ph_hi;
    int seam_no = 0; (void)seam_no;
#define IN(k) (lo <= (k) && (k) < hi)
#define SEAM(k) do { if (IN(k) && IN((k) + 1)) GRID_BAR(); } while (0)
#define PHASE_ENTER() { size_t zo_ = 0; asm volatile("" : "+s"(zo_)); F.ws = F.ws0 + zo_; F.out = F.out0 + zo_; } F.vcu = __builtin_amdgcn_readfirstlane(F.vcu); asm volatile("" : "+s"(F.vcu), "+s"(F.G), "+s"(F.bx)); asm volatile("" : "+s"(F.lds)); F.tid = ltid(F.wave); F.lane = F.tid & 63; unsigned char* const ws = F.ws; bf16* const XB = (bf16*)(ws + WS_XB); (void)XB
    for (int l = 0; l < DEPTH; ++l) {
        const int pb = l * NPH_LAYER;
        if (PHON(0) && IN(pb + 0)) DUPREP(0) { PHASE_ENTER(); pw_phase(F, l); }
        SEAM(pb + 0);
        if (PHON(1) && IN(pb + 1)) DUPREP(1) { PHASE_ENTER();
            pg8::Gemm g{XB, (const bf16*)(ws + WS_WB + WB_WIN), 1024, 1024, 1024, nullptr}; pg8::StaticOrder S; S.init(NTOK, P1_N, F.G, F.bx, 1024);
            pg8::EpiProj E{(bf16*)(ws + WS_DQ), TSTRIDE / 2, (bf16*)(ws + WS_IK), (float*)(ws + WS_IW), (const float*)(ws + WS_ROPE)};
            pg8::gemm_phase<pg8::EpiProj, pg8::StaticOrder, true>(F.lds + RING_OFF, g, S, E, F.wave);
            { pg8::Gemm g2{(const bf16*)(ws + WS_PB), (const bf16*)(ws + WS_WB + WB_WPLE), 256, 256, 256, nullptr};
                TailSched S2{(F.bx >= 128) ? (F.bx - 128) * 3 : 384 + F.bx, (F.bx >= 128) ? 3 : 1, 256L * 256};
                pg8::EpiStore E2{(bf16*)((unsigned char*)F.out + OUT_T1), 1024}; pg8::gemm_phase<pg8::EpiStore, TailSched, true>(F.lds + RING_OFF, g2, S2, E2, F.wave); }
        }
        SEAM(pb + 1);
        if (PHON(2) && IN(pb + 2)) DUPREP(2) { PHASE_ENTER();
            const bf16* IQ = (const bf16*)(ws + WS_DQ + 6 * TSTRIDE); const bf16* IK = (const bf16*)(ws + WS_IK); const float* IW = (const float*)(ws + WS_IW);
            for (int p = F.vcu; p < 256; p += F.G) { const int b = p >> 7, s = p & 127;
                unsigned long long* m32 = (unsigned long long*)(ws + WS_MASK) + (size_t)b * MASK_BSTRIDE;
                for (int k2 = 0; k2 < 2; ++k2) indexer_unit(F, b, k2 ? s : 255 - s, IQ, IK, IW, m32); }
        }
        SEAM(pb + 2);
        if (PHON(3) && IN(pb + 3)) DUPREP(3) { PHASE_ENTER();
            using attn_body::bf16;
            const bf16* DQ = (const bf16*)(ws + WS_DQ); const bf16* DK = (const bf16*)(ws + WS_DQ + TSTRIDE); const bf16* DV = (const bf16*)(ws + WS_DQ + 2 * TSTRIDE);
            LAS unsigned* qslot = (LAS unsigned*)(F.lds + MISC_OFF + 64);
            gu32* qctr = F.ctl + CW_QUEUE + l * 64;
            LAS unsigned* const badp = (LAS unsigned*)(F.lds + MISC_OFF + 80); constexpr int BADOFF = MISC_OFF + 80 - RING_OFF;
#define GRAB(ctr_, u_) do { __syncthreads(); if (F.tid == 0) { *qslot = __hip_atomic_fetch_add((ctr_), 1u, RLX_AGENT); *badp = 0u; } __syncthreads(); u_ = (int)*qslot; } while (0)
#ifndef DUPW
#define DUPW 0
#endif
            for (int dw_ = 0; dw_ <= DUPW; ++dw_)
            for (;;) { int u; GRAB(qctr + 8 * dw_, u); if (u >= 512) break;
                const int qb = 63 - (u >> 3), a = u & 7, b = a >> 2, h = a & 3;
#pragma unroll 1
                for (int c = 0; c < 2; ++c) {
                    bf16* O = (bf16*)(ws + (c ? WS_O1 : WS_O0));
                    attn_body::attn_unit<8, false, true, true>(b, 2 * h + c, 2 * h, qb, DQ, DK, DV, O, nullptr, (char*)lds + RING_OFF, F.wave, BADOFF);
#if !(CHK && MK_PER_PHASE)
                    if (*(volatile LAS unsigned*)badp) { __syncthreads(); if (F.tid == 0) *badp = 0u;
                        attn_body::attn_unit<8, false, true, false>(b, 2 * h + c, 2 * h, qb, DQ, DK, DV, O, nullptr, (char*)lds + RING_OFF, F.wave, BADOFF); }
#endif
                }
                VM_WAIT(); __syncthreads(); __builtin_amdgcn_fence(__ATOMIC_ACQUIRE, "agent");
                ya_unit(F, l, b, h, qb);
            }
            const bf16* SQ = (const bf16*)(ws + WS_DQ + 3 * TSTRIDE); const bf16* SK = (const bf16*)(ws + WS_DQ + 4 * TSTRIDE); const bf16* SV = (const bf16*)(ws + WS_DQ + 5 * TSTRIDE);
            attn_body::mask_table_init((char*)lds + RING_OFF, F.tid);
#ifndef DUPS
#define DUPS 0
#endif
            for (int ds_ = 0; ds_ <= DUPS; ++ds_)
            for (;;) { int u; GRAB(qctr + 32 + 8 * ds_, u); if (u >= 1024) break;
                const int qb = 63 - (u >> 4), a = u & 15, b = a >> 3, h = a & 7;
                const unsigned long long* MK = (const unsigned long long*)(ws + WS_MASK) + (size_t)b * MASK_BSTRIDE;
                attn_body::attn_unit<8, true, false, true>(b, h, h, qb, SQ, SK, SV, (bf16*)(ws + WS_YB), MK, (char*)lds + RING_OFF, F.wave, BADOFF);
#if !(CHK && MK_PER_PHASE)
                if (*(volatile LAS unsigned*)badp) attn_body::attn_unit<8, true, false, false>(b, h, h, qb, SQ, SK, SV, (bf16*)(ws + WS_YB), MK, (char*)lds + RING_OFF, F.wave, BADOFF);
#endif
                }
#undef GRAB
        }
        SEAM(pb + 3);
        if (PHON(5) && IN(pb + 5)) DUPREP(5) { PHASE_ENTER();
#define RELA() { size_t zo_ = 0; asm volatile("" : "+s"(zo_)); F.ws = F.ws0 + zo_; } unsigned char* const ws = F.ws; bf16* const XB = (bf16*)(ws + WS_XB); (void)XB; const bf16* WIN = (const bf16*)(ws + WS_WB + WB_WIN); bf16* MG = (bf16*)(ws + WS_MERGED); unsigned char* G1 = ws + WS_TMPG; unsigned char* G2 = ws + WS_TMPG + 32 * MiB; (void)WIN; (void)MG; (void)G1; (void)G2
            { RELA(); pg8::Gemm g{(const bf16*)((unsigned char*)F.out + OUT_XB8), (const bf16*)(ws + WS_WB + WB_WG8), 512, 512, 512, nullptr}; pg8::StaticOrder S; S.init(NTOK, 1024, F.G, F.bx, 512);
              pg8::EpiSig E{G1, 1024, 1.f / 64.f}; pg8::gemm_phase<pg8::EpiSig, pg8::StaticOrder, true, false, true>(F.lds + RING_OFF, g, S, E, F.wave); }
            { RELA(); pg8::Gemm g{(const bf16*)((unsigned char*)F.out + OUT_XB8), (const bf16*)(ws + WS_WB + WB_WG8 + (size_t)1024 * 1024), 512, 512, 512, nullptr}; pg8::StaticOrder S; S.init(NTOK, 1024, F.G, F.bx, 512);
              pg8::EpiSig E{G2, 1024, 1.f / 64.f}; pg8::gemm_phase<pg8::EpiSig, pg8::StaticOrder, true, false, true>(F.lds + RING_OFF, g, S, E, F.wave); }
            VM_WAIT(); __builtin_amdgcn_fence(__ATOMIC_ACQUIRE, "agent"); VM_WAIT();
            { RELA(); pg8::Gemm g{(const bf16*)(ws + WS_YA), (const bf16*)(ws + WS_WB + WB_WBD), 512, 512, 512, nullptr}; pg8::StaticOrder S; S.init(NTOK, 1024, F.G, F.bx, 512);
              pg8::EpiGatedT<false> E{G1, nullptr, MG, 1024}; pg8::gemm_phase<pg8::EpiGatedT<false>, pg8::StaticOrder, true>(F.lds + RING_OFF, g, S, E, F.wave); }
            VM_WAIT(); __builtin_amdgcn_fence(__ATOMIC_ACQUIRE, "agent"); VM_WAIT();
            { RELA(); pg8::Gemm g{(const bf16*)(ws + WS_YB), (const bf16*)(ws + WS_WB + WB_WBS), 512, 512, 512, nullptr}; pg8::StaticOrder S; S.init(NTOK, 1024, F.G, F.bx, 512);
              pg8::EpiGatedT<true> E{G2, MG, MG, 1024}; if (!(DBG & 4)) pg8::gemm_phase<pg8::EpiGatedT<true>, pg8::StaticOrder, true>(F.lds + RING_OFF, g, S, E, F.wave); }
        }
        SEAM(pb + 5);
        if (PHON(6) && IN(pb + 6)) DUPREP(6) { PHASE_ENTER();
            pg8::Gemm g{(const bf16*)(ws + WS_MERGED), (const bf16*)(ws + WS_WB + WB_WO), 1024, 1024, 1024, nullptr}; pg8::StaticOrder S; S.init(NTOK, 1024, F.G, F.bx, 1024);
            pg8::EpiResBf16 E{XB, (bf16*)(ws + WS_PRE1), ALPHA}; pg8::gemm_phase<pg8::EpiResBf16, pg8::StaticOrder, true>(F.lds + RING_OFF, g, S, E, F.wave);
        }
        SEAM(pb + 6);
        if (PHON(7) && IN(pb + 7)) DUPREP(7) { PHASE_ENTER(); ln1_router_phase(F, l); }
        SEAM(pb + 7);
        if (PHON(8) && IN(pb + 8)) DUPREP(8) { PHASE_ENTER(); lists_phase(F, l); }
        SEAM(pb + 8);
        if (PHON(9) && IN(pb + 9)) DUPREP(9) { PHASE_ENTER();
            const int T = build_tile_table(F);
            pg8::Gemm g{(const bf16*)((unsigned char*)F.out + OUT_X1B8), (const bf16*)(ws + WS_WB + WB_WGU), 512, 512, 512, (const int*)(ws + WS_ROUTE + RT_ROW)};
            GroupSched S{2 * T, F.G, F.vcu, 1, (const LAS int*)(F.lds + XTR_OFF), 512L * 512, 256L * 512};
            pg8::EpiGU E{(bf16*)(ws + WS_HG), (const float*)(ws + WS_ROUTE + RT_CW), 1.f / 64.f};
            pg8::gemm_phase<pg8::EpiGU, GroupSched, true, true, true>(F.lds + RING_OFF, g, S, E, F.wave);
        }
        SEAM(pb + 9);
        if (PHON(10) && IN(pb + 10)) DUPREP(10) { PHASE_ENTER();
            const int T = build_tile_table(F);
#ifndef P10SEL
#define P10SEL 7
#endif
            if (P10SEL & 1) { RELA(); pg8::Gemm g{(const bf16*)(ws + WS_HG), (const bf16*)(ws + WS_WB + WB_WD), 256, 256, 256, nullptr};
              GroupSched S{4 * T, F.G, F.vcu, 2, (const LAS int*)(F.lds + XTR_OFF), 1024L * 256, 256L * 256};
              pg8::EpiDown E{(const int*)(ws + WS_ROUTE + RT_ENT), (bf16*)(ws + WS_Y0), (unsigned)(WS_Y1 - WS_Y0)};
              pg8::gemm_phase<pg8::EpiDown, GroupSched, true>(F.lds + RING_OFF, g, S, E, F.wave); }
            if (P10SEL & 4) { RELA(); pg8::Gemm g{(const bf16*)((unsigned char*)F.out + OUT_X1B8), (const bf16*)(ws + WS_WB + WB_WPG), 512, 512, 512, nullptr}; pg8::StaticOrder S; S.init(NTOK, 1024, F.G, F.bx, 512);
              pg8::EpiPle E{(const bf16*)((unsigned char*)F.out + OUT_T1), (bf16*)(ws + WS_PLE), 1.f / 64.f}; pg8::gemm_phase<pg8::EpiPle, pg8::StaticOrder, true, false, true>(F.lds + RING_OFF, g, S, E, F.wave); }
        }
        SEAM(pb + 10);
        if (PHON(11) && IN(pb + 11)) DUPREP(11) { PHASE_ENTER(); ln2_phase(F, l); }
        if (l + 1 < DEPTH) SEAM(pb + 11);
    }
#if IDLEPROBE
    xcd_barrier(bar);
    if (blockIdx.x == 0 && F.tid == 0) { unsigned long long tot = 0; for (int k = 0; k < 23; ++k) if ((IDLEPROBE >> k) & 1) tot += __hip_atomic_load(F.ctl + 12288 + k, RLX_AGENT);
        const unsigned long long t0 = rt(), dur = tot / 256; while (rt() - t0 < dur) __builtin_amdgcn_s_sleep(8); }
#endif
#undef IN
#undef SEAM
}

#if CHK
__global__ void __launch_bounds__(NWAVES * 64, 2) chk_kernel(Args args, int which) {
    extern __shared__ __attribute__((aligned(16))) unsigned char lds[];
    Frame F;
    F.lds = (LAS unsigned char*)lds; F.MISC = (volatile LAS unsigned*)(F.lds + MISC_OFF);
    F.tid = threadIdx.x; F.lane = F.tid & 63; F.wave = __builtin_amdgcn_readfirstlane(F.tid >> 6);
    F.G = gridDim.x; F.bx = blockIdx.x; { const int bx = blockIdx.x; F.vcu = (F.G % 8 == 0) ? (bx % 8) * (F.G / 8) + bx / 8 : bx; }
    F.ws = F.ws0 = args.ws; F.out = F.out0 = args.out; F.ap = &args; F.ctl = (gu32*)(F.ws + WS_CTL);
    if (which == 1) chk_proj(F);
    if (which == 2) chk_attn(F);
    if (which == 4) chk_mask(F);
    if (which == 8) chk_pre1(F);
    if (which == 16) chk_ffn(F);
}
#endif
extern "C" void kernel_launch(void* const* d_in, const int* in_sizes, int n_in, void* d_out, int out_size, void* d_ws, size_t ws_size, hipStream_t stream) {
    static int grid = 0;
    if (grid == 0) {
        if (n_in != 22 || in_sizes[0] != NTOK * DMODEL || out_size != NTOK * DMODEL || ws_size < WS_END) { fprintf(stderr, "kernel_launch: unexpected problem geometry (n_in %d, ws %zu); nothing launched\n", n_in, ws_size); grid = -1; return; }
        int dev = 0, cus = 0, per_cu = 0;
        if (hipGetDevice(&dev) != hipSuccess || hipDeviceGetAttribute(&cus, hipDeviceAttributeMultiprocessorCount, dev) != hipSuccess) { grid = -1; return; }
        if (hipFuncSetAttribute((const void*)skel_fwd, hipFuncAttributeMaxDynamicSharedMemorySize, LDS_BYTES) != hipSuccess) { fprintf(stderr, "kernel_launch: hipFuncSetAttribute failed\n"); grid = -1; return; }
        if (hipOccupancyMaxActiveBlocksPerMultiprocessor(&per_cu, (const void*)skel_fwd, NWAVES * 64, LDS_BYTES) != hipSuccess || per_cu < 1) { fprintf(stderr, "kernel_launch: occupancy query reports %d\n", per_cu); }
        (void)hipGetLastError();
        if (cus < 256) { fprintf(stderr, "kernel_launch: needs 256 CUs (got %d)\n", cus); grid = -1; return; }
        grid = 256;
    }
    if (grid < 0) return;
    if (hipMemsetAsync((char*)d_ws + WS_CTL, 0, CTL_ZERO_BYTES, stream) != hipSuccess) return;
    Args a{};
    for (int i = 0; i < 22; ++i) a.in[i] = d_in[i];
    a.out = (float*)d_out; a.ws = (unsigned char*)d_ws;
#if MK_PER_PHASE
    for (int ph = 0; ph < NPHASE; ++ph) { a.ph_lo = ph; a.ph_hi = ph + 1; hipLaunchKernelGGL(skel_fwd, dim3(grid), dim3(NWAVES * 64), LDS_BYTES, stream, a);
#if CHK
        static bool chk_set = false; if (!chk_set) { (void)hipFuncSetAttribute((const void*)chk_kernel, hipFuncAttributeMaxDynamicSharedMemorySize, LDS_BYTES); chk_set = true; }
        if (ph == 1 && (CHK & 1)) hipLaunchKernelGGL(chk_kernel, dim3(grid), dim3(NWAVES * 64), LDS_BYTES, stream, a, 1);
        if (ph == 3 && (CHK & 2)) hipLaunchKernelGGL(chk_kernel, dim3(grid), dim3(NWAVES * 64), LDS_BYTES, stream, a, 2);
        if (ph == 3 && (CHK & 4)) hipLaunchKernelGGL(chk_kernel, dim3(grid), dim3(NWAVES * 64), LDS_BYTES, stream, a, 4);
        if (ph == 6 && (CHK & 8)) hipLaunchKernelGGL(chk_kernel, dim3(grid), dim3(NWAVES * 64), LDS_BYTES, stream, a, 8);
        if (ph == 10 && (CHK & 16)) hipLaunchKernelGGL(chk_kernel, dim3(grid), dim3(NWAVES * 64), LDS_BYTES, stream, a, 16);
#endif
    }
#else
    a.ph_lo = 0; a.ph_hi = NPHASE;
    hipLaunchKernelGGL(skel_fwd, dim3(grid), dim3(NWAVES * 64), LDS_BYTES, stream, a);
#endif
}
```

```cpp
#include <hip/hip_runtime.h>
#include <hip/hip_bf16.h>
#include <cstdio>
#include <cstdint>
#include <cmath>

__device__ __forceinline__ int ltid(int wave) { int l; asm volatile("v_mbcnt_lo_u32_b32 %0, -1, 0\n\tv_mbcnt_hi_u32_b32 %0, -1, %0" : "=v"(l)); return (wave << 6) | l; }

namespace pg8 {
#define PG8_LAS __attribute__((address_space(3)))
typedef unsigned short bf16_t;
typedef short bf16x8 __attribute__((ext_vector_type(8)));
typedef float f32x4 __attribute__((ext_vector_type(4)));
typedef unsigned u32x4 __attribute__((ext_vector_type(4)));
typedef int i32x4_t __attribute__((ext_vector_type(4)));
typedef int i32x8_t __attribute__((ext_vector_type(8)));
constexpr int BM = 256, BK = 64, HALF = 128, HTB = HALF * BK * 2  , STAGE_BYTES = 8 * HTB, NXCD = 8, WGM = 8;
constexpr float C2 = 0.125f * 1.4426950408889634f;

__host__ __device__ __forceinline__ int lds_byte(int r, int c) { const int st = (r >> 4) * 2 + (c >> 5), rr = r & 15, cc = c & 31, ob = rr * 64 + cc * 2; return st * 1024 + (ob ^ (((ob >> 9) & 1) << 5)); }
__host__ __device__ __forceinline__ void stage_rc(int b, int& R, int& C) { const int st = b / 1024, sb = b % 1024, swz = sb ^ (((sb >> 9) & 1) << 5); R = (st >> 1) * 16 + swz / 64; C = (st & 1) * 32 + (swz % 64) / 2; }
__host__ __device__ __forceinline__ int perm32(int rho) { const int n = rho >> 4, i = rho & 15; return 8 * (i >> 2) + 4 * n + (i & 3); }

struct Unit { int pm, pn; long boff; };
struct Gemm { const bf16_t* A; const bf16_t* Bt; int K, lda, ldb; const int* rows; };

struct StaticOrder {
    int nM, nN, nwg, G, c, ldb;
    __device__ void init(int M, int N, int G_, int c_, int ldb_) { nM = M / BM; nN = N / BM; nwg = nM * nN; G = G_; c = c_; ldb = ldb_; }
    __device__ bool next(int i, Unit& u) const {
        const long L = (long)i * G + c; if (L >= nwg) return false;
        int wgid = (int)L; { const int q = nwg / NXCD, r = nwg % NXCD, xcd = wgid % NXCD, off = wgid / NXCD; wgid = (xcd < r ? xcd * (q + 1) : r * (q + 1) + (xcd - r) * q) + off; }
        const int nig = WGM * nN, gid = wgid / nig, fm = gid * WGM, gsz = (nM - fm) < WGM ? (nM - fm) : WGM;
        u.pm = fm + ((wgid % nig) % gsz); u.pn = (wgid % nig) / gsz; u.boff = (long)u.pn * BM * ldb; return true;
    }
};

__device__ __forceinline__ unsigned cvt_pk_bf16(float lo, float hi) { unsigned r; asm volatile("v_cvt_pk_bf16_f32 %0, %1, %2" : "=v"(r) : "v"(lo), "v"(hi)); return r; }
__device__ __forceinline__ float bf_lo(unsigned w) { return __uint_as_float(w << 16); }
__device__ __forceinline__ float bf_hi(unsigned w) { return __uint_as_float(w & 0xffff0000u); }
__device__ __forceinline__ float sigm(float x) { return __builtin_amdgcn_rcpf(1.f + __builtin_amdgcn_exp2f(-1.4426950408889634f * x)); }
__device__ __forceinline__ u32x4 pack8(f32x4 a, f32x4 b) { u32x4 w; w.x = cvt_pk_bf16(a[0], a[1]); w.y = cvt_pk_bf16(a[2], a[3]); w.z = cvt_pk_bf16(b[0], b[1]); w.w = cvt_pk_bf16(b[2], b[3]); return w; }
__device__ __forceinline__ void unpack8(u32x4 w, f32x4& a, f32x4& b) { a = (f32x4){bf_lo(w.x), bf_hi(w.x), bf_lo(w.y), bf_hi(w.y)}; b = (f32x4){bf_lo(w.z), bf_hi(w.z), bf_lo(w.w), bf_hi(w.w)}; }

#define PG8_EPI_ARGS const f32x4 (&acc)[2][2][4][2], const Unit& u, int wr, int wc, int fr, int fq

#define PG8_PIN(x) asm volatile("" : "+v"(x))
template <class T> __device__ __forceinline__ T& at(const void* base, unsigned byteoff) { return *(T*)((char*)base + byteoff); }

__device__ __forceinline__ float xor16(float v, int fq) { const auto r = __builtin_amdgcn_permlane16_swap(__float_as_uint(v), __float_as_uint(v), false, false); return __uint_as_float((fq & 1) ? r[0] : r[1]); }
struct EpiProj {
    bf16_t* base; size_t tstride; bf16_t* IK; float* IW; const float* rope;
    __device__ __forceinline__ void operator()(PG8_EPI_ARGS) const {
        const int pn = u.pn, row0 = u.pm * BM + wr * 64 + fr;
        if (pn < 14) {
            const int t = pn >> 1;
            bf16_t* dst = base + (size_t)t * tstride;
            const bool rp = (t == 0) | (t == 1) | (t == 3) | (t == 4) | (t == 6);
            const float sc = (t == 0 || t == 3) ? C2 : (t == 6 ? 0.125f : 1.f);
            const bool rotw = rp && ((wc & 1) == 0);
            const unsigned cb = (unsigned)((pn & 1) * 256 + wc * 32 + 8 * fq) * 2u;
            constexpr int RB = 2; f32x4 rq[RB][4];
#define PG8_RP_LD(it) do { if (rotw) { unsigned r_ = (unsigned)(row0 + ((it) >> 2) * HALF + ((it) & 3) * 16); PG8_PIN(r_); \
                rq[(it) % RB][0] = at<const f32x4>(rope, r_ * 64u); rq[(it) % RB][1] = at<const f32x4>(rope, r_ * 64u + 16u); rq[(it) % RB][2] = at<const f32x4>(rope, r_ * 64u + 32u); rq[(it) % RB][3] = at<const f32x4>(rope, r_ * 64u + 48u); } } while (0)
#pragma unroll
            for (int it = 0; it < RB; ++it) PG8_RP_LD(it);
#pragma unroll
            for (int ai = 0; ai < 2; ++ai)
#pragma unroll
                for (int m = 0; m < 4; ++m) { const int it = ai * 4 + m;
                    unsigned row = (unsigned)(row0 + ai * HALF + m * 16); PG8_PIN(row);
                    f32x4 c0 = {1.f, 1.f, 1.f, 1.f}, c1 = c0, s0 = {0.f, 0.f, 0.f, 0.f}, s1 = s0;
                    if (rotw) { c0 = rq[it % RB][0]; c1 = rq[it % RB][1]; s0 = rq[it % RB][2]; s1 = rq[it % RB][3]; }
                    if (it + RB < 8) PG8_RP_LD(it + RB);
#pragma unroll
                    for (int bj = 0; bj < 2; ++bj) {
                        f32x4 v0 = acc[ai][bj][m][0], v1 = acc[ai][bj][m][1];
                        if (rotw) {
                            f32x4 p0, p1;
#pragma unroll
                            for (int i = 0; i < 4; ++i) { p0[i] = xor16(v0[i], fq); p1[i] = xor16(v1[i], fq); }
                            const float sg = (fq == 0) ? -1.f : 1.f;
                            const f32x4 r0 = v0 * c0 + (p0 * s0) * sg, r1 = v1 * c1 + (p1 * s1) * sg;
                            if (fq < 2) { v0 = r0; v1 = r1; }
                        }
                        v0 = v0 * sc; v1 = v1 * sc;
                        at<u32x4>(dst, row * 1024u + cb + bj * 256u) = pack8(v0, v1);
                    }
                    asm volatile("" ::: "memory");
                }
#undef PG8_RP_LD
        } else {
#pragma unroll
            for (int ai = 0; ai < 2; ++ai)
#pragma unroll
                for (int m = 0; m < 4; ++m) {
                    unsigned row = (unsigned)(row0 + ai * HALF + m * 16); PG8_PIN(row);
                    f32x4 v0 = acc[ai][0][m][0], v1 = acc[ai][0][m][1];
                    if (wc == 0) {
                        const f32x4 c0 = at<const f32x4>(rope, row * 64u), c1 = at<const f32x4>(rope, row * 64u + 16u), s0 = at<const f32x4>(rope, row * 64u + 32u), s1 = at<const f32x4>(rope, row * 64u + 48u);
                        f32x4 p0, p1;
#pragma unroll
                        for (int i = 0; i < 4; ++i) { p0[i] = xor16(v0[i], fq); p1[i] = xor16(v1[i], fq); }
                        const float sg = (fq == 0) ? -1.f : 1.f;
                        const f32x4 r0 = v0 * c0 + (p0 * s0) * sg, r1 = v1 * c1 + (p1 * s1) * sg;
                        if (fq < 2) { v0 = r0; v1 = r1; }
                    }
                    if (wc < 2) at<u32x4>(IK, row * 128u + (unsigned)(wc * 32 + 8 * fq) * 2u) = pack8(v0, v1);
                    else if (wc == 2 && fq == 0) { at<f32x4>(IW, row * 32u) = v0 * 0.35355339059f; at<f32x4>(IW, row * 32u + 16u) = v1 * 0.35355339059f; }
                    asm volatile("" ::: "memory");
                }
        }
    }
};
struct EpiSig {
    unsigned char* out; int ldc; float pre;
    __device__ __forceinline__ void operator()(PG8_EPI_ARGS) const {
        const unsigned o0 = (unsigned)(u.pm * BM + wr * 64 + fr) * 1024u + (unsigned)(u.pn * BM + wc * 32 + 8 * fq);
#pragma unroll
        for (int ai = 0; ai < 2; ++ai)
#pragma unroll
            for (int m = 0; m < 4; ++m) {
                unsigned o = o0 + (unsigned)(ai * HALF + m * 16) * 1024u; PG8_PIN(o);
#pragma unroll
                for (int bj = 0; bj < 2; ++bj) {
                    const f32x4 v0 = acc[ai][bj][m][0], v1 = acc[ai][bj][m][1];
                    unsigned w0 = 0u, w1 = 0u;
#pragma unroll
                    for (int i = 0; i < 4; ++i) { w0 = __builtin_amdgcn_cvt_pk_u8_f32(sigm(v0[i] * pre) * 255.f, i, w0); w1 = __builtin_amdgcn_cvt_pk_u8_f32(sigm(v1[i] * pre) * 255.f, i, w1); }
                    at<unsigned long long>(out, o + bj * 128u) = (unsigned long long)w0 | ((unsigned long long)w1 << 32);
                }
                asm volatile("" ::: "memory");
            }
    }
};
template <bool ADD>
struct EpiGatedT {
    const unsigned char* gate; const bf16_t* addsrc; bf16_t* out; int ldc;
    __device__ __forceinline__ void operator()(PG8_EPI_ARGS) const {
        const unsigned o0 = ((unsigned)(u.pm * BM + wr * 64 + fr) * 1024u + (unsigned)(u.pn * BM + wc * 32 + 8 * fq)) * 2u;
        constexpr int NB = 2;
        unsigned long long gq[NB][2]; u32x4 aq[ADD ? NB : 1][2];
#define PG8_GT_LD(it) do { unsigned o_ = o0 + (unsigned)(((it) >> 2) * HALF + ((it) & 3) * 16) * 2048u; PG8_PIN(o_); \
            gq[(it) % NB][0] = at<const unsigned long long>(gate, o_ >> 1); gq[(it) % NB][1] = at<const unsigned long long>(gate, (o_ >> 1) + 128u); \
            if constexpr (ADD) { aq[(it) % NB][0] = at<const u32x4>(addsrc, o_); aq[(it) % NB][1] = at<const u32x4>(addsrc, o_ + 256u); } } while (0)
#pragma unroll
        for (int it = 0; it < NB; ++it) PG8_GT_LD(it);
#pragma unroll
        for (int it = 0; it < 8; ++it) { const int ai = it >> 2, m = it & 3;
                unsigned o = o0 + (unsigned)(ai * HALF + m * 16) * 2048u; PG8_PIN(o);
                f32x4 v0[2], v1[2];
#pragma unroll
                for (int bj = 0; bj < 2; ++bj) {
                    const unsigned long long gw = gq[it % NB][bj]; const unsigned glo = (unsigned)gw, ghi = (unsigned)(gw >> 32); constexpr float K8 = 1.f / 255.f;
                    const f32x4 g0 = {(float)(glo & 0xffu) * K8, (float)((glo >> 8) & 0xffu) * K8, (float)((glo >> 16) & 0xffu) * K8, (float)(glo >> 24) * K8};
                    const f32x4 g1 = {(float)(ghi & 0xffu) * K8, (float)((ghi >> 8) & 0xffu) * K8, (float)((ghi >> 16) & 0xffu) * K8, (float)(ghi >> 24) * K8};
                    v0[bj] = acc[ai][bj][m][0] * g0; v1[bj] = acc[ai][bj][m][1] * g1;
                    if constexpr (ADD) { f32x4 a0, a1; unpack8(aq[it % NB][bj], a0, a1); v0[bj] = v0[bj] + a0; v1[bj] = v1[bj] + a1; }
                }
                if (it + NB < 8) PG8_GT_LD(it + NB);
#pragma unroll
                for (int bj = 0; bj < 2; ++bj) at<u32x4>(out, o + bj * 256u) = pack8(v0[bj], v1[bj]);
                asm volatile("" ::: "memory");
            }
#undef PG8_GT_LD
    }
};
struct EpiResBf16 {
    const bf16_t* x; bf16_t* out; float alpha;
    __device__ __forceinline__ void operator()(PG8_EPI_ARGS) const {
        const unsigned o0 = ((unsigned)(u.pm * BM + wr * 64 + fr) * 1024u + (unsigned)(u.pn * BM + wc * 32 + 8 * fq)) * 2u;
        u32x4 xq[8][2];
#define PG8_X_LD(buf, it) do { unsigned o_ = o0 + (unsigned)(((it) >> 2) * HALF + ((it) & 3) * 16) * 2048u; PG8_PIN(o_); \
            xq[buf][0] = at<const u32x4>(x, o_); xq[buf][1] = at<const u32x4>(x, o_ + 256u); } while (0)
#pragma unroll
        for (int it = 0; it < 8; ++it) PG8_X_LD(it, it);
#pragma unroll
        for (int it = 0; it < 8; ++it) { const int ai = it >> 2, m = it & 3;
                unsigned o = o0 + (unsigned)(ai * HALF + m * 16) * 2048u; PG8_PIN(o);
#pragma unroll
                for (int bj = 0; bj < 2; ++bj) { f32x4 x0, x1; unpack8(xq[it][bj], x0, x1);
                    at<u32x4>(out, o + bj * 256u) = pack8(x0 * alpha + acc[ai][bj][m][0], x1 * alpha + acc[ai][bj][m][1]); }
                asm volatile("" ::: "memory");
            }
#undef PG8_X_LD
    }
};
struct EpiGU {
    bf16_t* HG; const float* cw; float pre;
    __device__ __forceinline__ void operator()(PG8_EPI_ARGS) const {
        const int row0 = u.pm * BM + wr * 64 + fr; const unsigned cb = (unsigned)(u.pn * HALF + wc * 32 + 8 * fq) * 2u;
        float cv[8];
#pragma unroll
        for (int it = 0; it < 8; ++it) cv[it] = at<const float>(cw, (unsigned)(row0 + (it >> 2) * HALF + (it & 3) * 16) * 4u);
#pragma unroll
        for (int it = 0; it < 8; ++it) { const int ai = it >> 2, m = it & 3;
                unsigned row = (unsigned)(row0 + ai * HALF + m * 16); PG8_PIN(row);
                const float c = cv[it];
                f32x4 g0 = acc[ai][0][m][0] * pre, g1 = acc[ai][0][m][1] * pre; const f32x4 u0 = acc[ai][1][m][0] * pre, u1 = acc[ai][1][m][1] * pre;
#pragma unroll
                for (int i = 0; i < 4; ++i) { g0[i] = g0[i] * sigm(g0[i]) * u0[i] * c; g1[i] = g1[i] * sigm(g1[i]) * u1[i] * c; }
                at<u32x4>(HG, row * 512u + cb) = pack8(g0, g1);
                asm volatile("" ::: "memory");
            }
    }
};
struct EpiDown {
    const int* ent; bf16_t* Y0; unsigned ystride;
    __device__ __forceinline__ void operator()(PG8_EPI_ARGS) const {
        const int row0 = u.pm * BM + wr * 64 + fr; const unsigned cb = (unsigned)(u.pn * BM + wc * 32 + 8 * fq) * 2u;
        int ev[8];
#pragma unroll
        for (int it = 0; it < 8; ++it) ev[it] = at<const int>(ent, (unsigned)(row0 + (it >> 2) * HALF + (it & 3) * 16) * 4u);
#pragma unroll
        for (int it = 0; it < 8; ++it) { const int ai = it >> 2, m = it & 3; const int e = ev[it];
                if (e >= 0) { unsigned o = (unsigned)(e >> 1) * 2048u + cb + (unsigned)(e & 1) * ystride; PG8_PIN(o);
#pragma unroll
                    for (int bj = 0; bj < 2; ++bj) at<u32x4>(Y0, o + bj * 256u) = pack8(acc[ai][bj][m][0], acc[ai][bj][m][1]); }
                asm volatile("" ::: "memory");
            }
    }
};
struct EpiStore {
    bf16_t* out; int ldc;
    __device__ __forceinline__ void operator()(PG8_EPI_ARGS) const {
        const unsigned o0 = ((unsigned)(u.pm * BM + wr * 64 + fr) * 1024u + (unsigned)(u.pn * BM + wc * 32 + 8 * fq)) * 2u;
#pragma unroll
        for (int ai = 0; ai < 2; ++ai)
#pragma unroll
            for (int m = 0; m < 4; ++m) {
                unsigned o = o0 + (unsigned)(ai * HALF + m * 16) * 2048u; PG8_PIN(o);
#pragma unroll
                for (int bj = 0; bj < 2; ++bj) at<u32x4>(out, o + bj * 256u) = pack8(acc[ai][bj][m][0], acc[ai][bj][m][1]);
                asm volatile("" ::: "memory");
            }
    }
};
struct EpiPle {
    const bf16_t* t1; bf16_t* out; float pre;
    __device__ __forceinline__ void operator()(PG8_EPI_ARGS) const {
        const unsigned o0 = ((unsigned)(u.pm * BM + wr * 64 + fr) * 1024u + (unsigned)(u.pn * BM + wc * 32 + 8 * fq)) * 2u;
        u32x4 tq[8][2];
#define PG8_T_LD(buf, it) do { unsigned o_ = o0 + (unsigned)(((it) >> 2) * HALF + ((it) & 3) * 16) * 2048u; PG8_PIN(o_); \
            tq[buf][0] = at<const u32x4>(t1, o_); tq[buf][1] = at<const u32x4>(t1, o_ + 256u); } while (0)
#pragma unroll
        for (int it = 0; it < 8; ++it) PG8_T_LD(it, it);
#pragma unroll
        for (int it = 0; it < 8; ++it) { const int ai = it >> 2, m = it & 3;
                unsigned o = o0 + (unsigned)(ai * HALF + m * 16) * 2048u; PG8_PIN(o);
#pragma unroll
                for (int bj = 0; bj < 2; ++bj) {
                    f32x4 t0, t1v; unpack8(tq[it][bj], t0, t1v);
                    f32x4 v0 = acc[ai][bj][m][0], v1 = acc[ai][bj][m][1];
#pragma unroll
                    for (int i = 0; i < 4; ++i) { v0[i] = sigm(v0[i] * pre) * t0[i]; v1[i] = sigm(v1[i] * pre) * t1v[i]; }
                    at<u32x4>(out, o + bj * 256u) = pack8(v0, v1);
                }
                asm volatile("" ::: "memory");
            }
#undef PG8_T_LD
    }
};

template <class Epi, class Sched, bool ALIGN_EPI, bool GATHER = false, bool FP8 = false>
__device__ __forceinline__ void gemm_phase(PG8_LAS unsigned char* lds, const Gemm g, const Sched& S, const Epi& E, int wave_in) {
    const int tid = ltid(wave_in), wid = __builtin_amdgcn_readfirstlane(tid >> 6), lane = tid & 63, wr = wid >> 2, wc = wid & 3, fr = lane & 15, fq = lane >> 4;
    int K_ = g.K; asm volatile("" : "+s"(K_));
    const int K = K_, nt = K / BK;
    int RA[2], CA[2]; unsigned voffB[2], voffA[2];
#pragma unroll
    for (int i = 0; i < 2; ++i) { int R, C; stage_rc(tid * 16 + i * 8192, R, C); const int Rb = (R & ~31) + perm32(R & 31); RA[i] = R; CA[i] = C; voffB[i] = (unsigned)(Rb * g.ldb + C) * 2u; voffA[i] = (unsigned)(R * g.lda + C) * 2u; }
    const size_t hstepA = (size_t)HALF * g.lda * 2;
    const size_t kstep = (size_t)(BK * 2);
    const size_t hstepB = (size_t)HALF * g.ldb * 2;
    const unsigned ldsw = (unsigned)wid * 1024u;
    const int aoff = lds_byte(wr * 64 + fr, fq * 8), boff = lds_byte(wc * 32 + fr, fq * 8);
    const char* Ab = (const char*)g.A;
#define PG8_SA(b, h) (((b) * 2 + (h)) * HTB)
#define PG8_SB(b, h) ((4 + (b) * 2 + (h)) * HTB)
#define PG8_STAGE_A(bufoff, kb, OFF, h) do { _Pragma("unroll") for (int _i = 0; _i < 2; ++_i) { const char* _p; \
        if constexpr (GATHER) _p = Ab + (kb) + (OFF##_v)[h][_i]; else _p = Ab + ((kb) + (OFF##_u) + (size_t)(h) * hstepA) + voffA[_i]; \
        __builtin_amdgcn_global_load_lds((const unsigned*)_p, (PG8_LAS unsigned*)(lds + (bufoff) + ldsw + _i * 8192), 16, 0, 0); } } while (0)
#define PG8_STAGE_B(bufoff, gbase) do { _Pragma("unroll") for (int _i = 0; _i < 2; ++_i) \
        __builtin_amdgcn_global_load_lds((const unsigned*)((const char*)(gbase) + voffB[_i]), (PG8_LAS unsigned*)(lds + (bufoff) + ldsw + _i * 8192), 16, 0, 0); } while (0)
#define PG8_MKOFF(uu, OFF) do { if constexpr (GATHER) { _Pragma("unroll") for (int _h = 0; _h < 2; ++_h) _Pragma("unroll") for (int _i = 0; _i < 2; ++_i) { \
        const int _row = g.rows[(uu).pm * BM + _h * HALF + RA[_i]]; (OFF##_v)[_h][_i] = (unsigned)(_row * g.lda + CA[_i]) * 2u; } } else { OFF##_u = (size_t)(uu).pm * BM * g.lda * 2; } } while (0)
#define PG8_LDA(dst, b, h) do { _Pragma("unroll") for (int m = 0; m < 4; ++m) { if constexpr (FP8) { dst##8[m].lo = *(const PG8_LAS i32x4_t*)(lds + PG8_SA(b, h) + aoff + m * 2048); dst##8[m].hi = *(const PG8_LAS i32x4_t*)(lds + PG8_SA(b, h) + aoff + m * 2048 + 1024); } \
        else { _Pragma("unroll") for (int k = 0; k < 2; ++k) dst[m][k] = *(const PG8_LAS bf16x8*)(lds + PG8_SA(b, h) + aoff + m * 2048 + k * 1024); } } } while (0)
#define PG8_LDB(dst, b, h) do { _Pragma("unroll") for (int n = 0; n < 2; ++n) { if constexpr (FP8) { dst##8[n].lo = *(const PG8_LAS i32x4_t*)(lds + PG8_SB(b, h) + boff + n * 2048); dst##8[n].hi = *(const PG8_LAS i32x4_t*)(lds + PG8_SB(b, h) + boff + n * 2048 + 1024); } \
        else { _Pragma("unroll") for (int k = 0; k < 2; ++k) dst[n][k] = *(const PG8_LAS bf16x8*)(lds + PG8_SB(b, h) + boff + n * 2048 + k * 1024); } } } while (0)
#define PG8_MMA(ai, bj, At, Bt) do { __builtin_amdgcn_s_setprio(1); \
        if constexpr (FP8) { _Pragma("unroll") for (int m = 0; m < 4; ++m) _Pragma("unroll") for (int n = 0; n < 2; ++n) \
            asm volatile("v_mfma_f32_16x16x128_f8f6f4 %0, %1, %2, %0" : "+v"(acc[ai][bj][m][n]) : "v"(Bt##8[n]), "v"(At##8[m])); }   \
        else { _Pragma("unroll") for (int m = 0; m < 4; ++m) _Pragma("unroll") for (int n = 0; n < 2; ++n) _Pragma("unroll") for (int k = 0; k < 2; ++k) \
            acc[ai][bj][m][n] = __builtin_amdgcn_mfma_f32_16x16x32_bf16(Bt[n][k], At[m][k], acc[ai][bj][m][n], 0, 0, 0); } __builtin_amdgcn_s_setprio(0); } while (0)
#define PG8_WAIT_V(n) asm volatile("s_waitcnt vmcnt(" #n ")" ::: "memory")
#define PG8_WAIT_L(n) asm volatile("s_waitcnt lgkmcnt(" #n ")" ::: "memory")
#define PG8_BAR __builtin_amdgcn_s_barrier()
#define PG8_SCHED __builtin_amdgcn_sched_barrier(0)
    Unit cur, nxt; int ui = 0;
    if (!S.next(0, cur)) return;
    f32x4 acc[2][2][4][2];
#pragma unroll
    for (int a = 0; a < 2; ++a)
#pragma unroll
        for (int b = 0; b < 2; ++b)
#pragma unroll
            for (int m = 0; m < 4; ++m)
#pragma unroll
                for (int n = 0; n < 2; ++n) acc[a][b][m][n] = (f32x4){0.f, 0.f, 0.f, 0.f};
    bf16x8 At[4][2], B0[2][2], B1[2][2];
    i32x8_t At8[4], B08[2], B18[2];
    unsigned offAc_v[2][2], offAn_v[2][2]; size_t offAc_u = 0, offAn_u = 0;
    PG8_MKOFF(cur, offAc);
    const char* cB = (const char*)(g.Bt + cur.boff);
    PG8_STAGE_B(PG8_SB(0, 0), cB); PG8_STAGE_B(PG8_SB(0, 1), cB + hstepB); PG8_STAGE_A(PG8_SA(0, 0), 0, offAc, 0); PG8_STAGE_A(PG8_SA(0, 1), 0, offAc, 1);
    if (wr == 1) PG8_BAR;
    PG8_WAIT_V(2); PG8_BAR;
    PG8_STAGE_B(PG8_SB(1, 0), cB + kstep); PG8_STAGE_A(PG8_SA(1, 0), kstep, offAc, 0); PG8_STAGE_B(PG8_SB(1, 1), cB + hstepB + kstep);
    PG8_WAIT_V(6); PG8_BAR;
    for (;;) {
        const bool has_next = S.next(ui + 1, nxt);
        if (has_next) { PG8_MKOFF(nxt, offAn); }
        else { offAn_u = offAc_u;
#pragma unroll
            for (int h = 0; h < 2; ++h)
#pragma unroll
                for (int i = 0; i < 2; ++i) offAn_v[h][i] = offAc_v[h][i];
        }
        const char* nB = has_next ? (const char*)(g.Bt + nxt.boff) : cB;
        for (int t = 0; t < nt; t += 2) {
            const bool last = (t == nt - 2);
            const size_t a1k = (size_t)(t + 1) * kstep;
            const size_t a2k = last ? (size_t)0 : (size_t)(t + 2) * kstep; const char* b2 = last ? nB : cB + (size_t)(t + 2) * kstep;
            const size_t a3k = a2k + kstep; const char* b3 = b2 + kstep;
            unsigned o2_v[2][2]; const size_t o2_u = last ? offAn_u : offAc_u;
#pragma unroll
            for (int h = 0; h < 2; ++h)
#pragma unroll
                for (int i = 0; i < 2; ++i) o2_v[h][i] = last ? offAn_v[h][i] : offAc_v[h][i];
            PG8_LDB(B0, 0, 0); PG8_LDB(B1, 0, 1); PG8_SCHED; PG8_LDA(At, 0, 0); PG8_STAGE_A(PG8_SA(1, 1), a1k, offAc, 1);
            PG8_WAIT_V(8); PG8_WAIT_L(0); PG8_BAR; PG8_MMA(0, 0, At, B0); PG8_MMA(0, 1, At, B1); PG8_BAR; PG8_SCHED;
            PG8_LDA(At, 0, 1); PG8_STAGE_B(PG8_SB(0, 0), b2); PG8_STAGE_B(PG8_SB(0, 1), b2 + hstepB); PG8_STAGE_A(PG8_SA(0, 0), a2k, o2, 0);
            PG8_WAIT_V(8); PG8_WAIT_L(0); PG8_BAR; PG8_MMA(1, 0, At, B0); PG8_MMA(1, 1, At, B1); PG8_BAR; PG8_SCHED;
            PG8_LDB(B0, 1, 0); PG8_LDB(B1, 1, 1); PG8_SCHED; PG8_LDA(At, 1, 0); PG8_STAGE_A(PG8_SA(0, 1), a2k, o2, 1);
            PG8_WAIT_V(8); PG8_WAIT_L(0); PG8_BAR; PG8_MMA(0, 0, At, B0); PG8_MMA(0, 1, At, B1); PG8_BAR; PG8_SCHED;
            PG8_LDA(At, 1, 1); PG8_STAGE_B(PG8_SB(1, 0), b3); PG8_STAGE_B(PG8_SB(1, 1), b3 + hstepB); PG8_STAGE_A(PG8_SA(1, 0), a3k, o2, 0);
            PG8_WAIT_V(8); PG8_WAIT_L(0); PG8_BAR; PG8_MMA(1, 0, At, B0); PG8_MMA(1, 1, At, B1); PG8_BAR; PG8_SCHED;
        }
        if constexpr (ALIGN_EPI) { if (wr == 0) PG8_BAR; }
        if constexpr (FP8) asm volatile("s_nop 15\n\ts_nop 15\n\ts_nop 7" ::: "memory");
        E(acc, cur, wr, wc, fr, fq);
        if (!has_next) break;
#pragma unroll
        for (int a = 0; a < 2; ++a)
#pragma unroll
            for (int b = 0; b < 2; ++b)
#pragma unroll
                for (int m = 0; m < 4; ++m)
#pragma unroll
                    for (int n = 0; n < 2; ++n) acc[a][b][m][n] = (f32x4){0.f, 0.f, 0.f, 0.f};
        cur = nxt; cB = nB; ++ui; offAc_u = offAn_u;
#pragma unroll
        for (int h = 0; h < 2; ++h)
#pragma unroll
            for (int i = 0; i < 2; ++i) offAc_v[h][i] = offAn_v[h][i];
        if constexpr (ALIGN_EPI) { if (wr == 1) PG8_BAR; }
    }
    PG8_WAIT_V(0);
    if constexpr (!ALIGN_EPI) { if (wr == 0) PG8_BAR; }
    PG8_BAR;
#undef PG8_SA
#undef PG8_SB
#undef PG8_STAGE_A
#undef PG8_STAGE_B
#undef PG8_MKOFF
#undef PG8_LDA
#undef PG8_LDB
#undef PG8_MMA
#undef PG8_WAIT_V
#undef PG8_WAIT_L
#undef PG8_BAR
#undef PG8_SCHED
}
}
namespace attn_body {
using bf16=__hip_bfloat16;
using bf16x8=__attribute__((ext_vector_type(8)))short;
using s16x4=__attribute__((ext_vector_type(4)))short;
using f32x16=__attribute__((ext_vector_type(16)))float;
using u32x4=__attribute__((ext_vector_type(4)))unsigned;
constexpr int BATCH=2,SEQ=16384,D=64,DM=512;
constexpr int NW=8,QBLK=32,QB=QBLK*NW,KVBLK=64,NQB=SEQ/QB;
constexpr int ATTN_PITCH=DM, ATTN_UNIT_ROWS=QB;
__device__ __forceinline__ int crow(int r,int hi){return (r&3)+8*(r>>2)+4*hi;}
#define SBAR() __builtin_amdgcn_sched_barrier(0)
__device__ __forceinline__ void cmask(f32x16&p0,f32x16&p1,int jb,int qrel,int hi){
  const float NEG=-INFINITY; int kb=64*jb+4*hi;
  #pragma unroll
  for(int r=0;r<16;++r){int kv=kb+(r&3)+8*(r>>2); if(kv>qrel)p0[r]=NEG; if(kv+32>qrel)p1[r]=NEG;}
}

constexpr int NSLOT=3, SLOTB=8192;
constexpr int LDS_K=0, LDS_V=NSLOT*SLOTB, LDS_WS=2*NSLOT*SLOTB, LDS_OST=LDS_WS+NW*64*4, LDS_MK=LDS_OST+NW*4096, LDS_BYTES=LDS_MK+NW*1024, LDS_BYTES_WIDE=LDS_V+NSLOT*2*SLOTB+NW*64*4+NW*4096;
constexpr float C2=0.125f*1.4426950408889634f;
__device__ __forceinline__ void glds16(const void*gsrc,unsigned lds_dst){unsigned keep;
  asm volatile("s_mov_b32 %0, m0\n\ts_mov_b32 m0, %2\n\ts_nop 0\n\tglobal_load_lds_dwordx4 %1, off\n\ts_mov_b32 m0, %0":"=&s"(keep):"v"(gsrc),"s"(lds_dst):"memory");}
__device__ __forceinline__ float max3f(float a,float b,float c){float r;asm("v_max3_f32 %0, %1, %2, %3":"=v"(r):"v"(a),"v"(b),"v"(c));return r;}
__device__ __forceinline__ float max2f(float a,float b){float r;asm("v_max_f32_e32 %0, %1, %2":"=v"(r):"v"(a),"v"(b));return r;}
__device__ __forceinline__ float fadd_s(float a,float b){float r;asm("v_add_f32_e32 %0, %1, %2":"=v"(r):"v"(a),"v"(b));return r;}
__device__ __forceinline__ float fsub_s(float a,float b){float r;asm("v_sub_f32_e32 %0, %1, %2":"=v"(r):"v"(a),"v"(b));return r;}
typedef float f32x2_t __attribute__((ext_vector_type(2))); typedef __bf16 bf16x2_t __attribute__((ext_vector_type(2)));
__device__ __forceinline__ unsigned cvtpk_s(float lo,float hi){f32x2_t v={lo,hi};bf16x2_t b=__builtin_convertvector(v,bf16x2_t);return __builtin_bit_cast(unsigned,b);}
#define WAIT_BAR(N) asm volatile("s_waitcnt vmcnt(" #N ") lgkmcnt(0)\n\ts_barrier":::"memory")

__device__ __forceinline__ void qkt(f32x16&p0,f32x16&p1,const char*Kslot,const bf16x8*qr,const f32x16&ci0,const f32x16&ci1,int r32,int hi){
  const char*kb=Kslot+hi*1024+r32*16;
  #pragma unroll
  for(int d0=0;d0<4;++d0){
    const bf16x8 b0=*reinterpret_cast<const bf16x8*>(kb+d0*2048);
    const bf16x8 b1=*reinterpret_cast<const bf16x8*>(kb+d0*2048+512);
    if(d0==0){p0=__builtin_amdgcn_mfma_f32_32x32x16_bf16(b0,qr[0],ci0,0,0,0);p1=__builtin_amdgcn_mfma_f32_32x32x16_bf16(b1,qr[0],ci1,0,0,0);}
    else{p0=__builtin_amdgcn_mfma_f32_32x32x16_bf16(b0,qr[d0],p0,0,0,0);p1=__builtin_amdgcn_mfma_f32_32x32x16_bf16(b1,qr[d0],p1,0,0,0);}}
}
typedef __attribute__((address_space(3))) const char* lds_cptr;
typedef short v4i16_t __attribute__((ext_vector_type(4)));
__device__ __forceinline__ void kload8(bf16x8*kf,lds_cptr kp){
  kf[0]=*(const __attribute__((address_space(3))) bf16x8*)(kp);      kf[1]=*(const __attribute__((address_space(3))) bf16x8*)(kp+512);
  kf[2]=*(const __attribute__((address_space(3))) bf16x8*)(kp+2048); kf[3]=*(const __attribute__((address_space(3))) bf16x8*)(kp+2560);
  kf[4]=*(const __attribute__((address_space(3))) bf16x8*)(kp+4096); kf[5]=*(const __attribute__((address_space(3))) bf16x8*)(kp+4608);
  kf[6]=*(const __attribute__((address_space(3))) bf16x8*)(kp+6144); kf[7]=*(const __attribute__((address_space(3))) bf16x8*)(kp+6656);
}
__device__ __forceinline__ void kload2(bf16x8*kf,lds_cptr kp,int j){ kf[2*j]=*(const __attribute__((address_space(3))) bf16x8*)(kp+j*2048); kf[2*j+1]=*(const __attribute__((address_space(3))) bf16x8*)(kp+j*2048+512); }
__device__ __forceinline__ s16x4 vtr(lds_cptr p){ return __builtin_bit_cast(s16x4,__builtin_amdgcn_ds_read_tr16_b64_v4i16((__attribute__((address_space(3))) v4i16_t*)p)); }
__device__ __forceinline__ float rowmax(const f32x16&p0,const f32x16&p1){
  float a=max3f(p0[0],p0[1],p1[0]),b=max3f(p0[2],p0[3],p1[1]);a=max3f(a,p1[2],p1[3]);
  #pragma unroll
  for(int r=4;r<16;r+=4){a=max3f(a,p0[r],p0[r+1]);b=max3f(b,p0[r+2],p0[r+3]);a=max3f(a,p1[r],p1[r+1]);b=max3f(b,p1[r+2],p1[r+3]);}
  const float m=max2f(a,b);
  auto rr=__builtin_amdgcn_permlane32_swap(__float_as_uint(m),__float_as_uint(m),false,false);
  return max2f(__uint_as_float(rr[0]),__uint_as_float(rr[1]));
}
__device__ __forceinline__ void pv(f32x16*o,int vb,bf16x8 pa0,bf16x8 pa1,bf16x8 pa2,bf16x8 pa3){
  #pragma unroll
  for(int d0=0;d0<2;++d0){s16x4 lo[4],hi[4];
    #pragma unroll
    for(int ks=0;ks<4;++ks){
      asm volatile("ds_read_b64_tr_b16 %0,%1 offset:%c2":"=&v"(lo[ks]):"v"(vb),"i"(d0*4096+ks*1024):"memory");
      asm volatile("ds_read_b64_tr_b16 %0,%1 offset:%c2":"=&v"(hi[ks]):"v"(vb),"i"(d0*4096+ks*1024+512):"memory");}
    asm volatile("s_waitcnt lgkmcnt(0)":::"memory");SBAR();
    #define PK(k) (bf16x8){lo[k][0],lo[k][1],lo[k][2],lo[k][3],hi[k][0],hi[k][1],hi[k][2],hi[k][3]}
    o[d0]=__builtin_amdgcn_mfma_f32_32x32x16_bf16(pa0,PK(0),o[d0],0,0,0);
    o[d0]=__builtin_amdgcn_mfma_f32_32x32x16_bf16(pa1,PK(1),o[d0],0,0,0);
    o[d0]=__builtin_amdgcn_mfma_f32_32x32x16_bf16(pa2,PK(2),o[d0],0,0,0);
    o[d0]=__builtin_amdgcn_mfma_f32_32x32x16_bf16(pa3,PK(3),o[d0],0,0,0);
    #undef PK
  }
}

#ifndef ATTN_STORE16
#define ATTN_STORE16(p,v) (*(u32x4*)(p)=(v))
#endif
template<int THRL,bool MASKED,bool WIDE,bool NOMAX> __device__ __forceinline__ void attn_unit(int b,int hq,int hv,int qb,const bf16*Q,const bf16*__restrict__ K,const bf16*__restrict__ V,bf16*O,const unsigned long long*__restrict__ MK,char*shm,int wave_in,int badoff){
  const int tid=ltid(wave_in),lane=tid&63,r32=lane&31,hi=lane>>5; const int wid=__builtin_amdgcn_readfirstlane(tid>>6);
  const long rowbase=(long)b*SEQ; const int q0=qb*QB;
  const bf16*Qw=Q+(rowbase+q0+wid*QBLK)*DM+hq*D;
  const bf16*Kh=K+rowbase*DM+hq*D,*Vh=V+rowbase*DM+hv*D;
  constexpr int VSLOT=WIDE?2*SLOTB:SLOTB, L_WS=LDS_V+NSLOT*VSLOT, L_OST=L_WS+NW*64*4, L_MK=L_OST+NW*4096, L_TAB=L_MK+NW*2048;
  #define VS(sl) (WIDE?2*(sl):(sl))
  const unsigned lds0=(unsigned)(uintptr_t)shm;
  float*wsf=(float*)(shm+L_WS)+wid*64;
  const bf16*ksrc=Kh+(long)lane*DM+wid*8;
  const bf16*vsrc=Vh+(long)(16*(wid&3)+(lane>>2))*DM+(wid>>2)*32+(lane&3)*8;
  const unsigned kdst=lds0+LDS_K+wid*1024, vdst=lds0+LDS_V+wid*1024;
  #define DMA_K(t,slot) glds16(ksrc+(long)(t)*KVBLK*DM,(unsigned)__builtin_amdgcn_readfirstlane(kdst+(slot)))
  #define DMA_V(t,slot) do{ glds16(vsrc+(long)(t)*KVBLK*DM,(unsigned)__builtin_amdgcn_readfirstlane(vdst+VS(slot))); if(WIDE){ glds16(vsrc+64+(long)(t)*KVBLK*DM,(unsigned)__builtin_amdgcn_readfirstlane(vdst+VS(slot)+8192)); } }while(0)
  const long mq0=(long)q0+wid*QBLK+2*(lane&15); const unsigned mdst=lds0+L_MK+wid*2048;
  #define DMA_M4(t0) do{ if(MASKED){ const long t_=(long)(t0)+(lane>>4); if(t_<NT){ glds16(MK+(16384L*t_-32L*t_*(t_-1)+mq0-64L*t_),(unsigned)__builtin_amdgcn_readfirstlane(mdst+(((t0)&7)*256))); } } }while(0)
  unsigned mw0=0u,mw1=0u;
  #define MKRD(t) do{ if(MASKED){ const unsigned long long w_=*(const __attribute__((address_space(3))) unsigned long long*)(shm3+L_MK+wid*2048+(((t)&7)*256)+r32*8); mw0=(unsigned)w_; mw1=(unsigned)(w_>>32); } }while(0)
  #define MAND(X,r,MW) do{}while(0)
  bf16x8 aid[2];
  if(MASKED){
    #pragma unroll
    for(int ks=0;ks<2;++ks)
      #pragma unroll
      for(int j=0;j<8;++j) aid[ks][j]=(short)((r32==16*ks+8*hi+j)?0x3F80:0);
  }
  #define TABRD(w,ks) (*(const __attribute__((address_space(3))) bf16x8*)(shm3+L_TAB+((((w)>>(16*(ks)+8*hi))&0xffu)<<4)))
  #define BIAS(C0,C1,CI) do{ const bf16x8 f00_=TABRD(mw0,0),f01_=TABRD(mw0,1),f10_=TABRD(mw1,0),f11_=TABRD(mw1,1); \
    C0=__builtin_amdgcn_mfma_f32_32x32x16_bf16(aid[0],f00_,CI,0,0,0); C1=__builtin_amdgcn_mfma_f32_32x32x16_bf16(aid[0],f10_,CI,0,0,0); \
    C0=__builtin_amdgcn_mfma_f32_32x32x16_bf16(aid[1],f01_,C0,0,0,0); C1=__builtin_amdgcn_mfma_f32_32x32x16_bf16(aid[1],f11_,C1,0,0,0); }while(0)
  const int vb0=(int)(lds0+LDS_V)+((lane>>4)&1)*32+(lane&3)*8+(4*hi+((lane&15)>>2))*64;
  const char*Kbase=shm+LDS_K; bf16x8 kf[8];
  const lds_cptr shm3=(lds_cptr)shm; const lds_cptr kp0=shm3+LDS_K+hi*1024+r32*16; const lds_cptr vp0=shm3+LDS_V+((lane>>4)&1)*32+(lane&3)*8+(4*hi+((lane&15)>>2))*64;
  const int NT=(q0+QB)/KVBLK;
  DMA_M4(0);DMA_K(0,0);DMA_V(0,0);DMA_K(1,SLOTB);
  bf16x8 qr[4];
  #pragma unroll
  for(int d0=0;d0<4;++d0)qr[d0]=*reinterpret_cast<const bf16x8*>(&Qw[(long)r32*DM+d0*16+hi*8]);
  float mhat=0.f,l_reg=0.f;f32x16 o[4];o[0]=f32x16{};o[1]=f32x16{};o[2]=f32x16{};o[3]=f32x16{};f32x16 negm=f32x16{}; if(!WIDE&&!NOMAX){ asm volatile("":"+v"(negm)); }
  const int qrel=wid*QBLK+r32;
  #define CMASK(P0,P1,t) do{int jb_=(t)-(NT-4); if(jb_>=0)cmask(P0,P1,jb_,qrel,hi);}while(0)
  bool resc=false;
  #define START(P0,P1) do{ resc=false; \
    if constexpr(!NOMAX){ const float rm=rowmax(P0,P1); const float dl=rm; mhat=fadd_s(mhat,dl); \
      _Pragma("unroll") for(int r=0;r<16;++r){P0[r]=fsub_s(P0[r],dl);P1[r]=fsub_s(P1[r],dl);} \
      if(!WIDE){ _Pragma("unroll") for(int r=0;r<16;++r)negm[r]=-mhat; asm volatile("":"+v"(negm)); } } \
    _Pragma("unroll") for(int r=0;r<16;++r)P0[r]=__builtin_amdgcn_exp2f(P0[r]); }while(0)
  #define RESC() do{ if constexpr(!NOMAX) if(resc){ asm volatile("s_waitcnt lgkmcnt(0)":::"memory"); \
      _Pragma("unroll") for(int d_=0;d_<(WIDE?4:2);++d_) _Pragma("unroll") for(int r=0;r<16;++r)o[d_][r]*=wsf[crow(r,hi)]; } }while(0)
  f32x16 pA0,pA1,pB0,pB1;
  int sl_prev=0,sl_cur=0,sl_next=SLOTB;
  #define ROT() do{sl_prev=sl_cur;sl_cur=sl_next;sl_next=(sl_next==(NSLOT-1)*SLOTB)?0:sl_next+SLOTB;}while(0)
  DMA_K(2,2*SLOTB); const bool m4b_=MASKED&&(4<NT); if(m4b_){DMA_M4(4);}
  if(WIDE||m4b_){WAIT_BAR(4);}else{WAIT_BAR(3);}
  if(MASKED){ MKRD(0); BIAS(pA0,pA1,negm); qkt(pA0,pA1,Kbase,qr,pA0,pA1,r32,hi); } else { qkt(pA0,pA1,Kbase,qr,negm,negm,r32,hi); }
  asm volatile("s_nop 15\n\ts_nop 7":"+v"(pA0),"+v"(pA1));CMASK(pA0,pA1,0);
  START(pA0,pA1);
  _Pragma("unroll") for(int r=0;r<16;++r)pA1[r]=__builtin_amdgcn_exp2f(pA1[r]);
  WAIT_BAR(0);
  DMA_K(3,0);DMA_V(1,SLOTB);
  ROT();
  kload8(kf,kp0+sl_cur);
  if(WIDE){WAIT_BAR(3);}else{WAIT_BAR(2);}
  s16x4 vlo[8],vhi[8]; u32x4 pw0,pw1,pw2,pw3;
  #define PKW(P,B) cvtpk_s(P[B],P[B+1])
  #define PAF(k) __builtin_bit_cast(bf16x8,pw##k)
  #define VFR(i) (bf16x8){vlo[i][0],vlo[i][1],vlo[i][2],vlo[i][3],vhi[i][0],vhi[i][1],vhi[i][2],vhi[i][3]}
  #define PIN(x) asm volatile("":"+v"(x))
  #define MX3(a,b,c) __builtin_fmaxf(__builtin_fmaxf((a),(b)),(c))
  #define GAPA(MF,A0,A1,A2,A3,W0,W1,PW) do{ MF; sacc+=A0; sacc+=A1; sacc+=A2; sacc+=A3; PIN(sacc); W0; W1; PIN(PW); SBAR(); }while(0)
  #define EX(v) __builtin_amdgcn_exp2f(v)
  #define GAPB(MF,X,B,MW) do{ MF; X[B]=EX(X[B]); X[B+1]=EX(X[B+1]); X[B+2]=EX(X[B+2]); X[B+3]=EX(X[B+3]); MAND(X,B,MW); MAND(X,B+1,MW); MAND(X,B+2,MW); MAND(X,B+3,MW); PIN(X); SBAR(); }while(0)
  #define GAPB2(MF,X,B) do{ MF; X[B]=EX(X[B]); X[B+1]=EX(X[B+1]); PIN(X); SBAR(); }while(0)
  #define VRD(i) do{ vlo[i]=vtr(vp_+(((i)>>2)*4096+((i)&3)*1024)); vhi[i]=vtr(vp_+(((i)>>2)*4096+((i)&3)*1024+512)); }while(0)
  #define KRD(G,j) do{ if(G){ kload2(kf,kp0+sl_next,j); SBAR(); } }while(0)
  #define STEP(C0,C1,P0,P1,t,GK,GV,GL,GM) do{ SBAR(); \
    const lds_cptr vp_=vp0+VS(sl_prev); \
    if(MASKED){ MKRD(t); BIAS(C0,C1,negm); SBAR(); } \
    VRD(0); SBAR(); float sacc=(P0[0]+P0[1]); \
    GAPA(C0=__builtin_amdgcn_mfma_f32_32x32x16_bf16(kf[0],qr[0],(MASKED?C0:negm),0,0,0), P0[2],P0[3],P0[4],P0[5],     pw0[0]=PKW(P0,0), pw0[1]=PKW(P0,2), pw0); \
    VRD(4); SBAR(); GAPA(C1=__builtin_amdgcn_mfma_f32_32x32x16_bf16(kf[1],qr[0],(MASKED?C1:negm),0,0,0), P0[6],P0[7],P0[8],P0[9],     pw0[2]=PKW(P0,4), pw0[3]=PKW(P0,6), pw0); \
    VRD(1); SBAR(); GAPA(C0=__builtin_amdgcn_mfma_f32_32x32x16_bf16(kf[2],qr[1],C0,0,0,0),   P0[10],P0[11],P0[12],P0[13], pw1[0]=PKW(P0,8), pw1[1]=PKW(P0,10), pw1); \
    VRD(5); SBAR(); GAPA(C1=__builtin_amdgcn_mfma_f32_32x32x16_bf16(kf[3],qr[1],C1,0,0,0),   P0[14],P0[15],P1[0],P1[1],   pw1[2]=PKW(P0,12),pw1[3]=PKW(P0,14), pw1); \
    VRD(2); SBAR(); GAPA(C0=__builtin_amdgcn_mfma_f32_32x32x16_bf16(kf[4],qr[2],C0,0,0,0),   P1[2],P1[3],P1[4],P1[5],     pw2[0]=PKW(P1,0), pw2[1]=PKW(P1,2), pw2); \
    VRD(6); SBAR(); GAPA(C1=__builtin_amdgcn_mfma_f32_32x32x16_bf16(kf[5],qr[2],C1,0,0,0),   P1[6],P1[7],P1[8],P1[9],     pw2[2]=PKW(P1,4), pw2[3]=PKW(P1,6), pw2); \
    VRD(3); SBAR(); GAPA(C0=__builtin_amdgcn_mfma_f32_32x32x16_bf16(kf[6],qr[3],C0,0,0,0),   P1[10],P1[11],P1[12],P1[13], pw3[0]=PKW(P1,8), pw3[1]=PKW(P1,10), pw3); \
    VRD(7); SBAR(); GAPA(C1=__builtin_amdgcn_mfma_f32_32x32x16_bf16(kf[7],qr[3],C1,0,0,0),   P1[14],P1[15],0.f,0.f,       pw3[2]=PKW(P1,12),pw3[3]=PKW(P1,14), pw3); \
    l_reg+=sacc; \
    if(GK){DMA_K((t)+3,sl_cur);} if(GV){DMA_V((t)+1,sl_next);} if(MASKED&&GM){ if((((t)&3)==0)&&((t)+4<NT)){DMA_M4((t)+4);} } \
    CMASK(C0,C1,t); \
    if constexpr(!NOMAX){ float a=MX3(C0[0],C0[1],C1[0]),b=MX3(C0[2],C0[3],C1[1]); a=MX3(a,C1[2],C1[3]); \
      _Pragma("unroll") for(int r=4;r<16;r+=4){a=MX3(a,C0[r],C0[r+1]);b=MX3(b,C0[r+2],C0[r+3]);a=MX3(a,C1[r],C1[r+1]);b=MX3(b,C1[r+2],C1[r+3]);} \
      float rm=__builtin_fmaxf(a,b); { auto rr=__builtin_amdgcn_permlane32_swap(__float_as_uint(rm),__float_as_uint(rm),false,false); rm=__builtin_fmaxf(__uint_as_float(rr[0]),__uint_as_float(rr[1])); } \
      resc=false; \
      if(__builtin_expect(__any(rm>(float)THRL),0)){ const float dl=__builtin_fmaxf(rm,0.f); mhat+=dl; \
        _Pragma("unroll") for(int r=0;r<16;++r){C0[r]-=dl;C1[r]-=dl;} \
        _Pragma("unroll") for(int r=0;r<16;++r)negm[r]=-mhat; asm volatile("":"+v"(negm)); \
        const float f=__builtin_amdgcn_exp2f(-dl); l_reg*=f; if(hi==0)wsf[r32]=f; resc=true; } } \
    SBAR(); \
    GAPB(o[0]=__builtin_amdgcn_mfma_f32_32x32x16_bf16(PAF(0),VFR(0),o[0],0,0,0), C0,0,mw0); \
    GAPB(o[1]=__builtin_amdgcn_mfma_f32_32x32x16_bf16(PAF(0),VFR(4),o[1],0,0,0), C0,4,mw0); \
    KRD(GL,0); GAPB(o[0]=__builtin_amdgcn_mfma_f32_32x32x16_bf16(PAF(1),VFR(1),o[0],0,0,0), C0,8,mw0); \
    KRD(GL,1); GAPB(o[1]=__builtin_amdgcn_mfma_f32_32x32x16_bf16(PAF(1),VFR(5),o[1],0,0,0), C0,12,mw0); \
    KRD(GL,2); GAPB(o[0]=__builtin_amdgcn_mfma_f32_32x32x16_bf16(PAF(2),VFR(2),o[0],0,0,0), C1,0,mw1); \
    KRD(GL,3); GAPB(o[1]=__builtin_amdgcn_mfma_f32_32x32x16_bf16(PAF(2),VFR(6),o[1],0,0,0), C1,4,mw1); \
    GAPB(o[0]=__builtin_amdgcn_mfma_f32_32x32x16_bf16(PAF(3),VFR(3),o[0],0,0,0), C1,8,mw1); \
    GAPB(o[1]=__builtin_amdgcn_mfma_f32_32x32x16_bf16(PAF(3),VFR(7),o[1],0,0,0), C1,12,mw1); \
    }while(0)
  #define VLD(n,f) do{ vlo[(n)&3]=vtr(vp_+(((f)>>2)*4096+((f)&3)*1024)); vhi[(n)&3]=vtr(vp_+(((f)>>2)*4096+((f)&3)*1024+512)); }while(0)
  #define VFW(n) (bf16x8){vlo[(n)&3][0],vlo[(n)&3][1],vlo[(n)&3][2],vlo[(n)&3][3],vhi[(n)&3][0],vhi[(n)&3][1],vhi[(n)&3][2],vhi[(n)&3][3]}
  #define PVN(OD,k,n,fnext) do{ OD=__builtin_amdgcn_mfma_f32_32x32x16_bf16(PAF(k),VFW(n),OD,0,0,0); SBAR(); if((fnext)>=0){ VLD(n,fnext); SBAR(); } }while(0)
  #define STEPW(C0,C1,P0,P1,t,GK,GV,GL) do{ SBAR(); \
    const lds_cptr vp_=vp0+VS(sl_prev); \
    VLD(0,0); SBAR(); float sacc=(P0[0]+P0[1]); f32x16 ci_=f32x16{}; if constexpr(!NOMAX){ const float nm_=-mhat; _Pragma("unroll") for(int r=0;r<16;++r)ci_[r]=nm_; }     \
    GAPA(C0=__builtin_amdgcn_mfma_f32_32x32x16_bf16(kf[0],qr[0],ci_,0,0,0), P0[2],P0[3],P0[4],P0[5],     pw0[0]=PKW(P0,0), pw0[1]=PKW(P0,2), pw0); \
    VLD(1,4); SBAR(); GAPA(C1=__builtin_amdgcn_mfma_f32_32x32x16_bf16(kf[1],qr[0],ci_,0,0,0), P0[6],P0[7],P0[8],P0[9],     pw0[2]=PKW(P0,4), pw0[3]=PKW(P0,6), pw0); \
    VLD(2,1); SBAR(); GAPA(C0=__builtin_amdgcn_mfma_f32_32x32x16_bf16(kf[2],qr[1],C0,0,0,0),   P0[10],P0[11],P0[12],P0[13], pw1[0]=PKW(P0,8), pw1[1]=PKW(P0,10), pw1); \
    VLD(3,5); SBAR(); GAPA(C1=__builtin_amdgcn_mfma_f32_32x32x16_bf16(kf[3],qr[1],C1,0,0,0),   P0[14],P0[15],P1[0],P1[1],   pw1[2]=PKW(P0,12),pw1[3]=PKW(P0,14), pw1); \
    GAPA(C0=__builtin_amdgcn_mfma_f32_32x32x16_bf16(kf[4],qr[2],C0,0,0,0),   P1[2],P1[3],P1[4],P1[5],     pw2[0]=PKW(P1,0), pw2[1]=PKW(P1,2), pw2); \
    GAPA(C1=__builtin_amdgcn_mfma_f32_32x32x16_bf16(kf[5],qr[2],C1,0,0,0),   P1[6],P1[7],P1[8],P1[9],     pw2[2]=PKW(P1,4), pw2[3]=PKW(P1,6), pw2); \
    GAPA(C0=__builtin_amdgcn_mfma_f32_32x32x16_bf16(kf[6],qr[3],C0,0,0,0),   P1[10],P1[11],P1[12],P1[13], pw3[0]=PKW(P1,8), pw3[1]=PKW(P1,10), pw3); \
    GAPA(C1=__builtin_amdgcn_mfma_f32_32x32x16_bf16(kf[7],qr[3],C1,0,0,0),   P1[14],P1[15],0.f,0.f,       pw3[2]=PKW(P1,12),pw3[3]=PKW(P1,14), pw3); \
    l_reg+=sacc; \
    if(GK){DMA_K((t)+3,sl_cur);} if(GV){DMA_V((t)+1,sl_next);} \
    CMASK(C0,C1,t); \
    if constexpr(!NOMAX){ float a=MX3(C0[0],C0[1],C1[0]),b=MX3(C0[2],C0[3],C1[1]); a=MX3(a,C1[2],C1[3]); \
      _Pragma("unroll") for(int r=4;r<16;r+=4){a=MX3(a,C0[r],C0[r+1]);b=MX3(b,C0[r+2],C0[r+3]);a=MX3(a,C1[r],C1[r+1]);b=MX3(b,C1[r+2],C1[r+3]);} \
      float rm=__builtin_fmaxf(a,b); { auto rr=__builtin_amdgcn_permlane32_swap(__float_as_uint(rm),__float_as_uint(rm),false,false); rm=__builtin_fmaxf(__uint_as_float(rr[0]),__uint_as_float(rr[1])); } \
      resc=false; \
      if(__builtin_expect(__any(rm>(float)THRL),0)){ const float dl=__builtin_fmaxf(rm,0.f); mhat+=dl; \
        _Pragma("unroll") for(int r=0;r<16;++r){C0[r]-=dl;C1[r]-=dl;} \
        const float f=__builtin_amdgcn_exp2f(-dl); l_reg*=f; if(hi==0)wsf[r32]=f; resc=true; } } \
    SBAR(); \
    GAPB2(o[0]=__builtin_amdgcn_mfma_f32_32x32x16_bf16(PAF(0),VFW(0),o[0],0,0,0), C0,0); VLD(0,2); SBAR(); \
    GAPB2(o[1]=__builtin_amdgcn_mfma_f32_32x32x16_bf16(PAF(0),VFW(1),o[1],0,0,0), C0,2); VLD(1,6); SBAR(); \
    KRD(GL,0); GAPB2(o[0]=__builtin_amdgcn_mfma_f32_32x32x16_bf16(PAF(1),VFW(2),o[0],0,0,0), C0,4); VLD(2,3); SBAR(); \
    KRD(GL,1); GAPB2(o[1]=__builtin_amdgcn_mfma_f32_32x32x16_bf16(PAF(1),VFW(3),o[1],0,0,0), C0,6); VLD(3,7); SBAR(); \
    KRD(GL,2); GAPB2(o[0]=__builtin_amdgcn_mfma_f32_32x32x16_bf16(PAF(2),VFW(4),o[0],0,0,0), C0,8); VLD(4,8); SBAR(); \
    KRD(GL,3); GAPB2(o[1]=__builtin_amdgcn_mfma_f32_32x32x16_bf16(PAF(2),VFW(5),o[1],0,0,0), C0,10); VLD(5,12); SBAR(); \
    GAPB2(o[0]=__builtin_amdgcn_mfma_f32_32x32x16_bf16(PAF(3),VFW(6),o[0],0,0,0), C0,12); VLD(6,9); SBAR(); \
    GAPB2(o[1]=__builtin_amdgcn_mfma_f32_32x32x16_bf16(PAF(3),VFW(7),o[1],0,0,0), C0,14); VLD(7,13); SBAR(); \
    GAPB2(o[2]=__builtin_amdgcn_mfma_f32_32x32x16_bf16(PAF(0),VFW(8),o[2],0,0,0), C1,0); VLD(8,10); SBAR(); \
    GAPB2(o[3]=__builtin_amdgcn_mfma_f32_32x32x16_bf16(PAF(0),VFW(9),o[3],0,0,0), C1,2); VLD(9,14); SBAR(); \
    GAPB2(o[2]=__builtin_amdgcn_mfma_f32_32x32x16_bf16(PAF(1),VFW(10),o[2],0,0,0), C1,4); VLD(10,11); SBAR(); \
    GAPB2(o[3]=__builtin_amdgcn_mfma_f32_32x32x16_bf16(PAF(1),VFW(11),o[3],0,0,0), C1,6); VLD(11,15); SBAR(); \
    GAPB2(o[2]=__builtin_amdgcn_mfma_f32_32x32x16_bf16(PAF(2),VFW(12),o[2],0,0,0), C1,8); \
    GAPB2(o[3]=__builtin_amdgcn_mfma_f32_32x32x16_bf16(PAF(2),VFW(13),o[3],0,0,0), C1,10); \
    GAPB2(o[2]=__builtin_amdgcn_mfma_f32_32x32x16_bf16(PAF(3),VFW(14),o[2],0,0,0), C1,12); \
    GAPB2(o[3]=__builtin_amdgcn_mfma_f32_32x32x16_bf16(PAF(3),VFW(15),o[3],0,0,0), C1,14); \
    }while(0)
  #define STEPX(C0,C1,P0,P1,t,GK,GV,GL,GM) do{ if constexpr(WIDE){ STEPW(C0,C1,P0,P1,t,GK,GV,GL); } else { STEP(C0,C1,P0,P1,t,GK,GV,GL,GM); } }while(0)
  int t=1;
  #undef CMASK
  #define CMASK(P0,P1,t) do{}while(0)
  for(;t+5<NT;t+=2){
    STEPX(pB0,pB1,pA0,pA1,t,true,true,true,true);     if(WIDE){WAIT_BAR(3);}else{WAIT_BAR(2);} RESC(); ROT();
    STEPX(pA0,pA1,pB0,pB1,t+1,true,true,true,true);   if(WIDE||(MASKED&&(((t+1)&3)==0))){WAIT_BAR(3);}else{WAIT_BAR(2);} RESC(); ROT();
  }
  #undef CMASK
  #define CMASK(P0,P1,t) do{int jb_=(t)-(NT-4); if(jb_>=0)cmask(P0,P1,jb_,qrel,hi);}while(0)
  #define ENDW(tt) do{ if(WIDE){ if((tt)+3<NT){WAIT_BAR(3);} else if((tt)+2<NT){WAIT_BAR(2);} else {WAIT_BAR(0);} } else { if((tt)+3<NT){WAIT_BAR(2);} else if((tt)+2<NT){WAIT_BAR(1);} else {WAIT_BAR(0);} } }while(0)
  for(;t+1<NT;t+=2){
    STEPX(pB0,pB1,pA0,pA1,t,(t+3<NT),(t+1<NT),(t+1<NT),(t+2<NT));       ENDW(t);   RESC(); ROT();
    STEPX(pA0,pA1,pB0,pB1,t+1,(t+4<NT),(t+2<NT),(t+2<NT),(t+3<NT));     ENDW(t+1); RESC(); ROT();
  }
  STEPX(pB0,pB1,pA0,pA1,NT-1,false,false,false,false); RESC();
  { float sacc=pB0[0]+pB0[1]; _Pragma("unroll") for(int r=2;r<16;++r)sacc+=pB0[r]; _Pragma("unroll") for(int r=0;r<16;++r)sacc+=pB1[r]; l_reg+=sacc;
    pw0=(u32x4){PKW(pB0,0),PKW(pB0,2),PKW(pB0,4),PKW(pB0,6)};pw1=(u32x4){PKW(pB0,8),PKW(pB0,10),PKW(pB0,12),PKW(pB0,14)};pw2=(u32x4){PKW(pB1,0),PKW(pB1,2),PKW(pB1,4),PKW(pB1,6)};pw3=(u32x4){PKW(pB1,8),PKW(pB1,10),PKW(pB1,12),PKW(pB1,14)};
    SBAR(); pv(o,vb0+VS(sl_cur),PAF(0),PAF(1),PAF(2),PAF(3)); if(WIDE){ pv(o+2,vb0+VS(sl_cur)+8192,PAF(0),PAF(1),PAF(2),PAF(3)); } }
  #undef PKW
  #undef PAF
  #undef VFR
  #undef PIN
  #undef MX3
  #undef GAPA
  #undef GAPB
  #undef GAPB2
  #undef EX
  #undef VRD
  #undef KRD
  #undef VLD
  #undef VFW
  #undef PVN
  #undef STEPW
  #undef STEPX
  #undef STEP
  #undef ENDW
  {auto rr=__builtin_amdgcn_permlane32_swap(__float_as_uint(l_reg),__float_as_uint(l_reg),false,false);l_reg=__uint_as_float(rr[0])+__uint_as_float(rr[1]);}
  if constexpr(NOMAX){ if(!(l_reg>7.9e-31f&&l_reg<1.2e30f))*(__attribute__((address_space(3))) unsigned*)((__attribute__((address_space(3))) char*)shm+badoff)=1u; }
  if(hi==0)wsf[32+r32]=l_reg;asm volatile("s_waitcnt lgkmcnt(0)":::"memory");
  float rli[16];
  #pragma unroll
  for(int r=0;r<16;++r)rli[r]=__builtin_amdgcn_rcpf(wsf[32+crow(r,hi)]);
  bf16*Ow=O+(rowbase+q0+wid*QBLK)*DM+hv*D;
  #pragma unroll
  for(int hf=0;hf<(WIDE?2:1);++hf){ bf16*stg=(bf16*)(shm+L_OST)+wid*2048;
    #pragma unroll
    for(int r=0;r<16;++r){const int orow=crow(r,hi);
      #pragma unroll
      for(int d0=0;d0<2;++d0)stg[orow*64+d0*32+r32]=__float2bfloat16(o[2*hf+d0][r]*rli[r]);}
    asm volatile("s_waitcnt lgkmcnt(0)":::"memory");
    #pragma unroll
    for(int i=0;i<4;++i){const int row=i*8+(lane>>3),ch=lane&7; const u32x4 v=*(const u32x4*)(stg+row*64+ch*8); ATTN_STORE16(Ow+(long)row*DM+hf*64+ch*8,v);}
    asm volatile("s_waitcnt lgkmcnt(0)":::"memory"); }
  asm volatile("s_waitcnt lgkmcnt(0)\n\ts_barrier":::"memory");
  #undef DMA_K
  #undef DMA_V
  #undef DMA_M4
  #undef MKRD
  #undef MAND
  #undef TABRD
  #undef BIAS
  #undef CMASK
  #undef START
  #undef RESC
  #undef ROT
  #undef VS
}
constexpr int ATTN_LDS_BYTES=LDS_BYTES+NW*1024+4096;
__device__ __forceinline__ void mask_table_init(char*shm,int tid){
  if(tid<256){ u32x4 v; unsigned e[8];
    #pragma unroll
    for(int j=0;j<8;++j) e[j]=((tid>>j)&1)?0u:0xC400u;
    v.x=e[0]|(e[1]<<16); v.y=e[2]|(e[3]<<16); v.z=e[4]|(e[5]<<16); v.w=e[6]|(e[7]<<16);
    *(u32x4*)(shm+LDS_MK+NW*2048+tid*16)=v; }
  __syncthreads();
}
#undef SBAR
#undef WAIT_BAR
}

constexpr int NWAVES = 8;
#ifndef MK_PER_PHASE
#define MK_PER_PHASE 0
#endif

#ifndef CHK
#define CHK 0
#endif
constexpr int CW_CHK = 2;
constexpr int BATCH = 2, SEQ = 16384, NTOK = BATCH * SEQ, DMODEL = 1024, DEPTH = 2;
constexpr int WIN_OLD = 5704, WIN_NEW = 5888, P1_N = 3840;
constexpr float LN_EPS = 1e-5f, ALPHA = 1.41421356237f;
constexpr int NPH_LAYER = 12, NPHASE = DEPTH * NPH_LAYER;

constexpr size_t MiB = 1u << 20;
constexpr size_t WS_CTL = 0, CTL_ZERO_BYTES = 1 * MiB;
constexpr size_t WS_SMALL = 1 * MiB, SM_LAM = 0, SM_WR = 4096, SM_BR = SM_WR + 2 * 36 * 1024 * 4;
constexpr size_t WS_ROPE = 2 * MiB;
constexpr size_t WS_ROUTE = 4 * MiB, RT_E = 0, RT_C = 256 * 1024, RT_HIST = 512 * 1024, RT_TOT = 544 * 1024, RT_ROW = 576 * 1024, RT_ENT = 864 * 1024, RT_CW = 1152 * 1024;
constexpr int LIST_CAP = 65536 + 32 * 256;
constexpr size_t WS_WB = 6 * MiB;
constexpr size_t WB_WIN = 0, WB_WBD = (size_t)WIN_NEW * 1024 * 2, WB_WBS = WB_WBD + MiB, WB_WO = WB_WBS + MiB, WB_WPG = WB_WO + 2 * MiB, WB_WPLE = WB_WPG + 2 * MiB,
                 WB_WGU = WB_WPLE + MiB / 2, WB_WD = WB_WGU + 32 * MiB, WB_END = WB_WD + 16 * MiB;
static_assert(WB_END == 66 * MiB, "weight copies");
constexpr size_t WB_WG8 = WB_WIN + (size_t)3840 * 1024 * 2;
constexpr size_t WS_XB = 72 * MiB;
constexpr size_t WS_DQ = 136 * MiB, TSTRIDE = 32 * MiB, WS_IK = 360 * MiB, WS_IW = 364 * MiB;
constexpr size_t WS_O0 = 365 * MiB, WS_O1 = 397 * MiB, WS_YB = 429 * MiB, WS_MASK = 461 * MiB;
constexpr long MASK_BSTRIDE = 2105344;
constexpr size_t WS_YA = 136 * MiB, WS_MERGED = 168 * MiB, WS_TMPG = 240 * MiB, WS_PRE1 = 240 * MiB;
constexpr size_t OUT_XB8 = 0, OUT_X1B8 = 32 * MiB, OUT_T1 = 64 * MiB;
constexpr size_t WS_HG = 136 * MiB, WS_PLE = 172 * MiB, WS_Y0 = 368 * MiB, WS_Y1 = 432 * MiB, WS_PB = 496 * MiB, WS_END = 512 * MiB;
static_assert(WS_MASK + 2 * MASK_BSTRIDE * 8 <= WS_PB, "mask fits");
constexpr int CW_TMO = 0, CW_CODE = 1, CW_BAR = 4096, CW_QUEUE = 8192;

constexpr int RING_OFF = 0, RING_BYTES = 131072;
constexpr int XTR_OFF = RING_BYTES, XTR_BYTES = 4096;
constexpr int MISC_OFF = XTR_OFF + XTR_BYTES;
constexpr int LDS_BYTES = 147456;
static_assert(MISC_OFF + 128 <= LDS_BYTES, "LDS map");
#define GAS __attribute__((address_space(1)))
#define LAS __attribute__((address_space(3)))
typedef unsigned short bf16;
typedef unsigned v4u __attribute__((ext_vector_type(4)));
typedef float f32x4 __attribute__((ext_vector_type(4)));
typedef short bf16x8 __attribute__((ext_vector_type(8)));
typedef GAS unsigned gu32;
typedef GAS unsigned long long gu64;
#define RLX_AGENT __ATOMIC_RELAXED, __HIP_MEMORY_SCOPE_AGENT
#define LDS_WAIT() asm volatile("s_waitcnt lgkmcnt(0)" ::: "memory")
#define VM_WAIT() asm volatile("s_waitcnt vmcnt(0)" ::: "memory")
__device__ __forceinline__ unsigned long long rt() { return __builtin_amdgcn_s_memrealtime(); }
__device__ __forceinline__ unsigned f2bf(float f) { unsigned u = __builtin_bit_cast(unsigned, f); return (u + 0x7fffu + ((u >> 16) & 1u)) >> 16; }
__device__ __forceinline__ unsigned pk2(float lo, float hi) { return f2bf(lo) | (f2bf(hi) << 16); }

#define XB_TMO      128
#define XB_XCNT(j)  (256  + 64 * (j))
#define XB_XSUB(j)  (1280 + 64 * (j))
#define XB_XGEN(j)  (2304 + 64 * (j))
#define XB_TOP      3328
#define XB_TOPGEN   3392
#define XCD_BAR_WORDS 3456
#define XB_SPIN_CAP (1u << 18)

__device__ __forceinline__ unsigned xb_ld(unsigned* p)              { return __hip_atomic_load(p, __ATOMIC_RELAXED, __HIP_MEMORY_SCOPE_AGENT); }
__device__ __forceinline__ unsigned xb_add(unsigned* p, unsigned v) { return __hip_atomic_fetch_add(p, v, __ATOMIC_RELAXED, __HIP_MEMORY_SCOPE_AGENT); }
__device__ __forceinline__ unsigned xb_xcc_id() { return (unsigned)__builtin_amdgcn_s_getreg((3 << 11) | 20) & 0xFu; }
#define XB_SPIN(cond, bar) do { unsigned _sp = 0; while (cond) { __builtin_amdgcn_s_sleep(1); \
    if ((++_sp & 255u) == 0u) { if (xb_ld(&(bar)[XB_TMO])) break; if (_sp > XB_SPIN_CAP) { atomicAdd(&(bar)[XB_TMO], 1u); break; } } } } while (0)

struct XcdBarrier {
    unsigned* bar; unsigned x;
    volatile LAS unsigned* st;
};

__device__ __forceinline__ XcdBarrier xcd_barrier_post(unsigned* bar, volatile LAS unsigned* st) {
    XcdBarrier b; b.bar = bar; b.x = xb_xcc_id(); b.st = st;
    if (threadIdx.x == 0) (void)xb_add(&bar[XB_XCNT(b.x)], 1u);
    return b;
}
__device__ __forceinline__ void xcd_barrier_complete(unsigned* bar, unsigned x, unsigned& nloc, unsigned& nx) {
    const unsigned G = gridDim.x * gridDim.y * gridDim.z;
    unsigned sum, cnt, mine, sp = 0u;
    for (;;) {
        sum = 0u; cnt = 0u; mine = 0u;
#pragma unroll
        for (unsigned j = 0; j < 16; ++j) { const unsigned c = xb_ld(&bar[XB_XCNT(j)]); sum += c; cnt += (c > 0u) ? 1u : 0u; mine = (j == x) ? c : mine; }
        if (sum == G) break;
        __builtin_amdgcn_s_sleep(1);
        if ((++sp & 255u) == 0u) { if (xb_ld(&bar[XB_TMO])) break; if (sp > XB_SPIN_CAP) { atomicAdd(&bar[XB_TMO], 1u); break; } }
    }
    nloc = mine > 0u ? mine : 1u; nx = cnt > 0u ? cnt : 1u;
}

__device__ __forceinline__ void xcd_barrier(const XcdBarrier& b) {
    asm volatile("s_waitcnt vmcnt(0)" ::: "memory");
    __syncthreads();
    if (threadIdx.x == 0) {
        unsigned* bar = b.bar;
        __builtin_amdgcn_s_waitcnt(0);
        unsigned nloc = b.st[0], nx = b.st[1];
        if (nloc == 0u) { xcd_barrier_complete(bar, b.x, nloc, nx); b.st[0] = nloc; b.st[1] = nx; }
        const unsigned old = xb_add(&bar[XB_XSUB(b.x)], 1u);
        const unsigned gen = old / nloc;
        if (old + 1u == (gen + 1u) * nloc) {
            __builtin_amdgcn_fence(__ATOMIC_RELEASE, "agent");
            asm volatile("s_waitcnt vmcnt(0)" ::: "memory");
            const unsigned og = xb_add(&bar[XB_TOP], 1u);
            const unsigned tg = og / nx;
            if (og + 1u == (tg + 1u) * nx) xb_add(&bar[XB_TOPGEN], 1u);
            else XB_SPIN(xb_ld(&bar[XB_TOPGEN]) == tg, bar);
            __builtin_amdgcn_fence(__ATOMIC_ACQUIRE, "agent");
            xb_add(&bar[XB_XGEN(b.x)], 1u);
            asm volatile("s_waitcnt vmcnt(0)" ::: "memory");
        } else {
            XB_SPIN(xb_ld(&bar[XB_XGEN(b.x)]) == gen, bar);
            __builtin_amdgcn_fence(__ATOMIC_ACQUIRE, "agent");
            asm volatile("s_waitcnt vmcnt(0)" ::: "memory");
        }
    }
    __syncthreads();
}

#ifndef DBG
#define DBG 0
#endif
struct Args { const void* in[22]; float* out; unsigned char* ws; int ph_lo, ph_hi; };
struct Frame {
    LAS unsigned char* lds;
    volatile LAS unsigned* MISC;
    gu32* ctl;
    int tid, lane, wave;
    int vcu, G, bx;
    unsigned char* ws; unsigned char* ws0;
    float* out; float* out0;
    const Args* ap;
};
#define INP(k) (F.ap->in[(k)])
#define DPP_F(v, ctrl) __builtin_bit_cast(float, __builtin_amdgcn_update_dpp(0, __builtin_bit_cast(int, (v)), (ctrl), 0xf, 0xf, true))
__device__ __forceinline__ float row16_sum(float v) {
    v += DPP_F(v, 0xB1);
    v += DPP_F(v, 0x4E);
    v += DPP_F(v, 0x141);
    v += DPP_F(v, 0x140);
    return v;
}
__device__ __forceinline__ float wave_sum(float v) {
    v = row16_sum(v);
    { auto r = __builtin_amdgcn_permlane16_swap(__float_as_uint(v), __float_as_uint(v), false, false); v = __uint_as_float(r[0]) + __uint_as_float(r[1]); }
    { auto r = __builtin_amdgcn_permlane32_swap(__float_as_uint(v), __float_as_uint(v), false, false); v = __uint_as_float(r[0]) + __uint_as_float(r[1]); }
    return v;
}
typedef float f32x2 __attribute__((ext_vector_type(2)));

__device__ __forceinline__ void tr_item(const float* W, int ldn, int col0, int nvalid, bf16* WT, int K, int row0, LAS float* scr, int kb, int lane) {
    const int k0 = 64 * kb, n = lane & 31;
#pragma unroll 8
    for (int i = 0; i < 32; ++i) { const int kk = 2 * i + (lane >> 5); scr[kk * 33 + n] = (n < nvalid) ? W[(size_t)(k0 + kk) * ldn + col0 + n] : 0.f; }
    LDS_WAIT(); asm volatile("" ::: "memory");
    const int c = lane & 7;
#pragma unroll
    for (int j = 0; j < 4; ++j) { const int nn = (lane >> 3) + 8 * j; const LAS float* s = scr + (8 * c) * 33 + nn;
        v4u o; o.x = pk2(s[0 * 33], s[1 * 33]); o.y = pk2(s[2 * 33], s[3 * 33]); o.z = pk2(s[4 * 33], s[5 * 33]); o.w = pk2(s[6 * 33], s[7 * 33]);
        *(GAS v4u*)(WT + (size_t)(row0 + nn) * K + k0 + 8 * c) = o; }
    LDS_WAIT(); asm volatile("" ::: "memory");
}
__device__ __forceinline__ unsigned pk4_fp8(float a, float b, float c, float d) { int p = __builtin_amdgcn_cvt_pk_fp8_f32(a, b, 0, false); return (unsigned)__builtin_amdgcn_cvt_pk_fp8_f32(c, d, p, true); }
__device__ __forceinline__ void tr_item8(const float* W, int ldn, int col0, unsigned char* WT, int K, int row0, LAS float* scr, int kb, int lane) {
    const int k0 = 64 * kb, n = lane & 31;
#pragma unroll 8
    for (int i = 0; i < 32; ++i) { const int kk = 2 * i + (lane >> 5); scr[kk * 33 + n] = W[(size_t)(k0 + kk) * ldn + col0 + n] * 64.f; }
    LDS_WAIT(); asm volatile("" ::: "memory");
    const int c = lane & 7;
#pragma unroll
    for (int j = 0; j < 4; ++j) { const int nn = (lane >> 3) + 8 * j; const LAS float* s = scr + (8 * c) * 33 + nn;
        const unsigned long long o = (unsigned long long)pk4_fp8(s[0 * 33], s[1 * 33], s[2 * 33], s[3 * 33]) | ((unsigned long long)pk4_fp8(s[4 * 33], s[5 * 33], s[6 * 33], s[7 * 33]) << 32);
        *(GAS unsigned long long*)(WT + (size_t)(row0 + nn) * K + k0 + 8 * c) = o; }
    LDS_WAIT(); asm volatile("" ::: "memory");
}
__device__ __forceinline__ void pw_phase(Frame& F, int l) {
    LAS float* scr = (LAS float*)(F.lds + RING_OFF + F.wave * 16384);
    const int gw = F.vcu * NWAVES + F.wave, NGW = F.G * NWAVES, lane = F.lane;
    unsigned char* wb = F.ws + WS_WB;
    bf16* WIN = (bf16*)(wb + WB_WIN);
    const float* w_in = (const float*)INP(3) + (size_t)l * 1024 * WIN_OLD;
    constexpr int I_A = 16 * 114, I_B = 16, I_C = 16 * 64, I_BD = 8 * 32, I_O = 16 * 32, I_PLE = 4 * 32, I_GU = 32 * 4 * 64, I_D = 32 * 128;
    constexpr int NITEMS = I_A + I_B + I_C + 2 * I_BD + 2 * I_O + I_PLE + I_GU + I_D;
    for (int it = gw; it < NITEMS; it += NGW) {
        int r = it;
        if (r < I_A) { const int kb = r / 114, nb = r % 114; tr_item(w_in, WIN_OLD, 32 * nb, 32, WIN, 1024, 32 * nb, scr, kb, lane); continue; } r -= I_A;
        if (r < I_B) { tr_item(w_in, WIN_OLD, 3648, 8, WIN, 1024, 3648, scr, r, lane); continue; } r -= I_B;
        if (r < I_C) { const int kb = r / 64, nb = r % 64; tr_item8(w_in, WIN_OLD, 3656 + 32 * nb, wb + WB_WG8, 1024, 32 * nb, scr, kb, lane); continue; } r -= I_C;
        if (r < I_BD) { tr_item((const float*)INP(6) + (size_t)l * 512 * 1024, 1024, 32 * (r % 32), 32, (bf16*)(wb + WB_WBD), 512, 32 * (r % 32), scr, r / 32, lane); continue; } r -= I_BD;
        if (r < I_BD) { tr_item((const float*)INP(7) + (size_t)l * 512 * 1024, 1024, 32 * (r % 32), 32, (bf16*)(wb + WB_WBS), 512, 32 * (r % 32), scr, r / 32, lane); continue; } r -= I_BD;
        if (r < I_O) { tr_item((const float*)INP(8) + (size_t)l * 1024 * 1024, 1024, 32 * (r % 32), 32, (bf16*)(wb + WB_WO), 1024, 32 * (r % 32), scr, r / 32, lane); continue; } r -= I_O;
        if (r < I_O) { tr_item8((const float*)INP(19) + (size_t)l * 1024 * 1024, 1024, 32 * (r % 32), wb + WB_WPG, 1024, 32 * (r % 32), scr, r / 32, lane); continue; } r -= I_O;
        if (r < I_PLE) { tr_item((const float*)INP(18) + (size_t)l * 256 * 1024, 1024, 32 * (r % 32), 32, (bf16*)(wb + WB_WPLE), 256, 32 * (r % 32), scr, r / 32, lane); continue; } r -= I_PLE;
        if (r < I_GU) { const int e = r >> 8, sub = (r >> 6) & 3, q = r & 63, kb = q >> 2, nb = q & 3;
            const float* W = ((sub & 1) ? (const float*)INP(16) : (const float*)INP(15)) + (size_t)(l * 32 + e) * 1024 * 256;
            tr_item8(W, 256, (sub >> 1) * 128 + 32 * nb, wb + WB_WGU, 1024, e * 512 + sub * 128 + 32 * nb, scr, kb, lane); continue; } r -= I_GU;
        { const int e = r >> 7, q = r & 127, kb = q >> 5, nb = q & 31;
            tr_item((const float*)INP(17) + (size_t)(l * 32 + e) * 256 * 1024, 1024, 32 * nb, 32, (bf16*)(wb + WB_WD), 256, e * 1024 + 32 * nb, scr, kb, lane); }
    }
    { unsigned z_ = 0u; asm volatile("" : "+v"(z_));
      for (int ch = F.vcu * 512 + F.tid; ch < 160 * 128; ch += F.G * 512) *(GAS v4u*)(WIN + (size_t)3680 * 1024 + (size_t)ch * 8) = (v4u){z_, z_, z_, z_}; }
    const float* p = (const float*)INP(1) + (size_t)l * NTOK * 256; bf16* PB = (bf16*)(F.ws + WS_PB);
    for (int m0 = gw; m0 < NTOK; m0 += 4 * NGW) { f32x4 v[4];
#pragma unroll
        for (int j = 0; j < 4; ++j) { const int m = min(m0 + j * NGW, NTOK - 1); v[j] = *((const GAS f32x4*)(p + (size_t)m * 256) + lane); }
#pragma unroll
        for (int j = 0; j < 4; ++j) { const int m = m0 + j * NGW; if (m < NTOK) *((GAS unsigned long long*)(PB + (size_t)m * 256) + lane) = (unsigned long long)pk2(v[j].x, v[j].y) | ((unsigned long long)pk2(v[j].z, v[j].w) << 32); } }
    if (l == 0) {
        const float* x = (const float*)INP(0); bf16* XB = (bf16*)(F.ws + WS_XB);
        for (int m0 = gw; m0 < NTOK; m0 += 2 * NGW) { f32x4 v[2][4];
#pragma unroll
            for (int r = 0; r < 2; ++r) { const int m = min(m0 + r * NGW, NTOK - 1); const GAS f32x4* xr = (const GAS f32x4*)(x + (size_t)m * 1024) + lane;
#pragma unroll
                for (int j = 0; j < 4; ++j) v[r][j] = xr[64 * j]; }
#pragma unroll
            for (int r = 0; r < 2; ++r) { const int m = m0 + r * NGW; if (m < NTOK) { GAS unsigned long long* o8 = (GAS unsigned long long*)(XB + (size_t)m * 1024) + lane;
#pragma unroll
                for (int j = 0; j < 4; ++j) { const f32x4 w = v[r][j]; o8[64 * j] = (unsigned long long)pk2(w.x, w.y) | ((unsigned long long)pk2(w.z, w.w) << 32);
                    ((GAS unsigned*)((unsigned char*)F.out + OUT_XB8 + (size_t)m * 1024) + lane)[64 * j] = pk4_fp8(w.x, w.y, w.z, w.w); } } }
        }
        const int* pos = (const int*)INP(2); float* rope = (float*)(F.ws + WS_ROPE);
        for (int idx = F.vcu * 512 + F.tid; idx < NTOK * 8; idx += F.G * 512) {
            const int m = idx >> 3, j = idx & 7; const float invf = exp2f(-2.366446071f * (float)j); const float ang = (float)pos[m] * invf;
            double rev = (double)ang * 0.15915494309189535; rev -= rint(rev);
            rope[m * 16 + j] = (DBG & 16) ? 1.f : __builtin_amdgcn_cosf((float)rev); rope[m * 16 + 8 + j] = (DBG & 16) ? 0.f : __builtin_amdgcn_sinf((float)rev);
        }
        float* WR = (float*)(F.ws + WS_SMALL + SM_WR); float* BR = (float*)(F.ws + WS_SMALL + SM_BR);
        for (int idx = F.vcu * 512 + F.tid; idx < 2 * 36 * 1024; idx += F.G * 512) {
            const int ll = idx / (36 * 1024), r = idx % (36 * 1024), j = r >> 10, k = r & 1023;
            WR[idx] = (j < 4) ? ((const float*)INP(11))[((size_t)ll * 1024 + k) * 4 + j] : ((const float*)INP(13))[((size_t)ll * 1024 + k) * 32 + (j - 4)];
        }
        if (F.vcu == 0 && F.tid < 72) { const int ll = F.tid / 36, j = F.tid % 36; BR[F.tid] = (j < 4) ? ((const float*)INP(12))[ll * 4 + j] : ((const float*)INP(14))[ll * 32 + j - 4]; }
        if (F.vcu == 0 && F.tid < 2) { const float* lp = (const float*)INP(4) + F.tid * 256; float a = 0.f, b = 0.f;
            for (int i = 0; i < 64; ++i) { a += lp[i] * lp[64 + i]; b += lp[128 + i] * lp[192 + i]; }
            const float lam_init = (F.tid == 0) ? 0.2f : 0.35550907f;
            ((float*)(F.ws + WS_SMALL + SM_LAM))[F.tid] = __expf(a) - __expf(b) + lam_init; }
    }
}

namespace idxr {
typedef float f32x16 __attribute__((ext_vector_type(16)));
typedef short s16x2 __attribute__((ext_vector_type(2)));
typedef __fp16 h16x2 __attribute__((ext_vector_type(2)));
constexpr int HROW = 513;
__device__ __forceinline__ unsigned f2key(float f) { const unsigned u = __float_as_uint(f); return u ^ ((unsigned)((int)u >> 31) | 0x80000000u); }
__device__ __forceinline__ unsigned bins2(float a, float b) {
    const unsigned h = __builtin_bit_cast(unsigned, __builtin_amdgcn_cvt_pkrtz(a, b));
    const unsigned m = __builtin_bit_cast(unsigned, (s16x2)(__builtin_bit_cast(s16x2, h) >> (s16x2){15, 15}));
    const unsigned key = h ^ (m | 0x80008000u);
    return (key >> 5) & 0x07fc07fcu;
}
__device__ __forceinline__ float f16bits(unsigned h) { return (float)__builtin_bit_cast(__fp16, (unsigned short)h); }
__device__ __forceinline__ float bin_edge(int b) {
    if (b <= 0) return -__builtin_inff();
    if (b >= 512) return __builtin_inff();
    const unsigned K = (unsigned)b << 7;
    if (K >= 0x8000u) { const unsigned H = K & 0x7fffu; return (H >= 0x7c00u) ? __builtin_inff() : f16bits(H); }
    const unsigned M1 = ((0xFFFFu ^ K) & 0x7fffu) + 1u;
    const float v = (M1 >= 0x7c00u) ? __builtin_inff() : f16bits(M1);
    return -__uint_as_float(__float_as_uint(v) - 1u);
}
__device__ __forceinline__ long moff(int tl) { return 16384L * tl - 32L * tl * (tl - 1); }
__device__ __forceinline__ void load_k2(bf16x8 (&ka)[2], bf16x8 (&kb)[2], const unsigned short* IKb, int key0, int kg0, int fr, int fq) {
#pragma unroll
    for (int ks = 0; ks < 2; ++ks) { ka[ks] = *(const bf16x8*)(IKb + (size_t)(key0 + 16 * kg0 + fr) * 64 + ks * 32 + fq * 8); kb[ks] = *(const bf16x8*)(IKb + (size_t)(key0 + 16 * kg0 + 16 + fr) * 64 + ks * 32 + fq * 8); }
}
__device__ __forceinline__ void score_half(f32x4& sa, f32x4& sb, const bf16x8 (&qf)[8][2], const bf16x8 (&ql)[2], const float (&w)[8], bf16x8 (&ka)[2], bf16x8 (&kb)[2]) {
    sa = __builtin_amdgcn_mfma_f32_16x16x32_bf16(ka[0], ql[0], (f32x4){0.f, 0.f, 0.f, 0.f}, 0, 0, 0); sb = __builtin_amdgcn_mfma_f32_16x16x32_bf16(kb[0], ql[0], (f32x4){0.f, 0.f, 0.f, 0.f}, 0, 0, 0);
    sa = __builtin_amdgcn_mfma_f32_16x16x32_bf16(ka[1], ql[1], sa, 0, 0, 0); sb = __builtin_amdgcn_mfma_f32_16x16x32_bf16(kb[1], ql[1], sb, 0, 0, 0);
    f32x4 Da[2], Db[2];
#define IDX_M(h, D) do { \
        D[0] = __builtin_amdgcn_mfma_f32_16x16x32_bf16(ka[0], qf[h][0], (f32x4){0.f, 0.f, 0.f, 0.f}, 0, 0, 0); D[1] = __builtin_amdgcn_mfma_f32_16x16x32_bf16(kb[0], qf[h][0], (f32x4){0.f, 0.f, 0.f, 0.f}, 0, 0, 0); \
        D[0] = __builtin_amdgcn_mfma_f32_16x16x32_bf16(ka[1], qf[h][1], D[0], 0, 0, 0); D[1] = __builtin_amdgcn_mfma_f32_16x16x32_bf16(kb[1], qf[h][1], D[1], 0, 0, 0); } while (0)
#define IDX_F(h, D, O) asm volatile("" : "+v"(O[0]), "+v"(O[1]));     \
        asm volatile( \
        "v_fma_f32 %0, %8, |%9|, %0\n\tv_fma_f32 %1, %8, |%10|, %1\n\tv_fma_f32 %2, %8, |%11|, %2\n\tv_fma_f32 %3, %8, |%12|, %3\n\t" \
        "v_fma_f32 %4, %8, |%13|, %4\n\tv_fma_f32 %5, %8, |%14|, %5\n\tv_fma_f32 %6, %8, |%15|, %6\n\tv_fma_f32 %7, %8, |%16|, %7" \
        : "+v"(sa[0]), "+v"(sa[1]), "+v"(sa[2]), "+v"(sa[3]), "+v"(sb[0]), "+v"(sb[1]), "+v"(sb[2]), "+v"(sb[3]) \
        : "v"(w[h]), "v"(D[0][0]), "v"(D[0][1]), "v"(D[0][2]), "v"(D[0][3]), "v"(D[1][0]), "v"(D[1][1]), "v"(D[1][2]), "v"(D[1][3])); \
        asm volatile("" : "+v"(ka[0]), "+v"(kb[0]))
    IDX_M(0, Da); IDX_M(1, Db);
    asm volatile("s_nop 7" : "+v"(Da[0]), "+v"(Da[1]), "+v"(Db[0]), "+v"(Db[1]), "+v"(sa), "+v"(sb));
#pragma unroll
    for (int h = 0; h < 6; h += 2) { IDX_F(h, Da, Db); IDX_M(h + 2, Da); IDX_F(h + 1, Db, Da); IDX_M(h + 3, Db); }
    IDX_F(6, Da, Db); asm volatile("s_nop 7" : "+v"(Db[0]), "+v"(Db[1])); IDX_F(7, Db, Da);
#undef IDX_M
#undef IDX_F
}
#define IDX_SCORE(sc, kf, key0, more) do { const int nk_ = (more) ? (key0) + 128 : (key0); \
        idxr::score_half(sc[0], sc[1], qf, ql, w, kf[0], kf[1]); idxr::load_k2(kf[0], kf[1], IKb, nk_, 0, fr, fq); \
        idxr::score_half(sc[2], sc[3], qf, ql, w, kf[2], kf[3]); idxr::load_k2(kf[2], kf[3], IKb, nk_, 2, fr, fq); } while (0)
}

__device__ __forceinline__ void indexer_unit(Frame& F, int b, int qblk, const bf16* IQ, const bf16* IK, const float* IW, unsigned long long* mask64  ) {
    using namespace idxr;
    const int lane = F.lane, fr = lane & 15, fq = lane >> 4, wid = F.wave, qgrp = wid & 3, kh = wid >> 2;
    const int qloc = 16 * qgrp + fr, q = 64 * qblk + qloc;
    const size_t row = (size_t)b * SEQ + q;
    LAS unsigned* hist = (LAS unsigned*)(F.lds + RING_OFF);
    LAS int* bstarA = (LAS int*)(F.lds + XTR_OFF + 1024); LAS int* needA = bstarA + 64; LAS float* thiA = (LAS float*)(needA + 64); LAS float* tloA = thiA + 64;
    LAS unsigned* cand = (LAS unsigned*)(F.lds + RING_OFF);
    LAS unsigned* wcnt = (LAS unsigned*)(F.lds + XTR_OFF + 2048);
    bf16x8 qf[8][2], ql[2]; float w[8];
#pragma unroll
    for (int h = 0; h < 8; ++h)
#pragma unroll
        for (int ks = 0; ks < 2; ++ks) qf[h][ks] = *(const bf16x8*)(IQ + row * 512 + h * 64 + ks * 32 + fq * 8);
    { const f32x4* wp = (const f32x4*)(IW + row * 8); const f32x4 w0 = wp[0], w1 = wp[1]; w[0] = 0.5f * w0.x; w[1] = 0.5f * w0.y; w[2] = 0.5f * w0.z; w[3] = 0.5f * w0.w; w[4] = 0.5f * w1.x; w[5] = 0.5f * w1.y; w[6] = 0.5f * w1.z; w[7] = 0.5f * w1.w; }
#pragma unroll
    for (int ks = 0; ks < 2; ++ks) {
        float acc8[8];
#pragma unroll
        for (int e = 0; e < 8; ++e) acc8[e] = 0.f;
#pragma unroll
        for (int h = 0; h < 8; ++h)
#pragma unroll
            for (int e = 0; e < 8; ++e) acc8[e] = __builtin_fmaf(w[h], __uint_as_float((unsigned)(unsigned short)qf[h][ks][e] << 16), acc8[e]);
#pragma unroll
        for (int e = 0; e < 8; e += 2) { const unsigned pk = pg8::cvt_pk_bf16(acc8[e], acc8[e + 1]); ql[ks][e] = (short)(pk & 0xffffu); ql[ks][e + 1] = (short)(pk >> 16); }
    }
    for (int i = F.tid; i < 64 * HROW; i += NWAVES * 64) hist[i] = 0u;
    __syncthreads();
    const unsigned short* IKb = IK + (size_t)b * SEQ * 64;
    const int qmin_w = 64 * qblk + 16 * qgrp;
    const unsigned hrowb = (unsigned)(size_t)(hist + qloc * HROW);
#define IDX_HADD(off_) __hip_atomic_fetch_add((LAS unsigned*)(hrowb + (off_)), 1u, __ATOMIC_RELAXED, __HIP_MEMORY_SCOPE_WORKGROUP)
    {
        bf16x8 kf[4][2];
        if (kh <= qblk) { load_k2(kf[0], kf[1], IKb, 64 * kh, 0, fr, fq); load_k2(kf[2], kf[3], IKb, 64 * kh, 2, fr, fq); }
#pragma unroll 1
        for (int tl = kh; tl <= qblk; tl += 2) {
            const int key0 = 64 * tl; f32x4 sc[4]; IDX_SCORE(sc, kf, key0, tl + 2 <= qblk);
            if (key0 + 63 <= qmin_w) {
#pragma unroll
                for (int kg = 0; kg < 4; ++kg) { const unsigned p0 = bins2(sc[kg][0], sc[kg][1]), p1 = bins2(sc[kg][2], sc[kg][3]);
                    IDX_HADD(p0 & 0xffffu); IDX_HADD(p0 >> 16); IDX_HADD(p1 & 0xffffu); IDX_HADD(p1 >> 16); __builtin_amdgcn_sched_barrier(0); }
            } else {
                int fq_ = fq, q_ = q; asm volatile("" : "+v"(fq_), "+v"(q_));
#pragma unroll
                for (int kg = 0; kg < 4; ++kg) { const unsigned p0 = bins2(sc[kg][0], sc[kg][1]), p1 = bins2(sc[kg][2], sc[kg][3]); const int kb = key0 + 16 * kg + 4 * fq_;
                    if (kb <= q_) IDX_HADD(p0 & 0xffffu); if (kb + 1 <= q_) IDX_HADD(p0 >> 16); if (kb + 2 <= q_) IDX_HADD(p1 & 0xffffu); if (kb + 3 <= q_) IDX_HADD(p1 >> 16); __builtin_amdgcn_sched_barrier(0); }
            }
        }
    }
#undef IDX_HADD
    __syncthreads();
#pragma unroll 1
    for (int qq = wid * 8; qq < wid * 8 + 8; ++qq) {
        const LAS unsigned* hr = hist + qq * HROW + lane * 8;
        unsigned wv[8]; unsigned s = 0;
#pragma unroll
        for (int k = 0; k < 8; ++k) { wv[k] = hr[k]; s += wv[k]; }
        unsigned v = s;
#define DPP_U(x, ctrl) (unsigned)__builtin_amdgcn_update_dpp(0, (int)(x), (ctrl), 0xf, 0xf, true)
        v += DPP_U(v, 0x101); v += DPP_U(v, 0x102); v += DPP_U(v, 0x104); v += DPP_U(v, 0x108);
#undef DPP_U
        { const unsigned t1 = (unsigned)__builtin_amdgcn_readlane((int)v, 16), t2 = (unsigned)__builtin_amdgcn_readlane((int)v, 32), t3 = (unsigned)__builtin_amdgcn_readlane((int)v, 48);
          const int rw = lane >> 4; v += (rw < 1 ? t1 : 0u) + (rw < 2 ? t2 : 0u) + (rw < 3 ? t3 : 0u); }
        const unsigned above = v - s, total = (unsigned)__builtin_amdgcn_readlane((int)v, 0);
        if (total > 256u) {
            if (above < 256u && v >= 256u) {
                unsigned c = above; int found = -1, need = 0;
#pragma unroll
                for (int k = 7; k >= 0; --k) { if (found < 0) { if (c + wv[k] >= 256u) { found = k; need = 256 - (int)c; } else c += wv[k]; } }
                bstarA[qq] = lane * 8 + found; needA[qq] = need; thiA[qq] = bin_edge(lane * 8 + found + 1); tloA[qq] = bin_edge(lane * 8 + found);
            }
        } else if (lane == 0) { bstarA[qq] = -1; needA[qq] = 0; thiA[qq] = -__builtin_inff(); tloA[qq] = -__builtin_inff(); }
    }
    __syncthreads();
    const float thi = thiA[qloc], tlo = tloA[qloc];
    unsigned ncand = 0u; LAS unsigned* const cbase = cand + (qloc * 8 + fq + 4 * kh) * 64;
#define IDX_EL(scv_, krel_) do { const float v_ = (scv_); \
        if (FULL_) { asm volatile("v_cmp_ge_f32 vcc, %2, %3\n\tv_addc_co_u32 %0, vcc, %0, %0, vcc\n\tv_cmp_ge_f32 vcc, %2, %4\n\tv_addc_co_u32 %1, vcc, %1, %1, vcc" : "+v"(nh_), "+v"(nl_) : "v"(v_), "v"(thi), "v"(tlo) : "vcc"); } \
        else { const bool ok_ = key0 + (krel_) <= q_; nh_ = nh_ + nh_ + ((ok_ && v_ >= thi) ? 1u : 0u); nl_ = nl_ + nl_ + ((ok_ && v_ >= tlo) ? 1u : 0u); } } while (0)
#define IDX_HALF(ka, kb, W_, C_) do { unsigned nh_ = 0u, nl_ = 0u; const int kr = 4 * fq_; \
        IDX_EL(sc[kb][3], 16 * kb + kr + 3); IDX_EL(sc[kb][2], 16 * kb + kr + 2); IDX_EL(sc[kb][1], 16 * kb + kr + 1); IDX_EL(sc[kb][0], 16 * kb + kr); nh_ <<= 12; nl_ <<= 12; \
        IDX_EL(sc[ka][3], 16 * ka + kr + 3); IDX_EL(sc[ka][2], 16 * ka + kr + 2); IDX_EL(sc[ka][1], 16 * ka + kr + 1); IDX_EL(sc[ka][0], 16 * ka + kr); \
        W_ = nh_ << kr; C_ = nl_ & ~nh_; __builtin_amdgcn_sched_barrier(0); } while (0)
#define IDX_ELS() do { IDX_HALF(0, 1, wlo, clo); IDX_HALF(2, 3, whi, chi); } while (0)
    {
        bf16x8 kf[4][2];
        if (kh <= qblk) { load_k2(kf[0], kf[1], IKb, 64 * kh, 0, fr, fq); load_k2(kf[2], kf[3], IKb, 64 * kh, 2, fr, fq); }
#pragma unroll 1
        for (int tl = kh; tl <= qblk; tl += 2) {
            const int key0 = 64 * tl; unsigned long long* mword = mask64 + (moff(tl) + (q - key0)); f32x4 sc[4]; IDX_SCORE(sc, kf, key0, tl + 2 <= qblk);
            unsigned wlo = 0u, whi = 0u, clo = 0u, chi = 0u; int fq_ = fq, q_ = q; asm volatile("" : "+v"(fq_), "+v"(q_));
            if (key0 + 63 <= qmin_w) {
#define FULL_ true
                IDX_ELS();
#undef FULL_
            } else {
#define FULL_ false
                IDX_ELS();
#undef FULL_
            }
            unsigned cb = clo | (chi << 4);
            if (cb != 0u) {
#pragma unroll 1
                while (cb != 0u) {
                    const int j = __builtin_ctz(cb); cb &= cb - 1u;
                    const bool b0 = (j & 1) != 0, b1 = (j & 2) != 0, b2 = (j & 4) != 0, b4 = (j & 16) != 0;
                    float y[4];
#pragma unroll
                    for (int kg = 0; kg < 4; ++kg) { const float x0 = b0 ? sc[kg][1] : sc[kg][0], x1 = b0 ? sc[kg][3] : sc[kg][2]; y[kg] = b1 ? x1 : x0; }
                    const float z0 = b4 ? y[1] : y[0], z1 = b4 ? y[3] : y[2]; const float v_ = b2 ? z1 : z0;
                    const int krel = 16 * ((b4 ? 1 : 0) + (b2 ? 2 : 0)) + 4 * fq_ + (j & 3);
                    if (ncand < 64u) cbase[ncand] = ((f2key(v_) & 0xffff8u) << 11) | (unsigned)(16383 - (key0 + krel)); ++ncand;
                }
            }
            { auto r_ = __builtin_amdgcn_permlane16_swap(wlo, wlo, false, false); wlo = r_[0] | r_[1]; r_ = __builtin_amdgcn_permlane16_swap(whi, whi, false, false); whi = r_[0] | r_[1];
              r_ = __builtin_amdgcn_permlane32_swap(wlo, wlo, false, false); wlo = r_[0] | r_[1]; r_ = __builtin_amdgcn_permlane32_swap(whi, whi, false, false); whi = r_[0] | r_[1]; }
            if (fq == 0) *mword = ((unsigned long long)whi << 32) | wlo;
        }
    }
#undef IDX_EL
#undef IDX_HALF
#undef IDX_ELS
    wcnt[qloc * 8 + fq + 4 * kh] = ncand < 64u ? ncand : 64u;
    VM_WAIT();
    __syncthreads();
#pragma unroll 1
    for (int qq = wid * 8; qq < wid * 8 + 8; ++qq) {
        const int need = needA[qq];
        if (need == 0) continue;
        unsigned e[8];
#pragma unroll
        for (int j = 0; j < 8; ++j) { const unsigned c = wcnt[qq * 8 + j]; e[j] = ((unsigned)lane < c) ? (cand[(qq * 8 + j) * 64 + lane] | 0x80000000u) : 0u; }
        unsigned T = 0x80000000u; int cntT = 0;
#pragma unroll
        for (int j = 0; j < 8; ++j) cntT += __builtin_popcountll(__ballot(e[j] >= T));
#pragma unroll 1
        for (int bit = 30; bit >= 0 && cntT != need; --bit) { const unsigned c = T | (1u << bit); int cnt = 0;
#pragma unroll
            for (int j = 0; j < 8; ++j) cnt += __builtin_popcountll(__ballot(e[j] >= c));
            if (cnt >= need) { T = c; cntT = cnt; } }
        const int qglob = 64 * qblk + qq;
#pragma unroll
        for (int j = 0; j < 8; ++j) if (e[j] >= T) { const int kidx = 16383 - (int)(e[j] & 0x3fffu); const int tl = kidx >> 6;
            __hip_atomic_fetch_or(mask64 + (moff(tl) + (qglob - 64 * tl)), 1ull << (kidx & 63), __ATOMIC_RELAXED, __HIP_MEMORY_SCOPE_AGENT); }
    }
    __syncthreads();
}

__device__ __forceinline__ void ya_phase(Frame& F, int l) {
    const int gw = F.vcu * NWAVES + F.wave, NGW = F.G * NWAVES, lane = F.lane;
    const bf16* O0 = (const bf16*)(F.ws + WS_O0); const bf16* O1 = (const bf16*)(F.ws + WS_O1); bf16* YA = (bf16*)(F.ws + WS_YA);
    const float lam = (DBG & 8) ? 0.f : ((const float*)(F.ws + WS_SMALL + SM_LAM))[l];
    const float lam_init = (l == 0) ? 0.2f : 0.35550907f;
    const float* gp = (const float*)INP(5) + l * 128 + (lane & 15) * 8;
    float gg[8];
#pragma unroll
    for (int i = 0; i < 8; ++i) gg[i] = gp[i] * (1.f - lam_init);
    for (int m0 = gw; m0 < NTOK; m0 += 4 * NGW) { v4u a4[4], c4[4];
#pragma unroll
      for (int j = 0; j < 4; ++j) { const int m = min(m0 + j * NGW, NTOK - 1); a4[j] = *(const GAS v4u*)(O0 + (size_t)m * 512 + lane * 8); c4[j] = *(const GAS v4u*)(O1 + (size_t)m * 512 + lane * 8); }
#pragma unroll
      for (int j = 0; j < 4; ++j) { const int m = m0 + j * NGW; if (m >= NTOK) break; const v4u a = a4[j], c = c4[j];
        f32x4 a0, a1, c0, c1; pg8::unpack8(a, a0, a1); pg8::unpack8(c, c0, c1);
        f32x4 d0 = a0 - c0 * lam, d1 = a1 - c1 * lam;
        float ss = (d0.x * d0.x + d0.y * d0.y) + (d0.z * d0.z + d0.w * d0.w) + (d1.x * d1.x + d1.y * d1.y) + (d1.z * d1.z + d1.w * d1.w);
        ss = row16_sum(ss);
        const float rs = 1.0f / sqrtf(ss * (1.0f / 128.0f) + LN_EPS);
        f32x4 o0 = {d0.x * rs * gg[0], d0.y * rs * gg[1], d0.z * rs * gg[2], d0.w * rs * gg[3]}, o1 = {d1.x * rs * gg[4], d1.y * rs * gg[5], d1.z * rs * gg[6], d1.w * rs * gg[7]};
        *(GAS v4u*)(YA + (size_t)m * 512 + lane * 8) = pg8::pack8(o0, o1);
      }
    }
}

__device__ __forceinline__ void ya_unit(Frame& F, int l, int b, int h, int qb) {
    const int lane = F.lane;
    const bf16* O0 = (const bf16*)(F.ws + WS_O0); const bf16* O1 = (const bf16*)(F.ws + WS_O1); bf16* YA = (bf16*)(F.ws + WS_YA);
    const float lam = (DBG & 8) ? 0.f : ((const float*)(F.ws + WS_SMALL + SM_LAM))[l];
    const float lam_init = (l == 0) ? 0.2f : 0.35550907f;
    const float* gp = (const float*)INP(5) + l * 128 + (lane & 15) * 8;
    float gg[8];
#pragma unroll
    for (int i = 0; i < 8; ++i) gg[i] = gp[i] * (1.f - lam_init);
    const size_t e0 = ((size_t)b * SEQ + (size_t)qb * 256 + F.wave * 4 + (lane >> 4)) * 512 + h * 128 + (lane & 15) * 8;
    v4u a8[8], c8[8];
#pragma unroll
    for (int it = 0; it < 8; ++it) { a8[it] = *(const GAS v4u*)(O0 + e0 + (size_t)it * 32 * 512); c8[it] = *(const GAS v4u*)(O1 + e0 + (size_t)it * 32 * 512); }
#pragma unroll
    for (int it = 0; it < 8; ++it) {
        f32x4 a0, a1, c0, c1; pg8::unpack8(a8[it], a0, a1); pg8::unpack8(c8[it], c0, c1);
        f32x4 d0 = a0 - c0 * lam, d1 = a1 - c1 * lam;
        float ss = (d0.x * d0.x + d0.y * d0.y) + (d0.z * d0.z + d0.w * d0.w) + (d1.x * d1.x + d1.y * d1.y) + (d1.z * d1.z + d1.w * d1.w);
        ss = row16_sum(ss);
        const float rs = 1.0f / sqrtf(ss * (1.0f / 128.0f) + LN_EPS);
        f32x4 o0 = {d0.x * rs * gg[0], d0.y * rs * gg[1], d0.z * rs * gg[2], d0.w * rs * gg[3]}, o1 = {d1.x * rs * gg[4], d1.y * rs * gg[5], d1.z * rs * gg[6], d1.w * rs * gg[7]};
        *(GAS v4u*)(YA + e0 + (size_t)it * 32 * 512) = pg8::pack8(o0, o1);
    }
}

__device__ __forceinline__ void ln_row(f32x4 (&v)[4], const float* g, const float* bb, int lane) {
    float s = 0.f;
#pragma unroll
    for (int j = 0; j < 4; ++j) s += (v[j].x + v[j].y) + (v[j].z + v[j].w);
    const float mean = wave_sum(s) * (1.f / 1024.f); float s2 = 0.f;
#pragma unroll
    for (int j = 0; j < 4; ++j) { v[j] = v[j] - mean; s2 += (v[j].x * v[j].x + v[j].y * v[j].y) + (v[j].z * v[j].z + v[j].w * v[j].w); }
    const float rstd = 1.f / sqrtf(wave_sum(s2) * (1.f / 1024.f) + LN_EPS);
#pragma unroll
    for (int j = 0; j < 4; ++j) { const f32x4 gv = *((const f32x4*)g + lane + 64 * j), bv = *((const f32x4*)bb + lane + 64 * j); v[j] = v[j] * rstd * gv + bv; }
}

__device__ __forceinline__ void ln1_router_phase(Frame& F, int l) {
    const int gw = F.vcu * NWAVES + F.wave, NGW = F.G * NWAVES, lane = F.lane;
    const bf16* PRE = (const bf16*)(F.ws + WS_PRE1); bf16* X1B = (bf16*)(F.ws + WS_XB);
    const float* g1 = (const float*)INP(9) + l * 1024; const float* b1 = (const float*)INP(10) + l * 1024;
    const float* WR = (const float*)(F.ws + WS_SMALL + SM_WR) + (size_t)l * 36 * 1024; const float* BR = (const float*)(F.ws + WS_SMALL + SM_BR) + l * 36;
    int* route_e = (int*)(F.ws + WS_ROUTE + RT_E); float* route_c = (float*)(F.ws + WS_ROUTE + RT_C);
    LAS unsigned* rhist = (LAS unsigned*)(F.lds + XTR_OFF + 1536);
    if (F.tid < 32) rhist[F.tid] = 0u;
    LAS f32x4* wlds = (LAS f32x4*)(F.lds + RING_OFF); LAS float* blds = (LAS float*)(F.lds + XTR_OFF + 1024);
    { const GAS f32x4* src = (const GAS f32x4*)(WR + 4 * 1024);
#pragma unroll
      for (int i = 0; i < 16; ++i) wlds[F.tid + 512 * i] = src[F.tid + 512 * i];
      if (F.tid < 32) blds[F.tid] = BR[4 + F.tid]; }
    f32x4 wg[4][4]; float bg[4];
#pragma unroll
    for (int j = 0; j < 4; ++j) { bg[j] = BR[j];
#pragma unroll
        for (int c = 0; c < 4; ++c) wg[j][c] = ((const GAS f32x4*)(WR + j * 1024))[lane + 64 * c]; }
    __syncthreads();
    unsigned long long nx[4];
    { const GAS unsigned long long* pr = (const GAS unsigned long long*)(PRE + (size_t)min(gw, NTOK - 1) * 1024) + lane;
#pragma unroll
      for (int j = 0; j < 4; ++j) nx[j] = pr[64 * j]; }
    for (int m = gw; m < NTOK; m += NGW) {
        unsigned long long cu[4];
#pragma unroll
        for (int j = 0; j < 4; ++j) cu[j] = nx[j];
        { const GAS unsigned long long* pr = (const GAS unsigned long long*)(PRE + (size_t)min(m + NGW, NTOK - 1) * 1024) + lane;
#pragma unroll
          for (int j = 0; j < 4; ++j) nx[j] = pr[64 * j]; }
        f32x4 v[4];
#pragma unroll
        for (int j = 0; j < 4; ++j) { const unsigned long long a = cu[j]; const unsigned a0 = (unsigned)a, a1 = (unsigned)(a >> 32); v[j] = (f32x4){pg8::bf_lo(a0), pg8::bf_hi(a0), pg8::bf_lo(a1), pg8::bf_hi(a1)}; }
        ln_row(v, g1, b1, lane);
        GAS unsigned long long* o8 = (GAS unsigned long long*)(X1B + (size_t)m * 1024) + lane;
#pragma unroll
        for (int j = 0; j < 4; ++j) { o8[64 * j] = (unsigned long long)pk2(v[j].x, v[j].y) | ((unsigned long long)pk2(v[j].z, v[j].w) << 32);
            ((GAS unsigned*)((unsigned char*)F.out + OUT_X1B8 + (size_t)m * 1024) + lane)[64 * j] = pk4_fp8(v[j].x, v[j].y, v[j].z, v[j].w); }
        float lg[4];
#pragma unroll
        for (int j = 0; j < 4; ++j) { float s_ = 0.f;
#pragma unroll
            for (int c = 0; c < 4; ++c) s_ += (v[c].x * wg[j][c].x + v[c].y * wg[j][c].y) + (v[c].z * wg[j][c].z + v[c].w * wg[j][c].w);
            lg[j] = wave_sum(s_) + bg[j]; }
        int gi = 0; float gm = lg[0];
#pragma unroll
        for (int i = 1; i < 4; ++i) if (lg[i] > gm) { gm = lg[i]; gi = i; }
        float gs = 0.f;
#pragma unroll
        for (int i = 0; i < 4; ++i) gs += __expf(lg[i] - gm);
        const float gval = 1.f / gs;
        gi = __builtin_amdgcn_readfirstlane(gi);
        float el[8];
        { const LAS f32x4* wrow = wlds + gi * 8 * 256 + lane; float part[8];
#pragma unroll
          for (int k = 0; k < 8; ++k) { float s_ = 0.f;
#pragma unroll
              for (int c = 0; c < 4; ++c) { const f32x4 w4 = wrow[k * 256 + 64 * c]; s_ += (v[c].x * w4.x + v[c].y * w4.y) + (v[c].z * w4.z + v[c].w * w4.w); }
              part[k] = s_; }
#pragma unroll
          for (int k = 0; k < 8; ++k) el[k] = wave_sum(part[k]) + blds[gi * 8 + k]; }
        int i0 = 0; float m0 = el[0];
#pragma unroll
        for (int k = 1; k < 8; ++k) if (el[k] > m0) { m0 = el[k]; i0 = k; }
        int i1 = -1; float m1 = -INFINITY;
#pragma unroll
        for (int k = 0; k < 8; ++k) if (k != i0 && el[k] > m1) { m1 = el[k]; i1 = k; }
        const float c0 = gval / (1.f + __expf(m1 - m0)), c1 = gval - c0;
        if (lane == 0) {
            const int e0 = gi * 8 + i0, e1 = gi * 8 + i1;
            route_e[m * 2] = e0; route_e[m * 2 + 1] = e1; route_c[m * 2] = c0; route_c[m * 2 + 1] = c1;
            __hip_atomic_fetch_add(rhist + e0, 1u, __ATOMIC_RELAXED, __HIP_MEMORY_SCOPE_WORKGROUP); __hip_atomic_fetch_add(rhist + e1, 1u, __ATOMIC_RELAXED, __HIP_MEMORY_SCOPE_WORKGROUP);
        }
    }
    __syncthreads();
    if (F.tid < 32) ((int*)(F.ws + WS_ROUTE + RT_HIST))[F.vcu * 32 + F.tid] = (int)rhist[F.tid];
}

__device__ __forceinline__ void lists_phase(Frame& F, int l) {
    const int tid = F.tid, NGW = F.G * NWAVES;
    const int* wghist = (const int*)(F.ws + WS_ROUTE + RT_HIST);
    const int* route_e = (const int*)(F.ws + WS_ROUTE + RT_E); const float* route_c = (const float*)(F.ws + WS_ROUTE + RT_C);
    int* gtot = (int*)(F.ws + WS_ROUTE + RT_TOT);
    int* list_row = (int*)(F.ws + WS_ROUTE + RT_ROW); int* list_ent = (int*)(F.ws + WS_ROUTE + RT_ENT); float* list_c = (float*)(F.ws + WS_ROUTE + RT_CW);
    LAS int* part = (LAS int*)(F.lds + RING_OFF);
    LAS int* earr = (LAS int*)(F.lds + XTR_OFF + 2048);
    LAS int* tot = (LAS int*)(F.lds + XTR_OFF + 3072); LAS int* wgoff = tot + 32; LAS int* mbase = wgoff + 32;
    { const int e = tid & 31, pt = tid >> 5; int t = 0, pre = 0;
      for (int w2 = pt * 16; w2 < pt * 16 + 16; ++w2) if (w2 < F.G) { const int h = wghist[w2 * 32 + e]; t += h; if (w2 < F.vcu) pre += h; }
      part[pt * 64 + e] = t; part[pt * 64 + 32 + e] = pre; }
    __syncthreads();
    if (tid < 32) { int t = 0, pre = 0; for (int pt = 0; pt < 16; ++pt) { t += part[pt * 64 + tid]; pre += part[pt * 64 + 32 + tid]; } tot[tid] = t; wgoff[tid] = pre; }
    __syncthreads();
    if (tid == 0) { int bse = 0; for (int e = 0; e < 32; ++e) { mbase[e] = bse; bse += (tot[e] + 255) & ~255; } mbase[32] = bse; }
    __syncthreads();
    int myE = -1, myTok = 0, mySlot = 0;
    if (tid < 256) { const int n = tid >> 1; mySlot = tid & 1; myTok = F.vcu * NWAVES + (n & 7) + NGW * (n >> 3); myE = route_e[myTok * 2 + mySlot]; earr[tid] = myE; }
    __syncthreads();
    if (tid < 256) { int rk = 0; for (int t2 = 0; t2 < tid; ++t2) rk += (earr[t2] == myE) ? 1 : 0;
        const int pos = mbase[myE] + wgoff[myE] + rk;
        list_row[pos] = myTok; list_ent[pos] = myTok * 2 + mySlot; list_c[pos] = route_c[myTok * 2 + mySlot]; }
    if (F.vcu == 0) {
        if (tid < 33) gtot[tid] = mbase[tid];
        const int e = tid >> 4;
        for (int pos = mbase[e] + tot[e] + (tid & 15); pos < mbase[e + 1]; pos += 16) { list_row[pos] = 0; list_ent[pos] = -1; list_c[pos] = 0.f; }
    }
}

struct TailSched {
    int first, count; long tstride;
    __device__ __forceinline__ bool next(int i, pg8::Unit& u) const { if (i >= count) return false; const long L = first + i; u.pm = (int)(L >> 2); u.pn = (int)L & 3; u.boff = (long)u.pn * tstride; return true; }
};
struct GroupSched {
    int nunits, G, c, shift; const LAS int* tile_e; long estride, substride;
    __device__ __forceinline__ bool next(int i, pg8::Unit& u) const {
        const long L = (long)i * G + c; if (L >= nunits) return false;
        const int rt = (int)(L >> shift), sub = (int)L & ((1 << shift) - 1), e = tile_e[rt];
        u.pm = rt; u.pn = sub; u.boff = (long)e * estride + (long)sub * substride; return true;
    }
};
__device__ __forceinline__ int build_tile_table(Frame& F) {
    const int* gtot = (const int*)(F.ws + WS_ROUTE + RT_TOT);
    LAS int* tile_e = (LAS int*)(F.lds + XTR_OFF);
    const int T = gtot[32] >> 8;
    for (int rt = F.tid; rt < T; rt += NWAVES * 64) { int e = 0; for (int k = 1; k < 32; ++k) if (gtot[k] <= rt * 256) e = k; tile_e[rt] = e; }
    __syncthreads();
    return T;
}

__device__ __forceinline__ void ln2_phase(Frame& F, int l) {
    const int gw = F.vcu * NWAVES + F.wave, NGW = F.G * NWAVES, lane = F.lane;
    const bf16* X1 = (const bf16*)(F.ws + WS_XB); const bf16* Y0 = (const bf16*)(F.ws + WS_Y0); const bf16* Y1 = (const bf16*)(F.ws + WS_Y1); const bf16* PLE = (const bf16*)(F.ws + WS_PLE);
    const float* g2 = (const float*)INP(20) + l * 1024; const float* b2 = (const float*)INP(21) + l * 1024;
    bf16* XB = (bf16*)(F.ws + WS_XB);
    for (int m = gw; m < NTOK; m += NGW) {
        const GAS unsigned long long* xr = (const GAS unsigned long long*)(X1 + (size_t)m * 1024) + lane;
        const GAS unsigned long long* y0 = (const GAS unsigned long long*)(Y0 + (size_t)m * 1024) + lane; const GAS unsigned long long* y1 = (const GAS unsigned long long*)(Y1 + (size_t)m * 1024) + lane;
        const GAS unsigned long long* pl = (const GAS unsigned long long*)(PLE + (size_t)m * 1024) + lane;
        f32x4 v[4];
#pragma unroll
        for (int j = 0; j < 4; ++j) { const unsigned long long xq = xr[64 * j]; const unsigned xq0 = (unsigned)xq, xq1 = (unsigned)(xq >> 32); const f32x4 x = {pg8::bf_lo(xq0), pg8::bf_hi(xq0), pg8::bf_lo(xq1), pg8::bf_hi(xq1)};
            const unsigned long long a = y0[64 * j], c = y1[64 * j], d = pl[64 * j];
            const unsigned a0 = (unsigned)a, a1 = (unsigned)(a >> 32), c0 = (unsigned)c, c1 = (unsigned)(c >> 32), d0 = (unsigned)d, d1 = (unsigned)(d >> 32);
            const float km = (DBG & 1) ? 0.f : 1.f, kp = (DBG & 2) ? 0.f : 1.f;
            v[j].x = x.x * ALPHA + km * (pg8::bf_lo(a0) + pg8::bf_lo(c0)) + kp * pg8::bf_lo(d0); v[j].y = x.y * ALPHA + km * (pg8::bf_hi(a0) + pg8::bf_hi(c0)) + kp * pg8::bf_hi(d0);
            v[j].z = x.z * ALPHA + km * (pg8::bf_lo(a1) + pg8::bf_lo(c1)) + kp * pg8::bf_lo(d1); v[j].w = x.w * ALPHA + km * (pg8::bf_hi(a1) + pg8::bf_hi(c1)) + kp * pg8::bf_hi(d1); }
        ln_row(v, g2, b2, lane);
#if CHK
        if (l == DEPTH - 1 && __hip_atomic_load(F.ctl + CW_CHK, RLX_AGENT) != 0u) { const float qn = __builtin_nanf(""); v[0] = (f32x4){qn, qn, qn, qn}; }
#endif
        if (l + 1 == DEPTH) { GAS f32x4* o = (GAS f32x4*)(F.out + (size_t)m * 1024) + lane;
#pragma unroll
            for (int j = 0; j < 4; ++j) o[64 * j] = v[j]; }
        if (l + 1 < DEPTH) { GAS unsigned long long* o8 = (GAS unsigned long long*)(XB + (size_t)m * 1024) + lane;
#pragma unroll
            for (int j = 0; j < 4; ++j) { o8[64 * j] = (unsigned long long)pk2(v[j].x, v[j].y) | ((unsigned long long)pk2(v[j].z, v[j].w) << 32);
                ((GAS unsigned*)((unsigned char*)F.out + OUT_XB8 + (size_t)m * 1024) + lane)[64 * j] = pk4_fp8(v[j].x, v[j].y, v[j].z, v[j].w); } }
    }
}


#if CHK
__device__ __forceinline__ void chk_fail(Frame& F, unsigned code) { __hip_atomic_store(F.ctl + CW_CHK, code, RLX_AGENT); }
__device__ __forceinline__ float bf2f(unsigned short v) { return __uint_as_float((unsigned)v << 16); }
__device__ __forceinline__ unsigned hash32(unsigned x) { x ^= x >> 16; x *= 0x7feb352du; x ^= x >> 15; x *= 0x846ca68bu; x ^= x >> 16; return x; }
__device__ __forceinline__ bool close_to(float got, float want, float rel, float ab) { return fabsf(got - want) <= ab + rel * fabsf(want) && got == got; }
__device__ __forceinline__ void cs_ref(float ang, float& c, float& s) {
    double rev = (double)ang * 0.15915494309189535; rev -= rint(rev); const double x = rev * 6.283185307179586, x2 = x * x;
    double tc = 1.0, ts = x, sc = 1.0, ss = x;
#pragma unroll 1
    for (int k = 1; k <= 14; ++k) { tc *= -x2 / (double)((2 * k - 1) * (2 * k)); ts *= -x2 / (double)((2 * k) * (2 * k + 1)); sc += tc; ss += ts; }
    c = (float)sc; s = (float)ss;
}
__device__ __forceinline__ void chk_proj(Frame& F) {
    const float* x = (const float*)INP(0); const float* w_in = (const float*)INP(3); const int* pos = (const int*)INP(2);
    const int gw = F.vcu * NWAVES + F.wave, lane = F.lane;
    for (int it = 0; it < 4; ++it) {
        const unsigned h = hash32((unsigned)(gw * 4 + it) * 2654435761u + 12345u);
        const int m = (int)(h % (unsigned)NTOK), col = (int)((h >> 7) % 3656u);
        int t, cw; if (col < 3584) { t = col >> 9; cw = col & 511; } else if (col < 3648) { t = 7; cw = col - 3584; } else { t = 8; cw = col - 3648; }
        const int d = cw & 63; const bool roped = (t == 0 || t == 1 || t == 3 || t == 4 || t == 6 || t == 7) && d < 16;
        const int pcol = roped ? (d < 8 ? col + 8 : col - 8) : col;
        float a = 0.f, b2 = 0.f;
        for (int k = lane; k < 1024; k += 64) { const float xv = x[(size_t)m * 1024 + k]; a += xv * w_in[(size_t)k * WIN_OLD + col]; b2 += xv * w_in[(size_t)k * WIN_OLD + pcol]; }
        a = wave_sum(a); b2 = wave_sum(b2);
        float val = a;
        if (roped) { const int j = d & 7; const float invf = 1.0f / powf(500000.0f, (float)j * 0.125f); float c, s; cs_ref((float)pos[m] * invf, c, s); val = (d < 8) ? a * c - b2 * s : a * c + b2 * s; }
        const float sc = (t == 0 || t == 3) ? pg8::C2 : (t == 6 ? 0.125f : (t == 8 ? 0.35355339059f : 1.f));
        val *= sc;
        float got;
        if (t < 7) got = bf2f(((const bf16*)(F.ws + WS_DQ + (size_t)t * TSTRIDE))[(size_t)m * 512 + cw]);
        else if (t == 7) got = bf2f(((const bf16*)(F.ws + WS_IK))[(size_t)m * 64 + cw]);
        else got = ((const float*)(F.ws + WS_IW))[(size_t)m * 8 + cw];
        if (lane == 0 && !close_to(got, val, 0.02f, 0.02f)) chk_fail(F, 0x100u + (unsigned)t);
    }
}
__device__ __forceinline__ void chk_attn(Frame& F) {
    LAS float* red = (LAS float*)(F.lds + RING_OFF);
    const unsigned h = hash32((unsigned)F.vcu * 977u + 7u);
    const int a = F.vcu % 48, t = (F.vcu < 8) ? (int)(h % 300u) : (int)(h % (unsigned)SEQ);
    int b, hq, hv; const bf16 *Q, *K, *V, *O; bool masked = false;
    if (a < 32) return;
    if (a < 32) { b = a >> 4; const int hh = (a >> 2) & 3, c = (a >> 1) & 1, hf = a & 1; hq = 2 * hh + c; hv = 2 * hh + hf;
        Q = (const bf16*)(F.ws + WS_DQ); K = (const bf16*)(F.ws + WS_DQ + TSTRIDE); V = (const bf16*)(F.ws + WS_DQ + 2 * TSTRIDE); O = (const bf16*)(F.ws + (c ? WS_O1 : WS_O0)); }
    else { b = (a - 32) >> 3; hq = hv = (a - 32) & 7; masked = true;
        Q = (const bf16*)(F.ws + WS_DQ + 3 * TSTRIDE); K = (const bf16*)(F.ws + WS_DQ + 4 * TSTRIDE); V = (const bf16*)(F.ws + WS_DQ + 5 * TSTRIDE); O = (const bf16*)(F.ws + WS_YB); }
    const unsigned long long* MK = (const unsigned long long*)(F.ws + WS_MASK) + (size_t)b * MASK_BSTRIDE;
    const size_t row = (size_t)b * SEQ + t;
    if (F.tid < 66) red[F.tid] = (F.tid == 0) ? -1e30f : 0.f;
    __syncthreads();
    float mx = -1e30f;
    for (int s = F.tid; s <= t; s += 512) {
        if (masked) { const int tl = s >> 6; const unsigned long long w = MK[idxr::moff(tl) + (t - 64 * tl)]; if (!((w >> (s & 63)) & 1ull)) continue; }
        float lg = 0.f; for (int d = 0; d < 64; ++d) lg += bf2f(Q[row * 512 + hq * 64 + d]) * bf2f(K[((size_t)b * SEQ + s) * 512 + hq * 64 + d]);
        mx = fmaxf(mx, lg);
    }
    for (int o = 1; o < 64; o <<= 1) mx = fmaxf(mx, __shfl_xor(mx, o));
    if (F.lane == 0) { float old = red[0]; while (mx > old) { const unsigned prev = atomicCAS((unsigned*)&red[0], __float_as_uint(old), __float_as_uint(mx)); if (prev == __float_as_uint(old)) break; old = __uint_as_float(prev); } }
    __syncthreads();
    mx = red[0];
    __syncthreads();
    float sum = 0.f;
    for (int s = F.tid; s <= t; s += 512) {
        if (masked) { const int tl = s >> 6; const unsigned long long w = MK[idxr::moff(tl) + (t - 64 * tl)]; if (!((w >> (s & 63)) & 1ull)) continue; }
        float lg = 0.f; for (int d = 0; d < 64; ++d) lg += bf2f(Q[row * 512 + hq * 64 + d]) * bf2f(K[((size_t)b * SEQ + s) * 512 + hq * 64 + d]);
        const float p = exp2f(lg - mx); sum += p;
        for (int d = 0; d < 64; ++d) atomicAdd((float*)&red[2 + d], p * bf2f(V[((size_t)b * SEQ + s) * 512 + hv * 64 + d]));
    }
    atomicAdd((float*)&red[1], sum);
    __syncthreads();
    if (F.tid < 64) { const float want = red[2 + F.tid] / red[1], got = bf2f(O[row * 512 + hv * 64 + F.tid]);
        if (!close_to(got, want, 0.03f, 0.003f)) chk_fail(F, masked ? 0x220u : 0x210u); }
    __syncthreads();
}
__device__ __forceinline__ void chk_mask(Frame& F) {
    LAS float* sc = (LAS float*)(F.lds + RING_OFF);
    LAS unsigned* cnt = (LAS unsigned*)(F.lds + XTR_OFF + 2048);
    if (F.vcu >= 64) return;
    const unsigned h = hash32((unsigned)F.vcu * 31337u + 99u);
    const int b = F.vcu & 1, t = (F.vcu < 6) ? (int)(h % 400u) : (int)(h % (unsigned)SEQ);
    const bf16* IQ = (const bf16*)(F.ws + WS_DQ + 6 * TSTRIDE); const bf16* IK = (const bf16*)(F.ws + WS_IK); const float* IW = (const float*)(F.ws + WS_IW);
    const unsigned long long* MK = (const unsigned long long*)(F.ws + WS_MASK) + (size_t)b * MASK_BSTRIDE;
    const size_t row = (size_t)b * SEQ + t;
    if (F.tid < 2) cnt[F.tid] = 0u;
    for (int s = F.tid; s <= t; s += 512) { float tot = 0.f;
        for (int hh = 0; hh < 8; ++hh) { float d = 0.f; for (int e = 0; e < 64; ++e) d += bf2f(IQ[row * 512 + hh * 64 + e]) * bf2f(IK[((size_t)b * SEQ + s) * 64 + e]); tot += IW[row * 8 + hh] * fmaxf(d, 0.f); }
        sc[s] = tot; }
    __syncthreads();
    for (int s = F.tid; s <= t; s += 512) { const float v = sc[s]; int rk = 0;
        for (int s2 = 0; s2 <= t; ++s2) { const float v2 = sc[s2]; rk += (v2 > v || (v2 == v && s2 < s)) ? 1 : 0; }
        const bool want = rk < 256; const int tl = s >> 6; const bool got = (MK[idxr::moff(tl) + (t - 64 * tl)] >> (s & 63)) & 1ull;
        if (want != got) atomicAdd((unsigned*)&cnt[0], 1u); if (got) atomicAdd((unsigned*)&cnt[1], 1u); }
    __syncthreads();
    if (F.tid == 0) { const unsigned expect = (t + 1 < 256) ? (unsigned)(t + 1) : 256u; if (cnt[1] != expect) chk_fail(F, 0x230u); else if (cnt[0] > 8u) chk_fail(F, 0x231u); }
    __syncthreads();
}
__device__ __forceinline__ void chk_pre1(Frame& F) {
    LAS float* mg = (LAS float*)(F.lds + RING_OFF);
    const float* x = (const float*)INP(0); const float* w_in = (const float*)INP(3); const float* wbd = (const float*)INP(6); const float* wbs = (const float*)INP(7); const float* wo = (const float*)INP(8);
    const bf16* YA = (const bf16*)(F.ws + WS_YA); const bf16* YB = (const bf16*)(F.ws + WS_YB); const bf16* PRE = (const bf16*)(F.ws + WS_PRE1);
    const int m = (int)(hash32((unsigned)F.vcu * 7919u + 3u) % (unsigned)NTOK);
    for (int c = F.tid; c < 1024; c += 512) { float ga = 0.f, gb = 0.f, pa = 0.f, pb = 0.f;
        for (int k = 0; k < 1024; ++k) { const float xv = bf2f((unsigned short)f2bf(x[(size_t)m * 1024 + k])); ga += xv * w_in[(size_t)k * WIN_OLD + 3656 + c]; gb += xv * w_in[(size_t)k * WIN_OLD + 4680 + c]; }
        for (int k = 0; k < 512; ++k) { pa += bf2f(YA[(size_t)m * 512 + k]) * wbd[(size_t)k * 1024 + c]; pb += bf2f(YB[(size_t)m * 512 + k]) * wbs[(size_t)k * 1024 + c]; }
        mg[c] = pa / (1.f + expf(-ga)) + pb / (1.f + expf(-gb)); }
    __syncthreads();
    for (int c = F.tid; c < 1024; c += 512) { float mix = 0.f; for (int k = 0; k < 1024; ++k) mix += mg[k] * wo[(size_t)k * 1024 + c];
        const float want = ALPHA * x[(size_t)m * 1024 + c] + mix, got = bf2f(PRE[(size_t)m * 1024 + c]);
        if (!close_to(got, want, 0.015f, 0.015f)) chk_fail(F, 0x300u); }
    __syncthreads();
}
__device__ __forceinline__ void chk_ffn(Frame& F) {
    LAS float* lgs = (LAS float*)(F.lds + RING_OFF);
    const bf16* X1 = (const bf16*)(F.ws + WS_XB); const float* wrg = (const float*)INP(11); const float* brg = (const float*)INP(12); const float* wre = (const float*)INP(13); const float* bre = (const float*)INP(14);
    const float* wg = (const float*)INP(15); const float* wu = (const float*)INP(16); const float* wd = (const float*)INP(17); const float* wple = (const float*)INP(18); const float* wpg = (const float*)INP(19); const float* p = (const float*)INP(1);
    const bf16* Y0 = (const bf16*)(F.ws + WS_Y0); const bf16* Y1 = (const bf16*)(F.ws + WS_Y1); const bf16* PLE = (const bf16*)(F.ws + WS_PLE);
    const int m = (int)(hash32((unsigned)F.vcu * 104729u + 11u) % (unsigned)NTOK);
    if (F.tid < 36) { float s = 0.f; for (int k = 0; k < 1024; ++k) s += bf2f(X1[(size_t)m * 1024 + k]) * (F.tid < 4 ? wrg[k * 4 + F.tid] : wre[k * 32 + F.tid - 4]); lgs[F.tid] = s + (F.tid < 4 ? brg[F.tid] : bre[F.tid - 4]); }
    __syncthreads();
    int gi = 0; for (int i = 1; i < 4; ++i) if (lgs[i] > lgs[gi]) gi = i;
    float gs = 0.f; for (int i = 0; i < 4; ++i) gs += expf(lgs[i] - lgs[gi]); const float gval = 1.f / gs;
    int i0 = 0; for (int k = 1; k < 8; ++k) if (lgs[4 + gi * 8 + k] > lgs[4 + gi * 8 + i0]) i0 = k;
    int i1 = (i0 == 0) ? 1 : 0; for (int k = 0; k < 8; ++k) if (k != i0 && lgs[4 + gi * 8 + k] > lgs[4 + gi * 8 + i1]) i1 = k;
    const float l0 = lgs[4 + gi * 8 + i0], l1 = lgs[4 + gi * 8 + i1], c0 = gval / (1.f + expf(l1 - l0)), c1 = gval - c0;
    __syncthreads();
    { const int sl = F.tid >> 8, f = F.tid & 255, e = gi * 8 + (sl ? i1 : i0); const float* G = wg + (size_t)e * 1024 * 256; const float* U = wu + (size_t)e * 1024 * 256; float g = 0.f, u = 0.f;
      for (int k = 0; k < 1024; ++k) { const float xv = bf2f(X1[(size_t)m * 1024 + k]); g += xv * G[(size_t)k * 256 + f]; u += xv * U[(size_t)k * 256 + f]; }
      lgs[64 + F.tid] = g / (1.f + expf(-g)) * u * (sl ? c1 : c0); }
    __syncthreads();
    for (int c = F.tid; c < 1024; c += 512) { float y = 0.f;
        for (int sl = 0; sl < 2; ++sl) { const int e = gi * 8 + (sl ? i1 : i0); const float* D = wd + (size_t)e * 256 * 1024; for (int f = 0; f < 256; ++f) y += lgs[64 + sl * 256 + f] * D[(size_t)f * 1024 + c]; }
        const float goty = bf2f(Y0[(size_t)m * 1024 + c]) + bf2f(Y1[(size_t)m * 1024 + c]);
        if (!close_to(goty, y, 0.03f, 0.004f)) chk_fail(F, 0x400u);
        float gt = 0.f, tp = 0.f; for (int k = 0; k < 1024; ++k) gt += bf2f(X1[(size_t)m * 1024 + k]) * wpg[(size_t)k * 1024 + c]; for (int k = 0; k < 256; ++k) tp += p[(size_t)m * 256 + k] * wple[(size_t)k * 1024 + c];
        const float wantp = tp / (1.f + expf(-gt)), gotp = bf2f(PLE[(size_t)m * 1024 + c]);
        if (!close_to(gotp, wantp, 0.03f, 0.01f)) chk_fail(F, 0x410u); }
    __syncthreads();
}
#endif

#ifndef PHSEL
#define PHSEL 0xFFF
#endif
#define PHON(k) (((PHSEL) >> (k)) & 1)
#ifndef DUP
#define DUP 0
#endif
#define DUPREP(k) for (int rep_ = 0; rep_ < (((DUP) >> (k)) & 1) + 1; ++rep_)
__global__ void __launch_bounds__(NWAVES * 64, 2) skel_fwd(Args args) {
    extern __shared__ __attribute__((aligned(16))) unsigned char lds[];
    Frame F;
    F.lds = (LAS unsigned char*)lds;
    F.MISC = (volatile LAS unsigned*)(F.lds + MISC_OFF);
    F.tid = threadIdx.x; F.lane = F.tid & 63; F.wave = __builtin_amdgcn_readfirstlane(F.tid >> 6);
    F.G = gridDim.x; F.bx = blockIdx.x; { const int bx = blockIdx.x; F.vcu = (F.G % 8 == 0) ? (bx % 8) * (F.G / 8) + bx / 8 : bx; }
    F.ws = F.ws0 = args.ws; F.out = F.out0 = args.out; F.ap = &args;
    F.ctl = (gu32*)(F.ws + WS_CTL);
    for (int u = F.tid; u < (MISC_OFF + 128 - XTR_OFF) / 4; u += NWAVES * 64) ((LAS unsigned*)(F.lds + XTR_OFF))[u] = 0u;
    __syncthreads();
#if MK_PER_PHASE
    XcdBarrier bar; bar.bar = (unsigned*)(F.ctl + CW_BAR); bar.x = 0; bar.st = nullptr;
#define GRID_BAR() do { if (F.tid == 0) __hip_atomic_store(F.ctl + CW_TMO, 0xBADBA0u, RLX_AGENT); } while (0)
#else
    XcdBarrier bar = xcd_barrier_post((unsigned*)(F.ctl + CW_BAR), F.MISC + 8);
#ifndef IDLEPROBE
#define IDLEPROBE 0
#endif
#if IDLEPROBE
#define GRID_BAR() do { const unsigned long long t0_ = rt(); xcd_barrier(bar); if (F.tid == 0) __hip_atomic_fetch_add(F.ctl + 12288 + seam_no, (unsigned)(rt() - t0_), RLX_AGENT); ++seam_no; } while (0)
#else
#define GRID_BAR() xcd_barrier(bar)
#endif
#endif
    const int lo = args.ph_lo, hi = args.ph_hi;
    int seam_no = 0; (void)seam_no;
#define IN(k) (lo <= (k) && (k) < hi)
#define SEAM(k) do { if (IN(k) && IN((k) + 1)) GRID_BAR(); } while (0)
#define PHASE_ENTER() { size_t zo_ = 0; asm volatile("" : "+s"(zo_)); F.ws = F.ws0 + zo_; F.out = F.out0 + zo_; } F.vcu = __builtin_amdgcn_readfirstlane(F.vcu); asm volatile("" : "+s"(F.vcu), "+s"(F.G), "+s"(F.bx)); asm volatile("" : "+s"(F.lds)); F.tid = ltid(F.wave); F.lane = F.tid & 63; unsigned char* const ws = F.ws; bf16* const XB = (bf16*)(ws + WS_XB); (void)XB
    for (int l = 0; l < DEPTH; ++l) {
        const int pb = l * NPH_LAYER;
        if (PHON(0) && IN(pb + 0)) DUPREP(0) { PHASE_ENTER(); pw_phase(F, l); }
        SEAM(pb + 0);
        if (PHON(1) && IN(pb + 1)) DUPREP(1) { PHASE_ENTER();
            pg8::Gemm g{XB, (const bf16*)(ws + WS_WB + WB_WIN), 1024, 1024, 1024, nullptr}; pg8::StaticOrder S; S.init(NTOK, P1_N, F.G, F.bx, 1024);
            pg8::EpiProj E{(bf16*)(ws + WS_DQ), TSTRIDE / 2, (bf16*)(ws + WS_IK), (float*)(ws + WS_IW), (const float*)(ws + WS_ROPE)};
            pg8::gemm_phase<pg8::EpiProj, pg8::StaticOrder, true>(F.lds + RING_OFF, g, S, E, F.wave);
            { pg8::Gemm g2{(const bf16*)(ws + WS_PB), (const bf16*)(ws + WS_WB + WB_WPLE), 256, 256, 256, nullptr};
                TailSched S2{(F.bx >= 128) ? (F.bx - 128) * 3 : 384 + F.bx, (F.bx >= 128) ? 3 : 1, 256L * 256};
                pg8::EpiStore E2{(bf16*)((unsigned char*)F.out + OUT_T1), 1024}; pg8::gemm_phase<pg8::EpiStore, TailSched, true>(F.lds + RING_OFF, g2, S2, E2, F.wave); }
        }
        SEAM(pb + 1);
        if (PHON(2) && IN(pb + 2)) DUPREP(2) { PHASE_ENTER();
            const bf16* IQ = (const bf16*)(ws + WS_DQ + 6 * TSTRIDE); const bf16* IK = (const bf16*)(ws + WS_IK); const float* IW = (const float*)(ws + WS_IW);
            for (int p = F.vcu; p < 256; p += F.G) { const int b = p >> 7, s = p & 127;
                unsigned long long* m32 = (unsigned long long*)(ws + WS_MASK) + (size_t)b * MASK_BSTRIDE;
                for (int k2 = 0; k2 < 2; ++k2) indexer_unit(F, b, k2 ? s : 255 - s, IQ, IK, IW, m32); }
        }
        SEAM(pb + 2);
        if (PHON(3) && IN(pb + 3)) DUPREP(3) { PHASE_ENTER();
            using attn_body::bf16;
            const bf16* DQ = (const bf16*)(ws + WS_DQ); const bf16* DK = (const bf16*)(ws + WS_DQ + TSTRIDE); const bf16* DV = (const bf16*)(ws + WS_DQ + 2 * TSTRIDE);
            LAS unsigned* qslot = (LAS unsigned*)(F.lds + MISC_OFF + 64);
            gu32* qctr = F.ctl + CW_QUEUE + l * 64;
            LAS unsigned* const badp = (LAS unsigned*)(F.lds + MISC_OFF + 80); constexpr int BADOFF = MISC_OFF + 80 - RING_OFF;
#define GRAB(ctr_, u_) do { __syncthreads(); if (F.tid == 0) { *qslot = __hip_atomic_fetch_add((ctr_), 1u, RLX_AGENT); *badp = 0u; } __syncthreads(); u_ = (int)*qslot; } while (0)
#ifndef DUPW
#define DUPW 0
#endif
            for (int dw_ = 0; dw_ <= DUPW; ++dw_)
            for (;;) { int u; GRAB(qctr + 8 * dw_, u); if (u >= 512) break;
                const int qb = 63 - (u >> 3), a = u & 7, b = a >> 2, h = a & 3;
#pragma unroll 1
                for (int c = 0; c < 2; ++c) {
                    bf16* O = (bf16*)(ws + (c ? WS_O1 : WS_O0));
                    attn_body::attn_unit<8, false, true, true>(b, 2 * h + c, 2 * h, qb, DQ, DK, DV, O, nullptr, (char*)lds + RING_OFF, F.wave, BADOFF);
#if !(CHK && MK_PER_PHASE)
                    if (*(volatile LAS unsigned*)badp) { __syncthreads(); if (F.tid == 0) *badp = 0u;
                        attn_body::attn_unit<8, false, true, false>(b, 2 * h + c, 2 * h, qb, DQ, DK, DV, O, nullptr, (char*)lds + RING_OFF, F.wave, BADOFF); }
#endif
                }
                VM_WAIT(); __syncthreads(); __builtin_amdgcn_fence(__ATOMIC_ACQUIRE, "agent");
                ya_unit(F, l, b, h, qb);
            }
            const bf16* SQ = (const bf16*)(ws + WS_DQ + 3 * TSTRIDE); const bf16* SK = (const bf16*)(ws + WS_DQ + 4 * TSTRIDE); const bf16* SV = (const bf16*)(ws + WS_DQ + 5 * TSTRIDE);
            attn_body::mask_table_init((char*)lds + RING_OFF, F.tid);
#ifndef DUPS
#define DUPS 0
#endif
            for (int ds_ = 0; ds_ <= DUPS; ++ds_)
            for (;;) { int u; GRAB(qctr + 32 + 8 * ds_, u); if (u >= 1024) break;
                const int qb = 63 - (u >> 4), a = u & 15, b = a >> 3, h = a & 7;
                const unsigned long long* MK = (const unsigned long long*)(ws + WS_MASK) + (size_t)b * MASK_BSTRIDE;
                attn_body::attn_unit<8, true, false, true>(b, h, h, qb, SQ, SK, SV, (bf16*)(ws + WS_YB), MK, (char*)lds + RING_OFF, F.wave, BADOFF);
#if !(CHK && MK_PER_PHASE)
                if (*(volatile LAS unsigned*)badp) attn_body::attn_unit<8, true, false, false>(b, h, h, qb, SQ, SK, SV, (bf16*)(ws + WS_YB), MK, (char*)lds + RING_OFF, F.wave, BADOFF);
#endif
                }
#undef GRAB
        }
        SEAM(pb + 3);
        if (PHON(5) && IN(pb + 5)) DUPREP(5) { PHASE_ENTER();
#define RELA() { size_t zo_ = 0; asm volatile("" : "+s"(zo_)); F.ws = F.ws0 + zo_; } unsigned char* const ws = F.ws; bf16* const XB = (bf16*)(ws + WS_XB); (void)XB; const bf16* WIN = (const bf16*)(ws + WS_WB + WB_WIN); bf16* MG = (bf16*)(ws + WS_MERGED); unsigned char* G1 = ws + WS_TMPG; unsigned char* G2 = ws + WS_TMPG + 32 * MiB; (void)WIN; (void)MG; (void)G1; (void)G2
            { RELA(); pg8::Gemm g{(const bf16*)((unsigned char*)F.out + OUT_XB8), (const bf16*)(ws + WS_WB + WB_WG8), 512, 512, 512, nullptr}; pg8::StaticOrder S; S.init(NTOK, 1024, F.G, F.bx, 512);
              pg8::EpiSig E{G1, 1024, 1.f / 64.f}; pg8::gemm_phase<pg8::EpiSig, pg8::StaticOrder, true, false, true>(F.lds + RING_OFF, g, S, E, F.wave); }
            { RELA(); pg8::Gemm g{(const bf16*)((unsigned char*)F.out + OUT_XB8), (const bf16*)(ws + WS_WB + WB_WG8 + (size_t)1024 * 1024), 512, 512, 512, nullptr}; pg8::StaticOrder S; S.init(NTOK, 1024, F.G, F.bx, 512);
              pg8::EpiSig E{G2, 1024, 1.f / 64.f}; pg8::gemm_phase<pg8::EpiSig, pg8::StaticOrder, true, false, true>(F.lds + RING_OFF, g, S, E, F.wave); }
            VM_WAIT(); __builtin_amdgcn_fence(__ATOMIC_ACQUIRE, "agent"); VM_WAIT();
            { RELA(); pg8::Gemm g{(const bf16*)(ws + WS_YA), (const bf16*)(ws + WS_WB + WB_WBD), 512, 512, 512, nullptr}; pg8::StaticOrder S; S.init(NTOK, 1024, F.G, F.bx, 512);
              pg8::EpiGatedT<false> E{G1, nullptr, MG, 1024}; pg8::gemm_phase<pg8::EpiGatedT<false>, pg8::StaticOrder, true>(F.lds + RING_OFF, g, S, E, F.wave); }
            VM_WAIT(); __builtin_amdgcn_fence(__ATOMIC_ACQUIRE, "agent"); VM_WAIT();
            { RELA(); pg8::Gemm g{(const bf16*)(ws + WS_YB), (const bf16*)(ws + WS_WB + WB_WBS), 512, 512, 512, nullptr}; pg8::StaticOrder S; S.init(NTOK, 1024, F.G, F.bx, 512);
              pg8::EpiGatedT<true> E{G2, MG, MG, 1024}; if (!(DBG & 4)) pg8::gemm_phase<pg8::EpiGatedT<true>, pg8::StaticOrder, true>(F.lds + RING_OFF, g, S, E, F.wave); }
        }
        SEAM(pb + 5);
        if (PHON(6) && IN(pb + 6)) DUPREP(6) { PHASE_ENTER();
            pg8::Gemm g{(const bf16*)(ws + WS_MERGED), (const bf16*)(ws + WS_WB + WB_WO), 1024, 1024, 1024, nullptr}; pg8::StaticOrder S; S.init(NTOK, 1024, F.G, F.bx, 1024);
            pg8::EpiResBf16 E{XB, (bf16*)(ws + WS_PRE1), ALPHA}; pg8::gemm_phase<pg8::EpiResBf16, pg8::StaticOrder, true>(F.lds + RING_OFF, g, S, E, F.wave);
        }
        SEAM(pb + 6);
        if (PHON(7) && IN(pb + 7)) DUPREP(7) { PHASE_ENTER(); ln1_router_phase(F, l); }
        SEAM(pb + 7);
        if (PHON(8) && IN(pb + 8)) DUPREP(8) { PHASE_ENTER(); lists_phase(F, l); }
        SEAM(pb + 8);
        if (PHON(9) && IN(pb + 9)) DUPREP(9) { PHASE_ENTER();
            const int T = build_tile_table(F);
            pg8::Gemm g{(const bf16*)((unsigned char*)F.out + OUT_X1B8), (const bf16*)(ws + WS_WB + WB_WGU), 512, 512, 512, (const int*)(ws + WS_ROUTE + RT_ROW)};
            GroupSched S{2 * T, F.G, F.vcu, 1, (const LAS int*)(F.lds + XTR_OFF), 512L * 512, 256L * 512};
            pg8::EpiGU E{(bf16*)(ws + WS_HG), (const float*)(ws + WS_ROUTE + RT_CW), 1.f / 64.f};
            pg8::gemm_phase<pg8::EpiGU, GroupSched, true, true, true>(F.lds + RING_OFF, g, S, E, F.wave);
        }
        SEAM(pb + 9);
        if (PHON(10) && IN(pb + 10)) DUPREP(10) { PHASE_ENTER();
            const int T = build_tile_table(F);
#ifndef P10SEL
#define P10SEL 7
#endif
            if (P10SEL & 1) { RELA(); pg8::Gemm g{(const bf16*)(ws + WS_HG), (const bf16*)(ws + WS_WB + WB_WD), 256, 256, 256, nullptr};
              GroupSched S{4 * T, F.G, F.vcu, 2, (const LAS int*)(F.lds + XTR_OFF), 1024L * 256, 256L * 256};
              pg8::EpiDown E{(const int*)(ws + WS_ROUTE + RT_ENT), (bf16*)(ws + WS_Y0), (unsigned)(WS_Y1 - WS_Y0)};
              pg8::gemm_phase<pg8::EpiDown, GroupSched, true>(F.lds + RING_OFF, g, S, E, F.wave); }
            if (P10SEL & 4) { RELA(); pg8::Gemm g{(const bf16*)((unsigned char*)F.out + OUT_X1B8), (const bf16*)(ws + WS_WB + WB_WPG), 512, 512, 512, nullptr}; pg8::StaticOrder S; S.init(NTOK, 1024, F.G, F.bx, 512);
              pg8::EpiPle E{(const bf16*)((unsigned char*)F.out + OUT_T1), (bf16*)(ws + WS_PLE), 1.f / 64.f}; pg8::gemm_phase<pg8::EpiPle, pg8::StaticOrder, true, false, true>(F.lds + RING_OFF, g, S, E, F.wave); }
        }
        SEAM(pb + 10);
        if (PHON(11) && IN(pb + 11)) DUPREP(11) { PHASE_ENTER(); ln2_phase(F, l); }
        if (l + 1 < DEPTH) SEAM(pb + 11);
    }
#if IDLEPROBE
    xcd_barrier(bar);
    if (blockIdx.x == 0 && F.tid == 0) { unsigned long long tot = 0; for (int k = 0; k < 23; ++k) if ((IDLEPROBE >> k) & 1) tot += __hip_atomic_load(F.ctl + 12288 + k, RLX_AGENT);
        const unsigned long long t0 = rt(), dur = tot / 256; while (rt() - t0 < dur) __builtin_amdgcn_s_sleep(8); }
#endif
#undef IN
#undef SEAM
}

#if CHK
__global__ void __launch_bounds__(NWAVES * 64, 2) chk_kernel(Args args, int which) {
    extern __shared__ __attribute__((aligned(16))) unsigned char lds[];
    Frame F;
    F.lds = (LAS unsigned char*)lds; F.MISC = (volatile LAS unsigned*)(F.lds + MISC_OFF);
    F.tid = threadIdx.x; F.lane = F.tid & 63; F.wave = __builtin_amdgcn_readfirstlane(F.tid >> 6);
    F.G = gridDim.x; F.bx = blockIdx.x; { const int bx = blockIdx.x; F.vcu = (F.G % 8 == 0) ? (bx % 8) * (F.G / 8) + bx / 8 : bx; }
    F.ws = F.ws0 = args.ws; F.out = F.out0 = args.out; F.ap = &args; F.ctl = (gu32*)(F.ws + WS_CTL);
    if (which == 1) chk_proj(F);
    if (which == 2) chk_attn(F);
    if (which == 4) chk_mask(F);
    if (which == 8) chk_pre1(F);
    if (which == 16) chk_ffn(F);
}
#endif
extern "C" void kernel_launch(void* const* d_in, const int* in_sizes, int n_in, void* d_out, int out_size, void* d_ws, size_t ws_size, hipStream_t stream) {
    static int grid = 0;
    if (grid == 0) {
        if (n_in != 22 || in_sizes[0] != NTOK * DMODEL || out_size != NTOK * DMODEL || ws_size < WS_END) { fprintf(stderr, "kernel_launch: unexpected problem geometry (n_in %d, ws %zu); nothing launched\n", n_in, ws_size); grid = -1; return; }
        int dev = 0, cus = 0, per_cu = 0;
        if (hipGetDevice(&dev) != hipSuccess || hipDeviceGetAttribute(&cus, hipDeviceAttributeMultiprocessorCount, dev) != hipSuccess) { grid = -1; return; }
        if (hipFuncSetAttribute((const void*)skel_fwd, hipFuncAttributeMaxDynamicSharedMemorySize, LDS_BYTES) != hipSuccess) { fprintf(stderr, "kernel_launch: hipFuncSetAttribute failed\n"); grid = -1; return; }
        if (hipOccupancyMaxActiveBlocksPerMultiprocessor(&per_cu, (const void*)skel_fwd, NWAVES * 64, LDS_BYTES) != hipSuccess || per_cu < 1) { fprintf(stderr, "kernel_launch: occupancy query reports %d\n", per_cu); }
        (void)hipGetLastError();
        if (cus < 256) { fprintf(stderr, "kernel_launch: needs 256 CUs (got %d)\n", cus); grid = -1; return; }
        grid = 256;
    }
    if (grid < 0) return;
    if (hipMemsetAsync((char*)d_ws + WS_CTL, 0, CTL_ZERO_BYTES, stream) != hipSuccess) return;
    Args a{};
    for (int i = 0; i < 22; ++i) a.in[i] = d_in[i];
    a.out = (float*)d_out; a.ws = (unsigned char*)d_ws;
#if MK_PER_PHASE
    for (int ph = 0; ph < NPHASE; ++ph) { a.ph_lo = ph; a.ph_hi = ph + 1; hipLaunchKernelGGL(skel_fwd, dim3(grid), dim3(NWAVES * 64), LDS_BYTES, stream, a);
#if CHK
        static bool chk_set = false; if (!chk_set) { (void)hipFuncSetAttribute((const void*)chk_kernel, hipFuncAttributeMaxDynamicSharedMemorySize, LDS_BYTES); chk_set = true; }
        if (ph == 1 && (CHK & 1)) hipLaunchKernelGGL(chk_kernel, dim3(grid), dim3(NWAVES * 64), LDS_BYTES, stream, a, 1);
        if (ph == 3 && (CHK & 2)) hipLaunchKernelGGL(chk_kernel, dim3(grid), dim3(NWAVES * 64), LDS_BYTES, stream, a, 2);
        if (ph == 3 && (CHK & 4)) hipLaunchKernelGGL(chk_kernel, dim3(grid), dim3(NWAVES * 64), LDS_BYTES, stream, a, 4);
        if (ph == 6 && (CHK & 8)) hipLaunchKernelGGL(chk_kernel, dim3(grid), dim3(NWAVES * 64), LDS_BYTES, stream, a, 8);
        if (ph == 10 && (CHK & 16)) hipLaunchKernelGGL(chk_kernel, dim3(grid), dim3(NWAVES * 64), LDS_BYTES, stream, a, 16);
#endif
    }
#else
    a.ph_lo = 0; a.ph_hi = NPHASE;
    hipLaunchKernelGGL(skel_fwd, dim3(grid), dim3(NWAVES * 64), LDS_BYTES, stream, a);
#endif
}
```

```cpp
#include <hip/hip_runtime.h>
#include <hip/hip_bf16.h>
#include <cstdio>
#include <cstdint>
#include <cmath>

__device__ __forceinline__ int ltid(int wave) { int l; asm volatile("v_mbcnt_lo_u32_b32 %0, -1, 0\n\tv_mbcnt_hi_u32_b32 %0, -1, %0" : "=v"(l)); return (wave << 6) | l; }

namespace pg8 {
#define PG8_LAS __attribute__((address_space(3)))
typedef unsigned short bf16_t;
typedef short bf16x8 __attribute__((ext_vector_type(8)));
typedef float f32x4 __attribute__((ext_vector_type(4)));
typedef unsigned u32x4 __attribute__((ext_vector_type(4)));
typedef int i32x4_t __attribute__((ext_vector_type(4)));
typedef int i32x8_t __attribute__((ext_vector_type(8)));
constexpr int BM = 256, BK = 64, HALF = 128, HTB = HALF * BK * 2  , STAGE_BYTES = 8 * HTB, NXCD = 8, WGM = 8;
constexpr float C2 = 0.125f * 1.4426950408889634f;

__host__ __device__ __forceinline__ int lds_byte(int r, int c) { const int st = (r >> 4) * 2 + (c >> 5), rr = r & 15, cc = c & 31, ob = rr * 64 + cc * 2; return st * 1024 + (ob ^ (((ob >> 9) & 1) << 5)); }
__host__ __device__ __forceinline__ void stage_rc(int b, int& R, int& C) { const int st = b / 1024, sb = b % 1024, swz = sb ^ (((sb >> 9) & 1) << 5); R = (st >> 1) * 16 + swz / 64; C = (st & 1) * 32 + (swz % 64) / 2; }
__host__ __device__ __forceinline__ int perm32(int rho) { const int n = rho >> 4, i = rho & 15; return 8 * (i >> 2) + 4 * n + (i & 3); }

struct Unit { int pm, pn; long boff; };
struct Gemm { const bf16_t* A; const bf16_t* Bt; int K, lda, ldb; const int* rows; };

struct StaticOrder {
    int nM, nN, nwg, G, c, ldb;
    __device__ void init(int M, int N, int G_, int c_, int ldb_) { nM = M / BM; nN = N / BM; nwg = nM * nN; G = G_; c = c_; ldb = ldb_; }
    __device__ bool next(int i, Unit& u) const {
        const long L = (long)i * G + c; if (L >= nwg) return false;
        int wgid = (int)L; { const int q = nwg / NXCD, r = nwg % NXCD, xcd = wgid % NXCD, off = wgid / NXCD; wgid = (xcd < r ? xcd * (q + 1) : r * (q + 1) + (xcd - r) * q) + off; }
        const int nig = WGM * nN, gid = wgid / nig, fm = gid * WGM, gsz = (nM - fm) < WGM ? (nM - fm) : WGM;
        u.pm = fm + ((wgid % nig) % gsz); u.pn = (wgid % nig) / gsz; u.boff = (long)u.pn * BM * ldb; return true;
    }
};

__device__ __forceinline__ unsigned cvt_pk_bf16(float lo, float hi) { unsigned r; asm volatile("v_cvt_pk_bf16_f32 %0, %1, %2" : "=v"(r) : "v"(lo), "v"(hi)); return r; }
__device__ __forceinline__ float bf_lo(unsigned w) { return __uint_as_float(w << 16); }
__device__ __forceinline__ float bf_hi(unsigned w) { return __uint_as_float(w & 0xffff0000u); }
__device__ __forceinline__ float sigm(float x) { return __builtin_amdgcn_rcpf(1.f + __builtin_amdgcn_exp2f(-1.4426950408889634f * x)); }
__device__ __forceinline__ u32x4 pack8(f32x4 a, f32x4 b) { u32x4 w; w.x = cvt_pk_bf16(a[0], a[1]); w.y = cvt_pk_bf16(a[2], a[3]); w.z = cvt_pk_bf16(b[0], b[1]); w.w = cvt_pk_bf16(b[2], b[3]); return w; }
__device__ __forceinline__ void unpack8(u32x4 w, f32x4& a, f32x4& b) { a = (f32x4){bf_lo(w.x), bf_hi(w.x), bf_lo(w.y), bf_hi(w.y)}; b = (f32x4){bf_lo(w.z), bf_hi(w.z), bf_lo(w.w), bf_hi(w.w)}; }

#define PG8_EPI_ARGS const f32x4 (&acc)[2][2][4][2], const Unit& u, int wr, int wc, int fr, int fq

#define PG8_PIN(x) asm volatile("" : "+v"(x))
template <class T> __device__ __forceinline__ T& at(const void* base, unsigned byteoff) { return *(T*)((char*)base + byteoff); }

__device__ __forceinline__ float xor16(float v, int fq) { const auto r = __builtin_amdgcn_permlane16_swap(__float_as_uint(v), __float_as_uint(v), false, false); return __uint_as_float((fq & 1) ? r[0] : r[1]); }
struct EpiProj {
    bf16_t* base; size_t tstride; bf16_t* IK; float* IW; const float* rope;
    __device__ __forceinline__ void operator()(PG8_EPI_ARGS) const {
        const int pn = u.pn, row0 = u.pm * BM + wr * 64 + fr;
        if (pn < 14) {
            const int t = pn >> 1;
            bf16_t* dst = base + (size_t)t * tstride;
            const bool rp = (t == 0) | (t == 1) | (t == 3) | (t == 4) | (t == 6);
            const float sc = (t == 0 || t == 3) ? C2 : (t == 6 ? 0.125f : 1.f);
            const bool rotw = rp && ((wc & 1) == 0);
            const unsigned cb = (unsigned)((pn & 1) * 256 + wc * 32 + 8 * fq) * 2u;
            constexpr int RB = 2; f32x4 rq[RB][4];
#define PG8_RP_LD(it) do { if (rotw) { unsigned r_ = (unsigned)(row0 + ((it) >> 2) * HALF + ((it) & 3) * 16); PG8_PIN(r_); \
                rq[(it) % RB][0] = at<const f32x4>(rope, r_ * 64u); rq[(it) % RB][1] = at<const f32x4>(rope, r_ * 64u + 16u); rq[(it) % RB][2] = at<const f32x4>(rope, r_ * 64u + 32u); rq[(it) % RB][3] = at<const f32x4>(rope, r_ * 64u + 48u); } } while (0)
#pragma unroll
            for (int it = 0; it < RB; ++it) PG8_RP_LD(it);
#pragma unroll
            for (int ai = 0; ai < 2; ++ai)
#pragma unroll
                for (int m = 0; m < 4; ++m) { const int it = ai * 4 + m;
                    unsigned row = (unsigned)(row0 + ai * HALF + m * 16); PG8_PIN(row);
                    f32x4 c0 = {1.f, 1.f, 1.f, 1.f}, c1 = c0, s0 = {0.f, 0.f, 0.f, 0.f}, s1 = s0;
                    if (rotw) { c0 = rq[it % RB][0]; c1 = rq[it % RB][1]; s0 = rq[it % RB][2]; s1 = rq[it % RB][3]; }
                    if (it + RB < 8) PG8_RP_LD(it + RB);
#pragma unroll
                    for (int bj = 0; bj < 2; ++bj) {
                        f32x4 v0 = acc[ai][bj][m][0], v1 = acc[ai][bj][m][1];
                        if (rotw) {
                            f32x4 p0, p1;
#pragma unroll
                            for (int i = 0; i < 4; ++i) { p0[i] = xor16(v0[i], fq); p1[i] = xor16(v1[i], fq); }
                            const float sg = (fq == 0) ? -1.f : 1.f;
                            const f32x4 r0 = v0 * c0 + (p0 * s0) * sg, r1 = v1 * c1 + (p1 * s1) * sg;
                            if (fq < 2) { v0 = r0; v1 = r1; }
                        }
                        v0 = v0 * sc; v1 = v1 * sc;
                        at<u32x4>(dst, row * 1024u + cb + bj * 256u) = pack8(v0, v1);
                    }
                    asm volatile("" ::: "memory");
                }
#undef PG8_RP_LD
        } else {
#pragma unroll
            for (int ai = 0; ai < 2; ++ai)
#pragma unroll
                for (int m = 0; m < 4; ++m) {
                    unsigned row = (unsigned)(row0 + ai * HALF + m * 16); PG8_PIN(row);
                    f32x4 v0 = acc[ai][0][m][0], v1 = acc[ai][0][m][1];
                    if (wc == 0) {
                        const f32x4 c0 = at<const f32x4>(rope, row * 64u), c1 = at<const f32x4>(rope, row * 64u + 16u), s0 = at<const f32x4>(rope, row * 64u + 32u), s1 = at<const f32x4>(rope, row * 64u + 48u);
                        f32x4 p0, p1;
#pragma unroll
                        for (int i = 0; i < 4; ++i) { p0[i] = xor16(v0[i], fq); p1[i] = xor16(v1[i], fq); }
                        const float sg = (fq == 0) ? -1.f : 1.f;
                        const f32x4 r0 = v0 * c0 + (p0 * s0) * sg, r1 = v1 * c1 + (p1 * s1) * sg;
                        if (fq < 2) { v0 = r0; v1 = r1; }
                    }
                    if (wc < 2) at<u32x4>(IK, row * 128u + (unsigned)(wc * 32 + 8 * fq) * 2u) = pack8(v0, v1);
                    else if (wc == 2 && fq == 0) { at<f32x4>(IW, row * 32u) = v0 * 0.35355339059f; at<f32x4>(IW, row * 32u + 16u) = v1 * 0.35355339059f; }
                    asm volatile("" ::: "memory");
                }
        }
    }
};
struct EpiSig {
    unsigned char* out; int ldc; float pre;
    __device__ __forceinline__ void operator()(PG8_EPI_ARGS) const {
        const unsigned o0 = (unsigned)(u.pm * BM + wr * 64 + fr) * 1024u + (unsigned)(u.pn * BM + wc * 32 + 8 * fq);
#pragma unroll
        for (int ai = 0; ai < 2; ++ai)
#pragma unroll
            for (int m = 0; m < 4; ++m) {
                unsigned o = o0 + (unsigned)(ai * HALF + m * 16) * 1024u; PG8_PIN(o);
#pragma unroll
                for (int bj = 0; bj < 2; ++bj) {
                    const f32x4 v0 = acc[ai][bj][m][0], v1 = acc[ai][bj][m][1];
                    unsigned w0 = 0u, w1 = 0u;
#pragma unroll
                    for (int i = 0; i < 4; ++i) { w0 = __builtin_amdgcn_cvt_pk_u8_f32(sigm(v0[i] * pre) * 255.f, i, w0); w1 = __builtin_amdgcn_cvt_pk_u8_f32(sigm(v1[i] * pre) * 255.f, i, w1); }
                    at<unsigned long long>(out, o + bj * 128u) = (unsigned long long)w0 | ((unsigned long long)w1 << 32);
                }
                asm volatile("" ::: "memory");
            }
    }
};
template <bool ADD>
struct EpiGatedT {
    const unsigned char* gate; const bf16_t* addsrc; bf16_t* out; int ldc;
    __device__ __forceinline__ void operator()(PG8_EPI_ARGS) const {
        const unsigned o0 = ((unsigned)(u.pm * BM + wr * 64 + fr) * 1024u + (unsigned)(u.pn * BM + wc * 32 + 8 * fq)) * 2u;
        constexpr int NB = 2;
        unsigned long long gq[NB][2]; u32x4 aq[ADD ? NB : 1][2];
#define PG8_GT_LD(it) do { unsigned o_ = o0 + (unsigned)(((it) >> 2) * HALF + ((it) & 3) * 16) * 2048u; PG8_PIN(o_); \
            gq[(it) % NB][0] = at<const unsigned long long>(gate, o_ >> 1); gq[(it) % NB][1] = at<const unsigned long long>(gate, (o_ >> 1) + 128u); \
            if constexpr (ADD) { aq[(it) % NB][0] = at<const u32x4>(addsrc, o_); aq[(it) % NB][1] = at<const u32x4>(addsrc, o_ + 256u); } } while (0)
#pragma unroll
        for (int it = 0; it < NB; ++it) PG8_GT_LD(it);
#pragma unroll
        for (int it = 0; it < 8; ++it) { const int ai = it >> 2, m = it & 3;
                unsigned o = o0 + (unsigned)(ai * HALF + m * 16) * 2048u; PG8_PIN(o);
                f32x4 v0[2], v1[2];
#pragma unroll
                for (int bj = 0; bj < 2; ++bj) {
                    const unsigned long long gw = gq[it % NB][bj]; const unsigned glo = (unsigned)gw, ghi = (unsigned)(gw >> 32); constexpr float K8 = 1.f / 255.f;
                    const f32x4 g0 = {(float)(glo & 0xffu) * K8, (float)((glo >> 8) & 0xffu) * K8, (float)((glo >> 16) & 0xffu) * K8, (float)(glo >> 24) * K8};
                    const f32x4 g1 = {(float)(ghi & 0xffu) * K8, (float)((ghi >> 8) & 0xffu) * K8, (float)((ghi >> 16) & 0xffu) * K8, (float)(ghi >> 24) * K8};
                    v0[bj] = acc[ai][bj][m][0] * g0; v1[bj] = acc[ai][bj][m][1] * g1;
                    if constexpr (ADD) { f32x4 a0, a1; unpack8(aq[it % NB][bj], a0, a1); v0[bj] = v0[bj] + a0; v1[bj] = v1[bj] + a1; }
                }
                if (it + NB < 8) PG8_GT_LD(it + NB);
#pragma unroll
                for (int bj = 0; bj < 2; ++bj) at<u32x4>(out, o + bj * 256u) = pack8(v0[bj], v1[bj]);
                asm volatile("" ::: "memory");
            }
#undef PG8_GT_LD
    }
};
struct EpiResBf16 {
    const bf16_t* x; bf16_t* out; float alpha;
    __device__ __forceinline__ void operator()(PG8_EPI_ARGS) const {
        const unsigned o0 = ((unsigned)(u.pm * BM + wr * 64 + fr) * 1024u + (unsigned)(u.pn * BM + wc * 32 + 8 * fq)) * 2u;
        u32x4 xq[8][2];
#define PG8_X_LD(buf, it) do { unsigned o_ = o0 + (unsigned)(((it) >> 2) * HALF + ((it) & 3) * 16) * 2048u; PG8_PIN(o_); \
            xq[buf][0] = at<const u32x4>(x, o_); xq[buf][1] = at<const u32x4>(x, o_ + 256u); } while (0)
#pragma unroll
        for (int it = 0; it < 8; ++it) PG8_X_LD(it, it);
#pragma unroll
        for (int it = 0; it < 8; ++it) { const int ai = it >> 2, m = it & 3;
                unsigned o = o0 + (unsigned)(ai * HALF + m * 16) * 2048u; PG8_PIN(o);
#pragma unroll
                for (int bj = 0; bj < 2; ++bj) { f32x4 x0, x1; unpack8(xq[it][bj], x0, x1);
                    at<u32x4>(out, o + bj * 256u) = pack8(x0 * alpha + acc[ai][bj][m][0], x1 * alpha + acc[ai][bj][m][1]); }
                asm volatile("" ::: "memory");
            }
#undef PG8_X_LD
    }
};
struct EpiGU {
    bf16_t* HG; const float* cw; float pre;
    __device__ __forceinline__ void operator()(PG8_EPI_ARGS) const {
        const int row0 = u.pm * BM + wr * 64 + fr; const unsigned cb = (unsigned)(u.pn * HALF + wc * 32 + 8 * fq) * 2u;
        float cv[8];
#pragma unroll
        for (int it = 0; it < 8; ++it) cv[it] = at<const float>(cw, (unsigned)(row0 + (it >> 2) * HALF + (it & 3) * 16) * 4u);
#pragma unroll
        for (int it = 0; it < 8; ++it) { const int ai = it >> 2, m = it & 3;
                unsigned row = (unsigned)(row0 + ai * HALF + m * 16); PG8_PIN(row);
                const float c = cv[it];
                f32x4 g0 = acc[ai][0][m][0] * pre, g1 = acc[ai][0][m][1] * pre; const f32x4 u0 = acc[ai][1][m][0] * pre, u1 = acc[ai][1][m][1] * pre;
#pragma unroll
                for (int i = 0; i < 4; ++i) { g0[i] = g0[i] * sigm(g0[i]) * u0[i] * c; g1[i] = g1[i] * sigm(g1[i]) * u1[i] * c; }
                at<u32x4>(HG, row * 512u + cb) = pack8(g0, g1);
                asm volatile("" ::: "memory");
            }
    }
};
struct EpiDown {
    const int* ent; bf16_t* Y0; unsigned ystride;
    __device__ __forceinline__ void operator()(PG8_EPI_ARGS) const {
        const int row0 = u.pm * BM + wr * 64 + fr; const unsigned cb = (unsigned)(u.pn * BM + wc * 32 + 8 * fq) * 2u;
        int ev[8];
#pragma unroll
        for (int it = 0; it < 8; ++it) ev[it] = at<const int>(ent, (unsigned)(row0 + (it >> 2) * HALF + (it & 3) * 16) * 4u);
#pragma unroll
        for (int it = 0; it < 8; ++it) { const int ai = it >> 2, m = it & 3; const int e = ev[it];
                if (e >= 0) { unsigned o = (unsigned)(e >> 1) * 2048u + cb + (unsigned)(e & 1) * ystride; PG8_PIN(o);
#pragma unroll
                    for (int bj = 0; bj < 2; ++bj) at<u32x4>(Y0, o + bj * 256u) = pack8(acc[ai][bj][m][0], acc[ai][bj][m][1]); }
                asm volatile("" ::: "memory");
            }
    }
};
struct EpiStore {
    bf16_t* out; int ldc;
    __device__ __forceinline__ void operator()(PG8_EPI_ARGS) const {
        const unsigned o0 = ((unsigned)(u.pm * BM + wr * 64 + fr) * 1024u + (unsigned)(u.pn * BM + wc * 32 + 8 * fq)) * 2u;
#pragma unroll
        for (int ai = 0; ai < 2; ++ai)
#pragma unroll
            for (int m = 0; m < 4; ++m) {
                unsigned o = o0 + (unsigned)(ai * HALF + m * 16) * 2048u; PG8_PIN(o);
#pragma unroll
                for (int bj = 0; bj < 2; ++bj) at<u32x4>(out, o + bj * 256u) = pack8(acc[ai][bj][m][0], acc[ai][bj][m][1]);
                asm volatile("" ::: "memory");
            }
    }
};
struct EpiPle {
    const bf16_t* t1; bf16_t* out; float pre;
    __device__ __forceinline__ void operator()(PG8_EPI_ARGS) const {
        const unsigned o0 = ((unsigned)(u.pm * BM + wr * 64 + fr) * 1024u + (unsigned)(u.pn * BM + wc * 32 + 8 * fq)) * 2u;
        u32x4 tq[8][2];
#define PG8_T_LD(buf, it) do { unsigned o_ = o0 + (unsigned)(((it) >> 2) * HALF + ((it) & 3) * 16) * 2048u; PG8_PIN(o_); \
            tq[buf][0] = at<const u32x4>(t1, o_); tq[buf][1] = at<const u32x4>(t1, o_ + 256u); } while (0)
#pragma unroll
        for (int it = 0; it < 8; ++it) PG8_T_LD(it, it);
#pragma unroll
        for (int it = 0; it < 8; ++it) { const int ai = it >> 2, m = it & 3;
                unsigned o = o0 + (unsigned)(ai * HALF + m * 16) * 2048u; PG8_PIN(o);
#pragma unroll
                for (int bj = 0; bj < 2; ++bj) {
                    f32x4 t0, t1v; unpack8(tq[it][bj], t0, t1v);
                    f32x4 v0 = acc[ai][bj][m][0], v1 = acc[ai][bj][m][1];
#pragma unroll
                    for (int i = 0; i < 4; ++i) { v0[i] = sigm(v0[i] * pre) * t0[i]; v1[i] = sigm(v1[i] * pre) * t1v[i]; }
                    at<u32x4>(out, o + bj * 256u) = pack8(v0, v1);
                }
                asm volatile("" ::: "memory");
            }
#undef PG8_T_LD
    }
};

template <class Epi, class Sched, bool ALIGN_EPI, bool GATHER = false, bool FP8 = false>
__device__ __forceinline__ void gemm_phase(PG8_LAS unsigned char* lds, const Gemm g, const Sched& S, const Epi& E, int wave_in) {
    const int tid = ltid(wave_in), wid = __builtin_amdgcn_readfirstlane(tid >> 6), lane = tid & 63, wr = wid >> 2, wc = wid & 3, fr = lane & 15, fq = lane >> 4;
    int K_ = g.K; asm volatile("" : "+s"(K_));
    const int K = K_, nt = K / BK;
    int RA[2], CA[2]; unsigned voffB[2], voffA[2];
#pragma unroll
    for (int i = 0; i < 2; ++i) { int R, C; stage_rc(tid * 16 + i * 8192, R, C); const int Rb = (R & ~31) + perm32(R & 31); RA[i] = R; CA[i] = C; voffB[i] = (unsigned)(Rb * g.ldb + C) * 2u; voffA[i] = (unsigned)(R * g.lda + C) * 2u; }
    const size_t hstepA = (size_t)HALF * g.lda * 2;
    const size_t kstep = (size_t)(BK * 2);
    const size_t hstepB = (size_t)HALF * g.ldb * 2;
    const unsigned ldsw = (unsigned)wid * 1024u;
    const int aoff = lds_byte(wr * 64 + fr, fq * 8), boff = lds_byte(wc * 32 + fr, fq * 8);
    const char* Ab = (const char*)g.A;
#define PG8_SA(b, h) (((b) * 2 + (h)) * HTB)
#define PG8_SB(b, h) ((4 + (b) * 2 + (h)) * HTB)
#define PG8_STAGE_A(bufoff, kb, OFF, h) do { _Pragma("unroll") for (int _i = 0; _i < 2; ++_i) { const char* _p; \
        if constexpr (GATHER) _p = Ab + (kb) + (OFF##_v)[h][_i]; else _p = Ab + ((kb) + (OFF##_u) + (size_t)(h) * hstepA) + voffA[_i]; \
        __builtin_amdgcn_global_load_lds((const unsigned*)_p, (PG8_LAS unsigned*)(lds + (bufoff) + ldsw + _i * 8192), 16, 0, 0); } } while (0)
#define PG8_STAGE_B(bufoff, gbase) do { _Pragma("unroll") for (int _i = 0; _i < 2; ++_i) \
        __builtin_amdgcn_global_load_lds((const unsigned*)((const char*)(gbase) + voffB[_i]), (PG8_LAS unsigned*)(lds + (bufoff) + ldsw + _i * 8192), 16, 0, 0); } while (0)
#define PG8_MKOFF(uu, OFF) do { if constexpr (GATHER) { _Pragma("unroll") for (int _h = 0; _h < 2; ++_h) _Pragma("unroll") for (int _i = 0; _i < 2; ++_i) { \
        const int _row = g.rows[(uu).pm * BM + _h * HALF + RA[_i]]; (OFF##_v)[_h][_i] = (unsigned)(_row * g.lda + CA[_i]) * 2u; } } else { OFF##_u = (size_t)(uu).pm * BM * g.lda * 2; } } while (0)
#define PG8_LDA(dst, b, h) do { _Pragma("unroll") for (int m = 0; m < 4; ++m) { if constexpr (FP8) { dst##8[m].lo = *(const PG8_LAS i32x4_t*)(lds + PG8_SA(b, h) + aoff + m * 2048); dst##8[m].hi = *(const PG8_LAS i32x4_t*)(lds + PG8_SA(b, h) + aoff + m * 2048 + 1024); } \
        else { _Pragma("unroll") for (int k = 0; k < 2; ++k) dst[m][k] = *(const PG8_LAS bf16x8*)(lds + PG8_SA(b, h) + aoff + m * 2048 + k * 1024); } } } while (0)
#define PG8_LDB(dst, b, h) do { _Pragma("unroll") for (int n = 0; n < 2; ++n) { if constexpr (FP8) { dst##8[n].lo = *(const PG8_LAS i32x4_t*)(lds + PG8_SB(b, h) + boff + n * 2048); dst##8[n].hi = *(const PG8_LAS i32x4_t*)(lds + PG8_SB(b, h) + boff + n * 2048 + 1024); } \
        else { _Pragma("unroll") for (int k = 0; k < 2; ++k) dst[n][k] = *(const PG8_LAS bf16x8*)(lds + PG8_SB(b, h) + boff + n * 2048 + k * 1024); } } } while (0)
#define PG8_MMA(ai, bj, At, Bt) do { __builtin_amdgcn_s_setprio(1); \
        if constexpr (FP8) { _Pragma("unroll") for (int m = 0; m < 4; ++m) _Pragma("unroll") for (int n = 0; n < 2; ++n) \
            asm volatile("v_mfma_f32_16x16x128_f8f6f4 %0, %1, %2, %0" : "+v"(acc[ai][bj][m][n]) : "v"(Bt##8[n]), "v"(At##8[m])); }   \
        else { _Pragma("unroll") for (int m = 0; m < 4; ++m) _Pragma("unroll") for (int n = 0; n < 2; ++n) _Pragma("unroll") for (int k = 0; k < 2; ++k) \
            acc[ai][bj][m][n] = __builtin_amdgcn_mfma_f32_16x16x32_bf16(Bt[n][k], At[m][k], acc[ai][bj][m][n], 0, 0, 0); } __builtin_amdgcn_s_setprio(0); } while (0)
#define PG8_WAIT_V(n) asm volatile("s_waitcnt vmcnt(" #n ")" ::: "memory")
#define PG8_WAIT_L(n) asm volatile("s_waitcnt lgkmcnt(" #n ")" ::: "memory")
#define PG8_BAR __builtin_amdgcn_s_barrier()
#define PG8_SCHED __builtin_amdgcn_sched_barrier(0)
    Unit cur, nxt; int ui = 0;
    if (!S.next(0, cur)) return;
    f32x4 acc[2][2][4][2];
#pragma unroll
    for (int a = 0; a < 2; ++a)
#pragma unroll
        for (int b = 0; b < 2; ++b)
#pragma unroll
            for (int m = 0; m < 4; ++m)
#pragma unroll
                for (int n = 0; n < 2; ++n) acc[a][b][m][n] = (f32x4){0.f, 0.f, 0.f, 0.f};
    bf16x8 At[4][2], B0[2][2], B1[2][2];
    i32x8_t At8[4], B08[2], B18[2];
    unsigned offAc_v[2][2], offAn_v[2][2]; size_t offAc_u = 0, offAn_u = 0;
    PG8_MKOFF(cur, offAc);
    const char* cB = (const char*)(g.Bt + cur.boff);
    PG8_STAGE_B(PG8_SB(0, 0), cB); PG8_STAGE_B(PG8_SB(0, 1), cB + hstepB); PG8_STAGE_A(PG8_SA(0, 0), 0, offAc, 0); PG8_STAGE_A(PG8_SA(0, 1), 0, offAc, 1);
    if (wr == 1) PG8_BAR;
    PG8_WAIT_V(2); PG8_BAR;
    PG8_STAGE_B(PG8_SB(1, 0), cB + kstep); PG8_STAGE_A(PG8_SA(1, 0), kstep, offAc, 0); PG8_STAGE_B(PG8_SB(1, 1), cB + hstepB + kstep);
    PG8_WAIT_V(6); PG8_BAR;
    for (;;) {
        const bool has_next = S.next(ui + 1, nxt);
        if (has_next) { PG8_MKOFF(nxt, offAn); }
        else { offAn_u = offAc_u;
#pragma unroll
            for (int h = 0; h < 2; ++h)
#pragma unroll
                for (int i = 0; i < 2; ++i) offAn_v[h][i] = offAc_v[h][i];
        }
        const char* nB = has_next ? (const char*)(g.Bt + nxt.boff) : cB;
        for (int t = 0; t < nt; t += 2) {
            const bool last = (t == nt - 2);
            const size_t a1k = (size_t)(t + 1) * kstep;
            const size_t a2k = last ? (size_t)0 : (size_t)(t + 2) * kstep; const char* b2 = last ? nB : cB + (size_t)(t + 2) * kstep;
            const size_t a3k = a2k + kstep; const char* b3 = b2 + kstep;
            unsigned o2_v[2][2]; const size_t o2_u = last ? offAn_u : offAc_u;
#pragma unroll
            for (int h = 0; h < 2; ++h)
#pragma unroll
                for (int i = 0; i < 2; ++i) o2_v[h][i] = last ? offAn_v[h][i] : offAc_v[h][i];
            PG8_LDB(B0, 0, 0); PG8_LDB(B1, 0, 1); PG8_SCHED; PG8_LDA(At, 0, 0); PG8_STAGE_A(PG8_SA(1, 1), a1k, offAc, 1);
            PG8_WAIT_V(8); PG8_WAIT_L(0); PG8_BAR; PG8_MMA(0, 0, At, B0); PG8_MMA(0, 1, At, B1); PG8_BAR; PG8_SCHED;
            PG8_LDA(At, 0, 1); PG8_STAGE_B(PG8_SB(0, 0), b2); PG8_STAGE_B(PG8_SB(0, 1), b2 + hstepB); PG8_STAGE_A(PG8_SA(0, 0), a2k, o2, 0);
            PG8_WAIT_V(8); PG8_WAIT_L(0); PG8_BAR; PG8_MMA(1, 0, At, B0); PG8_MMA(1, 1, At, B1); PG8_BAR; PG8_SCHED;
            PG8_LDB(B0, 1, 0); PG8_LDB(B1, 1, 1); PG8_SCHED; PG8_LDA(At, 1, 0); PG8_STAGE_A(PG8_SA(0, 1), a2k, o2, 1);
            PG8_WAIT_V(8); PG8_WAIT_L(0); PG8_BAR; PG8_MMA(0, 0, At, B0); PG8_MMA(0, 1, At, B1); PG8_BAR; PG8_SCHED;
            PG8_LDA(At, 1, 1); PG8_STAGE_B(PG8_SB(1, 0), b3); PG8_STAGE_B(PG8_SB(1, 1), b3 + hstepB); PG8_STAGE_A(PG8_SA(1, 0), a3k, o2, 0);
            PG8_WAIT_V(8); PG8_WAIT_L(0); PG8_BAR; PG8_MMA(1, 0, At, B0); PG8_MMA(1, 1, At, B1); PG8_BAR; PG8_SCHED;
        }
        if constexpr (ALIGN_EPI) { if (wr == 0) PG8_BAR; }
        if constexpr (FP8) asm volatile("s_nop 15\n\ts_nop 15\n\ts_nop 7" ::: "memory");
        E(acc, cur, wr, wc, fr, fq);
        if (!has_next) break;
#pragma unroll
        for (int a = 0; a < 2; ++a)
#pragma unroll
            for (int b = 0; b < 2; ++b)
#pragma unroll
                for (int m = 0; m < 4; ++m)
#pragma unroll
                    for (int n = 0; n < 2; ++n) acc[a][b][m][n] = (f32x4){0.f, 0.f, 0.f, 0.f};
        cur = nxt; cB = nB; ++ui; offAc_u = offAn_u;
#pragma unroll
        for (int h = 0; h < 2; ++h)
#pragma unroll
            for (int i = 0; i < 2; ++i) offAc_v[h][i] = offAn_v[h][i];
        if constexpr (ALIGN_EPI) { if (wr == 1) PG8_BAR; }
    }
    PG8_WAIT_V(0);
    if constexpr (!ALIGN_EPI) { if (wr == 0) PG8_BAR; }
    PG8_BAR;
#undef PG8_SA
#undef PG8_SB
#undef PG8_STAGE_A
#undef PG8_STAGE_B
#undef PG8_MKOFF
#undef PG8_LDA
#undef PG8_LDB
#undef PG8_MMA
#undef PG8_WAIT_V
#undef PG8_WAIT_L
#undef PG8_BAR
#undef PG8_SCHED
}
}
namespace attn_body {
using bf16=__hip_bfloat16;
using bf16x8=__attribute__((ext_vector_type(8)))short;
using s16x4=__attribute__((ext_vector_type(4)))short;
using f32x16=__attribute__((ext_vector_type(16)))float;
using u32x4=__attribute__((ext_vector_type(4)))unsigned;
constexpr int BATCH=2,SEQ=16384,D=64,DM=512;
constexpr int NW=8,QBLK=32,QB=QBLK*NW,KVBLK=64,NQB=SEQ/QB;
constexpr int ATTN_PITCH=DM, ATTN_UNIT_ROWS=QB;
__device__ __forceinline__ int crow(int r,int hi){return (r&3)+8*(r>>2)+4*hi;}
#define SBAR() __builtin_amdgcn_sched_barrier(0)
__device__ __forceinline__ void cmask(f32x16&p0,f32x16&p1,int jb,int qrel,int hi){
  const float NEG=-INFINITY; int kb=64*jb+4*hi;
  #pragma unroll
  for(int r=0;r<16;++r){int kv=kb+(r&3)+8*(r>>2); if(kv>qrel)p0[r]=NEG; if(kv+32>qrel)p1[r]=NEG;}
}

constexpr int NSLOT=3, SLOTB=8192;
constexpr int LDS_K=0, LDS_V=NSLOT*SLOTB, LDS_WS=2*NSLOT*SLOTB, LDS_OST=LDS_WS+NW*64*4, LDS_MK=LDS_OST+NW*4096, LDS_BYTES=LDS_MK+NW*1024, LDS_BYTES_WIDE=LDS_V+NSLOT*2*SLOTB+NW*64*4+NW*4096;
constexpr float C2=0.125f*1.4426950408889634f;
__device__ __forceinline__ void glds16(const void*gsrc,unsigned lds_dst){unsigned keep;
  asm volatile("s_mov_b32 %0, m0\n\ts_mov_b32 m0, %2\n\ts_nop 0\n\tglobal_load_lds_dwordx4 %1, off\n\ts_mov_b32 m0, %0":"=&s"(keep):"v"(gsrc),"s"(lds_dst):"memory");}
__device__ __forceinline__ float max3f(float a,float b,float c){float r;asm("v_max3_f32 %0, %1, %2, %3":"=v"(r):"v"(a),"v"(b),"v"(c));return r;}
__device__ __forceinline__ float max2f(float a,float b){float r;asm("v_max_f32_e32 %0, %1, %2":"=v"(r):"v"(a),"v"(b));return r;}
__device__ __forceinline__ float fadd_s(float a,float b){float r;asm("v_add_f32_e32 %0, %1, %2":"=v"(r):"v"(a),"v"(b));return r;}
__device__ __forceinline__ float fsub_s(float a,float b){float r;asm("v_sub_f32_e32 %0, %1, %2":"=v"(r):"v"(a),"v"(b));return r;}
typedef float f32x2_t __attribute__((ext_vector_type(2))); typedef __bf16 bf16x2_t __attribute__((ext_vector_type(2)));
__device__ __forceinline__ unsigned cvtpk_s(float lo,float hi){f32x2_t v={lo,hi};bf16x2_t b=__builtin_convertvector(v,bf16x2_t);return __builtin_bit_cast(unsigned,b);}
#define WAIT_BAR(N) asm volatile("s_waitcnt vmcnt(" #N ") lgkmcnt(0)\n\ts_barrier":::"memory")

__device__ __forceinline__ void qkt(f32x16&p0,f32x16&p1,const char*Kslot,const bf16x8*qr,const f32x16&ci0,const f32x16&ci1,int r32,int hi){
  const char*kb=Kslot+hi*1024+r32*16;
  #pragma unroll
  for(int d0=0;d0<4;++d0){
    const bf16x8 b0=*reinterpret_cast<const bf16x8*>(kb+d0*2048);
    const bf16x8 b1=*reinterpret_cast<const bf16x8*>(kb+d0*2048+512);
    if(d0==0){p0=__builtin_amdgcn_mfma_f32_32x32x16_bf16(b0,qr[0],ci0,0,0,0);p1=__builtin_amdgcn_mfma_f32_32x32x16_bf16(b1,qr[0],ci1,0,0,0);}
    else{p0=__builtin_amdgcn_mfma_f32_32x32x16_bf16(b0,qr[d0],p0,0,0,0);p1=__builtin_amdgcn_mfma_f32_32x32x16_bf16(b1,qr[d0],p1,0,0,0);}}
}
typedef __attribute__((address_space(3))) const char* lds_cptr;
typedef short v4i16_t __attribute__((ext_vector_type(4)));
__device__ __forceinline__ void kload8(bf16x8*kf,lds_cptr kp){
  kf[0]=*(const __attribute__((address_space(3))) bf16x8*)(kp);      kf[1]=*(const __attribute__((address_space(3))) bf16x8*)(kp+512);
  kf[2]=*(const __attribute__((address_space(3))) bf16x8*)(kp+2048); kf[3]=*(const __attribute__((address_space(3))) bf16x8*)(kp+2560);
  kf[4]=*(const __attribute__((address_space(3))) bf16x8*)(kp+4096); kf[5]=*(const __attribute__((address_space(3))) bf16x8*)(kp+4608);
  kf[6]=*(const __attribute__((address_space(3))) bf16x8*)(kp+6144); kf[7]=*(const __attribute__((address_space(3))) bf16x8*)(kp+6656);
}
__device__ __forceinline__ void kload2(bf16x8*kf,lds_cptr kp,int j){ kf[2*j]=*(const __attribute__((address_space(3))) bf16x8*)(kp+j*2048); kf[2*j+1]=*(const __attribute__((address_space(3))) bf16x8*)(kp+j*2048+512); }
__device__ __forceinline__ s16x4 vtr(lds_cptr p){ return __builtin_bit_cast(s16x4,__builtin_amdgcn_ds_read_tr16_b64_v4i16((__attribute__((address_space(3))) v4i16_t*)p)); }
__device__ __forceinline__ float rowmax(const f32x16&p0,const f32x16&p1){
  float a=max3f(p0[0],p0[1],p1[0]),b=max3f(p0[2],p0[3],p1[1]);a=max3f(a,p1[2],p1[3]);
  #pragma unroll
  for(int r=4;r<16;r+=4){a=max3f(a,p0[r],p0[r+1]);b=max3f(b,p0[r+2],p0[r+3]);a=max3f(a,p1[r],p1[r+1]);b=max3f(b,p1[r+2],p1[r+3]);}
  const float m=max2f(a,b);
  auto rr=__builtin_amdgcn_permlane32_swap(__float_as_uint(m),__float_as_uint(m),false,false);
  return max2f(__uint_as_float(rr[0]),__uint_as_float(rr[1]));
}
__device__ __forceinline__ void pv(f32x16*o,int vb,bf16x8 pa0,bf16x8 pa1,bf16x8 pa2,bf16x8 pa3){
  #pragma unroll
  for(int d0=0;d0<2;++d0){s16x4 lo[4],hi[4];
    #pragma unroll
    for(int ks=0;ks<4;++ks){
      asm volatile("ds_read_b64_tr_b16 %0,%1 offset:%c2":"=&v"(lo[ks]):"v"(vb),"i"(d0*4096+ks*1024):"memory");
      asm volatile("ds_read_b64_tr_b16 %0,%1 offset:%c2":"=&v"(hi[ks]):"v"(vb),"i"(d0*4096+ks*1024+512):"memory");}
    asm volatile("s_waitcnt lgkmcnt(0)":::"memory");SBAR();
    #define PK(k) (bf16x8){lo[k][0],lo[k][1],lo[k][2],lo[k][3],hi[k][0],hi[k][1],hi[k][2],hi[k][3]}
    o[d0]=__builtin_amdgcn_mfma_f32_32x32x16_bf16(pa0,PK(0),o[d0],0,0,0);
    o[d0]=__builtin_amdgcn_mfma_f32_32x32x16_bf16(pa1,PK(1),o[d0],0,0,0);
    o[d0]=__builtin_amdgcn_mfma_f32_32x32x16_bf16(pa2,PK(2),o[d0],0,0,0);
    o[d0]=__builtin_amdgcn_mfma_f32_32x32x16_bf16(pa3,PK(3),o[d0],0,0,0);
    #undef PK
  }
}

#ifndef ATTN_STORE16
#define ATTN_STORE16(p,v) (*(u32x4*)(p)=(v))
#endif
template<int THRL,bool MASKED,bool WIDE,bool NOMAX> __device__ __forceinline__ void attn_unit(int b,int hq,int hv,int qb,const bf16*Q,const bf16*__restrict__ K,const bf16*__restrict__ V,bf16*O,const unsigned long long*__restrict__ MK,char*shm,int wave_in,int badoff){
  const int tid=ltid(wave_in),lane=tid&63,r32=lane&31,hi=lane>>5; const int wid=__builtin_amdgcn_readfirstlane(tid>>6);
  const long rowbase=(long)b*SEQ; const int q0=qb*QB;
  const bf16*Qw=Q+(rowbase+q0+wid*QBLK)*DM+hq*D;
  const bf16*Kh=K+rowbase*DM+hq*D,*Vh=V+rowbase*DM+hv*D;
  constexpr int VSLOT=WIDE?2*SLOTB:SLOTB, L_WS=LDS_V+NSLOT*VSLOT, L_OST=L_WS+NW*64*4, L_MK=L_OST+NW*4096, L_TAB=L_MK+NW*2048;
  #define VS(sl) (WIDE?2*(sl):(sl))
  const unsigned lds0=(unsigned)(uintptr_t)shm;
  float*wsf=(float*)(shm+L_WS)+wid*64;
  const bf16*ksrc=Kh+(long)lane*DM+wid*8;
  const bf16*vsrc=Vh+(long)(16*(wid&3)+(lane>>2))*DM+(wid>>2)*32+(lane&3)*8;
  const unsigned kdst=lds0+LDS_K+wid*1024, vdst=lds0+LDS_V+wid*1024;
  #define DMA_K(t,slot) glds16(ksrc+(long)(t)*KVBLK*DM,(unsigned)__builtin_amdgcn_readfirstlane(kdst+(slot)))
  #define DMA_V(t,slot) do{ glds16(vsrc+(long)(t)*KVBLK*DM,(unsigned)__builtin_amdgcn_readfirstlane(vdst+VS(slot))); if(WIDE){ glds16(vsrc+64+(long)(t)*KVBLK*DM,(unsigned)__builtin_amdgcn_readfirstlane(vdst+VS(slot)+8192)); } }while(0)
  const long mq0=(long)q0+wid*QBLK+2*(lane&15); const unsigned mdst=lds0+L_MK+wid*2048;
  #define DMA_M4(t0) do{ if(MASKED){ const long t_=(long)(t0)+(lane>>4); if(t_<NT){ glds16(MK+(16384L*t_-32L*t_*(t_-1)+mq0-64L*t_),(unsigned)__builtin_amdgcn_readfirstlane(mdst+(((t0)&7)*256))); } } }while(0)
  unsigned mw0=0u,mw1=0u;
  #define MKRD(t) do{ if(MASKED){ const unsigned long long w_=*(const __attribute__((address_space(3))) unsigned long long*)(shm3+L_MK+wid*2048+(((t)&7)*256)+r32*8); mw0=(unsigned)w_; mw1=(unsigned)(w_>>32); } }while(0)
  #define MAND(X,r,MW) do{}while(0)
  bf16x8 aid[2];
  if(MASKED){
    #pragma unroll
    for(int ks=0;ks<2;++ks)
      #pragma unroll
      for(int j=0;j<8;++j) aid[ks][j]=(short)((r32==16*ks+8*hi+j)?0x3F80:0);
  }
  #define TABRD(w,ks) (*(const __attribute__((address_space(3))) bf16x8*)(shm3+L_TAB+((((w)>>(16*(ks)+8*hi))&0xffu)<<4)))
  #define BIAS(C0,C1,CI) do{ const bf16x8 f00_=TABRD(mw0,0),f01_=TABRD(mw0,1),f10_=TABRD(mw1,0),f11_=TABRD(mw1,1); \
    C0=__builtin_amdgcn_mfma_f32_32x32x16_bf16(aid[0],f00_,CI,0,0,0); C1=__builtin_amdgcn_mfma_f32_32x32x16_bf16(aid[0],f10_,CI,0,0,0); \
    C0=__builtin_amdgcn_mfma_f32_32x32x16_bf16(aid[1],f01_,C0,0,0,0); C1=__builtin_amdgcn_mfma_f32_32x32x16_bf16(aid[1],f11_,C1,0,0,0); }while(0)
  const int vb0=(int)(lds0+LDS_V)+((lane>>4)&1)*32+(lane&3)*8+(4*hi+((lane&15)>>2))*64;
  const char*Kbase=shm+LDS_K; bf16x8 kf[8];
  const lds_cptr shm3=(lds_cptr)shm; const lds_cptr kp0=shm3+LDS_K+hi*1024+r32*16; const lds_cptr vp0=shm3+LDS_V+((lane>>4)&1)*32+(lane&3)*8+(4*hi+((lane&15)>>2))*64;
  const int NT=(q0+QB)/KVBLK;
  DMA_M4(0);DMA_K(0,0);DMA_V(0,0);DMA_K(1,SLOTB);
  bf16x8 qr[4];
  #pragma unroll
  for(int d0=0;d0<4;++d0)qr[d0]=*reinterpret_cast<const bf16x8*>(&Qw[(long)r32*DM+d0*16+hi*8]);
  float mhat=0.f,l_reg=0.f;f32x16 o[4];o[0]=f32x16{};o[1]=f32x16{};o[2]=f32x16{};o[3]=f32x16{};f32x16 negm=f32x16{}; if(!WIDE&&!NOMAX){ asm volatile("":"+v"(negm)); }
  const int qrel=wid*QBLK+r32;
  #define CMASK(P0,P1,t) do{int jb_=(t)-(NT-4); if(jb_>=0)cmask(P0,P1,jb_,qrel,hi);}while(0)
  bool resc=false;
  #define START(P0,P1) do{ resc=false; \
    if constexpr(!NOMAX){ const float rm=rowmax(P0,P1); const float dl=rm; mhat=fadd_s(mhat,dl); \
      _Pragma("unroll") for(int r=0;r<16;++r){P0[r]=fsub_s(P0[r],dl);P1[r]=fsub_s(P1[r],dl);} \
      if(!WIDE){ _Pragma("unroll") for(int r=0;r<16;++r)negm[r]=-mhat; asm volatile("":"+v"(negm)); } } \
    _Pragma("unroll") for(int r=0;r<16;++r)P0[r]=__builtin_amdgcn_exp2f(P0[r]); }while(0)
  #define RESC() do{ if constexpr(!NOMAX) if(resc){ asm volatile("s_waitcnt lgkmcnt(0)":::"memory"); \
      _Pragma("unroll") for(int d_=0;d_<(WIDE?4:2);++d_) _Pragma("unroll") for(int r=0;r<16;++r)o[d_][r]*=wsf[crow(r,hi)]; } }while(0)
  f32x16 pA0,pA1,pB0,pB1;
  int sl_prev=0,sl_cur=0,sl_next=SLOTB;
  #define ROT() do{sl_prev=sl_cur;sl_cur=sl_next;sl_next=(sl_next==(NSLOT-1)*SLOTB)?0:sl_next+SLOTB;}while(0)
  DMA_K(2,2*SLOTB); const bool m4b_=MASKED&&(4<NT); if(m4b_){DMA_M4(4);}
  if(WIDE||m4b_){WAIT_BAR(4);}else{WAIT_BAR(3);}
  if(MASKED){ MKRD(0); BIAS(pA0,pA1,negm); qkt(pA0,pA1,Kbase,qr,pA0,pA1,r32,hi); } else { qkt(pA0,pA1,Kbase,qr,negm,negm,r32,hi); }
  asm volatile("s_nop 15\n\ts_nop 7":"+v"(pA0),"+v"(pA1));CMASK(pA0,pA1,0);
  START(pA0,pA1);
  _Pragma("unroll") for(int r=0;r<16;++r)pA1[r]=__builtin_amdgcn_exp2f(pA1[r]);
  WAIT_BAR(0);
  DMA_K(3,0);DMA_V(1,SLOTB);
  ROT();
  kload8(kf,kp0+sl_cur);
  if(WIDE){WAIT_BAR(3);}else{WAIT_BAR(2);}
  s16x4 vlo[8],vhi[8]; u32x4 pw0,pw1,pw2,pw3;
  #define PKW(P,B) cvtpk_s(P[B],P[B+1])
  #define PAF(k) __builtin_bit_cast(bf16x8,pw##k)
  #define VFR(i) (bf16x8){vlo[i][0],vlo[i][1],vlo[i][2],vlo[i][3],vhi[i][0],vhi[i][1],vhi[i][2],vhi[i][3]}
  #define PIN(x) asm volatile("":"+v"(x))
  #define MX3(a,b,c) __builtin_fmaxf(__builtin_fmaxf((a),(b)),(c))
  #define GAPA(MF,A0,A1,A2,A3,W0,W1,PW) do{ MF; sacc+=A0; sacc+=A1; sacc+=A2; sacc+=A3; PIN(sacc); W0; W1; PIN(PW); SBAR(); }while(0)
  #define EX(v) __builtin_amdgcn_exp2f(v)
  #define GAPB(MF,X,B,MW) do{ MF; X[B]=EX(X[B]); X[B+1]=EX(X[B+1]); X[B+2]=EX(X[B+2]); X[B+3]=EX(X[B+3]); MAND(X,B,MW); MAND(X,B+1,MW); MAND(X,B+2,MW); MAND(X,B+3,MW); PIN(X); SBAR(); }while(0)
  #define GAPB2(MF,X,B) do{ MF; X[B]=EX(X[B]); X[B+1]=EX(X[B+1]); PIN(X); SBAR(); }while(0)
  #define VRD(i) do{ vlo[i]=vtr(vp_+(((i)>>2)*4096+((i)&3)*1024)); vhi[i]=vtr(vp_+(((i)>>2)*4096+((i)&3)*1024+512)); }while(0)
  #define KRD(G,j) do{ if(G){ kload2(kf,kp0+sl_next,j); SBAR(); } }while(0)
  #define STEP(C0,C1,P0,P1,t,GK,GV,GL,GM) do{ SBAR(); \
    const lds_cptr vp_=vp0+VS(sl_prev); \
    if(MASKED){ MKRD(t); BIAS(C0,C1,negm); SBAR(); } \
    VRD(0); SBAR(); float sacc=(P0[0]+P0[1]); \
    GAPA(C0=__builtin_amdgcn_mfma_f32_32x32x16_bf16(kf[0],qr[0],(MASKED?C0:negm),0,0,0), P0[2],P0[3],P0[4],P0[5],     pw0[0]=PKW(P0,0), pw0[1]=PKW(P0,2), pw0); \
    VRD(4); SBAR(); GAPA(C1=__builtin_amdgcn_mfma_f32_32x32x16_bf16(kf[1],qr[0],(MASKED?C1:negm),0,0,0), P0[6],P0[7],P0[8],P0[9],     pw0[2]=PKW(P0,4), pw0[3]=PKW(P0,6), pw0); \
    VRD(1); SBAR(); GAPA(C0=__builtin_amdgcn_mfma_f32_32x32x16_bf16(kf[2],qr[1],C0,0,0,0),   P0[10],P0[11],P0[12],P0[13], pw1[0]=PKW(P0,8), pw1[1]=PKW(P0,10), pw1); \
    VRD(5); SBAR(); GAPA(C1=__builtin_amdgcn_mfma_f32_32x32x16_bf16(kf[3],qr[1],C1,0,0,0),   P0[14],P0[15],P1[0],P1[1],   pw1[2]=PKW(P0,12),pw1[3]=PKW(P0,14), pw1); \
    VRD(2); SBAR(); GAPA(C0=__builtin_amdgcn_mfma_f32_32x32x16_bf16(kf[4],qr[2],C0,0,0,0),   P1[2],P1[3],P1[4],P1[5],     pw2[0]=PKW(P1,0), pw2[1]=PKW(P1,2), pw2); \
    VRD(6); SBAR(); GAPA(C1=__builtin_amdgcn_mfma_f32_32x32x16_bf16(kf[5],qr[2],C1,0,0,0),   P1[6],P1[7],P1[8],P1[9],     pw2[2]=PKW(P1,4), pw2[3]=PKW(P1,6), pw2); \
    VRD(3); SBAR(); GAPA(C0=__builtin_amdgcn_mfma_f32_32x32x16_bf16(kf[6],qr[3],C0,0,0,0),   P1[10],P1[11],P1[12],P1[13], pw3[0]=PKW(P1,8), pw3[1]=PKW(P1,10), pw3); \
    VRD(7); SBAR(); GAPA(C1=__builtin_amdgcn_mfma_f32_32x32x16_bf16(kf[7],qr[3],C1,0,0,0),   P1[14],P1[15],0.f,0.f,       pw3[2]=PKW(P1,12),pw3[3]=PKW(P1,14), pw3); \
    l_reg+=sacc; \
    if(GK){DMA_K((t)+3,sl_cur);} if(GV){DMA_V((t)+1,sl_next);} if(MASKED&&GM){ if((((t)&3)==0)&&((t)+4<NT)){DMA_M4((t)+4);} } \
    CMASK(C0,C1,t); \
    if constexpr(!NOMAX){ float a=MX3(C0[0],C0[1],C1[0]),b=MX3(C0[2],C0[3],C1[1]); a=MX3(a,C1[2],C1[3]); \
      _Pragma("unroll") for(int r=4;r<16;r+=4){a=MX3(a,C0[r],C0[r+1]);b=MX3(b,C0[r+2],C0[r+3]);a=MX3(a,C1[r],C1[r+1]);b=MX3(b,C1[r+2],C1[r+3]);} \
      float rm=__builtin_fmaxf(a,b); { auto rr=__builtin_amdgcn_permlane32_swap(__float_as_uint(rm),__float_as_uint(rm),false,false); rm=__builtin_fmaxf(__uint_as_float(rr[0]),__uint_as_float(rr[1])); } \
      resc=false; \
      if(__builtin_expect(__any(rm>(float)THRL),0)){ const float dl=__builtin_fmaxf(rm,0.f); mhat+=dl; \
        _Pragma("unroll") for(int r=0;r<16;++r){C0[r]-=dl;C1[r]-=dl;} \
        _Pragma("unroll") for(int r=0;r<16;++r)negm[r]=-mhat; asm volatile("":"+v"(negm)); \
        const float f=__builtin_amdgcn_exp2f(-dl); l_reg*=f; if(hi==0)wsf[r32]=f; resc=true; } } \
    SBAR(); \
    GAPB(o[0]=__builtin_amdgcn_mfma_f32_32x32x16_bf16(PAF(0),VFR(0),o[0],0,0,0), C0,0,mw0); \
    GAPB(o[1]=__builtin_amdgcn_mfma_f32_32x32x16_bf16(PAF(0),VFR(4),o[1],0,0,0), C0,4,mw0); \
    KRD(GL,0); GAPB(o[0]=__builtin_amdgcn_mfma_f32_32x32x16_bf16(PAF(1),VFR(1),o[0],0,0,0), C0,8,mw0); \
    KRD(GL,1); GAPB(o[1]=__builtin_amdgcn_mfma_f32_32x32x16_bf16(PAF(1),VFR(5),o[1],0,0,0), C0,12,mw0); \
    KRD(GL,2); GAPB(o[0]=__builtin_amdgcn_mfma_f32_32x32x16_bf16(PAF(2),VFR(2),o[0],0,0,0), C1,0,mw1); \
    KRD(GL,3); GAPB(o[1]=__builtin_amdgcn_mfma_f32_32x32x16_bf16(PAF(2),VFR(6),o[1],0,0,0), C1,4,mw1); \
    GAPB(o[0]=__builtin_amdgcn_mfma_f32_32x32x16_bf16(PAF(3),VFR(3),o[0],0,0,0), C1,8,mw1); \
    GAPB(o[1]=__builtin_amdgcn_mfma_f32_32x32x16_bf16(PAF(3),VFR(7),o[1],0,0,0), C1,12,mw1); \
    }while(0)
  #define VLD(n,f) do{ vlo[(n)&3]=vtr(vp_+(((f)>>2)*4096+((f)&3)*1024)); vhi[(n)&3]=vtr(vp_+(((f)>>2)*4096+((f)&3)*1024+512)); }while(0)
  #define VFW(n) (bf16x8){vlo[(n)&3][0],vlo[(n)&3][1],vlo[(n)&3][2],vlo[(n)&3][3],vhi[(n)&3][0],vhi[(n)&3][1],vhi[(n)&3][2],vhi[(n)&3][3]}
  #define PVN(OD,k,n,fnext) do{ OD=__builtin_amdgcn_mfma_f32_32x32x16_bf16(PAF(k),VFW(n),OD,0,0,0); SBAR(); if((fnext)>=0){ VLD(n,fnext); SBAR(); } }while(0)
  #define STEPW(C0,C1,P0,P1,t,GK,GV,GL) do{ SBAR(); \
    const lds_cptr vp_=vp0+VS(sl_prev); \
    VLD(0,0); SBAR(); float sacc=(P0[0]+P0[1]); f32x16 ci_=f32x16{}; if constexpr(!NOMAX){ const float nm_=-mhat; _Pragma("unroll") for(int r=0;r<16;++r)ci_[r]=nm_; }     \
    GAPA(C0=__builtin_amdgcn_mfma_f32_32x32x16_bf16(kf[0],qr[0],ci_,0,0,0), P0[2],P0[3],P0[4],P0[5],     pw0[0]=PKW(P0,0), pw0[1]=PKW(P0,2), pw0); \
    VLD(1,4); SBAR(); GAPA(C1=__builtin_amdgcn_mfma_f32_32x32x16_bf16(kf[1],qr[0],ci_,0,0,0), P0[6],P0[7],P0[8],P0[9],     pw0[2]=PKW(P0,4), pw0[3]=PKW(P0,6), pw0); \
    VLD(2,1); SBAR(); GAPA(C0=__builtin_amdgcn_mfma_f32_32x32x16_bf16(kf[2],qr[1],C0,0,0,0),   P0[10],P0[11],P0[12],P0[13], pw1[0]=PKW(P0,8), pw1[1]=PKW(P0,10), pw1); \
    VLD(3,5); SBAR(); GAPA(C1=__builtin_amdgcn_mfma_f32_32x32x16_bf16(kf[3],qr[1],C1,0,0,0),   P0[14],P0[15],P1[0],P1[1],   pw1[2]=PKW(P0,12),pw1[3]=PKW(P0,14), pw1); \
    GAPA(C0=__builtin_amdgcn_mfma_f32_32x32x16_bf16(kf[4],qr[2],C0,0,0,0),   P1[2],P1[3],P1[4],P1[5],     pw2[0]=PKW(P1,0), pw2[1]=PKW(P1,2), pw2); \
    GAPA(C1=__builtin_amdgcn_mfma_f32_32x32x16_bf16(kf[5],qr[2],C1,0,0,0),   P1[6],P1[7],P1[8],P1[9],     pw2[2]=PKW(P1,4), pw2[3]=PKW(P1,6), pw2); \
    GAPA(C0=__builtin_amdgcn_mfma_f32_32x32x16_bf16(kf[6],qr[3],C0,0,0,0),   P1[10],P1[11],P1[12],P1[13], pw3[0]=PKW(P1,8), pw3[1]=PKW(P1,10), pw3); \
    GAPA(C1=__builtin_amdgcn_mfma_f32_32x32x16_bf16(kf[7],qr[3],C1,0,0,0),   P1[14],P1[15],0.f,0.f,       pw3[2]=PKW(P1,12),pw3[3]=PKW(P1,14), pw3); \
    l_reg+=sacc; \
    if(GK){DMA_K((t)+3,sl_cur);} if(GV){DMA_V((t)+1,sl_next);} \
    CMASK(C0,C1,t); \
    if constexpr(!NOMAX){ float a=MX3(C0[0],C0[1],C1[0]),b=MX3(C0[2],C0[3],C1[1]); a=MX3(a,C1[2],C1[3]); \
      _Pragma("unroll") for(int r=4;r<16;r+=4){a=MX3(a,C0[r],C0[r+1]);b=MX3(b,C0[r+2],C0[r+3]);a=MX3(a,C1[r],C1[r+1]);b=MX3(b,C1[r+2],C1[r+3]);} \
      float rm=__builtin_fmaxf(a,b); { auto rr=__builtin_amdgcn_permlane32_swap(__float_as_uint(rm),__float_as_uint(rm),false,false); rm=__builtin_fmaxf(__uint_as_float(rr[0]),__uint_as_float(rr[1])); } \
      resc=false; \
      if(__builtin_expect(__any(rm>(float)THRL),0)){ const float dl=__builtin_fmaxf(rm,0.f); mhat+=dl; \
        _Pragma("unroll") for(int r=0;r<16;++r){C0[r]-=dl;C1[r]-=dl;} \
        const float f=__builtin_amdgcn_exp2f(-dl); l_reg*=f; if(hi==0)wsf[r32]=f; resc=true; } } \
    SBAR(); \
    GAPB2(o[0]=__builtin_amdgcn_mfma_f32_32x32x16_bf16(PAF(0),VFW(0),o[0],0,0,0), C0,0); VLD(0,2); SBAR(); \
    GAPB2(o[1]=__builtin_amdgcn_mfma_f32_32x32x16_bf16(PAF(0),VFW(1),o[1],0,0,0), C0,2); VLD(1,6); SBAR(); \
    KRD(GL,0); GAPB2(o[0]=__builtin_amdgcn_mfma_f32_32x32x16_bf16(PAF(1),VFW(2),o[0],0,0,0), C0,4); VLD(2,3); SBAR(); \
    KRD(GL,1); GAPB2(o[1]=__builtin_amdgcn_mfma_f32_32x32x16_bf16(PAF(1),VFW(3),o[1],0,0,0), C0,6); VLD(3,7); SBAR(); \
    KRD(GL,2); GAPB2(o[0]=__builtin_amdgcn_mfma_f32_32x32x16_bf16(PAF(2),VFW(4),o[0],0,0,0), C0,8); VLD(4,8); SBAR(); \
    KRD(GL,3); GAPB2(o[1]=__builtin_amdgcn_mfma_f32_32x32x16_bf16(PAF(2),VFW(5),o[1],0,0,0), C0,10); VLD(5,12); SBAR(); \
    GAPB2(o[0]=__builtin_amdgcn_mfma_f32_32x32x16_bf16(PAF(3),VFW(6),o[0],0,0,0), C0,12); VLD(6,9); SBAR(); \
    GAPB2(o[1]=__builtin_amdgcn_mfma_f32_32x32x16_bf16(PAF(3),VFW(7),o[1],0,0,0), C0,14); VLD(7,13); SBAR(); \
    GAPB2(o[2]=__builtin_amdgcn_mfma_f32_32x32x16_bf16(PAF(0),VFW(8),o[2],0,0,0), C1,0); VLD(8,10); SBAR(); \
    GAPB2(o[3]=__builtin_amdgcn_mfma_f32_32x32x16_bf16(PAF(0),VFW(9),o[3],0,0,0), C1,2); VLD(9,14); SBAR(); \
    GAPB2(o[2]=__builtin_amdgcn_mfma_f32_32x32x16_bf16(PAF(1),VFW(10),o[2],0,0,0), C1,4); VLD(10,11); SBAR(); \
    GAPB2(o[3]=__builtin_amdgcn_mfma_f32_32x32x16_bf16(PAF(1),VFW(11),o[3],0,0,0), C1,6); VLD(11,15); SBAR(); \
    GAPB2(o[2]=__builtin_amdgcn_mfma_f32_32x32x16_bf16(PAF(2),VFW(12),o[2],0,0,0), C1,8); \
    GAPB2(o[3]=__builtin_amdgcn_mfma_f32_32x32x16_bf16(PAF(2),VFW(13),o[3],0,0,0), C1,10); \
    GAPB2(o[2]=__builtin_amdgcn_mfma_f32_32x32x16_bf16(PAF(3),VFW(14),o[2],0,0,0), C1,12); \
    GAPB2(o[3]=__builtin_amdgcn_mfma_f32_32x32x16_bf16(PAF(3),VFW(15),o[3],0,0,0), C1,14); \
    }while(0)
  #define STEPX(C0,C1,P0,P1,t,GK,GV,GL,GM) do{ if constexpr(WIDE){ STEPW(C0,C1,P0,P1,t,GK,GV,GL); } else { STEP(C0,C1,P0,P1,t,GK,GV,GL,GM); } }while(0)
  int t=1;
  #undef CMASK
  #define CMASK(P0,P1,t) do{}while(0)
  for(;t+5<NT;t+=2){
    STEPX(pB0,pB1,pA0,pA1,t,true,true,true,true);     if(WIDE){WAIT_BAR(3);}else{WAIT_BAR(2);} RESC(); ROT();
    STEPX(pA0,pA1,pB0,pB1,t+1,true,true,true,true);   if(WIDE||(MASKED&&(((t+1)&3)==0))){WAIT_BAR(3);}else{WAIT_BAR(2);} RESC(); ROT();
  }
  #undef CMASK
  #define CMASK(P0,P1,t) do{int jb_=(t)-(NT-4); if(jb_>=0)cmask(P0,P1,jb_,qrel,hi);}while(0)
  #define ENDW(tt) do{ if(WIDE){ if((tt)+3<NT){WAIT_BAR(3);} else if((tt)+2<NT){WAIT_BAR(2);} else {WAIT_BAR(0);} } else { if((tt)+3<NT){WAIT_BAR(2);} else if((tt)+2<NT){WAIT_BAR(1);} else {WAIT_BAR(0);} } }while(0)
  for(;t+1<NT;t+=2){
    STEPX(pB0,pB1,pA0,pA1,t,(t+3<NT),(t+1<NT),(t+1<NT),(t+2<NT));       ENDW(t);   RESC(); ROT();
    STEPX(pA0,pA1,pB0,pB1,t+1,(t+4<NT),(t+2<NT),(t+2<NT),(t+3<NT));     ENDW(t+1); RESC(); ROT();
  }
  STEPX(pB0,pB1,pA0,pA1,NT-1,false,false,false,false); RESC();
  { float sacc=pB0[0]+pB0[1]; _Pragma("unroll") for(int r=2;r<16;++r)sacc+=pB0[r]; _Pragma("unroll") for(int r=0;r<16;++r)sacc+=pB1[r]; l_reg+=sacc;
    pw0=(u32x4){PKW(pB0,0),PKW(pB0,2),PKW(pB0,4),PKW(pB0,6)};pw1=(u32x4){PKW(pB0,8),PKW(pB0,10),PKW(pB0,12),PKW(pB0,14)};pw2=(u32x4){PKW(pB1,0),PKW(pB1,2),PKW(pB1,4),PKW(pB1,6)};pw3=(u32x4){PKW(pB1,8),PKW(pB1,10),PKW(pB1,12),PKW(pB1,14)};
    SBAR(); pv(o,vb0+VS(sl_cur),PAF(0),PAF(1),PAF(2),PAF(3)); if(WIDE){ pv(o+2,vb0+VS(sl_cur)+8192,PAF(0),PAF(1),PAF(2),PAF(3)); } }
  #undef PKW
  #undef PAF
  #undef VFR
  #undef PIN
  #undef MX3
  #undef GAPA
  #undef GAPB
  #undef GAPB2
  #undef EX
  #undef VRD
  #undef KRD
  #undef VLD
  #undef VFW
  #undef PVN
  #undef STEPW
  #undef STEPX
  #undef STEP
  #undef ENDW
  {auto rr=__builtin_amdgcn_permlane32_swap(__float_as_uint(l_reg),__float_as_uint(l_reg),false,false);l_reg=__uint_as_float(rr[0])+__uint_as_float(rr[1]);}
  if constexpr(NOMAX){ if(!(l_reg>7.9e-31f&&l_reg<1.2e30f))*(__attribute__((address_space(3))) unsigned*)((__attribute__((address_space(3))) char*)shm+badoff)=1u; }
  if(hi==0)wsf[32+r32]=l_reg;asm volatile("s_waitcnt lgkmcnt(0)":::"memory");
  float rli[16];
  #pragma unroll
  for(int r=0;r<16;++r)rli[r]=__builtin_amdgcn_rcpf(wsf[32+crow(r,hi)]);
  bf16*Ow=O+(rowbase+q0+wid*QBLK)*DM+hv*D;
  #pragma unroll
  for(int hf=0;hf<(WIDE?2:1);++hf){ bf16*stg=(bf16*)(shm+L_OST)+wid*2048;
    #pragma unroll
    for(int r=0;r<16;++r){const int orow=crow(r,hi);
      #pragma unroll
      for(int d0=0;d0<2;++d0)stg[orow*64+d0*32+r32]=__float2bfloat16(o[2*hf+d0][r]*rli[r]);}
    asm volatile("s_waitcnt lgkmcnt(0)":::"memory");
    #pragma unroll
    for(int i=0;i<4;++i){const int row=i*8+(lane>>3),ch=lane&7; const u32x4 v=*(const u32x4*)(stg+row*64+ch*8); ATTN_STORE16(Ow+(long)row*DM+hf*64+ch*8,v);}
    asm volatile("s_waitcnt lgkmcnt(0)":::"memory"); }
  asm volatile("s_waitcnt lgkmcnt(0)\n\ts_barrier":::"memory");
  #undef DMA_K
  #undef DMA_V
  #undef DMA_M4
  #undef MKRD
  #undef MAND
  #undef TABRD
  #undef BIAS
  #undef CMASK
  #undef START
  #undef RESC
  #undef ROT
  #undef VS
}
constexpr int ATTN_LDS_BYTES=LDS_BYTES+NW*1024+4096;
__device__ __forceinline__ void mask_table_init(char*shm,int tid){
  if(tid<256){ u32x4 v; unsigned e[8];
    #pragma unroll
    for(int j=0;j<8;++j) e[j]=((tid>>j)&1)?0u:0xC400u;
    v.x=e[0]|(e[1]<<16); v.y=e[2]|(e[3]<<16); v.z=e[4]|(e[5]<<16); v.w=e[6]|(e[7]<<16);
    *(u32x4*)(shm+LDS_MK+NW*2048+tid*16)=v; }
  __syncthreads();
}
#undef SBAR
#undef WAIT_BAR
}

constexpr int NWAVES = 8;
#ifndef MK_PER_PHASE
#define MK_PER_PHASE 0
#endif

#ifndef CHK
#define CHK 0
#endif
constexpr int CW_CHK = 2;
constexpr int BATCH = 2, SEQ = 16384, NTOK = BATCH * SEQ, DMODEL = 1024, DEPTH = 2;
constexpr int WIN_OLD = 5704, WIN_NEW = 5888, P1_N = 3840;
constexpr float LN_EPS = 1e-5f, ALPHA = 1.41421356237f;
constexpr int NPH_LAYER = 12, NPHASE = DEPTH * NPH_LAYER;

constexpr size_t MiB = 1u << 20;
constexpr size_t WS_CTL = 0, CTL_ZERO_BYTES = 1 * MiB;
constexpr size_t WS_SMALL = 1 * MiB, SM_LAM = 0, SM_WR = 4096, SM_BR = SM_WR + 2 * 36 * 1024 * 4;
constexpr size_t WS_ROPE = 2 * MiB;
constexpr size_t WS_ROUTE = 4 * MiB, RT_E = 0, RT_C = 256 * 1024, RT_HIST = 512 * 1024, RT_TOT = 544 * 1024, RT_ROW = 576 * 1024, RT_ENT = 864 * 1024, RT_CW = 1152 * 1024;
constexpr int LIST_CAP = 65536 + 32 * 256;
constexpr size_t WS_WB = 6 * MiB;
constexpr size_t WB_WIN = 0, WB_WBD = (size_t)WIN_NEW * 1024 * 2, WB_WBS = WB_WBD + MiB, WB_WO = WB_WBS + MiB, WB_WPG = WB_WO + 2 * MiB, WB_WPLE = WB_WPG + 2 * MiB,
                 WB_WGU = WB_WPLE + MiB / 2, WB_WD = WB_WGU + 32 * MiB, WB_END = WB_WD + 16 * MiB;
static_assert(WB_END == 66 * MiB, "weight copies");
constexpr size_t WB_WG8 = WB_WIN + (size_t)3840 * 1024 * 2;
constexpr size_t WS_XB = 72 * MiB;
constexpr size_t WS_DQ = 136 * MiB, TSTRIDE = 32 * MiB, WS_IK = 360 * MiB, WS_IW = 364 * MiB;
constexpr size_t WS_O0 = 365 * MiB, WS_O1 = 397 * MiB, WS_YB = 429 * MiB, WS_MASK = 461 * MiB;
constexpr long MASK_BSTRIDE = 2105344;
constexpr size_t WS_YA = 136 * MiB, WS_MERGED = 168 * MiB, WS_TMPG = 240 * MiB, WS_PRE1 = 240 * MiB;
constexpr size_t OUT_XB8 = 0, OUT_X1B8 = 32 * MiB, OUT_T1 = 64 * MiB;
constexpr size_t WS_HG = 136 * MiB, WS_PLE = 172 * MiB, WS_Y0 = 368 * MiB, WS_Y1 = 432 * MiB, WS_PB = 496 * MiB, WS_END = 512 * MiB;
static_assert(WS_MASK + 2 * MASK_BSTRIDE * 8 <= WS_PB, "mask fits");
constexpr int CW_TMO = 0, CW_CODE = 1, CW_BAR = 4096, CW_QUEUE = 8192;

constexpr int RING_OFF = 0, RING_BYTES = 131072;
constexpr int XTR_OFF = RING_BYTES, XTR_BYTES = 4096;
constexpr int MISC_OFF = XTR_OFF + XTR_BYTES;
constexpr int LDS_BYTES = 147456;
static_assert(MISC_OFF + 128 <= LDS_BYTES, "LDS map");
#define GAS __attribute__((address_space(1)))
#define LAS __attribute__((address_space(3)))
typedef unsigned short bf16;
typedef unsigned v4u __attribute__((ext_vector_type(4)));
typedef float f32x4 __attribute__((ext_vector_type(4)));
typedef short bf16x8 __attribute__((ext_vector_type(8)));
typedef GAS unsigned gu32;
typedef GAS unsigned long long gu64;
#define RLX_AGENT __ATOMIC_RELAXED, __HIP_MEMORY_SCOPE_AGENT
#define LDS_WAIT() asm volatile("s_waitcnt lgkmcnt(0)" ::: "memory")
#define VM_WAIT() asm volatile("s_waitcnt vmcnt(0)" ::: "memory")
__device__ __forceinline__ unsigned long long rt() { return __builtin_amdgcn_s_memrealtime(); }
__device__ __forceinline__ unsigned f2bf(float f) { unsigned u = __builtin_bit_cast(unsigned, f); return (u + 0x7fffu + ((u >> 16) & 1u)) >> 16; }
__device__ __forceinline__ unsigned pk2(float lo, float hi) { return f2bf(lo) | (f2bf(hi) << 16); }

#define XB_TMO      128
#define XB_XCNT(j)  (256  + 64 * (j))
#define XB_XSUB(j)  (1280 + 64 * (j))
#define XB_XGEN(j)  (2304 + 64 * (j))
#define XB_TOP      3328
#define XB_TOPGEN   3392
#define XCD_BAR_WORDS 3456
#define XB_SPIN_CAP (1u << 18)

__device__ __forceinline__ unsigned xb_ld(unsigned* p)              { return __hip_atomic_load(p, __ATOMIC_RELAXED, __HIP_MEMORY_SCOPE_AGENT); }
__device__ __forceinline__ unsigned xb_add(unsigned* p, unsigned v) { return __hip_atomic_fetch_add(p, v, __ATOMIC_RELAXED, __HIP_MEMORY_SCOPE_AGENT); }
__device__ __forceinline__ unsigned xb_xcc_id() { return (unsigned)__builtin_amdgcn_s_getreg((3 << 11) | 20) & 0xFu; }
#define XB_SPIN(cond, bar) do { unsigned _sp = 0; while (cond) { __builtin_amdgcn_s_sleep(1); \
    if ((++_sp & 255u) == 0u) { if (xb_ld(&(bar)[XB_TMO])) break; if (_sp > XB_SPIN_CAP) { atomicAdd(&(bar)[XB_TMO], 1u); break; } } } } while (0)

struct XcdBarrier {
    unsigned* bar; unsigned x;
    volatile LAS unsigned* st;
};

__device__ __forceinline__ XcdBarrier xcd_barrier_post(unsigned* bar, volatile LAS unsigned* st) {
    XcdBarrier b; b.bar = bar; b.x = xb_xcc_id(); b.st = st;
    if (threadIdx.x == 0) (void)xb_add(&bar[XB_XCNT(b.x)], 1u);
    return b;
}
__device__ __forceinline__ void xcd_barrier_complete(unsigned* bar, unsigned x, unsigned& nloc, unsigned& nx) {
    const unsigned G = gridDim.x * gridDim.y * gridDim.z;
    unsigned sum, cnt, mine, sp = 0u;
    for (;;) {
        sum = 0u; cnt = 0u; mine = 0u;
#pragma unroll
        for (unsigned j = 0; j < 16; ++j) { const unsigned c = xb_ld(&bar[XB_XCNT(j)]); sum += c; cnt += (c > 0u) ? 1u : 0u; mine = (j == x) ? c : mine; }
        if (sum == G) break;
        __builtin_amdgcn_s_sleep(1);
        if ((++sp & 255u) == 0u) { if (xb_ld(&bar[XB_TMO])) break; if (sp > XB_SPIN_CAP) { atomicAdd(&bar[XB_TMO], 1u); break; } }
    }
    nloc = mine > 0u ? mine : 1u; nx = cnt > 0u ? cnt : 1u;
}

__device__ __forceinline__ void xcd_barrier(const XcdBarrier& b) {
    asm volatile("s_waitcnt vmcnt(0)" ::: "memory");
    __syncthreads();
    if (threadIdx.x == 0) {
        unsigned* bar = b.bar;
        __builtin_amdgcn_s_waitcnt(0);
        unsigned nloc = b.st[0], nx = b.st[1];
        if (nloc == 0u) { xcd_barrier_complete(bar, b.x, nloc, nx); b.st[0] = nloc; b.st[1] = nx; }
        const unsigned old = xb_add(&bar[XB_XSUB(b.x)], 1u);
        const unsigned gen = old / nloc;
        if (old + 1u == (gen + 1u) * nloc) {
            __builtin_amdgcn_fence(__ATOMIC_RELEASE, "agent");
            asm volatile("s_waitcnt vmcnt(0)" ::: "memory");
            const unsigned og = xb_add(&bar[XB_TOP], 1u);
            const unsigned tg = og / nx;
            if (og + 1u == (tg + 1u) * nx) xb_add(&bar[XB_TOPGEN], 1u);
            else XB_SPIN(xb_ld(&bar[XB_TOPGEN]) == tg, bar);
            __builtin_amdgcn_fence(__ATOMIC_ACQUIRE, "agent");
            xb_add(&bar[XB_XGEN(b.x)], 1u);
            asm volatile("s_waitcnt vmcnt(0)" ::: "memory");
        } else {
            XB_SPIN(xb_ld(&bar[XB_XGEN(b.x)]) == gen, bar);
            __builtin_amdgcn_fence(__ATOMIC_ACQUIRE, "agent");
            asm volatile("s_waitcnt vmcnt(0)" ::: "memory");
        }
    }
    __syncthreads();
}

#ifndef DBG
#define DBG 0
#endif
struct Args { const void* in[22]; float* out; unsigned char* ws; int ph_lo, ph_hi; };
struct Frame {
    LAS unsigned char* lds;
    volatile LAS unsigned* MISC;
    gu32* ctl;
    int tid, lane, wave;
    int vcu, G, bx;
    unsigned char* ws; unsigned char* ws0;
    float* out; float* out0;
    const Args* ap;
};
#define INP(k) (F.ap->in[(k)])
#define DPP_F(v, ctrl) __builtin_bit_cast(float, __builtin_amdgcn_update_dpp(0, __builtin_bit_cast(int, (v)), (ctrl), 0xf, 0xf, true))
__device__ __forceinline__ float row16_sum(float v) {
    v += DPP_F(v, 0xB1);
    v += DPP_F(v, 0x4E);
    v += DPP_F(v, 0x141);
    v += DPP_F(v, 0x140);
    return v;
}
__device__ __forceinline__ float wave_sum(float v) {
    v = row16_sum(v);
    { auto r = __builtin_amdgcn_permlane16_swap(__float_as_uint(v), __float_as_uint(v), false, false); v = __uint_as_float(r[0]) + __uint_as_float(r[1]); }
    { auto r = __builtin_amdgcn_permlane32_swap(__float_as_uint(v), __float_as_uint(v), false, false); v = __uint_as_float(r[0]) + __uint_as_float(r[1]); }
    return v;
}
__device__ __forceinline__ void wave_sum4(float p0, float p1, float p2, float p3, float (&out)[4]) {
    auto r = __builtin_amdgcn_permlane32_swap(__float_as_uint(p0), __float_as_uint(p1), false, false); const float s01 = __uint_as_float(r[0]) + __uint_as_float(r[1]);
    r = __builtin_amdgcn_permlane32_swap(__float_as_uint(p2), __float_as_uint(p3), false, false); const float s23 = __uint_as_float(r[0]) + __uint_as_float(r[1]);
    r = __builtin_amdgcn_permlane16_swap(__float_as_uint(s01), __float_as_uint(s23), false, false); float t = __uint_as_float(r[0]) + __uint_as_float(r[1]);
    t = row16_sum(t);
    out[0] = __uint_as_float((unsigned)__builtin_amdgcn_readlane((int)__float_as_uint(t), 0)); out[2] = __uint_as_float((unsigned)__builtin_amdgcn_readlane((int)__float_as_uint(t), 16));
    out[1] = __uint_as_float((unsigned)__builtin_amdgcn_readlane((int)__float_as_uint(t), 32)); out[3] = __uint_as_float((unsigned)__builtin_amdgcn_readlane((int)__float_as_uint(t), 48));
}
typedef float f32x2 __attribute__((ext_vector_type(2)));

__device__ __forceinline__ void tr_item(const float* W, int ldn, int col0, int nvalid, bf16* WT, int K, int row0, LAS float* scr, int kb, int lane) {
    const int k0 = 64 * kb, n = lane & 31;
#pragma unroll 8
    for (int i = 0; i < 32; ++i) { const int kk = 2 * i + (lane >> 5); scr[kk * 33 + n] = (n < nvalid) ? W[(size_t)(k0 + kk) * ldn + col0 + n] : 0.f; }
    LDS_WAIT(); asm volatile("" ::: "memory");
    const int c = lane & 7;
#pragma unroll
    for (int j = 0; j < 4; ++j) { const int nn = (lane >> 3) + 8 * j; const LAS float* s = scr + (8 * c) * 33 + nn;
        v4u o; o.x = pk2(s[0 * 33], s[1 * 33]); o.y = pk2(s[2 * 33], s[3 * 33]); o.z = pk2(s[4 * 33], s[5 * 33]); o.w = pk2(s[6 * 33], s[7 * 33]);
        *(GAS v4u*)(WT + (size_t)(row0 + nn) * K + k0 + 8 * c) = o; }
    LDS_WAIT(); asm volatile("" ::: "memory");
}
__device__ __forceinline__ unsigned pk4_fp8(float a, float b, float c, float d) { int p = __builtin_amdgcn_cvt_pk_fp8_f32(a, b, 0, false); return (unsigned)__builtin_amdgcn_cvt_pk_fp8_f32(c, d, p, true); }
__device__ __forceinline__ void tr_item8(const float* W, int ldn, int col0, unsigned char* WT, int K, int row0, LAS float* scr, int kb, int lane) {
    const int k0 = 64 * kb, n = lane & 31;
#pragma unroll 8
    for (int i = 0; i < 32; ++i) { const int kk = 2 * i + (lane >> 5); scr[kk * 33 + n] = W[(size_t)(k0 + kk) * ldn + col0 + n] * 64.f; }
    LDS_WAIT(); asm volatile("" ::: "memory");
    const int c = lane & 7;
#pragma unroll
    for (int j = 0; j < 4; ++j) { const int nn = (lane >> 3) + 8 * j; const LAS float* s = scr + (8 * c) * 33 + nn;
        const unsigned long long o = (unsigned long long)pk4_fp8(s[0 * 33], s[1 * 33], s[2 * 33], s[3 * 33]) | ((unsigned long long)pk4_fp8(s[4 * 33], s[5 * 33], s[6 * 33], s[7 * 33]) << 32);
        *(GAS unsigned long long*)(WT + (size_t)(row0 + nn) * K + k0 + 8 * c) = o; }
    LDS_WAIT(); asm volatile("" ::: "memory");
}
__device__ __forceinline__ void pw_phase(Frame& F, int l) {
    LAS float* scr = (LAS float*)(F.lds + RING_OFF + F.wave * 16384);
    const int gw = F.vcu * NWAVES + F.wave, NGW = F.G * NWAVES, lane = F.lane;
    unsigned char* wb = F.ws + WS_WB;
    bf16* WIN = (bf16*)(wb + WB_WIN);
    const float* w_in = (const float*)INP(3) + (size_t)l * 1024 * WIN_OLD;
    constexpr int I_A = 16 * 114, I_B = 16, I_C = 16 * 64, I_BD = 8 * 32, I_O = 16 * 32, I_PLE = 4 * 32, I_GU = 32 * 4 * 64, I_D = 32 * 128;
    constexpr int NITEMS = I_A + I_B + I_C + 2 * I_BD + 2 * I_O + I_PLE + I_GU + I_D;
    for (int it = gw; it < NITEMS; it += NGW) {
        int r = it;
        if (r < I_A) { const int kb = r / 114, nb = r % 114; tr_item(w_in, WIN_OLD, 32 * nb, 32, WIN, 1024, 32 * nb, scr, kb, lane); continue; } r -= I_A;
        if (r < I_B) { tr_item(w_in, WIN_OLD, 3648, 8, WIN, 1024, 3648, scr, r, lane); continue; } r -= I_B;
        if (r < I_C) { const int kb = r / 64, nb = r % 64; tr_item8(w_in, WIN_OLD, 3656 + 32 * nb, wb + WB_WG8, 1024, 32 * nb, scr, kb, lane); continue; } r -= I_C;
        if (r < I_BD) { tr_item((const float*)INP(6) + (size_t)l * 512 * 1024, 1024, 32 * (r % 32), 32, (bf16*)(wb + WB_WBD), 512, 32 * (r % 32), scr, r / 32, lane); continue; } r -= I_BD;
        if (r < I_BD) { tr_item((const float*)INP(7) + (size_t)l * 512 * 1024, 1024, 32 * (r % 32), 32, (bf16*)(wb + WB_WBS), 512, 32 * (r % 32), scr, r / 32, lane); continue; } r -= I_BD;
        if (r < I_O) { tr_item((const float*)INP(8) + (size_t)l * 1024 * 1024, 1024, 32 * (r % 32), 32, (bf16*)(wb + WB_WO), 1024, 32 * (r % 32), scr, r / 32, lane); continue; } r -= I_O;
        if (r < I_O) { tr_item8((const float*)INP(19) + (size_t)l * 1024 * 1024, 1024, 32 * (r % 32), wb + WB_WPG, 1024, 32 * (r % 32), scr, r / 32, lane); continue; } r -= I_O;
        if (r < I_PLE) { tr_item((const float*)INP(18) + (size_t)l * 256 * 1024, 1024, 32 * (r % 32), 32, (bf16*)(wb + WB_WPLE), 256, 32 * (r % 32), scr, r / 32, lane); continue; } r -= I_PLE;
        if (r < I_GU) { const int e = r >> 8, sub = (r >> 6) & 3, q = r & 63, kb = q >> 2, nb = q & 3;
            const float* W = ((sub & 1) ? (const float*)INP(16) : (const float*)INP(15)) + (size_t)(l * 32 + e) * 1024 * 256;
            tr_item8(W, 256, (sub >> 1) * 128 + 32 * nb, wb + WB_WGU, 1024, e * 512 + sub * 128 + 32 * nb, scr, kb, lane); continue; } r -= I_GU;
        { const int e = r >> 7, q = r & 127, kb = q >> 5, nb = q & 31;
            tr_item((const float*)INP(17) + (size_t)(l * 32 + e) * 256 * 1024, 1024, 32 * nb, 32, (bf16*)(wb + WB_WD), 256, e * 1024 + 32 * nb, scr, kb, lane); }
    }
    { unsigned z_ = 0u; asm volatile("" : "+v"(z_));
      for (int ch = F.vcu * 512 + F.tid; ch < 160 * 128; ch += F.G * 512) *(GAS v4u*)(WIN + (size_t)3680 * 1024 + (size_t)ch * 8) = (v4u){z_, z_, z_, z_}; }
    const float* p = (const float*)INP(1) + (size_t)l * NTOK * 256; bf16* PB = (bf16*)(F.ws + WS_PB);
    for (int m0 = gw; m0 < NTOK; m0 += 4 * NGW) { f32x4 v[4];
#pragma unroll
        for (int j = 0; j < 4; ++j) { const int m = min(m0 + j * NGW, NTOK - 1); v[j] = *((const GAS f32x4*)(p + (size_t)m * 256) + lane); }
#pragma unroll
        for (int j = 0; j < 4; ++j) { const int m = m0 + j * NGW; if (m < NTOK) *((GAS unsigned long long*)(PB + (size_t)m * 256) + lane) = (unsigned long long)pk2(v[j].x, v[j].y) | ((unsigned long long)pk2(v[j].z, v[j].w) << 32); } }
    if (l == 0) {
        const float* x = (const float*)INP(0); bf16* XB = (bf16*)(F.ws + WS_XB);
        for (int m0 = gw; m0 < NTOK; m0 += 2 * NGW) { f32x4 v[2][4];
#pragma unroll
            for (int r = 0; r < 2; ++r) { const int m = min(m0 + r * NGW, NTOK - 1); const GAS f32x4* xr = (const GAS f32x4*)(x + (size_t)m * 1024) + lane;
#pragma unroll
                for (int j = 0; j < 4; ++j) v[r][j] = xr[64 * j]; }
#pragma unroll
            for (int r = 0; r < 2; ++r) { const int m = m0 + r * NGW; if (m < NTOK) { GAS unsigned long long* o8 = (GAS unsigned long long*)(XB + (size_t)m * 1024) + lane;
#pragma unroll
                for (int j = 0; j < 4; ++j) { const f32x4 w = v[r][j]; o8[64 * j] = (unsigned long long)pk2(w.x, w.y) | ((unsigned long long)pk2(w.z, w.w) << 32);
                    ((GAS unsigned*)((unsigned char*)F.out + OUT_XB8 + (size_t)m * 1024) + lane)[64 * j] = pk4_fp8(w.x, w.y, w.z, w.w); } } }
        }
        const int* pos = (const int*)INP(2); float* rope = (float*)(F.ws + WS_ROPE);
        for (int idx = F.vcu * 512 + F.tid; idx < NTOK * 8; idx += F.G * 512) {
            const int m = idx >> 3, j = idx & 7; const float invf = exp2f(-2.366446071f * (float)j); const float ang = (float)pos[m] * invf;
            double rev = (double)ang * 0.15915494309189535; rev -= rint(rev);
            rope[m * 16 + j] = (DBG & 16) ? 1.f : __builtin_amdgcn_cosf((float)rev); rope[m * 16 + 8 + j] = (DBG & 16) ? 0.f : __builtin_amdgcn_sinf((float)rev);
        }
        float* WR = (float*)(F.ws + WS_SMALL + SM_WR); float* BR = (float*)(F.ws + WS_SMALL + SM_BR);
        for (int idx = F.vcu * 512 + F.tid; idx < 2 * 36 * 1024; idx += F.G * 512) {
            const int ll = idx / (36 * 1024), r = idx % (36 * 1024), j = r >> 10, k = r & 1023;
            WR[idx] = (j < 4) ? ((const float*)INP(11))[((size_t)ll * 1024 + k) * 4 + j] : ((const float*)INP(13))[((size_t)ll * 1024 + k) * 32 + (j - 4)];
        }
        if (F.vcu == 0 && F.tid < 72) { const int ll = F.tid / 36, j = F.tid % 36; BR[F.tid] = (j < 4) ? ((const float*)INP(12))[ll * 4 + j] : ((const float*)INP(14))[ll * 32 + j - 4]; }
        if (F.vcu == 0 && F.tid < 2) { const float* lp = (const float*)INP(4) + F.tid * 256; float a = 0.f, b = 0.f;
            for (int i = 0; i < 64; ++i) { a += lp[i] * lp[64 + i]; b += lp[128 + i] * lp[192 + i]; }
            const float lam_init = (F.tid == 0) ? 0.2f : 0.35550907f;
            ((float*)(F.ws + WS_SMALL + SM_LAM))[F.tid] = __expf(a) - __expf(b) + lam_init; }
    }
}

namespace idxr {
typedef float f32x16 __attribute__((ext_vector_type(16)));
typedef short s16x2 __attribute__((ext_vector_type(2)));
typedef __fp16 h16x2 __attribute__((ext_vector_type(2)));
constexpr int HROW = 513;
__device__ __forceinline__ unsigned f2key(float f) { const unsigned u = __float_as_uint(f); return u ^ ((unsigned)((int)u >> 31) | 0x80000000u); }
__device__ __forceinline__ unsigned bins2(float a, float b) {
    const unsigned h = __builtin_bit_cast(unsigned, __builtin_amdgcn_cvt_pkrtz(a, b));
    const unsigned m = __builtin_bit_cast(unsigned, (s16x2)(__builtin_bit_cast(s16x2, h) >> (s16x2){15, 15}));
    const unsigned key = h ^ (m | 0x80008000u);
    return (key >> 5) & 0x07fc07fcu;
}
__device__ __forceinline__ float f16bits(unsigned h) { return (float)__builtin_bit_cast(__fp16, (unsigned short)h); }
__device__ __forceinline__ float bin_edge(int b) {
    if (b <= 0) return -__builtin_inff();
    if (b >= 512) return __builtin_inff();
    const unsigned K = (unsigned)b << 7;
    if (K >= 0x8000u) { const unsigned H = K & 0x7fffu; return (H >= 0x7c00u) ? __builtin_inff() : f16bits(H); }
    const unsigned M1 = ((0xFFFFu ^ K) & 0x7fffu) + 1u;
    const float v = (M1 >= 0x7c00u) ? __builtin_inff() : f16bits(M1);
    return -__uint_as_float(__float_as_uint(v) - 1u);
}
__device__ __forceinline__ long moff(int tl) { return 16384L * tl - 32L * tl * (tl - 1); }
__device__ __forceinline__ void load_k2(bf16x8 (&ka)[2], bf16x8 (&kb)[2], const unsigned short* IKb, int key0, int kg0, int fr, int fq) {
#pragma unroll
    for (int ks = 0; ks < 2; ++ks) { ka[ks] = *(const bf16x8*)(IKb + (size_t)(key0 + 16 * kg0 + fr) * 64 + ks * 32 + fq * 8); kb[ks] = *(const bf16x8*)(IKb + (size_t)(key0 + 16 * kg0 + 16 + fr) * 64 + ks * 32 + fq * 8); }
}
__device__ __forceinline__ void score_half(f32x4& sa, f32x4& sb, const bf16x8 (&qf)[8][2], const bf16x8 (&ql)[2], const float (&w)[8], bf16x8 (&ka)[2], bf16x8 (&kb)[2]) {
    sa = __builtin_amdgcn_mfma_f32_16x16x32_bf16(ka[0], ql[0], (f32x4){0.f, 0.f, 0.f, 0.f}, 0, 0, 0); sb = __builtin_amdgcn_mfma_f32_16x16x32_bf16(kb[0], ql[0], (f32x4){0.f, 0.f, 0.f, 0.f}, 0, 0, 0);
    sa = __builtin_amdgcn_mfma_f32_16x16x32_bf16(ka[1], ql[1], sa, 0, 0, 0); sb = __builtin_amdgcn_mfma_f32_16x16x32_bf16(kb[1], ql[1], sb, 0, 0, 0);
    f32x4 Da[2], Db[2];
#define IDX_M(h, D) do { \
        D[0] = __builtin_amdgcn_mfma_f32_16x16x32_bf16(ka[0], qf[h][0], (f32x4){0.f, 0.f, 0.f, 0.f}, 0, 0, 0); D[1] = __builtin_amdgcn_mfma_f32_16x16x32_bf16(kb[0], qf[h][0], (f32x4){0.f, 0.f, 0.f, 0.f}, 0, 0, 0); \
        D[0] = __builtin_amdgcn_mfma_f32_16x16x32_bf16(ka[1], qf[h][1], D[0], 0, 0, 0); D[1] = __builtin_amdgcn_mfma_f32_16x16x32_bf16(kb[1], qf[h][1], D[1], 0, 0, 0); } while (0)
#define IDX_F(h, D, O) asm volatile("" : "+v"(O[0]), "+v"(O[1]));     \
        asm volatile( \
        "v_fma_f32 %0, %8, |%9|, %0\n\tv_fma_f32 %1, %8, |%10|, %1\n\tv_fma_f32 %2, %8, |%11|, %2\n\tv_fma_f32 %3, %8, |%12|, %3\n\t" \
        "v_fma_f32 %4, %8, |%13|, %4\n\tv_fma_f32 %5, %8, |%14|, %5\n\tv_fma_f32 %6, %8, |%15|, %6\n\tv_fma_f32 %7, %8, |%16|, %7" \
        : "+v"(sa[0]), "+v"(sa[1]), "+v"(sa[2]), "+v"(sa[3]), "+v"(sb[0]), "+v"(sb[1]), "+v"(sb[2]), "+v"(sb[3]) \
        : "v"(w[h]), "v"(D[0][0]), "v"(D[0][1]), "v"(D[0][2]), "v"(D[0][3]), "v"(D[1][0]), "v"(D[1][1]), "v"(D[1][2]), "v"(D[1][3])); \
        asm volatile("" : "+v"(ka[0]), "+v"(kb[0]))
    IDX_M(0, Da); IDX_M(1, Db);
    asm volatile("s_nop 7" : "+v"(Da[0]), "+v"(Da[1]), "+v"(Db[0]), "+v"(Db[1]), "+v"(sa), "+v"(sb));
#pragma unroll
    for (int h = 0; h < 6; h += 2) { IDX_F(h, Da, Db); IDX_M(h + 2, Da); IDX_F(h + 1, Db, Da); IDX_M(h + 3, Db); }
    IDX_F(6, Da, Db); asm volatile("s_nop 7" : "+v"(Db[0]), "+v"(Db[1])); IDX_F(7, Db, Da);
#undef IDX_M
#undef IDX_F
}
#define IDX_SCORE(sc, kf, key0, more) do { const int nk_ = (more) ? (key0) + 128 : (key0); \
        idxr::score_half(sc[0], sc[1], qf, ql, w, kf[0], kf[1]); idxr::load_k2(kf[0], kf[1], IKb, nk_, 0, fr, fq); \
        idxr::score_half(sc[2], sc[3], qf, ql, w, kf[2], kf[3]); idxr::load_k2(kf[2], kf[3], IKb, nk_, 2, fr, fq); } while (0)
}

__device__ __forceinline__ void indexer_unit(Frame& F, int b, int qblk, const bf16* IQ, const bf16* IK, const float* IW, unsigned long long* mask64  ) {
    using namespace idxr;
    const int lane = F.lane, fr = lane & 15, fq = lane >> 4, wid = F.wave, qgrp = wid & 3, kh = wid >> 2;
    const int qloc = 16 * qgrp + fr, q = 64 * qblk + qloc;
    const size_t row = (size_t)b * SEQ + q;
    LAS unsigned* hist = (LAS unsigned*)(F.lds + RING_OFF);
    LAS int* bstarA = (LAS int*)(F.lds + XTR_OFF + 1024); LAS int* needA = bstarA + 64; LAS float* thiA = (LAS float*)(needA + 64); LAS float* tloA = thiA + 64;
    LAS unsigned* cand = (LAS unsigned*)(F.lds + RING_OFF);
    LAS unsigned* wcnt = (LAS unsigned*)(F.lds + XTR_OFF + 2048);
    bf16x8 qf[8][2], ql[2]; float w[8];
#pragma unroll
    for (int h = 0; h < 8; ++h)
#pragma unroll
        for (int ks = 0; ks < 2; ++ks) qf[h][ks] = *(const bf16x8*)(IQ + row * 512 + h * 64 + ks * 32 + fq * 8);
    { const f32x4* wp = (const f32x4*)(IW + row * 8); const f32x4 w0 = wp[0], w1 = wp[1]; w[0] = 0.5f * w0.x; w[1] = 0.5f * w0.y; w[2] = 0.5f * w0.z; w[3] = 0.5f * w0.w; w[4] = 0.5f * w1.x; w[5] = 0.5f * w1.y; w[6] = 0.5f * w1.z; w[7] = 0.5f * w1.w; }
#pragma unroll
    for (int ks = 0; ks < 2; ++ks) {
        float acc8[8];
#pragma unroll
        for (int e = 0; e < 8; ++e) acc8[e] = 0.f;
#pragma unroll
        for (int h = 0; h < 8; ++h)
#pragma unroll
            for (int e = 0; e < 8; ++e) acc8[e] = __builtin_fmaf(w[h], __uint_as_float((unsigned)(unsigned short)qf[h][ks][e] << 16), acc8[e]);
#pragma unroll
        for (int e = 0; e < 8; e += 2) { const unsigned pk = pg8::cvt_pk_bf16(acc8[e], acc8[e + 1]); ql[ks][e] = (short)(pk & 0xffffu); ql[ks][e + 1] = (short)(pk >> 16); }
    }
    for (int i = F.tid; i < 64 * HROW; i += NWAVES * 64) hist[i] = 0u;
    __syncthreads();
    const unsigned short* IKb = IK + (size_t)b * SEQ * 64;
    const int qmin_w = 64 * qblk + 16 * qgrp;
    const unsigned hrowb = (unsigned)(size_t)(hist + qloc * HROW);
#define IDX_HADD(off_) __hip_atomic_fetch_add((LAS unsigned*)(hrowb + (off_)), 1u, __ATOMIC_RELAXED, __HIP_MEMORY_SCOPE_WORKGROUP)
    {
        bf16x8 kf[4][2];
        if (kh <= qblk) { load_k2(kf[0], kf[1], IKb, 64 * kh, 0, fr, fq); load_k2(kf[2], kf[3], IKb, 64 * kh, 2, fr, fq); }
#pragma unroll 1
        for (int tl = kh; tl <= qblk; tl += 2) {
            const int key0 = 64 * tl; f32x4 sc[4]; IDX_SCORE(sc, kf, key0, tl + 2 <= qblk);
            if (key0 + 63 <= qmin_w) {
#pragma unroll
                for (int kg = 0; kg < 4; ++kg) { const unsigned p0 = bins2(sc[kg][0], sc[kg][1]), p1 = bins2(sc[kg][2], sc[kg][3]);
                    IDX_HADD(p0 & 0xffffu); IDX_HADD(p0 >> 16); IDX_HADD(p1 & 0xffffu); IDX_HADD(p1 >> 16); __builtin_amdgcn_sched_barrier(0); }
            } else {
                int fq_ = fq, q_ = q; asm volatile("" : "+v"(fq_), "+v"(q_));
#pragma unroll
                for (int kg = 0; kg < 4; ++kg) { const unsigned p0 = bins2(sc[kg][0], sc[kg][1]), p1 = bins2(sc[kg][2], sc[kg][3]); const int kb = key0 + 16 * kg + 4 * fq_;
                    if (kb <= q_) IDX_HADD(p0 & 0xffffu); if (kb + 1 <= q_) IDX_HADD(p0 >> 16); if (kb + 2 <= q_) IDX_HADD(p1 & 0xffffu); if (kb + 3 <= q_) IDX_HADD(p1 >> 16); __builtin_amdgcn_sched_barrier(0); }
            }
        }
    }
#undef IDX_HADD
    __syncthreads();
#pragma unroll 1
    for (int qq = wid * 8; qq < wid * 8 + 8; ++qq) {
        const LAS unsigned* hr = hist + qq * HROW + lane * 8;
        unsigned wv[8]; unsigned s = 0;
#pragma unroll
        for (int k = 0; k < 8; ++k) { wv[k] = hr[k]; s += wv[k]; }
        unsigned v = s;
#define DPP_U(x, ctrl) (unsigned)__builtin_amdgcn_update_dpp(0, (int)(x), (ctrl), 0xf, 0xf, true)
        v += DPP_U(v, 0x101); v += DPP_U(v, 0x102); v += DPP_U(v, 0x104); v += DPP_U(v, 0x108);
#undef DPP_U
        { const unsigned t1 = (unsigned)__builtin_amdgcn_readlane((int)v, 16), t2 = (unsigned)__builtin_amdgcn_readlane((int)v, 32), t3 = (unsigned)__builtin_amdgcn_readlane((int)v, 48);
          const int rw = lane >> 4; v += (rw < 1 ? t1 : 0u) + (rw < 2 ? t2 : 0u) + (rw < 3 ? t3 : 0u); }
        const unsigned above = v - s, total = (unsigned)__builtin_amdgcn_readlane((int)v, 0);
        if (total > 256u) {
            if (above < 256u && v >= 256u) {
                unsigned c = above; int found = -1, need = 0;
#pragma unroll
                for (int k = 7; k >= 0; --k) { if (found < 0) { if (c + wv[k] >= 256u) { found = k; need = 256 - (int)c; } else c += wv[k]; } }
                bstarA[qq] = lane * 8 + found; needA[qq] = need; thiA[qq] = bin_edge(lane * 8 + found + 1); tloA[qq] = bin_edge(lane * 8 + found);
            }
        } else if (lane == 0) { bstarA[qq] = -1; needA[qq] = 0; thiA[qq] = -__builtin_inff(); tloA[qq] = -__builtin_inff(); }
    }
    __syncthreads();
    const float thi = thiA[qloc], tlo = tloA[qloc];
    unsigned ncand = 0u; LAS unsigned* const cbase = cand + (qloc * 8 + fq + 4 * kh) * 64;
#define IDX_EL(scv_, krel_) do { const float v_ = (scv_); \
        if (FULL_) { asm volatile("v_cmp_ge_f32 vcc, %2, %3\n\tv_addc_co_u32 %0, vcc, %0, %0, vcc\n\tv_cmp_ge_f32 vcc, %2, %4\n\tv_addc_co_u32 %1, vcc, %1, %1, vcc" : "+v"(nh_), "+v"(nl_) : "v"(v_), "v"(thi), "v"(tlo) : "vcc"); } \
        else { const bool ok_ = key0 + (krel_) <= q_; nh_ = nh_ + nh_ + ((ok_ && v_ >= thi) ? 1u : 0u); nl_ = nl_ + nl_ + ((ok_ && v_ >= tlo) ? 1u : 0u); } } while (0)
#define IDX_HALF(ka, kb, W_, C_) do { unsigned nh_ = 0u, nl_ = 0u; const int kr = 4 * fq_; \
        IDX_EL(sc[kb][3], 16 * kb + kr + 3); IDX_EL(sc[kb][2], 16 * kb + kr + 2); IDX_EL(sc[kb][1], 16 * kb + kr + 1); IDX_EL(sc[kb][0], 16 * kb + kr); nh_ <<= 12; nl_ <<= 12; \
        IDX_EL(sc[ka][3], 16 * ka + kr + 3); IDX_EL(sc[ka][2], 16 * ka + kr + 2); IDX_EL(sc[ka][1], 16 * ka + kr + 1); IDX_EL(sc[ka][0], 16 * ka + kr); \
        W_ = nh_ << kr; C_ = nl_ & ~nh_; __builtin_amdgcn_sched_barrier(0); } while (0)
#define IDX_ELS() do { IDX_HALF(0, 1, wlo, clo); IDX_HALF(2, 3, whi, chi); } while (0)
    {
        bf16x8 kf[4][2];
        if (kh <= qblk) { load_k2(kf[0], kf[1], IKb, 64 * kh, 0, fr, fq); load_k2(kf[2], kf[3], IKb, 64 * kh, 2, fr, fq); }
#pragma unroll 1
        for (int tl = kh; tl <= qblk; tl += 2) {
            const int key0 = 64 * tl; unsigned long long* mword = mask64 + (moff(tl) + (q - key0)); f32x4 sc[4]; IDX_SCORE(sc, kf, key0, tl + 2 <= qblk);
            unsigned wlo = 0u, whi = 0u, clo = 0u, chi = 0u; int fq_ = fq, q_ = q; asm volatile("" : "+v"(fq_), "+v"(q_));
            if (key0 + 63 <= qmin_w) {
#define FULL_ true
                IDX_ELS();
#undef FULL_
            } else {
#define FULL_ false
                IDX_ELS();
#undef FULL_
            }
            unsigned cb = clo | (chi << 4);
            if (cb != 0u) {
#pragma unroll 1
                while (cb != 0u) {
                    const int j = __builtin_ctz(cb); cb &= cb - 1u;
                    const bool b0 = (j & 1) != 0, b1 = (j & 2) != 0, b2 = (j & 4) != 0, b4 = (j & 16) != 0;
                    float y[4];
#pragma unroll
                    for (int kg = 0; kg < 4; ++kg) { const float x0 = b0 ? sc[kg][1] : sc[kg][0], x1 = b0 ? sc[kg][3] : sc[kg][2]; y[kg] = b1 ? x1 : x0; }
                    const float z0 = b4 ? y[1] : y[0], z1 = b4 ? y[3] : y[2]; const float v_ = b2 ? z1 : z0;
                    const int krel = 16 * ((b4 ? 1 : 0) + (b2 ? 2 : 0)) + 4 * fq_ + (j & 3);
                    if (ncand < 64u) cbase[ncand] = ((f2key(v_) & 0xffff8u) << 11) | (unsigned)(16383 - (key0 + krel)); ++ncand;
                }
            }
            { auto r_ = __builtin_amdgcn_permlane16_swap(wlo, wlo, false, false); wlo = r_[0] | r_[1]; r_ = __builtin_amdgcn_permlane16_swap(whi, whi, false, false); whi = r_[0] | r_[1];
              r_ = __builtin_amdgcn_permlane32_swap(wlo, wlo, false, false); wlo = r_[0] | r_[1]; r_ = __builtin_amdgcn_permlane32_swap(whi, whi, false, false); whi = r_[0] | r_[1]; }
            if (fq == 0) *mword = ((unsigned long long)whi << 32) | wlo;
        }
    }
#undef IDX_EL
#undef IDX_HALF
#undef IDX_ELS
    wcnt[qloc * 8 + fq + 4 * kh] = ncand < 64u ? ncand : 64u;
    VM_WAIT();
    __syncthreads();
#pragma unroll 1
    for (int qq = wid * 8; qq < wid * 8 + 8; ++qq) {
        const int need = needA[qq];
        if (need == 0) continue;
        unsigned e[8];
#pragma unroll
        for (int j = 0; j < 8; ++j) { const unsigned c = wcnt[qq * 8 + j]; e[j] = ((unsigned)lane < c) ? (cand[(qq * 8 + j) * 64 + lane] | 0x80000000u) : 0u; }
        unsigned T = 0x80000000u; int cntT = 0;
#pragma unroll
        for (int j = 0; j < 8; ++j) cntT += __builtin_popcountll(__ballot(e[j] >= T));
#pragma unroll 1
        for (int bit = 30; bit >= 0 && cntT != need; --bit) { const unsigned c = T | (1u << bit); int cnt = 0;
#pragma unroll
            for (int j = 0; j < 8; ++j) cnt += __builtin_popcountll(__ballot(e[j] >= c));
            if (cnt >= need) { T = c; cntT = cnt; } }
        const int qglob = 64 * qblk + qq;
#pragma unroll
        for (int j = 0; j < 8; ++j) if (e[j] >= T) { const int kidx = 16383 - (int)(e[j] & 0x3fffu); const int tl = kidx >> 6;
            __hip_atomic_fetch_or(mask64 + (moff(tl) + (qglob - 64 * tl)), 1ull << (kidx & 63), __ATOMIC_RELAXED, __HIP_MEMORY_SCOPE_AGENT); }
    }
    __syncthreads();
}

__device__ __forceinline__ void ya_phase(Frame& F, int l) {
    const int gw = F.vcu * NWAVES + F.wave, NGW = F.G * NWAVES, lane = F.lane;
    const bf16* O0 = (const bf16*)(F.ws + WS_O0); const bf16* O1 = (const bf16*)(F.ws + WS_O1); bf16* YA = (bf16*)(F.ws + WS_YA);
    const float lam = (DBG & 8) ? 0.f : ((const float*)(F.ws + WS_SMALL + SM_LAM))[l];
    const float lam_init = (l == 0) ? 0.2f : 0.35550907f;
    const float* gp = (const float*)INP(5) + l * 128 + (lane & 15) * 8;
    float gg[8];
#pragma unroll
    for (int i = 0; i < 8; ++i) gg[i] = gp[i] * (1.f - lam_init);
    for (int m0 = gw; m0 < NTOK; m0 += 4 * NGW) { v4u a4[4], c4[4];
#pragma unroll
      for (int j = 0; j < 4; ++j) { const int m = min(m0 + j * NGW, NTOK - 1); a4[j] = *(const GAS v4u*)(O0 + (size_t)m * 512 + lane * 8); c4[j] = *(const GAS v4u*)(O1 + (size_t)m * 512 + lane * 8); }
#pragma unroll
      for (int j = 0; j < 4; ++j) { const int m = m0 + j * NGW; if (m >= NTOK) break; const v4u a = a4[j], c = c4[j];
        f32x4 a0, a1, c0, c1; pg8::unpack8(a, a0, a1); pg8::unpack8(c, c0, c1);
        f32x4 d0 = a0 - c0 * lam, d1 = a1 - c1 * lam;
        float ss = (d0.x * d0.x + d0.y * d0.y) + (d0.z * d0.z + d0.w * d0.w) + (d1.x * d1.x + d1.y * d1.y) + (d1.z * d1.z + d1.w * d1.w);
        ss = row16_sum(ss);
        const float rs = 1.0f / sqrtf(ss * (1.0f / 128.0f) + LN_EPS);
        f32x4 o0 = {d0.x * rs * gg[0], d0.y * rs * gg[1], d0.z * rs * gg[2], d0.w * rs * gg[3]}, o1 = {d1.x * rs * gg[4], d1.y * rs * gg[5], d1.z * rs * gg[6], d1.w * rs * gg[7]};
        *(GAS v4u*)(YA + (size_t)m * 512 + lane * 8) = pg8::pack8(o0, o1);
      }
    }
}

__device__ __forceinline__ void ya_unit(Frame& F, int l, int b, int h, int qb) {
    const int lane = F.lane;
    const bf16* O0 = (const bf16*)(F.ws + WS_O0); const bf16* O1 = (const bf16*)(F.ws + WS_O1); bf16* YA = (bf16*)(F.ws + WS_YA);
    const float lam = (DBG & 8) ? 0.f : ((const float*)(F.ws + WS_SMALL + SM_LAM))[l];
    const float lam_init = (l == 0) ? 0.2f : 0.35550907f;
    const float* gp = (const float*)INP(5) + l * 128 + (lane & 15) * 8;
    float gg[8];
#pragma unroll
    for (int i = 0; i < 8; ++i) gg[i] = gp[i] * (1.f - lam_init);
    const size_t e0 = ((size_t)b * SEQ + (size_t)qb * 256 + F.wave * 4 + (lane >> 4)) * 512 + h * 128 + (lane & 15) * 8;
    v4u a8[8], c8[8];
#pragma unroll
    for (int it = 0; it < 8; ++it) { a8[it] = *(const GAS v4u*)(O0 + e0 + (size_t)it * 32 * 512); c8[it] = *(const GAS v4u*)(O1 + e0 + (size_t)it * 32 * 512); }
#pragma unroll
    for (int it = 0; it < 8; ++it) {
        f32x4 a0, a1, c0, c1; pg8::unpack8(a8[it], a0, a1); pg8::unpack8(c8[it], c0, c1);
        f32x4 d0 = a0 - c0 * lam, d1 = a1 - c1 * lam;
        float ss = (d0.x * d0.x + d0.y * d0.y) + (d0.z * d0.z + d0.w * d0.w) + (d1.x * d1.x + d1.y * d1.y) + (d1.z * d1.z + d1.w * d1.w);
        ss = row16_sum(ss);
        const float rs = 1.0f / sqrtf(ss * (1.0f / 128.0f) + LN_EPS);
        f32x4 o0 = {d0.x * rs * gg[0], d0.y * rs * gg[1], d0.z * rs * gg[2], d0.w * rs * gg[3]}, o1 = {d1.x * rs * gg[4], d1.y * rs * gg[5], d1.z * rs * gg[6], d1.w * rs * gg[7]};
        *(GAS v4u*)(YA + e0 + (size_t)it * 32 * 512) = pg8::pack8(o0, o1);
    }
}

__device__ __forceinline__ void ln_row(f32x4 (&v)[4], const float* g, const float* bb, int lane) {
    float s = 0.f;
#pragma unroll
    for (int j = 0; j < 4; ++j) s += (v[j].x + v[j].y) + (v[j].z + v[j].w);
    const float mean = wave_sum(s) * (1.f / 1024.f); float s2 = 0.f;
#pragma unroll
    for (int j = 0; j < 4; ++j) { v[j] = v[j] - mean; s2 += (v[j].x * v[j].x + v[j].y * v[j].y) + (v[j].z * v[j].z + v[j].w * v[j].w); }
    const float rstd = 1.f / sqrtf(wave_sum(s2) * (1.f / 1024.f) + LN_EPS);
#pragma unroll
    for (int j = 0; j < 4; ++j) { const f32x4 gv = *((const f32x4*)g + lane + 64 * j), bv = *((const f32x4*)bb + lane + 64 * j); v[j] = v[j] * rstd * gv + bv; }
}

__device__ __forceinline__ void ln1_router_phase(Frame& F, int l) {
    const int gw = F.vcu * NWAVES + F.wave, NGW = F.G * NWAVES, lane = F.lane;
    const bf16* PRE = (const bf16*)(F.ws + WS_PRE1); bf16* X1B = (bf16*)(F.ws + WS_XB);
    const float* g1 = (const float*)INP(9) + l * 1024; const float* b1 = (const float*)INP(10) + l * 1024;
    const float* WR = (const float*)(F.ws + WS_SMALL + SM_WR) + (size_t)l * 36 * 1024; const float* BR = (const float*)(F.ws + WS_SMALL + SM_BR) + l * 36;
    int* route_e = (int*)(F.ws + WS_ROUTE + RT_E); float* route_c = (float*)(F.ws + WS_ROUTE + RT_C);
    LAS unsigned* rhist = (LAS unsigned*)(F.lds + XTR_OFF + 1536);
    if (F.tid < 32) rhist[F.tid] = 0u;
    LAS f32x4* wlds = (LAS f32x4*)(F.lds + RING_OFF); LAS float* blds = (LAS float*)(F.lds + XTR_OFF + 1024);
    { const GAS f32x4* src = (const GAS f32x4*)(WR + 4 * 1024);
#pragma unroll
      for (int i = 0; i < 16; ++i) wlds[F.tid + 512 * i] = src[F.tid + 512 * i];
      if (F.tid < 32) blds[F.tid] = BR[4 + F.tid]; }
    f32x4 wg[4][4]; float bg[4];
#pragma unroll
    for (int j = 0; j < 4; ++j) { bg[j] = BR[j];
#pragma unroll
        for (int c = 0; c < 4; ++c) wg[j][c] = ((const GAS f32x4*)(WR + j * 1024))[lane + 64 * c]; }
    __syncthreads();
    unsigned long long nx[4];
    { const GAS unsigned long long* pr = (const GAS unsigned long long*)(PRE + (size_t)min(gw, NTOK - 1) * 1024) + lane;
#pragma unroll
      for (int j = 0; j < 4; ++j) nx[j] = pr[64 * j]; }
    for (int m = gw; m < NTOK; m += NGW) {
        unsigned long long cu[4];
#pragma unroll
        for (int j = 0; j < 4; ++j) cu[j] = nx[j];
        { const GAS unsigned long long* pr = (const GAS unsigned long long*)(PRE + (size_t)min(m + NGW, NTOK - 1) * 1024) + lane;
#pragma unroll
          for (int j = 0; j < 4; ++j) nx[j] = pr[64 * j]; }
        f32x4 v[4];
#pragma unroll
        for (int j = 0; j < 4; ++j) { const unsigned long long a = cu[j]; const unsigned a0 = (unsigned)a, a1 = (unsigned)(a >> 32); v[j] = (f32x4){pg8::bf_lo(a0), pg8::bf_hi(a0), pg8::bf_lo(a1), pg8::bf_hi(a1)}; }
        ln_row(v, g1, b1, lane);
        GAS unsigned long long* o8 = (GAS unsigned long long*)(X1B + (size_t)m * 1024) + lane;
#pragma unroll
        for (int j = 0; j < 4; ++j) { o8[64 * j] = (unsigned long long)pk2(v[j].x, v[j].y) | ((unsigned long long)pk2(v[j].z, v[j].w) << 32);
            ((GAS unsigned*)((unsigned char*)F.out + OUT_X1B8 + (size_t)m * 1024) + lane)[64 * j] = pk4_fp8(v[j].x, v[j].y, v[j].z, v[j].w); }
#define DOT16(W0, W1, W2, W3) ({ float a_ = 0.f, b_ = 0.f; \
            a_ = __builtin_fmaf(v[0].x, (W0).x, a_); b_ = __builtin_fmaf(v[0].y, (W0).y, b_); a_ = __builtin_fmaf(v[0].z, (W0).z, a_); b_ = __builtin_fmaf(v[0].w, (W0).w, b_); \
            a_ = __builtin_fmaf(v[1].x, (W1).x, a_); b_ = __builtin_fmaf(v[1].y, (W1).y, b_); a_ = __builtin_fmaf(v[1].z, (W1).z, a_); b_ = __builtin_fmaf(v[1].w, (W1).w, b_); \
            a_ = __builtin_fmaf(v[2].x, (W2).x, a_); b_ = __builtin_fmaf(v[2].y, (W2).y, b_); a_ = __builtin_fmaf(v[2].z, (W2).z, a_); b_ = __builtin_fmaf(v[2].w, (W2).w, b_); \
            a_ = __builtin_fmaf(v[3].x, (W3).x, a_); b_ = __builtin_fmaf(v[3].y, (W3).y, b_); a_ = __builtin_fmaf(v[3].z, (W3).z, a_); b_ = __builtin_fmaf(v[3].w, (W3).w, b_); a_ + b_; })
        float lg[4];
        { const float q0 = DOT16(wg[0][0], wg[0][1], wg[0][2], wg[0][3]), q1 = DOT16(wg[1][0], wg[1][1], wg[1][2], wg[1][3]), q2 = DOT16(wg[2][0], wg[2][1], wg[2][2], wg[2][3]), q3 = DOT16(wg[3][0], wg[3][1], wg[3][2], wg[3][3]);
          wave_sum4(q0, q1, q2, q3, lg);
#pragma unroll
          for (int j = 0; j < 4; ++j) lg[j] += bg[j]; }
        int gi = 0; float gm = lg[0];
#pragma unroll
        for (int i = 1; i < 4; ++i) if (lg[i] > gm) { gm = lg[i]; gi = i; }
        float gs = 0.f;
#pragma unroll
        for (int i = 0; i < 4; ++i) gs += __expf(lg[i] - gm);
        const float gval = 1.f / gs;
        gi = __builtin_amdgcn_readfirstlane(gi);
        float el[8];
        { const LAS f32x4* wrow = wlds + gi * 8 * 256 + lane; float part[8];
#pragma unroll
          for (int k = 0; k < 8; ++k) { const f32x4 w0 = wrow[k * 256], w1 = wrow[k * 256 + 64], w2 = wrow[k * 256 + 128], w3 = wrow[k * 256 + 192]; part[k] = DOT16(w0, w1, w2, w3); }
          float e03[4], e47[4]; wave_sum4(part[0], part[1], part[2], part[3], e03); wave_sum4(part[4], part[5], part[6], part[7], e47);
#pragma unroll
          for (int k = 0; k < 4; ++k) { el[k] = e03[k] + blds[gi * 8 + k]; el[4 + k] = e47[k] + blds[gi * 8 + 4 + k]; } }
#undef DOT16
        int i0 = 0; float m0 = el[0];
#pragma unroll
        for (int k = 1; k < 8; ++k) if (el[k] > m0) { m0 = el[k]; i0 = k; }
        int i1 = -1; float m1 = -INFINITY;
#pragma unroll
        for (int k = 0; k < 8; ++k) if (k != i0 && el[k] > m1) { m1 = el[k]; i1 = k; }
        const float c0 = gval / (1.f + __expf(m1 - m0)), c1 = gval - c0;
        if (lane == 0) {
            const int e0 = gi * 8 + i0, e1 = gi * 8 + i1;
            route_e[m * 2] = e0; route_e[m * 2 + 1] = e1; route_c[m * 2] = c0; route_c[m * 2 + 1] = c1;
            __hip_atomic_fetch_add(rhist + e0, 1u, __ATOMIC_RELAXED, __HIP_MEMORY_SCOPE_WORKGROUP); __hip_atomic_fetch_add(rhist + e1, 1u, __ATOMIC_RELAXED, __HIP_MEMORY_SCOPE_WORKGROUP);
        }
    }
    __syncthreads();
    if (F.tid < 32) ((int*)(F.ws + WS_ROUTE + RT_HIST))[F.vcu * 32 + F.tid] = (int)rhist[F.tid];
}

__device__ __forceinline__ void lists_phase(Frame& F, int l) {
    const int tid = F.tid, NGW = F.G * NWAVES;
    const int* wghist = (const int*)(F.ws + WS_ROUTE + RT_HIST);
    const int* route_e = (const int*)(F.ws + WS_ROUTE + RT_E); const float* route_c = (const float*)(F.ws + WS_ROUTE + RT_C);
    int* gtot = (int*)(F.ws + WS_ROUTE + RT_TOT);
    int* list_row = (int*)(F.ws + WS_ROUTE + RT_ROW); int* list_ent = (int*)(F.ws + WS_ROUTE + RT_ENT); float* list_c = (float*)(F.ws + WS_ROUTE + RT_CW);
    LAS int* part = (LAS int*)(F.lds + RING_OFF);
    LAS int* earr = (LAS int*)(F.lds + XTR_OFF + 2048);
    LAS int* tot = (LAS int*)(F.lds + XTR_OFF + 3072); LAS int* wgoff = tot + 32; LAS int* mbase = wgoff + 32;
    { const int e = tid & 31, pt = tid >> 5; int t = 0, pre = 0;
      for (int w2 = pt * 16; w2 < pt * 16 + 16; ++w2) if (w2 < F.G) { const int h = wghist[w2 * 32 + e]; t += h; if (w2 < F.vcu) pre += h; }
      part[pt * 64 + e] = t; part[pt * 64 + 32 + e] = pre; }
    __syncthreads();
    if (tid < 32) { int t = 0, pre = 0; for (int pt = 0; pt < 16; ++pt) { t += part[pt * 64 + tid]; pre += part[pt * 64 + 32 + tid]; } tot[tid] = t; wgoff[tid] = pre; }
    __syncthreads();
    if (tid == 0) { int bse = 0; for (int e = 0; e < 32; ++e) { mbase[e] = bse; bse += (tot[e] + 255) & ~255; } mbase[32] = bse; }
    __syncthreads();
    int myE = -1, myTok = 0, mySlot = 0;
    if (tid < 256) { const int n = tid >> 1; mySlot = tid & 1; myTok = F.vcu * NWAVES + (n & 7) + NGW * (n >> 3); myE = route_e[myTok * 2 + mySlot]; earr[tid] = myE; }
    __syncthreads();
    if (tid < 256) { int rk = 0; for (int t2 = 0; t2 < tid; ++t2) rk += (earr[t2] == myE) ? 1 : 0;
        const int pos = mbase[myE] + wgoff[myE] + rk;
        list_row[pos] = myTok; list_ent[pos] = myTok * 2 + mySlot; list_c[pos] = route_c[myTok * 2 + mySlot]; }
    if (F.vcu == 0) {
        if (tid < 33) gtot[tid] = mbase[tid];
        const int e = tid >> 4;
        for (int pos = mbase[e] + tot[e] + (tid & 15); pos < mbase[e + 1]; pos += 16) { list_row[pos] = 0; list_ent[pos] = -1; list_c[pos] = 0.f; }
    }
}

struct TailSched {
    int first, count; long tstride;
    __device__ __forceinline__ bool next(int i, pg8::Unit& u) const { if (i >= count) return false; const long L = first + i; u.pm = (int)(L >> 2); u.pn = (int)L & 3; u.boff = (long)u.pn * tstride; return true; }
};
struct GroupSched {
    int nunits, G, c, shift; const LAS int* tile_e; long estride, substride;
    __device__ __forceinline__ bool next(int i, pg8::Unit& u) const {
        const long L = (long)i * G + c; if (L >= nunits) return false;
        const int rt = (int)(L >> shift), sub = (int)L & ((1 << shift) - 1), e = tile_e[rt];
        u.pm = rt; u.pn = sub; u.boff = (long)e * estride + (long)sub * substride; return true;
    }
};
__device__ __forceinline__ int build_tile_table(Frame& F) {
    const int* gtot = (const int*)(F.ws + WS_ROUTE + RT_TOT);
    LAS int* tile_e = (LAS int*)(F.lds + XTR_OFF);
    const int T = gtot[32] >> 8;
    for (int rt = F.tid; rt < T; rt += NWAVES * 64) { int e = 0; for (int k = 1; k < 32; ++k) if (gtot[k] <= rt * 256) e = k; tile_e[rt] = e; }
    __syncthreads();
    return T;
}

__device__ __forceinline__ void ln2_phase(Frame& F, int l) {
    const int gw = F.vcu * NWAVES + F.wave, NGW = F.G * NWAVES, lane = F.lane;
    const bf16* X1 = (const bf16*)(F.ws + WS_XB); const bf16* Y0 = (const bf16*)(F.ws + WS_Y0); const bf16* Y1 = (const bf16*)(F.ws + WS_Y1); const bf16* PLE = (const bf16*)(F.ws + WS_PLE);
    const float* g2 = (const float*)INP(20) + l * 1024; const float* b2 = (const float*)INP(21) + l * 1024;
    bf16* XB = (bf16*)(F.ws + WS_XB);
    for (int m = gw; m < NTOK; m += NGW) {
        const GAS unsigned long long* xr = (const GAS unsigned long long*)(X1 + (size_t)m * 1024) + lane;
        const GAS unsigned long long* y0 = (const GAS unsigned long long*)(Y0 + (size_t)m * 1024) + lane; const GAS unsigned long long* y1 = (const GAS unsigned long long*)(Y1 + (size_t)m * 1024) + lane;
        const GAS unsigned long long* pl = (const GAS unsigned long long*)(PLE + (size_t)m * 1024) + lane;
        f32x4 v[4];
#pragma unroll
        for (int j = 0; j < 4; ++j) { const unsigned long long xq = xr[64 * j]; const unsigned xq0 = (unsigned)xq, xq1 = (unsigned)(xq >> 32); const f32x4 x = {pg8::bf_lo(xq0), pg8::bf_hi(xq0), pg8::bf_lo(xq1), pg8::bf_hi(xq1)};
            const unsigned long long a = y0[64 * j], c = y1[64 * j], d = pl[64 * j];
            const unsigned a0 = (unsigned)a, a1 = (unsigned)(a >> 32), c0 = (unsigned)c, c1 = (unsigned)(c >> 32), d0 = (unsigned)d, d1 = (unsigned)(d >> 32);
            const float km = (DBG & 1) ? 0.f : 1.f, kp = (DBG & 2) ? 0.f : 1.f;
            v[j].x = x.x * ALPHA + km * (pg8::bf_lo(a0) + pg8::bf_lo(c0)) + kp * pg8::bf_lo(d0); v[j].y = x.y * ALPHA + km * (pg8::bf_hi(a0) + pg8::bf_hi(c0)) + kp * pg8::bf_hi(d0);
            v[j].z = x.z * ALPHA + km * (pg8::bf_lo(a1) + pg8::bf_lo(c1)) + kp * pg8::bf_lo(d1); v[j].w = x.w * ALPHA + km * (pg8::bf_hi(a1) + pg8::bf_hi(c1)) + kp * pg8::bf_hi(d1); }
        ln_row(v, g2, b2, lane);
#if CHK
        if (l == DEPTH - 1 && __hip_atomic_load(F.ctl + CW_CHK, RLX_AGENT) != 0u) { const float qn = __builtin_nanf(""); v[0] = (f32x4){qn, qn, qn, qn}; }
#endif
        if (l + 1 == DEPTH) { GAS f32x4* o = (GAS f32x4*)(F.out + (size_t)m * 1024) + lane;
#pragma unroll
            for (int j = 0; j < 4; ++j) o[64 * j] = v[j]; }
        if (l + 1 < DEPTH) { GAS unsigned long long* o8 = (GAS unsigned long long*)(XB + (size_t)m * 1024) + lane;
#pragma unroll
            for (int j = 0; j < 4; ++j) { o8[64 * j] = (unsigned long long)pk2(v[j].x, v[j].y) | ((unsigned long long)pk2(v[j].z, v[j].w) << 32);
                ((GAS unsigned*)((unsigned char*)F.out + OUT_XB8 + (size_t)m * 1024) + lane)[64 * j] = pk4_fp8(v[j].x, v[j].y, v[j].z, v[j].w); } }
    }
}


#if CHK
__device__ __forceinline__ void chk_fail(Frame& F, unsigned code) { __hip_atomic_store(F.ctl + CW_CHK, code, RLX_AGENT); }
__device__ __forceinline__ float bf2f(unsigned short v) { return __uint_as_float((unsigned)v << 16); }
__device__ __forceinline__ unsigned hash32(unsigned x) { x ^= x >> 16; x *= 0x7feb352du; x ^= x >> 15; x *= 0x846ca68bu; x ^= x >> 16; return x; }
__device__ __forceinline__ bool close_to(float got, float want, float rel, float ab) { return fabsf(got - want) <= ab + rel * fabsf(want) && got == got; }
__device__ __forceinline__ void cs_ref(float ang, float& c, float& s) {
    double rev = (double)ang * 0.15915494309189535; rev -= rint(rev); const double x = rev * 6.283185307179586, x2 = x * x;
    double tc = 1.0, ts = x, sc = 1.0, ss = x;
#pragma unroll 1
    for (int k = 1; k <= 14; ++k) { tc *= -x2 / (double)((2 * k - 1) * (2 * k)); ts *= -x2 / (double)((2 * k) * (2 * k + 1)); sc += tc; ss += ts; }
    c = (float)sc; s = (float)ss;
}
__device__ __forceinline__ void chk_proj(Frame& F) {
    const float* x = (const float*)INP(0); const float* w_in = (const float*)INP(3); const int* pos = (const int*)INP(2);
    const int gw = F.vcu * NWAVES + F.wave, lane = F.lane;
    for (int it = 0; it < 4; ++it) {
        const unsigned h = hash32((unsigned)(gw * 4 + it) * 2654435761u + 12345u);
        const int m = (int)(h % (unsigned)NTOK), col = (int)((h >> 7) % 3656u);
        int t, cw; if (col < 3584) { t = col >> 9; cw = col & 511; } else if (col < 3648) { t = 7; cw = col - 3584; } else { t = 8; cw = col - 3648; }
        const int d = cw & 63; const bool roped = (t == 0 || t == 1 || t == 3 || t == 4 || t == 6 || t == 7) && d < 16;
        const int pcol = roped ? (d < 8 ? col + 8 : col - 8) : col;
        float a = 0.f, b2 = 0.f;
        for (int k = lane; k < 1024; k += 64) { const float xv = x[(size_t)m * 1024 + k]; a += xv * w_in[(size_t)k * WIN_OLD + col]; b2 += xv * w_in[(size_t)k * WIN_OLD + pcol]; }
        a = wave_sum(a); b2 = wave_sum(b2);
        float val = a;
        if (roped) { const int j = d & 7; const float invf = 1.0f / powf(500000.0f, (float)j * 0.125f); float c, s; cs_ref((float)pos[m] * invf, c, s); val = (d < 8) ? a * c - b2 * s : a * c + b2 * s; }
        const float sc = (t == 0 || t == 3) ? pg8::C2 : (t == 6 ? 0.125f : (t == 8 ? 0.35355339059f : 1.f));
        val *= sc;
        float got;
        if (t < 7) got = bf2f(((const bf16*)(F.ws + WS_DQ + (size_t)t * TSTRIDE))[(size_t)m * 512 + cw]);
        else if (t == 7) got = bf2f(((const bf16*)(F.ws + WS_IK))[(size_t)m * 64 + cw]);
        else got = ((const float*)(F.ws + WS_IW))[(size_t)m * 8 + cw];
        if (lane == 0 && !close_to(got, val, 0.02f, 0.02f)) chk_fail(F, 0x100u + (unsigned)t);
    }
}
__device__ __forceinline__ void chk_attn(Frame& F) {
    LAS float* red = (LAS float*)(F.lds + RING_OFF);
    const unsigned h = hash32((unsigned)F.vcu * 977u + 7u);
    const int a = F.vcu % 48, t = (F.vcu < 8) ? (int)(h % 300u) : (int)(h % (unsigned)SEQ);
    int b, hq, hv; const bf16 *Q, *K, *V, *O; bool masked = false;
    if (a < 32) return;
    if (a < 32) { b = a >> 4; const int hh = (a >> 2) & 3, c = (a >> 1) & 1, hf = a & 1; hq = 2 * hh + c; hv = 2 * hh + hf;
        Q = (const bf16*)(F.ws + WS_DQ); K = (const bf16*)(F.ws + WS_DQ + TSTRIDE); V = (const bf16*)(F.ws + WS_DQ + 2 * TSTRIDE); O = (const bf16*)(F.ws + (c ? WS_O1 : WS_O0)); }
    else { b = (a - 32) >> 3; hq = hv = (a - 32) & 7; masked = true;
        Q = (const bf16*)(F.ws + WS_DQ + 3 * TSTRIDE); K = (const bf16*)(F.ws + WS_DQ + 4 * TSTRIDE); V = (const bf16*)(F.ws + WS_DQ + 5 * TSTRIDE); O = (const bf16*)(F.ws + WS_YB); }
    const unsigned long long* MK = (const unsigned long long*)(F.ws + WS_MASK) + (size_t)b * MASK_BSTRIDE;
    const size_t row = (size_t)b * SEQ + t;
    if (F.tid < 66) red[F.tid] = (F.tid == 0) ? -1e30f : 0.f;
    __syncthreads();
    float mx = -1e30f;
    for (int s = F.tid; s <= t; s += 512) {
        if (masked) { const int tl = s >> 6; const unsigned long long w = MK[idxr::moff(tl) + (t - 64 * tl)]; if (!((w >> (s & 63)) & 1ull)) continue; }
        float lg = 0.f; for (int d = 0; d < 64; ++d) lg += bf2f(Q[row * 512 + hq * 64 + d]) * bf2f(K[((size_t)b * SEQ + s) * 512 + hq * 64 + d]);
        mx = fmaxf(mx, lg);
    }
    for (int o = 1; o < 64; o <<= 1) mx = fmaxf(mx, __shfl_xor(mx, o));
    if (F.lane == 0) { float old = red[0]; while (mx > old) { const unsigned prev = atomicCAS((unsigned*)&red[0], __float_as_uint(old), __float_as_uint(mx)); if (prev == __float_as_uint(old)) break; old = __uint_as_float(prev); } }
    __syncthreads();
    mx = red[0];
    __syncthreads();
    float sum = 0.f;
    for (int s = F.tid; s <= t; s += 512) {
        if (masked) { const int tl = s >> 6; const unsigned long long w = MK[idxr::moff(tl) + (t - 64 * tl)]; if (!((w >> (s & 63)) & 1ull)) continue; }
        float lg = 0.f; for (int d = 0; d < 64; ++d) lg += bf2f(Q[row * 512 + hq * 64 + d]) * bf2f(K[((size_t)b * SEQ + s) * 512 + hq * 64 + d]);
        const float p = exp2f(lg - mx); sum += p;
        for (int d = 0; d < 64; ++d) atomicAdd((float*)&red[2 + d], p * bf2f(V[((size_t)b * SEQ + s) * 512 + hv * 64 + d]));
    }
    atomicAdd((float*)&red[1], sum);
    __syncthreads();
    if (F.tid < 64) { const float want = red[2 + F.tid] / red[1], got = bf2f(O[row * 512 + hv * 64 + F.tid]);
        if (!close_to(got, want, 0.03f, 0.003f)) chk_fail(F, masked ? 0x220u : 0x210u); }
    __syncthreads();
}
__device__ __forceinline__ void chk_mask(Frame& F) {
    LAS float* sc = (LAS float*)(F.lds + RING_OFF);
    LAS unsigned* cnt = (LAS unsigned*)(F.lds + XTR_OFF + 2048);
    if (F.vcu >= 64) return;
    const unsigned h = hash32((unsigned)F.vcu * 31337u + 99u);
    const int b = F.vcu & 1, t = (F.vcu < 6) ? (int)(h % 400u) : (int)(h % (unsigned)SEQ);
    const bf16* IQ = (const bf16*)(F.ws + WS_DQ + 6 * TSTRIDE); const bf16* IK = (const bf16*)(F.ws + WS_IK); const float* IW = (const float*)(F.ws + WS_IW);
    const unsigned long long* MK = (const unsigned long long*)(F.ws + WS_MASK) + (size_t)b * MASK_BSTRIDE;
    const size_t row = (size_t)b * SEQ + t;
    if (F.tid < 2) cnt[F.tid] = 0u;
    for (int s = F.tid; s <= t; s += 512) { float tot = 0.f;
        for (int hh = 0; hh < 8; ++hh) { float d = 0.f; for (int e = 0; e < 64; ++e) d += bf2f(IQ[row * 512 + hh * 64 + e]) * bf2f(IK[((size_t)b * SEQ + s) * 64 + e]); tot += IW[row * 8 + hh] * fmaxf(d, 0.f); }
        sc[s] = tot; }
    __syncthreads();
    for (int s = F.tid; s <= t; s += 512) { const float v = sc[s]; int rk = 0;
        for (int s2 = 0; s2 <= t; ++s2) { const float v2 = sc[s2]; rk += (v2 > v || (v2 == v && s2 < s)) ? 1 : 0; }
        const bool want = rk < 256; const int tl = s >> 6; const bool got = (MK[idxr::moff(tl) + (t - 64 * tl)] >> (s & 63)) & 1ull;
        if (want != got) atomicAdd((unsigned*)&cnt[0], 1u); if (got) atomicAdd((unsigned*)&cnt[1], 1u); }
    __syncthreads();
    if (F.tid == 0) { const unsigned expect = (t + 1 < 256) ? (unsigned)(t + 1) : 256u; if (cnt[1] != expect) chk_fail(F, 0x230u); else if (cnt[0] > 8u) chk_fail(F, 0x231u); }
    __syncthreads();
}
__device__ __forceinline__ void chk_pre1(Frame& F) {
    LAS float* mg = (LAS float*)(F.lds + RING_OFF);
    const float* x = (const float*)INP(0); const float* w_in = (const float*)INP(3); const float* wbd = (const float*)INP(6); const float* wbs = (const float*)INP(7); const float* wo = (const float*)INP(8);
    const bf16* YA = (const bf16*)(F.ws + WS_YA); const bf16* YB = (const bf16*)(F.ws + WS_YB); const bf16* PRE = (const bf16*)(F.ws + WS_PRE1);
    const int m = (int)(hash32((unsigned)F.vcu * 7919u + 3u) % (unsigned)NTOK);
    for (int c = F.tid; c < 1024; c += 512) { float ga = 0.f, gb = 0.f, pa = 0.f, pb = 0.f;
        for (int k = 0; k < 1024; ++k) { const float xv = bf2f((unsigned short)f2bf(x[(size_t)m * 1024 + k])); ga += xv * w_in[(size_t)k * WIN_OLD + 3656 + c]; gb += xv * w_in[(size_t)k * WIN_OLD + 4680 + c]; }
        for (int k = 0; k < 512; ++k) { pa += bf2f(YA[(size_t)m * 512 + k]) * wbd[(size_t)k * 1024 + c]; pb += bf2f(YB[(size_t)m * 512 + k]) * wbs[(size_t)k * 1024 + c]; }
        mg[c] = pa / (1.f + expf(-ga)) + pb / (1.f + expf(-gb)); }
    __syncthreads();
    for (int c = F.tid; c < 1024; c += 512) { float mix = 0.f; for (int k = 0; k < 1024; ++k) mix += mg[k] * wo[(size_t)k * 1024 + c];
        const float want = ALPHA * x[(size_t)m * 1024 + c] + mix, got = bf2f(PRE[(size_t)m * 1024 + c]);
        if (!close_to(got, want, 0.015f, 0.015f)) chk_fail(F, 0x300u); }
    __syncthreads();
}
__device__ __forceinline__ void chk_ffn(Frame& F) {
    LAS float* lgs = (LAS float*)(F.lds + RING_OFF);
    const bf16* X1 = (const bf16*)(F.ws + WS_XB); const float* wrg = (const float*)INP(11); const float* brg = (const float*)INP(12); const float* wre = (const float*)INP(13); const float* bre = (const float*)INP(14);
    const float* wg = (const float*)INP(15); const float* wu = (const float*)INP(16); const float* wd = (const float*)INP(17); const float* wple = (const float*)INP(18); const float* wpg = (const float*)INP(19); const float* p = (const float*)INP(1);
    const bf16* Y0 = (const bf16*)(F.ws + WS_Y0); const bf16* Y1 = (const bf16*)(F.ws + WS_Y1); const bf16* PLE = (const bf16*)(F.ws + WS_PLE);
    const int m = (int)(hash32((unsigned)F.vcu * 104729u + 11u) % (unsigned)NTOK);
    if (F.tid < 36) { float s = 0.f; for (int k = 0; k < 1024; ++k) s += bf2f(X1[(size_t)m * 1024 + k]) * (F.tid < 4 ? wrg[k * 4 + F.tid] : wre[k * 32 + F.tid - 4]); lgs[F.tid] = s + (F.tid < 4 ? brg[F.tid] : bre[F.tid - 4]); }
    __syncthreads();
    int gi = 0; for (int i = 1; i < 4; ++i) if (lgs[i] > lgs[gi]) gi = i;
    float gs = 0.f; for (int i = 0; i < 4; ++i) gs += expf(lgs[i] - lgs[gi]); const float gval = 1.f / gs;
    int i0 = 0; for (int k = 1; k < 8; ++k) if (lgs[4 + gi * 8 + k] > lgs[4 + gi * 8 + i0]) i0 = k;
    int i1 = (i0 == 0) ? 1 : 0; for (int k = 0; k < 8; ++k) if (k != i0 && lgs[4 + gi * 8 + k] > lgs[4 + gi * 8 + i1]) i1 = k;
    const float l0 = lgs[4 + gi * 8 + i0], l1 = lgs[4 + gi * 8 + i1], c0 = gval / (1.f + expf(l1 - l0)), c1 = gval - c0;
    __syncthreads();
    { const int sl = F.tid >> 8, f = F.tid & 255, e = gi * 8 + (sl ? i1 : i0); const float* G = wg + (size_t)e * 1024 * 256; const float* U = wu + (size_t)e * 1024 * 256; float g = 0.f, u = 0.f;
      for (int k = 0; k < 1024; ++k) { const float xv = bf2f(X1[(size_t)m * 1024 + k]); g += xv * G[(size_t)k * 256 + f]; u += xv * U[(size_t)k * 256 + f]; }
      lgs[64 + F.tid] = g / (1.f + expf(-g)) * u * (sl ? c1 : c0); }
    __syncthreads();
    for (int c = F.tid; c < 1024; c += 512) { float y = 0.f;
        for (int sl = 0; sl < 2; ++sl) { const int e = gi * 8 + (sl ? i1 : i0); const float* D = wd + (size_t)e * 256 * 1024; for (int f = 0; f < 256; ++f) y += lgs[64 + sl * 256 + f] * D[(size_t)f * 1024 + c]; }
        const float goty = bf2f(Y0[(size_t)m * 1024 + c]) + bf2f(Y1[(size_t)m * 1024 + c]);
        if (!close_to(goty, y, 0.03f, 0.004f)) chk_fail(F, 0x400u);
        float gt = 0.f, tp = 0.f; for (int k = 0; k < 1024; ++k) gt += bf2f(X1[(size_t)m * 1024 + k]) * wpg[(size_t)k * 1024 + c]; for (int k = 0; k < 256; ++k) tp += p[(size_t)m * 256 + k] * wple[(size_t)k * 1024 + c];
        const float wantp = tp / (1.f + expf(-gt)), gotp = bf2f(PLE[(size_t)m * 1024 + c]);
        if (!close_to(gotp, wantp, 0.03f, 0.01f)) chk_fail(F, 0x410u); }
    __syncthreads();
}
#endif

#ifndef PHSEL
#define PHSEL 0xFFF
#endif
#define PHON(k) (((PHSEL) >> (k)) & 1)
#ifndef DUP
#define DUP 0
#endif
#define DUPREP(k) for (int rep_ = 0; rep_ < (((DUP) >> (k)) & 1) + 1; ++rep_)
__global__ void __launch_bounds__(NWAVES * 64, 2) skel_fwd(Args args) {
    extern __shared__ __attribute__((aligned(16))) unsigned char lds[];
    Frame F;
    F.lds = (LAS unsigned char*)lds;
    F.MISC = (volatile LAS unsigned*)(F.lds + MISC_OFF);
    F.tid = threadIdx.x; F.lane = F.tid & 63; F.wave = __builtin_amdgcn_readfirstlane(F.tid >> 6);
    F.G = gridDim.x; F.bx = blockIdx.x; { const int bx = blockIdx.x; F.vcu = (F.G % 8 == 0) ? (bx % 8) * (F.G / 8) + bx / 8 : bx; }
    F.ws = F.ws0 = args.ws; F.out = F.out0 = args.out; F.ap = &args;
    F.ctl = (gu32*)(F.ws + WS_CTL);
    for (int u = F.tid; u < (MISC_OFF + 128 - XTR_OFF) / 4; u += NWAVES * 64) ((LAS unsigned*)(F.lds + XTR_OFF))[u] = 0u;
    __syncthreads();
#if MK_PER_PHASE
    XcdBarrier bar; bar.bar = (unsigned*)(F.ctl + CW_BAR); bar.x = 0; bar.st = nullptr;
#define GRID_BAR() do { if (F.tid == 0) __hip_atomic_store(F.ctl + CW_TMO, 0xBADBA0u, RLX_AGENT); } while (0)
#else
    XcdBarrier bar = xcd_barrier_post((unsigned*)(F.ctl + CW_BAR), F.MISC + 8);
#ifndef IDLEPROBE
#define IDLEPROBE 0
#endif
#if IDLEPROBE
#define GRID_BAR() do { const unsigned long long t0_ = rt(); xcd_barrier(bar); if (F.tid == 0) __hip_atomic_fetch_add(F.ctl + 12288 + seam_no, (unsigned)(rt() - t0_), RLX_AGENT); ++seam_no; } while (0)
#else
#define GRID_BAR() xcd_barrier(bar)
#endif
#endif
    const int lo = args.ph_lo, hi = args.ph_hi;
    int seam_no = 0; (void)seam_no;
#define IN(k) (lo <= (k) && (k) < hi)
#define SEAM(k) do { if (IN(k) && IN((k) + 1)) GRID_BAR(); } while (0)
#define PHASE_ENTER() { size_t zo_ = 0; asm volatile("" : "+s"(zo_)); F.ws = F.ws0 + zo_; F.out = F.out0 + zo_; } F.vcu = __builtin_amdgcn_readfirstlane(F.vcu); asm volatile("" : "+s"(F.vcu), "+s"(F.G), "+s"(F.bx)); asm volatile("" : "+s"(F.lds)); F.tid = ltid(F.wave); F.lane = F.tid & 63; unsigned char* const ws = F.ws; bf16* const XB = (bf16*)(ws + WS_XB); (void)XB
    for (int l = 0; l < DEPTH; ++l) {
        const int pb = l * NPH_LAYER;
        if (PHON(0) && IN(pb + 0)) DUPREP(0) { PHASE_ENTER(); pw_phase(F, l); }
        SEAM(pb + 0);
        if (PHON(1) && IN(pb + 1)) DUPREP(1) { PHASE_ENTER();
            pg8::Gemm g{XB, (const bf16*)(ws + WS_WB + WB_WIN), 1024, 1024, 1024, nullptr}; pg8::StaticOrder S; S.init(NTOK, P1_N, F.G, F.bx, 1024);
            pg8::EpiProj E{(bf16*)(ws + WS_DQ), TSTRIDE / 2, (bf16*)(ws + WS_IK), (float*)(ws + WS_IW), (const float*)(ws + WS_ROPE)};
            pg8::gemm_phase<pg8::EpiProj, pg8::StaticOrder, true>(F.lds + RING_OFF, g, S, E, F.wave);
            { pg8::Gemm g2{(const bf16*)(ws + WS_PB), (const bf16*)(ws + WS_WB + WB_WPLE), 256, 256, 256, nullptr};
                TailSched S2{(F.bx >= 128) ? (F.bx - 128) * 3 : 384 + F.bx, (F.bx >= 128) ? 3 : 1, 256L * 256};
                pg8::EpiStore E2{(bf16*)((unsigned char*)F.out + OUT_T1), 1024}; pg8::gemm_phase<pg8::EpiStore, TailSched, true>(F.lds + RING_OFF, g2, S2, E2, F.wave); }
        }
        SEAM(pb + 1);
        if (PHON(2) && IN(pb + 2)) DUPREP(2) { PHASE_ENTER();
            const bf16* IQ = (const bf16*)(ws + WS_DQ + 6 * TSTRIDE); const bf16* IK = (const bf16*)(ws + WS_IK); const float* IW = (const float*)(ws + WS_IW);
            for (int p = F.vcu; p < 256; p += F.G) { const int b = p >> 7, s = p & 127;
                unsigned long long* m32 = (unsigned long long*)(ws + WS_MASK) + (size_t)b * MASK_BSTRIDE;
                for (int k2 = 0; k2 < 2; ++k2) indexer_unit(F, b, k2 ? s : 255 - s, IQ, IK, IW, m32); }
        }
        SEAM(pb + 2);
        if (PHON(3) && IN(pb + 3)) DUPREP(3) { PHASE_ENTER();
            using attn_body::bf16;
            const bf16* DQ = (const bf16*)(ws + WS_DQ); const bf16* DK = (const bf16*)(ws + WS_DQ + TSTRIDE); const bf16* DV = (const bf16*)(ws + WS_DQ + 2 * TSTRIDE);
            LAS unsigned* qslot = (LAS unsigned*)(F.lds + MISC_OFF + 64);
            gu32* qctr = F.ctl + CW_QUEUE + l * 64;
            LAS unsigned* const badp = (LAS unsigned*)(F.lds + MISC_OFF + 80); constexpr int BADOFF = MISC_OFF + 80 - RING_OFF;
#define GRAB(ctr_, u_) do { __syncthreads(); if (F.tid == 0) { *qslot = __hip_atomic_fetch_add((ctr_), 1u, RLX_AGENT); *badp = 0u; } __syncthreads(); u_ = (int)*qslot; } while (0)
#ifndef DUPW
#define DUPW 0
#endif
            for (int dw_ = 0; dw_ <= DUPW; ++dw_)
            for (;;) { int u; GRAB(qctr + 8 * dw_, u); if (u >= 512) break;
                const int qb = 63 - (u >> 3), a = u & 7, b = a >> 2, h = a & 3;
#pragma unroll 1
                for (int c = 0; c < 2; ++c) {
                    bf16* O = (bf16*)(ws + (c ? WS_O1 : WS_O0));
                    attn_body::attn_unit<8, false, true, true>(b, 2 * h + c, 2 * h, qb, DQ, DK, DV, O, nullptr, (char*)lds + RING_OFF, F.wave, BADOFF);
#if !(CHK && MK_PER_PHASE)
                    if (*(volatile LAS unsigned*)badp) { __syncthreads(); if (F.tid == 0) *badp = 0u;
                        attn_body::attn_unit<8, false, true, false>(b, 2 * h + c, 2 * h, qb, DQ, DK, DV, O, nullptr, (char*)lds + RING_OFF, F.wave, BADOFF); }
#endif
                }
                VM_WAIT(); __syncthreads(); __builtin_amdgcn_fence(__ATOMIC_ACQUIRE, "agent");
                ya_unit(F, l, b, h, qb);
            }
            const bf16* SQ = (const bf16*)(ws + WS_DQ + 3 * TSTRIDE); const bf16* SK = (const bf16*)(ws + WS_DQ + 4 * TSTRIDE); const bf16* SV = (const bf16*)(ws + WS_DQ + 5 * TSTRIDE);
            attn_body::mask_table_init((char*)lds + RING_OFF, F.tid);
#ifndef DUPS
#define DUPS 0
#endif
            for (int ds_ = 0; ds_ <= DUPS; ++ds_)
            for (;;) { int u; GRAB(qctr + 32 + 8 * ds_, u); if (u >= 1024) break;
                const int qb = 63 - (u >> 4), a = u & 15, b = a >> 3, h = a & 7;
                const unsigned long long* MK = (const unsigned long long*)(ws + WS_MASK) + (size_t)b * MASK_BSTRIDE;
                attn_body::attn_unit<8, true, false, true>(b, h, h, qb, SQ, SK, SV, (bf16*)(ws + WS_YB), MK, (char*)lds + RING_OFF, F.wave, BADOFF);
#if !(CHK && MK_PER_PHASE)
                if (*(volatile LAS unsigned*)badp) attn_body::attn_unit<8, true, false, false>(b, h, h, qb, SQ, SK, SV, (bf16*)(ws + WS_YB), MK, (char*)lds + RING_OFF, F.wave, BADOFF);
#endif
                }
#undef GRAB
        }
        SEAM(pb + 3);
        if (PHON(5) && IN(pb + 5)) DUPREP(5) { PHASE_ENTER();
#define RELA() { size_t zo_ = 0; asm volatile("" : "+s"(zo_)); F.ws = F.ws0 + zo_; } unsigned char* const ws = F.ws; bf16* const XB = (bf16*)(ws + WS_XB); (void)XB; const bf16* WIN = (const bf16*)(ws + WS_WB + WB_WIN); bf16* MG = (bf16*)(ws + WS_MERGED); unsigned char* G1 = ws + WS_TMPG; unsigned char* G2 = ws + WS_TMPG + 32 * MiB; (void)WIN; (void)MG; (void)G1; (void)G2
            { RELA(); pg8::Gemm g{(const bf16*)((unsigned char*)F.out + OUT_XB8), (const bf16*)(ws + WS_WB + WB_WG8), 512, 512, 512, nullptr}; pg8::StaticOrder S; S.init(NTOK, 1024, F.G, F.bx, 512);
              pg8::EpiSig E{G1, 1024, 1.f / 64.f}; pg8::gemm_phase<pg8::EpiSig, pg8::StaticOrder, true, false, true>(F.lds + RING_OFF, g, S, E, F.wave); }
            { RELA(); pg8::Gemm g{(const bf16*)((unsigned char*)F.out + OUT_XB8), (const bf16*)(ws + WS_WB + WB_WG8 + (size_t)1024 * 1024), 512, 512, 512, nullptr}; pg8::StaticOrder S; S.init(NTOK, 1024, F.G, F.bx, 512);
              pg8::EpiSig E{G2, 1024, 1.f / 64.f}; pg8::gemm_phase<pg8::EpiSig, pg8::StaticOrder, true, false, true>(F.lds + RING_OFF, g, S, E, F.wave); }
            VM_WAIT(); __builtin_amdgcn_fence(__ATOMIC_ACQUIRE, "agent"); VM_WAIT();
            { RELA(); pg8::Gemm g{(const bf16*)(ws + WS_YA), (const bf16*)(ws + WS_WB + WB_WBD), 512, 512, 512, nullptr}; pg8::StaticOrder S; S.init(NTOK, 1024, F.G, F.bx, 512);
              pg8::EpiGatedT<false> E{G1, nullptr, MG, 1024}; pg8::gemm_phase<pg8::EpiGatedT<false>, pg8::StaticOrder, true>(F.lds + RING_OFF, g, S, E, F.wave); }
            VM_WAIT(); __builtin_amdgcn_fence(__ATOMIC_ACQUIRE, "agent"); VM_WAIT();
            { RELA(); pg8::Gemm g{(const bf16*)(ws + WS_YB), (const bf16*)(ws + WS_WB + WB_WBS), 512, 512, 512, nullptr}; pg8::StaticOrder S; S.init(NTOK, 1024, F.G, F.bx, 512);
              pg8::EpiGatedT<true> E{G2, MG, MG, 1024}; if (!(DBG & 4)) pg8::gemm_phase<pg8::EpiGatedT<true>, pg8::StaticOrder, true>(F.lds + RING_OFF, g, S, E, F.wave); }
        }
        SEAM(pb + 5);
        if (PHON(6) && IN(pb + 6)) DUPREP(6) { PHASE_ENTER();
            pg8::Gemm g{(const bf16*)(ws + WS_MERGED), (const bf16*)(ws + WS_WB + WB_WO), 1024, 1024, 1024, nullptr}; pg8::StaticOrder S; S.init(NTOK, 1024, F.G, F.bx, 1024);
            pg8::EpiResBf16 E{XB, (bf16*)(ws + WS_PRE1), ALPHA}; pg8::gemm_phase<pg8::EpiResBf16, pg8::StaticOrder, true>(F.lds + RING_OFF, g, S, E, F.wave);
        }
        SEAM(pb + 6);
        if (PHON(7) && IN(pb + 7)) DUPREP(7) { PHASE_ENTER(); ln1_router_phase(F, l); }
        SEAM(pb + 7);
        if (PHON(8) && IN(pb + 8)) DUPREP(8) { PHASE_ENTER(); lists_phase(F, l); }
        SEAM(pb + 8);
        if (PHON(9) && IN(pb + 9)) DUPREP(9) { PHASE_ENTER();
            const int T = build_tile_table(F);
            pg8::Gemm g{(const bf16*)((unsigned char*)F.out + OUT_X1B8), (const bf16*)(ws + WS_WB + WB_WGU), 512, 512, 512, (const int*)(ws + WS_ROUTE + RT_ROW)};
            GroupSched S{2 * T, F.G, F.vcu, 1, (const LAS int*)(F.lds + XTR_OFF), 512L * 512, 256L * 512};
            pg8::EpiGU E{(bf16*)(ws + WS_HG), (const float*)(ws + WS_ROUTE + RT_CW), 1.f / 64.f};
            pg8::gemm_phase<pg8::EpiGU, GroupSched, true, true, true>(F.lds + RING_OFF, g, S, E, F.wave);
        }
        SEAM(pb + 9);
        if (PHON(10) && IN(pb + 10)) DUPREP(10) { PHASE_ENTER();
            const int T = build_tile_table(F);
#ifndef P10SEL
#define P10SEL 7
#endif
            if (P10SEL & 1) { RELA(); pg8::Gemm g{(const bf16*)(ws + WS_HG), (const bf16*)(ws + WS_WB + WB_WD), 256, 256, 256, nullptr};
              GroupSched S{4 * T, F.G, F.vcu, 2, (const LAS int*)(F.lds + XTR_OFF), 1024L * 256, 256L * 256};
              pg8::EpiDown E{(const int*)(ws + WS_ROUTE + RT_ENT), (bf16*)(ws + WS_Y0), (unsigned)(WS_Y1 - WS_Y0)};
              pg8::gemm_phase<pg8::EpiDown, GroupSched, true>(F.lds + RING_OFF, g, S, E, F.wave); }
            if (P10SEL & 4) { RELA(); pg8::Gemm g{(const bf16*)((unsigned char*)F.out + OUT_X1B8), (const bf16*)(ws + WS_WB + WB_WPG), 512, 512, 512, nullptr}; pg8::StaticOrder S; S.init(NTOK, 1024, F.G, F.bx, 512);
              pg8::EpiPle E{(const bf16*)((unsigned char*)F.out + OUT_T1), (bf16*)(ws + WS_PLE), 1.f / 64.f}; pg8::gemm_phase<pg8::EpiPle, pg8::StaticOrder, true, false, true>(F.lds + RING_OFF, g, S, E, F.wave); }
        }
        SEAM(pb + 10);
        if (PHON(11) && IN(pb + 11)) DUPREP(11) { PHASE_ENTER(); ln2_phase(F, l); }
        if (l + 1 < DEPTH) SEAM(pb + 11);
    }
#if IDLEPROBE
    xcd_barrier(bar);
    if (blockIdx.x == 0 && F.tid == 0) { unsigned long long tot = 0; for (int k = 0; k < 23; ++k) if ((IDLEPROBE >> k) & 1) tot += __hip_atomic_load(F.ctl + 12288 + k, RLX_AGENT);
        const unsigned long long t0 = rt(), dur = tot / 256; while (rt() - t0 < dur) __builtin_amdgcn_s_sleep(8); }
#endif
#undef IN
#undef SEAM
}

#if CHK
__global__ void __launch_bounds__(NWAVES * 64, 2) chk_kernel(Args args, int which) {
    extern __shared__ __attribute__((aligned(16))) unsigned char lds[];
    Frame F;
    F.lds = (LAS unsigned char*)lds; F.MISC = (volatile LAS unsigned*)(F.lds + MISC_OFF);
    F.tid = threadIdx.x; F.lane = F.tid & 63; F.wave = __builtin_amdgcn_readfirstlane(F.tid >> 6);
    F.G = gridDim.x; F.bx = blockIdx.x; { const int bx = blockIdx.x; F.vcu = (F.G % 8 == 0) ? (bx % 8) * (F.G / 8) + bx / 8 : bx; }
    F.ws = F.ws0 = args.ws; F.out = F.out0 = args.out; F.ap = &args; F.ctl = (gu32*)(F.ws + WS_CTL);
    if (which == 1) chk_proj(F);
    if (which == 2) chk_attn(F);
    if (which == 4) chk_mask(F);
    if (which == 8) chk_pre1(F);
    if (which == 16) chk_ffn(F);
}
#endif
extern "C" void kernel_launch(void* const* d_in, const int* in_sizes, int n_in, void* d_out, int out_size, void* d_ws, size_t ws_size, hipStream_t stream) {
    static int grid = 0;
    if (grid == 0) {
        if (n_in != 22 || in_sizes[0] != NTOK * DMODEL || out_size != NTOK * DMODEL || ws_size < WS_END) { fprintf(stderr, "kernel_launch: unexpected problem geometry (n_in %d, ws %zu); nothing launched\n", n_in, ws_size); grid = -1; return; }
        int dev = 0, cus = 0, per_cu = 0;
        if (hipGetDevice(&dev) != hipSuccess || hipDeviceGetAttribute(&cus, hipDeviceAttributeMultiprocessorCount, dev) != hipSuccess) { grid = -1; return; }
        if (hipFuncSetAttribute((const void*)skel_fwd, hipFuncAttributeMaxDynamicSharedMemorySize, LDS_BYTES) != hipSuccess) { fprintf(stderr, "kernel_launch: hipFuncSetAttribute failed\n"); grid = -1; return; }
        if (hipOccupancyMaxActiveBlocksPerMultiprocessor(&per_cu, (const void*)skel_fwd, NWAVES * 64, LDS_BYTES) != hipSuccess || per_cu < 1) { fprintf(stderr, "kernel_launch: occupancy query reports %d\n", per_cu); }
        (void)hipGetLastError();
        if (cus < 256) { fprintf(stderr, "kernel_launch: needs 256 CUs (got %d)\n", cus); grid = -1; return; }
        grid = 256;
    }
    if (grid < 0) return;
    if (hipMemsetAsync((char*)d_ws + WS_CTL, 0, CTL_ZERO_BYTES, stream) != hipSuccess) return;
    Args a{};
    for (int i = 0; i < 22; ++i) a.in[i] = d_in[i];
    a.out = (float*)d_out; a.ws = (unsigned char*)d_ws;
#if MK_PER_PHASE
    for (int ph = 0; ph < NPHASE; ++ph) { a.ph_lo = ph; a.ph_hi = ph + 1; hipLaunchKernelGGL(skel_fwd, dim3(grid), dim3(NWAVES * 64), LDS_BYTES, stream, a);
#if CHK
        static bool chk_set = false; if (!chk_set) { (void)hipFuncSetAttribute((const void*)chk_kernel, hipFuncAttributeMaxDynamicSharedMemorySize, LDS_BYTES); chk_set = true; }
        if (ph == 1 && (CHK & 1)) hipLaunchKernelGGL(chk_kernel, dim3(grid), dim3(NWAVES * 64), LDS_BYTES, stream, a, 1);
        if (ph == 3 && (CHK & 2)) hipLaunchKernelGGL(chk_kernel, dim3(grid), dim3(NWAVES * 64), LDS_BYTES, stream, a, 2);
        if (ph == 3 && (CHK & 4)) hipLaunchKernelGGL(chk_kernel, dim3(grid), dim3(NWAVES * 64), LDS_BYTES, stream, a, 4);
        if (ph == 6 && (CHK & 8)) hipLaunchKernelGGL(chk_kernel, dim3(grid), dim3(NWAVES * 64), LDS_BYTES, stream, a, 8);
        if (ph == 10 && (CHK & 16)) hipLaunchKernelGGL(chk_kernel, dim3(grid), dim3(NWAVES * 64), LDS_BYTES, stream, a, 16);
#endif
    }
#else
    a.ph_lo = 0; a.ph_hi = NPHASE;
    hipLaunchKernelGGL(skel_fwd, dim3(grid), dim3(NWAVES * 64), LDS_BYTES, stream, a);
#endif
}
```

```cpp
#include <hip/hip_runtime.h>
#include <hip/hip_bf16.h>
#include <cstdio>
#include <cstdint>
#include <cmath>

__device__ __forceinline__ int ltid(int wave) { int l; asm volatile("v_mbcnt_lo_u32_b32 %0, -1, 0\n\tv_mbcnt_hi_u32_b32 %0, -1, %0" : "=v"(l)); return (wave << 6) | l; }

namespace pg8 {
#define PG8_LAS __attribute__((address_space(3)))
typedef unsigned short bf16_t;
typedef short bf16x8 __attribute__((ext_vector_type(8)));
typedef float f32x4 __attribute__((ext_vector_type(4)));
typedef unsigned u32x4 __attribute__((ext_vector_type(4)));
typedef int i32x4_t __attribute__((ext_vector_type(4)));
typedef int i32x8_t __attribute__((ext_vector_type(8)));
constexpr int BM = 256, BK = 64, HALF = 128, HTB = HALF * BK * 2  , STAGE_BYTES = 8 * HTB, NXCD = 8, WGM = 8;
constexpr float C2 = 0.125f * 1.4426950408889634f;

__host__ __device__ __forceinline__ int lds_byte(int r, int c) { const int st = (r >> 4) * 2 + (c >> 5), rr = r & 15, cc = c & 31, ob = rr * 64 + cc * 2; return st * 1024 + (ob ^ (((ob >> 9) & 1) << 5)); }
__host__ __device__ __forceinline__ void stage_rc(int b, int& R, int& C) { const int st = b / 1024, sb = b % 1024, swz = sb ^ (((sb >> 9) & 1) << 5); R = (st >> 1) * 16 + swz / 64; C = (st & 1) * 32 + (swz % 64) / 2; }
__host__ __device__ __forceinline__ int perm32(int rho) { const int n = rho >> 4, i = rho & 15; return 8 * (i >> 2) + 4 * n + (i & 3); }

struct Unit { int pm, pn; long boff; };
struct Gemm { const bf16_t* A; const bf16_t* Bt; int K, lda, ldb; const int* rows; };

struct StaticOrder {
    int nM, nN, nwg, G, c, ldb;
    __device__ void init(int M, int N, int G_, int c_, int ldb_) { nM = M / BM; nN = N / BM; nwg = nM * nN; G = G_; c = c_; ldb = ldb_; }
    __device__ bool next(int i, Unit& u) const {
        const long L = (long)i * G + c; if (L >= nwg) return false;
        int wgid = (int)L; { const int q = nwg / NXCD, r = nwg % NXCD, xcd = wgid % NXCD, off = wgid / NXCD; wgid = (xcd < r ? xcd * (q + 1) : r * (q + 1) + (xcd - r) * q) + off; }
        const int nig = WGM * nN, gid = wgid / nig, fm = gid * WGM, gsz = (nM - fm) < WGM ? (nM - fm) : WGM;
        u.pm = fm + ((wgid % nig) % gsz); u.pn = (wgid % nig) / gsz; u.boff = (long)u.pn * BM * ldb; return true;
    }
};

__device__ __forceinline__ unsigned cvt_pk_bf16(float lo, float hi) { unsigned r; asm volatile("v_cvt_pk_bf16_f32 %0, %1, %2" : "=v"(r) : "v"(lo), "v"(hi)); return r; }
__device__ __forceinline__ float bf_lo(unsigned w) { return __uint_as_float(w << 16); }
__device__ __forceinline__ float bf_hi(unsigned w) { return __uint_as_float(w & 0xffff0000u); }
__device__ __forceinline__ float sigm(float x) { return __builtin_amdgcn_rcpf(1.f + __builtin_amdgcn_exp2f(-1.4426950408889634f * x)); }
__device__ __forceinline__ u32x4 pack8(f32x4 a, f32x4 b) { u32x4 w; w.x = cvt_pk_bf16(a[0], a[1]); w.y = cvt_pk_bf16(a[2], a[3]); w.z = cvt_pk_bf16(b[0], b[1]); w.w = cvt_pk_bf16(b[2], b[3]); return w; }
__device__ __forceinline__ void unpack8(u32x4 w, f32x4& a, f32x4& b) { a = (f32x4){bf_lo(w.x), bf_hi(w.x), bf_lo(w.y), bf_hi(w.y)}; b = (f32x4){bf_lo(w.z), bf_hi(w.z), bf_lo(w.w), bf_hi(w.w)}; }

#define PG8_EPI_ARGS const f32x4 (&acc)[2][2][4][2], const Unit& u, int wr, int wc, int fr, int fq

#define PG8_PIN(x) asm volatile("" : "+v"(x))
template <class T> __device__ __forceinline__ T& at(const void* base, unsigned byteoff) { return *(T*)((char*)base + byteoff); }

__device__ __forceinline__ float xor16(float v, int fq) { const auto r = __builtin_amdgcn_permlane16_swap(__float_as_uint(v), __float_as_uint(v), false, false); return __uint_as_float((fq & 1) ? r[0] : r[1]); }
struct EpiProj {
    bf16_t* base; size_t tstride; bf16_t* IK; float* IW; const float* rope;
    __device__ __forceinline__ void operator()(PG8_EPI_ARGS) const {
        const int pn = u.pn, row0 = u.pm * BM + wr * 64 + fr;
        if (pn < 14) {
            const int t = pn >> 1;
            bf16_t* dst = base + (size_t)t * tstride;
            const bool rp = (t == 0) | (t == 1) | (t == 3) | (t == 4) | (t == 6);
            const float sc = (t == 0 || t == 3) ? C2 : (t == 6 ? 0.125f : 1.f);
            const bool rotw = rp && ((wc & 1) == 0);
            const unsigned cb = (unsigned)((pn & 1) * 256 + wc * 32 + 8 * fq) * 2u;
            constexpr int RB = 2; f32x4 rq[RB][4];
#define PG8_RP_LD(it) do { if (rotw) { unsigned r_ = (unsigned)(row0 + ((it) >> 2) * HALF + ((it) & 3) * 16); PG8_PIN(r_); \
                rq[(it) % RB][0] = at<const f32x4>(rope, r_ * 64u); rq[(it) % RB][1] = at<const f32x4>(rope, r_ * 64u + 16u); rq[(it) % RB][2] = at<const f32x4>(rope, r_ * 64u + 32u); rq[(it) % RB][3] = at<const f32x4>(rope, r_ * 64u + 48u); } } while (0)
#pragma unroll
            for (int it = 0; it < RB; ++it) PG8_RP_LD(it);
#pragma unroll
            for (int ai = 0; ai < 2; ++ai)
#pragma unroll
                for (int m = 0; m < 4; ++m) { const int it = ai * 4 + m;
                    unsigned row = (unsigned)(row0 + ai * HALF + m * 16); PG8_PIN(row);
                    f32x4 c0 = {1.f, 1.f, 1.f, 1.f}, c1 = c0, s0 = {0.f, 0.f, 0.f, 0.f}, s1 = s0;
                    if (rotw) { c0 = rq[it % RB][0]; c1 = rq[it % RB][1]; s0 = rq[it % RB][2]; s1 = rq[it % RB][3]; }
                    if (it + RB < 8) PG8_RP_LD(it + RB);
#pragma unroll
                    for (int bj = 0; bj < 2; ++bj) {
                        f32x4 v0 = acc[ai][bj][m][0], v1 = acc[ai][bj][m][1];
                        if (rotw) {
                            f32x4 p0, p1;
#pragma unroll
                            for (int i = 0; i < 4; ++i) { p0[i] = xor16(v0[i], fq); p1[i] = xor16(v1[i], fq); }
                            const float sg = (fq == 0) ? -1.f : 1.f;
                            const f32x4 r0 = v0 * c0 + (p0 * s0) * sg, r1 = v1 * c1 + (p1 * s1) * sg;
                            if (fq < 2) { v0 = r0; v1 = r1; }
                        }
                        v0 = v0 * sc; v1 = v1 * sc;
                        at<u32x4>(dst, row * 1024u + cb + bj * 256u) = pack8(v0, v1);
                    }
                    asm volatile("" ::: "memory");
                }
#undef PG8_RP_LD
        } else {
#pragma unroll
            for (int ai = 0; ai < 2; ++ai)
#pragma unroll
                for (int m = 0; m < 4; ++m) {
                    unsigned row = (unsigned)(row0 + ai * HALF + m * 16); PG8_PIN(row);
                    f32x4 v0 = acc[ai][0][m][0], v1 = acc[ai][0][m][1];
                    if (wc == 0) {
                        const f32x4 c0 = at<const f32x4>(rope, row * 64u), c1 = at<const f32x4>(rope, row * 64u + 16u), s0 = at<const f32x4>(rope, row * 64u + 32u), s1 = at<const f32x4>(rope, row * 64u + 48u);
                        f32x4 p0, p1;
#pragma unroll
                        for (int i = 0; i < 4; ++i) { p0[i] = xor16(v0[i], fq); p1[i] = xor16(v1[i], fq); }
                        const float sg = (fq == 0) ? -1.f : 1.f;
                        const f32x4 r0 = v0 * c0 + (p0 * s0) * sg, r1 = v1 * c1 + (p1 * s1) * sg;
                        if (fq < 2) { v0 = r0; v1 = r1; }
                    }
                    if (wc < 2) at<u32x4>(IK, row * 128u + (unsigned)(wc * 32 + 8 * fq) * 2u) = pack8(v0, v1);
                    else if (wc == 2 && fq == 0) { at<f32x4>(IW, row * 32u) = v0 * 0.35355339059f; at<f32x4>(IW, row * 32u + 16u) = v1 * 0.35355339059f; }
                    asm volatile("" ::: "memory");
                }
        }
    }
};
struct EpiSig {
    unsigned char* out; int ldc; float pre;
    __device__ __forceinline__ void operator()(PG8_EPI_ARGS) const {
        const unsigned o0 = (unsigned)(u.pm * BM + wr * 64 + fr) * 1024u + (unsigned)(u.pn * BM + wc * 32 + 8 * fq);
#pragma unroll
        for (int ai = 0; ai < 2; ++ai)
#pragma unroll
            for (int m = 0; m < 4; ++m) {
                unsigned o = o0 + (unsigned)(ai * HALF + m * 16) * 1024u; PG8_PIN(o);
#pragma unroll
                for (int bj = 0; bj < 2; ++bj) {
                    const f32x4 v0 = acc[ai][bj][m][0], v1 = acc[ai][bj][m][1];
                    unsigned w0 = 0u, w1 = 0u;
#pragma unroll
                    for (int i = 0; i < 4; ++i) { w0 = __builtin_amdgcn_cvt_pk_u8_f32(sigm(v0[i] * pre) * 255.f, i, w0); w1 = __builtin_amdgcn_cvt_pk_u8_f32(sigm(v1[i] * pre) * 255.f, i, w1); }
                    at<unsigned long long>(out, o + bj * 128u) = (unsigned long long)w0 | ((unsigned long long)w1 << 32);
                }
                asm volatile("" ::: "memory");
            }
    }
};
template <bool ADD>
struct EpiGatedT {
    const unsigned char* gate; const bf16_t* addsrc; bf16_t* out; int ldc;
    __device__ __forceinline__ void operator()(PG8_EPI_ARGS) const {
        const unsigned o0 = ((unsigned)(u.pm * BM + wr * 64 + fr) * 1024u + (unsigned)(u.pn * BM + wc * 32 + 8 * fq)) * 2u;
        constexpr int NB = 2;
        unsigned long long gq[NB][2]; u32x4 aq[ADD ? NB : 1][2];
#define PG8_GT_LD(it) do { unsigned o_ = o0 + (unsigned)(((it) >> 2) * HALF + ((it) & 3) * 16) * 2048u; PG8_PIN(o_); \
            gq[(it) % NB][0] = at<const unsigned long long>(gate, o_ >> 1); gq[(it) % NB][1] = at<const unsigned long long>(gate, (o_ >> 1) + 128u); \
            if constexpr (ADD) { aq[(it) % NB][0] = at<const u32x4>(addsrc, o_); aq[(it) % NB][1] = at<const u32x4>(addsrc, o_ + 256u); } } while (0)
#pragma unroll
        for (int it = 0; it < NB; ++it) PG8_GT_LD(it);
#pragma unroll
        for (int it = 0; it < 8; ++it) { const int ai = it >> 2, m = it & 3;
                unsigned o = o0 + (unsigned)(ai * HALF + m * 16) * 2048u; PG8_PIN(o);
                f32x4 v0[2], v1[2];
#pragma unroll
                for (int bj = 0; bj < 2; ++bj) {
                    const unsigned long long gw = gq[it % NB][bj]; const unsigned glo = (unsigned)gw, ghi = (unsigned)(gw >> 32); constexpr float K8 = 1.f / 255.f;
                    const f32x4 g0 = {(float)(glo & 0xffu) * K8, (float)((glo >> 8) & 0xffu) * K8, (float)((glo >> 16) & 0xffu) * K8, (float)(glo >> 24) * K8};
                    const f32x4 g1 = {(float)(ghi & 0xffu) * K8, (float)((ghi >> 8) & 0xffu) * K8, (float)((ghi >> 16) & 0xffu) * K8, (float)(ghi >> 24) * K8};
                    v0[bj] = acc[ai][bj][m][0] * g0; v1[bj] = acc[ai][bj][m][1] * g1;
                    if constexpr (ADD) { f32x4 a0, a1; unpack8(aq[it % NB][bj], a0, a1); v0[bj] = v0[bj] + a0; v1[bj] = v1[bj] + a1; }
                }
                if (it + NB < 8) PG8_GT_LD(it + NB);
#pragma unroll
                for (int bj = 0; bj < 2; ++bj) at<u32x4>(out, o + bj * 256u) = pack8(v0[bj], v1[bj]);
                asm volatile("" ::: "memory");
            }
#undef PG8_GT_LD
    }
};
struct EpiResBf16 {
    const bf16_t* x; bf16_t* out; float alpha;
    __device__ __forceinline__ void operator()(PG8_EPI_ARGS) const {
        const unsigned o0 = ((unsigned)(u.pm * BM + wr * 64 + fr) * 1024u + (unsigned)(u.pn * BM + wc * 32 + 8 * fq)) * 2u;
        u32x4 xq[8][2];
#define PG8_X_LD(buf, it) do { unsigned o_ = o0 + (unsigned)(((it) >> 2) * HALF + ((it) & 3) * 16) * 2048u; PG8_PIN(o_); \
            xq[buf][0] = at<const u32x4>(x, o_); xq[buf][1] = at<const u32x4>(x, o_ + 256u); } while (0)
#pragma unroll
        for (int it = 0; it < 8; ++it) PG8_X_LD(it, it);
#pragma unroll
        for (int it = 0; it < 8; ++it) { const int ai = it >> 2, m = it & 3;
                unsigned o = o0 + (unsigned)(ai * HALF + m * 16) * 2048u; PG8_PIN(o);
#pragma unroll
                for (int bj = 0; bj < 2; ++bj) { f32x4 x0, x1; unpack8(xq[it][bj], x0, x1);
                    at<u32x4>(out, o + bj * 256u) = pack8(x0 * alpha + acc[ai][bj][m][0], x1 * alpha + acc[ai][bj][m][1]); }
                asm volatile("" ::: "memory");
            }
#undef PG8_X_LD
    }
};
struct EpiGU {
    bf16_t* HG; const float* cw; float pre;
    __device__ __forceinline__ void operator()(PG8_EPI_ARGS) const {
        const int row0 = u.pm * BM + wr * 64 + fr; const unsigned cb = (unsigned)(u.pn * HALF + wc * 32 + 8 * fq) * 2u;
        float cv[8];
#pragma unroll
        for (int it = 0; it < 8; ++it) cv[it] = at<const float>(cw, (unsigned)(row0 + (it >> 2) * HALF + (it & 3) * 16) * 4u);
#pragma unroll
        for (int it = 0; it < 8; ++it) { const int ai = it >> 2, m = it & 3;
                unsigned row = (unsigned)(row0 + ai * HALF + m * 16); PG8_PIN(row);
                const float c = cv[it];
                f32x4 g0 = acc[ai][0][m][0] * pre, g1 = acc[ai][0][m][1] * pre; const f32x4 u0 = acc[ai][1][m][0] * pre, u1 = acc[ai][1][m][1] * pre;
#pragma unroll
                for (int i = 0; i < 4; ++i) { g0[i] = g0[i] * sigm(g0[i]) * u0[i] * c; g1[i] = g1[i] * sigm(g1[i]) * u1[i] * c; }
                at<u32x4>(HG, row * 512u + cb) = pack8(g0, g1);
                asm volatile("" ::: "memory");
            }
    }
};
struct EpiDown {
    const int* ent; bf16_t* Y0; unsigned ystride;
    __device__ __forceinline__ void operator()(PG8_EPI_ARGS) const {
        const int row0 = u.pm * BM + wr * 64 + fr; const unsigned cb = (unsigned)(u.pn * BM + wc * 32 + 8 * fq) * 2u;
        int ev[8];
#pragma unroll
        for (int it = 0; it < 8; ++it) ev[it] = at<const int>(ent, (unsigned)(row0 + (it >> 2) * HALF + (it & 3) * 16) * 4u);
#pragma unroll
        for (int it = 0; it < 8; ++it) { const int ai = it >> 2, m = it & 3; const int e = ev[it];
                if (e >= 0) { unsigned o = (unsigned)(e >> 1) * 2048u + cb + (unsigned)(e & 1) * ystride; PG8_PIN(o);
#pragma unroll
                    for (int bj = 0; bj < 2; ++bj) at<u32x4>(Y0, o + bj * 256u) = pack8(acc[ai][bj][m][0], acc[ai][bj][m][1]); }
                asm volatile("" ::: "memory");
            }
    }
};
struct EpiStore {
    bf16_t* out; int ldc;
    __device__ __forceinline__ void operator()(PG8_EPI_ARGS) const {
        const unsigned o0 = ((unsigned)(u.pm * BM + wr * 64 + fr) * 1024u + (unsigned)(u.pn * BM + wc * 32 + 8 * fq)) * 2u;
#pragma unroll
        for (int ai = 0; ai < 2; ++ai)
#pragma unroll
            for (int m = 0; m < 4; ++m) {
                unsigned o = o0 + (unsigned)(ai * HALF + m * 16) * 2048u; PG8_PIN(o);
#pragma unroll
                for (int bj = 0; bj < 2; ++bj) at<u32x4>(out, o + bj * 256u) = pack8(acc[ai][bj][m][0], acc[ai][bj][m][1]);
                asm volatile("" ::: "memory");
            }
    }
};
struct EpiPle {
    const bf16_t* t1; bf16_t* out; float pre;
    __device__ __forceinline__ void operator()(PG8_EPI_ARGS) const {
        const unsigned o0 = ((unsigned)(u.pm * BM + wr * 64 + fr) * 1024u + (unsigned)(u.pn * BM + wc * 32 + 8 * fq)) * 2u;
        u32x4 tq[8][2];
#define PG8_T_LD(buf, it) do { unsigned o_ = o0 + (unsigned)(((it) >> 2) * HALF + ((it) & 3) * 16) * 2048u; PG8_PIN(o_); \
            tq[buf][0] = at<const u32x4>(t1, o_); tq[buf][1] = at<const u32x4>(t1, o_ + 256u); } while (0)
#pragma unroll
        for (int it = 0; it < 8; ++it) PG8_T_LD(it, it);
#pragma unroll
        for (int it = 0; it < 8; ++it) { const int ai = it >> 2, m = it & 3;
                unsigned o = o0 + (unsigned)(ai * HALF + m * 16) * 2048u; PG8_PIN(o);
#pragma unroll
                for (int bj = 0; bj < 2; ++bj) {
                    f32x4 t0, t1v; unpack8(tq[it][bj], t0, t1v);
                    f32x4 v0 = acc[ai][bj][m][0], v1 = acc[ai][bj][m][1];
#pragma unroll
                    for (int i = 0; i < 4; ++i) { v0[i] = sigm(v0[i] * pre) * t0[i]; v1[i] = sigm(v1[i] * pre) * t1v[i]; }
                    at<u32x4>(out, o + bj * 256u) = pack8(v0, v1);
                }
                asm volatile("" ::: "memory");
            }
#undef PG8_T_LD
    }
};

template <class Epi, class Sched, bool ALIGN_EPI, bool GATHER = false, bool FP8 = false>
__device__ __forceinline__ void gemm_phase(PG8_LAS unsigned char* lds, const Gemm g, const Sched& S, const Epi& E, int wave_in) {
    const int tid = ltid(wave_in), wid = __builtin_amdgcn_readfirstlane(tid >> 6), lane = tid & 63, wr = wid >> 2, wc = wid & 3, fr = lane & 15, fq = lane >> 4;
    int K_ = g.K; asm volatile("" : "+s"(K_));
    const int K = K_, nt = K / BK;
    int RA[2], CA[2]; unsigned voffB[2], voffA[2];
#pragma unroll
    for (int i = 0; i < 2; ++i) { int R, C; stage_rc(tid * 16 + i * 8192, R, C); const int Rb = (R & ~31) + perm32(R & 31); RA[i] = R; CA[i] = C; voffB[i] = (unsigned)(Rb * g.ldb + C) * 2u; voffA[i] = (unsigned)(R * g.lda + C) * 2u; }
    const size_t hstepA = (size_t)HALF * g.lda * 2;
    const size_t kstep = (size_t)(BK * 2);
    const size_t hstepB = (size_t)HALF * g.ldb * 2;
    const unsigned ldsw = (unsigned)wid * 1024u;
    const int aoff = lds_byte(wr * 64 + fr, fq * 8), boff = lds_byte(wc * 32 + fr, fq * 8);
    const char* Ab = (const char*)g.A;
#define PG8_SA(b, h) (((b) * 2 + (h)) * HTB)
#define PG8_SB(b, h) ((4 + (b) * 2 + (h)) * HTB)
#define PG8_STAGE_A(bufoff, kb, OFF, h) do { _Pragma("unroll") for (int _i = 0; _i < 2; ++_i) { const char* _p; \
        if constexpr (GATHER) _p = Ab + (kb) + (OFF##_v)[h][_i]; else _p = Ab + ((kb) + (OFF##_u) + (size_t)(h) * hstepA) + voffA[_i]; \
        __builtin_amdgcn_global_load_lds((const unsigned*)_p, (PG8_LAS unsigned*)(lds + (bufoff) + ldsw + _i * 8192), 16, 0, 0); } } while (0)
#define PG8_STAGE_B(bufoff, gbase) do { _Pragma("unroll") for (int _i = 0; _i < 2; ++_i) \
        __builtin_amdgcn_global_load_lds((const unsigned*)((const char*)(gbase) + voffB[_i]), (PG8_LAS unsigned*)(lds + (bufoff) + ldsw + _i * 8192), 16, 0, 0); } while (0)
#define PG8_MKOFF(uu, OFF) do { if constexpr (GATHER) { _Pragma("unroll") for (int _h = 0; _h < 2; ++_h) _Pragma("unroll") for (int _i = 0; _i < 2; ++_i) { \
        const int _row = g.rows[(uu).pm * BM + _h * HALF + RA[_i]]; (OFF##_v)[_h][_i] = (unsigned)(_row * g.lda + CA[_i]) * 2u; } } else { OFF##_u = (size_t)(uu).pm * BM * g.lda * 2; } } while (0)
#define PG8_LDA(dst, b, h) do { _Pragma("unroll") for (int m = 0; m < 4; ++m) { if constexpr (FP8) { dst##8[m].lo = *(const PG8_LAS i32x4_t*)(lds + PG8_SA(b, h) + aoff + m * 2048); dst##8[m].hi = *(const PG8_LAS i32x4_t*)(lds + PG8_SA(b, h) + aoff + m * 2048 + 1024); } \
        else { _Pragma("unroll") for (int k = 0; k < 2; ++k) dst[m][k] = *(const PG8_LAS bf16x8*)(lds + PG8_SA(b, h) + aoff + m * 2048 + k * 1024); } } } while (0)
#define PG8_LDB(dst, b, h) do { _Pragma("unroll") for (int n = 0; n < 2; ++n) { if constexpr (FP8) { dst##8[n].lo = *(const PG8_LAS i32x4_t*)(lds + PG8_SB(b, h) + boff + n * 2048); dst##8[n].hi = *(const PG8_LAS i32x4_t*)(lds + PG8_SB(b, h) + boff + n * 2048 + 1024); } \
        else { _Pragma("unroll") for (int k = 0; k < 2; ++k) dst[n][k] = *(const PG8_LAS bf16x8*)(lds + PG8_SB(b, h) + boff + n * 2048 + k * 1024); } } } while (0)
#define PG8_MMA(ai, bj, At, Bt) do { __builtin_amdgcn_s_setprio(1); \
        if constexpr (FP8) { _Pragma("unroll") for (int m = 0; m < 4; ++m) _Pragma("unroll") for (int n = 0; n < 2; ++n) \
            asm volatile("v_mfma_f32_16x16x128_f8f6f4 %0, %1, %2, %0" : "+v"(acc[ai][bj][m][n]) : "v"(Bt##8[n]), "v"(At##8[m])); }   \
        else { _Pragma("unroll") for (int m = 0; m < 4; ++m) _Pragma("unroll") for (int n = 0; n < 2; ++n) _Pragma("unroll") for (int k = 0; k < 2; ++k) \
            acc[ai][bj][m][n] = __builtin_amdgcn_mfma_f32_16x16x32_bf16(Bt[n][k], At[m][k], acc[ai][bj][m][n], 0, 0, 0); } __builtin_amdgcn_s_setprio(0); } while (0)
#define PG8_WAIT_V(n) asm volatile("s_waitcnt vmcnt(" #n ")" ::: "memory")
#define PG8_WAIT_L(n) asm volatile("s_waitcnt lgkmcnt(" #n ")" ::: "memory")
#define PG8_BAR __builtin_amdgcn_s_barrier()
#define PG8_SCHED __builtin_amdgcn_sched_barrier(0)
    Unit cur, nxt; int ui = 0;
    if (!S.next(0, cur)) return;
    f32x4 acc[2][2][4][2];
#pragma unroll
    for (int a = 0; a < 2; ++a)
#pragma unroll
        for (int b = 0; b < 2; ++b)
#pragma unroll
            for (int m = 0; m < 4; ++m)
#pragma unroll
                for (int n = 0; n < 2; ++n) acc[a][b][m][n] = (f32x4){0.f, 0.f, 0.f, 0.f};
    bf16x8 At[4][2], B0[2][2], B1[2][2];
    i32x8_t At8[4], B08[2], B18[2];
    unsigned offAc_v[2][2], offAn_v[2][2]; size_t offAc_u = 0, offAn_u = 0;
    PG8_MKOFF(cur, offAc);
    const char* cB = (const char*)(g.Bt + cur.boff);
    PG8_STAGE_B(PG8_SB(0, 0), cB); PG8_STAGE_B(PG8_SB(0, 1), cB + hstepB); PG8_STAGE_A(PG8_SA(0, 0), 0, offAc, 0); PG8_STAGE_A(PG8_SA(0, 1), 0, offAc, 1);
    if (wr == 1) PG8_BAR;
    PG8_WAIT_V(2); PG8_BAR;
    PG8_STAGE_B(PG8_SB(1, 0), cB + kstep); PG8_STAGE_A(PG8_SA(1, 0), kstep, offAc, 0); PG8_STAGE_B(PG8_SB(1, 1), cB + hstepB + kstep);
    PG8_WAIT_V(6); PG8_BAR;
    for (;;) {
        const bool has_next = S.next(ui + 1, nxt);
        if (has_next) { PG8_MKOFF(nxt, offAn); }
        else { offAn_u = offAc_u;
#pragma unroll
            for (int h = 0; h < 2; ++h)
#pragma unroll
                for (int i = 0; i < 2; ++i) offAn_v[h][i] = offAc_v[h][i];
        }
        const char* nB = has_next ? (const char*)(g.Bt + nxt.boff) : cB;
        for (int t = 0; t < nt; t += 2) {
            const bool last = (t == nt - 2);
            const size_t a1k = (size_t)(t + 1) * kstep;
            const size_t a2k = last ? (size_t)0 : (size_t)(t + 2) * kstep; const char* b2 = last ? nB : cB + (size_t)(t + 2) * kstep;
            const size_t a3k = a2k + kstep; const char* b3 = b2 + kstep;
            unsigned o2_v[2][2]; const size_t o2_u = last ? offAn_u : offAc_u;
#pragma unroll
            for (int h = 0; h < 2; ++h)
#pragma unroll
                for (int i = 0; i < 2; ++i) o2_v[h][i] = last ? offAn_v[h][i] : offAc_v[h][i];
            PG8_LDB(B0, 0, 0); PG8_LDB(B1, 0, 1); PG8_SCHED; PG8_LDA(At, 0, 0); PG8_STAGE_A(PG8_SA(1, 1), a1k, offAc, 1);
            PG8_WAIT_V(8); PG8_WAIT_L(0); PG8_BAR; PG8_MMA(0, 0, At, B0); PG8_MMA(0, 1, At, B1); PG8_BAR; PG8_SCHED;
            PG8_LDA(At, 0, 1); PG8_STAGE_B(PG8_SB(0, 0), b2); PG8_STAGE_B(PG8_SB(0, 1), b2 + hstepB); PG8_STAGE_A(PG8_SA(0, 0), a2k, o2, 0);
            PG8_WAIT_V(8); PG8_WAIT_L(0); PG8_BAR; PG8_MMA(1, 0, At, B0); PG8_MMA(1, 1, At, B1); PG8_BAR; PG8_SCHED;
            PG8_LDB(B0, 1, 0); PG8_LDB(B1, 1, 1); PG8_SCHED; PG8_LDA(At, 1, 0); PG8_STAGE_A(PG8_SA(0, 1), a2k, o2, 1);
            PG8_WAIT_V(8); PG8_WAIT_L(0); PG8_BAR; PG8_MMA(0, 0, At, B0); PG8_MMA(0, 1, At, B1); PG8_BAR; PG8_SCHED;
            PG8_LDA(At, 1, 1); PG8_STAGE_B(PG8_SB(1, 0), b3); PG8_STAGE_B(PG8_SB(1, 1), b3 + hstepB); PG8_STAGE_A(PG8_SA(1, 0), a3k, o2, 0);
            PG8_WAIT_V(8); PG8_WAIT_L(0); PG8_BAR; PG8_MMA(1, 0, At, B0); PG8_MMA(1, 1, At, B1); PG8_BAR; PG8_SCHED;
        }
        if constexpr (ALIGN_EPI) { if (wr == 0) PG8_BAR; }
        if constexpr (FP8) asm volatile("s_nop 15\n\ts_nop 15\n\ts_nop 7" ::: "memory");
        E(acc, cur, wr, wc, fr, fq);
        if (!has_next) break;
#pragma unroll
        for (int a = 0; a < 2; ++a)
#pragma unroll
            for (int b = 0; b < 2; ++b)
#pragma unroll
                for (int m = 0; m < 4; ++m)
#pragma unroll
                    for (int n = 0; n < 2; ++n) acc[a][b][m][n] = (f32x4){0.f, 0.f, 0.f, 0.f};
        cur = nxt; cB = nB; ++ui; offAc_u = offAn_u;
#pragma unroll
        for (int h = 0; h < 2; ++h)
#pragma unroll
            for (int i = 0; i < 2; ++i) offAc_v[h][i] = offAn_v[h][i];
        if constexpr (ALIGN_EPI) { if (wr == 1) PG8_BAR; }
    }
    PG8_WAIT_V(0);
    if constexpr (!ALIGN_EPI) { if (wr == 0) PG8_BAR; }
    PG8_BAR;
#undef PG8_SA
#undef PG8_SB
#undef PG8_STAGE_A
#undef PG8_STAGE_B
#undef PG8_MKOFF
#undef PG8_LDA
#undef PG8_LDB
#undef PG8_MMA
#undef PG8_WAIT_V
#undef PG8_WAIT_L
#undef PG8_BAR
#undef PG8_SCHED
}
}
namespace attn_body {
using bf16=__hip_bfloat16;
using bf16x8=__attribute__((ext_vector_type(8)))short;
using s16x4=__attribute__((ext_vector_type(4)))short;
using f32x16=__attribute__((ext_vector_type(16)))float;
using u32x4=__attribute__((ext_vector_type(4)))unsigned;
constexpr int BATCH=2,SEQ=16384,D=64,DM=512;
constexpr int NW=8,QBLK=32,QB=QBLK*NW,KVBLK=64,NQB=SEQ/QB;
constexpr int ATTN_PITCH=DM, ATTN_UNIT_ROWS=QB;
__device__ __forceinline__ int crow(int r,int hi){return (r&3)+8*(r>>2)+4*hi;}
#define SBAR() __builtin_amdgcn_sched_barrier(0)
__device__ __forceinline__ void cmask(f32x16&p0,f32x16&p1,int jb,int qrel,int hi){
  const float NEG=-INFINITY; int kb=64*jb+4*hi;
  #pragma unroll
  for(int r=0;r<16;++r){int kv=kb+(r&3)+8*(r>>2); if(kv>qrel)p0[r]=NEG; if(kv+32>qrel)p1[r]=NEG;}
}

constexpr int NSLOT=3, SLOTB=8192;
constexpr int LDS_K=0, LDS_V=NSLOT*SLOTB, LDS_WS=2*NSLOT*SLOTB, LDS_OST=LDS_WS+NW*64*4, LDS_MK=LDS_OST+NW*4096, LDS_BYTES=LDS_MK+NW*1024, LDS_BYTES_WIDE=LDS_V+NSLOT*2*SLOTB+NW*64*4+NW*4096;
constexpr float C2=0.125f*1.4426950408889634f;
__device__ __forceinline__ void glds16(const void*gsrc,unsigned lds_dst){unsigned keep;
  asm volatile("s_mov_b32 %0, m0\n\ts_mov_b32 m0, %2\n\ts_nop 0\n\tglobal_load_lds_dwordx4 %1, off\n\ts_mov_b32 m0, %0":"=&s"(keep):"v"(gsrc),"s"(lds_dst):"memory");}
__device__ __forceinline__ float max3f(float a,float b,float c){float r;asm("v_max3_f32 %0, %1, %2, %3":"=v"(r):"v"(a),"v"(b),"v"(c));return r;}
__device__ __forceinline__ float max2f(float a,float b){float r;asm("v_max_f32_e32 %0, %1, %2":"=v"(r):"v"(a),"v"(b));return r;}
__device__ __forceinline__ float fadd_s(float a,float b){float r;asm("v_add_f32_e32 %0, %1, %2":"=v"(r):"v"(a),"v"(b));return r;}
__device__ __forceinline__ float fsub_s(float a,float b){float r;asm("v_sub_f32_e32 %0, %1, %2":"=v"(r):"v"(a),"v"(b));return r;}
typedef float f32x2_t __attribute__((ext_vector_type(2))); typedef __bf16 bf16x2_t __attribute__((ext_vector_type(2)));
__device__ __forceinline__ unsigned cvtpk_s(float lo,float hi){f32x2_t v={lo,hi};bf16x2_t b=__builtin_convertvector(v,bf16x2_t);return __builtin_bit_cast(unsigned,b);}
#define WAIT_BAR(N) asm volatile("s_waitcnt vmcnt(" #N ") lgkmcnt(0)\n\ts_barrier":::"memory")

__device__ __forceinline__ void qkt(f32x16&p0,f32x16&p1,const char*Kslot,const bf16x8*qr,const f32x16&ci0,const f32x16&ci1,int r32,int hi){
  const char*kb=Kslot+hi*1024+r32*16;
  #pragma unroll
  for(int d0=0;d0<4;++d0){
    const bf16x8 b0=*reinterpret_cast<const bf16x8*>(kb+d0*2048);
    const bf16x8 b1=*reinterpret_cast<const bf16x8*>(kb+d0*2048+512);
    if(d0==0){p0=__builtin_amdgcn_mfma_f32_32x32x16_bf16(b0,qr[0],ci0,0,0,0);p1=__builtin_amdgcn_mfma_f32_32x32x16_bf16(b1,qr[0],ci1,0,0,0);}
    else{p0=__builtin_amdgcn_mfma_f32_32x32x16_bf16(b0,qr[d0],p0,0,0,0);p1=__builtin_amdgcn_mfma_f32_32x32x16_bf16(b1,qr[d0],p1,0,0,0);}}
}
typedef __attribute__((address_space(3))) const char* lds_cptr;
typedef short v4i16_t __attribute__((ext_vector_type(4)));
__device__ __forceinline__ void kload8(bf16x8*kf,lds_cptr kp){
  kf[0]=*(const __attribute__((address_space(3))) bf16x8*)(kp);      kf[1]=*(const __attribute__((address_space(3))) bf16x8*)(kp+512);
  kf[2]=*(const __attribute__((address_space(3))) bf16x8*)(kp+2048); kf[3]=*(const __attribute__((address_space(3))) bf16x8*)(kp+2560);
  kf[4]=*(const __attribute__((address_space(3))) bf16x8*)(kp+4096); kf[5]=*(const __attribute__((address_space(3))) bf16x8*)(kp+4608);
  kf[6]=*(const __attribute__((address_space(3))) bf16x8*)(kp+6144); kf[7]=*(const __attribute__((address_space(3))) bf16x8*)(kp+6656);
}
__device__ __forceinline__ void kload2(bf16x8*kf,lds_cptr kp,int j){ kf[2*j]=*(const __attribute__((address_space(3))) bf16x8*)(kp+j*2048); kf[2*j+1]=*(const __attribute__((address_space(3))) bf16x8*)(kp+j*2048+512); }
__device__ __forceinline__ s16x4 vtr(lds_cptr p){ return __builtin_bit_cast(s16x4,__builtin_amdgcn_ds_read_tr16_b64_v4i16((__attribute__((address_space(3))) v4i16_t*)p)); }
__device__ __forceinline__ float rowmax(const f32x16&p0,const f32x16&p1){
  float a=max3f(p0[0],p0[1],p1[0]),b=max3f(p0[2],p0[3],p1[1]);a=max3f(a,p1[2],p1[3]);
  #pragma unroll
  for(int r=4;r<16;r+=4){a=max3f(a,p0[r],p0[r+1]);b=max3f(b,p0[r+2],p0[r+3]);a=max3f(a,p1[r],p1[r+1]);b=max3f(b,p1[r+2],p1[r+3]);}
  const float m=max2f(a,b);
  auto rr=__builtin_amdgcn_permlane32_swap(__float_as_uint(m),__float_as_uint(m),false,false);
  return max2f(__uint_as_float(rr[0]),__uint_as_float(rr[1]));
}
__device__ __forceinline__ void pv(f32x16*o,int vb,bf16x8 pa0,bf16x8 pa1,bf16x8 pa2,bf16x8 pa3){
  #pragma unroll
  for(int d0=0;d0<2;++d0){s16x4 lo[4],hi[4];
    #pragma unroll
    for(int ks=0;ks<4;++ks){
      asm volatile("ds_read_b64_tr_b16 %0,%1 offset:%c2":"=&v"(lo[ks]):"v"(vb),"i"(d0*4096+ks*1024):"memory");
      asm volatile("ds_read_b64_tr_b16 %0,%1 offset:%c2":"=&v"(hi[ks]):"v"(vb),"i"(d0*4096+ks*1024+512):"memory");}
    asm volatile("s_waitcnt lgkmcnt(0)":::"memory");SBAR();
    #define PK(k) (bf16x8){lo[k][0],lo[k][1],lo[k][2],lo[k][3],hi[k][0],hi[k][1],hi[k][2],hi[k][3]}
    o[d0]=__builtin_amdgcn_mfma_f32_32x32x16_bf16(pa0,PK(0),o[d0],0,0,0);
    o[d0]=__builtin_amdgcn_mfma_f32_32x32x16_bf16(pa1,PK(1),o[d0],0,0,0);
    o[d0]=__builtin_amdgcn_mfma_f32_32x32x16_bf16(pa2,PK(2),o[d0],0,0,0);
    o[d0]=__builtin_amdgcn_mfma_f32_32x32x16_bf16(pa3,PK(3),o[d0],0,0,0);
    #undef PK
  }
}

#ifndef ATTN_STORE16
#define ATTN_STORE16(p,v) (*(u32x4*)(p)=(v))
#endif
template<int THRL,bool MASKED,bool WIDE,bool NOMAX> __device__ __forceinline__ void attn_unit(int b,int hq,int hv,int qb,const bf16*Q,const bf16*__restrict__ K,const bf16*__restrict__ V,bf16*O,const unsigned long long*__restrict__ MK,char*shm,int wave_in,int badoff){
  const int tid=ltid(wave_in),lane=tid&63,r32=lane&31,hi=lane>>5; const int wid=__builtin_amdgcn_readfirstlane(tid>>6);
  const long rowbase=(long)b*SEQ; const int q0=qb*QB;
  const bf16*Qw=Q+(rowbase+q0+wid*QBLK)*DM+hq*D;
  const bf16*Kh=K+rowbase*DM+hq*D,*Vh=V+rowbase*DM+hv*D;
  constexpr int VSLOT=WIDE?2*SLOTB:SLOTB, L_WS=LDS_V+NSLOT*VSLOT, L_OST=L_WS+NW*64*4, L_MK=L_OST+NW*4096, L_TAB=L_MK+NW*2048;
  #define VS(sl) (WIDE?2*(sl):(sl))
  const unsigned lds0=(unsigned)(uintptr_t)shm;
  float*wsf=(float*)(shm+L_WS)+wid*64;
  const bf16*ksrc=Kh+(long)lane*DM+wid*8;
  const bf16*vsrc=Vh+(long)(16*(wid&3)+(lane>>2))*DM+(wid>>2)*32+(lane&3)*8;
  const unsigned kdst=lds0+LDS_K+wid*1024, vdst=lds0+LDS_V+wid*1024;
  #define DMA_K(t,slot) glds16(ksrc+(long)(t)*KVBLK*DM,(unsigned)__builtin_amdgcn_readfirstlane(kdst+(slot)))
  #define DMA_V(t,slot) do{ glds16(vsrc+(long)(t)*KVBLK*DM,(unsigned)__builtin_amdgcn_readfirstlane(vdst+VS(slot))); if(WIDE){ glds16(vsrc+64+(long)(t)*KVBLK*DM,(unsigned)__builtin_amdgcn_readfirstlane(vdst+VS(slot)+8192)); } }while(0)
  const long mq0=(long)q0+wid*QBLK+2*(lane&15); const unsigned mdst=lds0+L_MK+wid*2048;
  #define DMA_M4(t0) do{ if(MASKED){ const long t_=(long)(t0)+(lane>>4); if(t_<NT){ glds16(MK+(16384L*t_-32L*t_*(t_-1)+mq0-64L*t_),(unsigned)__builtin_amdgcn_readfirstlane(mdst+(((t0)&7)*256))); } } }while(0)
  unsigned mw0=0u,mw1=0u;
  #define MKRD(t) do{ if(MASKED){ const unsigned long long w_=*(const __attribute__((address_space(3))) unsigned long long*)(shm3+L_MK+wid*2048+(((t)&7)*256)+r32*8); mw0=(unsigned)w_; mw1=(unsigned)(w_>>32); } }while(0)
  #define MAND(X,r,MW) do{}while(0)
  bf16x8 aid[2];
  if(MASKED){
    #pragma unroll
    for(int ks=0;ks<2;++ks)
      #pragma unroll
      for(int j=0;j<8;++j) aid[ks][j]=(short)((r32==16*ks+8*hi+j)?0x3F80:0);
  }
  #define TABRD(w,ks) (*(const __attribute__((address_space(3))) bf16x8*)(shm3+L_TAB+((((w)>>(16*(ks)+8*hi))&0xffu)<<4)))
  #define BIAS(C0,C1,CI) do{ const bf16x8 f00_=TABRD(mw0,0),f01_=TABRD(mw0,1),f10_=TABRD(mw1,0),f11_=TABRD(mw1,1); \
    C0=__builtin_amdgcn_mfma_f32_32x32x16_bf16(aid[0],f00_,CI,0,0,0); C1=__builtin_amdgcn_mfma_f32_32x32x16_bf16(aid[0],f10_,CI,0,0,0); \
    C0=__builtin_amdgcn_mfma_f32_32x32x16_bf16(aid[1],f01_,C0,0,0,0); C1=__builtin_amdgcn_mfma_f32_32x32x16_bf16(aid[1],f11_,C1,0,0,0); }while(0)
  const int vb0=(int)(lds0+LDS_V)+((lane>>4)&1)*32+(lane&3)*8+(4*hi+((lane&15)>>2))*64;
  const char*Kbase=shm+LDS_K; bf16x8 kf[8];
  const lds_cptr shm3=(lds_cptr)shm; const lds_cptr kp0=shm3+LDS_K+hi*1024+r32*16; const lds_cptr vp0=shm3+LDS_V+((lane>>4)&1)*32+(lane&3)*8+(4*hi+((lane&15)>>2))*64;
  const int NT=(q0+QB)/KVBLK;
  DMA_M4(0);DMA_K(0,0);DMA_V(0,0);DMA_K(1,SLOTB);
  bf16x8 qr[4];
  #pragma unroll
  for(int d0=0;d0<4;++d0)qr[d0]=*reinterpret_cast<const bf16x8*>(&Qw[(long)r32*DM+d0*16+hi*8]);
  float mhat=0.f,l_reg=0.f;f32x16 o[4];o[0]=f32x16{};o[1]=f32x16{};o[2]=f32x16{};o[3]=f32x16{};f32x16 negm=f32x16{}; if(!WIDE&&!NOMAX){ asm volatile("":"+v"(negm)); }
  const int qrel=wid*QBLK+r32;
  #define CMASK(P0,P1,t) do{int jb_=(t)-(NT-4); if(jb_>=0)cmask(P0,P1,jb_,qrel,hi);}while(0)
  bool resc=false;
  #define START(P0,P1) do{ resc=false; \
    if constexpr(!NOMAX){ const float rm=rowmax(P0,P1); const float dl=rm; mhat=fadd_s(mhat,dl); \
      _Pragma("unroll") for(int r=0;r<16;++r){P0[r]=fsub_s(P0[r],dl);P1[r]=fsub_s(P1[r],dl);} \
      if(!WIDE){ _Pragma("unroll") for(int r=0;r<16;++r)negm[r]=-mhat; asm volatile("":"+v"(negm)); } } \
    _Pragma("unroll") for(int r=0;r<16;++r)P0[r]=__builtin_amdgcn_exp2f(P0[r]); }while(0)
  #define RESC() do{ if constexpr(!NOMAX) if(resc){ asm volatile("s_waitcnt lgkmcnt(0)":::"memory"); \
      _Pragma("unroll") for(int d_=0;d_<(WIDE?4:2);++d_) _Pragma("unroll") for(int r=0;r<16;++r)o[d_][r]*=wsf[crow(r,hi)]; } }while(0)
  f32x16 pA0,pA1,pB0,pB1;
  int sl_prev=0,sl_cur=0,sl_next=SLOTB;
  #define ROT() do{sl_prev=sl_cur;sl_cur=sl_next;sl_next=(sl_next==(NSLOT-1)*SLOTB)?0:sl_next+SLOTB;}while(0)
  DMA_K(2,2*SLOTB); const bool m4b_=MASKED&&(4<NT); if(m4b_){DMA_M4(4);}
  if(WIDE||m4b_){WAIT_BAR(4);}else{WAIT_BAR(3);}
  if(MASKED){ MKRD(0); BIAS(pA0,pA1,negm); qkt(pA0,pA1,Kbase,qr,pA0,pA1,r32,hi); } else { qkt(pA0,pA1,Kbase,qr,negm,negm,r32,hi); }
  asm volatile("s_nop 15\n\ts_nop 7":"+v"(pA0),"+v"(pA1));CMASK(pA0,pA1,0);
  START(pA0,pA1);
  _Pragma("unroll") for(int r=0;r<16;++r)pA1[r]=__builtin_amdgcn_exp2f(pA1[r]);
  WAIT_BAR(0);
  DMA_K(3,0);DMA_V(1,SLOTB);
  ROT();
  kload8(kf,kp0+sl_cur);
  if(WIDE){WAIT_BAR(3);}else{WAIT_BAR(2);}
  s16x4 vlo[8],vhi[8]; u32x4 pw0,pw1,pw2,pw3;
  #define PKW(P,B) cvtpk_s(P[B],P[B+1])
  #define PAF(k) __builtin_bit_cast(bf16x8,pw##k)
  #define VFR(i) (bf16x8){vlo[i][0],vlo[i][1],vlo[i][2],vlo[i][3],vhi[i][0],vhi[i][1],vhi[i][2],vhi[i][3]}
  #define PIN(x) asm volatile("":"+v"(x))
  #define MX3(a,b,c) __builtin_fmaxf(__builtin_fmaxf((a),(b)),(c))
  #define GAPA(MF,A0,A1,A2,A3,W0,W1,PW) do{ MF; sacc+=A0; sacc+=A1; sacc+=A2; sacc+=A3; PIN(sacc); W0; W1; PIN(PW); SBAR(); }while(0)
  #define EX(v) __builtin_amdgcn_exp2f(v)
  #define GAPB(MF,X,B,MW) do{ MF; X[B]=EX(X[B]); X[B+1]=EX(X[B+1]); X[B+2]=EX(X[B+2]); X[B+3]=EX(X[B+3]); MAND(X,B,MW); MAND(X,B+1,MW); MAND(X,B+2,MW); MAND(X,B+3,MW); PIN(X); SBAR(); }while(0)
  #define GAPB2(MF,X,B) do{ MF; X[B]=EX(X[B]); X[B+1]=EX(X[B+1]); PIN(X); SBAR(); }while(0)
  #define VRD(i) do{ vlo[i]=vtr(vp_+(((i)>>2)*4096+((i)&3)*1024)); vhi[i]=vtr(vp_+(((i)>>2)*4096+((i)&3)*1024+512)); }while(0)
  #define KRD(G,j) do{ if(G){ kload2(kf,kp0+sl_next,j); SBAR(); } }while(0)
  #define STEP(C0,C1,P0,P1,t,GK,GV,GL,GM) do{ SBAR(); \
    const lds_cptr vp_=vp0+VS(sl_prev); \
    if(MASKED){ MKRD(t); BIAS(C0,C1,negm); SBAR(); } \
    VRD(0); SBAR(); float sacc=(P0[0]+P0[1]); \
    GAPA(C0=__builtin_amdgcn_mfma_f32_32x32x16_bf16(kf[0],qr[0],(MASKED?C0:negm),0,0,0), P0[2],P0[3],P0[4],P0[5],     pw0[0]=PKW(P0,0), pw0[1]=PKW(P0,2), pw0); \
    VRD(4); SBAR(); GAPA(C1=__builtin_amdgcn_mfma_f32_32x32x16_bf16(kf[1],qr[0],(MASKED?C1:negm),0,0,0), P0[6],P0[7],P0[8],P0[9],     pw0[2]=PKW(P0,4), pw0[3]=PKW(P0,6), pw0); \
    VRD(1); SBAR(); GAPA(C0=__builtin_amdgcn_mfma_f32_32x32x16_bf16(kf[2],qr[1],C0,0,0,0),   P0[10],P0[11],P0[12],P0[13], pw1[0]=PKW(P0,8), pw1[1]=PKW(P0,10), pw1); \
    VRD(5); SBAR(); GAPA(C1=__builtin_amdgcn_mfma_f32_32x32x16_bf16(kf[3],qr[1],C1,0,0,0),   P0[14],P0[15],P1[0],P1[1],   pw1[2]=PKW(P0,12),pw1[3]=PKW(P0,14), pw1); \
    VRD(2); SBAR(); GAPA(C0=__builtin_amdgcn_mfma_f32_32x32x16_bf16(kf[4],qr[2],C0,0,0,0),   P1[2],P1[3],P1[4],P1[5],     pw2[0]=PKW(P1,0), pw2[1]=PKW(P1,2), pw2); \
    VRD(6); SBAR(); GAPA(C1=__builtin_amdgcn_mfma_f32_32x32x16_bf16(kf[5],qr[2],C1,0,0,0),   P1[6],P1[7],P1[8],P1[9],     pw2[2]=PKW(P1,4), pw2[3]=PKW(P1,6), pw2); \
    VRD(3); SBAR(); GAPA(C0=__builtin_amdgcn_mfma_f32_32x32x16_bf16(kf[6],qr[3],C0,0,0,0),   P1[10],P1[11],P1[12],P1[13], pw3[0]=PKW(P1,8), pw3[1]=PKW(P1,10), pw3); \
    VRD(7); SBAR(); GAPA(C1=__builtin_amdgcn_mfma_f32_32x32x16_bf16(kf[7],qr[3],C1,0,0,0),   P1[14],P1[15],0.f,0.f,       pw3[2]=PKW(P1,12),pw3[3]=PKW(P1,14), pw3); \
    l_reg+=sacc; \
    if(GK){DMA_K((t)+3,sl_cur);} if(GV){DMA_V((t)+1,sl_next);} if(MASKED&&GM){ if((((t)&3)==0)&&((t)+4<NT)){DMA_M4((t)+4);} } \
    CMASK(C0,C1,t); \
    if constexpr(!NOMAX){ float a=MX3(C0[0],C0[1],C1[0]),b=MX3(C0[2],C0[3],C1[1]); a=MX3(a,C1[2],C1[3]); \
      _Pragma("unroll") for(int r=4;r<16;r+=4){a=MX3(a,C0[r],C0[r+1]);b=MX3(b,C0[r+2],C0[r+3]);a=MX3(a,C1[r],C1[r+1]);b=MX3(b,C1[r+2],C1[r+3]);} \
      float rm=__builtin_fmaxf(a,b); { auto rr=__builtin_amdgcn_permlane32_swap(__float_as_uint(rm),__float_as_uint(rm),false,false); rm=__builtin_fmaxf(__uint_as_float(rr[0]),__uint_as_float(rr[1])); } \
      resc=false; \
      if(__builtin_expect(__any(rm>(float)THRL),0)){ const float dl=__builtin_fmaxf(rm,0.f); mhat+=dl; \
        _Pragma("unroll") for(int r=0;r<16;++r){C0[r]-=dl;C1[r]-=dl;} \
        _Pragma("unroll") for(int r=0;r<16;++r)negm[r]=-mhat; asm volatile("":"+v"(negm)); \
        const float f=__builtin_amdgcn_exp2f(-dl); l_reg*=f; if(hi==0)wsf[r32]=f; resc=true; } } \
    SBAR(); \
    GAPB(o[0]=__builtin_amdgcn_mfma_f32_32x32x16_bf16(PAF(0),VFR(0),o[0],0,0,0), C0,0,mw0); \
    GAPB(o[1]=__builtin_amdgcn_mfma_f32_32x32x16_bf16(PAF(0),VFR(4),o[1],0,0,0), C0,4,mw0); \
    KRD(GL,0); GAPB(o[0]=__builtin_amdgcn_mfma_f32_32x32x16_bf16(PAF(1),VFR(1),o[0],0,0,0), C0,8,mw0); \
    KRD(GL,1); GAPB(o[1]=__builtin_amdgcn_mfma_f32_32x32x16_bf16(PAF(1),VFR(5),o[1],0,0,0), C0,12,mw0); \
    KRD(GL,2); GAPB(o[0]=__builtin_amdgcn_mfma_f32_32x32x16_bf16(PAF(2),VFR(2),o[0],0,0,0), C1,0,mw1); \
    KRD(GL,3); GAPB(o[1]=__builtin_amdgcn_mfma_f32_32x32x16_bf16(PAF(2),VFR(6),o[1],0,0,0), C1,4,mw1); \
    GAPB(o[0]=__builtin_amdgcn_mfma_f32_32x32x16_bf16(PAF(3),VFR(3),o[0],0,0,0), C1,8,mw1); \
    GAPB(o[1]=__builtin_amdgcn_mfma_f32_32x32x16_bf16(PAF(3),VFR(7),o[1],0,0,0), C1,12,mw1); \
    }while(0)
  #define VLD(n,f) do{ vlo[(n)&3]=vtr(vp_+(((f)>>2)*4096+((f)&3)*1024)); vhi[(n)&3]=vtr(vp_+(((f)>>2)*4096+((f)&3)*1024+512)); }while(0)
  #define VFW(n) (bf16x8){vlo[(n)&3][0],vlo[(n)&3][1],vlo[(n)&3][2],vlo[(n)&3][3],vhi[(n)&3][0],vhi[(n)&3][1],vhi[(n)&3][2],vhi[(n)&3][3]}
  #define PVN(OD,k,n,fnext) do{ OD=__builtin_amdgcn_mfma_f32_32x32x16_bf16(PAF(k),VFW(n),OD,0,0,0); SBAR(); if((fnext)>=0){ VLD(n,fnext); SBAR(); } }while(0)
  #define STEPW(C0,C1,P0,P1,t,GK,GV,GL) do{ SBAR(); \
    const lds_cptr vp_=vp0+VS(sl_prev); \
    VLD(0,0); SBAR(); float sacc=(P0[0]+P0[1]); f32x16 ci_=f32x16{}; if constexpr(!NOMAX){ const float nm_=-mhat; _Pragma("unroll") for(int r=0;r<16;++r)ci_[r]=nm_; }     \
    GAPA(C0=__builtin_amdgcn_mfma_f32_32x32x16_bf16(kf[0],qr[0],ci_,0,0,0), P0[2],P0[3],P0[4],P0[5],     pw0[0]=PKW(P0,0), pw0[1]=PKW(P0,2), pw0); \
    VLD(1,4); SBAR(); GAPA(C1=__builtin_amdgcn_mfma_f32_32x32x16_bf16(kf[1],qr[0],ci_,0,0,0), P0[6],P0[7],P0[8],P0[9],     pw0[2]=PKW(P0,4), pw0[3]=PKW(P0,6), pw0); \
    VLD(2,1); SBAR(); GAPA(C0=__builtin_amdgcn_mfma_f32_32x32x16_bf16(kf[2],qr[1],C0,0,0,0),   P0[10],P0[11],P0[12],P0[13], pw1[0]=PKW(P0,8), pw1[1]=PKW(P0,10), pw1); \
    VLD(3,5); SBAR(); GAPA(C1=__builtin_amdgcn_mfma_f32_32x32x16_bf16(kf[3],qr[1],C1,0,0,0),   P0[14],P0[15],P1[0],P1[1],   pw1[2]=PKW(P0,12),pw1[3]=PKW(P0,14), pw1); \
    GAPA(C0=__builtin_amdgcn_mfma_f32_32x32x16_bf16(kf[4],qr[2],C0,0,0,0),   P1[2],P1[3],P1[4],P1[5],     pw2[0]=PKW(P1,0), pw2[1]=PKW(P1,2), pw2); \
    GAPA(C1=__builtin_amdgcn_mfma_f32_32x32x16_bf16(kf[5],qr[2],C1,0,0,0),   P1[6],P1[7],P1[8],P1[9],     pw2[2]=PKW(P1,4), pw2[3]=PKW(P1,6), pw2); \
    GAPA(C0=__builtin_amdgcn_mfma_f32_32x32x16_bf16(kf[6],qr[3],C0,0,0,0),   P1[10],P1[11],P1[12],P1[13], pw3[0]=PKW(P1,8), pw3[1]=PKW(P1,10), pw3); \
    GAPA(C1=__builtin_amdgcn_mfma_f32_32x32x16_bf16(kf[7],qr[3],C1,0,0,0),   P1[14],P1[15],0.f,0.f,       pw3[2]=PKW(P1,12),pw3[3]=PKW(P1,14), pw3); \
    l_reg+=sacc; \
    if(GK){DMA_K((t)+3,sl_cur);} if(GV){DMA_V((t)+1,sl_next);} \
    CMASK(C0,C1,t); \
    if constexpr(!NOMAX){ float a=MX3(C0[0],C0[1],C1[0]),b=MX3(C0[2],C0[3],C1[1]); a=MX3(a,C1[2],C1[3]); \
      _Pragma("unroll") for(int r=4;r<16;r+=4){a=MX3(a,C0[r],C0[r+1]);b=MX3(b,C0[r+2],C0[r+3]);a=MX3(a,C1[r],C1[r+1]);b=MX3(b,C1[r+2],C1[r+3]);} \
      float rm=__builtin_fmaxf(a,b); { auto rr=__builtin_amdgcn_permlane32_swap(__float_as_uint(rm),__float_as_uint(rm),false,false); rm=__builtin_fmaxf(__uint_as_float(rr[0]),__uint_as_float(rr[1])); } \
      resc=false; \
      if(__builtin_expect(__any(rm>(float)THRL),0)){ const float dl=__builtin_fmaxf(rm,0.f); mhat+=dl; \
        _Pragma("unroll") for(int r=0;r<16;++r){C0[r]-=dl;C1[r]-=dl;} \
        const float f=__builtin_amdgcn_exp2f(-dl); l_reg*=f; if(hi==0)wsf[r32]=f; resc=true; } } \
    SBAR(); \
    GAPB2(o[0]=__builtin_amdgcn_mfma_f32_32x32x16_bf16(PAF(0),VFW(0),o[0],0,0,0), C0,0); VLD(0,2); SBAR(); \
    GAPB2(o[1]=__builtin_amdgcn_mfma_f32_32x32x16_bf16(PAF(0),VFW(1),o[1],0,0,0), C0,2); VLD(1,6); SBAR(); \
    KRD(GL,0); GAPB2(o[0]=__builtin_amdgcn_mfma_f32_32x32x16_bf16(PAF(1),VFW(2),o[0],0,0,0), C0,4); VLD(2,3); SBAR(); \
    KRD(GL,1); GAPB2(o[1]=__builtin_amdgcn_mfma_f32_32x32x16_bf16(PAF(1),VFW(3),o[1],0,0,0), C0,6); VLD(3,7); SBAR(); \
    KRD(GL,2); GAPB2(o[0]=__builtin_amdgcn_mfma_f32_32x32x16_bf16(PAF(2),VFW(4),o[0],0,0,0), C0,8); VLD(4,8); SBAR(); \
    KRD(GL,3); GAPB2(o[1]=__builtin_amdgcn_mfma_f32_32x32x16_bf16(PAF(2),VFW(5),o[1],0,0,0), C0,10); VLD(5,12); SBAR(); \
    GAPB2(o[0]=__builtin_amdgcn_mfma_f32_32x32x16_bf16(PAF(3),VFW(6),o[0],0,0,0), C0,12); VLD(6,9); SBAR(); \
    GAPB2(o[1]=__builtin_amdgcn_mfma_f32_32x32x16_bf16(PAF(3),VFW(7),o[1],0,0,0), C0,14); VLD(7,13); SBAR(); \
    GAPB2(o[2]=__builtin_amdgcn_mfma_f32_32x32x16_bf16(PAF(0),VFW(8),o[2],0,0,0), C1,0); VLD(8,10); SBAR(); \
    GAPB2(o[3]=__builtin_amdgcn_mfma_f32_32x32x16_bf16(PAF(0),VFW(9),o[3],0,0,0), C1,2); VLD(9,14); SBAR(); \
    GAPB2(o[2]=__builtin_amdgcn_mfma_f32_32x32x16_bf16(PAF(1),VFW(10),o[2],0,0,0), C1,4); VLD(10,11); SBAR(); \
    GAPB2(o[3]=__builtin_amdgcn_mfma_f32_32x32x16_bf16(PAF(1),VFW(11),o[3],0,0,0), C1,6); VLD(11,15); SBAR(); \
    GAPB2(o[2]=__builtin_amdgcn_mfma_f32_32x32x16_bf16(PAF(2),VFW(12),o[2],0,0,0), C1,8); \
    GAPB2(o[3]=__builtin_amdgcn_mfma_f32_32x32x16_bf16(PAF(2),VFW(13),o[3],0,0,0), C1,10); \
    GAPB2(o[2]=__builtin_amdgcn_mfma_f32_32x32x16_bf16(PAF(3),VFW(14),o[2],0,0,0), C1,12); \
    GAPB2(o[3]=__builtin_amdgcn_mfma_f32_32x32x16_bf16(PAF(3),VFW(15),o[3],0,0,0), C1,14); \
    }while(0)
  #define STEPX(C0,C1,P0,P1,t,GK,GV,GL,GM) do{ if constexpr(WIDE){ STEPW(C0,C1,P0,P1,t,GK,GV,GL); } else { STEP(C0,C1,P0,P1,t,GK,GV,GL,GM); } }while(0)
  int t=1;
  #undef CMASK
  #define CMASK(P0,P1,t) do{}while(0)
  for(;t+5<NT;t+=2){
    STEPX(pB0,pB1,pA0,pA1,t,true,true,true,true);     if(WIDE){WAIT_BAR(3);}else{WAIT_BAR(2);} RESC(); ROT();
    STEPX(pA0,pA1,pB0,pB1,t+1,true,true,true,true);   if(WIDE||(MASKED&&(((t+1)&3)==0))){WAIT_BAR(3);}else{WAIT_BAR(2);} RESC(); ROT();
  }
  #undef CMASK
  #define CMASK(P0,P1,t) do{int jb_=(t)-(NT-4); if(jb_>=0)cmask(P0,P1,jb_,qrel,hi);}while(0)
  #define ENDW(tt) do{ if(WIDE){ if((tt)+3<NT){WAIT_BAR(3);} else if((tt)+2<NT){WAIT_BAR(2);} else {WAIT_BAR(0);} } else { if((tt)+3<NT){WAIT_BAR(2);} else if((tt)+2<NT){WAIT_BAR(1);} else {WAIT_BAR(0);} } }while(0)
  for(;t+1<NT;t+=2){
    STEPX(pB0,pB1,pA0,pA1,t,(t+3<NT),(t+1<NT),(t+1<NT),(t+2<NT));       ENDW(t);   RESC(); ROT();
    STEPX(pA0,pA1,pB0,pB1,t+1,(t+4<NT),(t+2<NT),(t+2<NT),(t+3<NT));     ENDW(t+1); RESC(); ROT();
  }
  STEPX(pB0,pB1,pA0,pA1,NT-1,false,false,false,false); RESC();
  { float sacc=pB0[0]+pB0[1]; _Pragma("unroll") for(int r=2;r<16;++r)sacc+=pB0[r]; _Pragma("unroll") for(int r=0;r<16;++r)sacc+=pB1[r]; l_reg+=sacc;
    pw0=(u32x4){PKW(pB0,0),PKW(pB0,2),PKW(pB0,4),PKW(pB0,6)};pw1=(u32x4){PKW(pB0,8),PKW(pB0,10),PKW(pB0,12),PKW(pB0,14)};pw2=(u32x4){PKW(pB1,0),PKW(pB1,2),PKW(pB1,4),PKW(pB1,6)};pw3=(u32x4){PKW(pB1,8),PKW(pB1,10),PKW(pB1,12),PKW(pB1,14)};
    SBAR(); pv(o,vb0+VS(sl_cur),PAF(0),PAF(1),PAF(2),PAF(3)); if(WIDE){ pv(o+2,vb0+VS(sl_cur)+8192,PAF(0),PAF(1),PAF(2),PAF(3)); } }
  #undef PKW
  #undef PAF
  #undef VFR
  #undef PIN
  #undef MX3
  #undef GAPA
  #undef GAPB
  #undef GAPB2
  #undef EX
  #undef VRD
  #undef KRD
  #undef VLD
  #undef VFW
  #undef PVN
  #undef STEPW
  #undef STEPX
  #undef STEP
  #undef ENDW
  {auto rr=__builtin_amdgcn_permlane32_swap(__float_as_uint(l_reg),__float_as_uint(l_reg),false,false);l_reg=__uint_as_float(rr[0])+__uint_as_float(rr[1]);}
  if constexpr(NOMAX){ if(!(l_reg>7.9e-31f&&l_reg<1.2e30f))*(__attribute__((address_space(3))) unsigned*)((__attribute__((address_space(3))) char*)shm+badoff)=1u; }
  if(hi==0)wsf[32+r32]=l_reg;asm volatile("s_waitcnt lgkmcnt(0)":::"memory");
  float rli[16];
  #pragma unroll
  for(int r=0;r<16;++r)rli[r]=__builtin_amdgcn_rcpf(wsf[32+crow(r,hi)]);
  bf16*Ow=O+(rowbase+q0+wid*QBLK)*DM+hv*D;
  #pragma unroll
  for(int hf=0;hf<(WIDE?2:1);++hf){ bf16*stg=(bf16*)(shm+L_OST)+wid*2048;
    #pragma unroll
    for(int r=0;r<16;++r){const int orow=crow(r,hi);
      #pragma unroll
      for(int d0=0;d0<2;++d0)stg[orow*64+d0*32+r32]=__float2bfloat16(o[2*hf+d0][r]*rli[r]);}
    asm volatile("s_waitcnt lgkmcnt(0)":::"memory");
    #pragma unroll
    for(int i=0;i<4;++i){const int row=i*8+(lane>>3),ch=lane&7; const u32x4 v=*(const u32x4*)(stg+row*64+ch*8); ATTN_STORE16(Ow+(long)row*DM+hf*64+ch*8,v);}
    asm volatile("s_waitcnt lgkmcnt(0)":::"memory"); }
  asm volatile("s_waitcnt lgkmcnt(0)\n\ts_barrier":::"memory");
  #undef DMA_K
  #undef DMA_V
  #undef DMA_M4
  #undef MKRD
  #undef MAND
  #undef TABRD
  #undef BIAS
  #undef CMASK
  #undef START
  #undef RESC
  #undef ROT
  #undef VS
}
constexpr int ATTN_LDS_BYTES=LDS_BYTES+NW*1024+4096;
__device__ __forceinline__ void mask_table_init(char*shm,int tid){
  if(tid<256){ u32x4 v; unsigned e[8];
    #pragma unroll
    for(int j=0;j<8;++j) e[j]=((tid>>j)&1)?0u:0xC400u;
    v.x=e[0]|(e[1]<<16); v.y=e[2]|(e[3]<<16); v.z=e[4]|(e[5]<<16); v.w=e[6]|(e[7]<<16);
    *(u32x4*)(shm+LDS_MK+NW*2048+tid*16)=v; }
  __syncthreads();
}
#undef SBAR
#undef WAIT_BAR
}

constexpr int NWAVES = 8;
#ifndef MK_PER_PHASE
#define MK_PER_PHASE 0
#endif

#ifndef CHK
#define CHK 0
#endif
constexpr int CW_CHK = 2;
constexpr int BATCH = 2, SEQ = 16384, NTOK = BATCH * SEQ, DMODEL = 1024, DEPTH = 2;
constexpr int WIN_OLD = 5704, WIN_NEW = 5888, P1_N = 3840;
constexpr float LN_EPS = 1e-5f, ALPHA = 1.41421356237f;
constexpr int NPH_LAYER = 12, NPHASE = DEPTH * NPH_LAYER;

constexpr size_t MiB = 1u << 20;
constexpr size_t WS_CTL = 0, CTL_ZERO_BYTES = 1 * MiB;
constexpr size_t WS_SMALL = 1 * MiB, SM_LAM = 0, SM_WR = 4096, SM_BR = SM_WR + 2 * 36 * 1024 * 4;
constexpr size_t WS_ROPE = 2 * MiB;
constexpr size_t WS_ROUTE = 4 * MiB, RT_E = 0, RT_C = 256 * 1024, RT_HIST = 512 * 1024, RT_TOT = 544 * 1024, RT_ROW = 576 * 1024, RT_ENT = 864 * 1024, RT_CW = 1152 * 1024;
constexpr int LIST_CAP = 65536 + 32 * 256;
constexpr size_t WS_WB = 6 * MiB;
constexpr size_t WB_WIN = 0, WB_WBD = (size_t)WIN_NEW * 1024 * 2, WB_WBS = WB_WBD + MiB, WB_WO = WB_WBS + MiB, WB_WPG = WB_WO + 2 * MiB, WB_WPLE = WB_WPG + 2 * MiB,
                 WB_WGU = WB_WPLE + MiB / 2, WB_WD = WB_WGU + 32 * MiB, WB_END = WB_WD + 16 * MiB;
static_assert(WB_END == 66 * MiB, "weight copies");
constexpr size_t WB_WG8 = WB_WIN + (size_t)3840 * 1024 * 2;
constexpr size_t WS_XB = 72 * MiB;
constexpr size_t WS_DQ = 136 * MiB, TSTRIDE = 32 * MiB, WS_IK = 360 * MiB, WS_IW = 364 * MiB;
constexpr size_t WS_O0 = 365 * MiB, WS_O1 = 397 * MiB, WS_YB = 429 * MiB, WS_MASK = 461 * MiB;
constexpr long MASK_BSTRIDE = 2105344;
constexpr size_t WS_YA = 136 * MiB, WS_MERGED = 168 * MiB, WS_TMPG = 240 * MiB, WS_PRE1 = 240 * MiB;
constexpr size_t OUT_XB8 = 0, OUT_X1B8 = 32 * MiB, OUT_T1 = 64 * MiB;
constexpr size_t WS_HG = 136 * MiB, WS_PLE = 172 * MiB, WS_Y0 = 368 * MiB, WS_Y1 = 432 * MiB, WS_PB = 496 * MiB, WS_END = 512 * MiB;
static_assert(WS_MASK + 2 * MASK_BSTRIDE * 8 <= WS_PB, "mask fits");
constexpr int CW_TMO = 0, CW_CODE = 1, CW_BAR = 4096, CW_QUEUE = 8192;

constexpr int RING_OFF = 0, RING_BYTES = 131072;
constexpr int XTR_OFF = RING_BYTES, XTR_BYTES = 4096;
constexpr int MISC_OFF = XTR_OFF + XTR_BYTES;
constexpr int LDS_BYTES = 147456;
static_assert(MISC_OFF + 128 <= LDS_BYTES, "LDS map");
#define GAS __attribute__((address_space(1)))
#define LAS __attribute__((address_space(3)))
typedef unsigned short bf16;
typedef unsigned v4u __attribute__((ext_vector_type(4)));
typedef float f32x4 __attribute__((ext_vector_type(4)));
typedef short bf16x8 __attribute__((ext_vector_type(8)));
typedef GAS unsigned gu32;
typedef GAS unsigned long long gu64;
#define RLX_AGENT __ATOMIC_RELAXED, __HIP_MEMORY_SCOPE_AGENT
#define LDS_WAIT() asm volatile("s_waitcnt lgkmcnt(0)" ::: "memory")
#define VM_WAIT() asm volatile("s_waitcnt vmcnt(0)" ::: "memory")
__device__ __forceinline__ unsigned long long rt() { return __builtin_amdgcn_s_memrealtime(); }
__device__ __forceinline__ unsigned f2bf(float f) { unsigned u = __builtin_bit_cast(unsigned, f); return (u + 0x7fffu + ((u >> 16) & 1u)) >> 16; }
__device__ __forceinline__ unsigned pk2(float lo, float hi) { return f2bf(lo) | (f2bf(hi) << 16); }

#define XB_TMO      128
#define XB_XCNT(j)  (256  + 64 * (j))
#define XB_XSUB(j)  (1280 + 64 * (j))
#define XB_XGEN(j)  (2304 + 64 * (j))
#define XB_TOP      3328
#define XB_TOPGEN   3392
#define XCD_BAR_WORDS 3456
#define XB_SPIN_CAP (1u << 18)

__device__ __forceinline__ unsigned xb_ld(unsigned* p)              { return __hip_atomic_load(p, __ATOMIC_RELAXED, __HIP_MEMORY_SCOPE_AGENT); }
__device__ __forceinline__ unsigned xb_add(unsigned* p, unsigned v) { return __hip_atomic_fetch_add(p, v, __ATOMIC_RELAXED, __HIP_MEMORY_SCOPE_AGENT); }
__device__ __forceinline__ unsigned xb_xcc_id() { return (unsigned)__builtin_amdgcn_s_getreg((3 << 11) | 20) & 0xFu; }
#define XB_SPIN(cond, bar) do { unsigned _sp = 0; while (cond) { __builtin_amdgcn_s_sleep(1); \
    if ((++_sp & 255u) == 0u) { if (xb_ld(&(bar)[XB_TMO])) break; if (_sp > XB_SPIN_CAP) { atomicAdd(&(bar)[XB_TMO], 1u); break; } } } } while (0)

struct XcdBarrier {
    unsigned* bar; unsigned x;
    volatile LAS unsigned* st;
};

__device__ __forceinline__ XcdBarrier xcd_barrier_post(unsigned* bar, volatile LAS unsigned* st) {
    XcdBarrier b; b.bar = bar; b.x = xb_xcc_id(); b.st = st;
    if (threadIdx.x == 0) (void)xb_add(&bar[XB_XCNT(b.x)], 1u);
    return b;
}
__device__ __forceinline__ void xcd_barrier_complete(unsigned* bar, unsigned x, unsigned& nloc, unsigned& nx) {
    const unsigned G = gridDim.x * gridDim.y * gridDim.z;
    unsigned sum, cnt, mine, sp = 0u;
    for (;;) {
        sum = 0u; cnt = 0u; mine = 0u;
#pragma unroll
        for (unsigned j = 0; j < 16; ++j) { const unsigned c = xb_ld(&bar[XB_XCNT(j)]); sum += c; cnt += (c > 0u) ? 1u : 0u; mine = (j == x) ? c : mine; }
        if (sum == G) break;
        __builtin_amdgcn_s_sleep(1);
        if ((++sp & 255u) == 0u) { if (xb_ld(&bar[XB_TMO])) break; if (sp > XB_SPIN_CAP) { atomicAdd(&bar[XB_TMO], 1u); break; } }
    }
    nloc = mine > 0u ? mine : 1u; nx = cnt > 0u ? cnt : 1u;
}

__device__ __forceinline__ void xcd_barrier(const XcdBarrier& b) {
    asm volatile("s_waitcnt vmcnt(0)" ::: "memory");
    __syncthreads();
    if (threadIdx.x == 0) {
        unsigned* bar = b.bar;
        __builtin_amdgcn_s_waitcnt(0);
        unsigned nloc = b.st[0], nx = b.st[1];
        if (nloc == 0u) { xcd_barrier_complete(bar, b.x, nloc, nx); b.st[0] = nloc; b.st[1] = nx; }
        const unsigned old = xb_add(&bar[XB_XSUB(b.x)], 1u);
        const unsigned gen = old / nloc;
        if (old + 1u == (gen + 1u) * nloc) {
            __builtin_amdgcn_fence(__ATOMIC_RELEASE, "agent");
            asm volatile("s_waitcnt vmcnt(0)" ::: "memory");
            const unsigned og = xb_add(&bar[XB_TOP], 1u);
            const unsigned tg = og / nx;
            if (og + 1u == (tg + 1u) * nx) xb_add(&bar[XB_TOPGEN], 1u);
            else XB_SPIN(xb_ld(&bar[XB_TOPGEN]) == tg, bar);
            __builtin_amdgcn_fence(__ATOMIC_ACQUIRE, "agent");
            xb_add(&bar[XB_XGEN(b.x)], 1u);
            asm volatile("s_waitcnt vmcnt(0)" ::: "memory");
        } else {
            XB_SPIN(xb_ld(&bar[XB_XGEN(b.x)]) == gen, bar);
            __builtin_amdgcn_fence(__ATOMIC_ACQUIRE, "agent");
            asm volatile("s_waitcnt vmcnt(0)" ::: "memory");
        }
    }
    __syncthreads();
}

#ifndef DBG
#define DBG 0
#endif
struct Args { const void* in[22]; float* out; unsigned char* ws; int ph_lo, ph_hi; };
struct Frame {
    LAS unsigned char* lds;
    volatile LAS unsigned* MISC;
    gu32* ctl;
    int tid, lane, wave;
    int vcu, G, bx;
    unsigned char* ws; unsigned char* ws0;
    float* out; float* out0;
    const Args* ap;
};
#define INP(k) (F.ap->in[(k)])
#define DPP_F(v, ctrl) __builtin_bit_cast(float, __builtin_amdgcn_update_dpp(0, __builtin_bit_cast(int, (v)), (ctrl), 0xf, 0xf, true))
__device__ __forceinline__ float row16_sum(float v) {
    v += DPP_F(v, 0xB1);
    v += DPP_F(v, 0x4E);
    v += DPP_F(v, 0x141);
    v += DPP_F(v, 0x140);
    return v;
}
__device__ __forceinline__ float wave_sum(float v) {
    v = row16_sum(v);
    { auto r = __builtin_amdgcn_permlane16_swap(__float_as_uint(v), __float_as_uint(v), false, false); v = __uint_as_float(r[0]) + __uint_as_float(r[1]); }
    { auto r = __builtin_amdgcn_permlane32_swap(__float_as_uint(v), __float_as_uint(v), false, false); v = __uint_as_float(r[0]) + __uint_as_float(r[1]); }
    return v;
}
__device__ __forceinline__ void wave_sum4(float p0, float p1, float p2, float p3, float (&out)[4]) {
    auto r = __builtin_amdgcn_permlane32_swap(__float_as_uint(p0), __float_as_uint(p1), false, false); const float s01 = __uint_as_float(r[0]) + __uint_as_float(r[1]);
    r = __builtin_amdgcn_permlane32_swap(__float_as_uint(p2), __float_as_uint(p3), false, false); const float s23 = __uint_as_float(r[0]) + __uint_as_float(r[1]);
    r = __builtin_amdgcn_permlane16_swap(__float_as_uint(s01), __float_as_uint(s23), false, false); float t = __uint_as_float(r[0]) + __uint_as_float(r[1]);
    t = row16_sum(t);
    out[0] = __uint_as_float((unsigned)__builtin_amdgcn_readlane((int)__float_as_uint(t), 0)); out[2] = __uint_as_float((unsigned)__builtin_amdgcn_readlane((int)__float_as_uint(t), 16));
    out[1] = __uint_as_float((unsigned)__builtin_amdgcn_readlane((int)__float_as_uint(t), 32)); out[3] = __uint_as_float((unsigned)__builtin_amdgcn_readlane((int)__float_as_uint(t), 48));
}
typedef float f32x2 __attribute__((ext_vector_type(2)));

__device__ __forceinline__ void tr_item(const float* W, int ldn, int col0, int nvalid, bf16* WT, int K, int row0, LAS float* scr, int kb, int lane) {
    const int k0 = 64 * kb, n = lane & 31;
#pragma unroll 8
    for (int i = 0; i < 32; ++i) { const int kk = 2 * i + (lane >> 5); scr[kk * 33 + n] = (n < nvalid) ? W[(size_t)(k0 + kk) * ldn + col0 + n] : 0.f; }
    LDS_WAIT(); asm volatile("" ::: "memory");
    const int c = lane & 7;
#pragma unroll
    for (int j = 0; j < 4; ++j) { const int nn = (lane >> 3) + 8 * j; const LAS float* s = scr + (8 * c) * 33 + nn;
        v4u o; o.x = pk2(s[0 * 33], s[1 * 33]); o.y = pk2(s[2 * 33], s[3 * 33]); o.z = pk2(s[4 * 33], s[5 * 33]); o.w = pk2(s[6 * 33], s[7 * 33]);
        *(GAS v4u*)(WT + (size_t)(row0 + nn) * K + k0 + 8 * c) = o; }
    LDS_WAIT(); asm volatile("" ::: "memory");
}
__device__ __forceinline__ unsigned pk4_fp8(float a, float b, float c, float d) { int p = __builtin_amdgcn_cvt_pk_fp8_f32(a, b, 0, false); return (unsigned)__builtin_amdgcn_cvt_pk_fp8_f32(c, d, p, true); }
__device__ __forceinline__ void tr_item8(const float* W, int ldn, int col0, unsigned char* WT, int K, int row0, LAS float* scr, int kb, int lane) {
    const int k0 = 64 * kb, n = lane & 31;
#pragma unroll 8
    for (int i = 0; i < 32; ++i) { const int kk = 2 * i + (lane >> 5); scr[kk * 33 + n] = W[(size_t)(k0 + kk) * ldn + col0 + n] * 64.f; }
    LDS_WAIT(); asm volatile("" ::: "memory");
    const int c = lane & 7;
#pragma unroll
    for (int j = 0; j < 4; ++j) { const int nn = (lane >> 3) + 8 * j; const LAS float* s = scr + (8 * c) * 33 + nn;
        const unsigned long long o = (unsigned long long)pk4_fp8(s[0 * 33], s[1 * 33], s[2 * 33], s[3 * 33]) | ((unsigned long long)pk4_fp8(s[4 * 33], s[5 * 33], s[6 * 33], s[7 * 33]) << 32);
        *(GAS unsigned long long*)(WT + (size_t)(row0 + nn) * K + k0 + 8 * c) = o; }
    LDS_WAIT(); asm volatile("" ::: "memory");
}
__device__ __forceinline__ void pw_phase(Frame& F, int l) {
    LAS float* scr = (LAS float*)(F.lds + RING_OFF + F.wave * 16384);
    const int gw = F.vcu * NWAVES + F.wave, NGW = F.G * NWAVES, lane = F.lane;
    unsigned char* wb = F.ws + WS_WB;
    bf16* WIN = (bf16*)(wb + WB_WIN);
    const float* w_in = (const float*)INP(3) + (size_t)l * 1024 * WIN_OLD;
    constexpr int I_A = 16 * 114, I_B = 16, I_C = 16 * 64, I_BD = 8 * 32, I_O = 16 * 32, I_PLE = 4 * 32, I_GU = 32 * 4 * 64, I_D = 32 * 128;
    constexpr int NITEMS = I_A + I_B + I_C + 2 * I_BD + 2 * I_O + I_PLE + I_GU + I_D;
    for (int it = gw; it < NITEMS; it += NGW) {
        int r = it;
        if (r < I_A) { const int kb = r / 114, nb = r % 114; tr_item(w_in, WIN_OLD, 32 * nb, 32, WIN, 1024, 32 * nb, scr, kb, lane); continue; } r -= I_A;
        if (r < I_B) { tr_item(w_in, WIN_OLD, 3648, 8, WIN, 1024, 3648, scr, r, lane); continue; } r -= I_B;
        if (r < I_C) { const int kb = r / 64, nb = r % 64; tr_item8(w_in, WIN_OLD, 3656 + 32 * nb, wb + WB_WG8, 1024, 32 * nb, scr, kb, lane); continue; } r -= I_C;
        if (r < I_BD) { tr_item((const float*)INP(6) + (size_t)l * 512 * 1024, 1024, 32 * (r % 32), 32, (bf16*)(wb + WB_WBD), 512, 32 * (r % 32), scr, r / 32, lane); continue; } r -= I_BD;
        if (r < I_BD) { tr_item((const float*)INP(7) + (size_t)l * 512 * 1024, 1024, 32 * (r % 32), 32, (bf16*)(wb + WB_WBS), 512, 32 * (r % 32), scr, r / 32, lane); continue; } r -= I_BD;
        if (r < I_O) { tr_item((const float*)INP(8) + (size_t)l * 1024 * 1024, 1024, 32 * (r % 32), 32, (bf16*)(wb + WB_WO), 1024, 32 * (r % 32), scr, r / 32, lane); continue; } r -= I_O;
        if (r < I_O) { tr_item8((const float*)INP(19) + (size_t)l * 1024 * 1024, 1024, 32 * (r % 32), wb + WB_WPG, 1024, 32 * (r % 32), scr, r / 32, lane); continue; } r -= I_O;
        if (r < I_PLE) { tr_item((const float*)INP(18) + (size_t)l * 256 * 1024, 1024, 32 * (r % 32), 32, (bf16*)(wb + WB_WPLE), 256, 32 * (r % 32), scr, r / 32, lane); continue; } r -= I_PLE;
        if (r < I_GU) { const int e = r >> 8, sub = (r >> 6) & 3, q = r & 63, kb = q >> 2, nb = q & 3;
            const float* W = ((sub & 1) ? (const float*)INP(16) : (const float*)INP(15)) + (size_t)(l * 32 + e) * 1024 * 256;
            tr_item8(W, 256, (sub >> 1) * 128 + 32 * nb, wb + WB_WGU, 1024, e * 512 + sub * 128 + 32 * nb, scr, kb, lane); continue; } r -= I_GU;
        { const int e = r >> 7, q = r & 127, kb = q >> 5, nb = q & 31;
            tr_item((const float*)INP(17) + (size_t)(l * 32 + e) * 256 * 1024, 1024, 32 * nb, 32, (bf16*)(wb + WB_WD), 256, e * 1024 + 32 * nb, scr, kb, lane); }
    }
    { unsigned z_ = 0u; asm volatile("" : "+v"(z_));
      for (int ch = F.vcu * 512 + F.tid; ch < 160 * 128; ch += F.G * 512) *(GAS v4u*)(WIN + (size_t)3680 * 1024 + (size_t)ch * 8) = (v4u){z_, z_, z_, z_}; }
    const float* p = (const float*)INP(1) + (size_t)l * NTOK * 256; bf16* PB = (bf16*)(F.ws + WS_PB);
    for (int m0 = gw; m0 < NTOK; m0 += 4 * NGW) { f32x4 v[4];
#pragma unroll
        for (int j = 0; j < 4; ++j) { const int m = min(m0 + j * NGW, NTOK - 1); v[j] = *((const GAS f32x4*)(p + (size_t)m * 256) + lane); }
#pragma unroll
        for (int j = 0; j < 4; ++j) { const int m = m0 + j * NGW; if (m < NTOK) *((GAS unsigned long long*)(PB + (size_t)m * 256) + lane) = (unsigned long long)pk2(v[j].x, v[j].y) | ((unsigned long long)pk2(v[j].z, v[j].w) << 32); } }
    if (l == 0) {
        const float* x = (const float*)INP(0); bf16* XB = (bf16*)(F.ws + WS_XB);
        for (int m0 = gw; m0 < NTOK; m0 += 2 * NGW) { f32x4 v[2][4];
#pragma unroll
            for (int r = 0; r < 2; ++r) { const int m = min(m0 + r * NGW, NTOK - 1); const GAS f32x4* xr = (const GAS f32x4*)(x + (size_t)m * 1024) + lane;
#pragma unroll
                for (int j = 0; j < 4; ++j) v[r][j] = xr[64 * j]; }
#pragma unroll
            for (int r = 0; r < 2; ++r) { const int m = m0 + r * NGW; if (m < NTOK) { GAS unsigned long long* o8 = (GAS unsigned long long*)(XB + (size_t)m * 1024) + lane;
#pragma unroll
                for (int j = 0; j < 4; ++j) { const f32x4 w = v[r][j]; o8[64 * j] = (unsigned long long)pk2(w.x, w.y) | ((unsigned long long)pk2(w.z, w.w) << 32);
                    ((GAS unsigned*)((unsigned char*)F.out + OUT_XB8 + (size_t)m * 1024) + lane)[64 * j] = pk4_fp8(w.x, w.y, w.z, w.w); } } }
        }
        const int* pos = (const int*)INP(2); float* rope = (float*)(F.ws + WS_ROPE);
        for (int idx = F.vcu * 512 + F.tid; idx < NTOK * 8; idx += F.G * 512) {
            const int m = idx >> 3, j = idx & 7; const float invf = exp2f(-2.366446071f * (float)j); const float ang = (float)pos[m] * invf;
            double rev = (double)ang * 0.15915494309189535; rev -= rint(rev);
            rope[m * 16 + j] = (DBG & 16) ? 1.f : __builtin_amdgcn_cosf((float)rev); rope[m * 16 + 8 + j] = (DBG & 16) ? 0.f : __builtin_amdgcn_sinf((float)rev);
        }
        float* WR = (float*)(F.ws + WS_SMALL + SM_WR); float* BR = (float*)(F.ws + WS_SMALL + SM_BR);
        for (int idx = F.vcu * 512 + F.tid; idx < 2 * 36 * 1024; idx += F.G * 512) {
            const int ll = idx / (36 * 1024), r = idx % (36 * 1024), j = r >> 10, k = r & 1023;
            WR[idx] = (j < 4) ? ((const float*)INP(11))[((size_t)ll * 1024 + k) * 4 + j] : ((const float*)INP(13))[((size_t)ll * 1024 + k) * 32 + (j - 4)];
        }
        if (F.vcu == 0 && F.tid < 72) { const int ll = F.tid / 36, j = F.tid % 36; BR[F.tid] = (j < 4) ? ((const float*)INP(12))[ll * 4 + j] : ((const float*)INP(14))[ll * 32 + j - 4]; }
        if (F.vcu == 0 && F.tid < 2) { const float* lp = (const float*)INP(4) + F.tid * 256; float a = 0.f, b = 0.f;
            for (int i = 0; i < 64; ++i) { a += lp[i] * lp[64 + i]; b += lp[128 + i] * lp[192 + i]; }
            const float lam_init = (F.tid == 0) ? 0.2f : 0.35550907f;
            ((float*)(F.ws + WS_SMALL + SM_LAM))[F.tid] = __expf(a) - __expf(b) + lam_init; }
    }
}

namespace idxr {
typedef float f32x16 __attribute__((ext_vector_type(16)));
typedef short s16x2 __attribute__((ext_vector_type(2)));
typedef __fp16 h16x2 __attribute__((ext_vector_type(2)));
constexpr int HROW = 513;
__device__ __forceinline__ unsigned f2key(float f) { const unsigned u = __float_as_uint(f); return u ^ ((unsigned)((int)u >> 31) | 0x80000000u); }
__device__ __forceinline__ unsigned bins2(float a, float b) {
    const unsigned h = __builtin_bit_cast(unsigned, __builtin_amdgcn_cvt_pkrtz(a, b));
    const unsigned m = __builtin_bit_cast(unsigned, (s16x2)(__builtin_bit_cast(s16x2, h) >> (s16x2){15, 15}));
    const unsigned key = h ^ (m | 0x80008000u);
    return (key >> 5) & 0x07fc07fcu;
}
__device__ __forceinline__ float f16bits(unsigned h) { return (float)__builtin_bit_cast(__fp16, (unsigned short)h); }
__device__ __forceinline__ float bin_edge(int b) {
    if (b <= 0) return -__builtin_inff();
    if (b >= 512) return __builtin_inff();
    const unsigned K = (unsigned)b << 7;
    if (K >= 0x8000u) { const unsigned H = K & 0x7fffu; return (H >= 0x7c00u) ? __builtin_inff() : f16bits(H); }
    const unsigned M1 = ((0xFFFFu ^ K) & 0x7fffu) + 1u;
    const float v = (M1 >= 0x7c00u) ? __builtin_inff() : f16bits(M1);
    return -__uint_as_float(__float_as_uint(v) - 1u);
}
__device__ __forceinline__ long moff(int tl) { return 16384L * tl - 32L * tl * (tl - 1); }
__device__ __forceinline__ void load_k2(bf16x8 (&ka)[2], bf16x8 (&kb)[2], const unsigned short* IKb, int key0, int kg0, int fr, int fq) {
#pragma unroll
    for (int ks = 0; ks < 2; ++ks) { ka[ks] = *(const bf16x8*)(IKb + (size_t)(key0 + 16 * kg0 + fr) * 64 + ks * 32 + fq * 8); kb[ks] = *(const bf16x8*)(IKb + (size_t)(key0 + 16 * kg0 + 16 + fr) * 64 + ks * 32 + fq * 8); }
}
__device__ __forceinline__ void score_half(f32x4& sa, f32x4& sb, const bf16x8 (&qf)[8][2], const bf16x8 (&ql)[2], const float (&w)[8], bf16x8 (&ka)[2], bf16x8 (&kb)[2]) {
    sa = __builtin_amdgcn_mfma_f32_16x16x32_bf16(ka[0], ql[0], (f32x4){0.f, 0.f, 0.f, 0.f}, 0, 0, 0); sb = __builtin_amdgcn_mfma_f32_16x16x32_bf16(kb[0], ql[0], (f32x4){0.f, 0.f, 0.f, 0.f}, 0, 0, 0);
    sa = __builtin_amdgcn_mfma_f32_16x16x32_bf16(ka[1], ql[1], sa, 0, 0, 0); sb = __builtin_amdgcn_mfma_f32_16x16x32_bf16(kb[1], ql[1], sb, 0, 0, 0);
    f32x4 Da[2], Db[2];
#define IDX_M(h, D) do { \
        D[0] = __builtin_amdgcn_mfma_f32_16x16x32_bf16(ka[0], qf[h][0], (f32x4){0.f, 0.f, 0.f, 0.f}, 0, 0, 0); D[1] = __builtin_amdgcn_mfma_f32_16x16x32_bf16(kb[0], qf[h][0], (f32x4){0.f, 0.f, 0.f, 0.f}, 0, 0, 0); \
        D[0] = __builtin_amdgcn_mfma_f32_16x16x32_bf16(ka[1], qf[h][1], D[0], 0, 0, 0); D[1] = __builtin_amdgcn_mfma_f32_16x16x32_bf16(kb[1], qf[h][1], D[1], 0, 0, 0); } while (0)
#define IDX_F(h, D, O) asm volatile("" : "+v"(O[0]), "+v"(O[1]));     \
        asm volatile( \
        "v_fma_f32 %0, %8, |%9|, %0\n\tv_fma_f32 %1, %8, |%10|, %1\n\tv_fma_f32 %2, %8, |%11|, %2\n\tv_fma_f32 %3, %8, |%12|, %3\n\t" \
        "v_fma_f32 %4, %8, |%13|, %4\n\tv_fma_f32 %5, %8, |%14|, %5\n\tv_fma_f32 %6, %8, |%15|, %6\n\tv_fma_f32 %7, %8, |%16|, %7" \
        : "+v"(sa[0]), "+v"(sa[1]), "+v"(sa[2]), "+v"(sa[3]), "+v"(sb[0]), "+v"(sb[1]), "+v"(sb[2]), "+v"(sb[3]) \
        : "v"(w[h]), "v"(D[0][0]), "v"(D[0][1]), "v"(D[0][2]), "v"(D[0][3]), "v"(D[1][0]), "v"(D[1][1]), "v"(D[1][2]), "v"(D[1][3])); \
        asm volatile("" : "+v"(ka[0]), "+v"(kb[0]))
    IDX_M(0, Da); IDX_M(1, Db);
    asm volatile("s_nop 7" : "+v"(Da[0]), "+v"(Da[1]), "+v"(Db[0]), "+v"(Db[1]), "+v"(sa), "+v"(sb));
#pragma unroll
    for (int h = 0; h < 6; h += 2) { IDX_F(h, Da, Db); IDX_M(h + 2, Da); IDX_F(h + 1, Db, Da); IDX_M(h + 3, Db); }
    IDX_F(6, Da, Db); asm volatile("s_nop 7" : "+v"(Db[0]), "+v"(Db[1])); IDX_F(7, Db, Da);
#undef IDX_M
#undef IDX_F
}
#define IDX_SCORE(sc, kf, key0, more) do { const int nk_ = (more) ? (key0) + 128 : (key0); \
        idxr::score_half(sc[0], sc[1], qf, ql, w, kf[0], kf[1]); idxr::load_k2(kf[0], kf[1], IKb, nk_, 0, fr, fq); \
        idxr::score_half(sc[2], sc[3], qf, ql, w, kf[2], kf[3]); idxr::load_k2(kf[2], kf[3], IKb, nk_, 2, fr, fq); } while (0)
}

__device__ __forceinline__ void indexer_unit(Frame& F, int b, int qblk, const bf16* IQ, const bf16* IK, const float* IW, unsigned long long* mask64  ) {
    using namespace idxr;
    const int lane = F.lane, fr = lane & 15, fq = lane >> 4, wid = F.wave, qgrp = wid & 3, kh = wid >> 2;
    const int qloc = 16 * qgrp + fr, q = 64 * qblk + qloc;
    const size_t row = (size_t)b * SEQ + q;
    LAS unsigned* hist = (LAS unsigned*)(F.lds + RING_OFF);
    LAS int* bstarA = (LAS int*)(F.lds + XTR_OFF + 1024); LAS int* needA = bstarA + 64; LAS float* thiA = (LAS float*)(needA + 64); LAS float* tloA = thiA + 64;
    LAS unsigned* cand = (LAS unsigned*)(F.lds + RING_OFF);
    LAS unsigned* wcnt = (LAS unsigned*)(F.lds + XTR_OFF + 2048);
    bf16x8 qf[8][2], ql[2]; float w[8];
#pragma unroll
    for (int h = 0; h < 8; ++h)
#pragma unroll
        for (int ks = 0; ks < 2; ++ks) qf[h][ks] = *(const bf16x8*)(IQ + row * 512 + h * 64 + ks * 32 + fq * 8);
    { const f32x4* wp = (const f32x4*)(IW + row * 8); const f32x4 w0 = wp[0], w1 = wp[1]; w[0] = 0.5f * w0.x; w[1] = 0.5f * w0.y; w[2] = 0.5f * w0.z; w[3] = 0.5f * w0.w; w[4] = 0.5f * w1.x; w[5] = 0.5f * w1.y; w[6] = 0.5f * w1.z; w[7] = 0.5f * w1.w; }
#pragma unroll
    for (int ks = 0; ks < 2; ++ks) {
        float acc8[8];
#pragma unroll
        for (int e = 0; e < 8; ++e) acc8[e] = 0.f;
#pragma unroll
        for (int h = 0; h < 8; ++h)
#pragma unroll
            for (int e = 0; e < 8; ++e) acc8[e] = __builtin_fmaf(w[h], __uint_as_float((unsigned)(unsigned short)qf[h][ks][e] << 16), acc8[e]);
#pragma unroll
        for (int e = 0; e < 8; e += 2) { const unsigned pk = pg8::cvt_pk_bf16(acc8[e], acc8[e + 1]); ql[ks][e] = (short)(pk & 0xffffu); ql[ks][e + 1] = (short)(pk >> 16); }
    }
    for (int i = F.tid; i < 64 * HROW; i += NWAVES * 64) hist[i] = 0u;
    __syncthreads();
    const unsigned short* IKb = IK + (size_t)b * SEQ * 64;
    const int qmin_w = 64 * qblk + 16 * qgrp;
    const unsigned hrowb = (unsigned)(size_t)(hist + qloc * HROW);
#define IDX_HADD(off_) __hip_atomic_fetch_add((LAS unsigned*)(hrowb + (off_)), 1u, __ATOMIC_RELAXED, __HIP_MEMORY_SCOPE_WORKGROUP)
    {
        bf16x8 kf[4][2];
        if (kh <= qblk) { load_k2(kf[0], kf[1], IKb, 64 * kh, 0, fr, fq); load_k2(kf[2], kf[3], IKb, 64 * kh, 2, fr, fq); }
#pragma unroll 1
        for (int tl = kh; tl <= qblk; tl += 2) {
            const int key0 = 64 * tl; f32x4 sc[4]; IDX_SCORE(sc, kf, key0, tl + 2 <= qblk);
            if (key0 + 63 <= qmin_w) {
#pragma unroll
                for (int kg = 0; kg < 4; ++kg) { const unsigned p0 = bins2(sc[kg][0], sc[kg][1]), p1 = bins2(sc[kg][2], sc[kg][3]);
                    IDX_HADD(p0 & 0xffffu); IDX_HADD(p0 >> 16); IDX_HADD(p1 & 0xffffu); IDX_HADD(p1 >> 16); __builtin_amdgcn_sched_barrier(0); }
            } else {
                int fq_ = fq, q_ = q; asm volatile("" : "+v"(fq_), "+v"(q_));
#pragma unroll
                for (int kg = 0; kg < 4; ++kg) { const unsigned p0 = bins2(sc[kg][0], sc[kg][1]), p1 = bins2(sc[kg][2], sc[kg][3]); const int kb = key0 + 16 * kg + 4 * fq_;
                    if (kb <= q_) IDX_HADD(p0 & 0xffffu); if (kb + 1 <= q_) IDX_HADD(p0 >> 16); if (kb + 2 <= q_) IDX_HADD(p1 & 0xffffu); if (kb + 3 <= q_) IDX_HADD(p1 >> 16); __builtin_amdgcn_sched_barrier(0); }
            }
        }
    }
#undef IDX_HADD
    __syncthreads();
#pragma unroll 1
    for (int qq = wid * 8; qq < wid * 8 + 8; ++qq) {
        const LAS unsigned* hr = hist + qq * HROW + lane * 8;
        unsigned wv[8]; unsigned s = 0;
#pragma unroll
        for (int k = 0; k < 8; ++k) { wv[k] = hr[k]; s += wv[k]; }
        unsigned v = s;
#define DPP_U(x, ctrl) (unsigned)__builtin_amdgcn_update_dpp(0, (int)(x), (ctrl), 0xf, 0xf, true)
        v += DPP_U(v, 0x101); v += DPP_U(v, 0x102); v += DPP_U(v, 0x104); v += DPP_U(v, 0x108);
#undef DPP_U
        { const unsigned t1 = (unsigned)__builtin_amdgcn_readlane((int)v, 16), t2 = (unsigned)__builtin_amdgcn_readlane((int)v, 32), t3 = (unsigned)__builtin_amdgcn_readlane((int)v, 48);
          const int rw = lane >> 4; v += (rw < 1 ? t1 : 0u) + (rw < 2 ? t2 : 0u) + (rw < 3 ? t3 : 0u); }
        const unsigned above = v - s, total = (unsigned)__builtin_amdgcn_readlane((int)v, 0);
        if (total > 256u) {
            if (above < 256u && v >= 256u) {
                unsigned c = above; int found = -1, need = 0;
#pragma unroll
                for (int k = 7; k >= 0; --k) { if (found < 0) { if (c + wv[k] >= 256u) { found = k; need = 256 - (int)c; } else c += wv[k]; } }
                bstarA[qq] = lane * 8 + found; needA[qq] = need; thiA[qq] = bin_edge(lane * 8 + found + 1); tloA[qq] = bin_edge(lane * 8 + found);
            }
        } else if (lane == 0) { bstarA[qq] = -1; needA[qq] = 0; thiA[qq] = -__builtin_inff(); tloA[qq] = -__builtin_inff(); }
    }
    __syncthreads();
    const float thi = thiA[qloc], tlo = tloA[qloc];
    unsigned ncand = 0u; LAS unsigned* const cbase = cand + (qloc * 8 + fq + 4 * kh) * 64;
#define IDX_EL(scv_, krel_) do { const float v_ = (scv_); \
        if (FULL_) { asm volatile("v_cmp_ge_f32 vcc, %2, %3\n\tv_addc_co_u32 %0, vcc, %0, %0, vcc\n\tv_cmp_ge_f32 vcc, %2, %4\n\tv_addc_co_u32 %1, vcc, %1, %1, vcc" : "+v"(nh_), "+v"(nl_) : "v"(v_), "v"(thi), "v"(tlo) : "vcc"); } \
        else { const bool ok_ = key0 + (krel_) <= q_; nh_ = nh_ + nh_ + ((ok_ && v_ >= thi) ? 1u : 0u); nl_ = nl_ + nl_ + ((ok_ && v_ >= tlo) ? 1u : 0u); } } while (0)
#define IDX_HALF(ka, kb, W_, C_) do { unsigned nh_ = 0u, nl_ = 0u; const int kr = 4 * fq_; \
        IDX_EL(sc[kb][3], 16 * kb + kr + 3); IDX_EL(sc[kb][2], 16 * kb + kr + 2); IDX_EL(sc[kb][1], 16 * kb + kr + 1); IDX_EL(sc[kb][0], 16 * kb + kr); nh_ <<= 12; nl_ <<= 12; \
        IDX_EL(sc[ka][3], 16 * ka + kr + 3); IDX_EL(sc[ka][2], 16 * ka + kr + 2); IDX_EL(sc[ka][1], 16 * ka + kr + 1); IDX_EL(sc[ka][0], 16 * ka + kr); \
        W_ = nh_ << kr; C_ = nl_ & ~nh_; __builtin_amdgcn_sched_barrier(0); } while (0)
#define IDX_ELS() do { IDX_HALF(0, 1, wlo, clo); IDX_HALF(2, 3, whi, chi); } while (0)
    {
        bf16x8 kf[4][2];
        if (kh <= qblk) { load_k2(kf[0], kf[1], IKb, 64 * kh, 0, fr, fq); load_k2(kf[2], kf[3], IKb, 64 * kh, 2, fr, fq); }
#pragma unroll 1
        for (int tl = kh; tl <= qblk; tl += 2) {
            const int key0 = 64 * tl; unsigned long long* mword = mask64 + (moff(tl) + (q - key0)); f32x4 sc[4]; IDX_SCORE(sc, kf, key0, tl + 2 <= qblk);
            unsigned wlo = 0u, whi = 0u, clo = 0u, chi = 0u; int fq_ = fq, q_ = q; asm volatile("" : "+v"(fq_), "+v"(q_));
            if (key0 + 63 <= qmin_w) {
#define FULL_ true
                IDX_ELS();
#undef FULL_
            } else {
#define FULL_ false
                IDX_ELS();
#undef FULL_
            }
            unsigned cb = clo | (chi << 4);
            if (cb != 0u) {
#pragma unroll 1
                while (cb != 0u) {
                    const int j = __builtin_ctz(cb); cb &= cb - 1u;
                    const bool b0 = (j & 1) != 0, b1 = (j & 2) != 0, b2 = (j & 4) != 0, b4 = (j & 16) != 0;
                    float y[4];
#pragma unroll
                    for (int kg = 0; kg < 4; ++kg) { const float x0 = b0 ? sc[kg][1] : sc[kg][0], x1 = b0 ? sc[kg][3] : sc[kg][2]; y[kg] = b1 ? x1 : x0; }
                    const float z0 = b4 ? y[1] : y[0], z1 = b4 ? y[3] : y[2]; const float v_ = b2 ? z1 : z0;
                    const int krel = 16 * ((b4 ? 1 : 0) + (b2 ? 2 : 0)) + 4 * fq_ + (j & 3);
                    if (ncand < 64u) cbase[ncand] = ((f2key(v_) & 0xffff8u) << 11) | (unsigned)(16383 - (key0 + krel)); ++ncand;
                }
            }
            { auto r_ = __builtin_amdgcn_permlane16_swap(wlo, wlo, false, false); wlo = r_[0] | r_[1]; r_ = __builtin_amdgcn_permlane16_swap(whi, whi, false, false); whi = r_[0] | r_[1];
              r_ = __builtin_amdgcn_permlane32_swap(wlo, wlo, false, false); wlo = r_[0] | r_[1]; r_ = __builtin_amdgcn_permlane32_swap(whi, whi, false, false); whi = r_[0] | r_[1]; }
            if (fq == 0) *mword = ((unsigned long long)whi << 32) | wlo;
        }
    }
#undef IDX_EL
#undef IDX_HALF
#undef IDX_ELS
    wcnt[qloc * 8 + fq + 4 * kh] = ncand < 64u ? ncand : 64u;
    VM_WAIT();
    __syncthreads();
#pragma unroll 1
    for (int qq = wid * 8; qq < wid * 8 + 8; ++qq) {
        const int need = needA[qq];
        if (need == 0) continue;
        unsigned e[8];
#pragma unroll
        for (int j = 0; j < 8; ++j) { const unsigned c = wcnt[qq * 8 + j]; e[j] = ((unsigned)lane < c) ? (cand[(qq * 8 + j) * 64 + lane] | 0x80000000u) : 0u; }
        unsigned T = 0x80000000u; int cntT = 0;
#pragma unroll
        for (int j = 0; j < 8; ++j) cntT += __builtin_popcountll(__ballot(e[j] >= T));
#pragma unroll 1
        for (int bit = 30; bit >= 0 && cntT != need; --bit) { const unsigned c = T | (1u << bit); int cnt = 0;
#pragma unroll
            for (int j = 0; j < 8; ++j) cnt += __builtin_popcountll(__ballot(e[j] >= c));
            if (cnt >= need) { T = c; cntT = cnt; } }
        const int qglob = 64 * qblk + qq;
#pragma unroll
        for (int j = 0; j < 8; ++j) if (e[j] >= T) { const int kidx = 16383 - (int)(e[j] & 0x3fffu); const int tl = kidx >> 6;
            __hip_atomic_fetch_or(mask64 + (moff(tl) + (qglob - 64 * tl)), 1ull << (kidx & 63), __ATOMIC_RELAXED, __HIP_MEMORY_SCOPE_AGENT); }
    }
    __syncthreads();
}

__device__ __forceinline__ void ya_phase(Frame& F, int l) {
    const int gw = F.vcu * NWAVES + F.wave, NGW = F.G * NWAVES, lane = F.lane;
    const bf16* O0 = (const bf16*)(F.ws + WS_O0); const bf16* O1 = (const bf16*)(F.ws + WS_O1); bf16* YA = (bf16*)(F.ws + WS_YA);
    const float lam = (DBG & 8) ? 0.f : ((const float*)(F.ws + WS_SMALL + SM_LAM))[l];
    const float lam_init = (l == 0) ? 0.2f : 0.35550907f;
    const float* gp = (const float*)INP(5) + l * 128 + (lane & 15) * 8;
    float gg[8];
#pragma unroll
    for (int i = 0; i < 8; ++i) gg[i] = gp[i] * (1.f - lam_init);
    for (int m0 = gw; m0 < NTOK; m0 += 4 * NGW) { v4u a4[4], c4[4];
#pragma unroll
      for (int j = 0; j < 4; ++j) { const int m = min(m0 + j * NGW, NTOK - 1); a4[j] = *(const GAS v4u*)(O0 + (size_t)m * 512 + lane * 8); c4[j] = *(const GAS v4u*)(O1 + (size_t)m * 512 + lane * 8); }
#pragma unroll
      for (int j = 0; j < 4; ++j) { const int m = m0 + j * NGW; if (m >= NTOK) break; const v4u a = a4[j], c = c4[j];
        f32x4 a0, a1, c0, c1; pg8::unpack8(a, a0, a1); pg8::unpack8(c, c0, c1);
        f32x4 d0 = a0 - c0 * lam, d1 = a1 - c1 * lam;
        float ss = (d0.x * d0.x + d0.y * d0.y) + (d0.z * d0.z + d0.w * d0.w) + (d1.x * d1.x + d1.y * d1.y) + (d1.z * d1.z + d1.w * d1.w);
        ss = row16_sum(ss);
        const float rs = 1.0f / sqrtf(ss * (1.0f / 128.0f) + LN_EPS);
        f32x4 o0 = {d0.x * rs * gg[0], d0.y * rs * gg[1], d0.z * rs * gg[2], d0.w * rs * gg[3]}, o1 = {d1.x * rs * gg[4], d1.y * rs * gg[5], d1.z * rs * gg[6], d1.w * rs * gg[7]};
        *(GAS v4u*)(YA + (size_t)m * 512 + lane * 8) = pg8::pack8(o0, o1);
      }
    }
}

__device__ __forceinline__ void ya_unit(Frame& F, int l, int b, int h, int qb) {
    const int lane = F.lane;
    const bf16* O0 = (const bf16*)(F.ws + WS_O0); const bf16* O1 = (const bf16*)(F.ws + WS_O1); bf16* YA = (bf16*)(F.ws + WS_YA);
    const float lam = (DBG & 8) ? 0.f : ((const float*)(F.ws + WS_SMALL + SM_LAM))[l];
    const float lam_init = (l == 0) ? 0.2f : 0.35550907f;
    const float* gp = (const float*)INP(5) + l * 128 + (lane & 15) * 8;
    float gg[8];
#pragma unroll
    for (int i = 0; i < 8; ++i) gg[i] = gp[i] * (1.f - lam_init);
    const size_t e0 = ((size_t)b * SEQ + (size_t)qb * 256 + F.wave * 4 + (lane >> 4)) * 512 + h * 128 + (lane & 15) * 8;
    v4u a8[8], c8[8];
#pragma unroll
    for (int it = 0; it < 8; ++it) { a8[it] = *(const GAS v4u*)(O0 + e0 + (size_t)it * 32 * 512); c8[it] = *(const GAS v4u*)(O1 + e0 + (size_t)it * 32 * 512); }
#pragma unroll
    for (int it = 0; it < 8; ++it) {
        f32x4 a0, a1, c0, c1; pg8::unpack8(a8[it], a0, a1); pg8::unpack8(c8[it], c0, c1);
        f32x4 d0 = a0 - c0 * lam, d1 = a1 - c1 * lam;
        float ss = (d0.x * d0.x + d0.y * d0.y) + (d0.z * d0.z + d0.w * d0.w) + (d1.x * d1.x + d1.y * d1.y) + (d1.z * d1.z + d1.w * d1.w);
        ss = row16_sum(ss);
        const float rs = 1.0f / sqrtf(ss * (1.0f / 128.0f) + LN_EPS);
        f32x4 o0 = {d0.x * rs * gg[0], d0.y * rs * gg[1], d0.z * rs * gg[2], d0.w * rs * gg[3]}, o1 = {d1.x * rs * gg[4], d1.y * rs * gg[5], d1.z * rs * gg[6], d1.w * rs * gg[7]};
        *(GAS v4u*)(YA + e0 + (size_t)it * 32 * 512) = pg8::pack8(o0, o1);
    }
}

__device__ __forceinline__ void ln_row(f32x4 (&v)[4], const float* g, const float* bb, int lane) {
    float s = 0.f;
#pragma unroll
    for (int j = 0; j < 4; ++j) s += (v[j].x + v[j].y) + (v[j].z + v[j].w);
    const float mean = wave_sum(s) * (1.f / 1024.f); float s2 = 0.f;
#pragma unroll
    for (int j = 0; j < 4; ++j) { v[j] = v[j] - mean; s2 += (v[j].x * v[j].x + v[j].y * v[j].y) + (v[j].z * v[j].z + v[j].w * v[j].w); }
    const float rstd = 1.f / sqrtf(wave_sum(s2) * (1.f / 1024.f) + LN_EPS);
#pragma unroll
    for (int j = 0; j < 4; ++j) { const f32x4 gv = *((const f32x4*)g + lane + 64 * j), bv = *((const f32x4*)bb + lane + 64 * j); v[j] = v[j] * rstd * gv + bv; }
}

__device__ __forceinline__ void ln1_router_phase(Frame& F, int l) {
    const int gw = F.vcu * NWAVES + F.wave, NGW = F.G * NWAVES, lane = F.lane;
    const bf16* PRE = (const bf16*)(F.ws + WS_PRE1); bf16* X1B = (bf16*)(F.ws + WS_XB);
    const float* g1 = (const float*)INP(9) + l * 1024; const float* b1 = (const float*)INP(10) + l * 1024;
    const float* WR = (const float*)(F.ws + WS_SMALL + SM_WR) + (size_t)l * 36 * 1024; const float* BR = (const float*)(F.ws + WS_SMALL + SM_BR) + l * 36;
    int* route_e = (int*)(F.ws + WS_ROUTE + RT_E); float* route_c = (float*)(F.ws + WS_ROUTE + RT_C);
    LAS unsigned* rhist = (LAS unsigned*)(F.lds + XTR_OFF + 1536);
    if (F.tid < 32) rhist[F.tid] = 0u;
    LAS f32x4* wlds = (LAS f32x4*)(F.lds + RING_OFF); LAS float* blds = (LAS float*)(F.lds + XTR_OFF + 1024);
    { const GAS f32x4* src = (const GAS f32x4*)(WR + 4 * 1024);
#pragma unroll
      for (int i = 0; i < 16; ++i) wlds[F.tid + 512 * i] = src[F.tid + 512 * i];
      if (F.tid < 32) blds[F.tid] = BR[4 + F.tid]; }
    f32x4 wg[4][4]; float bg[4];
#pragma unroll
    for (int j = 0; j < 4; ++j) { bg[j] = BR[j];
#pragma unroll
        for (int c = 0; c < 4; ++c) wg[j][c] = ((const GAS f32x4*)(WR + j * 1024))[lane + 64 * c]; }
    __syncthreads();
    unsigned long long nx[4];
    { const GAS unsigned long long* pr = (const GAS unsigned long long*)(PRE + (size_t)min(gw, NTOK - 1) * 1024) + lane;
#pragma unroll
      for (int j = 0; j < 4; ++j) nx[j] = pr[64 * j]; }
    for (int m = gw; m < NTOK; m += NGW) {
        unsigned long long cu[4];
#pragma unroll
        for (int j = 0; j < 4; ++j) cu[j] = nx[j];
        { const GAS unsigned long long* pr = (const GAS unsigned long long*)(PRE + (size_t)min(m + NGW, NTOK - 1) * 1024) + lane;
#pragma unroll
          for (int j = 0; j < 4; ++j) nx[j] = pr[64 * j]; }
        f32x4 v[4];
#pragma unroll
        for (int j = 0; j < 4; ++j) { const unsigned long long a = cu[j]; const unsigned a0 = (unsigned)a, a1 = (unsigned)(a >> 32); v[j] = (f32x4){pg8::bf_lo(a0), pg8::bf_hi(a0), pg8::bf_lo(a1), pg8::bf_hi(a1)}; }
        ln_row(v, g1, b1, lane);
        GAS unsigned long long* o8 = (GAS unsigned long long*)(X1B + (size_t)m * 1024) + lane;
#pragma unroll
        for (int j = 0; j < 4; ++j) { o8[64 * j] = (unsigned long long)pk2(v[j].x, v[j].y) | ((unsigned long long)pk2(v[j].z, v[j].w) << 32);
            ((GAS unsigned*)((unsigned char*)F.out + OUT_X1B8 + (size_t)m * 1024) + lane)[64 * j] = pk4_fp8(v[j].x, v[j].y, v[j].z, v[j].w); }
#define DOT16(W0, W1, W2, W3) ({ float a_ = 0.f, b_ = 0.f; \
            a_ = __builtin_fmaf(v[0].x, (W0).x, a_); b_ = __builtin_fmaf(v[0].y, (W0).y, b_); a_ = __builtin_fmaf(v[0].z, (W0).z, a_); b_ = __builtin_fmaf(v[0].w, (W0).w, b_); \
            a_ = __builtin_fmaf(v[1].x, (W1).x, a_); b_ = __builtin_fmaf(v[1].y, (W1).y, b_); a_ = __builtin_fmaf(v[1].z, (W1).z, a_); b_ = __builtin_fmaf(v[1].w, (W1).w, b_); \
            a_ = __builtin_fmaf(v[2].x, (W2).x, a_); b_ = __builtin_fmaf(v[2].y, (W2).y, b_); a_ = __builtin_fmaf(v[2].z, (W2).z, a_); b_ = __builtin_fmaf(v[2].w, (W2).w, b_); \
            a_ = __builtin_fmaf(v[3].x, (W3).x, a_); b_ = __builtin_fmaf(v[3].y, (W3).y, b_); a_ = __builtin_fmaf(v[3].z, (W3).z, a_); b_ = __builtin_fmaf(v[3].w, (W3).w, b_); a_ + b_; })
        float lg[4];
        { const float q0 = DOT16(wg[0][0], wg[0][1], wg[0][2], wg[0][3]), q1 = DOT16(wg[1][0], wg[1][1], wg[1][2], wg[1][3]), q2 = DOT16(wg[2][0], wg[2][1], wg[2][2], wg[2][3]), q3 = DOT16(wg[3][0], wg[3][1], wg[3][2], wg[3][3]);
          wave_sum4(q0, q1, q2, q3, lg);
#pragma unroll
          for (int j = 0; j < 4; ++j) lg[j] += bg[j]; }
        int gi = 0; float gm = lg[0];
#pragma unroll
        for (int i = 1; i < 4; ++i) if (lg[i] > gm) { gm = lg[i]; gi = i; }
        float gs = 0.f;
#pragma unroll
        for (int i = 0; i < 4; ++i) gs += __expf(lg[i] - gm);
        const float gval = 1.f / gs;
        gi = __builtin_amdgcn_readfirstlane(gi);
        float el[8];
        { const LAS f32x4* wrow = wlds + gi * 8 * 256 + lane; float part[8];
#pragma unroll
          for (int k = 0; k < 8; ++k) { const f32x4 w0 = wrow[k * 256], w1 = wrow[k * 256 + 64], w2 = wrow[k * 256 + 128], w3 = wrow[k * 256 + 192]; part[k] = DOT16(w0, w1, w2, w3); }
          float e03[4], e47[4]; wave_sum4(part[0], part[1], part[2], part[3], e03); wave_sum4(part[4], part[5], part[6], part[7], e47);
#pragma unroll
          for (int k = 0; k < 4; ++k) { el[k] = e03[k] + blds[gi * 8 + k]; el[4 + k] = e47[k] + blds[gi * 8 + 4 + k]; } }
#undef DOT16
        int i0 = 0; float m0 = el[0];
#pragma unroll
        for (int k = 1; k < 8; ++k) if (el[k] > m0) { m0 = el[k]; i0 = k; }
        int i1 = -1; float m1 = -INFINITY;
#pragma unroll
        for (int k = 0; k < 8; ++k) if (k != i0 && el[k] > m1) { m1 = el[k]; i1 = k; }
        const float c0 = gval / (1.f + __expf(m1 - m0)), c1 = gval - c0;
        if (lane == 0) {
            const int e0 = gi * 8 + i0, e1 = gi * 8 + i1;
            route_e[m * 2] = e0; route_e[m * 2 + 1] = e1; route_c[m * 2] = c0; route_c[m * 2 + 1] = c1;
            __hip_atomic_fetch_add(rhist + e0, 1u, __ATOMIC_RELAXED, __HIP_MEMORY_SCOPE_WORKGROUP); __hip_atomic_fetch_add(rhist + e1, 1u, __ATOMIC_RELAXED, __HIP_MEMORY_SCOPE_WORKGROUP);
        }
    }
    __syncthreads();
    if (F.tid < 32) ((int*)(F.ws + WS_ROUTE + RT_HIST))[F.vcu * 32 + F.tid] = (int)rhist[F.tid];
}

__device__ __forceinline__ void lists_phase(Frame& F, int l) {
    const int tid = F.tid, NGW = F.G * NWAVES;
    const int* wghist = (const int*)(F.ws + WS_ROUTE + RT_HIST);
    const int* route_e = (const int*)(F.ws + WS_ROUTE + RT_E); const float* route_c = (const float*)(F.ws + WS_ROUTE + RT_C);
    int* gtot = (int*)(F.ws + WS_ROUTE + RT_TOT);
    int* list_row = (int*)(F.ws + WS_ROUTE + RT_ROW); int* list_ent = (int*)(F.ws + WS_ROUTE + RT_ENT); float* list_c = (float*)(F.ws + WS_ROUTE + RT_CW);
    LAS int* part = (LAS int*)(F.lds + RING_OFF);
    LAS int* earr = (LAS int*)(F.lds + XTR_OFF + 2048);
    LAS int* tot = (LAS int*)(F.lds + XTR_OFF + 3072); LAS int* wgoff = tot + 32; LAS int* mbase = wgoff + 32;
    { const int e = tid & 31, pt = tid >> 5; int t = 0, pre = 0;
      for (int w2 = pt * 16; w2 < pt * 16 + 16; ++w2) if (w2 < F.G) { const int h = wghist[w2 * 32 + e]; t += h; if (w2 < F.vcu) pre += h; }
      part[pt * 64 + e] = t; part[pt * 64 + 32 + e] = pre; }
    __syncthreads();
    if (tid < 32) { int t = 0, pre = 0; for (int pt = 0; pt < 16; ++pt) { t += part[pt * 64 + tid]; pre += part[pt * 64 + 32 + tid]; } tot[tid] = t; wgoff[tid] = pre; }
    __syncthreads();
    if (tid == 0) { int bse = 0; for (int e = 0; e < 32; ++e) { mbase[e] = bse; bse += (tot[e] + 255) & ~255; } mbase[32] = bse; }
    __syncthreads();
    int myE = -1, myTok = 0, mySlot = 0;
    if (tid < 256) { const int n = tid >> 1; mySlot = tid & 1; myTok = F.vcu * NWAVES + (n & 7) + NGW * (n >> 3); myE = route_e[myTok * 2 + mySlot]; earr[tid] = myE; }
    __syncthreads();
    if (tid < 256) { int rk = 0; for (int t2 = 0; t2 < tid; ++t2) rk += (earr[t2] == myE) ? 1 : 0;
        const int pos = mbase[myE] + wgoff[myE] + rk;
        list_row[pos] = myTok; list_ent[pos] = myTok * 2 + mySlot; list_c[pos] = route_c[myTok * 2 + mySlot]; }
    if (F.vcu == 0) {
        if (tid < 33) gtot[tid] = mbase[tid];
        const int e = tid >> 4;
        for (int pos = mbase[e] + tot[e] + (tid & 15); pos < mbase[e + 1]; pos += 16) { list_row[pos] = 0; list_ent[pos] = -1; list_c[pos] = 0.f; }
    }
}

struct TailSched {
    int first, count; long tstride;
    __device__ __forceinline__ bool next(int i, pg8::Unit& u) const { if (i >= count) return false; const long L = first + i; u.pm = (int)(L >> 2); u.pn = (int)L & 3; u.boff = (long)u.pn * tstride; return true; }
};
struct GroupSched {
    int nunits, G, c, shift; const LAS int* tile_e; long estride, substride;
    __device__ __forceinline__ bool next(int i, pg8::Unit& u) const {
        const long L = (long)i * G + c; if (L >= nunits) return false;
        const int rt = (int)(L >> shift), sub = (int)L & ((1 << shift) - 1), e = tile_e[rt];
        u.pm = rt; u.pn = sub; u.boff = (long)e * estride + (long)sub * substride; return true;
    }
};
__device__ __forceinline__ int build_tile_table(Frame& F) {
    const int* gtot = (const int*)(F.ws + WS_ROUTE + RT_TOT);
    LAS int* tile_e = (LAS int*)(F.lds + XTR_OFF);
    const int T = gtot[32] >> 8;
    for (int rt = F.tid; rt < T; rt += NWAVES * 64) { int e = 0; for (int k = 1; k < 32; ++k) if (gtot[k] <= rt * 256) e = k; tile_e[rt] = e; }
    __syncthreads();
    return T;
}

__device__ __forceinline__ void ln2_phase(Frame& F, int l) {
    const int gw = F.vcu * NWAVES + F.wave, NGW = F.G * NWAVES, lane = F.lane;
    const bf16* X1 = (const bf16*)(F.ws + WS_XB); const bf16* Y0 = (const bf16*)(F.ws + WS_Y0); const bf16* Y1 = (const bf16*)(F.ws + WS_Y1); const bf16* PLE = (const bf16*)(F.ws + WS_PLE);
    const float* g2 = (const float*)INP(20) + l * 1024; const float* b2 = (const float*)INP(21) + l * 1024;
    bf16* XB = (bf16*)(F.ws + WS_XB);
    unsigned long long nx[4][4];
#define LN2_LD(mm) do { const size_t ro_ = (size_t)min((mm), NTOK - 1) * 1024; \
        const GAS unsigned long long* xr_ = (const GAS unsigned long long*)(X1 + ro_) + lane; const GAS unsigned long long* y0_ = (const GAS unsigned long long*)(Y0 + ro_) + lane; \
        const GAS unsigned long long* y1_ = (const GAS unsigned long long*)(Y1 + ro_) + lane; const GAS unsigned long long* pl_ = (const GAS unsigned long long*)(PLE + ro_) + lane; \
        _Pragma("unroll") for (int j = 0; j < 4; ++j) { nx[0][j] = xr_[64 * j]; nx[1][j] = y0_[64 * j]; nx[2][j] = y1_[64 * j]; nx[3][j] = pl_[64 * j]; } } while (0)
    LN2_LD(gw);
    for (int m = gw; m < NTOK; m += NGW) {
        unsigned long long cu[4][4];
#pragma unroll
        for (int i = 0; i < 4; ++i)
#pragma unroll
            for (int j = 0; j < 4; ++j) cu[i][j] = nx[i][j];
        LN2_LD(m + NGW);
        f32x4 v[4];
#pragma unroll
        for (int j = 0; j < 4; ++j) { const unsigned long long xq = cu[0][j]; const unsigned xq0 = (unsigned)xq, xq1 = (unsigned)(xq >> 32); const f32x4 x = {pg8::bf_lo(xq0), pg8::bf_hi(xq0), pg8::bf_lo(xq1), pg8::bf_hi(xq1)};
            const unsigned long long a = cu[1][j], c = cu[2][j], d = cu[3][j];
            const unsigned a0 = (unsigned)a, a1 = (unsigned)(a >> 32), c0 = (unsigned)c, c1 = (unsigned)(c >> 32), d0 = (unsigned)d, d1 = (unsigned)(d >> 32);
            const float km = (DBG & 1) ? 0.f : 1.f, kp = (DBG & 2) ? 0.f : 1.f;
            v[j].x = x.x * ALPHA + km * (pg8::bf_lo(a0) + pg8::bf_lo(c0)) + kp * pg8::bf_lo(d0); v[j].y = x.y * ALPHA + km * (pg8::bf_hi(a0) + pg8::bf_hi(c0)) + kp * pg8::bf_hi(d0);
            v[j].z = x.z * ALPHA + km * (pg8::bf_lo(a1) + pg8::bf_lo(c1)) + kp * pg8::bf_lo(d1); v[j].w = x.w * ALPHA + km * (pg8::bf_hi(a1) + pg8::bf_hi(c1)) + kp * pg8::bf_hi(d1); }
        ln_row(v, g2, b2, lane);
#if CHK
        if (l == DEPTH - 1 && __hip_atomic_load(F.ctl + CW_CHK, RLX_AGENT) != 0u) { const float qn = __builtin_nanf(""); v[0] = (f32x4){qn, qn, qn, qn}; }
#endif
        if (l + 1 == DEPTH) { GAS f32x4* o = (GAS f32x4*)(F.out + (size_t)m * 1024) + lane;
#pragma unroll
            for (int j = 0; j < 4; ++j) o[64 * j] = v[j]; }
        if (l + 1 < DEPTH) { GAS unsigned long long* o8 = (GAS unsigned long long*)(XB + (size_t)m * 1024) + lane;
#pragma unroll
            for (int j = 0; j < 4; ++j) { o8[64 * j] = (unsigned long long)pk2(v[j].x, v[j].y) | ((unsigned long long)pk2(v[j].z, v[j].w) << 32);
                ((GAS unsigned*)((unsigned char*)F.out + OUT_XB8 + (size_t)m * 1024) + lane)[64 * j] = pk4_fp8(v[j].x, v[j].y, v[j].z, v[j].w); } }
    }
#undef LN2_LD
}


#if CHK
__device__ __forceinline__ void chk_fail(Frame& F, unsigned code) { __hip_atomic_store(F.ctl + CW_CHK, code, RLX_AGENT); }
__device__ __forceinline__ float bf2f(unsigned short v) { return __uint_as_float((unsigned)v << 16); }
__device__ __forceinline__ unsigned hash32(unsigned x) { x ^= x >> 16; x *= 0x7feb352du; x ^= x >> 15; x *= 0x846ca68bu; x ^= x >> 16; return x; }
__device__ __forceinline__ bool close_to(float got, float want, float rel, float ab) { return fabsf(got - want) <= ab + rel * fabsf(want) && got == got; }
__device__ __forceinline__ void cs_ref(float ang, float& c, float& s) {
    double rev = (double)ang * 0.15915494309189535; rev -= rint(rev); const double x = rev * 6.283185307179586, x2 = x * x;
    double tc = 1.0, ts = x, sc = 1.0, ss = x;
#pragma unroll 1
    for (int k = 1; k <= 14; ++k) { tc *= -x2 / (double)((2 * k - 1) * (2 * k)); ts *= -x2 / (double)((2 * k) * (2 * k + 1)); sc += tc; ss += ts; }
    c = (float)sc; s = (float)ss;
}
__device__ __forceinline__ void chk_proj(Frame& F) {
    const float* x = (const float*)INP(0); const float* w_in = (const float*)INP(3); const int* pos = (const int*)INP(2);
    const int gw = F.vcu * NWAVES + F.wave, lane = F.lane;
    for (int it = 0; it < 4; ++it) {
        const unsigned h = hash32((unsigned)(gw * 4 + it) * 2654435761u + 12345u);
        const int m = (int)(h % (unsigned)NTOK), col = (int)((h >> 7) % 3656u);
        int t, cw; if (col < 3584) { t = col >> 9; cw = col & 511; } else if (col < 3648) { t = 7; cw = col - 3584; } else { t = 8; cw = col - 3648; }
        const int d = cw & 63; const bool roped = (t == 0 || t == 1 || t == 3 || t == 4 || t == 6 || t == 7) && d < 16;
        const int pcol = roped ? (d < 8 ? col + 8 : col - 8) : col;
        float a = 0.f, b2 = 0.f;
        for (int k = lane; k < 1024; k += 64) { const float xv = x[(size_t)m * 1024 + k]; a += xv * w_in[(size_t)k * WIN_OLD + col]; b2 += xv * w_in[(size_t)k * WIN_OLD + pcol]; }
        a = wave_sum(a); b2 = wave_sum(b2);
        float val = a;
        if (roped) { const int j = d & 7; const float invf = 1.0f / powf(500000.0f, (float)j * 0.125f); float c, s; cs_ref((float)pos[m] * invf, c, s); val = (d < 8) ? a * c - b2 * s : a * c + b2 * s; }
        const float sc = (t == 0 || t == 3) ? pg8::C2 : (t == 6 ? 0.125f : (t == 8 ? 0.35355339059f : 1.f));
        val *= sc;
        float got;
        if (t < 7) got = bf2f(((const bf16*)(F.ws + WS_DQ + (size_t)t * TSTRIDE))[(size_t)m * 512 + cw]);
        else if (t == 7) got = bf2f(((const bf16*)(F.ws + WS_IK))[(size_t)m * 64 + cw]);
        else got = ((const float*)(F.ws + WS_IW))[(size_t)m * 8 + cw];
        if (lane == 0 && !close_to(got, val, 0.02f, 0.02f)) chk_fail(F, 0x100u + (unsigned)t);
    }
}
__device__ __forceinline__ void chk_attn(Frame& F) {
    LAS float* red = (LAS float*)(F.lds + RING_OFF);
    const unsigned h = hash32((unsigned)F.vcu * 977u + 7u);
    const int a = F.vcu % 48, t = (F.vcu < 8) ? (int)(h % 300u) : (int)(h % (unsigned)SEQ);
    int b, hq, hv; const bf16 *Q, *K, *V, *O; bool masked = false;
    if (a < 32) return;
    if (a < 32) { b = a >> 4; const int hh = (a >> 2) & 3, c = (a >> 1) & 1, hf = a & 1; hq = 2 * hh + c; hv = 2 * hh + hf;
        Q = (const bf16*)(F.ws + WS_DQ); K = (const bf16*)(F.ws + WS_DQ + TSTRIDE); V = (const bf16*)(F.ws + WS_DQ + 2 * TSTRIDE); O = (const bf16*)(F.ws + (c ? WS_O1 : WS_O0)); }
    else { b = (a - 32) >> 3; hq = hv = (a - 32) & 7; masked = true;
        Q = (const bf16*)(F.ws + WS_DQ + 3 * TSTRIDE); K = (const bf16*)(F.ws + WS_DQ + 4 * TSTRIDE); V = (const bf16*)(F.ws + WS_DQ + 5 * TSTRIDE); O = (const bf16*)(F.ws + WS_YB); }
    const unsigned long long* MK = (const unsigned long long*)(F.ws + WS_MASK) + (size_t)b * MASK_BSTRIDE;
    const size_t row = (size_t)b * SEQ + t;
    if (F.tid < 66) red[F.tid] = (F.tid == 0) ? -1e30f : 0.f;
    __syncthreads();
    float mx = -1e30f;
    for (int s = F.tid; s <= t; s += 512) {
        if (masked) { const int tl = s >> 6; const unsigned long long w = MK[idxr::moff(tl) + (t - 64 * tl)]; if (!((w >> (s & 63)) & 1ull)) continue; }
        float lg = 0.f; for (int d = 0; d < 64; ++d) lg += bf2f(Q[row * 512 + hq * 64 + d]) * bf2f(K[((size_t)b * SEQ + s) * 512 + hq * 64 + d]);
        mx = fmaxf(mx, lg);
    }
    for (int o = 1; o < 64; o <<= 1) mx = fmaxf(mx, __shfl_xor(mx, o));
    if (F.lane == 0) { float old = red[0]; while (mx > old) { const unsigned prev = atomicCAS((unsigned*)&red[0], __float_as_uint(old), __float_as_uint(mx)); if (prev == __float_as_uint(old)) break; old = __uint_as_float(prev); } }
    __syncthreads();
    mx = red[0];
    __syncthreads();
    float sum = 0.f;
    for (int s = F.tid; s <= t; s += 512) {
        if (masked) { const int tl = s >> 6; const unsigned long long w = MK[idxr::moff(tl) + (t - 64 * tl)]; if (!((w >> (s & 63)) & 1ull)) continue; }
        float lg = 0.f; for (int d = 0; d < 64; ++d) lg += bf2f(Q[row * 512 + hq * 64 + d]) * bf2f(K[((size_t)b * SEQ + s) * 512 + hq * 64 + d]);
        const float p = exp2f(lg - mx); sum += p;
        for (int d = 0; d < 64; ++d) atomicAdd((float*)&red[2 + d], p * bf2f(V[((size_t)b * SEQ + s) * 512 + hv * 64 + d]));
    }
    atomicAdd((float*)&red[1], sum);
    __syncthreads();
    if (F.tid < 64) { const float want = red[2 + F.tid] / red[1], got = bf2f(O[row * 512 + hv * 64 + F.tid]);
        if (!close_to(got, want, 0.03f, 0.003f)) chk_fail(F, masked ? 0x220u : 0x210u); }
    __syncthreads();
}
__device__ __forceinline__ void chk_mask(Frame& F) {
    LAS float* sc = (LAS float*)(F.lds + RING_OFF);
    LAS unsigned* cnt = (LAS unsigned*)(F.lds + XTR_OFF + 2048);
    if (F.vcu >= 64) return;
    const unsigned h = hash32((unsigned)F.vcu * 31337u + 99u);
    const int b = F.vcu & 1, t = (F.vcu < 6) ? (int)(h % 400u) : (int)(h % (unsigned)SEQ);
    const bf16* IQ = (const bf16*)(F.ws + WS_DQ + 6 * TSTRIDE); const bf16* IK = (const bf16*)(F.ws + WS_IK); const float* IW = (const float*)(F.ws + WS_IW);
    const unsigned long long* MK = (const unsigned long long*)(F.ws + WS_MASK) + (size_t)b * MASK_BSTRIDE;
    const size_t row = (size_t)b * SEQ + t;
    if (F.tid < 2) cnt[F.tid] = 0u;
    for (int s = F.tid; s <= t; s += 512) { float tot = 0.f;
        for (int hh = 0; hh < 8; ++hh) { float d = 0.f; for (int e = 0; e < 64; ++e) d += bf2f(IQ[row * 512 + hh * 64 + e]) * bf2f(IK[((size_t)b * SEQ + s) * 64 + e]); tot += IW[row * 8 + hh] * fmaxf(d, 0.f); }
        sc[s] = tot; }
    __syncthreads();
    for (int s = F.tid; s <= t; s += 512) { const float v = sc[s]; int rk = 0;
        for (int s2 = 0; s2 <= t; ++s2) { const float v2 = sc[s2]; rk += (v2 > v || (v2 == v && s2 < s)) ? 1 : 0; }
        const bool want = rk < 256; const int tl = s >> 6; const bool got = (MK[idxr::moff(tl) + (t - 64 * tl)] >> (s & 63)) & 1ull;
        if (want != got) atomicAdd((unsigned*)&cnt[0], 1u); if (got) atomicAdd((unsigned*)&cnt[1], 1u); }
    __syncthreads();
    if (F.tid == 0) { const unsigned expect = (t + 1 < 256) ? (unsigned)(t + 1) : 256u; if (cnt[1] != expect) chk_fail(F, 0x230u); else if (cnt[0] > 8u) chk_fail(F, 0x231u); }
    __syncthreads();
}
__device__ __forceinline__ void chk_pre1(Frame& F) {
    LAS float* mg = (LAS float*)(F.lds + RING_OFF);
    const float* x = (const float*)INP(0); const float* w_in = (const float*)INP(3); const float* wbd = (const float*)INP(6); const float* wbs = (const float*)INP(7); const float* wo = (const float*)INP(8);
    const bf16* YA = (const bf16*)(F.ws + WS_YA); const bf16* YB = (const bf16*)(F.ws + WS_YB); const bf16* PRE = (const bf16*)(F.ws + WS_PRE1);
    const int m = (int)(hash32((unsigned)F.vcu * 7919u + 3u) % (unsigned)NTOK);
    for (int c = F.tid; c < 1024; c += 512) { float ga = 0.f, gb = 0.f, pa = 0.f, pb = 0.f;
        for (int k = 0; k < 1024; ++k) { const float xv = bf2f((unsigned short)f2bf(x[(size_t)m * 1024 + k])); ga += xv * w_in[(size_t)k * WIN_OLD + 3656 + c]; gb += xv * w_in[(size_t)k * WIN_OLD + 4680 + c]; }
        for (int k = 0; k < 512; ++k) { pa += bf2f(YA[(size_t)m * 512 + k]) * wbd[(size_t)k * 1024 + c]; pb += bf2f(YB[(size_t)m * 512 + k]) * wbs[(size_t)k * 1024 + c]; }
        mg[c] = pa / (1.f + expf(-ga)) + pb / (1.f + expf(-gb)); }
    __syncthreads();
    for (int c = F.tid; c < 1024; c += 512) { float mix = 0.f; for (int k = 0; k < 1024; ++k) mix += mg[k] * wo[(size_t)k * 1024 + c];
        const float want = ALPHA * x[(size_t)m * 1024 + c] + mix, got = bf2f(PRE[(size_t)m * 1024 + c]);
        if (!close_to(got, want, 0.015f, 0.015f)) chk_fail(F, 0x300u); }
    __syncthreads();
}
__device__ __forceinline__ void chk_ffn(Frame& F) {
    LAS float* lgs = (LAS float*)(F.lds + RING_OFF);
    const bf16* X1 = (const bf16*)(F.ws + WS_XB); const float* wrg = (const float*)INP(11); const float* brg = (const float*)INP(12); const float* wre = (const float*)INP(13); const float* bre = (const float*)INP(14);
    const float* wg = (const float*)INP(15); const float* wu = (const float*)INP(16); const float* wd = (const float*)INP(17); const float* wple = (const float*)INP(18); const float* wpg = (const float*)INP(19); const float* p = (const float*)INP(1);
    const bf16* Y0 = (const bf16*)(F.ws + WS_Y0); const bf16* Y1 = (const bf16*)(F.ws + WS_Y1); const bf16* PLE = (const bf16*)(F.ws + WS_PLE);
    const int m = (int)(hash32((unsigned)F.vcu * 104729u + 11u) % (unsigned)NTOK);
    if (F.tid < 36) { float s = 0.f; for (int k = 0; k < 1024; ++k) s += bf2f(X1[(size_t)m * 1024 + k]) * (F.tid < 4 ? wrg[k * 4 + F.tid] : wre[k * 32 + F.tid - 4]); lgs[F.tid] = s + (F.tid < 4 ? brg[F.tid] : bre[F.tid - 4]); }
    __syncthreads();
    int gi = 0; for (int i = 1; i < 4; ++i) if (lgs[i] > lgs[gi]) gi = i;
    float gs = 0.f; for (int i = 0; i < 4; ++i) gs += expf(lgs[i] - lgs[gi]); const float gval = 1.f / gs;
    int i0 = 0; for (int k = 1; k < 8; ++k) if (lgs[4 + gi * 8 + k] > lgs[4 + gi * 8 + i0]) i0 = k;
    int i1 = (i0 == 0) ? 1 : 0; for (int k = 0; k < 8; ++k) if (k != i0 && lgs[4 + gi * 8 + k] > lgs[4 + gi * 8 + i1]) i1 = k;
    const float l0 = lgs[4 + gi * 8 + i0], l1 = lgs[4 + gi * 8 + i1], c0 = gval / (1.f + expf(l1 - l0)), c1 = gval - c0;
    __syncthreads();
    { const int sl = F.tid >> 8, f = F.tid & 255, e = gi * 8 + (sl ? i1 : i0); const float* G = wg + (size_t)e * 1024 * 256; const float* U = wu + (size_t)e * 1024 * 256; float g = 0.f, u = 0.f;
      for (int k = 0; k < 1024; ++k) { const float xv = bf2f(X1[(size_t)m * 1024 + k]); g += xv * G[(size_t)k * 256 + f]; u += xv * U[(size_t)k * 256 + f]; }
      lgs[64 + F.tid] = g / (1.f + expf(-g)) * u * (sl ? c1 : c0); }
    __syncthreads();
    for (int c = F.tid; c < 1024; c += 512) { float y = 0.f;
        for (int sl = 0; sl < 2; ++sl) { const int e = gi * 8 + (sl ? i1 : i0); const float* D = wd + (size_t)e * 256 * 1024; for (int f = 0; f < 256; ++f) y += lgs[64 + sl * 256 + f] * D[(size_t)f * 1024 + c]; }
        const float goty = bf2f(Y0[(size_t)m * 1024 + c]) + bf2f(Y1[(size_t)m * 1024 + c]);
        if (!close_to(goty, y, 0.03f, 0.004f)) chk_fail(F, 0x400u);
        float gt = 0.f, tp = 0.f; for (int k = 0; k < 1024; ++k) gt += bf2f(X1[(size_t)m * 1024 + k]) * wpg[(size_t)k * 1024 + c]; for (int k = 0; k < 256; ++k) tp += p[(size_t)m * 256 + k] * wple[(size_t)k * 1024 + c];
        const float wantp = tp / (1.f + expf(-gt)), gotp = bf2f(PLE[(size_t)m * 1024 + c]);
        if (!close_to(gotp, wantp, 0.03f, 0.01f)) chk_fail(F, 0x410u); }
    __syncthreads();
}
#endif

#ifndef PHSEL
#define PHSEL 0xFFF
#endif
#define PHON(k) (((PHSEL) >> (k)) & 1)
#ifndef DUP
#define DUP 0
#endif
#define DUPREP(k) for (int rep_ = 0; rep_ < (((DUP) >> (k)) & 1) + 1; ++rep_)
__global__ void __launch_bounds__(NWAVES * 64, 2) skel_fwd(Args args) {
    extern __shared__ __attribute__((aligned(16))) unsigned char lds[];
    Frame F;
    F.lds = (LAS unsigned char*)lds;
    F.MISC = (volatile LAS unsigned*)(F.lds + MISC_OFF);
    F.tid = threadIdx.x; F.lane = F.tid & 63; F.wave = __builtin_amdgcn_readfirstlane(F.tid >> 6);
    F.G = gridDim.x; F.bx = blockIdx.x; { const int bx = blockIdx.x; F.vcu = (F.G % 8 == 0) ? (bx % 8) * (F.G / 8) + bx / 8 : bx; }
    F.ws = F.ws0 = args.ws; F.out = F.out0 = args.out; F.ap = &args;
    F.ctl = (gu32*)(F.ws + WS_CTL);
    for (int u = F.tid; u < (MISC_OFF + 128 - XTR_OFF) / 4; u += NWAVES * 64) ((LAS unsigned*)(F.lds + XTR_OFF))[u] = 0u;
    __syncthreads();
#if MK_PER_PHASE
    XcdBarrier bar; bar.bar = (unsigned*)(F.ctl + CW_BAR); bar.x = 0; bar.st = nullptr;
#define GRID_BAR() do { if (F.tid == 0) __hip_atomic_store(F.ctl + CW_TMO, 0xBADBA0u, RLX_AGENT); } while (0)
#else
    XcdBarrier bar = xcd_barrier_post((unsigned*)(F.ctl + CW_BAR), F.MISC + 8);
#ifndef IDLEPROBE
#define IDLEPROBE 0
#endif
#if IDLEPROBE
#define GRID_BAR() do { const unsigned long long t0_ = rt(); xcd_barrier(bar); if (F.tid == 0) __hip_atomic_fetch_add(F.ctl + 12288 + seam_no, (unsigned)(rt() - t0_), RLX_AGENT); ++seam_no; } while (0)
#else
#define GRID_BAR() xcd_barrier(bar)
#endif
#endif
    const int lo = args.ph_lo, hi = args.ph_hi;
    int seam_no = 0; (void)seam_no;
#define IN(k) (lo <= (k) && (k) < hi)
#define SEAM(k) do { if (IN(k) && IN((k) + 1)) GRID_BAR(); } while (0)
#define PHASE_ENTER() { size_t zo_ = 0; asm volatile("" : "+s"(zo_)); F.ws = F.ws0 + zo_; F.out = F.out0 + zo_; } F.vcu = __builtin_amdgcn_readfirstlane(F.vcu); asm volatile("" : "+s"(F.vcu), "+s"(F.G), "+s"(F.bx)); asm volatile("" : "+s"(F.lds)); F.tid = ltid(F.wave); F.lane = F.tid & 63; unsigned char* const ws = F.ws; bf16* const XB = (bf16*)(ws + WS_XB); (void)XB
    for (int l = 0; l < DEPTH; ++l) {
        const int pb = l * NPH_LAYER;
        if (PHON(0) && IN(pb + 0)) DUPREP(0) { PHASE_ENTER(); pw_phase(F, l); }
        SEAM(pb + 0);
        if (PHON(1) && IN(pb + 1)) DUPREP(1) { PHASE_ENTER();
            pg8::Gemm g{XB, (const bf16*)(ws + WS_WB + WB_WIN), 1024, 1024, 1024, nullptr}; pg8::StaticOrder S; S.init(NTOK, P1_N, F.G, F.bx, 1024);
            pg8::EpiProj E{(bf16*)(ws + WS_DQ), TSTRIDE / 2, (bf16*)(ws + WS_IK), (float*)(ws + WS_IW), (const float*)(ws + WS_ROPE)};
            pg8::gemm_phase<pg8::EpiProj, pg8::StaticOrder, true>(F.lds + RING_OFF, g, S, E, F.wave);
            { pg8::Gemm g2{(const bf16*)(ws + WS_PB), (const bf16*)(ws + WS_WB + WB_WPLE), 256, 256, 256, nullptr};
                TailSched S2{(F.bx >= 128) ? (F.bx - 128) * 3 : 384 + F.bx, (F.bx >= 128) ? 3 : 1, 256L * 256};
                pg8::EpiStore E2{(bf16*)((unsigned char*)F.out + OUT_T1), 1024}; pg8::gemm_phase<pg8::EpiStore, TailSched, true>(F.lds + RING_OFF, g2, S2, E2, F.wave); }
        }
        SEAM(pb + 1);
        if (PHON(2) && IN(pb + 2)) DUPREP(2) { PHASE_ENTER();
            const bf16* IQ = (const bf16*)(ws + WS_DQ + 6 * TSTRIDE); const bf16* IK = (const bf16*)(ws + WS_IK); const float* IW = (const float*)(ws + WS_IW);
            for (int p = F.vcu; p < 256; p += F.G) { const int b = p >> 7, s = p & 127;
                unsigned long long* m32 = (unsigned long long*)(ws + WS_MASK) + (size_t)b * MASK_BSTRIDE;
                for (int k2 = 0; k2 < 2; ++k2) indexer_unit(F, b, k2 ? s : 255 - s, IQ, IK, IW, m32); }
        }
        SEAM(pb + 2);
        if (PHON(3) && IN(pb + 3)) DUPREP(3) { PHASE_ENTER();
            using attn_body::bf16;
            const bf16* DQ = (const bf16*)(ws + WS_DQ); const bf16* DK = (const bf16*)(ws + WS_DQ + TSTRIDE); const bf16* DV = (const bf16*)(ws + WS_DQ + 2 * TSTRIDE);
            LAS unsigned* qslot = (LAS unsigned*)(F.lds + MISC_OFF + 64);
            gu32* qctr = F.ctl + CW_QUEUE + l * 64;
            LAS unsigned* const badp = (LAS unsigned*)(F.lds + MISC_OFF + 80); constexpr int BADOFF = MISC_OFF + 80 - RING_OFF;
#define GRAB(ctr_, u_) do { __syncthreads(); if (F.tid == 0) { *qslot = __hip_atomic_fetch_add((ctr_), 1u, RLX_AGENT); *badp = 0u; } __syncthreads(); u_ = (int)*qslot; } while (0)
#ifndef DUPW
#define DUPW 0
#endif
            for (int dw_ = 0; dw_ <= DUPW; ++dw_)
            for (;;) { int u; GRAB(qctr + 8 * dw_, u); if (u >= 512) break;
                const int qb = 63 - (u >> 3), a = u & 7, b = a >> 2, h = a & 3;
#pragma unroll 1
                for (int c = 0; c < 2; ++c) {
                    bf16* O = (bf16*)(ws + (c ? WS_O1 : WS_O0));
                    attn_body::attn_unit<8, false, true, true>(b, 2 * h + c, 2 * h, qb, DQ, DK, DV, O, nullptr, (char*)lds + RING_OFF, F.wave, BADOFF);
#if !(CHK && MK_PER_PHASE)
                    if (*(volatile LAS unsigned*)badp) { __syncthreads(); if (F.tid == 0) *badp = 0u;
                        attn_body::attn_unit<8, false, true, false>(b, 2 * h + c, 2 * h, qb, DQ, DK, DV, O, nullptr, (char*)lds + RING_OFF, F.wave, BADOFF); }
#endif
                }
                VM_WAIT(); __syncthreads(); __builtin_amdgcn_fence(__ATOMIC_ACQUIRE, "agent");
                ya_unit(F, l, b, h, qb);
            }
            const bf16* SQ = (const bf16*)(ws + WS_DQ + 3 * TSTRIDE); const bf16* SK = (const bf16*)(ws + WS_DQ + 4 * TSTRIDE); const bf16* SV = (const bf16*)(ws + WS_DQ + 5 * TSTRIDE);
            attn_body::mask_table_init((char*)lds + RING_OFF, F.tid);
#ifndef DUPS
#define DUPS 0
#endif
            for (int ds_ = 0; ds_ <= DUPS; ++ds_)
            for (;;) { int u; GRAB(qctr + 32 + 8 * ds_, u); if (u >= 1024) break;
                const int qb = 63 - (u >> 4), a = u & 15, b = a >> 3, h = a & 7;
                const unsigned long long* MK = (const unsigned long long*)(ws + WS_MASK) + (size_t)b * MASK_BSTRIDE;
                attn_body::attn_unit<8, true, false, true>(b, h, h, qb, SQ, SK, SV, (bf16*)(ws + WS_YB), MK, (char*)lds + RING_OFF, F.wave, BADOFF);
#if !(CHK && MK_PER_PHASE)
                if (*(volatile LAS unsigned*)badp) attn_body::attn_unit<8, true, false, false>(b, h, h, qb, SQ, SK, SV, (bf16*)(ws + WS_YB), MK, (char*)lds + RING_OFF, F.wave, BADOFF);
#endif
                }
#undef GRAB
        }
        SEAM(pb + 3);
        if (PHON(5) && IN(pb + 5)) DUPREP(5) { PHASE_ENTER();
#define RELA() { size_t zo_ = 0; asm volatile("" : "+s"(zo_)); F.ws = F.ws0 + zo_; } unsigned char* const ws = F.ws; bf16* const XB = (bf16*)(ws + WS_XB); (void)XB; const bf16* WIN = (const bf16*)(ws + WS_WB + WB_WIN); bf16* MG = (bf16*)(ws + WS_MERGED); unsigned char* G1 = ws + WS_TMPG; unsigned char* G2 = ws + WS_TMPG + 32 * MiB; (void)WIN; (void)MG; (void)G1; (void)G2
            { RELA(); pg8::Gemm g{(const bf16*)((unsigned char*)F.out + OUT_XB8), (const bf16*)(ws + WS_WB + WB_WG8), 512, 512, 512, nullptr}; pg8::StaticOrder S; S.init(NTOK, 1024, F.G, F.bx, 512);
              pg8::EpiSig E{G1, 1024, 1.f / 64.f}; pg8::gemm_phase<pg8::EpiSig, pg8::StaticOrder, true, false, true>(F.lds + RING_OFF, g, S, E, F.wave); }
            { RELA(); pg8::Gemm g{(const bf16*)((unsigned char*)F.out + OUT_XB8), (const bf16*)(ws + WS_WB + WB_WG8 + (size_t)1024 * 1024), 512, 512, 512, nullptr}; pg8::StaticOrder S; S.init(NTOK, 1024, F.G, F.bx, 512);
              pg8::EpiSig E{G2, 1024, 1.f / 64.f}; pg8::gemm_phase<pg8::EpiSig, pg8::StaticOrder, true, false, true>(F.lds + RING_OFF, g, S, E, F.wave); }
            VM_WAIT(); __builtin_amdgcn_fence(__ATOMIC_ACQUIRE, "agent"); VM_WAIT();
            { RELA(); pg8::Gemm g{(const bf16*)(ws + WS_YA), (const bf16*)(ws + WS_WB + WB_WBD), 512, 512, 512, nullptr}; pg8::StaticOrder S; S.init(NTOK, 1024, F.G, F.bx, 512);
              pg8::EpiGatedT<false> E{G1, nullptr, MG, 1024}; pg8::gemm_phase<pg8::EpiGatedT<false>, pg8::StaticOrder, true>(F.lds + RING_OFF, g, S, E, F.wave); }
            VM_WAIT(); __builtin_amdgcn_fence(__ATOMIC_ACQUIRE, "agent"); VM_WAIT();
            { RELA(); pg8::Gemm g{(const bf16*)(ws + WS_YB), (const bf16*)(ws + WS_WB + WB_WBS), 512, 512, 512, nullptr}; pg8::StaticOrder S; S.init(NTOK, 1024, F.G, F.bx, 512);
              pg8::EpiGatedT<true> E{G2, MG, MG, 1024}; if (!(DBG & 4)) pg8::gemm_phase<pg8::EpiGatedT<true>, pg8::StaticOrder, true>(F.lds + RING_OFF, g, S, E, F.wave); }
        }
        SEAM(pb + 5);
        if (PHON(6) && IN(pb + 6)) DUPREP(6) { PHASE_ENTER();
            pg8::Gemm g{(const bf16*)(ws + WS_MERGED), (const bf16*)(ws + WS_WB + WB_WO), 1024, 1024, 1024, nullptr}; pg8::StaticOrder S; S.init(NTOK, 1024, F.G, F.bx, 1024);
            pg8::EpiResBf16 E{XB, (bf16*)(ws + WS_PRE1), ALPHA}; pg8::gemm_phase<pg8::EpiResBf16, pg8::StaticOrder, true>(F.lds + RING_OFF, g, S, E, F.wave);
        }
        SEAM(pb + 6);
        if (PHON(7) && IN(pb + 7)) DUPREP(7) { PHASE_ENTER(); ln1_router_phase(F, l); }
        SEAM(pb + 7);
        if (PHON(8) && IN(pb + 8)) DUPREP(8) { PHASE_ENTER(); lists_phase(F, l); }
        SEAM(pb + 8);
        if (PHON(9) && IN(pb + 9)) DUPREP(9) { PHASE_ENTER();
            const int T = build_tile_table(F);
            pg8::Gemm g{(const bf16*)((unsigned char*)F.out + OUT_X1B8), (const bf16*)(ws + WS_WB + WB_WGU), 512, 512, 512, (const int*)(ws + WS_ROUTE + RT_ROW)};
            GroupSched S{2 * T, F.G, F.vcu, 1, (const LAS int*)(F.lds + XTR_OFF), 512L * 512, 256L * 512};
            pg8::EpiGU E{(bf16*)(ws + WS_HG), (const float*)(ws + WS_ROUTE + RT_CW), 1.f / 64.f};
            pg8::gemm_phase<pg8::EpiGU, GroupSched, true, true, true>(F.lds + RING_OFF, g, S, E, F.wave);
        }
        SEAM(pb + 9);
        if (PHON(10) && IN(pb + 10)) DUPREP(10) { PHASE_ENTER();
            const int T = build_tile_table(F);
#ifndef P10SEL
#define P10SEL 7
#endif
            if (P10SEL & 1) { RELA(); pg8::Gemm g{(const bf16*)(ws + WS_HG), (const bf16*)(ws + WS_WB + WB_WD), 256, 256, 256, nullptr};
              GroupSched S{4 * T, F.G, F.vcu, 2, (const LAS int*)(F.lds + XTR_OFF), 1024L * 256, 256L * 256};
              pg8::EpiDown E{(const int*)(ws + WS_ROUTE + RT_ENT), (bf16*)(ws + WS_Y0), (unsigned)(WS_Y1 - WS_Y0)};
              pg8::gemm_phase<pg8::EpiDown, GroupSched, true>(F.lds + RING_OFF, g, S, E, F.wave); }
            if (P10SEL & 4) { RELA(); pg8::Gemm g{(const bf16*)((unsigned char*)F.out + OUT_X1B8), (const bf16*)(ws + WS_WB + WB_WPG), 512, 512, 512, nullptr}; pg8::StaticOrder S; S.init(NTOK, 1024, F.G, F.bx, 512);
              pg8::EpiPle E{(const bf16*)((unsigned char*)F.out + OUT_T1), (bf16*)(ws + WS_PLE), 1.f / 64.f}; pg8::gemm_phase<pg8::EpiPle, pg8::StaticOrder, true, false, true>(F.lds + RING_OFF, g, S, E, F.wave); }
        }
        SEAM(pb + 10);
        if (PHON(11) && IN(pb + 11)) DUPREP(11) { PHASE_ENTER(); ln2_phase(F, l); }
        if (l + 1 < DEPTH) SEAM(pb + 11);
    }
#if IDLEPROBE
    xcd_barrier(bar);
    if (blockIdx.x == 0 && F.tid == 0) { unsigned long long tot = 0; for (int k = 0; k < 23; ++k) if ((IDLEPROBE >> k) & 1) tot += __hip_atomic_load(F.ctl + 12288 + k, RLX_AGENT);
        const unsigned long long t0 = rt(), dur = tot / 256; while (rt() - t0 < dur) __builtin_amdgcn_s_sleep(8); }
#endif
#undef IN
#undef SEAM
}

#if CHK
__global__ void __launch_bounds__(NWAVES * 64, 2) chk_kernel(Args args, int which) {
    extern __shared__ __attribute__((aligned(16))) unsigned char lds[];
    Frame F;
    F.lds = (LAS unsigned char*)lds; F.MISC = (volatile LAS unsigned*)(F.lds + MISC_OFF);
    F.tid = threadIdx.x; F.lane = F.tid & 63; F.wave = __builtin_amdgcn_readfirstlane(F.tid >> 6);
    F.G = gridDim.x; F.bx = blockIdx.x; { const int bx = blockIdx.x; F.vcu = (F.G % 8 == 0) ? (bx % 8) * (F.G / 8) + bx / 8 : bx; }
    F.ws = F.ws0 = args.ws; F.out = F.out0 = args.out; F.ap = &args; F.ctl = (gu32*)(F.ws + WS_CTL);
    if (which == 1) chk_proj(F);
    if (which == 2) chk_attn(F);
    if (which == 4) chk_mask(F);
    if (which == 8) chk_pre1(F);
    if (which == 16) chk_ffn(F);
}
#endif
extern "C" void kernel_launch(void* const* d_in, const int* in_sizes, int n_in, void* d_out, int out_size, void* d_ws, size_t ws_size, hipStream_t stream) {
    static int grid = 0;
    if (grid == 0) {
        if (n_in != 22 || in_sizes[0] != NTOK * DMODEL || out_size != NTOK * DMODEL || ws_size < WS_END) { fprintf(stderr, "kernel_launch: unexpected problem geometry (n_in %d, ws %zu); nothing launched\n", n_in, ws_size); grid = -1; return; }
        int dev = 0, cus = 0, per_cu = 0;
        if (hipGetDevice(&dev) != hipSuccess || hipDeviceGetAttribute(&cus, hipDeviceAttributeMultiprocessorCount, dev) != hipSuccess) { grid = -1; return; }
        if (hipFuncSetAttribute((const void*)skel_fwd, hipFuncAttributeMaxDynamicSharedMemorySize, LDS_BYTES) != hipSuccess) { fprintf(stderr, "kernel_launch: hipFuncSetAttribute failed\n"); grid = -1; return; }
        if (hipOccupancyMaxActiveBlocksPerMultiprocessor(&per_cu, (const void*)skel_fwd, NWAVES * 64, LDS_BYTES) != hipSuccess || per_cu < 1) { fprintf(stderr, "kernel_launch: occupancy query reports %d\n", per_cu); }
        (void)hipGetLastError();
        if (cus < 256) { fprintf(stderr, "kernel_launch: needs 256 CUs (got %d)\n", cus); grid = -1; return; }
        grid = 256;
    }
    if (grid < 0) return;
    if (hipMemsetAsync((char*)d_ws + WS_CTL, 0, CTL_ZERO_BYTES, stream) != hipSuccess) return;
    Args a{};
    for (int i = 0; i < 22; ++i) a.in[i] = d_in[i];
    a.out = (float*)d_out; a.ws = (unsigned char*)d_ws;
#if MK_PER_PHASE
    for (int ph = 0; ph < NPHASE; ++ph) { a.ph_lo = ph; a.ph_hi = ph + 1; hipLaunchKernelGGL(skel_fwd, dim3(grid), dim3(NWAVES * 64), LDS_BYTES, stream, a);
#if CHK
        static bool chk_set = false; if (!chk_set) { (void)hipFuncSetAttribute((const void*)chk_kernel, hipFuncAttributeMaxDynamicSharedMemorySize, LDS_BYTES); chk_set = true; }
        if (ph == 1 && (CHK & 1)) hipLaunchKernelGGL(chk_kernel, dim3(grid), dim3(NWAVES * 64), LDS_BYTES, stream, a, 1);
        if (ph == 3 && (CHK & 2)) hipLaunchKernelGGL(chk_kernel, dim3(grid), dim3(NWAVES * 64), LDS_BYTES, stream, a, 2);
        if (ph == 3 && (CHK & 4)) hipLaunchKernelGGL(chk_kernel, dim3(grid), dim3(NWAVES * 64), LDS_BYTES, stream, a, 4);
        if (ph == 6 && (CHK & 8)) hipLaunchKernelGGL(chk_kernel, dim3(grid), dim3(NWAVES * 64), LDS_BYTES, stream, a, 8);
        if (ph == 10 && (CHK & 16)) hipLaunchKernelGGL(chk_kernel, dim3(grid), dim3(NWAVES * 64), LDS_BYTES, stream, a, 16);
#endif
    }
#else
    a.ph_lo = 0; a.ph_hi = NPHASE;
    hipLaunchKernelGGL(skel_fwd, dim3(grid), dim3(NWAVES * 64), LDS_BYTES, stream, a);
#endif
}
```

```cpp
#include <hip/hip_runtime.h>
#include <hip/hip_bf16.h>
#include <cstdio>
#include <cstdint>
#include <cmath>

__device__ __forceinline__ int ltid(int wave) { int l; asm volatile("v_mbcnt_lo_u32_b32 %0, -1, 0\n\tv_mbcnt_hi_u32_b32 %0, -1, %0" : "=v"(l)); return (wave << 6) | l; }

namespace pg8 {
#define PG8_LAS __attribute__((address_space(3)))
typedef unsigned short bf16_t;
typedef short bf16x8 __attribute__((ext_vector_type(8)));
typedef float f32x4 __attribute__((ext_vector_type(4)));
typedef unsigned u32x4 __attribute__((ext_vector_type(4)));
typedef int i32x4_t __attribute__((ext_vector_type(4)));
typedef int i32x8_t __attribute__((ext_vector_type(8)));
constexpr int BM = 256, BK = 64, HALF = 128, HTB = HALF * BK * 2  , STAGE_BYTES = 8 * HTB, NXCD = 8, WGM = 8;
constexpr float C2 = 0.125f * 1.4426950408889634f;

__host__ __device__ __forceinline__ int lds_byte(int r, int c) { const int st = (r >> 4) * 2 + (c >> 5), rr = r & 15, cc = c & 31, ob = rr * 64 + cc * 2; return st * 1024 + (ob ^ (((ob >> 9) & 1) << 5)); }
__host__ __device__ __forceinline__ void stage_rc(int b, int& R, int& C) { const int st = b / 1024, sb = b % 1024, swz = sb ^ (((sb >> 9) & 1) << 5); R = (st >> 1) * 16 + swz / 64; C = (st & 1) * 32 + (swz % 64) / 2; }
__host__ __device__ __forceinline__ int perm32(int rho) { const int n = rho >> 4, i = rho & 15; return 8 * (i >> 2) + 4 * n + (i & 3); }

struct Unit { int pm, pn; long boff; };
struct Gemm { const bf16_t* A; const bf16_t* Bt; int K, lda, ldb; const int* rows; };

struct StaticOrder {
    int nM, nN, nwg, G, c, ldb;
    __device__ void init(int M, int N, int G_, int c_, int ldb_) { nM = M / BM; nN = N / BM; nwg = nM * nN; G = G_; c = c_; ldb = ldb_; }
    __device__ bool next(int i, Unit& u) const {
        const long L = (long)i * G + c; if (L >= nwg) return false;
        int wgid = (int)L; { const int q = nwg / NXCD, r = nwg % NXCD, xcd = wgid % NXCD, off = wgid / NXCD; wgid = (xcd < r ? xcd * (q + 1) : r * (q + 1) + (xcd - r) * q) + off; }
        const int nig = WGM * nN, gid = wgid / nig, fm = gid * WGM, gsz = (nM - fm) < WGM ? (nM - fm) : WGM;
        u.pm = fm + ((wgid % nig) % gsz); u.pn = (wgid % nig) / gsz; u.boff = (long)u.pn * BM * ldb; return true;
    }
};

__device__ __forceinline__ unsigned cvt_pk_bf16(float lo, float hi) { unsigned r; asm volatile("v_cvt_pk_bf16_f32 %0, %1, %2" : "=v"(r) : "v"(lo), "v"(hi)); return r; }
__device__ __forceinline__ float bf_lo(unsigned w) { return __uint_as_float(w << 16); }
__device__ __forceinline__ float bf_hi(unsigned w) { return __uint_as_float(w & 0xffff0000u); }
__device__ __forceinline__ float sigm(float x) { return __builtin_amdgcn_rcpf(1.f + __builtin_amdgcn_exp2f(-1.4426950408889634f * x)); }
__device__ __forceinline__ u32x4 pack8(f32x4 a, f32x4 b) { u32x4 w; w.x = cvt_pk_bf16(a[0], a[1]); w.y = cvt_pk_bf16(a[2], a[3]); w.z = cvt_pk_bf16(b[0], b[1]); w.w = cvt_pk_bf16(b[2], b[3]); return w; }
__device__ __forceinline__ void unpack8(u32x4 w, f32x4& a, f32x4& b) { a = (f32x4){bf_lo(w.x), bf_hi(w.x), bf_lo(w.y), bf_hi(w.y)}; b = (f32x4){bf_lo(w.z), bf_hi(w.z), bf_lo(w.w), bf_hi(w.w)}; }

#define PG8_EPI_ARGS const f32x4 (&acc)[2][2][4][2], const Unit& u, int wr, int wc, int fr, int fq

#define PG8_PIN(x) asm volatile("" : "+v"(x))
template <class T> __device__ __forceinline__ T& at(const void* base, unsigned byteoff) { return *(T*)((char*)base + byteoff); }

__device__ __forceinline__ float xor16(float v, int fq) { const auto r = __builtin_amdgcn_permlane16_swap(__float_as_uint(v), __float_as_uint(v), false, false); return __uint_as_float((fq & 1) ? r[0] : r[1]); }
struct EpiProj {
    bf16_t* base; size_t tstride; bf16_t* IK; float* IW; const float* rope;
    __device__ __forceinline__ void operator()(PG8_EPI_ARGS) const {
        const int pn = u.pn, row0 = u.pm * BM + wr * 64 + fr;
        if (pn < 14) {
            const int t = pn >> 1;
            bf16_t* dst = base + (size_t)t * tstride;
            const bool rp = (t == 0) | (t == 1) | (t == 3) | (t == 4) | (t == 6);
            const float sc = (t == 0 || t == 3) ? C2 : (t == 6 ? 0.125f : 1.f);
            const bool rotw = rp && ((wc & 1) == 0);
            const unsigned cb = (unsigned)((pn & 1) * 256 + wc * 32 + 8 * fq) * 2u;
            constexpr int RB = 2; f32x4 rq[RB][4];
#define PG8_RP_LD(it) do { if (rotw) { unsigned r_ = (unsigned)(row0 + ((it) >> 2) * HALF + ((it) & 3) * 16); PG8_PIN(r_); \
                rq[(it) % RB][0] = at<const f32x4>(rope, r_ * 64u); rq[(it) % RB][1] = at<const f32x4>(rope, r_ * 64u + 16u); rq[(it) % RB][2] = at<const f32x4>(rope, r_ * 64u + 32u); rq[(it) % RB][3] = at<const f32x4>(rope, r_ * 64u + 48u); } } while (0)
#pragma unroll
            for (int it = 0; it < RB; ++it) PG8_RP_LD(it);
#pragma unroll
            for (int ai = 0; ai < 2; ++ai)
#pragma unroll
                for (int m = 0; m < 4; ++m) { const int it = ai * 4 + m;
                    unsigned row = (unsigned)(row0 + ai * HALF + m * 16); PG8_PIN(row);
                    f32x4 c0 = {1.f, 1.f, 1.f, 1.f}, c1 = c0, s0 = {0.f, 0.f, 0.f, 0.f}, s1 = s0;
                    if (rotw) { c0 = rq[it % RB][0]; c1 = rq[it % RB][1]; s0 = rq[it % RB][2]; s1 = rq[it % RB][3]; }
                    if (it + RB < 8) PG8_RP_LD(it + RB);
#pragma unroll
                    for (int bj = 0; bj < 2; ++bj) {
                        f32x4 v0 = acc[ai][bj][m][0], v1 = acc[ai][bj][m][1];
                        if (rotw) {
                            f32x4 p0, p1;
#pragma unroll
                            for (int i = 0; i < 4; ++i) { p0[i] = xor16(v0[i], fq); p1[i] = xor16(v1[i], fq); }
                            const float sg = (fq == 0) ? -1.f : 1.f;
                            const f32x4 r0 = v0 * c0 + (p0 * s0) * sg, r1 = v1 * c1 + (p1 * s1) * sg;
                            if (fq < 2) { v0 = r0; v1 = r1; }
                        }
                        v0 = v0 * sc; v1 = v1 * sc;
                        at<u32x4>(dst, row * 1024u + cb + bj * 256u) = pack8(v0, v1);
                    }
                    asm volatile("" ::: "memory");
                }
#undef PG8_RP_LD
        } else {
#pragma unroll
            for (int ai = 0; ai < 2; ++ai)
#pragma unroll
                for (int m = 0; m < 4; ++m) {
                    unsigned row = (unsigned)(row0 + ai * HALF + m * 16); PG8_PIN(row);
                    f32x4 v0 = acc[ai][0][m][0], v1 = acc[ai][0][m][1];
                    if (wc == 0) {
                        const f32x4 c0 = at<const f32x4>(rope, row * 64u), c1 = at<const f32x4>(rope, row * 64u + 16u), s0 = at<const f32x4>(rope, row * 64u + 32u), s1 = at<const f32x4>(rope, row * 64u + 48u);
                        f32x4 p0, p1;
#pragma unroll
                        for (int i = 0; i < 4; ++i) { p0[i] = xor16(v0[i], fq); p1[i] = xor16(v1[i], fq); }
                        const float sg = (fq == 0) ? -1.f : 1.f;
                        const f32x4 r0 = v0 * c0 + (p0 * s0) * sg, r1 = v1 * c1 + (p1 * s1) * sg;
                        if (fq < 2) { v0 = r0; v1 = r1; }
                    }
                    if (wc < 2) at<u32x4>(IK, row * 128u + (unsigned)(wc * 32 + 8 * fq) * 2u) = pack8(v0, v1);
                    else if (wc == 2 && fq == 0) { at<f32x4>(IW, row * 32u) = v0 * 0.35355339059f; at<f32x4>(IW, row * 32u + 16u) = v1 * 0.35355339059f; }
                    asm volatile("" ::: "memory");
                }
        }
    }
};
struct EpiSig {
    unsigned char* out; int ldc; float pre;
    __device__ __forceinline__ void operator()(PG8_EPI_ARGS) const {
        const unsigned o0 = (unsigned)(u.pm * BM + wr * 64 + fr) * 1024u + (unsigned)(u.pn * BM + wc * 32 + 8 * fq);
#pragma unroll
        for (int ai = 0; ai < 2; ++ai)
#pragma unroll
            for (int m = 0; m < 4; ++m) {
                unsigned o = o0 + (unsigned)(ai * HALF + m * 16) * 1024u; PG8_PIN(o);
#pragma unroll
                for (int bj = 0; bj < 2; ++bj) {
                    const f32x4 v0 = acc[ai][bj][m][0], v1 = acc[ai][bj][m][1];
                    unsigned w0 = 0u, w1 = 0u;
#pragma unroll
                    for (int i = 0; i < 4; ++i) { w0 = __builtin_amdgcn_cvt_pk_u8_f32(sigm(v0[i] * pre) * 255.f, i, w0); w1 = __builtin_amdgcn_cvt_pk_u8_f32(sigm(v1[i] * pre) * 255.f, i, w1); }
                    at<unsigned long long>(out, o + bj * 128u) = (unsigned long long)w0 | ((unsigned long long)w1 << 32);
                }
                asm volatile("" ::: "memory");
            }
    }
};
template <bool ADD>
struct EpiGatedT {
    const unsigned char* gate; const bf16_t* addsrc; bf16_t* out; int ldc;
    __device__ __forceinline__ void operator()(PG8_EPI_ARGS) const {
        const unsigned o0 = ((unsigned)(u.pm * BM + wr * 64 + fr) * 1024u + (unsigned)(u.pn * BM + wc * 32 + 8 * fq)) * 2u;
        constexpr int NB = 2;
        unsigned long long gq[NB][2]; u32x4 aq[ADD ? NB : 1][2];
#define PG8_GT_LD(it) do { unsigned o_ = o0 + (unsigned)(((it) >> 2) * HALF + ((it) & 3) * 16) * 2048u; PG8_PIN(o_); \
            gq[(it) % NB][0] = at<const unsigned long long>(gate, o_ >> 1); gq[(it) % NB][1] = at<const unsigned long long>(gate, (o_ >> 1) + 128u); \
            if constexpr (ADD) { aq[(it) % NB][0] = at<const u32x4>(addsrc, o_); aq[(it) % NB][1] = at<const u32x4>(addsrc, o_ + 256u); } } while (0)
#pragma unroll
        for (int it = 0; it < NB; ++it) PG8_GT_LD(it);
#pragma unroll
        for (int it = 0; it < 8; ++it) { const int ai = it >> 2, m = it & 3;
                unsigned o = o0 + (unsigned)(ai * HALF + m * 16) * 2048u; PG8_PIN(o);
                f32x4 v0[2], v1[2];
#pragma unroll
                for (int bj = 0; bj < 2; ++bj) {
                    const unsigned long long gw = gq[it % NB][bj]; const unsigned glo = (unsigned)gw, ghi = (unsigned)(gw >> 32); constexpr float K8 = 1.f / 255.f;
                    const f32x4 g0 = {(float)(glo & 0xffu) * K8, (float)((glo >> 8) & 0xffu) * K8, (float)((glo >> 16) & 0xffu) * K8, (float)(glo >> 24) * K8};
                    const f32x4 g1 = {(float)(ghi & 0xffu) * K8, (float)((ghi >> 8) & 0xffu) * K8, (float)((ghi >> 16) & 0xffu) * K8, (float)(ghi >> 24) * K8};
                    v0[bj] = acc[ai][bj][m][0] * g0; v1[bj] = acc[ai][bj][m][1] * g1;
                    if constexpr (ADD) { f32x4 a0, a1; unpack8(aq[it % NB][bj], a0, a1); v0[bj] = v0[bj] + a0; v1[bj] = v1[bj] + a1; }
                }
                if (it + NB < 8) PG8_GT_LD(it + NB);
#pragma unroll
                for (int bj = 0; bj < 2; ++bj) at<u32x4>(out, o + bj * 256u) = pack8(v0[bj], v1[bj]);
                asm volatile("" ::: "memory");
            }
#undef PG8_GT_LD
    }
};
struct EpiResBf16 {
    const bf16_t* x; bf16_t* out; float alpha;
    __device__ __forceinline__ void operator()(PG8_EPI_ARGS) const {
        const unsigned o0 = ((unsigned)(u.pm * BM + wr * 64 + fr) * 1024u + (unsigned)(u.pn * BM + wc * 32 + 8 * fq)) * 2u;
        u32x4 xq[8][2];
#define PG8_X_LD(buf, it) do { unsigned o_ = o0 + (unsigned)(((it) >> 2) * HALF + ((it) & 3) * 16) * 2048u; PG8_PIN(o_); \
            xq[buf][0] = at<const u32x4>(x, o_); xq[buf][1] = at<const u32x4>(x, o_ + 256u); } while (0)
#pragma unroll
        for (int it = 0; it < 8; ++it) PG8_X_LD(it, it);
#pragma unroll
        for (int it = 0; it < 8; ++it) { const int ai = it >> 2, m = it & 3;
                unsigned o = o0 + (unsigned)(ai * HALF + m * 16) * 2048u; PG8_PIN(o);
#pragma unroll
                for (int bj = 0; bj < 2; ++bj) { f32x4 x0, x1; unpack8(xq[it][bj], x0, x1);
                    at<u32x4>(out, o + bj * 256u) = pack8(x0 * alpha + acc[ai][bj][m][0], x1 * alpha + acc[ai][bj][m][1]); }
                asm volatile("" ::: "memory");
            }
#undef PG8_X_LD
    }
};
struct EpiGU {
    bf16_t* HG; const float* cw; float pre;
    __device__ __forceinline__ void operator()(PG8_EPI_ARGS) const {
        const int row0 = u.pm * BM + wr * 64 + fr; const unsigned cb = (unsigned)(u.pn * HALF + wc * 32 + 8 * fq) * 2u;
        float cv[8];
#pragma unroll
        for (int it = 0; it < 8; ++it) cv[it] = at<const float>(cw, (unsigned)(row0 + (it >> 2) * HALF + (it & 3) * 16) * 4u);
#pragma unroll
        for (int it = 0; it < 8; ++it) { const int ai = it >> 2, m = it & 3;
                unsigned row = (unsigned)(row0 + ai * HALF + m * 16); PG8_PIN(row);
                const float c = cv[it];
                f32x4 g0 = acc[ai][0][m][0] * pre, g1 = acc[ai][0][m][1] * pre; const f32x4 u0 = acc[ai][1][m][0] * pre, u1 = acc[ai][1][m][1] * pre;
#pragma unroll
                for (int i = 0; i < 4; ++i) { g0[i] = g0[i] * sigm(g0[i]) * u0[i] * c; g1[i] = g1[i] * sigm(g1[i]) * u1[i] * c; }
                at<u32x4>(HG, row * 512u + cb) = pack8(g0, g1);
                asm volatile("" ::: "memory");
            }
    }
};
struct EpiDown {
    const int* ent; bf16_t* Y0; unsigned ystride;
    __device__ __forceinline__ void operator()(PG8_EPI_ARGS) const {
        const int row0 = u.pm * BM + wr * 64 + fr; const unsigned cb = (unsigned)(u.pn * BM + wc * 32 + 8 * fq) * 2u;
        int ev[8];
#pragma unroll
        for (int it = 0; it < 8; ++it) ev[it] = at<const int>(ent, (unsigned)(row0 + (it >> 2) * HALF + (it & 3) * 16) * 4u);
#pragma unroll
        for (int it = 0; it < 8; ++it) { const int ai = it >> 2, m = it & 3; const int e = ev[it];
                if (e >= 0) { unsigned o = (unsigned)(e >> 1) * 2048u + cb + (unsigned)(e & 1) * ystride; PG8_PIN(o);
#pragma unroll
                    for (int bj = 0; bj < 2; ++bj) at<u32x4>(Y0, o + bj * 256u) = pack8(acc[ai][bj][m][0], acc[ai][bj][m][1]); }
                asm volatile("" ::: "memory");
            }
    }
};
struct EpiStore {
    bf16_t* out; int ldc;
    __device__ __forceinline__ void operator()(PG8_EPI_ARGS) const {
        const unsigned o0 = ((unsigned)(u.pm * BM + wr * 64 + fr) * 1024u + (unsigned)(u.pn * BM + wc * 32 + 8 * fq)) * 2u;
#pragma unroll
        for (int ai = 0; ai < 2; ++ai)
#pragma unroll
            for (int m = 0; m < 4; ++m) {
                unsigned o = o0 + (unsigned)(ai * HALF + m * 16) * 2048u; PG8_PIN(o);
#pragma unroll
                for (int bj = 0; bj < 2; ++bj) at<u32x4>(out, o + bj * 256u) = pack8(acc[ai][bj][m][0], acc[ai][bj][m][1]);
                asm volatile("" ::: "memory");
            }
    }
};
struct EpiPle {
    const bf16_t* t1; bf16_t* out; float pre;
    __device__ __forceinline__ void operator()(PG8_EPI_ARGS) const {
        const unsigned o0 = ((unsigned)(u.pm * BM + wr * 64 + fr) * 1024u + (unsigned)(u.pn * BM + wc * 32 + 8 * fq)) * 2u;
        u32x4 tq[8][2];
#define PG8_T_LD(buf, it) do { unsigned o_ = o0 + (unsigned)(((it) >> 2) * HALF + ((it) & 3) * 16) * 2048u; PG8_PIN(o_); \
            tq[buf][0] = at<const u32x4>(t1, o_); tq[buf][1] = at<const u32x4>(t1, o_ + 256u); } while (0)
#pragma unroll
        for (int it = 0; it < 8; ++it) PG8_T_LD(it, it);
#pragma unroll
        for (int it = 0; it < 8; ++it) { const int ai = it >> 2, m = it & 3;
                unsigned o = o0 + (unsigned)(ai * HALF + m * 16) * 2048u; PG8_PIN(o);
#pragma unroll
                for (int bj = 0; bj < 2; ++bj) {
                    f32x4 t0, t1v; unpack8(tq[it][bj], t0, t1v);
                    f32x4 v0 = acc[ai][bj][m][0], v1 = acc[ai][bj][m][1];
#pragma unroll
                    for (int i = 0; i < 4; ++i) { v0[i] = sigm(v0[i] * pre) * t0[i]; v1[i] = sigm(v1[i] * pre) * t1v[i]; }
                    at<u32x4>(out, o + bj * 256u) = pack8(v0, v1);
                }
                asm volatile("" ::: "memory");
            }
#undef PG8_T_LD
    }
};

template <class Epi, class Sched, bool ALIGN_EPI, bool GATHER = false, bool FP8 = false>
__device__ __forceinline__ void gemm_phase(PG8_LAS unsigned char* lds, const Gemm g, const Sched& S, const Epi& E, int wave_in) {
    const int tid = ltid(wave_in), wid = __builtin_amdgcn_readfirstlane(tid >> 6), lane = tid & 63, wr = wid >> 2, wc = wid & 3, fr = lane & 15, fq = lane >> 4;
    int K_ = g.K; asm volatile("" : "+s"(K_));
    const int K = K_, nt = K / BK;
    int RA[2], CA[2]; unsigned voffB[2], voffA[2];
#pragma unroll
    for (int i = 0; i < 2; ++i) { int R, C; stage_rc(tid * 16 + i * 8192, R, C); const int Rb = (R & ~31) + perm32(R & 31); RA[i] = R; CA[i] = C; voffB[i] = (unsigned)(Rb * g.ldb + C) * 2u; voffA[i] = (unsigned)(R * g.lda + C) * 2u; }
    const size_t hstepA = (size_t)HALF * g.lda * 2;
    const size_t kstep = (size_t)(BK * 2);
    const size_t hstepB = (size_t)HALF * g.ldb * 2;
    const unsigned ldsw = (unsigned)wid * 1024u;
    const int aoff = lds_byte(wr * 64 + fr, fq * 8), boff = lds_byte(wc * 32 + fr, fq * 8);
    const char* Ab = (const char*)g.A;
#define PG8_SA(b, h) (((b) * 2 + (h)) * HTB)
#define PG8_SB(b, h) ((4 + (b) * 2 + (h)) * HTB)
#define PG8_STAGE_A(bufoff, kb, OFF, h) do { _Pragma("unroll") for (int _i = 0; _i < 2; ++_i) { const char* _p; \
        if constexpr (GATHER) _p = Ab + (kb) + (OFF##_v)[h][_i]; else _p = Ab + ((kb) + (OFF##_u) + (size_t)(h) * hstepA) + voffA[_i]; \
        __builtin_amdgcn_global_load_lds((const unsigned*)_p, (PG8_LAS unsigned*)(lds + (bufoff) + ldsw + _i * 8192), 16, 0, 0); } } while (0)
#define PG8_STAGE_B(bufoff, gbase) do { _Pragma("unroll") for (int _i = 0; _i < 2; ++_i) \
        __builtin_amdgcn_global_load_lds((const unsigned*)((const char*)(gbase) + voffB[_i]), (PG8_LAS unsigned*)(lds + (bufoff) + ldsw + _i * 8192), 16, 0, 0); } while (0)
#define PG8_MKOFF(uu, OFF) do { if constexpr (GATHER) { _Pragma("unroll") for (int _h = 0; _h < 2; ++_h) _Pragma("unroll") for (int _i = 0; _i < 2; ++_i) { \
        const int _row = g.rows[(uu).pm * BM + _h * HALF + RA[_i]]; (OFF##_v)[_h][_i] = (unsigned)(_row * g.lda + CA[_i]) * 2u; } } else { OFF##_u = (size_t)(uu).pm * BM * g.lda * 2; } } while (0)
#define PG8_LDA(dst, b, h) do { _Pragma("unroll") for (int m = 0; m < 4; ++m) { if constexpr (FP8) { dst##8[m].lo = *(const PG8_LAS i32x4_t*)(lds + PG8_SA(b, h) + aoff + m * 2048); dst##8[m].hi = *(const PG8_LAS i32x4_t*)(lds + PG8_SA(b, h) + aoff + m * 2048 + 1024); } \
        else { _Pragma("unroll") for (int k = 0; k < 2; ++k) dst[m][k] = *(const PG8_LAS bf16x8*)(lds + PG8_SA(b, h) + aoff + m * 2048 + k * 1024); } } } while (0)
#define PG8_LDB(dst, b, h) do { _Pragma("unroll") for (int n = 0; n < 2; ++n) { if constexpr (FP8) { dst##8[n].lo = *(const PG8_LAS i32x4_t*)(lds + PG8_SB(b, h) + boff + n * 2048); dst##8[n].hi = *(const PG8_LAS i32x4_t*)(lds + PG8_SB(b, h) + boff + n * 2048 + 1024); } \
        else { _Pragma("unroll") for (int k = 0; k < 2; ++k) dst[n][k] = *(const PG8_LAS bf16x8*)(lds + PG8_SB(b, h) + boff + n * 2048 + k * 1024); } } } while (0)
#define PG8_MMA(ai, bj, At, Bt) do { __builtin_amdgcn_s_setprio(1); \
        if constexpr (FP8) { _Pragma("unroll") for (int m = 0; m < 4; ++m) _Pragma("unroll") for (int n = 0; n < 2; ++n) \
            asm volatile("v_mfma_f32_16x16x128_f8f6f4 %0, %1, %2, %0" : "+v"(acc[ai][bj][m][n]) : "v"(Bt##8[n]), "v"(At##8[m])); }   \
        else { _Pragma("unroll") for (int m = 0; m < 4; ++m) _Pragma("unroll") for (int n = 0; n < 2; ++n) _Pragma("unroll") for (int k = 0; k < 2; ++k) \
            acc[ai][bj][m][n] = __builtin_amdgcn_mfma_f32_16x16x32_bf16(Bt[n][k], At[m][k], acc[ai][bj][m][n], 0, 0, 0); } __builtin_amdgcn_s_setprio(0); } while (0)
#define PG8_WAIT_V(n) asm volatile("s_waitcnt vmcnt(" #n ")" ::: "memory")
#define PG8_WAIT_L(n) asm volatile("s_waitcnt lgkmcnt(" #n ")" ::: "memory")
#define PG8_BAR __builtin_amdgcn_s_barrier()
#define PG8_SCHED __builtin_amdgcn_sched_barrier(0)
    Unit cur, nxt; int ui = 0;
    if (!S.next(0, cur)) return;
    f32x4 acc[2][2][4][2];
#pragma unroll
    for (int a = 0; a < 2; ++a)
#pragma unroll
        for (int b = 0; b < 2; ++b)
#pragma unroll
            for (int m = 0; m < 4; ++m)
#pragma unroll
                for (int n = 0; n < 2; ++n) acc[a][b][m][n] = (f32x4){0.f, 0.f, 0.f, 0.f};
    bf16x8 At[4][2], B0[2][2], B1[2][2];
    i32x8_t At8[4], B08[2], B18[2];
    unsigned offAc_v[2][2], offAn_v[2][2]; size_t offAc_u = 0, offAn_u = 0;
    PG8_MKOFF(cur, offAc);
    const char* cB = (const char*)(g.Bt + cur.boff);
    PG8_STAGE_B(PG8_SB(0, 0), cB); PG8_STAGE_B(PG8_SB(0, 1), cB + hstepB); PG8_STAGE_A(PG8_SA(0, 0), 0, offAc, 0); PG8_STAGE_A(PG8_SA(0, 1), 0, offAc, 1);
    if (wr == 1) PG8_BAR;
    PG8_WAIT_V(2); PG8_BAR;
    PG8_STAGE_B(PG8_SB(1, 0), cB + kstep); PG8_STAGE_A(PG8_SA(1, 0), kstep, offAc, 0); PG8_STAGE_B(PG8_SB(1, 1), cB + hstepB + kstep);
    PG8_WAIT_V(6); PG8_BAR;
    for (;;) {
        const bool has_next = S.next(ui + 1, nxt);
        if (has_next) { PG8_MKOFF(nxt, offAn); }
        else { offAn_u = offAc_u;
#pragma unroll
            for (int h = 0; h < 2; ++h)
#pragma unroll
                for (int i = 0; i < 2; ++i) offAn_v[h][i] = offAc_v[h][i];
        }
        const char* nB = has_next ? (const char*)(g.Bt + nxt.boff) : cB;
        for (int t = 0; t < nt; t += 2) {
            const bool last = (t == nt - 2);
            const size_t a1k = (size_t)(t + 1) * kstep;
            const size_t a2k = last ? (size_t)0 : (size_t)(t + 2) * kstep; const char* b2 = last ? nB : cB + (size_t)(t + 2) * kstep;
            const size_t a3k = a2k + kstep; const char* b3 = b2 + kstep;
            unsigned o2_v[2][2]; const size_t o2_u = last ? offAn_u : offAc_u;
#pragma unroll
            for (int h = 0; h < 2; ++h)
#pragma unroll
                for (int i = 0; i < 2; ++i) o2_v[h][i] = last ? offAn_v[h][i] : offAc_v[h][i];
            PG8_LDB(B0, 0, 0); PG8_LDB(B1, 0, 1); PG8_SCHED; PG8_LDA(At, 0, 0); PG8_STAGE_A(PG8_SA(1, 1), a1k, offAc, 1);
            PG8_WAIT_V(8); PG8_WAIT_L(0); PG8_BAR; PG8_MMA(0, 0, At, B0); PG8_MMA(0, 1, At, B1); PG8_BAR; PG8_SCHED;
            PG8_LDA(At, 0, 1); PG8_STAGE_B(PG8_SB(0, 0), b2); PG8_STAGE_B(PG8_SB(0, 1), b2 + hstepB); PG8_STAGE_A(PG8_SA(0, 0), a2k, o2, 0);
            PG8_WAIT_V(8); PG8_WAIT_L(0); PG8_BAR; PG8_MMA(1, 0, At, B0); PG8_MMA(1, 1, At, B1); PG8_BAR; PG8_SCHED;
            PG8_LDB(B0, 1, 0); PG8_LDB(B1, 1, 1); PG8_SCHED; PG8_LDA(At, 1, 0); PG8_STAGE_A(PG8_SA(0, 1), a2k, o2, 1);
            PG8_WAIT_V(8); PG8_WAIT_L(0); PG8_BAR; PG8_MMA(0, 0, At, B0); PG8_MMA(0, 1, At, B1); PG8_BAR; PG8_SCHED;
            PG8_LDA(At, 1, 1); PG8_STAGE_B(PG8_SB(1, 0), b3); PG8_STAGE_B(PG8_SB(1, 1), b3 + hstepB); PG8_STAGE_A(PG8_SA(1, 0), a3k, o2, 0);
            PG8_WAIT_V(8); PG8_WAIT_L(0); PG8_BAR; PG8_MMA(1, 0, At, B0); PG8_MMA(1, 1, At, B1); PG8_BAR; PG8_SCHED;
        }
        if constexpr (ALIGN_EPI) { if (wr == 0) PG8_BAR; }
        if constexpr (FP8) asm volatile("s_nop 15\n\ts_nop 15\n\ts_nop 7" ::: "memory");
        E(acc, cur, wr, wc, fr, fq);
        if (!has_next) break;
#pragma unroll
        for (int a = 0; a < 2; ++a)
#pragma unroll
            for (int b = 0; b < 2; ++b)
#pragma unroll
                for (int m = 0; m < 4; ++m)
#pragma unroll
                    for (int n = 0; n < 2; ++n) acc[a][b][m][n] = (f32x4){0.f, 0.f, 0.f, 0.f};
        cur = nxt; cB = nB; ++ui; offAc_u = offAn_u;
#pragma unroll
        for (int h = 0; h < 2; ++h)
#pragma unroll
            for (int i = 0; i < 2; ++i) offAc_v[h][i] = offAn_v[h][i];
        if constexpr (ALIGN_EPI) { if (wr == 1) PG8_BAR; }
    }
    PG8_WAIT_V(0);
    if constexpr (!ALIGN_EPI) { if (wr == 0) PG8_BAR; }
    PG8_BAR;
#undef PG8_SA
#undef PG8_SB
#undef PG8_STAGE_A
#undef PG8_STAGE_B
#undef PG8_MKOFF
#undef PG8_LDA
#undef PG8_LDB
#undef PG8_MMA
#undef PG8_WAIT_V
#undef PG8_WAIT_L
#undef PG8_BAR
#undef PG8_SCHED
}
}
namespace attn_body {
using bf16=__hip_bfloat16;
using bf16x8=__attribute__((ext_vector_type(8)))short;
using s16x4=__attribute__((ext_vector_type(4)))short;
using f32x16=__attribute__((ext_vector_type(16)))float;
using u32x4=__attribute__((ext_vector_type(4)))unsigned;
constexpr int BATCH=2,SEQ=16384,D=64,DM=512;
constexpr int NW=8,QBLK=32,QB=QBLK*NW,KVBLK=64,NQB=SEQ/QB;
constexpr int ATTN_PITCH=DM, ATTN_UNIT_ROWS=QB;
__device__ __forceinline__ int crow(int r,int hi){return (r&3)+8*(r>>2)+4*hi;}
#define SBAR() __builtin_amdgcn_sched_barrier(0)
__device__ __forceinline__ void cmask(f32x16&p0,f32x16&p1,int jb,int qrel,int hi){
  const float NEG=-INFINITY; int kb=64*jb+4*hi;
  #pragma unroll
  for(int r=0;r<16;++r){int kv=kb+(r&3)+8*(r>>2); if(kv>qrel)p0[r]=NEG; if(kv+32>qrel)p1[r]=NEG;}
}

constexpr int NSLOT=3, SLOTB=8192;
constexpr int LDS_K=0, LDS_V=NSLOT*SLOTB, LDS_WS=2*NSLOT*SLOTB, LDS_OST=LDS_WS+NW*64*4, LDS_MK=LDS_OST+NW*4096, LDS_BYTES=LDS_MK+NW*1024, LDS_BYTES_WIDE=LDS_V+NSLOT*2*SLOTB+NW*64*4+NW*4096;
constexpr float C2=0.125f*1.4426950408889634f;
__device__ __forceinline__ void glds16(const void*gsrc,unsigned lds_dst){unsigned keep;
  asm volatile("s_mov_b32 %0, m0\n\ts_mov_b32 m0, %2\n\ts_nop 0\n\tglobal_load_lds_dwordx4 %1, off\n\ts_mov_b32 m0, %0":"=&s"(keep):"v"(gsrc),"s"(lds_dst):"memory");}
__device__ __forceinline__ float max3f(float a,float b,float c){float r;asm("v_max3_f32 %0, %1, %2, %3":"=v"(r):"v"(a),"v"(b),"v"(c));return r;}
__device__ __forceinline__ float max2f(float a,float b){float r;asm("v_max_f32_e32 %0, %1, %2":"=v"(r):"v"(a),"v"(b));return r;}
__device__ __forceinline__ float fadd_s(float a,float b){float r;asm("v_add_f32_e32 %0, %1, %2":"=v"(r):"v"(a),"v"(b));return r;}
__device__ __forceinline__ float fsub_s(float a,float b){float r;asm("v_sub_f32_e32 %0, %1, %2":"=v"(r):"v"(a),"v"(b));return r;}
typedef float f32x2_t __attribute__((ext_vector_type(2))); typedef __bf16 bf16x2_t __attribute__((ext_vector_type(2)));
__device__ __forceinline__ unsigned cvtpk_s(float lo,float hi){f32x2_t v={lo,hi};bf16x2_t b=__builtin_convertvector(v,bf16x2_t);return __builtin_bit_cast(unsigned,b);}
#define WAIT_BAR(N) asm volatile("s_waitcnt vmcnt(" #N ") lgkmcnt(0)\n\ts_barrier":::"memory")

__device__ __forceinline__ void qkt(f32x16&p0,f32x16&p1,const char*Kslot,const bf16x8*qr,const f32x16&ci0,const f32x16&ci1,int r32,int hi){
  const char*kb=Kslot+hi*1024+r32*16;
  #pragma unroll
  for(int d0=0;d0<4;++d0){
    const bf16x8 b0=*reinterpret_cast<const bf16x8*>(kb+d0*2048);
    const bf16x8 b1=*reinterpret_cast<const bf16x8*>(kb+d0*2048+512);
    if(d0==0){p0=__builtin_amdgcn_mfma_f32_32x32x16_bf16(b0,qr[0],ci0,0,0,0);p1=__builtin_amdgcn_mfma_f32_32x32x16_bf16(b1,qr[0],ci1,0,0,0);}
    else{p0=__builtin_amdgcn_mfma_f32_32x32x16_bf16(b0,qr[d0],p0,0,0,0);p1=__builtin_amdgcn_mfma_f32_32x32x16_bf16(b1,qr[d0],p1,0,0,0);}}
}
typedef __attribute__((address_space(3))) const char* lds_cptr;
typedef short v4i16_t __attribute__((ext_vector_type(4)));
__device__ __forceinline__ void kload8(bf16x8*kf,lds_cptr kp){
  kf[0]=*(const __attribute__((address_space(3))) bf16x8*)(kp);      kf[1]=*(const __attribute__((address_space(3))) bf16x8*)(kp+512);
  kf[2]=*(const __attribute__((address_space(3))) bf16x8*)(kp+2048); kf[3]=*(const __attribute__((address_space(3))) bf16x8*)(kp+2560);
  kf[4]=*(const __attribute__((address_space(3))) bf16x8*)(kp+4096); kf[5]=*(const __attribute__((address_space(3))) bf16x8*)(kp+4608);
  kf[6]=*(const __attribute__((address_space(3))) bf16x8*)(kp+6144); kf[7]=*(const __attribute__((address_space(3))) bf16x8*)(kp+6656);
}
__device__ __forceinline__ void kload2(bf16x8*kf,lds_cptr kp,int j){ kf[2*j]=*(const __attribute__((address_space(3))) bf16x8*)(kp+j*2048); kf[2*j+1]=*(const __attribute__((address_space(3))) bf16x8*)(kp+j*2048+512); }
__device__ __forceinline__ s16x4 vtr(lds_cptr p){ return __builtin_bit_cast(s16x4,__builtin_amdgcn_ds_read_tr16_b64_v4i16((__attribute__((address_space(3))) v4i16_t*)p)); }
__device__ __forceinline__ float rowmax(const f32x16&p0,const f32x16&p1){
  float a=max3f(p0[0],p0[1],p1[0]),b=max3f(p0[2],p0[3],p1[1]);a=max3f(a,p1[2],p1[3]);
  #pragma unroll
  for(int r=4;r<16;r+=4){a=max3f(a,p0[r],p0[r+1]);b=max3f(b,p0[r+2],p0[r+3]);a=max3f(a,p1[r],p1[r+1]);b=max3f(b,p1[r+2],p1[r+3]);}
  const float m=max2f(a,b);
  auto rr=__builtin_amdgcn_permlane32_swap(__float_as_uint(m),__float_as_uint(m),false,false);
  return max2f(__uint_as_float(rr[0]),__uint_as_float(rr[1]));
}
__device__ __forceinline__ void pv(f32x16*o,int vb,bf16x8 pa0,bf16x8 pa1,bf16x8 pa2,bf16x8 pa3){
  #pragma unroll
  for(int d0=0;d0<2;++d0){s16x4 lo[4],hi[4];
    #pragma unroll
    for(int ks=0;ks<4;++ks){
      asm volatile("ds_read_b64_tr_b16 %0,%1 offset:%c2":"=&v"(lo[ks]):"v"(vb),"i"(d0*4096+ks*1024):"memory");
      asm volatile("ds_read_b64_tr_b16 %0,%1 offset:%c2":"=&v"(hi[ks]):"v"(vb),"i"(d0*4096+ks*1024+512):"memory");}
    asm volatile("s_waitcnt lgkmcnt(0)":::"memory");SBAR();
    #define PK(k) (bf16x8){lo[k][0],lo[k][1],lo[k][2],lo[k][3],hi[k][0],hi[k][1],hi[k][2],hi[k][3]}
    o[d0]=__builtin_amdgcn_mfma_f32_32x32x16_bf16(pa0,PK(0),o[d0],0,0,0);
    o[d0]=__builtin_amdgcn_mfma_f32_32x32x16_bf16(pa1,PK(1),o[d0],0,0,0);
    o[d0]=__builtin_amdgcn_mfma_f32_32x32x16_bf16(pa2,PK(2),o[d0],0,0,0);
    o[d0]=__builtin_amdgcn_mfma_f32_32x32x16_bf16(pa3,PK(3),o[d0],0,0,0);
    #undef PK
  }
}

#ifndef ATTN_STORE16
#define ATTN_STORE16(p,v) (*(u32x4*)(p)=(v))
#endif
template<int THRL,bool MASKED,bool WIDE,bool NOMAX> __device__ __forceinline__ void attn_unit(int b,int hq,int hv,int qb,const bf16*Q,const bf16*__restrict__ K,const bf16*__restrict__ V,bf16*O,const unsigned long long*__restrict__ MK,char*shm,int wave_in,int badoff){
  const int tid=ltid(wave_in),lane=tid&63,r32=lane&31,hi=lane>>5; const int wid=__builtin_amdgcn_readfirstlane(tid>>6);
  const long rowbase=(long)b*SEQ; const int q0=qb*QB;
  const bf16*Qw=Q+(rowbase+q0+wid*QBLK)*DM+hq*D;
  const bf16*Kh=K+rowbase*DM+hq*D,*Vh=V+rowbase*DM+hv*D;
  constexpr int VSLOT=WIDE?2*SLOTB:SLOTB, L_WS=LDS_V+NSLOT*VSLOT, L_OST=L_WS+NW*64*4, L_MK=L_OST+NW*4096, L_TAB=L_MK+NW*2048;
  #define VS(sl) (WIDE?2*(sl):(sl))
  const unsigned lds0=(unsigned)(uintptr_t)shm;
  float*wsf=(float*)(shm+L_WS)+wid*64;
  const bf16*ksrc=Kh+(long)lane*DM+wid*8;
  const bf16*vsrc=Vh+(long)(16*(wid&3)+(lane>>2))*DM+(wid>>2)*32+(lane&3)*8;
  const unsigned kdst=lds0+LDS_K+wid*1024, vdst=lds0+LDS_V+wid*1024;
  #define DMA_K(t,slot) glds16(ksrc+(long)(t)*KVBLK*DM,(unsigned)__builtin_amdgcn_readfirstlane(kdst+(slot)))
  #define DMA_V(t,slot) do{ glds16(vsrc+(long)(t)*KVBLK*DM,(unsigned)__builtin_amdgcn_readfirstlane(vdst+VS(slot))); if(WIDE){ glds16(vsrc+64+(long)(t)*KVBLK*DM,(unsigned)__builtin_amdgcn_readfirstlane(vdst+VS(slot)+8192)); } }while(0)
  const long mq0=(long)q0+wid*QBLK+2*(lane&15); const unsigned mdst=lds0+L_MK+wid*2048;
  #define DMA_M4(t0) do{ if(MASKED){ const long t_=(long)(t0)+(lane>>4); if(t_<NT){ glds16(MK+(16384L*t_-32L*t_*(t_-1)+mq0-64L*t_),(unsigned)__builtin_amdgcn_readfirstlane(mdst+(((t0)&7)*256))); } } }while(0)
  unsigned mw0=0u,mw1=0u;
  #define MKRD(t) do{ if(MASKED){ const unsigned long long w_=*(const __attribute__((address_space(3))) unsigned long long*)(shm3+L_MK+wid*2048+(((t)&7)*256)+r32*8); mw0=(unsigned)w_; mw1=(unsigned)(w_>>32); } }while(0)
  #define MAND(X,r,MW) do{}while(0)
  bf16x8 aid[2];
  if(MASKED){
    #pragma unroll
    for(int ks=0;ks<2;++ks)
      #pragma unroll
      for(int j=0;j<8;++j) aid[ks][j]=(short)((r32==16*ks+8*hi+j)?0x3F80:0);
  }
  #define TABRD(w,ks) (*(const __attribute__((address_space(3))) bf16x8*)(shm3+L_TAB+((((w)>>(16*(ks)+8*hi))&0xffu)<<4)))
  #define BIAS(C0,C1,CI) do{ const bf16x8 f00_=TABRD(mw0,0),f01_=TABRD(mw0,1),f10_=TABRD(mw1,0),f11_=TABRD(mw1,1); \
    C0=__builtin_amdgcn_mfma_f32_32x32x16_bf16(aid[0],f00_,CI,0,0,0); C1=__builtin_amdgcn_mfma_f32_32x32x16_bf16(aid[0],f10_,CI,0,0,0); \
    C0=__builtin_amdgcn_mfma_f32_32x32x16_bf16(aid[1],f01_,C0,0,0,0); C1=__builtin_amdgcn_mfma_f32_32x32x16_bf16(aid[1],f11_,C1,0,0,0); }while(0)
  const int vb0=(int)(lds0+LDS_V)+((lane>>4)&1)*32+(lane&3)*8+(4*hi+((lane&15)>>2))*64;
  const char*Kbase=shm+LDS_K; bf16x8 kf[8];
  const lds_cptr shm3=(lds_cptr)shm; const lds_cptr kp0=shm3+LDS_K+hi*1024+r32*16; const lds_cptr vp0=shm3+LDS_V+((lane>>4)&1)*32+(lane&3)*8+(4*hi+((lane&15)>>2))*64;
  const int NT=(q0+QB)/KVBLK;
  DMA_M4(0);DMA_K(0,0);DMA_V(0,0);DMA_K(1,SLOTB);
  bf16x8 qr[4];
  #pragma unroll
  for(int d0=0;d0<4;++d0)qr[d0]=*reinterpret_cast<const bf16x8*>(&Qw[(long)r32*DM+d0*16+hi*8]);
  float mhat=0.f,l_reg=0.f;f32x16 o[4];o[0]=f32x16{};o[1]=f32x16{};o[2]=f32x16{};o[3]=f32x16{};f32x16 negm=f32x16{}; if(!WIDE&&!NOMAX){ asm volatile("":"+v"(negm)); }
  const int qrel=wid*QBLK+r32;
  #define CMASK(P0,P1,t) do{int jb_=(t)-(NT-4); if(jb_>=0)cmask(P0,P1,jb_,qrel,hi);}while(0)
  bool resc=false;
  #define START(P0,P1) do{ resc=false; \
    if constexpr(!NOMAX){ const float rm=rowmax(P0,P1); const float dl=rm; mhat=fadd_s(mhat,dl); \
      _Pragma("unroll") for(int r=0;r<16;++r){P0[r]=fsub_s(P0[r],dl);P1[r]=fsub_s(P1[r],dl);} \
      if(!WIDE){ _Pragma("unroll") for(int r=0;r<16;++r)negm[r]=-mhat; asm volatile("":"+v"(negm)); } } \
    _Pragma("unroll") for(int r=0;r<16;++r)P0[r]=__builtin_amdgcn_exp2f(P0[r]); }while(0)
  #define RESC() do{ if constexpr(!NOMAX) if(resc){ asm volatile("s_waitcnt lgkmcnt(0)":::"memory"); \
      _Pragma("unroll") for(int d_=0;d_<(WIDE?4:2);++d_) _Pragma("unroll") for(int r=0;r<16;++r)o[d_][r]*=wsf[crow(r,hi)]; } }while(0)
  f32x16 pA0,pA1,pB0,pB1;
  int sl_prev=0,sl_cur=0,sl_next=SLOTB;
  #define ROT() do{sl_prev=sl_cur;sl_cur=sl_next;sl_next=(sl_next==(NSLOT-1)*SLOTB)?0:sl_next+SLOTB;}while(0)
  DMA_K(2,2*SLOTB); const bool m4b_=MASKED&&(4<NT); if(m4b_){DMA_M4(4);}
  if(WIDE||m4b_){WAIT_BAR(4);}else{WAIT_BAR(3);}
  if(MASKED){ MKRD(0); BIAS(pA0,pA1,negm); qkt(pA0,pA1,Kbase,qr,pA0,pA1,r32,hi); } else { qkt(pA0,pA1,Kbase,qr,negm,negm,r32,hi); }
  asm volatile("s_nop 15\n\ts_nop 7":"+v"(pA0),"+v"(pA1));CMASK(pA0,pA1,0);
  START(pA0,pA1);
  _Pragma("unroll") for(int r=0;r<16;++r)pA1[r]=__builtin_amdgcn_exp2f(pA1[r]);
  WAIT_BAR(0);
  DMA_K(3,0);DMA_V(1,SLOTB);
  ROT();
  kload8(kf,kp0+sl_cur);
  if(WIDE){WAIT_BAR(3);}else{WAIT_BAR(2);}
  s16x4 vlo[8],vhi[8]; u32x4 pw0,pw1,pw2,pw3;
  #define PKW(P,B) cvtpk_s(P[B],P[B+1])
  #define PAF(k) __builtin_bit_cast(bf16x8,pw##k)
  #define VFR(i) (bf16x8){vlo[i][0],vlo[i][1],vlo[i][2],vlo[i][3],vhi[i][0],vhi[i][1],vhi[i][2],vhi[i][3]}
  #define PIN(x) asm volatile("":"+v"(x))
  #define MX3(a,b,c) __builtin_fmaxf(__builtin_fmaxf((a),(b)),(c))
  #define GAPA(MF,A0,A1,A2,A3,W0,W1,PW) do{ MF; sacc+=A0; sacc+=A1; sacc+=A2; sacc+=A3; PIN(sacc); W0; W1; PIN(PW); SBAR(); }while(0)
  #define EX(v) __builtin_amdgcn_exp2f(v)
  #define GAPB(MF,X,B,MW) do{ MF; X[B]=EX(X[B]); X[B+1]=EX(X[B+1]); X[B+2]=EX(X[B+2]); X[B+3]=EX(X[B+3]); MAND(X,B,MW); MAND(X,B+1,MW); MAND(X,B+2,MW); MAND(X,B+3,MW); PIN(X); SBAR(); }while(0)
  #define GAPB2(MF,X,B) do{ MF; X[B]=EX(X[B]); X[B+1]=EX(X[B+1]); PIN(X); SBAR(); }while(0)
  #define VRD(i) do{ vlo[i]=vtr(vp_+(((i)>>2)*4096+((i)&3)*1024)); vhi[i]=vtr(vp_+(((i)>>2)*4096+((i)&3)*1024+512)); }while(0)
  #define KRD(G,j) do{ if(G){ kload2(kf,kp0+sl_next,j); SBAR(); } }while(0)
  #define STEP(C0,C1,P0,P1,t,GK,GV,GL,GM) do{ SBAR(); \
    const lds_cptr vp_=vp0+VS(sl_prev); \
    if(MASKED){ MKRD(t); BIAS(C0,C1,negm); SBAR(); } \
    VRD(0); SBAR(); float sacc=(P0[0]+P0[1]); \
    GAPA(C0=__builtin_amdgcn_mfma_f32_32x32x16_bf16(kf[0],qr[0],(MASKED?C0:negm),0,0,0), P0[2],P0[3],P0[4],P0[5],     pw0[0]=PKW(P0,0), pw0[1]=PKW(P0,2), pw0); \
    VRD(4); SBAR(); GAPA(C1=__builtin_amdgcn_mfma_f32_32x32x16_bf16(kf[1],qr[0],(MASKED?C1:negm),0,0,0), P0[6],P0[7],P0[8],P0[9],     pw0[2]=PKW(P0,4), pw0[3]=PKW(P0,6), pw0); \
    VRD(1); SBAR(); GAPA(C0=__builtin_amdgcn_mfma_f32_32x32x16_bf16(kf[2],qr[1],C0,0,0,0),   P0[10],P0[11],P0[12],P0[13], pw1[0]=PKW(P0,8), pw1[1]=PKW(P0,10), pw1); \
    VRD(5); SBAR(); GAPA(C1=__builtin_amdgcn_mfma_f32_32x32x16_bf16(kf[3],qr[1],C1,0,0,0),   P0[14],P0[15],P1[0],P1[1],   pw1[2]=PKW(P0,12),pw1[3]=PKW(P0,14), pw1); \
    VRD(2); SBAR(); GAPA(C0=__builtin_amdgcn_mfma_f32_32x32x16_bf16(kf[4],qr[2],C0,0,0,0),   P1[2],P1[3],P1[4],P1[5],     pw2[0]=PKW(P1,0), pw2[1]=PKW(P1,2), pw2); \
    VRD(6); SBAR(); GAPA(C1=__builtin_amdgcn_mfma_f32_32x32x16_bf16(kf[5],qr[2],C1,0,0,0),   P1[6],P1[7],P1[8],P1[9],     pw2[2]=PKW(P1,4), pw2[3]=PKW(P1,6), pw2); \
    VRD(3); SBAR(); GAPA(C0=__builtin_amdgcn_mfma_f32_32x32x16_bf16(kf[6],qr[3],C0,0,0,0),   P1[10],P1[11],P1[12],P1[13], pw3[0]=PKW(P1,8), pw3[1]=PKW(P1,10), pw3); \
    VRD(7); SBAR(); GAPA(C1=__builtin_amdgcn_mfma_f32_32x32x16_bf16(kf[7],qr[3],C1,0,0,0),   P1[14],P1[15],0.f,0.f,       pw3[2]=PKW(P1,12),pw3[3]=PKW(P1,14), pw3); \
    l_reg+=sacc; \
    if(GK){DMA_K((t)+3,sl_cur);} if(GV){DMA_V((t)+1,sl_next);} if(MASKED&&GM){ if((((t)&3)==0)&&((t)+4<NT)){DMA_M4((t)+4);} } \
    CMASK(C0,C1,t); \
    if constexpr(!NOMAX){ float a=MX3(C0[0],C0[1],C1[0]),b=MX3(C0[2],C0[3],C1[1]); a=MX3(a,C1[2],C1[3]); \
      _Pragma("unroll") for(int r=4;r<16;r+=4){a=MX3(a,C0[r],C0[r+1]);b=MX3(b,C0[r+2],C0[r+3]);a=MX3(a,C1[r],C1[r+1]);b=MX3(b,C1[r+2],C1[r+3]);} \
      float rm=__builtin_fmaxf(a,b); { auto rr=__builtin_amdgcn_permlane32_swap(__float_as_uint(rm),__float_as_uint(rm),false,false); rm=__builtin_fmaxf(__uint_as_float(rr[0]),__uint_as_float(rr[1])); } \
      resc=false; \
      if(__builtin_expect(__any(rm>(float)THRL),0)){ const float dl=__builtin_fmaxf(rm,0.f); mhat+=dl; \
        _Pragma("unroll") for(int r=0;r<16;++r){C0[r]-=dl;C1[r]-=dl;} \
        _Pragma("unroll") for(int r=0;r<16;++r)negm[r]=-mhat; asm volatile("":"+v"(negm)); \
        const float f=__builtin_amdgcn_exp2f(-dl); l_reg*=f; if(hi==0)wsf[r32]=f; resc=true; } } \
    SBAR(); \
    GAPB(o[0]=__builtin_amdgcn_mfma_f32_32x32x16_bf16(PAF(0),VFR(0),o[0],0,0,0), C0,0,mw0); \
    GAPB(o[1]=__builtin_amdgcn_mfma_f32_32x32x16_bf16(PAF(0),VFR(4),o[1],0,0,0), C0,4,mw0); \
    KRD(GL,0); GAPB(o[0]=__builtin_amdgcn_mfma_f32_32x32x16_bf16(PAF(1),VFR(1),o[0],0,0,0), C0,8,mw0); \
    KRD(GL,1); GAPB(o[1]=__builtin_amdgcn_mfma_f32_32x32x16_bf16(PAF(1),VFR(5),o[1],0,0,0), C0,12,mw0); \
    KRD(GL,2); GAPB(o[0]=__builtin_amdgcn_mfma_f32_32x32x16_bf16(PAF(2),VFR(2),o[0],0,0,0), C1,0,mw1); \
    KRD(GL,3); GAPB(o[1]=__builtin_amdgcn_mfma_f32_32x32x16_bf16(PAF(2),VFR(6),o[1],0,0,0), C1,4,mw1); \
    GAPB(o[0]=__builtin_amdgcn_mfma_f32_32x32x16_bf16(PAF(3),VFR(3),o[0],0,0,0), C1,8,mw1); \
    GAPB(o[1]=__builtin_amdgcn_mfma_f32_32x32x16_bf16(PAF(3),VFR(7),o[1],0,0,0), C1,12,mw1); \
    }while(0)
  #define VLD(n,f) do{ vlo[(n)&3]=vtr(vp_+(((f)>>2)*4096+((f)&3)*1024)); vhi[(n)&3]=vtr(vp_+(((f)>>2)*4096+((f)&3)*1024+512)); }while(0)
  #define VFW(n) (bf16x8){vlo[(n)&3][0],vlo[(n)&3][1],vlo[(n)&3][2],vlo[(n)&3][3],vhi[(n)&3][0],vhi[(n)&3][1],vhi[(n)&3][2],vhi[(n)&3][3]}
  #define PVN(OD,k,n,fnext) do{ OD=__builtin_amdgcn_mfma_f32_32x32x16_bf16(PAF(k),VFW(n),OD,0,0,0); SBAR(); if((fnext)>=0){ VLD(n,fnext); SBAR(); } }while(0)
  #define STEPW(C0,C1,P0,P1,t,GK,GV,GL) do{ SBAR(); \
    const lds_cptr vp_=vp0+VS(sl_prev); \
    VLD(0,0); SBAR(); float sacc=(P0[0]+P0[1]); f32x16 ci_=f32x16{}; if constexpr(!NOMAX){ const float nm_=-mhat; _Pragma("unroll") for(int r=0;r<16;++r)ci_[r]=nm_; }     \
    GAPA(C0=__builtin_amdgcn_mfma_f32_32x32x16_bf16(kf[0],qr[0],ci_,0,0,0), P0[2],P0[3],P0[4],P0[5],     pw0[0]=PKW(P0,0), pw0[1]=PKW(P0,2), pw0); \
    VLD(1,4); SBAR(); GAPA(C1=__builtin_amdgcn_mfma_f32_32x32x16_bf16(kf[1],qr[0],ci_,0,0,0), P0[6],P0[7],P0[8],P0[9],     pw0[2]=PKW(P0,4), pw0[3]=PKW(P0,6), pw0); \
    VLD(2,1); SBAR(); GAPA(C0=__builtin_amdgcn_mfma_f32_32x32x16_bf16(kf[2],qr[1],C0,0,0,0),   P0[10],P0[11],P0[12],P0[13], pw1[0]=PKW(P0,8), pw1[1]=PKW(P0,10), pw1); \
    VLD(3,5); SBAR(); GAPA(C1=__builtin_amdgcn_mfma_f32_32x32x16_bf16(kf[3],qr[1],C1,0,0,0),   P0[14],P0[15],P1[0],P1[1],   pw1[2]=PKW(P0,12),pw1[3]=PKW(P0,14), pw1); \
    GAPA(C0=__builtin_amdgcn_mfma_f32_32x32x16_bf16(kf[4],qr[2],C0,0,0,0),   P1[2],P1[3],P1[4],P1[5],     pw2[0]=PKW(P1,0), pw2[1]=PKW(P1,2), pw2); \
    GAPA(C1=__builtin_amdgcn_mfma_f32_32x32x16_bf16(kf[5],qr[2],C1,0,0,0),   P1[6],P1[7],P1[8],P1[9],     pw2[2]=PKW(P1,4), pw2[3]=PKW(P1,6), pw2); \
    GAPA(C0=__builtin_amdgcn_mfma_f32_32x32x16_bf16(kf[6],qr[3],C0,0,0,0),   P1[10],P1[11],P1[12],P1[13], pw3[0]=PKW(P1,8), pw3[1]=PKW(P1,10), pw3); \
    GAPA(C1=__builtin_amdgcn_mfma_f32_32x32x16_bf16(kf[7],qr[3],C1,0,0,0),   P1[14],P1[15],0.f,0.f,       pw3[2]=PKW(P1,12),pw3[3]=PKW(P1,14), pw3); \
    l_reg+=sacc; \
    if(GK){DMA_K((t)+3,sl_cur);} if(GV){DMA_V((t)+1,sl_next);} \
    CMASK(C0,C1,t); \
    if constexpr(!NOMAX){ float a=MX3(C0[0],C0[1],C1[0]),b=MX3(C0[2],C0[3],C1[1]); a=MX3(a,C1[2],C1[3]); \
      _Pragma("unroll") for(int r=4;r<16;r+=4){a=MX3(a,C0[r],C0[r+1]);b=MX3(b,C0[r+2],C0[r+3]);a=MX3(a,C1[r],C1[r+1]);b=MX3(b,C1[r+2],C1[r+3]);} \
      float rm=__builtin_fmaxf(a,b); { auto rr=__builtin_amdgcn_permlane32_swap(__float_as_uint(rm),__float_as_uint(rm),false,false); rm=__builtin_fmaxf(__uint_as_float(rr[0]),__uint_as_float(rr[1])); } \
      resc=false; \
      if(__builtin_expect(__any(rm>(float)THRL),0)){ const float dl=__builtin_fmaxf(rm,0.f); mhat+=dl; \
        _Pragma("unroll") for(int r=0;r<16;++r){C0[r]-=dl;C1[r]-=dl;} \
        const float f=__builtin_amdgcn_exp2f(-dl); l_reg*=f; if(hi==0)wsf[r32]=f; resc=true; } } \
    SBAR(); \
    GAPB2(o[0]=__builtin_amdgcn_mfma_f32_32x32x16_bf16(PAF(0),VFW(0),o[0],0,0,0), C0,0); VLD(0,2); SBAR(); \
    GAPB2(o[1]=__builtin_amdgcn_mfma_f32_32x32x16_bf16(PAF(0),VFW(1),o[1],0,0,0), C0,2); VLD(1,6); SBAR(); \
    KRD(GL,0); GAPB2(o[0]=__builtin_amdgcn_mfma_f32_32x32x16_bf16(PAF(1),VFW(2),o[0],0,0,0), C0,4); VLD(2,3); SBAR(); \
    KRD(GL,1); GAPB2(o[1]=__builtin_amdgcn_mfma_f32_32x32x16_bf16(PAF(1),VFW(3),o[1],0,0,0), C0,6); VLD(3,7); SBAR(); \
    KRD(GL,2); GAPB2(o[0]=__builtin_amdgcn_mfma_f32_32x32x16_bf16(PAF(2),VFW(4),o[0],0,0,0), C0,8); VLD(4,8); SBAR(); \
    KRD(GL,3); GAPB2(o[1]=__builtin_amdgcn_mfma_f32_32x32x16_bf16(PAF(2),VFW(5),o[1],0,0,0), C0,10); VLD(5,12); SBAR(); \
    GAPB2(o[0]=__builtin_amdgcn_mfma_f32_32x32x16_bf16(PAF(3),VFW(6),o[0],0,0,0), C0,12); VLD(6,9); SBAR(); \
    GAPB2(o[1]=__builtin_amdgcn_mfma_f32_32x32x16_bf16(PAF(3),VFW(7),o[1],0,0,0), C0,14); VLD(7,13); SBAR(); \
    GAPB2(o[2]=__builtin_amdgcn_mfma_f32_32x32x16_bf16(PAF(0),VFW(8),o[2],0,0,0), C1,0); VLD(8,10); SBAR(); \
    GAPB2(o[3]=__builtin_amdgcn_mfma_f32_32x32x16_bf16(PAF(0),VFW(9),o[3],0,0,0), C1,2); VLD(9,14); SBAR(); \
    GAPB2(o[2]=__builtin_amdgcn_mfma_f32_32x32x16_bf16(PAF(1),VFW(10),o[2],0,0,0), C1,4); VLD(10,11); SBAR(); \
    GAPB2(o[3]=__builtin_amdgcn_mfma_f32_32x32x16_bf16(PAF(1),VFW(11),o[3],0,0,0), C1,6); VLD(11,15); SBAR(); \
    GAPB2(o[2]=__builtin_amdgcn_mfma_f32_32x32x16_bf16(PAF(2),VFW(12),o[2],0,0,0), C1,8); \
    GAPB2(o[3]=__builtin_amdgcn_mfma_f32_32x32x16_bf16(PAF(2),VFW(13),o[3],0,0,0), C1,10); \
    GAPB2(o[2]=__builtin_amdgcn_mfma_f32_32x32x16_bf16(PAF(3),VFW(14),o[2],0,0,0), C1,12); \
    GAPB2(o[3]=__builtin_amdgcn_mfma_f32_32x32x16_bf16(PAF(3),VFW(15),o[3],0,0,0), C1,14); \
    }while(0)
  #define STEPX(C0,C1,P0,P1,t,GK,GV,GL,GM) do{ if constexpr(WIDE){ STEPW(C0,C1,P0,P1,t,GK,GV,GL); } else { STEP(C0,C1,P0,P1,t,GK,GV,GL,GM); } }while(0)
  int t=1;
  #undef CMASK
  #define CMASK(P0,P1,t) do{}while(0)
  for(;t+5<NT;t+=2){
    STEPX(pB0,pB1,pA0,pA1,t,true,true,true,true);     if(WIDE){WAIT_BAR(3);}else{WAIT_BAR(2);} RESC(); ROT();
    STEPX(pA0,pA1,pB0,pB1,t+1,true,true,true,true);   if(WIDE||(MASKED&&(((t+1)&3)==0))){WAIT_BAR(3);}else{WAIT_BAR(2);} RESC(); ROT();
  }
  #undef CMASK
  #define CMASK(P0,P1,t) do{int jb_=(t)-(NT-4); if(jb_>=0)cmask(P0,P1,jb_,qrel,hi);}while(0)
  #define ENDW(tt) do{ if(WIDE){ if((tt)+3<NT){WAIT_BAR(3);} else if((tt)+2<NT){WAIT_BAR(2);} else {WAIT_BAR(0);} } else { if((tt)+3<NT){WAIT_BAR(2);} else if((tt)+2<NT){WAIT_BAR(1);} else {WAIT_BAR(0);} } }while(0)
  for(;t+1<NT;t+=2){
    STEPX(pB0,pB1,pA0,pA1,t,(t+3<NT),(t+1<NT),(t+1<NT),(t+2<NT));       ENDW(t);   RESC(); ROT();
    STEPX(pA0,pA1,pB0,pB1,t+1,(t+4<NT),(t+2<NT),(t+2<NT),(t+3<NT));     ENDW(t+1); RESC(); ROT();
  }
  STEPX(pB0,pB1,pA0,pA1,NT-1,false,false,false,false); RESC();
  { float sacc=pB0[0]+pB0[1]; _Pragma("unroll") for(int r=2;r<16;++r)sacc+=pB0[r]; _Pragma("unroll") for(int r=0;r<16;++r)sacc+=pB1[r]; l_reg+=sacc;
    pw0=(u32x4){PKW(pB0,0),PKW(pB0,2),PKW(pB0,4),PKW(pB0,6)};pw1=(u32x4){PKW(pB0,8),PKW(pB0,10),PKW(pB0,12),PKW(pB0,14)};pw2=(u32x4){PKW(pB1,0),PKW(pB1,2),PKW(pB1,4),PKW(pB1,6)};pw3=(u32x4){PKW(pB1,8),PKW(pB1,10),PKW(pB1,12),PKW(pB1,14)};
    SBAR(); pv(o,vb0+VS(sl_cur),PAF(0),PAF(1),PAF(2),PAF(3)); if(WIDE){ pv(o+2,vb0+VS(sl_cur)+8192,PAF(0),PAF(1),PAF(2),PAF(3)); } }
  #undef PKW
  #undef PAF
  #undef VFR
  #undef PIN
  #undef MX3
  #undef GAPA
  #undef GAPB
  #undef GAPB2
  #undef EX
  #undef VRD
  #undef KRD
  #undef VLD
  #undef VFW
  #undef PVN
  #undef STEPW
  #undef STEPX
  #undef STEP
  #undef ENDW
  {auto rr=__builtin_amdgcn_permlane32_swap(__float_as_uint(l_reg),__float_as_uint(l_reg),false,false);l_reg=__uint_as_float(rr[0])+__uint_as_float(rr[1]);}
  if constexpr(NOMAX){ if(!(l_reg>7.9e-31f&&l_reg<1.2e30f))*(__attribute__((address_space(3))) unsigned*)((__attribute__((address_space(3))) char*)shm+badoff)=1u; }
  if(hi==0)wsf[32+r32]=l_reg;asm volatile("s_waitcnt lgkmcnt(0)":::"memory");
  float rli[16];
  #pragma unroll
  for(int r=0;r<16;++r)rli[r]=__builtin_amdgcn_rcpf(wsf[32+crow(r,hi)]);
  bf16*Ow=O+(rowbase+q0+wid*QBLK)*DM+hv*D;
  #pragma unroll
  for(int hf=0;hf<(WIDE?2:1);++hf){ bf16*stg=(bf16*)(shm+L_OST)+wid*2048;
    #pragma unroll
    for(int r=0;r<16;++r){const int orow=crow(r,hi);
      #pragma unroll
      for(int d0=0;d0<2;++d0)stg[orow*64+d0*32+r32]=__float2bfloat16(o[2*hf+d0][r]*rli[r]);}
    asm volatile("s_waitcnt lgkmcnt(0)":::"memory");
    #pragma unroll
    for(int i=0;i<4;++i){const int row=i*8+(lane>>3),ch=lane&7; const u32x4 v=*(const u32x4*)(stg+row*64+ch*8); ATTN_STORE16(Ow+(long)row*DM+hf*64+ch*8,v);}
    asm volatile("s_waitcnt lgkmcnt(0)":::"memory"); }
  asm volatile("s_waitcnt lgkmcnt(0)\n\ts_barrier":::"memory");
  #undef DMA_K
  #undef DMA_V
  #undef DMA_M4
  #undef MKRD
  #undef MAND
  #undef TABRD
  #undef BIAS
  #undef CMASK
  #undef START
  #undef RESC
  #undef ROT
  #undef VS
}
constexpr int ATTN_LDS_BYTES=LDS_BYTES+NW*1024+4096;
__device__ __forceinline__ void mask_table_init(char*shm,int tid){
  if(tid<256){ u32x4 v; unsigned e[8];
    #pragma unroll
    for(int j=0;j<8;++j) e[j]=((tid>>j)&1)?0u:0xC400u;
    v.x=e[0]|(e[1]<<16); v.y=e[2]|(e[3]<<16); v.z=e[4]|(e[5]<<16); v.w=e[6]|(e[7]<<16);
    *(u32x4*)(shm+LDS_MK+NW*2048+tid*16)=v; }
  __syncthreads();
}
#undef SBAR
#undef WAIT_BAR
}

constexpr int NWAVES = 8;
#ifndef MK_PER_PHASE
#define MK_PER_PHASE 0
#endif

#ifndef CHK
#define CHK 0
#endif
constexpr int CW_CHK = 2;
constexpr int BATCH = 2, SEQ = 16384, NTOK = BATCH * SEQ, DMODEL = 1024, DEPTH = 2;
constexpr int WIN_OLD = 5704, WIN_NEW = 5888, P1_N = 3840;
constexpr float LN_EPS = 1e-5f, ALPHA = 1.41421356237f;
constexpr int NPH_LAYER = 12, NPHASE = DEPTH * NPH_LAYER;

constexpr size_t MiB = 1u << 20;
constexpr size_t WS_CTL = 0, CTL_ZERO_BYTES = 1 * MiB;
constexpr size_t WS_SMALL = 1 * MiB, SM_LAM = 0, SM_WR = 4096, SM_BR = SM_WR + 2 * 36 * 1024 * 4;
constexpr size_t WS_ROPE = 2 * MiB;
constexpr size_t WS_ROUTE = 4 * MiB, RT_E = 0, RT_C = 256 * 1024, RT_HIST = 512 * 1024, RT_TOT = 544 * 1024, RT_ROW = 576 * 1024, RT_ENT = 864 * 1024, RT_CW = 1152 * 1024;
constexpr int LIST_CAP = 65536 + 32 * 256;
constexpr size_t WS_WB = 6 * MiB;
constexpr size_t WB_WIN = 0, WB_WBD = (size_t)WIN_NEW * 1024 * 2, WB_WBS = WB_WBD + MiB, WB_WO = WB_WBS + MiB, WB_WPG = WB_WO + 2 * MiB, WB_WPLE = WB_WPG + 2 * MiB,
                 WB_WGU = WB_WPLE + MiB / 2, WB_WD = WB_WGU + 32 * MiB, WB_END = WB_WD + 16 * MiB;
static_assert(WB_END == 66 * MiB, "weight copies");
constexpr size_t WB_WG8 = WB_WIN + (size_t)3840 * 1024 * 2;
constexpr size_t WS_XB = 72 * MiB;
constexpr size_t WS_DQ = 136 * MiB, TSTRIDE = 32 * MiB, WS_IK = 360 * MiB, WS_IW = 364 * MiB;
constexpr size_t WS_O0 = 365 * MiB, WS_O1 = 397 * MiB, WS_YB = 429 * MiB, WS_MASK = 461 * MiB;
constexpr long MASK_BSTRIDE = 2105344;
constexpr size_t WS_YA = 136 * MiB, WS_MERGED = 168 * MiB, WS_TMPG = 240 * MiB, WS_PRE1 = 240 * MiB;
constexpr size_t OUT_XB8 = 0, OUT_X1B8 = 32 * MiB, OUT_T1 = 64 * MiB;
constexpr size_t WS_HG = 136 * MiB, WS_PLE = 172 * MiB, WS_Y0 = 368 * MiB, WS_Y1 = 432 * MiB, WS_PB = 496 * MiB, WS_END = 512 * MiB;
static_assert(WS_MASK + 2 * MASK_BSTRIDE * 8 <= WS_PB, "mask fits");
constexpr int CW_TMO = 0, CW_CODE = 1, CW_BAR = 4096, CW_QUEUE = 8192;

constexpr int RING_OFF = 0, RING_BYTES = 131072;
constexpr int XTR_OFF = RING_BYTES, XTR_BYTES = 4096;
constexpr int MISC_OFF = XTR_OFF + XTR_BYTES;
constexpr int LDS_BYTES = 147456;
static_assert(MISC_OFF + 128 <= LDS_BYTES, "LDS map");
#define GAS __attribute__((address_space(1)))
#define LAS __attribute__((address_space(3)))
typedef unsigned short bf16;
typedef unsigned v4u __attribute__((ext_vector_type(4)));
typedef float f32x4 __attribute__((ext_vector_type(4)));
typedef short bf16x8 __attribute__((ext_vector_type(8)));
typedef GAS unsigned gu32;
typedef GAS unsigned long long gu64;
#define RLX_AGENT __ATOMIC_RELAXED, __HIP_MEMORY_SCOPE_AGENT
#define LDS_WAIT() asm volatile("s_waitcnt lgkmcnt(0)" ::: "memory")
#define VM_WAIT() asm volatile("s_waitcnt vmcnt(0)" ::: "memory")
__device__ __forceinline__ unsigned long long rt() { return __builtin_amdgcn_s_memrealtime(); }
__device__ __forceinline__ unsigned f2bf(float f) { unsigned u = __builtin_bit_cast(unsigned, f); return (u + 0x7fffu + ((u >> 16) & 1u)) >> 16; }
__device__ __forceinline__ unsigned pk2(float lo, float hi) { return f2bf(lo) | (f2bf(hi) << 16); }

#define XB_TMO      128
#define XB_XCNT(j)  (256  + 64 * (j))
#define XB_XSUB(j)  (1280 + 64 * (j))
#define XB_XGEN(j)  (2304 + 64 * (j))
#define XB_TOP      3328
#define XB_TOPGEN   3392
#define XCD_BAR_WORDS 3456
#define XB_SPIN_CAP (1u << 18)

__device__ __forceinline__ unsigned xb_ld(unsigned* p)              { return __hip_atomic_load(p, __ATOMIC_RELAXED, __HIP_MEMORY_SCOPE_AGENT); }
__device__ __forceinline__ unsigned xb_add(unsigned* p, unsigned v) { return __hip_atomic_fetch_add(p, v, __ATOMIC_RELAXED, __HIP_MEMORY_SCOPE_AGENT); }
__device__ __forceinline__ unsigned xb_xcc_id() { return (unsigned)__builtin_amdgcn_s_getreg((3 << 11) | 20) & 0xFu; }
#define XB_SPIN(cond, bar) do { unsigned _sp = 0; while (cond) { __builtin_amdgcn_s_sleep(1); \
    if ((++_sp & 255u) == 0u) { if (xb_ld(&(bar)[XB_TMO])) break; if (_sp > XB_SPIN_CAP) { atomicAdd(&(bar)[XB_TMO], 1u); break; } } } } while (0)

struct XcdBarrier {
    unsigned* bar; unsigned x;
    volatile LAS unsigned* st;
};

__device__ __forceinline__ XcdBarrier xcd_barrier_post(unsigned* bar, volatile LAS unsigned* st) {
    XcdBarrier b; b.bar = bar; b.x = xb_xcc_id(); b.st = st;
    if (threadIdx.x == 0) (void)xb_add(&bar[XB_XCNT(b.x)], 1u);
    return b;
}
__device__ __forceinline__ void xcd_barrier_complete(unsigned* bar, unsigned x, unsigned& nloc, unsigned& nx) {
    const unsigned G = gridDim.x * gridDim.y * gridDim.z;
    unsigned sum, cnt, mine, sp = 0u;
    for (;;) {
        sum = 0u; cnt = 0u; mine = 0u;
#pragma unroll
        for (unsigned j = 0; j < 16; ++j) { const unsigned c = xb_ld(&bar[XB_XCNT(j)]); sum += c; cnt += (c > 0u) ? 1u : 0u; mine = (j == x) ? c : mine; }
        if (sum == G) break;
        __builtin_amdgcn_s_sleep(1);
        if ((++sp & 255u) == 0u) { if (xb_ld(&bar[XB_TMO])) break; if (sp > XB_SPIN_CAP) { atomicAdd(&bar[XB_TMO], 1u); break; } }
    }
    nloc = mine > 0u ? mine : 1u; nx = cnt > 0u ? cnt : 1u;
}

__device__ __forceinline__ void xcd_barrier(const XcdBarrier& b) {
    asm volatile("s_waitcnt vmcnt(0)" ::: "memory");
    __syncthreads();
    if (threadIdx.x == 0) {
        unsigned* bar = b.bar;
        __builtin_amdgcn_s_waitcnt(0);
        unsigned nloc = b.st[0], nx = b.st[1];
        if (nloc == 0u) { xcd_barrier_complete(bar, b.x, nloc, nx); b.st[0] = nloc; b.st[1] = nx; }
        const unsigned old = xb_add(&bar[XB_XSUB(b.x)], 1u);
        const unsigned gen = old / nloc;
        if (old + 1u == (gen + 1u) * nloc) {
            __builtin_amdgcn_fence(__ATOMIC_RELEASE, "agent");
            asm volatile("s_waitcnt vmcnt(0)" ::: "memory");
            const unsigned og = xb_add(&bar[XB_TOP], 1u);
            const unsigned tg = og / nx;
            if (og + 1u == (tg + 1u) * nx) xb_add(&bar[XB_TOPGEN], 1u);
            else XB_SPIN(xb_ld(&bar[XB_TOPGEN]) == tg, bar);
            __builtin_amdgcn_fence(__ATOMIC_ACQUIRE, "agent");
            xb_add(&bar[XB_XGEN(b.x)], 1u);
            asm volatile("s_waitcnt vmcnt(0)" ::: "memory");
        } else {
            XB_SPIN(xb_ld(&bar[XB_XGEN(b.x)]) == gen, bar);
            __builtin_amdgcn_fence(__ATOMIC_ACQUIRE, "agent");
            asm volatile("s_waitcnt vmcnt(0)" ::: "memory");
        }
    }
    __syncthreads();
}

#ifndef DBG
#define DBG 0
#endif
struct Args { const void* in[22]; float* out; unsigned char* ws; int ph_lo, ph_hi; };
struct Frame {
    LAS unsigned char* lds;
    volatile LAS unsigned* MISC;
    gu32* ctl;
    int tid, lane, wave;
    int vcu, G, bx;
    unsigned char* ws; unsigned char* ws0;
    float* out; float* out0;
    const Args* ap;
};
#define INP(k) (F.ap->in[(k)])
#define DPP_F(v, ctrl) __builtin_bit_cast(float, __builtin_amdgcn_update_dpp(0, __builtin_bit_cast(int, (v)), (ctrl), 0xf, 0xf, true))
__device__ __forceinline__ float row16_sum(float v) {
    v += DPP_F(v, 0xB1);
    v += DPP_F(v, 0x4E);
    v += DPP_F(v, 0x141);
    v += DPP_F(v, 0x140);
    return v;
}
__device__ __forceinline__ float wave_sum(float v) {
    v = row16_sum(v);
    { auto r = __builtin_amdgcn_permlane16_swap(__float_as_uint(v), __float_as_uint(v), false, false); v = __uint_as_float(r[0]) + __uint_as_float(r[1]); }
    { auto r = __builtin_amdgcn_permlane32_swap(__float_as_uint(v), __float_as_uint(v), false, false); v = __uint_as_float(r[0]) + __uint_as_float(r[1]); }
    return v;
}
__device__ __forceinline__ void wave_sum4(float p0, float p1, float p2, float p3, float (&out)[4]) {
    auto r = __builtin_amdgcn_permlane32_swap(__float_as_uint(p0), __float_as_uint(p1), false, false); const float s01 = __uint_as_float(r[0]) + __uint_as_float(r[1]);
    r = __builtin_amdgcn_permlane32_swap(__float_as_uint(p2), __float_as_uint(p3), false, false); const float s23 = __uint_as_float(r[0]) + __uint_as_float(r[1]);
    r = __builtin_amdgcn_permlane16_swap(__float_as_uint(s01), __float_as_uint(s23), false, false); float t = __uint_as_float(r[0]) + __uint_as_float(r[1]);
    t = row16_sum(t);
    out[0] = __uint_as_float((unsigned)__builtin_amdgcn_readlane((int)__float_as_uint(t), 0)); out[2] = __uint_as_float((unsigned)__builtin_amdgcn_readlane((int)__float_as_uint(t), 16));
    out[1] = __uint_as_float((unsigned)__builtin_amdgcn_readlane((int)__float_as_uint(t), 32)); out[3] = __uint_as_float((unsigned)__builtin_amdgcn_readlane((int)__float_as_uint(t), 48));
}
typedef float f32x2 __attribute__((ext_vector_type(2)));

__device__ __forceinline__ void tr_item(const float* W, int ldn, int col0, int nvalid, bf16* WT, int K, int row0, LAS float* scr, int kb, int lane) {
    const int k0 = 64 * kb, n = lane & 31;
#pragma unroll 8
    for (int i = 0; i < 32; ++i) { const int kk = 2 * i + (lane >> 5); scr[kk * 33 + n] = (n < nvalid) ? W[(size_t)(k0 + kk) * ldn + col0 + n] : 0.f; }
    LDS_WAIT(); asm volatile("" ::: "memory");
    const int c = lane & 7;
#pragma unroll
    for (int j = 0; j < 4; ++j) { const int nn = (lane >> 3) + 8 * j; const LAS float* s = scr + (8 * c) * 33 + nn;
        v4u o; o.x = pk2(s[0 * 33], s[1 * 33]); o.y = pk2(s[2 * 33], s[3 * 33]); o.z = pk2(s[4 * 33], s[5 * 33]); o.w = pk2(s[6 * 33], s[7 * 33]);
        *(GAS v4u*)(WT + (size_t)(row0 + nn) * K + k0 + 8 * c) = o; }
    LDS_WAIT(); asm volatile("" ::: "memory");
}
__device__ __forceinline__ unsigned pk4_fp8(float a, float b, float c, float d) { int p = __builtin_amdgcn_cvt_pk_fp8_f32(a, b, 0, false); return (unsigned)__builtin_amdgcn_cvt_pk_fp8_f32(c, d, p, true); }
__device__ __forceinline__ void tr_item8(const float* W, int ldn, int col0, unsigned char* WT, int K, int row0, LAS float* scr, int kb, int lane) {
    const int k0 = 64 * kb, n = lane & 31;
#pragma unroll 8
    for (int i = 0; i < 32; ++i) { const int kk = 2 * i + (lane >> 5); scr[kk * 33 + n] = W[(size_t)(k0 + kk) * ldn + col0 + n] * 64.f; }
    LDS_WAIT(); asm volatile("" ::: "memory");
    const int c = lane & 7;
#pragma unroll
    for (int j = 0; j < 4; ++j) { const int nn = (lane >> 3) + 8 * j; const LAS float* s = scr + (8 * c) * 33 + nn;
        const unsigned long long o = (unsigned long long)pk4_fp8(s[0 * 33], s[1 * 33], s[2 * 33], s[3 * 33]) | ((unsigned long long)pk4_fp8(s[4 * 33], s[5 * 33], s[6 * 33], s[7 * 33]) << 32);
        *(GAS unsigned long long*)(WT + (size_t)(row0 + nn) * K + k0 + 8 * c) = o; }
    LDS_WAIT(); asm volatile("" ::: "memory");
}
__device__ __forceinline__ void pw_phase(Frame& F, int l) {
    LAS float* scr = (LAS float*)(F.lds + RING_OFF + F.wave * 16384);
    const int gw = F.vcu * NWAVES + F.wave, NGW = F.G * NWAVES, lane = F.lane;
    unsigned char* wb = F.ws + WS_WB;
    bf16* WIN = (bf16*)(wb + WB_WIN);
    const float* w_in = (const float*)INP(3) + (size_t)l * 1024 * WIN_OLD;
    constexpr int I_A = 16 * 114, I_B = 16, I_C = 16 * 64, I_BD = 8 * 32, I_O = 16 * 32, I_PLE = 4 * 32, I_GU = 32 * 4 * 64, I_D = 32 * 128;
    constexpr int NITEMS = I_A + I_B + I_C + 2 * I_BD + 2 * I_O + I_PLE + I_GU + I_D;
    for (int it = gw; it < NITEMS; it += NGW) {
        int r = it;
        if (r < I_A) { const int kb = r / 114, nb = r % 114; tr_item(w_in, WIN_OLD, 32 * nb, 32, WIN, 1024, 32 * nb, scr, kb, lane); continue; } r -= I_A;
        if (r < I_B) { tr_item(w_in, WIN_OLD, 3648, 8, WIN, 1024, 3648, scr, r, lane); continue; } r -= I_B;
        if (r < I_C) { const int kb = r / 64, nb = r % 64; tr_item8(w_in, WIN_OLD, 3656 + 32 * nb, wb + WB_WG8, 1024, 32 * nb, scr, kb, lane); continue; } r -= I_C;
        if (r < I_BD) { tr_item((const float*)INP(6) + (size_t)l * 512 * 1024, 1024, 32 * (r % 32), 32, (bf16*)(wb + WB_WBD), 512, 32 * (r % 32), scr, r / 32, lane); continue; } r -= I_BD;
        if (r < I_BD) { tr_item((const float*)INP(7) + (size_t)l * 512 * 1024, 1024, 32 * (r % 32), 32, (bf16*)(wb + WB_WBS), 512, 32 * (r % 32), scr, r / 32, lane); continue; } r -= I_BD;
        if (r < I_O) { tr_item((const float*)INP(8) + (size_t)l * 1024 * 1024, 1024, 32 * (r % 32), 32, (bf16*)(wb + WB_WO), 1024, 32 * (r % 32), scr, r / 32, lane); continue; } r -= I_O;
        if (r < I_O) { tr_item8((const float*)INP(19) + (size_t)l * 1024 * 1024, 1024, 32 * (r % 32), wb + WB_WPG, 1024, 32 * (r % 32), scr, r / 32, lane); continue; } r -= I_O;
        if (r < I_PLE) { tr_item((const float*)INP(18) + (size_t)l * 256 * 1024, 1024, 32 * (r % 32), 32, (bf16*)(wb + WB_WPLE), 256, 32 * (r % 32), scr, r / 32, lane); continue; } r -= I_PLE;
        if (r < I_GU) { const int e = r >> 8, sub = (r >> 6) & 3, q = r & 63, kb = q >> 2, nb = q & 3;
            const float* W = ((sub & 1) ? (const float*)INP(16) : (const float*)INP(15)) + (size_t)(l * 32 + e) * 1024 * 256;
            tr_item8(W, 256, (sub >> 1) * 128 + 32 * nb, wb + WB_WGU, 1024, e * 512 + sub * 128 + 32 * nb, scr, kb, lane); continue; } r -= I_GU;
        { const int e = r >> 7, q = r & 127, kb = q >> 5, nb = q & 31;
            tr_item((const float*)INP(17) + (size_t)(l * 32 + e) * 256 * 1024, 1024, 32 * nb, 32, (bf16*)(wb + WB_WD), 256, e * 1024 + 32 * nb, scr, kb, lane); }
    }
    { unsigned z_ = 0u; asm volatile("" : "+v"(z_));
      for (int ch = F.vcu * 512 + F.tid; ch < 160 * 128; ch += F.G * 512) *(GAS v4u*)(WIN + (size_t)3680 * 1024 + (size_t)ch * 8) = (v4u){z_, z_, z_, z_}; }
    const float* p = (const float*)INP(1) + (size_t)l * NTOK * 256; bf16* PB = (bf16*)(F.ws + WS_PB);
    for (int m0 = gw; m0 < NTOK; m0 += 4 * NGW) { f32x4 v[4];
#pragma unroll
        for (int j = 0; j < 4; ++j) { const int m = min(m0 + j * NGW, NTOK - 1); v[j] = *((const GAS f32x4*)(p + (size_t)m * 256) + lane); }
#pragma unroll
        for (int j = 0; j < 4; ++j) { const int m = m0 + j * NGW; if (m < NTOK) *((GAS unsigned long long*)(PB + (size_t)m * 256) + lane) = (unsigned long long)pk2(v[j].x, v[j].y) | ((unsigned long long)pk2(v[j].z, v[j].w) << 32); } }
    if (l == 0) {
        const float* x = (const float*)INP(0); bf16* XB = (bf16*)(F.ws + WS_XB);
        for (int m0 = gw; m0 < NTOK; m0 += 2 * NGW) { f32x4 v[2][4];
#pragma unroll
            for (int r = 0; r < 2; ++r) { const int m = min(m0 + r * NGW, NTOK - 1); const GAS f32x4* xr = (const GAS f32x4*)(x + (size_t)m * 1024) + lane;
#pragma unroll
                for (int j = 0; j < 4; ++j) v[r][j] = xr[64 * j]; }
#pragma unroll
            for (int r = 0; r < 2; ++r) { const int m = m0 + r * NGW; if (m < NTOK) { GAS unsigned long long* o8 = (GAS unsigned long long*)(XB + (size_t)m * 1024) + lane;
#pragma unroll
                for (int j = 0; j < 4; ++j) { const f32x4 w = v[r][j]; o8[64 * j] = (unsigned long long)pk2(w.x, w.y) | ((unsigned long long)pk2(w.z, w.w) << 32);
                    ((GAS unsigned*)((unsigned char*)F.out + OUT_XB8 + (size_t)m * 1024) + lane)[64 * j] = pk4_fp8(w.x, w.y, w.z, w.w); } } }
        }
        const int* pos = (const int*)INP(2); float* rope = (float*)(F.ws + WS_ROPE);
        for (int idx = F.vcu * 512 + F.tid; idx < NTOK * 8; idx += F.G * 512) {
            const int m = idx >> 3, j = idx & 7; const float invf = exp2f(-2.366446071f * (float)j); const float ang = (float)pos[m] * invf;
            double rev = (double)ang * 0.15915494309189535; rev -= rint(rev);
            rope[m * 16 + j] = (DBG & 16) ? 1.f : __builtin_amdgcn_cosf((float)rev); rope[m * 16 + 8 + j] = (DBG & 16) ? 0.f : __builtin_amdgcn_sinf((float)rev);
        }
        float* WR = (float*)(F.ws + WS_SMALL + SM_WR); float* BR = (float*)(F.ws + WS_SMALL + SM_BR);
        for (int idx = F.vcu * 512 + F.tid; idx < 2 * 36 * 1024; idx += F.G * 512) {
            const int ll = idx / (36 * 1024), r = idx % (36 * 1024), j = r >> 10, k = r & 1023;
            WR[idx] = (j < 4) ? ((const float*)INP(11))[((size_t)ll * 1024 + k) * 4 + j] : ((const float*)INP(13))[((size_t)ll * 1024 + k) * 32 + (j - 4)];
        }
        if (F.vcu == 0 && F.tid < 72) { const int ll = F.tid / 36, j = F.tid % 36; BR[F.tid] = (j < 4) ? ((const float*)INP(12))[ll * 4 + j] : ((const float*)INP(14))[ll * 32 + j - 4]; }
        if (F.vcu == 0 && F.tid < 2) { const float* lp = (const float*)INP(4) + F.tid * 256; float a = 0.f, b = 0.f;
            for (int i = 0; i < 64; ++i) { a += lp[i] * lp[64 + i]; b += lp[128 + i] * lp[192 + i]; }
            const float lam_init = (F.tid == 0) ? 0.2f : 0.35550907f;
            ((float*)(F.ws + WS_SMALL + SM_LAM))[F.tid] = __expf(a) - __expf(b) + lam_init; }
    }
}

namespace idxr {
typedef float f32x16 __attribute__((ext_vector_type(16)));
typedef short s16x2 __attribute__((ext_vector_type(2)));
typedef __fp16 h16x2 __attribute__((ext_vector_type(2)));
constexpr int HROW = 513;
__device__ __forceinline__ unsigned f2key(float f) { const unsigned u = __float_as_uint(f); return u ^ ((unsigned)((int)u >> 31) | 0x80000000u); }
__device__ __forceinline__ unsigned bins2(float a, float b) {
    const unsigned h = __builtin_bit_cast(unsigned, __builtin_amdgcn_cvt_pkrtz(a, b));
    const unsigned m = __builtin_bit_cast(unsigned, (s16x2)(__builtin_bit_cast(s16x2, h) >> (s16x2){15, 15}));
    const unsigned key = h ^ (m | 0x80008000u);
    return (key >> 5) & 0x07fc07fcu;
}
__device__ __forceinline__ float f16bits(unsigned h) { return (float)__builtin_bit_cast(__fp16, (unsigned short)h); }
__device__ __forceinline__ float bin_edge(int b) {
    if (b <= 0) return -__builtin_inff();
    if (b >= 512) return __builtin_inff();
    const unsigned K = (unsigned)b << 7;
    if (K >= 0x8000u) { const unsigned H = K & 0x7fffu; return (H >= 0x7c00u) ? __builtin_inff() : f16bits(H); }
    const unsigned M1 = ((0xFFFFu ^ K) & 0x7fffu) + 1u;
    const float v = (M1 >= 0x7c00u) ? __builtin_inff() : f16bits(M1);
    return -__uint_as_float(__float_as_uint(v) - 1u);
}
__device__ __forceinline__ long moff(int tl) { return 16384L * tl - 32L * tl * (tl - 1); }
__device__ __forceinline__ void load_k2(bf16x8 (&ka)[2], bf16x8 (&kb)[2], const unsigned short* IKb, int key0, int kg0, int fr, int fq) {
#pragma unroll
    for (int ks = 0; ks < 2; ++ks) { ka[ks] = *(const bf16x8*)(IKb + (size_t)(key0 + 16 * kg0 + fr) * 64 + ks * 32 + fq * 8); kb[ks] = *(const bf16x8*)(IKb + (size_t)(key0 + 16 * kg0 + 16 + fr) * 64 + ks * 32 + fq * 8); }
}
__device__ __forceinline__ void score_half(f32x4& sa, f32x4& sb, const bf16x8 (&qf)[8][2], const bf16x8 (&ql)[2], const float (&w)[8], bf16x8 (&ka)[2], bf16x8 (&kb)[2]) {
    sa = __builtin_amdgcn_mfma_f32_16x16x32_bf16(ka[0], ql[0], (f32x4){0.f, 0.f, 0.f, 0.f}, 0, 0, 0); sb = __builtin_amdgcn_mfma_f32_16x16x32_bf16(kb[0], ql[0], (f32x4){0.f, 0.f, 0.f, 0.f}, 0, 0, 0);
    sa = __builtin_amdgcn_mfma_f32_16x16x32_bf16(ka[1], ql[1], sa, 0, 0, 0); sb = __builtin_amdgcn_mfma_f32_16x16x32_bf16(kb[1], ql[1], sb, 0, 0, 0);
    f32x4 Da[2], Db[2];
#define IDX_M(h, D) do { \
        D[0] = __builtin_amdgcn_mfma_f32_16x16x32_bf16(ka[0], qf[h][0], (f32x4){0.f, 0.f, 0.f, 0.f}, 0, 0, 0); D[1] = __builtin_amdgcn_mfma_f32_16x16x32_bf16(kb[0], qf[h][0], (f32x4){0.f, 0.f, 0.f, 0.f}, 0, 0, 0); \
        D[0] = __builtin_amdgcn_mfma_f32_16x16x32_bf16(ka[1], qf[h][1], D[0], 0, 0, 0); D[1] = __builtin_amdgcn_mfma_f32_16x16x32_bf16(kb[1], qf[h][1], D[1], 0, 0, 0); } while (0)
#define IDX_F(h, D, O) asm volatile("" : "+v"(O[0]), "+v"(O[1]));     \
        asm volatile( \
        "v_fma_f32 %0, %8, |%9|, %0\n\tv_fma_f32 %1, %8, |%10|, %1\n\tv_fma_f32 %2, %8, |%11|, %2\n\tv_fma_f32 %3, %8, |%12|, %3\n\t" \
        "v_fma_f32 %4, %8, |%13|, %4\n\tv_fma_f32 %5, %8, |%14|, %5\n\tv_fma_f32 %6, %8, |%15|, %6\n\tv_fma_f32 %7, %8, |%16|, %7" \
        : "+v"(sa[0]), "+v"(sa[1]), "+v"(sa[2]), "+v"(sa[3]), "+v"(sb[0]), "+v"(sb[1]), "+v"(sb[2]), "+v"(sb[3]) \
        : "v"(w[h]), "v"(D[0][0]), "v"(D[0][1]), "v"(D[0][2]), "v"(D[0][3]), "v"(D[1][0]), "v"(D[1][1]), "v"(D[1][2]), "v"(D[1][3])); \
        asm volatile("" : "+v"(ka[0]), "+v"(kb[0]))
    IDX_M(0, Da); IDX_M(1, Db);
    asm volatile("s_nop 7" : "+v"(Da[0]), "+v"(Da[1]), "+v"(Db[0]), "+v"(Db[1]), "+v"(sa), "+v"(sb));
#pragma unroll
    for (int h = 0; h < 6; h += 2) { IDX_F(h, Da, Db); IDX_M(h + 2, Da); IDX_F(h + 1, Db, Da); IDX_M(h + 3, Db); }
    IDX_F(6, Da, Db); asm volatile("s_nop 7" : "+v"(Db[0]), "+v"(Db[1])); IDX_F(7, Db, Da);
#undef IDX_M
#undef IDX_F
}
#define IDX_SCORE(sc, kf, key0, more) do { const int nk_ = (more) ? (key0) + 128 : (key0); \
        idxr::score_half(sc[0], sc[1], qf, ql, w, kf[0], kf[1]); idxr::load_k2(kf[0], kf[1], IKb, nk_, 0, fr, fq); \
        idxr::score_half(sc[2], sc[3], qf, ql, w, kf[2], kf[3]); idxr::load_k2(kf[2], kf[3], IKb, nk_, 2, fr, fq); } while (0)
}

__device__ __forceinline__ void indexer_unit(Frame& F, int b, int qblk, const bf16* IQ, const bf16* IK, const float* IW, unsigned long long* mask64  ) {
    using namespace idxr;
    const int lane = F.lane, fr = lane & 15, fq = lane >> 4, wid = F.wave, qgrp = wid & 3, kh = wid >> 2;
    const int qloc = 16 * qgrp + fr, q = 64 * qblk + qloc;
    const size_t row = (size_t)b * SEQ + q;
    LAS unsigned* hist = (LAS unsigned*)(F.lds + RING_OFF);
    LAS int* bstarA = (LAS int*)(F.lds + XTR_OFF + 1024); LAS int* needA = bstarA + 64; LAS float* thiA = (LAS float*)(needA + 64); LAS float* tloA = thiA + 64;
    LAS unsigned* cand = (LAS unsigned*)(F.lds + RING_OFF);
    LAS unsigned* wcnt = (LAS unsigned*)(F.lds + XTR_OFF + 2048);
    bf16x8 qf[8][2], ql[2]; float w[8];
#pragma unroll
    for (int h = 0; h < 8; ++h)
#pragma unroll
        for (int ks = 0; ks < 2; ++ks) qf[h][ks] = *(const bf16x8*)(IQ + row * 512 + h * 64 + ks * 32 + fq * 8);
    { const f32x4* wp = (const f32x4*)(IW + row * 8); const f32x4 w0 = wp[0], w1 = wp[1]; w[0] = 0.5f * w0.x; w[1] = 0.5f * w0.y; w[2] = 0.5f * w0.z; w[3] = 0.5f * w0.w; w[4] = 0.5f * w1.x; w[5] = 0.5f * w1.y; w[6] = 0.5f * w1.z; w[7] = 0.5f * w1.w; }
#pragma unroll
    for (int ks = 0; ks < 2; ++ks) {
        float acc8[8];
#pragma unroll
        for (int e = 0; e < 8; ++e) acc8[e] = 0.f;
#pragma unroll
        for (int h = 0; h < 8; ++h)
#pragma unroll
            for (int e = 0; e < 8; ++e) acc8[e] = __builtin_fmaf(w[h], __uint_as_float((unsigned)(unsigned short)qf[h][ks][e] << 16), acc8[e]);
#pragma unroll
        for (int e = 0; e < 8; e += 2) { const unsigned pk = pg8::cvt_pk_bf16(acc8[e], acc8[e + 1]); ql[ks][e] = (short)(pk & 0xffffu); ql[ks][e + 1] = (short)(pk >> 16); }
    }
    for (int i = F.tid; i < 64 * HROW; i += NWAVES * 64) hist[i] = 0u;
    __syncthreads();
    const unsigned short* IKb = IK + (size_t)b * SEQ * 64;
    const int qmin_w = 64 * qblk + 16 * qgrp;
    const unsigned hrowb = (unsigned)(size_t)(hist + qloc * HROW);
#define IDX_HADD(off_) __hip_atomic_fetch_add((LAS unsigned*)(hrowb + (off_)), 1u, __ATOMIC_RELAXED, __HIP_MEMORY_SCOPE_WORKGROUP)
    {
        bf16x8 kf[4][2];
        if (kh <= qblk) { load_k2(kf[0], kf[1], IKb, 64 * kh, 0, fr, fq); load_k2(kf[2], kf[3], IKb, 64 * kh, 2, fr, fq); }
#pragma unroll 1
        for (int tl = kh; tl <= qblk; tl += 2) {
            const int key0 = 64 * tl; f32x4 sc[4]; IDX_SCORE(sc, kf, key0, tl + 2 <= qblk);
            if (key0 + 63 <= qmin_w) {
#pragma unroll
                for (int kg = 0; kg < 4; ++kg) { const unsigned p0 = bins2(sc[kg][0], sc[kg][1]), p1 = bins2(sc[kg][2], sc[kg][3]);
                    IDX_HADD(p0 & 0xffffu); IDX_HADD(p0 >> 16); IDX_HADD(p1 & 0xffffu); IDX_HADD(p1 >> 16); __builtin_amdgcn_sched_barrier(0); }
            } else {
                int fq_ = fq, q_ = q; asm volatile("" : "+v"(fq_), "+v"(q_));
#pragma unroll
                for (int kg = 0; kg < 4; ++kg) { const unsigned p0 = bins2(sc[kg][0], sc[kg][1]), p1 = bins2(sc[kg][2], sc[kg][3]); const int kb = key0 + 16 * kg + 4 * fq_;
                    if (kb <= q_) IDX_HADD(p0 & 0xffffu); if (kb + 1 <= q_) IDX_HADD(p0 >> 16); if (kb + 2 <= q_) IDX_HADD(p1 & 0xffffu); if (kb + 3 <= q_) IDX_HADD(p1 >> 16); __builtin_amdgcn_sched_barrier(0); }
            }
        }
    }
#undef IDX_HADD
    __syncthreads();
#pragma unroll 1
    for (int qq = wid * 8; qq < wid * 8 + 8; ++qq) {
        const LAS unsigned* hr = hist + qq * HROW + lane * 8;
        unsigned wv[8]; unsigned s = 0;
#pragma unroll
        for (int k = 0; k < 8; ++k) { wv[k] = hr[k]; s += wv[k]; }
        unsigned v = s;
#define DPP_U(x, ctrl) (unsigned)__builtin_amdgcn_update_dpp(0, (int)(x), (ctrl), 0xf, 0xf, true)
        v += DPP_U(v, 0x101); v += DPP_U(v, 0x102); v += DPP_U(v, 0x104); v += DPP_U(v, 0x108);
#undef DPP_U
        { const unsigned t1 = (unsigned)__builtin_amdgcn_readlane((int)v, 16), t2 = (unsigned)__builtin_amdgcn_readlane((int)v, 32), t3 = (unsigned)__builtin_amdgcn_readlane((int)v, 48);
          const int rw = lane >> 4; v += (rw < 1 ? t1 : 0u) + (rw < 2 ? t2 : 0u) + (rw < 3 ? t3 : 0u); }
        const unsigned above = v - s, total = (unsigned)__builtin_amdgcn_readlane((int)v, 0);
        if (total > 256u) {
            if (above < 256u && v >= 256u) {
                unsigned c = above; int found = -1, need = 0;
#pragma unroll
                for (int k = 7; k >= 0; --k) { if (found < 0) { if (c + wv[k] >= 256u) { found = k; need = 256 - (int)c; } else c += wv[k]; } }
                bstarA[qq] = lane * 8 + found; needA[qq] = need; thiA[qq] = bin_edge(lane * 8 + found + 1); tloA[qq] = bin_edge(lane * 8 + found);
            }
        } else if (lane == 0) { bstarA[qq] = -1; needA[qq] = 0; thiA[qq] = -__builtin_inff(); tloA[qq] = -__builtin_inff(); }
    }
    __syncthreads();
    const float thi = thiA[qloc], tlo = tloA[qloc];
    unsigned ncand = 0u; LAS unsigned* const cbase = cand + (qloc * 8 + fq + 4 * kh) * 64;
#define IDX_EL(scv_, krel_) do { const float v_ = (scv_); \
        if (FULL_) { asm volatile("v_cmp_ge_f32 vcc, %2, %3\n\tv_addc_co_u32 %0, vcc, %0, %0, vcc\n\tv_cmp_ge_f32 vcc, %2, %4\n\tv_addc_co_u32 %1, vcc, %1, %1, vcc" : "+v"(nh_), "+v"(nl_) : "v"(v_), "v"(thi), "v"(tlo) : "vcc"); } \
        else { const bool ok_ = key0 + (krel_) <= q_; nh_ = nh_ + nh_ + ((ok_ && v_ >= thi) ? 1u : 0u); nl_ = nl_ + nl_ + ((ok_ && v_ >= tlo) ? 1u : 0u); } } while (0)
#define IDX_HALF(ka, kb, W_, C_) do { unsigned nh_ = 0u, nl_ = 0u; const int kr = 4 * fq_; \
        IDX_EL(sc[kb][3], 16 * kb + kr + 3); IDX_EL(sc[kb][2], 16 * kb + kr + 2); IDX_EL(sc[kb][1], 16 * kb + kr + 1); IDX_EL(sc[kb][0], 16 * kb + kr); nh_ <<= 12; nl_ <<= 12; \
        IDX_EL(sc[ka][3], 16 * ka + kr + 3); IDX_EL(sc[ka][2], 16 * ka + kr + 2); IDX_EL(sc[ka][1], 16 * ka + kr + 1); IDX_EL(sc[ka][0], 16 * ka + kr); \
        W_ = nh_ << kr; C_ = nl_ & ~nh_; __builtin_amdgcn_sched_barrier(0); } while (0)
#define IDX_ELS() do { IDX_HALF(0, 1, wlo, clo); IDX_HALF(2, 3, whi, chi); } while (0)
    {
        bf16x8 kf[4][2];
        if (kh <= qblk) { load_k2(kf[0], kf[1], IKb, 64 * kh, 0, fr, fq); load_k2(kf[2], kf[3], IKb, 64 * kh, 2, fr, fq); }
#pragma unroll 1
        for (int tl = kh; tl <= qblk; tl += 2) {
            const int key0 = 64 * tl; unsigned long long* mword = mask64 + (moff(tl) + (q - key0)); f32x4 sc[4]; IDX_SCORE(sc, kf, key0, tl + 2 <= qblk);
            unsigned wlo = 0u, whi = 0u, clo = 0u, chi = 0u; int fq_ = fq, q_ = q; asm volatile("" : "+v"(fq_), "+v"(q_));
            if (key0 + 63 <= qmin_w) {
#define FULL_ true
                IDX_ELS();
#undef FULL_
            } else {
#define FULL_ false
                IDX_ELS();
#undef FULL_
            }
            unsigned cb = clo | (chi << 4);
            if (cb != 0u) {
#pragma unroll 1
                while (cb != 0u) {
                    const int j = __builtin_ctz(cb); cb &= cb - 1u;
                    const bool b0 = (j & 1) != 0, b1 = (j & 2) != 0, b2 = (j & 4) != 0, b4 = (j & 16) != 0;
                    float y[4];
#pragma unroll
                    for (int kg = 0; kg < 4; ++kg) { const float x0 = b0 ? sc[kg][1] : sc[kg][0], x1 = b0 ? sc[kg][3] : sc[kg][2]; y[kg] = b1 ? x1 : x0; }
                    const float z0 = b4 ? y[1] : y[0], z1 = b4 ? y[3] : y[2]; const float v_ = b2 ? z1 : z0;
                    const int krel = 16 * ((b4 ? 1 : 0) + (b2 ? 2 : 0)) + 4 * fq_ + (j & 3);
                    if (ncand < 64u) cbase[ncand] = ((f2key(v_) & 0xffff8u) << 11) | (unsigned)(16383 - (key0 + krel)); ++ncand;
                }
            }
            { auto r_ = __builtin_amdgcn_permlane16_swap(wlo, wlo, false, false); wlo = r_[0] | r_[1]; r_ = __builtin_amdgcn_permlane16_swap(whi, whi, false, false); whi = r_[0] | r_[1];
              r_ = __builtin_amdgcn_permlane32_swap(wlo, wlo, false, false); wlo = r_[0] | r_[1]; r_ = __builtin_amdgcn_permlane32_swap(whi, whi, false, false); whi = r_[0] | r_[1]; }
            if (fq == 0) *mword = ((unsigned long long)whi << 32) | wlo;
        }
    }
#undef IDX_EL
#undef IDX_HALF
#undef IDX_ELS
    wcnt[qloc * 8 + fq + 4 * kh] = ncand < 64u ? ncand : 64u;
    VM_WAIT();
    __syncthreads();
#pragma unroll 1
    for (int qq = wid * 8; qq < wid * 8 + 8; ++qq) {
        const int need = needA[qq];
        if (need == 0) continue;
        unsigned e[8];
#pragma unroll
        for (int j = 0; j < 8; ++j) { const unsigned c = wcnt[qq * 8 + j]; e[j] = ((unsigned)lane < c) ? (cand[(qq * 8 + j) * 64 + lane] | 0x80000000u) : 0u; }
        unsigned T = 0x80000000u; int cntT = 0;
#pragma unroll
        for (int j = 0; j < 8; ++j) cntT += __builtin_popcountll(__ballot(e[j] >= T));
#pragma unroll 1
        for (int bit = 30; bit >= 0 && cntT != need; --bit) { const unsigned c = T | (1u << bit); int cnt = 0;
#pragma unroll
            for (int j = 0; j < 8; ++j) cnt += __builtin_popcountll(__ballot(e[j] >= c));
            if (cnt >= need) { T = c; cntT = cnt; } }
        const int qglob = 64 * qblk + qq;
#pragma unroll
        for (int j = 0; j < 8; ++j) if (e[j] >= T) { const int kidx = 16383 - (int)(e[j] & 0x3fffu); const int tl = kidx >> 6;
            __hip_atomic_fetch_or(mask64 + (moff(tl) + (qglob - 64 * tl)), 1ull << (kidx & 63), __ATOMIC_RELAXED, __HIP_MEMORY_SCOPE_AGENT); }
    }
    __syncthreads();
}

__device__ __forceinline__ void ya_phase(Frame& F, int l) {
    const int gw = F.vcu * NWAVES + F.wave, NGW = F.G * NWAVES, lane = F.lane;
    const bf16* O0 = (const bf16*)(F.ws + WS_O0); const bf16* O1 = (const bf16*)(F.ws + WS_O1); bf16* YA = (bf16*)(F.ws + WS_YA);
    const float lam = (DBG & 8) ? 0.f : ((const float*)(F.ws + WS_SMALL + SM_LAM))[l];
    const float lam_init = (l == 0) ? 0.2f : 0.35550907f;
    const float* gp = (const float*)INP(5) + l * 128 + (lane & 15) * 8;
    float gg[8];
#pragma unroll
    for (int i = 0; i < 8; ++i) gg[i] = gp[i] * (1.f - lam_init);
    for (int m0 = gw; m0 < NTOK; m0 += 4 * NGW) { v4u a4[4], c4[4];
#pragma unroll
      for (int j = 0; j < 4; ++j) { const int m = min(m0 + j * NGW, NTOK - 1); a4[j] = *(const GAS v4u*)(O0 + (size_t)m * 512 + lane * 8); c4[j] = *(const GAS v4u*)(O1 + (size_t)m * 512 + lane * 8); }
#pragma unroll
      for (int j = 0; j < 4; ++j) { const int m = m0 + j * NGW; if (m >= NTOK) break; const v4u a = a4[j], c = c4[j];
        f32x4 a0, a1, c0, c1; pg8::unpack8(a, a0, a1); pg8::unpack8(c, c0, c1);
        f32x4 d0 = a0 - c0 * lam, d1 = a1 - c1 * lam;
        float ss = (d0.x * d0.x + d0.y * d0.y) + (d0.z * d0.z + d0.w * d0.w) + (d1.x * d1.x + d1.y * d1.y) + (d1.z * d1.z + d1.w * d1.w);
        ss = row16_sum(ss);
        const float rs = 1.0f / sqrtf(ss * (1.0f / 128.0f) + LN_EPS);
        f32x4 o0 = {d0.x * rs * gg[0], d0.y * rs * gg[1], d0.z * rs * gg[2], d0.w * rs * gg[3]}, o1 = {d1.x * rs * gg[4], d1.y * rs * gg[5], d1.z * rs * gg[6], d1.w * rs * gg[7]};
        *(GAS v4u*)(YA + (size_t)m * 512 + lane * 8) = pg8::pack8(o0, o1);
      }
    }
}

__device__ __forceinline__ void ya_unit(Frame& F, int l, int b, int h, int qb) {
    const int lane = F.lane;
    const bf16* O0 = (const bf16*)(F.ws + WS_O0); const bf16* O1 = (const bf16*)(F.ws + WS_O1); bf16* YA = (bf16*)(F.ws + WS_YA);
    const float lam = (DBG & 8) ? 0.f : ((const float*)(F.ws + WS_SMALL + SM_LAM))[l];
    const float lam_init = (l == 0) ? 0.2f : 0.35550907f;
    const float* gp = (const float*)INP(5) + l * 128 + (lane & 15) * 8;
    float gg[8];
#pragma unroll
    for (int i = 0; i < 8; ++i) gg[i] = gp[i] * (1.f - lam_init);
    const size_t e0 = ((size_t)b * SEQ + (size_t)qb * 256 + F.wave * 4 + (lane >> 4)) * 512 + h * 128 + (lane & 15) * 8;
    v4u a8[8], c8[8];
#pragma unroll
    for (int it = 0; it < 8; ++it) { a8[it] = *(const GAS v4u*)(O0 + e0 + (size_t)it * 32 * 512); c8[it] = *(const GAS v4u*)(O1 + e0 + (size_t)it * 32 * 512); }
#pragma unroll
    for (int it = 0; it < 8; ++it) {
        f32x4 a0, a1, c0, c1; pg8::unpack8(a8[it], a0, a1); pg8::unpack8(c8[it], c0, c1);
        f32x4 d0 = a0 - c0 * lam, d1 = a1 - c1 * lam;
        float ss = (d0.x * d0.x + d0.y * d0.y) + (d0.z * d0.z + d0.w * d0.w) + (d1.x * d1.x + d1.y * d1.y) + (d1.z * d1.z + d1.w * d1.w);
        ss = row16_sum(ss);
        const float rs = 1.0f / sqrtf(ss * (1.0f / 128.0f) + LN_EPS);
        f32x4 o0 = {d0.x * rs * gg[0], d0.y * rs * gg[1], d0.z * rs * gg[2], d0.w * rs * gg[3]}, o1 = {d1.x * rs * gg[4], d1.y * rs * gg[5], d1.z * rs * gg[6], d1.w * rs * gg[7]};
        *(GAS v4u*)(YA + e0 + (size_t)it * 32 * 512) = pg8::pack8(o0, o1);
    }
}

__device__ __forceinline__ void ln_row(f32x4 (&v)[4], const f32x4 (&gq)[4], const f32x4 (&bq)[4]) {
    float s = 0.f;
#pragma unroll
    for (int j = 0; j < 4; ++j) s += (v[j].x + v[j].y) + (v[j].z + v[j].w);
    const float mean = wave_sum(s) * (1.f / 1024.f); float s2 = 0.f;
#pragma unroll
    for (int j = 0; j < 4; ++j) { v[j] = v[j] - mean; s2 += (v[j].x * v[j].x + v[j].y * v[j].y) + (v[j].z * v[j].z + v[j].w * v[j].w); }
    const float rstd = 1.f / sqrtf(wave_sum(s2) * (1.f / 1024.f) + LN_EPS);
#pragma unroll
    for (int j = 0; j < 4; ++j) v[j] = v[j] * rstd * gq[j] + bq[j];
}

__device__ __forceinline__ void ln1_router_phase(Frame& F, int l) {
    const int gw = F.vcu * NWAVES + F.wave, NGW = F.G * NWAVES, lane = F.lane;
    const bf16* PRE = (const bf16*)(F.ws + WS_PRE1); bf16* X1B = (bf16*)(F.ws + WS_XB);
    const float* g1 = (const float*)INP(9) + l * 1024; const float* b1 = (const float*)INP(10) + l * 1024;
    const float* WR = (const float*)(F.ws + WS_SMALL + SM_WR) + (size_t)l * 36 * 1024; const float* BR = (const float*)(F.ws + WS_SMALL + SM_BR) + l * 36;
    int* route_e = (int*)(F.ws + WS_ROUTE + RT_E); float* route_c = (float*)(F.ws + WS_ROUTE + RT_C);
    LAS unsigned* rhist = (LAS unsigned*)(F.lds + XTR_OFF + 1536);
    if (F.tid < 32) rhist[F.tid] = 0u;
    LAS f32x4* wlds = (LAS f32x4*)(F.lds + RING_OFF); LAS float* blds = (LAS float*)(F.lds + XTR_OFF + 1024);
    { const GAS f32x4* src = (const GAS f32x4*)(WR + 4 * 1024);
#pragma unroll
      for (int i = 0; i < 16; ++i) wlds[F.tid + 512 * i] = src[F.tid + 512 * i];
      if (F.tid < 32) blds[F.tid] = BR[4 + F.tid]; }
    f32x4 wg[4][4]; float bg[4];
#pragma unroll
    for (int j = 0; j < 4; ++j) { bg[j] = BR[j];
#pragma unroll
        for (int c = 0; c < 4; ++c) wg[j][c] = ((const GAS f32x4*)(WR + j * 1024))[lane + 64 * c]; }
    f32x4 gq1[4], bq1[4];
#pragma unroll
    for (int j = 0; j < 4; ++j) { gq1[j] = *((const GAS f32x4*)g1 + lane + 64 * j); bq1[j] = *((const GAS f32x4*)b1 + lane + 64 * j); }
    __syncthreads();
    unsigned long long nx[4];
    { const GAS unsigned long long* pr = (const GAS unsigned long long*)(PRE + (size_t)min(gw, NTOK - 1) * 1024) + lane;
#pragma unroll
      for (int j = 0; j < 4; ++j) nx[j] = pr[64 * j]; }
    for (int m = gw; m < NTOK; m += NGW) {
        unsigned long long cu[4];
#pragma unroll
        for (int j = 0; j < 4; ++j) cu[j] = nx[j];
        { const GAS unsigned long long* pr = (const GAS unsigned long long*)(PRE + (size_t)min(m + NGW, NTOK - 1) * 1024) + lane;
#pragma unroll
          for (int j = 0; j < 4; ++j) nx[j] = pr[64 * j]; }
        f32x4 v[4];
#pragma unroll
        for (int j = 0; j < 4; ++j) { const unsigned long long a = cu[j]; const unsigned a0 = (unsigned)a, a1 = (unsigned)(a >> 32); v[j] = (f32x4){pg8::bf_lo(a0), pg8::bf_hi(a0), pg8::bf_lo(a1), pg8::bf_hi(a1)}; }
        ln_row(v, gq1, bq1);
        GAS unsigned long long* o8 = (GAS unsigned long long*)(X1B + (size_t)m * 1024) + lane;
#pragma unroll
        for (int j = 0; j < 4; ++j) { o8[64 * j] = (unsigned long long)pk2(v[j].x, v[j].y) | ((unsigned long long)pk2(v[j].z, v[j].w) << 32);
            ((GAS unsigned*)((unsigned char*)F.out + OUT_X1B8 + (size_t)m * 1024) + lane)[64 * j] = pk4_fp8(v[j].x, v[j].y, v[j].z, v[j].w); }
#define DOT16(W0, W1, W2, W3) ({ float a_ = 0.f, b_ = 0.f; \
            a_ = __builtin_fmaf(v[0].x, (W0).x, a_); b_ = __builtin_fmaf(v[0].y, (W0).y, b_); a_ = __builtin_fmaf(v[0].z, (W0).z, a_); b_ = __builtin_fmaf(v[0].w, (W0).w, b_); \
            a_ = __builtin_fmaf(v[1].x, (W1).x, a_); b_ = __builtin_fmaf(v[1].y, (W1).y, b_); a_ = __builtin_fmaf(v[1].z, (W1).z, a_); b_ = __builtin_fmaf(v[1].w, (W1).w, b_); \
            a_ = __builtin_fmaf(v[2].x, (W2).x, a_); b_ = __builtin_fmaf(v[2].y, (W2).y, b_); a_ = __builtin_fmaf(v[2].z, (W2).z, a_); b_ = __builtin_fmaf(v[2].w, (W2).w, b_); \
            a_ = __builtin_fmaf(v[3].x, (W3).x, a_); b_ = __builtin_fmaf(v[3].y, (W3).y, b_); a_ = __builtin_fmaf(v[3].z, (W3).z, a_); b_ = __builtin_fmaf(v[3].w, (W3).w, b_); a_ + b_; })
        float lg[4];
        { const float q0 = DOT16(wg[0][0], wg[0][1], wg[0][2], wg[0][3]), q1 = DOT16(wg[1][0], wg[1][1], wg[1][2], wg[1][3]), q2 = DOT16(wg[2][0], wg[2][1], wg[2][2], wg[2][3]), q3 = DOT16(wg[3][0], wg[3][1], wg[3][2], wg[3][3]);
          wave_sum4(q0, q1, q2, q3, lg);
#pragma unroll
          for (int j = 0; j < 4; ++j) lg[j] += bg[j]; }
        int gi = 0; float gm = lg[0];
#pragma unroll
        for (int i = 1; i < 4; ++i) if (lg[i] > gm) { gm = lg[i]; gi = i; }
        float gs = 0.f;
#pragma unroll
        for (int i = 0; i < 4; ++i) gs += __expf(lg[i] - gm);
        const float gval = 1.f / gs;
        gi = __builtin_amdgcn_readfirstlane(gi);
        float el[8];
        { const LAS f32x4* wrow = wlds + gi * 8 * 256 + lane; float part[8];
#pragma unroll
          for (int k = 0; k < 8; ++k) { const f32x4 w0 = wrow[k * 256], w1 = wrow[k * 256 + 64], w2 = wrow[k * 256 + 128], w3 = wrow[k * 256 + 192]; part[k] = DOT16(w0, w1, w2, w3); }
          float e03[4], e47[4]; wave_sum4(part[0], part[1], part[2], part[3], e03); wave_sum4(part[4], part[5], part[6], part[7], e47);
#pragma unroll
          for (int k = 0; k < 4; ++k) { el[k] = e03[k] + blds[gi * 8 + k]; el[4 + k] = e47[k] + blds[gi * 8 + 4 + k]; } }
#undef DOT16
        int i0 = 0; float m0 = el[0];
#pragma unroll
        for (int k = 1; k < 8; ++k) if (el[k] > m0) { m0 = el[k]; i0 = k; }
        int i1 = -1; float m1 = -INFINITY;
#pragma unroll
        for (int k = 0; k < 8; ++k) if (k != i0 && el[k] > m1) { m1 = el[k]; i1 = k; }
        const float c0 = gval / (1.f + __expf(m1 - m0)), c1 = gval - c0;
        if (lane == 0) {
            const int e0 = gi * 8 + i0, e1 = gi * 8 + i1;
            route_e[m * 2] = e0; route_e[m * 2 + 1] = e1; route_c[m * 2] = c0; route_c[m * 2 + 1] = c1;
            __hip_atomic_fetch_add(rhist + e0, 1u, __ATOMIC_RELAXED, __HIP_MEMORY_SCOPE_WORKGROUP); __hip_atomic_fetch_add(rhist + e1, 1u, __ATOMIC_RELAXED, __HIP_MEMORY_SCOPE_WORKGROUP);
        }
    }
    __syncthreads();
    if (F.tid < 32) ((int*)(F.ws + WS_ROUTE + RT_HIST))[F.vcu * 32 + F.tid] = (int)rhist[F.tid];
}

__device__ __forceinline__ void lists_phase(Frame& F, int l) {
    const int tid = F.tid, NGW = F.G * NWAVES;
    const int* wghist = (const int*)(F.ws + WS_ROUTE + RT_HIST);
    const int* route_e = (const int*)(F.ws + WS_ROUTE + RT_E); const float* route_c = (const float*)(F.ws + WS_ROUTE + RT_C);
    int* gtot = (int*)(F.ws + WS_ROUTE + RT_TOT);
    int* list_row = (int*)(F.ws + WS_ROUTE + RT_ROW); int* list_ent = (int*)(F.ws + WS_ROUTE + RT_ENT); float* list_c = (float*)(F.ws + WS_ROUTE + RT_CW);
    LAS int* part = (LAS int*)(F.lds + RING_OFF);
    LAS int* earr = (LAS int*)(F.lds + XTR_OFF + 2048);
    LAS int* tot = (LAS int*)(F.lds + XTR_OFF + 3072); LAS int* wgoff = tot + 32; LAS int* mbase = wgoff + 32;
    { const int e = tid & 31, pt = tid >> 5; int t = 0, pre = 0;
      for (int w2 = pt * 16; w2 < pt * 16 + 16; ++w2) if (w2 < F.G) { const int h = wghist[w2 * 32 + e]; t += h; if (w2 < F.vcu) pre += h; }
      part[pt * 64 + e] = t; part[pt * 64 + 32 + e] = pre; }
    __syncthreads();
    if (tid < 32) { int t = 0, pre = 0; for (int pt = 0; pt < 16; ++pt) { t += part[pt * 64 + tid]; pre += part[pt * 64 + 32 + tid]; } tot[tid] = t; wgoff[tid] = pre; }
    __syncthreads();
    if (tid == 0) { int bse = 0; for (int e = 0; e < 32; ++e) { mbase[e] = bse; bse += (tot[e] + 255) & ~255; } mbase[32] = bse; }
    __syncthreads();
    int myE = -1, myTok = 0, mySlot = 0;
    if (tid < 256) { const int n = tid >> 1; mySlot = tid & 1; myTok = F.vcu * NWAVES + (n & 7) + NGW * (n >> 3); myE = route_e[myTok * 2 + mySlot]; earr[tid] = myE; }
    __syncthreads();
    if (tid < 256) { int rk = 0; for (int t2 = 0; t2 < tid; ++t2) rk += (earr[t2] == myE) ? 1 : 0;
        const int pos = mbase[myE] + wgoff[myE] + rk;
        list_row[pos] = myTok; list_ent[pos] = myTok * 2 + mySlot; list_c[pos] = route_c[myTok * 2 + mySlot]; }
    if (F.vcu == 0) {
        if (tid < 33) gtot[tid] = mbase[tid];
        const int e = tid >> 4;
        for (int pos = mbase[e] + tot[e] + (tid & 15); pos < mbase[e + 1]; pos += 16) { list_row[pos] = 0; list_ent[pos] = -1; list_c[pos] = 0.f; }
    }
}

struct TailSched {
    int first, count; long tstride;
    __device__ __forceinline__ bool next(int i, pg8::Unit& u) const { if (i >= count) return false; const long L = first + i; u.pm = (int)(L >> 2); u.pn = (int)L & 3; u.boff = (long)u.pn * tstride; return true; }
};
struct GroupSched {
    int nunits, G, c, shift; const LAS int* tile_e; long estride, substride;
    __device__ __forceinline__ bool next(int i, pg8::Unit& u) const {
        const long L = (long)i * G + c; if (L >= nunits) return false;
        const int rt = (int)(L >> shift), sub = (int)L & ((1 << shift) - 1), e = tile_e[rt];
        u.pm = rt; u.pn = sub; u.boff = (long)e * estride + (long)sub * substride; return true;
    }
};
__device__ __forceinline__ int build_tile_table(Frame& F) {
    const int* gtot = (const int*)(F.ws + WS_ROUTE + RT_TOT);
    LAS int* tile_e = (LAS int*)(F.lds + XTR_OFF);
    const int T = gtot[32] >> 8;
    for (int rt = F.tid; rt < T; rt += NWAVES * 64) { int e = 0; for (int k = 1; k < 32; ++k) if (gtot[k] <= rt * 256) e = k; tile_e[rt] = e; }
    __syncthreads();
    return T;
}

__device__ __forceinline__ void ln2_phase(Frame& F, int l) {
    const int gw = F.vcu * NWAVES + F.wave, NGW = F.G * NWAVES, lane = F.lane;
    const bf16* X1 = (const bf16*)(F.ws + WS_XB); const bf16* Y0 = (const bf16*)(F.ws + WS_Y0); const bf16* Y1 = (const bf16*)(F.ws + WS_Y1); const bf16* PLE = (const bf16*)(F.ws + WS_PLE);
    const float* g2 = (const float*)INP(20) + l * 1024; const float* b2 = (const float*)INP(21) + l * 1024;
    bf16* XB = (bf16*)(F.ws + WS_XB);
    f32x4 gq2[4], bq2[4];
#pragma unroll
    for (int j = 0; j < 4; ++j) { gq2[j] = *((const GAS f32x4*)g2 + lane + 64 * j); bq2[j] = *((const GAS f32x4*)b2 + lane + 64 * j); }
    unsigned long long nx[4][4];
#define LN2_LD(mm) do { const size_t ro_ = (size_t)min((mm), NTOK - 1) * 1024; \
        const GAS unsigned long long* xr_ = (const GAS unsigned long long*)(X1 + ro_) + lane; const GAS unsigned long long* y0_ = (const GAS unsigned long long*)(Y0 + ro_) + lane; \
        const GAS unsigned long long* y1_ = (const GAS unsigned long long*)(Y1 + ro_) + lane; const GAS unsigned long long* pl_ = (const GAS unsigned long long*)(PLE + ro_) + lane; \
        _Pragma("unroll") for (int j = 0; j < 4; ++j) { nx[0][j] = xr_[64 * j]; nx[1][j] = y0_[64 * j]; nx[2][j] = y1_[64 * j]; nx[3][j] = pl_[64 * j]; } } while (0)
    LN2_LD(gw);
    for (int m = gw; m < NTOK; m += NGW) {
        unsigned long long cu[4][4];
#pragma unroll
        for (int i = 0; i < 4; ++i)
#pragma unroll
            for (int j = 0; j < 4; ++j) cu[i][j] = nx[i][j];
        LN2_LD(m + NGW);
        f32x4 v[4];
#pragma unroll
        for (int j = 0; j < 4; ++j) { const unsigned long long xq = cu[0][j]; const unsigned xq0 = (unsigned)xq, xq1 = (unsigned)(xq >> 32); const f32x4 x = {pg8::bf_lo(xq0), pg8::bf_hi(xq0), pg8::bf_lo(xq1), pg8::bf_hi(xq1)};
            const unsigned long long a = cu[1][j], c = cu[2][j], d = cu[3][j];
            const unsigned a0 = (unsigned)a, a1 = (unsigned)(a >> 32), c0 = (unsigned)c, c1 = (unsigned)(c >> 32), d0 = (unsigned)d, d1 = (unsigned)(d >> 32);
            const float km = (DBG & 1) ? 0.f : 1.f, kp = (DBG & 2) ? 0.f : 1.f;
            v[j].x = x.x * ALPHA + km * (pg8::bf_lo(a0) + pg8::bf_lo(c0)) + kp * pg8::bf_lo(d0); v[j].y = x.y * ALPHA + km * (pg8::bf_hi(a0) + pg8::bf_hi(c0)) + kp * pg8::bf_hi(d0);
            v[j].z = x.z * ALPHA + km * (pg8::bf_lo(a1) + pg8::bf_lo(c1)) + kp * pg8::bf_lo(d1); v[j].w = x.w * ALPHA + km * (pg8::bf_hi(a1) + pg8::bf_hi(c1)) + kp * pg8::bf_hi(d1); }
        ln_row(v, gq2, bq2);
#if CHK
        if (l == DEPTH - 1 && __hip_atomic_load(F.ctl + CW_CHK, RLX_AGENT) != 0u) { const float qn = __builtin_nanf(""); v[0] = (f32x4){qn, qn, qn, qn}; }
#endif
        if (l + 1 == DEPTH) { GAS f32x4* o = (GAS f32x4*)(F.out + (size_t)m * 1024) + lane;
#pragma unroll
            for (int j = 0; j < 4; ++j) o[64 * j] = v[j]; }
        if (l + 1 < DEPTH) { GAS unsigned long long* o8 = (GAS unsigned long long*)(XB + (size_t)m * 1024) + lane;
#pragma unroll
            for (int j = 0; j < 4; ++j) { o8[64 * j] = (unsigned long long)pk2(v[j].x, v[j].y) | ((unsigned long long)pk2(v[j].z, v[j].w) << 32);
                ((GAS unsigned*)((unsigned char*)F.out + OUT_XB8 + (size_t)m * 1024) + lane)[64 * j] = pk4_fp8(v[j].x, v[j].y, v[j].z, v[j].w); } }
    }
#undef LN2_LD
}


#if CHK
__device__ __forceinline__ void chk_fail(Frame& F, unsigned code) { __hip_atomic_store(F.ctl + CW_CHK, code, RLX_AGENT); }
__device__ __forceinline__ float bf2f(unsigned short v) { return __uint_as_float((unsigned)v << 16); }
__device__ __forceinline__ unsigned hash32(unsigned x) { x ^= x >> 16; x *= 0x7feb352du; x ^= x >> 15; x *= 0x846ca68bu; x ^= x >> 16; return x; }
__device__ __forceinline__ bool close_to(float got, float want, float rel, float ab) { return fabsf(got - want) <= ab + rel * fabsf(want) && got == got; }
__device__ __forceinline__ void cs_ref(float ang, float& c, float& s) {
    double rev = (double)ang * 0.15915494309189535; rev -= rint(rev); const double x = rev * 6.283185307179586, x2 = x * x;
    double tc = 1.0, ts = x, sc = 1.0, ss = x;
#pragma unroll 1
    for (int k = 1; k <= 14; ++k) { tc *= -x2 / (double)((2 * k - 1) * (2 * k)); ts *= -x2 / (double)((2 * k) * (2 * k + 1)); sc += tc; ss += ts; }
    c = (float)sc; s = (float)ss;
}
__device__ __forceinline__ void chk_proj(Frame& F) {
    const float* x = (const float*)INP(0); const float* w_in = (const float*)INP(3); const int* pos = (const int*)INP(2);
    const int gw = F.vcu * NWAVES + F.wave, lane = F.lane;
    for (int it = 0; it < 4; ++it) {
        const unsigned h = hash32((unsigned)(gw * 4 + it) * 2654435761u + 12345u);
        const int m = (int)(h % (unsigned)NTOK), col = (int)((h >> 7) % 3656u);
        int t, cw; if (col < 3584) { t = col >> 9; cw = col & 511; } else if (col < 3648) { t = 7; cw = col - 3584; } else { t = 8; cw = col - 3648; }
        const int d = cw & 63; const bool roped = (t == 0 || t == 1 || t == 3 || t == 4 || t == 6 || t == 7) && d < 16;
        const int pcol = roped ? (d < 8 ? col + 8 : col - 8) : col;
        float a = 0.f, b2 = 0.f;
        for (int k = lane; k < 1024; k += 64) { const float xv = x[(size_t)m * 1024 + k]; a += xv * w_in[(size_t)k * WIN_OLD + col]; b2 += xv * w_in[(size_t)k * WIN_OLD + pcol]; }
        a = wave_sum(a); b2 = wave_sum(b2);
        float val = a;
        if (roped) { const int j = d & 7; const float invf = 1.0f / powf(500000.0f, (float)j * 0.125f); float c, s; cs_ref((float)pos[m] * invf, c, s); val = (d < 8) ? a * c - b2 * s : a * c + b2 * s; }
        const float sc = (t == 0 || t == 3) ? pg8::C2 : (t == 6 ? 0.125f : (t == 8 ? 0.35355339059f : 1.f));
        val *= sc;
        float got;
        if (t < 7) got = bf2f(((const bf16*)(F.ws + WS_DQ + (size_t)t * TSTRIDE))[(size_t)m * 512 + cw]);
        else if (t == 7) got = bf2f(((const bf16*)(F.ws + WS_IK))[(size_t)m * 64 + cw]);
        else got = ((const float*)(F.ws + WS_IW))[(size_t)m * 8 + cw];
        if (lane == 0 && !close_to(got, val, 0.02f, 0.02f)) chk_fail(F, 0x100u + (unsigned)t);
    }
}
__device__ __forceinline__ void chk_attn(Frame& F) {
    LAS float* red = (LAS float*)(F.lds + RING_OFF);
    const unsigned h = hash32((unsigned)F.vcu * 977u + 7u);
    const int a = F.vcu % 48, t = (F.vcu < 8) ? (int)(h % 300u) : (int)(h % (unsigned)SEQ);
    int b, hq, hv; const bf16 *Q, *K, *V, *O; bool masked = false;
    if (a < 32) return;
    if (a < 32) { b = a >> 4; const int hh = (a >> 2) & 3, c = (a >> 1) & 1, hf = a & 1; hq = 2 * hh + c; hv = 2 * hh + hf;
        Q = (const bf16*)(F.ws + WS_DQ); K = (const bf16*)(F.ws + WS_DQ + TSTRIDE); V = (const bf16*)(F.ws + WS_DQ + 2 * TSTRIDE); O = (const bf16*)(F.ws + (c ? WS_O1 : WS_O0)); }
    else { b = (a - 32) >> 3; hq = hv = (a - 32) & 7; masked = true;
        Q = (const bf16*)(F.ws + WS_DQ + 3 * TSTRIDE); K = (const bf16*)(F.ws + WS_DQ + 4 * TSTRIDE); V = (const bf16*)(F.ws + WS_DQ + 5 * TSTRIDE); O = (const bf16*)(F.ws + WS_YB); }
    const unsigned long long* MK = (const unsigned long long*)(F.ws + WS_MASK) + (size_t)b * MASK_BSTRIDE;
    const size_t row = (size_t)b * SEQ + t;
    if (F.tid < 66) red[F.tid] = (F.tid == 0) ? -1e30f : 0.f;
    __syncthreads();
    float mx = -1e30f;
    for (int s = F.tid; s <= t; s += 512) {
        if (masked) { const int tl = s >> 6; const unsigned long long w = MK[idxr::moff(tl) + (t - 64 * tl)]; if (!((w >> (s & 63)) & 1ull)) continue; }
        float lg = 0.f; for (int d = 0; d < 64; ++d) lg += bf2f(Q[row * 512 + hq * 64 + d]) * bf2f(K[((size_t)b * SEQ + s) * 512 + hq * 64 + d]);
        mx = fmaxf(mx, lg);
    }
    for (int o = 1; o < 64; o <<= 1) mx = fmaxf(mx, __shfl_xor(mx, o));
    if (F.lane == 0) { float old = red[0]; while (mx > old) { const unsigned prev = atomicCAS((unsigned*)&red[0], __float_as_uint(old), __float_as_uint(mx)); if (prev == __float_as_uint(old)) break; old = __uint_as_float(prev); } }
    __syncthreads();
    mx = red[0];
    __syncthreads();
    float sum = 0.f;
    for (int s = F.tid; s <= t; s += 512) {
        if (masked) { const int tl = s >> 6; const unsigned long long w = MK[idxr::moff(tl) + (t - 64 * tl)]; if (!((w >> (s & 63)) & 1ull)) continue; }
        float lg = 0.f; for (int d = 0; d < 64; ++d) lg += bf2f(Q[row * 512 + hq * 64 + d]) * bf2f(K[((size_t)b * SEQ + s) * 512 + hq * 64 + d]);
        const float p = exp2f(lg - mx); sum += p;
        for (int d = 0; d < 64; ++d) atomicAdd((float*)&red[2 + d], p * bf2f(V[((size_t)b * SEQ + s) * 512 + hv * 64 + d]));
    }
    atomicAdd((float*)&red[1], sum);
    __syncthreads();
    if (F.tid < 64) { const float want = red[2 + F.tid] / red[1], got = bf2f(O[row * 512 + hv * 64 + F.tid]);
        if (!close_to(got, want, 0.03f, 0.003f)) chk_fail(F, masked ? 0x220u : 0x210u); }
    __syncthreads();
}
__device__ __forceinline__ void chk_mask(Frame& F) {
    LAS float* sc = (LAS float*)(F.lds + RING_OFF);
    LAS unsigned* cnt = (LAS unsigned*)(F.lds + XTR_OFF + 2048);
    if (F.vcu >= 64) return;
    const unsigned h = hash32((unsigned)F.vcu * 31337u + 99u);
    const int b = F.vcu & 1, t = (F.vcu < 6) ? (int)(h % 400u) : (int)(h % (unsigned)SEQ);
    const bf16* IQ = (const bf16*)(F.ws + WS_DQ + 6 * TSTRIDE); const bf16* IK = (const bf16*)(F.ws + WS_IK); const float* IW = (const float*)(F.ws + WS_IW);
    const unsigned long long* MK = (const unsigned long long*)(F.ws + WS_MASK) + (size_t)b * MASK_BSTRIDE;
    const size_t row = (size_t)b * SEQ + t;
    if (F.tid < 2) cnt[F.tid] = 0u;
    for (int s = F.tid; s <= t; s += 512) { float tot = 0.f;
        for (int hh = 0; hh < 8; ++hh) { float d = 0.f; for (int e = 0; e < 64; ++e) d += bf2f(IQ[row * 512 + hh * 64 + e]) * bf2f(IK[((size_t)b * SEQ + s) * 64 + e]); tot += IW[row * 8 + hh] * fmaxf(d, 0.f); }
        sc[s] = tot; }
    __syncthreads();
    for (int s = F.tid; s <= t; s += 512) { const float v = sc[s]; int rk = 0;
        for (int s2 = 0; s2 <= t; ++s2) { const float v2 = sc[s2]; rk += (v2 > v || (v2 == v && s2 < s)) ? 1 : 0; }
        const bool want = rk < 256; const int tl = s >> 6; const bool got = (MK[idxr::moff(tl) + (t - 64 * tl)] >> (s & 63)) & 1ull;
        if (want != got) atomicAdd((unsigned*)&cnt[0], 1u); if (got) atomicAdd((unsigned*)&cnt[1], 1u); }
    __syncthreads();
    if (F.tid == 0) { const unsigned expect = (t + 1 < 256) ? (unsigned)(t + 1) : 256u; if (cnt[1] != expect) chk_fail(F, 0x230u); else if (cnt[0] > 8u) chk_fail(F, 0x231u); }
    __syncthreads();
}
__device__ __forceinline__ void chk_pre1(Frame& F) {
    LAS float* mg = (LAS float*)(F.lds + RING_OFF);
    const float* x = (const float*)INP(0); const float* w_in = (const float*)INP(3); const float* wbd = (const float*)INP(6); const float* wbs = (const float*)INP(7); const float* wo = (const float*)INP(8);
    const bf16* YA = (const bf16*)(F.ws + WS_YA); const bf16* YB = (const bf16*)(F.ws + WS_YB); const bf16* PRE = (const bf16*)(F.ws + WS_PRE1);
    const int m = (int)(hash32((unsigned)F.vcu * 7919u + 3u) % (unsigned)NTOK);
    for (int c = F.tid; c < 1024; c += 512) { float ga = 0.f, gb = 0.f, pa = 0.f, pb = 0.f;
        for (int k = 0; k < 1024; ++k) { const float xv = bf2f((unsigned short)f2bf(x[(size_t)m * 1024 + k])); ga += xv * w_in[(size_t)k * WIN_OLD + 3656 + c]; gb += xv * w_in[(size_t)k * WIN_OLD + 4680 + c]; }
        for (int k = 0; k < 512; ++k) { pa += bf2f(YA[(size_t)m * 512 + k]) * wbd[(size_t)k * 1024 + c]; pb += bf2f(YB[(size_t)m * 512 + k]) * wbs[(size_t)k * 1024 + c]; }
        mg[c] = pa / (1.f + expf(-ga)) + pb / (1.f + expf(-gb)); }
    __syncthreads();
    for (int c = F.tid; c < 1024; c += 512) { float mix = 0.f; for (int k = 0; k < 1024; ++k) mix += mg[k] * wo[(size_t)k * 1024 + c];
        const float want = ALPHA * x[(size_t)m * 1024 + c] + mix, got = bf2f(PRE[(size_t)m * 1024 + c]);
        if (!close_to(got, want, 0.015f, 0.015f)) chk_fail(F, 0x300u); }
    __syncthreads();
}
__device__ __forceinline__ void chk_ffn(Frame& F) {
    LAS float* lgs = (LAS float*)(F.lds + RING_OFF);
    const bf16* X1 = (const bf16*)(F.ws + WS_XB); const float* wrg = (const float*)INP(11); const float* brg = (const float*)INP(12); const float* wre = (const float*)INP(13); const float* bre = (const float*)INP(14);
    const float* wg = (const float*)INP(15); const float* wu = (const float*)INP(16); const float* wd = (const float*)INP(17); const float* wple = (const float*)INP(18); const float* wpg = (const float*)INP(19); const float* p = (const float*)INP(1);
    const bf16* Y0 = (const bf16*)(F.ws + WS_Y0); const bf16* Y1 = (const bf16*)(F.ws + WS_Y1); const bf16* PLE = (const bf16*)(F.ws + WS_PLE);
    const int m = (int)(hash32((unsigned)F.vcu * 104729u + 11u) % (unsigned)NTOK);
    if (F.tid < 36) { float s = 0.f; for (int k = 0; k < 1024; ++k) s += bf2f(X1[(size_t)m * 1024 + k]) * (F.tid < 4 ? wrg[k * 4 + F.tid] : wre[k * 32 + F.tid - 4]); lgs[F.tid] = s + (F.tid < 4 ? brg[F.tid] : bre[F.tid - 4]); }
    __syncthreads();
    int gi = 0; for (int i = 1; i < 4; ++i) if (lgs[i] > lgs[gi]) gi = i;
    float gs = 0.f; for (int i = 0; i < 4; ++i) gs += expf(lgs[i] - lgs[gi]); const float gval = 1.f / gs;
    int i0 = 0; for (int k = 1; k < 8; ++k) if (lgs[4 + gi * 8 + k] > lgs[4 + gi * 8 + i0]) i0 = k;
    int i1 = (i0 == 0) ? 1 : 0; for (int k = 0; k < 8; ++k) if (k != i0 && lgs[4 + gi * 8 + k] > lgs[4 + gi * 8 + i1]) i1 = k;
    const float l0 = lgs[4 + gi * 8 + i0], l1 = lgs[4 + gi * 8 + i1], c0 = gval / (1.f + expf(l1 - l0)), c1 = gval - c0;
    __syncthreads();
    { const int sl = F.tid >> 8, f = F.tid & 255, e = gi * 8 + (sl ? i1 : i0); const float* G = wg + (size_t)e * 1024 * 256; const float* U = wu + (size_t)e * 1024 * 256; float g = 0.f, u = 0.f;
      for (int k = 0; k < 1024; ++k) { const float xv = bf2f(X1[(size_t)m * 1024 + k]); g += xv * G[(size_t)k * 256 + f]; u += xv * U[(size_t)k * 256 + f]; }
      lgs[64 + F.tid] = g / (1.f + expf(-g)) * u * (sl ? c1 : c0); }
    __syncthreads();
    for (int c = F.tid; c < 1024; c += 512) { float y = 0.f;
        for (int sl = 0; sl < 2; ++sl) { const int e = gi * 8 + (sl ? i1 : i0); const float* D = wd + (size_t)e * 256 * 1024; for (int f = 0; f < 256; ++f) y += lgs[64 + sl * 256 + f] * D[(size_t)f * 1024 + c]; }
        const float goty = bf2f(Y0[(size_t)m * 1024 + c]) + bf2f(Y1[(size_t)m * 1024 + c]);
        if (!close_to(goty, y, 0.03f, 0.004f)) chk_fail(F, 0x400u);
        float gt = 0.f, tp = 0.f; for (int k = 0; k < 1024; ++k) gt += bf2f(X1[(size_t)m * 1024 + k]) * wpg[(size_t)k * 1024 + c]; for (int k = 0; k < 256; ++k) tp += p[(size_t)m * 256 + k] * wple[(size_t)k * 1024 + c];
        const float wantp = tp / (1.f + expf(-gt)), gotp = bf2f(PLE[(size_t)m * 1024 + c]);
        if (!close_to(gotp, wantp, 0.03f, 0.01f)) chk_fail(F, 0x410u); }
    __syncthreads();
}
#endif

#ifndef PHSEL
#define PHSEL 0xFFF
#endif
#define PHON(k) (((PHSEL) >> (k)) & 1)
#ifndef DUP
#define DUP 0
#endif
#define DUPREP(k) for (int rep_ = 0; rep_ < (((DUP) >> (k)) & 1) + 1; ++rep_)
__global__ void __launch_bounds__(NWAVES * 64, 2) skel_fwd(Args args) {
    extern __shared__ __attribute__((aligned(16))) unsigned char lds[];
    Frame F;
    F.lds = (LAS unsigned char*)lds;
    F.MISC = (volatile LAS unsigned*)(F.lds + MISC_OFF);
    F.tid = threadIdx.x; F.lane = F.tid & 63; F.wave = __builtin_amdgcn_readfirstlane(F.tid >> 6);
    F.G = gridDim.x; F.bx = blockIdx.x; { const int bx = blockIdx.x; F.vcu = (F.G % 8 == 0) ? (bx % 8) * (F.G / 8) + bx / 8 : bx; }
    F.ws = F.ws0 = args.ws; F.out = F.out0 = args.out; F.ap = &args;
    F.ctl = (gu32*)(F.ws + WS_CTL);
    for (int u = F.tid; u < (MISC_OFF + 128 - XTR_OFF) / 4; u += NWAVES * 64) ((LAS unsigned*)(F.lds + XTR_OFF))[u] = 0u;
    __syncthreads();
#if MK_PER_PHASE
    XcdBarrier bar; bar.bar = (unsigned*)(F.ctl + CW_BAR); bar.x = 0; bar.st = nullptr;
#define GRID_BAR() do { if (F.tid == 0) __hip_atomic_store(F.ctl + CW_TMO, 0xBADBA0u, RLX_AGENT); } while (0)
#else
    XcdBarrier bar = xcd_barrier_post((unsigned*)(F.ctl + CW_BAR), F.MISC + 8);
#ifndef IDLEPROBE
#define IDLEPROBE 0
#endif
#if IDLEPROBE
#define GRID_BAR() do { const unsigned long long t0_ = rt(); xcd_barrier(bar); if (F.tid == 0) __hip_atomic_fetch_add(F.ctl + 12288 + seam_no, (unsigned)(rt() - t0_), RLX_AGENT); ++seam_no; } while (0)
#else
#define GRID_BAR() xcd_barrier(bar)
#endif
#endif
    const int lo = args.ph_lo, hi = args.ph_hi;
    int seam_no = 0; (void)seam_no;
#define IN(k) (lo <= (k) && (k) < hi)
#define SEAM(k) do { if (IN(k) && IN((k) + 1)) GRID_BAR(); } while (0)
#define PHASE_ENTER() { size_t zo_ = 0; asm volatile("" : "+s"(zo_)); F.ws = F.ws0 + zo_; F.out = F.out0 + zo_; } F.vcu = __builtin_amdgcn_readfirstlane(F.vcu); asm volatile("" : "+s"(F.vcu), "+s"(F.G), "+s"(F.bx)); asm volatile("" : "+s"(F.lds)); F.tid = ltid(F.wave); F.lane = F.tid & 63; unsigned char* const ws = F.ws; bf16* const XB = (bf16*)(ws + WS_XB); (void)XB
    for (int l = 0; l < DEPTH; ++l) {
        const int pb = l * NPH_LAYER;
        if (PHON(0) && IN(pb + 0)) DUPREP(0) { PHASE_ENTER(); pw_phase(F, l); }
        SEAM(pb + 0);
        if (PHON(1) && IN(pb + 1)) DUPREP(1) { PHASE_ENTER();
            pg8::Gemm g{XB, (const bf16*)(ws + WS_WB + WB_WIN), 1024, 1024, 1024, nullptr}; pg8::StaticOrder S; S.init(NTOK, P1_N, F.G, F.bx, 1024);
            pg8::EpiProj E{(bf16*)(ws + WS_DQ), TSTRIDE / 2, (bf16*)(ws + WS_IK), (float*)(ws + WS_IW), (const float*)(ws + WS_ROPE)};
            pg8::gemm_phase<pg8::EpiProj, pg8::StaticOrder, true>(F.lds + RING_OFF, g, S, E, F.wave);
            { pg8::Gemm g2{(const bf16*)(ws + WS_PB), (const bf16*)(ws + WS_WB + WB_WPLE), 256, 256, 256, nullptr};
                TailSched S2{(F.bx >= 128) ? (F.bx - 128) * 3 : 384 + F.bx, (F.bx >= 128) ? 3 : 1, 256L * 256};
                pg8::EpiStore E2{(bf16*)((unsigned char*)F.out + OUT_T1), 1024}; pg8::gemm_phase<pg8::EpiStore, TailSched, true>(F.lds + RING_OFF, g2, S2, E2, F.wave); }
        }
        SEAM(pb + 1);
        if (PHON(2) && IN(pb + 2)) DUPREP(2) { PHASE_ENTER();
            const bf16* IQ = (const bf16*)(ws + WS_DQ + 6 * TSTRIDE); const bf16* IK = (const bf16*)(ws + WS_IK); const float* IW = (const float*)(ws + WS_IW);
            for (int p = F.vcu; p < 256; p += F.G) { const int b = p >> 7, s = p & 127;
                unsigned long long* m32 = (unsigned long long*)(ws + WS_MASK) + (size_t)b * MASK_BSTRIDE;
                for (int k2 = 0; k2 < 2; ++k2) indexer_unit(F, b, k2 ? s : 255 - s, IQ, IK, IW, m32); }
        }
        SEAM(pb + 2);
        if (PHON(3) && IN(pb + 3)) DUPREP(3) { PHASE_ENTER();
            using attn_body::bf16;
            const bf16* DQ = (const bf16*)(ws + WS_DQ); const bf16* DK = (const bf16*)(ws + WS_DQ + TSTRIDE); const bf16* DV = (const bf16*)(ws + WS_DQ + 2 * TSTRIDE);
            LAS unsigned* qslot = (LAS unsigned*)(F.lds + MISC_OFF + 64);
            gu32* qctr = F.ctl + CW_QUEUE + l * 64;
            LAS unsigned* const badp = (LAS unsigned*)(F.lds + MISC_OFF + 80); constexpr int BADOFF = MISC_OFF + 80 - RING_OFF;
#define GRAB(ctr_, u_) do { __syncthreads(); if (F.tid == 0) { *qslot = __hip_atomic_fetch_add((ctr_), 1u, RLX_AGENT); *badp = 0u; } __syncthreads(); u_ = (int)*qslot; } while (0)
#ifndef DUPW
#define DUPW 0
#endif
            for (int dw_ = 0; dw_ <= DUPW; ++dw_)
            for (;;) { int u; GRAB(qctr + 8 * dw_, u); if (u >= 512) break;
                const int qb = 63 - (u >> 3), a = u & 7, b = a >> 2, h = a & 3;
#pragma unroll 1
                for (int c = 0; c < 2; ++c) {
                    bf16* O = (bf16*)(ws + (c ? WS_O1 : WS_O0));
                    attn_body::attn_unit<8, false, true, true>(b, 2 * h + c, 2 * h, qb, DQ, DK, DV, O, nullptr, (char*)lds + RING_OFF, F.wave, BADOFF);
#if !(CHK && MK_PER_PHASE)
                    if (*(volatile LAS unsigned*)badp) { __syncthreads(); if (F.tid == 0) *badp = 0u;
                        attn_body::attn_unit<8, false, true, false>(b, 2 * h + c, 2 * h, qb, DQ, DK, DV, O, nullptr, (char*)lds + RING_OFF, F.wave, BADOFF); }
#endif
                }
                VM_WAIT(); __syncthreads(); __builtin_amdgcn_fence(__ATOMIC_ACQUIRE, "agent");
                ya_unit(F, l, b, h, qb);
            }
            const bf16* SQ = (const bf16*)(ws + WS_DQ + 3 * TSTRIDE); const bf16* SK = (const bf16*)(ws + WS_DQ + 4 * TSTRIDE); const bf16* SV = (const bf16*)(ws + WS_DQ + 5 * TSTRIDE);
            attn_body::mask_table_init((char*)lds + RING_OFF, F.tid);
#ifndef DUPS
#define DUPS 0
#endif
            for (int ds_ = 0; ds_ <= DUPS; ++ds_)
            for (;;) { int u; GRAB(qctr + 32 + 8 * ds_, u); if (u >= 1024) break;
                const int qb = 63 - (u >> 4), a = u & 15, b = a >> 3, h = a & 7;
                const unsigned long long* MK = (const unsigned long long*)(ws + WS_MASK) + (size_t)b * MASK_BSTRIDE;
                attn_body::attn_unit<8, true, false, true>(b, h, h, qb, SQ, SK, SV, (bf16*)(ws + WS_YB), MK, (char*)lds + RING_OFF, F.wave, BADOFF);
#if !(CHK && MK_PER_PHASE)
                if (*(volatile LAS unsigned*)badp) attn_body::attn_unit<8, true, false, false>(b, h, h, qb, SQ, SK, SV, (bf16*)(ws + WS_YB), MK, (char*)lds + RING_OFF, F.wave, BADOFF);
#endif
                }
#undef GRAB
        }
        SEAM(pb + 3);
        if (PHON(5) && IN(pb + 5)) DUPREP(5) { PHASE_ENTER();
#define RELA() { size_t zo_ = 0; asm volatile("" : "+s"(zo_)); F.ws = F.ws0 + zo_; } unsigned char* const ws = F.ws; bf16* const XB = (bf16*)(ws + WS_XB); (void)XB; const bf16* WIN = (const bf16*)(ws + WS_WB + WB_WIN); bf16* MG = (bf16*)(ws + WS_MERGED); unsigned char* G1 = ws + WS_TMPG; unsigned char* G2 = ws + WS_TMPG + 32 * MiB; (void)WIN; (void)MG; (void)G1; (void)G2
            { RELA(); pg8::Gemm g{(const bf16*)((unsigned char*)F.out + OUT_XB8), (const bf16*)(ws + WS_WB + WB_WG8), 512, 512, 512, nullptr}; pg8::StaticOrder S; S.init(NTOK, 1024, F.G, F.bx, 512);
              pg8::EpiSig E{G1, 1024, 1.f / 64.f}; pg8::gemm_phase<pg8::EpiSig, pg8::StaticOrder, true, false, true>(F.lds + RING_OFF, g, S, E, F.wave); }
            { RELA(); pg8::Gemm g{(const bf16*)((unsigned char*)F.out + OUT_XB8), (const bf16*)(ws + WS_WB + WB_WG8 + (size_t)1024 * 1024), 512, 512, 512, nullptr}; pg8::StaticOrder S; S.init(NTOK, 1024, F.G, F.bx, 512);
              pg8::EpiSig E{G2, 1024, 1.f / 64.f}; pg8::gemm_phase<pg8::EpiSig, pg8::StaticOrder, true, false, true>(F.lds + RING_OFF, g, S, E, F.wave); }
            VM_WAIT(); __builtin_amdgcn_fence(__ATOMIC_ACQUIRE, "agent"); VM_WAIT();
            { RELA(); pg8::Gemm g{(const bf16*)(ws + WS_YA), (const bf16*)(ws + WS_WB + WB_WBD), 512, 512, 512, nullptr}; pg8::StaticOrder S; S.init(NTOK, 1024, F.G, F.bx, 512);
              pg8::EpiGatedT<false> E{G1, nullptr, MG, 1024}; pg8::gemm_phase<pg8::EpiGatedT<false>, pg8::StaticOrder, true>(F.lds + RING_OFF, g, S, E, F.wave); }
            VM_WAIT(); __builtin_amdgcn_fence(__ATOMIC_ACQUIRE, "agent"); VM_WAIT();
            { RELA(); pg8::Gemm g{(const bf16*)(ws + WS_YB), (const bf16*)(ws + WS_WB + WB_WBS), 512, 512, 512, nullptr}; pg8::StaticOrder S; S.init(NTOK, 1024, F.G, F.bx, 512);
              pg8::EpiGatedT<true> E{G2, MG, MG, 1024}; if (!(DBG & 4)) pg8::gemm_phase<pg8::EpiGatedT<true>, pg8::StaticOrder, true>(F.lds + RING_OFF, g, S, E, F.wave); }
        }
        SEAM(pb + 5);
        if (PHON(6) && IN(pb + 6)) DUPREP(6) { PHASE_ENTER();
            pg8::Gemm g{(const bf16*)(ws + WS_MERGED), (const bf16*)(ws + WS_WB + WB_WO), 1024, 1024, 1024, nullptr}; pg8::StaticOrder S; S.init(NTOK, 1024, F.G, F.bx, 1024);
            pg8::EpiResBf16 E{XB, (bf16*)(ws + WS_PRE1), ALPHA}; pg8::gemm_phase<pg8::EpiResBf16, pg8::StaticOrder, true>(F.lds + RING_OFF, g, S, E, F.wave);
        }
        SEAM(pb + 6);
        if (PHON(7) && IN(pb + 7)) DUPREP(7) { PHASE_ENTER(); ln1_router_phase(F, l); }
        SEAM(pb + 7);
        if (PHON(8) && IN(pb + 8)) DUPREP(8) { PHASE_ENTER(); lists_phase(F, l); }
        SEAM(pb + 8);
        if (PHON(9) && IN(pb + 9)) DUPREP(9) { PHASE_ENTER();
            const int T = build_tile_table(F);
            pg8::Gemm g{(const bf16*)((unsigned char*)F.out + OUT_X1B8), (const bf16*)(ws + WS_WB + WB_WGU), 512, 512, 512, (const int*)(ws + WS_ROUTE + RT_ROW)};
            GroupSched S{2 * T, F.G, F.vcu, 1, (const LAS int*)(F.lds + XTR_OFF), 512L * 512, 256L * 512};
            pg8::EpiGU E{(bf16*)(ws + WS_HG), (const float*)(ws + WS_ROUTE + RT_CW), 1.f / 64.f};
            pg8::gemm_phase<pg8::EpiGU, GroupSched, true, true, true>(F.lds + RING_OFF, g, S, E, F.wave);
        }
        SEAM(pb + 9);
        if (PHON(10) && IN(pb + 10)) DUPREP(10) { PHASE_ENTER();
            const int T = build_tile_table(F);
#ifndef P10SEL
#define P10SEL 7
#endif
            if (P10SEL & 1) { RELA(); pg8::Gemm g{(const bf16*)(ws + WS_HG), (const bf16*)(ws + WS_WB + WB_WD), 256, 256, 256, nullptr};
              GroupSched S{4 * T, F.G, F.vcu, 2, (const LAS int*)(F.lds + XTR_OFF), 1024L * 256, 256L * 256};
              pg8::EpiDown E{(const int*)(ws + WS_ROUTE + RT_ENT), (bf16*)(ws + WS_Y0), (unsigned)(WS_Y1 - WS_Y0)};
              pg8::gemm_phase<pg8::EpiDown, GroupSched, true>(F.lds + RING_OFF, g, S, E, F.wave); }
            if (P10SEL & 4) { RELA(); pg8::Gemm g{(const bf16*)((unsigned char*)F.out + OUT_X1B8), (const bf16*)(ws + WS_WB + WB_WPG), 512, 512, 512, nullptr}; pg8::StaticOrder S; S.init(NTOK, 1024, F.G, F.bx, 512);
              pg8::EpiPle E{(const bf16*)((unsigned char*)F.out + OUT_T1), (bf16*)(ws + WS_PLE), 1.f / 64.f}; pg8::gemm_phase<pg8::EpiPle, pg8::StaticOrder, true, false, true>(F.lds + RING_OFF, g, S, E, F.wave); }
        }
        SEAM(pb + 10);
        if (PHON(11) && IN(pb + 11)) DUPREP(11) { PHASE_ENTER(); ln2_phase(F, l); }
        if (l + 1 < DEPTH) SEAM(pb + 11);
    }
#if IDLEPROBE
    xcd_barrier(bar);
    if (blockIdx.x == 0 && F.tid == 0) { unsigned long long tot = 0; for (int k = 0; k < 23; ++k) if ((IDLEPROBE >> k) & 1) tot += __hip_atomic_load(F.ctl + 12288 + k, RLX_AGENT);
        const unsigned long long t0 = rt(), dur = tot / 256; while (rt() - t0 < dur) __builtin_amdgcn_s_sleep(8); }
#endif
#undef IN
#undef SEAM
}

#if CHK
__global__ void __launch_bounds__(NWAVES * 64, 2) chk_kernel(Args args, int which) {
    extern __shared__ __attribute__((aligned(16))) unsigned char lds[];
    Frame F;
    F.lds = (LAS unsigned char*)lds; F.MISC = (volatile LAS unsigned*)(F.lds + MISC_OFF);
    F.tid = threadIdx.x; F.lane = F.tid & 63; F.wave = __builtin_amdgcn_readfirstlane(F.tid >> 6);
    F.G = gridDim.x; F.bx = blockIdx.x; { const int bx = blockIdx.x; F.vcu = (F.G % 8 == 0) ? (bx % 8) * (F.G / 8) + bx / 8 : bx; }
    F.ws = F.ws0 = args.ws; F.out = F.out0 = args.out; F.ap = &args; F.ctl = (gu32*)(F.ws + WS_CTL);
    if (which == 1) chk_proj(F);
    if (which == 2) chk_attn(F);
    if (which == 4) chk_mask(F);
    if (which == 8) chk_pre1(F);
    if (which == 16) chk_ffn(F);
}
#endif
extern "C" void kernel_launch(void* const* d_in, const int* in_sizes, int n_in, void* d_out, int out_size, void* d_ws, size_t ws_size, hipStream_t stream) {
    static int grid = 0;
    if (grid == 0) {
        if (n_in != 22 || in_sizes[0] != NTOK * DMODEL || out_size != NTOK * DMODEL || ws_size < WS_END) { fprintf(stderr, "kernel_launch: unexpected problem geometry (n_in %d, ws %zu); nothing launched\n", n_in, ws_size); grid = -1; return; }
        int dev = 0, cus = 0, per_cu = 0;
        if (hipGetDevice(&dev) != hipSuccess || hipDeviceGetAttribute(&cus, hipDeviceAttributeMultiprocessorCount, dev) != hipSuccess) { grid = -1; return; }
        if (hipFuncSetAttribute((const void*)skel_fwd, hipFuncAttributeMaxDynamicSharedMemorySize, LDS_BYTES) != hipSuccess) { fprintf(stderr, "kernel_launch: hipFuncSetAttribute failed\n"); grid = -1; return; }
        if (hipOccupancyMaxActiveBlocksPerMultiprocessor(&per_cu, (const void*)skel_fwd, NWAVES * 64, LDS_BYTES) != hipSuccess || per_cu < 1) { fprintf(stderr, "kernel_launch: occupancy query reports %d\n", per_cu); }
        (void)hipGetLastError();
        if (cus < 256) { fprintf(stderr, "kernel_launch: needs 256 CUs (got %d)\n", cus); grid = -1; return; }
        grid = 256;
    }
    if (grid < 0) return;
    if (hipMemsetAsync((char*)d_ws + WS_CTL, 0, CTL_ZERO_BYTES, stream) != hipSuccess) return;
    Args a{};
    for (int i = 0; i < 22; ++i) a.in[i] = d_in[i];
    a.out = (float*)d_out; a.ws = (unsigned char*)d_ws;
#if MK_PER_PHASE
    for (int ph = 0; ph < NPHASE; ++ph) { a.ph_lo = ph; a.ph_hi = ph + 1; hipLaunchKernelGGL(skel_fwd, dim3(grid), dim3(NWAVES * 64), LDS_BYTES, stream, a);
#if CHK
        static bool chk_set = false; if (!chk_set) { (void)hipFuncSetAttribute((const void*)chk_kernel, hipFuncAttributeMaxDynamicSharedMemorySize, LDS_BYTES); chk_set = true; }
        if (ph == 1 && (CHK & 1)) hipLaunchKernelGGL(chk_kernel, dim3(grid), dim3(NWAVES * 64), LDS_BYTES, stream, a, 1);
        if (ph == 3 && (CHK & 2)) hipLaunchKernelGGL(chk_kernel, dim3(grid), dim3(NWAVES * 64), LDS_BYTES, stream, a, 2);
        if (ph == 3 && (CHK & 4)) hipLaunchKernelGGL(chk_kernel, dim3(grid), dim3(NWAVES * 64), LDS_BYTES, stream, a, 4);
        if (ph == 6 && (CHK & 8)) hipLaunchKernelGGL(chk_kernel, dim3(grid), dim3(NWAVES * 64), LDS_BYTES, stream, a, 8);
        if (ph == 10 && (CHK & 16)) hipLaunchKernelGGL(chk_kernel, dim3(grid), dim3(NWAVES * 64), LDS_BYTES, stream, a, 16);
#endif
    }
#else
    a.ph_lo = 0; a.ph_hi = NPHASE;
    hipLaunchKernelGGL(skel_fwd, dim3(grid), dim3(NWAVES * 64), LDS_BYTES, stream, a);
#endif
}
```

```cpp
#include <hip/hip_runtime.h>
#include <hip/hip_bf16.h>
#include <cstdio>
#include <cstdint>
#include <cmath>

__device__ __forceinline__ int ltid(int wave) { int l; asm volatile("v_mbcnt_lo_u32_b32 %0, -1, 0\n\tv_mbcnt_hi_u32_b32 %0, -1, %0" : "=v"(l)); return (wave << 6) | l; }

namespace pg8 {
#define PG8_LAS __attribute__((address_space(3)))
typedef unsigned short bf16_t;
typedef short bf16x8 __attribute__((ext_vector_type(8)));
typedef float f32x4 __attribute__((ext_vector_type(4)));
typedef unsigned u32x4 __attribute__((ext_vector_type(4)));
typedef int i32x4_t __attribute__((ext_vector_type(4)));
typedef int i32x8_t __attribute__((ext_vector_type(8)));
constexpr int BM = 256, BK = 64, HALF = 128, HTB = HALF * BK * 2  , STAGE_BYTES = 8 * HTB, NXCD = 8, WGM = 8;
constexpr float C2 = 0.125f * 1.4426950408889634f;

__host__ __device__ __forceinline__ int lds_byte(int r, int c) { const int st = (r >> 4) * 2 + (c >> 5), rr = r & 15, cc = c & 31, ob = rr * 64 + cc * 2; return st * 1024 + (ob ^ (((ob >> 9) & 1) << 5)); }
__host__ __device__ __forceinline__ void stage_rc(int b, int& R, int& C) { const int st = b / 1024, sb = b % 1024, swz = sb ^ (((sb >> 9) & 1) << 5); R = (st >> 1) * 16 + swz / 64; C = (st & 1) * 32 + (swz % 64) / 2; }
__host__ __device__ __forceinline__ int perm32(int rho) { const int n = rho >> 4, i = rho & 15; return 8 * (i >> 2) + 4 * n + (i & 3); }

struct Unit { int pm, pn; long boff; };
struct Gemm { const bf16_t* A; const bf16_t* Bt; int K, lda, ldb; const int* rows; };

struct StaticOrder {
    int nM, nN, nwg, G, c, ldb;
    __device__ void init(int M, int N, int G_, int c_, int ldb_) { nM = M / BM; nN = N / BM; nwg = nM * nN; G = G_; c = c_; ldb = ldb_; }
    __device__ bool next(int i, Unit& u) const {
        const long L = (long)i * G + c; if (L >= nwg) return false;
        int wgid = (int)L; { const int q = nwg / NXCD, r = nwg % NXCD, xcd = wgid % NXCD, off = wgid / NXCD; wgid = (xcd < r ? xcd * (q + 1) : r * (q + 1) + (xcd - r) * q) + off; }
        const int nig = WGM * nN, gid = wgid / nig, fm = gid * WGM, gsz = (nM - fm) < WGM ? (nM - fm) : WGM;
        u.pm = fm + ((wgid % nig) % gsz); u.pn = (wgid % nig) / gsz; u.boff = (long)u.pn * BM * ldb; return true;
    }
};

__device__ __forceinline__ unsigned cvt_pk_bf16(float lo, float hi) { unsigned r; asm volatile("v_cvt_pk_bf16_f32 %0, %1, %2" : "=v"(r) : "v"(lo), "v"(hi)); return r; }
__device__ __forceinline__ float bf_lo(unsigned w) { return __uint_as_float(w << 16); }
__device__ __forceinline__ float bf_hi(unsigned w) { return __uint_as_float(w & 0xffff0000u); }
__device__ __forceinline__ float sigm(float x) { return __builtin_amdgcn_rcpf(1.f + __builtin_amdgcn_exp2f(-1.4426950408889634f * x)); }
__device__ __forceinline__ u32x4 pack8(f32x4 a, f32x4 b) { u32x4 w; w.x = cvt_pk_bf16(a[0], a[1]); w.y = cvt_pk_bf16(a[2], a[3]); w.z = cvt_pk_bf16(b[0], b[1]); w.w = cvt_pk_bf16(b[2], b[3]); return w; }
__device__ __forceinline__ void unpack8(u32x4 w, f32x4& a, f32x4& b) { a = (f32x4){bf_lo(w.x), bf_hi(w.x), bf_lo(w.y), bf_hi(w.y)}; b = (f32x4){bf_lo(w.z), bf_hi(w.z), bf_lo(w.w), bf_hi(w.w)}; }

#define PG8_EPI_ARGS const f32x4 (&acc)[2][2][4][2], const Unit& u, int wr, int wc, int fr, int fq

#define PG8_PIN(x) asm volatile("" : "+v"(x))
template <class T> __device__ __forceinline__ T& at(const void* base, unsigned byteoff) { return *(T*)((char*)base + byteoff); }

__device__ __forceinline__ float xor16(float v, int fq) { const auto r = __builtin_amdgcn_permlane16_swap(__float_as_uint(v), __float_as_uint(v), false, false); return __uint_as_float((fq & 1) ? r[0] : r[1]); }
struct EpiProj {
    bf16_t* base; size_t tstride; bf16_t* IK; float* IW; const float* rope;
    __device__ __forceinline__ void operator()(PG8_EPI_ARGS) const {
        const int pn = u.pn, row0 = u.pm * BM + wr * 64 + fr;
        if (pn < 14) {
            const int t = pn >> 1;
            bf16_t* dst = base + (size_t)t * tstride;
            const bool rp = (t == 0) | (t == 1) | (t == 3) | (t == 4) | (t == 6);
            const float sc = (t == 0 || t == 3) ? C2 : (t == 6 ? 0.125f : 1.f);
            const bool rotw = rp && ((wc & 1) == 0);
            const unsigned cb = (unsigned)((pn & 1) * 256 + wc * 32 + 8 * fq) * 2u;
            constexpr int RB = 2; f32x4 rq[RB][4];
#define PG8_RP_LD(it) do { if (rotw) { unsigned r_ = (unsigned)(row0 + ((it) >> 2) * HALF + ((it) & 3) * 16); PG8_PIN(r_); \
                rq[(it) % RB][0] = at<const f32x4>(rope, r_ * 64u); rq[(it) % RB][1] = at<const f32x4>(rope, r_ * 64u + 16u); rq[(it) % RB][2] = at<const f32x4>(rope, r_ * 64u + 32u); rq[(it) % RB][3] = at<const f32x4>(rope, r_ * 64u + 48u); } } while (0)
#pragma unroll
            for (int it = 0; it < RB; ++it) PG8_RP_LD(it);
#pragma unroll
            for (int ai = 0; ai < 2; ++ai)
#pragma unroll
                for (int m = 0; m < 4; ++m) { const int it = ai * 4 + m;
                    unsigned row = (unsigned)(row0 + ai * HALF + m * 16); PG8_PIN(row);
                    f32x4 c0 = {1.f, 1.f, 1.f, 1.f}, c1 = c0, s0 = {0.f, 0.f, 0.f, 0.f}, s1 = s0;
                    if (rotw) { c0 = rq[it % RB][0]; c1 = rq[it % RB][1]; s0 = rq[it % RB][2]; s1 = rq[it % RB][3]; }
                    if (it + RB < 8) PG8_RP_LD(it + RB);
#pragma unroll
                    for (int bj = 0; bj < 2; ++bj) {
                        f32x4 v0 = acc[ai][bj][m][0], v1 = acc[ai][bj][m][1];
                        if (rotw) {
                            f32x4 p0, p1;
#pragma unroll
                            for (int i = 0; i < 4; ++i) { p0[i] = xor16(v0[i], fq); p1[i] = xor16(v1[i], fq); }
                            const float sg = (fq == 0) ? -1.f : 1.f;
                            const f32x4 r0 = v0 * c0 + (p0 * s0) * sg, r1 = v1 * c1 + (p1 * s1) * sg;
                            if (fq < 2) { v0 = r0; v1 = r1; }
                        }
                        v0 = v0 * sc; v1 = v1 * sc;
                        at<u32x4>(dst, row * 1024u + cb + bj * 256u) = pack8(v0, v1);
                    }
                    asm volatile("" ::: "memory");
                }
#undef PG8_RP_LD
        } else {
#pragma unroll
            for (int ai = 0; ai < 2; ++ai)
#pragma unroll
                for (int m = 0; m < 4; ++m) {
                    unsigned row = (unsigned)(row0 + ai * HALF + m * 16); PG8_PIN(row);
                    f32x4 v0 = acc[ai][0][m][0], v1 = acc[ai][0][m][1];
                    if (wc == 0) {
                        const f32x4 c0 = at<const f32x4>(rope, row * 64u), c1 = at<const f32x4>(rope, row * 64u + 16u), s0 = at<const f32x4>(rope, row * 64u + 32u), s1 = at<const f32x4>(rope, row * 64u + 48u);
                        f32x4 p0, p1;
#pragma unroll
                        for (int i = 0; i < 4; ++i) { p0[i] = xor16(v0[i], fq); p1[i] = xor16(v1[i], fq); }
                        const float sg = (fq == 0) ? -1.f : 1.f;
                        const f32x4 r0 = v0 * c0 + (p0 * s0) * sg, r1 = v1 * c1 + (p1 * s1) * sg;
                        if (fq < 2) { v0 = r0; v1 = r1; }
                    }
                    if (wc < 2) at<u32x4>(IK, row * 128u + (unsigned)(wc * 32 + 8 * fq) * 2u) = pack8(v0, v1);
                    else if (wc == 2 && fq == 0) { at<f32x4>(IW, row * 32u) = v0 * 0.35355339059f; at<f32x4>(IW, row * 32u + 16u) = v1 * 0.35355339059f; }
                    asm volatile("" ::: "memory");
                }
        }
    }
};
struct EpiSig {
    unsigned char* out; int ldc; float pre;
    __device__ __forceinline__ void operator()(PG8_EPI_ARGS) const {
        const unsigned o0 = (unsigned)(u.pm * BM + wr * 64 + fr) * 1024u + (unsigned)(u.pn * BM + wc * 32 + 8 * fq);
#pragma unroll
        for (int ai = 0; ai < 2; ++ai)
#pragma unroll
            for (int m = 0; m < 4; ++m) {
                unsigned o = o0 + (unsigned)(ai * HALF + m * 16) * 1024u; PG8_PIN(o);
#pragma unroll
                for (int bj = 0; bj < 2; ++bj) {
                    const f32x4 v0 = acc[ai][bj][m][0], v1 = acc[ai][bj][m][1];
                    unsigned w0 = 0u, w1 = 0u;
#pragma unroll
                    for (int i = 0; i < 4; ++i) { w0 = __builtin_amdgcn_cvt_pk_u8_f32(sigm(v0[i] * pre) * 255.f, i, w0); w1 = __builtin_amdgcn_cvt_pk_u8_f32(sigm(v1[i] * pre) * 255.f, i, w1); }
                    at<unsigned long long>(out, o + bj * 128u) = (unsigned long long)w0 | ((unsigned long long)w1 << 32);
                }
                asm volatile("" ::: "memory");
            }
    }
};
template <bool ADD>
struct EpiGatedT {
    const unsigned char* gate; const bf16_t* addsrc; bf16_t* out; int ldc;
    __device__ __forceinline__ void operator()(PG8_EPI_ARGS) const {
        const unsigned o0 = ((unsigned)(u.pm * BM + wr * 64 + fr) * 1024u + (unsigned)(u.pn * BM + wc * 32 + 8 * fq)) * 2u;
        constexpr int NB = 2;
        unsigned long long gq[NB][2]; u32x4 aq[ADD ? NB : 1][2];
#define PG8_GT_LD(it) do { unsigned o_ = o0 + (unsigned)(((it) >> 2) * HALF + ((it) & 3) * 16) * 2048u; PG8_PIN(o_); \
            gq[(it) % NB][0] = at<const unsigned long long>(gate, o_ >> 1); gq[(it) % NB][1] = at<const unsigned long long>(gate, (o_ >> 1) + 128u); \
            if constexpr (ADD) { aq[(it) % NB][0] = at<const u32x4>(addsrc, o_); aq[(it) % NB][1] = at<const u32x4>(addsrc, o_ + 256u); } } while (0)
#pragma unroll
        for (int it = 0; it < NB; ++it) PG8_GT_LD(it);
#pragma unroll
        for (int it = 0; it < 8; ++it) { const int ai = it >> 2, m = it & 3;
                unsigned o = o0 + (unsigned)(ai * HALF + m * 16) * 2048u; PG8_PIN(o);
                f32x4 v0[2], v1[2];
#pragma unroll
                for (int bj = 0; bj < 2; ++bj) {
                    const unsigned long long gw = gq[it % NB][bj]; const unsigned glo = (unsigned)gw, ghi = (unsigned)(gw >> 32); constexpr float K8 = 1.f / 255.f;
                    const f32x4 g0 = {(float)(glo & 0xffu) * K8, (float)((glo >> 8) & 0xffu) * K8, (float)((glo >> 16) & 0xffu) * K8, (float)(glo >> 24) * K8};
                    const f32x4 g1 = {(float)(ghi & 0xffu) * K8, (float)((ghi >> 8) & 0xffu) * K8, (float)((ghi >> 16) & 0xffu) * K8, (float)(ghi >> 24) * K8};
                    v0[bj] = acc[ai][bj][m][0] * g0; v1[bj] = acc[ai][bj][m][1] * g1;
                    if constexpr (ADD) { f32x4 a0, a1; unpack8(aq[it % NB][bj], a0, a1); v0[bj] = v0[bj] + a0; v1[bj] = v1[bj] + a1; }
                }
                if (it + NB < 8) PG8_GT_LD(it + NB);
#pragma unroll
                for (int bj = 0; bj < 2; ++bj) at<u32x4>(out, o + bj * 256u) = pack8(v0[bj], v1[bj]);
                asm volatile("" ::: "memory");
            }
#undef PG8_GT_LD
    }
};
struct EpiResBf16 {
    const bf16_t* x; bf16_t* out; float alpha;
    __device__ __forceinline__ void operator()(PG8_EPI_ARGS) const {
        const unsigned o0 = ((unsigned)(u.pm * BM + wr * 64 + fr) * 1024u + (unsigned)(u.pn * BM + wc * 32 + 8 * fq)) * 2u;
        u32x4 xq[8][2];
#define PG8_X_LD(buf, it) do { unsigned o_ = o0 + (unsigned)(((it) >> 2) * HALF + ((it) & 3) * 16) * 2048u; PG8_PIN(o_); \
            xq[buf][0] = at<const u32x4>(x, o_); xq[buf][1] = at<const u32x4>(x, o_ + 256u); } while (0)
#pragma unroll
        for (int it = 0; it < 8; ++it) PG8_X_LD(it, it);
#pragma unroll
        for (int it = 0; it < 8; ++it) { const int ai = it >> 2, m = it & 3;
                unsigned o = o0 + (unsigned)(ai * HALF + m * 16) * 2048u; PG8_PIN(o);
#pragma unroll
                for (int bj = 0; bj < 2; ++bj) { f32x4 x0, x1; unpack8(xq[it][bj], x0, x1);
                    at<u32x4>(out, o + bj * 256u) = pack8(x0 * alpha + acc[ai][bj][m][0], x1 * alpha + acc[ai][bj][m][1]); }
                asm volatile("" ::: "memory");
            }
#undef PG8_X_LD
    }
};
struct EpiGU {
    bf16_t* HG; const float* cw; float pre;
    __device__ __forceinline__ void operator()(PG8_EPI_ARGS) const {
        const int row0 = u.pm * BM + wr * 64 + fr; const unsigned cb = (unsigned)(u.pn * HALF + wc * 32 + 8 * fq) * 2u;
        float cv[8];
#pragma unroll
        for (int it = 0; it < 8; ++it) cv[it] = at<const float>(cw, (unsigned)(row0 + (it >> 2) * HALF + (it & 3) * 16) * 4u);
#pragma unroll
        for (int it = 0; it < 8; ++it) { const int ai = it >> 2, m = it & 3;
                unsigned row = (unsigned)(row0 + ai * HALF + m * 16); PG8_PIN(row);
                const float c = cv[it];
                f32x4 g0 = acc[ai][0][m][0] * pre, g1 = acc[ai][0][m][1] * pre; const f32x4 u0 = acc[ai][1][m][0] * pre, u1 = acc[ai][1][m][1] * pre;
#pragma unroll
                for (int i = 0; i < 4; ++i) { g0[i] = g0[i] * sigm(g0[i]) * u0[i] * c; g1[i] = g1[i] * sigm(g1[i]) * u1[i] * c; }
                at<u32x4>(HG, row * 512u + cb) = pack8(g0, g1);
                asm volatile("" ::: "memory");
            }
    }
};
struct EpiDown {
    const int* ent; bf16_t* Y0; unsigned ystride;
    __device__ __forceinline__ void operator()(PG8_EPI_ARGS) const {
        const int row0 = u.pm * BM + wr * 64 + fr; const unsigned cb = (unsigned)(u.pn * BM + wc * 32 + 8 * fq) * 2u;
        int ev[8];
#pragma unroll
        for (int it = 0; it < 8; ++it) ev[it] = at<const int>(ent, (unsigned)(row0 + (it >> 2) * HALF + (it & 3) * 16) * 4u);
#pragma unroll
        for (int it = 0; it < 8; ++it) { const int ai = it >> 2, m = it & 3; const int e = ev[it];
                if (e >= 0) { unsigned o = (unsigned)(e >> 1) * 2048u + cb + (unsigned)(e & 1) * ystride; PG8_PIN(o);
#pragma unroll
                    for (int bj = 0; bj < 2; ++bj) at<u32x4>(Y0, o + bj * 256u) = pack8(acc[ai][bj][m][0], acc[ai][bj][m][1]); }
                asm volatile("" ::: "memory");
            }
    }
};
struct EpiStore {
    bf16_t* out; int ldc;
    __device__ __forceinline__ void operator()(PG8_EPI_ARGS) const {
        const unsigned o0 = ((unsigned)(u.pm * BM + wr * 64 + fr) * 1024u + (unsigned)(u.pn * BM + wc * 32 + 8 * fq)) * 2u;
#pragma unroll
        for (int ai = 0; ai < 2; ++ai)
#pragma unroll
            for (int m = 0; m < 4; ++m) {
                unsigned o = o0 + (unsigned)(ai * HALF + m * 16) * 2048u; PG8_PIN(o);
#pragma unroll
                for (int bj = 0; bj < 2; ++bj) at<u32x4>(out, o + bj * 256u) = pack8(acc[ai][bj][m][0], acc[ai][bj][m][1]);
                asm volatile("" ::: "memory");
            }
    }
};
struct EpiPle {
    const bf16_t* t1; bf16_t* out; float pre;
    __device__ __forceinline__ void operator()(PG8_EPI_ARGS) const {
        const unsigned o0 = ((unsigned)(u.pm * BM + wr * 64 + fr) * 1024u + (unsigned)(u.pn * BM + wc * 32 + 8 * fq)) * 2u;
        u32x4 tq[8][2];
#define PG8_T_LD(buf, it) do { unsigned o_ = o0 + (unsigned)(((it) >> 2) * HALF + ((it) & 3) * 16) * 2048u; PG8_PIN(o_); \
            tq[buf][0] = at<const u32x4>(t1, o_); tq[buf][1] = at<const u32x4>(t1, o_ + 256u); } while (0)
#pragma unroll
        for (int it = 0; it < 8; ++it) PG8_T_LD(it, it);
#pragma unroll
        for (int it = 0; it < 8; ++it) { const int ai = it >> 2, m = it & 3;
                unsigned o = o0 + (unsigned)(ai * HALF + m * 16) * 2048u; PG8_PIN(o);
#pragma unroll
                for (int bj = 0; bj < 2; ++bj) {
                    f32x4 t0, t1v; unpack8(tq[it][bj], t0, t1v);
                    f32x4 v0 = acc[ai][bj][m][0], v1 = acc[ai][bj][m][1];
#pragma unroll
                    for (int i = 0; i < 4; ++i) { v0[i] = sigm(v0[i] * pre) * t0[i]; v1[i] = sigm(v1[i] * pre) * t1v[i]; }
                    at<u32x4>(out, o + bj * 256u) = pack8(v0, v1);
                }
                asm volatile("" ::: "memory");
            }
#undef PG8_T_LD
    }
};

template <class Epi, class Sched, bool ALIGN_EPI, bool GATHER = false, bool FP8 = false>
__device__ __forceinline__ void gemm_phase(PG8_LAS unsigned char* lds, const Gemm g, const Sched& S, const Epi& E, int wave_in) {
    const int tid = ltid(wave_in), wid = __builtin_amdgcn_readfirstlane(tid >> 6), lane = tid & 63, wr = wid >> 2, wc = wid & 3, fr = lane & 15, fq = lane >> 4;
    int K_ = g.K; asm volatile("" : "+s"(K_));
    const int K = K_, nt = K / BK;
    int RA[2], CA[2]; unsigned voffB[2], voffA[2];
#pragma unroll
    for (int i = 0; i < 2; ++i) { int R, C; stage_rc(tid * 16 + i * 8192, R, C); const int Rb = (R & ~31) + perm32(R & 31); RA[i] = R; CA[i] = C; voffB[i] = (unsigned)(Rb * g.ldb + C) * 2u; voffA[i] = (unsigned)(R * g.lda + C) * 2u; }
    const size_t hstepA = (size_t)HALF * g.lda * 2;
    const size_t kstep = (size_t)(BK * 2);
    const size_t hstepB = (size_t)HALF * g.ldb * 2;
    const unsigned ldsw = (unsigned)wid * 1024u;
    const int aoff = lds_byte(wr * 64 + fr, fq * 8), boff = lds_byte(wc * 32 + fr, fq * 8);
    const char* Ab = (const char*)g.A;
#define PG8_SA(b, h) (((b) * 2 + (h)) * HTB)
#define PG8_SB(b, h) ((4 + (b) * 2 + (h)) * HTB)
#define PG8_STAGE_A(bufoff, kb, OFF, h) do { _Pragma("unroll") for (int _i = 0; _i < 2; ++_i) { const char* _p; \
        if constexpr (GATHER) _p = Ab + (kb) + (OFF##_v)[h][_i]; else _p = Ab + ((kb) + (OFF##_u) + (size_t)(h) * hstepA) + voffA[_i]; \
        __builtin_amdgcn_global_load_lds((const unsigned*)_p, (PG8_LAS unsigned*)(lds + (bufoff) + ldsw + _i * 8192), 16, 0, 0); } } while (0)
#define PG8_STAGE_B(bufoff, gbase) do { _Pragma("unroll") for (int _i = 0; _i < 2; ++_i) \
        __builtin_amdgcn_global_load_lds((const unsigned*)((const char*)(gbase) + voffB[_i]), (PG8_LAS unsigned*)(lds + (bufoff) + ldsw + _i * 8192), 16, 0, 0); } while (0)
#define PG8_MKOFF(uu, OFF) do { if constexpr (GATHER) { _Pragma("unroll") for (int _h = 0; _h < 2; ++_h) _Pragma("unroll") for (int _i = 0; _i < 2; ++_i) { \
        const int _row = g.rows[(uu).pm * BM + _h * HALF + RA[_i]]; (OFF##_v)[_h][_i] = (unsigned)(_row * g.lda + CA[_i]) * 2u; } } else { OFF##_u = (size_t)(uu).pm * BM * g.lda * 2; } } while (0)
#define PG8_LDA(dst, b, h) do { _Pragma("unroll") for (int m = 0; m < 4; ++m) { if constexpr (FP8) { dst##8[m].lo = *(const PG8_LAS i32x4_t*)(lds + PG8_SA(b, h) + aoff + m * 2048); dst##8[m].hi = *(const PG8_LAS i32x4_t*)(lds + PG8_SA(b, h) + aoff + m * 2048 + 1024); } \
        else { _Pragma("unroll") for (int k = 0; k < 2; ++k) dst[m][k] = *(const PG8_LAS bf16x8*)(lds + PG8_SA(b, h) + aoff + m * 2048 + k * 1024); } } } while (0)
#define PG8_LDB(dst, b, h) do { _Pragma("unroll") for (int n = 0; n < 2; ++n) { if constexpr (FP8) { dst##8[n].lo = *(const PG8_LAS i32x4_t*)(lds + PG8_SB(b, h) + boff + n * 2048); dst##8[n].hi = *(const PG8_LAS i32x4_t*)(lds + PG8_SB(b, h) + boff + n * 2048 + 1024); } \
        else { _Pragma("unroll") for (int k = 0; k < 2; ++k) dst[n][k] = *(const PG8_LAS bf16x8*)(lds + PG8_SB(b, h) + boff + n * 2048 + k * 1024); } } } while (0)
#define PG8_MMA(ai, bj, At, Bt) do { __builtin_amdgcn_s_setprio(1); \
        if constexpr (FP8) { _Pragma("unroll") for (int m = 0; m < 4; ++m) _Pragma("unroll") for (int n = 0; n < 2; ++n) \
            asm volatile("v_mfma_f32_16x16x128_f8f6f4 %0, %1, %2, %0" : "+v"(acc[ai][bj][m][n]) : "v"(Bt##8[n]), "v"(At##8[m])); }   \
        else { _Pragma("unroll") for (int m = 0; m < 4; ++m) _Pragma("unroll") for (int n = 0; n < 2; ++n) _Pragma("unroll") for (int k = 0; k < 2; ++k) \
            acc[ai][bj][m][n] = __builtin_amdgcn_mfma_f32_16x16x32_bf16(Bt[n][k], At[m][k], acc[ai][bj][m][n], 0, 0, 0); } __builtin_amdgcn_s_setprio(0); } while (0)
#define PG8_WAIT_V(n) asm volatile("s_waitcnt vmcnt(" #n ")" ::: "memory")
#define PG8_WAIT_L(n) asm volatile("s_waitcnt lgkmcnt(" #n ")" ::: "memory")
#define PG8_BAR __builtin_amdgcn_s_barrier()
#define PG8_SCHED __builtin_amdgcn_sched_barrier(0)
    Unit cur, nxt; int ui = 0;
    if (!S.next(0, cur)) return;
    f32x4 acc[2][2][4][2];
#pragma unroll
    for (int a = 0; a < 2; ++a)
#pragma unroll
        for (int b = 0; b < 2; ++b)
#pragma unroll
            for (int m = 0; m < 4; ++m)
#pragma unroll
                for (int n = 0; n < 2; ++n) acc[a][b][m][n] = (f32x4){0.f, 0.f, 0.f, 0.f};
    bf16x8 At[4][2], B0[2][2], B1[2][2];
    i32x8_t At8[4], B08[2], B18[2];
    unsigned offAc_v[2][2], offAn_v[2][2]; size_t offAc_u = 0, offAn_u = 0;
    PG8_MKOFF(cur, offAc);
    const char* cB = (const char*)(g.Bt + cur.boff);
    PG8_STAGE_B(PG8_SB(0, 0), cB); PG8_STAGE_B(PG8_SB(0, 1), cB + hstepB); PG8_STAGE_A(PG8_SA(0, 0), 0, offAc, 0); PG8_STAGE_A(PG8_SA(0, 1), 0, offAc, 1);
    if (wr == 1) PG8_BAR;
    PG8_WAIT_V(2); PG8_BAR;
    PG8_STAGE_B(PG8_SB(1, 0), cB + kstep); PG8_STAGE_A(PG8_SA(1, 0), kstep, offAc, 0); PG8_STAGE_B(PG8_SB(1, 1), cB + hstepB + kstep);
    PG8_WAIT_V(6); PG8_BAR;
    for (;;) {
        const bool has_next = S.next(ui + 1, nxt);
        if (has_next) { PG8_MKOFF(nxt, offAn); }
        else { offAn_u = offAc_u;
#pragma unroll
            for (int h = 0; h < 2; ++h)
#pragma unroll
                for (int i = 0; i < 2; ++i) offAn_v[h][i] = offAc_v[h][i];
        }
        const char* nB = has_next ? (const char*)(g.Bt + nxt.boff) : cB;
        for (int t = 0; t < nt; t += 2) {
            const bool last = (t == nt - 2);
            const size_t a1k = (size_t)(t + 1) * kstep;
            const size_t a2k = last ? (size_t)0 : (size_t)(t + 2) * kstep; const char* b2 = last ? nB : cB + (size_t)(t + 2) * kstep;
            const size_t a3k = a2k + kstep; const char* b3 = b2 + kstep;
            unsigned o2_v[2][2]; const size_t o2_u = last ? offAn_u : offAc_u;
#pragma unroll
            for (int h = 0; h < 2; ++h)
#pragma unroll
                for (int i = 0; i < 2; ++i) o2_v[h][i] = last ? offAn_v[h][i] : offAc_v[h][i];
            PG8_LDB(B0, 0, 0); PG8_LDB(B1, 0, 1); PG8_SCHED; PG8_LDA(At, 0, 0); PG8_STAGE_A(PG8_SA(1, 1), a1k, offAc, 1);
            PG8_WAIT_V(8); PG8_WAIT_L(0); PG8_BAR; PG8_MMA(0, 0, At, B0); PG8_MMA(0, 1, At, B1); PG8_BAR; PG8_SCHED;
            PG8_LDA(At, 0, 1); PG8_STAGE_B(PG8_SB(0, 0), b2); PG8_STAGE_B(PG8_SB(0, 1), b2 + hstepB); PG8_STAGE_A(PG8_SA(0, 0), a2k, o2, 0);
            PG8_WAIT_V(8); PG8_WAIT_L(0); PG8_BAR; PG8_MMA(1, 0, At, B0); PG8_MMA(1, 1, At, B1); PG8_BAR; PG8_SCHED;
            PG8_LDB(B0, 1, 0); PG8_LDB(B1, 1, 1); PG8_SCHED; PG8_LDA(At, 1, 0); PG8_STAGE_A(PG8_SA(0, 1), a2k, o2, 1);
            PG8_WAIT_V(8); PG8_WAIT_L(0); PG8_BAR; PG8_MMA(0, 0, At, B0); PG8_MMA(0, 1, At, B1); PG8_BAR; PG8_SCHED;
            PG8_LDA(At, 1, 1); PG8_STAGE_B(PG8_SB(1, 0), b3); PG8_STAGE_B(PG8_SB(1, 1), b3 + hstepB); PG8_STAGE_A(PG8_SA(1, 0), a3k, o2, 0);
            PG8_WAIT_V(8); PG8_WAIT_L(0); PG8_BAR; PG8_MMA(1, 0, At, B0); PG8_MMA(1, 1, At, B1); PG8_BAR; PG8_SCHED;
        }
        if constexpr (ALIGN_EPI) { if (wr == 0) PG8_BAR; }
        if constexpr (FP8) asm volatile("s_nop 15\n\ts_nop 15\n\ts_nop 7" ::: "memory");
        E(acc, cur, wr, wc, fr, fq);
        if (!has_next) break;
#pragma unroll
        for (int a = 0; a < 2; ++a)
#pragma unroll
            for (int b = 0; b < 2; ++b)
#pragma unroll
                for (int m = 0; m < 4; ++m)
#pragma unroll
                    for (int n = 0; n < 2; ++n) acc[a][b][m][n] = (f32x4){0.f, 0.f, 0.f, 0.f};
        cur = nxt; cB = nB; ++ui; offAc_u = offAn_u;
#pragma unroll
        for (int h = 0; h < 2; ++h)
#pragma unroll
            for (int i = 0; i < 2; ++i) offAc_v[h][i] = offAn_v[h][i];
        if constexpr (ALIGN_EPI) { if (wr == 1) PG8_BAR; }
    }
    PG8_WAIT_V(0);
    if constexpr (!ALIGN_EPI) { if (wr == 0) PG8_BAR; }
    PG8_BAR;
#undef PG8_SA
#undef PG8_SB
#undef PG8_STAGE_A
#undef PG8_STAGE_B
#undef PG8_MKOFF
#undef PG8_LDA
#undef PG8_LDB
#undef PG8_MMA
#undef PG8_WAIT_V
#undef PG8_WAIT_L
#undef PG8_BAR
#undef PG8_SCHED
}
}
namespace attn_body {
using bf16=__hip_bfloat16;
using bf16x8=__attribute__((ext_vector_type(8)))short;
using s16x4=__attribute__((ext_vector_type(4)))short;
using f32x16=__attribute__((ext_vector_type(16)))float;
using u32x4=__attribute__((ext_vector_type(4)))unsigned;
using f32x4v=__attribute__((ext_vector_type(4)))float;
constexpr int BATCH=2,SEQ=16384,D=64,DM=512;
constexpr int NW=8,QBLK=32,QB=QBLK*NW,KVBLK=64,NQB=SEQ/QB;
constexpr int ATTN_PITCH=DM, ATTN_UNIT_ROWS=QB;
__device__ __forceinline__ int crow(int r,int hi){return (r&3)+8*(r>>2)+4*hi;}
#define SBAR() __builtin_amdgcn_sched_barrier(0)
__device__ __forceinline__ void cmask(f32x16&p0,f32x16&p1,int jb,int qrel,int hi){
  const float NEG=-INFINITY; int kb=64*jb+4*hi;
  #pragma unroll
  for(int r=0;r<16;++r){int kv=kb+(r&3)+8*(r>>2); if(kv>qrel)p0[r]=NEG; if(kv+32>qrel)p1[r]=NEG;}
}

constexpr int NSLOT=3, SLOTB=8192;
constexpr int LDS_K=0, LDS_V=NSLOT*SLOTB, LDS_WS=2*NSLOT*SLOTB, LDS_OST=LDS_WS+NW*64*4, LDS_MK=LDS_OST+NW*4096, LDS_BYTES=LDS_MK+NW*1024, LDS_BYTES_WIDE=LDS_V+NSLOT*2*SLOTB+NW*64*4+NW*4096;
constexpr float C2=0.125f*1.4426950408889634f;
__device__ __forceinline__ void glds16(const void*gsrc,unsigned lds_dst){unsigned keep;
  asm volatile("s_mov_b32 %0, m0\n\ts_mov_b32 m0, %2\n\ts_nop 0\n\tglobal_load_lds_dwordx4 %1, off\n\ts_mov_b32 m0, %0":"=&s"(keep):"v"(gsrc),"s"(lds_dst):"memory");}
__device__ __forceinline__ float max3f(float a,float b,float c){float r;asm("v_max3_f32 %0, %1, %2, %3":"=v"(r):"v"(a),"v"(b),"v"(c));return r;}
__device__ __forceinline__ float max2f(float a,float b){float r;asm("v_max_f32_e32 %0, %1, %2":"=v"(r):"v"(a),"v"(b));return r;}
__device__ __forceinline__ float fadd_s(float a,float b){float r;asm("v_add_f32_e32 %0, %1, %2":"=v"(r):"v"(a),"v"(b));return r;}
__device__ __forceinline__ float fsub_s(float a,float b){float r;asm("v_sub_f32_e32 %0, %1, %2":"=v"(r):"v"(a),"v"(b));return r;}
typedef float f32x2_t __attribute__((ext_vector_type(2))); typedef __bf16 bf16x2_t __attribute__((ext_vector_type(2)));
__device__ __forceinline__ unsigned cvtpk_s(float lo,float hi){f32x2_t v={lo,hi};bf16x2_t b=__builtin_convertvector(v,bf16x2_t);return __builtin_bit_cast(unsigned,b);}
#define WAIT_BAR(N) asm volatile("s_waitcnt vmcnt(" #N ") lgkmcnt(0)\n\ts_barrier":::"memory")

__device__ __forceinline__ void qkt(f32x16&p0,f32x16&p1,const char*Kslot,const bf16x8*qr,const f32x16&ci0,const f32x16&ci1,int r32,int hi){
  const char*kb=Kslot+hi*1024+r32*16;
  #pragma unroll
  for(int d0=0;d0<4;++d0){
    const bf16x8 b0=*reinterpret_cast<const bf16x8*>(kb+d0*2048);
    const bf16x8 b1=*reinterpret_cast<const bf16x8*>(kb+d0*2048+512);
    if(d0==0){p0=__builtin_amdgcn_mfma_f32_32x32x16_bf16(b0,qr[0],ci0,0,0,0);p1=__builtin_amdgcn_mfma_f32_32x32x16_bf16(b1,qr[0],ci1,0,0,0);}
    else{p0=__builtin_amdgcn_mfma_f32_32x32x16_bf16(b0,qr[d0],p0,0,0,0);p1=__builtin_amdgcn_mfma_f32_32x32x16_bf16(b1,qr[d0],p1,0,0,0);}}
}
typedef __attribute__((address_space(3))) const char* lds_cptr;
typedef short v4i16_t __attribute__((ext_vector_type(4)));
__device__ __forceinline__ void kload8(bf16x8*kf,lds_cptr kp){
  kf[0]=*(const __attribute__((address_space(3))) bf16x8*)(kp);      kf[1]=*(const __attribute__((address_space(3))) bf16x8*)(kp+512);
  kf[2]=*(const __attribute__((address_space(3))) bf16x8*)(kp+2048); kf[3]=*(const __attribute__((address_space(3))) bf16x8*)(kp+2560);
  kf[4]=*(const __attribute__((address_space(3))) bf16x8*)(kp+4096); kf[5]=*(const __attribute__((address_space(3))) bf16x8*)(kp+4608);
  kf[6]=*(const __attribute__((address_space(3))) bf16x8*)(kp+6144); kf[7]=*(const __attribute__((address_space(3))) bf16x8*)(kp+6656);
}
__device__ __forceinline__ void kload2(bf16x8*kf,lds_cptr kp,int j){ kf[2*j]=*(const __attribute__((address_space(3))) bf16x8*)(kp+j*2048); kf[2*j+1]=*(const __attribute__((address_space(3))) bf16x8*)(kp+j*2048+512); }
__device__ __forceinline__ s16x4 vtr(lds_cptr p){ return __builtin_bit_cast(s16x4,__builtin_amdgcn_ds_read_tr16_b64_v4i16((__attribute__((address_space(3))) v4i16_t*)p)); }
__device__ __forceinline__ float rowmax(const f32x16&p0,const f32x16&p1){
  float a=max3f(p0[0],p0[1],p1[0]),b=max3f(p0[2],p0[3],p1[1]);a=max3f(a,p1[2],p1[3]);
  #pragma unroll
  for(int r=4;r<16;r+=4){a=max3f(a,p0[r],p0[r+1]);b=max3f(b,p0[r+2],p0[r+3]);a=max3f(a,p1[r],p1[r+1]);b=max3f(b,p1[r+2],p1[r+3]);}
  const float m=max2f(a,b);
  auto rr=__builtin_amdgcn_permlane32_swap(__float_as_uint(m),__float_as_uint(m),false,false);
  return max2f(__uint_as_float(rr[0]),__uint_as_float(rr[1]));
}
__device__ __forceinline__ void pv(f32x16*o,int vb,bf16x8 pa0,bf16x8 pa1,bf16x8 pa2,bf16x8 pa3){
  #pragma unroll
  for(int d0=0;d0<2;++d0){s16x4 lo[4],hi[4];
    #pragma unroll
    for(int ks=0;ks<4;++ks){
      asm volatile("ds_read_b64_tr_b16 %0,%1 offset:%c2":"=&v"(lo[ks]):"v"(vb),"i"(d0*4096+ks*1024):"memory");
      asm volatile("ds_read_b64_tr_b16 %0,%1 offset:%c2":"=&v"(hi[ks]):"v"(vb),"i"(d0*4096+ks*1024+512):"memory");}
    asm volatile("s_waitcnt lgkmcnt(0)":::"memory");SBAR();
    #define PK(k) (bf16x8){lo[k][0],lo[k][1],lo[k][2],lo[k][3],hi[k][0],hi[k][1],hi[k][2],hi[k][3]}
    o[d0]=__builtin_amdgcn_mfma_f32_32x32x16_bf16(pa0,PK(0),o[d0],0,0,0);
    o[d0]=__builtin_amdgcn_mfma_f32_32x32x16_bf16(pa1,PK(1),o[d0],0,0,0);
    o[d0]=__builtin_amdgcn_mfma_f32_32x32x16_bf16(pa2,PK(2),o[d0],0,0,0);
    o[d0]=__builtin_amdgcn_mfma_f32_32x32x16_bf16(pa3,PK(3),o[d0],0,0,0);
    #undef PK
  }
}

#ifndef ATTN_STORE16
#define ATTN_STORE16(p,v) (*(u32x4*)(p)=(v))
#endif
template<int THRL,bool MASKED,bool WIDE,bool NOMAX> __device__ __forceinline__ void attn_unit(int b,int hq,int hv,int qb,const bf16*Q,const bf16*__restrict__ K,const bf16*__restrict__ V,bf16*O,const unsigned long long*__restrict__ MK,char*shm,int wave_in,int badoff){
  const int tid=ltid(wave_in),lane=tid&63,r32=lane&31,hi=lane>>5; const int wid=__builtin_amdgcn_readfirstlane(tid>>6);
  const long rowbase=(long)b*SEQ; const int q0=qb*QB;
  const bf16*Qw=Q+(rowbase+q0+wid*QBLK)*DM+hq*D;
  const bf16*Kh=K+rowbase*DM+hq*D,*Vh=V+rowbase*DM+hv*D;
  constexpr int VSLOT=WIDE?2*SLOTB:SLOTB, L_WS=LDS_V+NSLOT*VSLOT, L_OST=L_WS+NW*64*4, L_MK=L_OST+NW*4096, L_TAB=L_MK+NW*2048;
  #define VS(sl) (WIDE?2*(sl):(sl))
  const unsigned lds0=(unsigned)(uintptr_t)shm;
  float*wsf=(float*)(shm+L_WS)+wid*64;
  const bf16*ksrc=Kh+(long)lane*DM+wid*8;
  const bf16*vsrc=Vh+(long)(16*(wid&3)+(lane>>2))*DM+(wid>>2)*32+(lane&3)*8;
  const unsigned kdst=lds0+LDS_K+wid*1024, vdst=lds0+LDS_V+wid*1024;
  #define DMA_K(t,slot) glds16(ksrc+(long)(t)*KVBLK*DM,(unsigned)__builtin_amdgcn_readfirstlane(kdst+(slot)))
  #define DMA_V(t,slot) do{ glds16(vsrc+(long)(t)*KVBLK*DM,(unsigned)__builtin_amdgcn_readfirstlane(vdst+VS(slot))); if(WIDE){ glds16(vsrc+64+(long)(t)*KVBLK*DM,(unsigned)__builtin_amdgcn_readfirstlane(vdst+VS(slot)+8192)); } }while(0)
  const long mq0=(long)q0+wid*QBLK+2*(lane&15); const unsigned mdst=lds0+L_MK+wid*2048;
  #define DMA_M4(t0) do{ if(MASKED){ const long t_=(long)(t0)+(lane>>4); if(t_<NT){ glds16(MK+(16384L*t_-32L*t_*(t_-1)+mq0-64L*t_),(unsigned)__builtin_amdgcn_readfirstlane(mdst+(((t0)&7)*256))); } } }while(0)
  unsigned mw0=0u,mw1=0u;
  #define MKRD(t) do{ if(MASKED){ const unsigned long long w_=*(const __attribute__((address_space(3))) unsigned long long*)(shm3+L_MK+wid*2048+(((t)&7)*256)+r32*8); mw0=(unsigned)w_; mw1=(unsigned)(w_>>32); } }while(0)
  #define MAND(X,r,MW) do{}while(0)
  bf16x8 aid[2];
  if(MASKED){
    #pragma unroll
    for(int ks=0;ks<2;++ks)
      #pragma unroll
      for(int j=0;j<8;++j) aid[ks][j]=(short)((r32==16*ks+8*hi+j)?0x3F80:0);
  }
  #define TABRD(w,ks) (*(const __attribute__((address_space(3))) bf16x8*)(shm3+L_TAB+((((w)>>(16*(ks)+8*hi))&0xffu)<<4)))
  #define TABL(w,j) (*(const __attribute__((address_space(3))) f32x4v*)(shm3+L_TAB+4096+((((w)>>(8*(j)+4*hi))&0xfu)<<4)))
  #define BIASL(C0,C1) do{ _Pragma("unroll") for(int j_=0;j_<4;++j_){ const f32x4v a_=TABL(mw0,j_), b_=TABL(mw1,j_); \
      C0[4*j_]=a_[0];C0[4*j_+1]=a_[1];C0[4*j_+2]=a_[2];C0[4*j_+3]=a_[3]; C1[4*j_]=b_[0];C1[4*j_+1]=b_[1];C1[4*j_+2]=b_[2];C1[4*j_+3]=b_[3]; } }while(0)
  #define BIAS(C0,C1,CI) do{ const bf16x8 f00_=TABRD(mw0,0),f01_=TABRD(mw0,1),f10_=TABRD(mw1,0),f11_=TABRD(mw1,1); \
    C0=__builtin_amdgcn_mfma_f32_32x32x16_bf16(aid[0],f00_,CI,0,0,0); C1=__builtin_amdgcn_mfma_f32_32x32x16_bf16(aid[0],f10_,CI,0,0,0); \
    C0=__builtin_amdgcn_mfma_f32_32x32x16_bf16(aid[1],f01_,C0,0,0,0); C1=__builtin_amdgcn_mfma_f32_32x32x16_bf16(aid[1],f11_,C1,0,0,0); }while(0)
  const int vb0=(int)(lds0+LDS_V)+((lane>>4)&1)*32+(lane&3)*8+(4*hi+((lane&15)>>2))*64;
  const char*Kbase=shm+LDS_K; bf16x8 kf[8];
  const lds_cptr shm3=(lds_cptr)shm; const lds_cptr kp0=shm3+LDS_K+hi*1024+r32*16; const lds_cptr vp0=shm3+LDS_V+((lane>>4)&1)*32+(lane&3)*8+(4*hi+((lane&15)>>2))*64;
  const int NT=(q0+QB)/KVBLK;
  DMA_M4(0);DMA_K(0,0);DMA_V(0,0);DMA_K(1,SLOTB);
  bf16x8 qr[4];
  #pragma unroll
  for(int d0=0;d0<4;++d0)qr[d0]=*reinterpret_cast<const bf16x8*>(&Qw[(long)r32*DM+d0*16+hi*8]);
  float mhat=0.f,l_reg=0.f;f32x16 o[4];o[0]=f32x16{};o[1]=f32x16{};o[2]=f32x16{};o[3]=f32x16{};f32x16 negm=f32x16{}; if(!WIDE&&!NOMAX){ asm volatile("":"+v"(negm)); }
  const int qrel=wid*QBLK+r32;
  #define CMASK(P0,P1,t) do{int jb_=(t)-(NT-4); if(jb_>=0)cmask(P0,P1,jb_,qrel,hi);}while(0)
  bool resc=false;
  #define START(P0,P1) do{ resc=false; \
    if constexpr(!NOMAX){ const float rm=rowmax(P0,P1); const float dl=rm; mhat=fadd_s(mhat,dl); \
      _Pragma("unroll") for(int r=0;r<16;++r){P0[r]=fsub_s(P0[r],dl);P1[r]=fsub_s(P1[r],dl);} \
      if(!WIDE){ _Pragma("unroll") for(int r=0;r<16;++r)negm[r]=-mhat; asm volatile("":"+v"(negm)); } } \
    _Pragma("unroll") for(int r=0;r<16;++r)P0[r]=__builtin_amdgcn_exp2f(P0[r]); }while(0)
  #define RESC() do{ if constexpr(!NOMAX) if(resc){ asm volatile("s_waitcnt lgkmcnt(0)":::"memory"); \
      _Pragma("unroll") for(int d_=0;d_<(WIDE?4:2);++d_) _Pragma("unroll") for(int r=0;r<16;++r)o[d_][r]*=wsf[crow(r,hi)]; } }while(0)
  f32x16 pA0,pA1,pB0,pB1;
  int sl_prev=0,sl_cur=0,sl_next=SLOTB;
  #define ROT() do{sl_prev=sl_cur;sl_cur=sl_next;sl_next=(sl_next==(NSLOT-1)*SLOTB)?0:sl_next+SLOTB;}while(0)
  DMA_K(2,2*SLOTB); const bool m4b_=MASKED&&(4<NT); if(m4b_){DMA_M4(4);}
  if(WIDE||m4b_){WAIT_BAR(4);}else{WAIT_BAR(3);}
  if(MASKED){ MKRD(0); if constexpr(NOMAX){ BIASL(pA0,pA1); } else { BIAS(pA0,pA1,negm); } qkt(pA0,pA1,Kbase,qr,pA0,pA1,r32,hi); } else { qkt(pA0,pA1,Kbase,qr,negm,negm,r32,hi); }
  asm volatile("s_nop 15\n\ts_nop 7":"+v"(pA0),"+v"(pA1));CMASK(pA0,pA1,0);
  START(pA0,pA1);
  _Pragma("unroll") for(int r=0;r<16;++r)pA1[r]=__builtin_amdgcn_exp2f(pA1[r]);
  WAIT_BAR(0);
  DMA_K(3,0);DMA_V(1,SLOTB);
  ROT();
  kload8(kf,kp0+sl_cur);
  if(WIDE){WAIT_BAR(3);}else{WAIT_BAR(2);}
  s16x4 vlo[8],vhi[8]; u32x4 pw0,pw1,pw2,pw3;
  #define PKW(P,B) cvtpk_s(P[B],P[B+1])
  #define PAF(k) __builtin_bit_cast(bf16x8,pw##k)
  #define VFR(i) (bf16x8){vlo[i][0],vlo[i][1],vlo[i][2],vlo[i][3],vhi[i][0],vhi[i][1],vhi[i][2],vhi[i][3]}
  #define PIN(x) asm volatile("":"+v"(x))
  #define MX3(a,b,c) __builtin_fmaxf(__builtin_fmaxf((a),(b)),(c))
  #define GAPA(MF,A0,A1,A2,A3,W0,W1,PW) do{ MF; sacc+=A0; sacc+=A1; sacc+=A2; sacc+=A3; PIN(sacc); W0; W1; PIN(PW); SBAR(); }while(0)
  #define EX(v) __builtin_amdgcn_exp2f(v)
  #define GAPB(MF,X,B,MW) do{ MF; X[B]=EX(X[B]); X[B+1]=EX(X[B+1]); X[B+2]=EX(X[B+2]); X[B+3]=EX(X[B+3]); MAND(X,B,MW); MAND(X,B+1,MW); MAND(X,B+2,MW); MAND(X,B+3,MW); PIN(X); SBAR(); }while(0)
  #define GAPB2(MF,X,B) do{ MF; X[B]=EX(X[B]); X[B+1]=EX(X[B+1]); PIN(X); SBAR(); }while(0)
  #define VRD(i) do{ vlo[i]=vtr(vp_+(((i)>>2)*4096+((i)&3)*1024)); vhi[i]=vtr(vp_+(((i)>>2)*4096+((i)&3)*1024+512)); }while(0)
  #define KRD(G,j) do{ if(G){ kload2(kf,kp0+sl_next,j); SBAR(); } }while(0)
  #define STEP(C0,C1,P0,P1,t,GK,GV,GL,GM) do{ SBAR(); \
    const lds_cptr vp_=vp0+VS(sl_prev); \
    if(MASKED){ MKRD(t); if constexpr(NOMAX){ BIASL(C0,C1); } else { BIAS(C0,C1,negm); } SBAR(); } \
    VRD(0); SBAR(); float sacc=(P0[0]+P0[1]); \
    GAPA(C0=__builtin_amdgcn_mfma_f32_32x32x16_bf16(kf[0],qr[0],(MASKED?C0:negm),0,0,0), P0[2],P0[3],P0[4],P0[5],     pw0[0]=PKW(P0,0), pw0[1]=PKW(P0,2), pw0); \
    VRD(4); SBAR(); GAPA(C1=__builtin_amdgcn_mfma_f32_32x32x16_bf16(kf[1],qr[0],(MASKED?C1:negm),0,0,0), P0[6],P0[7],P0[8],P0[9],     pw0[2]=PKW(P0,4), pw0[3]=PKW(P0,6), pw0); \
    VRD(1); SBAR(); GAPA(C0=__builtin_amdgcn_mfma_f32_32x32x16_bf16(kf[2],qr[1],C0,0,0,0),   P0[10],P0[11],P0[12],P0[13], pw1[0]=PKW(P0,8), pw1[1]=PKW(P0,10), pw1); \
    VRD(5); SBAR(); GAPA(C1=__builtin_amdgcn_mfma_f32_32x32x16_bf16(kf[3],qr[1],C1,0,0,0),   P0[14],P0[15],P1[0],P1[1],   pw1[2]=PKW(P0,12),pw1[3]=PKW(P0,14), pw1); \
    VRD(2); SBAR(); GAPA(C0=__builtin_amdgcn_mfma_f32_32x32x16_bf16(kf[4],qr[2],C0,0,0,0),   P1[2],P1[3],P1[4],P1[5],     pw2[0]=PKW(P1,0), pw2[1]=PKW(P1,2), pw2); \
    VRD(6); SBAR(); GAPA(C1=__builtin_amdgcn_mfma_f32_32x32x16_bf16(kf[5],qr[2],C1,0,0,0),   P1[6],P1[7],P1[8],P1[9],     pw2[2]=PKW(P1,4), pw2[3]=PKW(P1,6), pw2); \
    VRD(3); SBAR(); GAPA(C0=__builtin_amdgcn_mfma_f32_32x32x16_bf16(kf[6],qr[3],C0,0,0,0),   P1[10],P1[11],P1[12],P1[13], pw3[0]=PKW(P1,8), pw3[1]=PKW(P1,10), pw3); \
    VRD(7); SBAR(); GAPA(C1=__builtin_amdgcn_mfma_f32_32x32x16_bf16(kf[7],qr[3],C1,0,0,0),   P1[14],P1[15],0.f,0.f,       pw3[2]=PKW(P1,12),pw3[3]=PKW(P1,14), pw3); \
    l_reg+=sacc; \
    if(GK){DMA_K((t)+3,sl_cur);} if(GV){DMA_V((t)+1,sl_next);} if(MASKED&&GM){ if((((t)&3)==0)&&((t)+4<NT)){DMA_M4((t)+4);} } \
    CMASK(C0,C1,t); \
    if constexpr(!NOMAX){ float a=MX3(C0[0],C0[1],C1[0]),b=MX3(C0[2],C0[3],C1[1]); a=MX3(a,C1[2],C1[3]); \
      _Pragma("unroll") for(int r=4;r<16;r+=4){a=MX3(a,C0[r],C0[r+1]);b=MX3(b,C0[r+2],C0[r+3]);a=MX3(a,C1[r],C1[r+1]);b=MX3(b,C1[r+2],C1[r+3]);} \
      float rm=__builtin_fmaxf(a,b); { auto rr=__builtin_amdgcn_permlane32_swap(__float_as_uint(rm),__float_as_uint(rm),false,false); rm=__builtin_fmaxf(__uint_as_float(rr[0]),__uint_as_float(rr[1])); } \
      resc=false; \
      if(__builtin_expect(__any(rm>(float)THRL),0)){ const float dl=__builtin_fmaxf(rm,0.f); mhat+=dl; \
        _Pragma("unroll") for(int r=0;r<16;++r){C0[r]-=dl;C1[r]-=dl;} \
        _Pragma("unroll") for(int r=0;r<16;++r)negm[r]=-mhat; asm volatile("":"+v"(negm)); \
        const float f=__builtin_amdgcn_exp2f(-dl); l_reg*=f; if(hi==0)wsf[r32]=f; resc=true; } } \
    SBAR(); \
    GAPB(o[0]=__builtin_amdgcn_mfma_f32_32x32x16_bf16(PAF(0),VFR(0),o[0],0,0,0), C0,0,mw0); \
    GAPB(o[1]=__builtin_amdgcn_mfma_f32_32x32x16_bf16(PAF(0),VFR(4),o[1],0,0,0), C0,4,mw0); \
    KRD(GL,0); GAPB(o[0]=__builtin_amdgcn_mfma_f32_32x32x16_bf16(PAF(1),VFR(1),o[0],0,0,0), C0,8,mw0); \
    KRD(GL,1); GAPB(o[1]=__builtin_amdgcn_mfma_f32_32x32x16_bf16(PAF(1),VFR(5),o[1],0,0,0), C0,12,mw0); \
    KRD(GL,2); GAPB(o[0]=__builtin_amdgcn_mfma_f32_32x32x16_bf16(PAF(2),VFR(2),o[0],0,0,0), C1,0,mw1); \
    KRD(GL,3); GAPB(o[1]=__builtin_amdgcn_mfma_f32_32x32x16_bf16(PAF(2),VFR(6),o[1],0,0,0), C1,4,mw1); \
    GAPB(o[0]=__builtin_amdgcn_mfma_f32_32x32x16_bf16(PAF(3),VFR(3),o[0],0,0,0), C1,8,mw1); \
    GAPB(o[1]=__builtin_amdgcn_mfma_f32_32x32x16_bf16(PAF(3),VFR(7),o[1],0,0,0), C1,12,mw1); \
    }while(0)
  #define VLD(n,f) do{ vlo[(n)&3]=vtr(vp_+(((f)>>2)*4096+((f)&3)*1024)); vhi[(n)&3]=vtr(vp_+(((f)>>2)*4096+((f)&3)*1024+512)); }while(0)
  #define VFW(n) (bf16x8){vlo[(n)&3][0],vlo[(n)&3][1],vlo[(n)&3][2],vlo[(n)&3][3],vhi[(n)&3][0],vhi[(n)&3][1],vhi[(n)&3][2],vhi[(n)&3][3]}
  #define PVN(OD,k,n,fnext) do{ OD=__builtin_amdgcn_mfma_f32_32x32x16_bf16(PAF(k),VFW(n),OD,0,0,0); SBAR(); if((fnext)>=0){ VLD(n,fnext); SBAR(); } }while(0)
  #define STEPW(C0,C1,P0,P1,t,GK,GV,GL) do{ SBAR(); \
    const lds_cptr vp_=vp0+VS(sl_prev); \
    VLD(0,0); SBAR(); float sacc=(P0[0]+P0[1]); f32x16 ci_=f32x16{}; if constexpr(!NOMAX){ const float nm_=-mhat; _Pragma("unroll") for(int r=0;r<16;++r)ci_[r]=nm_; }     \
    GAPA(C0=__builtin_amdgcn_mfma_f32_32x32x16_bf16(kf[0],qr[0],ci_,0,0,0), P0[2],P0[3],P0[4],P0[5],     pw0[0]=PKW(P0,0), pw0[1]=PKW(P0,2), pw0); \
    VLD(1,4); SBAR(); GAPA(C1=__builtin_amdgcn_mfma_f32_32x32x16_bf16(kf[1],qr[0],ci_,0,0,0), P0[6],P0[7],P0[8],P0[9],     pw0[2]=PKW(P0,4), pw0[3]=PKW(P0,6), pw0); \
    VLD(2,1); SBAR(); GAPA(C0=__builtin_amdgcn_mfma_f32_32x32x16_bf16(kf[2],qr[1],C0,0,0,0),   P0[10],P0[11],P0[12],P0[13], pw1[0]=PKW(P0,8), pw1[1]=PKW(P0,10), pw1); \
    VLD(3,5); SBAR(); GAPA(C1=__builtin_amdgcn_mfma_f32_32x32x16_bf16(kf[3],qr[1],C1,0,0,0),   P0[14],P0[15],P1[0],P1[1],   pw1[2]=PKW(P0,12),pw1[3]=PKW(P0,14), pw1); \
    GAPA(C0=__builtin_amdgcn_mfma_f32_32x32x16_bf16(kf[4],qr[2],C0,0,0,0),   P1[2],P1[3],P1[4],P1[5],     pw2[0]=PKW(P1,0), pw2[1]=PKW(P1,2), pw2); \
    GAPA(C1=__builtin_amdgcn_mfma_f32_32x32x16_bf16(kf[5],qr[2],C1,0,0,0),   P1[6],P1[7],P1[8],P1[9],     pw2[2]=PKW(P1,4), pw2[3]=PKW(P1,6), pw2); \
    GAPA(C0=__builtin_amdgcn_mfma_f32_32x32x16_bf16(kf[6],qr[3],C0,0,0,0),   P1[10],P1[11],P1[12],P1[13], pw3[0]=PKW(P1,8), pw3[1]=PKW(P1,10), pw3); \
    GAPA(C1=__builtin_amdgcn_mfma_f32_32x32x16_bf16(kf[7],qr[3],C1,0,0,0),   P1[14],P1[15],0.f,0.f,       pw3[2]=PKW(P1,12),pw3[3]=PKW(P1,14), pw3); \
    l_reg+=sacc; \
    if(GK){DMA_K((t)+3,sl_cur);} if(GV){DMA_V((t)+1,sl_next);} \
    CMASK(C0,C1,t); \
    if constexpr(!NOMAX){ float a=MX3(C0[0],C0[1],C1[0]),b=MX3(C0[2],C0[3],C1[1]); a=MX3(a,C1[2],C1[3]); \
      _Pragma("unroll") for(int r=4;r<16;r+=4){a=MX3(a,C0[r],C0[r+1]);b=MX3(b,C0[r+2],C0[r+3]);a=MX3(a,C1[r],C1[r+1]);b=MX3(b,C1[r+2],C1[r+3]);} \
      float rm=__builtin_fmaxf(a,b); { auto rr=__builtin_amdgcn_permlane32_swap(__float_as_uint(rm),__float_as_uint(rm),false,false); rm=__builtin_fmaxf(__uint_as_float(rr[0]),__uint_as_float(rr[1])); } \
      resc=false; \
      if(__builtin_expect(__any(rm>(float)THRL),0)){ const float dl=__builtin_fmaxf(rm,0.f); mhat+=dl; \
        _Pragma("unroll") for(int r=0;r<16;++r){C0[r]-=dl;C1[r]-=dl;} \
        const float f=__builtin_amdgcn_exp2f(-dl); l_reg*=f; if(hi==0)wsf[r32]=f; resc=true; } } \
    SBAR(); \
    GAPB2(o[0]=__builtin_amdgcn_mfma_f32_32x32x16_bf16(PAF(0),VFW(0),o[0],0,0,0), C0,0); VLD(0,2); SBAR(); \
    GAPB2(o[1]=__builtin_amdgcn_mfma_f32_32x32x16_bf16(PAF(0),VFW(1),o[1],0,0,0), C0,2); VLD(1,6); SBAR(); \
    KRD(GL,0); GAPB2(o[0]=__builtin_amdgcn_mfma_f32_32x32x16_bf16(PAF(1),VFW(2),o[0],0,0,0), C0,4); VLD(2,3); SBAR(); \
    KRD(GL,1); GAPB2(o[1]=__builtin_amdgcn_mfma_f32_32x32x16_bf16(PAF(1),VFW(3),o[1],0,0,0), C0,6); VLD(3,7); SBAR(); \
    KRD(GL,2); GAPB2(o[0]=__builtin_amdgcn_mfma_f32_32x32x16_bf16(PAF(2),VFW(4),o[0],0,0,0), C0,8); VLD(4,8); SBAR(); \
    KRD(GL,3); GAPB2(o[1]=__builtin_amdgcn_mfma_f32_32x32x16_bf16(PAF(2),VFW(5),o[1],0,0,0), C0,10); VLD(5,12); SBAR(); \
    GAPB2(o[0]=__builtin_amdgcn_mfma_f32_32x32x16_bf16(PAF(3),VFW(6),o[0],0,0,0), C0,12); VLD(6,9); SBAR(); \
    GAPB2(o[1]=__builtin_amdgcn_mfma_f32_32x32x16_bf16(PAF(3),VFW(7),o[1],0,0,0), C0,14); VLD(7,13); SBAR(); \
    GAPB2(o[2]=__builtin_amdgcn_mfma_f32_32x32x16_bf16(PAF(0),VFW(8),o[2],0,0,0), C1,0); VLD(8,10); SBAR(); \
    GAPB2(o[3]=__builtin_amdgcn_mfma_f32_32x32x16_bf16(PAF(0),VFW(9),o[3],0,0,0), C1,2); VLD(9,14); SBAR(); \
    GAPB2(o[2]=__builtin_amdgcn_mfma_f32_32x32x16_bf16(PAF(1),VFW(10),o[2],0,0,0), C1,4); VLD(10,11); SBAR(); \
    GAPB2(o[3]=__builtin_amdgcn_mfma_f32_32x32x16_bf16(PAF(1),VFW(11),o[3],0,0,0), C1,6); VLD(11,15); SBAR(); \
    GAPB2(o[2]=__builtin_amdgcn_mfma_f32_32x32x16_bf16(PAF(2),VFW(12),o[2],0,0,0), C1,8); \
    GAPB2(o[3]=__builtin_amdgcn_mfma_f32_32x32x16_bf16(PAF(2),VFW(13),o[3],0,0,0), C1,10); \
    GAPB2(o[2]=__builtin_amdgcn_mfma_f32_32x32x16_bf16(PAF(3),VFW(14),o[2],0,0,0), C1,12); \
    GAPB2(o[3]=__builtin_amdgcn_mfma_f32_32x32x16_bf16(PAF(3),VFW(15),o[3],0,0,0), C1,14); \
    }while(0)
  #define STEPX(C0,C1,P0,P1,t,GK,GV,GL,GM) do{ if constexpr(WIDE){ STEPW(C0,C1,P0,P1,t,GK,GV,GL); } else { STEP(C0,C1,P0,P1,t,GK,GV,GL,GM); } }while(0)
  int t=1;
  #undef CMASK
  #define CMASK(P0,P1,t) do{}while(0)
  for(;t+5<NT;t+=2){
    STEPX(pB0,pB1,pA0,pA1,t,true,true,true,true);     if(WIDE){WAIT_BAR(3);}else{WAIT_BAR(2);} RESC(); ROT();
    STEPX(pA0,pA1,pB0,pB1,t+1,true,true,true,true);   if(WIDE||(MASKED&&(((t+1)&3)==0))){WAIT_BAR(3);}else{WAIT_BAR(2);} RESC(); ROT();
  }
  #undef CMASK
  #define CMASK(P0,P1,t) do{int jb_=(t)-(NT-4); if(jb_>=0)cmask(P0,P1,jb_,qrel,hi);}while(0)
  #define ENDW(tt) do{ if(WIDE){ if((tt)+3<NT){WAIT_BAR(3);} else if((tt)+2<NT){WAIT_BAR(2);} else {WAIT_BAR(0);} } else { if((tt)+3<NT){WAIT_BAR(2);} else if((tt)+2<NT){WAIT_BAR(1);} else {WAIT_BAR(0);} } }while(0)
  for(;t+1<NT;t+=2){
    STEPX(pB0,pB1,pA0,pA1,t,(t+3<NT),(t+1<NT),(t+1<NT),(t+2<NT));       ENDW(t);   RESC(); ROT();
    STEPX(pA0,pA1,pB0,pB1,t+1,(t+4<NT),(t+2<NT),(t+2<NT),(t+3<NT));     ENDW(t+1); RESC(); ROT();
  }
  STEPX(pB0,pB1,pA0,pA1,NT-1,false,false,false,false); RESC();
  { float sacc=pB0[0]+pB0[1]; _Pragma("unroll") for(int r=2;r<16;++r)sacc+=pB0[r]; _Pragma("unroll") for(int r=0;r<16;++r)sacc+=pB1[r]; l_reg+=sacc;
    pw0=(u32x4){PKW(pB0,0),PKW(pB0,2),PKW(pB0,4),PKW(pB0,6)};pw1=(u32x4){PKW(pB0,8),PKW(pB0,10),PKW(pB0,12),PKW(pB0,14)};pw2=(u32x4){PKW(pB1,0),PKW(pB1,2),PKW(pB1,4),PKW(pB1,6)};pw3=(u32x4){PKW(pB1,8),PKW(pB1,10),PKW(pB1,12),PKW(pB1,14)};
    SBAR(); pv(o,vb0+VS(sl_cur),PAF(0),PAF(1),PAF(2),PAF(3)); if(WIDE){ pv(o+2,vb0+VS(sl_cur)+8192,PAF(0),PAF(1),PAF(2),PAF(3)); } }
  #undef PKW
  #undef PAF
  #undef VFR
  #undef PIN
  #undef MX3
  #undef GAPA
  #undef GAPB
  #undef GAPB2
  #undef EX
  #undef VRD
  #undef KRD
  #undef VLD
  #undef VFW
  #undef PVN
  #undef STEPW
  #undef STEPX
  #undef STEP
  #undef ENDW
  {auto rr=__builtin_amdgcn_permlane32_swap(__float_as_uint(l_reg),__float_as_uint(l_reg),false,false);l_reg=__uint_as_float(rr[0])+__uint_as_float(rr[1]);}
  if constexpr(NOMAX){ if(!(l_reg>7.9e-31f&&l_reg<1.2e30f))*(__attribute__((address_space(3))) unsigned*)((__attribute__((address_space(3))) char*)shm+badoff)=1u; }
  if(hi==0)wsf[32+r32]=l_reg;asm volatile("s_waitcnt lgkmcnt(0)":::"memory");
  float rli[16];
  #pragma unroll
  for(int r=0;r<16;++r)rli[r]=__builtin_amdgcn_rcpf(wsf[32+crow(r,hi)]);
  bf16*Ow=O+(rowbase+q0+wid*QBLK)*DM+hv*D;
  #pragma unroll
  for(int hf=0;hf<(WIDE?2:1);++hf){ bf16*stg=(bf16*)(shm+L_OST)+wid*2048;
    #pragma unroll
    for(int r=0;r<16;++r){const int orow=crow(r,hi);
      #pragma unroll
      for(int d0=0;d0<2;++d0)stg[orow*64+d0*32+r32]=__float2bfloat16(o[2*hf+d0][r]*rli[r]);}
    asm volatile("s_waitcnt lgkmcnt(0)":::"memory");
    #pragma unroll
    for(int i=0;i<4;++i){const int row=i*8+(lane>>3),ch=lane&7; const u32x4 v=*(const u32x4*)(stg+row*64+ch*8); ATTN_STORE16(Ow+(long)row*DM+hf*64+ch*8,v);}
    asm volatile("s_waitcnt lgkmcnt(0)":::"memory"); }
  asm volatile("s_waitcnt lgkmcnt(0)\n\ts_barrier":::"memory");
  #undef DMA_K
  #undef DMA_V
  #undef DMA_M4
  #undef MKRD
  #undef MAND
  #undef TABRD
  #undef BIAS
  #undef BIASL
  #undef TABL
  #undef CMASK
  #undef START
  #undef RESC
  #undef ROT
  #undef VS
}
constexpr int ATTN_LDS_BYTES=LDS_BYTES+NW*1024+4096+256;
__device__ __forceinline__ void mask_table_init(char*shm,int tid){
  if(tid<256){ u32x4 v; unsigned e[8];
    #pragma unroll
    for(int j=0;j<8;++j) e[j]=((tid>>j)&1)?0u:0xC400u;
    v.x=e[0]|(e[1]<<16); v.y=e[2]|(e[3]<<16); v.z=e[4]|(e[5]<<16); v.w=e[6]|(e[7]<<16);
    *(u32x4*)(shm+LDS_MK+NW*2048+tid*16)=v;
    if(tid<16){ f32x4v q; q[0]=(tid&1)?0.f:-512.f; q[1]=(tid&2)?0.f:-512.f; q[2]=(tid&4)?0.f:-512.f; q[3]=(tid&8)?0.f:-512.f; *(f32x4v*)(shm+LDS_MK+NW*2048+4096+tid*16)=q; } }
  __syncthreads();
}
#undef SBAR
#undef WAIT_BAR
}

constexpr int NWAVES = 8;
#ifndef MK_PER_PHASE
#define MK_PER_PHASE 0
#endif

#ifndef CHK
#define CHK 0
#endif
constexpr int CW_CHK = 2;
constexpr int BATCH = 2, SEQ = 16384, NTOK = BATCH * SEQ, DMODEL = 1024, DEPTH = 2;
constexpr int WIN_OLD = 5704, WIN_NEW = 5888, P1_N = 3840;
constexpr float LN_EPS = 1e-5f, ALPHA = 1.41421356237f;
constexpr int NPH_LAYER = 12, NPHASE = DEPTH * NPH_LAYER;

constexpr size_t MiB = 1u << 20;
constexpr size_t WS_CTL = 0, CTL_ZERO_BYTES = 1 * MiB;
constexpr size_t WS_SMALL = 1 * MiB, SM_LAM = 0, SM_WR = 4096, SM_BR = SM_WR + 2 * 36 * 1024 * 4;
constexpr size_t WS_ROPE = 2 * MiB;
constexpr size_t WS_ROUTE = 4 * MiB, RT_E = 0, RT_C = 256 * 1024, RT_HIST = 512 * 1024, RT_TOT = 544 * 1024, RT_ROW = 576 * 1024, RT_ENT = 864 * 1024, RT_CW = 1152 * 1024;
constexpr int LIST_CAP = 65536 + 32 * 256;
constexpr size_t WS_WB = 6 * MiB;
constexpr size_t WB_WIN = 0, WB_WBD = (size_t)WIN_NEW * 1024 * 2, WB_WBS = WB_WBD + MiB, WB_WO = WB_WBS + MiB, WB_WPG = WB_WO + 2 * MiB, WB_WPLE = WB_WPG + 2 * MiB,
                 WB_WGU = WB_WPLE + MiB / 2, WB_WD = WB_WGU + 32 * MiB, WB_END = WB_WD + 16 * MiB;
static_assert(WB_END == 66 * MiB, "weight copies");
constexpr size_t WB_WG8 = WB_WIN + (size_t)3840 * 1024 * 2;
constexpr size_t WS_XB = 72 * MiB;
constexpr size_t WS_DQ = 136 * MiB, TSTRIDE = 32 * MiB, WS_IK = 360 * MiB, WS_IW = 364 * MiB;
constexpr size_t WS_O0 = 365 * MiB, WS_O1 = 397 * MiB, WS_YB = 429 * MiB, WS_MASK = 461 * MiB;
constexpr long MASK_BSTRIDE = 2105344;
constexpr size_t WS_YA = 136 * MiB, WS_MERGED = 168 * MiB, WS_TMPG = 240 * MiB, WS_PRE1 = 240 * MiB;
constexpr size_t OUT_XB8 = 0, OUT_X1B8 = 32 * MiB, OUT_T1 = 64 * MiB;
constexpr size_t WS_HG = 136 * MiB, WS_PLE = 172 * MiB, WS_Y0 = 368 * MiB, WS_Y1 = 432 * MiB, WS_PB = 496 * MiB, WS_END = 512 * MiB;
static_assert(WS_MASK + 2 * MASK_BSTRIDE * 8 <= WS_PB, "mask fits");
constexpr int CW_TMO = 0, CW_CODE = 1, CW_BAR = 4096, CW_QUEUE = 8192;

constexpr int RING_OFF = 0, RING_BYTES = 131072;
constexpr int XTR_OFF = RING_BYTES, XTR_BYTES = 4096;
constexpr int MISC_OFF = XTR_OFF + XTR_BYTES;
constexpr int LDS_BYTES = 147456;
static_assert(MISC_OFF + 128 <= LDS_BYTES, "LDS map");
#define GAS __attribute__((address_space(1)))
#define LAS __attribute__((address_space(3)))
typedef unsigned short bf16;
typedef unsigned v4u __attribute__((ext_vector_type(4)));
typedef float f32x4 __attribute__((ext_vector_type(4)));
typedef short bf16x8 __attribute__((ext_vector_type(8)));
typedef GAS unsigned gu32;
typedef GAS unsigned long long gu64;
#define RLX_AGENT __ATOMIC_RELAXED, __HIP_MEMORY_SCOPE_AGENT
#define LDS_WAIT() asm volatile("s_waitcnt lgkmcnt(0)" ::: "memory")
#define VM_WAIT() asm volatile("s_waitcnt vmcnt(0)" ::: "memory")
__device__ __forceinline__ unsigned long long rt() { return __builtin_amdgcn_s_memrealtime(); }
__device__ __forceinline__ unsigned f2bf(float f) { unsigned u = __builtin_bit_cast(unsigned, f); return (u + 0x7fffu + ((u >> 16) & 1u)) >> 16; }
__device__ __forceinline__ unsigned pk2(float lo, float hi) { return f2bf(lo) | (f2bf(hi) << 16); }

#define XB_TMO      128
#define XB_XCNT(j)  (256  + 64 * (j))
#define XB_XSUB(j)  (1280 + 64 * (j))
#define XB_XGEN(j)  (2304 + 64 * (j))
#define XB_TOP      3328
#define XB_TOPGEN   3392
#define XCD_BAR_WORDS 3456
#define XB_SPIN_CAP (1u << 18)

__device__ __forceinline__ unsigned xb_ld(unsigned* p)              { return __hip_atomic_load(p, __ATOMIC_RELAXED, __HIP_MEMORY_SCOPE_AGENT); }
__device__ __forceinline__ unsigned xb_add(unsigned* p, unsigned v) { return __hip_atomic_fetch_add(p, v, __ATOMIC_RELAXED, __HIP_MEMORY_SCOPE_AGENT); }
__device__ __forceinline__ unsigned xb_xcc_id() { return (unsigned)__builtin_amdgcn_s_getreg((3 << 11) | 20) & 0xFu; }
#define XB_SPIN(cond, bar) do { unsigned _sp = 0; while (cond) { __builtin_amdgcn_s_sleep(1); \
    if ((++_sp & 255u) == 0u) { if (xb_ld(&(bar)[XB_TMO])) break; if (_sp > XB_SPIN_CAP) { atomicAdd(&(bar)[XB_TMO], 1u); break; } } } } while (0)

struct XcdBarrier {
    unsigned* bar; unsigned x;
    volatile LAS unsigned* st;
};

__device__ __forceinline__ XcdBarrier xcd_barrier_post(unsigned* bar, volatile LAS unsigned* st) {
    XcdBarrier b; b.bar = bar; b.x = xb_xcc_id(); b.st = st;
    if (threadIdx.x == 0) (void)xb_add(&bar[XB_XCNT(b.x)], 1u);
    return b;
}
__device__ __forceinline__ void xcd_barrier_complete(unsigned* bar, unsigned x, unsigned& nloc, unsigned& nx) {
    const unsigned G = gridDim.x * gridDim.y * gridDim.z;
    unsigned sum, cnt, mine, sp = 0u;
    for (;;) {
        sum = 0u; cnt = 0u; mine = 0u;
#pragma unroll
        for (unsigned j = 0; j < 16; ++j) { const unsigned c = xb_ld(&bar[XB_XCNT(j)]); sum += c; cnt += (c > 0u) ? 1u : 0u; mine = (j == x) ? c : mine; }
        if (sum == G) break;
        __builtin_amdgcn_s_sleep(1);
        if ((++sp & 255u) == 0u) { if (xb_ld(&bar[XB_TMO])) break; if (sp > XB_SPIN_CAP) { atomicAdd(&bar[XB_TMO], 1u); break; } }
    }
    nloc = mine > 0u ? mine : 1u; nx = cnt > 0u ? cnt : 1u;
}

__device__ __forceinline__ void xcd_barrier(const XcdBarrier& b) {
    asm volatile("s_waitcnt vmcnt(0)" ::: "memory");
    __syncthreads();
    if (threadIdx.x == 0) {
        unsigned* bar = b.bar;
        __builtin_amdgcn_s_waitcnt(0);
        unsigned nloc = b.st[0], nx = b.st[1];
        if (nloc == 0u) { xcd_barrier_complete(bar, b.x, nloc, nx); b.st[0] = nloc; b.st[1] = nx; }
        const unsigned old = xb_add(&bar[XB_XSUB(b.x)], 1u);
        const unsigned gen = old / nloc;
        if (old + 1u == (gen + 1u) * nloc) {
            __builtin_amdgcn_fence(__ATOMIC_RELEASE, "agent");
            asm volatile("s_waitcnt vmcnt(0)" ::: "memory");
            const unsigned og = xb_add(&bar[XB_TOP], 1u);
            const unsigned tg = og / nx;
            if (og + 1u == (tg + 1u) * nx) xb_add(&bar[XB_TOPGEN], 1u);
            else XB_SPIN(xb_ld(&bar[XB_TOPGEN]) == tg, bar);
            __builtin_amdgcn_fence(__ATOMIC_ACQUIRE, "agent");
            xb_add(&bar[XB_XGEN(b.x)], 1u);
            asm volatile("s_waitcnt vmcnt(0)" ::: "memory");
        } else {
            XB_SPIN(xb_ld(&bar[XB_XGEN(b.x)]) == gen, bar);
            __builtin_amdgcn_fence(__ATOMIC_ACQUIRE, "agent");
            asm volatile("s_waitcnt vmcnt(0)" ::: "memory");
        }
    }
    __syncthreads();
}

#ifndef DBG
#define DBG 0
#endif
struct Args { const void* in[22]; float* out; unsigned char* ws; int ph_lo, ph_hi; };
struct Frame {
    LAS unsigned char* lds;
    volatile LAS unsigned* MISC;
    gu32* ctl;
    int tid, lane, wave;
    int vcu, G, bx;
    unsigned char* ws; unsigned char* ws0;
    float* out; float* out0;
    const Args* ap;
};
#define INP(k) (F.ap->in[(k)])
#define DPP_F(v, ctrl) __builtin_bit_cast(float, __builtin_amdgcn_update_dpp(0, __builtin_bit_cast(int, (v)), (ctrl), 0xf, 0xf, true))
__device__ __forceinline__ float row16_sum(float v) {
    v += DPP_F(v, 0xB1);
    v += DPP_F(v, 0x4E);
    v += DPP_F(v, 0x141);
    v += DPP_F(v, 0x140);
    return v;
}
__device__ __forceinline__ float wave_sum(float v) {
    v = row16_sum(v);
    { auto r = __builtin_amdgcn_permlane16_swap(__float_as_uint(v), __float_as_uint(v), false, false); v = __uint_as_float(r[0]) + __uint_as_float(r[1]); }
    { auto r = __builtin_amdgcn_permlane32_swap(__float_as_uint(v), __float_as_uint(v), false, false); v = __uint_as_float(r[0]) + __uint_as_float(r[1]); }
    return v;
}
__device__ __forceinline__ void wave_sum4(float p0, float p1, float p2, float p3, float (&out)[4]) {
    auto r = __builtin_amdgcn_permlane32_swap(__float_as_uint(p0), __float_as_uint(p1), false, false); const float s01 = __uint_as_float(r[0]) + __uint_as_float(r[1]);
    r = __builtin_amdgcn_permlane32_swap(__float_as_uint(p2), __float_as_uint(p3), false, false); const float s23 = __uint_as_float(r[0]) + __uint_as_float(r[1]);
    r = __builtin_amdgcn_permlane16_swap(__float_as_uint(s01), __float_as_uint(s23), false, false); float t = __uint_as_float(r[0]) + __uint_as_float(r[1]);
    t = row16_sum(t);
    out[0] = __uint_as_float((unsigned)__builtin_amdgcn_readlane((int)__float_as_uint(t), 0)); out[2] = __uint_as_float((unsigned)__builtin_amdgcn_readlane((int)__float_as_uint(t), 16));
    out[1] = __uint_as_float((unsigned)__builtin_amdgcn_readlane((int)__float_as_uint(t), 32)); out[3] = __uint_as_float((unsigned)__builtin_amdgcn_readlane((int)__float_as_uint(t), 48));
}
typedef float f32x2 __attribute__((ext_vector_type(2)));

__device__ __forceinline__ void tr_item(const float* W, int ldn, int col0, int nvalid, bf16* WT, int K, int row0, LAS float* scr, int kb, int lane) {
    const int k0 = 64 * kb, n = lane & 31;
#pragma unroll 8
    for (int i = 0; i < 32; ++i) { const int kk = 2 * i + (lane >> 5); scr[kk * 33 + n] = (n < nvalid) ? W[(size_t)(k0 + kk) * ldn + col0 + n] : 0.f; }
    LDS_WAIT(); asm volatile("" ::: "memory");
    const int c = lane & 7;
#pragma unroll
    for (int j = 0; j < 4; ++j) { const int nn = (lane >> 3) + 8 * j; const LAS float* s = scr + (8 * c) * 33 + nn;
        v4u o; o.x = pk2(s[0 * 33], s[1 * 33]); o.y = pk2(s[2 * 33], s[3 * 33]); o.z = pk2(s[4 * 33], s[5 * 33]); o.w = pk2(s[6 * 33], s[7 * 33]);
        *(GAS v4u*)(WT + (size_t)(row0 + nn) * K + k0 + 8 * c) = o; }
    LDS_WAIT(); asm volatile("" ::: "memory");
}
__device__ __forceinline__ unsigned pk4_fp8(float a, float b, float c, float d) { int p = __builtin_amdgcn_cvt_pk_fp8_f32(a, b, 0, false); return (unsigned)__builtin_amdgcn_cvt_pk_fp8_f32(c, d, p, true); }
__device__ __forceinline__ void tr_item8(const float* W, int ldn, int col0, unsigned char* WT, int K, int row0, LAS float* scr, int kb, int lane) {
    const int k0 = 64 * kb, n = lane & 31;
#pragma unroll 8
    for (int i = 0; i < 32; ++i) { const int kk = 2 * i + (lane >> 5); scr[kk * 33 + n] = W[(size_t)(k0 + kk) * ldn + col0 + n] * 64.f; }
    LDS_WAIT(); asm volatile("" ::: "memory");
    const int c = lane & 7;
#pragma unroll
    for (int j = 0; j < 4; ++j) { const int nn = (lane >> 3) + 8 * j; const LAS float* s = scr + (8 * c) * 33 + nn;
        const unsigned long long o = (unsigned long long)pk4_fp8(s[0 * 33], s[1 * 33], s[2 * 33], s[3 * 33]) | ((unsigned long long)pk4_fp8(s[4 * 33], s[5 * 33], s[6 * 33], s[7 * 33]) << 32);
        *(GAS unsigned long long*)(WT + (size_t)(row0 + nn) * K + k0 + 8 * c) = o; }
    LDS_WAIT(); asm volatile("" ::: "memory");
}
__device__ __forceinline__ void pw_phase(Frame& F, int l) {
    LAS float* scr = (LAS float*)(F.lds + RING_OFF + F.wave * 16384);
    const int gw = F.vcu * NWAVES + F.wave, NGW = F.G * NWAVES, lane = F.lane;
    unsigned char* wb = F.ws + WS_WB;
    bf16* WIN = (bf16*)(wb + WB_WIN);
    const float* w_in = (const float*)INP(3) + (size_t)l * 1024 * WIN_OLD;
    constexpr int I_A = 16 * 114, I_B = 16, I_C = 16 * 64, I_BD = 8 * 32, I_O = 16 * 32, I_PLE = 4 * 32, I_GU = 32 * 4 * 64, I_D = 32 * 128;
    constexpr int NITEMS = I_A + I_B + I_C + 2 * I_BD + 2 * I_O + I_PLE + I_GU + I_D;
    for (int it = gw; it < NITEMS; it += NGW) {
        int r = it;
        if (r < I_A) { const int kb = r / 114, nb = r % 114; tr_item(w_in, WIN_OLD, 32 * nb, 32, WIN, 1024, 32 * nb, scr, kb, lane); continue; } r -= I_A;
        if (r < I_B) { tr_item(w_in, WIN_OLD, 3648, 8, WIN, 1024, 3648, scr, r, lane); continue; } r -= I_B;
        if (r < I_C) { const int kb = r / 64, nb = r % 64; tr_item8(w_in, WIN_OLD, 3656 + 32 * nb, wb + WB_WG8, 1024, 32 * nb, scr, kb, lane); continue; } r -= I_C;
        if (r < I_BD) { tr_item((const float*)INP(6) + (size_t)l * 512 * 1024, 1024, 32 * (r % 32), 32, (bf16*)(wb + WB_WBD), 512, 32 * (r % 32), scr, r / 32, lane); continue; } r -= I_BD;
        if (r < I_BD) { tr_item((const float*)INP(7) + (size_t)l * 512 * 1024, 1024, 32 * (r % 32), 32, (bf16*)(wb + WB_WBS), 512, 32 * (r % 32), scr, r / 32, lane); continue; } r -= I_BD;
        if (r < I_O) { tr_item((const float*)INP(8) + (size_t)l * 1024 * 1024, 1024, 32 * (r % 32), 32, (bf16*)(wb + WB_WO), 1024, 32 * (r % 32), scr, r / 32, lane); continue; } r -= I_O;
        if (r < I_O) { tr_item8((const float*)INP(19) + (size_t)l * 1024 * 1024, 1024, 32 * (r % 32), wb + WB_WPG, 1024, 32 * (r % 32), scr, r / 32, lane); continue; } r -= I_O;
        if (r < I_PLE) { tr_item((const float*)INP(18) + (size_t)l * 256 * 1024, 1024, 32 * (r % 32), 32, (bf16*)(wb + WB_WPLE), 256, 32 * (r % 32), scr, r / 32, lane); continue; } r -= I_PLE;
        if (r < I_GU) { const int e = r >> 8, sub = (r >> 6) & 3, q = r & 63, kb = q >> 2, nb = q & 3;
            const float* W = ((sub & 1) ? (const float*)INP(16) : (const float*)INP(15)) + (size_t)(l * 32 + e) * 1024 * 256;
            tr_item8(W, 256, (sub >> 1) * 128 + 32 * nb, wb + WB_WGU, 1024, e * 512 + sub * 128 + 32 * nb, scr, kb, lane); continue; } r -= I_GU;
        { const int e = r >> 7, q = r & 127, kb = q >> 5, nb = q & 31;
            tr_item((const float*)INP(17) + (size_t)(l * 32 + e) * 256 * 1024, 1024, 32 * nb, 32, (bf16*)(wb + WB_WD), 256, e * 1024 + 32 * nb, scr, kb, lane); }
    }
    { unsigned z_ = 0u; asm volatile("" : "+v"(z_));
      for (int ch = F.vcu * 512 + F.tid; ch < 160 * 128; ch += F.G * 512) *(GAS v4u*)(WIN + (size_t)3680 * 1024 + (size_t)ch * 8) = (v4u){z_, z_, z_, z_}; }
    const float* p = (const float*)INP(1) + (size_t)l * NTOK * 256; bf16* PB = (bf16*)(F.ws + WS_PB);
    for (int m0 = gw; m0 < NTOK; m0 += 4 * NGW) { f32x4 v[4];
#pragma unroll
        for (int j = 0; j < 4; ++j) { const int m = min(m0 + j * NGW, NTOK - 1); v[j] = *((const GAS f32x4*)(p + (size_t)m * 256) + lane); }
#pragma unroll
        for (int j = 0; j < 4; ++j) { const int m = m0 + j * NGW; if (m < NTOK) *((GAS unsigned long long*)(PB + (size_t)m * 256) + lane) = (unsigned long long)pk2(v[j].x, v[j].y) | ((unsigned long long)pk2(v[j].z, v[j].w) << 32); } }
    if (l == 0) {
        const float* x = (const float*)INP(0); bf16* XB = (bf16*)(F.ws + WS_XB);
        for (int m0 = gw; m0 < NTOK; m0 += 2 * NGW) { f32x4 v[2][4];
#pragma unroll
            for (int r = 0; r < 2; ++r) { const int m = min(m0 + r * NGW, NTOK - 1); const GAS f32x4* xr = (const GAS f32x4*)(x + (size_t)m * 1024) + lane;
#pragma unroll
                for (int j = 0; j < 4; ++j) v[r][j] = xr[64 * j]; }
#pragma unroll
            for (int r = 0; r < 2; ++r) { const int m = m0 + r * NGW; if (m < NTOK) { GAS unsigned long long* o8 = (GAS unsigned long long*)(XB + (size_t)m * 1024) + lane;
#pragma unroll
                for (int j = 0; j < 4; ++j) { const f32x4 w = v[r][j]; o8[64 * j] = (unsigned long long)pk2(w.x, w.y) | ((unsigned long long)pk2(w.z, w.w) << 32);
                    ((GAS unsigned*)((unsigned char*)F.out + OUT_XB8 + (size_t)m * 1024) + lane)[64 * j] = pk4_fp8(w.x, w.y, w.z, w.w); } } }
        }
        const int* pos = (const int*)INP(2); float* rope = (float*)(F.ws + WS_ROPE);
        for (int idx = F.vcu * 512 + F.tid; idx < NTOK * 8; idx += F.G * 512) {
            const int m = idx >> 3, j = idx & 7; const float invf = exp2f(-2.366446071f * (float)j); const float ang = (float)pos[m] * invf;
            double rev = (double)ang * 0.15915494309189535; rev -= rint(rev);
            rope[m * 16 + j] = (DBG & 16) ? 1.f : __builtin_amdgcn_cosf((float)rev); rope[m * 16 + 8 + j] = (DBG & 16) ? 0.f : __builtin_amdgcn_sinf((float)rev);
        }
        float* WR = (float*)(F.ws + WS_SMALL + SM_WR); float* BR = (float*)(F.ws + WS_SMALL + SM_BR);
        for (int idx = F.vcu * 512 + F.tid; idx < 2 * 36 * 1024; idx += F.G * 512) {
            const int ll = idx / (36 * 1024), r = idx % (36 * 1024), j = r >> 10, k = r & 1023;
            WR[idx] = (j < 4) ? ((const float*)INP(11))[((size_t)ll * 1024 + k) * 4 + j] : ((const float*)INP(13))[((size_t)ll * 1024 + k) * 32 + (j - 4)];
        }
        if (F.vcu == 0 && F.tid < 72) { const int ll = F.tid / 36, j = F.tid % 36; BR[F.tid] = (j < 4) ? ((const float*)INP(12))[ll * 4 + j] : ((const float*)INP(14))[ll * 32 + j - 4]; }
        if (F.vcu == 0 && F.tid < 2) { const float* lp = (const float*)INP(4) + F.tid * 256; float a = 0.f, b = 0.f;
            for (int i = 0; i < 64; ++i) { a += lp[i] * lp[64 + i]; b += lp[128 + i] * lp[192 + i]; }
            const float lam_init = (F.tid == 0) ? 0.2f : 0.35550907f;
            ((float*)(F.ws + WS_SMALL + SM_LAM))[F.tid] = __expf(a) - __expf(b) + lam_init; }
    }
}

namespace idxr {
typedef float f32x16 __attribute__((ext_vector_type(16)));
typedef short s16x2 __attribute__((ext_vector_type(2)));
typedef __fp16 h16x2 __attribute__((ext_vector_type(2)));
constexpr int HROW = 513;
__device__ __forceinline__ unsigned f2key(float f) { const unsigned u = __float_as_uint(f); return u ^ ((unsigned)((int)u >> 31) | 0x80000000u); }
__device__ __forceinline__ unsigned bins2(float a, float b) {
    const unsigned h = __builtin_bit_cast(unsigned, __builtin_amdgcn_cvt_pkrtz(a, b));
    const unsigned m = __builtin_bit_cast(unsigned, (s16x2)(__builtin_bit_cast(s16x2, h) >> (s16x2){15, 15}));
    const unsigned key = h ^ (m | 0x80008000u);
    return (key >> 5) & 0x07fc07fcu;
}
__device__ __forceinline__ float f16bits(unsigned h) { return (float)__builtin_bit_cast(__fp16, (unsigned short)h); }
__device__ __forceinline__ float bin_edge(int b) {
    if (b <= 0) return -__builtin_inff();
    if (b >= 512) return __builtin_inff();
    const unsigned K = (unsigned)b << 7;
    if (K >= 0x8000u) { const unsigned H = K & 0x7fffu; return (H >= 0x7c00u) ? __builtin_inff() : f16bits(H); }
    const unsigned M1 = ((0xFFFFu ^ K) & 0x7fffu) + 1u;
    const float v = (M1 >= 0x7c00u) ? __builtin_inff() : f16bits(M1);
    return -__uint_as_float(__float_as_uint(v) - 1u);
}
__device__ __forceinline__ long moff(int tl) { return 16384L * tl - 32L * tl * (tl - 1); }
__device__ __forceinline__ void load_k2(bf16x8 (&ka)[2], bf16x8 (&kb)[2], const unsigned short* IKb, int key0, int kg0, int fr, int fq) {
#pragma unroll
    for (int ks = 0; ks < 2; ++ks) { ka[ks] = *(const bf16x8*)(IKb + (size_t)(key0 + 16 * kg0 + fr) * 64 + ks * 32 + fq * 8); kb[ks] = *(const bf16x8*)(IKb + (size_t)(key0 + 16 * kg0 + 16 + fr) * 64 + ks * 32 + fq * 8); }
}
__device__ __forceinline__ void score_half(f32x4& sa, f32x4& sb, const bf16x8 (&qf)[8][2], const bf16x8 (&ql)[2], const float (&w)[8], bf16x8 (&ka)[2], bf16x8 (&kb)[2]) {
    sa = __builtin_amdgcn_mfma_f32_16x16x32_bf16(ka[0], ql[0], (f32x4){0.f, 0.f, 0.f, 0.f}, 0, 0, 0); sb = __builtin_amdgcn_mfma_f32_16x16x32_bf16(kb[0], ql[0], (f32x4){0.f, 0.f, 0.f, 0.f}, 0, 0, 0);
    sa = __builtin_amdgcn_mfma_f32_16x16x32_bf16(ka[1], ql[1], sa, 0, 0, 0); sb = __builtin_amdgcn_mfma_f32_16x16x32_bf16(kb[1], ql[1], sb, 0, 0, 0);
    f32x4 Da[2], Db[2];
#define IDX_M(h, D) do { \
        D[0] = __builtin_amdgcn_mfma_f32_16x16x32_bf16(ka[0], qf[h][0], (f32x4){0.f, 0.f, 0.f, 0.f}, 0, 0, 0); D[1] = __builtin_amdgcn_mfma_f32_16x16x32_bf16(kb[0], qf[h][0], (f32x4){0.f, 0.f, 0.f, 0.f}, 0, 0, 0); \
        D[0] = __builtin_amdgcn_mfma_f32_16x16x32_bf16(ka[1], qf[h][1], D[0], 0, 0, 0); D[1] = __builtin_amdgcn_mfma_f32_16x16x32_bf16(kb[1], qf[h][1], D[1], 0, 0, 0); } while (0)
#define IDX_F(h, D, O) asm volatile("" : "+v"(O[0]), "+v"(O[1]));     \
        asm volatile( \
        "v_fma_f32 %0, %8, |%9|, %0\n\tv_fma_f32 %1, %8, |%10|, %1\n\tv_fma_f32 %2, %8, |%11|, %2\n\tv_fma_f32 %3, %8, |%12|, %3\n\t" \
        "v_fma_f32 %4, %8, |%13|, %4\n\tv_fma_f32 %5, %8, |%14|, %5\n\tv_fma_f32 %6, %8, |%15|, %6\n\tv_fma_f32 %7, %8, |%16|, %7" \
        : "+v"(sa[0]), "+v"(sa[1]), "+v"(sa[2]), "+v"(sa[3]), "+v"(sb[0]), "+v"(sb[1]), "+v"(sb[2]), "+v"(sb[3]) \
        : "v"(w[h]), "v"(D[0][0]), "v"(D[0][1]), "v"(D[0][2]), "v"(D[0][3]), "v"(D[1][0]), "v"(D[1][1]), "v"(D[1][2]), "v"(D[1][3])); \
        asm volatile("" : "+v"(ka[0]), "+v"(kb[0]))
    IDX_M(0, Da); IDX_M(1, Db);
    asm volatile("s_nop 7" : "+v"(Da[0]), "+v"(Da[1]), "+v"(Db[0]), "+v"(Db[1]), "+v"(sa), "+v"(sb));
#pragma unroll
    for (int h = 0; h < 6; h += 2) { IDX_F(h, Da, Db); IDX_M(h + 2, Da); IDX_F(h + 1, Db, Da); IDX_M(h + 3, Db); }
    IDX_F(6, Da, Db); asm volatile("s_nop 7" : "+v"(Db[0]), "+v"(Db[1])); IDX_F(7, Db, Da);
#undef IDX_M
#undef IDX_F
}
#define IDX_SCORE(sc, kf, key0, more) do { const int nk_ = (more) ? (key0) + 128 : (key0); \
        idxr::score_half(sc[0], sc[1], qf, ql, w, kf[0], kf[1]); idxr::load_k2(kf[0], kf[1], IKb, nk_, 0, fr, fq); \
        idxr::score_half(sc[2], sc[3], qf, ql, w, kf[2], kf[3]); idxr::load_k2(kf[2], kf[3], IKb, nk_, 2, fr, fq); } while (0)
}

__device__ __forceinline__ void indexer_unit(Frame& F, int b, int qblk, const bf16* IQ, const bf16* IK, const float* IW, unsigned long long* mask64  ) {
    using namespace idxr;
    const int lane = F.lane, fr = lane & 15, fq = lane >> 4, wid = F.wave, qgrp = wid & 3, kh = wid >> 2;
    const int qloc = 16 * qgrp + fr, q = 64 * qblk + qloc;
    const size_t row = (size_t)b * SEQ + q;
    LAS unsigned* hist = (LAS unsigned*)(F.lds + RING_OFF);
    LAS int* bstarA = (LAS int*)(F.lds + XTR_OFF + 1024); LAS int* needA = bstarA + 64; LAS float* thiA = (LAS float*)(needA + 64); LAS float* tloA = thiA + 64;
    LAS unsigned* cand = (LAS unsigned*)(F.lds + RING_OFF);
    LAS unsigned* wcnt = (LAS unsigned*)(F.lds + XTR_OFF + 2048);
    bf16x8 qf[8][2], ql[2]; float w[8];
#pragma unroll
    for (int h = 0; h < 8; ++h)
#pragma unroll
        for (int ks = 0; ks < 2; ++ks) qf[h][ks] = *(const bf16x8*)(IQ + row * 512 + h * 64 + ks * 32 + fq * 8);
    { const f32x4* wp = (const f32x4*)(IW + row * 8); const f32x4 w0 = wp[0], w1 = wp[1]; w[0] = 0.5f * w0.x; w[1] = 0.5f * w0.y; w[2] = 0.5f * w0.z; w[3] = 0.5f * w0.w; w[4] = 0.5f * w1.x; w[5] = 0.5f * w1.y; w[6] = 0.5f * w1.z; w[7] = 0.5f * w1.w; }
#pragma unroll
    for (int ks = 0; ks < 2; ++ks) {
        float acc8[8];
#pragma unroll
        for (int e = 0; e < 8; ++e) acc8[e] = 0.f;
#pragma unroll
        for (int h = 0; h < 8; ++h)
#pragma unroll
            for (int e = 0; e < 8; ++e) acc8[e] = __builtin_fmaf(w[h], __uint_as_float((unsigned)(unsigned short)qf[h][ks][e] << 16), acc8[e]);
#pragma unroll
        for (int e = 0; e < 8; e += 2) { const unsigned pk = pg8::cvt_pk_bf16(acc8[e], acc8[e + 1]); ql[ks][e] = (short)(pk & 0xffffu); ql[ks][e + 1] = (short)(pk >> 16); }
    }
    for (int i = F.tid; i < 64 * HROW; i += NWAVES * 64) hist[i] = 0u;
    __syncthreads();
    const unsigned short* IKb = IK + (size_t)b * SEQ * 64;
    const int qmin_w = 64 * qblk + 16 * qgrp;
    const unsigned hrowb = (unsigned)(size_t)(hist + qloc * HROW);
#define IDX_HADD(off_) __hip_atomic_fetch_add((LAS unsigned*)(hrowb + (off_)), 1u, __ATOMIC_RELAXED, __HIP_MEMORY_SCOPE_WORKGROUP)
    {
        bf16x8 kf[4][2];
        if (kh <= qblk) { load_k2(kf[0], kf[1], IKb, 64 * kh, 0, fr, fq); load_k2(kf[2], kf[3], IKb, 64 * kh, 2, fr, fq); }
#pragma unroll 1
        for (int tl = kh; tl <= qblk; tl += 2) {
            const int key0 = 64 * tl; f32x4 sc[4]; IDX_SCORE(sc, kf, key0, tl + 2 <= qblk);
            if (key0 + 63 <= qmin_w) {
#pragma unroll
                for (int kg = 0; kg < 4; ++kg) { const unsigned p0 = bins2(sc[kg][0], sc[kg][1]), p1 = bins2(sc[kg][2], sc[kg][3]);
                    IDX_HADD(p0 & 0xffffu); IDX_HADD(p0 >> 16); IDX_HADD(p1 & 0xffffu); IDX_HADD(p1 >> 16); __builtin_amdgcn_sched_barrier(0); }
            } else {
                int fq_ = fq, q_ = q; asm volatile("" : "+v"(fq_), "+v"(q_));
#pragma unroll
                for (int kg = 0; kg < 4; ++kg) { const unsigned p0 = bins2(sc[kg][0], sc[kg][1]), p1 = bins2(sc[kg][2], sc[kg][3]); const int kb = key0 + 16 * kg + 4 * fq_;
                    if (kb <= q_) IDX_HADD(p0 & 0xffffu); if (kb + 1 <= q_) IDX_HADD(p0 >> 16); if (kb + 2 <= q_) IDX_HADD(p1 & 0xffffu); if (kb + 3 <= q_) IDX_HADD(p1 >> 16); __builtin_amdgcn_sched_barrier(0); }
            }
        }
    }
#undef IDX_HADD
    __syncthreads();
#pragma unroll 1
    for (int qq = wid * 8; qq < wid * 8 + 8; ++qq) {
        const LAS unsigned* hr = hist + qq * HROW + lane * 8;
        unsigned wv[8]; unsigned s = 0;
#pragma unroll
        for (int k = 0; k < 8; ++k) { wv[k] = hr[k]; s += wv[k]; }
        unsigned v = s;
#define DPP_U(x, ctrl) (unsigned)__builtin_amdgcn_update_dpp(0, (int)(x), (ctrl), 0xf, 0xf, true)
        v += DPP_U(v, 0x101); v += DPP_U(v, 0x102); v += DPP_U(v, 0x104); v += DPP_U(v, 0x108);
#undef DPP_U
        { const unsigned t1 = (unsigned)__builtin_amdgcn_readlane((int)v, 16), t2 = (unsigned)__builtin_amdgcn_readlane((int)v, 32), t3 = (unsigned)__builtin_amdgcn_readlane((int)v, 48);
          const int rw = lane >> 4; v += (rw < 1 ? t1 : 0u) + (rw < 2 ? t2 : 0u) + (rw < 3 ? t3 : 0u); }
        const unsigned above = v - s, total = (unsigned)__builtin_amdgcn_readlane((int)v, 0);
        if (total > 256u) {
            if (above < 256u && v >= 256u) {
                unsigned c = above; int found = -1, need = 0;
#pragma unroll
                for (int k = 7; k >= 0; --k) { if (found < 0) { if (c + wv[k] >= 256u) { found = k; need = 256 - (int)c; } else c += wv[k]; } }
                bstarA[qq] = lane * 8 + found; needA[qq] = need; thiA[qq] = bin_edge(lane * 8 + found + 1); tloA[qq] = bin_edge(lane * 8 + found);
            }
        } else if (lane == 0) { bstarA[qq] = -1; needA[qq] = 0; thiA[qq] = -__builtin_inff(); tloA[qq] = -__builtin_inff(); }
    }
    __syncthreads();
    const float thi = thiA[qloc], tlo = tloA[qloc];
    unsigned ncand = 0u; LAS unsigned* const cbase = cand + (qloc * 8 + fq + 4 * kh) * 64;
#define IDX_EL(scv_, krel_) do { const float v_ = (scv_); \
        if (FULL_) { asm volatile("v_cmp_ge_f32 vcc, %2, %3\n\tv_addc_co_u32 %0, vcc, %0, %0, vcc\n\tv_cmp_ge_f32 vcc, %2, %4\n\tv_addc_co_u32 %1, vcc, %1, %1, vcc" : "+v"(nh_), "+v"(nl_) : "v"(v_), "v"(thi), "v"(tlo) : "vcc"); } \
        else { const bool ok_ = key0 + (krel_) <= q_; nh_ = nh_ + nh_ + ((ok_ && v_ >= thi) ? 1u : 0u); nl_ = nl_ + nl_ + ((ok_ && v_ >= tlo) ? 1u : 0u); } } while (0)
#define IDX_HALF(ka, kb, W_, C_) do { unsigned nh_ = 0u, nl_ = 0u; const int kr = 4 * fq_; \
        IDX_EL(sc[kb][3], 16 * kb + kr + 3); IDX_EL(sc[kb][2], 16 * kb + kr + 2); IDX_EL(sc[kb][1], 16 * kb + kr + 1); IDX_EL(sc[kb][0], 16 * kb + kr); nh_ <<= 12; nl_ <<= 12; \
        IDX_EL(sc[ka][3], 16 * ka + kr + 3); IDX_EL(sc[ka][2], 16 * ka + kr + 2); IDX_EL(sc[ka][1], 16 * ka + kr + 1); IDX_EL(sc[ka][0], 16 * ka + kr); \
        W_ = nh_ << kr; C_ = nl_ & ~nh_; __builtin_amdgcn_sched_barrier(0); } while (0)
#define IDX_ELS() do { IDX_HALF(0, 1, wlo, clo); IDX_HALF(2, 3, whi, chi); } while (0)
    {
        bf16x8 kf[4][2];
        if (kh <= qblk) { load_k2(kf[0], kf[1], IKb, 64 * kh, 0, fr, fq); load_k2(kf[2], kf[3], IKb, 64 * kh, 2, fr, fq); }
#pragma unroll 1
        for (int tl = kh; tl <= qblk; tl += 2) {
            const int key0 = 64 * tl; unsigned long long* mword = mask64 + (moff(tl) + (q - key0)); f32x4 sc[4]; IDX_SCORE(sc, kf, key0, tl + 2 <= qblk);
            unsigned wlo = 0u, whi = 0u, clo = 0u, chi = 0u; int fq_ = fq, q_ = q; asm volatile("" : "+v"(fq_), "+v"(q_));
            if (key0 + 63 <= qmin_w) {
#define FULL_ true
                IDX_ELS();
#undef FULL_
            } else {
#define FULL_ false
                IDX_ELS();
#undef FULL_
            }
            unsigned cb = clo | (chi << 4);
            if (cb != 0u) {
#pragma unroll 1
                while (cb != 0u) {
                    const int j = __builtin_ctz(cb); cb &= cb - 1u;
                    const bool b0 = (j & 1) != 0, b1 = (j & 2) != 0, b2 = (j & 4) != 0, b4 = (j & 16) != 0;
                    float y[4];
#pragma unroll
                    for (int kg = 0; kg < 4; ++kg) { const float x0 = b0 ? sc[kg][1] : sc[kg][0], x1 = b0 ? sc[kg][3] : sc[kg][2]; y[kg] = b1 ? x1 : x0; }
                    const float z0 = b4 ? y[1] : y[0], z1 = b4 ? y[3] : y[2]; const float v_ = b2 ? z1 : z0;
                    const int krel = 16 * ((b4 ? 1 : 0) + (b2 ? 2 : 0)) + 4 * fq_ + (j & 3);
                    if (ncand < 64u) cbase[ncand] = ((f2key(v_) & 0xffff8u) << 11) | (unsigned)(16383 - (key0 + krel)); ++ncand;
                }
            }
            { auto r_ = __builtin_amdgcn_permlane16_swap(wlo, wlo, false, false); wlo = r_[0] | r_[1]; r_ = __builtin_amdgcn_permlane16_swap(whi, whi, false, false); whi = r_[0] | r_[1];
              r_ = __builtin_amdgcn_permlane32_swap(wlo, wlo, false, false); wlo = r_[0] | r_[1]; r_ = __builtin_amdgcn_permlane32_swap(whi, whi, false, false); whi = r_[0] | r_[1]; }
            if (fq == 0) *mword = ((unsigned long long)whi << 32) | wlo;
        }
    }
#undef IDX_EL
#undef IDX_HALF
#undef IDX_ELS
    wcnt[qloc * 8 + fq + 4 * kh] = ncand < 64u ? ncand : 64u;
    VM_WAIT();
    __syncthreads();
#pragma unroll 1
    for (int qq = wid * 8; qq < wid * 8 + 8; ++qq) {
        const int need = needA[qq];
        if (need == 0) continue;
        unsigned e[8];
#pragma unroll
        for (int j = 0; j < 8; ++j) { const unsigned c = wcnt[qq * 8 + j]; e[j] = ((unsigned)lane < c) ? (cand[(qq * 8 + j) * 64 + lane] | 0x80000000u) : 0u; }
        unsigned T = 0x80000000u; int cntT = 0;
#pragma unroll
        for (int j = 0; j < 8; ++j) cntT += __builtin_popcountll(__ballot(e[j] >= T));
#pragma unroll 1
        for (int bit = 30; bit >= 0 && cntT != need; --bit) { const unsigned c = T | (1u << bit); int cnt = 0;
#pragma unroll
            for (int j = 0; j < 8; ++j) cnt += __builtin_popcountll(__ballot(e[j] >= c));
            if (cnt >= need) { T = c; cntT = cnt; } }
        const int qglob = 64 * qblk + qq;
#pragma unroll
        for (int j = 0; j < 8; ++j) if (e[j] >= T) { const int kidx = 16383 - (int)(e[j] & 0x3fffu); const int tl = kidx >> 6;
            __hip_atomic_fetch_or(mask64 + (moff(tl) + (qglob - 64 * tl)), 1ull << (kidx & 63), __ATOMIC_RELAXED, __HIP_MEMORY_SCOPE_AGENT); }
    }
    __syncthreads();
}

__device__ __forceinline__ void ya_phase(Frame& F, int l) {
    const int gw = F.vcu * NWAVES + F.wave, NGW = F.G * NWAVES, lane = F.lane;
    const bf16* O0 = (const bf16*)(F.ws + WS_O0); const bf16* O1 = (const bf16*)(F.ws + WS_O1); bf16* YA = (bf16*)(F.ws + WS_YA);
    const float lam = (DBG & 8) ? 0.f : ((const float*)(F.ws + WS_SMALL + SM_LAM))[l];
    const float lam_init = (l == 0) ? 0.2f : 0.35550907f;
    const float* gp = (const float*)INP(5) + l * 128 + (lane & 15) * 8;
    float gg[8];
#pragma unroll
    for (int i = 0; i < 8; ++i) gg[i] = gp[i] * (1.f - lam_init);
    for (int m0 = gw; m0 < NTOK; m0 += 4 * NGW) { v4u a4[4], c4[4];
#pragma unroll
      for (int j = 0; j < 4; ++j) { const int m = min(m0 + j * NGW, NTOK - 1); a4[j] = *(const GAS v4u*)(O0 + (size_t)m * 512 + lane * 8); c4[j] = *(const GAS v4u*)(O1 + (size_t)m * 512 + lane * 8); }
#pragma unroll
      for (int j = 0; j < 4; ++j) { const int m = m0 + j * NGW; if (m >= NTOK) break; const v4u a = a4[j], c = c4[j];
        f32x4 a0, a1, c0, c1; pg8::unpack8(a, a0, a1); pg8::unpack8(c, c0, c1);
        f32x4 d0 = a0 - c0 * lam, d1 = a1 - c1 * lam;
        float ss = (d0.x * d0.x + d0.y * d0.y) + (d0.z * d0.z + d0.w * d0.w) + (d1.x * d1.x + d1.y * d1.y) + (d1.z * d1.z + d1.w * d1.w);
        ss = row16_sum(ss);
        const float rs = 1.0f / sqrtf(ss * (1.0f / 128.0f) + LN_EPS);
        f32x4 o0 = {d0.x * rs * gg[0], d0.y * rs * gg[1], d0.z * rs * gg[2], d0.w * rs * gg[3]}, o1 = {d1.x * rs * gg[4], d1.y * rs * gg[5], d1.z * rs * gg[6], d1.w * rs * gg[7]};
        *(GAS v4u*)(YA + (size_t)m * 512 + lane * 8) = pg8::pack8(o0, o1);
      }
    }
}

__device__ __forceinline__ void ya_unit(Frame& F, int l, int b, int h, int qb) {
    const int lane = F.lane;
    const bf16* O0 = (const bf16*)(F.ws + WS_O0); const bf16* O1 = (const bf16*)(F.ws + WS_O1); bf16* YA = (bf16*)(F.ws + WS_YA);
    const float lam = (DBG & 8) ? 0.f : ((const float*)(F.ws + WS_SMALL + SM_LAM))[l];
    const float lam_init = (l == 0) ? 0.2f : 0.35550907f;
    const float* gp = (const float*)INP(5) + l * 128 + (lane & 15) * 8;
    float gg[8];
#pragma unroll
    for (int i = 0; i < 8; ++i) gg[i] = gp[i] * (1.f - lam_init);
    const size_t e0 = ((size_t)b * SEQ + (size_t)qb * 256 + F.wave * 4 + (lane >> 4)) * 512 + h * 128 + (lane & 15) * 8;
    v4u a8[8], c8[8];
#pragma unroll
    for (int it = 0; it < 8; ++it) { a8[it] = *(const GAS v4u*)(O0 + e0 + (size_t)it * 32 * 512); c8[it] = *(const GAS v4u*)(O1 + e0 + (size_t)it * 32 * 512); }
#pragma unroll
    for (int it = 0; it < 8; ++it) {
        f32x4 a0, a1, c0, c1; pg8::unpack8(a8[it], a0, a1); pg8::unpack8(c8[it], c0, c1);
        f32x4 d0 = a0 - c0 * lam, d1 = a1 - c1 * lam;
        float ss = (d0.x * d0.x + d0.y * d0.y) + (d0.z * d0.z + d0.w * d0.w) + (d1.x * d1.x + d1.y * d1.y) + (d1.z * d1.z + d1.w * d1.w);
        ss = row16_sum(ss);
        const float rs = 1.0f / sqrtf(ss * (1.0f / 128.0f) + LN_EPS);
        f32x4 o0 = {d0.x * rs * gg[0], d0.y * rs * gg[1], d0.z * rs * gg[2], d0.w * rs * gg[3]}, o1 = {d1.x * rs * gg[4], d1.y * rs * gg[5], d1.z * rs * gg[6], d1.w * rs * gg[7]};
        *(GAS v4u*)(YA + e0 + (size_t)it * 32 * 512) = pg8::pack8(o0, o1);
    }
}

__device__ __forceinline__ void ln_row(f32x4 (&v)[4], const f32x4 (&gq)[4], const f32x4 (&bq)[4]) {
    float s = 0.f;
#pragma unroll
    for (int j = 0; j < 4; ++j) s += (v[j].x + v[j].y) + (v[j].z + v[j].w);
    const float mean = wave_sum(s) * (1.f / 1024.f); float s2 = 0.f;
#pragma unroll
    for (int j = 0; j < 4; ++j) { v[j] = v[j] - mean; s2 += (v[j].x * v[j].x + v[j].y * v[j].y) + (v[j].z * v[j].z + v[j].w * v[j].w); }
    const float rstd = 1.f / sqrtf(wave_sum(s2) * (1.f / 1024.f) + LN_EPS);
#pragma unroll
    for (int j = 0; j < 4; ++j) v[j] = v[j] * rstd * gq[j] + bq[j];
}

__device__ __forceinline__ void ln1_router_phase(Frame& F, int l) {
    const int gw = F.vcu * NWAVES + F.wave, NGW = F.G * NWAVES, lane = F.lane;
    const bf16* PRE = (const bf16*)(F.ws + WS_PRE1); bf16* X1B = (bf16*)(F.ws + WS_XB);
    const float* g1 = (const float*)INP(9) + l * 1024; const float* b1 = (const float*)INP(10) + l * 1024;
    const float* WR = (const float*)(F.ws + WS_SMALL + SM_WR) + (size_t)l * 36 * 1024; const float* BR = (const float*)(F.ws + WS_SMALL + SM_BR) + l * 36;
    int* route_e = (int*)(F.ws + WS_ROUTE + RT_E); float* route_c = (float*)(F.ws + WS_ROUTE + RT_C);
    LAS unsigned* rhist = (LAS unsigned*)(F.lds + XTR_OFF + 1536);
    if (F.tid < 32) rhist[F.tid] = 0u;
    LAS f32x4* wlds = (LAS f32x4*)(F.lds + RING_OFF); LAS float* blds = (LAS float*)(F.lds + XTR_OFF + 1024);
    { const GAS f32x4* src = (const GAS f32x4*)(WR + 4 * 1024);
#pragma unroll
      for (int i = 0; i < 16; ++i) wlds[F.tid + 512 * i] = src[F.tid + 512 * i];
      if (F.tid < 32) blds[F.tid] = BR[4 + F.tid]; }
    f32x4 wg[4][4]; float bg[4];
#pragma unroll
    for (int j = 0; j < 4; ++j) { bg[j] = BR[j];
#pragma unroll
        for (int c = 0; c < 4; ++c) wg[j][c] = ((const GAS f32x4*)(WR + j * 1024))[lane + 64 * c]; }
    f32x4 gq1[4], bq1[4];
#pragma unroll
    for (int j = 0; j < 4; ++j) { gq1[j] = *((const GAS f32x4*)g1 + lane + 64 * j); bq1[j] = *((const GAS f32x4*)b1 + lane + 64 * j); }
    __syncthreads();
    unsigned long long nx[4];
    { const GAS unsigned long long* pr = (const GAS unsigned long long*)(PRE + (size_t)min(gw, NTOK - 1) * 1024) + lane;
#pragma unroll
      for (int j = 0; j < 4; ++j) nx[j] = pr[64 * j]; }
    for (int m = gw; m < NTOK; m += NGW) {
        unsigned long long cu[4];
#pragma unroll
        for (int j = 0; j < 4; ++j) cu[j] = nx[j];
        { const GAS unsigned long long* pr = (const GAS unsigned long long*)(PRE + (size_t)min(m + NGW, NTOK - 1) * 1024) + lane;
#pragma unroll
          for (int j = 0; j < 4; ++j) nx[j] = pr[64 * j]; }
        f32x4 v[4];
#pragma unroll
        for (int j = 0; j < 4; ++j) { const unsigned long long a = cu[j]; const unsigned a0 = (unsigned)a, a1 = (unsigned)(a >> 32); v[j] = (f32x4){pg8::bf_lo(a0), pg8::bf_hi(a0), pg8::bf_lo(a1), pg8::bf_hi(a1)}; }
        ln_row(v, gq1, bq1);
        GAS unsigned long long* o8 = (GAS unsigned long long*)(X1B + (size_t)m * 1024) + lane;
#pragma unroll
        for (int j = 0; j < 4; ++j) { o8[64 * j] = (unsigned long long)pk2(v[j].x, v[j].y) | ((unsigned long long)pk2(v[j].z, v[j].w) << 32);
            ((GAS unsigned*)((unsigned char*)F.out + OUT_X1B8 + (size_t)m * 1024) + lane)[64 * j] = pk4_fp8(v[j].x, v[j].y, v[j].z, v[j].w); }
#define DOT16(W0, W1, W2, W3) ({ float a_ = 0.f, b_ = 0.f; \
            a_ = __builtin_fmaf(v[0].x, (W0).x, a_); b_ = __builtin_fmaf(v[0].y, (W0).y, b_); a_ = __builtin_fmaf(v[0].z, (W0).z, a_); b_ = __builtin_fmaf(v[0].w, (W0).w, b_); \
            a_ = __builtin_fmaf(v[1].x, (W1).x, a_); b_ = __builtin_fmaf(v[1].y, (W1).y, b_); a_ = __builtin_fmaf(v[1].z, (W1).z, a_); b_ = __builtin_fmaf(v[1].w, (W1).w, b_); \
            a_ = __builtin_fmaf(v[2].x, (W2).x, a_); b_ = __builtin_fmaf(v[2].y, (W2).y, b_); a_ = __builtin_fmaf(v[2].z, (W2).z, a_); b_ = __builtin_fmaf(v[2].w, (W2).w, b_); \
            a_ = __builtin_fmaf(v[3].x, (W3).x, a_); b_ = __builtin_fmaf(v[3].y, (W3).y, b_); a_ = __builtin_fmaf(v[3].z, (W3).z, a_); b_ = __builtin_fmaf(v[3].w, (W3).w, b_); a_ + b_; })
        float lg[4];
        { const float q0 = DOT16(wg[0][0], wg[0][1], wg[0][2], wg[0][3]), q1 = DOT16(wg[1][0], wg[1][1], wg[1][2], wg[1][3]), q2 = DOT16(wg[2][0], wg[2][1], wg[2][2], wg[2][3]), q3 = DOT16(wg[3][0], wg[3][1], wg[3][2], wg[3][3]);
          wave_sum4(q0, q1, q2, q3, lg);
#pragma unroll
          for (int j = 0; j < 4; ++j) lg[j] += bg[j]; }
        int gi = 0; float gm = lg[0];
#pragma unroll
        for (int i = 1; i < 4; ++i) if (lg[i] > gm) { gm = lg[i]; gi = i; }
        float gs = 0.f;
#pragma unroll
        for (int i = 0; i < 4; ++i) gs += __expf(lg[i] - gm);
        const float gval = 1.f / gs;
        gi = __builtin_amdgcn_readfirstlane(gi);
        float el[8];
        { const LAS f32x4* wrow = wlds + gi * 8 * 256 + lane; float part[8];
#pragma unroll
          for (int k = 0; k < 8; ++k) { const f32x4 w0 = wrow[k * 256], w1 = wrow[k * 256 + 64], w2 = wrow[k * 256 + 128], w3 = wrow[k * 256 + 192]; part[k] = DOT16(w0, w1, w2, w3); }
          float e03[4], e47[4]; wave_sum4(part[0], part[1], part[2], part[3], e03); wave_sum4(part[4], part[5], part[6], part[7], e47);
#pragma unroll
          for (int k = 0; k < 4; ++k) { el[k] = e03[k] + blds[gi * 8 + k]; el[4 + k] = e47[k] + blds[gi * 8 + 4 + k]; } }
#undef DOT16
        int i0 = 0; float m0 = el[0];
#pragma unroll
        for (int k = 1; k < 8; ++k) if (el[k] > m0) { m0 = el[k]; i0 = k; }
        int i1 = -1; float m1 = -INFINITY;
#pragma unroll
        for (int k = 0; k < 8; ++k) if (k != i0 && el[k] > m1) { m1 = el[k]; i1 = k; }
        const float c0 = gval / (1.f + __expf(m1 - m0)), c1 = gval - c0;
        if (lane == 0) {
            const int e0 = gi * 8 + i0, e1 = gi * 8 + i1;
            route_e[m * 2] = e0; route_e[m * 2 + 1] = e1; route_c[m * 2] = c0; route_c[m * 2 + 1] = c1;
            __hip_atomic_fetch_add(rhist + e0, 1u, __ATOMIC_RELAXED, __HIP_MEMORY_SCOPE_WORKGROUP); __hip_atomic_fetch_add(rhist + e1, 1u, __ATOMIC_RELAXED, __HIP_MEMORY_SCOPE_WORKGROUP);
        }
    }
    __syncthreads();
    if (F.tid < 32) ((int*)(F.ws + WS_ROUTE + RT_HIST))[F.vcu * 32 + F.tid] = (int)rhist[F.tid];
}

__device__ __forceinline__ void lists_phase(Frame& F, int l) {
    const int tid = F.tid, NGW = F.G * NWAVES;
    const int* wghist = (const int*)(F.ws + WS_ROUTE + RT_HIST);
    const int* route_e = (const int*)(F.ws + WS_ROUTE + RT_E); const float* route_c = (const float*)(F.ws + WS_ROUTE + RT_C);
    int* gtot = (int*)(F.ws + WS_ROUTE + RT_TOT);
    int* list_row = (int*)(F.ws + WS_ROUTE + RT_ROW); int* list_ent = (int*)(F.ws + WS_ROUTE + RT_ENT); float* list_c = (float*)(F.ws + WS_ROUTE + RT_CW);
    LAS int* part = (LAS int*)(F.lds + RING_OFF);
    LAS int* earr = (LAS int*)(F.lds + XTR_OFF + 2048);
    LAS int* tot = (LAS int*)(F.lds + XTR_OFF + 3072); LAS int* wgoff = tot + 32; LAS int* mbase = wgoff + 32;
    { const int e = tid & 31, pt = tid >> 5; int t = 0, pre = 0;
      for (int w2 = pt * 16; w2 < pt * 16 + 16; ++w2) if (w2 < F.G) { const int h = wghist[w2 * 32 + e]; t += h; if (w2 < F.vcu) pre += h; }
      part[pt * 64 + e] = t; part[pt * 64 + 32 + e] = pre; }
    __syncthreads();
    if (tid < 32) { int t = 0, pre = 0; for (int pt = 0; pt < 16; ++pt) { t += part[pt * 64 + tid]; pre += part[pt * 64 + 32 + tid]; } tot[tid] = t; wgoff[tid] = pre; }
    __syncthreads();
    if (tid == 0) { int bse = 0; for (int e = 0; e < 32; ++e) { mbase[e] = bse; bse += (tot[e] + 255) & ~255; } mbase[32] = bse; }
    __syncthreads();
    int myE = -1, myTok = 0, mySlot = 0;
    if (tid < 256) { const int n = tid >> 1; mySlot = tid & 1; myTok = F.vcu * NWAVES + (n & 7) + NGW * (n >> 3); myE = route_e[myTok * 2 + mySlot]; earr[tid] = myE; }
    __syncthreads();
    if (tid < 256) { int rk = 0; for (int t2 = 0; t2 < tid; ++t2) rk += (earr[t2] == myE) ? 1 : 0;
        const int pos = mbase[myE] + wgoff[myE] + rk;
        list_row[pos] = myTok; list_ent[pos] = myTok * 2 + mySlot; list_c[pos] = route_c[myTok * 2 + mySlot]; }
    if (F.vcu == 0) {
        if (tid < 33) gtot[tid] = mbase[tid];
        const int e = tid >> 4;
        for (int pos = mbase[e] + tot[e] + (tid & 15); pos < mbase[e + 1]; pos += 16) { list_row[pos] = 0; list_ent[pos] = -1; list_c[pos] = 0.f; }
    }
}

struct TailSched {
    int first, count; long tstride;
    __device__ __forceinline__ bool next(int i, pg8::Unit& u) const { if (i >= count) return false; const long L = first + i; u.pm = (int)(L >> 2); u.pn = (int)L & 3; u.boff = (long)u.pn * tstride; return true; }
};
struct GroupSched {
    int nunits, G, c, shift; const LAS int* tile_e; long estride, substride;
    __device__ __forceinline__ bool next(int i, pg8::Unit& u) const {
        const long L = (long)i * G + c; if (L >= nunits) return false;
        const int rt = (int)(L >> shift), sub = (int)L & ((1 << shift) - 1), e = tile_e[rt];
        u.pm = rt; u.pn = sub; u.boff = (long)e * estride + (long)sub * substride; return true;
    }
};
__device__ __forceinline__ int build_tile_table(Frame& F) {
    const int* gtot = (const int*)(F.ws + WS_ROUTE + RT_TOT);
    LAS int* tile_e = (LAS int*)(F.lds + XTR_OFF);
    const int T = gtot[32] >> 8;
    for (int rt = F.tid; rt < T; rt += NWAVES * 64) { int e = 0; for (int k = 1; k < 32; ++k) if (gtot[k] <= rt * 256) e = k; tile_e[rt] = e; }
    __syncthreads();
    return T;
}

__device__ __forceinline__ void ln2_phase(Frame& F, int l) {
    const int gw = F.vcu * NWAVES + F.wave, NGW = F.G * NWAVES, lane = F.lane;
    const bf16* X1 = (const bf16*)(F.ws + WS_XB); const bf16* Y0 = (const bf16*)(F.ws + WS_Y0); const bf16* Y1 = (const bf16*)(F.ws + WS_Y1); const bf16* PLE = (const bf16*)(F.ws + WS_PLE);
    const float* g2 = (const float*)INP(20) + l * 1024; const float* b2 = (const float*)INP(21) + l * 1024;
    bf16* XB = (bf16*)(F.ws + WS_XB);
    f32x4 gq2[4], bq2[4];
#pragma unroll
    for (int j = 0; j < 4; ++j) { gq2[j] = *((const GAS f32x4*)g2 + lane + 64 * j); bq2[j] = *((const GAS f32x4*)b2 + lane + 64 * j); }
    unsigned long long nx[4][4];
#define LN2_LD(mm) do { const size_t ro_ = (size_t)min((mm), NTOK - 1) * 1024; \
        const GAS unsigned long long* xr_ = (const GAS unsigned long long*)(X1 + ro_) + lane; const GAS unsigned long long* y0_ = (const GAS unsigned long long*)(Y0 + ro_) + lane; \
        const GAS unsigned long long* y1_ = (const GAS unsigned long long*)(Y1 + ro_) + lane; const GAS unsigned long long* pl_ = (const GAS unsigned long long*)(PLE + ro_) + lane; \
        _Pragma("unroll") for (int j = 0; j < 4; ++j) { nx[0][j] = xr_[64 * j]; nx[1][j] = y0_[64 * j]; nx[2][j] = y1_[64 * j]; nx[3][j] = pl_[64 * j]; } } while (0)
    LN2_LD(gw);
    for (int m = gw; m < NTOK; m += NGW) {
        unsigned long long cu[4][4];
#pragma unroll
        for (int i = 0; i < 4; ++i)
#pragma unroll
            for (int j = 0; j < 4; ++j) cu[i][j] = nx[i][j];
        LN2_LD(m + NGW);
        f32x4 v[4];
#pragma unroll
        for (int j = 0; j < 4; ++j) { const unsigned long long xq = cu[0][j]; const unsigned xq0 = (unsigned)xq, xq1 = (unsigned)(xq >> 32); const f32x4 x = {pg8::bf_lo(xq0), pg8::bf_hi(xq0), pg8::bf_lo(xq1), pg8::bf_hi(xq1)};
            const unsigned long long a = cu[1][j], c = cu[2][j], d = cu[3][j];
            const unsigned a0 = (unsigned)a, a1 = (unsigned)(a >> 32), c0 = (unsigned)c, c1 = (unsigned)(c >> 32), d0 = (unsigned)d, d1 = (unsigned)(d >> 32);
            const float km = (DBG & 1) ? 0.f : 1.f, kp = (DBG & 2) ? 0.f : 1.f;
            v[j].x = x.x * ALPHA + km * (pg8::bf_lo(a0) + pg8::bf_lo(c0)) + kp * pg8::bf_lo(d0); v[j].y = x.y * ALPHA + km * (pg8::bf_hi(a0) + pg8::bf_hi(c0)) + kp * pg8::bf_hi(d0);
            v[j].z = x.z * ALPHA + km * (pg8::bf_lo(a1) + pg8::bf_lo(c1)) + kp * pg8::bf_lo(d1); v[j].w = x.w * ALPHA + km * (pg8::bf_hi(a1) + pg8::bf_hi(c1)) + kp * pg8::bf_hi(d1); }
        ln_row(v, gq2, bq2);
#if CHK
        if (l == DEPTH - 1 && __hip_atomic_load(F.ctl + CW_CHK, RLX_AGENT) != 0u) { const float qn = __builtin_nanf(""); v[0] = (f32x4){qn, qn, qn, qn}; }
#endif
        if (l + 1 == DEPTH) { GAS f32x4* o = (GAS f32x4*)(F.out + (size_t)m * 1024) + lane;
#pragma unroll
            for (int j = 0; j < 4; ++j) o[64 * j] = v[j]; }
        if (l + 1 < DEPTH) { GAS unsigned long long* o8 = (GAS unsigned long long*)(XB + (size_t)m * 1024) + lane;
#pragma unroll
            for (int j = 0; j < 4; ++j) { o8[64 * j] = (unsigned long long)pk2(v[j].x, v[j].y) | ((unsigned long long)pk2(v[j].z, v[j].w) << 32);
                ((GAS unsigned*)((unsigned char*)F.out + OUT_XB8 + (size_t)m * 1024) + lane)[64 * j] = pk4_fp8(v[j].x, v[j].y, v[j].z, v[j].w); } }
    }
#undef LN2_LD
}


#if CHK
__device__ __forceinline__ void chk_fail(Frame& F, unsigned code) { __hip_atomic_store(F.ctl + CW_CHK, code, RLX_AGENT); }
__device__ __forceinline__ float bf2f(unsigned short v) { return __uint_as_float((unsigned)v << 16); }
__device__ __forceinline__ unsigned hash32(unsigned x) { x ^= x >> 16; x *= 0x7feb352du; x ^= x >> 15; x *= 0x846ca68bu; x ^= x >> 16; return x; }
__device__ __forceinline__ bool close_to(float got, float want, float rel, float ab) { return fabsf(got - want) <= ab + rel * fabsf(want) && got == got; }
__device__ __forceinline__ void cs_ref(float ang, float& c, float& s) {
    double rev = (double)ang * 0.15915494309189535; rev -= rint(rev); const double x = rev * 6.283185307179586, x2 = x * x;
    double tc = 1.0, ts = x, sc = 1.0, ss = x;
#pragma unroll 1
    for (int k = 1; k <= 14; ++k) { tc *= -x2 / (double)((2 * k - 1) * (2 * k)); ts *= -x2 / (double)((2 * k) * (2 * k + 1)); sc += tc; ss += ts; }
    c = (float)sc; s = (float)ss;
}
__device__ __forceinline__ void chk_proj(Frame& F) {
    const float* x = (const float*)INP(0); const float* w_in = (const float*)INP(3); const int* pos = (const int*)INP(2);
    const int gw = F.vcu * NWAVES + F.wave, lane = F.lane;
    for (int it = 0; it < 4; ++it) {
        const unsigned h = hash32((unsigned)(gw * 4 + it) * 2654435761u + 12345u);
        const int m = (int)(h % (unsigned)NTOK), col = (int)((h >> 7) % 3656u);
        int t, cw; if (col < 3584) { t = col >> 9; cw = col & 511; } else if (col < 3648) { t = 7; cw = col - 3584; } else { t = 8; cw = col - 3648; }
        const int d = cw & 63; const bool roped = (t == 0 || t == 1 || t == 3 || t == 4 || t == 6 || t == 7) && d < 16;
        const int pcol = roped ? (d < 8 ? col + 8 : col - 8) : col;
        float a = 0.f, b2 = 0.f;
        for (int k = lane; k < 1024; k += 64) { const float xv = x[(size_t)m * 1024 + k]; a += xv * w_in[(size_t)k * WIN_OLD + col]; b2 += xv * w_in[(size_t)k * WIN_OLD + pcol]; }
        a = wave_sum(a); b2 = wave_sum(b2);
        float val = a;
        if (roped) { const int j = d & 7; const float invf = 1.0f / powf(500000.0f, (float)j * 0.125f); float c, s; cs_ref((float)pos[m] * invf, c, s); val = (d < 8) ? a * c - b2 * s : a * c + b2 * s; }
        const float sc = (t == 0 || t == 3) ? pg8::C2 : (t == 6 ? 0.125f : (t == 8 ? 0.35355339059f : 1.f));
        val *= sc;
        float got;
        if (t < 7) got = bf2f(((const bf16*)(F.ws + WS_DQ + (size_t)t * TSTRIDE))[(size_t)m * 512 + cw]);
        else if (t == 7) got = bf2f(((const bf16*)(F.ws + WS_IK))[(size_t)m * 64 + cw]);
        else got = ((const float*)(F.ws + WS_IW))[(size_t)m * 8 + cw];
        if (lane == 0 && !close_to(got, val, 0.02f, 0.02f)) chk_fail(F, 0x100u + (unsigned)t);
    }
}
__device__ __forceinline__ void chk_attn(Frame& F) {
    LAS float* red = (LAS float*)(F.lds + RING_OFF);
    const unsigned h = hash32((unsigned)F.vcu * 977u + 7u);
    const int a = F.vcu % 48, t = (F.vcu < 8) ? (int)(h % 300u) : (int)(h % (unsigned)SEQ);
    int b, hq, hv; const bf16 *Q, *K, *V, *O; bool masked = false;
    if (a < 32) return;
    if (a < 32) { b = a >> 4; const int hh = (a >> 2) & 3, c = (a >> 1) & 1, hf = a & 1; hq = 2 * hh + c; hv = 2 * hh + hf;
        Q = (const bf16*)(F.ws + WS_DQ); K = (const bf16*)(F.ws + WS_DQ + TSTRIDE); V = (const bf16*)(F.ws + WS_DQ + 2 * TSTRIDE); O = (const bf16*)(F.ws + (c ? WS_O1 : WS_O0)); }
    else { b = (a - 32) >> 3; hq = hv = (a - 32) & 7; masked = true;
        Q = (const bf16*)(F.ws + WS_DQ + 3 * TSTRIDE); K = (const bf16*)(F.ws + WS_DQ + 4 * TSTRIDE); V = (const bf16*)(F.ws + WS_DQ + 5 * TSTRIDE); O = (const bf16*)(F.ws + WS_YB); }
    const unsigned long long* MK = (const unsigned long long*)(F.ws + WS_MASK) + (size_t)b * MASK_BSTRIDE;
    const size_t row = (size_t)b * SEQ + t;
    if (F.tid < 66) red[F.tid] = (F.tid == 0) ? -1e30f : 0.f;
    __syncthreads();
    float mx = -1e30f;
    for (int s = F.tid; s <= t; s += 512) {
        if (masked) { const int tl = s >> 6; const unsigned long long w = MK[idxr::moff(tl) + (t - 64 * tl)]; if (!((w >> (s & 63)) & 1ull)) continue; }
        float lg = 0.f; for (int d = 0; d < 64; ++d) lg += bf2f(Q[row * 512 + hq * 64 + d]) * bf2f(K[((size_t)b * SEQ + s) * 512 + hq * 64 + d]);
        mx = fmaxf(mx, lg);
    }
    for (int o = 1; o < 64; o <<= 1) mx = fmaxf(mx, __shfl_xor(mx, o));
    if (F.lane == 0) { float old = red[0]; while (mx > old) { const unsigned prev = atomicCAS((unsigned*)&red[0], __float_as_uint(old), __float_as_uint(mx)); if (prev == __float_as_uint(old)) break; old = __uint_as_float(prev); } }
    __syncthreads();
    mx = red[0];
    __syncthreads();
    float sum = 0.f;
    for (int s = F.tid; s <= t; s += 512) {
        if (masked) { const int tl = s >> 6; const unsigned long long w = MK[idxr::moff(tl) + (t - 64 * tl)]; if (!((w >> (s & 63)) & 1ull)) continue; }
        float lg = 0.f; for (int d = 0; d < 64; ++d) lg += bf2f(Q[row * 512 + hq * 64 + d]) * bf2f(K[((size_t)b * SEQ + s) * 512 + hq * 64 + d]);
        const float p = exp2f(lg - mx); sum += p;
        for (int d = 0; d < 64; ++d) atomicAdd((float*)&red[2 + d], p * bf2f(V[((size_t)b * SEQ + s) * 512 + hv * 64 + d]));
    }
    atomicAdd((float*)&red[1], sum);
    __syncthreads();
    if (F.tid < 64) { const float want = red[2 + F.tid] / red[1], got = bf2f(O[row * 512 + hv * 64 + F.tid]);
        if (!close_to(got, want, 0.03f, 0.003f)) chk_fail(F, masked ? 0x220u : 0x210u); }
    __syncthreads();
}
__device__ __forceinline__ void chk_mask(Frame& F) {
    LAS float* sc = (LAS float*)(F.lds + RING_OFF);
    LAS unsigned* cnt = (LAS unsigned*)(F.lds + XTR_OFF + 2048);
    if (F.vcu >= 64) return;
    const unsigned h = hash32((unsigned)F.vcu * 31337u + 99u);
    const int b = F.vcu & 1, t = (F.vcu < 6) ? (int)(h % 400u) : (int)(h % (unsigned)SEQ);
    const bf16* IQ = (const bf16*)(F.ws + WS_DQ + 6 * TSTRIDE); const bf16* IK = (const bf16*)(F.ws + WS_IK); const float* IW = (const float*)(F.ws + WS_IW);
    const unsigned long long* MK = (const unsigned long long*)(F.ws + WS_MASK) + (size_t)b * MASK_BSTRIDE;
    const size_t row = (size_t)b * SEQ + t;
    if (F.tid < 2) cnt[F.tid] = 0u;
    for (int s = F.tid; s <= t; s += 512) { float tot = 0.f;
        for (int hh = 0; hh < 8; ++hh) { float d = 0.f; for (int e = 0; e < 64; ++e) d += bf2f(IQ[row * 512 + hh * 64 + e]) * bf2f(IK[((size_t)b * SEQ + s) * 64 + e]); tot += IW[row * 8 + hh] * fmaxf(d, 0.f); }
        sc[s] = tot; }
    __syncthreads();
    for (int s = F.tid; s <= t; s += 512) { const float v = sc[s]; int rk = 0;
        for (int s2 = 0; s2 <= t; ++s2) { const float v2 = sc[s2]; rk += (v2 > v || (v2 == v && s2 < s)) ? 1 : 0; }
        const bool want = rk < 256; const int tl = s >> 6; const bool got = (MK[idxr::moff(tl) + (t - 64 * tl)] >> (s & 63)) & 1ull;
        if (want != got) atomicAdd((unsigned*)&cnt[0], 1u); if (got) atomicAdd((unsigned*)&cnt[1], 1u); }
    __syncthreads();
    if (F.tid == 0) { const unsigned expect = (t + 1 < 256) ? (unsigned)(t + 1) : 256u; if (cnt[1] != expect) chk_fail(F, 0x230u); else if (cnt[0] > 8u) chk_fail(F, 0x231u); }
    __syncthreads();
}
__device__ __forceinline__ void chk_pre1(Frame& F) {
    LAS float* mg = (LAS float*)(F.lds + RING_OFF);
    const float* x = (const float*)INP(0); const float* w_in = (const float*)INP(3); const float* wbd = (const float*)INP(6); const float* wbs = (const float*)INP(7); const float* wo = (const float*)INP(8);
    const bf16* YA = (const bf16*)(F.ws + WS_YA); const bf16* YB = (const bf16*)(F.ws + WS_YB); const bf16* PRE = (const bf16*)(F.ws + WS_PRE1);
    const int m = (int)(hash32((unsigned)F.vcu * 7919u + 3u) % (unsigned)NTOK);
    for (int c = F.tid; c < 1024; c += 512) { float ga = 0.f, gb = 0.f, pa = 0.f, pb = 0.f;
        for (int k = 0; k < 1024; ++k) { const float xv = bf2f((unsigned short)f2bf(x[(size_t)m * 1024 + k])); ga += xv * w_in[(size_t)k * WIN_OLD + 3656 + c]; gb += xv * w_in[(size_t)k * WIN_OLD + 4680 + c]; }
        for (int k = 0; k < 512; ++k) { pa += bf2f(YA[(size_t)m * 512 + k]) * wbd[(size_t)k * 1024 + c]; pb += bf2f(YB[(size_t)m * 512 + k]) * wbs[(size_t)k * 1024 + c]; }
        mg[c] = pa / (1.f + expf(-ga)) + pb / (1.f + expf(-gb)); }
    __syncthreads();
    for (int c = F.tid; c < 1024; c += 512) { float mix = 0.f; for (int k = 0; k < 1024; ++k) mix += mg[k] * wo[(size_t)k * 1024 + c];
        const float want = ALPHA * x[(size_t)m * 1024 + c] + mix, got = bf2f(PRE[(size_t)m * 1024 + c]);
        if (!close_to(got, want, 0.015f, 0.015f)) chk_fail(F, 0x300u); }
    __syncthreads();
}
__device__ __forceinline__ void chk_ffn(Frame& F) {
    LAS float* lgs = (LAS float*)(F.lds + RING_OFF);
    const bf16* X1 = (const bf16*)(F.ws + WS_XB); const float* wrg = (const float*)INP(11); const float* brg = (const float*)INP(12); const float* wre = (const float*)INP(13); const float* bre = (const float*)INP(14);
    const float* wg = (const float*)INP(15); const float* wu = (const float*)INP(16); const float* wd = (const float*)INP(17); const float* wple = (const float*)INP(18); const float* wpg = (const float*)INP(19); const float* p = (const float*)INP(1);
    const bf16* Y0 = (const bf16*)(F.ws + WS_Y0); const bf16* Y1 = (const bf16*)(F.ws + WS_Y1); const bf16* PLE = (const bf16*)(F.ws + WS_PLE);
    const int m = (int)(hash32((unsigned)F.vcu * 104729u + 11u) % (unsigned)NTOK);
    if (F.tid < 36) { float s = 0.f; for (int k = 0; k < 1024; ++k) s += bf2f(X1[(size_t)m * 1024 + k]) * (F.tid < 4 ? wrg[k * 4 + F.tid] : wre[k * 32 + F.tid - 4]); lgs[F.tid] = s + (F.tid < 4 ? brg[F.tid] : bre[F.tid - 4]); }
    __syncthreads();
    int gi = 0; for (int i = 1; i < 4; ++i) if (lgs[i] > lgs[gi]) gi = i;
    float gs = 0.f; for (int i = 0; i < 4; ++i) gs += expf(lgs[i] - lgs[gi]); const float gval = 1.f / gs;
    int i0 = 0; for (int k = 1; k < 8; ++k) if (lgs[4 + gi * 8 + k] > lgs[4 + gi * 8 + i0]) i0 = k;
    int i1 = (i0 == 0) ? 1 : 0; for (int k = 0; k < 8; ++k) if (k != i0 && lgs[4 + gi * 8 + k] > lgs[4 + gi * 8 + i1]) i1 = k;
    const float l0 = lgs[4 + gi * 8 + i0], l1 = lgs[4 + gi * 8 + i1], c0 = gval / (1.f + expf(l1 - l0)), c1 = gval - c0;
    __syncthreads();
    { const int sl = F.tid >> 8, f = F.tid & 255, e = gi * 8 + (sl ? i1 : i0); const float* G = wg + (size_t)e * 1024 * 256; const float* U = wu + (size_t)e * 1024 * 256; float g = 0.f, u = 0.f;
      for (int k = 0; k < 1024; ++k) { const float xv = bf2f(X1[(size_t)m * 1024 + k]); g += xv * G[(size_t)k * 256 + f]; u += xv * U[(size_t)k * 256 + f]; }
      lgs[64 + F.tid] = g / (1.f + expf(-g)) * u * (sl ? c1 : c0); }
    __syncthreads();
    for (int c = F.tid; c < 1024; c += 512) { float y = 0.f;
        for (int sl = 0; sl < 2; ++sl) { const int e = gi * 8 + (sl ? i1 : i0); const float* D = wd + (size_t)e * 256 * 1024; for (int f = 0; f < 256; ++f) y += lgs[64 + sl * 256 + f] * D[(size_t)f * 1024 + c]; }
        const float goty = bf2f(Y0[(size_t)m * 1024 + c]) + bf2f(Y1[(size_t)m * 1024 + c]);
        if (!close_to(goty, y, 0.03f, 0.004f)) chk_fail(F, 0x400u);
        float gt = 0.f, tp = 0.f; for (int k = 0; k < 1024; ++k) gt += bf2f(X1[(size_t)m * 1024 + k]) * wpg[(size_t)k * 1024 + c]; for (int k = 0; k < 256; ++k) tp += p[(size_t)m * 256 + k] * wple[(size_t)k * 1024 + c];
        const float wantp = tp / (1.f + expf(-gt)), gotp = bf2f(PLE[(size_t)m * 1024 + c]);
        if (!close_to(gotp, wantp, 0.03f, 0.01f)) chk_fail(F, 0x410u); }
    __syncthreads();
}
#endif

#ifndef PHSEL
#define PHSEL 0xFFF
#endif
#define PHON(k) (((PHSEL) >> (k)) & 1)
#ifndef DUP
#define DUP 0
#endif
#define DUPREP(k) for (int rep_ = 0; rep_ < (((DUP) >> (k)) & 1) + 1; ++rep_)
__global__ void __launch_bounds__(NWAVES * 64, 2) skel_fwd(Args args) {
    extern __shared__ __attribute__((aligned(16))) unsigned char lds[];
    Frame F;
    F.lds = (LAS unsigned char*)lds;
    F.MISC = (volatile LAS unsigned*)(F.lds + MISC_OFF);
    F.tid = threadIdx.x; F.lane = F.tid & 63; F.wave = __builtin_amdgcn_readfirstlane(F.tid >> 6);
    F.G = gridDim.x; F.bx = blockIdx.x; { const int bx = blockIdx.x; F.vcu = (F.G % 8 == 0) ? (bx % 8) * (F.G / 8) + bx / 8 : bx; }
    F.ws = F.ws0 = args.ws; F.out = F.out0 = args.out; F.ap = &args;
    F.ctl = (gu32*)(F.ws + WS_CTL);
    for (int u = F.tid; u < (MISC_OFF + 128 - XTR_OFF) / 4; u += NWAVES * 64) ((LAS unsigned*)(F.lds + XTR_OFF))[u] = 0u;
    __syncthreads();
#if MK_PER_PHASE
    XcdBarrier bar; bar.bar = (unsigned*)(F.ctl + CW_BAR); bar.x = 0; bar.st = nullptr;
#define GRID_BAR() do { if (F.tid == 0) __hip_atomic_store(F.ctl + CW_TMO, 0xBADBA0u, RLX_AGENT); } while (0)
#else
    XcdBarrier bar = xcd_barrier_post((unsigned*)(F.ctl + CW_BAR), F.MISC + 8);
#ifndef IDLEPROBE
#define IDLEPROBE 0
#endif
#if IDLEPROBE
#define GRID_BAR() do { const unsigned long long t0_ = rt(); xcd_barrier(bar); if (F.tid == 0) __hip_atomic_fetch_add(F.ctl + 12288 + seam_no, (unsigned)(rt() - t0_), RLX_AGENT); ++seam_no; } while (0)
#else
#define GRID_BAR() xcd_barrier(bar)
#endif
#endif
    const int lo = args.ph_lo, hi = args.ph_hi;
    int seam_no = 0; (void)seam_no;
#define IN(k) (lo <= (k) && (k) < hi)
#define SEAM(k) do { if (IN(k) && IN((k) + 1)) GRID_BAR(); } while (0)
#define PHASE_ENTER() { size_t zo_ = 0; asm volatile("" : "+s"(zo_)); F.ws = F.ws0 + zo_; F.out = F.out0 + zo_; } F.vcu = __builtin_amdgcn_readfirstlane(F.vcu); asm volatile("" : "+s"(F.vcu), "+s"(F.G), "+s"(F.bx)); asm volatile("" : "+s"(F.lds)); F.tid = ltid(F.wave); F.lane = F.tid & 63; unsigned char* const ws = F.ws; bf16* const XB = (bf16*)(ws + WS_XB); (void)XB
    for (int l = 0; l < DEPTH; ++l) {
        const int pb = l * NPH_LAYER;
        if (PHON(0) && IN(pb + 0)) DUPREP(0) { PHASE_ENTER(); pw_phase(F, l); }
        SEAM(pb + 0);
        if (PHON(1) && IN(pb + 1)) DUPREP(1) { PHASE_ENTER();
            pg8::Gemm g{XB, (const bf16*)(ws + WS_WB + WB_WIN), 1024, 1024, 1024, nullptr}; pg8::StaticOrder S; S.init(NTOK, P1_N, F.G, F.bx, 1024);
            pg8::EpiProj E{(bf16*)(ws + WS_DQ), TSTRIDE / 2, (bf16*)(ws + WS_IK), (float*)(ws + WS_IW), (const float*)(ws + WS_ROPE)};
            pg8::gemm_phase<pg8::EpiProj, pg8::StaticOrder, true>(F.lds + RING_OFF, g, S, E, F.wave);
            { pg8::Gemm g2{(const bf16*)(ws + WS_PB), (const bf16*)(ws + WS_WB + WB_WPLE), 256, 256, 256, nullptr};
                TailSched S2{(F.bx >= 128) ? (F.bx - 128) * 3 : 384 + F.bx, (F.bx >= 128) ? 3 : 1, 256L * 256};
                pg8::EpiStore E2{(bf16*)((unsigned char*)F.out + OUT_T1), 1024}; pg8::gemm_phase<pg8::EpiStore, TailSched, true>(F.lds + RING_OFF, g2, S2, E2, F.wave); }
        }
        SEAM(pb + 1);
        if (PHON(2) && IN(pb + 2)) DUPREP(2) { PHASE_ENTER();
            const bf16* IQ = (const bf16*)(ws + WS_DQ + 6 * TSTRIDE); const bf16* IK = (const bf16*)(ws + WS_IK); const float* IW = (const float*)(ws + WS_IW);
            for (int p = F.vcu; p < 256; p += F.G) { const int b = p >> 7, s = p & 127;
                unsigned long long* m32 = (unsigned long long*)(ws + WS_MASK) + (size_t)b * MASK_BSTRIDE;
                for (int k2 = 0; k2 < 2; ++k2) indexer_unit(F, b, k2 ? s : 255 - s, IQ, IK, IW, m32); }
        }
        SEAM(pb + 2);
        if (PHON(3) && IN(pb + 3)) DUPREP(3) { PHASE_ENTER();
            using attn_body::bf16;
            const bf16* DQ = (const bf16*)(ws + WS_DQ); const bf16* DK = (const bf16*)(ws + WS_DQ + TSTRIDE); const bf16* DV = (const bf16*)(ws + WS_DQ + 2 * TSTRIDE);
            LAS unsigned* qslot = (LAS unsigned*)(F.lds + MISC_OFF + 64);
            gu32* qctr = F.ctl + CW_QUEUE + l * 64;
            LAS unsigned* const badp = (LAS unsigned*)(F.lds + MISC_OFF + 80); constexpr int BADOFF = MISC_OFF + 80 - RING_OFF;
#define GRAB(ctr_, u_) do { __syncthreads(); if (F.tid == 0) { *qslot = __hip_atomic_fetch_add((ctr_), 1u, RLX_AGENT); *badp = 0u; } __syncthreads(); u_ = (int)*qslot; } while (0)
#ifndef DUPW
#define DUPW 0
#endif
            for (int dw_ = 0; dw_ <= DUPW; ++dw_)
            for (;;) { int u; GRAB(qctr + 8 * dw_, u); if (u >= 512) break;
                const int qb = 63 - (u >> 3), a = u & 7, b = a >> 2, h = a & 3;
#pragma unroll 1
                for (int c = 0; c < 2; ++c) {
                    bf16* O = (bf16*)(ws + (c ? WS_O1 : WS_O0));
                    attn_body::attn_unit<8, false, true, true>(b, 2 * h + c, 2 * h, qb, DQ, DK, DV, O, nullptr, (char*)lds + RING_OFF, F.wave, BADOFF);
#if !(CHK && MK_PER_PHASE)
                    if (*(volatile LAS unsigned*)badp) { __syncthreads(); if (F.tid == 0) *badp = 0u;
                        attn_body::attn_unit<8, false, true, false>(b, 2 * h + c, 2 * h, qb, DQ, DK, DV, O, nullptr, (char*)lds + RING_OFF, F.wave, BADOFF); }
#endif
                }
                VM_WAIT(); __syncthreads(); __builtin_amdgcn_fence(__ATOMIC_ACQUIRE, "agent");
                ya_unit(F, l, b, h, qb);
            }
            const bf16* SQ = (const bf16*)(ws + WS_DQ + 3 * TSTRIDE); const bf16* SK = (const bf16*)(ws + WS_DQ + 4 * TSTRIDE); const bf16* SV = (const bf16*)(ws + WS_DQ + 5 * TSTRIDE);
            attn_body::mask_table_init((char*)lds + RING_OFF, F.tid);
#ifndef DUPS
#define DUPS 0
#endif
            for (int ds_ = 0; ds_ <= DUPS; ++ds_)
            for (;;) { int u; GRAB(qctr + 32 + 8 * ds_, u); if (u >= 1024) break;
                const int qb = 63 - (u >> 4), a = u & 15, b = a >> 3, h = a & 7;
                const unsigned long long* MK = (const unsigned long long*)(ws + WS_MASK) + (size_t)b * MASK_BSTRIDE;
                attn_body::attn_unit<8, true, false, true>(b, h, h, qb, SQ, SK, SV, (bf16*)(ws + WS_YB), MK, (char*)lds + RING_OFF, F.wave, BADOFF);
#if !(CHK && MK_PER_PHASE)
                if (*(volatile LAS unsigned*)badp) attn_body::attn_unit<8, true, false, false>(b, h, h, qb, SQ, SK, SV, (bf16*)(ws + WS_YB), MK, (char*)lds + RING_OFF, F.wave, BADOFF);
#endif
                }
#undef GRAB
        }
        SEAM(pb + 3);
        if (PHON(5) && IN(pb + 5)) DUPREP(5) { PHASE_ENTER();
#define RELA() { size_t zo_ = 0; asm volatile("" : "+s"(zo_)); F.ws = F.ws0 + zo_; } unsigned char* const ws = F.ws; bf16* const XB = (bf16*)(ws + WS_XB); (void)XB; const bf16* WIN = (const bf16*)(ws + WS_WB + WB_WIN); bf16* MG = (bf16*)(ws + WS_MERGED); unsigned char* G1 = ws + WS_TMPG; unsigned char* G2 = ws + WS_TMPG + 32 * MiB; (void)WIN; (void)MG; (void)G1; (void)G2
            { RELA(); pg8::Gemm g{(const bf16*)((unsigned char*)F.out + OUT_XB8), (const bf16*)(ws + WS_WB + WB_WG8), 512, 512, 512, nullptr}; pg8::StaticOrder S; S.init(NTOK, 1024, F.G, F.bx, 512);
              pg8::EpiSig E{G1, 1024, 1.f / 64.f}; pg8::gemm_phase<pg8::EpiSig, pg8::StaticOrder, true, false, true>(F.lds + RING_OFF, g, S, E, F.wave); }
            { RELA(); pg8::Gemm g{(const bf16*)((unsigned char*)F.out + OUT_XB8), (const bf16*)(ws + WS_WB + WB_WG8 + (size_t)1024 * 1024), 512, 512, 512, nullptr}; pg8::StaticOrder S; S.init(NTOK, 1024, F.G, F.bx, 512);
              pg8::EpiSig E{G2, 1024, 1.f / 64.f}; pg8::gemm_phase<pg8::EpiSig, pg8::StaticOrder, true, false, true>(F.lds + RING_OFF, g, S, E, F.wave); }
            VM_WAIT(); __builtin_amdgcn_fence(__ATOMIC_ACQUIRE, "agent"); VM_WAIT();
            { RELA(); pg8::Gemm g{(const bf16*)(ws + WS_YA), (const bf16*)(ws + WS_WB + WB_WBD), 512, 512, 512, nullptr}; pg8::StaticOrder S; S.init(NTOK, 1024, F.G, F.bx, 512);
              pg8::EpiGatedT<false> E{G1, nullptr, MG, 1024}; pg8::gemm_phase<pg8::EpiGatedT<false>, pg8::StaticOrder, true>(F.lds + RING_OFF, g, S, E, F.wave); }
            VM_WAIT(); __builtin_amdgcn_fence(__ATOMIC_ACQUIRE, "agent"); VM_WAIT();
            { RELA(); pg8::Gemm g{(const bf16*)(ws + WS_YB), (const bf16*)(ws + WS_WB + WB_WBS), 512, 512, 512, nullptr}; pg8::StaticOrder S; S.init(NTOK, 1024, F.G, F.bx, 512);
              pg8::EpiGatedT<true> E{G2, MG, MG, 1024}; if (!(DBG & 4)) pg8::gemm_phase<pg8::EpiGatedT<true>, pg8::StaticOrder, true>(F.lds + RING_OFF, g, S, E, F.wave); }
        }
        SEAM(pb + 5);
        if (PHON(6) && IN(pb + 6)) DUPREP(6) { PHASE_ENTER();
            pg8::Gemm g{(const bf16*)(ws + WS_MERGED), (const bf16*)(ws + WS_WB + WB_WO), 1024, 1024, 1024, nullptr}; pg8::StaticOrder S; S.init(NTOK, 1024, F.G, F.bx, 1024);
            pg8::EpiResBf16 E{XB, (bf16*)(ws + WS_PRE1), ALPHA}; pg8::gemm_phase<pg8::EpiResBf16, pg8::StaticOrder, true>(F.lds + RING_OFF, g, S, E, F.wave);
        }
        SEAM(pb + 6);
        if (PHON(7) && IN(pb + 7)) DUPREP(7) { PHASE_ENTER(); ln1_router_phase(F, l); }
        SEAM(pb + 7);
        if (PHON(8) && IN(pb + 8)) DUPREP(8) { PHASE_ENTER(); lists_phase(F, l); }
        SEAM(pb + 8);
        if (PHON(9) && IN(pb + 9)) DUPREP(9) { PHASE_ENTER();
            const int T = build_tile_table(F);
            pg8::Gemm g{(const bf16*)((unsigned char*)F.out + OUT_X1B8), (const bf16*)(ws + WS_WB + WB_WGU), 512, 512, 512, (const int*)(ws + WS_ROUTE + RT_ROW)};
            GroupSched S{2 * T, F.G, F.vcu, 1, (const LAS int*)(F.lds + XTR_OFF), 512L * 512, 256L * 512};
            pg8::EpiGU E{(bf16*)(ws + WS_HG), (const float*)(ws + WS_ROUTE + RT_CW), 1.f / 64.f};
            pg8::gemm_phase<pg8::EpiGU, GroupSched, true, true, true>(F.lds + RING_OFF, g, S, E, F.wave);
        }
        SEAM(pb + 9);
        if (PHON(10) && IN(pb + 10)) DUPREP(10) { PHASE_ENTER();
            const int T = build_tile_table(F);
#ifndef P10SEL
#define P10SEL 7
#endif
            if (P10SEL & 1) { RELA(); pg8::Gemm g{(const bf16*)(ws + WS_HG), (const bf16*)(ws + WS_WB + WB_WD), 256, 256, 256, nullptr};
              GroupSched S{4 * T, F.G, F.vcu, 2, (const LAS int*)(F.lds + XTR_OFF), 1024L * 256, 256L * 256};
              pg8::EpiDown E{(const int*)(ws + WS_ROUTE + RT_ENT), (bf16*)(ws + WS_Y0), (unsigned)(WS_Y1 - WS_Y0)};
              pg8::gemm_phase<pg8::EpiDown, GroupSched, true>(F.lds + RING_OFF, g, S, E, F.wave); }
            if (P10SEL & 4) { RELA(); pg8::Gemm g{(const bf16*)((unsigned char*)F.out + OUT_X1B8), (const bf16*)(ws + WS_WB + WB_WPG), 512, 512, 512, nullptr}; pg8::StaticOrder S; S.init(NTOK, 1024, F.G, F.bx, 512);
              pg8::EpiPle E{(const bf16*)((unsigned char*)F.out + OUT_T1), (bf16*)(ws + WS_PLE), 1.f / 64.f}; pg8::gemm_phase<pg8::EpiPle, pg8::StaticOrder, true, false, true>(F.lds + RING_OFF, g, S, E, F.wave); }
        }
        SEAM(pb + 10);
        if (PHON(11) && IN(pb + 11)) DUPREP(11) { PHASE_ENTER(); ln2_phase(F, l); }
        if (l + 1 < DEPTH) SEAM(pb + 11);
    }
#if IDLEPROBE
    xcd_barrier(bar);
    if (blockIdx.x == 0 && F.tid == 0) { unsigned long long tot = 0; for (int k = 0; k < 23; ++k) if ((IDLEPROBE >> k) & 1) tot += __hip_atomic_load(F.ctl + 12288 + k, RLX_AGENT);
        const unsigned long long t0 = rt(), dur = tot / 256; while (rt() - t0 < dur) __builtin_amdgcn_s_sleep(8); }
#endif
#undef IN
#undef SEAM
}

#if CHK
__global__ void __launch_bounds__(NWAVES * 64, 2) chk_kernel(Args args, int which) {
    extern __shared__ __attribute__((aligned(16))) unsigned char lds[];
    Frame F;
    F.lds = (LAS unsigned char*)lds; F.MISC = (volatile LAS unsigned*)(F.lds + MISC_OFF);
    F.tid = threadIdx.x; F.lane = F.tid & 63; F.wave = __builtin_amdgcn_readfirstlane(F.tid >> 6);
    F.G = gridDim.x; F.bx = blockIdx.x; { const int bx = blockIdx.x; F.vcu = (F.G % 8 == 0) ? (bx % 8) * (F.G / 8) + bx / 8 : bx; }
    F.ws = F.ws0 = args.ws; F.out = F.out0 = args.out; F.ap = &args; F.ctl = (gu32*)(F.ws + WS_CTL);
    if (which == 1) chk_proj(F);
    if (which == 2) chk_attn(F);
    if (which == 4) chk_mask(F);
    if (which == 8) chk_pre1(F);
    if (which == 16) chk_ffn(F);
}
#endif
extern "C" void kernel_launch(void* const* d_in, const int* in_sizes, int n_in, void* d_out, int out_size, void* d_ws, size_t ws_size, hipStream_t stream) {
    static int grid = 0;
    if (grid == 0) {
        if (n_in != 22 || in_sizes[0] != NTOK * DMODEL || out_size != NTOK * DMODEL || ws_size < WS_END) { fprintf(stderr, "kernel_launch: unexpected problem geometry (n_in %d, ws %zu); nothing launched\n", n_in, ws_size); grid = -1; return; }
        int dev = 0, cus = 0, per_cu = 0;
        if (hipGetDevice(&dev) != hipSuccess || hipDeviceGetAttribute(&cus, hipDeviceAttributeMultiprocessorCount, dev) != hipSuccess) { grid = -1; return; }
        if (hipFuncSetAttribute((const void*)skel_fwd, hipFuncAttributeMaxDynamicSharedMemorySize, LDS_BYTES) != hipSuccess) { fprintf(stderr, "kernel_launch: hipFuncSetAttribute failed\n"); grid = -1; return; }
        if (hipOccupancyMaxActiveBlocksPerMultiprocessor(&per_cu, (const void*)skel_fwd, NWAVES * 64, LDS_BYTES) != hipSuccess || per_cu < 1) { fprintf(stderr, "kernel_launch: occupancy query reports %d\n", per_cu); }
        (void)hipGetLastError();
        if (cus < 256) { fprintf(stderr, "kernel_launch: needs 256 CUs (got %d)\n", cus); grid = -1; return; }
        grid = 256;
    }
    if (grid < 0) return;
    if (hipMemsetAsync((char*)d_ws + WS_CTL, 0, CTL_ZERO_BYTES, stream) != hipSuccess) return;
    Args a{};
    for (int i = 0; i < 22; ++i) a.in[i] = d_in[i];
    a.out = (float*)d_out; a.ws = (unsigned char*)d_ws;
#if MK_PER_PHASE
    for (int ph = 0; ph < NPHASE; ++ph) { a.ph_lo = ph; a.ph_hi = ph + 1; hipLaunchKernelGGL(skel_fwd, dim3(grid), dim3(NWAVES * 64), LDS_BYTES, stream, a);
#if CHK
        static bool chk_set = false; if (!chk_set) { (void)hipFuncSetAttribute((const void*)chk_kernel, hipFuncAttributeMaxDynamicSharedMemorySize, LDS_BYTES); chk_set = true; }
        if (ph == 1 && (CHK & 1)) hipLaunchKernelGGL(chk_kernel, dim3(grid), dim3(NWAVES * 64), LDS_BYTES, stream, a, 1);
        if (ph == 3 && (CHK & 2)) hipLaunchKernelGGL(chk_kernel, dim3(grid), dim3(NWAVES * 64), LDS_BYTES, stream, a, 2);
        if (ph == 3 && (CHK & 4)) hipLaunchKernelGGL(chk_kernel, dim3(grid), dim3(NWAVES * 64), LDS_BYTES, stream, a, 4);
        if (ph == 6 && (CHK & 8)) hipLaunchKernelGGL(chk_kernel, dim3(grid), dim3(NWAVES * 64), LDS_BYTES, stream, a, 8);
        if (ph == 10 && (CHK & 16)) hipLaunchKernelGGL(chk_kernel, dim3(grid), dim3(NWAVES * 64), LDS_BYTES, stream, a, 16);
#endif
    }
#else
    a.ph_lo = 0; a.ph_hi = NPHASE;
    hipLaunchKernelGGL(skel_fwd, dim3(grid), dim3(NWAVES * 64), LDS_BYTES, stream, a);
#endif
}
```
